# Optimizing an MI355X kernel written in HIP

```python
import math
import numpy as np
import jax
import jax.numpy as jnp
from jax import lax

D_MODEL = 1024
BATCH = 16
SEQ = 4096
DEPTH = 4

HEAD_DIM = 64
NSA_Q_HEADS = 8
NSA_KV_HEADS = 2
NSA_GROUP = NSA_Q_HEADS // NSA_KV_HEADS
NSA_WIDTH = NSA_Q_HEADS * HEAD_DIM
CMP_LEN = 32
CMP_STRIDE = 16
CMP_HIDDEN = 256
SEL_LEN = 64
SEL_TOPK = 16
WINDOW = 512
NSA_Q_BLOCK = 64
ROPE_THETA = 10000.0
HALF_DIM = HEAD_DIM // 2
FORCED_SCORE = 1e9
NEG_INF = -1e30
CONV_WIDTH = 256
CONV_LEN = 31
S5_WIDTH = 256
S5_GROUP_CH = 16
S5_GROUPS = S5_WIDTH // S5_GROUP_CH
S5_STATE = 64
DT_MIN = 1e-3
DT_MAX = 1e-1
MIX_WIDTH = NSA_WIDTH + CONV_WIDTH + S5_WIDTH
KV_WIDTH = 6 * NSA_KV_HEADS * HEAD_DIM
GATE_WIDTH = 3 * NSA_Q_HEADS
IN_WIDTH = NSA_WIDTH + KV_WIDTH + GATE_WIDTH + 2 * CONV_WIDTH + S5_WIDTH
SPLIT_POINTS = (NSA_WIDTH,
                NSA_WIDTH + KV_WIDTH,
                NSA_WIDTH + KV_WIDTH + GATE_WIDTH,
                NSA_WIDTH + KV_WIDTH + GATE_WIDTH + 2 * CONV_WIDTH)
D_FF = 2816
N_EXPERTS = 8
TOP_K = 2
D_FF_EXPERT = 3584
N_DENSE = (DEPTH + 1) // 2
N_MOE = DEPTH // 2
PLE_DIM = 256
POS_OFFSET_MAX = 4096
ALPHA = (2 * DEPTH) ** 0.25
BETA = (8 * DEPTH) ** -0.25
LN_EPS = 1e-5

kernel_name = "hybrid_nsa_conformer_s5_moe_deepnorm"


def layer_norm(x, g, b):
    xf = x.astype(jnp.float32)
    mu = xf.mean(-1, keepdims=True)
    var = jnp.square(xf - mu).mean(-1, keepdims=True)
    return ((xf - mu) * lax.rsqrt(var + LN_EPS) * g + b).astype(x.dtype)


def masked_softmax(s, mask):
    s = jnp.where(mask, s, NEG_INF)
    m = s.max(-1, keepdims=True)
    e = jnp.where(mask, jnp.exp(s - m), 0.0)
    return e / jnp.maximum(e.sum(-1, keepdims=True), 1e-30)


def rope_tables(positions):
    inv_freq = ROPE_THETA ** (-jnp.arange(0, HEAD_DIM, 2, dtype=jnp.float32) / HEAD_DIM)
    ang = positions[..., None].astype(jnp.float32) * inv_freq
    return jnp.cos(ang)[:, :, None, :], jnp.sin(ang)[:, :, None, :]


def apply_rope(t, cos, sin):
    tf = t.astype(jnp.float32)
    t1, t2 = tf[..., :HALF_DIM], tf[..., HALF_DIM:]
    return jnp.concatenate([t1 * cos - t2 * sin, t2 * cos + t1 * sin], -1).astype(t.dtype)


def nsa_attention(q, k_cmp, v_cmp, k_sel, v_sel, k_win, v_win, gates,
                  cmp_pe, cmp_w1, cmp_b1, cmp_w2, cmp_b2):
    B, L = q.shape[0], q.shape[1]
    scale = HEAD_DIM ** -0.5
    qg = q.reshape(B, L, NSA_KV_HEADS, NSA_GROUP, HEAD_DIM).transpose(0, 2, 3, 1, 4)
    gg = gates.reshape(B, L, NSA_KV_HEADS, NSA_GROUP, 3).transpose(0, 2, 3, 1, 4)
    to_kv = lambda t: t.transpose(0, 2, 1, 3)

    n_cmp = (L - CMP_LEN) // CMP_STRIDE + 1
    blk_idx = np.arange(n_cmp)[:, None] * CMP_STRIDE + np.arange(CMP_LEN)[None, :]

    def compress(t, j):
        blocks = t[:, :, blk_idx] + cmp_pe[j]
        flat = blocks.reshape(B, NSA_KV_HEADS, n_cmp, CMP_LEN * HEAD_DIM)
        return jax.nn.gelu(flat @ cmp_w1[j] + cmp_b1[j]) @ cmp_w2[j] + cmp_b2[j]

    kc = compress(to_kv(k_cmp), 0)
    vc = compress(to_kv(v_cmp), 1)
    cmp_end = jnp.asarray(np.arange(n_cmp) * CMP_STRIDE + CMP_LEN - 1)

    n_sel = L // SEL_LEN
    topk = min(SEL_TOPK, n_sel)
    c_start = np.arange(n_cmp)[:, None] * CMP_STRIDE
    s_start = np.arange(n_sel)[None, :] * SEL_LEN
    overlap = jnp.asarray(((c_start < s_start + SEL_LEN) & (c_start + CMP_LEN > s_start)).astype(np.float32))
    ks_blocks = to_kv(k_sel).reshape(B, NSA_KV_HEADS, n_sel, SEL_LEN, HEAD_DIM)
    vs_blocks = to_kv(v_sel).reshape(B, NSA_KV_HEADS, n_sel, SEL_LEN, HEAD_DIM)
    gather = jax.vmap(jax.vmap(lambda blk, ix: blk[ix]))
    sel_offsets = jnp.arange(SEL_LEN)
    blk_ids = jnp.arange(n_sel)

    pad = ((0, 0), (0, 0), (WINDOW, 0), (0, 0))
    kw = jnp.pad(to_kv(k_win), pad)
    vw = jnp.pad(to_kv(v_win), pad)

    def block_fn(c):
        q0 = c * NSA_Q_BLOCK
        qc = lax.dynamic_slice_in_dim(qg, q0, NSA_Q_BLOCK, axis=3)
        gc = lax.dynamic_slice_in_dim(gg, q0, NSA_Q_BLOCK, axis=3)
        t = q0 + jnp.arange(NSA_Q_BLOCK)

        s = jnp.einsum('bkgqd,bknd->bkgqn', qc, kc).astype(jnp.float32) * scale
        p_cmp = masked_softmax(s, cmp_end[None, :] <= t[:, None])
        o_cmp = jnp.einsum('bkgqn,bknd->bkgqd', p_cmp, vc)

        imp = jnp.einsum('bkgqn,ns->bkqs', p_cmp, overlap)
        qblk = t // SEL_LEN
        forced = (blk_ids[None, :] == 0) | (blk_ids[None, :] == qblk[:, None]) | (blk_ids[None, :] == qblk[:, None] - 1)
        score = jnp.where(forced, FORCED_SCORE, jnp.where(blk_ids[None, :] <= qblk[:, None], imp, NEG_INF))
        _, idx = lax.top_k(score, topk)
        ks = gather(ks_blocks, idx).reshape(B, NSA_KV_HEADS, NSA_Q_BLOCK, topk * SEL_LEN, HEAD_DIM)
        vs = gather(vs_blocks, idx).reshape(B, NSA_KV_HEADS, NSA_Q_BLOCK, topk * SEL_LEN, HEAD_DIM)
        pos = (idx[..., None] * SEL_LEN + sel_offsets).reshape(B, NSA_KV_HEADS, NSA_Q_BLOCK, topk * SEL_LEN)
        s = jnp.einsum('bkgqd,bkqsd->bkgqs', qc, ks).astype(jnp.float32) * scale
        p_sel = masked_softmax(s, (pos <= t[:, None])[:, :, None])
        o_sel = jnp.einsum('bkgqs,bkqsd->bkgqd', p_sel, vs)

        kwc = lax.dynamic_slice_in_dim(kw, q0, NSA_Q_BLOCK + WINDOW, axis=2)
        vwc = lax.dynamic_slice_in_dim(vw, q0, NSA_Q_BLOCK + WINDOW, axis=2)
        wpos = q0 - WINDOW + jnp.arange(NSA_Q_BLOCK + WINDOW)
        wmask = (wpos[None, :] <= t[:, None]) & (wpos[None, :] > t[:, None] - WINDOW) & (wpos[None, :] >= 0)
        s = jnp.einsum('bkgqd,bksd->bkgqs', qc, kwc).astype(jnp.float32) * scale
        p_win = masked_softmax(s, wmask)
        o_win = jnp.einsum('bkgqs,bksd->bkgqd', p_win, vwc)

        return (gc[..., 0:1] * o_cmp + gc[..., 1:2] * o_sel + gc[..., 2:3] * o_win).astype(q.dtype)

    out = lax.map(block_fn, jnp.arange(L // NSA_Q_BLOCK))
    return out.transpose(1, 0, 4, 2, 3, 5).reshape(B, L, NSA_WIDTH)


def conformer_conv(zc, conv_w, conv_b, ln_g, ln_b):
    u = zc[..., :CONV_WIDTH] * jax.nn.sigmoid(zc[..., CONV_WIDTH:])
    y = lax.conv_general_dilated(u, conv_w[:, None, :].astype(u.dtype), (1,), [(CONV_LEN - 1, 0)],
                                 dimension_numbers=('NWC', 'WIO', 'NWC'),
                                 feature_group_count=CONV_WIDTH) + conv_b
    return jax.nn.silu(layer_norm(y, ln_g, ln_b))


def _complex_linear_combine(e1, e2):
    a1r, a1i, b1r, b1i = e1
    a2r, a2i, b2r, b2i = e2
    return (a2r * a1r - a2i * a1i,
            a2r * a1i + a2i * a1r,
            a2r * b1r - a2i * b1i + b2r,
            a2r * b1i + a2i * b1r + b2i)


def s5_layer(u, a_re, a_im, log_dt, b_re, b_im, c_re, c_im, d_skip, glu_w, glu_b):
    B, L, _ = u.shape
    uf = u.astype(jnp.float32)
    ug = uf.reshape(B, L, S5_GROUPS, S5_GROUP_CH)
    a_re = a_re.astype(jnp.float32)
    a_im = a_im.astype(jnp.float32)
    dt = jnp.exp(log_dt.astype(jnp.float32))[:, None]
    mag = jnp.exp(a_re * dt)
    ab_re = mag * jnp.cos(a_im * dt)
    ab_im = mag * jnp.sin(a_im * dt)
    den = a_re * a_re + a_im * a_im
    coef_re = ((ab_re - 1.0) * a_re + ab_im * a_im) / den
    coef_im = (ab_im * a_re - (ab_re - 1.0) * a_im) / den
    b_re = b_re.astype(jnp.float32)
    b_im = b_im.astype(jnp.float32)
    bb_re = coef_re[..., None] * b_re - coef_im[..., None] * b_im
    bb_im = coef_re[..., None] * b_im + coef_im[..., None] * b_re
    bu_re = jnp.einsum('blgc,gnc->blgn', ug, bb_re)
    bu_im = jnp.einsum('blgc,gnc->blgn', ug, bb_im)
    shape = bu_re.shape
    elems = (jnp.broadcast_to(ab_re, shape), jnp.broadcast_to(ab_im, shape), bu_re, bu_im)
    _, _, h_re, h_im = lax.associative_scan(_complex_linear_combine, elems, axis=1)
    y = (jnp.einsum('blgn,gcn->blgc', h_re, c_re.astype(jnp.float32))
         - jnp.einsum('blgn,gcn->blgc', h_im, c_im.astype(jnp.float32)))
    y = y.reshape(B, L, S5_WIDTH) + d_skip * uf
    z = jax.nn.gelu(y)
    return (z * jax.nn.sigmoid(z @ glu_w + glu_b)).astype(u.dtype)


def hybrid_mixer(x, cos, sin, w_in, w_out, cmp_pe, cmp_w1, cmp_b1, cmp_w2, cmp_b2,
                 conv_w, conv_b, conv_ln_g, conv_ln_b,
                 s5_a_re, s5_a_im, s5_log_dt, s5_b_re, s5_b_im, s5_c_re, s5_c_im,
                 s5_d, s5_glu_w, s5_glu_b):
    B, L, _ = x.shape
    z = x @ w_in
    zq, zkv, zg, zc, zs = jnp.split(z, SPLIT_POINTS, axis=-1)
    q = apply_rope(zq.reshape(B, L, NSA_Q_HEADS, HEAD_DIM), cos, sin)
    kv = zkv.reshape(B, L, 6, NSA_KV_HEADS, HEAD_DIM)
    k_cmp = apply_rope(kv[:, :, 0], cos, sin)
    k_sel = apply_rope(kv[:, :, 2], cos, sin)
    k_win = apply_rope(kv[:, :, 4], cos, sin)
    gates = jax.nn.sigmoid(zg).reshape(B, L, NSA_Q_HEADS, 3)
    o_nsa = nsa_attention(q, k_cmp, kv[:, :, 1], k_sel, kv[:, :, 3], k_win, kv[:, :, 5], gates,
                          cmp_pe, cmp_w1, cmp_b1, cmp_w2, cmp_b2)
    o_conv = conformer_conv(zc, conv_w, conv_b, conv_ln_g, conv_ln_b)
    o_s5 = s5_layer(zs, s5_a_re, s5_a_im, s5_log_dt, s5_b_re, s5_b_im, s5_c_re, s5_c_im,
                    s5_d, s5_glu_w, s5_glu_b)
    return jnp.concatenate([o_nsa, o_conv.astype(o_nsa.dtype), o_s5.astype(o_nsa.dtype)], -1) @ w_out


def swiglu(x, w1, w3, w2):
    return (jax.nn.silu(x @ w1) * (x @ w3)) @ w2


def moe_swiglu(x, router, w1, w3, w2):
    logits = (x @ router).astype(jnp.float32)
    top_vals, top_idx = lax.top_k(logits, TOP_K)
    wts = jax.nn.softmax(top_vals, axis=-1)
    comb = jnp.einsum('blk,blke->ble', wts, jax.nn.one_hot(top_idx, N_EXPERTS, dtype=jnp.float32))
    y = jnp.zeros(x.shape, jnp.float32)
    for e in range(N_EXPERTS):
        y = y + comb[..., e:e + 1] * swiglu(x, w1[e], w3[e], w2[e])
    return y.astype(x.dtype)


def setup_inputs(seed: int = 0) -> dict:
    key = jax.random.key(seed)
    keys = iter(jax.random.split(key, 48))
    f32 = jnp.float32

    def nrm(shape, scale):
        return jax.random.normal(next(keys), shape, f32) * scale

    x = nrm((BATCH, SEQ, D_MODEL), 1.0)
    p = nrm((DEPTH, BATCH, SEQ, PLE_DIM), 1.0)
    offsets = jax.random.randint(next(keys), (BATCH, 1), 0, POS_OFFSET_MAX, dtype=jnp.int32)
    positions = offsets + jnp.arange(SEQ, dtype=jnp.int32)[None, :]
    w_in = nrm((DEPTH, D_MODEL, IN_WIDTH), D_MODEL ** -0.5)
    w_out = nrm((DEPTH, MIX_WIDTH, D_MODEL), MIX_WIDTH ** -0.5 * BETA)
    cmp_pe = nrm((DEPTH, 2, CMP_LEN, HEAD_DIM), 0.1)
    cmp_w1 = nrm((DEPTH, 2, CMP_LEN * HEAD_DIM, CMP_HIDDEN), (CMP_LEN * HEAD_DIM) ** -0.5)
    cmp_b1 = nrm((DEPTH, 2, CMP_HIDDEN), 0.02)
    cmp_w2 = nrm((DEPTH, 2, CMP_HIDDEN, HEAD_DIM), CMP_HIDDEN ** -0.5)
    cmp_b2 = nrm((DEPTH, 2, HEAD_DIM), 0.02)
    conv_w = nrm((DEPTH, CONV_LEN, CONV_WIDTH), CONV_LEN ** -0.5)
    conv_b = nrm((DEPTH, CONV_WIDTH), 0.02)
    conv_ln_g = 1.0 + nrm((DEPTH, CONV_WIDTH), 0.02)
    conv_ln_b = nrm((DEPTH, CONV_WIDTH), 0.02)
    s5_a_re = -0.5 + nrm((DEPTH, S5_GROUPS, S5_STATE), 0.01)
    s5_a_im = math.pi * jnp.arange(S5_STATE, dtype=f32) + nrm((DEPTH, S5_GROUPS, S5_STATE), 0.01)
    s5_log_dt = jax.random.uniform(next(keys), (DEPTH, S5_GROUPS), f32,
                                   math.log(DT_MIN), math.log(DT_MAX))
    s5_b_re = nrm((DEPTH, S5_GROUPS, S5_STATE, S5_GROUP_CH), (2 * S5_GROUP_CH) ** -0.5)
    s5_b_im = nrm((DEPTH, S5_GROUPS, S5_STATE, S5_GROUP_CH), (2 * S5_GROUP_CH) ** -0.5)
    s5_c_re = nrm((DEPTH, S5_GROUPS, S5_GROUP_CH, S5_STATE), S5_STATE ** -0.5)
    s5_c_im = nrm((DEPTH, S5_GROUPS, S5_GROUP_CH, S5_STATE), S5_STATE ** -0.5)
    s5_d = nrm((DEPTH, S5_WIDTH), 1.0)
    s5_glu_w = nrm((DEPTH, S5_WIDTH, S5_WIDTH), S5_WIDTH ** -0.5)
    s5_glu_b = nrm((DEPTH, S5_WIDTH), 0.02)
    ffn_w1 = nrm((N_DENSE, D_MODEL, D_FF), D_MODEL ** -0.5)
    ffn_w3 = nrm((N_DENSE, D_MODEL, D_FF), D_MODEL ** -0.5)
    ffn_w2 = nrm((N_DENSE, D_FF, D_MODEL), D_FF ** -0.5 * BETA)
    moe_router = nrm((N_MOE, D_MODEL, N_EXPERTS), D_MODEL ** -0.5)
    moe_w1 = nrm((N_MOE, N_EXPERTS, D_MODEL, D_FF_EXPERT), D_MODEL ** -0.5)
    moe_w3 = nrm((N_MOE, N_EXPERTS, D_MODEL, D_FF_EXPERT), D_MODEL ** -0.5)
    moe_w2 = nrm((N_MOE, N_EXPERTS, D_FF_EXPERT, D_MODEL), D_FF_EXPERT ** -0.5 * BETA)
    ple_gate_w = nrm((DEPTH, D_MODEL, D_MODEL), D_MODEL ** -0.5)
    ple_gate_b = nrm((DEPTH, D_MODEL), 0.02)
    ple_proj = nrm((DEPTH, PLE_DIM, D_MODEL), PLE_DIM ** -0.5 * BETA)
    ln_g = 1.0 + nrm((DEPTH, 3, D_MODEL), 0.02)
    ln_b = nrm((DEPTH, 3, D_MODEL), 0.02)
    return {"x": x, "p": p, "positions": positions, "w_in": w_in, "w_out": w_out,
            "cmp_pe": cmp_pe, "cmp_w1": cmp_w1, "cmp_b1": cmp_b1, "cmp_w2": cmp_w2, "cmp_b2": cmp_b2,
            "conv_w": conv_w, "conv_b": conv_b, "conv_ln_g": conv_ln_g, "conv_ln_b": conv_ln_b,
            "s5_a_re": s5_a_re, "s5_a_im": s5_a_im, "s5_log_dt": s5_log_dt,
            "s5_b_re": s5_b_re, "s5_b_im": s5_b_im, "s5_c_re": s5_c_re, "s5_c_im": s5_c_im,
            "s5_d": s5_d, "s5_glu_w": s5_glu_w, "s5_glu_b": s5_glu_b,
            "ffn_w1": ffn_w1, "ffn_w3": ffn_w3, "ffn_w2": ffn_w2,
            "moe_router": moe_router, "moe_w1": moe_w1, "moe_w3": moe_w3, "moe_w2": moe_w2,
            "ple_gate_w": ple_gate_w, "ple_gate_b": ple_gate_b, "ple_proj": ple_proj,
            "ln_g": ln_g, "ln_b": ln_b}


def reference(x, p, positions, w_in, w_out, cmp_pe, cmp_w1, cmp_b1, cmp_w2, cmp_b2,
              conv_w, conv_b, conv_ln_g, conv_ln_b,
              s5_a_re, s5_a_im, s5_log_dt, s5_b_re, s5_b_im, s5_c_re, s5_c_im,
              s5_d, s5_glu_w, s5_glu_b,
              ffn_w1, ffn_w3, ffn_w2, moe_router, moe_w1, moe_w3, moe_w2,
              ple_gate_w, ple_gate_b, ple_proj, ln_g, ln_b):
    cos, sin = rope_tables(positions)
    for i in range(DEPTH):
        h = hybrid_mixer(x, cos, sin, w_in[i], w_out[i],
                         cmp_pe[i], cmp_w1[i], cmp_b1[i], cmp_w2[i], cmp_b2[i],
                         conv_w[i], conv_b[i], conv_ln_g[i], conv_ln_b[i],
                         s5_a_re[i], s5_a_im[i], s5_log_dt[i], s5_b_re[i], s5_b_im[i],
                         s5_c_re[i], s5_c_im[i], s5_d[i], s5_glu_w[i], s5_glu_b[i])
        x = layer_norm(ALPHA * x + h.astype(x.dtype), ln_g[i, 0], ln_b[i, 0])
        j = i // 2
        if i % 2 == 0:
            f = swiglu(x, ffn_w1[j], ffn_w3[j], ffn_w2[j])
        else:
            f = moe_swiglu(x, moe_router[j], moe_w1[j], moe_w3[j], moe_w2[j])
        x = layer_norm(ALPHA * x + f.astype(x.dtype), ln_g[i, 1], ln_b[i, 1])
        e = (p[i] @ ple_proj[i]) * jax.nn.sigmoid(x @ ple_gate_w[i] + ple_gate_b[i])
        x = layer_norm(ALPHA * x + e.astype(x.dtype), ln_g[i, 2], ln_b[i, 2])
    return x
```

```cpp
#include <hip/hip_runtime.h>
#include <cstdint>
#include <cstdio>
#ifndef MK_MULTI
#define MK_MULTI 0
#endif
#ifndef MK_CHECK
#define MK_CHECK 0
#endif
#ifndef CHK_LAYER
#define CHK_LAYER 15
#endif

#define GAS __attribute__((address_space(1)))
#define LAS __attribute__((address_space(3)))
typedef unsigned short bf16_t;
typedef short bf16x8 __attribute__((ext_vector_type(8)));
typedef float f32x4 __attribute__((ext_vector_type(4)));
typedef float f32x2 __attribute__((ext_vector_type(2)));
typedef float f32x16 __attribute__((ext_vector_type(16)));
typedef unsigned u32x4 __attribute__((ext_vector_type(4)));
typedef unsigned u32x2 __attribute__((ext_vector_type(2)));

constexpr int NB = 16, SEQ = 4096, T = NB * SEQ, D = 1024, DEPTH = 4;
constexpr int INW = 2072, INP = 2304;
constexpr int ZKV = 512, ZG = 1280, ZC = 1304, ZS = 1816;
constexpr int DFF = 2816, DFE = 3584, NEXP = 8, PLE = 256;
constexpr int NCMP = 255;
constexpr int S5LC = 32, S5NCH = SEQ / S5LC, S5K = S5LC * 16 + 128;
constexpr float ALPHA = 1.6817928305074290f;
constexpr float LN_EPS = 1e-5f;
constexpr float QSCALE = 0.125f * 1.4426950408889634f;
constexpr float NEGF = -1e30f;
constexpr int MOE_TILES_MAX = 520, MOE_CHUNK_TILES = 128, MOE_NCHUNK = 5;

typedef __bf16 bf16x2_t __attribute__((ext_vector_type(2)));
__device__ __forceinline__ unsigned cvt_pk_bf16(float lo, float hi) { f32x2 v = {lo, hi}; const bf16x2_t b = __builtin_convertvector(v, bf16x2_t); return __builtin_bit_cast(unsigned, b); }
__device__ __forceinline__ bf16_t f2bf(float f) { return (bf16_t)(cvt_pk_bf16(f, 0.f) & 0xffffu); }
__device__ __forceinline__ float bf2f(unsigned v) { return __uint_as_float(v << 16); }
__device__ __forceinline__ float bflo(unsigned w) { return __uint_as_float(w << 16); }
__device__ __forceinline__ float bfhi(unsigned w) { return __uint_as_float(w & 0xffff0000u); }
__device__ __forceinline__ float fast_exp2(float x) { return __builtin_amdgcn_exp2f(x); }
__device__ __forceinline__ float fast_rcp(float x) { return __builtin_amdgcn_rcpf(x); }
__device__ __forceinline__ float sigmoidf_(float x) { return fast_rcp(1.0f + fast_exp2(-1.4426950408889634f * x)); }
__device__ __forceinline__ float siluf_(float x) { return x * sigmoidf_(x); }
__device__ __forceinline__ float gelu_tanh(float x) { const float u = 0.7978845608028654f * (x + 0.044715f * x * x * x); return x * sigmoidf_(2.0f * u); }
__device__ __forceinline__ float wave_sum(float v) {
#pragma unroll
    for (int o = 1; o < 64; o <<= 1) v += __shfl_xor(v, o);
    return v;
}
#define LDS_WAIT() asm volatile("s_waitcnt lgkmcnt(0)" ::: "memory")
#define VM_WAIT() asm volatile("s_waitcnt vmcnt(0)" ::: "memory")

namespace pg8 {
constexpr int BM = 256, BK = 64, HALF = 128, HTB = HALF * BK * 2, STAGE_BYTES = 8 * HTB, NXCD = 8, WGM = 8;
__host__ __device__ __forceinline__ int lds_byte(int r, int c) { const int st = (r >> 4) * 2 + (c >> 5), rr = r & 15, cc = c & 31, ob = rr * 64 + cc * 2; return st * 1024 + (ob ^ (((ob >> 9) & 1) << 5)); }
__host__ __device__ __forceinline__ void stage_rc(int b, int& R, int& C) { const int st = b / 1024, sb = b % 1024, swz = sb ^ (((sb >> 9) & 1) << 5); R = (st >> 1) * 16 + swz / 64; C = (st & 1) * 32 + (swz % 64) / 2; }
__host__ __device__ __forceinline__ int perm32(int rho) { const int n = rho >> 4, i = rho & 15; return 8 * (i >> 2) + 4 * n + (i & 3); }

struct Unit { int pm, pn; long long offA, offB; int aux; };
struct Gemm { const bf16_t* A; const bf16_t* Bt; int K, lda, ldb; };

__device__ __forceinline__ bool static_tile(int i, int G, int c, int nM, int nN, int& pm, int& pn) {
    const int nwg = nM * nN; const long L = (long)i * G + c; if (L >= nwg) return false;
    int wgid = (int)L; { const int q = nwg / NXCD, r = nwg % NXCD, xcd = wgid % NXCD, off = wgid / NXCD; wgid = (xcd < r ? xcd * (q + 1) : r * (q + 1) + (xcd - r) * q) + off; }
    const int nig = WGM * nN, gid = wgid / nig, fm = gid * WGM, gsz = (nM - fm) < WGM ? (nM - fm) : WGM;
    pm = fm + ((wgid % nig) % gsz); pn = (wgid % nig) / gsz; return true;
}
struct PlainOrder {
    int nM, nN, G, c; long long sA, sB;
    __device__ __forceinline__ bool next(int i, Unit& u) const { if (!static_tile(i, G, c, nM, nN, u.pm, u.pn)) return false; u.offA = (long long)u.pm * sA; u.offB = (long long)u.pn * sB; u.aux = 0; return true; }
};
struct GroupedOrder {
    int ng, nM, nN, G, c; long long sA, sB, gA, gB;
    __device__ __forceinline__ bool next(int i, Unit& u) const {
        const long L = (long)i * G + c; const int per = nM * nN; if (L >= (long)ng * per) return false;
        const int gi = (int)(L / per), r = (int)(L % per); u.pm = r / nN; u.pn = r % nN; u.aux = gi;
        u.offA = (long long)gi * gA + (long long)u.pm * sA; u.offB = (long long)gi * gB + (long long)u.pn * sB; return true; }
};

template <class Epi, class Sched>
__device__ __forceinline__ void gemm_phase(LAS unsigned char* lds, const Gemm g, const Sched& S, const Epi& E) {
    int tid_ = threadIdx.x; asm volatile("" : "+v"(tid_));
    const int tid = tid_, wid = __builtin_amdgcn_readfirstlane(tid >> 6), lane = tid & 63, wr = wid >> 2, wc = wid & 3, fr = lane & 15, fq = lane >> 4;
    int K_ = g.K; asm volatile("" : "+s"(K_));
    const int K = K_, nt = K / BK; (void)K;
    unsigned voffA[2], voffB[2];
#pragma unroll
    for (int i = 0; i < 2; ++i) { int R, C; stage_rc(tid * 16 + i * 8192, R, C); const int Rb = Epi::PERM ? ((R & ~31) + perm32(R & 31)) : R;
        voffA[i] = (unsigned)(R * g.lda + C) * 2u; voffB[i] = (unsigned)(Rb * g.ldb + C) * 2u; }
    const size_t kstep = (size_t)(BK * 2);
    const size_t hstepA = (size_t)HALF * g.lda * 2, hstepB = (size_t)HALF * g.ldb * 2;
    const unsigned ldsw = (unsigned)wid * 1024u;
    const int aoff = lds_byte(wr * 64 + fr, fq * 8), boff = lds_byte(wc * 32 + fr, fq * 8);
#define PG8_SA(b, h) (((b) * 2 + (h)) * HTB)
#define PG8_SB(b, h) ((4 + (b) * 2 + (h)) * HTB)
#define PG8_STAGE(bufoff, gbase, voff) do { _Pragma("unroll") for (int _i = 0; _i < 2; ++_i) \
        __builtin_amdgcn_global_load_lds((const unsigned*)((const char*)(gbase) + (voff)[_i]), (LAS unsigned*)(lds + (bufoff) + ldsw + _i * 8192), 16, 0, 0); } while (0)
#define PG8_LDA(dst, b, h) do { _Pragma("unroll") for (int m = 0; m < 4; ++m) _Pragma("unroll") for (int k = 0; k < 2; ++k) dst[m][k] = *(const LAS bf16x8*)(lds + PG8_SA(b, h) + aoff + m * 2048 + k * 1024); } while (0)
#define PG8_LDB(dst, b, h) do { _Pragma("unroll") for (int n = 0; n < 2; ++n) _Pragma("unroll") for (int k = 0; k < 2; ++k) dst[n][k] = *(const LAS bf16x8*)(lds + PG8_SB(b, h) + boff + n * 2048 + k * 1024); } while (0)
#define PG8_MMA(ai, bj, At, Bt) do { __builtin_amdgcn_s_setprio(1); _Pragma("unroll") for (int m = 0; m < 4; ++m) _Pragma("unroll") for (int n = 0; n < 2; ++n) _Pragma("unroll") for (int k = 0; k < 2; ++k) \
        acc[ai][bj][m][n] = __builtin_amdgcn_mfma_f32_16x16x32_bf16(Bt[n][k], At[m][k], acc[ai][bj][m][n], 0, 0, 0); __builtin_amdgcn_s_setprio(0); } while (0)
#define PG8_WAIT_V(n) asm volatile("s_waitcnt vmcnt(" #n ")" ::: "memory")
#define PG8_WAIT_L(n) asm volatile("s_waitcnt lgkmcnt(" #n ")" ::: "memory")
#define PG8_BAR __builtin_amdgcn_s_barrier()
#define PG8_SCHED __builtin_amdgcn_sched_barrier(0)
    Unit cur, nxt; int ui = 0;
    if (!S.next(0, cur)) return;
    f32x4 acc[2][2][4][2];
#pragma unroll
    for (int a = 0; a < 2; ++a)
#pragma unroll
        for (int b = 0; b < 2; ++b)
#pragma unroll
            for (int m = 0; m < 4; ++m)
#pragma unroll
                for (int n = 0; n < 2; ++n) acc[a][b][m][n] = (f32x4){0.f, 0.f, 0.f, 0.f};
    bf16x8 At[4][2], B0[2][2], B1[2][2];
    const char* cA = (const char*)g.A + cur.offA; const char* cB = (const char*)g.Bt + cur.offB;
    PG8_STAGE(PG8_SB(0, 0), cB, voffB); PG8_STAGE(PG8_SB(0, 1), cB + hstepB, voffB); PG8_STAGE(PG8_SA(0, 0), cA, voffA); PG8_STAGE(PG8_SA(0, 1), cA + hstepA, voffA);
    if (wr == 1) PG8_BAR;
    PG8_WAIT_V(2); PG8_BAR;
    PG8_STAGE(PG8_SB(1, 0), cB + kstep, voffB); PG8_STAGE(PG8_SA(1, 0), cA + kstep, voffA); PG8_STAGE(PG8_SB(1, 1), cB + hstepB + kstep, voffB);
    PG8_WAIT_V(6); PG8_BAR;
    for (;;) {
        const bool has_next = S.next(ui + 1, nxt);
        const char* nA = has_next ? (const char*)g.A + nxt.offA : cA; const char* nB = has_next ? (const char*)g.Bt + nxt.offB : cB;
        for (int t = 0; t < nt; t += 2) {
            const bool last = (t == nt - 2);
            const char* a1 = cA + (size_t)(t + 1) * kstep;
            const char* a2 = last ? nA : cA + (size_t)(t + 2) * kstep; const char* b2 = last ? nB : cB + (size_t)(t + 2) * kstep;
            const char* a3 = a2 + kstep; const char* b3 = b2 + kstep;
            PG8_LDB(B0, 0, 0); PG8_LDB(B1, 0, 1); PG8_SCHED; PG8_LDA(At, 0, 0); PG8_STAGE(PG8_SA(1, 1), a1 + hstepA, voffA);
            PG8_WAIT_V(8); PG8_WAIT_L(0); PG8_BAR; PG8_MMA(0, 0, At, B0); PG8_MMA(0, 1, At, B1); PG8_BAR; PG8_SCHED;
            PG8_LDA(At, 0, 1); PG8_STAGE(PG8_SB(0, 0), b2, voffB); PG8_STAGE(PG8_SB(0, 1), b2 + hstepB, voffB); PG8_STAGE(PG8_SA(0, 0), a2, voffA);
            PG8_WAIT_V(8); PG8_WAIT_L(0); PG8_BAR; PG8_MMA(1, 0, At, B0); PG8_MMA(1, 1, At, B1); PG8_BAR; PG8_SCHED;
            PG8_LDB(B0, 1, 0); PG8_LDB(B1, 1, 1); PG8_SCHED; PG8_LDA(At, 1, 0); PG8_STAGE(PG8_SA(0, 1), a2 + hstepA, voffA);
            PG8_WAIT_V(8); PG8_WAIT_L(0); PG8_BAR; PG8_MMA(0, 0, At, B0); PG8_MMA(0, 1, At, B1); PG8_BAR; PG8_SCHED;
            PG8_LDA(At, 1, 1); PG8_STAGE(PG8_SB(1, 0), b3, voffB); PG8_STAGE(PG8_SB(1, 1), b3 + hstepB, voffB); PG8_STAGE(PG8_SA(1, 0), a3, voffA);
            PG8_WAIT_V(8); PG8_WAIT_L(0); PG8_BAR; PG8_MMA(1, 0, At, B0); PG8_MMA(1, 1, At, B1); PG8_BAR; PG8_SCHED;
        }
        if (wr == 0) PG8_BAR;
        E(acc, cur, wr, wc, fr, fq);
        if (!has_next) break;
#pragma unroll
        for (int a = 0; a < 2; ++a)
#pragma unroll
            for (int b = 0; b < 2; ++b)
#pragma unroll
                for (int m = 0; m < 4; ++m)
#pragma unroll
                    for (int n = 0; n < 2; ++n) acc[a][b][m][n] = (f32x4){0.f, 0.f, 0.f, 0.f};
        cur = nxt; cA = nA; cB = nB; ++ui;
        if (wr == 1) PG8_BAR;
    }
    PG8_WAIT_V(0);
    PG8_BAR;
#undef PG8_SA
#undef PG8_SB
#undef PG8_STAGE
#undef PG8_LDA
#undef PG8_LDB
#undef PG8_MMA
#undef PG8_WAIT_V
#undef PG8_WAIT_L
#undef PG8_BAR
#undef PG8_SCHED
}
}

#define XB_TMO      128
#define XB_XCNT(j)  (256  + 64 * (j))
#define XB_XSUB(j)  (1280 + 64 * (j))
#define XB_XGEN(j)  (2304 + 64 * (j))
#define XB_TOP      3328
#define XB_TOPGEN   3392
#define XCD_BAR_WORDS 3456
#define XB_SPIN_CAP (1u << 20)
__device__ __forceinline__ unsigned xb_ld(unsigned* p)              { return __hip_atomic_load(p, __ATOMIC_RELAXED, __HIP_MEMORY_SCOPE_AGENT); }
__device__ __forceinline__ unsigned xb_add(unsigned* p, unsigned v) { return __hip_atomic_fetch_add(p, v, __ATOMIC_RELAXED, __HIP_MEMORY_SCOPE_AGENT); }
__device__ __forceinline__ unsigned xb_xcc_id() { return (unsigned)__builtin_amdgcn_s_getreg((3 << 11) | 20) & 0xFu; }
#define XB_SPIN(cond, bar) do { unsigned _sp = 0; while (cond) { __builtin_amdgcn_s_sleep(1); \
    if ((++_sp & 255u) == 0u) { if (xb_ld(&(bar)[XB_TMO])) break; if (_sp > XB_SPIN_CAP) { atomicAdd(&(bar)[XB_TMO], 1u); break; } } } } while (0)
struct XcdBarrier { unsigned* bar; unsigned x; volatile LAS unsigned* st; };
__device__ __forceinline__ XcdBarrier xcd_barrier_post(unsigned* bar, volatile LAS unsigned* st) {
    XcdBarrier b; b.bar = bar; b.x = xb_xcc_id(); b.st = st;
    if (threadIdx.x == 0) (void)xb_add(&bar[XB_XCNT(b.x)], 1u);
    return b;
}
__device__ __forceinline__ void xcd_barrier_complete(unsigned* bar, unsigned x, unsigned& nloc, unsigned& nx) {
    const unsigned G = gridDim.x * gridDim.y * gridDim.z;
    unsigned sum, cnt, mine, sp = 0u;
    for (;;) {
        sum = 0u; cnt = 0u; mine = 0u;
#pragma unroll
        for (unsigned j = 0; j < 16; ++j) { const unsigned c = xb_ld(&bar[XB_XCNT(j)]); sum += c; cnt += (c > 0u) ? 1u : 0u; mine = (j == x) ? c : mine; }
        if (sum == G) break;
        __builtin_amdgcn_s_sleep(1);
        if ((++sp & 255u) == 0u) { if (xb_ld(&bar[XB_TMO])) break; if (sp > XB_SPIN_CAP) { atomicAdd(&bar[XB_TMO], 1u); break; } }
    }
    nloc = mine > 0u ? mine : 1u; nx = cnt > 0u ? cnt : 1u;
}
__device__ __forceinline__ void xcd_barrier(const XcdBarrier& b) {
    asm volatile("s_waitcnt vmcnt(0)" ::: "memory");
    __syncthreads();
    if (threadIdx.x == 0) {
        unsigned* bar = b.bar;
        __builtin_amdgcn_s_waitcnt(0);
        unsigned nloc = b.st[0], nx = b.st[1];
        if (nloc == 0u) { xcd_barrier_complete(bar, b.x, nloc, nx); b.st[0] = nloc; b.st[1] = nx; }
        const unsigned old = xb_add(&bar[XB_XSUB(b.x)], 1u);
        const unsigned gen = old / nloc;
        if (old + 1u == (gen + 1u) * nloc) {
            __builtin_amdgcn_fence(__ATOMIC_RELEASE, "agent");
            asm volatile("s_waitcnt vmcnt(0)" ::: "memory");
            const unsigned og = xb_add(&bar[XB_TOP], 1u);
            const unsigned tg = og / nx;
            if (og + 1u == (tg + 1u) * nx) xb_add(&bar[XB_TOPGEN], 1u);
            else XB_SPIN(xb_ld(&bar[XB_TOPGEN]) == tg, bar);
            __builtin_amdgcn_fence(__ATOMIC_ACQUIRE, "agent");
            xb_add(&bar[XB_XGEN(b.x)], 1u);
            asm volatile("s_waitcnt vmcnt(0)" ::: "memory");
        } else {
            XB_SPIN(xb_ld(&bar[XB_XGEN(b.x)]) == gen, bar);
            __builtin_amdgcn_fence(__ATOMIC_ACQUIRE, "agent");
            asm volatile("s_waitcnt vmcnt(0)" ::: "memory");
        }
    }
    __syncthreads();
}
namespace nsa {
constexpr int PITCH = 144, TILE_LDS = 64 * PITCH;
__device__ __forceinline__ int crow(int r, int hi) { return (r & 3) + 8 * (r >> 2) + 4 * hi; }
__device__ __forceinline__ int vslot(int kk) { return (kk & 0x33) | (((kk >> 2) & 1) << 3) | (((kk >> 3) & 1) << 2); }

struct Lane { int lane, c, hi, wid, tid; };

__device__ __forceinline__ void qk_tile(f32x16& p0, f32x16& p1, const LAS unsigned char* Ks, const bf16x8 (&qr)[4], float bias, const Lane& L) {
#pragma unroll
    for (int r = 0; r < 16; ++r) { p0[r] = bias; p1[r] = bias; }
    const LAS unsigned char* kb = Ks + L.c * PITCH + L.hi * 16;
#pragma unroll
    for (int d0 = 0; d0 < 4; ++d0) {
        const bf16x8 k0 = *(const LAS bf16x8*)(kb + d0 * 32);
        const bf16x8 k1 = *(const LAS bf16x8*)(kb + 32 * PITCH + d0 * 32);
        p0 = __builtin_amdgcn_mfma_f32_32x32x16_bf16(k0, qr[d0], p0, 0, 0, 0);
        p1 = __builtin_amdgcn_mfma_f32_32x32x16_bf16(k1, qr[d0], p1, 0, 0, 0);
    }
}
__device__ __forceinline__ void mask_range(f32x16& p0, f32x16& p1, int lo, int hi_, int hi) {
#pragma unroll
    for (int r = 0; r < 16; ++r) { const int k0 = crow(r, hi), k1 = k0 + 32;
        if (k0 <= lo || k0 > hi_) p0[r] = NEGF;
        if (k1 <= lo || k1 > hi_) p1[r] = NEGF; }
}
__device__ __forceinline__ float tile_max(const f32x16& p0, const f32x16& p1) {
    float a = fmaxf(p0[0], p1[0]);
#pragma unroll
    for (int r = 1; r < 16; ++r) a = fmaxf(a, fmaxf(p0[r], p1[r]));
    return fmaxf(a, __shfl_xor(a, 32));
}
__device__ __forceinline__ void pv_tile(f32x16& o0, f32x16& o1, const LAS unsigned char* Vs, const f32x16& p0, const f32x16& p1, const Lane& L) {
    const LAS unsigned char* vb = Vs + L.c * PITCH + L.hi * 16;
#pragma unroll
    for (int s = 0; s < 4; ++s) {
        u32x4 w;
        if (s < 2) { const int b = 8 * (s & 1); w.x = cvt_pk_bf16(p0[b], p0[b + 1]); w.y = cvt_pk_bf16(p0[b + 2], p0[b + 3]); w.z = cvt_pk_bf16(p0[b + 4], p0[b + 5]); w.w = cvt_pk_bf16(p0[b + 6], p0[b + 7]); }
        else       { const int b = 8 * (s & 1); w.x = cvt_pk_bf16(p1[b], p1[b + 1]); w.y = cvt_pk_bf16(p1[b + 2], p1[b + 3]); w.z = cvt_pk_bf16(p1[b + 4], p1[b + 5]); w.w = cvt_pk_bf16(p1[b + 6], p1[b + 7]); }
        const bf16x8 pf = __builtin_bit_cast(bf16x8, w);
        const bf16x8 v0 = *(const LAS bf16x8*)(vb + s * 32);
        const bf16x8 v1 = *(const LAS bf16x8*)(vb + 32 * PITCH + s * 32);
        o0 = __builtin_amdgcn_mfma_f32_32x32x16_bf16(v0, pf, o0, 0, 0, 0);
        o1 = __builtin_amdgcn_mfma_f32_32x32x16_bf16(v1, pf, o1, 0, 0, 0);
    }
}
__device__ __forceinline__ void softmax_pv(f32x16& p0, f32x16& p1, f32x16& o0, f32x16& o1, float& m, float& l, const LAS unsigned char* Vs, const Lane& L) {
    const float mx = tile_max(p0, p1), mn = fmaxf(m, mx), alpha = fast_exp2(m - mn); m = mn;
    float ls = 0.f;
#pragma unroll
    for (int r = 0; r < 16; ++r) { p0[r] = fast_exp2(p0[r] - mn); p1[r] = fast_exp2(p1[r] - mn); ls += p0[r] + p1[r]; }
    l = l * alpha + ls;
#pragma unroll
    for (int r = 0; r < 16; ++r) { o0[r] *= alpha; o1[r] *= alpha; }
    pv_tile(o0, o1, Vs, p0, p1, L);
}
__device__ __forceinline__ int stage_off(int tid) { return (tid >> 3) * PITCH + (tid & 7) * 16; }

__device__ __forceinline__ void load_q(bf16x8 (&qr)[4], const bf16_t* qbuf, long tok, int head, int hi) {
    const bf16_t* qp = qbuf + tok * 512 + head * 64 + hi * 8;
#pragma unroll
    for (int d0 = 0; d0 < 4; ++d0) qr[d0] = *(const bf16x8*)(qp + d0 * 16);
}

template <int MODE>
__device__ __forceinline__ void run_branch(f32x16& o0, f32x16& o1, float& m, float& l, const bf16_t* Kt  , const bf16_t* Vt  ,
                                           int jlo, int jhi, int qb, int qrel, unsigned long long selw, const bf16x8 (&qr)[4], LAS unsigned char* lds, const Lane& L) {
    LAS unsigned char* Kbuf = lds; LAS unsigned char* Vbuf = lds + 2 * TILE_LDS;
    const int so = stage_off(L.tid);
    u32x4 kreg = *(const u32x4*)((const char*)Kt + (size_t)jlo * 8192 + L.tid * 16);
    u32x4 vreg = *(const u32x4*)((const char*)Vt + (size_t)jlo * 8192 + L.tid * 16);
    *(LAS u32x4*)(Kbuf + so) = kreg; *(LAS u32x4*)(Vbuf + so) = vreg;
    __syncthreads();
    for (int j = jlo; j <= jhi; ++j) {
        const int cur = (j - jlo) & 1;
        if (j < jhi) { kreg = *(const u32x4*)((const char*)Kt + (size_t)(j + 1) * 8192 + L.tid * 16); vreg = *(const u32x4*)((const char*)Vt + (size_t)(j + 1) * 8192 + L.tid * 16); }
        f32x16 p0, p1;
        float bias = 0.f;
        if (MODE == 0) bias = ((selw >> j) & 1ull) ? 0.f : NEGF;
        qk_tile(p0, p1, Kbuf + cur * TILE_LDS, qr, bias, L);
        if (j == qb) mask_range(p0, p1, -1, qrel, L.hi);
        if (MODE == 1 && j == qb - 8) mask_range(p0, p1, qrel, 64, L.hi);
        softmax_pv(p0, p1, o0, o1, m, l, Vbuf + cur * TILE_LDS, L);
        if (j < jhi) { *(LAS u32x4*)(Kbuf + (cur ^ 1) * TILE_LDS + so) = kreg; *(LAS u32x4*)(Vbuf + (cur ^ 1) * TILE_LDS + so) = vreg; }
        __syncthreads();
    }
}
}
namespace nsa {
struct AttnPtrs {
    const bf16_t* q;
    const bf16_t* z;
    const bf16_t* kc;
    const bf16_t* vct;
    const bf16_t* ksel;
    const bf16_t* vselt;
    const bf16_t* kwin; const bf16_t* vwint;
    unsigned long long* selmask;
    bf16_t* mix;
};
template <bool ACCUM>
__device__ __forceinline__ void store_o(const f32x16& a0, const f32x16& a1, bf16_t* mix, long tok, int head, int hi) {
    bf16_t* op = mix + tok * 1024 + head * 64 + 4 * hi;
#pragma unroll
    for (int dd = 0; dd < 2; ++dd)
#pragma unroll
        for (int rq = 0; rq < 4; ++rq) {
            float v0, v1, v2, v3;
            if (dd == 0) { v0 = a0[4 * rq]; v1 = a0[4 * rq + 1]; v2 = a0[4 * rq + 2]; v3 = a0[4 * rq + 3]; }
            else         { v0 = a1[4 * rq]; v1 = a1[4 * rq + 1]; v2 = a1[4 * rq + 2]; v3 = a1[4 * rq + 3]; }
            u32x2* p = (u32x2*)(op + dd * 32 + rq * 8);
            if (ACCUM) { const u32x2 old = *p; v0 += bflo(old.x); v1 += bfhi(old.x); v2 += bflo(old.y); v3 += bfhi(old.y); }
            u32x2 w; w.x = cvt_pk_bf16(v0, v1); w.y = cvt_pk_bf16(v2, v3); *p = w;
        }
}
__device__ __forceinline__ float gate_of(const bf16_t* z, long tok, int head, int br) { return sigmoidf_(bf2f(z[tok * INP + ZG + head * 3 + br])); }

__device__ __forceinline__ void cmp_unit(int bh, int qb, const AttnPtrs& P, LAS unsigned char* lds, const Lane& L) {
    const int b = bh >> 1, h = bh & 1, t0 = qb * 64;
    const int ql = 8 * L.wid + (L.c >> 2), g = L.c & 3, tq = t0 + ql, head = 4 * h + g;
    const long tok = (long)b * SEQ + tq;
    LAS unsigned char* Kb = lds; LAS unsigned char* Vb = lds + 4 * TILE_LDS;
    LAS float* G4 = (LAS float*)(lds + 8 * TILE_LDS); LAS float* E3 = G4 + 64 * 64;
    {
        const char* ks = (const char*)(P.kc + (size_t)bh * 256 * 64); const char* vs = (const char*)(P.vct + (size_t)bh * 256 * 64);
        const int so = stage_off(L.tid);
#pragma unroll
        for (int jn = 0; jn < 4; ++jn) { const u32x4 kv = *(const u32x4*)(ks + jn * 8192 + L.tid * 16); const u32x4 vv = *(const u32x4*)(vs + jn * 8192 + L.tid * 16);
            *(LAS u32x4*)(Kb + jn * TILE_LDS + so) = kv; *(LAS u32x4*)(Vb + jn * TILE_LDS + so) = vv; }
    }
    bf16x8 qr[4]; load_q(qr, P.q, tok, head, L.hi);
    __syncthreads();
    const int nmax = (tq >= 31) ? ((tq - 31) >> 4) : -1;
    float m = NEGF, l = 0.f;
    for (int jn = 0; jn < 4; ++jn) {
        f32x16 p0, p1; qk_tile(p0, p1, Kb + jn * TILE_LDS, qr, 0.f, L);
        mask_range(p0, p1, -1, nmax - 64 * jn, L.hi);
        const float mx = tile_max(p0, p1), mn = fmaxf(m, mx), alpha = fast_exp2(m - mn); m = mn;
        float ls = 0.f;
#pragma unroll
        for (int r = 0; r < 16; ++r) ls += fast_exp2(p0[r] - mn) + fast_exp2(p1[r] - mn);
        l = l * alpha + ls;
    }
    l += __shfl_xor(l, 32);
    const float inv = (nmax >= 0) ? fast_rcp(l) : 0.f;
    f32x16 o0, o1;
#pragma unroll
    for (int r = 0; r < 16; ++r) { o0[r] = 0.f; o1[r] = 0.f; }
    for (int jn = 0; jn < 4; ++jn) {
        f32x16 p0, p1; qk_tile(p0, p1, Kb + jn * TILE_LDS, qr, 0.f, L);
        mask_range(p0, p1, -1, nmax - 64 * jn, L.hi);
#pragma unroll
        for (int r = 0; r < 16; ++r) { p0[r] = fast_exp2(p0[r] - m) * inv; p1[r] = fast_exp2(p1[r] - m) * inv; }
        pv_tile(o0, o1, Vb + jn * TILE_LDS, p0, p1, L);
#pragma unroll
        for (int kh = 0; kh < 2; ++kh)
#pragma unroll
            for (int rq = 0; rq < 4; ++rq) {
                float gs, e3;
                if (kh == 0) { gs = (p0[4 * rq] + p0[4 * rq + 1]) + (p0[4 * rq + 2] + p0[4 * rq + 3]); e3 = p0[4 * rq + 3]; }
                else         { gs = (p1[4 * rq] + p1[4 * rq + 1]) + (p1[4 * rq + 2] + p1[4 * rq + 3]); e3 = p1[4 * rq + 3]; }
                gs += __shfl_xor(gs, 1); gs += __shfl_xor(gs, 2); e3 += __shfl_xor(e3, 1); e3 += __shfl_xor(e3, 2);
                if (g == 0) { const int s = 16 * jn + 8 * kh + 2 * rq + L.hi; G4[ql * 64 + s] = gs; E3[ql * 64 + s] = e3; }
            }
    }
    {
        const float gt = gate_of(P.z, tok, head, 0);
#pragma unroll
        for (int r = 0; r < 16; ++r) { o0[r] *= gt; o1[r] *= gt; }
        store_o<false>(o0, o1, P.mix, tok, head, L.hi);
    }
    __syncthreads();
    for (int i = 0; i < 8; ++i) {
        const int q = 8 * L.wid + i, s = L.lane;
        const float imp = G4[q * 64 + s] + (s > 0 ? E3[q * 64 + s - 1] : 0.f);
        const bool forced = (s == 0) || (s == qb) || (s == qb - 1);
        const float score = forced ? 1e9f : (s <= qb ? imp : NEGF);
        int rank = 0;
#pragma unroll
        for (int j = 0; j < 64; ++j) { const float v = __builtin_bit_cast(float, __builtin_amdgcn_readlane(__builtin_bit_cast(int, score), j)); rank += (v > score || (v == score && j < s)) ? 1 : 0; }
        const unsigned long long mask = __ballot(rank < 16);
        if (L.lane == 0) P.selmask[(size_t)bh * SEQ + t0 + q] = mask;
    }
    __syncthreads();
}

__device__ __forceinline__ void sw_unit(int bh, int qb, const AttnPtrs& P, LAS unsigned char* lds, const Lane& L) {
    const int b = bh >> 1, h = bh & 1, t0 = qb * 64;
    const int ql = 8 * L.wid + (L.c >> 2), g = L.c & 3, tq = t0 + ql, head = 4 * h + g;
    const long tok = (long)b * SEQ + tq;
    bf16x8 qr[4]; load_q(qr, P.q, tok, head, L.hi);
    const unsigned long long selw = P.selmask[(size_t)bh * SEQ + tq];
    f32x16 r0, r1;
    {
        f32x16 o0, o1; float m = NEGF, l = 0.f;
#pragma unroll
        for (int r = 0; r < 16; ++r) { o0[r] = 0.f; o1[r] = 0.f; }
        run_branch<0>(o0, o1, m, l, P.ksel + (size_t)bh * SEQ * 64, P.vselt + (size_t)bh * SEQ * 64, 0, qb, qb, ql, selw, qr, lds, L);
        l += __shfl_xor(l, 32);
        const float sc = gate_of(P.z, tok, head, 1) * fast_rcp(l);
#pragma unroll
        for (int r = 0; r < 16; ++r) { r0[r] = o0[r] * sc; r1[r] = o1[r] * sc; }
    }
    {
        f32x16 o0, o1; float m = NEGF, l = 0.f;
#pragma unroll
        for (int r = 0; r < 16; ++r) { o0[r] = 0.f; o1[r] = 0.f; }
        run_branch<1>(o0, o1, m, l, P.kwin + (size_t)bh * SEQ * 64, P.vwint + (size_t)bh * SEQ * 64, qb >= 8 ? qb - 8 : 0, qb, qb, ql, 0ull, qr, lds, L);
        l += __shfl_xor(l, 32);
        const float sc = gate_of(P.z, tok, head, 2) * fast_rcp(l);
#pragma unroll
        for (int r = 0; r < 16; ++r) { r0[r] += o0[r] * sc; r1[r] += o1[r] * sc; }
    }
    store_o<true>(r0, r1, P.mix, tok, head, L.hi);
}
}
namespace epi {
using pg8::Unit; using pg8::BM; using pg8::HALF;
struct Bf16Plain {
    static constexpr bool PERM = true;
    bf16_t* O; int ldc;
    __device__ __forceinline__ void operator()(const f32x4 (&acc)[2][2][4][2], const Unit& u, int wr, int wc, int fr, int fq) const {
        const int row0 = u.pm * BM + wr * 64 + fr, col0 = u.pn * BM + wc * 32 + 8 * fq;
#pragma unroll
        for (int ai = 0; ai < 2; ++ai)
#pragma unroll
            for (int m = 0; m < 4; ++m) { bf16_t* rowp = O + (size_t)(row0 + ai * HALF + m * 16) * ldc + col0;
#pragma unroll
                for (int bj = 0; bj < 2; ++bj) { const f32x4 v0 = acc[ai][bj][m][0], v1 = acc[ai][bj][m][1];
                    u32x4 w; w.x = cvt_pk_bf16(v0[0], v0[1]); w.y = cvt_pk_bf16(v0[2], v0[3]); w.z = cvt_pk_bf16(v1[0], v1[1]); w.w = cvt_pk_bf16(v1[2], v1[3]);
                    *(u32x4*)(rowp + bj * HALF) = w; } }
    }
};
struct F32Grouped {
    static constexpr bool PERM = false;
    float* C; int ldc; size_t gstride;
    __device__ __forceinline__ void operator()(const f32x4 (&acc)[2][2][4][2], const Unit& u, int wr, int wc, int fr, int fq) const {
        const int row0 = u.pm * BM + wr * 64 + fr, col0 = u.pn * BM + wc * 32 + 4 * fq; float* Cg = C + (size_t)u.aux * gstride;
#pragma unroll
        for (int ai = 0; ai < 2; ++ai)
#pragma unroll
            for (int m = 0; m < 4; ++m) { float* rowp = Cg + (size_t)(row0 + ai * HALF + m * 16) * ldc + col0;
#pragma unroll
                for (int bj = 0; bj < 2; ++bj)
#pragma unroll
                    for (int n = 0; n < 2; ++n) *(f32x4*)(rowp + bj * HALF + n * 16) = acc[ai][bj][m][n]; }
    }
};
struct SwiGlu {
    static constexpr bool PERM = true;
    bf16_t* H; int ldc;
    __device__ __forceinline__ void operator()(const f32x4 (&acc)[2][2][4][2], const Unit& u, int wr, int wc, int fr, int fq) const {
        const int row0 = u.pm * BM + wr * 64 + fr, col0 = u.pn * HALF + wc * 32 + 8 * fq;
#pragma unroll
        for (int ai = 0; ai < 2; ++ai)
#pragma unroll
            for (int m = 0; m < 4; ++m) { bf16_t* rowp = H + (size_t)(row0 + ai * HALF + m * 16) * ldc + col0;
                float o[8];
#pragma unroll
                for (int n = 0; n < 2; ++n)
#pragma unroll
                    for (int e = 0; e < 4; ++e) o[4 * n + e] = siluf_(acc[ai][0][m][n][e]) * acc[ai][1][m][n][e];
                u32x4 w; w.x = cvt_pk_bf16(o[0], o[1]); w.y = cvt_pk_bf16(o[2], o[3]); w.z = cvt_pk_bf16(o[4], o[5]); w.w = cvt_pk_bf16(o[6], o[7]);
                *(u32x4*)rowp = w; }
    }
};
struct MoeDown {
    static constexpr bool PERM = true;
    bf16_t* Y; const int* row_tok;
    __device__ __forceinline__ void operator()(const f32x4 (&acc)[2][2][4][2], const Unit& u, int wr, int wc, int fr, int fq) const {
        const int srow0 = u.aux * BM + wr * 64 + fr, col0 = u.pn * BM + wc * 32 + 8 * fq;
#pragma unroll
        for (int ai = 0; ai < 2; ++ai)
#pragma unroll
            for (int m = 0; m < 4; ++m) { const int dst = row_tok[srow0 + ai * HALF + m * 16];
                if (dst >= 0) { bf16_t* rowp = Y + (size_t)dst * D + col0;
#pragma unroll
                    for (int bj = 0; bj < 2; ++bj) { const f32x4 v0 = acc[ai][bj][m][0], v1 = acc[ai][bj][m][1];
                        u32x4 w; w.x = cvt_pk_bf16(v0[0], v0[1]); w.y = cvt_pk_bf16(v0[2], v0[3]); w.z = cvt_pk_bf16(v1[0], v1[1]); w.w = cvt_pk_bf16(v1[2], v1[3]);
                        *(u32x4*)(rowp + bj * HALF) = w; } } }
    }
};
struct SigmoidBias {
    static constexpr bool PERM = true;
    bf16_t* O; int ldc; const float* bias;
    __device__ __forceinline__ void operator()(const f32x4 (&acc)[2][2][4][2], const Unit& u, int wr, int wc, int fr, int fq) const {
        const int row0 = u.pm * BM + wr * 64 + fr, col0 = u.pn * BM + wc * 32 + 8 * fq;
        f32x4 bv[2][2];
#pragma unroll
        for (int bj = 0; bj < 2; ++bj)
#pragma unroll
            for (int n = 0; n < 2; ++n) bv[bj][n] = *(const f32x4*)(bias + col0 + bj * HALF + 4 * n);
#pragma unroll
        for (int ai = 0; ai < 2; ++ai)
#pragma unroll
            for (int m = 0; m < 4; ++m) { bf16_t* rowp = O + (size_t)(row0 + ai * HALF + m * 16) * ldc + col0;
#pragma unroll
                for (int bj = 0; bj < 2; ++bj) { f32x4 v0 = acc[ai][bj][m][0] + bv[bj][0], v1 = acc[ai][bj][m][1] + bv[bj][1];
#pragma unroll
                    for (int e = 0; e < 4; ++e) { v0[e] = sigmoidf_(v0[e]); v1[e] = sigmoidf_(v1[e]); }
                    u32x4 w; w.x = cvt_pk_bf16(v0[0], v0[1]); w.y = cvt_pk_bf16(v0[2], v0[3]); w.z = cvt_pk_bf16(v1[0], v1[1]); w.w = cvt_pk_bf16(v1[2], v1[3]);
                    *(u32x4*)(rowp + bj * HALF) = w; } }
    }
};
struct MulBf16 {
    static constexpr bool PERM = true;
    bf16_t* O; const bf16_t* G; int ldc;
    __device__ __forceinline__ void operator()(const f32x4 (&acc)[2][2][4][2], const Unit& u, int wr, int wc, int fr, int fq) const {
        const int row0 = u.pm * BM + wr * 64 + fr, col0 = u.pn * BM + wc * 32 + 8 * fq;
#pragma unroll
        for (int ai = 0; ai < 2; ++ai)
#pragma unroll
            for (int m = 0; m < 4; ++m) { const size_t off = (size_t)(row0 + ai * HALF + m * 16) * ldc + col0;
#pragma unroll
                for (int bj = 0; bj < 2; ++bj) { const f32x4 v0 = acc[ai][bj][m][0], v1 = acc[ai][bj][m][1]; const u32x4 gq = *(const u32x4*)(G + off + bj * HALF);
                    u32x4 w; w.x = cvt_pk_bf16(v0[0] * bflo(gq.x), v0[1] * bfhi(gq.x)); w.y = cvt_pk_bf16(v0[2] * bflo(gq.y), v0[3] * bfhi(gq.y));
                    w.z = cvt_pk_bf16(v1[0] * bflo(gq.z), v1[1] * bfhi(gq.z)); w.w = cvt_pk_bf16(v1[2] * bflo(gq.w), v1[3] * bfhi(gq.w));
                    *(u32x4*)(O + off + bj * HALF) = w; }
                asm volatile("" ::: "memory"); }
    }
};
struct S5Out {
    static constexpr bool PERM = true;
    bf16_t* ZS5; const bf16_t* Z; const float* dskip;
    __device__ __forceinline__ void operator()(const f32x4 (&acc)[2][2][4][2], const Unit& u, int wr, int wc, int fr, int fq) const {
        const int g = u.aux, row0 = u.pm * BM + wr * 64 + fr;
#pragma unroll
        for (int bj = 0; bj < 2; ++bj) { const int col = u.pn * BM + bj * HALF + wc * 32 + 8 * fq, jo = col >> 4, co0 = col & 15, ch0 = g * 16 + co0;
            const f32x4 d0 = *(const f32x4*)(dskip + ch0), d1 = *(const f32x4*)(dskip + ch0 + 4);
#pragma unroll
            for (int ai = 0; ai < 2; ++ai)
#pragma unroll
                for (int m = 0; m < 4; ++m) { const int mr = row0 + ai * HALF + m * 16; const long tok = (long)(mr >> 7) * SEQ + (mr & 127) * S5LC + jo;
                    const u32x4 uq = *(const u32x4*)(Z + tok * INP + ZS + ch0); const f32x4 v0 = acc[ai][bj][m][0], v1 = acc[ai][bj][m][1];
                    u32x4 w; w.x = cvt_pk_bf16(gelu_tanh(v0[0] + d0[0] * bflo(uq.x)), gelu_tanh(v0[1] + d0[1] * bfhi(uq.x)));
                    w.y = cvt_pk_bf16(gelu_tanh(v0[2] + d0[2] * bflo(uq.y)), gelu_tanh(v0[3] + d0[3] * bfhi(uq.y)));
                    w.z = cvt_pk_bf16(gelu_tanh(v1[0] + d1[0] * bflo(uq.z)), gelu_tanh(v1[1] + d1[1] * bfhi(uq.z)));
                    w.w = cvt_pk_bf16(gelu_tanh(v1[2] + d1[2] * bflo(uq.w)), gelu_tanh(v1[3] + d1[3] * bfhi(uq.w)));
                    *(u32x4*)(ZS5 + tok * 256 + ch0) = w; asm volatile("" ::: "memory"); } }
    }
};
struct S5Glu {
    static constexpr bool PERM = true;
    bf16_t* MIX; const bf16_t* ZS5; const float* bias;
    __device__ __forceinline__ void operator()(const f32x4 (&acc)[2][2][4][2], const Unit& u, int wr, int wc, int fr, int fq) const {
        const int row0 = u.pm * BM + wr * 64 + fr, col0 = wc * 32 + 8 * fq;
#pragma unroll
        for (int bj = 0; bj < 2; ++bj) { const int col = col0 + bj * HALF; const f32x4 b0 = *(const f32x4*)(bias + col), b1 = *(const f32x4*)(bias + col + 4);
#pragma unroll
            for (int ai = 0; ai < 2; ++ai)
#pragma unroll
                for (int m = 0; m < 4; ++m) { const size_t row = (size_t)(row0 + ai * HALF + m * 16); const u32x4 zq = *(const u32x4*)(ZS5 + row * 256 + col);
                    const f32x4 v0 = acc[ai][bj][m][0] + b0, v1 = acc[ai][bj][m][1] + b1;
                    u32x4 w; w.x = cvt_pk_bf16(bflo(zq.x) * sigmoidf_(v0[0]), bfhi(zq.x) * sigmoidf_(v0[1])); w.y = cvt_pk_bf16(bflo(zq.y) * sigmoidf_(v0[2]), bfhi(zq.y) * sigmoidf_(v0[3]));
                    w.z = cvt_pk_bf16(bflo(zq.z) * sigmoidf_(v1[0]), bfhi(zq.z) * sigmoidf_(v1[1])); w.w = cvt_pk_bf16(bflo(zq.w) * sigmoidf_(v1[2]), bfhi(zq.w) * sigmoidf_(v1[3]));
                    *(u32x4*)(MIX + row * 1024 + 768 + col) = w; asm volatile("" ::: "memory"); } }
    }
};
}
constexpr size_t MiB = 1u << 20;
constexpr size_t WS_CTL = 0, CTL_ZERO_BYTES = 1 * MiB;
constexpr size_t WS_SMALL = 1 * MiB;
constexpr size_t SM_APOW = WS_SMALL;
constexpr size_t SM_BBAR = WS_SMALL + 5 * MiB / 4;
constexpr size_t SM_KTAB = WS_SMALL + 2 * MiB;
constexpr size_t SM_CMPB = WS_SMALL + 4 * MiB;
constexpr size_t SM_TOKE = WS_SMALL + 4 * MiB + 256 * 1024;
constexpr size_t SM_TOKW = WS_SMALL + 4 * MiB + 512 * 1024;
constexpr size_t SM_ROWTOK = WS_SMALL + 5 * MiB + 256 * 1024;
constexpr size_t SM_PCNT = WS_SMALL + 6 * MiB;
constexpr size_t SM_TILEEXP = WS_SMALL + 6 * MiB + 16384;
constexpr size_t WS_ROPE = 8 * MiB;
constexpr size_t WS_W = 24 * MiB;
constexpr size_t W_IN = WS_W;
constexpr size_t W_OUT = W_IN + (size_t)INP * D * 2;
constexpr size_t W_GATE = W_OUT + (size_t)D * D * 2;
constexpr size_t W_PROJ = W_GATE + (size_t)D * D * 2;
constexpr size_t W_CMP = W_PROJ + (size_t)D * PLE * 2;
constexpr size_t W_GLU = W_CMP + (size_t)2 * 512 * 1024 * 2;
constexpr size_t W_S5B = W_GLU + (size_t)256 * 256 * 2;
constexpr size_t W_S5S = W_S5B + (size_t)16 * 512 * S5K * 2;
constexpr size_t W_UP = W_S5S + (size_t)16 * 256 * 512 * 2;
constexpr size_t W_DN = W_UP + (size_t)NEXP * 2 * DFE * D * 2;
constexpr size_t W_END_ = W_DN + (size_t)NEXP * D * DFE * 2;
static_assert(W_END_ <= WS_W + 240 * MiB, "weight region");
constexpr size_t WS_XB = 264 * MiB;
constexpr size_t WS_PB = 392 * MiB;
constexpr size_t WS_Z = 424 * MiB;
constexpr size_t WS_QKV = 712 * MiB;
constexpr size_t WS_Q = WS_QKV, WS_KCMP = WS_QKV + 64 * MiB, WS_VCMP = WS_KCMP + 16 * MiB, WS_KSEL = WS_VCMP + 16 * MiB, WS_VSEL = WS_KSEL + 16 * MiB, WS_KWIN = WS_VSEL + 16 * MiB, WS_VWIN = WS_KWIN + 16 * MiB;
constexpr size_t WS_MIX = 872 * MiB;
constexpr size_t WS_CMP = 1000 * MiB;
constexpr size_t WS_CMPP = WS_CMP, WS_KC = WS_CMP + 32 * MiB, WS_VCT = WS_KC + 1 * MiB, WS_SELM = WS_VCT + 1 * MiB;
constexpr size_t WS_S5 = 1036 * MiB;
constexpr size_t WS_S5A = WS_S5, WS_S5S = WS_S5 + 40 * MiB, WS_ZS5 = WS_S5S + 32 * MiB;
constexpr size_t WS_HBUF = 1140 * MiB;
constexpr size_t WS_END = 1268 * MiB;
constexpr size_t WS_FFH = WS_Z, WS_XS = WS_Z, WS_MH = WS_Z + 260 * MiB, WS_YB = WS_MH + 224 * MiB;
static_assert(WS_YB + 256 * MiB <= WS_END && WS_FFH + (size_t)T * DFF * 2 <= WS_MIX, "overlays");
constexpr int CW_BAR = 4096;

struct Args { const void* in[36]; float* out; unsigned char* ws; int gp_lo, gp_hi, use_bar, pad; };
struct Frame { LAS unsigned char* lds; int tid, lane, wave, G, bid; };
constexpr int RING_BYTES = 131072, LDSCTL_OFF = RING_BYTES, LDS_BYTES = 147456;
typedef __attribute__((address_space(4))) const Args CArgs;
__device__ __forceinline__ void load_args(Args& a) { CArgs* p = (CArgs*)__builtin_amdgcn_kernarg_segment_ptr(); asm volatile("" : "+s"(p)); __builtin_memcpy(&a, p, sizeof(Args)); }
__device__ __forceinline__ Frame make_frame(LAS unsigned char* lds) { Frame F; F.lds = lds; int t = threadIdx.x; asm volatile("" : "+v"(t)); F.tid = t; F.lane = t & 63; F.wave = __builtin_amdgcn_readfirstlane(t >> 6);
    int b = blockIdx.x, g = gridDim.x; asm volatile("" : "+s"(b), "+s"(g)); F.bid = b; F.G = g; return F; }

__constant__ double c_invfreq_rev[32] = {0.15915494309189535, 0.11934937021124886, 0.08949940160889101, 0.06711508300522726, 0.050329212104487035, 0.03774158471741977, 0.0283021958306234, 0.02122365276477766, 0.015915494309189534, 0.011934937021124886, 0.008949940160889102, 0.006711508300522725, 0.005032921210448704, 0.003774158471741977, 0.00283021958306234, 0.0021223652764777662, 0.0015915494309189536, 0.0011934937021124885, 0.0008949940160889102, 0.0006711508300522726, 0.0005032921210448703, 0.00037741584717419774, 0.00028302195830623395, 0.0002122365276477766, 0.00015915494309189535, 0.00011934937021124886, 8.949940160889102e-05, 6.711508300522725e-05, 5.0329212104487035e-05, 3.774158471741978e-05, 2.8302195830623396e-05, 2.122365276477766e-05};

__device__ __forceinline__ void sincos_rev(double rev, float& c, float& s) { const double fr = rev - __builtin_floor(rev); const float f = (float)fr; s = __builtin_amdgcn_sinf(f); c = __builtin_amdgcn_cosf(f); }

__device__ __forceinline__ void phase_init0(const Frame& F, const Args& a) {
    const size_t gt = (size_t)F.bid * 512 + F.tid, NT = (size_t)F.G * 512;
    const int* pos = (const int*)a.in[2]; f32x2* rope = (f32x2*)(a.ws + WS_ROPE);
    for (size_t i = gt; i < (size_t)T * 32; i += NT) { const int tok = (int)(i >> 5), k = (int)(i & 31); float c, s; sincos_rev((double)pos[tok] * c_invfreq_rev[k], c, s); rope[i] = (f32x2){c, s}; }
    const float* are = (const float*)a.in[14]; const float* aim = (const float*)a.in[15]; const float* ldt = (const float*)a.in[16];
    const float* bre = (const float*)a.in[17]; const float* bim = (const float*)a.in[18];
    f32x2* apow = (f32x2*)(a.ws + SM_APOW); f32x2* bbar = (f32x2*)(a.ws + SM_BBAR);
    for (size_t i = gt; i < (size_t)DEPTH * 16 * 64 * 34; i += NT) { const int k = (int)(i % 34), lgn = (int)(i / 34), lg = lgn >> 6;
        const float dt = __expf(ldt[lg]); const float ar = are[lgn] * dt; const double rev = (double)k * ((double)aim[lgn] * (double)dt) * 0.15915494309189535;
        float c, s; sincos_rev(rev, c, s); const float mg = __expf((float)k * ar); apow[i] = (f32x2){mg * c, mg * s}; }
    for (size_t i = gt; i < (size_t)DEPTH * 16 * 64 * 16; i += NT) { const int lgn = (int)(i >> 4), lg = lgn >> 6;
        const float dt = __expf(ldt[lg]); const float lr = are[lgn], li = aim[lgn]; const double rev = ((double)li * (double)dt) * 0.15915494309189535;
        float c, s; sincos_rev(rev, c, s); const float mg = __expf(lr * dt); const float abr = mg * c, abi = mg * s, den = lr * lr + li * li;
        const float cr = ((abr - 1.0f) * lr + abi * li) / den, ci = (abi * lr - (abr - 1.0f) * li) / den;
        const float br = bre[i], bi = bim[i]; bbar[i] = (f32x2){cr * br - ci * bi, cr * bi + ci * br}; }
    const f32x4* x4 = (const f32x4*)a.in[0]; u32x2* xb = (u32x2*)(a.ws + WS_XB);
    for (size_t i = gt; i < (size_t)T * D / 4; i += NT) { const f32x4 v = x4[i]; u32x2 w; w.x = cvt_pk_bf16(v[0], v[1]); w.y = cvt_pk_bf16(v[2], v[3]); xb[i] = w; }
}
__device__ __forceinline__ void phase_init1(const Frame& F, const Args& a) {
    const size_t gt = (size_t)F.bid * 512 + F.tid, NT = (size_t)F.G * 512;
    const float* cre = (const float*)a.in[19]; const float* cim = (const float*)a.in[20];
    const f32x2* apow = (const f32x2*)(a.ws + SM_APOW); const f32x2* bbar = (const f32x2*)(a.ws + SM_BBAR); float* ktab = (float*)(a.ws + SM_KTAB);
    for (size_t i = gt; i < (size_t)DEPTH * 16 * 32 * 256; i += NT) { const int ci = (int)(i & 15), co = (int)((i >> 4) & 15), tau = (int)((i >> 8) & 31), lg = (int)(i >> 13);
        float acc = 0.f;
        for (int n = 0; n < 64; ++n) { const f32x2 P = apow[((size_t)lg * 64 + n) * 34 + tau], Bb = bbar[((size_t)lg * 64 + n) * 16 + ci]; const float cr = cre[((size_t)lg * 16 + co) * 64 + n], cm = cim[((size_t)lg * 16 + co) * 64 + n];
            const float hr = P.x * Bb.x - P.y * Bb.y, hi = P.x * Bb.y + P.y * Bb.x; acc += cr * hr - cm * hi; }
        ktab[i] = acc; }
}

__device__ __forceinline__ void transpose_item(const float* W, int ldw, int k0, int n0, int nvalid, bf16_t* dstrow, int dst_ld, LAS float* scr, int lane) {
#pragma unroll 8
    for (int i = 0; i < 32; ++i) { const int kk = 2 * i + (lane >> 5), nn = lane & 31; scr[kk * 33 + nn] = (nn < nvalid) ? W[(size_t)(k0 + kk) * ldw + n0 + nn] : 0.f; }
    LDS_WAIT(); asm volatile("" ::: "memory");
    const int c = lane & 7;
#pragma unroll
    for (int j = 0; j < 4; ++j) { const int n = (lane >> 3) + 8 * j; const LAS float* s = scr + (8 * c) * 33 + n;
        u32x4 o; o.x = cvt_pk_bf16(s[0 * 33], s[1 * 33]); o.y = cvt_pk_bf16(s[2 * 33], s[3 * 33]); o.z = cvt_pk_bf16(s[4 * 33], s[5 * 33]); o.w = cvt_pk_bf16(s[6 * 33], s[7 * 33]);
        if (n < nvalid) *(u32x4*)(dstrow + (size_t)n * dst_ld + 8 * c) = o; }
    LDS_WAIT(); asm volatile("" ::: "memory");
}
__device__ __forceinline__ void transpose_mat(const float* W, int K, int N, bf16_t* dst, int dst_ld, int mode, LAS float* scr, int lane, int& cursor, int gw, int NGW) {
    const int nblk = (N + 31) / 32, items = (K / 64) * nblk;
    int it = ((gw - cursor) % NGW + NGW) % NGW;
    for (; it < items; it += NGW) { const int kb = it / nblk, nb = it % nblk, k0 = 64 * kb, n0 = 32 * nb; const int nv = (N - n0) < 32 ? (N - n0) : 32;
        const int drow = mode == 0 ? n0 : ((n0 >> 7) * 256 + (n0 & 127) + (mode == 2 ? 128 : 0));
        transpose_item(W, N, k0, n0, nv, dst + (size_t)drow * dst_ld + k0, dst_ld, scr, lane); }
    cursor = (cursor + items) % NGW;
}

__device__ __forceinline__ void phase_prep(const Frame& F, const Args& a, int l) {
    LAS float* scr = (LAS float*)(F.lds + F.wave * 16384);
    const int gw = F.bid * 8 + F.wave, NGW = F.G * 8; int cursor = 0;
    unsigned char* ws = a.ws;
    transpose_mat((const float*)a.in[3] + (size_t)l * D * INW, D, INW, (bf16_t*)(ws + W_IN), D, 0, scr, F.lane, cursor, gw, NGW);
    transpose_mat((const float*)a.in[4] + (size_t)l * D * D, D, D, (bf16_t*)(ws + W_OUT), D, 0, scr, F.lane, cursor, gw, NGW);
    transpose_mat((const float*)a.in[31] + (size_t)l * D * D, D, D, (bf16_t*)(ws + W_GATE), D, 0, scr, F.lane, cursor, gw, NGW);
    transpose_mat((const float*)a.in[33] + (size_t)l * PLE * D, PLE, D, (bf16_t*)(ws + W_PROJ), PLE, 0, scr, F.lane, cursor, gw, NGW);
    for (int j = 0; j < 2; ++j) { const float* w1 = (const float*)a.in[6] + ((size_t)l * 2 + j) * 2048 * 256; bf16_t* dst = (bf16_t*)(ws + W_CMP) + (size_t)j * 512 * 1024;
        transpose_mat(w1, 1024, 256, dst, 1024, 0, scr, F.lane, cursor, gw, NGW);
        transpose_mat(w1 + (size_t)1024 * 256, 1024, 256, dst + (size_t)256 * 1024, 1024, 0, scr, F.lane, cursor, gw, NGW); }
    transpose_mat((const float*)a.in[22] + (size_t)l * 256 * 256, 256, 256, (bf16_t*)(ws + W_GLU), 256, 0, scr, F.lane, cursor, gw, NGW);
    const int j2 = l >> 1;
    if ((l & 1) == 0) {
        transpose_mat((const float*)a.in[24] + (size_t)j2 * D * DFF, D, DFF, (bf16_t*)(ws + W_UP), D, 1, scr, F.lane, cursor, gw, NGW);
        transpose_mat((const float*)a.in[25] + (size_t)j2 * D * DFF, D, DFF, (bf16_t*)(ws + W_UP), D, 2, scr, F.lane, cursor, gw, NGW);
        transpose_mat((const float*)a.in[26] + (size_t)j2 * DFF * D, DFF, D, (bf16_t*)(ws + W_DN), DFF, 0, scr, F.lane, cursor, gw, NGW);
    } else {
        for (int e = 0; e < NEXP; ++e) { const size_t eo = (size_t)j2 * NEXP + e;
            transpose_mat((const float*)a.in[28] + eo * D * DFE, D, DFE, (bf16_t*)(ws + W_UP) + (size_t)e * 2 * DFE * D, D, 1, scr, F.lane, cursor, gw, NGW);
            transpose_mat((const float*)a.in[29] + eo * D * DFE, D, DFE, (bf16_t*)(ws + W_UP) + (size_t)e * 2 * DFE * D, D, 2, scr, F.lane, cursor, gw, NGW);
            transpose_mat((const float*)a.in[30] + eo * DFE * D, DFE, D, (bf16_t*)(ws + W_DN) + (size_t)e * D * DFE, DFE, 0, scr, F.lane, cursor, gw, NGW); }
    }
    const size_t gt = (size_t)F.bid * 512 + F.tid, NT = (size_t)F.G * 512;
    {
        u32x4* zp = (u32x4*)((bf16_t*)(ws + W_IN) + (size_t)INW * D); const size_t n16 = (size_t)(INP - INW) * D * 2 / 16;
        for (size_t i = gt; i < n16; i += NT) zp[i] = (u32x4){0u, 0u, 0u, 0u};
    }
    {
        const f32x4* p4 = (const f32x4*)((const float*)a.in[1] + (size_t)l * T * PLE); u32x2* pb = (u32x2*)(ws + WS_PB);
        for (size_t i = gt; i < (size_t)T * PLE / 4; i += NT) { const f32x4 v = p4[i]; u32x2 w; w.x = cvt_pk_bf16(v[0], v[1]); w.y = cvt_pk_bf16(v[2], v[3]); pb[i] = w; }
    }
    {
        const float* ktab = (const float*)(ws + SM_KTAB) + (size_t)l * 16 * 32 * 256; const f32x2* apow = (const f32x2*)(ws + SM_APOW) + (size_t)l * 16 * 64 * 34; const f32x2* bbar = (const f32x2*)(ws + SM_BBAR) + (size_t)l * 16 * 64 * 16;
        const float* cre = (const float*)a.in[19] + (size_t)l * 16 * 16 * 64; const float* cim = (const float*)a.in[20] + (size_t)l * 16 * 16 * 64;
        bf16_t* Bt = (bf16_t*)(ws + W_S5B);
        for (size_t i = gt; i < (size_t)16 * 512 * S5K; i += NT) { const int k = (int)(i % S5K), row = (int)((i / S5K) & 511), g = (int)(i / ((size_t)S5K * 512)); const int jo = row >> 4, co = row & 15;
            float v;
            if (k < 512) { const int ji = k >> 4, ci = k & 15; v = (jo >= ji) ? ktab[(((size_t)g * 32 + (jo - ji)) * 16 + co) * 16 + ci] : 0.f; }
            else { const int n = (k - 512) & 63; const f32x2 P = apow[((size_t)g * 64 + n) * 34 + jo + 1]; const float cr = cre[((size_t)g * 16 + co) * 64 + n], cm = cim[((size_t)g * 16 + co) * 64 + n];
                v = (k < 576) ? (cr * P.x - cm * P.y) : -(cr * P.y + cm * P.x); }
            Bt[i] = f2bf(v); }
        bf16_t* St = (bf16_t*)(ws + W_S5S);
        for (size_t i = gt; i < (size_t)16 * 256 * 512; i += NT) { const int k = (int)(i & 511), np = (int)((i >> 9) & 255), g = (int)(i >> 17); const int j = k >> 4, ci = k & 15;
            float v = 0.f;
            if (np < 128) { const int n = np & 63; const f32x2 P = apow[((size_t)g * 64 + n) * 34 + (S5LC - 1 - j)], Bb = bbar[((size_t)g * 64 + n) * 16 + ci]; v = (np < 64) ? (P.x * Bb.x - P.y * Bb.y) : (P.x * Bb.y + P.y * Bb.x); }
            St[i] = f2bf(v); }
    }
    {
        float* cb = (float*)(ws + SM_CMPB);
        for (int o = gw; o < 512; o += NGW) { const int j = o >> 8, c = o & 255; const float* w1 = (const float*)a.in[6] + ((size_t)l * 2 + j) * 2048 * 256; const float* pe = (const float*)a.in[5] + ((size_t)l * 2 + j) * 2048;
            float s = 0.f; for (int k = F.lane; k < 2048; k += 64) s += pe[k] * w1[(size_t)k * 256 + c];
            s = wave_sum(s); if (F.lane == 0) cb[o] = s + ((const float*)a.in[7])[((size_t)l * 2 + j) * 256 + c]; }
    }
}

__device__ __forceinline__ void phase_post(const Frame& F, const Args& a) {
    unsigned char* ws = a.ws; const bf16_t* z = (const bf16_t*)(ws + WS_Z); const f32x2* rope = (const f32x2*)(ws + WS_ROPE);
    bf16_t* qr = (bf16_t*)(ws + WS_Q); bf16_t* vcmp = (bf16_t*)(ws + WS_VCMP); bf16_t* ap = (bf16_t*)(ws + WS_S5A);
    const int gw = F.bid * 8 + F.wave, NGW = F.G * 8, lane = F.lane;
    for (int tok = gw; tok < T; tok += NGW) {
        const bf16_t* zr = z + (size_t)tok * INP; const int b = tok >> 12, t = tok & 4095;
#pragma unroll
        for (int it = 0; it < 4; ++it) { const int idx = lane + 64 * it, head = idx >> 5, i = idx & 31; const f32x2 cs = rope[(size_t)tok * 32 + i];
            const float x1 = bf2f(zr[head * 64 + i]), x2 = bf2f(zr[head * 64 + 32 + i]);
            qr[(size_t)tok * 512 + head * 64 + i] = f2bf((x1 * cs.x - x2 * cs.y) * QSCALE); qr[(size_t)tok * 512 + head * 64 + 32 + i] = f2bf((x2 * cs.x + x1 * cs.y) * QSCALE); }
#pragma unroll
        for (int it = 0; it < 3; ++it) { const int idx = lane + 64 * it, kk = idx >> 5, i = idx & 31, which = kk >> 1, h = kk & 1; const f32x2 cs = rope[(size_t)tok * 32 + i];
            const int col = ZKV + ((2 * which) * 2 + h) * 64; const float x1 = bf2f(zr[col + i]), x2 = bf2f(zr[col + 32 + i]);
            bf16_t* kd = (bf16_t*)(ws + (which == 0 ? WS_KCMP : which == 1 ? WS_KSEL : WS_KWIN)) + ((size_t)(b * 2 + h) * SEQ + t) * 64;
            kd[i] = f2bf(x1 * cs.x - x2 * cs.y); kd[32 + i] = f2bf(x2 * cs.x + x1 * cs.y); }
        {
            const int h = lane >> 5, d2 = (lane & 31) * 2; const unsigned v = *(const unsigned*)(zr + ZKV + (1 * 2 + h) * 64 + d2);
            *(unsigned*)(vcmp + ((size_t)(b * 2 + h) * SEQ + t) * 64 + d2) = v; }
        {
            const int g = lane >> 2, ch0 = (lane & 3) * 4; const u32x2 v = *(const u32x2*)(zr + ZS + lane * 4);
            *(u32x2*)(ap + ((size_t)g * 2048 + b * 128 + (t >> 5)) * S5K + (t & 31) * 16 + ch0) = v; }
    }
    LAS bf16_t* scr = (LAS bf16_t*)(F.lds + F.wave * 16384);
    for (int it = gw; it < 2 * 32 * 64; it += NGW) { const int which = it >> 11, bh = (it >> 6) & 31, tile = it & 63, b = bh >> 1, h = bh & 1;
        const bf16_t* src = z + ((size_t)b * SEQ + tile * 64) * INP + ZKV + ((which ? 5 : 3) * 2 + h) * 64;
#pragma unroll
        for (int r = 0; r < 8; ++r) { const int key = r * 8 + (lane >> 3), ch = lane & 7; const u32x4 v = *(const u32x4*)(src + (size_t)key * INP + ch * 8);
            LAS unsigned* d = (LAS unsigned*)(scr + key * 66 + ch * 8); d[0] = v.x; d[1] = v.y; d[2] = v.z; d[3] = v.w; }
        LDS_WAIT(); asm volatile("" ::: "memory");
        bf16_t* dst = (bf16_t*)(ws + (which ? WS_VWIN : WS_VSEL)) + ((size_t)bh * 64 + tile) * 4096 + lane * 64;
#pragma unroll
        for (int sg = 0; sg < 8; ++sg) { unsigned w[4];
#pragma unroll
            for (int e = 0; e < 4; ++e) { const int s0 = sg * 8 + 2 * e, k0 = nsa::vslot(s0), k1 = nsa::vslot(s0 + 1); w[e] = (unsigned)scr[k0 * 66 + lane] | ((unsigned)scr[k1 * 66 + lane] << 16); }
            *(u32x4*)(dst + sg * 8) = (u32x4){w[0], w[1], w[2], w[3]}; }
        LDS_WAIT(); asm volatile("" ::: "memory");
    }
}
__device__ __forceinline__ void conv_items(const Frame& F, const Args& a, int l, int first, int stride) {
    const bf16_t* z = (const bf16_t*)(a.ws + WS_Z); bf16_t* mix = (bf16_t*)(a.ws + WS_MIX);
    const float* cw = (const float*)a.in[10] + (size_t)l * 31 * 256; const float* cb = (const float*)a.in[11] + (size_t)l * 256;
    const float* lg = (const float*)a.in[12] + (size_t)l * 256; const float* lb = (const float*)a.in[13] + (size_t)l * 256;
    LAS float* U = (LAS float*)F.lds;
    LAS float* Y = (LAS float*)(F.lds + 65536);
    const int c = F.tid & 255, half = F.tid >> 8;
    float w[31];
#pragma unroll
    for (int j = 0; j < 31; ++j) w[j] = cw[j * 256 + c];
    const float bias = cb[c];
    for (int it = first; it < NB * (SEQ / 32); it += stride) { const int b = it >> 7, t0 = (it & 127) * 32;
        for (int r = half; r < 62; r += 2) { const int t = t0 - 30 + r; float u = 0.f;
            if (t >= 0) { const bf16_t* zr = z + ((size_t)b * SEQ + t) * INP + ZC; u = bf2f(zr[c]) * sigmoidf_(bf2f(zr[256 + c])); }
            U[r * 256 + c] = u; }
        __syncthreads();
        for (int i = 0; i < 16; ++i) { const int tl = half * 16 + i; float acc = bias;
#pragma unroll
            for (int j = 0; j < 31; ++j) acc += w[j] * U[(tl + j) * 256 + c];
            Y[tl * 256 + c] = acc; }
        __syncthreads();
        for (int i = 0; i < 4; ++i) { const int tl = F.wave * 4 + i; const f32x4 v = *(const LAS f32x4*)(Y + tl * 256 + F.lane * 4);
            const float mean = wave_sum((v[0] + v[1]) + (v[2] + v[3])) * (1.f / 256.f); const f32x4 dlt = v - mean;
            const float var = wave_sum((dlt[0] * dlt[0] + dlt[1] * dlt[1]) + (dlt[2] * dlt[2] + dlt[3] * dlt[3])) * (1.f / 256.f); const float rstd = 1.0f / sqrtf(var + LN_EPS);
            const f32x4 gg = *(const f32x4*)(lg + F.lane * 4), bb = *(const f32x4*)(lb + F.lane * 4);
            float o[4];
#pragma unroll
            for (int e = 0; e < 4; ++e) o[e] = siluf_(dlt[e] * rstd * gg[e] + bb[e]);
            u32x2 wv; wv.x = cvt_pk_bf16(o[0], o[1]); wv.y = cvt_pk_bf16(o[2], o[3]);
            *(u32x2*)(mix + ((size_t)b * SEQ + t0 + tl) * 1024 + 512 + F.lane * 4) = wv; }
        __syncthreads();
    }
}
__device__ __forceinline__ void cmp_stage2(const Frame& F, const Args& a, int l) {
    unsigned char* ws = a.ws; const float* cb = (const float*)(ws + SM_CMPB);
    LAS float* hs = (LAS float*)(F.lds + F.wave * 16384);
    const int gw = F.bid * 8 + F.wave, NGW = F.G * 8, lane = F.lane;
    for (int it = gw; it < 2 * 32 * 256; it += NGW) { const int j = it >> 13, bh = (it >> 8) & 31, n = it & 255;
        const float* w2 = (const float*)a.in[8] + ((size_t)l * 2 + j) * 256 * 64; const float* b2 = (const float*)a.in[9] + ((size_t)l * 2 + j) * 64;
        float outv = 0.f;
        if (n < NCMP) {
            const float* P = (const float*)(ws + WS_CMPP) + (size_t)j * 8192 * 512 + ((size_t)bh * 256 + n) * 512;
            const f32x4 p0 = *(const f32x4*)(P + lane * 4), p1 = *(const f32x4*)(P + 512 + 256 + lane * 4), bb = *(const f32x4*)(cb + j * 256 + lane * 4);
            f32x4 hv; for (int e = 0; e < 4; ++e) hv[e] = gelu_tanh(p0[e] + p1[e] + bb[e]);
            *(LAS f32x4*)(hs + lane * 4) = hv; LDS_WAIT(); asm volatile("" ::: "memory");
            float acc = b2[lane];
#pragma unroll 8
            for (int c = 0; c < 256; ++c) acc += hs[c] * w2[c * 64 + lane];
            outv = acc; LDS_WAIT(); asm volatile("" ::: "memory");
        }
        if (j == 0) ((bf16_t*)(ws + WS_KC))[((size_t)bh * 256 + n) * 64 + lane] = f2bf(outv);
        else ((bf16_t*)(ws + WS_VCT))[((size_t)bh * 4 + (n >> 6)) * 4096 + lane * 64 + nsa::vslot(n & 63)] = f2bf(outv);
    }
}
__device__ __forceinline__ void s5_carry(const Frame& F, const Args& a, int l) {
    unsigned char* ws = a.ws; const f32x2* apow = (const f32x2*)(ws + SM_APOW) + (size_t)l * 16 * 64 * 34;
    const float* S = (const float*)(ws + WS_S5S); bf16_t* ap = (bf16_t*)(ws + WS_S5A);
    const int gt = F.bid * 512 + F.tid, NT = F.G * 512;
    for (int i = gt; i < 16 * NB * 64; i += NT) { const int n = i & 63, b = (i >> 6) & 15, g = i >> 10;
        const f32x2 A = apow[((size_t)g * 64 + n) * 34 + S5LC]; float hr = 0.f, hi = 0.f;
        const float* sp = S + ((size_t)g * 2048 + b * 128) * 256 + n; bf16_t* dp = ap + ((size_t)g * 2048 + b * 128) * S5K + 512 + n;
        for (int c0 = 0; c0 < S5NCH; c0 += 8) { float sr[8], si[8];
#pragma unroll
            for (int k = 0; k < 8; ++k) { sr[k] = sp[(size_t)(c0 + k) * 256]; si[k] = sp[(size_t)(c0 + k) * 256 + 64]; }
#pragma unroll
            for (int k = 0; k < 8; ++k) { dp[(size_t)(c0 + k) * S5K] = f2bf(hr); dp[(size_t)(c0 + k) * S5K + 64] = f2bf(hi);
                const float nr = A.x * hr - A.y * hi + sr[k], ni = A.x * hi + A.y * hr + si[k]; hr = nr; hi = ni; } }
    }
}
template <int MODE, bool ROUTE>
__device__ __forceinline__ void ln_phase(const Frame& F, const Args& a, const float* xin, const float* gain, const float* beta, const float* router) {
    unsigned char* ws = a.ws; float* xout = a.out; bf16_t* xb = (bf16_t*)(ws + WS_XB);
    const bf16_t* hb = (const bf16_t*)(ws + (MODE == 0 ? WS_HBUF : WS_YB)); const f32x2* tokw = (const f32x2*)(ws + SM_TOKW);
    LAS int* cnt = (LAS int*)F.lds;
    const int lane = F.lane;
    f32x4 gv[4], bv[4];
#pragma unroll
    for (int j = 0; j < 4; ++j) { gv[j] = *(const f32x4*)(gain + 4 * lane + 256 * j); bv[j] = *(const f32x4*)(beta + 4 * lane + 256 * j); }
    for (int pm = F.bid; pm < T / 256; pm += F.G) {
        if (ROUTE) { if (F.tid < 8) cnt[F.tid] = 0; __syncthreads(); }
        for (int i = 0; i < 32; ++i) { const size_t row = (size_t)pm * 256 + F.wave * 32 + i;
            f32x4 v[4]; float s = 0.f;
            f32x2 w01 = (f32x2){0.f, 0.f}; if (MODE == 1) w01 = tokw[row];
#pragma unroll
            for (int j = 0; j < 4; ++j) { const f32x4 xv = *(const f32x4*)(xin + row * D + 4 * lane + 256 * j); f32x4 hv;
                if (MODE == 0) { const u32x2 q = *(const u32x2*)(hb + row * D + 4 * lane + 256 * j); hv = (f32x4){bflo(q.x), bfhi(q.x), bflo(q.y), bfhi(q.y)}; }
                else { const u32x2 q0 = *(const u32x2*)(hb + (2 * row) * D + 4 * lane + 256 * j), q1 = *(const u32x2*)(hb + (2 * row + 1) * D + 4 * lane + 256 * j);
                    hv = (f32x4){w01.x * bflo(q0.x) + w01.y * bflo(q1.x), w01.x * bfhi(q0.x) + w01.y * bfhi(q1.x), w01.x * bflo(q0.y) + w01.y * bflo(q1.y), w01.x * bfhi(q0.y) + w01.y * bfhi(q1.y)}; }
                v[j] = xv * ALPHA + hv; s += (v[j][0] + v[j][1]) + (v[j][2] + v[j][3]); }
            const float mean = wave_sum(s) * (1.f / D); float s2 = 0.f;
#pragma unroll
            for (int j = 0; j < 4; ++j) { v[j] = v[j] - mean; s2 += (v[j][0] * v[j][0] + v[j][1] * v[j][1]) + (v[j][2] * v[j][2] + v[j][3] * v[j][3]); }
            const float rstd = 1.0f / sqrtf(wave_sum(s2) * (1.f / D) + LN_EPS);
#pragma unroll
            for (int j = 0; j < 4; ++j) { v[j] = v[j] * rstd * gv[j] + bv[j];
                *(f32x4*)(xout + row * D + 4 * lane + 256 * j) = v[j];
                u32x2 w; w.x = cvt_pk_bf16(v[j][0], v[j][1]); w.y = cvt_pk_bf16(v[j][2], v[j][3]); *(u32x2*)(xb + row * D + 4 * lane + 256 * j) = w; }
            if (ROUTE) {
                float lg[8];
#pragma unroll
                for (int e = 0; e < 8; ++e) lg[e] = 0.f;
#pragma unroll
                for (int j = 0; j < 4; ++j)
#pragma unroll
                    for (int k = 0; k < 4; ++k) { const float* rr = router + (size_t)(4 * lane + 256 * j + k) * 8; const f32x4 r0 = *(const f32x4*)rr, r1 = *(const f32x4*)(rr + 4); const float xv = v[j][k];
                        lg[0] += xv * r0[0]; lg[1] += xv * r0[1]; lg[2] += xv * r0[2]; lg[3] += xv * r0[3]; lg[4] += xv * r1[0]; lg[5] += xv * r1[1]; lg[6] += xv * r1[2]; lg[7] += xv * r1[3]; }
#pragma unroll
                for (int e = 0; e < 8; ++e) lg[e] = wave_sum(lg[e]);
                int e0 = 0; float m0 = lg[0];
#pragma unroll
                for (int e = 1; e < 8; ++e) if (lg[e] > m0) { m0 = lg[e]; e0 = e; }
                int e1 = -1; float m1 = -3.0e38f;
#pragma unroll
                for (int e = 0; e < 8; ++e) if (e != e0 && lg[e] > m1) { m1 = lg[e]; e1 = e; }
                const float w0 = 1.0f / (1.0f + __expf(m1 - m0));
                if (lane == 0) { ((int*)(ws + SM_TOKE))[row] = e0 | (e1 << 8); ((f32x2*)(ws + SM_TOKW))[row] = (f32x2){w0, 1.0f - w0}; __hip_atomic_fetch_add(&cnt[e0], 1, __ATOMIC_RELAXED, __HIP_MEMORY_SCOPE_WORKGROUP); __hip_atomic_fetch_add(&cnt[e1], 1, __ATOMIC_RELAXED, __HIP_MEMORY_SCOPE_WORKGROUP); }
            }
        }
        if (ROUTE) { __syncthreads(); if (F.tid < 8) ((int*)(ws + SM_PCNT))[pm * 8 + F.tid] = cnt[F.tid]; __syncthreads(); }
    }
}
__device__ __forceinline__ void moe_gather(const Frame& F, const Args& a) {
    unsigned char* ws = a.ws; const int* pcnt = (const int*)(ws + SM_PCNT); const int* toke = (const int*)(ws + SM_TOKE);
    int* rowtok = (int*)(ws + SM_ROWTOK); int* tileexp = (int*)(ws + SM_TILEEXP);
    const bf16_t* xb = (const bf16_t*)(ws + WS_XB); bf16_t* xs = (bf16_t*)(ws + WS_XS);
    LAS int* sm = (LAS int*)F.lds;
    for (int pm = F.bid; pm < T / 256; pm += F.G) {
        for (int q = F.tid; q < (T / 256) * 8; q += 512) sm[1024 + q] = pcnt[q];
        if (F.tid >= 32 && F.tid < 288) sm[F.tid] = toke[pm * 256 + F.tid - 32];
        __syncthreads();
        if (F.tid < 8) { int tot = 0, before = 0; for (int q = 0; q < T / 256; ++q) { const int c = sm[1024 + q * 8 + F.tid]; tot += c; if (q < pm) before += c; } sm[F.tid] = tot; sm[16 + F.tid] = before; }
        __syncthreads();
        if (F.tid == 0) { int st = 0; for (int e = 0; e < 8; ++e) { sm[8 + e] = st * 256; st += (sm[e] + 255) >> 8; } sm[24] = st; }
        __syncthreads();
        {
            const int i = F.tid >> 1, k = F.tid & 1; const int ee = sm[32 + i]; const int e = k ? (ee >> 8) : (ee & 255);
            int cntb = 0; for (int q = 0; q < i; ++q) { const int o = sm[32 + q]; cntb += ((o & 255) == e) + ((o >> 8) == e); }
            const int dest = sm[8 + e] + sm[16 + e] + cntb; sm[512 + F.tid] = dest; rowtok[dest] = 2 * (pm * 256 + i) + k;
        }
        __syncthreads();
        for (int r = F.wave; r < 512; r += 8) { const int dest = sm[512 + r]; const size_t tok = (size_t)pm * 256 + (r >> 1);
            const u32x4* s = (const u32x4*)(xb + tok * D); u32x4* d = (u32x4*)(xs + (size_t)dest * D); d[F.lane] = s[F.lane]; d[64 + F.lane] = s[64 + F.lane]; }
        if (pm == 0) {
            for (int e = 0; e < 8; ++e) { const int r0 = sm[8 + e] + sm[e], r1 = sm[8 + e] + (((sm[e] + 255) >> 8) << 8); for (int r = r0 + F.tid; r < r1; r += 512) rowtok[r] = -1;
                const int t0 = sm[8 + e] >> 8, t1 = r1 >> 8; for (int t = t0 + F.tid; t < t1; t += 512) tileexp[t] = e; }
            if (F.tid == 0) tileexp[1023] = sm[24];
        }
        __syncthreads();
    }
}
struct MoeUpOrder { int ntile, G, c, chunk; const int* tileexp;
    __device__ __forceinline__ bool next(int i, pg8::Unit& u) const { if (!pg8::static_tile(i, G, c, ntile, 2 * DFE / 256, u.pm, u.pn)) return false;
        const int tile = chunk * MOE_CHUNK_TILES + u.pm, e = tileexp[tile]; u.aux = tile; u.offA = (long long)tile * 256 * D * 2; u.offB = ((long long)e * 2 * DFE + (long long)u.pn * 256) * D * 2; return true; } };
struct MoeDnOrder { int ntile, G, c, chunk; const int* tileexp;
    __device__ __forceinline__ bool next(int i, pg8::Unit& u) const { if (!pg8::static_tile(i, G, c, ntile, D / 256, u.pm, u.pn)) return false;
        const int tile = chunk * MOE_CHUNK_TILES + u.pm, e = tileexp[tile]; u.aux = tile; u.offA = (long long)u.pm * 256 * DFE * 2; u.offB = ((long long)e * D + (long long)u.pn * 256) * DFE * 2; return true; } };

enum { PH_PREP = 0, PH_WIN, PH_POST, PH_MIX1, PH_MIX2, PH_MIX3, PH_MIX4, PH_WOUT, PH_LN1, PH_FUP, PH_FDN, PH_MGATH = 9, PH_MUP0 = 10, PH_LN2 = 21, PH_PGATE, PH_PPROJ, PH_LN3, PH_PER_LAYER = 32 };
constexpr int GP_END = 2 + 32 * DEPTH;

__global__ void __launch_bounds__(512, 2) mk_fwd(Args a0) {
    extern __shared__ __attribute__((aligned(16))) unsigned char lds_raw[];
    LAS unsigned char* const lds = (LAS unsigned char*)lds_raw;
    for (int u = threadIdx.x; u < (LDS_BYTES - LDSCTL_OFF) / 4; u += 512) ((LAS unsigned*)(lds + LDSCTL_OFF))[u] = 0u;
    __syncthreads();
    const int gp_lo = a0.gp_lo, gp_hi = a0.gp_hi;
    XcdBarrier bar; bar.bar = (unsigned*)(a0.ws + WS_CTL) + CW_BAR; bar.x = 0; bar.st = nullptr;
    if (a0.use_bar) bar = xcd_barrier_post((unsigned*)(a0.ws + WS_CTL) + CW_BAR, (volatile LAS unsigned*)(lds + LDSCTL_OFF + 32));
#define RUN(gp) (gp_lo <= (gp) && (gp) < gp_hi)
#define SEAM(gp) do { if (gp_lo <= (gp) && (gp) + 1 < gp_hi) xcd_barrier(bar); } while (0)
#define PH_BEGIN Args a; load_args(a); const Frame F = make_frame(lds); unsigned char* const ws = a.ws; int l = lx; asm volatile("" : "+s"(l)); (void)l; (void)ws; \
    bf16_t* const xb = (bf16_t*)(ws + WS_XB); bf16_t* const z = (bf16_t*)(ws + WS_Z); bf16_t* const mix = (bf16_t*)(ws + WS_MIX); bf16_t* const hbuf = (bf16_t*)(ws + WS_HBUF); const long long S1K = 256ll * 1024 * 2; \
    (void)xb; (void)z; (void)mix; (void)hbuf; (void)S1K;
#define AP_DEF const nsa::Lane L{F.lane, F.lane & 31, F.lane >> 5, F.wave, F.tid}; \
    const nsa::AttnPtrs AP{(const bf16_t*)(ws + WS_Q), z, (const bf16_t*)(ws + WS_KC), (const bf16_t*)(ws + WS_VCT), (const bf16_t*)(ws + WS_KSEL), (const bf16_t*)(ws + WS_VSEL), \
                           (const bf16_t*)(ws + WS_KWIN), (const bf16_t*)(ws + WS_VWIN), (unsigned long long*)(ws + WS_SELM), mix};
    { const int lx = 0;
    if (RUN(0)) { PH_BEGIN phase_init0(F, a); }
    SEAM(0);
    if (RUN(1)) { PH_BEGIN phase_init1(F, a); }
    SEAM(1);
    }
    for (int lx = 0; lx < DEPTH; ++lx) {
        const int base = 2 + PH_PER_LAYER * lx; const bool moe = (lx & 1) != 0;
        if (RUN(base + PH_PREP)) { PH_BEGIN phase_prep(F, a, l); }
        SEAM(base + PH_PREP);
        if (RUN(base + PH_WIN)) { PH_BEGIN
            pg8::Gemm g{xb, (const bf16_t*)(ws + W_IN), D, D, D}; pg8::PlainOrder S{T / 256, INP / 256, F.G, F.bid, S1K, S1K}; epi::Bf16Plain E{z, INP};
            pg8::gemm_phase(F.lds, g, S, E);
        }
        SEAM(base + PH_WIN);
        if (RUN(base + PH_POST)) { PH_BEGIN phase_post(F, a); }
        SEAM(base + PH_POST);
        if (RUN(base + PH_MIX1)) {
            {   PH_BEGIN
                pg8::Gemm g{(const bf16_t*)(ws + WS_KCMP), (const bf16_t*)(ws + W_CMP), 1024, 1024, 1024};
                pg8::GroupedOrder S{2, 32, 2, F.G, F.bid, S1K, S1K, (long long)(WS_VCMP - WS_KCMP), 512ll * 1024 * 2}; epi::F32Grouped E{(float*)(ws + WS_CMPP), 512, (size_t)8192 * 512};
                pg8::gemm_phase(F.lds, g, S, E);
            }
            {   PH_BEGIN
                pg8::Gemm g{(const bf16_t*)(ws + WS_S5A), (const bf16_t*)(ws + W_S5S), 512, S5K, 512};
                pg8::GroupedOrder S{16, 8, 1, F.G, (F.bid + F.G / 2) % F.G, 256ll * S5K * 2, 256ll * 512 * 2, 2048ll * S5K * 2, 256ll * 512 * 2}; epi::F32Grouped E{(float*)(ws + WS_S5S), 256, (size_t)2048 * 256};
                pg8::gemm_phase(F.lds, g, S, E);
            }
            {   PH_BEGIN conv_items(F, a, l, F.bid, F.G); }
        }
        SEAM(base + PH_MIX1);
        if (RUN(base + PH_MIX2)) { { PH_BEGIN cmp_stage2(F, a, l); } { PH_BEGIN s5_carry(F, a, l); } }
        SEAM(base + PH_MIX2);
        if (RUN(base + PH_MIX3)) {
            {   PH_BEGIN
                pg8::Gemm g{(const bf16_t*)(ws + WS_S5A), (const bf16_t*)(ws + W_S5B), S5K, S5K, S5K};
                pg8::GroupedOrder S{16, 8, 2, F.G, F.bid, 256ll * S5K * 2, 256ll * S5K * 2, 2048ll * S5K * 2, 512ll * S5K * 2}; epi::S5Out E{(bf16_t*)(ws + WS_ZS5), z, (const float*)a.in[21] + (size_t)l * 256};
                pg8::gemm_phase(F.lds, g, S, E);
            }
            {   PH_BEGIN AP_DEF for (int u = F.bid; u < 32 * 64; u += F.G) nsa::cmp_unit(u >> 6, u & 63, AP, F.lds, L); }
        }
        SEAM(base + PH_MIX3);
        if (RUN(base + PH_MIX4)) {
            {   PH_BEGIN
                pg8::Gemm g{(const bf16_t*)(ws + WS_ZS5), (const bf16_t*)(ws + W_GLU), 256, 256, 256};
                pg8::PlainOrder S{T / 256, 1, F.G, F.bid, 256ll * 256 * 2, 256ll * 256 * 2}; epi::S5Glu E{mix, (const bf16_t*)(ws + WS_ZS5), (const float*)a.in[23] + (size_t)l * 256};
                pg8::gemm_phase(F.lds, g, S, E);
            }
            {   PH_BEGIN AP_DEF for (int p = F.bid; p < 32 * 32; p += F.G) { const int bh = p >> 5, s = p & 31; nsa::sw_unit(bh, s, AP, F.lds, L); nsa::sw_unit(bh, 63 - s, AP, F.lds, L); } }
        }
        SEAM(base + PH_MIX4);
        if (RUN(base + PH_WOUT)) { PH_BEGIN
            pg8::Gemm g{mix, (const bf16_t*)(ws + W_OUT), D, D, D}; pg8::PlainOrder S{T / 256, D / 256, F.G, F.bid, S1K, S1K}; epi::Bf16Plain E{hbuf, D};
            pg8::gemm_phase(F.lds, g, S, E);
        }
        SEAM(base + PH_WOUT);
        if (RUN(base + PH_LN1)) { PH_BEGIN
            const float* xin = (l == 0) ? (const float*)a.in[0] : (const float*)a.out;
            const float* gg = (const float*)a.in[34] + ((size_t)l * 3 + 0) * D; const float* bb = (const float*)a.in[35] + ((size_t)l * 3 + 0) * D;
            if (l & 1) ln_phase<0, true>(F, a, xin, gg, bb, (const float*)a.in[27] + (size_t)(l >> 1) * D * NEXP); else ln_phase<0, false>(F, a, xin, gg, bb, nullptr);
        }
        SEAM(base + PH_LN1);
        if (!moe) {
            if (RUN(base + PH_FUP)) { PH_BEGIN
                pg8::Gemm g{xb, (const bf16_t*)(ws + W_UP), D, D, D}; pg8::PlainOrder S{T / 256, 2 * DFF / 256, F.G, F.bid, S1K, S1K}; epi::SwiGlu E{(bf16_t*)(ws + WS_FFH), DFF};
                pg8::gemm_phase(F.lds, g, S, E);
            }
            SEAM(base + PH_FUP);
            if (RUN(base + PH_FDN)) { PH_BEGIN
                pg8::Gemm g{(const bf16_t*)(ws + WS_FFH), (const bf16_t*)(ws + W_DN), DFF, DFF, DFF}; pg8::PlainOrder S{T / 256, D / 256, F.G, F.bid, 256ll * DFF * 2, 256ll * DFF * 2}; epi::Bf16Plain E{hbuf, D};
                pg8::gemm_phase(F.lds, g, S, E);
            }
            SEAM(base + PH_FDN);
        } else {
            if (RUN(base + PH_MGATH)) { PH_BEGIN moe_gather(F, a); }
            SEAM(base + PH_MGATH);
            for (int cx = 0; cx < MOE_NCHUNK; ++cx) {
                if (RUN(base + PH_MUP0 + 2 * cx)) { PH_BEGIN int c = cx; asm volatile("" : "+s"(c)); const int* tileexp = (const int*)(ws + SM_TILEEXP);
                    int nt = tileexp[1023] - c * MOE_CHUNK_TILES; nt = nt < 0 ? 0 : (nt > MOE_CHUNK_TILES ? MOE_CHUNK_TILES : nt);
                    pg8::Gemm g{(const bf16_t*)(ws + WS_XS), (const bf16_t*)(ws + W_UP), D, D, D}; MoeUpOrder S{nt, F.G, F.bid, c, tileexp}; epi::SwiGlu E{(bf16_t*)(ws + WS_MH), DFE};
                    pg8::gemm_phase(F.lds, g, S, E);
                }
                SEAM(base + PH_MUP0 + 2 * cx);
                if (RUN(base + PH_MUP0 + 2 * cx + 1)) { PH_BEGIN int c = cx; asm volatile("" : "+s"(c)); const int* tileexp = (const int*)(ws + SM_TILEEXP);
                    int nt = tileexp[1023] - c * MOE_CHUNK_TILES; nt = nt < 0 ? 0 : (nt > MOE_CHUNK_TILES ? MOE_CHUNK_TILES : nt);
                    pg8::Gemm g{(const bf16_t*)(ws + WS_MH), (const bf16_t*)(ws + W_DN), DFE, DFE, DFE}; MoeDnOrder S{nt, F.G, F.bid, c, tileexp}; epi::MoeDown E{(bf16_t*)(ws + WS_YB), (const int*)(ws + SM_ROWTOK)};
                    pg8::gemm_phase(F.lds, g, S, E);
                }
                SEAM(base + PH_MUP0 + 2 * cx + 1);
            }
        }
        if (RUN(base + PH_LN2)) { PH_BEGIN
            const float* gg = (const float*)a.in[34] + ((size_t)l * 3 + 1) * D; const float* bb = (const float*)a.in[35] + ((size_t)l * 3 + 1) * D;
            if (l & 1) ln_phase<1, false>(F, a, a.out, gg, bb, nullptr); else ln_phase<0, false>(F, a, a.out, gg, bb, nullptr);
        }
        SEAM(base + PH_LN2);
        if (RUN(base + PH_PGATE)) { PH_BEGIN
            pg8::Gemm g{xb, (const bf16_t*)(ws + W_GATE), D, D, D}; pg8::PlainOrder S{T / 256, D / 256, F.G, F.bid, S1K, S1K}; epi::SigmoidBias E{mix, D, (const float*)a.in[32] + (size_t)l * D};
            pg8::gemm_phase(F.lds, g, S, E);
        }
        SEAM(base + PH_PGATE);
        if (RUN(base + PH_PPROJ)) { PH_BEGIN
            pg8::Gemm g{(const bf16_t*)(ws + WS_PB), (const bf16_t*)(ws + W_PROJ), PLE, PLE, PLE}; pg8::PlainOrder S{T / 256, D / 256, F.G, F.bid, 256ll * PLE * 2, 256ll * PLE * 2}; epi::MulBf16 E{hbuf, mix, D};
            pg8::gemm_phase(F.lds, g, S, E);
        }
        SEAM(base + PH_PPROJ);
        if (RUN(base + PH_LN3)) { PH_BEGIN
            const float* gg = (const float*)a.in[34] + ((size_t)l * 3 + 2) * D; const float* bb = (const float*)a.in[35] + ((size_t)l * 3 + 2) * D;
            ln_phase<0, false>(F, a, a.out, gg, bb, nullptr);
        }
        SEAM(base + PH_LN3);
    }
#undef RUN
#undef SEAM
}

#if MK_CHECK
constexpr size_t SM_CHK = WS_SMALL + 6 * MiB + 65536;
__device__ __forceinline__ unsigned hsh(unsigned x) { x ^= x >> 16; x *= 0x7feb352dU; x ^= x >> 15; x *= 0x846ca68bU; x ^= x >> 16; return x; }
__device__ __forceinline__ bool cbad(float got, float ref, float rtol, float atol) { return !(fabsf(got - ref) <= rtol * fabsf(ref) + atol); }
__device__ __forceinline__ void cfail(unsigned char* ws, int code) { if (code == 14) atomicAdd((unsigned*)(ws + SM_CHK) + 2, 1u); if (code == 22) atomicAdd((unsigned*)(ws + SM_CHK) + 3, 1u); if (code >= 64) atomicOr((unsigned*)(ws + SM_CHK) + 1, 1u << (code - 64)); else atomicOr((unsigned*)(ws + SM_CHK), 1u << code); }
__device__ __forceinline__ float bfat(const bf16_t* p, size_t i) { return bf2f(p[i]); }
__global__ void chk_gemm(Args a, int code, const bf16_t* A, int lda, int K, const float* W, const float* W3, int N, const bf16_t* O, int ldo, int mode, const float* bias, const bf16_t* G, int rows) {
    const unsigned s = blockIdx.x * blockDim.x + threadIdx.x; const int tok = hsh(s * 2 + 1) % rows, col = hsh(s * 2 + 2) % N;
    float acc = 0.f, acc3 = 0.f;
    for (int k = 0; k < K; ++k) { const float x = bfat(A, (size_t)tok * lda + k); acc += x * (mode == 7 ? W[(size_t)col * N + k] : W[(size_t)k * N + col]); if (mode == 2) acc3 += x * W3[(size_t)k * N + col]; }
    float ref = acc;
    if (mode == 1 || mode == 7) ref = 1.f / (1.f + expf(-(acc + bias[col])));
    if (mode == 5) ref = 1.f / (1.f + expf(-acc));
    if (mode == 6) ref = acc + bias[col];
    if (mode == 2) ref = acc / (1.f + expf(-acc)) * acc3;
    if (mode == 3) ref = acc * bfat(G, (size_t)tok * ldo + col);
    if (mode == 4) ref = bfat(A, (size_t)tok * lda + col) / (1.f + expf(-(acc + bias[col])));
    const float got = bfat(O, (size_t)tok * ldo + col);
    if (cbad(got, ref, 0.03f, 0.03f)) cfail(a.ws, code);
}
__global__ void chk_rope(Args a, int code) {
    unsigned char* ws = a.ws; const bf16_t* z = (const bf16_t*)(ws + WS_Z); const int* pos = (const int*)a.in[2];
    const unsigned s = blockIdx.x * blockDim.x + threadIdx.x; const int tok = hsh(s * 3 + 1) % T, i = hsh(s * 3 + 2) % 32, sel = hsh(s * 3 + 3) % 14;
    float c, sn; sincos_rev((double)pos[tok] * c_invfreq_rev[i], c, sn);
    int col; const bf16_t* dst; float sc = 1.f;
    if (sel < 8) { col = sel * 64; dst = (const bf16_t*)(ws + WS_Q) + (size_t)tok * 512 + sel * 64; sc = QSCALE; }
    else { const int kk = sel - 8, which = kk >> 1, h = kk & 1; col = ZKV + (which * 2 * 2 + h) * 64; dst = (const bf16_t*)(ws + (which == 0 ? WS_KCMP : which == 1 ? WS_KSEL : WS_KWIN)) + ((size_t)((tok >> 12) * 2 + h) * SEQ + (tok & 4095)) * 64; }
    const float x1 = bfat(z, (size_t)tok * INP + col + i), x2 = bfat(z, (size_t)tok * INP + col + 32 + i);
    if (cbad(bf2f(dst[i]), (x1 * c - x2 * sn) * sc, 0.02f, 0.02f) || cbad(bf2f(dst[32 + i]), (x2 * c + x1 * sn) * sc, 0.02f, 0.02f)) cfail(ws, code);
}
__global__ void chk_cmp(Args a, int code, int l) {
    unsigned char* ws = a.ws; __shared__ float hid[256];
    const int s = blockIdx.x, j = s & 1, bh = hsh(s * 5 + 1) % 32, n = (s < 8) ? (s < 4 ? 0 : 254) : hsh(s * 5 + 2) % 255, c = threadIdx.x;
    const bf16_t* src = (const bf16_t*)(ws + (j == 0 ? WS_KCMP : WS_VCMP)) + ((size_t)bh * SEQ + 16 * n) * 64;
    const float* pe = (const float*)a.in[5] + ((size_t)l * 2 + j) * 2048; const float* w1 = (const float*)a.in[6] + ((size_t)l * 2 + j) * 2048 * 256;
    float acc = ((const float*)a.in[7])[((size_t)l * 2 + j) * 256 + c];
    for (int k = 0; k < 2048; ++k) acc += (bf2f(src[k]) + pe[k]) * w1[(size_t)k * 256 + c];
    const float u = 0.7978845608f * (acc + 0.044715f * acc * acc * acc); hid[c] = 0.5f * acc * (1.f + tanhf(u));
    __syncthreads();
    if (c < 64) { const float* w2 = (const float*)a.in[8] + ((size_t)l * 2 + j) * 256 * 64; float o = ((const float*)a.in[9])[((size_t)l * 2 + j) * 64 + c];
        for (int k = 0; k < 256; ++k) o += hid[k] * w2[k * 64 + c];
        const float got = j == 0 ? bfat((const bf16_t*)(ws + WS_KC), ((size_t)bh * 256 + n) * 64 + c) : bfat((const bf16_t*)(ws + WS_VCT), ((size_t)bh * 4 + (n >> 6)) * 4096 + c * 64 + nsa::vslot(n & 63));
        if (cbad(got, o, 0.04f, 0.02f)) cfail(ws, code); }
}
__device__ __forceinline__ float chk_dot(const bf16_t* q, const bf16_t* k) { float d_ = 0.f; for (int d = 0; d < 64; ++d) d_ += bf2f(q[d]) * bf2f(k[d]); return d_; }
__global__ void chk_attn(Args a, int code, int stage) {
    unsigned char* ws = a.ws; const int lane = threadIdx.x, s = blockIdx.x;
    const int b = hsh(s * 7 + 1) % NB, head = hsh(s * 7 + 2) % 8, t = (s < 6) ? (s == 0 ? 0 : s == 1 ? 30 : s == 2 ? 31 : s == 3 ? 63 : s == 4 ? 64 : 4095) : hsh(s * 7 + 3) % SEQ;
    const int h = head >> 2, bh = b * 2 + h, qb = t >> 6; const size_t tok = (size_t)b * SEQ + t;
    const bf16_t* z = (const bf16_t*)(ws + WS_Z); const bf16_t* q = (const bf16_t*)(ws + WS_Q) + tok * 512 + head * 64;
    float outv = 0.f;
    {
        const bf16_t* kc = (const bf16_t*)(ws + WS_KC) + (size_t)bh * 256 * 64; const bf16_t* vct = (const bf16_t*)(ws + WS_VCT) + (size_t)bh * 4 * 4096;
        float m = -3e38f;
        for (int i = 0; i < 4; ++i) { const int n = lane + 64 * i; const float d_ = chk_dot(q, kc + n * 64); const bool ok = (n < 255) && (16 * n + 31 <= t); if (ok) m = fmaxf(m, d_); }
        for (int o = 1; o < 64; o <<= 1) m = fmaxf(m, __shfl_xor(m, o));
        float l_ = 0.f, accd = 0.f;
        for (int i = 0; i < 4; ++i) { const int n = lane + 64 * i; const float d_ = chk_dot(q, kc + n * 64); const bool ok = (n < 255) && (16 * n + 31 <= t); const float p = ok ? exp2f(d_ - m) : 0.f; l_ += p;
            for (int d = 0; d < 64; ++d) { float v = p * bf2f(vct[(n >> 6) * 4096 + d * 64 + nsa::vslot(n & 63)]); for (int o = 1; o < 64; o <<= 1) v += __shfl_xor(v, o); if (lane == d) accd += v; } }
        for (int o = 1; o < 64; o <<= 1) l_ += __shfl_xor(l_, o);
        const float g0 = 1.f / (1.f + expf(-bf2f(z[tok * INP + ZG + head * 3 + 0])));
        if (l_ > 0.f) outv += g0 * accd / l_;
    }
    const unsigned long long selw = ((const unsigned long long*)(ws + WS_SELM))[(size_t)bh * SEQ + t];
    if (stage == 0) {
        const int cnt = __popcll(selw & ((qb >= 63) ? ~0ull : ((1ull << (qb + 1)) - 1ull))); const int want = qb + 1 < 16 ? qb + 1 : 16;
        const bool f0 = (selw & 1ull) && ((selw >> qb) & 1ull) && (qb == 0 || ((selw >> (qb - 1)) & 1ull));
        if (lane == 0 && (cnt != want || !f0)) cfail(ws, code + 1);
    } else {
        for (int br = 1; br < 3; ++br) {
            const bf16_t* kb = (const bf16_t*)(ws + (br == 1 ? WS_KSEL : WS_KWIN)) + (size_t)bh * SEQ * 64; const int vcol = ZKV + ((br == 1 ? 3 : 5) * 2 + h) * 64;
            float m = -3e38f, l_ = 0.f, accd = 0.f;
            for (int pass = 0; pass < 2; ++pass) {
                for (int j = 0; j <= qb; ++j) { const int kp = 64 * j + lane; bool ok = kp <= t;
                    if (br == 1) ok = ok && ((selw >> j) & 1ull); else ok = ok && (kp > t - 512);
                    if (!__any(ok)) continue;
                    const float d_ = chk_dot(q, kb + (size_t)kp * 64);
                    if (pass == 0) { if (ok) m = fmaxf(m, d_); }
                    else { const float p = ok ? exp2f(d_ - m) : 0.f; l_ += p;
                        for (int d = 0; d < 64; ++d) { float v = p * bf2f(z[((size_t)b * SEQ + kp) * INP + vcol + d]); for (int o = 1; o < 64; o <<= 1) v += __shfl_xor(v, o); if (lane == d) accd += v; } } }
                if (pass == 0) for (int o = 1; o < 64; o <<= 1) m = fmaxf(m, __shfl_xor(m, o));
            }
            for (int o = 1; o < 64; o <<= 1) l_ += __shfl_xor(l_, o);
            const float gt = 1.f / (1.f + expf(-bf2f(z[tok * INP + ZG + head * 3 + br])));
            outv += gt * accd / l_;
        }
    }
    const bf16_t* mixr = (const bf16_t*)(ws + WS_MIX) + tok * 1024 + head * 64;
    const bool bad = cbad(bf2f(mixr[lane]), outv, 0.05f, 0.006f);
    if (__any(bad) && lane == 0) cfail(ws, code);
}
__global__ void chk_conv(Args a, int code, int l) {
    unsigned char* ws = a.ws; const int lane = threadIdx.x, s = blockIdx.x; const int b = hsh(s * 3 + 1) % NB, t = (s < 4) ? (s == 0 ? 0 : s == 1 ? 29 : s == 2 ? 30 : 31) : hsh(s * 3 + 2) % SEQ;
    const bf16_t* z = (const bf16_t*)(ws + WS_Z); const float* cw = (const float*)a.in[10] + (size_t)l * 31 * 256; const float* cb = (const float*)a.in[11] + (size_t)l * 256;
    float y[4]; float sum = 0.f;
#pragma unroll
    for (int e = 0; e < 4; ++e) { const int c = lane * 4 + e; float acc = cb[c];
        for (int j = 0; j < 31; ++j) { const int tt = t + j - 30; if (tt < 0) continue; const bf16_t* zr = z + ((size_t)b * SEQ + tt) * INP + ZC; acc += cw[j * 256 + c] * (bf2f(zr[c]) / (1.f + expf(-bf2f(zr[256 + c])))); }
        y[e] = acc; sum += acc; }
    for (int o = 1; o < 64; o <<= 1) sum += __shfl_xor(sum, o);
    const float mean = sum / 256.f; float var = 0.f;
#pragma unroll
    for (int e = 0; e < 4; ++e) var += (y[e] - mean) * (y[e] - mean);
    for (int o = 1; o < 64; o <<= 1) var += __shfl_xor(var, o);
    const float rstd = 1.f / sqrtf(var / 256.f + LN_EPS); bool bad = false;
#pragma unroll
    for (int e = 0; e < 4; ++e) { const int c = lane * 4 + e; const float v = (y[e] - mean) * rstd * ((const float*)a.in[12])[l * 256 + c] + ((const float*)a.in[13])[l * 256 + c]; const float ref = v / (1.f + expf(-v));
        bad = bad || cbad(bfat((const bf16_t*)(ws + WS_MIX), ((size_t)b * SEQ + t) * 1024 + 512 + c), ref, 0.03f, 0.02f); }
    if (__any(bad) && lane == 0) cfail(ws, code);
}
__global__ void chk_s5(Args a, int code, int l) {
    unsigned char* ws = a.ws; const int n = threadIdx.x, s = blockIdx.x, b = hsh(s * 3 + 1) % NB, g = hsh(s * 3 + 2) % 16, lg = l * 16 + g;
    const bf16_t* z = (const bf16_t*)(ws + WS_Z);
    const float dt = expf(((const float*)a.in[16])[lg]), lr = ((const float*)a.in[14])[lg * 64 + n], li = ((const float*)a.in[15])[lg * 64 + n];
    const float mg = expf(lr * dt), abr = mg * cosf(li * dt), abi = mg * sinf(li * dt), den = lr * lr + li * li;
    const float cr = ((abr - 1.f) * lr + abi * li) / den, ci = (abi * lr - (abr - 1.f) * li) / den;
    float bbr[16], bbi[16];
#pragma unroll
    for (int c = 0; c < 16; ++c) { const float br = ((const float*)a.in[17])[((size_t)lg * 64 + n) * 16 + c], bi = ((const float*)a.in[18])[((size_t)lg * 64 + n) * 16 + c]; bbr[c] = cr * br - ci * bi; bbi[c] = cr * bi + ci * br; }
    float hr = 0.f, hi = 0.f; bool bad = false;
    for (int t = 0; t < SEQ; ++t) { const bf16_t* ur = z + ((size_t)b * SEQ + t) * INP + ZS + g * 16; float ur_ = 0.f, ui_ = 0.f, uu[16];
#pragma unroll
        for (int c = 0; c < 16; ++c) { uu[c] = bf2f(ur[c]); ur_ += bbr[c] * uu[c]; ui_ += bbi[c] * uu[c]; }
        const float nr = abr * hr - abi * hi + ur_, ni = abr * hi + abi * hr + ui_; hr = nr; hi = ni;
        if (t < 3 || (t & 1023) == 1023 || t == 31 || t == 32 || t == 33 || t == 100 || t == 2000) {
#pragma unroll
            for (int co = 0; co < 16; ++co) { float v = hr * ((const float*)a.in[19])[((size_t)lg * 16 + co) * 64 + n] - hi * ((const float*)a.in[20])[((size_t)lg * 16 + co) * 64 + n];
                for (int o = 1; o < 64; o <<= 1) v += __shfl_xor(v, o);
                const float y = v + ((const float*)a.in[21])[l * 256 + g * 16 + co] * uu[co]; const float u = 0.7978845608f * (y + 0.044715f * y * y * y), ref = 0.5f * y * (1.f + tanhf(u));
                bad = bad || cbad(bfat((const bf16_t*)(ws + WS_ZS5), ((size_t)b * SEQ + t) * 256 + g * 16 + co), ref, 0.04f, 0.03f); } } }
    if (n == 0 && bad) cfail(ws, code);
}
__global__ void chk_ln1(Args a, int code) {
    unsigned char* ws = a.ws; const int lane = threadIdx.x, row = hsh(blockIdx.x * 3 + 1) % T; const float* x = (const float*)a.in[0] + (size_t)row * D; const bf16_t* hb = (const bf16_t*)(ws + WS_HBUF) + (size_t)row * D;
    float v[16], s = 0.f;
#pragma unroll
    for (int i = 0; i < 16; ++i) { const int c = lane + 64 * i; v[i] = ALPHA * x[c] + bf2f(hb[c]); s += v[i]; }
    for (int o = 1; o < 64; o <<= 1) s += __shfl_xor(s, o);
    const float mean = s / D; float q = 0.f;
#pragma unroll
    for (int i = 0; i < 16; ++i) q += (v[i] - mean) * (v[i] - mean);
    for (int o = 1; o < 64; o <<= 1) q += __shfl_xor(q, o);
    const float rstd = 1.f / sqrtf(q / D + LN_EPS); bool bad = false;
#pragma unroll
    for (int i = 0; i < 16; ++i) { const int c = lane + 64 * i; const float ref = (v[i] - mean) * rstd * ((const float*)a.in[34])[c] + ((const float*)a.in[35])[c];
        bad = bad || cbad(a.out[(size_t)row * D + c], ref, 0.01f, 0.01f) || cbad(bfat((const bf16_t*)(ws + WS_XB), (size_t)row * D + c), ref, 0.02f, 0.02f); }
    if (__any(bad) && lane == 0) cfail(ws, code);
}
__global__ void chk_moe(Args a, int code, int j2) {
    unsigned char* ws = a.ws; __shared__ float hid[DFE]; __shared__ float lgs[8];
    const int tok = hsh(blockIdx.x * 3 + 1) % T, k = blockIdx.x & 1, c = threadIdx.x; const bf16_t* xr = (const bf16_t*)(ws + WS_XB) + (size_t)tok * D;
    if (c < 8) { float acc = 0.f; for (int i = 0; i < D; ++i) acc += bf2f(xr[i]) * ((const float*)a.in[27])[((size_t)j2 * D + i) * 8 + c]; lgs[c] = acc; }
    __syncthreads();
    const int ee = ((const int*)(ws + SM_TOKE))[tok], e0 = ee & 255, e1 = ee >> 8, e = k ? e1 : e0; const f32x2 w = ((const f32x2*)(ws + SM_TOKW))[tok];
    if (c == 0) { bool bad = (e0 == e1) || e0 > 7 || e1 > 7 || e0 < 0 || e1 < 0; if (!bad) { for (int i = 0; i < 8; ++i) if (i != e0 && i != e1 && (lgs[i] > lgs[e1] + 0.02f)) bad = true; if (lgs[e1] > lgs[e0] + 0.02f) bad = true;
            const float w0 = 1.f / (1.f + expf(lgs[e1] - lgs[e0])); if (cbad(w.x, w0, 0.02f, 0.01f) || cbad(w.y, 1.f - w0, 0.02f, 0.01f)) bad = true; }
        if (bad) cfail(ws, code); }
    const float* w1 = (const float*)a.in[28] + ((size_t)j2 * 8 + e) * D * DFE; const float* w3 = (const float*)a.in[29] + ((size_t)j2 * 8 + e) * D * DFE; const float* w2 = (const float*)a.in[30] + ((size_t)j2 * 8 + e) * DFE * D;
    for (int f = c; f < DFE; f += 256) { float a1 = 0.f, a3 = 0.f; for (int i = 0; i < D; ++i) { const float x = bf2f(xr[i]); a1 += x * w1[(size_t)i * DFE + f]; a3 += x * w3[(size_t)i * DFE + f]; } hid[f] = a1 / (1.f + expf(-a1)) * a3; }
    __syncthreads();
    bool bad = false;
    for (int col = c; col < D; col += 256) { float acc = 0.f; for (int f = 0; f < DFE; ++f) acc += hid[f] * w2[(size_t)f * D + col]; bad = bad || cbad(bfat((const bf16_t*)(ws + WS_YB), ((size_t)2 * tok + k) * D + col), acc, 0.04f, 0.03f); }
    if (bad) cfail(ws, code + 1);
}
__global__ void chk_range01(Args a, int code, const bf16_t* O, size_t n) { const size_t i = ((size_t)hsh(blockIdx.x * blockDim.x + threadIdx.x) * 2654435761ull) % n; const float v = bf2f(O[i]); if (!(v > 0.f && v < 1.f)) cfail(a.ws, code); }
__global__ void chk_wt(Args a, int code, const bf16_t* Wt, const float* W, int K, int N) { const unsigned s = blockIdx.x * blockDim.x + threadIdx.x; const int n = hsh(s * 2 + 1) % N, k = hsh(s * 2 + 2) % K;
    if (cbad(bf2f(Wt[(size_t)n * K + k]), W[(size_t)k * N + n], 0.01f, 1e-4f)) cfail(a.ws, code); }
__global__ void chk_spike_bf(Args a, int code, const bf16_t* p, size_t n, float thr) { bool bad = false; for (size_t i = (size_t)blockIdx.x * blockDim.x + threadIdx.x; i < n; i += (size_t)gridDim.x * blockDim.x) { const float v = bf2f(p[i]); bad = bad || !(fabsf(v) <= thr); }
    if (bad) atomicOr((unsigned*)(a.ws + SM_CHK) + 8 + (code >> 5), 1u << (code & 31));
    if (code == 7) { unsigned c = 0; for (size_t i = (size_t)blockIdx.x * blockDim.x + threadIdx.x; i < n; i += (size_t)gridDim.x * blockDim.x) { const float v = bf2f(p[i]); c += !(fabsf(v) <= thr); if (v != v) atomicAdd((unsigned*)(a.ws + SM_CHK) + 13, 1u); else if (fabsf(v) > thr && fabsf(v) < 100.f) atomicAdd((unsigned*)(a.ws + SM_CHK) + 14, 1u); } if (c) atomicAdd((unsigned*)(a.ws + SM_CHK) + 12, c); } }
__global__ void chk_spike_f32(Args a, int code, const float* p, size_t n, float thr) { bool bad = false; for (size_t i = (size_t)blockIdx.x * blockDim.x + threadIdx.x; i < n; i += (size_t)gridDim.x * blockDim.x) { const float v = p[i]; bad = bad || !(fabsf(v) <= thr); }
    if (bad) atomicOr((unsigned*)(a.ws + SM_CHK) + 8 + (code >> 5), 1u << (code & 31)); }
__global__ void chk_final(Args a) { unsigned m = *(const unsigned*)(a.ws + SM_CHK); const unsigned v = ((const unsigned*)(a.ws + SM_CHK))[1];
    { const unsigned s0 = ((const unsigned*)(a.ws + SM_CHK))[8], s1 = ((const unsigned*)(a.ws + SM_CHK))[9]; if (s0 && (__ffs(s0) - 1) == 7) { { const unsigned nn = ((const unsigned*)(a.ws + SM_CHK))[13], ns = ((const unsigned*)(a.ws + SM_CHK))[14]; a.out[0] = nn ? 3e6f + (float)nn : (ns ? 5e6f + (float)ns : 7e6f); } return; } if (s0 | s1) { const int k = s0 ? (__ffs(s0) - 1) : (32 + __ffs(s1) - 1); a.out[0] = 1000.f + 100.f * (float)k; return; } }
    (void)v; { const unsigned c14 = ((const unsigned*)(a.ws + SM_CHK))[2], c22 = ((const unsigned*)(a.ws + SM_CHK))[3]; if (c14 || c22) { a.out[0] = 1000.f + (float)c14; a.out[1] = -(500.f + 0.1f * (float)c22); return; } }
    if (m) { const int k = __ffs(m) - 1; a.out[0] = (k < 10) ? 100.f * k : (k < 19 ? 1000.f * (k - 9) : 10000.f * (k - 18)); } }
static void run_spikes(const Args& a, int gp, hipStream_t st) {
    if (gp < 2) return; const int l = (gp - 2) / PH_PER_LAYER, ph = (gp - 2) % PH_PER_LAYER; unsigned char* ws = a.ws; const int c0 = l * 10; const bool moe = (l & 1) != 0;
    const bf16_t* z = (const bf16_t*)(ws + WS_Z); const bf16_t* mix = (const bf16_t*)(ws + WS_MIX); const bf16_t* hbuf = (const bf16_t*)(ws + WS_HBUF);
#define SPK_BF(code, p, n, thr) hipLaunchKernelGGL(chk_spike_bf, dim3(1024), dim3(256), 0, st, a, code, p, (size_t)(n), thr)
    if (ph == PH_WIN) SPK_BF(c0 + 0, z, (size_t)T * INP, 15.f);
    if (ph == PH_MIX4) SPK_BF(c0 + 1, mix, (size_t)T * D, 15.f);
    if (ph == PH_WOUT) SPK_BF(c0 + 2, hbuf, (size_t)T * D, 15.f);
    if (ph == PH_LN1) hipLaunchKernelGGL(chk_spike_f32, dim3(1024), dim3(256), 0, st, a, c0 + 3, (const float*)a.out, (size_t)T * D, 12.f);
    if (!moe && ph == PH_FUP) SPK_BF(c0 + 4, (const bf16_t*)(ws + WS_FFH), (size_t)T * DFF, 150.f);
    if (!moe && ph == PH_FDN) SPK_BF(c0 + 5, hbuf, (size_t)T * D, 15.f);
    if (moe && ph == PH_MUP0 + 2 * MOE_NCHUNK - 1) SPK_BF(c0 + 5, (const bf16_t*)(ws + WS_YB), (size_t)2 * T * D, 30.f);
    if (ph == PH_LN2) hipLaunchKernelGGL(chk_spike_f32, dim3(1024), dim3(256), 0, st, a, c0 + 6, (const float*)a.out, (size_t)T * D, 12.f);
    if (ph == PH_PGATE) SPK_BF(c0 + 7, mix, (size_t)T * D, 1.0f);
    if (ph == PH_PPROJ) SPK_BF(c0 + 8, hbuf, (size_t)T * D, 15.f);
    if (ph == PH_LN3) hipLaunchKernelGGL(chk_spike_f32, dim3(1024), dim3(256), 0, st, a, c0 + 9, (const float*)a.out, (size_t)T * D, 12.f);
}
static void run_checks(const Args& a, int gp, hipStream_t st) {
    run_spikes(a, gp, st);
    if (gp < 2) return; const int l = (gp - 2) / PH_PER_LAYER, ph = (gp - 2) % PH_PER_LAYER; if (!((CHK_LAYER >> l) & 1)) return;
    unsigned char* ws = a.ws; const int j2 = l >> 1; const bool moe = (l & 1) != 0;
    const bf16_t* xb = (const bf16_t*)(ws + WS_XB); const bf16_t* z = (const bf16_t*)(ws + WS_Z); const bf16_t* mix = (const bf16_t*)(ws + WS_MIX); const bf16_t* hbuf = (const bf16_t*)(ws + WS_HBUF);
    if (ph == PH_PREP) { hipLaunchKernelGGL(chk_wt, dim3(64), dim3(256), 0, st, a, 18, (const bf16_t*)(ws + W_GATE), (const float*)a.in[31] + (size_t)l * D * D, D, D);
        hipLaunchKernelGGL(chk_wt, dim3(64), dim3(256), 0, st, a, 17, (const bf16_t*)(ws + W_OUT), (const float*)a.in[4] + (size_t)l * D * D, D, D); }
    if (ph == PH_PGATE) hipLaunchKernelGGL(chk_wt, dim3(64), dim3(256), 0, st, a, 19, (const bf16_t*)(ws + W_GATE), (const float*)a.in[31] + (size_t)l * D * D, D, D);
    if (ph == PH_WIN) hipLaunchKernelGGL(chk_gemm, dim3(16), dim3(256), 0, st, a, 1, xb, D, D, (const float*)a.in[3] + (size_t)l * D * INW, (const float*)nullptr, INW, z, INP, 0, (const float*)nullptr, (const bf16_t*)nullptr, T);
    if (ph == PH_POST) hipLaunchKernelGGL(chk_rope, dim3(16), dim3(256), 0, st, a, 2);
    if (ph == PH_MIX2) hipLaunchKernelGGL(chk_cmp, dim3(64), dim3(256), 0, st, a, 3, l);
    if (ph == PH_MIX1) hipLaunchKernelGGL(chk_conv, dim3(64), dim3(64), 0, st, a, 4, l);
    if (ph == PH_MIX3) { hipLaunchKernelGGL(chk_s5, dim3(8), dim3(64), 0, st, a, 5, l); hipLaunchKernelGGL(chk_attn, dim3(64), dim3(64), 0, st, a, 6, 0); }
    if (ph == PH_MIX4) { hipLaunchKernelGGL(chk_attn, dim3(64), dim3(64), 0, st, a, 8, 1);
        hipLaunchKernelGGL(chk_gemm, dim3(16), dim3(256), 0, st, a, 9, (const bf16_t*)(ws + WS_ZS5), 256, 256, (const float*)a.in[22] + (size_t)l * 256 * 256, (const float*)nullptr, 256, mix + 768, D, 4, (const float*)a.in[23] + (size_t)l * 256, (const bf16_t*)nullptr, T); }
    if (ph == PH_WOUT) hipLaunchKernelGGL(chk_gemm, dim3(16), dim3(256), 0, st, a, 10, mix, D, D, (const float*)a.in[4] + (size_t)l * D * D, (const float*)nullptr, D, hbuf, D, 0, (const float*)nullptr, (const bf16_t*)nullptr, T);
    if (ph == PH_LN1 && l == 0) hipLaunchKernelGGL(chk_ln1, dim3(64), dim3(64), 0, st, a, 11);
    if (!moe && ph == PH_FUP) hipLaunchKernelGGL(chk_gemm, dim3(16), dim3(256), 0, st, a, 12, xb, D, D, (const float*)a.in[24] + (size_t)j2 * D * DFF, (const float*)a.in[25] + (size_t)j2 * D * DFF, DFF, (const bf16_t*)(ws + WS_FFH), DFF, 2, (const float*)nullptr, (const bf16_t*)nullptr, T);
    if (!moe && ph == PH_FDN) hipLaunchKernelGGL(chk_gemm, dim3(16), dim3(256), 0, st, a, 13, (const bf16_t*)(ws + WS_FFH), DFF, DFF, (const float*)a.in[26] + (size_t)j2 * DFF * D, (const float*)nullptr, D, hbuf, D, 0, (const float*)nullptr, (const bf16_t*)nullptr, T);
    if (ph == PH_PGATE) { hipLaunchKernelGGL(chk_range01, dim3(16), dim3(256), 0, st, a, 22, mix, (size_t)T * D); }
    if (ph == PH_PGATE) { for (int v = 0; v < 3; ++v) hipLaunchKernelGGL(chk_gemm, dim3(16), dim3(256), 0, st, a, 64 + v, xb, D, D, (const float*)a.in[31] + (size_t)l * D * D, (const float*)nullptr, D, mix, D, 5 + v, (const float*)a.in[32] + (size_t)l * D, (const bf16_t*)nullptr, T); }
    if (ph == PH_PGATE) hipLaunchKernelGGL(chk_gemm, dim3(16), dim3(256), 0, st, a, 14, xb, D, D, (const float*)a.in[31] + (size_t)l * D * D, (const float*)nullptr, D, mix, D, 1, (const float*)a.in[32] + (size_t)l * D, (const bf16_t*)nullptr, T);
    if (ph == PH_PPROJ) hipLaunchKernelGGL(chk_gemm, dim3(16), dim3(256), 0, st, a, 15, (const bf16_t*)(ws + WS_PB), PLE, PLE, (const float*)a.in[33] + (size_t)l * PLE * D, (const float*)nullptr, D, hbuf, D, 3, (const float*)nullptr, mix, T);
    if (moe && ph == PH_MUP0 + 2 * MOE_NCHUNK - 1) hipLaunchKernelGGL(chk_moe, dim3(32), dim3(256), 0, st, a, 23, j2);
}
#endif
static bool phase_applies(int gp) {
    if (gp < 2) return true;
    const int l = (gp - 2) / PH_PER_LAYER, ph = (gp - 2) % PH_PER_LAYER; const bool moe = (l & 1) != 0;
    if (ph <= PH_LN1) return true;
    if (ph == PH_LN2 || ph == PH_PGATE || ph == PH_PPROJ || ph == PH_LN3) return true;
    if (!moe) return ph == PH_FUP || ph == PH_FDN;
    return ph >= PH_MGATH && ph < PH_MUP0 + 2 * MOE_NCHUNK;
}
extern "C" void kernel_launch(void* const* d_in, const int* in_sizes, int n_in, void* d_out, int out_size, void* d_ws, size_t ws_size, hipStream_t stream) {
    static int grid = 0;
    if (grid == 0) {
        if (n_in != 36 || out_size != T * D || ws_size < WS_END) { fprintf(stderr, "kernel_launch: unexpected problem (n_in %d out %d ws %zu, need %zu)\n", n_in, out_size, ws_size, (size_t)WS_END); grid = -1; return; }
        int dev = 0, cus = 0, per_cu = 0;
        if (hipGetDevice(&dev) != hipSuccess || hipDeviceGetAttribute(&cus, hipDeviceAttributeMultiprocessorCount, dev) != hipSuccess) { grid = -1; return; }
        if (hipFuncSetAttribute((const void*)mk_fwd, hipFuncAttributeMaxDynamicSharedMemorySize, LDS_BYTES) != hipSuccess) { fprintf(stderr, "kernel_launch: hipFuncSetAttribute failed\n"); grid = -1; return; }
        if (hipOccupancyMaxActiveBlocksPerMultiprocessor(&per_cu, (const void*)mk_fwd, 512, LDS_BYTES) != hipSuccess || per_cu < 1) fprintf(stderr, "kernel_launch: occupancy query reports %d\n", per_cu);
        (void)hipGetLastError();
        grid = cus;
    }
    if (grid < 0) return;
    (void)in_sizes;
    if (hipMemsetAsync((char*)d_ws + WS_CTL, 0, CTL_ZERO_BYTES, stream) != hipSuccess) return;
#if MK_CHECK
    (void)hipMemsetAsync((char*)d_ws + SM_CHK, 0, 256, stream);
#endif
    Args a{};
    for (int i = 0; i < 36; ++i) a.in[i] = d_in[i];
    a.out = (float*)d_out; a.ws = (unsigned char*)d_ws; a.pad = 0;
#if MK_MULTI
    for (int gp = 0; gp < GP_END; ++gp) { if (!phase_applies(gp)) continue; a.gp_lo = gp; a.gp_hi = gp + 1; a.use_bar = 0;
        hipLaunchKernelGGL(mk_fwd, dim3(grid), dim3(512), LDS_BYTES, stream, a);
#if MK_CHECK
        run_checks(a, gp, stream);
#endif
    }
#if MK_CHECK
    hipLaunchKernelGGL(chk_final, dim3(1), dim3(1), 0, stream, a);
#endif
#else
    a.gp_lo = 0; a.gp_hi = GP_END; a.use_bar = 1;
    hipLaunchKernelGGL(mk_fwd, dim3(grid), dim3(512), LDS_BYTES, stream, a);
#endif
}
```

```cpp
#include <hip/hip_runtime.h>
#include <cstdint>
#include <cstdio>
#ifndef MK_TAILSPLIT
#define MK_TAILSPLIT 1
#endif
#ifndef MK_MULTI
#define MK_MULTI 0
#endif
#ifndef MK_CHECK
#define MK_CHECK 0
#endif
#ifndef MK_REP_G1
#define MK_REP_G1 1
#endif
#ifndef MK_REP_G2
#define MK_REP_G2 1
#endif
#ifndef MK_REP_CU
#define MK_REP_CU 1
#endif
#ifndef MK_REP_TK
#define MK_REP_TK 1
#endif
#ifndef MK_REP_WOUT
#define MK_REP_WOUT 1
#endif
#ifndef MK_REP_CONV
#define MK_REP_CONV 1
#endif
#ifndef MK_REP_ST2
#define MK_REP_ST2 1
#endif
#ifndef MK_REP_CARRY
#define MK_REP_CARRY 1
#endif
#ifndef MK_REPCMP
#define MK_REPCMP 1
#endif
#ifndef MK_ALIGN_EPI
#define MK_ALIGN_EPI 1
#endif
#ifndef MK_PROBE
#define MK_PROBE 0
#endif
#ifndef PROBE_A
#define PROBE_A 0
#endif
#ifndef PROBE_B
#define PROBE_B 0
#endif
#ifndef CHK_LAYER
#define CHK_LAYER 15
#endif

#define GAS __attribute__((address_space(1)))
#define LAS __attribute__((address_space(3)))
typedef unsigned short bf16_t;
typedef short bf16x8 __attribute__((ext_vector_type(8)));
typedef float f32x4 __attribute__((ext_vector_type(4)));
typedef float f32x2 __attribute__((ext_vector_type(2)));
typedef float f32x16 __attribute__((ext_vector_type(16)));
typedef unsigned u32x4 __attribute__((ext_vector_type(4)));
typedef unsigned u32x2 __attribute__((ext_vector_type(2)));

constexpr int NB = 16, SEQ = 4096, T = NB * SEQ, D = 1024, DEPTH = 4;
constexpr int INW = 2072, INP = 2304;
constexpr int ZKV = 512, ZG = 1280, ZC = 1304, ZS = 1816;
constexpr int DFF = 2816, DFE = 3584, NEXP = 8, PLE = 256;
constexpr int NCMP = 255;
constexpr int S5LC = 32, S5NCH = SEQ / S5LC, S5K = S5LC * 16 + 128;
constexpr float ALPHA = 1.6817928305074290f;
constexpr float LN_EPS = 1e-5f;
constexpr float QSCALE = 0.125f * 1.4426950408889634f;
constexpr float NEGF = -1e30f;
constexpr int MOE_TILES_MAX = 520, MOE_CHUNK_TILES = 128, MOE_NCHUNK = 5;

typedef __bf16 bf16x2_t __attribute__((ext_vector_type(2)));
__device__ __forceinline__ unsigned cvt_pk_bf16(float lo, float hi) { f32x2 v = {lo, hi}; const bf16x2_t b = __builtin_convertvector(v, bf16x2_t); return __builtin_bit_cast(unsigned, b); }
__device__ __forceinline__ bf16_t f2bf(float f) { return (bf16_t)(cvt_pk_bf16(f, 0.f) & 0xffffu); }
__device__ __forceinline__ float bf2f(unsigned v) { return __uint_as_float(v << 16); }
__device__ __forceinline__ float bflo(unsigned w) { return __uint_as_float(w << 16); }
__device__ __forceinline__ float bfhi(unsigned w) { return __uint_as_float(w & 0xffff0000u); }
__device__ __forceinline__ float fast_exp2(float x) { return __builtin_amdgcn_exp2f(x); }
__device__ __forceinline__ float fast_rcp(float x) { return __builtin_amdgcn_rcpf(x); }
__device__ __forceinline__ float sigmoidf_(float x) { return fast_rcp(1.0f + fast_exp2(-1.4426950408889634f * x)); }
__device__ __forceinline__ float siluf_(float x) { return x * sigmoidf_(x); }
__device__ __forceinline__ float gelu_tanh(float x) { const float u = 0.7978845608028654f * (x + 0.044715f * x * x * x); return x * sigmoidf_(2.0f * u); }
__device__ __forceinline__ int lane_id_fresh() { unsigned z = 0u; asm volatile("" : "+v"(z)); return (int)__builtin_amdgcn_mbcnt_hi(~0u, __builtin_amdgcn_mbcnt_lo(~0u, z)); }
template <int MASK> __device__ __forceinline__ float xshfl(float v) {
    if (MASK == 32) { const unsigned u = __float_as_uint(v); auto rr = __builtin_amdgcn_permlane32_swap(u, u, false, false); return __uint_as_float((rr[0] == u) ? rr[1] : rr[0]); }
    return __uint_as_float((unsigned)__builtin_amdgcn_ds_swizzle((int)__float_as_uint(v), 0x1f | (MASK << 10)));
}
__device__ __forceinline__ float wave_sum(float v) {
    v += xshfl<1>(v); v += xshfl<2>(v); v += xshfl<4>(v); v += xshfl<8>(v); v += xshfl<16>(v); v += xshfl<32>(v);
    return v;
}
#define LDS_WAIT() asm volatile("s_waitcnt lgkmcnt(0)" ::: "memory")
#define VM_WAIT() asm volatile("s_waitcnt vmcnt(0)" ::: "memory")

namespace pg8 {
constexpr int BM = 256, BK = 64, HALF = 128, HTB = HALF * BK * 2, STAGE_BYTES = 8 * HTB, NXCD = 8, WGM = 8;
__host__ __device__ __forceinline__ int lds_byte(int r, int c) { const int st = (r >> 4) * 2 + (c >> 5), rr = r & 15, cc = c & 31, ob = rr * 64 + cc * 2; return st * 1024 + (ob ^ (((ob >> 9) & 1) << 5)); }
__host__ __device__ __forceinline__ void stage_rc(int b, int& R, int& C) { const int st = b / 1024, sb = b % 1024, swz = sb ^ (((sb >> 9) & 1) << 5); R = (st >> 1) * 16 + swz / 64; C = (st & 1) * 32 + (swz % 64) / 2; }
__host__ __device__ __forceinline__ int perm32(int rho) { const int n = rho >> 4, i = rho & 15; return 8 * (i >> 2) + 4 * n + (i & 3); }

struct Unit { int pm, pn; long long offA, offB; int aux; };
struct Gemm { const bf16_t* A; const bf16_t* Bt; int K, lda, ldb; };

__device__ __forceinline__ bool static_tile(int i, int G, int c, int nM, int nN, int& pm, int& pn) {
    const int nwg = nM * nN; const long L = (long)i * G + c; if (L >= nwg) return false;
    int wgid = (int)L; { const int q = nwg / NXCD, r = nwg % NXCD, xcd = wgid % NXCD, off = wgid / NXCD; wgid = (xcd < r ? xcd * (q + 1) : r * (q + 1) + (xcd - r) * q) + off; }
    const int nig = WGM * nN, gid = wgid / nig, fm = gid * WGM, gsz = (nM - fm) < WGM ? (nM - fm) : WGM;
    pm = fm + ((wgid % nig) % gsz); pn = (wgid % nig) / gsz; return true;
}
struct PlainOrder {
    int nM, nN, G, c; long long sA, sB;
    __device__ __forceinline__ bool next(int i, Unit& u) const { if (!static_tile(i, G, c, nM, nN, u.pm, u.pn)) return false; u.offA = (long long)u.pm * sA; u.offB = (long long)u.pn * sB; u.aux = 0; return true; }
};
struct PanelOrder {
    int nM, nN, G, c; long long sA, sB;
    __device__ __forceinline__ bool next(int i, Unit& u) const { const int pm = c + G * (i / nN); if (pm >= nM) return false; u.pm = pm; u.pn = i % nN; u.offA = (long long)pm * sA; u.offB = (long long)u.pn * sB; u.aux = 0; return true; }
};
struct ListOrder {
    int n, pm, aux; long long offA0, offB0, sB;
    __device__ __forceinline__ bool next(int i, Unit& u) const { if (i >= n) return false; u.pm = pm; u.pn = i; u.aux = aux; u.offA = offA0; u.offB = offB0 + (long long)i * sB; return true; }
};
struct GroupedOrder {
    int ng, nM, nN, G, c; long long sA, sB, gA, gB;
    __device__ __forceinline__ bool next(int i, Unit& u) const {
        const long L = (long)i * G + c; const int per = nM * nN; if (L >= (long)ng * per) return false;
        const int gi = (int)(L / per), r = (int)(L % per); u.pm = r / nN; u.pn = r % nN; u.aux = gi;
        u.offA = (long long)gi * gA + (long long)u.pm * sA; u.offB = (long long)gi * gB + (long long)u.pn * sB; return true; }
};

template <class Epi, class Sched>
__device__ __forceinline__ void gemm_phase(LAS unsigned char* lds, const Gemm g, const Sched& S, const Epi& E, int tid_in) {
    int tid_ = tid_in; asm volatile("" : "+v"(tid_));
    const int tid = tid_, wid = __builtin_amdgcn_readfirstlane(tid >> 6), lane = tid & 63, wr = wid >> 2, wc = wid & 3, fr = lane & 15, fq = lane >> 4;
    int K_ = g.K; asm volatile("" : "+s"(K_));
    const int K = K_, nt = K / BK; (void)K;
    unsigned voffA[2], voffB[2];
#pragma unroll
    for (int i = 0; i < 2; ++i) { int R, C; stage_rc(tid * 16 + i * 8192, R, C); const int Rb = Epi::PERM ? ((R & ~31) + perm32(R & 31)) : R;
        voffA[i] = (unsigned)(R * g.lda + C) * 2u; voffB[i] = (unsigned)(Rb * g.ldb + C) * 2u; }
    const size_t kstep = (size_t)(BK * 2);
    const size_t hstepA = (size_t)HALF * g.lda * 2, hstepB = (size_t)HALF * g.ldb * 2;
    const unsigned ldsw = (unsigned)wid * 1024u;
    const int aoff = lds_byte(wr * 64 + fr, fq * 8), boff = lds_byte(wc * 32 + fr, fq * 8);
#define PG8_SA(b, h) (((b) * 2 + (h)) * HTB)
#define PG8_SB(b, h) ((4 + (b) * 2 + (h)) * HTB)
#define PG8_STAGE(bufoff, gbase, voff) do { _Pragma("unroll") for (int _i = 0; _i < 2; ++_i) \
        __builtin_amdgcn_global_load_lds((const unsigned*)((const char*)(gbase) + (voff)[_i]), (LAS unsigned*)(lds + (bufoff) + ldsw + _i * 8192), 16, 0, 0); } while (0)
#define PG8_LDA(dst, b, h) do { _Pragma("unroll") for (int m = 0; m < 4; ++m) _Pragma("unroll") for (int k = 0; k < 2; ++k) dst[m][k] = *(const LAS bf16x8*)(lds + PG8_SA(b, h) + aoff + m * 2048 + k * 1024); } while (0)
#define PG8_LDB(dst, b, h) do { _Pragma("unroll") for (int n = 0; n < 2; ++n) _Pragma("unroll") for (int k = 0; k < 2; ++k) dst[n][k] = *(const LAS bf16x8*)(lds + PG8_SB(b, h) + boff + n * 2048 + k * 1024); } while (0)
#define PG8_MMA(ai, bj, At, Bt) do { __builtin_amdgcn_s_setprio(1); _Pragma("unroll") for (int m = 0; m < 4; ++m) _Pragma("unroll") for (int n = 0; n < 2; ++n) _Pragma("unroll") for (int k = 0; k < 2; ++k) \
        acc[ai][bj][m][n] = __builtin_amdgcn_mfma_f32_16x16x32_bf16(Bt[n][k], At[m][k], acc[ai][bj][m][n], 0, 0, 0); __builtin_amdgcn_s_setprio(0); } while (0)
#define PG8_WAIT_V(n) asm volatile("s_waitcnt vmcnt(" #n ")" ::: "memory")
#define PG8_WAIT_L(n) asm volatile("s_waitcnt lgkmcnt(" #n ")" ::: "memory")
#define PG8_BAR __builtin_amdgcn_s_barrier()
#define PG8_SCHED __builtin_amdgcn_sched_barrier(0)
    Unit cur, nxt; int ui = 0;
    if (!S.next(0, cur)) return;
    f32x4 acc[2][2][4][2];
#pragma unroll
    for (int a = 0; a < 2; ++a)
#pragma unroll
        for (int b = 0; b < 2; ++b)
#pragma unroll
            for (int m = 0; m < 4; ++m)
#pragma unroll
                for (int n = 0; n < 2; ++n) acc[a][b][m][n] = (f32x4){0.f, 0.f, 0.f, 0.f};
    bf16x8 At[4][2], B0[2][2], B1[2][2];
    const char* cA = (const char*)g.A + cur.offA; const char* cB = (const char*)g.Bt + cur.offB;
    PG8_STAGE(PG8_SB(0, 0), cB, voffB); PG8_STAGE(PG8_SB(0, 1), cB + hstepB, voffB); PG8_STAGE(PG8_SA(0, 0), cA, voffA); PG8_STAGE(PG8_SA(0, 1), cA + hstepA, voffA);
    if (wr == 1) PG8_BAR;
    PG8_WAIT_V(2); PG8_BAR;
    PG8_STAGE(PG8_SB(1, 0), cB + kstep, voffB); PG8_STAGE(PG8_SA(1, 0), cA + kstep, voffA); PG8_STAGE(PG8_SB(1, 1), cB + hstepB + kstep, voffB);
    PG8_WAIT_V(6); PG8_BAR;
    for (;;) {
        const bool has_next = S.next(ui + 1, nxt);
        const char* nA = has_next ? (const char*)g.A + nxt.offA : cA; const char* nB = has_next ? (const char*)g.Bt + nxt.offB : cB;
        for (int t = 0; t < nt; t += 2) {
            const bool last = (t == nt - 2);
            const char* a1 = cA + (size_t)(t + 1) * kstep;
            const char* a2 = last ? nA : cA + (size_t)(t + 2) * kstep; const char* b2 = last ? nB : cB + (size_t)(t + 2) * kstep;
            const char* a3 = a2 + kstep; const char* b3 = b2 + kstep;
            PG8_LDB(B0, 0, 0); PG8_LDB(B1, 0, 1); PG8_SCHED; PG8_LDA(At, 0, 0); PG8_STAGE(PG8_SA(1, 1), a1 + hstepA, voffA);
            PG8_WAIT_V(8); PG8_WAIT_L(0); PG8_BAR; PG8_MMA(0, 0, At, B0); PG8_MMA(0, 1, At, B1); PG8_BAR; PG8_SCHED;
            PG8_LDA(At, 0, 1); PG8_STAGE(PG8_SB(0, 0), b2, voffB); PG8_STAGE(PG8_SB(0, 1), b2 + hstepB, voffB); PG8_STAGE(PG8_SA(0, 0), a2, voffA);
            PG8_WAIT_V(8); PG8_WAIT_L(0); PG8_BAR; PG8_MMA(1, 0, At, B0); PG8_MMA(1, 1, At, B1); PG8_BAR; PG8_SCHED;
            PG8_LDB(B0, 1, 0); PG8_LDB(B1, 1, 1); PG8_SCHED; PG8_LDA(At, 1, 0); PG8_STAGE(PG8_SA(0, 1), a2 + hstepA, voffA);
            PG8_WAIT_V(8); PG8_WAIT_L(0); PG8_BAR; PG8_MMA(0, 0, At, B0); PG8_MMA(0, 1, At, B1); PG8_BAR; PG8_SCHED;
            PG8_LDA(At, 1, 1); PG8_STAGE(PG8_SB(1, 0), b3, voffB); PG8_STAGE(PG8_SB(1, 1), b3 + hstepB, voffB); PG8_STAGE(PG8_SA(1, 0), a3, voffA);
            PG8_WAIT_V(8); PG8_WAIT_L(0); PG8_BAR; PG8_MMA(1, 0, At, B0); PG8_MMA(1, 1, At, B1); PG8_BAR; PG8_SCHED;
        }
#if MK_ALIGN_EPI
        if (wr == 0) PG8_BAR;
#endif
        { int fr_ = fr, fq_ = fq; asm volatile("" : "+v"(fr_), "+v"(fq_));
          E(acc, cur, wr, wc, fr_, fq_); }
        if (!has_next) break;
#pragma unroll
        for (int a = 0; a < 2; ++a)
#pragma unroll
            for (int b = 0; b < 2; ++b)
#pragma unroll
                for (int m = 0; m < 4; ++m)
#pragma unroll
                    for (int n = 0; n < 2; ++n) acc[a][b][m][n] = (f32x4){0.f, 0.f, 0.f, 0.f};
        cur = nxt; cA = nA; cB = nB; ++ui;
#if MK_ALIGN_EPI
        if (wr == 1) PG8_BAR;
#endif
    }
    PG8_WAIT_V(0);
#if !MK_ALIGN_EPI
    if (wr == 0) PG8_BAR;
#endif
    PG8_BAR;
#undef PG8_SA
#undef PG8_SB
#undef PG8_STAGE
#undef PG8_LDA
#undef PG8_LDB
#undef PG8_MMA
#undef PG8_WAIT_V
#undef PG8_WAIT_L
#undef PG8_BAR
#undef PG8_SCHED
}
}

#define XB_TMO      128
#define XB_XCNT(j)  (256  + 64 * (j))
#define XB_XSUB(j)  (1280 + 64 * (j))
#define XB_XGEN(j)  (2304 + 64 * (j))
#define XB_TOP      3328
#define XB_TOPGEN   3392
#define XCD_BAR_WORDS 3456
#define XB_SPIN_CAP (1u << 20)
__device__ __forceinline__ unsigned xb_ld(unsigned* p)              { return __hip_atomic_load(p, __ATOMIC_RELAXED, __HIP_MEMORY_SCOPE_AGENT); }
__device__ __forceinline__ unsigned xb_add(unsigned* p, unsigned v) { return __hip_atomic_fetch_add(p, v, __ATOMIC_RELAXED, __HIP_MEMORY_SCOPE_AGENT); }
__device__ __forceinline__ unsigned xb_xcc_id() { return (unsigned)__builtin_amdgcn_s_getreg((3 << 11) | 20) & 0xFu; }
#define XB_SPIN(cond, bar) do { unsigned _sp = 0; while (cond) { __builtin_amdgcn_s_sleep(1); \
    if ((++_sp & 255u) == 0u) { if (xb_ld(&(bar)[XB_TMO])) break; if (_sp > XB_SPIN_CAP) { atomicAdd(&(bar)[XB_TMO], 1u); break; } } } } while (0)
struct XcdBarrier { unsigned* bar; unsigned x; volatile LAS unsigned* st; };
__device__ __forceinline__ XcdBarrier xcd_barrier_post(unsigned* bar, volatile LAS unsigned* st) {
    XcdBarrier b; b.bar = bar; b.x = xb_xcc_id(); b.st = st;
    if (threadIdx.x == 0) (void)xb_add(&bar[XB_XCNT(b.x)], 1u);
    return b;
}
__device__ __forceinline__ void xcd_barrier_complete(unsigned* bar, unsigned x, unsigned& nloc, unsigned& nx) {
    const unsigned G = gridDim.x * gridDim.y * gridDim.z;
    unsigned sum, cnt, mine, sp = 0u;
    for (;;) {
        sum = 0u; cnt = 0u; mine = 0u;
#pragma unroll 1
        for (unsigned j = 0; j < 16; ++j) { const unsigned c = xb_ld(&bar[XB_XCNT(j)]); sum += c; cnt += (c > 0u) ? 1u : 0u; mine = (j == x) ? c : mine; }
        if (sum == G) break;
        __builtin_amdgcn_s_sleep(1);
        if ((++sp & 255u) == 0u) { if (xb_ld(&bar[XB_TMO])) break; if (sp > XB_SPIN_CAP) { atomicAdd(&bar[XB_TMO], 1u); break; } }
    }
    nloc = mine > 0u ? mine : 1u; nx = cnt > 0u ? cnt : 1u;
}
__device__ __forceinline__ void xcd_barrier(const XcdBarrier& b, int wave_id) {
    asm volatile("s_waitcnt vmcnt(0)" ::: "memory");
    __syncthreads();
    if (wave_id == 0 && lane_id_fresh() == 0) {
        unsigned* bar = b.bar; asm volatile("" : "+s"(bar));
        __builtin_amdgcn_s_waitcnt(0);
        unsigned nloc = b.st[0], nx = b.st[1];
        if (nloc == 0u) { xcd_barrier_complete(bar, b.x, nloc, nx); b.st[0] = nloc; b.st[1] = nx; }
        const unsigned old = xb_add(&bar[XB_XSUB(b.x)], 1u);
        const unsigned gen = old / nloc;
        if (old + 1u == (gen + 1u) * nloc) {
            __builtin_amdgcn_fence(__ATOMIC_RELEASE, "agent");
            asm volatile("s_waitcnt vmcnt(0)" ::: "memory");
            const unsigned og = xb_add(&bar[XB_TOP], 1u);
            const unsigned tg = og / nx;
            if (og + 1u == (tg + 1u) * nx) xb_add(&bar[XB_TOPGEN], 1u);
            else XB_SPIN(xb_ld(&bar[XB_TOPGEN]) == tg, bar);
            __builtin_amdgcn_fence(__ATOMIC_ACQUIRE, "agent");
            xb_add(&bar[XB_XGEN(b.x)], 1u);
            asm volatile("s_waitcnt vmcnt(0)" ::: "memory");
        } else {
            XB_SPIN(xb_ld(&bar[XB_XGEN(b.x)]) == gen, bar);
            __builtin_amdgcn_fence(__ATOMIC_ACQUIRE, "agent");
            asm volatile("s_waitcnt vmcnt(0)" ::: "memory");
        }
    }
    __syncthreads();
}
namespace nsa {
constexpr int PITCH = 144, TILE_LDS = 64 * PITCH;
__device__ __forceinline__ int crow(int r, int hi) { return (r & 3) + 8 * (r >> 2) + 4 * hi; }
__device__ __forceinline__ int vslot(int kk) { return (kk & 0x33) | (((kk >> 2) & 1) << 3) | (((kk >> 3) & 1) << 2); }

struct Lane { int lane, c, hi, wid, tid; };

__device__ __forceinline__ void qk_tile(f32x16& p0, f32x16& p1, const LAS unsigned char* Ks, const bf16x8 (&qr)[4], float bias, const Lane& L) {
#pragma unroll
    for (int r = 0; r < 16; ++r) { p0[r] = bias; p1[r] = bias; }
    const LAS unsigned char* kb = Ks + L.c * PITCH + L.hi * 16;
#pragma unroll
    for (int d0 = 0; d0 < 4; ++d0) {
        const bf16x8 k0 = *(const LAS bf16x8*)(kb + d0 * 32);
        const bf16x8 k1 = *(const LAS bf16x8*)(kb + 32 * PITCH + d0 * 32);
        p0 = __builtin_amdgcn_mfma_f32_32x32x16_bf16(k0, qr[d0], p0, 0, 0, 0);
        p1 = __builtin_amdgcn_mfma_f32_32x32x16_bf16(k1, qr[d0], p1, 0, 0, 0);
    }
}
__device__ __forceinline__ void qk_tile_c(f32x16& p0, f32x16& p1, const LAS unsigned char* Ks, const bf16x8 (&qr)[4], const f32x16& cv, const Lane& L) {
    const LAS unsigned char* kb = Ks + L.c * PITCH + L.hi * 16;
    { const bf16x8 k0 = *(const LAS bf16x8*)(kb); const bf16x8 k1 = *(const LAS bf16x8*)(kb + 32 * PITCH);
      p0 = __builtin_amdgcn_mfma_f32_32x32x16_bf16(k0, qr[0], cv, 0, 0, 0); p1 = __builtin_amdgcn_mfma_f32_32x32x16_bf16(k1, qr[0], cv, 0, 0, 0); }
#pragma unroll
    for (int d0 = 1; d0 < 4; ++d0) {
        const bf16x8 k0 = *(const LAS bf16x8*)(kb + d0 * 32);
        const bf16x8 k1 = *(const LAS bf16x8*)(kb + 32 * PITCH + d0 * 32);
        p0 = __builtin_amdgcn_mfma_f32_32x32x16_bf16(k0, qr[d0], p0, 0, 0, 0);
        p1 = __builtin_amdgcn_mfma_f32_32x32x16_bf16(k1, qr[d0], p1, 0, 0, 0);
    }
}
__device__ __forceinline__ void mask_range(f32x16& p0, f32x16& p1, int lo, int hi_, int hi) {
#pragma unroll
    for (int r = 0; r < 16; ++r) { const int k0 = crow(r, hi), k1 = k0 + 32;
        if (k0 <= lo || k0 > hi_) p0[r] = NEGF;
        if (k1 <= lo || k1 > hi_) p1[r] = NEGF; }
}
__device__ __forceinline__ float tile_max(const f32x16& p0, const f32x16& p1) {
    float a = fmaxf(p0[0], p1[0]);
#pragma unroll
    for (int r = 1; r < 16; ++r) a = fmaxf(a, fmaxf(p0[r], p1[r]));
    return fmaxf(a, xshfl<32>(a));
}
__device__ __forceinline__ void pv_tile(f32x16& o0, f32x16& o1, const LAS unsigned char* Vs, const f32x16& p0, const f32x16& p1, const Lane& L) {
    const LAS unsigned char* vb = Vs + L.c * PITCH + L.hi * 16;
#pragma unroll
    for (int s = 0; s < 4; ++s) {
        u32x4 w;
        if (s < 2) { const int b = 8 * (s & 1); w.x = cvt_pk_bf16(p0[b], p0[b + 1]); w.y = cvt_pk_bf16(p0[b + 2], p0[b + 3]); w.z = cvt_pk_bf16(p0[b + 4], p0[b + 5]); w.w = cvt_pk_bf16(p0[b + 6], p0[b + 7]); }
        else       { const int b = 8 * (s & 1); w.x = cvt_pk_bf16(p1[b], p1[b + 1]); w.y = cvt_pk_bf16(p1[b + 2], p1[b + 3]); w.z = cvt_pk_bf16(p1[b + 4], p1[b + 5]); w.w = cvt_pk_bf16(p1[b + 6], p1[b + 7]); }
        const bf16x8 pf = __builtin_bit_cast(bf16x8, w);
        const bf16x8 v0 = *(const LAS bf16x8*)(vb + s * 32);
        const bf16x8 v1 = *(const LAS bf16x8*)(vb + 32 * PITCH + s * 32);
        o0 = __builtin_amdgcn_mfma_f32_32x32x16_bf16(v0, pf, o0, 0, 0, 0);
        o1 = __builtin_amdgcn_mfma_f32_32x32x16_bf16(v1, pf, o1, 0, 0, 0);
        if (s & 1) __builtin_amdgcn_sched_barrier(0);
    }
}
__device__ __forceinline__ void softmax_pv(f32x16& p0, f32x16& p1, f32x16& o0, f32x16& o1, float& m, float& l, const LAS unsigned char* Vs, const Lane& L) {
    const float mx = tile_max(p0, p1), mn = fmaxf(m, mx), alpha = fast_exp2(m - mn); m = mn;
    float ls = 0.f;
#pragma unroll
    for (int r = 0; r < 16; ++r) { p0[r] = fast_exp2(p0[r] - mn); p1[r] = fast_exp2(p1[r] - mn); ls += p0[r] + p1[r]; }
    l = l * alpha + ls;
#pragma unroll
    for (int r = 0; r < 16; ++r) { o0[r] *= alpha; o1[r] *= alpha; }
    pv_tile(o0, o1, Vs, p0, p1, L);
}
__device__ __forceinline__ int stage_off(int tid) { return (tid >> 3) * PITCH + (tid & 7) * 16; }

__device__ __forceinline__ void load_q(bf16x8 (&qr)[4], const bf16_t* qbuf, long tok, int head, int hi) {
    const bf16_t* qp = qbuf + tok * 512 + head * 64 + hi * 8;
#pragma unroll
    for (int d0 = 0; d0 < 4; ++d0) qr[d0] = *(const bf16x8*)(qp + d0 * 16);
}

__device__ __forceinline__ u32x4 vload(const bf16_t* Vt, int j, const Lane& L) { return *(const u32x4*)((const char*)Vt + (size_t)j * 8192 + L.lane * 128 + L.wid * 16); }
__device__ __forceinline__ void vstore(LAS unsigned char* Vs, const u32x4 v, const Lane& L) {
    LAS unsigned short* p = (LAS unsigned short*)(Vs + (8 * L.wid) * PITCH) + vslot(L.lane);
    p[0 * (PITCH / 2)] = (unsigned short)(v.x & 0xffffu); p[1 * (PITCH / 2)] = (unsigned short)(v.x >> 16); p[2 * (PITCH / 2)] = (unsigned short)(v.y & 0xffffu); p[3 * (PITCH / 2)] = (unsigned short)(v.y >> 16);
    p[4 * (PITCH / 2)] = (unsigned short)(v.z & 0xffffu); p[5 * (PITCH / 2)] = (unsigned short)(v.z >> 16); p[6 * (PITCH / 2)] = (unsigned short)(v.w & 0xffffu); p[7 * (PITCH / 2)] = (unsigned short)(v.w >> 16);
}
template <int MODE>
__device__ __forceinline__ void run_branch(f32x16& o0, f32x16& o1, float& mref, float& l, const bf16_t* Kt  , const bf16_t* Vt  ,
                                           int jlo, int jhi, int qb, int qrel, unsigned long long selw, const bf16x8 (&qr)[4], LAS unsigned char* lds, const Lane& L) {
    LAS unsigned char* Kbuf = lds; LAS unsigned char* Vbuf = lds + 2 * TILE_LDS;
    const int so = stage_off(L.tid);
    u32x4 kreg = *(const u32x4*)((const char*)Kt + (size_t)jlo * 8192 + L.tid * 16);
    u32x4 vreg = vload(Vt, jlo, L);
    *(LAS u32x4*)(Kbuf + so) = kreg; vstore(Vbuf, vreg, L);
    __syncthreads();
    f32x16 cv;
#pragma unroll
    for (int r = 0; r < 16; ++r) cv[r] = -mref;
    for (int j = jlo; j <= jhi; ++j) {
        const int cur = (j - jlo) & 1;
        if (j < jhi) { kreg = *(const u32x4*)((const char*)Kt + (size_t)(j + 1) * 8192 + L.tid * 16); vreg = vload(Vt, j + 1, L); }
        f32x16 p0, p1;
        if (MODE == 0) { const float cb = ((selw >> j) & 1ull) ? -mref : NEGF;
#pragma unroll
            for (int r = 0; r < 16; ++r) cv[r] = cb; }
        qk_tile_c(p0, p1, Kbuf + cur * TILE_LDS, qr, cv, L);
        if (j == qb) mask_range(p0, p1, -1, qrel, L.hi);
        if (MODE == 1 && j == qb - 8) mask_range(p0, p1, qrel, 64, L.hi);
        const float mx = tile_max(p0, p1);
        if (__any(mx > 8.0f)) {
            const float dl = fmaxf(mx, 0.f), f = fast_exp2(-dl); mref += dl; l *= f;
#pragma unroll
            for (int r = 0; r < 16; ++r) { o0[r] *= f; o1[r] *= f; p0[r] -= dl; p1[r] -= dl; }
            if (MODE == 1) {
#pragma unroll
                for (int r = 0; r < 16; ++r) cv[r] = -mref; }
        }
        float ls = 0.f;
#pragma unroll
        for (int r = 0; r < 16; ++r) { p0[r] = fast_exp2(p0[r]); p1[r] = fast_exp2(p1[r]); ls += p0[r] + p1[r]; }
        l += ls;
        pv_tile(o0, o1, Vbuf + cur * TILE_LDS, p0, p1, L);
        if (j < jhi) { *(LAS u32x4*)(Kbuf + (cur ^ 1) * TILE_LDS + so) = kreg; vstore(Vbuf + (cur ^ 1) * TILE_LDS, vreg, L); }
        __syncthreads();
    }
}
struct SoftState { float mref, l; };
__device__ __forceinline__ void softmax_step2(f32x16& p0, f32x16& p1, f32x16& o0, f32x16& o1, SoftState& st, bool sel, bf16x8 (&pf)[4]) {
    if (__any(st.mref != 0.f)) {
#pragma unroll
        for (int r = 0; r < 16; ++r) { p0[r] -= st.mref; p1[r] -= st.mref; } }
    float ls = 0.f;
#pragma unroll
    for (int r = 0; r < 16; ++r) { p0[r] = fast_exp2(p0[r]); p1[r] = fast_exp2(p1[r]); ls += p0[r] + p1[r]; }
    ls = sel ? ls : 0.f; st.l += ls;
#pragma unroll
    for (int s = 0; s < 4; ++s) { u32x4 w; const int b = 8 * (s & 1);
        if (s < 2) { w.x = cvt_pk_bf16(p0[b], p0[b + 1]); w.y = cvt_pk_bf16(p0[b + 2], p0[b + 3]); w.z = cvt_pk_bf16(p0[b + 4], p0[b + 5]); w.w = cvt_pk_bf16(p0[b + 6], p0[b + 7]); }
        else       { w.x = cvt_pk_bf16(p1[b], p1[b + 1]); w.y = cvt_pk_bf16(p1[b + 2], p1[b + 3]); w.z = cvt_pk_bf16(p1[b + 4], p1[b + 5]); w.w = cvt_pk_bf16(p1[b + 6], p1[b + 7]); }
        if (!sel) w = (u32x4){0u, 0u, 0u, 0u};
        pf[s] = __builtin_bit_cast(bf16x8, w); }
}
__device__ __forceinline__ void renorm_step(f32x16& o0, f32x16& o1, SoftState& st) {
    if (__any(st.l > 1.0995116e12f)) { const bool big = st.l > 1.0995116e12f; const float f = big ? 9.094947e-13f : 1.0f; st.mref += big ? 40.f : 0.f; st.l *= f;
#pragma unroll
        for (int r = 0; r < 16; ++r) { o0[r] *= f; o1[r] *= f; } }
}
template <int MODE>
__device__ __forceinline__ void run_branch2(f32x16& oa0, f32x16& oa1, SoftState& sa, f32x16& ob0, f32x16& ob1, SoftState& sb, const bf16_t* Kt, const bf16_t* Vt, int jlo, int jhi, int qbw, int qrela,
                                            const LAS unsigned long long* selp  , const bf16x8 (&qa)[4], const bf16x8 (&qbf)[4], LAS unsigned char* lds, const Lane& L) {
    LAS unsigned char* Kbuf = lds; LAS unsigned char* Vbuf = lds + 2 * TILE_LDS;
    const int so = stage_off(L.tid);
    {   const u32x4 kreg = *(const u32x4*)((const char*)Kt + (size_t)jlo * 8192 + L.tid * 16); const u32x4 vreg = vload(Vt, jlo, L);
        *(LAS u32x4*)(Kbuf + so) = kreg; vstore(Vbuf, vreg, L); }
    __syncthreads();
    for (int j = jlo; j <= jhi; ++j) {
        const int cur = (j - jlo) & 1;
        const bool act = (j <= qbw) && (MODE == 0 || j >= qbw - 8);
        u32x4 kreg, vreg;
        bf16x8 fa[4], fb[4];
        if (act) {
            f32x16 pa0, pa1, pb0, pb1;
#pragma unroll
            for (int r = 0; r < 16; ++r) { pa0[r] = 0.f; pa1[r] = 0.f; pb0[r] = 0.f; pb1[r] = 0.f; }
            const LAS unsigned char* kb = Kbuf + cur * TILE_LDS + L.c * PITCH + L.hi * 16;
#pragma unroll
            for (int d0 = 0; d0 < 4; ++d0) { const bf16x8 k0 = *(const LAS bf16x8*)(kb + d0 * 32); const bf16x8 k1 = *(const LAS bf16x8*)(kb + 32 * PITCH + d0 * 32);
                pa0 = __builtin_amdgcn_mfma_f32_32x32x16_bf16(k0, qa[d0], pa0, 0, 0, 0); pa1 = __builtin_amdgcn_mfma_f32_32x32x16_bf16(k1, qa[d0], pa1, 0, 0, 0);
                pb0 = __builtin_amdgcn_mfma_f32_32x32x16_bf16(k0, qbf[d0], pb0, 0, 0, 0); pb1 = __builtin_amdgcn_mfma_f32_32x32x16_bf16(k1, qbf[d0], pb1, 0, 0, 0); }
            if (j == qbw) { mask_range(pa0, pa1, -1, qrela, L.hi); mask_range(pb0, pb1, -1, qrela + 8, L.hi); }
            if (MODE == 1 && j == qbw - 8) { mask_range(pa0, pa1, qrela, 64, L.hi); mask_range(pb0, pb1, qrela + 8, 64, L.hi); }
            bool sela = true, selb = true;
            if (MODE == 0) { sela = (selp[0] >> j) & 1ull; selb = (selp[1] >> j) & 1ull; }
            softmax_step2(pa0, pa1, oa0, oa1, sa, sela, fa);
            __builtin_amdgcn_sched_barrier(0);
            softmax_step2(pb0, pb1, ob0, ob1, sb, selb, fb);
            __builtin_amdgcn_sched_barrier(0);
        }
        if (j < jhi) { kreg = *(const u32x4*)((const char*)Kt + (size_t)(j + 1) * 8192 + L.tid * 16); vreg = vload(Vt, j + 1, L); }
        if (act) {
            const LAS unsigned char* vb = Vbuf + cur * TILE_LDS + L.c * PITCH + L.hi * 16;
#pragma unroll
            for (int s = 0; s < 4; ++s) {
                const bf16x8 v0 = *(const LAS bf16x8*)(vb + s * 32); const bf16x8 v1 = *(const LAS bf16x8*)(vb + 32 * PITCH + s * 32);
                oa0 = __builtin_amdgcn_mfma_f32_32x32x16_bf16(v0, fa[s], oa0, 0, 0, 0); oa1 = __builtin_amdgcn_mfma_f32_32x32x16_bf16(v1, fa[s], oa1, 0, 0, 0);
                ob0 = __builtin_amdgcn_mfma_f32_32x32x16_bf16(v0, fb[s], ob0, 0, 0, 0); ob1 = __builtin_amdgcn_mfma_f32_32x32x16_bf16(v1, fb[s], ob1, 0, 0, 0); }
            renorm_step(oa0, oa1, sa); renorm_step(ob0, ob1, sb);
        }
        if (j < jhi) { *(LAS u32x4*)(Kbuf + (cur ^ 1) * TILE_LDS + so) = kreg; vstore(Vbuf + (cur ^ 1) * TILE_LDS, vreg, L); }
        __syncthreads();
    }
}
}
namespace nsa {
struct AttnPtrs {
    const bf16_t* q;
    const bf16_t* z;
    const bf16_t* kc;
    const bf16_t* vct;
    const bf16_t* ksel;
    const bf16_t* vselt;
    const bf16_t* kwin; const bf16_t* vwint;
    unsigned long long* selmask;
    bf16_t* mix;
};
template <bool ACCUM>
__device__ __forceinline__ void store_o(const f32x16& a0, const f32x16& a1, bf16_t* mix, long tok, int head, int hi) {
    bf16_t* op = mix + tok * 1024 + head * 64 + 4 * hi;
#pragma unroll
    for (int dd = 0; dd < 2; ++dd)
#pragma unroll
        for (int rq = 0; rq < 4; ++rq) {
            float v0, v1, v2, v3;
            if (dd == 0) { v0 = a0[4 * rq]; v1 = a0[4 * rq + 1]; v2 = a0[4 * rq + 2]; v3 = a0[4 * rq + 3]; }
            else         { v0 = a1[4 * rq]; v1 = a1[4 * rq + 1]; v2 = a1[4 * rq + 2]; v3 = a1[4 * rq + 3]; }
            u32x2* p = (u32x2*)(op + dd * 32 + rq * 8);
            if (ACCUM) { const u32x2 old = *p; v0 += bflo(old.x); v1 += bfhi(old.x); v2 += bflo(old.y); v3 += bfhi(old.y); }
            u32x2 w; w.x = cvt_pk_bf16(v0, v1); w.y = cvt_pk_bf16(v2, v3); *p = w;
        }
}
__device__ __forceinline__ float gate_of(const bf16_t* z, long tok, int head, int br) { return sigmoidf_(bf2f(z[tok * INP + ZG + head * 3 + br])); }

struct CmpPre { bf16x8 qr[4]; };
__device__ __forceinline__ void cmp_prefetch(CmpPre& R, int bh, int qb, const AttnPtrs& P, const Lane& L) {
    const int b = bh >> 1, h = bh & 1, tq = qb * 64 + 8 * L.wid + (L.c >> 2), head = 4 * h + (L.c & 3); const long tok = (long)b * SEQ + tq;
    load_q(R.qr, P.q, tok, head, L.hi);
}
__device__ __forceinline__ void cmp_stage(const CmpPre& R, LAS unsigned char* lds, const Lane& L, bf16x8 (&qr)[4], float& gt) {
    (void)lds; (void)L;
#pragma unroll
    for (int d0 = 0; d0 < 4; ++d0) qr[d0] = R.qr[d0];
    gt = 0.f;
}
template <bool STAGE>
__device__ __forceinline__ void cmp_unit(int bh, int qb, const AttnPtrs& P, LAS unsigned char* lds, const Lane& L) {
    const int b = bh >> 1, h = bh & 1, t0 = qb * 64;
    const int ql = 8 * L.wid + (L.c >> 2), g = L.c & 3, tq = t0 + ql, head = 4 * h + g;
    const long tok = (long)b * SEQ + tq;
    LAS unsigned char* Kb = lds; LAS unsigned char* Vb = lds + 4 * TILE_LDS;
    LAS float* G4 = (LAS float*)(lds + 8 * TILE_LDS); LAS float* E3 = G4 + 64 * 64;
    const float gate_raw = bf2f(P.z[tok * INP + ZG + head * 3 + 0]);
    bf16x8 qr[4]; load_q(qr, P.q, tok, head, L.hi);
    u32x4 vv[4];
    if (STAGE) { const char* ks = (const char*)(P.kc + (size_t)bh * 256 * 64); const char* vs = (const char*)(P.vct + (size_t)bh * 256 * 64); const int so = stage_off(L.tid); u32x4 kk[4];
#pragma unroll
      for (int jn = 0; jn < 4; ++jn) kk[jn] = *(const u32x4*)(ks + jn * 8192 + L.tid * 16);
#pragma unroll
      for (int jn = 0; jn < 4; ++jn) vv[jn] = *(const u32x4*)(vs + jn * 8192 + L.tid * 16);
#pragma unroll
      for (int jn = 0; jn < 4; ++jn) *(LAS u32x4*)(Kb + jn * TILE_LDS + so) = kk[jn]; }
    __syncthreads();
    const int nmax = (tq >= 31) ? ((tq - 31) >> 4) : -1;
    const int tq_lo = t0 + 8 * L.wid, tq_hi = tq_lo + 7;
    const int nmax_lo = (tq_lo >= 31) ? ((tq_lo - 31) >> 4) : -1, nmax_hi = (tq_hi >= 31) ? ((tq_hi - 31) >> 4) : -1;
    const int ntile = (nmax_hi >= 0) ? (nmax_hi >> 6) + 1 : 0;
    float l = 0.f;
    for (int jn = 0; jn < ntile; ++jn) {
        f32x16 p0, p1; qk_tile(p0, p1, Kb + jn * TILE_LDS, qr, 0.f, L);
        if (64 * jn + 63 > nmax_lo) mask_range(p0, p1, -1, nmax - 64 * jn, L.hi);
        float ls = 0.f;
#pragma unroll
        for (int r = 0; r < 16; ++r) ls += fast_exp2(p0[r]) + fast_exp2(p1[r]);
        l += ls;
    }
    if (STAGE) { const int so = stage_off(L.tid);
#pragma unroll
      for (int jn = 0; jn < 4; ++jn) *(LAS u32x4*)(Vb + jn * TILE_LDS + so) = vv[jn]; }
    __syncthreads();
    l += xshfl<32>(l);
    const float inv = (nmax >= 0 && l > 0.f) ? fast_rcp(l) : 0.f;
    f32x16 o0, o1;
#pragma unroll
    for (int r = 0; r < 16; ++r) { o0[r] = 0.f; o1[r] = 0.f; }
    for (int jn = 0; jn < ntile; ++jn) {
        f32x16 p0, p1; qk_tile(p0, p1, Kb + jn * TILE_LDS, qr, 0.f, L);
        if (64 * jn + 63 > nmax_lo) mask_range(p0, p1, -1, nmax - 64 * jn, L.hi);
#pragma unroll
        for (int r = 0; r < 16; ++r) { p0[r] = fast_exp2(p0[r]); p1[r] = fast_exp2(p1[r]); }
        pv_tile(o0, o1, Vb + jn * TILE_LDS, p0, p1, L);
#pragma unroll
        for (int kh = 0; kh < 2; ++kh)
#pragma unroll
            for (int rq = 0; rq < 4; ++rq) {
                float gs, e3;
                if (kh == 0) { gs = (p0[4 * rq] + p0[4 * rq + 1]) + (p0[4 * rq + 2] + p0[4 * rq + 3]); e3 = p0[4 * rq + 3]; }
                else         { gs = (p1[4 * rq] + p1[4 * rq + 1]) + (p1[4 * rq + 2] + p1[4 * rq + 3]); e3 = p1[4 * rq + 3]; }
                gs *= inv; e3 *= inv;
                gs += xshfl<1>(gs); gs += xshfl<2>(gs); e3 += xshfl<1>(e3); e3 += xshfl<2>(e3);
                if (g == 0) { const int s = 16 * jn + 8 * kh + 2 * rq + L.hi; G4[ql * 64 + s] = gs; E3[ql * 64 + s] = e3; }
            }
    }
    {
        const float gt = sigmoidf_(gate_raw) * inv;
#pragma unroll
        for (int r = 0; r < 16; ++r) { o0[r] *= gt; o1[r] *= gt; }
        store_o<false>(o0, o1, P.mix, tok, head, L.hi);
    }
    __syncthreads();
}
__device__ __forceinline__ void cmp_topk(int bh, int qb, const AttnPtrs& P, LAS unsigned char* lds, const Lane& L) {
    const int t0 = qb * 64; LAS float* G4 = (LAS float*)(lds + 8 * TILE_LDS); LAS float* E3 = G4 + 64 * 64;
    const int s = L.lane;
    if (qb < 16) { const unsigned long long mask = (1ull << (qb + 1)) - 1ull;
        if (L.lane < 8) P.selmask[(size_t)bh * SEQ + t0 + 8 * L.wid + L.lane] = mask; }
    else {
        const bool cand = (s >= 1) && (s <= qb - 2);
        unsigned bits[8], T[8];
#pragma unroll
        for (int i = 0; i < 8; ++i) { const int q = 8 * L.wid + i; const float imp = G4[q * 64 + s] + (s > 0 ? E3[q * 64 + s - 1] : 0.f); bits[i] = cand ? __float_as_uint(fmaxf(imp, 0.f)) : 0u; T[i] = 0u; }
        for (int bit = 30; bit >= 0; --bit) {
#pragma unroll
            for (int i = 0; i < 8; ++i) { const unsigned c = T[i] | (1u << bit); if (__popcll(__ballot(cand && bits[i] >= c)) >= 13) T[i] = c; } }
#pragma unroll
        for (int i = 0; i < 8; ++i) {
            const unsigned long long gt = __ballot(cand && bits[i] > T[i]); unsigned long long eq = __ballot(cand && bits[i] == T[i]);
            int need = 13 - __popcll(gt); unsigned long long take = 0ull;
            while (need > 0 && eq) { const unsigned long long low = eq & (0ull - eq); take |= low; eq ^= low; --need; }
            const unsigned long long mask = gt | take | 1ull | (1ull << qb) | (1ull << (qb - 1));
            if (L.lane == 0) P.selmask[(size_t)bh * SEQ + t0 + 8 * L.wid + i] = mask; }
    }
    __syncthreads();
}

__device__ __forceinline__ void sw_unit(int bh, int qb, const AttnPtrs& P, LAS unsigned char* lds, const Lane& L) {
    const int b = bh >> 1, h = bh & 1, t0 = qb * 64;
    const int ql = 8 * L.wid + (L.c >> 2), g = L.c & 3, tq = t0 + ql, head = 4 * h + g;
    const long tok = (long)b * SEQ + tq;
    bf16x8 qr[4]; load_q(qr, P.q, tok, head, L.hi);
    const unsigned long long selw = P.selmask[(size_t)bh * SEQ + tq];
    const float g1raw = bf2f(P.z[tok * INP + ZG + head * 3 + 1]), g2raw = bf2f(P.z[tok * INP + ZG + head * 3 + 2]);
    f32x16 r0, r1;
    {
        f32x16 o0, o1; float m = 0.f, l = 0.f;
#pragma unroll
        for (int r = 0; r < 16; ++r) { o0[r] = 0.f; o1[r] = 0.f; }
        run_branch<0>(o0, o1, m, l, P.ksel + (size_t)bh * SEQ * 64, P.vselt + (size_t)bh * SEQ * 64, 0, qb, qb, ql, selw, qr, lds, L);
        l += xshfl<32>(l);
        const float sc = sigmoidf_(g1raw) * fast_rcp(l);
#pragma unroll
        for (int r = 0; r < 16; ++r) { r0[r] = o0[r] * sc; r1[r] = o1[r] * sc; }
    }
    {
        f32x16 o0, o1; float m = 0.f, l = 0.f;
#pragma unroll
        for (int r = 0; r < 16; ++r) { o0[r] = 0.f; o1[r] = 0.f; }
        run_branch<1>(o0, o1, m, l, P.kwin + (size_t)bh * SEQ * 64, P.vwint + (size_t)bh * SEQ * 64, qb >= 8 ? qb - 8 : 0, qb, qb, ql, 0ull, qr, lds, L);
        l += xshfl<32>(l);
        const float sc = sigmoidf_(g2raw) * fast_rcp(l);
#pragma unroll
        for (int r = 0; r < 16; ++r) { r0[r] += o0[r] * sc; r1[r] += o1[r] * sc; }
    }
    store_o<true>(r0, r1, P.mix, tok, head, L.hi);
}
__device__ __forceinline__ void sw_unit2(int bh, int qb2, const AttnPtrs& P, LAS unsigned char* lds, const Lane& L) {
    const int b = bh >> 1, h = bh & 1, qbw = 2 * qb2 + (L.wid >> 2);
    const int qrela = 16 * (L.wid & 3) + (L.c >> 2), qrelb = qrela + 8, g = L.c & 3, head = 4 * h + g;
    const long toka = (long)b * SEQ + 64 * qbw + qrela, tokb = toka + 8;
    bf16x8 qa[4], qbf[4]; load_q(qa, P.q, toka, head, L.hi); load_q(qbf, P.q, tokb, head, L.hi);
    LAS unsigned long long* selp = (LAS unsigned long long*)(lds + 4 * TILE_LDS + 8192) + L.tid * 2;
    selp[0] = P.selmask[(size_t)bh * SEQ + 64 * qbw + qrela]; selp[1] = P.selmask[(size_t)bh * SEQ + 64 * qbw + qrelb];
    LAS float* gpark = (LAS float*)(lds + 4 * TILE_LDS) + L.tid * 4;
    gpark[0] = bf2f(P.z[toka * INP + ZG + head * 3 + 1]); gpark[1] = bf2f(P.z[tokb * INP + ZG + head * 3 + 1]); gpark[2] = bf2f(P.z[toka * INP + ZG + head * 3 + 2]); gpark[3] = bf2f(P.z[tokb * INP + ZG + head * 3 + 2]);
    {
        f32x16 oa0, oa1, ob0, ob1; SoftState sa{0.f, 0.f}, sb{0.f, 0.f};
#pragma unroll
        for (int r = 0; r < 16; ++r) { oa0[r] = 0.f; oa1[r] = 0.f; ob0[r] = 0.f; ob1[r] = 0.f; }
        run_branch2<0>(oa0, oa1, sa, ob0, ob1, sb, P.ksel + (size_t)bh * SEQ * 64, P.vselt + (size_t)bh * SEQ * 64, 0, 2 * qb2 + 1, qbw, qrela, selp, qa, qbf, lds, L);
        sa.l += xshfl<32>(sa.l); sb.l += xshfl<32>(sb.l);
        const float sca = sigmoidf_(gpark[0]) * fast_rcp(sa.l), scb = sigmoidf_(gpark[1]) * fast_rcp(sb.l);
#pragma unroll
        for (int r = 0; r < 16; ++r) { oa0[r] *= sca; oa1[r] *= sca; ob0[r] *= scb; ob1[r] *= scb; }
        { int qe = qrela; asm volatile("" : "+v"(qe));
          store_o<true>(oa0, oa1, P.mix, (long)b * SEQ + 64 * qbw + qe, head, L.hi); store_o<true>(ob0, ob1, P.mix, (long)b * SEQ + 64 * qbw + qe + 8, head, L.hi); }
    }
    {
        f32x16 oa0, oa1, ob0, ob1; SoftState sa{0.f, 0.f}, sb{0.f, 0.f};
#pragma unroll
        for (int r = 0; r < 16; ++r) { oa0[r] = 0.f; oa1[r] = 0.f; ob0[r] = 0.f; ob1[r] = 0.f; }
        run_branch2<1>(oa0, oa1, sa, ob0, ob1, sb, P.kwin + (size_t)bh * SEQ * 64, P.vwint + (size_t)bh * SEQ * 64, 2 * qb2 >= 8 ? 2 * qb2 - 8 : 0, 2 * qb2 + 1, qbw, qrela, selp, qa, qbf, lds, L);
        sa.l += xshfl<32>(sa.l); sb.l += xshfl<32>(sb.l);
        const float sca = sigmoidf_(gpark[2]) * fast_rcp(sa.l), scb = sigmoidf_(gpark[3]) * fast_rcp(sb.l);
#pragma unroll
        for (int r = 0; r < 16; ++r) { oa0[r] *= sca; oa1[r] *= sca; ob0[r] *= scb; ob1[r] *= scb; }
        { int qe = qrela; asm volatile("" : "+v"(qe));
          store_o<true>(oa0, oa1, P.mix, (long)b * SEQ + 64 * qbw + qe, head, L.hi); store_o<true>(ob0, ob1, P.mix, (long)b * SEQ + 64 * qbw + qe + 8, head, L.hi); }
    }
}
}
namespace epi {
using pg8::Unit; using pg8::BM; using pg8::HALF;
struct Bf16Plain {
    static constexpr bool PERM = true;
    bf16_t* O; int ldc;
    __device__ __forceinline__ void operator()(const f32x4 (&acc)[2][2][4][2], const Unit& u, int wr, int wc, int fr, int fq) const {
        const int row0 = u.pm * BM + wr * 64 + fr, col0 = u.pn * BM + wc * 32 + 8 * fq;
#pragma unroll
        for (int ai = 0; ai < 2; ++ai)
#pragma unroll
            for (int m = 0; m < 4; ++m) { bf16_t* rowp = O + (size_t)(row0 + ai * HALF + m * 16) * ldc + col0;
#pragma unroll
                for (int bj = 0; bj < 2; ++bj) { const f32x4 v0 = acc[ai][bj][m][0], v1 = acc[ai][bj][m][1];
                    u32x4 w; w.x = cvt_pk_bf16(v0[0], v0[1]); w.y = cvt_pk_bf16(v0[2], v0[3]); w.z = cvt_pk_bf16(v1[0], v1[1]); w.w = cvt_pk_bf16(v1[2], v1[3]);
                    *(u32x4*)(rowp + bj * HALF) = w; } }
    }
};
struct Bf16Sc1 {
    static constexpr bool PERM = true;
    bf16_t* O; int ldc; unsigned nbytes;
    __device__ __forceinline__ void operator()(const f32x4 (&acc)[2][2][4][2], const Unit& u, int wr, int wc, int fr, int fq) const {
        const __amdgpu_buffer_rsrc_t rsrc = __builtin_amdgcn_make_buffer_rsrc(O, 0, nbytes, 0x00020000);
        const int row0 = u.pm * BM + wr * 64 + fr, col0 = u.pn * BM + wc * 32 + 8 * fq;
#pragma unroll
        for (int ai = 0; ai < 2; ++ai)
#pragma unroll
            for (int m = 0; m < 4; ++m) { const unsigned off = (unsigned)(((size_t)(row0 + ai * HALF + m * 16) * ldc + col0) * 2);
#pragma unroll
                for (int bj = 0; bj < 2; ++bj) { const f32x4 v0 = acc[ai][bj][m][0], v1 = acc[ai][bj][m][1];
                    u32x4 w; w.x = cvt_pk_bf16(v0[0], v0[1]); w.y = cvt_pk_bf16(v0[2], v0[3]); w.z = cvt_pk_bf16(v1[0], v1[1]); w.w = cvt_pk_bf16(v1[2], v1[3]);
                    __builtin_amdgcn_raw_buffer_store_b128(w, rsrc, off + bj * HALF * 2, 0,   16); } }
    }
};
struct F32Grouped {
    static constexpr bool PERM = false;
    float* C; int ldc; size_t gstride;
    __device__ __forceinline__ void operator()(const f32x4 (&acc)[2][2][4][2], const Unit& u, int wr, int wc, int fr, int fq) const {
        const int row0 = u.pm * BM + wr * 64 + fr, col0 = u.pn * BM + wc * 32 + 4 * fq; float* Cg = C + (size_t)u.aux * gstride;
#pragma unroll
        for (int ai = 0; ai < 2; ++ai)
#pragma unroll
            for (int m = 0; m < 4; ++m) { float* rowp = Cg + (size_t)(row0 + ai * HALF + m * 16) * ldc + col0;
#pragma unroll
                for (int bj = 0; bj < 2; ++bj)
#pragma unroll
                    for (int n = 0; n < 2; ++n) *(f32x4*)(rowp + bj * HALF + n * 16) = acc[ai][bj][m][n]; }
    }
};
struct SwiGlu {
    static constexpr bool PERM = true;
    bf16_t* H; int ldc;
    __device__ __forceinline__ void operator()(const f32x4 (&acc)[2][2][4][2], const Unit& u, int wr, int wc, int fr, int fq) const {
        const int row0 = u.pm * BM + wr * 64 + fr, col0 = u.pn * HALF + wc * 32 + 8 * fq;
#pragma unroll
        for (int ai = 0; ai < 2; ++ai)
#pragma unroll
            for (int m = 0; m < 4; ++m) { bf16_t* rowp = H + (size_t)(row0 + ai * HALF + m * 16) * ldc + col0;
                float o[8];
#pragma unroll
                for (int n = 0; n < 2; ++n)
#pragma unroll
                    for (int e = 0; e < 4; ++e) o[4 * n + e] = siluf_(acc[ai][0][m][n][e]) * acc[ai][1][m][n][e];
                u32x4 w; w.x = cvt_pk_bf16(o[0], o[1]); w.y = cvt_pk_bf16(o[2], o[3]); w.z = cvt_pk_bf16(o[4], o[5]); w.w = cvt_pk_bf16(o[6], o[7]);
                *(u32x4*)rowp = w; }
    }
};
struct MoeDown {
    static constexpr bool PERM = true;
    bf16_t* Y; const int* row_tok;
    __device__ __forceinline__ void operator()(const f32x4 (&acc)[2][2][4][2], const Unit& u, int wr, int wc, int fr, int fq) const {
        const int srow0 = u.aux * BM + wr * 64 + fr, col0 = u.pn * BM + wc * 32 + 8 * fq;
        int dsts[8];
#pragma unroll
        for (int it = 0; it < 8; ++it) dsts[it] = row_tok[srow0 + (it >> 2) * HALF + (it & 3) * 16];
#pragma unroll
        for (int ai = 0; ai < 2; ++ai)
#pragma unroll
            for (int m = 0; m < 4; ++m) { const int dst = dsts[ai * 4 + m];
                if (dst >= 0) { bf16_t* rowp = Y + (size_t)dst * D + col0;
#pragma unroll
                    for (int bj = 0; bj < 2; ++bj) { const f32x4 v0 = acc[ai][bj][m][0], v1 = acc[ai][bj][m][1];
                        u32x4 w; w.x = cvt_pk_bf16(v0[0], v0[1]); w.y = cvt_pk_bf16(v0[2], v0[3]); w.z = cvt_pk_bf16(v1[0], v1[1]); w.w = cvt_pk_bf16(v1[2], v1[3]);
                        *(u32x4*)(rowp + bj * HALF) = w; } } }
    }
};
struct SigmoidBias {
    static constexpr bool PERM = true;
    bf16_t* O; int ldc; const float* bias;
    __device__ __forceinline__ void operator()(const f32x4 (&acc)[2][2][4][2], const Unit& u, int wr, int wc, int fr, int fq) const {
        const int row0 = u.pm * BM + wr * 64 + fr, col0 = u.pn * BM + wc * 32 + 8 * fq;
        f32x4 bv[2][2];
#pragma unroll
        for (int bj = 0; bj < 2; ++bj)
#pragma unroll
            for (int n = 0; n < 2; ++n) bv[bj][n] = *(const f32x4*)(bias + col0 + bj * HALF + 4 * n);
#pragma unroll
        for (int ai = 0; ai < 2; ++ai)
#pragma unroll
            for (int m = 0; m < 4; ++m) { bf16_t* rowp = O + (size_t)(row0 + ai * HALF + m * 16) * ldc + col0;
#pragma unroll
                for (int bj = 0; bj < 2; ++bj) { f32x4 v0 = acc[ai][bj][m][0] + bv[bj][0], v1 = acc[ai][bj][m][1] + bv[bj][1];
#pragma unroll
                    for (int e = 0; e < 4; ++e) { v0[e] = sigmoidf_(v0[e]); v1[e] = sigmoidf_(v1[e]); }
                    u32x4 w; w.x = cvt_pk_bf16(v0[0], v0[1]); w.y = cvt_pk_bf16(v0[2], v0[3]); w.z = cvt_pk_bf16(v1[0], v1[1]); w.w = cvt_pk_bf16(v1[2], v1[3]);
                    *(u32x4*)(rowp + bj * HALF) = w; } }
    }
};
struct MulBf16 {
    static constexpr bool PERM = true;
    bf16_t* O; const bf16_t* G; int ldc;
    __device__ __forceinline__ void operator()(const f32x4 (&acc)[2][2][4][2], const Unit& u, int wr, int wc, int fr, int fq) const {
        const int row0 = u.pm * BM + wr * 64 + fr, col0 = u.pn * BM + wc * 32 + 8 * fq;
        u32x4 gq[2], gn[2];
        { const size_t off = (size_t)row0 * ldc + col0; gn[0] = *(const u32x4*)(G + off); gn[1] = *(const u32x4*)(G + off + HALF); }
#pragma unroll
        for (int it = 0; it < 8; ++it) { const int ai = it >> 2, m = it & 3; const size_t off = (size_t)(row0 + ai * HALF + m * 16) * ldc + col0;
            gq[0] = gn[0]; gq[1] = gn[1];
            if (it < 7) { const int ai2 = (it + 1) >> 2, m2 = (it + 1) & 3; const size_t off2 = (size_t)(row0 + ai2 * HALF + m2 * 16) * ldc + col0; gn[0] = *(const u32x4*)(G + off2); gn[1] = *(const u32x4*)(G + off2 + HALF); }
#pragma unroll
            for (int bj = 0; bj < 2; ++bj) { const f32x4 v0 = acc[ai][bj][m][0], v1 = acc[ai][bj][m][1]; const u32x4 g4 = gq[bj];
                u32x4 w; w.x = cvt_pk_bf16(v0[0] * bflo(g4.x), v0[1] * bfhi(g4.x)); w.y = cvt_pk_bf16(v0[2] * bflo(g4.y), v0[3] * bfhi(g4.y));
                w.z = cvt_pk_bf16(v1[0] * bflo(g4.z), v1[1] * bfhi(g4.z)); w.w = cvt_pk_bf16(v1[2] * bflo(g4.w), v1[3] * bfhi(g4.w));
                *(u32x4*)(O + off + bj * HALF) = w; }
            asm volatile("" ::: "memory"); }
    }
};
struct S5Out {
    static constexpr bool PERM = true;
    bf16_t* ZS5; const bf16_t* Z; const float* dskip;
    __device__ __forceinline__ void operator()(const f32x4 (&acc)[2][2][4][2], const Unit& u, int wr, int wc, int fr, int fq) const {
        const int g = u.aux, row0 = u.pm * BM + wr * 64 + fr;
#pragma unroll
        for (int bj = 0; bj < 2; ++bj) { const int col = u.pn * BM + bj * HALF + wc * 32 + 8 * fq, jo = col >> 4, co0 = col & 15, ch0 = g * 16 + co0;
            const f32x4 d0 = *(const f32x4*)(dskip + ch0), d1 = *(const f32x4*)(dskip + ch0 + 4);
#pragma unroll
            for (int ai = 0; ai < 2; ++ai)
#pragma unroll
                for (int m = 0; m < 4; ++m) { const int mr = row0 + ai * HALF + m * 16; const long tok = (long)(mr >> 7) * SEQ + (mr & 127) * S5LC + jo;
                    const u32x4 uq = *(const u32x4*)(Z + tok * INP + ZS + ch0); const f32x4 v0 = acc[ai][bj][m][0], v1 = acc[ai][bj][m][1];
                    u32x4 w; w.x = cvt_pk_bf16(gelu_tanh(v0[0] + d0[0] * bflo(uq.x)), gelu_tanh(v0[1] + d0[1] * bfhi(uq.x)));
                    w.y = cvt_pk_bf16(gelu_tanh(v0[2] + d0[2] * bflo(uq.y)), gelu_tanh(v0[3] + d0[3] * bfhi(uq.y)));
                    w.z = cvt_pk_bf16(gelu_tanh(v1[0] + d1[0] * bflo(uq.z)), gelu_tanh(v1[1] + d1[1] * bfhi(uq.z)));
                    w.w = cvt_pk_bf16(gelu_tanh(v1[2] + d1[2] * bflo(uq.w)), gelu_tanh(v1[3] + d1[3] * bfhi(uq.w)));
                    *(u32x4*)(ZS5 + tok * 256 + ch0) = w; asm volatile("" ::: "memory"); } }
    }
};
struct S5Glu {
    static constexpr bool PERM = true;
    bf16_t* MIX; const bf16_t* ZS5; const float* bias;
    __device__ __forceinline__ void operator()(const f32x4 (&acc)[2][2][4][2], const Unit& u, int wr, int wc, int fr, int fq) const {
        const int row0 = u.pm * BM + wr * 64 + fr, col0 = wc * 32 + 8 * fq;
#pragma unroll
        for (int bj = 0; bj < 2; ++bj) { const int col = col0 + bj * HALF; const f32x4 b0 = *(const f32x4*)(bias + col), b1 = *(const f32x4*)(bias + col + 4);
#pragma unroll
            for (int ai = 0; ai < 2; ++ai)
#pragma unroll
                for (int m = 0; m < 4; ++m) { const size_t row = (size_t)(row0 + ai * HALF + m * 16); const u32x4 zq = *(const u32x4*)(ZS5 + row * 256 + col);
                    const f32x4 v0 = acc[ai][bj][m][0] + b0, v1 = acc[ai][bj][m][1] + b1;
                    u32x4 w; w.x = cvt_pk_bf16(bflo(zq.x) * sigmoidf_(v0[0]), bfhi(zq.x) * sigmoidf_(v0[1])); w.y = cvt_pk_bf16(bflo(zq.y) * sigmoidf_(v0[2]), bfhi(zq.y) * sigmoidf_(v0[3]));
                    w.z = cvt_pk_bf16(bflo(zq.z) * sigmoidf_(v1[0]), bfhi(zq.z) * sigmoidf_(v1[1])); w.w = cvt_pk_bf16(bflo(zq.w) * sigmoidf_(v1[2]), bfhi(zq.w) * sigmoidf_(v1[3]));
                    *(u32x4*)(MIX + row * 1024 + 768 + col) = w; asm volatile("" ::: "memory"); } }
    }
};
struct EpiWin {
    static constexpr bool PERM = true;
    bf16_t* Z; bf16_t* Q; bf16_t* KV; bf16_t* AP; const f32x2* rope;
    __device__ __forceinline__ void operator()(const f32x4 (&acc)[2][2][4][2], const Unit& u, int wr, int wc, int fr, int fq) const {
        const int row0 = u.pm * BM + wr * 64 + fr;
        if (u.pn >= 5) {
#pragma unroll
            for (int bj = 0; bj < 2; ++bj) { const int col0 = u.pn * BM + bj * HALF + wc * 32 + 8 * fq; const int sc0 = col0 - ZS; const bool s5 = (sc0 >= 0) && (sc0 < 256);
#pragma unroll
                for (int ai = 0; ai < 2; ++ai)
#pragma unroll
                    for (int m = 0; m < 4; ++m) { const int tok = row0 + ai * HALF + m * 16; const f32x4 v0 = acc[ai][bj][m][0], v1 = acc[ai][bj][m][1];
                        u32x4 w; w.x = cvt_pk_bf16(v0[0], v0[1]); w.y = cvt_pk_bf16(v0[2], v0[3]); w.z = cvt_pk_bf16(v1[0], v1[1]); w.w = cvt_pk_bf16(v1[2], v1[3]);
                        *(u32x4*)(Z + (size_t)tok * INP + col0) = w;
                        if (s5) { const int b = tok >> 12, t = tok & 4095; *(u32x4*)(AP + ((size_t)(sc0 >> 4) * 2048 + b * 128 + (t >> 5)) * S5K + (t & 31) * 16 + (sc0 & 15)) = w; } } }
            return;
        }
#pragma unroll
        for (int bj = 0; bj < 2; ++bj) {
            const int colh = bj * HALF + wc * 32 + 8 * fq;
            const int qi = 4 * (wc & 1) + fq, d1 = 4 * qi;
            const bool isv = (u.pn >= 2) && (bj == 1);
            f32x4 cn0 = (f32x4){0.f, 0.f, 0.f, 0.f}, cn1 = cn0;
            if (!isv) { cn0 = *(const f32x4*)(rope + (size_t)row0 * 32 + d1); cn1 = *(const f32x4*)(rope + (size_t)row0 * 32 + d1 + 2); }
#pragma unroll
            for (int it = 0; it < 8; ++it) { const int ai = it >> 2, m = it & 3; const int tok = row0 + ai * HALF + m * 16; const int b = tok >> 12, t = tok & 4095; const f32x4 x1 = acc[ai][bj][m][0], x2 = acc[ai][bj][m][1];
                    if (isv) { bf16_t* dst = KV + (size_t)((u.pn - 2) * 2 + 1) * (8u << 20) + ((size_t)(b * 2 + (wc >> 1)) * SEQ + t) * 64 + 32 * (wc & 1) + 8 * fq;
                        u32x4 w; w.x = cvt_pk_bf16(x1[0], x1[1]); w.y = cvt_pk_bf16(x1[2], x1[3]); w.z = cvt_pk_bf16(x2[0], x2[1]); w.w = cvt_pk_bf16(x2[2], x2[3]); *(u32x4*)dst = w; }
                    else { const f32x4 cs0 = cn0, cs1 = cn1;
                        if (it < 7) { const int tok2 = row0 + ((it + 1) >> 2) * HALF + ((it + 1) & 3) * 16; cn0 = *(const f32x4*)(rope + (size_t)tok2 * 32 + d1); cn1 = *(const f32x4*)(rope + (size_t)tok2 * 32 + d1 + 2); }
                        const float sc = (u.pn < 2) ? QSCALE : 1.0f;
                        const float o10 = (x1[0] * cs0[0] - x2[0] * cs0[1]) * sc, o11 = (x1[1] * cs0[2] - x2[1] * cs0[3]) * sc, o12 = (x1[2] * cs1[0] - x2[2] * cs1[1]) * sc, o13 = (x1[3] * cs1[2] - x2[3] * cs1[3]) * sc;
                        const float o20 = (x2[0] * cs0[0] + x1[0] * cs0[1]) * sc, o21 = (x2[1] * cs0[2] + x1[1] * cs0[3]) * sc, o22 = (x2[2] * cs1[0] + x1[2] * cs1[1]) * sc, o23 = (x2[3] * cs1[2] + x1[3] * cs1[3]) * sc;
                        bf16_t* dst = (u.pn < 2) ? Q + (size_t)tok * 512 + (u.pn * 4 + (colh >> 6)) * 64 + d1
                                                 : KV + (size_t)((u.pn - 2) * 2) * (8u << 20) + ((size_t)(b * 2 + (wc >> 1)) * SEQ + t) * 64 + d1;
                        u32x2 w1, w2; w1.x = cvt_pk_bf16(o10, o11); w1.y = cvt_pk_bf16(o12, o13); w2.x = cvt_pk_bf16(o20, o21); w2.y = cvt_pk_bf16(o22, o23);
                        *(u32x2*)dst = w1; *(u32x2*)(dst + 32) = w2; }
                    asm volatile("" ::: "memory"); }
        }
    }
};
}
constexpr size_t MiB = 1u << 20;
constexpr size_t WS_CTL = 0, CTL_ZERO_BYTES = 1 * MiB;
constexpr size_t WS_SMALL = 1 * MiB;
constexpr size_t SM_APOW = WS_SMALL;
constexpr size_t SM_BBAR = WS_SMALL + 5 * MiB / 4;
constexpr size_t SM_KTAB = WS_SMALL + 2 * MiB;
constexpr size_t SM_CMPB = WS_SMALL + 4 * MiB;
constexpr size_t SM_TOKE = WS_SMALL + 4 * MiB + 256 * 1024;
constexpr size_t SM_TOKW = WS_SMALL + 4 * MiB + 512 * 1024;
constexpr size_t SM_ROWTOK = WS_SMALL + 5 * MiB + 256 * 1024;
constexpr size_t SM_PCNT = WS_SMALL + 6 * MiB;
constexpr size_t SM_TILEEXP = WS_SMALL + 6 * MiB + 16384;
constexpr size_t WS_ROPE = 8 * MiB;
constexpr size_t WS_W = 24 * MiB;
constexpr size_t W_IN = WS_W;
constexpr size_t W_OUT = W_IN + (size_t)INP * D * 2;
constexpr size_t W_GATE = W_OUT + (size_t)D * D * 2;
constexpr size_t W_PROJ = W_GATE + (size_t)D * D * 2;
constexpr size_t W_CMP = W_PROJ + (size_t)D * PLE * 2;
constexpr size_t W_GLU = W_CMP + (size_t)2 * 512 * 1024 * 2;
constexpr size_t W_S5B = W_GLU + (size_t)256 * 256 * 2;
constexpr size_t W_S5S = W_S5B + (size_t)16 * 512 * S5K * 2;
constexpr size_t W_UP = W_S5S + (size_t)16 * 256 * 512 * 2;
constexpr size_t W_DN = W_UP + (size_t)NEXP * 2 * DFE * D * 2;
constexpr size_t W_END_ = W_DN + (size_t)NEXP * D * DFE * 2;
static_assert(W_END_ <= WS_W + 240 * MiB, "weight region");
constexpr size_t WS_XB = 264 * MiB;
constexpr size_t WS_PB = 392 * MiB;
constexpr size_t WS_Z = 424 * MiB;
constexpr size_t WS_QKV = 712 * MiB;
constexpr size_t WS_Q = WS_QKV, WS_KCMP = WS_QKV + 64 * MiB, WS_VCMP = WS_KCMP + 16 * MiB, WS_KSEL = WS_VCMP + 16 * MiB, WS_VSEL = WS_KSEL + 16 * MiB, WS_KWIN = WS_VSEL + 16 * MiB, WS_VWIN = WS_KWIN + 16 * MiB;
constexpr size_t WS_MIX = 872 * MiB;
constexpr size_t WS_CMP = 1000 * MiB;
constexpr size_t WS_CMPP = WS_CMP, WS_KC = WS_CMP + 32 * MiB, WS_VCT = WS_KC + 1 * MiB, WS_SELM = WS_VCT + 1 * MiB;
constexpr size_t WS_S5 = 1036 * MiB;
constexpr size_t WS_S5A = WS_S5, WS_S5S = WS_S5 + 40 * MiB, WS_ZS5 = WS_S5S + 32 * MiB;
constexpr size_t WS_HBUF = 1140 * MiB;
constexpr size_t WS_END = 1268 * MiB;
constexpr size_t WS_FFH = WS_Z, WS_XS = WS_Z, WS_MH = WS_Z + 260 * MiB, WS_YB = WS_MH + 224 * MiB;
static_assert(WS_YB + 256 * MiB <= WS_END && WS_FFH + (size_t)T * DFF * 2 <= WS_MIX, "overlays");
constexpr size_t WS_PLEG = WS_Z, WS_PLEH = WS_Z + 128 * MiB;
static_assert(WS_PLEH + 128 * MiB <= WS_MH, "per-layer-embedding buffers of the MoE layers");
constexpr int CW_BAR = 4096;
constexpr int CW_TMO = 64;
constexpr int CW_CNT = 16384, CNT_BANK = 256 * 64;
static_assert((CW_CNT + 8 * CNT_BANK) * 4 <= (int)CTL_ZERO_BYTES, "panel counters inside the per-call memset");

struct Args { const void* in[36]; float* out; unsigned char* ws; int gp_lo, gp_hi, use_bar, pad; };
struct Frame { LAS unsigned char* lds; int tid, lane, wave, G, bid; };
constexpr int RING_BYTES = 131072, LDSCTL_OFF = RING_BYTES, LDS_BYTES = 147456;
typedef __attribute__((address_space(4))) const Args CArgs;
__device__ __forceinline__ void load_args(Args& a) { CArgs* p = (CArgs*)__builtin_amdgcn_kernarg_segment_ptr(); asm volatile("" : "+s"(p)); __builtin_memcpy(&a, p, sizeof(Args)); }
__device__ __forceinline__ Frame make_frame(LAS unsigned char* lds, int wave0) { Frame F; F.lds = lds;
    int w = wave0; asm volatile("" : "+s"(w)); int ln = lane_id_fresh(); F.lane = ln; F.wave = w; F.tid = w * 64 + ln;
    int b = blockIdx.x, g = gridDim.x; asm volatile("" : "+s"(b), "+s"(g)); F.bid = b; F.G = g; return F; }

__constant__ double c_invfreq_rev[32] = {0.15915494309189535, 0.11934937021124886, 0.08949940160889101, 0.06711508300522726, 0.050329212104487035, 0.03774158471741977, 0.0283021958306234, 0.02122365276477766, 0.015915494309189534, 0.011934937021124886, 0.008949940160889102, 0.006711508300522725, 0.005032921210448704, 0.003774158471741977, 0.00283021958306234, 0.0021223652764777662, 0.0015915494309189536, 0.0011934937021124885, 0.0008949940160889102, 0.0006711508300522726, 0.0005032921210448703, 0.00037741584717419774, 0.00028302195830623395, 0.0002122365276477766, 0.00015915494309189535, 0.00011934937021124886, 8.949940160889102e-05, 6.711508300522725e-05, 5.0329212104487035e-05, 3.774158471741978e-05, 2.8302195830623396e-05, 2.122365276477766e-05};

__device__ __forceinline__ void sincos_rev(double rev, float& c, float& s) { const double fr = rev - __builtin_floor(rev); const float f = (float)fr; s = __builtin_amdgcn_sinf(f); c = __builtin_amdgcn_cosf(f); }

template <class Sched>
__device__ __forceinline__ void panels_publish_wait(const Frame& F, unsigned* ctl, int bank, const Sched& S, unsigned need) {
    unsigned* cnt = ctl + CW_CNT + bank * CNT_BANK;
    if (F.tid == 0) { pg8::Unit u; for (int i = 0; S.next(i, u); ++i) __hip_atomic_fetch_add(cnt + 64 * u.pm, 1u, __ATOMIC_RELAXED, __HIP_MEMORY_SCOPE_AGENT); }
    if (F.wave == 0) {
        for (int pm = F.bid; pm < T / 256; pm += F.G) { unsigned spins = 0;
            while ((unsigned)__builtin_amdgcn_readfirstlane(__hip_atomic_load(cnt + 64 * pm, __ATOMIC_RELAXED, __HIP_MEMORY_SCOPE_AGENT)) < need) {
                __builtin_amdgcn_s_sleep(1);
                if (++spins > (1u << 22)) { if (F.lane == 0) __hip_atomic_store(ctl + CW_TMO, 1u, __ATOMIC_RELAXED, __HIP_MEMORY_SCOPE_AGENT); break; }
                if ((spins & 1023u) == 0u && __builtin_amdgcn_readfirstlane(__hip_atomic_load(ctl + CW_TMO, __ATOMIC_RELAXED, __HIP_MEMORY_SCOPE_AGENT))) break; } }
        __builtin_amdgcn_fence(__ATOMIC_ACQUIRE, "agent");
        asm volatile("s_waitcnt vmcnt(0)" ::: "memory");
    }
    __syncthreads();
}
__device__ __forceinline__ void phase_init0(const Frame& F, const Args& a) {
    const size_t gt = (size_t)F.bid * 512 + F.tid, NT = (size_t)F.G * 512;
    const int* pos = (const int*)a.in[2]; f32x2* rope = (f32x2*)(a.ws + WS_ROPE);
    for (size_t i = gt; i < (size_t)T * 32; i += NT) { const int tok = (int)(i >> 5), k = (int)(i & 31); float c, s; sincos_rev((double)pos[tok] * c_invfreq_rev[k], c, s); rope[i] = (f32x2){c, s}; }
    const float* are = (const float*)a.in[14]; const float* aim = (const float*)a.in[15]; const float* ldt = (const float*)a.in[16];
    const float* bre = (const float*)a.in[17]; const float* bim = (const float*)a.in[18];
    f32x2* apow = (f32x2*)(a.ws + SM_APOW); f32x2* bbar = (f32x2*)(a.ws + SM_BBAR);
    for (size_t i = gt; i < (size_t)DEPTH * 16 * 64 * 34; i += NT) { const int k = (int)(i % 34), lgn = (int)(i / 34), lg = lgn >> 6;
        const float dt = __expf(ldt[lg]); const float ar = are[lgn] * dt; const double rev = (double)k * ((double)aim[lgn] * (double)dt) * 0.15915494309189535;
        float c, s; sincos_rev(rev, c, s); const float mg = __expf((float)k * ar); apow[i] = (f32x2){mg * c, mg * s}; }
    for (size_t i = gt; i < (size_t)DEPTH * 16 * 64 * 16; i += NT) { const int lgn = (int)(i >> 4), lg = lgn >> 6;
        const float dt = __expf(ldt[lg]); const float lr = are[lgn], li = aim[lgn]; const double rev = ((double)li * (double)dt) * 0.15915494309189535;
        float c, s; sincos_rev(rev, c, s); const float mg = __expf(lr * dt); const float abr = mg * c, abi = mg * s, den = lr * lr + li * li;
        const float cr = ((abr - 1.0f) * lr + abi * li) / den, ci = (abi * lr - (abr - 1.0f) * li) / den;
        const float br = bre[i], bi = bim[i]; bbar[i] = (f32x2){cr * br - ci * bi, cr * bi + ci * br}; }
    const f32x4* x4 = (const f32x4*)a.in[0]; u32x2* xb = (u32x2*)(a.ws + WS_XB);
    for (size_t i = gt; i < (size_t)T * D / 4; i += 4 * NT) { f32x4 v[4];
#pragma unroll
        for (int q = 0; q < 4; ++q) { const size_t ii = i + q * NT; v[q] = (ii < (size_t)T * D / 4) ? x4[ii] : (f32x4){0.f, 0.f, 0.f, 0.f}; }
#pragma unroll
        for (int q = 0; q < 4; ++q) { const size_t ii = i + q * NT; if (ii < (size_t)T * D / 4) { u32x2 w; w.x = cvt_pk_bf16(v[q][0], v[q][1]); w.y = cvt_pk_bf16(v[q][2], v[q][3]); xb[ii] = w; } } }
}
__device__ __forceinline__ void phase_init1(const Frame& F, const Args& a) {
    const size_t gt = (size_t)F.bid * 512 + F.tid, NT = (size_t)F.G * 512;
    const float* cre = (const float*)a.in[19]; const float* cim = (const float*)a.in[20];
    const f32x2* apow = (const f32x2*)(a.ws + SM_APOW); const f32x2* bbar = (const f32x2*)(a.ws + SM_BBAR); float* ktab = (float*)(a.ws + SM_KTAB);
    for (size_t i = gt; i < (size_t)DEPTH * 16 * 32 * 256; i += NT) { const int ci = (int)(i & 15), co = (int)((i >> 4) & 15), tau = (int)((i >> 8) & 31), lg = (int)(i >> 13);
        float acc = 0.f;
        for (int n = 0; n < 64; ++n) { const f32x2 P = apow[((size_t)lg * 64 + n) * 34 + tau], Bb = bbar[((size_t)lg * 64 + n) * 16 + ci]; const float cr = cre[((size_t)lg * 16 + co) * 64 + n], cm = cim[((size_t)lg * 16 + co) * 64 + n];
            const float hr = P.x * Bb.x - P.y * Bb.y, hi = P.x * Bb.y + P.y * Bb.x; acc += cr * hr - cm * hi; }
        ktab[i] = acc; }
}

__device__ __forceinline__ void transpose_item(const float* W, int ldw, int k0, int n0, int nvalid, bf16_t* dstrow, int dst_ld, LAS float* scr, int lane, int permhi) {
    float tv[32];
#pragma unroll
    for (int i = 0; i < 32; ++i) { const int kk = 2 * i + (lane >> 5), nn = lane & 31; tv[i] = (nn < nvalid) ? W[(size_t)(k0 + kk) * ldw + n0 + nn] : 0.f; }
#pragma unroll
    for (int i = 0; i < 32; ++i) { const int kk = 2 * i + (lane >> 5), nn = lane & 31; scr[kk * 33 + nn] = tv[i]; }
    LDS_WAIT(); asm volatile("" ::: "memory");
    const int c = lane & 7;
#pragma unroll
    for (int j = 0; j < 4; ++j) { const int n = (lane >> 3) + 8 * j; const LAS float* s = scr + (8 * c) * 33 + n;
        u32x4 o; o.x = cvt_pk_bf16(s[0 * 33], s[1 * 33]); o.y = cvt_pk_bf16(s[2 * 33], s[3 * 33]); o.z = cvt_pk_bf16(s[4 * 33], s[5 * 33]); o.w = cvt_pk_bf16(s[6 * 33], s[7 * 33]);
        const int drow = permhi < 0 ? n : (8 * (n >> 2) + 4 * permhi + (n & 3));
        if (n < nvalid) *(u32x4*)(dstrow + (size_t)drow * dst_ld + 8 * c) = o; }
    LDS_WAIT(); asm volatile("" ::: "memory");
}
__device__ __forceinline__ void transpose_mat(const float* W, int K, int N, bf16_t* dst, int dst_ld, int mode, LAS float* scr, int lane, int& cursor, int gw, int NGW) {
    const int nblk = (N + 31) / 32, items = (K / 64) * nblk;
    int it = ((gw - cursor) % NGW + NGW) % NGW;
    for (; it < items; it += NGW) { const int kb = it / nblk, nb = it % nblk, k0 = 64 * kb, n0 = 32 * nb; const int nv = (N - n0) < 32 ? (N - n0) : 32;
        int drow = n0, permhi = -1;
        if (mode == 1 || mode == 2) drow = (n0 >> 7) * 256 + (n0 & 127) + (mode == 2 ? 128 : 0);
        if (mode == 3 && (n0 < 512 || (n0 < 1280 && (((n0 - 512) >> 7) & 1) == 0))) { drow = n0 & ~63; permhi = (n0 >> 5) & 1; }
        transpose_item(W, N, k0, n0, nv, dst + (size_t)drow * dst_ld + k0, dst_ld, scr, lane, permhi); }
    cursor = (cursor + items) % NGW;
}

__device__ __forceinline__ void phase_prep(const Frame& F, const Args& a, int l, int part = 0) {
    LAS float* scr = (LAS float*)(F.lds + F.wave * 16384);
    const int gw = F.bid * 8 + F.wave, NGW = F.G * 8; int cursor = 0;
    unsigned char* ws = a.ws;
    if (part != 1) {
        transpose_mat((const float*)a.in[31] + (size_t)l * D * D, D, D, (bf16_t*)(ws + W_GATE), D, 0, scr, F.lane, cursor, gw, NGW);
        transpose_mat((const float*)a.in[33] + (size_t)l * PLE * D, PLE, D, (bf16_t*)(ws + W_PROJ), PLE, 0, scr, F.lane, cursor, gw, NGW);
        const size_t gt = (size_t)F.bid * 512 + F.tid, NT = (size_t)F.G * 512;
        const f32x4* p4 = (const f32x4*)((const float*)a.in[1] + (size_t)l * T * PLE); u32x2* pb = (u32x2*)(ws + WS_PB);
        for (size_t i = gt; i < (size_t)T * PLE / 4; i += 4 * NT) { f32x4 v[4];
#pragma unroll
            for (int q = 0; q < 4; ++q) { const size_t ii = i + q * NT; v[q] = (ii < (size_t)T * PLE / 4) ? p4[ii] : (f32x4){0.f, 0.f, 0.f, 0.f}; }
#pragma unroll
            for (int q = 0; q < 4; ++q) { const size_t ii = i + q * NT; if (ii < (size_t)T * PLE / 4) { u32x2 w; w.x = cvt_pk_bf16(v[q][0], v[q][1]); w.y = cvt_pk_bf16(v[q][2], v[q][3]); pb[ii] = w; } } }
    }
    if (part != 1) {
        const int j2 = l >> 1;
        if ((l & 1) == 0) transpose_mat((const float*)a.in[26] + (size_t)j2 * DFF * D, DFF, D, (bf16_t*)(ws + W_DN), DFF, 0, scr, F.lane, cursor, gw, NGW);
        else for (int e = 0; e < NEXP; ++e) { const size_t eo = (size_t)j2 * NEXP + e;
            transpose_mat((const float*)a.in[30] + eo * DFE * D, DFE, D, (bf16_t*)(ws + W_DN) + (size_t)e * D * DFE, DFE, 0, scr, F.lane, cursor, gw, NGW); }
    }
    if (part == 2) return;
    transpose_mat((const float*)a.in[3] + (size_t)l * D * INW, D, INW, (bf16_t*)(ws + W_IN), D, 3, scr, F.lane, cursor, gw, NGW);
    transpose_mat((const float*)a.in[4] + (size_t)l * D * D, D, D, (bf16_t*)(ws + W_OUT), D, 0, scr, F.lane, cursor, gw, NGW);
    for (int j = 0; j < 2; ++j) { const float* w1 = (const float*)a.in[6] + ((size_t)l * 2 + j) * 2048 * 256; bf16_t* dst = (bf16_t*)(ws + W_CMP) + (size_t)j * 512 * 1024;
        transpose_mat(w1, 1024, 256, dst, 1024, 0, scr, F.lane, cursor, gw, NGW);
        transpose_mat(w1 + (size_t)1024 * 256, 1024, 256, dst + (size_t)256 * 1024, 1024, 0, scr, F.lane, cursor, gw, NGW); }
    transpose_mat((const float*)a.in[22] + (size_t)l * 256 * 256, 256, 256, (bf16_t*)(ws + W_GLU), 256, 0, scr, F.lane, cursor, gw, NGW);
    const int j2 = l >> 1;
    if ((l & 1) == 0) {
        transpose_mat((const float*)a.in[24] + (size_t)j2 * D * DFF, D, DFF, (bf16_t*)(ws + W_UP), D, 1, scr, F.lane, cursor, gw, NGW);
        transpose_mat((const float*)a.in[25] + (size_t)j2 * D * DFF, D, DFF, (bf16_t*)(ws + W_UP), D, 2, scr, F.lane, cursor, gw, NGW);
    } else {
        for (int e = 0; e < NEXP; ++e) { const size_t eo = (size_t)j2 * NEXP + e;
            transpose_mat((const float*)a.in[28] + eo * D * DFE, D, DFE, (bf16_t*)(ws + W_UP) + (size_t)e * 2 * DFE * D, D, 1, scr, F.lane, cursor, gw, NGW);
            transpose_mat((const float*)a.in[29] + eo * D * DFE, D, DFE, (bf16_t*)(ws + W_UP) + (size_t)e * 2 * DFE * D, D, 2, scr, F.lane, cursor, gw, NGW); }
    }
    const size_t gt = (size_t)F.bid * 512 + F.tid, NT = (size_t)F.G * 512;
    {
        u32x4* zp = (u32x4*)((bf16_t*)(ws + W_IN) + (size_t)INW * D); const size_t n16 = (size_t)(INP - INW) * D * 2 / 16;
        unsigned zz = 0u; asm volatile("" : "+v"(zz));
        for (size_t i = gt; i < n16; i += NT) zp[i] = (u32x4){zz, zz, zz, zz};
    }
    {
        const float* ktab = (const float*)(ws + SM_KTAB) + (size_t)l * 16 * 32 * 256; const f32x2* apow = (const f32x2*)(ws + SM_APOW) + (size_t)l * 16 * 64 * 34; const f32x2* bbar = (const f32x2*)(ws + SM_BBAR) + (size_t)l * 16 * 64 * 16;
        const float* cre = (const float*)a.in[19] + (size_t)l * 16 * 16 * 64; const float* cim = (const float*)a.in[20] + (size_t)l * 16 * 16 * 64;
        bf16_t* Bt = (bf16_t*)(ws + W_S5B);
        for (size_t i = gt; i < (size_t)16 * 512 * S5K; i += NT) { const int k = (int)(i % S5K), row = (int)((i / S5K) & 511), g = (int)(i / ((size_t)S5K * 512)); const int jo = row >> 4, co = row & 15;
            float v;
            if (k < 512) { const int ji = k >> 4, ci = k & 15; v = (jo >= ji) ? ktab[(((size_t)g * 32 + (jo - ji)) * 16 + co) * 16 + ci] : 0.f; }
            else { const int n = (k - 512) & 63; const f32x2 P = apow[((size_t)g * 64 + n) * 34 + jo + 1]; const float cr = cre[((size_t)g * 16 + co) * 64 + n], cm = cim[((size_t)g * 16 + co) * 64 + n];
                v = (k < 576) ? (cr * P.x - cm * P.y) : -(cr * P.y + cm * P.x); }
            Bt[i] = f2bf(v); }
        bf16_t* St = (bf16_t*)(ws + W_S5S);
        for (size_t i = gt; i < (size_t)16 * 256 * 512; i += NT) { const int k = (int)(i & 511), np = (int)((i >> 9) & 255), g = (int)(i >> 17); const int j = k >> 4, ci = k & 15;
            float v = 0.f;
            if (np < 128) { const int n = np & 63; const f32x2 P = apow[((size_t)g * 64 + n) * 34 + (S5LC - 1 - j)], Bb = bbar[((size_t)g * 64 + n) * 16 + ci]; v = (np < 64) ? (P.x * Bb.x - P.y * Bb.y) : (P.x * Bb.y + P.y * Bb.x); }
            St[i] = f2bf(v); }
    }
    {
        float* cb = (float*)(ws + SM_CMPB); LAS float* red = (LAS float*)(F.lds + 8 * 16384 - 4096);
        for (int o = F.bid; o < 8; o += F.G) { const int j = o >> 2, cblk = o & 3; const float* w1 = (const float*)a.in[6] + ((size_t)l * 2 + j) * 2048 * 256 + cblk * 64 + F.lane; const float* pe = (const float*)a.in[5] + ((size_t)l * 2 + j) * 2048;
            float s0 = 0.f, s1 = 0.f, s2 = 0.f, s3 = 0.f;
#pragma unroll 4
            for (int k = 256 * F.wave; k < 256 * F.wave + 256; k += 4) { s0 += pe[k] * w1[(size_t)k * 256]; s1 += pe[k + 1] * w1[(size_t)(k + 1) * 256]; s2 += pe[k + 2] * w1[(size_t)(k + 2) * 256]; s3 += pe[k + 3] * w1[(size_t)(k + 3) * 256]; }
            __syncthreads(); red[F.wave * 64 + F.lane] = (s0 + s1) + (s2 + s3); __syncthreads();
            if (F.wave == 0) { float t = ((const float*)a.in[7])[((size_t)l * 2 + j) * 256 + cblk * 64 + F.lane];
#pragma unroll
                for (int w = 0; w < 8; ++w) t += red[w * 64 + F.lane];
                cb[j * 256 + cblk * 64 + F.lane] = t; }
            __syncthreads(); }
    }
}

__device__ __forceinline__ void conv_items(const Frame& F, const Args& a, int l, int first, int stride, int last = NB * (SEQ / 32)) {
    const bf16_t* z = (const bf16_t*)(a.ws + WS_Z); bf16_t* mix = (bf16_t*)(a.ws + WS_MIX);
    const float* cw = (const float*)a.in[10] + (size_t)l * 31 * 256; const float* cb = (const float*)a.in[11] + (size_t)l * 256;
    const float* lg = (const float*)a.in[12] + (size_t)l * 256; const float* lb = (const float*)a.in[13] + (size_t)l * 256;
    LAS float* U = (LAS float*)F.lds;
    LAS float* Y = (LAS float*)(F.lds + 65536);
    const int cp = F.tid & 127, tg = F.tid >> 7, c = 2 * cp;
    f32x2 w[31];
#pragma unroll
    for (int j = 0; j < 31; ++j) w[j] = *(const f32x2*)(cw + j * 256 + c);
    const f32x2 bias = *(const f32x2*)(cb + c);
    unsigned pva[16], pvg[16];
    auto fetch = [&](int it) { const int b = it >> 7, t0 = (it & 127) * 32;
#pragma unroll
        for (int q = 0; q < 16; ++q) { const int r = tg + 4 * q, t = t0 - 30 + r; pva[q] = 0u; pvg[q] = 0u;
            if (r < 62 && t >= 0) { const bf16_t* zr = z + ((size_t)b * SEQ + t) * INP + ZC; pva[q] = *(const unsigned*)(zr + c); pvg[q] = *(const unsigned*)(zr + 256 + c); } } };
    if (first < last) fetch(first);
    for (int it = first; it < last; it += stride) { const int b = it >> 7, t0 = (it & 127) * 32;
#pragma unroll
        for (int q = 0; q < 16; ++q) { const int r = tg + 4 * q, t = t0 - 30 + r;
            if (r < 62) { f32x2 u = (f32x2){0.f, 0.f}; if (t >= 0) u = (f32x2){bflo(pva[q]) * sigmoidf_(bflo(pvg[q])), bfhi(pva[q]) * sigmoidf_(bfhi(pvg[q]))};
                *(LAS f32x2*)(U + r * 256 + c) = u; } }
        if (it + stride < last) fetch(it + stride);
        __syncthreads();
        {   f32x2 acc[8];
#pragma unroll
            for (int i = 0; i < 8; ++i) acc[i] = bias;
#pragma unroll
            for (int k = 0; k < 38; ++k) { const f32x2 u = *(const LAS f32x2*)(U + (tg * 8 + k) * 256 + c);
#pragma unroll
                for (int i = 0; i < 8; ++i) { const int j = k - i; if (j >= 0 && j < 31) acc[i] += w[j] * u; } }
#pragma unroll
            for (int i = 0; i < 8; ++i) *(LAS f32x2*)(Y + (tg * 8 + i) * 256 + c) = acc[i];
        }
        __syncthreads();
        for (int i = 0; i < 4; ++i) { const int tl = F.wave * 4 + i; const f32x4 v = *(const LAS f32x4*)(Y + tl * 256 + F.lane * 4);
            const float mean = wave_sum((v[0] + v[1]) + (v[2] + v[3])) * (1.f / 256.f); const f32x4 dlt = v - mean;
            const float var = wave_sum((dlt[0] * dlt[0] + dlt[1] * dlt[1]) + (dlt[2] * dlt[2] + dlt[3] * dlt[3])) * (1.f / 256.f); const float rstd = 1.0f / sqrtf(var + LN_EPS);
            const f32x4 gg = *(const f32x4*)(lg + F.lane * 4), bb = *(const f32x4*)(lb + F.lane * 4);
            float o[4];
#pragma unroll
            for (int e = 0; e < 4; ++e) o[e] = siluf_(dlt[e] * rstd * gg[e] + bb[e]);
            u32x2 wv; wv.x = cvt_pk_bf16(o[0], o[1]); wv.y = cvt_pk_bf16(o[2], o[3]);
            *(u32x2*)(mix + ((size_t)b * SEQ + t0 + tl) * 1024 + 512 + F.lane * 4) = wv; }
        __syncthreads();
    }
}
__device__ __forceinline__ void cmp_stage2(const Frame& F, const Args& a, int l) {
    unsigned char* ws = a.ws; const float* cb = (const float*)(ws + SM_CMPB);
    LAS float* w2s = (LAS float*)F.lds;
    LAS float* hs = (LAS float*)(F.lds + 65536 + F.wave * 1024);
    const int gw = F.bid * 8 + F.wave, NGW = F.G * 8, lane = F.lane;
    for (int j = 0; j < 2; ++j) {
        const float* w2 = (const float*)a.in[8] + ((size_t)l * 2 + j) * 256 * 64; const float* b2 = (const float*)a.in[9] + ((size_t)l * 2 + j) * 64;
        __syncthreads();
        for (int i = F.tid; i < 256 * 64 / 4; i += 512) *(LAS f32x4*)(w2s + 4 * i) = *(const f32x4*)(w2 + 4 * i);
        __syncthreads();
        for (int it = gw; it < 32 * 256; it += NGW) { const int bh = it >> 8, n = it & 255;
            float outv = 0.f;
            if (n < NCMP) {
                const float* P = (const float*)(ws + WS_CMPP) + (size_t)j * 8192 * 512 + ((size_t)bh * 256 + n) * 512;
                const f32x4 p0 = *(const f32x4*)(P + lane * 4), p1 = *(const f32x4*)(P + 512 + 256 + lane * 4), bb = *(const f32x4*)(cb + j * 256 + lane * 4);
                f32x4 hv;
#pragma unroll
                for (int e = 0; e < 4; ++e) hv[e] = gelu_tanh(p0[e] + p1[e] + bb[e]);
                *(LAS f32x4*)(hs + lane * 4) = hv; LDS_WAIT(); asm volatile("" ::: "memory");
                float acc0 = b2[lane], acc1 = 0.f, acc2 = 0.f, acc3 = 0.f;
#pragma unroll 4
                for (int c = 0; c < 256; c += 4) { const f32x4 h4 = *(const LAS f32x4*)(hs + c);
                    acc0 += h4[0] * w2s[c * 64 + lane]; acc1 += h4[1] * w2s[(c + 1) * 64 + lane]; acc2 += h4[2] * w2s[(c + 2) * 64 + lane]; acc3 += h4[3] * w2s[(c + 3) * 64 + lane]; }
                outv = (acc0 + acc1) + (acc2 + acc3); LDS_WAIT(); asm volatile("" ::: "memory");
            }
            if (j == 0) ((bf16_t*)(ws + WS_KC))[((size_t)bh * 256 + n) * 64 + lane] = f2bf(outv);
            else ((bf16_t*)(ws + WS_VCT))[((size_t)bh * 4 + (n >> 6)) * 4096 + lane * 64 + nsa::vslot(n & 63)] = f2bf(outv);
        }
    }
    __syncthreads();
}
__device__ __forceinline__ void cmp_stage2_panel(const Frame& F, const Args& a, int l, int j, int bh) {
    constexpr int HP = 528;
    unsigned char* ws = a.ws; const float* cb = (const float*)(ws + SM_CMPB);
    LAS unsigned char* Hs = F.lds;
    LAS unsigned char* Ws = F.lds + 128 * HP;
    const int lane = F.lane, w = F.wave;
    const float* w2 = (const float*)a.in[8] + ((size_t)l * 2 + j) * 256 * 64; const float* b2 = (const float*)a.in[9] + ((size_t)l * 2 + j) * 64;
    const float* Pb = (const float*)(ws + WS_CMPP) + (size_t)j * 8192 * 512 + (size_t)bh * 256 * 512;
    __syncthreads();
    for (int i = F.tid; i < 256 * 64; i += 512) { const int c = i >> 6, d = i & 63; *(LAS bf16_t*)(Ws + d * HP + c * 2) = f2bf(w2[i]); }
    const f32x4 bb = *(const f32x4*)(cb + j * 256 + lane * 4);
    for (int half = 0; half < 2; ++half) {
        __syncthreads();
#pragma unroll 4
        for (int rr = 0; rr < 16; ++rr) { const int r = 16 * w + rr, n = half * 128 + r, n1 = n < 255 ? n + 1 : n;
            const f32x4 p0 = *(const f32x4*)(Pb + (size_t)n * 512 + lane * 4), p1 = *(const f32x4*)(Pb + (size_t)n1 * 512 + 256 + lane * 4);
            u32x2 hv; hv.x = cvt_pk_bf16(gelu_tanh(p0[0] + p1[0] + bb[0]), gelu_tanh(p0[1] + p1[1] + bb[1])); hv.y = cvt_pk_bf16(gelu_tanh(p0[2] + p1[2] + bb[2]), gelu_tanh(p0[3] + p1[3] + bb[3]));
            *(LAS u32x2*)(Hs + r * HP + lane * 8) = hv; }
        __syncthreads();
        f32x4 acc[4];
#pragma unroll
        for (int cbk = 0; cbk < 4; ++cbk) acc[cbk] = (f32x4){0.f, 0.f, 0.f, 0.f};
        const LAS unsigned char* ap = Hs + (16 * w + (lane & 15)) * HP + (lane >> 4) * 16;
        const LAS unsigned char* bp = Ws + (lane & 15) * HP + (lane >> 4) * 16;
#pragma unroll
        for (int ks = 0; ks < 8; ++ks) { const bf16x8 af = *(const LAS bf16x8*)(ap + ks * 64);
#pragma unroll
            for (int cbk = 0; cbk < 4; ++cbk) { const bf16x8 bf = *(const LAS bf16x8*)(bp + cbk * 16 * HP + ks * 64); acc[cbk] = __builtin_amdgcn_mfma_f32_16x16x32_bf16(af, bf, acc[cbk], 0, 0, 0); } }
#pragma unroll
        for (int cbk = 0; cbk < 4; ++cbk) { const int d = 16 * cbk + (lane & 15); const float bv = b2[d];
#pragma unroll
            for (int e = 0; e < 4; ++e) { const int n = half * 128 + 16 * w + 4 * (lane >> 4) + e; const float outv = n < NCMP ? acc[cbk][e] + bv : 0.f;
                if (j == 0) ((bf16_t*)(ws + WS_KC))[((size_t)bh * 256 + n) * 64 + d] = f2bf(outv);
                else ((bf16_t*)(ws + WS_VCT))[((size_t)bh * 4 + (n >> 6)) * 4096 + d * 64 + nsa::vslot(n & 63)] = f2bf(outv); } }
    }
    __syncthreads();
}
__device__ __forceinline__ void s5_carry_panel(const Frame& F, const Args& a, int l, int g, int pm) {
    unsigned char* ws = a.ws; const f32x2* apow = (const f32x2*)(ws + SM_APOW) + (size_t)l * 16 * 64 * 34;
    const float* S = (const float*)(ws + WS_S5S); bf16_t* ap = (bf16_t*)(ws + WS_S5A);
    if (F.tid < 128) { const int n = F.tid & 63, b = 2 * pm + (F.tid >> 6);
        const f32x2 A = apow[((size_t)g * 64 + n) * 34 + S5LC]; float hr = 0.f, hi = 0.f;
        const float* sp = S + ((size_t)g * 2048 + b * 128) * 256 + n; bf16_t* dp = ap + ((size_t)g * 2048 + b * 128) * S5K + 512 + n;
        for (int c0 = 0; c0 < S5NCH; c0 += 8) { float sr[8], si[8];
#pragma unroll
            for (int k = 0; k < 8; ++k) { sr[k] = sp[(size_t)(c0 + k) * 256]; si[k] = sp[(size_t)(c0 + k) * 256 + 64]; }
#pragma unroll
            for (int k = 0; k < 8; ++k) { dp[(size_t)(c0 + k) * S5K] = f2bf(hr); dp[(size_t)(c0 + k) * S5K + 64] = f2bf(hi);
                const float nr = A.x * hr - A.y * hi + sr[k], ni = A.x * hi + A.y * hr + si[k]; hr = nr; hi = ni; } }
    }
}
__device__ __forceinline__ void s5_carry(const Frame& F, const Args& a, int l) {
    unsigned char* ws = a.ws; const f32x2* apow = (const f32x2*)(ws + SM_APOW) + (size_t)l * 16 * 64 * 34;
    const float* S = (const float*)(ws + WS_S5S); bf16_t* ap = (bf16_t*)(ws + WS_S5A);
    const int gt = F.bid * 512 + F.tid, NT = F.G * 512;
    for (int i = gt; i < 16 * NB * 64; i += NT) { const int n = i & 63, b = (i >> 6) & 15, g = i >> 10;
        const f32x2 A = apow[((size_t)g * 64 + n) * 34 + S5LC]; float hr = 0.f, hi = 0.f;
        const float* sp = S + ((size_t)g * 2048 + b * 128) * 256 + n; bf16_t* dp = ap + ((size_t)g * 2048 + b * 128) * S5K + 512 + n;
        for (int c0 = 0; c0 < S5NCH; c0 += 8) { float sr[8], si[8];
#pragma unroll
            for (int k = 0; k < 8; ++k) { sr[k] = sp[(size_t)(c0 + k) * 256]; si[k] = sp[(size_t)(c0 + k) * 256 + 64]; }
#pragma unroll
            for (int k = 0; k < 8; ++k) { dp[(size_t)(c0 + k) * S5K] = f2bf(hr); dp[(size_t)(c0 + k) * S5K + 64] = f2bf(hi);
                const float nr = A.x * hr - A.y * hi + sr[k], ni = A.x * hi + A.y * hr + si[k]; hr = nr; hi = ni; } }
    }
}
template <int MODE, bool ROUTE, bool FINAL>
__device__ __forceinline__ void ln_panel(const Frame& F, const Args& a, int pm, const float* gain, const float* beta, const float* router, size_t h_off = WS_HBUF) {
    unsigned char* ws = a.ws; float* xout = a.out; bf16_t* xb = (bf16_t*)(ws + WS_XB);
    const bf16_t* hb = (const bf16_t*)(ws + (MODE == 0 ? h_off : WS_YB)); const f32x2* tokw = (const f32x2*)(ws + SM_TOKW);
    LAS int* cnt = (LAS int*)F.lds;
    const int lane = F.lane;
    f32x4 gv[4], bv[4];
#pragma unroll
    for (int j = 0; j < 4; ++j) { gv[j] = *(const f32x4*)(gain + 4 * lane + 256 * j); bv[j] = *(const f32x4*)(beta + 4 * lane + 256 * j); }
    if (ROUTE) { if (F.tid < 8) cnt[F.tid] = 0; __syncthreads(); }
    u32x2 nx[4], nh0[4], nh1[4]; f32x2 nw = (f32x2){0.f, 0.f};
    { const size_t row = (size_t)pm * 256 + F.wave * 32; if (MODE == 1) nw = tokw[row];
#pragma unroll
      for (int j = 0; j < 4; ++j) { nx[j] = *(const u32x2*)(xb + row * D + 4 * lane + 256 * j);
          if (MODE == 0) { nh0[j] = *(const u32x2*)(hb + row * D + 4 * lane + 256 * j); nh1[j] = nh0[j]; } else { nh0[j] = *(const u32x2*)(hb + (2 * row) * D + 4 * lane + 256 * j); nh1[j] = *(const u32x2*)(hb + (2 * row + 1) * D + 4 * lane + 256 * j); } } }
    for (int i = 0; i < 32; ++i) { const size_t row = (size_t)pm * 256 + F.wave * 32 + i;
        f32x4 v[4]; float s = 0.f;
        u32x2 cx[4], ch0[4], ch1[4]; const f32x2 w01 = nw;
#pragma unroll
        for (int j = 0; j < 4; ++j) { cx[j] = nx[j]; ch0[j] = nh0[j]; ch1[j] = nh1[j]; }
        if (i < 31) { const size_t rn = row + 1; if (MODE == 1) nw = tokw[rn];
#pragma unroll
            for (int j = 0; j < 4; ++j) { nx[j] = *(const u32x2*)(xb + rn * D + 4 * lane + 256 * j);
                if (MODE == 0) { nh0[j] = *(const u32x2*)(hb + rn * D + 4 * lane + 256 * j); nh1[j] = nh0[j]; } else { nh0[j] = *(const u32x2*)(hb + (2 * rn) * D + 4 * lane + 256 * j); nh1[j] = *(const u32x2*)(hb + (2 * rn + 1) * D + 4 * lane + 256 * j); } } }
#pragma unroll
        for (int j = 0; j < 4; ++j) { const u32x2 xq = cx[j]; const f32x4 xv = (f32x4){bflo(xq.x), bfhi(xq.x), bflo(xq.y), bfhi(xq.y)}; f32x4 hv;
            if (MODE == 0) { const u32x2 q = ch0[j]; hv = (f32x4){bflo(q.x), bfhi(q.x), bflo(q.y), bfhi(q.y)}; }
            else { const u32x2 q0 = ch0[j], q1 = ch1[j];
                hv = (f32x4){w01.x * bflo(q0.x) + w01.y * bflo(q1.x), w01.x * bfhi(q0.x) + w01.y * bfhi(q1.x), w01.x * bflo(q0.y) + w01.y * bflo(q1.y), w01.x * bfhi(q0.y) + w01.y * bfhi(q1.y)}; }
            v[j] = xv * ALPHA + hv; s += (v[j][0] + v[j][1]) + (v[j][2] + v[j][3]); }
        const float mean = wave_sum(s) * (1.f / D); float s2 = 0.f;
#pragma unroll
        for (int j = 0; j < 4; ++j) { v[j] = v[j] - mean; s2 += (v[j][0] * v[j][0] + v[j][1] * v[j][1]) + (v[j][2] * v[j][2] + v[j][3] * v[j][3]); }
        const float rstd = 1.0f / sqrtf(wave_sum(s2) * (1.f / D) + LN_EPS);
#pragma unroll
        for (int j = 0; j < 4; ++j) { v[j] = v[j] * rstd * gv[j] + bv[j];
            if (FINAL) *(f32x4*)(xout + row * D + 4 * lane + 256 * j) = v[j];
            u32x2 w; w.x = cvt_pk_bf16(v[j][0], v[j][1]); w.y = cvt_pk_bf16(v[j][2], v[j][3]); *(u32x2*)(xb + row * D + 4 * lane + 256 * j) = w; }
        if (ROUTE) {
            float lg[8];
#pragma unroll
            for (int e = 0; e < 8; ++e) lg[e] = 0.f;
#pragma unroll
            for (int j = 0; j < 4; ++j)
#pragma unroll
                for (int k = 0; k < 4; ++k) { const float* rr = router + (size_t)(4 * lane + 256 * j + k) * 8; const f32x4 r0 = *(const f32x4*)rr, r1 = *(const f32x4*)(rr + 4); const float xv = v[j][k];
                    lg[0] += xv * r0[0]; lg[1] += xv * r0[1]; lg[2] += xv * r0[2]; lg[3] += xv * r0[3]; lg[4] += xv * r1[0]; lg[5] += xv * r1[1]; lg[6] += xv * r1[2]; lg[7] += xv * r1[3]; }
            {
                const bool h5 = (lane & 32) != 0, h4 = (lane & 16) != 0, h3 = (lane & 8) != 0;
                float r4[4], r2[2], r1;
#pragma unroll
                for (int i = 0; i < 4; ++i) { const float send = h5 ? lg[i] : lg[4 + i], mine = h5 ? lg[4 + i] : lg[i]; r4[i] = mine + xshfl<32>(send); }
#pragma unroll
                for (int i = 0; i < 2; ++i) { const float send = h4 ? r4[i] : r4[2 + i], mine = h4 ? r4[2 + i] : r4[i]; r2[i] = mine + xshfl<16>(send); }
                { const float send = h3 ? r2[0] : r2[1], mine = h3 ? r2[1] : r2[0]; r1 = mine + xshfl<8>(send); }
                r1 += xshfl<4>(r1); r1 += xshfl<2>(r1); r1 += xshfl<1>(r1);
#pragma unroll
                for (int e = 0; e < 8; ++e) lg[e] = __builtin_bit_cast(float, __builtin_amdgcn_readlane(__builtin_bit_cast(int, r1), 8 * e));
            }
            int e0 = 0; float m0 = lg[0];
#pragma unroll
            for (int e = 1; e < 8; ++e) if (lg[e] > m0) { m0 = lg[e]; e0 = e; }
            int e1 = -1; float m1 = -3.0e38f;
#pragma unroll
            for (int e = 0; e < 8; ++e) if (e != e0 && lg[e] > m1) { m1 = lg[e]; e1 = e; }
            const float w0 = 1.0f / (1.0f + __expf(m1 - m0));
            if (lane == 0) { ((int*)(ws + SM_TOKE))[row] = e0 | (e1 << 8); ((f32x2*)(ws + SM_TOKW))[row] = (f32x2){w0, 1.0f - w0}; __hip_atomic_fetch_add(&cnt[e0], 1, __ATOMIC_RELAXED, __HIP_MEMORY_SCOPE_WORKGROUP); __hip_atomic_fetch_add(&cnt[e1], 1, __ATOMIC_RELAXED, __HIP_MEMORY_SCOPE_WORKGROUP); }
        }
    }
    if (ROUTE) { __syncthreads(); if (F.tid < 8) ((int*)(ws + SM_PCNT))[pm * 8 + F.tid] = cnt[F.tid]; __syncthreads(); }
}
__device__ __forceinline__ void moe_gather(const Frame& F, const Args& a) {
    unsigned char* ws = a.ws; const int* pcnt = (const int*)(ws + SM_PCNT); const int* toke = (const int*)(ws + SM_TOKE);
    int* rowtok = (int*)(ws + SM_ROWTOK); int* tileexp = (int*)(ws + SM_TILEEXP);
    const bf16_t* xb = (const bf16_t*)(ws + WS_XB); bf16_t* xs = (bf16_t*)(ws + WS_XS);
    LAS int* sm = (LAS int*)F.lds;
    for (int pm = F.bid; pm < T / 256; pm += F.G) {
        for (int q = F.tid; q < (T / 256) * 8; q += 512) sm[1024 + q] = pcnt[q];
        if (F.tid >= 32 && F.tid < 288) sm[F.tid] = toke[pm * 256 + F.tid - 32];
        __syncthreads();
        if (F.tid < 8) { int tot = 0, before = 0; for (int q = 0; q < T / 256; ++q) { const int c = sm[1024 + q * 8 + F.tid]; tot += c; if (q < pm) before += c; } sm[F.tid] = tot; sm[16 + F.tid] = before; }
        __syncthreads();
        if (F.tid == 0) { int st = 0; for (int e = 0; e < 8; ++e) { sm[8 + e] = st * 256; st += (sm[e] + 255) >> 8; } sm[24] = st; }
        __syncthreads();
        {
            const int i = F.tid >> 1, k = F.tid & 1; const int ee = sm[32 + i]; const int e = k ? (ee >> 8) : (ee & 255);
            int cntb = 0; for (int q = 0; q < i; ++q) { const int o = sm[32 + q]; cntb += ((o & 255) == e) + ((o >> 8) == e); }
            const int dest = sm[8 + e] + sm[16 + e] + cntb; sm[512 + F.tid] = dest; rowtok[dest] = 2 * (pm * 256 + i) + k;
        }
        __syncthreads();
        for (int r0 = F.wave * 64; r0 < F.wave * 64 + 64; r0 += 8) {
            u32x4 va[8], vb[8];
#pragma unroll
            for (int q = 0; q < 8; ++q) { const size_t tok = (size_t)pm * 256 + ((r0 + q) >> 1); const u32x4* s = (const u32x4*)(xb + tok * D); va[q] = s[F.lane]; vb[q] = s[64 + F.lane]; }
#pragma unroll
            for (int q = 0; q < 8; ++q) { const int dest = sm[512 + r0 + q]; u32x4* d = (u32x4*)(xs + (size_t)dest * D); d[F.lane] = va[q]; d[64 + F.lane] = vb[q]; } }
        if (pm == 0) {
            for (int e = 0; e < 8; ++e) { const int r0 = sm[8 + e] + sm[e], r1 = sm[8 + e] + (((sm[e] + 255) >> 8) << 8); for (int r = r0 + F.tid; r < r1; r += 512) rowtok[r] = -1;
                const int t0 = sm[8 + e] >> 8, t1 = r1 >> 8; for (int t = t0 + F.tid; t < t1; t += 512) tileexp[t] = e; }
            if (F.tid == 0) tileexp[1023] = sm[24];
        }
        __syncthreads();
    }
}

__device__ __forceinline__ void moe_tail_finalize(const Frame& F, const Args& a) {
    const int* tileexp = (const int*)(a.ws + SM_TILEEXP); int nt = tileexp[1023] - (MOE_NCHUNK - 1) * MOE_CHUNK_TILES; nt = nt < 0 ? 0 : (nt > 8 ? 8 : nt);
    const float* YT = (const float*)(a.ws + WS_XS); const int* row_tok = (const int*)(a.ws + SM_ROWTOK) + (MOE_NCHUNK - 1) * MOE_CHUNK_TILES * 256; bf16_t* Y = (bf16_t*)(a.ws + WS_YB);
    const int c8 = (F.tid & 127) * 8;
    for (int r = F.bid * 4 + (F.tid >> 7); r < nt * 256; r += F.G * 4) { const int dst = row_tok[r]; if (dst < 0) continue;
        f32x4 s0 = (f32x4){0.f, 0.f, 0.f, 0.f}, s1 = s0;
#pragma unroll
        for (int ks = 0; ks < 7; ++ks) { const float* p = YT + ((size_t)ks * 2048 + r) * D + c8; s0 += *(const f32x4*)p; s1 += *(const f32x4*)(p + 4); }
        u32x4 w; w.x = cvt_pk_bf16(s0[0], s0[1]); w.y = cvt_pk_bf16(s0[2], s0[3]); w.z = cvt_pk_bf16(s1[0], s1[1]); w.w = cvt_pk_bf16(s1[2], s1[3]);
        *(u32x4*)(Y + (size_t)dst * D + c8) = w; }
}
struct MoeUpOrder { int ntile, G, c, chunk; const int* tileexp;
    __device__ __forceinline__ bool next(int i, pg8::Unit& u) const { if (!pg8::static_tile(i, G, c, ntile, 2 * DFE / 256, u.pm, u.pn)) return false;
        const int tile = chunk * MOE_CHUNK_TILES + u.pm, e = tileexp[tile]; u.aux = tile; u.offA = (long long)tile * 256 * D * 2; u.offB = ((long long)e * 2 * DFE + (long long)u.pn * 256) * D * 2; return true; } };
struct MoeDnOrder { int ntile, G, c, chunk; const int* tileexp;
    __device__ __forceinline__ bool next(int i, pg8::Unit& u) const { if (!pg8::static_tile(i, G, c, ntile, D / 256, u.pm, u.pn)) return false;
        const int tile = chunk * MOE_CHUNK_TILES + u.pm, e = tileexp[tile]; u.aux = tile; u.offA = (long long)u.pm * 256 * DFE * 2; u.offB = ((long long)e * D + (long long)u.pn * 256) * DFE * 2; return true; } };

struct MoeDnTailOrder { int ntile, G, c; const int* tileexp;
    __device__ __forceinline__ bool next(int i, pg8::Unit& u) const { const long L = (long)i * G + c; if (L >= (long)ntile * 28) return false;
        const int ks = (int)(L % 7), rest = (int)(L / 7); u.pn = rest & 3; u.pm = rest >> 2; u.aux = ks;
        const int tile = (MOE_NCHUNK - 1) * MOE_CHUNK_TILES + u.pm, e = tileexp[tile];
        u.offA = (long long)u.pm * 256 * DFE * 2 + (long long)ks * 512 * 2; u.offB = ((long long)e * D + (long long)u.pn * 256) * DFE * 2 + (long long)ks * 512 * 2; return true; } };

enum { PH_PREP = 0, PH_WIN, PH_POST, PH_MIX1, PH_MIX2, PH_MIX3, PH_MIX4, PH_WOUT, PH_LN1, PH_FUP, PH_FDN, PH_MGATH = 9, PH_MUP0 = 10, PH_LN2 = 21, PH_PGATE, PH_PPROJ, PH_LN3, PH_PER_LAYER = 32 };
constexpr int GP_END = 2 + 32 * DEPTH;

__global__ void __launch_bounds__(512, 2) mk_fwd(Args a0) {
    extern __shared__ __attribute__((aligned(16))) unsigned char lds_raw[];
    LAS unsigned char* const lds = (LAS unsigned char*)lds_raw;
    for (int u = threadIdx.x; u < (LDS_BYTES - LDSCTL_OFF) / 4; u += 512) ((LAS unsigned*)(lds + LDSCTL_OFF))[u] = 0u;
    __syncthreads();
    const int gp_lo = a0.gp_lo, gp_hi = a0.gp_hi; const int F0bid = blockIdx.x, F0G = gridDim.x; const int wave0 = __builtin_amdgcn_readfirstlane(threadIdx.x >> 6);
    XcdBarrier bar; bar.bar = (unsigned*)(a0.ws + WS_CTL) + CW_BAR; bar.x = 0; bar.st = nullptr;
    if (a0.use_bar) bar = xcd_barrier_post((unsigned*)(a0.ws + WS_CTL) + CW_BAR, (volatile LAS unsigned*)(lds + LDSCTL_OFF + 32));
#if MK_PROBE
#define PRW ((volatile LAS unsigned*)(lds + LDSCTL_OFF + 128))
    if (threadIdx.x == 0) { const unsigned long long t_ = __builtin_amdgcn_s_memrealtime(); PRW[0] = (unsigned)t_; PRW[1] = (unsigned)(t_ >> 32); PRW[2] = 0u; PRW[3] = 0u; PRW[4] = (unsigned)t_; PRW[5] = (unsigned)(t_ >> 32); }
#define STAMP(cls) do { if (wave0 == 0 && lane_id_fresh() == 0) { const unsigned long long t_ = __builtin_amdgcn_s_memrealtime(); const unsigned long long p_ = ((unsigned long long)PRW[1] << 32) | PRW[0]; const unsigned d_ = (unsigned)(t_ - p_); \
        PRW[0] = (unsigned)t_; PRW[1] = (unsigned)(t_ >> 32); if ((PROBE_A >> (cls)) & 1) PRW[2] += d_; if ((PROBE_B >> (cls)) & 1) PRW[3] += d_; } } while (0)
#else
#define STAMP(cls) do {} while (0)
#endif
#define RUN(gp) (gp_lo <= (gp) && (gp) < gp_hi)
#define SEAM(gp) do { if (gp_lo <= (gp) && (gp) + 1 < gp_hi) xcd_barrier(bar, wave0); } while (0)
#define PH_BEGIN Args a; load_args(a); const Frame F = make_frame(lds, wave0); unsigned char* const ws = a.ws; int l = lx; asm volatile("" : "+s"(l)); (void)l; (void)ws; \
    bf16_t* const xb = (bf16_t*)(ws + WS_XB); bf16_t* const z = (bf16_t*)(ws + WS_Z); bf16_t* const mix = (bf16_t*)(ws + WS_MIX); bf16_t* const hbuf = (bf16_t*)(ws + WS_HBUF); const long long S1K = 256ll * 1024 * 2; \
    (void)xb; (void)z; (void)mix; (void)hbuf; (void)S1K;
#define AP_DEF const nsa::Lane L{F.lane, F.lane & 31, F.lane >> 5, F.wave, F.tid}; \
    const nsa::AttnPtrs AP{(const bf16_t*)(ws + WS_Q), z, (const bf16_t*)(ws + WS_KC), (const bf16_t*)(ws + WS_VCT), (const bf16_t*)(ws + WS_KSEL), (const bf16_t*)(ws + WS_VSEL), \
                           (const bf16_t*)(ws + WS_KWIN), (const bf16_t*)(ws + WS_VWIN), (unsigned long long*)(ws + WS_SELM), mix};
    { const int lx = 0;
    if (RUN(0)) { PH_BEGIN phase_init0(F, a); }
    SEAM(0); STAMP(0);
    if (RUN(1)) { PH_BEGIN phase_init1(F, a); }
    SEAM(1); STAMP(0);
    }
    for (int lx = 0; lx < DEPTH; ++lx) {
        const int base = 2 + PH_PER_LAYER * lx; const bool moe = (lx & 1) != 0;
        if (lx == 0) {
            if (RUN(base + PH_PREP)) { PH_BEGIN phase_prep(F, a, l); }
            SEAM(base + PH_PREP); STAMP(1);
        }
        if (RUN(base + PH_WIN)) {
            {   PH_BEGIN
                pg8::Gemm g{xb, (const bf16_t*)(ws + W_IN), D, D, D}; pg8::PlainOrder S{T / 256, INP / 256, F.G, F.bid, S1K, S1K};
                epi::EpiWin E{z, (bf16_t*)(ws + WS_Q), (bf16_t*)(ws + WS_KCMP), (bf16_t*)(ws + WS_S5A), (const f32x2*)(ws + WS_ROPE)};
                pg8::gemm_phase(F.lds, g, S, E, F.tid);
            }
            if (lx > 0) { __syncthreads(); PH_BEGIN phase_prep(F, a, l, 2); }
        }
        SEAM(base + PH_WIN); STAMP(2);
        if (RUN(base + PH_MIX1)) {
            for (int r = F0bid; r < 128; r += F0G) {
                {   PH_BEGIN const int g_ = r >> 3, pm_ = r & 7;
                    pg8::Gemm g{(const bf16_t*)(ws + WS_S5A), (const bf16_t*)(ws + W_S5S), 512, S5K, 512};
                    pg8::ListOrder S{1, pm_, g_, (long long)g_ * 2048 * S5K * 2 + (long long)pm_ * 256 * S5K * 2, (long long)g_ * 256 * 512 * 2, 0}; epi::F32Grouped E{(float*)(ws + WS_S5S), 256, (size_t)2048 * 256};
                    pg8::gemm_phase(F.lds, g, S, E, F.tid); }
                __syncthreads();
                {   PH_BEGIN int nr = MK_REP_CARRY; asm volatile("" : "+s"(nr)); for (int q = 0; q < nr; ++q) s5_carry_panel(F, a, l, r >> 3, r & 7); }
                asm volatile("s_waitcnt vmcnt(0)" ::: "memory"); __syncthreads();
                {   PH_BEGIN const int g_ = r >> 3, pm_ = r & 7;
                    pg8::Gemm g{(const bf16_t*)(ws + WS_S5A), (const bf16_t*)(ws + W_S5B), S5K, S5K, S5K};
                    pg8::ListOrder S{2, pm_, g_, (long long)g_ * 2048 * S5K * 2 + (long long)pm_ * 256 * S5K * 2, (long long)g_ * 512 * S5K * 2, 256ll * S5K * 2}; epi::S5Out E{(bf16_t*)(ws + WS_ZS5), z, (const float*)a.in[21] + (size_t)l * 256};
                    pg8::gemm_phase(F.lds, g, S, E, F.tid); }
            }
            for (int r = F0bid - 128; r < 64; r += F0G) { if (r < 0) continue;
                {   PH_BEGIN const int j_ = r >> 5, bh_ = r & 31;
                    pg8::Gemm g{(const bf16_t*)(ws + WS_KCMP), (const bf16_t*)(ws + W_CMP), 1024, 1024, 1024};
                    pg8::ListOrder S{2, bh_, j_, (long long)j_ * (long long)(WS_VCMP - WS_KCMP) + (long long)bh_ * S1K, (long long)j_ * 512 * 1024 * 2, S1K}; epi::F32Grouped E{(float*)(ws + WS_CMPP), 512, (size_t)8192 * 512};
                    pg8::gemm_phase(F.lds, g, S, E, F.tid); }
                asm volatile("s_waitcnt vmcnt(0)" ::: "memory"); __syncthreads();
                {   PH_BEGIN int nr = MK_REP_ST2; asm volatile("" : "+s"(nr)); for (int q = 0; q < nr; ++q) cmp_stage2_panel(F, a, l, r >> 5, r & 31); }
            }
            {   PH_BEGIN
                if (F.G == 256) { const int c = F.bid; const int beg = c < 128 ? c * 5 : (c < 192 ? 640 + (c - 128) * 6 : 1024 + (c - 192) * 16), cnt = c < 128 ? 5 : (c < 192 ? 6 : 16); conv_items(F, a, l, beg, 1, beg + cnt); }
                else conv_items(F, a, l, F.bid, F.G); }
        }
        SEAM(base + PH_MIX1); STAMP(4);
        if (RUN(base + PH_MIX3)) {
            {   PH_BEGIN
                pg8::Gemm g{(const bf16_t*)(ws + WS_ZS5), (const bf16_t*)(ws + W_GLU), 256, 256, 256};
                pg8::PlainOrder S{T / 256, 1, F.G, F.bid, 256ll * 256 * 2, 256ll * 256 * 2}; epi::S5Glu E{mix, (const bf16_t*)(ws + WS_ZS5), (const float*)a.in[23] + (size_t)l * 256};
                pg8::gemm_phase(F.lds, g, S, E, F.tid);
            }
            {   PH_BEGIN AP_DEF
                for (int p = F.bid; p < 32 * 16; p += F.G) { const int bh = p >> 4, s = p & 15;
                    for (int half = 0; half < 2; ++half) { const int qb2 = half ? 31 - s : s;
                        nsa::cmp_unit<true>(bh, 2 * qb2, AP, F.lds, L); nsa::cmp_topk(bh, 2 * qb2, AP, F.lds, L);
                        nsa::cmp_unit<false>(bh, 2 * qb2 + 1, AP, F.lds, L); nsa::cmp_topk(bh, 2 * qb2 + 1, AP, F.lds, L); } } }
            asm volatile("s_waitcnt vmcnt(0)" ::: "memory"); __syncthreads();
            {   PH_BEGIN AP_DEF
                for (int p = F.bid; p < 32 * 16; p += F.G) { const int bh = p >> 4, s = p & 15; nsa::sw_unit2(bh, s, AP, F.lds, L); nsa::sw_unit2(bh, 31 - s, AP, F.lds, L); } }
        }
        SEAM(base + PH_MIX3); STAMP(6);

        if (RUN(base + PH_WOUT)) {
            {   PH_BEGIN
                pg8::Gemm g{mix, (const bf16_t*)(ws + W_OUT), D, D, D}; pg8::PlainOrder S{T / 256, D / 256, F.G, F.bid, S1K, S1K}; epi::Bf16Sc1 E{hbuf, D, (unsigned)((size_t)T * D * 2)};
                pg8::gemm_phase(F.lds, g, S, E, F.tid);
            }
            {   PH_BEGIN pg8::PlainOrder S{T / 256, D / 256, F.G, F.bid, S1K, S1K}; panels_publish_wait(F, (unsigned*)(ws + WS_CTL), 2 * l + 0, S, (unsigned)(D / 256)); }
            {   PH_BEGIN
                const float* gg = (const float*)a.in[34] + ((size_t)l * 3 + 0) * D; const float* bb = (const float*)a.in[35] + ((size_t)l * 3 + 0) * D;
                for (int pm = F.bid; pm < T / 256; pm += F.G) { if (l & 1) ln_panel<0, true, false>(F, a, pm, gg, bb, (const float*)a.in[27] + (size_t)(l >> 1) * D * NEXP); else ln_panel<0, false, false>(F, a, pm, gg, bb, nullptr); }
            }
        }
        SEAM(base + PH_WOUT); STAMP(8);
        if (!moe) {
            if (RUN(base + PH_FUP)) { PH_BEGIN
                pg8::Gemm g{xb, (const bf16_t*)(ws + W_UP), D, D, D}; pg8::PlainOrder S{T / 256, 2 * DFF / 256, F.G, F.bid, S1K, S1K}; epi::SwiGlu E{(bf16_t*)(ws + WS_FFH), DFF};
                pg8::gemm_phase(F.lds, g, S, E, F.tid);
            }
            SEAM(base + PH_FUP); STAMP(9);
            if (RUN(base + PH_FDN)) {
                {   PH_BEGIN
                    pg8::Gemm g{(const bf16_t*)(ws + WS_FFH), (const bf16_t*)(ws + W_DN), DFF, DFF, DFF}; pg8::PlainOrder S{T / 256, D / 256, F.G, F.bid, 256ll * DFF * 2, 256ll * DFF * 2}; epi::Bf16Sc1 E{hbuf, D, (unsigned)((size_t)T * D * 2)};
                    pg8::gemm_phase(F.lds, g, S, E, F.tid);
                }
                {   PH_BEGIN pg8::PlainOrder S{T / 256, D / 256, F.G, F.bid, 256ll * DFF * 2, 256ll * DFF * 2}; panels_publish_wait(F, (unsigned*)(ws + WS_CTL), 2 * l + 1, S, (unsigned)(D / 256)); }
                {   PH_BEGIN
                    const float* gg = (const float*)a.in[34] + ((size_t)l * 3 + 1) * D; const float* bb = (const float*)a.in[35] + ((size_t)l * 3 + 1) * D;
                    for (int pm = F.bid; pm < T / 256; pm += F.G) ln_panel<0, false, false>(F, a, pm, gg, bb, nullptr);
                }
            }
            asm volatile("s_waitcnt vmcnt(0)" ::: "memory"); __syncthreads(); STAMP(10);
        } else {
            if (RUN(base + PH_MGATH)) { PH_BEGIN moe_gather(F, a); }
            SEAM(base + PH_MGATH); STAMP(11);
            for (int cx = 0; cx < MOE_NCHUNK; ++cx) {
                if (RUN(base + PH_MUP0 + 2 * cx)) { PH_BEGIN int c = cx; asm volatile("" : "+s"(c)); const int* tileexp = (const int*)(ws + SM_TILEEXP);
                    int nt = tileexp[1023] - c * MOE_CHUNK_TILES; nt = nt < 0 ? 0 : (nt > MOE_CHUNK_TILES ? MOE_CHUNK_TILES : nt);
                    pg8::Gemm g{(const bf16_t*)(ws + WS_XS), (const bf16_t*)(ws + W_UP), D, D, D}; MoeUpOrder S{nt, F.G, F.bid, c, tileexp}; epi::SwiGlu E{(bf16_t*)(ws + WS_MH), DFE};
                    pg8::gemm_phase(F.lds, g, S, E, F.tid);
                }
                SEAM(base + PH_MUP0 + 2 * cx); STAMP(12);
                if (RUN(base + PH_MUP0 + 2 * cx + 1)) { PH_BEGIN int c = cx; asm volatile("" : "+s"(c)); const int* tileexp = (const int*)(ws + SM_TILEEXP);
                    int nt = tileexp[1023] - c * MOE_CHUNK_TILES; nt = nt < 0 ? 0 : (nt > MOE_CHUNK_TILES ? MOE_CHUNK_TILES : nt);
                    if (cx < MOE_NCHUNK - MK_TAILSPLIT) {
                        pg8::Gemm g{(const bf16_t*)(ws + WS_MH), (const bf16_t*)(ws + W_DN), DFE, DFE, DFE}; MoeDnOrder S{nt, F.G, F.bid, c, tileexp}; epi::MoeDown E{(bf16_t*)(ws + WS_YB), (const int*)(ws + SM_ROWTOK)};
                        pg8::gemm_phase(F.lds, g, S, E, F.tid);
                    } else {
                        nt = nt > 8 ? 8 : nt;
                        pg8::Gemm g{(const bf16_t*)(ws + WS_MH), (const bf16_t*)(ws + W_DN), 512, DFE, DFE}; MoeDnTailOrder S{nt, F.G, F.bid, tileexp}; epi::F32Grouped E{(float*)(ws + WS_XS), D, (size_t)2048 * D};
                        pg8::gemm_phase(F.lds, g, S, E, F.tid);
                    }
                }
                SEAM(base + PH_MUP0 + 2 * cx + 1); STAMP(13);
            }
#if MK_TAILSPLIT
            if (RUN(base + PH_MUP0 + 2 * MOE_NCHUNK)) { PH_BEGIN moe_tail_finalize(F, a); }
            SEAM(base + PH_MUP0 + 2 * MOE_NCHUNK); STAMP(13);
#endif
        }
        if (RUN(base + PH_PGATE)) {
            if (moe) {
                {   PH_BEGIN
                    const float* gg = (const float*)a.in[34] + ((size_t)l * 3 + 1) * D; const float* bb = (const float*)a.in[35] + ((size_t)l * 3 + 1) * D;
                    for (int pm = F.bid; pm < T / 256; pm += F.G) ln_panel<1, false, false>(F, a, pm, gg, bb, nullptr);
                }
                asm volatile("s_waitcnt vmcnt(0)" ::: "memory"); __syncthreads();
            }
            {   PH_BEGIN
                pg8::Gemm g{xb, (const bf16_t*)(ws + W_GATE), D, D, D}; pg8::PanelOrder S{T / 256, D / 256, F.G, F.bid, S1K, S1K}; epi::SigmoidBias E{(l & 1) ? (bf16_t*)(ws + WS_PLEG) : mix, D, (const float*)a.in[32] + (size_t)l * D};
                pg8::gemm_phase(F.lds, g, S, E, F.tid);
            }
            __syncthreads();
            {   PH_BEGIN
                pg8::Gemm g{(const bf16_t*)(ws + WS_PB), (const bf16_t*)(ws + W_PROJ), PLE, PLE, PLE}; pg8::PanelOrder S{T / 256, D / 256, F.G, F.bid, 256ll * PLE * 2, 256ll * PLE * 2}; epi::MulBf16 E{(l & 1) ? (bf16_t*)(ws + WS_PLEH) : hbuf, (l & 1) ? (bf16_t*)(ws + WS_PLEG) : mix, D};
                pg8::gemm_phase(F.lds, g, S, E, F.tid);
            }
            __syncthreads();
            {   PH_BEGIN
                const float* gg = (const float*)a.in[34] + ((size_t)l * 3 + 2) * D; const float* bb = (const float*)a.in[35] + ((size_t)l * 3 + 2) * D;
                const size_t hoff = (l & 1) ? WS_PLEH : WS_HBUF;
                for (int pm = F.bid; pm < T / 256; pm += F.G) { if (l == DEPTH - 1) ln_panel<0, false, true>(F, a, pm, gg, bb, nullptr, hoff); else ln_panel<0, false, false>(F, a, pm, gg, bb, nullptr, hoff); }
            }
            if (lx + 1 < DEPTH) { __syncthreads(); PH_BEGIN phase_prep(F, a, l + 1, 1); }
        }
        SEAM(base + PH_PGATE); STAMP(15);
    }
#if MK_PROBE
    if (blockIdx.x == 0) {
        __syncthreads(); asm volatile("s_waitcnt vmcnt(0)" ::: "memory");
        const unsigned long long t1 = ((unsigned long long)PRW[1] << 32) | PRW[0], t0 = ((unsigned long long)PRW[5] << 32) | PRW[4];
        const float tot = (float)(unsigned)(t1 - t0), fa = (float)PRW[2] / tot, fb = (float)PRW[3] / tot;
        Args ae; load_args(ae);
        const int tidp = wave0 * 64 + lane_id_fresh();
        if (tidp == 0) ae.out[0] += 1.0f + 8.0f * fa;
        for (int i = tidp; i < 100000; i += 512) ae.out[1024 + i] += 0.5f * fb;
    }
#endif
#undef RUN
#undef SEAM
}

static bool phase_applies(int gp) {
    if (gp < 2) return true;
    const int l = (gp - 2) / PH_PER_LAYER, ph = (gp - 2) % PH_PER_LAYER; const bool moe = (l & 1) != 0;
    if (ph == PH_PREP) return l == 0;
    if (ph < PH_LN1) return ph != PH_POST && ph != PH_MIX2 && ph != PH_MIX4;
    if (ph == PH_PGATE) return true;
    if (!moe) return ph == PH_FUP || ph == PH_FDN;
    return ph >= PH_MGATH && ph <= PH_MUP0 + 2 * MOE_NCHUNK;
}
extern "C" void kernel_launch(void* const* d_in, const int* in_sizes, int n_in, void* d_out, int out_size, void* d_ws, size_t ws_size, hipStream_t stream) {
    static int grid = 0;
    if (grid == 0) {
        if (n_in != 36 || out_size != T * D || ws_size < WS_END) { fprintf(stderr, "kernel_launch: unexpected problem (n_in %d out %d ws %zu, need %zu)\n", n_in, out_size, ws_size, (size_t)WS_END); grid = -1; return; }
        int dev = 0, cus = 0, per_cu = 0;
        if (hipGetDevice(&dev) != hipSuccess || hipDeviceGetAttribute(&cus, hipDeviceAttributeMultiprocessorCount, dev) != hipSuccess) { grid = -1; return; }
        if (hipFuncSetAttribute((const void*)mk_fwd, hipFuncAttributeMaxDynamicSharedMemorySize, LDS_BYTES) != hipSuccess) { fprintf(stderr, "kernel_launch: hipFuncSetAttribute failed\n"); grid = -1; return; }
        if (hipOccupancyMaxActiveBlocksPerMultiprocessor(&per_cu, (const void*)mk_fwd, 512, LDS_BYTES) != hipSuccess || per_cu < 1) fprintf(stderr, "kernel_launch: occupancy query reports %d\n", per_cu);
        (void)hipGetLastError();
        grid = cus;
    }
    if (grid < 0) return;
    (void)in_sizes;
    if (hipMemsetAsync((char*)d_ws + WS_CTL, 0, CTL_ZERO_BYTES, stream) != hipSuccess) return;
#if MK_CHECK
    (void)hipMemsetAsync((char*)d_ws + SM_CHK, 0, 256, stream);
#endif
    Args a{};
    for (int i = 0; i < 36; ++i) a.in[i] = d_in[i];
    a.out = (float*)d_out; a.ws = (unsigned char*)d_ws; a.pad = 0;
#if MK_MULTI
    for (int gp = 0; gp < GP_END; ++gp) { if (!phase_applies(gp)) continue; a.gp_lo = gp; a.gp_hi = gp + 1; a.use_bar = 0;
        hipLaunchKernelGGL(mk_fwd, dim3(grid), dim3(512), LDS_BYTES, stream, a);
#if MK_CHECK
        run_checks(a, gp, stream);
#endif
    }
#if MK_CHECK
    hipLaunchKernelGGL(chk_final, dim3(1), dim3(1), 0, stream, a);
#endif
#else
    a.gp_lo = 0; a.gp_hi = GP_END; a.use_bar = 1;
    hipLaunchKernelGGL(mk_fwd, dim3(grid), dim3(512), LDS_BYTES, stream, a);
#endif
}
```

```cpp
#include <hip/hip_runtime.h>
#include <cstdint>
#include <cstdio>
#ifndef MK_TAILSPLIT
#define MK_TAILSPLIT 1
#endif
#ifndef MK_MULTI
#define MK_MULTI 0
#endif
#ifndef MK_CHECK
#define MK_CHECK 0
#endif
#ifndef MK_REP_G1
#define MK_REP_G1 1
#endif
#ifndef MK_REP_G2
#define MK_REP_G2 1
#endif
#ifndef MK_REP_CU
#define MK_REP_CU 1
#endif
#ifndef MK_REP_TK
#define MK_REP_TK 1
#endif
#ifndef MK_REP_WOUT
#define MK_REP_WOUT 1
#endif
#ifndef MK_REP_CONV
#define MK_REP_CONV 1
#endif
#ifndef MK_REP_ST2
#define MK_REP_ST2 1
#endif
#ifndef MK_REP_CARRY
#define MK_REP_CARRY 1
#endif
#ifndef MK_REPCMP
#define MK_REPCMP 1
#endif
#ifndef MK_ALIGN_EPI
#define MK_ALIGN_EPI 1
#endif
#ifndef MK_PROBE
#define MK_PROBE 0
#endif
#ifndef PROBE_A
#define PROBE_A 0
#endif
#ifndef PROBE_B
#define PROBE_B 0
#endif
#ifndef CHK_LAYER
#define CHK_LAYER 15
#endif

#define GAS __attribute__((address_space(1)))
#define LAS __attribute__((address_space(3)))
typedef unsigned short bf16_t;
typedef short bf16x8 __attribute__((ext_vector_type(8)));
typedef float f32x4 __attribute__((ext_vector_type(4)));
typedef float f32x2 __attribute__((ext_vector_type(2)));
typedef float f32x16 __attribute__((ext_vector_type(16)));
typedef unsigned u32x4 __attribute__((ext_vector_type(4)));
typedef unsigned u32x2 __attribute__((ext_vector_type(2)));

constexpr int NB = 16, SEQ = 4096, T = NB * SEQ, D = 1024, DEPTH = 4;
constexpr int INW = 2072, INP = 2304;
constexpr int ZKV = 512, ZG = 1280, ZC = 1304, ZS = 1816;
constexpr int DFF = 2816, DFE = 3584, NEXP = 8, PLE = 256;
constexpr int NCMP = 255;
constexpr int S5LC = 32, S5NCH = SEQ / S5LC, S5K = S5LC * 16 + 128;
constexpr float ALPHA = 1.6817928305074290f;
constexpr float LN_EPS = 1e-5f;
constexpr float QSCALE = 0.125f * 1.4426950408889634f;
constexpr float NEGF = -1e30f;
constexpr int MOE_TILES_MAX = 520, MOE_CHUNK_TILES = 128, MOE_NCHUNK = 5;

typedef __bf16 bf16x2_t __attribute__((ext_vector_type(2)));
__device__ __forceinline__ unsigned cvt_pk_bf16(float lo, float hi) { f32x2 v = {lo, hi}; const bf16x2_t b = __builtin_convertvector(v, bf16x2_t); return __builtin_bit_cast(unsigned, b); }
__device__ __forceinline__ bf16_t f2bf(float f) { return (bf16_t)(cvt_pk_bf16(f, 0.f) & 0xffffu); }
__device__ __forceinline__ float bf2f(unsigned v) { return __uint_as_float(v << 16); }
__device__ __forceinline__ float bflo(unsigned w) { return __uint_as_float(w << 16); }
__device__ __forceinline__ float bfhi(unsigned w) { return __uint_as_float(w & 0xffff0000u); }
__device__ __forceinline__ float fast_exp2(float x) { return __builtin_amdgcn_exp2f(x); }
__device__ __forceinline__ float fast_rcp(float x) { return __builtin_amdgcn_rcpf(x); }
__device__ __forceinline__ float sigmoidf_(float x) { return fast_rcp(1.0f + fast_exp2(-1.4426950408889634f * x)); }
__device__ __forceinline__ float siluf_(float x) { return x * sigmoidf_(x); }
__device__ __forceinline__ float gelu_tanh(float x) { const float u = 0.7978845608028654f * (x + 0.044715f * x * x * x); return x * sigmoidf_(2.0f * u); }
__device__ __forceinline__ int lane_id_fresh() { unsigned z = 0u; asm volatile("" : "+v"(z)); return (int)__builtin_amdgcn_mbcnt_hi(~0u, __builtin_amdgcn_mbcnt_lo(~0u, z)); }
template <int MASK> __device__ __forceinline__ float xshfl(float v) {
    if (MASK == 32) { const unsigned u = __float_as_uint(v); auto rr = __builtin_amdgcn_permlane32_swap(u, u, false, false); return __uint_as_float((rr[0] == u) ? rr[1] : rr[0]); }
    return __uint_as_float((unsigned)__builtin_amdgcn_ds_swizzle((int)__float_as_uint(v), 0x1f | (MASK << 10)));
}
__device__ __forceinline__ float wave_sum(float v) {
    v += xshfl<1>(v); v += xshfl<2>(v); v += xshfl<4>(v); v += xshfl<8>(v); v += xshfl<16>(v); v += xshfl<32>(v);
    return v;
}
#define LDS_WAIT() asm volatile("s_waitcnt lgkmcnt(0)" ::: "memory")
#define VM_WAIT() asm volatile("s_waitcnt vmcnt(0)" ::: "memory")

namespace pg8 {
constexpr int BM = 256, BK = 64, HALF = 128, HTB = HALF * BK * 2, STAGE_BYTES = 8 * HTB, NXCD = 8, WGM = 8;
__host__ __device__ __forceinline__ int lds_byte(int r, int c) { const int st = (r >> 4) * 2 + (c >> 5), rr = r & 15, cc = c & 31, ob = rr * 64 + cc * 2; return st * 1024 + (ob ^ (((ob >> 9) & 1) << 5)); }
__host__ __device__ __forceinline__ void stage_rc(int b, int& R, int& C) { const int st = b / 1024, sb = b % 1024, swz = sb ^ (((sb >> 9) & 1) << 5); R = (st >> 1) * 16 + swz / 64; C = (st & 1) * 32 + (swz % 64) / 2; }
__host__ __device__ __forceinline__ int perm32(int rho) { const int n = rho >> 4, i = rho & 15; return 8 * (i >> 2) + 4 * n + (i & 3); }

struct Unit { int pm, pn; long long offA, offB; int aux; };
struct Gemm { const bf16_t* A; const bf16_t* Bt; int K, lda, ldb; };

__device__ __forceinline__ bool static_tile(int i, int G, int c, int nM, int nN, int& pm, int& pn) {
    const int nwg = nM * nN; const long L = (long)i * G + c; if (L >= nwg) return false;
    int wgid = (int)L; { const int q = nwg / NXCD, r = nwg % NXCD, xcd = wgid % NXCD, off = wgid / NXCD; wgid = (xcd < r ? xcd * (q + 1) : r * (q + 1) + (xcd - r) * q) + off; }
    const int nig = WGM * nN, gid = wgid / nig, fm = gid * WGM, gsz = (nM - fm) < WGM ? (nM - fm) : WGM;
    pm = fm + ((wgid % nig) % gsz); pn = (wgid % nig) / gsz; return true;
}
struct PlainOrder {
    int nM, nN, G, c; long long sA, sB;
    __device__ __forceinline__ bool next(int i, Unit& u) const { if (!static_tile(i, G, c, nM, nN, u.pm, u.pn)) return false; u.offA = (long long)u.pm * sA; u.offB = (long long)u.pn * sB; u.aux = 0; return true; }
};
struct PanelOrder {
    int nM, nN, G, c; long long sA, sB;
    __device__ __forceinline__ bool next(int i, Unit& u) const { const int pm = c + G * (i / nN); if (pm >= nM) return false; u.pm = pm; u.pn = i % nN; u.offA = (long long)pm * sA; u.offB = (long long)u.pn * sB; u.aux = 0; return true; }
};
struct ListOrder {
    int n, pm, aux; long long offA0, offB0, sB;
    __device__ __forceinline__ bool next(int i, Unit& u) const { if (i >= n) return false; u.pm = pm; u.pn = i; u.aux = aux; u.offA = offA0; u.offB = offB0 + (long long)i * sB; return true; }
};
struct GroupedOrder {
    int ng, nM, nN, G, c; long long sA, sB, gA, gB;
    __device__ __forceinline__ bool next(int i, Unit& u) const {
        const long L = (long)i * G + c; const int per = nM * nN; if (L >= (long)ng * per) return false;
        const int gi = (int)(L / per), r = (int)(L % per); u.pm = r / nN; u.pn = r % nN; u.aux = gi;
        u.offA = (long long)gi * gA + (long long)u.pm * sA; u.offB = (long long)gi * gB + (long long)u.pn * sB; return true; }
};

template <class Epi, class Sched>
__device__ __forceinline__ void gemm_phase(LAS unsigned char* lds, const Gemm g, const Sched& S, const Epi& E, int tid_in) {
    int tid_ = tid_in; asm volatile("" : "+v"(tid_));
    const int tid = tid_, wid = __builtin_amdgcn_readfirstlane(tid >> 6), lane = tid & 63, wr = wid >> 2, wc = wid & 3, fr = lane & 15, fq = lane >> 4;
    int K_ = g.K; asm volatile("" : "+s"(K_));
    const int K = K_, nt = K / BK; (void)K;
    unsigned voffA[2], voffB[2];
#pragma unroll
    for (int i = 0; i < 2; ++i) { int R, C; stage_rc(tid * 16 + i * 8192, R, C); const int Rb = Epi::PERM ? ((R & ~31) + perm32(R & 31)) : R;
        voffA[i] = (unsigned)(R * g.lda + C) * 2u; voffB[i] = (unsigned)(Rb * g.ldb + C) * 2u; }
    const size_t kstep = (size_t)(BK * 2);
    const size_t hstepA = (size_t)HALF * g.lda * 2, hstepB = (size_t)HALF * g.ldb * 2;
    const unsigned ldsw = (unsigned)wid * 1024u;
    const int aoff = lds_byte(wr * 64 + fr, fq * 8), boff = lds_byte(wc * 32 + fr, fq * 8);
#define PG8_SA(b, h) (((b) * 2 + (h)) * HTB)
#define PG8_SB(b, h) ((4 + (b) * 2 + (h)) * HTB)
#define PG8_STAGE(bufoff, gbase, voff) do { _Pragma("unroll") for (int _i = 0; _i < 2; ++_i) \
        __builtin_amdgcn_global_load_lds((const unsigned*)((const char*)(gbase) + (voff)[_i]), (LAS unsigned*)(lds + (bufoff) + ldsw + _i * 8192), 16, 0, 0); } while (0)
#define PG8_LDA(dst, b, h) do { _Pragma("unroll") for (int m = 0; m < 4; ++m) _Pragma("unroll") for (int k = 0; k < 2; ++k) dst[m][k] = *(const LAS bf16x8*)(lds + PG8_SA(b, h) + aoff + m * 2048 + k * 1024); } while (0)
#define PG8_LDB(dst, b, h) do { _Pragma("unroll") for (int n = 0; n < 2; ++n) _Pragma("unroll") for (int k = 0; k < 2; ++k) dst[n][k] = *(const LAS bf16x8*)(lds + PG8_SB(b, h) + boff + n * 2048 + k * 1024); } while (0)
#define PG8_MMA(ai, bj, At, Bt) do { __builtin_amdgcn_s_setprio(1); _Pragma("unroll") for (int m = 0; m < 4; ++m) _Pragma("unroll") for (int n = 0; n < 2; ++n) _Pragma("unroll") for (int k = 0; k < 2; ++k) \
        acc[ai][bj][m][n] = __builtin_amdgcn_mfma_f32_16x16x32_bf16(Bt[n][k], At[m][k], acc[ai][bj][m][n], 0, 0, 0); __builtin_amdgcn_s_setprio(0); } while (0)
#define PG8_WAIT_V(n) asm volatile("s_waitcnt vmcnt(" #n ")" ::: "memory")
#define PG8_WAIT_L(n) asm volatile("s_waitcnt lgkmcnt(" #n ")" ::: "memory")
#define PG8_BAR __builtin_amdgcn_s_barrier()
#define PG8_SCHED __builtin_amdgcn_sched_barrier(0)
    Unit cur, nxt; int ui = 0;
    if (!S.next(0, cur)) return;
    f32x4 acc[2][2][4][2];
#pragma unroll
    for (int a = 0; a < 2; ++a)
#pragma unroll
        for (int b = 0; b < 2; ++b)
#pragma unroll
            for (int m = 0; m < 4; ++m)
#pragma unroll
                for (int n = 0; n < 2; ++n) acc[a][b][m][n] = (f32x4){0.f, 0.f, 0.f, 0.f};
    bf16x8 At[4][2], B0[2][2], B1[2][2];
    const char* cA = (const char*)g.A + cur.offA; const char* cB = (const char*)g.Bt + cur.offB;
    PG8_STAGE(PG8_SB(0, 0), cB, voffB); PG8_STAGE(PG8_SB(0, 1), cB + hstepB, voffB); PG8_STAGE(PG8_SA(0, 0), cA, voffA); PG8_STAGE(PG8_SA(0, 1), cA + hstepA, voffA);
    if (wr == 1) PG8_BAR;
    PG8_WAIT_V(2); PG8_BAR;
    PG8_STAGE(PG8_SB(1, 0), cB + kstep, voffB); PG8_STAGE(PG8_SA(1, 0), cA + kstep, voffA); PG8_STAGE(PG8_SB(1, 1), cB + hstepB + kstep, voffB);
    PG8_WAIT_V(6); PG8_BAR;
    for (;;) {
        const bool has_next = S.next(ui + 1, nxt);
        const char* nA = has_next ? (const char*)g.A + nxt.offA : cA; const char* nB = has_next ? (const char*)g.Bt + nxt.offB : cB;
        for (int t = 0; t < nt; t += 2) {
            const bool last = (t == nt - 2);
            const char* a1 = cA + (size_t)(t + 1) * kstep;
            const char* a2 = last ? nA : cA + (size_t)(t + 2) * kstep; const char* b2 = last ? nB : cB + (size_t)(t + 2) * kstep;
            const char* a3 = a2 + kstep; const char* b3 = b2 + kstep;
            PG8_LDB(B0, 0, 0); PG8_LDB(B1, 0, 1); PG8_SCHED; PG8_LDA(At, 0, 0); PG8_STAGE(PG8_SA(1, 1), a1 + hstepA, voffA);
            PG8_WAIT_V(8); PG8_WAIT_L(0); PG8_BAR; PG8_MMA(0, 0, At, B0); PG8_MMA(0, 1, At, B1); PG8_BAR; PG8_SCHED;
            PG8_LDA(At, 0, 1); PG8_STAGE(PG8_SB(0, 0), b2, voffB); PG8_STAGE(PG8_SB(0, 1), b2 + hstepB, voffB); PG8_STAGE(PG8_SA(0, 0), a2, voffA);
            PG8_WAIT_V(8); PG8_WAIT_L(0); PG8_BAR; PG8_MMA(1, 0, At, B0); PG8_MMA(1, 1, At, B1); PG8_BAR; PG8_SCHED;
            PG8_LDB(B0, 1, 0); PG8_LDB(B1, 1, 1); PG8_SCHED; PG8_LDA(At, 1, 0); PG8_STAGE(PG8_SA(0, 1), a2 + hstepA, voffA);
            PG8_WAIT_V(8); PG8_WAIT_L(0); PG8_BAR; PG8_MMA(0, 0, At, B0); PG8_MMA(0, 1, At, B1); PG8_BAR; PG8_SCHED;
            PG8_LDA(At, 1, 1); PG8_STAGE(PG8_SB(1, 0), b3, voffB); PG8_STAGE(PG8_SB(1, 1), b3 + hstepB, voffB); PG8_STAGE(PG8_SA(1, 0), a3, voffA);
            PG8_WAIT_V(8); PG8_WAIT_L(0); PG8_BAR; PG8_MMA(1, 0, At, B0); PG8_MMA(1, 1, At, B1); PG8_BAR; PG8_SCHED;
        }
#if MK_ALIGN_EPI
        if (wr == 0) PG8_BAR;
#endif
        { int fr_ = fr, fq_ = fq; asm volatile("" : "+v"(fr_), "+v"(fq_));
          E(acc, cur, wr, wc, fr_, fq_); }
        if (!has_next) break;
#pragma unroll
        for (int a = 0; a < 2; ++a)
#pragma unroll
            for (int b = 0; b < 2; ++b)
#pragma unroll
                for (int m = 0; m < 4; ++m)
#pragma unroll
                    for (int n = 0; n < 2; ++n) acc[a][b][m][n] = (f32x4){0.f, 0.f, 0.f, 0.f};
        cur = nxt; cA = nA; cB = nB; ++ui;
#if MK_ALIGN_EPI
        if (wr == 1) PG8_BAR;
#endif
    }
    PG8_WAIT_V(0);
#if !MK_ALIGN_EPI
    if (wr == 0) PG8_BAR;
#endif
    PG8_BAR;
#undef PG8_SA
#undef PG8_SB
#undef PG8_STAGE
#undef PG8_LDA
#undef PG8_LDB
#undef PG8_MMA
#undef PG8_WAIT_V
#undef PG8_WAIT_L
#undef PG8_BAR
#undef PG8_SCHED
}
}

#define XB_TMO      128
#define XB_XCNT(j)  (256  + 64 * (j))
#define XB_XSUB(j)  (1280 + 64 * (j))
#define XB_XGEN(j)  (2304 + 64 * (j))
#define XB_TOP      3328
#define XB_TOPGEN   3392
#define XCD_BAR_WORDS 3456
#define XB_SPIN_CAP (1u << 20)
__device__ __forceinline__ unsigned xb_ld(unsigned* p)              { return __hip_atomic_load(p, __ATOMIC_RELAXED, __HIP_MEMORY_SCOPE_AGENT); }
__device__ __forceinline__ unsigned xb_add(unsigned* p, unsigned v) { return __hip_atomic_fetch_add(p, v, __ATOMIC_RELAXED, __HIP_MEMORY_SCOPE_AGENT); }
__device__ __forceinline__ unsigned xb_xcc_id() { return (unsigned)__builtin_amdgcn_s_getreg((3 << 11) | 20) & 0xFu; }
#define XB_SPIN(cond, bar) do { unsigned _sp = 0; while (cond) { __builtin_amdgcn_s_sleep(1); \
    if ((++_sp & 255u) == 0u) { if (xb_ld(&(bar)[XB_TMO])) break; if (_sp > XB_SPIN_CAP) { atomicAdd(&(bar)[XB_TMO], 1u); break; } } } } while (0)
struct XcdBarrier { unsigned* bar; unsigned x; volatile LAS unsigned* st; };
__device__ __forceinline__ XcdBarrier xcd_barrier_post(unsigned* bar, volatile LAS unsigned* st) {
    XcdBarrier b; b.bar = bar; b.x = xb_xcc_id(); b.st = st;
    if (threadIdx.x == 0) (void)xb_add(&bar[XB_XCNT(b.x)], 1u);
    return b;
}
__device__ __forceinline__ void xcd_barrier_complete(unsigned* bar, unsigned x, unsigned& nloc, unsigned& nx) {
    const unsigned G = gridDim.x * gridDim.y * gridDim.z;
    unsigned sum, cnt, mine, sp = 0u;
    for (;;) {
        sum = 0u; cnt = 0u; mine = 0u;
#pragma unroll 1
        for (unsigned j = 0; j < 16; ++j) { const unsigned c = xb_ld(&bar[XB_XCNT(j)]); sum += c; cnt += (c > 0u) ? 1u : 0u; mine = (j == x) ? c : mine; }
        if (sum == G) break;
        __builtin_amdgcn_s_sleep(1);
        if ((++sp & 255u) == 0u) { if (xb_ld(&bar[XB_TMO])) break; if (sp > XB_SPIN_CAP) { atomicAdd(&bar[XB_TMO], 1u); break; } }
    }
    nloc = mine > 0u ? mine : 1u; nx = cnt > 0u ? cnt : 1u;
}
__device__ __forceinline__ void xcd_barrier(const XcdBarrier& b, int wave_id) {
    asm volatile("s_waitcnt vmcnt(0)" ::: "memory");
    __syncthreads();
    if (wave_id == 0 && lane_id_fresh() == 0) {
        unsigned* bar = b.bar; asm volatile("" : "+s"(bar));
        __builtin_amdgcn_s_waitcnt(0);
        unsigned nloc = b.st[0], nx = b.st[1];
        if (nloc == 0u) { xcd_barrier_complete(bar, b.x, nloc, nx); b.st[0] = nloc; b.st[1] = nx; }
        const unsigned old = xb_add(&bar[XB_XSUB(b.x)], 1u);
        const unsigned gen = old / nloc;
        if (old + 1u == (gen + 1u) * nloc) {
            __builtin_amdgcn_fence(__ATOMIC_RELEASE, "agent");
            asm volatile("s_waitcnt vmcnt(0)" ::: "memory");
            const unsigned og = xb_add(&bar[XB_TOP], 1u);
            const unsigned tg = og / nx;
            if (og + 1u == (tg + 1u) * nx) xb_add(&bar[XB_TOPGEN], 1u);
            else XB_SPIN(xb_ld(&bar[XB_TOPGEN]) == tg, bar);
            __builtin_amdgcn_fence(__ATOMIC_ACQUIRE, "agent");
            xb_add(&bar[XB_XGEN(b.x)], 1u);
            asm volatile("s_waitcnt vmcnt(0)" ::: "memory");
        } else {
            XB_SPIN(xb_ld(&bar[XB_XGEN(b.x)]) == gen, bar);
            __builtin_amdgcn_fence(__ATOMIC_ACQUIRE, "agent");
            asm volatile("s_waitcnt vmcnt(0)" ::: "memory");
        }
    }
    __syncthreads();
}
namespace nsa {
constexpr int PITCH = 144, TILE_LDS = 64 * PITCH;
__device__ __forceinline__ int crow(int r, int hi) { return (r & 3) + 8 * (r >> 2) + 4 * hi; }
__device__ __forceinline__ int vslot(int kk) { return (kk & 0x33) | (((kk >> 2) & 1) << 3) | (((kk >> 3) & 1) << 2); }

struct Lane { int lane, c, hi, wid, tid; };

__device__ __forceinline__ void qk_tile(f32x16& p0, f32x16& p1, const LAS unsigned char* Ks, const bf16x8 (&qr)[4], float bias, const Lane& L) {
#pragma unroll
    for (int r = 0; r < 16; ++r) { p0[r] = bias; p1[r] = bias; }
    const LAS unsigned char* kb = Ks + L.c * PITCH + L.hi * 16;
#pragma unroll
    for (int d0 = 0; d0 < 4; ++d0) {
        const bf16x8 k0 = *(const LAS bf16x8*)(kb + d0 * 32);
        const bf16x8 k1 = *(const LAS bf16x8*)(kb + 32 * PITCH + d0 * 32);
        p0 = __builtin_amdgcn_mfma_f32_32x32x16_bf16(k0, qr[d0], p0, 0, 0, 0);
        p1 = __builtin_amdgcn_mfma_f32_32x32x16_bf16(k1, qr[d0], p1, 0, 0, 0);
    }
}
__device__ __forceinline__ void qk_tile_c(f32x16& p0, f32x16& p1, const LAS unsigned char* Ks, const bf16x8 (&qr)[4], const f32x16& cv, const Lane& L) {
    const LAS unsigned char* kb = Ks + L.c * PITCH + L.hi * 16;
    { const bf16x8 k0 = *(const LAS bf16x8*)(kb); const bf16x8 k1 = *(const LAS bf16x8*)(kb + 32 * PITCH);
      p0 = __builtin_amdgcn_mfma_f32_32x32x16_bf16(k0, qr[0], cv, 0, 0, 0); p1 = __builtin_amdgcn_mfma_f32_32x32x16_bf16(k1, qr[0], cv, 0, 0, 0); }
#pragma unroll
    for (int d0 = 1; d0 < 4; ++d0) {
        const bf16x8 k0 = *(const LAS bf16x8*)(kb + d0 * 32);
        const bf16x8 k1 = *(const LAS bf16x8*)(kb + 32 * PITCH + d0 * 32);
        p0 = __builtin_amdgcn_mfma_f32_32x32x16_bf16(k0, qr[d0], p0, 0, 0, 0);
        p1 = __builtin_amdgcn_mfma_f32_32x32x16_bf16(k1, qr[d0], p1, 0, 0, 0);
    }
}
__device__ __forceinline__ void mask_range(f32x16& p0, f32x16& p1, int lo, int hi_, int hi) {
#pragma unroll
    for (int r = 0; r < 16; ++r) { const int k0 = crow(r, hi), k1 = k0 + 32;
        if (k0 <= lo || k0 > hi_) p0[r] = NEGF;
        if (k1 <= lo || k1 > hi_) p1[r] = NEGF; }
}
__device__ __forceinline__ float tile_max(const f32x16& p0, const f32x16& p1) {
    float a = fmaxf(p0[0], p1[0]);
#pragma unroll
    for (int r = 1; r < 16; ++r) a = fmaxf(a, fmaxf(p0[r], p1[r]));
    return fmaxf(a, xshfl<32>(a));
}
__device__ __forceinline__ void pv_tile(f32x16& o0, f32x16& o1, const LAS unsigned char* Vs, const f32x16& p0, const f32x16& p1, const Lane& L) {
    const LAS unsigned char* vb = Vs + L.c * PITCH + L.hi * 16;
#pragma unroll
    for (int s = 0; s < 4; ++s) {
        u32x4 w;
        if (s < 2) { const int b = 8 * (s & 1); w.x = cvt_pk_bf16(p0[b], p0[b + 1]); w.y = cvt_pk_bf16(p0[b + 2], p0[b + 3]); w.z = cvt_pk_bf16(p0[b + 4], p0[b + 5]); w.w = cvt_pk_bf16(p0[b + 6], p0[b + 7]); }
        else       { const int b = 8 * (s & 1); w.x = cvt_pk_bf16(p1[b], p1[b + 1]); w.y = cvt_pk_bf16(p1[b + 2], p1[b + 3]); w.z = cvt_pk_bf16(p1[b + 4], p1[b + 5]); w.w = cvt_pk_bf16(p1[b + 6], p1[b + 7]); }
        const bf16x8 pf = __builtin_bit_cast(bf16x8, w);
        const bf16x8 v0 = *(const LAS bf16x8*)(vb + s * 32);
        const bf16x8 v1 = *(const LAS bf16x8*)(vb + 32 * PITCH + s * 32);
        o0 = __builtin_amdgcn_mfma_f32_32x32x16_bf16(v0, pf, o0, 0, 0, 0);
        o1 = __builtin_amdgcn_mfma_f32_32x32x16_bf16(v1, pf, o1, 0, 0, 0);
        if (s & 1) __builtin_amdgcn_sched_barrier(0);
    }
}
__device__ __forceinline__ void softmax_pv(f32x16& p0, f32x16& p1, f32x16& o0, f32x16& o1, float& m, float& l, const LAS unsigned char* Vs, const Lane& L) {
    const float mx = tile_max(p0, p1), mn = fmaxf(m, mx), alpha = fast_exp2(m - mn); m = mn;
    float ls = 0.f;
#pragma unroll
    for (int r = 0; r < 16; ++r) { p0[r] = fast_exp2(p0[r] - mn); p1[r] = fast_exp2(p1[r] - mn); ls += p0[r] + p1[r]; }
    l = l * alpha + ls;
#pragma unroll
    for (int r = 0; r < 16; ++r) { o0[r] *= alpha; o1[r] *= alpha; }
    pv_tile(o0, o1, Vs, p0, p1, L);
}
__device__ __forceinline__ int stage_off(int tid) { return (tid >> 3) * PITCH + (tid & 7) * 16; }

__device__ __forceinline__ void load_q(bf16x8 (&qr)[4], const bf16_t* qbuf, long tok, int head, int hi) {
    const bf16_t* qp = qbuf + tok * 512 + head * 64 + hi * 8;
#pragma unroll
    for (int d0 = 0; d0 < 4; ++d0) qr[d0] = *(const bf16x8*)(qp + d0 * 16);
}

__device__ __forceinline__ u32x4 vload(const bf16_t* Vt, int j, const Lane& L) { return *(const u32x4*)((const char*)Vt + (size_t)j * 8192 + L.lane * 128 + L.wid * 16); }
__device__ __forceinline__ void vstore(LAS unsigned char* Vs, const u32x4 v, const Lane& L) {
    LAS unsigned short* p = (LAS unsigned short*)(Vs + (8 * L.wid) * PITCH) + vslot(L.lane);
    p[0 * (PITCH / 2)] = (unsigned short)(v.x & 0xffffu); p[1 * (PITCH / 2)] = (unsigned short)(v.x >> 16); p[2 * (PITCH / 2)] = (unsigned short)(v.y & 0xffffu); p[3 * (PITCH / 2)] = (unsigned short)(v.y >> 16);
    p[4 * (PITCH / 2)] = (unsigned short)(v.z & 0xffffu); p[5 * (PITCH / 2)] = (unsigned short)(v.z >> 16); p[6 * (PITCH / 2)] = (unsigned short)(v.w & 0xffffu); p[7 * (PITCH / 2)] = (unsigned short)(v.w >> 16);
}
template <int MODE>
__device__ __forceinline__ void run_branch(f32x16& o0, f32x16& o1, float& mref, float& l, const bf16_t* Kt  , const bf16_t* Vt  ,
                                           int jlo, int jhi, int qb, int qrel, unsigned long long selw, const bf16x8 (&qr)[4], LAS unsigned char* lds, const Lane& L) {
    LAS unsigned char* Kbuf = lds; LAS unsigned char* Vbuf = lds + 2 * TILE_LDS;
    const int so = stage_off(L.tid);
    u32x4 kreg = *(const u32x4*)((const char*)Kt + (size_t)jlo * 8192 + L.tid * 16);
    u32x4 vreg = vload(Vt, jlo, L);
    *(LAS u32x4*)(Kbuf + so) = kreg; vstore(Vbuf, vreg, L);
    __syncthreads();
    f32x16 cv;
#pragma unroll
    for (int r = 0; r < 16; ++r) cv[r] = -mref;
    for (int j = jlo; j <= jhi; ++j) {
        const int cur = (j - jlo) & 1;
        if (j < jhi) { kreg = *(const u32x4*)((const char*)Kt + (size_t)(j + 1) * 8192 + L.tid * 16); vreg = vload(Vt, j + 1, L); }
        f32x16 p0, p1;
        if (MODE == 0) { const float cb = ((selw >> j) & 1ull) ? -mref : NEGF;
#pragma unroll
            for (int r = 0; r < 16; ++r) cv[r] = cb; }
        qk_tile_c(p0, p1, Kbuf + cur * TILE_LDS, qr, cv, L);
        if (j == qb) mask_range(p0, p1, -1, qrel, L.hi);
        if (MODE == 1 && j == qb - 8) mask_range(p0, p1, qrel, 64, L.hi);
        const float mx = tile_max(p0, p1);
        if (__any(mx > 8.0f)) {
            const float dl = fmaxf(mx, 0.f), f = fast_exp2(-dl); mref += dl; l *= f;
#pragma unroll
            for (int r = 0; r < 16; ++r) { o0[r] *= f; o1[r] *= f; p0[r] -= dl; p1[r] -= dl; }
            if (MODE == 1) {
#pragma unroll
                for (int r = 0; r < 16; ++r) cv[r] = -mref; }
        }
        float ls = 0.f;
#pragma unroll
        for (int r = 0; r < 16; ++r) { p0[r] = fast_exp2(p0[r]); p1[r] = fast_exp2(p1[r]); ls += p0[r] + p1[r]; }
        l += ls;
        pv_tile(o0, o1, Vbuf + cur * TILE_LDS, p0, p1, L);
        if (j < jhi) { *(LAS u32x4*)(Kbuf + (cur ^ 1) * TILE_LDS + so) = kreg; vstore(Vbuf + (cur ^ 1) * TILE_LDS, vreg, L); }
        __syncthreads();
    }
}
struct SoftState { float mref, l; };
__device__ __forceinline__ void softmax_step2(f32x16& p0, f32x16& p1, f32x16& o0, f32x16& o1, SoftState& st, bool sel, bf16x8 (&pf)[4]) {
    if (__any(st.mref != 0.f)) {
#pragma unroll
        for (int r = 0; r < 16; ++r) { p0[r] -= st.mref; p1[r] -= st.mref; } }
    float ls = 0.f;
#pragma unroll
    for (int r = 0; r < 16; ++r) { p0[r] = fast_exp2(p0[r]); p1[r] = fast_exp2(p1[r]); ls += p0[r] + p1[r]; }
    ls = sel ? ls : 0.f; st.l += ls;
#pragma unroll
    for (int s = 0; s < 4; ++s) { u32x4 w; const int b = 8 * (s & 1);
        if (s < 2) { w.x = cvt_pk_bf16(p0[b], p0[b + 1]); w.y = cvt_pk_bf16(p0[b + 2], p0[b + 3]); w.z = cvt_pk_bf16(p0[b + 4], p0[b + 5]); w.w = cvt_pk_bf16(p0[b + 6], p0[b + 7]); }
        else       { w.x = cvt_pk_bf16(p1[b], p1[b + 1]); w.y = cvt_pk_bf16(p1[b + 2], p1[b + 3]); w.z = cvt_pk_bf16(p1[b + 4], p1[b + 5]); w.w = cvt_pk_bf16(p1[b + 6], p1[b + 7]); }
        if (!sel) w = (u32x4){0u, 0u, 0u, 0u};
        pf[s] = __builtin_bit_cast(bf16x8, w); }
}
__device__ __forceinline__ void renorm_step(f32x16& o0, f32x16& o1, SoftState& st) {
    if (__any(st.l > 1.0995116e12f)) { const bool big = st.l > 1.0995116e12f; const float f = big ? 9.094947e-13f : 1.0f; st.mref += big ? 40.f : 0.f; st.l *= f;
#pragma unroll
        for (int r = 0; r < 16; ++r) { o0[r] *= f; o1[r] *= f; } }
}
template <int MODE>
__device__ __forceinline__ void run_branch2(f32x16& oa0, f32x16& oa1, SoftState& sa, f32x16& ob0, f32x16& ob1, SoftState& sb, const bf16_t* Kt, const bf16_t* Vt, int jlo, int jhi, int qbw, int qrela,
                                            const LAS unsigned long long* selp  , const bf16x8 (&qa)[4], const bf16x8 (&qbf)[4], LAS unsigned char* lds, const Lane& L) {
    LAS unsigned char* Kbuf = lds; LAS unsigned char* Vbuf = lds + 2 * TILE_LDS;
    const int so = stage_off(L.tid);
    {   const u32x4 kreg = *(const u32x4*)((const char*)Kt + (size_t)jlo * 8192 + L.tid * 16); const u32x4 vreg = vload(Vt, jlo, L);
        *(LAS u32x4*)(Kbuf + so) = kreg; vstore(Vbuf, vreg, L); }
    __syncthreads();
    for (int j = jlo; j <= jhi; ++j) {
        const int cur = (j - jlo) & 1;
        const bool act = (j <= qbw) && (MODE == 0 || j >= qbw - 8);
        u32x4 kreg, vreg;
        bf16x8 fa[4], fb[4];
        if (act) {
            f32x16 pa0, pa1, pb0, pb1;
#pragma unroll
            for (int r = 0; r < 16; ++r) { pa0[r] = 0.f; pa1[r] = 0.f; pb0[r] = 0.f; pb1[r] = 0.f; }
            const LAS unsigned char* kb = Kbuf + cur * TILE_LDS + L.c * PITCH + L.hi * 16;
#pragma unroll
            for (int d0 = 0; d0 < 4; ++d0) { const bf16x8 k0 = *(const LAS bf16x8*)(kb + d0 * 32); const bf16x8 k1 = *(const LAS bf16x8*)(kb + 32 * PITCH + d0 * 32);
                pa0 = __builtin_amdgcn_mfma_f32_32x32x16_bf16(k0, qa[d0], pa0, 0, 0, 0); pa1 = __builtin_amdgcn_mfma_f32_32x32x16_bf16(k1, qa[d0], pa1, 0, 0, 0);
                pb0 = __builtin_amdgcn_mfma_f32_32x32x16_bf16(k0, qbf[d0], pb0, 0, 0, 0); pb1 = __builtin_amdgcn_mfma_f32_32x32x16_bf16(k1, qbf[d0], pb1, 0, 0, 0); }
            if (j == qbw) { mask_range(pa0, pa1, -1, qrela, L.hi); mask_range(pb0, pb1, -1, qrela + 8, L.hi); }
            if (MODE == 1 && j == qbw - 8) { mask_range(pa0, pa1, qrela, 64, L.hi); mask_range(pb0, pb1, qrela + 8, 64, L.hi); }
            bool sela = true, selb = true;
            if (MODE == 0) { sela = (selp[0] >> j) & 1ull; selb = (selp[1] >> j) & 1ull; }
            softmax_step2(pa0, pa1, oa0, oa1, sa, sela, fa);
            __builtin_amdgcn_sched_barrier(0);
            softmax_step2(pb0, pb1, ob0, ob1, sb, selb, fb);
            __builtin_amdgcn_sched_barrier(0);
        }
        if (j < jhi) { kreg = *(const u32x4*)((const char*)Kt + (size_t)(j + 1) * 8192 + L.tid * 16); vreg = vload(Vt, j + 1, L); }
        if (act) {
            const LAS unsigned char* vb = Vbuf + cur * TILE_LDS + L.c * PITCH + L.hi * 16;
#pragma unroll
            for (int s = 0; s < 4; ++s) {
                const bf16x8 v0 = *(const LAS bf16x8*)(vb + s * 32); const bf16x8 v1 = *(const LAS bf16x8*)(vb + 32 * PITCH + s * 32);
                oa0 = __builtin_amdgcn_mfma_f32_32x32x16_bf16(v0, fa[s], oa0, 0, 0, 0); oa1 = __builtin_amdgcn_mfma_f32_32x32x16_bf16(v1, fa[s], oa1, 0, 0, 0);
                ob0 = __builtin_amdgcn_mfma_f32_32x32x16_bf16(v0, fb[s], ob0, 0, 0, 0); ob1 = __builtin_amdgcn_mfma_f32_32x32x16_bf16(v1, fb[s], ob1, 0, 0, 0); }
            renorm_step(oa0, oa1, sa); renorm_step(ob0, ob1, sb);
        }
        if (j < jhi) { *(LAS u32x4*)(Kbuf + (cur ^ 1) * TILE_LDS + so) = kreg; vstore(Vbuf + (cur ^ 1) * TILE_LDS, vreg, L); }
        __syncthreads();
    }
}
}
namespace nsa {
struct AttnPtrs {
    const bf16_t* q;
    const bf16_t* z;
    const bf16_t* kc;
    const bf16_t* vct;
    const bf16_t* ksel;
    const bf16_t* vselt;
    const bf16_t* kwin; const bf16_t* vwint;
    unsigned long long* selmask;
    bf16_t* mix;
};
template <bool ACCUM>
__device__ __forceinline__ void store_o(const f32x16& a0, const f32x16& a1, bf16_t* mix, long tok, int head, int hi) {
    bf16_t* op = mix + tok * 1024 + head * 64 + 4 * hi;
#pragma unroll
    for (int dd = 0; dd < 2; ++dd)
#pragma unroll
        for (int rq = 0; rq < 4; ++rq) {
            float v0, v1, v2, v3;
            if (dd == 0) { v0 = a0[4 * rq]; v1 = a0[4 * rq + 1]; v2 = a0[4 * rq + 2]; v3 = a0[4 * rq + 3]; }
            else         { v0 = a1[4 * rq]; v1 = a1[4 * rq + 1]; v2 = a1[4 * rq + 2]; v3 = a1[4 * rq + 3]; }
            u32x2* p = (u32x2*)(op + dd * 32 + rq * 8);
            if (ACCUM) { const u32x2 old = *p; v0 += bflo(old.x); v1 += bfhi(old.x); v2 += bflo(old.y); v3 += bfhi(old.y); }
            u32x2 w; w.x = cvt_pk_bf16(v0, v1); w.y = cvt_pk_bf16(v2, v3); *p = w;
        }
}
__device__ __forceinline__ float gate_of(const bf16_t* z, long tok, int head, int br) { return sigmoidf_(bf2f(z[tok * INP + ZG + head * 3 + br])); }

struct CmpPre { bf16x8 qr[4]; };
__device__ __forceinline__ void cmp_prefetch(CmpPre& R, int bh, int qb, const AttnPtrs& P, const Lane& L) {
    const int b = bh >> 1, h = bh & 1, tq = qb * 64 + 8 * L.wid + (L.c >> 2), head = 4 * h + (L.c & 3); const long tok = (long)b * SEQ + tq;
    load_q(R.qr, P.q, tok, head, L.hi);
}
__device__ __forceinline__ void cmp_stage(const CmpPre& R, LAS unsigned char* lds, const Lane& L, bf16x8 (&qr)[4], float& gt) {
    (void)lds; (void)L;
#pragma unroll
    for (int d0 = 0; d0 < 4; ++d0) qr[d0] = R.qr[d0];
    gt = 0.f;
}
template <bool STAGE>
__device__ __forceinline__ void cmp_unit(int bh, int qb, const AttnPtrs& P, LAS unsigned char* lds, const Lane& L) {
    const int b = bh >> 1, h = bh & 1, t0 = qb * 64;
    const int ql = 8 * L.wid + (L.c >> 2), g = L.c & 3, tq = t0 + ql, head = 4 * h + g;
    const long tok = (long)b * SEQ + tq;
    LAS unsigned char* Kb = lds; LAS unsigned char* Vb = lds + 4 * TILE_LDS;
    LAS float* G4 = (LAS float*)(lds + 8 * TILE_LDS); LAS float* E3 = G4 + 64 * 64;
    const float gate_raw = bf2f(P.z[tok * INP + ZG + head * 3 + 0]);
    bf16x8 qr[4]; load_q(qr, P.q, tok, head, L.hi);
    u32x4 vv[4];
    if (STAGE) { const char* ks = (const char*)(P.kc + (size_t)bh * 256 * 64); const char* vs = (const char*)(P.vct + (size_t)bh * 256 * 64); const int so = stage_off(L.tid); u32x4 kk[4];
#pragma unroll
      for (int jn = 0; jn < 4; ++jn) kk[jn] = *(const u32x4*)(ks + jn * 8192 + L.tid * 16);
#pragma unroll
      for (int jn = 0; jn < 4; ++jn) vv[jn] = *(const u32x4*)(vs + jn * 8192 + L.tid * 16);
#pragma unroll
      for (int jn = 0; jn < 4; ++jn) *(LAS u32x4*)(Kb + jn * TILE_LDS + so) = kk[jn]; }
    __syncthreads();
    const int nmax = (tq >= 31) ? ((tq - 31) >> 4) : -1;
    const int tq_lo = t0 + 8 * L.wid, tq_hi = tq_lo + 7;
    const int nmax_lo = (tq_lo >= 31) ? ((tq_lo - 31) >> 4) : -1, nmax_hi = (tq_hi >= 31) ? ((tq_hi - 31) >> 4) : -1;
    const int ntile = (nmax_hi >= 0) ? (nmax_hi >> 6) + 1 : 0;
    float l = 0.f;
    for (int jn = 0; jn < ntile; ++jn) {
        f32x16 p0, p1; qk_tile(p0, p1, Kb + jn * TILE_LDS, qr, 0.f, L);
        if (64 * jn + 63 > nmax_lo) mask_range(p0, p1, -1, nmax - 64 * jn, L.hi);
        float ls = 0.f;
#pragma unroll
        for (int r = 0; r < 16; ++r) ls += fast_exp2(p0[r]) + fast_exp2(p1[r]);
        l += ls;
    }
    if (STAGE) { const int so = stage_off(L.tid);
#pragma unroll
      for (int jn = 0; jn < 4; ++jn) *(LAS u32x4*)(Vb + jn * TILE_LDS + so) = vv[jn]; }
    __syncthreads();
    l += xshfl<32>(l);
    const float inv = (nmax >= 0 && l > 0.f) ? fast_rcp(l) : 0.f;
    f32x16 o0, o1;
#pragma unroll
    for (int r = 0; r < 16; ++r) { o0[r] = 0.f; o1[r] = 0.f; }
    for (int jn = 0; jn < ntile; ++jn) {
        f32x16 p0, p1; qk_tile(p0, p1, Kb + jn * TILE_LDS, qr, 0.f, L);
        if (64 * jn + 63 > nmax_lo) mask_range(p0, p1, -1, nmax - 64 * jn, L.hi);
#pragma unroll
        for (int r = 0; r < 16; ++r) { p0[r] = fast_exp2(p0[r]); p1[r] = fast_exp2(p1[r]); }
        pv_tile(o0, o1, Vb + jn * TILE_LDS, p0, p1, L);
#pragma unroll
        for (int kh = 0; kh < 2; ++kh)
#pragma unroll
            for (int rq = 0; rq < 4; ++rq) {
                float gs, e3;
                if (kh == 0) { gs = (p0[4 * rq] + p0[4 * rq + 1]) + (p0[4 * rq + 2] + p0[4 * rq + 3]); e3 = p0[4 * rq + 3]; }
                else         { gs = (p1[4 * rq] + p1[4 * rq + 1]) + (p1[4 * rq + 2] + p1[4 * rq + 3]); e3 = p1[4 * rq + 3]; }
                gs *= inv; e3 *= inv;
                gs += xshfl<1>(gs); gs += xshfl<2>(gs); e3 += xshfl<1>(e3); e3 += xshfl<2>(e3);
                if (g == 0) { const int s = 16 * jn + 8 * kh + 2 * rq + L.hi; G4[ql * 64 + s] = gs; E3[ql * 64 + s] = e3; }
            }
    }
    {
        const float gt = sigmoidf_(gate_raw) * inv;
#pragma unroll
        for (int r = 0; r < 16; ++r) { o0[r] *= gt; o1[r] *= gt; }
        store_o<false>(o0, o1, P.mix, tok, head, L.hi);
    }
    __syncthreads();
}
__device__ __forceinline__ void cmp_topk(int bh, int qb, const AttnPtrs& P, LAS unsigned char* lds, const Lane& L) {
    const int t0 = qb * 64; LAS float* G4 = (LAS float*)(lds + 8 * TILE_LDS); LAS float* E3 = G4 + 64 * 64;
    const int s = L.lane;
    if (qb < 16) { const unsigned long long mask = (1ull << (qb + 1)) - 1ull;
        if (L.lane < 8) P.selmask[(size_t)bh * SEQ + t0 + 8 * L.wid + L.lane] = mask; }
    else {
        const bool cand = (s >= 1) && (s <= qb - 2);
        unsigned bits[8], T[8];
#pragma unroll
        for (int i = 0; i < 8; ++i) { const int q = 8 * L.wid + i; const float imp = G4[q * 64 + s] + (s > 0 ? E3[q * 64 + s - 1] : 0.f); bits[i] = cand ? __float_as_uint(fmaxf(imp, 0.f)) : 0u; T[i] = 0u; }
        int cnt[8];
#pragma unroll
        for (int i = 0; i < 8; ++i) cnt[i] = qb - 2;
        for (int bit = 30; bit >= 0; --bit) { int open_ = 0;
#pragma unroll
            for (int i = 0; i < 8; ++i) { const unsigned c = T[i] | (1u << bit); const int n = __popcll(__ballot(cand && bits[i] >= c)); if (n >= 13) { T[i] = c; cnt[i] = n; } open_ |= (cnt[i] != 13); }
            if (!open_) break; }
#pragma unroll
        for (int i = 0; i < 8; ++i) {
            const unsigned long long gt = __ballot(cand && bits[i] > T[i]); unsigned long long eq = __ballot(cand && bits[i] == T[i]);
            int need = 13 - __popcll(gt); unsigned long long take = 0ull;
            while (need > 0 && eq) { const unsigned long long low = eq & (0ull - eq); take |= low; eq ^= low; --need; }
            const unsigned long long mask = gt | take | 1ull | (1ull << qb) | (1ull << (qb - 1));
            if (L.lane == 0) P.selmask[(size_t)bh * SEQ + t0 + 8 * L.wid + i] = mask; }
    }
    __syncthreads();
}

__device__ __forceinline__ void sw_unit(int bh, int qb, const AttnPtrs& P, LAS unsigned char* lds, const Lane& L) {
    const int b = bh >> 1, h = bh & 1, t0 = qb * 64;
    const int ql = 8 * L.wid + (L.c >> 2), g = L.c & 3, tq = t0 + ql, head = 4 * h + g;
    const long tok = (long)b * SEQ + tq;
    bf16x8 qr[4]; load_q(qr, P.q, tok, head, L.hi);
    const unsigned long long selw = P.selmask[(size_t)bh * SEQ + tq];
    const float g1raw = bf2f(P.z[tok * INP + ZG + head * 3 + 1]), g2raw = bf2f(P.z[tok * INP + ZG + head * 3 + 2]);
    f32x16 r0, r1;
    {
        f32x16 o0, o1; float m = 0.f, l = 0.f;
#pragma unroll
        for (int r = 0; r < 16; ++r) { o0[r] = 0.f; o1[r] = 0.f; }
        run_branch<0>(o0, o1, m, l, P.ksel + (size_t)bh * SEQ * 64, P.vselt + (size_t)bh * SEQ * 64, 0, qb, qb, ql, selw, qr, lds, L);
        l += xshfl<32>(l);
        const float sc = sigmoidf_(g1raw) * fast_rcp(l);
#pragma unroll
        for (int r = 0; r < 16; ++r) { r0[r] = o0[r] * sc; r1[r] = o1[r] * sc; }
    }
    {
        f32x16 o0, o1; float m = 0.f, l = 0.f;
#pragma unroll
        for (int r = 0; r < 16; ++r) { o0[r] = 0.f; o1[r] = 0.f; }
        run_branch<1>(o0, o1, m, l, P.kwin + (size_t)bh * SEQ * 64, P.vwint + (size_t)bh * SEQ * 64, qb >= 8 ? qb - 8 : 0, qb, qb, ql, 0ull, qr, lds, L);
        l += xshfl<32>(l);
        const float sc = sigmoidf_(g2raw) * fast_rcp(l);
#pragma unroll
        for (int r = 0; r < 16; ++r) { r0[r] += o0[r] * sc; r1[r] += o1[r] * sc; }
    }
    store_o<true>(r0, r1, P.mix, tok, head, L.hi);
}
__device__ __forceinline__ void sw_unit2(int bh, int qb2, const AttnPtrs& P, LAS unsigned char* lds, const Lane& L) {
    const int b = bh >> 1, h = bh & 1, qbw = 2 * qb2 + (L.wid >> 2);
    const int qrela = 16 * (L.wid & 3) + (L.c >> 2), qrelb = qrela + 8, g = L.c & 3, head = 4 * h + g;
    const long toka = (long)b * SEQ + 64 * qbw + qrela, tokb = toka + 8;
    bf16x8 qa[4], qbf[4]; load_q(qa, P.q, toka, head, L.hi); load_q(qbf, P.q, tokb, head, L.hi);
    LAS unsigned long long* selp = (LAS unsigned long long*)(lds + 4 * TILE_LDS + 8192) + L.tid * 2;
    selp[0] = P.selmask[(size_t)bh * SEQ + 64 * qbw + qrela]; selp[1] = P.selmask[(size_t)bh * SEQ + 64 * qbw + qrelb];
    LAS float* gpark = (LAS float*)(lds + 4 * TILE_LDS) + L.tid * 4;
    gpark[0] = bf2f(P.z[toka * INP + ZG + head * 3 + 1]); gpark[1] = bf2f(P.z[tokb * INP + ZG + head * 3 + 1]); gpark[2] = bf2f(P.z[toka * INP + ZG + head * 3 + 2]); gpark[3] = bf2f(P.z[tokb * INP + ZG + head * 3 + 2]);
    {
        f32x16 oa0, oa1, ob0, ob1; SoftState sa{0.f, 0.f}, sb{0.f, 0.f};
#pragma unroll
        for (int r = 0; r < 16; ++r) { oa0[r] = 0.f; oa1[r] = 0.f; ob0[r] = 0.f; ob1[r] = 0.f; }
        run_branch2<0>(oa0, oa1, sa, ob0, ob1, sb, P.ksel + (size_t)bh * SEQ * 64, P.vselt + (size_t)bh * SEQ * 64, 0, 2 * qb2 + 1, qbw, qrela, selp, qa, qbf, lds, L);
        sa.l += xshfl<32>(sa.l); sb.l += xshfl<32>(sb.l);
        const float sca = sigmoidf_(gpark[0]) * fast_rcp(sa.l), scb = sigmoidf_(gpark[1]) * fast_rcp(sb.l);
#pragma unroll
        for (int r = 0; r < 16; ++r) { oa0[r] *= sca; oa1[r] *= sca; ob0[r] *= scb; ob1[r] *= scb; }
        { int qe = qrela; asm volatile("" : "+v"(qe));
          store_o<true>(oa0, oa1, P.mix, (long)b * SEQ + 64 * qbw + qe, head, L.hi); store_o<true>(ob0, ob1, P.mix, (long)b * SEQ + 64 * qbw + qe + 8, head, L.hi); }
    }
    {
        f32x16 oa0, oa1, ob0, ob1; SoftState sa{0.f, 0.f}, sb{0.f, 0.f};
#pragma unroll
        for (int r = 0; r < 16; ++r) { oa0[r] = 0.f; oa1[r] = 0.f; ob0[r] = 0.f; ob1[r] = 0.f; }
        run_branch2<1>(oa0, oa1, sa, ob0, ob1, sb, P.kwin + (size_t)bh * SEQ * 64, P.vwint + (size_t)bh * SEQ * 64, 2 * qb2 >= 8 ? 2 * qb2 - 8 : 0, 2 * qb2 + 1, qbw, qrela, selp, qa, qbf, lds, L);
        sa.l += xshfl<32>(sa.l); sb.l += xshfl<32>(sb.l);
        const float sca = sigmoidf_(gpark[2]) * fast_rcp(sa.l), scb = sigmoidf_(gpark[3]) * fast_rcp(sb.l);
#pragma unroll
        for (int r = 0; r < 16; ++r) { oa0[r] *= sca; oa1[r] *= sca; ob0[r] *= scb; ob1[r] *= scb; }
        { int qe = qrela; asm volatile("" : "+v"(qe));
          store_o<true>(oa0, oa1, P.mix, (long)b * SEQ + 64 * qbw + qe, head, L.hi); store_o<true>(ob0, ob1, P.mix, (long)b * SEQ + 64 * qbw + qe + 8, head, L.hi); }
    }
}
}
namespace epi {
using pg8::Unit; using pg8::BM; using pg8::HALF;
struct Bf16Plain {
    static constexpr bool PERM = true;
    bf16_t* O; int ldc;
    __device__ __forceinline__ void operator()(const f32x4 (&acc)[2][2][4][2], const Unit& u, int wr, int wc, int fr, int fq) const {
        const int row0 = u.pm * BM + wr * 64 + fr, col0 = u.pn * BM + wc * 32 + 8 * fq;
#pragma unroll
        for (int ai = 0; ai < 2; ++ai)
#pragma unroll
            for (int m = 0; m < 4; ++m) { bf16_t* rowp = O + (size_t)(row0 + ai * HALF + m * 16) * ldc + col0;
#pragma unroll
                for (int bj = 0; bj < 2; ++bj) { const f32x4 v0 = acc[ai][bj][m][0], v1 = acc[ai][bj][m][1];
                    u32x4 w; w.x = cvt_pk_bf16(v0[0], v0[1]); w.y = cvt_pk_bf16(v0[2], v0[3]); w.z = cvt_pk_bf16(v1[0], v1[1]); w.w = cvt_pk_bf16(v1[2], v1[3]);
                    *(u32x4*)(rowp + bj * HALF) = w; } }
    }
};
struct Bf16Sc1 {
    static constexpr bool PERM = true;
    bf16_t* O; int ldc; unsigned nbytes;
    __device__ __forceinline__ void operator()(const f32x4 (&acc)[2][2][4][2], const Unit& u, int wr, int wc, int fr, int fq) const {
        const __amdgpu_buffer_rsrc_t rsrc = __builtin_amdgcn_make_buffer_rsrc(O, 0, nbytes, 0x00020000);
        const int row0 = u.pm * BM + wr * 64 + fr, col0 = u.pn * BM + wc * 32 + 8 * fq;
#pragma unroll
        for (int ai = 0; ai < 2; ++ai)
#pragma unroll
            for (int m = 0; m < 4; ++m) { const unsigned off = (unsigned)(((size_t)(row0 + ai * HALF + m * 16) * ldc + col0) * 2);
#pragma unroll
                for (int bj = 0; bj < 2; ++bj) { const f32x4 v0 = acc[ai][bj][m][0], v1 = acc[ai][bj][m][1];
                    u32x4 w; w.x = cvt_pk_bf16(v0[0], v0[1]); w.y = cvt_pk_bf16(v0[2], v0[3]); w.z = cvt_pk_bf16(v1[0], v1[1]); w.w = cvt_pk_bf16(v1[2], v1[3]);
                    __builtin_amdgcn_raw_buffer_store_b128(w, rsrc, off + bj * HALF * 2, 0,   16); } }
    }
};
struct F32Grouped {
    static constexpr bool PERM = false;
    float* C; int ldc; size_t gstride;
    __device__ __forceinline__ void operator()(const f32x4 (&acc)[2][2][4][2], const Unit& u, int wr, int wc, int fr, int fq) const {
        const int row0 = u.pm * BM + wr * 64 + fr, col0 = u.pn * BM + wc * 32 + 4 * fq; float* Cg = C + (size_t)u.aux * gstride;
#pragma unroll
        for (int ai = 0; ai < 2; ++ai)
#pragma unroll
            for (int m = 0; m < 4; ++m) { float* rowp = Cg + (size_t)(row0 + ai * HALF + m * 16) * ldc + col0;
#pragma unroll
                for (int bj = 0; bj < 2; ++bj)
#pragma unroll
                    for (int n = 0; n < 2; ++n) *(f32x4*)(rowp + bj * HALF + n * 16) = acc[ai][bj][m][n]; }
    }
};
struct SwiGlu {
    static constexpr bool PERM = true;
    bf16_t* H; int ldc;
    __device__ __forceinline__ void operator()(const f32x4 (&acc)[2][2][4][2], const Unit& u, int wr, int wc, int fr, int fq) const {
        const int row0 = u.pm * BM + wr * 64 + fr, col0 = u.pn * HALF + wc * 32 + 8 * fq;
#pragma unroll
        for (int ai = 0; ai < 2; ++ai)
#pragma unroll
            for (int m = 0; m < 4; ++m) { bf16_t* rowp = H + (size_t)(row0 + ai * HALF + m * 16) * ldc + col0;
                float o[8];
#pragma unroll
                for (int n = 0; n < 2; ++n)
#pragma unroll
                    for (int e = 0; e < 4; ++e) o[4 * n + e] = siluf_(acc[ai][0][m][n][e]) * acc[ai][1][m][n][e];
                u32x4 w; w.x = cvt_pk_bf16(o[0], o[1]); w.y = cvt_pk_bf16(o[2], o[3]); w.z = cvt_pk_bf16(o[4], o[5]); w.w = cvt_pk_bf16(o[6], o[7]);
                *(u32x4*)rowp = w; }
    }
};
struct MoeDown {
    static constexpr bool PERM = true;
    bf16_t* Y; const int* row_tok;
    __device__ __forceinline__ void operator()(const f32x4 (&acc)[2][2][4][2], const Unit& u, int wr, int wc, int fr, int fq) const {
        const int srow0 = u.aux * BM + wr * 64 + fr, col0 = u.pn * BM + wc * 32 + 8 * fq;
        int dsts[8];
#pragma unroll
        for (int it = 0; it < 8; ++it) dsts[it] = row_tok[srow0 + (it >> 2) * HALF + (it & 3) * 16];
#pragma unroll
        for (int ai = 0; ai < 2; ++ai)
#pragma unroll
            for (int m = 0; m < 4; ++m) { const int dst = dsts[ai * 4 + m];
                if (dst >= 0) { bf16_t* rowp = Y + (size_t)dst * D + col0;
#pragma unroll
                    for (int bj = 0; bj < 2; ++bj) { const f32x4 v0 = acc[ai][bj][m][0], v1 = acc[ai][bj][m][1];
                        u32x4 w; w.x = cvt_pk_bf16(v0[0], v0[1]); w.y = cvt_pk_bf16(v0[2], v0[3]); w.z = cvt_pk_bf16(v1[0], v1[1]); w.w = cvt_pk_bf16(v1[2], v1[3]);
                        *(u32x4*)(rowp + bj * HALF) = w; } } }
    }
};
struct SigmoidBias {
    static constexpr bool PERM = true;
    bf16_t* O; int ldc; const float* bias;
    __device__ __forceinline__ void operator()(const f32x4 (&acc)[2][2][4][2], const Unit& u, int wr, int wc, int fr, int fq) const {
        const int row0 = u.pm * BM + wr * 64 + fr, col0 = u.pn * BM + wc * 32 + 8 * fq;
        f32x4 bv[2][2];
#pragma unroll
        for (int bj = 0; bj < 2; ++bj)
#pragma unroll
            for (int n = 0; n < 2; ++n) bv[bj][n] = *(const f32x4*)(bias + col0 + bj * HALF + 4 * n);
#pragma unroll
        for (int ai = 0; ai < 2; ++ai)
#pragma unroll
            for (int m = 0; m < 4; ++m) { bf16_t* rowp = O + (size_t)(row0 + ai * HALF + m * 16) * ldc + col0;
#pragma unroll
                for (int bj = 0; bj < 2; ++bj) { f32x4 v0 = acc[ai][bj][m][0] + bv[bj][0], v1 = acc[ai][bj][m][1] + bv[bj][1];
#pragma unroll
                    for (int e = 0; e < 4; ++e) { v0[e] = sigmoidf_(v0[e]); v1[e] = sigmoidf_(v1[e]); }
                    u32x4 w; w.x = cvt_pk_bf16(v0[0], v0[1]); w.y = cvt_pk_bf16(v0[2], v0[3]); w.z = cvt_pk_bf16(v1[0], v1[1]); w.w = cvt_pk_bf16(v1[2], v1[3]);
                    *(u32x4*)(rowp + bj * HALF) = w; } }
    }
};
struct MulBf16 {
    static constexpr bool PERM = true;
    bf16_t* O; const bf16_t* G; int ldc;
    __device__ __forceinline__ void operator()(const f32x4 (&acc)[2][2][4][2], const Unit& u, int wr, int wc, int fr, int fq) const {
        const int row0 = u.pm * BM + wr * 64 + fr, col0 = u.pn * BM + wc * 32 + 8 * fq;
        u32x4 gq[2], gn[2];
        { const size_t off = (size_t)row0 * ldc + col0; gn[0] = *(const u32x4*)(G + off); gn[1] = *(const u32x4*)(G + off + HALF); }
#pragma unroll
        for (int it = 0; it < 8; ++it) { const int ai = it >> 2, m = it & 3; const size_t off = (size_t)(row0 + ai * HALF + m * 16) * ldc + col0;
            gq[0] = gn[0]; gq[1] = gn[1];
            if (it < 7) { const int ai2 = (it + 1) >> 2, m2 = (it + 1) & 3; const size_t off2 = (size_t)(row0 + ai2 * HALF + m2 * 16) * ldc + col0; gn[0] = *(const u32x4*)(G + off2); gn[1] = *(const u32x4*)(G + off2 + HALF); }
#pragma unroll
            for (int bj = 0; bj < 2; ++bj) { const f32x4 v0 = acc[ai][bj][m][0], v1 = acc[ai][bj][m][1]; const u32x4 g4 = gq[bj];
                u32x4 w; w.x = cvt_pk_bf16(v0[0] * bflo(g4.x), v0[1] * bfhi(g4.x)); w.y = cvt_pk_bf16(v0[2] * bflo(g4.y), v0[3] * bfhi(g4.y));
                w.z = cvt_pk_bf16(v1[0] * bflo(g4.z), v1[1] * bfhi(g4.z)); w.w = cvt_pk_bf16(v1[2] * bflo(g4.w), v1[3] * bfhi(g4.w));
                *(u32x4*)(O + off + bj * HALF) = w; }
            asm volatile("" ::: "memory"); }
    }
};
struct S5Out {
    static constexpr bool PERM = true;
    bf16_t* ZS5; const bf16_t* Z; const float* dskip;
    __device__ __forceinline__ void operator()(const f32x4 (&acc)[2][2][4][2], const Unit& u, int wr, int wc, int fr, int fq) const {
        const int g = u.aux, row0 = u.pm * BM + wr * 64 + fr;
#pragma unroll
        for (int bj = 0; bj < 2; ++bj) { const int col = u.pn * BM + bj * HALF + wc * 32 + 8 * fq, jo = col >> 4, co0 = col & 15, ch0 = g * 16 + co0;
            const f32x4 d0 = *(const f32x4*)(dskip + ch0), d1 = *(const f32x4*)(dskip + ch0 + 4);
#pragma unroll
            for (int ai = 0; ai < 2; ++ai)
#pragma unroll
                for (int m = 0; m < 4; ++m) { const int mr = row0 + ai * HALF + m * 16; const long tok = (long)(mr >> 7) * SEQ + (mr & 127) * S5LC + jo;
                    const u32x4 uq = *(const u32x4*)(Z + tok * INP + ZS + ch0); const f32x4 v0 = acc[ai][bj][m][0], v1 = acc[ai][bj][m][1];
                    u32x4 w; w.x = cvt_pk_bf16(gelu_tanh(v0[0] + d0[0] * bflo(uq.x)), gelu_tanh(v0[1] + d0[1] * bfhi(uq.x)));
                    w.y = cvt_pk_bf16(gelu_tanh(v0[2] + d0[2] * bflo(uq.y)), gelu_tanh(v0[3] + d0[3] * bfhi(uq.y)));
                    w.z = cvt_pk_bf16(gelu_tanh(v1[0] + d1[0] * bflo(uq.z)), gelu_tanh(v1[1] + d1[1] * bfhi(uq.z)));
                    w.w = cvt_pk_bf16(gelu_tanh(v1[2] + d1[2] * bflo(uq.w)), gelu_tanh(v1[3] + d1[3] * bfhi(uq.w)));
                    *(u32x4*)(ZS5 + tok * 256 + ch0) = w; asm volatile("" ::: "memory"); } }
    }
};
struct S5Glu {
    static constexpr bool PERM = true;
    bf16_t* MIX; const bf16_t* ZS5; const float* bias;
    __device__ __forceinline__ void operator()(const f32x4 (&acc)[2][2][4][2], const Unit& u, int wr, int wc, int fr, int fq) const {
        const int row0 = u.pm * BM + wr * 64 + fr, col0 = wc * 32 + 8 * fq;
#pragma unroll
        for (int bj = 0; bj < 2; ++bj) { const int col = col0 + bj * HALF; const f32x4 b0 = *(const f32x4*)(bias + col), b1 = *(const f32x4*)(bias + col + 4);
#pragma unroll
            for (int ai = 0; ai < 2; ++ai)
#pragma unroll
                for (int m = 0; m < 4; ++m) { const size_t row = (size_t)(row0 + ai * HALF + m * 16); const u32x4 zq = *(const u32x4*)(ZS5 + row * 256 + col);
                    const f32x4 v0 = acc[ai][bj][m][0] + b0, v1 = acc[ai][bj][m][1] + b1;
                    u32x4 w; w.x = cvt_pk_bf16(bflo(zq.x) * sigmoidf_(v0[0]), bfhi(zq.x) * sigmoidf_(v0[1])); w.y = cvt_pk_bf16(bflo(zq.y) * sigmoidf_(v0[2]), bfhi(zq.y) * sigmoidf_(v0[3]));
                    w.z = cvt_pk_bf16(bflo(zq.z) * sigmoidf_(v1[0]), bfhi(zq.z) * sigmoidf_(v1[1])); w.w = cvt_pk_bf16(bflo(zq.w) * sigmoidf_(v1[2]), bfhi(zq.w) * sigmoidf_(v1[3]));
                    *(u32x4*)(MIX + row * 1024 + 768 + col) = w; asm volatile("" ::: "memory"); } }
    }
};
struct EpiWin {
    static constexpr bool PERM = true;
    bf16_t* Z; bf16_t* Q; bf16_t* KV; bf16_t* AP; const f32x2* rope;
    __device__ __forceinline__ void operator()(const f32x4 (&acc)[2][2][4][2], const Unit& u, int wr, int wc, int fr, int fq) const {
        const int row0 = u.pm * BM + wr * 64 + fr;
        if (u.pn >= 5) {
#pragma unroll
            for (int bj = 0; bj < 2; ++bj) { const int col0 = u.pn * BM + bj * HALF + wc * 32 + 8 * fq; const int sc0 = col0 - ZS; const bool s5 = (sc0 >= 0) && (sc0 < 256);
#pragma unroll
                for (int ai = 0; ai < 2; ++ai)
#pragma unroll
                    for (int m = 0; m < 4; ++m) { const int tok = row0 + ai * HALF + m * 16; const f32x4 v0 = acc[ai][bj][m][0], v1 = acc[ai][bj][m][1];
                        u32x4 w; w.x = cvt_pk_bf16(v0[0], v0[1]); w.y = cvt_pk_bf16(v0[2], v0[3]); w.z = cvt_pk_bf16(v1[0], v1[1]); w.w = cvt_pk_bf16(v1[2], v1[3]);
                        *(u32x4*)(Z + (size_t)tok * INP + col0) = w;
                        if (s5) { const int b = tok >> 12, t = tok & 4095; *(u32x4*)(AP + ((size_t)(sc0 >> 4) * 2048 + b * 128 + (t >> 5)) * S5K + (t & 31) * 16 + (sc0 & 15)) = w; } } }
            return;
        }
#pragma unroll
        for (int bj = 0; bj < 2; ++bj) {
            const int colh = bj * HALF + wc * 32 + 8 * fq;
            const int qi = 4 * (wc & 1) + fq, d1 = 4 * qi;
            const bool isv = (u.pn >= 2) && (bj == 1);
            f32x4 cn0 = (f32x4){0.f, 0.f, 0.f, 0.f}, cn1 = cn0;
            if (!isv) { cn0 = *(const f32x4*)(rope + (size_t)row0 * 32 + d1); cn1 = *(const f32x4*)(rope + (size_t)row0 * 32 + d1 + 2); }
#pragma unroll
            for (int it = 0; it < 8; ++it) { const int ai = it >> 2, m = it & 3; const int tok = row0 + ai * HALF + m * 16; const int b = tok >> 12, t = tok & 4095; const f32x4 x1 = acc[ai][bj][m][0], x2 = acc[ai][bj][m][1];
                    if (isv) { bf16_t* dst = KV + (size_t)((u.pn - 2) * 2 + 1) * (8u << 20) + ((size_t)(b * 2 + (wc >> 1)) * SEQ + t) * 64 + 32 * (wc & 1) + 8 * fq;
                        u32x4 w; w.x = cvt_pk_bf16(x1[0], x1[1]); w.y = cvt_pk_bf16(x1[2], x1[3]); w.z = cvt_pk_bf16(x2[0], x2[1]); w.w = cvt_pk_bf16(x2[2], x2[3]); *(u32x4*)dst = w; }
                    else { const f32x4 cs0 = cn0, cs1 = cn1;
                        if (it < 7) { const int tok2 = row0 + ((it + 1) >> 2) * HALF + ((it + 1) & 3) * 16; cn0 = *(const f32x4*)(rope + (size_t)tok2 * 32 + d1); cn1 = *(const f32x4*)(rope + (size_t)tok2 * 32 + d1 + 2); }
                        const float sc = (u.pn < 2) ? QSCALE : 1.0f;
                        const float o10 = (x1[0] * cs0[0] - x2[0] * cs0[1]) * sc, o11 = (x1[1] * cs0[2] - x2[1] * cs0[3]) * sc, o12 = (x1[2] * cs1[0] - x2[2] * cs1[1]) * sc, o13 = (x1[3] * cs1[2] - x2[3] * cs1[3]) * sc;
                        const float o20 = (x2[0] * cs0[0] + x1[0] * cs0[1]) * sc, o21 = (x2[1] * cs0[2] + x1[1] * cs0[3]) * sc, o22 = (x2[2] * cs1[0] + x1[2] * cs1[1]) * sc, o23 = (x2[3] * cs1[2] + x1[3] * cs1[3]) * sc;
                        bf16_t* dst = (u.pn < 2) ? Q + (size_t)tok * 512 + (u.pn * 4 + (colh >> 6)) * 64 + d1
                                                 : KV + (size_t)((u.pn - 2) * 2) * (8u << 20) + ((size_t)(b * 2 + (wc >> 1)) * SEQ + t) * 64 + d1;
                        u32x2 w1, w2; w1.x = cvt_pk_bf16(o10, o11); w1.y = cvt_pk_bf16(o12, o13); w2.x = cvt_pk_bf16(o20, o21); w2.y = cvt_pk_bf16(o22, o23);
                        *(u32x2*)dst = w1; *(u32x2*)(dst + 32) = w2; }
                    asm volatile("" ::: "memory"); }
        }
    }
};
}
constexpr size_t MiB = 1u << 20;
constexpr size_t WS_CTL = 0, CTL_ZERO_BYTES = 1 * MiB;
constexpr size_t WS_SMALL = 1 * MiB;
constexpr size_t SM_APOW = WS_SMALL;
constexpr size_t SM_BBAR = WS_SMALL + 5 * MiB / 4;
constexpr size_t SM_KTAB = WS_SMALL + 2 * MiB;
constexpr size_t SM_CMPB = WS_SMALL + 4 * MiB;
constexpr size_t SM_TOKE = WS_SMALL + 4 * MiB + 256 * 1024;
constexpr size_t SM_TOKW = WS_SMALL + 4 * MiB + 512 * 1024;
constexpr size_t SM_ROWTOK = WS_SMALL + 5 * MiB + 256 * 1024;
constexpr size_t SM_PCNT = WS_SMALL + 6 * MiB;
constexpr size_t SM_TILEEXP = WS_SMALL + 6 * MiB + 16384;
constexpr size_t WS_ROPE = 8 * MiB;
constexpr size_t WS_W = 24 * MiB;
constexpr size_t W_IN = WS_W;
constexpr size_t W_OUT = W_IN + (size_t)INP * D * 2;
constexpr size_t W_GATE = W_OUT + (size_t)D * D * 2;
constexpr size_t W_PROJ = W_GATE + (size_t)D * D * 2;
constexpr size_t W_CMP = W_PROJ + (size_t)D * PLE * 2;
constexpr size_t W_GLU = W_CMP + (size_t)2 * 512 * 1024 * 2;
constexpr size_t W_S5B = W_GLU + (size_t)256 * 256 * 2;
constexpr size_t W_S5S = W_S5B + (size_t)16 * 512 * S5K * 2;
constexpr size_t W_UP = W_S5S + (size_t)16 * 256 * 512 * 2;
constexpr size_t W_DN = W_UP + (size_t)NEXP * 2 * DFE * D * 2;
constexpr size_t W_END_ = W_DN + (size_t)NEXP * D * DFE * 2;
static_assert(W_END_ <= WS_W + 240 * MiB, "weight region");
constexpr size_t WS_XB = 264 * MiB;
constexpr size_t WS_PB = 392 * MiB;
constexpr size_t WS_Z = 424 * MiB;
constexpr size_t WS_QKV = 712 * MiB;
constexpr size_t WS_Q = WS_QKV, WS_KCMP = WS_QKV + 64 * MiB, WS_VCMP = WS_KCMP + 16 * MiB, WS_KSEL = WS_VCMP + 16 * MiB, WS_VSEL = WS_KSEL + 16 * MiB, WS_KWIN = WS_VSEL + 16 * MiB, WS_VWIN = WS_KWIN + 16 * MiB;
constexpr size_t WS_MIX = 872 * MiB;
constexpr size_t WS_CMP = 1000 * MiB;
constexpr size_t WS_CMPP = WS_CMP, WS_KC = WS_CMP + 32 * MiB, WS_VCT = WS_KC + 1 * MiB, WS_SELM = WS_VCT + 1 * MiB;
constexpr size_t WS_S5 = 1036 * MiB;
constexpr size_t WS_S5A = WS_S5, WS_S5S = WS_S5 + 40 * MiB, WS_ZS5 = WS_S5S + 32 * MiB;
constexpr size_t WS_HBUF = 1140 * MiB;
constexpr size_t WS_END = 1268 * MiB;
constexpr size_t WS_FFH = WS_Z, WS_XS = WS_Z, WS_MH = WS_Z + 260 * MiB, WS_YB = WS_MH + 224 * MiB;
static_assert(WS_YB + 256 * MiB <= WS_END && WS_FFH + (size_t)T * DFF * 2 <= WS_MIX, "overlays");
constexpr size_t WS_PLEG = WS_Z, WS_PLEH = WS_Z + 128 * MiB;
static_assert(WS_PLEH + 128 * MiB <= WS_MH, "per-layer-embedding buffers of the MoE layers");
constexpr int CW_BAR = 4096;
constexpr int CW_TMO = 64;
constexpr int CW_CNT = 16384, CNT_BANK = 256 * 64;
static_assert((CW_CNT + 8 * CNT_BANK) * 4 <= (int)CTL_ZERO_BYTES, "panel counters inside the per-call memset");

struct Args { const void* in[36]; float* out; unsigned char* ws; int gp_lo, gp_hi, use_bar, pad; };
struct Frame { LAS unsigned char* lds; int tid, lane, wave, G, bid; };
constexpr int RING_BYTES = 131072, LDSCTL_OFF = RING_BYTES, LDS_BYTES = 147456;
typedef __attribute__((address_space(4))) const Args CArgs;
__device__ __forceinline__ void load_args(Args& a) { CArgs* p = (CArgs*)__builtin_amdgcn_kernarg_segment_ptr(); asm volatile("" : "+s"(p)); __builtin_memcpy(&a, p, sizeof(Args)); }
__device__ __forceinline__ Frame make_frame(LAS unsigned char* lds, int wave0) { Frame F; F.lds = lds;
    int w = wave0; asm volatile("" : "+s"(w)); int ln = lane_id_fresh(); F.lane = ln; F.wave = w; F.tid = w * 64 + ln;
    int b = blockIdx.x, g = gridDim.x; asm volatile("" : "+s"(b), "+s"(g)); F.bid = b; F.G = g; return F; }

__constant__ double c_invfreq_rev[32] = {0.15915494309189535, 0.11934937021124886, 0.08949940160889101, 0.06711508300522726, 0.050329212104487035, 0.03774158471741977, 0.0283021958306234, 0.02122365276477766, 0.015915494309189534, 0.011934937021124886, 0.008949940160889102, 0.006711508300522725, 0.005032921210448704, 0.003774158471741977, 0.00283021958306234, 0.0021223652764777662, 0.0015915494309189536, 0.0011934937021124885, 0.0008949940160889102, 0.0006711508300522726, 0.0005032921210448703, 0.00037741584717419774, 0.00028302195830623395, 0.0002122365276477766, 0.00015915494309189535, 0.00011934937021124886, 8.949940160889102e-05, 6.711508300522725e-05, 5.0329212104487035e-05, 3.774158471741978e-05, 2.8302195830623396e-05, 2.122365276477766e-05};

__device__ __forceinline__ void sincos_rev(double rev, float& c, float& s) { const double fr = rev - __builtin_floor(rev); const float f = (float)fr; s = __builtin_amdgcn_sinf(f); c = __builtin_amdgcn_cosf(f); }

template <class Sched>
__device__ __forceinline__ void panels_publish_wait(const Frame& F, unsigned* ctl, int bank, const Sched& S, unsigned need) {
    unsigned* cnt = ctl + CW_CNT + bank * CNT_BANK;
    if (F.tid == 0) { pg8::Unit u; for (int i = 0; S.next(i, u); ++i) __hip_atomic_fetch_add(cnt + 64 * u.pm, 1u, __ATOMIC_RELAXED, __HIP_MEMORY_SCOPE_AGENT); }
    if (F.wave == 0) {
        for (int pm = F.bid; pm < T / 256; pm += F.G) { unsigned spins = 0;
            while ((unsigned)__builtin_amdgcn_readfirstlane(__hip_atomic_load(cnt + 64 * pm, __ATOMIC_RELAXED, __HIP_MEMORY_SCOPE_AGENT)) < need) {
                __builtin_amdgcn_s_sleep(1);
                if (++spins > (1u << 22)) { if (F.lane == 0) __hip_atomic_store(ctl + CW_TMO, 1u, __ATOMIC_RELAXED, __HIP_MEMORY_SCOPE_AGENT); break; }
                if ((spins & 1023u) == 0u && __builtin_amdgcn_readfirstlane(__hip_atomic_load(ctl + CW_TMO, __ATOMIC_RELAXED, __HIP_MEMORY_SCOPE_AGENT))) break; } }
        __builtin_amdgcn_fence(__ATOMIC_ACQUIRE, "agent");
        asm volatile("s_waitcnt vmcnt(0)" ::: "memory");
    }
    __syncthreads();
}
__device__ __forceinline__ void phase_init0(const Frame& F, const Args& a) {
    const size_t gt = (size_t)F.bid * 512 + F.tid, NT = (size_t)F.G * 512;
    const int* pos = (const int*)a.in[2]; f32x2* rope = (f32x2*)(a.ws + WS_ROPE);
    for (size_t i = gt; i < (size_t)T * 32; i += NT) { const int tok = (int)(i >> 5), k = (int)(i & 31); float c, s; sincos_rev((double)pos[tok] * c_invfreq_rev[k], c, s); rope[i] = (f32x2){c, s}; }
    const float* are = (const float*)a.in[14]; const float* aim = (const float*)a.in[15]; const float* ldt = (const float*)a.in[16];
    const float* bre = (const float*)a.in[17]; const float* bim = (const float*)a.in[18];
    f32x2* apow = (f32x2*)(a.ws + SM_APOW); f32x2* bbar = (f32x2*)(a.ws + SM_BBAR);
    for (size_t i = gt; i < (size_t)DEPTH * 16 * 64 * 34; i += NT) { const int k = (int)(i % 34), lgn = (int)(i / 34), lg = lgn >> 6;
        const float dt = __expf(ldt[lg]); const float ar = are[lgn] * dt; const double rev = (double)k * ((double)aim[lgn] * (double)dt) * 0.15915494309189535;
        float c, s; sincos_rev(rev, c, s); const float mg = __expf((float)k * ar); apow[i] = (f32x2){mg * c, mg * s}; }
    for (size_t i = gt; i < (size_t)DEPTH * 16 * 64 * 16; i += NT) { const int lgn = (int)(i >> 4), lg = lgn >> 6;
        const float dt = __expf(ldt[lg]); const float lr = are[lgn], li = aim[lgn]; const double rev = ((double)li * (double)dt) * 0.15915494309189535;
        float c, s; sincos_rev(rev, c, s); const float mg = __expf(lr * dt); const float abr = mg * c, abi = mg * s, den = lr * lr + li * li;
        const float cr = ((abr - 1.0f) * lr + abi * li) / den, ci = (abi * lr - (abr - 1.0f) * li) / den;
        const float br = bre[i], bi = bim[i]; bbar[i] = (f32x2){cr * br - ci * bi, cr * bi + ci * br}; }
    const f32x4* x4 = (const f32x4*)a.in[0]; u32x2* xb = (u32x2*)(a.ws + WS_XB);
    for (size_t i = gt; i < (size_t)T * D / 4; i += 4 * NT) { f32x4 v[4];
#pragma unroll
        for (int q = 0; q < 4; ++q) { const size_t ii = i + q * NT; v[q] = (ii < (size_t)T * D / 4) ? x4[ii] : (f32x4){0.f, 0.f, 0.f, 0.f}; }
#pragma unroll
        for (int q = 0; q < 4; ++q) { const size_t ii = i + q * NT; if (ii < (size_t)T * D / 4) { u32x2 w; w.x = cvt_pk_bf16(v[q][0], v[q][1]); w.y = cvt_pk_bf16(v[q][2], v[q][3]); xb[ii] = w; } } }
}
__device__ __forceinline__ void phase_init1(const Frame& F, const Args& a) {
    const size_t gt = (size_t)F.bid * 512 + F.tid, NT = (size_t)F.G * 512;
    const float* cre = (const float*)a.in[19]; const float* cim = (const float*)a.in[20];
    const f32x2* apow = (const f32x2*)(a.ws + SM_APOW); const f32x2* bbar = (const f32x2*)(a.ws + SM_BBAR); float* ktab = (float*)(a.ws + SM_KTAB);
    for (size_t i = gt; i < (size_t)DEPTH * 16 * 32 * 256; i += NT) { const int ci = (int)(i & 15), co = (int)((i >> 4) & 15), tau = (int)((i >> 8) & 31), lg = (int)(i >> 13);
        float acc = 0.f;
        for (int n = 0; n < 64; ++n) { const f32x2 P = apow[((size_t)lg * 64 + n) * 34 + tau], Bb = bbar[((size_t)lg * 64 + n) * 16 + ci]; const float cr = cre[((size_t)lg * 16 + co) * 64 + n], cm = cim[((size_t)lg * 16 + co) * 64 + n];
            const float hr = P.x * Bb.x - P.y * Bb.y, hi = P.x * Bb.y + P.y * Bb.x; acc += cr * hr - cm * hi; }
        ktab[i] = acc; }
}

__device__ __forceinline__ void transpose_item(const float* W, int ldw, int k0, int n0, int nvalid, bf16_t* dstrow, int dst_ld, LAS float* scr, int lane, int permhi) {
    float tv[32];
#pragma unroll
    for (int i = 0; i < 32; ++i) { const int kk = 2 * i + (lane >> 5), nn = lane & 31; tv[i] = (nn < nvalid) ? W[(size_t)(k0 + kk) * ldw + n0 + nn] : 0.f; }
#pragma unroll
    for (int i = 0; i < 32; ++i) { const int kk = 2 * i + (lane >> 5), nn = lane & 31; scr[kk * 33 + nn] = tv[i]; }
    LDS_WAIT(); asm volatile("" ::: "memory");
    const int c = lane & 7;
#pragma unroll
    for (int j = 0; j < 4; ++j) { const int n = (lane >> 3) + 8 * j; const LAS float* s = scr + (8 * c) * 33 + n;
        u32x4 o; o.x = cvt_pk_bf16(s[0 * 33], s[1 * 33]); o.y = cvt_pk_bf16(s[2 * 33], s[3 * 33]); o.z = cvt_pk_bf16(s[4 * 33], s[5 * 33]); o.w = cvt_pk_bf16(s[6 * 33], s[7 * 33]);
        const int drow = permhi < 0 ? n : (8 * (n >> 2) + 4 * permhi + (n & 3));
        if (n < nvalid) *(u32x4*)(dstrow + (size_t)drow * dst_ld + 8 * c) = o; }
    LDS_WAIT(); asm volatile("" ::: "memory");
}
__device__ __forceinline__ void transpose_mat(const float* W, int K, int N, bf16_t* dst, int dst_ld, int mode, LAS float* scr, int lane, int& cursor, int gw, int NGW) {
    const int nblk = (N + 31) / 32, items = (K / 64) * nblk;
    int it = ((gw - cursor) % NGW + NGW) % NGW;
    for (; it < items; it += NGW) { const int kb = it / nblk, nb = it % nblk, k0 = 64 * kb, n0 = 32 * nb; const int nv = (N - n0) < 32 ? (N - n0) : 32;
        int drow = n0, permhi = -1;
        if (mode == 1 || mode == 2) drow = (n0 >> 7) * 256 + (n0 & 127) + (mode == 2 ? 128 : 0);
        if (mode == 3 && (n0 < 512 || (n0 < 1280 && (((n0 - 512) >> 7) & 1) == 0))) { drow = n0 & ~63; permhi = (n0 >> 5) & 1; }
        transpose_item(W, N, k0, n0, nv, dst + (size_t)drow * dst_ld + k0, dst_ld, scr, lane, permhi); }
    cursor = (cursor + items) % NGW;
}

__device__ __forceinline__ void phase_prep(const Frame& F, const Args& a, int l) {
    LAS float* scr = (LAS float*)(F.lds + F.wave * 16384);
    const int gw = F.bid * 8 + F.wave, NGW = F.G * 8; int cursor = 0;
    unsigned char* ws = a.ws;
    transpose_mat((const float*)a.in[3] + (size_t)l * D * INW, D, INW, (bf16_t*)(ws + W_IN), D, 3, scr, F.lane, cursor, gw, NGW);
    transpose_mat((const float*)a.in[4] + (size_t)l * D * D, D, D, (bf16_t*)(ws + W_OUT), D, 0, scr, F.lane, cursor, gw, NGW);
    transpose_mat((const float*)a.in[31] + (size_t)l * D * D, D, D, (bf16_t*)(ws + W_GATE), D, 0, scr, F.lane, cursor, gw, NGW);
    transpose_mat((const float*)a.in[33] + (size_t)l * PLE * D, PLE, D, (bf16_t*)(ws + W_PROJ), PLE, 0, scr, F.lane, cursor, gw, NGW);
    for (int j = 0; j < 2; ++j) { const float* w1 = (const float*)a.in[6] + ((size_t)l * 2 + j) * 2048 * 256; bf16_t* dst = (bf16_t*)(ws + W_CMP) + (size_t)j * 512 * 1024;
        transpose_mat(w1, 1024, 256, dst, 1024, 0, scr, F.lane, cursor, gw, NGW);
        transpose_mat(w1 + (size_t)1024 * 256, 1024, 256, dst + (size_t)256 * 1024, 1024, 0, scr, F.lane, cursor, gw, NGW); }
    transpose_mat((const float*)a.in[22] + (size_t)l * 256 * 256, 256, 256, (bf16_t*)(ws + W_GLU), 256, 0, scr, F.lane, cursor, gw, NGW);
    const int j2 = l >> 1;
    if ((l & 1) == 0) {
        transpose_mat((const float*)a.in[24] + (size_t)j2 * D * DFF, D, DFF, (bf16_t*)(ws + W_UP), D, 1, scr, F.lane, cursor, gw, NGW);
        transpose_mat((const float*)a.in[25] + (size_t)j2 * D * DFF, D, DFF, (bf16_t*)(ws + W_UP), D, 2, scr, F.lane, cursor, gw, NGW);
        transpose_mat((const float*)a.in[26] + (size_t)j2 * DFF * D, DFF, D, (bf16_t*)(ws + W_DN), DFF, 0, scr, F.lane, cursor, gw, NGW);
    } else {
        for (int e = 0; e < NEXP; ++e) { const size_t eo = (size_t)j2 * NEXP + e;
            transpose_mat((const float*)a.in[28] + eo * D * DFE, D, DFE, (bf16_t*)(ws + W_UP) + (size_t)e * 2 * DFE * D, D, 1, scr, F.lane, cursor, gw, NGW);
            transpose_mat((const float*)a.in[29] + eo * D * DFE, D, DFE, (bf16_t*)(ws + W_UP) + (size_t)e * 2 * DFE * D, D, 2, scr, F.lane, cursor, gw, NGW);
            transpose_mat((const float*)a.in[30] + eo * DFE * D, DFE, D, (bf16_t*)(ws + W_DN) + (size_t)e * D * DFE, DFE, 0, scr, F.lane, cursor, gw, NGW); }
    }
    const size_t gt = (size_t)F.bid * 512 + F.tid, NT = (size_t)F.G * 512;
    {
        u32x4* zp = (u32x4*)((bf16_t*)(ws + W_IN) + (size_t)INW * D); const size_t n16 = (size_t)(INP - INW) * D * 2 / 16;
        unsigned zz = 0u; asm volatile("" : "+v"(zz));
        for (size_t i = gt; i < n16; i += NT) zp[i] = (u32x4){zz, zz, zz, zz};
    }
    {
        const f32x4* p4 = (const f32x4*)((const float*)a.in[1] + (size_t)l * T * PLE); u32x2* pb = (u32x2*)(ws + WS_PB);
        for (size_t i = gt; i < (size_t)T * PLE / 4; i += 4 * NT) { f32x4 v[4];
#pragma unroll
            for (int q = 0; q < 4; ++q) { const size_t ii = i + q * NT; v[q] = (ii < (size_t)T * PLE / 4) ? p4[ii] : (f32x4){0.f, 0.f, 0.f, 0.f}; }
#pragma unroll
            for (int q = 0; q < 4; ++q) { const size_t ii = i + q * NT; if (ii < (size_t)T * PLE / 4) { u32x2 w; w.x = cvt_pk_bf16(v[q][0], v[q][1]); w.y = cvt_pk_bf16(v[q][2], v[q][3]); pb[ii] = w; } } }
    }
    {
        const float* ktab = (const float*)(ws + SM_KTAB) + (size_t)l * 16 * 32 * 256; const f32x2* apow = (const f32x2*)(ws + SM_APOW) + (size_t)l * 16 * 64 * 34; const f32x2* bbar = (const f32x2*)(ws + SM_BBAR) + (size_t)l * 16 * 64 * 16;
        const float* cre = (const float*)a.in[19] + (size_t)l * 16 * 16 * 64; const float* cim = (const float*)a.in[20] + (size_t)l * 16 * 16 * 64;
        bf16_t* Bt = (bf16_t*)(ws + W_S5B);
        for (size_t i = gt; i < (size_t)16 * 512 * S5K; i += NT) { const int k = (int)(i % S5K), row = (int)((i / S5K) & 511), g = (int)(i / ((size_t)S5K * 512)); const int jo = row >> 4, co = row & 15;
            float v;
            if (k < 512) { const int ji = k >> 4, ci = k & 15; v = (jo >= ji) ? ktab[(((size_t)g * 32 + (jo - ji)) * 16 + co) * 16 + ci] : 0.f; }
            else { const int n = (k - 512) & 63; const f32x2 P = apow[((size_t)g * 64 + n) * 34 + jo + 1]; const float cr = cre[((size_t)g * 16 + co) * 64 + n], cm = cim[((size_t)g * 16 + co) * 64 + n];
                v = (k < 576) ? (cr * P.x - cm * P.y) : -(cr * P.y + cm * P.x); }
            Bt[i] = f2bf(v); }
        bf16_t* St = (bf16_t*)(ws + W_S5S);
        for (size_t i = gt; i < (size_t)16 * 256 * 512; i += NT) { const int k = (int)(i & 511), np = (int)((i >> 9) & 255), g = (int)(i >> 17); const int j = k >> 4, ci = k & 15;
            float v = 0.f;
            if (np < 128) { const int n = np & 63; const f32x2 P = apow[((size_t)g * 64 + n) * 34 + (S5LC - 1 - j)], Bb = bbar[((size_t)g * 64 + n) * 16 + ci]; v = (np < 64) ? (P.x * Bb.x - P.y * Bb.y) : (P.x * Bb.y + P.y * Bb.x); }
            St[i] = f2bf(v); }
    }
    {
        float* cb = (float*)(ws + SM_CMPB); LAS float* red = (LAS float*)(F.lds + 8 * 16384 - 4096);
        for (int o = F.bid; o < 8; o += F.G) { const int j = o >> 2, cblk = o & 3; const float* w1 = (const float*)a.in[6] + ((size_t)l * 2 + j) * 2048 * 256 + cblk * 64 + F.lane; const float* pe = (const float*)a.in[5] + ((size_t)l * 2 + j) * 2048;
            float s0 = 0.f, s1 = 0.f, s2 = 0.f, s3 = 0.f;
#pragma unroll 4
            for (int k = 256 * F.wave; k < 256 * F.wave + 256; k += 4) { s0 += pe[k] * w1[(size_t)k * 256]; s1 += pe[k + 1] * w1[(size_t)(k + 1) * 256]; s2 += pe[k + 2] * w1[(size_t)(k + 2) * 256]; s3 += pe[k + 3] * w1[(size_t)(k + 3) * 256]; }
            __syncthreads(); red[F.wave * 64 + F.lane] = (s0 + s1) + (s2 + s3); __syncthreads();
            if (F.wave == 0) { float t = ((const float*)a.in[7])[((size_t)l * 2 + j) * 256 + cblk * 64 + F.lane];
#pragma unroll
                for (int w = 0; w < 8; ++w) t += red[w * 64 + F.lane];
                cb[j * 256 + cblk * 64 + F.lane] = t; }
            __syncthreads(); }
    }
}

__device__ __forceinline__ void conv_items(const Frame& F, const Args& a, int l, int first, int stride, int last = NB * (SEQ / 32)) {
    const bf16_t* z = (const bf16_t*)(a.ws + WS_Z); bf16_t* mix = (bf16_t*)(a.ws + WS_MIX);
    const float* cw = (const float*)a.in[10] + (size_t)l * 31 * 256; const float* cb = (const float*)a.in[11] + (size_t)l * 256;
    const float* lg = (const float*)a.in[12] + (size_t)l * 256; const float* lb = (const float*)a.in[13] + (size_t)l * 256;
    LAS float* U = (LAS float*)F.lds;
    LAS float* Y = (LAS float*)(F.lds + 65536);
    const int cp = F.tid & 127, tg = F.tid >> 7, c = 2 * cp;
    f32x2 w[31];
#pragma unroll
    for (int j = 0; j < 31; ++j) w[j] = *(const f32x2*)(cw + j * 256 + c);
    const f32x2 bias = *(const f32x2*)(cb + c);
    unsigned pva[16], pvg[16];
    auto fetch = [&](int it) { const int b = it >> 7, t0 = (it & 127) * 32;
#pragma unroll
        for (int q = 0; q < 16; ++q) { const int r = tg + 4 * q, t = t0 - 30 + r; pva[q] = 0u; pvg[q] = 0u;
            if (r < 62 && t >= 0) { const bf16_t* zr = z + ((size_t)b * SEQ + t) * INP + ZC; pva[q] = *(const unsigned*)(zr + c); pvg[q] = *(const unsigned*)(zr + 256 + c); } } };
    if (first < last) fetch(first);
    for (int it = first; it < last; it += stride) { const int b = it >> 7, t0 = (it & 127) * 32;
#pragma unroll
        for (int q = 0; q < 16; ++q) { const int r = tg + 4 * q, t = t0 - 30 + r;
            if (r < 62) { f32x2 u = (f32x2){0.f, 0.f}; if (t >= 0) u = (f32x2){bflo(pva[q]) * sigmoidf_(bflo(pvg[q])), bfhi(pva[q]) * sigmoidf_(bfhi(pvg[q]))};
                *(LAS f32x2*)(U + r * 256 + c) = u; } }
        if (it + stride < last) fetch(it + stride);
        __syncthreads();
        {   f32x2 acc[8];
#pragma unroll
            for (int i = 0; i < 8; ++i) acc[i] = bias;
#pragma unroll
            for (int k = 0; k < 38; ++k) { const f32x2 u = *(const LAS f32x2*)(U + (tg * 8 + k) * 256 + c);
#pragma unroll
                for (int i = 0; i < 8; ++i) { const int j = k - i; if (j >= 0 && j < 31) acc[i] += w[j] * u; } }
#pragma unroll
            for (int i = 0; i < 8; ++i) *(LAS f32x2*)(Y + (tg * 8 + i) * 256 + c) = acc[i];
        }
        __syncthreads();
        for (int i = 0; i < 4; ++i) { const int tl = F.wave * 4 + i; const f32x4 v = *(const LAS f32x4*)(Y + tl * 256 + F.lane * 4);
            const float mean = wave_sum((v[0] + v[1]) + (v[2] + v[3])) * (1.f / 256.f); const f32x4 dlt = v - mean;
            const float var = wave_sum((dlt[0] * dlt[0] + dlt[1] * dlt[1]) + (dlt[2] * dlt[2] + dlt[3] * dlt[3])) * (1.f / 256.f); const float rstd = 1.0f / sqrtf(var + LN_EPS);
            const f32x4 gg = *(const f32x4*)(lg + F.lane * 4), bb = *(const f32x4*)(lb + F.lane * 4);
            float o[4];
#pragma unroll
            for (int e = 0; e < 4; ++e) o[e] = siluf_(dlt[e] * rstd * gg[e] + bb[e]);
            u32x2 wv; wv.x = cvt_pk_bf16(o[0], o[1]); wv.y = cvt_pk_bf16(o[2], o[3]);
            *(u32x2*)(mix + ((size_t)b * SEQ + t0 + tl) * 1024 + 512 + F.lane * 4) = wv; }
        __syncthreads();
    }
}
__device__ __forceinline__ void cmp_stage2(const Frame& F, const Args& a, int l) {
    unsigned char* ws = a.ws; const float* cb = (const float*)(ws + SM_CMPB);
    LAS float* w2s = (LAS float*)F.lds;
    LAS float* hs = (LAS float*)(F.lds + 65536 + F.wave * 1024);
    const int gw = F.bid * 8 + F.wave, NGW = F.G * 8, lane = F.lane;
    for (int j = 0; j < 2; ++j) {
        const float* w2 = (const float*)a.in[8] + ((size_t)l * 2 + j) * 256 * 64; const float* b2 = (const float*)a.in[9] + ((size_t)l * 2 + j) * 64;
        __syncthreads();
        for (int i = F.tid; i < 256 * 64 / 4; i += 512) *(LAS f32x4*)(w2s + 4 * i) = *(const f32x4*)(w2 + 4 * i);
        __syncthreads();
        for (int it = gw; it < 32 * 256; it += NGW) { const int bh = it >> 8, n = it & 255;
            float outv = 0.f;
            if (n < NCMP) {
                const float* P = (const float*)(ws + WS_CMPP) + (size_t)j * 8192 * 512 + ((size_t)bh * 256 + n) * 512;
                const f32x4 p0 = *(const f32x4*)(P + lane * 4), p1 = *(const f32x4*)(P + 512 + 256 + lane * 4), bb = *(const f32x4*)(cb + j * 256 + lane * 4);
                f32x4 hv;
#pragma unroll
                for (int e = 0; e < 4; ++e) hv[e] = gelu_tanh(p0[e] + p1[e] + bb[e]);
                *(LAS f32x4*)(hs + lane * 4) = hv; LDS_WAIT(); asm volatile("" ::: "memory");
                float acc0 = b2[lane], acc1 = 0.f, acc2 = 0.f, acc3 = 0.f;
#pragma unroll 4
                for (int c = 0; c < 256; c += 4) { const f32x4 h4 = *(const LAS f32x4*)(hs + c);
                    acc0 += h4[0] * w2s[c * 64 + lane]; acc1 += h4[1] * w2s[(c + 1) * 64 + lane]; acc2 += h4[2] * w2s[(c + 2) * 64 + lane]; acc3 += h4[3] * w2s[(c + 3) * 64 + lane]; }
                outv = (acc0 + acc1) + (acc2 + acc3); LDS_WAIT(); asm volatile("" ::: "memory");
            }
            if (j == 0) ((bf16_t*)(ws + WS_KC))[((size_t)bh * 256 + n) * 64 + lane] = f2bf(outv);
            else ((bf16_t*)(ws + WS_VCT))[((size_t)bh * 4 + (n >> 6)) * 4096 + lane * 64 + nsa::vslot(n & 63)] = f2bf(outv);
        }
    }
    __syncthreads();
}
__device__ __forceinline__ void cmp_stage2_panel(const Frame& F, const Args& a, int l, int j, int bh) {
    constexpr int HP = 528;
    unsigned char* ws = a.ws; const float* cb = (const float*)(ws + SM_CMPB);
    LAS unsigned char* Hs = F.lds;
    LAS unsigned char* Ws = F.lds + 128 * HP;
    const int lane = F.lane, w = F.wave;
    const float* w2 = (const float*)a.in[8] + ((size_t)l * 2 + j) * 256 * 64; const float* b2 = (const float*)a.in[9] + ((size_t)l * 2 + j) * 64;
    const float* Pb = (const float*)(ws + WS_CMPP) + (size_t)j * 8192 * 512 + (size_t)bh * 256 * 512;
    __syncthreads();
    for (int i = F.tid; i < 256 * 64; i += 512) { const int c = i >> 6, d = i & 63; *(LAS bf16_t*)(Ws + d * HP + c * 2) = f2bf(w2[i]); }
    const f32x4 bb = *(const f32x4*)(cb + j * 256 + lane * 4);
    for (int half = 0; half < 2; ++half) {
        __syncthreads();
#pragma unroll 4
        for (int rr = 0; rr < 16; ++rr) { const int r = 16 * w + rr, n = half * 128 + r, n1 = n < 255 ? n + 1 : n;
            const f32x4 p0 = *(const f32x4*)(Pb + (size_t)n * 512 + lane * 4), p1 = *(const f32x4*)(Pb + (size_t)n1 * 512 + 256 + lane * 4);
            u32x2 hv; hv.x = cvt_pk_bf16(gelu_tanh(p0[0] + p1[0] + bb[0]), gelu_tanh(p0[1] + p1[1] + bb[1])); hv.y = cvt_pk_bf16(gelu_tanh(p0[2] + p1[2] + bb[2]), gelu_tanh(p0[3] + p1[3] + bb[3]));
            *(LAS u32x2*)(Hs + r * HP + lane * 8) = hv; }
        __syncthreads();
        f32x4 acc[4];
#pragma unroll
        for (int cbk = 0; cbk < 4; ++cbk) acc[cbk] = (f32x4){0.f, 0.f, 0.f, 0.f};
        const LAS unsigned char* ap = Hs + (16 * w + (lane & 15)) * HP + (lane >> 4) * 16;
        const LAS unsigned char* bp = Ws + (lane & 15) * HP + (lane >> 4) * 16;
#pragma unroll
        for (int ks = 0; ks < 8; ++ks) { const bf16x8 af = *(const LAS bf16x8*)(ap + ks * 64);
#pragma unroll
            for (int cbk = 0; cbk < 4; ++cbk) { const bf16x8 bf = *(const LAS bf16x8*)(bp + cbk * 16 * HP + ks * 64); acc[cbk] = __builtin_amdgcn_mfma_f32_16x16x32_bf16(af, bf, acc[cbk], 0, 0, 0); } }
#pragma unroll
        for (int cbk = 0; cbk < 4; ++cbk) { const int d = 16 * cbk + (lane & 15); const float bv = b2[d];
#pragma unroll
            for (int e = 0; e < 4; ++e) { const int n = half * 128 + 16 * w + 4 * (lane >> 4) + e; const float outv = n < NCMP ? acc[cbk][e] + bv : 0.f;
                if (j == 0) ((bf16_t*)(ws + WS_KC))[((size_t)bh * 256 + n) * 64 + d] = f2bf(outv);
                else ((bf16_t*)(ws + WS_VCT))[((size_t)bh * 4 + (n >> 6)) * 4096 + d * 64 + nsa::vslot(n & 63)] = f2bf(outv); } }
    }
    __syncthreads();
}
__device__ __forceinline__ void s5_carry_panel(const Frame& F, const Args& a, int l, int g, int pm) {
    unsigned char* ws = a.ws; const f32x2* apow = (const f32x2*)(ws + SM_APOW) + (size_t)l * 16 * 64 * 34;
    const float* S = (const float*)(ws + WS_S5S); bf16_t* ap = (bf16_t*)(ws + WS_S5A);
    if (F.tid < 128) { const int n = F.tid & 63, b = 2 * pm + (F.tid >> 6);
        const f32x2 A = apow[((size_t)g * 64 + n) * 34 + S5LC]; float hr = 0.f, hi = 0.f;
        const float* sp = S + ((size_t)g * 2048 + b * 128) * 256 + n; bf16_t* dp = ap + ((size_t)g * 2048 + b * 128) * S5K + 512 + n;
        for (int c0 = 0; c0 < S5NCH; c0 += 8) { float sr[8], si[8];
#pragma unroll
            for (int k = 0; k < 8; ++k) { sr[k] = sp[(size_t)(c0 + k) * 256]; si[k] = sp[(size_t)(c0 + k) * 256 + 64]; }
#pragma unroll
            for (int k = 0; k < 8; ++k) { dp[(size_t)(c0 + k) * S5K] = f2bf(hr); dp[(size_t)(c0 + k) * S5K + 64] = f2bf(hi);
                const float nr = A.x * hr - A.y * hi + sr[k], ni = A.x * hi + A.y * hr + si[k]; hr = nr; hi = ni; } }
    }
}
__device__ __forceinline__ void s5_carry(const Frame& F, const Args& a, int l) {
    unsigned char* ws = a.ws; const f32x2* apow = (const f32x2*)(ws + SM_APOW) + (size_t)l * 16 * 64 * 34;
    const float* S = (const float*)(ws + WS_S5S); bf16_t* ap = (bf16_t*)(ws + WS_S5A);
    const int gt = F.bid * 512 + F.tid, NT = F.G * 512;
    for (int i = gt; i < 16 * NB * 64; i += NT) { const int n = i & 63, b = (i >> 6) & 15, g = i >> 10;
        const f32x2 A = apow[((size_t)g * 64 + n) * 34 + S5LC]; float hr = 0.f, hi = 0.f;
        const float* sp = S + ((size_t)g * 2048 + b * 128) * 256 + n; bf16_t* dp = ap + ((size_t)g * 2048 + b * 128) * S5K + 512 + n;
        for (int c0 = 0; c0 < S5NCH; c0 += 8) { float sr[8], si[8];
#pragma unroll
            for (int k = 0; k < 8; ++k) { sr[k] = sp[(size_t)(c0 + k) * 256]; si[k] = sp[(size_t)(c0 + k) * 256 + 64]; }
#pragma unroll
            for (int k = 0; k < 8; ++k) { dp[(size_t)(c0 + k) * S5K] = f2bf(hr); dp[(size_t)(c0 + k) * S5K + 64] = f2bf(hi);
                const float nr = A.x * hr - A.y * hi + sr[k], ni = A.x * hi + A.y * hr + si[k]; hr = nr; hi = ni; } }
    }
}
template <int MODE, bool ROUTE, bool FINAL>
__device__ __forceinline__ void ln_panel(const Frame& F, const Args& a, int pm, const float* gain, const float* beta, const float* router, size_t h_off = WS_HBUF) {
    unsigned char* ws = a.ws; float* xout = a.out; bf16_t* xb = (bf16_t*)(ws + WS_XB);
    const bf16_t* hb = (const bf16_t*)(ws + (MODE == 0 ? h_off : WS_YB)); const f32x2* tokw = (const f32x2*)(ws + SM_TOKW);
    LAS int* cnt = (LAS int*)F.lds;
    const int lane = F.lane;
    f32x4 gv[4], bv[4];
#pragma unroll
    for (int j = 0; j < 4; ++j) { gv[j] = *(const f32x4*)(gain + 4 * lane + 256 * j); bv[j] = *(const f32x4*)(beta + 4 * lane + 256 * j); }
    if (ROUTE) { if (F.tid < 8) cnt[F.tid] = 0; __syncthreads(); }
    u32x2 nx[4], nh0[4], nh1[4]; f32x2 nw = (f32x2){0.f, 0.f};
    { const size_t row = (size_t)pm * 256 + F.wave * 32; if (MODE == 1) nw = tokw[row];
#pragma unroll
      for (int j = 0; j < 4; ++j) { nx[j] = *(const u32x2*)(xb + row * D + 4 * lane + 256 * j);
          if (MODE == 0) { nh0[j] = *(const u32x2*)(hb + row * D + 4 * lane + 256 * j); nh1[j] = nh0[j]; } else { nh0[j] = *(const u32x2*)(hb + (2 * row) * D + 4 * lane + 256 * j); nh1[j] = *(const u32x2*)(hb + (2 * row + 1) * D + 4 * lane + 256 * j); } } }
    for (int i = 0; i < 32; ++i) { const size_t row = (size_t)pm * 256 + F.wave * 32 + i;
        f32x4 v[4]; float s = 0.f;
        u32x2 cx[4], ch0[4], ch1[4]; const f32x2 w01 = nw;
#pragma unroll
        for (int j = 0; j < 4; ++j) { cx[j] = nx[j]; ch0[j] = nh0[j]; ch1[j] = nh1[j]; }
        if (i < 31) { const size_t rn = row + 1; if (MODE == 1) nw = tokw[rn];
#pragma unroll
            for (int j = 0; j < 4; ++j) { nx[j] = *(const u32x2*)(xb + rn * D + 4 * lane + 256 * j);
                if (MODE == 0) { nh0[j] = *(const u32x2*)(hb + rn * D + 4 * lane + 256 * j); nh1[j] = nh0[j]; } else { nh0[j] = *(const u32x2*)(hb + (2 * rn) * D + 4 * lane + 256 * j); nh1[j] = *(const u32x2*)(hb + (2 * rn + 1) * D + 4 * lane + 256 * j); } } }
#pragma unroll
        for (int j = 0; j < 4; ++j) { const u32x2 xq = cx[j]; const f32x4 xv = (f32x4){bflo(xq.x), bfhi(xq.x), bflo(xq.y), bfhi(xq.y)}; f32x4 hv;
            if (MODE == 0) { const u32x2 q = ch0[j]; hv = (f32x4){bflo(q.x), bfhi(q.x), bflo(q.y), bfhi(q.y)}; }
            else { const u32x2 q0 = ch0[j], q1 = ch1[j];
                hv = (f32x4){w01.x * bflo(q0.x) + w01.y * bflo(q1.x), w01.x * bfhi(q0.x) + w01.y * bfhi(q1.x), w01.x * bflo(q0.y) + w01.y * bflo(q1.y), w01.x * bfhi(q0.y) + w01.y * bfhi(q1.y)}; }
            v[j] = xv * ALPHA + hv; s += (v[j][0] + v[j][1]) + (v[j][2] + v[j][3]); }
        const float mean = wave_sum(s) * (1.f / D); float s2 = 0.f;
#pragma unroll
        for (int j = 0; j < 4; ++j) { v[j] = v[j] - mean; s2 += (v[j][0] * v[j][0] + v[j][1] * v[j][1]) + (v[j][2] * v[j][2] + v[j][3] * v[j][3]); }
        const float rstd = 1.0f / sqrtf(wave_sum(s2) * (1.f / D) + LN_EPS);
#pragma unroll
        for (int j = 0; j < 4; ++j) { v[j] = v[j] * rstd * gv[j] + bv[j];
            if (FINAL) *(f32x4*)(xout + row * D + 4 * lane + 256 * j) = v[j];
            u32x2 w; w.x = cvt_pk_bf16(v[j][0], v[j][1]); w.y = cvt_pk_bf16(v[j][2], v[j][3]); *(u32x2*)(xb + row * D + 4 * lane + 256 * j) = w; }
        if (ROUTE) {
            float lg[8];
#pragma unroll
            for (int e = 0; e < 8; ++e) lg[e] = 0.f;
#pragma unroll
            for (int j = 0; j < 4; ++j)
#pragma unroll
                for (int k = 0; k < 4; ++k) { const float* rr = router + (size_t)(4 * lane + 256 * j + k) * 8; const f32x4 r0 = *(const f32x4*)rr, r1 = *(const f32x4*)(rr + 4); const float xv = v[j][k];
                    lg[0] += xv * r0[0]; lg[1] += xv * r0[1]; lg[2] += xv * r0[2]; lg[3] += xv * r0[3]; lg[4] += xv * r1[0]; lg[5] += xv * r1[1]; lg[6] += xv * r1[2]; lg[7] += xv * r1[3]; }
            {
                const bool h5 = (lane & 32) != 0, h4 = (lane & 16) != 0, h3 = (lane & 8) != 0;
                float r4[4], r2[2], r1;
#pragma unroll
                for (int i = 0; i < 4; ++i) { const float send = h5 ? lg[i] : lg[4 + i], mine = h5 ? lg[4 + i] : lg[i]; r4[i] = mine + xshfl<32>(send); }
#pragma unroll
                for (int i = 0; i < 2; ++i) { const float send = h4 ? r4[i] : r4[2 + i], mine = h4 ? r4[2 + i] : r4[i]; r2[i] = mine + xshfl<16>(send); }
                { const float send = h3 ? r2[0] : r2[1], mine = h3 ? r2[1] : r2[0]; r1 = mine + xshfl<8>(send); }
                r1 += xshfl<4>(r1); r1 += xshfl<2>(r1); r1 += xshfl<1>(r1);
#pragma unroll
                for (int e = 0; e < 8; ++e) lg[e] = __builtin_bit_cast(float, __builtin_amdgcn_readlane(__builtin_bit_cast(int, r1), 8 * e));
            }
            int e0 = 0; float m0 = lg[0];
#pragma unroll
            for (int e = 1; e < 8; ++e) if (lg[e] > m0) { m0 = lg[e]; e0 = e; }
            int e1 = -1; float m1 = -3.0e38f;
#pragma unroll
            for (int e = 0; e < 8; ++e) if (e != e0 && lg[e] > m1) { m1 = lg[e]; e1 = e; }
            const float w0 = 1.0f / (1.0f + __expf(m1 - m0));
            if (lane == 0) { ((int*)(ws + SM_TOKE))[row] = e0 | (e1 << 8); ((f32x2*)(ws + SM_TOKW))[row] = (f32x2){w0, 1.0f - w0}; __hip_atomic_fetch_add(&cnt[e0], 1, __ATOMIC_RELAXED, __HIP_MEMORY_SCOPE_WORKGROUP); __hip_atomic_fetch_add(&cnt[e1], 1, __ATOMIC_RELAXED, __HIP_MEMORY_SCOPE_WORKGROUP); }
        }
    }
    if (ROUTE) { __syncthreads(); if (F.tid < 8) ((int*)(ws + SM_PCNT))[pm * 8 + F.tid] = cnt[F.tid]; __syncthreads(); }
}
__device__ __forceinline__ void moe_gather(const Frame& F, const Args& a) {
    unsigned char* ws = a.ws; const int* pcnt = (const int*)(ws + SM_PCNT); const int* toke = (const int*)(ws + SM_TOKE);
    int* rowtok = (int*)(ws + SM_ROWTOK); int* tileexp = (int*)(ws + SM_TILEEXP);
    const bf16_t* xb = (const bf16_t*)(ws + WS_XB); bf16_t* xs = (bf16_t*)(ws + WS_XS);
    LAS int* sm = (LAS int*)F.lds;
    for (int pm = F.bid; pm < T / 256; pm += F.G) {
        for (int q = F.tid; q < (T / 256) * 8; q += 512) sm[1024 + q] = pcnt[q];
        if (F.tid >= 32 && F.tid < 288) sm[F.tid] = toke[pm * 256 + F.tid - 32];
        __syncthreads();
        if (F.tid < 8) { int tot = 0, before = 0; for (int q = 0; q < T / 256; ++q) { const int c = sm[1024 + q * 8 + F.tid]; tot += c; if (q < pm) before += c; } sm[F.tid] = tot; sm[16 + F.tid] = before; }
        __syncthreads();
        if (F.tid == 0) { int st = 0; for (int e = 0; e < 8; ++e) { sm[8 + e] = st * 256; st += (sm[e] + 255) >> 8; } sm[24] = st; }
        __syncthreads();
        {
            const int i = F.tid >> 1, k = F.tid & 1; const int ee = sm[32 + i]; const int e = k ? (ee >> 8) : (ee & 255);
            int cntb = 0; for (int q = 0; q < i; ++q) { const int o = sm[32 + q]; cntb += ((o & 255) == e) + ((o >> 8) == e); }
            const int dest = sm[8 + e] + sm[16 + e] + cntb; sm[512 + F.tid] = dest; rowtok[dest] = 2 * (pm * 256 + i) + k;
        }
        __syncthreads();
        for (int r0 = F.wave * 64; r0 < F.wave * 64 + 64; r0 += 8) {
            u32x4 va[8], vb[8];
#pragma unroll
            for (int q = 0; q < 8; ++q) { const size_t tok = (size_t)pm * 256 + ((r0 + q) >> 1); const u32x4* s = (const u32x4*)(xb + tok * D); va[q] = s[F.lane]; vb[q] = s[64 + F.lane]; }
#pragma unroll
            for (int q = 0; q < 8; ++q) { const int dest = sm[512 + r0 + q]; u32x4* d = (u32x4*)(xs + (size_t)dest * D); d[F.lane] = va[q]; d[64 + F.lane] = vb[q]; } }
        if (pm == 0) {
            for (int e = 0; e < 8; ++e) { const int r0 = sm[8 + e] + sm[e], r1 = sm[8 + e] + (((sm[e] + 255) >> 8) << 8); for (int r = r0 + F.tid; r < r1; r += 512) rowtok[r] = -1;
                const int t0 = sm[8 + e] >> 8, t1 = r1 >> 8; for (int t = t0 + F.tid; t < t1; t += 512) tileexp[t] = e; }
            if (F.tid == 0) tileexp[1023] = sm[24];
        }
        __syncthreads();
    }
}

__device__ __forceinline__ void moe_tail_finalize(const Frame& F, const Args& a) {
    const int* tileexp = (const int*)(a.ws + SM_TILEEXP); int nt = tileexp[1023] - (MOE_NCHUNK - 1) * MOE_CHUNK_TILES; nt = nt < 0 ? 0 : (nt > 8 ? 8 : nt);
    const float* YT = (const float*)(a.ws + WS_XS); const int* row_tok = (const int*)(a.ws + SM_ROWTOK) + (MOE_NCHUNK - 1) * MOE_CHUNK_TILES * 256; bf16_t* Y = (bf16_t*)(a.ws + WS_YB);
    const int c8 = (F.tid & 127) * 8;
    for (int r = F.bid * 4 + (F.tid >> 7); r < nt * 256; r += F.G * 4) { const int dst = row_tok[r]; if (dst < 0) continue;
        f32x4 s0 = (f32x4){0.f, 0.f, 0.f, 0.f}, s1 = s0;
#pragma unroll
        for (int ks = 0; ks < 7; ++ks) { const float* p = YT + ((size_t)ks * 2048 + r) * D + c8; s0 += *(const f32x4*)p; s1 += *(const f32x4*)(p + 4); }
        u32x4 w; w.x = cvt_pk_bf16(s0[0], s0[1]); w.y = cvt_pk_bf16(s0[2], s0[3]); w.z = cvt_pk_bf16(s1[0], s1[1]); w.w = cvt_pk_bf16(s1[2], s1[3]);
        *(u32x4*)(Y + (size_t)dst * D + c8) = w; }
}
struct MoeUpOrder { int ntile, G, c, chunk; const int* tileexp;
    __device__ __forceinline__ bool next(int i, pg8::Unit& u) const { if (!pg8::static_tile(i, G, c, ntile, 2 * DFE / 256, u.pm, u.pn)) return false;
        const int tile = chunk * MOE_CHUNK_TILES + u.pm, e = tileexp[tile]; u.aux = tile; u.offA = (long long)tile * 256 * D * 2; u.offB = ((long long)e * 2 * DFE + (long long)u.pn * 256) * D * 2; return true; } };
struct MoeDnOrder { int ntile, G, c, chunk; const int* tileexp;
    __device__ __forceinline__ bool next(int i, pg8::Unit& u) const { if (!pg8::static_tile(i, G, c, ntile, D / 256, u.pm, u.pn)) return false;
        const int tile = chunk * MOE_CHUNK_TILES + u.pm, e = tileexp[tile]; u.aux = tile; u.offA = (long long)u.pm * 256 * DFE * 2; u.offB = ((long long)e * D + (long long)u.pn * 256) * DFE * 2; return true; } };

struct MoeDnTailOrder { int ntile, G, c; const int* tileexp;
    __device__ __forceinline__ bool next(int i, pg8::Unit& u) const { const long L = (long)i * G + c; if (L >= (long)ntile * 28) return false;
        const int ks = (int)(L % 7), rest = (int)(L / 7); u.pn = rest & 3; u.pm = rest >> 2; u.aux = ks;
        const int tile = (MOE_NCHUNK - 1) * MOE_CHUNK_TILES + u.pm, e = tileexp[tile];
        u.offA = (long long)u.pm * 256 * DFE * 2 + (long long)ks * 512 * 2; u.offB = ((long long)e * D + (long long)u.pn * 256) * DFE * 2 + (long long)ks * 512 * 2; return true; } };

enum { PH_PREP = 0, PH_WIN, PH_POST, PH_MIX1, PH_MIX2, PH_MIX3, PH_MIX4, PH_WOUT, PH_LN1, PH_FUP, PH_FDN, PH_MGATH = 9, PH_MUP0 = 10, PH_LN2 = 21, PH_PGATE, PH_PPROJ, PH_LN3, PH_PER_LAYER = 32 };
constexpr int GP_END = 2 + 32 * DEPTH;

__global__ void __launch_bounds__(512, 2) mk_fwd(Args a0) {
    extern __shared__ __attribute__((aligned(16))) unsigned char lds_raw[];
    LAS unsigned char* const lds = (LAS unsigned char*)lds_raw;
    for (int u = threadIdx.x; u < (LDS_BYTES - LDSCTL_OFF) / 4; u += 512) ((LAS unsigned*)(lds + LDSCTL_OFF))[u] = 0u;
    __syncthreads();
    const int gp_lo = a0.gp_lo, gp_hi = a0.gp_hi; const int F0bid = blockIdx.x, F0G = gridDim.x; const int wave0 = __builtin_amdgcn_readfirstlane(threadIdx.x >> 6);
    XcdBarrier bar; bar.bar = (unsigned*)(a0.ws + WS_CTL) + CW_BAR; bar.x = 0; bar.st = nullptr;
    if (a0.use_bar) bar = xcd_barrier_post((unsigned*)(a0.ws + WS_CTL) + CW_BAR, (volatile LAS unsigned*)(lds + LDSCTL_OFF + 32));
#if MK_PROBE
#define PRW ((volatile LAS unsigned*)(lds + LDSCTL_OFF + 128))
    if (threadIdx.x == 0) { const unsigned long long t_ = __builtin_amdgcn_s_memrealtime(); PRW[0] = (unsigned)t_; PRW[1] = (unsigned)(t_ >> 32); PRW[2] = 0u; PRW[3] = 0u; PRW[4] = (unsigned)t_; PRW[5] = (unsigned)(t_ >> 32); }
#define STAMP(cls) do { if (wave0 == 0 && lane_id_fresh() == 0) { const unsigned long long t_ = __builtin_amdgcn_s_memrealtime(); const unsigned long long p_ = ((unsigned long long)PRW[1] << 32) | PRW[0]; const unsigned d_ = (unsigned)(t_ - p_); \
        PRW[0] = (unsigned)t_; PRW[1] = (unsigned)(t_ >> 32); if ((PROBE_A >> (cls)) & 1) PRW[2] += d_; if ((PROBE_B >> (cls)) & 1) PRW[3] += d_; } } while (0)
#else
#define STAMP(cls) do {} while (0)
#endif
#define RUN(gp) (gp_lo <= (gp) && (gp) < gp_hi)
#define SEAM(gp) do { if (gp_lo <= (gp) && (gp) + 1 < gp_hi) xcd_barrier(bar, wave0); } while (0)
#define PH_BEGIN Args a; load_args(a); const Frame F = make_frame(lds, wave0); unsigned char* const ws = a.ws; int l = lx; asm volatile("" : "+s"(l)); (void)l; (void)ws; \
    bf16_t* const xb = (bf16_t*)(ws + WS_XB); bf16_t* const z = (bf16_t*)(ws + WS_Z); bf16_t* const mix = (bf16_t*)(ws + WS_MIX); bf16_t* const hbuf = (bf16_t*)(ws + WS_HBUF); const long long S1K = 256ll * 1024 * 2; \
    (void)xb; (void)z; (void)mix; (void)hbuf; (void)S1K;
#define AP_DEF const nsa::Lane L{F.lane, F.lane & 31, F.lane >> 5, F.wave, F.tid}; \
    const nsa::AttnPtrs AP{(const bf16_t*)(ws + WS_Q), z, (const bf16_t*)(ws + WS_KC), (const bf16_t*)(ws + WS_VCT), (const bf16_t*)(ws + WS_KSEL), (const bf16_t*)(ws + WS_VSEL), \
                           (const bf16_t*)(ws + WS_KWIN), (const bf16_t*)(ws + WS_VWIN), (unsigned long long*)(ws + WS_SELM), mix};
    { const int lx = 0;
    if (RUN(0)) { PH_BEGIN phase_init0(F, a); }
    SEAM(0); STAMP(0);
    if (RUN(1)) { PH_BEGIN phase_init1(F, a); }
    SEAM(1); STAMP(0);
    }
    for (int lx = 0; lx < DEPTH; ++lx) {
        const int base = 2 + PH_PER_LAYER * lx; const bool moe = (lx & 1) != 0;
        if (RUN(base + PH_PREP)) { PH_BEGIN phase_prep(F, a, l); }
        SEAM(base + PH_PREP); STAMP(1);
        if (RUN(base + PH_WIN)) { PH_BEGIN
            pg8::Gemm g{xb, (const bf16_t*)(ws + W_IN), D, D, D}; pg8::PlainOrder S{T / 256, INP / 256, F.G, F.bid, S1K, S1K};
            epi::EpiWin E{z, (bf16_t*)(ws + WS_Q), (bf16_t*)(ws + WS_KCMP), (bf16_t*)(ws + WS_S5A), (const f32x2*)(ws + WS_ROPE)};
            pg8::gemm_phase(F.lds, g, S, E, F.tid);
        }
        SEAM(base + PH_WIN); STAMP(2);
        if (RUN(base + PH_MIX1)) {
            for (int r = F0bid; r < 128; r += F0G) {
                {   PH_BEGIN const int g_ = r >> 3, pm_ = r & 7;
                    pg8::Gemm g{(const bf16_t*)(ws + WS_S5A), (const bf16_t*)(ws + W_S5S), 512, S5K, 512};
                    pg8::ListOrder S{1, pm_, g_, (long long)g_ * 2048 * S5K * 2 + (long long)pm_ * 256 * S5K * 2, (long long)g_ * 256 * 512 * 2, 0}; epi::F32Grouped E{(float*)(ws + WS_S5S), 256, (size_t)2048 * 256};
                    pg8::gemm_phase(F.lds, g, S, E, F.tid); }
                __syncthreads();
                {   PH_BEGIN int nr = MK_REP_CARRY; asm volatile("" : "+s"(nr)); for (int q = 0; q < nr; ++q) s5_carry_panel(F, a, l, r >> 3, r & 7); }
                asm volatile("s_waitcnt vmcnt(0)" ::: "memory"); __syncthreads();
                {   PH_BEGIN const int g_ = r >> 3, pm_ = r & 7;
                    pg8::Gemm g{(const bf16_t*)(ws + WS_S5A), (const bf16_t*)(ws + W_S5B), S5K, S5K, S5K};
                    pg8::ListOrder S{2, pm_, g_, (long long)g_ * 2048 * S5K * 2 + (long long)pm_ * 256 * S5K * 2, (long long)g_ * 512 * S5K * 2, 256ll * S5K * 2}; epi::S5Out E{(bf16_t*)(ws + WS_ZS5), z, (const float*)a.in[21] + (size_t)l * 256};
                    pg8::gemm_phase(F.lds, g, S, E, F.tid); }
            }
            for (int r = F0bid - 128; r < 64; r += F0G) { if (r < 0) continue;
                {   PH_BEGIN const int j_ = r >> 5, bh_ = r & 31;
                    pg8::Gemm g{(const bf16_t*)(ws + WS_KCMP), (const bf16_t*)(ws + W_CMP), 1024, 1024, 1024};
                    pg8::ListOrder S{2, bh_, j_, (long long)j_ * (long long)(WS_VCMP - WS_KCMP) + (long long)bh_ * S1K, (long long)j_ * 512 * 1024 * 2, S1K}; epi::F32Grouped E{(float*)(ws + WS_CMPP), 512, (size_t)8192 * 512};
                    pg8::gemm_phase(F.lds, g, S, E, F.tid); }
                asm volatile("s_waitcnt vmcnt(0)" ::: "memory"); __syncthreads();
                {   PH_BEGIN int nr = MK_REP_ST2; asm volatile("" : "+s"(nr)); for (int q = 0; q < nr; ++q) cmp_stage2_panel(F, a, l, r >> 5, r & 31); }
            }
            {   PH_BEGIN
                if (F.G == 256) { const int c = F.bid; const int beg = c < 128 ? c * 5 : (c < 192 ? 640 + (c - 128) * 6 : 1024 + (c - 192) * 16), cnt = c < 128 ? 5 : (c < 192 ? 6 : 16); conv_items(F, a, l, beg, 1, beg + cnt); }
                else conv_items(F, a, l, F.bid, F.G); }
        }
        SEAM(base + PH_MIX1); STAMP(4);
        if (RUN(base + PH_MIX3)) {
            {   PH_BEGIN
                pg8::Gemm g{(const bf16_t*)(ws + WS_ZS5), (const bf16_t*)(ws + W_GLU), 256, 256, 256};
                pg8::PlainOrder S{T / 256, 1, F.G, F.bid, 256ll * 256 * 2, 256ll * 256 * 2}; epi::S5Glu E{mix, (const bf16_t*)(ws + WS_ZS5), (const float*)a.in[23] + (size_t)l * 256};
                pg8::gemm_phase(F.lds, g, S, E, F.tid);
            }
            {   PH_BEGIN AP_DEF
                for (int p = F.bid; p < 32 * 16; p += F.G) { const int bh = p >> 4, s = p & 15;
                    for (int half = 0; half < 2; ++half) { const int qb2 = half ? 31 - s : s;
                        nsa::cmp_unit<true>(bh, 2 * qb2, AP, F.lds, L); nsa::cmp_topk(bh, 2 * qb2, AP, F.lds, L);
                        nsa::cmp_unit<false>(bh, 2 * qb2 + 1, AP, F.lds, L); nsa::cmp_topk(bh, 2 * qb2 + 1, AP, F.lds, L); } } }
            asm volatile("s_waitcnt vmcnt(0)" ::: "memory"); __syncthreads();
            {   PH_BEGIN AP_DEF
                for (int p = F.bid; p < 32 * 16; p += F.G) { const int bh = p >> 4, s = p & 15; nsa::sw_unit2(bh, s, AP, F.lds, L); nsa::sw_unit2(bh, 31 - s, AP, F.lds, L); } }
        }
        SEAM(base + PH_MIX3); STAMP(6);

        if (RUN(base + PH_WOUT)) {
            {   PH_BEGIN
                pg8::Gemm g{mix, (const bf16_t*)(ws + W_OUT), D, D, D}; pg8::PlainOrder S{T / 256, D / 256, F.G, F.bid, S1K, S1K}; epi::Bf16Sc1 E{hbuf, D, (unsigned)((size_t)T * D * 2)};
                pg8::gemm_phase(F.lds, g, S, E, F.tid);
            }
            {   PH_BEGIN pg8::PlainOrder S{T / 256, D / 256, F.G, F.bid, S1K, S1K}; panels_publish_wait(F, (unsigned*)(ws + WS_CTL), 2 * l + 0, S, (unsigned)(D / 256)); }
            {   PH_BEGIN
                const float* gg = (const float*)a.in[34] + ((size_t)l * 3 + 0) * D; const float* bb = (const float*)a.in[35] + ((size_t)l * 3 + 0) * D;
                for (int pm = F.bid; pm < T / 256; pm += F.G) { if (l & 1) ln_panel<0, true, false>(F, a, pm, gg, bb, (const float*)a.in[27] + (size_t)(l >> 1) * D * NEXP); else ln_panel<0, false, false>(F, a, pm, gg, bb, nullptr); }
            }
        }
        SEAM(base + PH_WOUT); STAMP(8);
        if (!moe) {
            if (RUN(base + PH_FUP)) { PH_BEGIN
                pg8::Gemm g{xb, (const bf16_t*)(ws + W_UP), D, D, D}; pg8::PlainOrder S{T / 256, 2 * DFF / 256, F.G, F.bid, S1K, S1K}; epi::SwiGlu E{(bf16_t*)(ws + WS_FFH), DFF};
                pg8::gemm_phase(F.lds, g, S, E, F.tid);
            }
            SEAM(base + PH_FUP); STAMP(9);
            if (RUN(base + PH_FDN)) {
                {   PH_BEGIN
                    pg8::Gemm g{(const bf16_t*)(ws + WS_FFH), (const bf16_t*)(ws + W_DN), DFF, DFF, DFF}; pg8::PlainOrder S{T / 256, D / 256, F.G, F.bid, 256ll * DFF * 2, 256ll * DFF * 2}; epi::Bf16Sc1 E{hbuf, D, (unsigned)((size_t)T * D * 2)};
                    pg8::gemm_phase(F.lds, g, S, E, F.tid);
                }
                {   PH_BEGIN pg8::PlainOrder S{T / 256, D / 256, F.G, F.bid, 256ll * DFF * 2, 256ll * DFF * 2}; panels_publish_wait(F, (unsigned*)(ws + WS_CTL), 2 * l + 1, S, (unsigned)(D / 256)); }
                {   PH_BEGIN
                    const float* gg = (const float*)a.in[34] + ((size_t)l * 3 + 1) * D; const float* bb = (const float*)a.in[35] + ((size_t)l * 3 + 1) * D;
                    for (int pm = F.bid; pm < T / 256; pm += F.G) ln_panel<0, false, false>(F, a, pm, gg, bb, nullptr);
                }
            }
            asm volatile("s_waitcnt vmcnt(0)" ::: "memory"); __syncthreads(); STAMP(10);
        } else {
            if (RUN(base + PH_MGATH)) { PH_BEGIN moe_gather(F, a); }
            SEAM(base + PH_MGATH); STAMP(11);
            for (int cx = 0; cx < MOE_NCHUNK; ++cx) {
                if (RUN(base + PH_MUP0 + 2 * cx)) { PH_BEGIN int c = cx; asm volatile("" : "+s"(c)); const int* tileexp = (const int*)(ws + SM_TILEEXP);
                    int nt = tileexp[1023] - c * MOE_CHUNK_TILES; nt = nt < 0 ? 0 : (nt > MOE_CHUNK_TILES ? MOE_CHUNK_TILES : nt);
                    pg8::Gemm g{(const bf16_t*)(ws + WS_XS), (const bf16_t*)(ws + W_UP), D, D, D}; MoeUpOrder S{nt, F.G, F.bid, c, tileexp}; epi::SwiGlu E{(bf16_t*)(ws + WS_MH), DFE};
                    pg8::gemm_phase(F.lds, g, S, E, F.tid);
                }
                SEAM(base + PH_MUP0 + 2 * cx); STAMP(12);
                if (RUN(base + PH_MUP0 + 2 * cx + 1)) { PH_BEGIN int c = cx; asm volatile("" : "+s"(c)); const int* tileexp = (const int*)(ws + SM_TILEEXP);
                    int nt = tileexp[1023] - c * MOE_CHUNK_TILES; nt = nt < 0 ? 0 : (nt > MOE_CHUNK_TILES ? MOE_CHUNK_TILES : nt);
                    if (cx < MOE_NCHUNK - MK_TAILSPLIT) {
                        pg8::Gemm g{(const bf16_t*)(ws + WS_MH), (const bf16_t*)(ws + W_DN), DFE, DFE, DFE}; MoeDnOrder S{nt, F.G, F.bid, c, tileexp}; epi::MoeDown E{(bf16_t*)(ws + WS_YB), (const int*)(ws + SM_ROWTOK)};
                        pg8::gemm_phase(F.lds, g, S, E, F.tid);
                    } else {
                        nt = nt > 8 ? 8 : nt;
                        pg8::Gemm g{(const bf16_t*)(ws + WS_MH), (const bf16_t*)(ws + W_DN), 512, DFE, DFE}; MoeDnTailOrder S{nt, F.G, F.bid, tileexp}; epi::F32Grouped E{(float*)(ws + WS_XS), D, (size_t)2048 * D};
                        pg8::gemm_phase(F.lds, g, S, E, F.tid);
                    }
                }
                SEAM(base + PH_MUP0 + 2 * cx + 1); STAMP(13);
            }
#if MK_TAILSPLIT
            if (RUN(base + PH_MUP0 + 2 * MOE_NCHUNK)) { PH_BEGIN moe_tail_finalize(F, a); }
            SEAM(base + PH_MUP0 + 2 * MOE_NCHUNK); STAMP(13);
#endif
        }
        if (RUN(base + PH_PGATE)) {
            if (moe) {
                {   PH_BEGIN
                    const float* gg = (const float*)a.in[34] + ((size_t)l * 3 + 1) * D; const float* bb = (const float*)a.in[35] + ((size_t)l * 3 + 1) * D;
                    for (int pm = F.bid; pm < T / 256; pm += F.G) ln_panel<1, false, false>(F, a, pm, gg, bb, nullptr);
                }
                asm volatile("s_waitcnt vmcnt(0)" ::: "memory"); __syncthreads();
            }
            {   PH_BEGIN
                pg8::Gemm g{xb, (const bf16_t*)(ws + W_GATE), D, D, D}; pg8::PanelOrder S{T / 256, D / 256, F.G, F.bid, S1K, S1K}; epi::SigmoidBias E{(l & 1) ? (bf16_t*)(ws + WS_PLEG) : mix, D, (const float*)a.in[32] + (size_t)l * D};
                pg8::gemm_phase(F.lds, g, S, E, F.tid);
            }
            __syncthreads();
            {   PH_BEGIN
                pg8::Gemm g{(const bf16_t*)(ws + WS_PB), (const bf16_t*)(ws + W_PROJ), PLE, PLE, PLE}; pg8::PanelOrder S{T / 256, D / 256, F.G, F.bid, 256ll * PLE * 2, 256ll * PLE * 2}; epi::MulBf16 E{(l & 1) ? (bf16_t*)(ws + WS_PLEH) : hbuf, (l & 1) ? (bf16_t*)(ws + WS_PLEG) : mix, D};
                pg8::gemm_phase(F.lds, g, S, E, F.tid);
            }
            __syncthreads();
            {   PH_BEGIN
                const float* gg = (const float*)a.in[34] + ((size_t)l * 3 + 2) * D; const float* bb = (const float*)a.in[35] + ((size_t)l * 3 + 2) * D;
                const size_t hoff = (l & 1) ? WS_PLEH : WS_HBUF;
                for (int pm = F.bid; pm < T / 256; pm += F.G) { if (l == DEPTH - 1) ln_panel<0, false, true>(F, a, pm, gg, bb, nullptr, hoff); else ln_panel<0, false, false>(F, a, pm, gg, bb, nullptr, hoff); }
            }
        }
        SEAM(base + PH_PGATE); STAMP(15);
    }
#if MK_PROBE
    if (blockIdx.x == 0) {
        __syncthreads(); asm volatile("s_waitcnt vmcnt(0)" ::: "memory");
        const unsigned long long t1 = ((unsigned long long)PRW[1] << 32) | PRW[0], t0 = ((unsigned long long)PRW[5] << 32) | PRW[4];
        const float tot = (float)(unsigned)(t1 - t0), fa = (float)PRW[2] / tot, fb = (float)PRW[3] / tot;
        Args ae; load_args(ae);
        const int tidp = wave0 * 64 + lane_id_fresh();
        if (tidp == 0) ae.out[0] += 1.0f + 8.0f * fa;
        for (int i = tidp; i < 100000; i += 512) ae.out[1024 + i] += 0.5f * fb;
    }
#endif
#undef RUN
#undef SEAM
}

static bool phase_applies(int gp) {
    if (gp < 2) return true;
    const int l = (gp - 2) / PH_PER_LAYER, ph = (gp - 2) % PH_PER_LAYER; const bool moe = (l & 1) != 0;
    if (ph < PH_LN1) return ph != PH_POST && ph != PH_MIX2 && ph != PH_MIX4;
    if (ph == PH_PGATE) return true;
    if (!moe) return ph == PH_FUP || ph == PH_FDN;
    return ph >= PH_MGATH && ph <= PH_MUP0 + 2 * MOE_NCHUNK;
}
extern "C" void kernel_launch(void* const* d_in, const int* in_sizes, int n_in, void* d_out, int out_size, void* d_ws, size_t ws_size, hipStream_t stream) {
    static int grid = 0;
    if (grid == 0) {
        if (n_in != 36 || out_size != T * D || ws_size < WS_END) { fprintf(stderr, "kernel_launch: unexpected problem (n_in %d out %d ws %zu, need %zu)\n", n_in, out_size, ws_size, (size_t)WS_END); grid = -1; return; }
        int dev = 0, cus = 0, per_cu = 0;
        if (hipGetDevice(&dev) != hipSuccess || hipDeviceGetAttribute(&cus, hipDeviceAttributeMultiprocessorCount, dev) != hipSuccess) { grid = -1; return; }
        if (hipFuncSetAttribute((const void*)mk_fwd, hipFuncAttributeMaxDynamicSharedMemorySize, LDS_BYTES) != hipSuccess) { fprintf(stderr, "kernel_launch: hipFuncSetAttribute failed\n"); grid = -1; return; }
        if (hipOccupancyMaxActiveBlocksPerMultiprocessor(&per_cu, (const void*)mk_fwd, 512, LDS_BYTES) != hipSuccess || per_cu < 1) fprintf(stderr, "kernel_launch: occupancy query reports %d\n", per_cu);
        (void)hipGetLastError();
        grid = cus;
    }
    if (grid < 0) return;
    (void)in_sizes;
    if (hipMemsetAsync((char*)d_ws + WS_CTL, 0, CTL_ZERO_BYTES, stream) != hipSuccess) return;
#if MK_CHECK
    (void)hipMemsetAsync((char*)d_ws + SM_CHK, 0, 256, stream);
#endif
    Args a{};
    for (int i = 0; i < 36; ++i) a.in[i] = d_in[i];
    a.out = (float*)d_out; a.ws = (unsigned char*)d_ws; a.pad = 0;
#if MK_MULTI
    for (int gp = 0; gp < GP_END; ++gp) { if (!phase_applies(gp)) continue; a.gp_lo = gp; a.gp_hi = gp + 1; a.use_bar = 0;
        hipLaunchKernelGGL(mk_fwd, dim3(grid), dim3(512), LDS_BYTES, stream, a);
#if MK_CHECK
        run_checks(a, gp, stream);
#endif
    }
#if MK_CHECK
    hipLaunchKernelGGL(chk_final, dim3(1), dim3(1), 0, stream, a);
#endif
#else
    a.gp_lo = 0; a.gp_hi = GP_END; a.use_bar = 1;
    hipLaunchKernelGGL(mk_fwd, dim3(grid), dim3(512), LDS_BYTES, stream, a);
#endif
}
```

```cpp
#include <hip/hip_runtime.h>
#include <cstdint>
#include <cstdio>
#ifndef MK_TAILSPLIT
#define MK_TAILSPLIT 1
#endif
#ifndef MK_MULTI
#define MK_MULTI 0
#endif
#ifndef MK_CHECK
#define MK_CHECK 0
#endif
#ifndef MK_REP_G1
#define MK_REP_G1 1
#endif
#ifndef MK_REP_G2
#define MK_REP_G2 1
#endif
#ifndef MK_REP_CU
#define MK_REP_CU 1
#endif
#ifndef MK_REP_TK
#define MK_REP_TK 1
#endif
#ifndef MK_REP_WOUT
#define MK_REP_WOUT 1
#endif
#ifndef MK_REP_CONV
#define MK_REP_CONV 1
#endif
#ifndef MK_REP_ST2
#define MK_REP_ST2 1
#endif
#ifndef MK_REP_CARRY
#define MK_REP_CARRY 1
#endif
#ifndef MK_REPCMP
#define MK_REPCMP 1
#endif
#ifndef MK_ALIGN_EPI
#define MK_ALIGN_EPI 1
#endif
#ifndef MK_PROBE
#define MK_PROBE 0
#endif
#ifndef PROBE_A
#define PROBE_A 0
#endif
#ifndef PROBE_B
#define PROBE_B 0
#endif
#ifndef CHK_LAYER
#define CHK_LAYER 15
#endif

#define GAS __attribute__((address_space(1)))
#define LAS __attribute__((address_space(3)))
typedef unsigned short bf16_t;
typedef short bf16x8 __attribute__((ext_vector_type(8)));
typedef float f32x4 __attribute__((ext_vector_type(4)));
typedef float f32x2 __attribute__((ext_vector_type(2)));
typedef float f32x16 __attribute__((ext_vector_type(16)));
typedef unsigned u32x4 __attribute__((ext_vector_type(4)));
typedef unsigned u32x2 __attribute__((ext_vector_type(2)));

constexpr int NB = 16, SEQ = 4096, T = NB * SEQ, D = 1024, DEPTH = 4;
constexpr int INW = 2072, INP = 2304;
constexpr int ZKV = 512, ZG = 1280, ZC = 1304, ZS = 1816;
constexpr int DFF = 2816, DFE = 3584, NEXP = 8, PLE = 256;
constexpr int NCMP = 255;
constexpr int S5LC = 32, S5NCH = SEQ / S5LC, S5K = S5LC * 16 + 128;
constexpr float ALPHA = 1.6817928305074290f;
constexpr float LN_EPS = 1e-5f;
constexpr float QSCALE = 0.125f * 1.4426950408889634f;
constexpr float NEGF = -1e30f;
constexpr int MOE_TILES_MAX = 520, MOE_CHUNK_TILES = 128, MOE_NCHUNK = 5;

typedef __bf16 bf16x2_t __attribute__((ext_vector_type(2)));
__device__ __forceinline__ unsigned cvt_pk_bf16(float lo, float hi) { f32x2 v = {lo, hi}; const bf16x2_t b = __builtin_convertvector(v, bf16x2_t); return __builtin_bit_cast(unsigned, b); }
__device__ __forceinline__ bf16_t f2bf(float f) { return (bf16_t)(cvt_pk_bf16(f, 0.f) & 0xffffu); }
__device__ __forceinline__ float bf2f(unsigned v) { return __uint_as_float(v << 16); }
__device__ __forceinline__ float bflo(unsigned w) { return __uint_as_float(w << 16); }
__device__ __forceinline__ float bfhi(unsigned w) { return __uint_as_float(w & 0xffff0000u); }
__device__ __forceinline__ float fast_exp2(float x) { return __builtin_amdgcn_exp2f(x); }
__device__ __forceinline__ float fast_rcp(float x) { return __builtin_amdgcn_rcpf(x); }
__device__ __forceinline__ float sigmoidf_(float x) { return fast_rcp(1.0f + fast_exp2(-1.4426950408889634f * x)); }
__device__ __forceinline__ float siluf_(float x) { return x * sigmoidf_(x); }
__device__ __forceinline__ float gelu_tanh(float x) { const float u = 0.7978845608028654f * (x + 0.044715f * x * x * x); return x * sigmoidf_(2.0f * u); }
__device__ __forceinline__ int lane_id_fresh() { unsigned z = 0u; asm volatile("" : "+v"(z)); return (int)__builtin_amdgcn_mbcnt_hi(~0u, __builtin_amdgcn_mbcnt_lo(~0u, z)); }
template <int MASK> __device__ __forceinline__ float xshfl(float v) {
    if (MASK == 32) { const unsigned u = __float_as_uint(v); auto rr = __builtin_amdgcn_permlane32_swap(u, u, false, false); return __uint_as_float((rr[0] == u) ? rr[1] : rr[0]); }
    return __uint_as_float((unsigned)__builtin_amdgcn_ds_swizzle((int)__float_as_uint(v), 0x1f | (MASK << 10)));
}
__device__ __forceinline__ float wave_sum(float v) {
    v += xshfl<1>(v); v += xshfl<2>(v); v += xshfl<4>(v); v += xshfl<8>(v); v += xshfl<16>(v); v += xshfl<32>(v);
    return v;
}
#define LDS_WAIT() asm volatile("s_waitcnt lgkmcnt(0)" ::: "memory")
#define VM_WAIT() asm volatile("s_waitcnt vmcnt(0)" ::: "memory")

namespace pg8 {
constexpr int BM = 256, BK = 64, HALF = 128, HTB = HALF * BK * 2, STAGE_BYTES = 8 * HTB, NXCD = 8, WGM = 8;
__host__ __device__ __forceinline__ int lds_byte(int r, int c) { const int st = (r >> 4) * 2 + (c >> 5), rr = r & 15, cc = c & 31, ob = rr * 64 + cc * 2; return st * 1024 + (ob ^ (((ob >> 9) & 1) << 5)); }
__host__ __device__ __forceinline__ void stage_rc(int b, int& R, int& C) { const int st = b / 1024, sb = b % 1024, swz = sb ^ (((sb >> 9) & 1) << 5); R = (st >> 1) * 16 + swz / 64; C = (st & 1) * 32 + (swz % 64) / 2; }
__host__ __device__ __forceinline__ int perm32(int rho) { const int n = rho >> 4, i = rho & 15; return 8 * (i >> 2) + 4 * n + (i & 3); }

struct Unit { int pm, pn; long long offA, offB; int aux; };
struct Gemm { const bf16_t* A; const bf16_t* Bt; int K, lda, ldb; };

__device__ __forceinline__ bool static_tile(int i, int G, int c, int nM, int nN, int& pm, int& pn) {
    const int nwg = nM * nN; const long L = (long)i * G + c; if (L >= nwg) return false;
    int wgid = (int)L; { const int q = nwg / NXCD, r = nwg % NXCD, xcd = wgid % NXCD, off = wgid / NXCD; wgid = (xcd < r ? xcd * (q + 1) : r * (q + 1) + (xcd - r) * q) + off; }
    const int nig = WGM * nN, gid = wgid / nig, fm = gid * WGM, gsz = (nM - fm) < WGM ? (nM - fm) : WGM;
    pm = fm + ((wgid % nig) % gsz); pn = (wgid % nig) / gsz; return true;
}
struct PlainOrder {
    int nM, nN, G, c; long long sA, sB;
    __device__ __forceinline__ bool next(int i, Unit& u) const { if (!static_tile(i, G, c, nM, nN, u.pm, u.pn)) return false; u.offA = (long long)u.pm * sA; u.offB = (long long)u.pn * sB; u.aux = 0; return true; }
};
struct PanelOrder {
    int nM, nN, G, c; long long sA, sB;
    __device__ __forceinline__ bool next(int i, Unit& u) const { const int pm = c + G * (i / nN); if (pm >= nM) return false; u.pm = pm; u.pn = i % nN; u.offA = (long long)pm * sA; u.offB = (long long)u.pn * sB; u.aux = 0; return true; }
};
struct ListOrder {
    int n, pm, aux; long long offA0, offB0, sB;
    __device__ __forceinline__ bool next(int i, Unit& u) const { if (i >= n) return false; u.pm = pm; u.pn = i; u.aux = aux; u.offA = offA0; u.offB = offB0 + (long long)i * sB; return true; }
};
struct GroupedOrder {
    int ng, nM, nN, G, c; long long sA, sB, gA, gB;
    __device__ __forceinline__ bool next(int i, Unit& u) const {
        const long L = (long)i * G + c; const int per = nM * nN; if (L >= (long)ng * per) return false;
        const int gi = (int)(L / per), r = (int)(L % per); u.pm = r / nN; u.pn = r % nN; u.aux = gi;
        u.offA = (long long)gi * gA + (long long)u.pm * sA; u.offB = (long long)gi * gB + (long long)u.pn * sB; return true; }
};

template <class Epi, class Sched>
__device__ __forceinline__ void gemm_phase(LAS unsigned char* lds, const Gemm g, const Sched& S, const Epi& E, int tid_in) {
    int tid_ = tid_in; asm volatile("" : "+v"(tid_));
    const int tid = tid_, wid = __builtin_amdgcn_readfirstlane(tid >> 6), lane = tid & 63, wr = wid >> 2, wc = wid & 3, fr = lane & 15, fq = lane >> 4;
    int K_ = g.K; asm volatile("" : "+s"(K_));
    const int K = K_, nt = K / BK; (void)K;
    unsigned voffA[2], voffB[2];
#pragma unroll
    for (int i = 0; i < 2; ++i) { int R, C; stage_rc(tid * 16 + i * 8192, R, C); const int Rb = Epi::PERM ? ((R & ~31) + perm32(R & 31)) : R;
        voffA[i] = (unsigned)(R * g.lda + C) * 2u; voffB[i] = (unsigned)(Rb * g.ldb + C) * 2u; }
    const size_t kstep = (size_t)(BK * 2);
    const size_t hstepA = (size_t)HALF * g.lda * 2, hstepB = (size_t)HALF * g.ldb * 2;
    const unsigned ldsw = (unsigned)wid * 1024u;
    const int aoff = lds_byte(wr * 64 + fr, fq * 8), boff = lds_byte(wc * 32 + fr, fq * 8);
#define PG8_SA(b, h) (((b) * 2 + (h)) * HTB)
#define PG8_SB(b, h) ((4 + (b) * 2 + (h)) * HTB)
#define PG8_STAGE(bufoff, gbase, voff) do { _Pragma("unroll") for (int _i = 0; _i < 2; ++_i) \
        __builtin_amdgcn_global_load_lds((const unsigned*)((const char*)(gbase) + (voff)[_i]), (LAS unsigned*)(lds + (bufoff) + ldsw + _i * 8192), 16, 0, 0); } while (0)
#define PG8_LDA(dst, b, h) do { _Pragma("unroll") for (int m = 0; m < 4; ++m) _Pragma("unroll") for (int k = 0; k < 2; ++k) dst[m][k] = *(const LAS bf16x8*)(lds + PG8_SA(b, h) + aoff + m * 2048 + k * 1024); } while (0)
#define PG8_LDB(dst, b, h) do { _Pragma("unroll") for (int n = 0; n < 2; ++n) _Pragma("unroll") for (int k = 0; k < 2; ++k) dst[n][k] = *(const LAS bf16x8*)(lds + PG8_SB(b, h) + boff + n * 2048 + k * 1024); } while (0)
#define PG8_MMA(ai, bj, At, Bt) do { __builtin_amdgcn_s_setprio(1); _Pragma("unroll") for (int m = 0; m < 4; ++m) _Pragma("unroll") for (int n = 0; n < 2; ++n) _Pragma("unroll") for (int k = 0; k < 2; ++k) \
        acc[ai][bj][m][n] = __builtin_amdgcn_mfma_f32_16x16x32_bf16(Bt[n][k], At[m][k], acc[ai][bj][m][n], 0, 0, 0); __builtin_amdgcn_s_setprio(0); } while (0)
#define PG8_WAIT_V(n) asm volatile("s_waitcnt vmcnt(" #n ")" ::: "memory")
#define PG8_WAIT_L(n) asm volatile("s_waitcnt lgkmcnt(" #n ")" ::: "memory")
#define PG8_BAR __builtin_amdgcn_s_barrier()
#define PG8_SCHED __builtin_amdgcn_sched_barrier(0)
    Unit cur, nxt; int ui = 0;
    if (!S.next(0, cur)) return;
    f32x4 acc[2][2][4][2];
#pragma unroll
    for (int a = 0; a < 2; ++a)
#pragma unroll
        for (int b = 0; b < 2; ++b)
#pragma unroll
            for (int m = 0; m < 4; ++m)
#pragma unroll
                for (int n = 0; n < 2; ++n) acc[a][b][m][n] = (f32x4){0.f, 0.f, 0.f, 0.f};
    bf16x8 At[4][2], B0[2][2], B1[2][2];
    const char* cA = (const char*)g.A + cur.offA; const char* cB = (const char*)g.Bt + cur.offB;
    PG8_STAGE(PG8_SB(0, 0), cB, voffB); PG8_STAGE(PG8_SB(0, 1), cB + hstepB, voffB); PG8_STAGE(PG8_SA(0, 0), cA, voffA); PG8_STAGE(PG8_SA(0, 1), cA + hstepA, voffA);
    if (wr == 1) PG8_BAR;
    PG8_WAIT_V(2); PG8_BAR;
    PG8_STAGE(PG8_SB(1, 0), cB + kstep, voffB); PG8_STAGE(PG8_SA(1, 0), cA + kstep, voffA); PG8_STAGE(PG8_SB(1, 1), cB + hstepB + kstep, voffB);
    PG8_WAIT_V(6); PG8_BAR;
    for (;;) {
        const bool has_next = S.next(ui + 1, nxt);
        const char* nA = has_next ? (const char*)g.A + nxt.offA : cA; const char* nB = has_next ? (const char*)g.Bt + nxt.offB : cB;
        for (int t = 0; t < nt; t += 2) {
            const bool last = (t == nt - 2);
            const char* a1 = cA + (size_t)(t + 1) * kstep;
            const char* a2 = last ? nA : cA + (size_t)(t + 2) * kstep; const char* b2 = last ? nB : cB + (size_t)(t + 2) * kstep;
            const char* a3 = a2 + kstep; const char* b3 = b2 + kstep;
            PG8_LDB(B0, 0, 0); PG8_LDB(B1, 0, 1); PG8_SCHED; PG8_LDA(At, 0, 0); PG8_STAGE(PG8_SA(1, 1), a1 + hstepA, voffA);
            PG8_WAIT_V(8); PG8_WAIT_L(0); PG8_BAR; PG8_MMA(0, 0, At, B0); PG8_MMA(0, 1, At, B1); PG8_BAR; PG8_SCHED;
            PG8_LDA(At, 0, 1); PG8_STAGE(PG8_SB(0, 0), b2, voffB); PG8_STAGE(PG8_SB(0, 1), b2 + hstepB, voffB); PG8_STAGE(PG8_SA(0, 0), a2, voffA);
            PG8_WAIT_V(8); PG8_WAIT_L(0); PG8_BAR; PG8_MMA(1, 0, At, B0); PG8_MMA(1, 1, At, B1); PG8_BAR; PG8_SCHED;
            PG8_LDB(B0, 1, 0); PG8_LDB(B1, 1, 1); PG8_SCHED; PG8_LDA(At, 1, 0); PG8_STAGE(PG8_SA(0, 1), a2 + hstepA, voffA);
            PG8_WAIT_V(8); PG8_WAIT_L(0); PG8_BAR; PG8_MMA(0, 0, At, B0); PG8_MMA(0, 1, At, B1); PG8_BAR; PG8_SCHED;
            PG8_LDA(At, 1, 1); PG8_STAGE(PG8_SB(1, 0), b3, voffB); PG8_STAGE(PG8_SB(1, 1), b3 + hstepB, voffB); PG8_STAGE(PG8_SA(1, 0), a3, voffA);
            PG8_WAIT_V(8); PG8_WAIT_L(0); PG8_BAR; PG8_MMA(1, 0, At, B0); PG8_MMA(1, 1, At, B1); PG8_BAR; PG8_SCHED;
        }
#if MK_ALIGN_EPI
        if (wr == 0) PG8_BAR;
#endif
        { int fr_ = fr, fq_ = fq; asm volatile("" : "+v"(fr_), "+v"(fq_));
          E(acc, cur, wr, wc, fr_, fq_); }
        if (!has_next) break;
#pragma unroll
        for (int a = 0; a < 2; ++a)
#pragma unroll
            for (int b = 0; b < 2; ++b)
#pragma unroll
                for (int m = 0; m < 4; ++m)
#pragma unroll
                    for (int n = 0; n < 2; ++n) acc[a][b][m][n] = (f32x4){0.f, 0.f, 0.f, 0.f};
        cur = nxt; cA = nA; cB = nB; ++ui;
#if MK_ALIGN_EPI
        if (wr == 1) PG8_BAR;
#endif
    }
    PG8_WAIT_V(0);
#if !MK_ALIGN_EPI
    if (wr == 0) PG8_BAR;
#endif
    PG8_BAR;
#undef PG8_SA
#undef PG8_SB
#undef PG8_STAGE
#undef PG8_LDA
#undef PG8_LDB
#undef PG8_MMA
#undef PG8_WAIT_V
#undef PG8_WAIT_L
#undef PG8_BAR
#undef PG8_SCHED
}
}

#define XB_TMO      128
#define XB_XCNT(j)  (256  + 64 * (j))
#define XB_XSUB(j)  (1280 + 64 * (j))
#define XB_XGEN(j)  (2304 + 64 * (j))
#define XB_TOP      3328
#define XB_TOPGEN   3392
#define XCD_BAR_WORDS 3456
#define XB_SPIN_CAP (1u << 20)
__device__ __forceinline__ unsigned xb_ld(unsigned* p)              { return __hip_atomic_load(p, __ATOMIC_RELAXED, __HIP_MEMORY_SCOPE_AGENT); }
__device__ __forceinline__ unsigned xb_add(unsigned* p, unsigned v) { return __hip_atomic_fetch_add(p, v, __ATOMIC_RELAXED, __HIP_MEMORY_SCOPE_AGENT); }
__device__ __forceinline__ unsigned xb_xcc_id() { return (unsigned)__builtin_amdgcn_s_getreg((3 << 11) | 20) & 0xFu; }
#define XB_SPIN(cond, bar) do { unsigned _sp = 0; while (cond) { __builtin_amdgcn_s_sleep(1); \
    if ((++_sp & 255u) == 0u) { if (xb_ld(&(bar)[XB_TMO])) break; if (_sp > XB_SPIN_CAP) { atomicAdd(&(bar)[XB_TMO], 1u); break; } } } } while (0)
struct XcdBarrier { unsigned* bar; unsigned x; volatile LAS unsigned* st; };
__device__ __forceinline__ XcdBarrier xcd_barrier_post(unsigned* bar, volatile LAS unsigned* st) {
    XcdBarrier b; b.bar = bar; b.x = xb_xcc_id(); b.st = st;
    if (threadIdx.x == 0) (void)xb_add(&bar[XB_XCNT(b.x)], 1u);
    return b;
}
__device__ __forceinline__ void xcd_barrier_complete(unsigned* bar, unsigned x, unsigned& nloc, unsigned& nx) {
    const unsigned G = gridDim.x * gridDim.y * gridDim.z;
    unsigned sum, cnt, mine, sp = 0u;
    for (;;) {
        sum = 0u; cnt = 0u; mine = 0u;
#pragma unroll 1
        for (unsigned j = 0; j < 16; ++j) { const unsigned c = xb_ld(&bar[XB_XCNT(j)]); sum += c; cnt += (c > 0u) ? 1u : 0u; mine = (j == x) ? c : mine; }
        if (sum == G) break;
        __builtin_amdgcn_s_sleep(1);
        if ((++sp & 255u) == 0u) { if (xb_ld(&bar[XB_TMO])) break; if (sp > XB_SPIN_CAP) { atomicAdd(&bar[XB_TMO], 1u); break; } }
    }
    nloc = mine > 0u ? mine : 1u; nx = cnt > 0u ? cnt : 1u;
}
__device__ __forceinline__ void xcd_barrier(const XcdBarrier& b, int wave_id) {
    asm volatile("s_waitcnt vmcnt(0)" ::: "memory");
    __syncthreads();
    if (wave_id == 0 && lane_id_fresh() == 0) {
        unsigned* bar = b.bar; asm volatile("" : "+s"(bar));
        __builtin_amdgcn_s_waitcnt(0);
        unsigned nloc = b.st[0], nx = b.st[1];
        if (nloc == 0u) { xcd_barrier_complete(bar, b.x, nloc, nx); b.st[0] = nloc; b.st[1] = nx; }
        const unsigned old = xb_add(&bar[XB_XSUB(b.x)], 1u);
        const unsigned gen = old / nloc;
        if (old + 1u == (gen + 1u) * nloc) {
            __builtin_amdgcn_fence(__ATOMIC_RELEASE, "agent");
            asm volatile("s_waitcnt vmcnt(0)" ::: "memory");
            const unsigned og = xb_add(&bar[XB_TOP], 1u);
            const unsigned tg = og / nx;
            if (og + 1u == (tg + 1u) * nx) xb_add(&bar[XB_TOPGEN], 1u);
            else XB_SPIN(xb_ld(&bar[XB_TOPGEN]) == tg, bar);
            __builtin_amdgcn_fence(__ATOMIC_ACQUIRE, "agent");
            xb_add(&bar[XB_XGEN(b.x)], 1u);
            asm volatile("s_waitcnt vmcnt(0)" ::: "memory");
        } else {
            XB_SPIN(xb_ld(&bar[XB_XGEN(b.x)]) == gen, bar);
            __builtin_amdgcn_fence(__ATOMIC_ACQUIRE, "agent");
            asm volatile("s_waitcnt vmcnt(0)" ::: "memory");
        }
    }
    __syncthreads();
}
namespace nsa {
constexpr int PITCH = 144, TILE_LDS = 64 * PITCH;
__device__ __forceinline__ int crow(int r, int hi) { return (r & 3) + 8 * (r >> 2) + 4 * hi; }
__device__ __forceinline__ int vslot(int kk) { return (kk & 0x33) | (((kk >> 2) & 1) << 3) | (((kk >> 3) & 1) << 2); }

struct Lane { int lane, c, hi, wid, tid; };

__device__ __forceinline__ void qk_tile(f32x16& p0, f32x16& p1, const LAS unsigned char* Ks, const bf16x8 (&qr)[4], float bias, const Lane& L) {
#pragma unroll
    for (int r = 0; r < 16; ++r) { p0[r] = bias; p1[r] = bias; }
    const LAS unsigned char* kb = Ks + L.c * PITCH + L.hi * 16;
#pragma unroll
    for (int d0 = 0; d0 < 4; ++d0) {
        const bf16x8 k0 = *(const LAS bf16x8*)(kb + d0 * 32);
        const bf16x8 k1 = *(const LAS bf16x8*)(kb + 32 * PITCH + d0 * 32);
        p0 = __builtin_amdgcn_mfma_f32_32x32x16_bf16(k0, qr[d0], p0, 0, 0, 0);
        p1 = __builtin_amdgcn_mfma_f32_32x32x16_bf16(k1, qr[d0], p1, 0, 0, 0);
    }
}
__device__ __forceinline__ void qk_tile_c(f32x16& p0, f32x16& p1, const LAS unsigned char* Ks, const bf16x8 (&qr)[4], const f32x16& cv, const Lane& L) {
    const LAS unsigned char* kb = Ks + L.c * PITCH + L.hi * 16;
    { const bf16x8 k0 = *(const LAS bf16x8*)(kb); const bf16x8 k1 = *(const LAS bf16x8*)(kb + 32 * PITCH);
      p0 = __builtin_amdgcn_mfma_f32_32x32x16_bf16(k0, qr[0], cv, 0, 0, 0); p1 = __builtin_amdgcn_mfma_f32_32x32x16_bf16(k1, qr[0], cv, 0, 0, 0); }
#pragma unroll
    for (int d0 = 1; d0 < 4; ++d0) {
        const bf16x8 k0 = *(const LAS bf16x8*)(kb + d0 * 32);
        const bf16x8 k1 = *(const LAS bf16x8*)(kb + 32 * PITCH + d0 * 32);
        p0 = __builtin_amdgcn_mfma_f32_32x32x16_bf16(k0, qr[d0], p0, 0, 0, 0);
        p1 = __builtin_amdgcn_mfma_f32_32x32x16_bf16(k1, qr[d0], p1, 0, 0, 0);
    }
}
__device__ __forceinline__ void mask_range(f32x16& p0, f32x16& p1, int lo, int hi_, int hi) {
#pragma unroll
    for (int r = 0; r < 16; ++r) { const int k0 = crow(r, hi), k1 = k0 + 32;
        if (k0 <= lo || k0 > hi_) p0[r] = NEGF;
        if (k1 <= lo || k1 > hi_) p1[r] = NEGF; }
}
__device__ __forceinline__ float tile_max(const f32x16& p0, const f32x16& p1) {
    float a = fmaxf(p0[0], p1[0]);
#pragma unroll
    for (int r = 1; r < 16; ++r) a = fmaxf(a, fmaxf(p0[r], p1[r]));
    return fmaxf(a, xshfl<32>(a));
}
__device__ __forceinline__ void pv_tile(f32x16& o0, f32x16& o1, const LAS unsigned char* Vs, const f32x16& p0, const f32x16& p1, const Lane& L) {
    const LAS unsigned char* vb = Vs + L.c * PITCH + L.hi * 16;
#pragma unroll
    for (int s = 0; s < 4; ++s) {
        u32x4 w;
        if (s < 2) { const int b = 8 * (s & 1); w.x = cvt_pk_bf16(p0[b], p0[b + 1]); w.y = cvt_pk_bf16(p0[b + 2], p0[b + 3]); w.z = cvt_pk_bf16(p0[b + 4], p0[b + 5]); w.w = cvt_pk_bf16(p0[b + 6], p0[b + 7]); }
        else       { const int b = 8 * (s & 1); w.x = cvt_pk_bf16(p1[b], p1[b + 1]); w.y = cvt_pk_bf16(p1[b + 2], p1[b + 3]); w.z = cvt_pk_bf16(p1[b + 4], p1[b + 5]); w.w = cvt_pk_bf16(p1[b + 6], p1[b + 7]); }
        const bf16x8 pf = __builtin_bit_cast(bf16x8, w);
        const bf16x8 v0 = *(const LAS bf16x8*)(vb + s * 32);
        const bf16x8 v1 = *(const LAS bf16x8*)(vb + 32 * PITCH + s * 32);
        o0 = __builtin_amdgcn_mfma_f32_32x32x16_bf16(v0, pf, o0, 0, 0, 0);
        o1 = __builtin_amdgcn_mfma_f32_32x32x16_bf16(v1, pf, o1, 0, 0, 0);
        if (s & 1) __builtin_amdgcn_sched_barrier(0);
    }
}
__device__ __forceinline__ void softmax_pv(f32x16& p0, f32x16& p1, f32x16& o0, f32x16& o1, float& m, float& l, const LAS unsigned char* Vs, const Lane& L) {
    const float mx = tile_max(p0, p1), mn = fmaxf(m, mx), alpha = fast_exp2(m - mn); m = mn;
    float ls = 0.f;
#pragma unroll
    for (int r = 0; r < 16; ++r) { p0[r] = fast_exp2(p0[r] - mn); p1[r] = fast_exp2(p1[r] - mn); ls += p0[r] + p1[r]; }
    l = l * alpha + ls;
#pragma unroll
    for (int r = 0; r < 16; ++r) { o0[r] *= alpha; o1[r] *= alpha; }
    pv_tile(o0, o1, Vs, p0, p1, L);
}
__device__ __forceinline__ int stage_off(int tid) { return (tid >> 3) * PITCH + (tid & 7) * 16; }

__device__ __forceinline__ void load_q(bf16x8 (&qr)[4], const bf16_t* qbuf, long tok, int head, int hi) {
    const bf16_t* qp = qbuf + tok * 512 + head * 64 + hi * 8;
#pragma unroll
    for (int d0 = 0; d0 < 4; ++d0) qr[d0] = *(const bf16x8*)(qp + d0 * 16);
}

__device__ __forceinline__ u32x4 vload(const bf16_t* Vt, int j, const Lane& L) { return *(const u32x4*)((const char*)Vt + (size_t)j * 8192 + L.lane * 128 + L.wid * 16); }
__device__ __forceinline__ void vstore(LAS unsigned char* Vs, const u32x4 v, const Lane& L) {
    LAS unsigned short* p = (LAS unsigned short*)(Vs + (8 * L.wid) * PITCH) + vslot(L.lane);
    p[0 * (PITCH / 2)] = (unsigned short)(v.x & 0xffffu); p[1 * (PITCH / 2)] = (unsigned short)(v.x >> 16); p[2 * (PITCH / 2)] = (unsigned short)(v.y & 0xffffu); p[3 * (PITCH / 2)] = (unsigned short)(v.y >> 16);
    p[4 * (PITCH / 2)] = (unsigned short)(v.z & 0xffffu); p[5 * (PITCH / 2)] = (unsigned short)(v.z >> 16); p[6 * (PITCH / 2)] = (unsigned short)(v.w & 0xffffu); p[7 * (PITCH / 2)] = (unsigned short)(v.w >> 16);
}
template <int MODE>
__device__ __forceinline__ void run_branch(f32x16& o0, f32x16& o1, float& mref, float& l, const bf16_t* Kt  , const bf16_t* Vt  ,
                                           int jlo, int jhi, int qb, int qrel, unsigned long long selw, const bf16x8 (&qr)[4], LAS unsigned char* lds, const Lane& L) {
    LAS unsigned char* Kbuf = lds; LAS unsigned char* Vbuf = lds + 2 * TILE_LDS;
    const int so = stage_off(L.tid);
    u32x4 kreg = *(const u32x4*)((const char*)Kt + (size_t)jlo * 8192 + L.tid * 16);
    u32x4 vreg = vload(Vt, jlo, L);
    *(LAS u32x4*)(Kbuf + so) = kreg; vstore(Vbuf, vreg, L);
    __syncthreads();
    f32x16 cv;
#pragma unroll
    for (int r = 0; r < 16; ++r) cv[r] = -mref;
    for (int j = jlo; j <= jhi; ++j) {
        const int cur = (j - jlo) & 1;
        if (j < jhi) { kreg = *(const u32x4*)((const char*)Kt + (size_t)(j + 1) * 8192 + L.tid * 16); vreg = vload(Vt, j + 1, L); }
        f32x16 p0, p1;
        if (MODE == 0) { const float cb = ((selw >> j) & 1ull) ? -mref : NEGF;
#pragma unroll
            for (int r = 0; r < 16; ++r) cv[r] = cb; }
        qk_tile_c(p0, p1, Kbuf + cur * TILE_LDS, qr, cv, L);
        if (j == qb) mask_range(p0, p1, -1, qrel, L.hi);
        if (MODE == 1 && j == qb - 8) mask_range(p0, p1, qrel, 64, L.hi);
        const float mx = tile_max(p0, p1);
        if (__any(mx > 8.0f)) {
            const float dl = fmaxf(mx, 0.f), f = fast_exp2(-dl); mref += dl; l *= f;
#pragma unroll
            for (int r = 0; r < 16; ++r) { o0[r] *= f; o1[r] *= f; p0[r] -= dl; p1[r] -= dl; }
            if (MODE == 1) {
#pragma unroll
                for (int r = 0; r < 16; ++r) cv[r] = -mref; }
        }
        float ls = 0.f;
#pragma unroll
        for (int r = 0; r < 16; ++r) { p0[r] = fast_exp2(p0[r]); p1[r] = fast_exp2(p1[r]); ls += p0[r] + p1[r]; }
        l += ls;
        pv_tile(o0, o1, Vbuf + cur * TILE_LDS, p0, p1, L);
        if (j < jhi) { *(LAS u32x4*)(Kbuf + (cur ^ 1) * TILE_LDS + so) = kreg; vstore(Vbuf + (cur ^ 1) * TILE_LDS, vreg, L); }
        __syncthreads();
    }
}
struct SoftState { float mref, l; };
__device__ __forceinline__ void softmax_step2(f32x16& p0, f32x16& p1, f32x16& o0, f32x16& o1, SoftState& st, bool sel, bf16x8 (&pf)[4]) {
    if (__any(st.mref != 0.f)) {
#pragma unroll
        for (int r = 0; r < 16; ++r) { p0[r] -= st.mref; p1[r] -= st.mref; } }
    float ls = 0.f;
#pragma unroll
    for (int r = 0; r < 16; ++r) { p0[r] = fast_exp2(p0[r]); p1[r] = fast_exp2(p1[r]); ls += p0[r] + p1[r]; }
    ls = sel ? ls : 0.f; st.l += ls;
#pragma unroll
    for (int s = 0; s < 4; ++s) { u32x4 w; const int b = 8 * (s & 1);
        if (s < 2) { w.x = cvt_pk_bf16(p0[b], p0[b + 1]); w.y = cvt_pk_bf16(p0[b + 2], p0[b + 3]); w.z = cvt_pk_bf16(p0[b + 4], p0[b + 5]); w.w = cvt_pk_bf16(p0[b + 6], p0[b + 7]); }
        else       { w.x = cvt_pk_bf16(p1[b], p1[b + 1]); w.y = cvt_pk_bf16(p1[b + 2], p1[b + 3]); w.z = cvt_pk_bf16(p1[b + 4], p1[b + 5]); w.w = cvt_pk_bf16(p1[b + 6], p1[b + 7]); }
        if (!sel) w = (u32x4){0u, 0u, 0u, 0u};
        pf[s] = __builtin_bit_cast(bf16x8, w); }
}
__device__ __forceinline__ void renorm_step(f32x16& o0, f32x16& o1, SoftState& st) {
    if (__any(st.l > 1.0995116e12f)) { const bool big = st.l > 1.0995116e12f; const float f = big ? 9.094947e-13f : 1.0f; st.mref += big ? 40.f : 0.f; st.l *= f;
#pragma unroll
        for (int r = 0; r < 16; ++r) { o0[r] *= f; o1[r] *= f; } }
}
template <int MODE>
__device__ __forceinline__ void run_branch2(f32x16& oa0, f32x16& oa1, SoftState& sa, f32x16& ob0, f32x16& ob1, SoftState& sb, const bf16_t* Kt, const bf16_t* Vt, int jlo, int jhi, int qbw, int qrela,
                                            const LAS unsigned long long* selp  , const bf16x8 (&qa)[4], const bf16x8 (&qbf)[4], LAS unsigned char* lds, const Lane& L) {
    LAS unsigned char* Kbuf = lds; LAS unsigned char* Vbuf = lds + 2 * TILE_LDS;
    const int so = stage_off(L.tid);
    {   const u32x4 kreg = *(const u32x4*)((const char*)Kt + (size_t)jlo * 8192 + L.tid * 16); const u32x4 vreg = vload(Vt, jlo, L);
        *(LAS u32x4*)(Kbuf + so) = kreg; vstore(Vbuf, vreg, L); }
    __syncthreads();
    for (int j = jlo; j <= jhi; ++j) {
        const int cur = (j - jlo) & 1;
        const bool act = (j <= qbw) && (MODE == 0 || j >= qbw - 8);
        u32x4 kreg, vreg;
        bf16x8 fa[4], fb[4];
        if (act) {
            f32x16 pa0, pa1, pb0, pb1;
#pragma unroll
            for (int r = 0; r < 16; ++r) { pa0[r] = 0.f; pa1[r] = 0.f; pb0[r] = 0.f; pb1[r] = 0.f; }
            const LAS unsigned char* kb = Kbuf + cur * TILE_LDS + L.c * PITCH + L.hi * 16;
#pragma unroll
            for (int d0 = 0; d0 < 4; ++d0) { const bf16x8 k0 = *(const LAS bf16x8*)(kb + d0 * 32); const bf16x8 k1 = *(const LAS bf16x8*)(kb + 32 * PITCH + d0 * 32);
                pa0 = __builtin_amdgcn_mfma_f32_32x32x16_bf16(k0, qa[d0], pa0, 0, 0, 0); pa1 = __builtin_amdgcn_mfma_f32_32x32x16_bf16(k1, qa[d0], pa1, 0, 0, 0);
                pb0 = __builtin_amdgcn_mfma_f32_32x32x16_bf16(k0, qbf[d0], pb0, 0, 0, 0); pb1 = __builtin_amdgcn_mfma_f32_32x32x16_bf16(k1, qbf[d0], pb1, 0, 0, 0); }
            if (j == qbw) { mask_range(pa0, pa1, -1, qrela, L.hi); mask_range(pb0, pb1, -1, qrela + 8, L.hi); }
            if (MODE == 1 && j == qbw - 8) { mask_range(pa0, pa1, qrela, 64, L.hi); mask_range(pb0, pb1, qrela + 8, 64, L.hi); }
            bool sela = true, selb = true;
            if (MODE == 0) { sela = (selp[0] >> j) & 1ull; selb = (selp[1] >> j) & 1ull; }
            softmax_step2(pa0, pa1, oa0, oa1, sa, sela, fa);
            __builtin_amdgcn_sched_barrier(0);
            softmax_step2(pb0, pb1, ob0, ob1, sb, selb, fb);
            __builtin_amdgcn_sched_barrier(0);
        }
        if (j < jhi) { kreg = *(const u32x4*)((const char*)Kt + (size_t)(j + 1) * 8192 + L.tid * 16); vreg = vload(Vt, j + 1, L); }
        if (act) {
            const LAS unsigned char* vb = Vbuf + cur * TILE_LDS + L.c * PITCH + L.hi * 16;
#pragma unroll
            for (int s = 0; s < 4; ++s) {
                const bf16x8 v0 = *(const LAS bf16x8*)(vb + s * 32); const bf16x8 v1 = *(const LAS bf16x8*)(vb + 32 * PITCH + s * 32);
                oa0 = __builtin_amdgcn_mfma_f32_32x32x16_bf16(v0, fa[s], oa0, 0, 0, 0); oa1 = __builtin_amdgcn_mfma_f32_32x32x16_bf16(v1, fa[s], oa1, 0, 0, 0);
                ob0 = __builtin_amdgcn_mfma_f32_32x32x16_bf16(v0, fb[s], ob0, 0, 0, 0); ob1 = __builtin_amdgcn_mfma_f32_32x32x16_bf16(v1, fb[s], ob1, 0, 0, 0); }
            renorm_step(oa0, oa1, sa); renorm_step(ob0, ob1, sb);
        }
        if (j < jhi) { *(LAS u32x4*)(Kbuf + (cur ^ 1) * TILE_LDS + so) = kreg; vstore(Vbuf + (cur ^ 1) * TILE_LDS, vreg, L); }
        __syncthreads();
    }
}
}
namespace nsa {
struct AttnPtrs {
    const bf16_t* q;
    const bf16_t* z;
    const bf16_t* kc;
    const bf16_t* vct;
    const bf16_t* ksel;
    const bf16_t* vselt;
    const bf16_t* kwin; const bf16_t* vwint;
    unsigned long long* selmask;
    bf16_t* mix;
};
template <bool ACCUM>
__device__ __forceinline__ void store_o(const f32x16& a0, const f32x16& a1, bf16_t* mix, long tok, int head, int hi) {
    bf16_t* op = mix + tok * 1024 + head * 64 + 4 * hi;
#pragma unroll
    for (int dd = 0; dd < 2; ++dd)
#pragma unroll
        for (int rq = 0; rq < 4; ++rq) {
            float v0, v1, v2, v3;
            if (dd == 0) { v0 = a0[4 * rq]; v1 = a0[4 * rq + 1]; v2 = a0[4 * rq + 2]; v3 = a0[4 * rq + 3]; }
            else         { v0 = a1[4 * rq]; v1 = a1[4 * rq + 1]; v2 = a1[4 * rq + 2]; v3 = a1[4 * rq + 3]; }
            u32x2* p = (u32x2*)(op + dd * 32 + rq * 8);
            if (ACCUM) { const u32x2 old = *p; v0 += bflo(old.x); v1 += bfhi(old.x); v2 += bflo(old.y); v3 += bfhi(old.y); }
            u32x2 w; w.x = cvt_pk_bf16(v0, v1); w.y = cvt_pk_bf16(v2, v3); *p = w;
        }
}
__device__ __forceinline__ float gate_of(const bf16_t* z, long tok, int head, int br) { return sigmoidf_(bf2f(z[tok * INP + ZG + head * 3 + br])); }

struct CmpPre { bf16x8 qr[4]; };
__device__ __forceinline__ void cmp_prefetch(CmpPre& R, int bh, int qb, const AttnPtrs& P, const Lane& L) {
    const int b = bh >> 1, h = bh & 1, tq = qb * 64 + 8 * L.wid + (L.c >> 2), head = 4 * h + (L.c & 3); const long tok = (long)b * SEQ + tq;
    load_q(R.qr, P.q, tok, head, L.hi);
}
__device__ __forceinline__ void cmp_stage(const CmpPre& R, LAS unsigned char* lds, const Lane& L, bf16x8 (&qr)[4], float& gt) {
    (void)lds; (void)L;
#pragma unroll
    for (int d0 = 0; d0 < 4; ++d0) qr[d0] = R.qr[d0];
    gt = 0.f;
}
template <bool STAGE>
__device__ __forceinline__ void cmp_unit(int bh, int qb, const AttnPtrs& P, LAS unsigned char* lds, const Lane& L) {
    const int b = bh >> 1, h = bh & 1, t0 = qb * 64;
    const int ql = 8 * L.wid + (L.c >> 2), g = L.c & 3, tq = t0 + ql, head = 4 * h + g;
    const long tok = (long)b * SEQ + tq;
    LAS unsigned char* Kb = lds; LAS unsigned char* Vb = lds + 4 * TILE_LDS;
    LAS float* G4 = (LAS float*)(lds + 8 * TILE_LDS); LAS float* E3 = G4 + 64 * 64;
    const float gate_raw = bf2f(P.z[tok * INP + ZG + head * 3 + 0]);
    bf16x8 qr[4]; load_q(qr, P.q, tok, head, L.hi);
    if (STAGE) { const char* ks = (const char*)(P.kc + (size_t)bh * 256 * 64); const char* vs = (const char*)(P.vct + (size_t)bh * 256 * 64); const int so = stage_off(L.tid); u32x4 kk[4], vv[4];
#pragma unroll
      for (int jn = 0; jn < 4; ++jn) kk[jn] = *(const u32x4*)(ks + jn * 8192 + L.tid * 16);
#pragma unroll
      for (int jn = 0; jn < 4; ++jn) vv[jn] = *(const u32x4*)(vs + jn * 8192 + L.tid * 16);
#pragma unroll
      for (int jn = 0; jn < 4; ++jn) *(LAS u32x4*)(Kb + jn * TILE_LDS + so) = kk[jn];
#pragma unroll
      for (int jn = 0; jn < 4; ++jn) *(LAS u32x4*)(Vb + jn * TILE_LDS + so) = vv[jn]; }
    __syncthreads();
    const int nmax = (tq >= 31) ? ((tq - 31) >> 4) : -1;
    const int tq_lo = t0 + 8 * L.wid, tq_hi = tq_lo + 7;
    const int nmax_lo = (tq_lo >= 31) ? ((tq_lo - 31) >> 4) : -1, nmax_hi = (tq_hi >= 31) ? ((tq_hi - 31) >> 4) : -1;
    const int ntile = (nmax_hi >= 0) ? (nmax_hi >> 6) + 1 : 0;
    const bool need_imp = qb >= 16;
    float l = 0.f;
    f32x16 o0, o1;
#pragma unroll
    for (int r = 0; r < 16; ++r) { o0[r] = 0.f; o1[r] = 0.f; }
    float gsr[4][8], e3r[4][8];
#pragma unroll
    for (int jn = 0; jn < 4; ++jn)
#pragma unroll
        for (int i = 0; i < 8; ++i) { gsr[jn][i] = 0.f; e3r[jn][i] = 0.f; }
#pragma unroll
    for (int jn = 0; jn < 4; ++jn) {
        if (jn < ntile) {
            f32x16 p0, p1; qk_tile(p0, p1, Kb + jn * TILE_LDS, qr, 0.f, L);
            if (64 * jn + 63 > nmax_lo) mask_range(p0, p1, -1, nmax - 64 * jn, L.hi);
            float ls = 0.f;
#pragma unroll
            for (int r = 0; r < 16; ++r) { p0[r] = fast_exp2(p0[r]); p1[r] = fast_exp2(p1[r]); ls += p0[r] + p1[r]; }
            l += ls;
            if (need_imp) {
#pragma unroll
                for (int rq = 0; rq < 4; ++rq) { gsr[jn][rq] = (p0[4 * rq] + p0[4 * rq + 1]) + (p0[4 * rq + 2] + p0[4 * rq + 3]); e3r[jn][rq] = p0[4 * rq + 3];
                                                 gsr[jn][4 + rq] = (p1[4 * rq] + p1[4 * rq + 1]) + (p1[4 * rq + 2] + p1[4 * rq + 3]); e3r[jn][4 + rq] = p1[4 * rq + 3]; } }
            pv_tile(o0, o1, Vb + jn * TILE_LDS, p0, p1, L);
        }
        __builtin_amdgcn_sched_barrier(0);
    }
    l += xshfl<32>(l);
    const float inv = (nmax >= 0 && l > 0.f) ? fast_rcp(l) : 0.f;
    if (need_imp) {
        LAS float* gp = G4 + ql * 64 + L.hi; asm volatile("" : "+v"(gp));
#pragma unroll
        for (int jn = 0; jn < 4; ++jn) {
            if (jn < ntile) {
#pragma unroll
                for (int i = 0; i < 8; ++i) { float gs = gsr[jn][i] * inv, e3 = e3r[jn][i] * inv;
                    gs += xshfl<1>(gs); gs += xshfl<2>(gs); e3 += xshfl<1>(e3); e3 += xshfl<2>(e3);
                    if (g == 0) { gp[16 * jn + 2 * i] = gs; gp[64 * 64 + 16 * jn + 2 * i] = e3; } }
            }
        }
    }
    {
        const float gt = sigmoidf_(gate_raw) * inv;
#pragma unroll
        for (int r = 0; r < 16; ++r) { o0[r] *= gt; o1[r] *= gt; }
        store_o<false>(o0, o1, P.mix, tok, head, L.hi);
    }
    __syncthreads();
}
__device__ __forceinline__ void cmp_topk(int bh, int qb, const AttnPtrs& P, LAS unsigned char* lds, const Lane& L) {
    const int t0 = qb * 64; LAS float* G4 = (LAS float*)(lds + 8 * TILE_LDS); LAS float* E3 = G4 + 64 * 64;
    const int s = L.lane;
    if (qb < 16) { const unsigned long long mask = (1ull << (qb + 1)) - 1ull;
        if (L.lane < 8) P.selmask[(size_t)bh * SEQ + t0 + 8 * L.wid + L.lane] = mask; }
    else {
        const bool cand = (s >= 1) && (s <= qb - 2);
        unsigned bits[8], T[8];
#pragma unroll
        for (int i = 0; i < 8; ++i) { const int q = 8 * L.wid + i; const float imp = G4[q * 64 + s] + (s > 0 ? E3[q * 64 + s - 1] : 0.f); bits[i] = cand ? __float_as_uint(fmaxf(imp, 0.f)) : 0u; T[i] = 0u; }
        int cnt[8];
#pragma unroll
        for (int i = 0; i < 8; ++i) cnt[i] = qb - 2;
        for (int bit = 30; bit >= 0; --bit) { int open_ = 0;
#pragma unroll
            for (int i = 0; i < 8; ++i) { const unsigned c = T[i] | (1u << bit); const int n = __popcll(__ballot(cand && bits[i] >= c)); if (n >= 13) { T[i] = c; cnt[i] = n; } open_ |= (cnt[i] != 13); }
            if (!open_) break; }
#pragma unroll
        for (int i = 0; i < 8; ++i) {
            const unsigned long long gt = __ballot(cand && bits[i] > T[i]); unsigned long long eq = __ballot(cand && bits[i] == T[i]);
            int need = 13 - __popcll(gt); unsigned long long take = 0ull;
            while (need > 0 && eq) { const unsigned long long low = eq & (0ull - eq); take |= low; eq ^= low; --need; }
            const unsigned long long mask = gt | take | 1ull | (1ull << qb) | (1ull << (qb - 1));
            if (L.lane == 0) P.selmask[(size_t)bh * SEQ + t0 + 8 * L.wid + i] = mask; }
    }
    __syncthreads();
}

__device__ __forceinline__ void sw_unit(int bh, int qb, const AttnPtrs& P, LAS unsigned char* lds, const Lane& L) {
    const int b = bh >> 1, h = bh & 1, t0 = qb * 64;
    const int ql = 8 * L.wid + (L.c >> 2), g = L.c & 3, tq = t0 + ql, head = 4 * h + g;
    const long tok = (long)b * SEQ + tq;
    bf16x8 qr[4]; load_q(qr, P.q, tok, head, L.hi);
    const unsigned long long selw = P.selmask[(size_t)bh * SEQ + tq];
    const float g1raw = bf2f(P.z[tok * INP + ZG + head * 3 + 1]), g2raw = bf2f(P.z[tok * INP + ZG + head * 3 + 2]);
    f32x16 r0, r1;
    {
        f32x16 o0, o1; float m = 0.f, l = 0.f;
#pragma unroll
        for (int r = 0; r < 16; ++r) { o0[r] = 0.f; o1[r] = 0.f; }
        run_branch<0>(o0, o1, m, l, P.ksel + (size_t)bh * SEQ * 64, P.vselt + (size_t)bh * SEQ * 64, 0, qb, qb, ql, selw, qr, lds, L);
        l += xshfl<32>(l);
        const float sc = sigmoidf_(g1raw) * fast_rcp(l);
#pragma unroll
        for (int r = 0; r < 16; ++r) { r0[r] = o0[r] * sc; r1[r] = o1[r] * sc; }
    }
    {
        f32x16 o0, o1; float m = 0.f, l = 0.f;
#pragma unroll
        for (int r = 0; r < 16; ++r) { o0[r] = 0.f; o1[r] = 0.f; }
        run_branch<1>(o0, o1, m, l, P.kwin + (size_t)bh * SEQ * 64, P.vwint + (size_t)bh * SEQ * 64, qb >= 8 ? qb - 8 : 0, qb, qb, ql, 0ull, qr, lds, L);
        l += xshfl<32>(l);
        const float sc = sigmoidf_(g2raw) * fast_rcp(l);
#pragma unroll
        for (int r = 0; r < 16; ++r) { r0[r] += o0[r] * sc; r1[r] += o1[r] * sc; }
    }
    store_o<true>(r0, r1, P.mix, tok, head, L.hi);
}
__device__ __forceinline__ void sw_unit2(int bh, int qb2, const AttnPtrs& P, LAS unsigned char* lds, const Lane& L) {
    const int b = bh >> 1, h = bh & 1, qbw = 2 * qb2 + (L.wid >> 2);
    const int qrela = 16 * (L.wid & 3) + (L.c >> 2), qrelb = qrela + 8, g = L.c & 3, head = 4 * h + g;
    const long toka = (long)b * SEQ + 64 * qbw + qrela, tokb = toka + 8;
    bf16x8 qa[4], qbf[4]; load_q(qa, P.q, toka, head, L.hi); load_q(qbf, P.q, tokb, head, L.hi);
    LAS unsigned long long* selp = (LAS unsigned long long*)(lds + 4 * TILE_LDS + 8192) + L.tid * 2;
    selp[0] = P.selmask[(size_t)bh * SEQ + 64 * qbw + qrela]; selp[1] = P.selmask[(size_t)bh * SEQ + 64 * qbw + qrelb];
    LAS float* gpark = (LAS float*)(lds + 4 * TILE_LDS) + L.tid * 4;
    gpark[0] = bf2f(P.z[toka * INP + ZG + head * 3 + 1]); gpark[1] = bf2f(P.z[tokb * INP + ZG + head * 3 + 1]); gpark[2] = bf2f(P.z[toka * INP + ZG + head * 3 + 2]); gpark[3] = bf2f(P.z[tokb * INP + ZG + head * 3 + 2]);
    {
        f32x16 oa0, oa1, ob0, ob1; SoftState sa{0.f, 0.f}, sb{0.f, 0.f};
#pragma unroll
        for (int r = 0; r < 16; ++r) { oa0[r] = 0.f; oa1[r] = 0.f; ob0[r] = 0.f; ob1[r] = 0.f; }
        run_branch2<0>(oa0, oa1, sa, ob0, ob1, sb, P.ksel + (size_t)bh * SEQ * 64, P.vselt + (size_t)bh * SEQ * 64, 0, 2 * qb2 + 1, qbw, qrela, selp, qa, qbf, lds, L);
        sa.l += xshfl<32>(sa.l); sb.l += xshfl<32>(sb.l);
        const float sca = sigmoidf_(gpark[0]) * fast_rcp(sa.l), scb = sigmoidf_(gpark[1]) * fast_rcp(sb.l);
#pragma unroll
        for (int r = 0; r < 16; ++r) { oa0[r] *= sca; oa1[r] *= sca; ob0[r] *= scb; ob1[r] *= scb; }
        { int qe = qrela; asm volatile("" : "+v"(qe));
          store_o<true>(oa0, oa1, P.mix, (long)b * SEQ + 64 * qbw + qe, head, L.hi); store_o<true>(ob0, ob1, P.mix, (long)b * SEQ + 64 * qbw + qe + 8, head, L.hi); }
    }
    {
        f32x16 oa0, oa1, ob0, ob1; SoftState sa{0.f, 0.f}, sb{0.f, 0.f};
#pragma unroll
        for (int r = 0; r < 16; ++r) { oa0[r] = 0.f; oa1[r] = 0.f; ob0[r] = 0.f; ob1[r] = 0.f; }
        run_branch2<1>(oa0, oa1, sa, ob0, ob1, sb, P.kwin + (size_t)bh * SEQ * 64, P.vwint + (size_t)bh * SEQ * 64, 2 * qb2 >= 8 ? 2 * qb2 - 8 : 0, 2 * qb2 + 1, qbw, qrela, selp, qa, qbf, lds, L);
        sa.l += xshfl<32>(sa.l); sb.l += xshfl<32>(sb.l);
        const float sca = sigmoidf_(gpark[2]) * fast_rcp(sa.l), scb = sigmoidf_(gpark[3]) * fast_rcp(sb.l);
#pragma unroll
        for (int r = 0; r < 16; ++r) { oa0[r] *= sca; oa1[r] *= sca; ob0[r] *= scb; ob1[r] *= scb; }
        { int qe = qrela; asm volatile("" : "+v"(qe));
          store_o<true>(oa0, oa1, P.mix, (long)b * SEQ + 64 * qbw + qe, head, L.hi); store_o<true>(ob0, ob1, P.mix, (long)b * SEQ + 64 * qbw + qe + 8, head, L.hi); }
    }
}
}
namespace epi {
using pg8::Unit; using pg8::BM; using pg8::HALF;
struct Bf16Plain {
    static constexpr bool PERM = true;
    bf16_t* O; int ldc;
    __device__ __forceinline__ void operator()(const f32x4 (&acc)[2][2][4][2], const Unit& u, int wr, int wc, int fr, int fq) const {
        const int row0 = u.pm * BM + wr * 64 + fr, col0 = u.pn * BM + wc * 32 + 8 * fq;
#pragma unroll
        for (int ai = 0; ai < 2; ++ai)
#pragma unroll
            for (int m = 0; m < 4; ++m) { bf16_t* rowp = O + (size_t)(row0 + ai * HALF + m * 16) * ldc + col0;
#pragma unroll
                for (int bj = 0; bj < 2; ++bj) { const f32x4 v0 = acc[ai][bj][m][0], v1 = acc[ai][bj][m][1];
                    u32x4 w; w.x = cvt_pk_bf16(v0[0], v0[1]); w.y = cvt_pk_bf16(v0[2], v0[3]); w.z = cvt_pk_bf16(v1[0], v1[1]); w.w = cvt_pk_bf16(v1[2], v1[3]);
                    *(u32x4*)(rowp + bj * HALF) = w; } }
    }
};
struct Bf16Sc1 {
    static constexpr bool PERM = true;
    bf16_t* O; int ldc; unsigned nbytes;
    __device__ __forceinline__ void operator()(const f32x4 (&acc)[2][2][4][2], const Unit& u, int wr, int wc, int fr, int fq) const {
        const __amdgpu_buffer_rsrc_t rsrc = __builtin_amdgcn_make_buffer_rsrc(O, 0, nbytes, 0x00020000);
        const int row0 = u.pm * BM + wr * 64 + fr, col0 = u.pn * BM + wc * 32 + 8 * fq;
#pragma unroll
        for (int ai = 0; ai < 2; ++ai)
#pragma unroll
            for (int m = 0; m < 4; ++m) { const unsigned off = (unsigned)(((size_t)(row0 + ai * HALF + m * 16) * ldc + col0) * 2);
#pragma unroll
                for (int bj = 0; bj < 2; ++bj) { const f32x4 v0 = acc[ai][bj][m][0], v1 = acc[ai][bj][m][1];
                    u32x4 w; w.x = cvt_pk_bf16(v0[0], v0[1]); w.y = cvt_pk_bf16(v0[2], v0[3]); w.z = cvt_pk_bf16(v1[0], v1[1]); w.w = cvt_pk_bf16(v1[2], v1[3]);
                    __builtin_amdgcn_raw_buffer_store_b128(w, rsrc, off + bj * HALF * 2, 0,   16); } }
    }
};
struct F32Grouped {
    static constexpr bool PERM = false;
    float* C; int ldc; size_t gstride;
    __device__ __forceinline__ void operator()(const f32x4 (&acc)[2][2][4][2], const Unit& u, int wr, int wc, int fr, int fq) const {
        const int row0 = u.pm * BM + wr * 64 + fr, col0 = u.pn * BM + wc * 32 + 4 * fq; float* Cg = C + (size_t)u.aux * gstride;
#pragma unroll
        for (int ai = 0; ai < 2; ++ai)
#pragma unroll
            for (int m = 0; m < 4; ++m) { float* rowp = Cg + (size_t)(row0 + ai * HALF + m * 16) * ldc + col0;
#pragma unroll
                for (int bj = 0; bj < 2; ++bj)
#pragma unroll
                    for (int n = 0; n < 2; ++n) *(f32x4*)(rowp + bj * HALF + n * 16) = acc[ai][bj][m][n]; }
    }
};
struct SwiGlu {
    static constexpr bool PERM = true;
    bf16_t* H; int ldc;
    __device__ __forceinline__ void operator()(const f32x4 (&acc)[2][2][4][2], const Unit& u, int wr, int wc, int fr, int fq) const {
        const int row0 = u.pm * BM + wr * 64 + fr, col0 = u.pn * HALF + wc * 32 + 8 * fq;
#pragma unroll
        for (int ai = 0; ai < 2; ++ai)
#pragma unroll
            for (int m = 0; m < 4; ++m) { bf16_t* rowp = H + (size_t)(row0 + ai * HALF + m * 16) * ldc + col0;
                float o[8];
#pragma unroll
                for (int n = 0; n < 2; ++n)
#pragma unroll
                    for (int e = 0; e < 4; ++e) o[4 * n + e] = siluf_(acc[ai][0][m][n][e]) * acc[ai][1][m][n][e];
                u32x4 w; w.x = cvt_pk_bf16(o[0], o[1]); w.y = cvt_pk_bf16(o[2], o[3]); w.z = cvt_pk_bf16(o[4], o[5]); w.w = cvt_pk_bf16(o[6], o[7]);
                *(u32x4*)rowp = w; }
    }
};
struct MoeDown {
    static constexpr bool PERM = true;
    bf16_t* Y; const int* row_tok;
    __device__ __forceinline__ void operator()(const f32x4 (&acc)[2][2][4][2], const Unit& u, int wr, int wc, int fr, int fq) const {
        const int srow0 = u.aux * BM + wr * 64 + fr, col0 = u.pn * BM + wc * 32 + 8 * fq;
        int dsts[8];
#pragma unroll
        for (int it = 0; it < 8; ++it) dsts[it] = row_tok[srow0 + (it >> 2) * HALF + (it & 3) * 16];
#pragma unroll
        for (int ai = 0; ai < 2; ++ai)
#pragma unroll
            for (int m = 0; m < 4; ++m) { const int dst = dsts[ai * 4 + m];
                if (dst >= 0) { bf16_t* rowp = Y + (size_t)dst * D + col0;
#pragma unroll
                    for (int bj = 0; bj < 2; ++bj) { const f32x4 v0 = acc[ai][bj][m][0], v1 = acc[ai][bj][m][1];
                        u32x4 w; w.x = cvt_pk_bf16(v0[0], v0[1]); w.y = cvt_pk_bf16(v0[2], v0[3]); w.z = cvt_pk_bf16(v1[0], v1[1]); w.w = cvt_pk_bf16(v1[2], v1[3]);
                        *(u32x4*)(rowp + bj * HALF) = w; } } }
    }
};
struct SigmoidBias {
    static constexpr bool PERM = true;
    bf16_t* O; int ldc; const float* bias;
    __device__ __forceinline__ void operator()(const f32x4 (&acc)[2][2][4][2], const Unit& u, int wr, int wc, int fr, int fq) const {
        const int row0 = u.pm * BM + wr * 64 + fr, col0 = u.pn * BM + wc * 32 + 8 * fq;
        f32x4 bv[2][2];
#pragma unroll
        for (int bj = 0; bj < 2; ++bj)
#pragma unroll
            for (int n = 0; n < 2; ++n) bv[bj][n] = *(const f32x4*)(bias + col0 + bj * HALF + 4 * n);
#pragma unroll
        for (int ai = 0; ai < 2; ++ai)
#pragma unroll
            for (int m = 0; m < 4; ++m) { bf16_t* rowp = O + (size_t)(row0 + ai * HALF + m * 16) * ldc + col0;
#pragma unroll
                for (int bj = 0; bj < 2; ++bj) { f32x4 v0 = acc[ai][bj][m][0] + bv[bj][0], v1 = acc[ai][bj][m][1] + bv[bj][1];
#pragma unroll
                    for (int e = 0; e < 4; ++e) { v0[e] = sigmoidf_(v0[e]); v1[e] = sigmoidf_(v1[e]); }
                    u32x4 w; w.x = cvt_pk_bf16(v0[0], v0[1]); w.y = cvt_pk_bf16(v0[2], v0[3]); w.z = cvt_pk_bf16(v1[0], v1[1]); w.w = cvt_pk_bf16(v1[2], v1[3]);
                    *(u32x4*)(rowp + bj * HALF) = w; } }
    }
};
struct MulBf16 {
    static constexpr bool PERM = true;
    bf16_t* O; const bf16_t* G; int ldc;
    __device__ __forceinline__ void operator()(const f32x4 (&acc)[2][2][4][2], const Unit& u, int wr, int wc, int fr, int fq) const {
        const int row0 = u.pm * BM + wr * 64 + fr, col0 = u.pn * BM + wc * 32 + 8 * fq;
        u32x4 gq[2], gn[2];
        { const size_t off = (size_t)row0 * ldc + col0; gn[0] = *(const u32x4*)(G + off); gn[1] = *(const u32x4*)(G + off + HALF); }
#pragma unroll
        for (int it = 0; it < 8; ++it) { const int ai = it >> 2, m = it & 3; const size_t off = (size_t)(row0 + ai * HALF + m * 16) * ldc + col0;
            gq[0] = gn[0]; gq[1] = gn[1];
            if (it < 7) { const int ai2 = (it + 1) >> 2, m2 = (it + 1) & 3; const size_t off2 = (size_t)(row0 + ai2 * HALF + m2 * 16) * ldc + col0; gn[0] = *(const u32x4*)(G + off2); gn[1] = *(const u32x4*)(G + off2 + HALF); }
#pragma unroll
            for (int bj = 0; bj < 2; ++bj) { const f32x4 v0 = acc[ai][bj][m][0], v1 = acc[ai][bj][m][1]; const u32x4 g4 = gq[bj];
                u32x4 w; w.x = cvt_pk_bf16(v0[0] * bflo(g4.x), v0[1] * bfhi(g4.x)); w.y = cvt_pk_bf16(v0[2] * bflo(g4.y), v0[3] * bfhi(g4.y));
                w.z = cvt_pk_bf16(v1[0] * bflo(g4.z), v1[1] * bfhi(g4.z)); w.w = cvt_pk_bf16(v1[2] * bflo(g4.w), v1[3] * bfhi(g4.w));
                *(u32x4*)(O + off + bj * HALF) = w; }
            asm volatile("" ::: "memory"); }
    }
};
struct S5Out {
    static constexpr bool PERM = true;
    bf16_t* ZS5; const bf16_t* Z; const float* dskip;
    __device__ __forceinline__ void operator()(const f32x4 (&acc)[2][2][4][2], const Unit& u, int wr, int wc, int fr, int fq) const {
        const int g = u.aux, row0 = u.pm * BM + wr * 64 + fr;
#pragma unroll
        for (int bj = 0; bj < 2; ++bj) { const int col = u.pn * BM + bj * HALF + wc * 32 + 8 * fq, jo = col >> 4, co0 = col & 15, ch0 = g * 16 + co0;
            const f32x4 d0 = *(const f32x4*)(dskip + ch0), d1 = *(const f32x4*)(dskip + ch0 + 4);
#pragma unroll
            for (int ai = 0; ai < 2; ++ai)
#pragma unroll
                for (int m = 0; m < 4; ++m) { const int mr = row0 + ai * HALF + m * 16; const long tok = (long)(mr >> 7) * SEQ + (mr & 127) * S5LC + jo;
                    const u32x4 uq = *(const u32x4*)(Z + tok * INP + ZS + ch0); const f32x4 v0 = acc[ai][bj][m][0], v1 = acc[ai][bj][m][1];
                    u32x4 w; w.x = cvt_pk_bf16(gelu_tanh(v0[0] + d0[0] * bflo(uq.x)), gelu_tanh(v0[1] + d0[1] * bfhi(uq.x)));
                    w.y = cvt_pk_bf16(gelu_tanh(v0[2] + d0[2] * bflo(uq.y)), gelu_tanh(v0[3] + d0[3] * bfhi(uq.y)));
                    w.z = cvt_pk_bf16(gelu_tanh(v1[0] + d1[0] * bflo(uq.z)), gelu_tanh(v1[1] + d1[1] * bfhi(uq.z)));
                    w.w = cvt_pk_bf16(gelu_tanh(v1[2] + d1[2] * bflo(uq.w)), gelu_tanh(v1[3] + d1[3] * bfhi(uq.w)));
                    *(u32x4*)(ZS5 + tok * 256 + ch0) = w; asm volatile("" ::: "memory"); } }
    }
};
struct S5Glu {
    static constexpr bool PERM = true;
    bf16_t* MIX; const bf16_t* ZS5; const float* bias;
    __device__ __forceinline__ void operator()(const f32x4 (&acc)[2][2][4][2], const Unit& u, int wr, int wc, int fr, int fq) const {
        const int row0 = u.pm * BM + wr * 64 + fr, col0 = wc * 32 + 8 * fq;
#pragma unroll
        for (int bj = 0; bj < 2; ++bj) { const int col = col0 + bj * HALF; const f32x4 b0 = *(const f32x4*)(bias + col), b1 = *(const f32x4*)(bias + col + 4);
#pragma unroll
            for (int ai = 0; ai < 2; ++ai)
#pragma unroll
                for (int m = 0; m < 4; ++m) { const size_t row = (size_t)(row0 + ai * HALF + m * 16); const u32x4 zq = *(const u32x4*)(ZS5 + row * 256 + col);
                    const f32x4 v0 = acc[ai][bj][m][0] + b0, v1 = acc[ai][bj][m][1] + b1;
                    u32x4 w; w.x = cvt_pk_bf16(bflo(zq.x) * sigmoidf_(v0[0]), bfhi(zq.x) * sigmoidf_(v0[1])); w.y = cvt_pk_bf16(bflo(zq.y) * sigmoidf_(v0[2]), bfhi(zq.y) * sigmoidf_(v0[3]));
                    w.z = cvt_pk_bf16(bflo(zq.z) * sigmoidf_(v1[0]), bfhi(zq.z) * sigmoidf_(v1[1])); w.w = cvt_pk_bf16(bflo(zq.w) * sigmoidf_(v1[2]), bfhi(zq.w) * sigmoidf_(v1[3]));
                    *(u32x4*)(MIX + row * 1024 + 768 + col) = w; asm volatile("" ::: "memory"); } }
    }
};
struct EpiWin {
    static constexpr bool PERM = true;
    bf16_t* Z; bf16_t* Q; bf16_t* KV; bf16_t* AP; const f32x2* rope;
    __device__ __forceinline__ void operator()(const f32x4 (&acc)[2][2][4][2], const Unit& u, int wr, int wc, int fr, int fq) const {
        const int row0 = u.pm * BM + wr * 64 + fr;
        if (u.pn >= 5) {
#pragma unroll
            for (int bj = 0; bj < 2; ++bj) { const int col0 = u.pn * BM + bj * HALF + wc * 32 + 8 * fq; const int sc0 = col0 - ZS; const bool s5 = (sc0 >= 0) && (sc0 < 256);
#pragma unroll
                for (int ai = 0; ai < 2; ++ai)
#pragma unroll
                    for (int m = 0; m < 4; ++m) { const int tok = row0 + ai * HALF + m * 16; const f32x4 v0 = acc[ai][bj][m][0], v1 = acc[ai][bj][m][1];
                        u32x4 w; w.x = cvt_pk_bf16(v0[0], v0[1]); w.y = cvt_pk_bf16(v0[2], v0[3]); w.z = cvt_pk_bf16(v1[0], v1[1]); w.w = cvt_pk_bf16(v1[2], v1[3]);
                        *(u32x4*)(Z + (size_t)tok * INP + col0) = w;
                        if (s5) { const int b = tok >> 12, t = tok & 4095; *(u32x4*)(AP + ((size_t)(sc0 >> 4) * 2048 + b * 128 + (t >> 5)) * S5K + (t & 31) * 16 + (sc0 & 15)) = w; } } }
            return;
        }
#pragma unroll
        for (int bj = 0; bj < 2; ++bj) {
            const int colh = bj * HALF + wc * 32 + 8 * fq;
            const int qi = 4 * (wc & 1) + fq, d1 = 4 * qi;
            const bool isv = (u.pn >= 2) && (bj == 1);
            f32x4 cn0 = (f32x4){0.f, 0.f, 0.f, 0.f}, cn1 = cn0;
            if (!isv) { cn0 = *(const f32x4*)(rope + (size_t)row0 * 32 + d1); cn1 = *(const f32x4*)(rope + (size_t)row0 * 32 + d1 + 2); }
#pragma unroll
            for (int it = 0; it < 8; ++it) { const int ai = it >> 2, m = it & 3; const int tok = row0 + ai * HALF + m * 16; const int b = tok >> 12, t = tok & 4095; const f32x4 x1 = acc[ai][bj][m][0], x2 = acc[ai][bj][m][1];
                    if (isv) { bf16_t* dst = KV + (size_t)((u.pn - 2) * 2 + 1) * (8u << 20) + ((size_t)(b * 2 + (wc >> 1)) * SEQ + t) * 64 + 32 * (wc & 1) + 8 * fq;
                        u32x4 w; w.x = cvt_pk_bf16(x1[0], x1[1]); w.y = cvt_pk_bf16(x1[2], x1[3]); w.z = cvt_pk_bf16(x2[0], x2[1]); w.w = cvt_pk_bf16(x2[2], x2[3]); *(u32x4*)dst = w; }
                    else { const f32x4 cs0 = cn0, cs1 = cn1;
                        if (it < 7) { const int tok2 = row0 + ((it + 1) >> 2) * HALF + ((it + 1) & 3) * 16; cn0 = *(const f32x4*)(rope + (size_t)tok2 * 32 + d1); cn1 = *(const f32x4*)(rope + (size_t)tok2 * 32 + d1 + 2); }
                        const float sc = (u.pn < 2) ? QSCALE : 1.0f;
                        const float o10 = (x1[0] * cs0[0] - x2[0] * cs0[1]) * sc, o11 = (x1[1] * cs0[2] - x2[1] * cs0[3]) * sc, o12 = (x1[2] * cs1[0] - x2[2] * cs1[1]) * sc, o13 = (x1[3] * cs1[2] - x2[3] * cs1[3]) * sc;
                        const float o20 = (x2[0] * cs0[0] + x1[0] * cs0[1]) * sc, o21 = (x2[1] * cs0[2] + x1[1] * cs0[3]) * sc, o22 = (x2[2] * cs1[0] + x1[2] * cs1[1]) * sc, o23 = (x2[3] * cs1[2] + x1[3] * cs1[3]) * sc;
                        bf16_t* dst = (u.pn < 2) ? Q + (size_t)tok * 512 + (u.pn * 4 + (colh >> 6)) * 64 + d1
                                                 : KV + (size_t)((u.pn - 2) * 2) * (8u << 20) + ((size_t)(b * 2 + (wc >> 1)) * SEQ + t) * 64 + d1;
                        u32x2 w1, w2; w1.x = cvt_pk_bf16(o10, o11); w1.y = cvt_pk_bf16(o12, o13); w2.x = cvt_pk_bf16(o20, o21); w2.y = cvt_pk_bf16(o22, o23);
                        *(u32x2*)dst = w1; *(u32x2*)(dst + 32) = w2; }
                    asm volatile("" ::: "memory"); }
        }
    }
};
}
constexpr size_t MiB = 1u << 20;
constexpr size_t WS_CTL = 0, CTL_ZERO_BYTES = 1 * MiB;
constexpr size_t WS_SMALL = 1 * MiB;
constexpr size_t SM_APOW = WS_SMALL;
constexpr size_t SM_BBAR = WS_SMALL + 5 * MiB / 4;
constexpr size_t SM_KTAB = WS_SMALL + 2 * MiB;
constexpr size_t SM_CMPB = WS_SMALL + 4 * MiB;
constexpr size_t SM_TOKE = WS_SMALL + 4 * MiB + 256 * 1024;
constexpr size_t SM_TOKW = WS_SMALL + 4 * MiB + 512 * 1024;
constexpr size_t SM_ROWTOK = WS_SMALL + 5 * MiB + 256 * 1024;
constexpr size_t SM_PCNT = WS_SMALL + 6 * MiB;
constexpr size_t SM_TILEEXP = WS_SMALL + 6 * MiB + 16384;
constexpr size_t WS_ROPE = 8 * MiB;
constexpr size_t WS_W = 24 * MiB;
constexpr size_t W_IN = WS_W;
constexpr size_t W_OUT = W_IN + (size_t)INP * D * 2;
constexpr size_t W_GATE = W_OUT + (size_t)D * D * 2;
constexpr size_t W_PROJ = W_GATE + (size_t)D * D * 2;
constexpr size_t W_CMP = W_PROJ + (size_t)D * PLE * 2;
constexpr size_t W_GLU = W_CMP + (size_t)2 * 512 * 1024 * 2;
constexpr size_t W_S5B = W_GLU + (size_t)256 * 256 * 2;
constexpr size_t W_S5S = W_S5B + (size_t)16 * 512 * S5K * 2;
constexpr size_t W_UP = W_S5S + (size_t)16 * 256 * 512 * 2;
constexpr size_t W_DN = W_UP + (size_t)NEXP * 2 * DFE * D * 2;
constexpr size_t W_END_ = W_DN + (size_t)NEXP * D * DFE * 2;
static_assert(W_END_ <= WS_W + 240 * MiB, "weight region");
constexpr size_t WS_XB = 264 * MiB;
constexpr size_t WS_PB = 392 * MiB;
constexpr size_t WS_Z = 424 * MiB;
constexpr size_t WS_QKV = 712 * MiB;
constexpr size_t WS_Q = WS_QKV, WS_KCMP = WS_QKV + 64 * MiB, WS_VCMP = WS_KCMP + 16 * MiB, WS_KSEL = WS_VCMP + 16 * MiB, WS_VSEL = WS_KSEL + 16 * MiB, WS_KWIN = WS_VSEL + 16 * MiB, WS_VWIN = WS_KWIN + 16 * MiB;
constexpr size_t WS_MIX = 872 * MiB;
constexpr size_t WS_CMP = 1000 * MiB;
constexpr size_t WS_CMPP = WS_CMP, WS_KC = WS_CMP + 32 * MiB, WS_VCT = WS_KC + 1 * MiB, WS_SELM = WS_VCT + 1 * MiB;
constexpr size_t WS_S5 = 1036 * MiB;
constexpr size_t WS_S5A = WS_S5, WS_S5S = WS_S5 + 40 * MiB, WS_ZS5 = WS_S5S + 32 * MiB;
constexpr size_t WS_HBUF = 1140 * MiB;
constexpr size_t WS_END = 1268 * MiB;
constexpr size_t WS_FFH = WS_Z, WS_XS = WS_Z, WS_MH = WS_Z + 260 * MiB, WS_YB = WS_MH + 224 * MiB;
static_assert(WS_YB + 256 * MiB <= WS_END && WS_FFH + (size_t)T * DFF * 2 <= WS_MIX, "overlays");
constexpr size_t WS_PLEG = WS_Z, WS_PLEH = WS_Z + 128 * MiB;
static_assert(WS_PLEH + 128 * MiB <= WS_MH, "per-layer-embedding buffers of the MoE layers");
constexpr int CW_BAR = 4096;
constexpr int CW_TMO = 64;
constexpr int CW_CNT = 16384, CNT_BANK = 256 * 64;
static_assert((CW_CNT + 8 * CNT_BANK) * 4 <= (int)CTL_ZERO_BYTES, "panel counters inside the per-call memset");

struct Args { const void* in[36]; float* out; unsigned char* ws; int gp_lo, gp_hi, use_bar, pad; };
struct Frame { LAS unsigned char* lds; int tid, lane, wave, G, bid; };
constexpr int RING_BYTES = 131072, LDSCTL_OFF = RING_BYTES, LDS_BYTES = 147456;
typedef __attribute__((address_space(4))) const Args CArgs;
__device__ __forceinline__ void load_args(Args& a) { CArgs* p = (CArgs*)__builtin_amdgcn_kernarg_segment_ptr(); asm volatile("" : "+s"(p)); __builtin_memcpy(&a, p, sizeof(Args)); }
__device__ __forceinline__ Frame make_frame(LAS unsigned char* lds, int wave0) { Frame F; F.lds = lds;
    int w = wave0; asm volatile("" : "+s"(w)); int ln = lane_id_fresh(); F.lane = ln; F.wave = w; F.tid = w * 64 + ln;
    int b = blockIdx.x, g = gridDim.x; asm volatile("" : "+s"(b), "+s"(g)); F.bid = b; F.G = g; return F; }

__constant__ double c_invfreq_rev[32] = {0.15915494309189535, 0.11934937021124886, 0.08949940160889101, 0.06711508300522726, 0.050329212104487035, 0.03774158471741977, 0.0283021958306234, 0.02122365276477766, 0.015915494309189534, 0.011934937021124886, 0.008949940160889102, 0.006711508300522725, 0.005032921210448704, 0.003774158471741977, 0.00283021958306234, 0.0021223652764777662, 0.0015915494309189536, 0.0011934937021124885, 0.0008949940160889102, 0.0006711508300522726, 0.0005032921210448703, 0.00037741584717419774, 0.00028302195830623395, 0.0002122365276477766, 0.00015915494309189535, 0.00011934937021124886, 8.949940160889102e-05, 6.711508300522725e-05, 5.0329212104487035e-05, 3.774158471741978e-05, 2.8302195830623396e-05, 2.122365276477766e-05};

__device__ __forceinline__ void sincos_rev(double rev, float& c, float& s) { const double fr = rev - __builtin_floor(rev); const float f = (float)fr; s = __builtin_amdgcn_sinf(f); c = __builtin_amdgcn_cosf(f); }

template <class Sched>
__device__ __forceinline__ void panels_publish_wait(const Frame& F, unsigned* ctl, int bank, const Sched& S, unsigned need) {
    unsigned* cnt = ctl + CW_CNT + bank * CNT_BANK;
    if (F.tid == 0) { pg8::Unit u; for (int i = 0; S.next(i, u); ++i) __hip_atomic_fetch_add(cnt + 64 * u.pm, 1u, __ATOMIC_RELAXED, __HIP_MEMORY_SCOPE_AGENT); }
    if (F.wave == 0) {
        for (int pm = F.bid; pm < T / 256; pm += F.G) { unsigned spins = 0;
            while ((unsigned)__builtin_amdgcn_readfirstlane(__hip_atomic_load(cnt + 64 * pm, __ATOMIC_RELAXED, __HIP_MEMORY_SCOPE_AGENT)) < need) {
                __builtin_amdgcn_s_sleep(1);
                if (++spins > (1u << 22)) { if (F.lane == 0) __hip_atomic_store(ctl + CW_TMO, 1u, __ATOMIC_RELAXED, __HIP_MEMORY_SCOPE_AGENT); break; }
                if ((spins & 1023u) == 0u && __builtin_amdgcn_readfirstlane(__hip_atomic_load(ctl + CW_TMO, __ATOMIC_RELAXED, __HIP_MEMORY_SCOPE_AGENT))) break; } }
        __builtin_amdgcn_fence(__ATOMIC_ACQUIRE, "agent");
        asm volatile("s_waitcnt vmcnt(0)" ::: "memory");
    }
    __syncthreads();
}
__device__ __forceinline__ void phase_init0(const Frame& F, const Args& a) {
    const size_t gt = (size_t)F.bid * 512 + F.tid, NT = (size_t)F.G * 512;
    const int* pos = (const int*)a.in[2]; f32x2* rope = (f32x2*)(a.ws + WS_ROPE);
    for (size_t i = gt; i < (size_t)T * 32; i += NT) { const int tok = (int)(i >> 5), k = (int)(i & 31); float c, s; sincos_rev((double)pos[tok] * c_invfreq_rev[k], c, s); rope[i] = (f32x2){c, s}; }
    const float* are = (const float*)a.in[14]; const float* aim = (const float*)a.in[15]; const float* ldt = (const float*)a.in[16];
    const float* bre = (const float*)a.in[17]; const float* bim = (const float*)a.in[18];
    f32x2* apow = (f32x2*)(a.ws + SM_APOW); f32x2* bbar = (f32x2*)(a.ws + SM_BBAR);
    for (size_t i = gt; i < (size_t)DEPTH * 16 * 64 * 34; i += NT) { const int k = (int)(i % 34), lgn = (int)(i / 34), lg = lgn >> 6;
        const float dt = __expf(ldt[lg]); const float ar = are[lgn] * dt; const double rev = (double)k * ((double)aim[lgn] * (double)dt) * 0.15915494309189535;
        float c, s; sincos_rev(rev, c, s); const float mg = __expf((float)k * ar); apow[i] = (f32x2){mg * c, mg * s}; }
    for (size_t i = gt; i < (size_t)DEPTH * 16 * 64 * 16; i += NT) { const int lgn = (int)(i >> 4), lg = lgn >> 6;
        const float dt = __expf(ldt[lg]); const float lr = are[lgn], li = aim[lgn]; const double rev = ((double)li * (double)dt) * 0.15915494309189535;
        float c, s; sincos_rev(rev, c, s); const float mg = __expf(lr * dt); const float abr = mg * c, abi = mg * s, den = lr * lr + li * li;
        const float cr = ((abr - 1.0f) * lr + abi * li) / den, ci = (abi * lr - (abr - 1.0f) * li) / den;
        const float br = bre[i], bi = bim[i]; bbar[i] = (f32x2){cr * br - ci * bi, cr * bi + ci * br}; }
    const f32x4* x4 = (const f32x4*)a.in[0]; u32x2* xb = (u32x2*)(a.ws + WS_XB);
    for (size_t i = gt; i < (size_t)T * D / 4; i += 4 * NT) { f32x4 v[4];
#pragma unroll
        for (int q = 0; q < 4; ++q) { const size_t ii = i + q * NT; v[q] = (ii < (size_t)T * D / 4) ? x4[ii] : (f32x4){0.f, 0.f, 0.f, 0.f}; }
#pragma unroll
        for (int q = 0; q < 4; ++q) { const size_t ii = i + q * NT; if (ii < (size_t)T * D / 4) { u32x2 w; w.x = cvt_pk_bf16(v[q][0], v[q][1]); w.y = cvt_pk_bf16(v[q][2], v[q][3]); xb[ii] = w; } } }
}
__device__ __forceinline__ void phase_init1(const Frame& F, const Args& a) {
    const size_t gt = (size_t)F.bid * 512 + F.tid, NT = (size_t)F.G * 512;
    const float* cre = (const float*)a.in[19]; const float* cim = (const float*)a.in[20];
    const f32x2* apow = (const f32x2*)(a.ws + SM_APOW); const f32x2* bbar = (const f32x2*)(a.ws + SM_BBAR); float* ktab = (float*)(a.ws + SM_KTAB);
    for (size_t i = gt; i < (size_t)DEPTH * 16 * 32 * 256; i += NT) { const int ci = (int)(i & 15), co = (int)((i >> 4) & 15), tau = (int)((i >> 8) & 31), lg = (int)(i >> 13);
        float acc = 0.f;
        for (int n = 0; n < 64; ++n) { const f32x2 P = apow[((size_t)lg * 64 + n) * 34 + tau], Bb = bbar[((size_t)lg * 64 + n) * 16 + ci]; const float cr = cre[((size_t)lg * 16 + co) * 64 + n], cm = cim[((size_t)lg * 16 + co) * 64 + n];
            const float hr = P.x * Bb.x - P.y * Bb.y, hi = P.x * Bb.y + P.y * Bb.x; acc += cr * hr - cm * hi; }
        ktab[i] = acc; }
}

__device__ __forceinline__ void transpose_item(const float* W, int ldw, int k0, int n0, int nvalid, bf16_t* dstrow, int dst_ld, LAS float* scr, int lane, int permhi) {
    float tv[32];
#pragma unroll
    for (int i = 0; i < 32; ++i) { const int kk = 2 * i + (lane >> 5), nn = lane & 31; tv[i] = (nn < nvalid) ? W[(size_t)(k0 + kk) * ldw + n0 + nn] : 0.f; }
#pragma unroll
    for (int i = 0; i < 32; ++i) { const int kk = 2 * i + (lane >> 5), nn = lane & 31; scr[kk * 33 + nn] = tv[i]; }
    LDS_WAIT(); asm volatile("" ::: "memory");
    const int c = lane & 7;
#pragma unroll
    for (int j = 0; j < 4; ++j) { const int n = (lane >> 3) + 8 * j; const LAS float* s = scr + (8 * c) * 33 + n;
        u32x4 o; o.x = cvt_pk_bf16(s[0 * 33], s[1 * 33]); o.y = cvt_pk_bf16(s[2 * 33], s[3 * 33]); o.z = cvt_pk_bf16(s[4 * 33], s[5 * 33]); o.w = cvt_pk_bf16(s[6 * 33], s[7 * 33]);
        const int drow = permhi < 0 ? n : (8 * (n >> 2) + 4 * permhi + (n & 3));
        if (n < nvalid) *(u32x4*)(dstrow + (size_t)drow * dst_ld + 8 * c) = o; }
    LDS_WAIT(); asm volatile("" ::: "memory");
}
__device__ __forceinline__ void transpose_mat(const float* W, int K, int N, bf16_t* dst, int dst_ld, int mode, LAS float* scr, int lane, int& cursor, int gw, int NGW) {
    const int nblk = (N + 31) / 32, items = (K / 64) * nblk;
    int it = ((gw - cursor) % NGW + NGW) % NGW;
    for (; it < items; it += NGW) { const int kb = it / nblk, nb = it % nblk, k0 = 64 * kb, n0 = 32 * nb; const int nv = (N - n0) < 32 ? (N - n0) : 32;
        int drow = n0, permhi = -1;
        if (mode == 1 || mode == 2) drow = (n0 >> 7) * 256 + (n0 & 127) + (mode == 2 ? 128 : 0);
        if (mode == 3 && (n0 < 512 || (n0 < 1280 && (((n0 - 512) >> 7) & 1) == 0))) { drow = n0 & ~63; permhi = (n0 >> 5) & 1; }
        transpose_item(W, N, k0, n0, nv, dst + (size_t)drow * dst_ld + k0, dst_ld, scr, lane, permhi); }
    cursor = (cursor + items) % NGW;
}

__device__ __forceinline__ void phase_prep(const Frame& F, const Args& a, int l) {
    LAS float* scr = (LAS float*)(F.lds + F.wave * 16384);
    const int gw = F.bid * 8 + F.wave, NGW = F.G * 8; int cursor = 0;
    unsigned char* ws = a.ws;
    transpose_mat((const float*)a.in[3] + (size_t)l * D * INW, D, INW, (bf16_t*)(ws + W_IN), D, 3, scr, F.lane, cursor, gw, NGW);
    transpose_mat((const float*)a.in[4] + (size_t)l * D * D, D, D, (bf16_t*)(ws + W_OUT), D, 0, scr, F.lane, cursor, gw, NGW);
    transpose_mat((const float*)a.in[31] + (size_t)l * D * D, D, D, (bf16_t*)(ws + W_GATE), D, 0, scr, F.lane, cursor, gw, NGW);
    transpose_mat((const float*)a.in[33] + (size_t)l * PLE * D, PLE, D, (bf16_t*)(ws + W_PROJ), PLE, 0, scr, F.lane, cursor, gw, NGW);
    for (int j = 0; j < 2; ++j) { const float* w1 = (const float*)a.in[6] + ((size_t)l * 2 + j) * 2048 * 256; bf16_t* dst = (bf16_t*)(ws + W_CMP) + (size_t)j * 512 * 1024;
        transpose_mat(w1, 1024, 256, dst, 1024, 0, scr, F.lane, cursor, gw, NGW);
        transpose_mat(w1 + (size_t)1024 * 256, 1024, 256, dst + (size_t)256 * 1024, 1024, 0, scr, F.lane, cursor, gw, NGW); }
    transpose_mat((const float*)a.in[22] + (size_t)l * 256 * 256, 256, 256, (bf16_t*)(ws + W_GLU), 256, 0, scr, F.lane, cursor, gw, NGW);
    const int j2 = l >> 1;
    if ((l & 1) == 0) {
        transpose_mat((const float*)a.in[24] + (size_t)j2 * D * DFF, D, DFF, (bf16_t*)(ws + W_UP), D, 1, scr, F.lane, cursor, gw, NGW);
        transpose_mat((const float*)a.in[25] + (size_t)j2 * D * DFF, D, DFF, (bf16_t*)(ws + W_UP), D, 2, scr, F.lane, cursor, gw, NGW);
        transpose_mat((const float*)a.in[26] + (size_t)j2 * DFF * D, DFF, D, (bf16_t*)(ws + W_DN), DFF, 0, scr, F.lane, cursor, gw, NGW);
    } else {
        for (int e = 0; e < NEXP; ++e) { const size_t eo = (size_t)j2 * NEXP + e;
            transpose_mat((const float*)a.in[28] + eo * D * DFE, D, DFE, (bf16_t*)(ws + W_UP) + (size_t)e * 2 * DFE * D, D, 1, scr, F.lane, cursor, gw, NGW);
            transpose_mat((const float*)a.in[29] + eo * D * DFE, D, DFE, (bf16_t*)(ws + W_UP) + (size_t)e * 2 * DFE * D, D, 2, scr, F.lane, cursor, gw, NGW);
            transpose_mat((const float*)a.in[30] + eo * DFE * D, DFE, D, (bf16_t*)(ws + W_DN) + (size_t)e * D * DFE, DFE, 0, scr, F.lane, cursor, gw, NGW); }
    }
    const size_t gt = (size_t)F.bid * 512 + F.tid, NT = (size_t)F.G * 512;
    {
        u32x4* zp = (u32x4*)((bf16_t*)(ws + W_IN) + (size_t)INW * D); const size_t n16 = (size_t)(INP - INW) * D * 2 / 16;
        unsigned zz = 0u; asm volatile("" : "+v"(zz));
        for (size_t i = gt; i < n16; i += NT) zp[i] = (u32x4){zz, zz, zz, zz};
    }
    {
        const f32x4* p4 = (const f32x4*)((const float*)a.in[1] + (size_t)l * T * PLE); u32x2* pb = (u32x2*)(ws + WS_PB);
        for (size_t i = gt; i < (size_t)T * PLE / 4; i += 4 * NT) { f32x4 v[4];
#pragma unroll
            for (int q = 0; q < 4; ++q) { const size_t ii = i + q * NT; v[q] = (ii < (size_t)T * PLE / 4) ? p4[ii] : (f32x4){0.f, 0.f, 0.f, 0.f}; }
#pragma unroll
            for (int q = 0; q < 4; ++q) { const size_t ii = i + q * NT; if (ii < (size_t)T * PLE / 4) { u32x2 w; w.x = cvt_pk_bf16(v[q][0], v[q][1]); w.y = cvt_pk_bf16(v[q][2], v[q][3]); pb[ii] = w; } } }
    }
    {
        const float* ktab = (const float*)(ws + SM_KTAB) + (size_t)l * 16 * 32 * 256; const f32x2* apow = (const f32x2*)(ws + SM_APOW) + (size_t)l * 16 * 64 * 34; const f32x2* bbar = (const f32x2*)(ws + SM_BBAR) + (size_t)l * 16 * 64 * 16;
        const float* cre = (const float*)a.in[19] + (size_t)l * 16 * 16 * 64; const float* cim = (const float*)a.in[20] + (size_t)l * 16 * 16 * 64;
        bf16_t* Bt = (bf16_t*)(ws + W_S5B);
        for (size_t i = gt; i < (size_t)16 * 512 * S5K; i += NT) { const int k = (int)(i % S5K), row = (int)((i / S5K) & 511), g = (int)(i / ((size_t)S5K * 512)); const int jo = row >> 4, co = row & 15;
            float v;
            if (k < 512) { const int ji = k >> 4, ci = k & 15; v = (jo >= ji) ? ktab[(((size_t)g * 32 + (jo - ji)) * 16 + co) * 16 + ci] : 0.f; }
            else { const int n = (k - 512) & 63; const f32x2 P = apow[((size_t)g * 64 + n) * 34 + jo + 1]; const float cr = cre[((size_t)g * 16 + co) * 64 + n], cm = cim[((size_t)g * 16 + co) * 64 + n];
                v = (k < 576) ? (cr * P.x - cm * P.y) : -(cr * P.y + cm * P.x); }
            Bt[i] = f2bf(v); }
        bf16_t* St = (bf16_t*)(ws + W_S5S);
        for (size_t i = gt; i < (size_t)16 * 256 * 512; i += NT) { const int k = (int)(i & 511), np = (int)((i >> 9) & 255), g = (int)(i >> 17); const int j = k >> 4, ci = k & 15;
            float v = 0.f;
            if (np < 128) { const int n = np & 63; const f32x2 P = apow[((size_t)g * 64 + n) * 34 + (S5LC - 1 - j)], Bb = bbar[((size_t)g * 64 + n) * 16 + ci]; v = (np < 64) ? (P.x * Bb.x - P.y * Bb.y) : (P.x * Bb.y + P.y * Bb.x); }
            St[i] = f2bf(v); }
    }
    {
        float* cb = (float*)(ws + SM_CMPB); LAS float* red = (LAS float*)(F.lds + 8 * 16384 - 4096);
        for (int o = F.bid; o < 8; o += F.G) { const int j = o >> 2, cblk = o & 3; const float* w1 = (const float*)a.in[6] + ((size_t)l * 2 + j) * 2048 * 256 + cblk * 64 + F.lane; const float* pe = (const float*)a.in[5] + ((size_t)l * 2 + j) * 2048;
            float s0 = 0.f, s1 = 0.f, s2 = 0.f, s3 = 0.f;
#pragma unroll 4
            for (int k = 256 * F.wave; k < 256 * F.wave + 256; k += 4) { s0 += pe[k] * w1[(size_t)k * 256]; s1 += pe[k + 1] * w1[(size_t)(k + 1) * 256]; s2 += pe[k + 2] * w1[(size_t)(k + 2) * 256]; s3 += pe[k + 3] * w1[(size_t)(k + 3) * 256]; }
            __syncthreads(); red[F.wave * 64 + F.lane] = (s0 + s1) + (s2 + s3); __syncthreads();
            if (F.wave == 0) { float t = ((const float*)a.in[7])[((size_t)l * 2 + j) * 256 + cblk * 64 + F.lane];
#pragma unroll
                for (int w = 0; w < 8; ++w) t += red[w * 64 + F.lane];
                cb[j * 256 + cblk * 64 + F.lane] = t; }
            __syncthreads(); }
    }
}

__device__ __forceinline__ void conv_items(const Frame& F, const Args& a, int l, int first, int stride, int last = NB * (SEQ / 32)) {
    const bf16_t* z = (const bf16_t*)(a.ws + WS_Z); bf16_t* mix = (bf16_t*)(a.ws + WS_MIX);
    const float* cw = (const float*)a.in[10] + (size_t)l * 31 * 256; const float* cb = (const float*)a.in[11] + (size_t)l * 256;
    const float* lg = (const float*)a.in[12] + (size_t)l * 256; const float* lb = (const float*)a.in[13] + (size_t)l * 256;
    LAS float* U = (LAS float*)F.lds;
    LAS float* Y = (LAS float*)(F.lds + 65536);
    const int cp = F.tid & 127, tg = F.tid >> 7, c = 2 * cp;
    f32x2 w[31];
#pragma unroll
    for (int j = 0; j < 31; ++j) w[j] = *(const f32x2*)(cw + j * 256 + c);
    const f32x2 bias = *(const f32x2*)(cb + c);
    unsigned pva[16], pvg[16];
    auto fetch = [&](int it) { const int b = it >> 7, t0 = (it & 127) * 32;
#pragma unroll
        for (int q = 0; q < 16; ++q) { const int r = tg + 4 * q, t = t0 - 30 + r; pva[q] = 0u; pvg[q] = 0u;
            if (r < 62 && t >= 0) { const bf16_t* zr = z + ((size_t)b * SEQ + t) * INP + ZC; pva[q] = *(const unsigned*)(zr + c); pvg[q] = *(const unsigned*)(zr + 256 + c); } } };
    if (first < last) fetch(first);
    for (int it = first; it < last; it += stride) { const int b = it >> 7, t0 = (it & 127) * 32;
#pragma unroll
        for (int q = 0; q < 16; ++q) { const int r = tg + 4 * q, t = t0 - 30 + r;
            if (r < 62) { f32x2 u = (f32x2){0.f, 0.f}; if (t >= 0) u = (f32x2){bflo(pva[q]) * sigmoidf_(bflo(pvg[q])), bfhi(pva[q]) * sigmoidf_(bfhi(pvg[q]))};
                *(LAS f32x2*)(U + r * 256 + c) = u; } }
        if (it + stride < last) fetch(it + stride);
        __syncthreads();
        {   f32x2 acc[8];
#pragma unroll
            for (int i = 0; i < 8; ++i) acc[i] = bias;
#pragma unroll
            for (int k = 0; k < 38; ++k) { const f32x2 u = *(const LAS f32x2*)(U + (tg * 8 + k) * 256 + c);
#pragma unroll
                for (int i = 0; i < 8; ++i) { const int j = k - i; if (j >= 0 && j < 31) acc[i] += w[j] * u; } }
#pragma unroll
            for (int i = 0; i < 8; ++i) *(LAS f32x2*)(Y + (tg * 8 + i) * 256 + c) = acc[i];
        }
        __syncthreads();
        for (int i = 0; i < 4; ++i) { const int tl = F.wave * 4 + i; const f32x4 v = *(const LAS f32x4*)(Y + tl * 256 + F.lane * 4);
            const float mean = wave_sum((v[0] + v[1]) + (v[2] + v[3])) * (1.f / 256.f); const f32x4 dlt = v - mean;
            const float var = wave_sum((dlt[0] * dlt[0] + dlt[1] * dlt[1]) + (dlt[2] * dlt[2] + dlt[3] * dlt[3])) * (1.f / 256.f); const float rstd = 1.0f / sqrtf(var + LN_EPS);
            const f32x4 gg = *(const f32x4*)(lg + F.lane * 4), bb = *(const f32x4*)(lb + F.lane * 4);
            float o[4];
#pragma unroll
            for (int e = 0; e < 4; ++e) o[e] = siluf_(dlt[e] * rstd * gg[e] + bb[e]);
            u32x2 wv; wv.x = cvt_pk_bf16(o[0], o[1]); wv.y = cvt_pk_bf16(o[2], o[3]);
            *(u32x2*)(mix + ((size_t)b * SEQ + t0 + tl) * 1024 + 512 + F.lane * 4) = wv; }
        __syncthreads();
    }
}
__device__ __forceinline__ void cmp_stage2(const Frame& F, const Args& a, int l) {
    unsigned char* ws = a.ws; const float* cb = (const float*)(ws + SM_CMPB);
    LAS float* w2s = (LAS float*)F.lds;
    LAS float* hs = (LAS float*)(F.lds + 65536 + F.wave * 1024);
    const int gw = F.bid * 8 + F.wave, NGW = F.G * 8, lane = F.lane;
    for (int j = 0; j < 2; ++j) {
        const float* w2 = (const float*)a.in[8] + ((size_t)l * 2 + j) * 256 * 64; const float* b2 = (const float*)a.in[9] + ((size_t)l * 2 + j) * 64;
        __syncthreads();
        for (int i = F.tid; i < 256 * 64 / 4; i += 512) *(LAS f32x4*)(w2s + 4 * i) = *(const f32x4*)(w2 + 4 * i);
        __syncthreads();
        for (int it = gw; it < 32 * 256; it += NGW) { const int bh = it >> 8, n = it & 255;
            float outv = 0.f;
            if (n < NCMP) {
                const float* P = (const float*)(ws + WS_CMPP) + (size_t)j * 8192 * 512 + ((size_t)bh * 256 + n) * 512;
                const f32x4 p0 = *(const f32x4*)(P + lane * 4), p1 = *(const f32x4*)(P + 512 + 256 + lane * 4), bb = *(const f32x4*)(cb + j * 256 + lane * 4);
                f32x4 hv;
#pragma unroll
                for (int e = 0; e < 4; ++e) hv[e] = gelu_tanh(p0[e] + p1[e] + bb[e]);
                *(LAS f32x4*)(hs + lane * 4) = hv; LDS_WAIT(); asm volatile("" ::: "memory");
                float acc0 = b2[lane], acc1 = 0.f, acc2 = 0.f, acc3 = 0.f;
#pragma unroll 4
                for (int c = 0; c < 256; c += 4) { const f32x4 h4 = *(const LAS f32x4*)(hs + c);
                    acc0 += h4[0] * w2s[c * 64 + lane]; acc1 += h4[1] * w2s[(c + 1) * 64 + lane]; acc2 += h4[2] * w2s[(c + 2) * 64 + lane]; acc3 += h4[3] * w2s[(c + 3) * 64 + lane]; }
                outv = (acc0 + acc1) + (acc2 + acc3); LDS_WAIT(); asm volatile("" ::: "memory");
            }
            if (j == 0) ((bf16_t*)(ws + WS_KC))[((size_t)bh * 256 + n) * 64 + lane] = f2bf(outv);
            else ((bf16_t*)(ws + WS_VCT))[((size_t)bh * 4 + (n >> 6)) * 4096 + lane * 64 + nsa::vslot(n & 63)] = f2bf(outv);
        }
    }
    __syncthreads();
}
__device__ __forceinline__ void cmp_stage2_panel(const Frame& F, const Args& a, int l, int j, int bh) {
    constexpr int HP = 528;
    unsigned char* ws = a.ws; const float* cb = (const float*)(ws + SM_CMPB);
    LAS unsigned char* Hs = F.lds;
    LAS unsigned char* Ws = F.lds + 128 * HP;
    const int lane = F.lane, w = F.wave;
    const float* w2 = (const float*)a.in[8] + ((size_t)l * 2 + j) * 256 * 64; const float* b2 = (const float*)a.in[9] + ((size_t)l * 2 + j) * 64;
    const float* Pb = (const float*)(ws + WS_CMPP) + (size_t)j * 8192 * 512 + (size_t)bh * 256 * 512;
    __syncthreads();
    for (int i = F.tid; i < 256 * 64; i += 512) { const int c = i >> 6, d = i & 63; *(LAS bf16_t*)(Ws + d * HP + c * 2) = f2bf(w2[i]); }
    const f32x4 bb = *(const f32x4*)(cb + j * 256 + lane * 4);
    for (int half = 0; half < 2; ++half) {
        __syncthreads();
#pragma unroll 4
        for (int rr = 0; rr < 16; ++rr) { const int r = 16 * w + rr, n = half * 128 + r, n1 = n < 255 ? n + 1 : n;
            const f32x4 p0 = *(const f32x4*)(Pb + (size_t)n * 512 + lane * 4), p1 = *(const f32x4*)(Pb + (size_t)n1 * 512 + 256 + lane * 4);
            u32x2 hv; hv.x = cvt_pk_bf16(gelu_tanh(p0[0] + p1[0] + bb[0]), gelu_tanh(p0[1] + p1[1] + bb[1])); hv.y = cvt_pk_bf16(gelu_tanh(p0[2] + p1[2] + bb[2]), gelu_tanh(p0[3] + p1[3] + bb[3]));
            *(LAS u32x2*)(Hs + r * HP + lane * 8) = hv; }
        __syncthreads();
        f32x4 acc[4];
#pragma unroll
        for (int cbk = 0; cbk < 4; ++cbk) acc[cbk] = (f32x4){0.f, 0.f, 0.f, 0.f};
        const LAS unsigned char* ap = Hs + (16 * w + (lane & 15)) * HP + (lane >> 4) * 16;
        const LAS unsigned char* bp = Ws + (lane & 15) * HP + (lane >> 4) * 16;
#pragma unroll
        for (int ks = 0; ks < 8; ++ks) { const bf16x8 af = *(const LAS bf16x8*)(ap + ks * 64);
#pragma unroll
            for (int cbk = 0; cbk < 4; ++cbk) { const bf16x8 bf = *(const LAS bf16x8*)(bp + cbk * 16 * HP + ks * 64); acc[cbk] = __builtin_amdgcn_mfma_f32_16x16x32_bf16(af, bf, acc[cbk], 0, 0, 0); } }
#pragma unroll
        for (int cbk = 0; cbk < 4; ++cbk) { const int d = 16 * cbk + (lane & 15); const float bv = b2[d];
#pragma unroll
            for (int e = 0; e < 4; ++e) { const int n = half * 128 + 16 * w + 4 * (lane >> 4) + e; const float outv = n < NCMP ? acc[cbk][e] + bv : 0.f;
                if (j == 0) ((bf16_t*)(ws + WS_KC))[((size_t)bh * 256 + n) * 64 + d] = f2bf(outv);
                else ((bf16_t*)(ws + WS_VCT))[((size_t)bh * 4 + (n >> 6)) * 4096 + d * 64 + nsa::vslot(n & 63)] = f2bf(outv); } }
    }
    __syncthreads();
}
__device__ __forceinline__ void s5_carry_panel(const Frame& F, const Args& a, int l, int g, int pm) {
    unsigned char* ws = a.ws; const f32x2* apow = (const f32x2*)(ws + SM_APOW) + (size_t)l * 16 * 64 * 34;
    const float* S = (const float*)(ws + WS_S5S); bf16_t* ap = (bf16_t*)(ws + WS_S5A);
    if (F.tid < 128) { const int n = F.tid & 63, b = 2 * pm + (F.tid >> 6);
        const f32x2 A = apow[((size_t)g * 64 + n) * 34 + S5LC]; float hr = 0.f, hi = 0.f;
        const float* sp = S + ((size_t)g * 2048 + b * 128) * 256 + n; bf16_t* dp = ap + ((size_t)g * 2048 + b * 128) * S5K + 512 + n;
        for (int c0 = 0; c0 < S5NCH; c0 += 8) { float sr[8], si[8];
#pragma unroll
            for (int k = 0; k < 8; ++k) { sr[k] = sp[(size_t)(c0 + k) * 256]; si[k] = sp[(size_t)(c0 + k) * 256 + 64]; }
#pragma unroll
            for (int k = 0; k < 8; ++k) { dp[(size_t)(c0 + k) * S5K] = f2bf(hr); dp[(size_t)(c0 + k) * S5K + 64] = f2bf(hi);
                const float nr = A.x * hr - A.y * hi + sr[k], ni = A.x * hi + A.y * hr + si[k]; hr = nr; hi = ni; } }
    }
}
__device__ __forceinline__ void s5_carry(const Frame& F, const Args& a, int l) {
    unsigned char* ws = a.ws; const f32x2* apow = (const f32x2*)(ws + SM_APOW) + (size_t)l * 16 * 64 * 34;
    const float* S = (const float*)(ws + WS_S5S); bf16_t* ap = (bf16_t*)(ws + WS_S5A);
    const int gt = F.bid * 512 + F.tid, NT = F.G * 512;
    for (int i = gt; i < 16 * NB * 64; i += NT) { const int n = i & 63, b = (i >> 6) & 15, g = i >> 10;
        const f32x2 A = apow[((size_t)g * 64 + n) * 34 + S5LC]; float hr = 0.f, hi = 0.f;
        const float* sp = S + ((size_t)g * 2048 + b * 128) * 256 + n; bf16_t* dp = ap + ((size_t)g * 2048 + b * 128) * S5K + 512 + n;
        for (int c0 = 0; c0 < S5NCH; c0 += 8) { float sr[8], si[8];
#pragma unroll
            for (int k = 0; k < 8; ++k) { sr[k] = sp[(size_t)(c0 + k) * 256]; si[k] = sp[(size_t)(c0 + k) * 256 + 64]; }
#pragma unroll
            for (int k = 0; k < 8; ++k) { dp[(size_t)(c0 + k) * S5K] = f2bf(hr); dp[(size_t)(c0 + k) * S5K + 64] = f2bf(hi);
                const float nr = A.x * hr - A.y * hi + sr[k], ni = A.x * hi + A.y * hr + si[k]; hr = nr; hi = ni; } }
    }
}
template <int MODE, bool ROUTE, bool FINAL>
__device__ __forceinline__ void ln_panel(const Frame& F, const Args& a, int pm, const float* gain, const float* beta, const float* router, size_t h_off = WS_HBUF) {
    unsigned char* ws = a.ws; float* xout = a.out; bf16_t* xb = (bf16_t*)(ws + WS_XB);
    const bf16_t* hb = (const bf16_t*)(ws + (MODE == 0 ? h_off : WS_YB)); const f32x2* tokw = (const f32x2*)(ws + SM_TOKW);
    LAS int* cnt = (LAS int*)F.lds;
    const int lane = F.lane;
    f32x4 gv[4], bv[4];
#pragma unroll
    for (int j = 0; j < 4; ++j) { gv[j] = *(const f32x4*)(gain + 4 * lane + 256 * j); bv[j] = *(const f32x4*)(beta + 4 * lane + 256 * j); }
    if (ROUTE) { if (F.tid < 8) cnt[F.tid] = 0; __syncthreads(); }
    u32x2 nx[4], nh0[4], nh1[4]; f32x2 nw = (f32x2){0.f, 0.f};
    { const size_t row = (size_t)pm * 256 + F.wave * 32; if (MODE == 1) nw = tokw[row];
#pragma unroll
      for (int j = 0; j < 4; ++j) { nx[j] = *(const u32x2*)(xb + row * D + 4 * lane + 256 * j);
          if (MODE == 0) { nh0[j] = *(const u32x2*)(hb + row * D + 4 * lane + 256 * j); nh1[j] = nh0[j]; } else { nh0[j] = *(const u32x2*)(hb + (2 * row) * D + 4 * lane + 256 * j); nh1[j] = *(const u32x2*)(hb + (2 * row + 1) * D + 4 * lane + 256 * j); } } }
    for (int i = 0; i < 32; ++i) { const size_t row = (size_t)pm * 256 + F.wave * 32 + i;
        f32x4 v[4]; float s = 0.f;
        u32x2 cx[4], ch0[4], ch1[4]; const f32x2 w01 = nw;
#pragma unroll
        for (int j = 0; j < 4; ++j) { cx[j] = nx[j]; ch0[j] = nh0[j]; ch1[j] = nh1[j]; }
        if (i < 31) { const size_t rn = row + 1; if (MODE == 1) nw = tokw[rn];
#pragma unroll
            for (int j = 0; j < 4; ++j) { nx[j] = *(const u32x2*)(xb + rn * D + 4 * lane + 256 * j);
                if (MODE == 0) { nh0[j] = *(const u32x2*)(hb + rn * D + 4 * lane + 256 * j); nh1[j] = nh0[j]; } else { nh0[j] = *(const u32x2*)(hb + (2 * rn) * D + 4 * lane + 256 * j); nh1[j] = *(const u32x2*)(hb + (2 * rn + 1) * D + 4 * lane + 256 * j); } } }
#pragma unroll
        for (int j = 0; j < 4; ++j) { const u32x2 xq = cx[j]; const f32x4 xv = (f32x4){bflo(xq.x), bfhi(xq.x), bflo(xq.y), bfhi(xq.y)}; f32x4 hv;
            if (MODE == 0) { const u32x2 q = ch0[j]; hv = (f32x4){bflo(q.x), bfhi(q.x), bflo(q.y), bfhi(q.y)}; }
            else { const u32x2 q0 = ch0[j], q1 = ch1[j];
                hv = (f32x4){w01.x * bflo(q0.x) + w01.y * bflo(q1.x), w01.x * bfhi(q0.x) + w01.y * bfhi(q1.x), w01.x * bflo(q0.y) + w01.y * bflo(q1.y), w01.x * bfhi(q0.y) + w01.y * bfhi(q1.y)}; }
            v[j] = xv * ALPHA + hv; s += (v[j][0] + v[j][1]) + (v[j][2] + v[j][3]); }
        const float mean = wave_sum(s) * (1.f / D); float s2 = 0.f;
#pragma unroll
        for (int j = 0; j < 4; ++j) { v[j] = v[j] - mean; s2 += (v[j][0] * v[j][0] + v[j][1] * v[j][1]) + (v[j][2] * v[j][2] + v[j][3] * v[j][3]); }
        const float rstd = 1.0f / sqrtf(wave_sum(s2) * (1.f / D) + LN_EPS);
#pragma unroll
        for (int j = 0; j < 4; ++j) { v[j] = v[j] * rstd * gv[j] + bv[j];
            if (FINAL) *(f32x4*)(xout + row * D + 4 * lane + 256 * j) = v[j];
            u32x2 w; w.x = cvt_pk_bf16(v[j][0], v[j][1]); w.y = cvt_pk_bf16(v[j][2], v[j][3]); *(u32x2*)(xb + row * D + 4 * lane + 256 * j) = w; }
        if (ROUTE) {
            float lg[8];
#pragma unroll
            for (int e = 0; e < 8; ++e) lg[e] = 0.f;
#pragma unroll
            for (int j = 0; j < 4; ++j)
#pragma unroll
                for (int k = 0; k < 4; ++k) { const float* rr = router + (size_t)(4 * lane + 256 * j + k) * 8; const f32x4 r0 = *(const f32x4*)rr, r1 = *(const f32x4*)(rr + 4); const float xv = v[j][k];
                    lg[0] += xv * r0[0]; lg[1] += xv * r0[1]; lg[2] += xv * r0[2]; lg[3] += xv * r0[3]; lg[4] += xv * r1[0]; lg[5] += xv * r1[1]; lg[6] += xv * r1[2]; lg[7] += xv * r1[3]; }
            {
                const bool h5 = (lane & 32) != 0, h4 = (lane & 16) != 0, h3 = (lane & 8) != 0;
                float r4[4], r2[2], r1;
#pragma unroll
                for (int i = 0; i < 4; ++i) { const float send = h5 ? lg[i] : lg[4 + i], mine = h5 ? lg[4 + i] : lg[i]; r4[i] = mine + xshfl<32>(send); }
#pragma unroll
                for (int i = 0; i < 2; ++i) { const float send = h4 ? r4[i] : r4[2 + i], mine = h4 ? r4[2 + i] : r4[i]; r2[i] = mine + xshfl<16>(send); }
                { const float send = h3 ? r2[0] : r2[1], mine = h3 ? r2[1] : r2[0]; r1 = mine + xshfl<8>(send); }
                r1 += xshfl<4>(r1); r1 += xshfl<2>(r1); r1 += xshfl<1>(r1);
#pragma unroll
                for (int e = 0; e < 8; ++e) lg[e] = __builtin_bit_cast(float, __builtin_amdgcn_readlane(__builtin_bit_cast(int, r1), 8 * e));
            }
            int e0 = 0; float m0 = lg[0];
#pragma unroll
            for (int e = 1; e < 8; ++e) if (lg[e] > m0) { m0 = lg[e]; e0 = e; }
            int e1 = -1; float m1 = -3.0e38f;
#pragma unroll
            for (int e = 0; e < 8; ++e) if (e != e0 && lg[e] > m1) { m1 = lg[e]; e1 = e; }
            const float w0 = 1.0f / (1.0f + __expf(m1 - m0));
            if (lane == 0) { ((int*)(ws + SM_TOKE))[row] = e0 | (e1 << 8); ((f32x2*)(ws + SM_TOKW))[row] = (f32x2){w0, 1.0f - w0}; __hip_atomic_fetch_add(&cnt[e0], 1, __ATOMIC_RELAXED, __HIP_MEMORY_SCOPE_WORKGROUP); __hip_atomic_fetch_add(&cnt[e1], 1, __ATOMIC_RELAXED, __HIP_MEMORY_SCOPE_WORKGROUP); }
        }
    }
    if (ROUTE) { __syncthreads(); if (F.tid < 8) ((int*)(ws + SM_PCNT))[pm * 8 + F.tid] = cnt[F.tid]; __syncthreads(); }
}
__device__ __forceinline__ void moe_gather(const Frame& F, const Args& a) {
    unsigned char* ws = a.ws; const int* pcnt = (const int*)(ws + SM_PCNT); const int* toke = (const int*)(ws + SM_TOKE);
    int* rowtok = (int*)(ws + SM_ROWTOK); int* tileexp = (int*)(ws + SM_TILEEXP);
    const bf16_t* xb = (const bf16_t*)(ws + WS_XB); bf16_t* xs = (bf16_t*)(ws + WS_XS);
    LAS int* sm = (LAS int*)F.lds;
    for (int pm = F.bid; pm < T / 256; pm += F.G) {
        for (int q = F.tid; q < (T / 256) * 8; q += 512) sm[1024 + q] = pcnt[q];
        if (F.tid >= 32 && F.tid < 288) sm[F.tid] = toke[pm * 256 + F.tid - 32];
        __syncthreads();
        if (F.tid < 8) { int tot = 0, before = 0; for (int q = 0; q < T / 256; ++q) { const int c = sm[1024 + q * 8 + F.tid]; tot += c; if (q < pm) before += c; } sm[F.tid] = tot; sm[16 + F.tid] = before; }
        __syncthreads();
        if (F.tid == 0) { int st = 0; for (int e = 0; e < 8; ++e) { sm[8 + e] = st * 256; st += (sm[e] + 255) >> 8; } sm[24] = st; }
        __syncthreads();
        {
            const int i = F.tid >> 1, k = F.tid & 1; const int ee = sm[32 + i]; const int e = k ? (ee >> 8) : (ee & 255);
            int cntb = 0; for (int q = 0; q < i; ++q) { const int o = sm[32 + q]; cntb += ((o & 255) == e) + ((o >> 8) == e); }
            const int dest = sm[8 + e] + sm[16 + e] + cntb; sm[512 + F.tid] = dest; rowtok[dest] = 2 * (pm * 256 + i) + k;
        }
        __syncthreads();
        for (int r0 = F.wave * 64; r0 < F.wave * 64 + 64; r0 += 8) {
            u32x4 va[8], vb[8];
#pragma unroll
            for (int q = 0; q < 8; ++q) { const size_t tok = (size_t)pm * 256 + ((r0 + q) >> 1); const u32x4* s = (const u32x4*)(xb + tok * D); va[q] = s[F.lane]; vb[q] = s[64 + F.lane]; }
#pragma unroll
            for (int q = 0; q < 8; ++q) { const int dest = sm[512 + r0 + q]; u32x4* d = (u32x4*)(xs + (size_t)dest * D); d[F.lane] = va[q]; d[64 + F.lane] = vb[q]; } }
        if (pm == 0) {
            for (int e = 0; e < 8; ++e) { const int r0 = sm[8 + e] + sm[e], r1 = sm[8 + e] + (((sm[e] + 255) >> 8) << 8); for (int r = r0 + F.tid; r < r1; r += 512) rowtok[r] = -1;
                const int t0 = sm[8 + e] >> 8, t1 = r1 >> 8; for (int t = t0 + F.tid; t < t1; t += 512) tileexp[t] = e; }
            if (F.tid == 0) tileexp[1023] = sm[24];
        }
        __syncthreads();
    }
}

__device__ __forceinline__ void moe_tail_finalize(const Frame& F, const Args& a) {
    const int* tileexp = (const int*)(a.ws + SM_TILEEXP); int nt = tileexp[1023] - (MOE_NCHUNK - 1) * MOE_CHUNK_TILES; nt = nt < 0 ? 0 : (nt > 8 ? 8 : nt);
    const float* YT = (const float*)(a.ws + WS_XS); const int* row_tok = (const int*)(a.ws + SM_ROWTOK) + (MOE_NCHUNK - 1) * MOE_CHUNK_TILES * 256; bf16_t* Y = (bf16_t*)(a.ws + WS_YB);
    const int c8 = (F.tid & 127) * 8;
    for (int r = F.bid * 4 + (F.tid >> 7); r < nt * 256; r += F.G * 4) { const int dst = row_tok[r]; if (dst < 0) continue;
        f32x4 s0 = (f32x4){0.f, 0.f, 0.f, 0.f}, s1 = s0;
#pragma unroll
        for (int ks = 0; ks < 7; ++ks) { const float* p = YT + ((size_t)ks * 2048 + r) * D + c8; s0 += *(const f32x4*)p; s1 += *(const f32x4*)(p + 4); }
        u32x4 w; w.x = cvt_pk_bf16(s0[0], s0[1]); w.y = cvt_pk_bf16(s0[2], s0[3]); w.z = cvt_pk_bf16(s1[0], s1[1]); w.w = cvt_pk_bf16(s1[2], s1[3]);
        *(u32x4*)(Y + (size_t)dst * D + c8) = w; }
}
struct MoeUpOrder { int ntile, G, c, chunk; const int* tileexp;
    __device__ __forceinline__ bool next(int i, pg8::Unit& u) const { if (!pg8::static_tile(i, G, c, ntile, 2 * DFE / 256, u.pm, u.pn)) return false;
        const int tile = chunk * MOE_CHUNK_TILES + u.pm, e = tileexp[tile]; u.aux = tile; u.offA = (long long)tile * 256 * D * 2; u.offB = ((long long)e * 2 * DFE + (long long)u.pn * 256) * D * 2; return true; } };
struct MoeDnOrder { int ntile, G, c, chunk; const int* tileexp;
    __device__ __forceinline__ bool next(int i, pg8::Unit& u) const { if (!pg8::static_tile(i, G, c, ntile, D / 256, u.pm, u.pn)) return false;
        const int tile = chunk * MOE_CHUNK_TILES + u.pm, e = tileexp[tile]; u.aux = tile; u.offA = (long long)u.pm * 256 * DFE * 2; u.offB = ((long long)e * D + (long long)u.pn * 256) * DFE * 2; return true; } };

struct MoeDnTailOrder { int ntile, G, c; const int* tileexp;
    __device__ __forceinline__ bool next(int i, pg8::Unit& u) const { const long L = (long)i * G + c; if (L >= (long)ntile * 28) return false;
        const int ks = (int)(L % 7), rest = (int)(L / 7); u.pn = rest & 3; u.pm = rest >> 2; u.aux = ks;
        const int tile = (MOE_NCHUNK - 1) * MOE_CHUNK_TILES + u.pm, e = tileexp[tile];
        u.offA = (long long)u.pm * 256 * DFE * 2 + (long long)ks * 512 * 2; u.offB = ((long long)e * D + (long long)u.pn * 256) * DFE * 2 + (long long)ks * 512 * 2; return true; } };

enum { PH_PREP = 0, PH_WIN, PH_POST, PH_MIX1, PH_MIX2, PH_MIX3, PH_MIX4, PH_WOUT, PH_LN1, PH_FUP, PH_FDN, PH_MGATH = 9, PH_MUP0 = 10, PH_LN2 = 21, PH_PGATE, PH_PPROJ, PH_LN3, PH_PER_LAYER = 32 };
constexpr int GP_END = 2 + 32 * DEPTH;

__global__ void __launch_bounds__(512, 2) mk_fwd(Args a0) {
    extern __shared__ __attribute__((aligned(16))) unsigned char lds_raw[];
    LAS unsigned char* const lds = (LAS unsigned char*)lds_raw;
    for (int u = threadIdx.x; u < (LDS_BYTES - LDSCTL_OFF) / 4; u += 512) ((LAS unsigned*)(lds + LDSCTL_OFF))[u] = 0u;
    __syncthreads();
    const int gp_lo = a0.gp_lo, gp_hi = a0.gp_hi; const int F0bid = blockIdx.x, F0G = gridDim.x; const int wave0 = __builtin_amdgcn_readfirstlane(threadIdx.x >> 6);
    XcdBarrier bar; bar.bar = (unsigned*)(a0.ws + WS_CTL) + CW_BAR; bar.x = 0; bar.st = nullptr;
    if (a0.use_bar) bar = xcd_barrier_post((unsigned*)(a0.ws + WS_CTL) + CW_BAR, (volatile LAS unsigned*)(lds + LDSCTL_OFF + 32));
#if MK_PROBE
#define PRW ((volatile LAS unsigned*)(lds + LDSCTL_OFF + 128))
    if (threadIdx.x == 0) { const unsigned long long t_ = __builtin_amdgcn_s_memrealtime(); PRW[0] = (unsigned)t_; PRW[1] = (unsigned)(t_ >> 32); PRW[2] = 0u; PRW[3] = 0u; PRW[4] = (unsigned)t_; PRW[5] = (unsigned)(t_ >> 32); }
#define STAMP(cls) do { if (wave0 == 0 && lane_id_fresh() == 0) { const unsigned long long t_ = __builtin_amdgcn_s_memrealtime(); const unsigned long long p_ = ((unsigned long long)PRW[1] << 32) | PRW[0]; const unsigned d_ = (unsigned)(t_ - p_); \
        PRW[0] = (unsigned)t_; PRW[1] = (unsigned)(t_ >> 32); if ((PROBE_A >> (cls)) & 1) PRW[2] += d_; if ((PROBE_B >> (cls)) & 1) PRW[3] += d_; } } while (0)
#else
#define STAMP(cls) do {} while (0)
#endif
#define RUN(gp) (gp_lo <= (gp) && (gp) < gp_hi)
#define SEAM(gp) do { if (gp_lo <= (gp) && (gp) + 1 < gp_hi) xcd_barrier(bar, wave0); } while (0)
#define PH_BEGIN Args a; load_args(a); const Frame F = make_frame(lds, wave0); unsigned char* const ws = a.ws; int l = lx; asm volatile("" : "+s"(l)); (void)l; (void)ws; \
    bf16_t* const xb = (bf16_t*)(ws + WS_XB); bf16_t* const z = (bf16_t*)(ws + WS_Z); bf16_t* const mix = (bf16_t*)(ws + WS_MIX); bf16_t* const hbuf = (bf16_t*)(ws + WS_HBUF); const long long S1K = 256ll * 1024 * 2; \
    (void)xb; (void)z; (void)mix; (void)hbuf; (void)S1K;
#define AP_DEF const nsa::Lane L{F.lane, F.lane & 31, F.lane >> 5, F.wave, F.tid}; \
    const nsa::AttnPtrs AP{(const bf16_t*)(ws + WS_Q), z, (const bf16_t*)(ws + WS_KC), (const bf16_t*)(ws + WS_VCT), (const bf16_t*)(ws + WS_KSEL), (const bf16_t*)(ws + WS_VSEL), \
                           (const bf16_t*)(ws + WS_KWIN), (const bf16_t*)(ws + WS_VWIN), (unsigned long long*)(ws + WS_SELM), mix};
    { const int lx = 0;
    if (RUN(0)) { PH_BEGIN phase_init0(F, a); }
    SEAM(0); STAMP(0);
    if (RUN(1)) { PH_BEGIN phase_init1(F, a); }
    SEAM(1); STAMP(0);
    }
    for (int lx = 0; lx < DEPTH; ++lx) {
        const int base = 2 + PH_PER_LAYER * lx; const bool moe = (lx & 1) != 0;
        if (RUN(base + PH_PREP)) { PH_BEGIN phase_prep(F, a, l); }
        SEAM(base + PH_PREP); STAMP(1);
        if (RUN(base + PH_WIN)) { PH_BEGIN
            pg8::Gemm g{xb, (const bf16_t*)(ws + W_IN), D, D, D}; pg8::PlainOrder S{T / 256, INP / 256, F.G, F.bid, S1K, S1K};
            epi::EpiWin E{z, (bf16_t*)(ws + WS_Q), (bf16_t*)(ws + WS_KCMP), (bf16_t*)(ws + WS_S5A), (const f32x2*)(ws + WS_ROPE)};
            pg8::gemm_phase(F.lds, g, S, E, F.tid);
        }
        SEAM(base + PH_WIN); STAMP(2);
        if (RUN(base + PH_MIX1)) {
            for (int r = F0bid; r < 128; r += F0G) {
                {   PH_BEGIN const int g_ = r >> 3, pm_ = r & 7;
                    pg8::Gemm g{(const bf16_t*)(ws + WS_S5A), (const bf16_t*)(ws + W_S5S), 512, S5K, 512};
                    pg8::ListOrder S{1, pm_, g_, (long long)g_ * 2048 * S5K * 2 + (long long)pm_ * 256 * S5K * 2, (long long)g_ * 256 * 512 * 2, 0}; epi::F32Grouped E{(float*)(ws + WS_S5S), 256, (size_t)2048 * 256};
                    pg8::gemm_phase(F.lds, g, S, E, F.tid); }
                __syncthreads();
                {   PH_BEGIN int nr = MK_REP_CARRY; asm volatile("" : "+s"(nr)); for (int q = 0; q < nr; ++q) s5_carry_panel(F, a, l, r >> 3, r & 7); }
                asm volatile("s_waitcnt vmcnt(0)" ::: "memory"); __syncthreads();
                {   PH_BEGIN const int g_ = r >> 3, pm_ = r & 7;
                    pg8::Gemm g{(const bf16_t*)(ws + WS_S5A), (const bf16_t*)(ws + W_S5B), S5K, S5K, S5K};
                    pg8::ListOrder S{2, pm_, g_, (long long)g_ * 2048 * S5K * 2 + (long long)pm_ * 256 * S5K * 2, (long long)g_ * 512 * S5K * 2, 256ll * S5K * 2}; epi::S5Out E{(bf16_t*)(ws + WS_ZS5), z, (const float*)a.in[21] + (size_t)l * 256};
                    pg8::gemm_phase(F.lds, g, S, E, F.tid); }
            }
            for (int r = F0bid - 128; r < 64; r += F0G) { if (r < 0) continue;
                {   PH_BEGIN const int j_ = r >> 5, bh_ = r & 31;
                    pg8::Gemm g{(const bf16_t*)(ws + WS_KCMP), (const bf16_t*)(ws + W_CMP), 1024, 1024, 1024};
                    pg8::ListOrder S{2, bh_, j_, (long long)j_ * (long long)(WS_VCMP - WS_KCMP) + (long long)bh_ * S1K, (long long)j_ * 512 * 1024 * 2, S1K}; epi::F32Grouped E{(float*)(ws + WS_CMPP), 512, (size_t)8192 * 512};
                    pg8::gemm_phase(F.lds, g, S, E, F.tid); }
                asm volatile("s_waitcnt vmcnt(0)" ::: "memory"); __syncthreads();
                {   PH_BEGIN int nr = MK_REP_ST2; asm volatile("" : "+s"(nr)); for (int q = 0; q < nr; ++q) cmp_stage2_panel(F, a, l, r >> 5, r & 31); }
            }
            {   PH_BEGIN
                if (F.G == 256) { const int c = F.bid; const int beg = c < 128 ? c * 5 : (c < 192 ? 640 + (c - 128) * 6 : 1024 + (c - 192) * 16), cnt = c < 128 ? 5 : (c < 192 ? 6 : 16); conv_items(F, a, l, beg, 1, beg + cnt); }
                else conv_items(F, a, l, F.bid, F.G); }
        }
        SEAM(base + PH_MIX1); STAMP(4);
        if (RUN(base + PH_MIX3)) {
            {   PH_BEGIN
                pg8::Gemm g{(const bf16_t*)(ws + WS_ZS5), (const bf16_t*)(ws + W_GLU), 256, 256, 256};
                pg8::PlainOrder S{T / 256, 1, F.G, F.bid, 256ll * 256 * 2, 256ll * 256 * 2}; epi::S5Glu E{mix, (const bf16_t*)(ws + WS_ZS5), (const float*)a.in[23] + (size_t)l * 256};
                pg8::gemm_phase(F.lds, g, S, E, F.tid);
            }
            {   PH_BEGIN AP_DEF
                for (int p = F.bid; p < 32 * 16; p += F.G) { const int bh = p >> 4, s = p & 15;
                    for (int half = 0; half < 2; ++half) { const int qb2 = half ? 31 - s : s;
                        nsa::cmp_unit<true>(bh, 2 * qb2, AP, F.lds, L); nsa::cmp_topk(bh, 2 * qb2, AP, F.lds, L);
                        nsa::cmp_unit<false>(bh, 2 * qb2 + 1, AP, F.lds, L); nsa::cmp_topk(bh, 2 * qb2 + 1, AP, F.lds, L); } } }
            asm volatile("s_waitcnt vmcnt(0)" ::: "memory"); __syncthreads();
            {   PH_BEGIN AP_DEF
                for (int p = F.bid; p < 32 * 16; p += F.G) { const int bh = p >> 4, s = p & 15; nsa::sw_unit2(bh, s, AP, F.lds, L); nsa::sw_unit2(bh, 31 - s, AP, F.lds, L); } }
        }
        SEAM(base + PH_MIX3); STAMP(6);

        if (RUN(base + PH_WOUT)) {
            {   PH_BEGIN
                pg8::Gemm g{mix, (const bf16_t*)(ws + W_OUT), D, D, D}; pg8::PlainOrder S{T / 256, D / 256, F.G, F.bid, S1K, S1K}; epi::Bf16Sc1 E{hbuf, D, (unsigned)((size_t)T * D * 2)};
                pg8::gemm_phase(F.lds, g, S, E, F.tid);
            }
            {   PH_BEGIN pg8::PlainOrder S{T / 256, D / 256, F.G, F.bid, S1K, S1K}; panels_publish_wait(F, (unsigned*)(ws + WS_CTL), 2 * l + 0, S, (unsigned)(D / 256)); }
            {   PH_BEGIN
                const float* gg = (const float*)a.in[34] + ((size_t)l * 3 + 0) * D; const float* bb = (const float*)a.in[35] + ((size_t)l * 3 + 0) * D;
                for (int pm = F.bid; pm < T / 256; pm += F.G) { if (l & 1) ln_panel<0, true, false>(F, a, pm, gg, bb, (const float*)a.in[27] + (size_t)(l >> 1) * D * NEXP); else ln_panel<0, false, false>(F, a, pm, gg, bb, nullptr); }
            }
        }
        SEAM(base + PH_WOUT); STAMP(8);
        if (!moe) {
            if (RUN(base + PH_FUP)) { PH_BEGIN
                pg8::Gemm g{xb, (const bf16_t*)(ws + W_UP), D, D, D}; pg8::PlainOrder S{T / 256, 2 * DFF / 256, F.G, F.bid, S1K, S1K}; epi::SwiGlu E{(bf16_t*)(ws + WS_FFH), DFF};
                pg8::gemm_phase(F.lds, g, S, E, F.tid);
            }
            SEAM(base + PH_FUP); STAMP(9);
            if (RUN(base + PH_FDN)) {
                {   PH_BEGIN
                    pg8::Gemm g{(const bf16_t*)(ws + WS_FFH), (const bf16_t*)(ws + W_DN), DFF, DFF, DFF}; pg8::PlainOrder S{T / 256, D / 256, F.G, F.bid, 256ll * DFF * 2, 256ll * DFF * 2}; epi::Bf16Sc1 E{hbuf, D, (unsigned)((size_t)T * D * 2)};
                    pg8::gemm_phase(F.lds, g, S, E, F.tid);
                }
                {   PH_BEGIN pg8::PlainOrder S{T / 256, D / 256, F.G, F.bid, 256ll * DFF * 2, 256ll * DFF * 2}; panels_publish_wait(F, (unsigned*)(ws + WS_CTL), 2 * l + 1, S, (unsigned)(D / 256)); }
                {   PH_BEGIN
                    const float* gg = (const float*)a.in[34] + ((size_t)l * 3 + 1) * D; const float* bb = (const float*)a.in[35] + ((size_t)l * 3 + 1) * D;
                    for (int pm = F.bid; pm < T / 256; pm += F.G) ln_panel<0, false, false>(F, a, pm, gg, bb, nullptr);
                }
            }
            asm volatile("s_waitcnt vmcnt(0)" ::: "memory"); __syncthreads(); STAMP(10);
        } else {
            if (RUN(base + PH_MGATH)) { PH_BEGIN moe_gather(F, a); }
            SEAM(base + PH_MGATH); STAMP(11);
            for (int cx = 0; cx < MOE_NCHUNK; ++cx) {
                if (RUN(base + PH_MUP0 + 2 * cx)) { PH_BEGIN int c = cx; asm volatile("" : "+s"(c)); const int* tileexp = (const int*)(ws + SM_TILEEXP);
                    int nt = tileexp[1023] - c * MOE_CHUNK_TILES; nt = nt < 0 ? 0 : (nt > MOE_CHUNK_TILES ? MOE_CHUNK_TILES : nt);
                    pg8::Gemm g{(const bf16_t*)(ws + WS_XS), (const bf16_t*)(ws + W_UP), D, D, D}; MoeUpOrder S{nt, F.G, F.bid, c, tileexp}; epi::SwiGlu E{(bf16_t*)(ws + WS_MH), DFE};
                    pg8::gemm_phase(F.lds, g, S, E, F.tid);
                }
                SEAM(base + PH_MUP0 + 2 * cx); STAMP(12);
                if (RUN(base + PH_MUP0 + 2 * cx + 1)) { PH_BEGIN int c = cx; asm volatile("" : "+s"(c)); const int* tileexp = (const int*)(ws + SM_TILEEXP);
                    int nt = tileexp[1023] - c * MOE_CHUNK_TILES; nt = nt < 0 ? 0 : (nt > MOE_CHUNK_TILES ? MOE_CHUNK_TILES : nt);
                    if (cx < MOE_NCHUNK - MK_TAILSPLIT) {
                        pg8::Gemm g{(const bf16_t*)(ws + WS_MH), (const bf16_t*)(ws + W_DN), DFE, DFE, DFE}; MoeDnOrder S{nt, F.G, F.bid, c, tileexp}; epi::MoeDown E{(bf16_t*)(ws + WS_YB), (const int*)(ws + SM_ROWTOK)};
                        pg8::gemm_phase(F.lds, g, S, E, F.tid);
                    } else {
                        nt = nt > 8 ? 8 : nt;
                        pg8::Gemm g{(const bf16_t*)(ws + WS_MH), (const bf16_t*)(ws + W_DN), 512, DFE, DFE}; MoeDnTailOrder S{nt, F.G, F.bid, tileexp}; epi::F32Grouped E{(float*)(ws + WS_XS), D, (size_t)2048 * D};
                        pg8::gemm_phase(F.lds, g, S, E, F.tid);
                    }
                }
                SEAM(base + PH_MUP0 + 2 * cx + 1); STAMP(13);
            }
#if MK_TAILSPLIT
            if (RUN(base + PH_MUP0 + 2 * MOE_NCHUNK)) { PH_BEGIN moe_tail_finalize(F, a); }
            SEAM(base + PH_MUP0 + 2 * MOE_NCHUNK); STAMP(13);
#endif
        }
        if (RUN(base + PH_PGATE)) {
            if (moe) {
                {   PH_BEGIN
                    const float* gg = (const float*)a.in[34] + ((size_t)l * 3 + 1) * D; const float* bb = (const float*)a.in[35] + ((size_t)l * 3 + 1) * D;
                    for (int pm = F.bid; pm < T / 256; pm += F.G) ln_panel<1, false, false>(F, a, pm, gg, bb, nullptr);
                }
                asm volatile("s_waitcnt vmcnt(0)" ::: "memory"); __syncthreads();
            }
            {   PH_BEGIN
                pg8::Gemm g{xb, (const bf16_t*)(ws + W_GATE), D, D, D}; pg8::PanelOrder S{T / 256, D / 256, F.G, F.bid, S1K, S1K}; epi::SigmoidBias E{(l & 1) ? (bf16_t*)(ws + WS_PLEG) : mix, D, (const float*)a.in[32] + (size_t)l * D};
                pg8::gemm_phase(F.lds, g, S, E, F.tid);
            }
            __syncthreads();
            {   PH_BEGIN
                pg8::Gemm g{(const bf16_t*)(ws + WS_PB), (const bf16_t*)(ws + W_PROJ), PLE, PLE, PLE}; pg8::PanelOrder S{T / 256, D / 256, F.G, F.bid, 256ll * PLE * 2, 256ll * PLE * 2}; epi::MulBf16 E{(l & 1) ? (bf16_t*)(ws + WS_PLEH) : hbuf, (l & 1) ? (bf16_t*)(ws + WS_PLEG) : mix, D};
                pg8::gemm_phase(F.lds, g, S, E, F.tid);
            }
            __syncthreads();
            {   PH_BEGIN
                const float* gg = (const float*)a.in[34] + ((size_t)l * 3 + 2) * D; const float* bb = (const float*)a.in[35] + ((size_t)l * 3 + 2) * D;
                const size_t hoff = (l & 1) ? WS_PLEH : WS_HBUF;
                for (int pm = F.bid; pm < T / 256; pm += F.G) { if (l == DEPTH - 1) ln_panel<0, false, true>(F, a, pm, gg, bb, nullptr, hoff); else ln_panel<0, false, false>(F, a, pm, gg, bb, nullptr, hoff); }
            }
        }
        SEAM(base + PH_PGATE); STAMP(15);
    }
#if MK_PROBE
    if (blockIdx.x == 0) {
        __syncthreads(); asm volatile("s_waitcnt vmcnt(0)" ::: "memory");
        const unsigned long long t1 = ((unsigned long long)PRW[1] << 32) | PRW[0], t0 = ((unsigned long long)PRW[5] << 32) | PRW[4];
        const float tot = (float)(unsigned)(t1 - t0), fa = (float)PRW[2] / tot, fb = (float)PRW[3] / tot;
        Args ae; load_args(ae);
        const int tidp = wave0 * 64 + lane_id_fresh();
        if (tidp == 0) ae.out[0] += 1.0f + 8.0f * fa;
        for (int i = tidp; i < 100000; i += 512) ae.out[1024 + i] += 0.5f * fb;
    }
#endif
#undef RUN
#undef SEAM
}

static bool phase_applies(int gp) {
    if (gp < 2) return true;
    const int l = (gp - 2) / PH_PER_LAYER, ph = (gp - 2) % PH_PER_LAYER; const bool moe = (l & 1) != 0;
    if (ph < PH_LN1) return ph != PH_POST && ph != PH_MIX2 && ph != PH_MIX4;
    if (ph == PH_PGATE) return true;
    if (!moe) return ph == PH_FUP || ph == PH_FDN;
    return ph >= PH_MGATH && ph <= PH_MUP0 + 2 * MOE_NCHUNK;
}
extern "C" void kernel_launch(void* const* d_in, const int* in_sizes, int n_in, void* d_out, int out_size, void* d_ws, size_t ws_size, hipStream_t stream) {
    static int grid = 0;
    if (grid == 0) {
        if (n_in != 36 || out_size != T * D || ws_size < WS_END) { fprintf(stderr, "kernel_launch: unexpected problem (n_in %d out %d ws %zu, need %zu)\n", n_in, out_size, ws_size, (size_t)WS_END); grid = -1; return; }
        int dev = 0, cus = 0, per_cu = 0;
        if (hipGetDevice(&dev) != hipSuccess || hipDeviceGetAttribute(&cus, hipDeviceAttributeMultiprocessorCount, dev) != hipSuccess) { grid = -1; return; }
        if (hipFuncSetAttribute((const void*)mk_fwd, hipFuncAttributeMaxDynamicSharedMemorySize, LDS_BYTES) != hipSuccess) { fprintf(stderr, "kernel_launch: hipFuncSetAttribute failed\n"); grid = -1; return; }
        if (hipOccupancyMaxActiveBlocksPerMultiprocessor(&per_cu, (const void*)mk_fwd, 512, LDS_BYTES) != hipSuccess || per_cu < 1) fprintf(stderr, "kernel_launch: occupancy query reports %d\n", per_cu);
        (void)hipGetLastError();
        grid = cus;
    }
    if (grid < 0) return;
    (void)in_sizes;
    if (hipMemsetAsync((char*)d_ws + WS_CTL, 0, CTL_ZERO_BYTES, stream) != hipSuccess) return;
#if MK_CHECK
    (void)hipMemsetAsync((char*)d_ws + SM_CHK, 0, 256, stream);
#endif
    Args a{};
    for (int i = 0; i < 36; ++i) a.in[i] = d_in[i];
    a.out = (float*)d_out; a.ws = (unsigned char*)d_ws; a.pad = 0;
#if MK_MULTI
    for (int gp = 0; gp < GP_END; ++gp) { if (!phase_applies(gp)) continue; a.gp_lo = gp; a.gp_hi = gp + 1; a.use_bar = 0;
        hipLaunchKernelGGL(mk_fwd, dim3(grid), dim3(512), LDS_BYTES, stream, a);
#if MK_CHECK
        run_checks(a, gp, stream);
#endif
    }
#if MK_CHECK
    hipLaunchKernelGGL(chk_final, dim3(1), dim3(1), 0, stream, a);
#endif
#else
    a.gp_lo = 0; a.gp_hi = GP_END; a.use_bar = 1;
    hipLaunchKernelGGL(mk_fwd, dim3(grid), dim3(512), LDS_BYTES, stream, a);
#endif
}
```

```cpp
#include <hip/hip_runtime.h>
#include <cstdint>
#include <cstdio>
#ifndef MK_TAILSPLIT
#define MK_TAILSPLIT 1
#endif
#ifndef MK_MULTI
#define MK_MULTI 0
#endif
#ifndef MK_CHECK
#define MK_CHECK 0
#endif
#ifndef MK_REP_G1
#define MK_REP_G1 1
#endif
#ifndef MK_REP_G2
#define MK_REP_G2 1
#endif
#ifndef MK_REP_CU
#define MK_REP_CU 1
#endif
#ifndef MK_REP_TK
#define MK_REP_TK 1
#endif
#ifndef MK_REP_WOUT
#define MK_REP_WOUT 1
#endif
#ifndef MK_REP_CONV
#define MK_REP_CONV 1
#endif
#ifndef MK_REP_ST2
#define MK_REP_ST2 1
#endif
#ifndef MK_REP_CARRY
#define MK_REP_CARRY 1
#endif
#ifndef MK_REPCMP
#define MK_REPCMP 1
#endif
#ifndef MK_ALIGN_EPI
#define MK_ALIGN_EPI 1
#endif
#ifndef MK_PROBE
#define MK_PROBE 0
#endif
#ifndef PROBE_A
#define PROBE_A 0
#endif
#ifndef PROBE_B
#define PROBE_B 0
#endif
#ifndef CHK_LAYER
#define CHK_LAYER 15
#endif

#define GAS __attribute__((address_space(1)))
#define LAS __attribute__((address_space(3)))
typedef unsigned short bf16_t;
typedef short bf16x8 __attribute__((ext_vector_type(8)));
typedef float f32x4 __attribute__((ext_vector_type(4)));
typedef float f32x2 __attribute__((ext_vector_type(2)));
typedef float f32x16 __attribute__((ext_vector_type(16)));
typedef unsigned u32x4 __attribute__((ext_vector_type(4)));
typedef unsigned u32x2 __attribute__((ext_vector_type(2)));

constexpr int NB = 16, SEQ = 4096, T = NB * SEQ, D = 1024, DEPTH = 4;
constexpr int INW = 2072, INP = 2304;
constexpr int ZKV = 512, ZG = 1280, ZC = 1304, ZS = 1816;
constexpr int DFF = 2816, DFE = 3584, NEXP = 8, PLE = 256;
constexpr int NCMP = 255;
constexpr int S5LC = 32, S5NCH = SEQ / S5LC, S5K = S5LC * 16 + 128;
constexpr float ALPHA = 1.6817928305074290f;
constexpr float LN_EPS = 1e-5f;
constexpr float QSCALE = 0.125f * 1.4426950408889634f;
constexpr float NEGF = -1e30f;
constexpr int MOE_TILES_MAX = 520, MOE_CHUNK_TILES = 128, MOE_NCHUNK = 5;

typedef __bf16 bf16x2_t __attribute__((ext_vector_type(2)));
__device__ __forceinline__ unsigned cvt_pk_bf16(float lo, float hi) { f32x2 v = {lo, hi}; const bf16x2_t b = __builtin_convertvector(v, bf16x2_t); return __builtin_bit_cast(unsigned, b); }
__device__ __forceinline__ bf16_t f2bf(float f) { return (bf16_t)(cvt_pk_bf16(f, 0.f) & 0xffffu); }
__device__ __forceinline__ float bf2f(unsigned v) { return __uint_as_float(v << 16); }
__device__ __forceinline__ float bflo(unsigned w) { return __uint_as_float(w << 16); }
__device__ __forceinline__ float bfhi(unsigned w) { return __uint_as_float(w & 0xffff0000u); }
__device__ __forceinline__ float fast_exp2(float x) { return __builtin_amdgcn_exp2f(x); }
__device__ __forceinline__ float fast_rcp(float x) { return __builtin_amdgcn_rcpf(x); }
__device__ __forceinline__ float sigmoidf_(float x) { return fast_rcp(1.0f + fast_exp2(-1.4426950408889634f * x)); }
__device__ __forceinline__ float siluf_(float x) { return x * sigmoidf_(x); }
__device__ __forceinline__ float gelu_tanh(float x) { const float u = 0.7978845608028654f * (x + 0.044715f * x * x * x); return x * sigmoidf_(2.0f * u); }
__device__ __forceinline__ int lane_id_fresh() { unsigned z = 0u; asm volatile("" : "+v"(z)); return (int)__builtin_amdgcn_mbcnt_hi(~0u, __builtin_amdgcn_mbcnt_lo(~0u, z)); }
template <int MASK> __device__ __forceinline__ float xshfl(float v) {
    if (MASK == 1) return __uint_as_float((unsigned)__builtin_amdgcn_update_dpp(0, (int)__float_as_uint(v), 0xB1, 0xF, 0xF, true));
    if (MASK == 2) return __uint_as_float((unsigned)__builtin_amdgcn_update_dpp(0, (int)__float_as_uint(v), 0x4E, 0xF, 0xF, true));
    if (MASK == 32) { const unsigned u = __float_as_uint(v); auto rr = __builtin_amdgcn_permlane32_swap(u, u, false, false); return __uint_as_float((rr[0] == u) ? rr[1] : rr[0]); }
    return __uint_as_float((unsigned)__builtin_amdgcn_ds_swizzle((int)__float_as_uint(v), 0x1f | (MASK << 10)));
}
__device__ __forceinline__ float xsum32(float v) { const unsigned u = __float_as_uint(v); auto rr = __builtin_amdgcn_permlane32_swap(u, u, false, false); return __uint_as_float(rr[0]) + __uint_as_float(rr[1]); }
__device__ __forceinline__ float xsum16(float v) { const unsigned u = __float_as_uint(v); auto rr = __builtin_amdgcn_permlane16_swap(u, u, false, false); return __uint_as_float(rr[0]) + __uint_as_float(rr[1]); }
__device__ __forceinline__ float swapsum32(float a, float b) { auto rr = __builtin_amdgcn_permlane32_swap(__float_as_uint(a), __float_as_uint(b), false, false); return __uint_as_float(rr[0]) + __uint_as_float(rr[1]); }
__device__ __forceinline__ float swapsum16(float a, float b) { auto rr = __builtin_amdgcn_permlane16_swap(__float_as_uint(a), __float_as_uint(b), false, false); return __uint_as_float(rr[0]) + __uint_as_float(rr[1]); }
__device__ __forceinline__ float dpp_half_mirror(float v) { return __uint_as_float((unsigned)__builtin_amdgcn_update_dpp(0, (int)__float_as_uint(v), 0x141, 0xF, 0xF, true)); }
__device__ __forceinline__ float wave_sum(float v) {
    v += xshfl<1>(v); v += xshfl<2>(v);
    v += __uint_as_float((unsigned)__builtin_amdgcn_update_dpp(0, (int)__float_as_uint(v), 0x141, 0xF, 0xF, true));
    v += __uint_as_float((unsigned)__builtin_amdgcn_update_dpp(0, (int)__float_as_uint(v), 0x140, 0xF, 0xF, true));
    v = xsum16(v); v = xsum32(v);
    return v;
}
#define LDS_WAIT() asm volatile("s_waitcnt lgkmcnt(0)" ::: "memory")
#define VM_WAIT() asm volatile("s_waitcnt vmcnt(0)" ::: "memory")

namespace pg8 {
constexpr int BM = 256, BK = 64, HALF = 128, HTB = HALF * BK * 2, STAGE_BYTES = 8 * HTB, NXCD = 8, WGM = 8;
__host__ __device__ __forceinline__ int lds_byte(int r, int c) { const int st = (r >> 4) * 2 + (c >> 5), rr = r & 15, cc = c & 31, ob = rr * 64 + cc * 2; return st * 1024 + (ob ^ (((ob >> 9) & 1) << 5)); }
__host__ __device__ __forceinline__ void stage_rc(int b, int& R, int& C) { const int st = b / 1024, sb = b % 1024, swz = sb ^ (((sb >> 9) & 1) << 5); R = (st >> 1) * 16 + swz / 64; C = (st & 1) * 32 + (swz % 64) / 2; }
__host__ __device__ __forceinline__ int perm32(int rho) { const int n = rho >> 4, i = rho & 15; return 8 * (i >> 2) + 4 * n + (i & 3); }

struct Unit { int pm, pn; long long offA, offB; int aux; };
struct Gemm { const bf16_t* A; const bf16_t* Bt; int K, lda, ldb; };

__device__ __forceinline__ bool static_tile(int i, int G, int c, int nM, int nN, int& pm, int& pn) {
    const int nwg = nM * nN; const long L = (long)i * G + c; if (L >= nwg) return false;
    int wgid = (int)L; { const int q = nwg / NXCD, r = nwg % NXCD, xcd = wgid % NXCD, off = wgid / NXCD; wgid = (xcd < r ? xcd * (q + 1) : r * (q + 1) + (xcd - r) * q) + off; }
    const int nig = WGM * nN, gid = wgid / nig, fm = gid * WGM, gsz = (nM - fm) < WGM ? (nM - fm) : WGM;
    pm = fm + ((wgid % nig) % gsz); pn = (wgid % nig) / gsz; return true;
}
struct PlainOrder {
    int nM, nN, G, c; long long sA, sB;
    __device__ __forceinline__ bool next(int i, Unit& u) const { if (!static_tile(i, G, c, nM, nN, u.pm, u.pn)) return false; u.offA = (long long)u.pm * sA; u.offB = (long long)u.pn * sB; u.aux = 0; return true; }
};
struct PanelOrder {
    int nM, nN, G, c; long long sA, sB;
    __device__ __forceinline__ bool next(int i, Unit& u) const { const int pm = c + G * (i / nN); if (pm >= nM) return false; u.pm = pm; u.pn = i % nN; u.offA = (long long)pm * sA; u.offB = (long long)u.pn * sB; u.aux = 0; return true; }
};
struct ListOrder {
    int n, pm, aux; long long offA0, offB0, sB;
    __device__ __forceinline__ bool next(int i, Unit& u) const { if (i >= n) return false; u.pm = pm; u.pn = i; u.aux = aux; u.offA = offA0; u.offB = offB0 + (long long)i * sB; return true; }
};
struct GroupedOrder {
    int ng, nM, nN, G, c; long long sA, sB, gA, gB;
    __device__ __forceinline__ bool next(int i, Unit& u) const {
        const long L = (long)i * G + c; const int per = nM * nN; if (L >= (long)ng * per) return false;
        const int gi = (int)(L / per), r = (int)(L % per); u.pm = r / nN; u.pn = r % nN; u.aux = gi;
        u.offA = (long long)gi * gA + (long long)u.pm * sA; u.offB = (long long)gi * gB + (long long)u.pn * sB; return true; }
};

template <class Epi, class Sched>
__device__ __forceinline__ void gemm_phase(LAS unsigned char* lds, const Gemm g, const Sched& S, const Epi& E, int tid_in) {
    int tid_ = tid_in; asm volatile("" : "+v"(tid_));
    const int tid = tid_, wid = __builtin_amdgcn_readfirstlane(tid >> 6), lane = tid & 63, wr = wid >> 2, wc = wid & 3, fr = lane & 15, fq = lane >> 4;
    int K_ = g.K; asm volatile("" : "+s"(K_));
    const int K = K_, nt = K / BK; (void)K;
    unsigned voffA[2], voffB[2];
#pragma unroll
    for (int i = 0; i < 2; ++i) { int R, C; stage_rc(tid * 16 + i * 8192, R, C); const int Rb = Epi::PERM ? ((R & ~31) + perm32(R & 31)) : R;
        voffA[i] = (unsigned)(R * g.lda + C) * 2u; voffB[i] = (unsigned)(Rb * g.ldb + C) * 2u; }
    const size_t kstep = (size_t)(BK * 2);
    const size_t hstepA = (size_t)HALF * g.lda * 2, hstepB = (size_t)HALF * g.ldb * 2;
    const unsigned ldsw = (unsigned)wid * 1024u;
    const int aoff = lds_byte(wr * 64 + fr, fq * 8), boff = lds_byte(wc * 32 + fr, fq * 8);
#define PG8_SA(b, h) (((b) * 2 + (h)) * HTB)
#define PG8_SB(b, h) ((4 + (b) * 2 + (h)) * HTB)
#define PG8_STAGE(bufoff, gbase, voff) do { _Pragma("unroll") for (int _i = 0; _i < 2; ++_i) \
        __builtin_amdgcn_global_load_lds((const unsigned*)((const char*)(gbase) + (voff)[_i]), (LAS unsigned*)(lds + (bufoff) + ldsw + _i * 8192), 16, 0, 0); } while (0)
#define PG8_LDA(dst, b, h) do { _Pragma("unroll") for (int m = 0; m < 4; ++m) _Pragma("unroll") for (int k = 0; k < 2; ++k) dst[m][k] = *(const LAS bf16x8*)(lds + PG8_SA(b, h) + aoff + m * 2048 + k * 1024); } while (0)
#define PG8_LDB(dst, b, h) do { _Pragma("unroll") for (int n = 0; n < 2; ++n) _Pragma("unroll") for (int k = 0; k < 2; ++k) dst[n][k] = *(const LAS bf16x8*)(lds + PG8_SB(b, h) + boff + n * 2048 + k * 1024); } while (0)
#define PG8_MMA(ai, bj, At, Bt) do { __builtin_amdgcn_s_setprio(1); _Pragma("unroll") for (int m = 0; m < 4; ++m) _Pragma("unroll") for (int n = 0; n < 2; ++n) _Pragma("unroll") for (int k = 0; k < 2; ++k) \
        acc[ai][bj][m][n] = __builtin_amdgcn_mfma_f32_16x16x32_bf16(Bt[n][k], At[m][k], acc[ai][bj][m][n], 0, 0, 0); __builtin_amdgcn_s_setprio(0); } while (0)
#define PG8_WAIT_V(n) asm volatile("s_waitcnt vmcnt(" #n ")" ::: "memory")
#define PG8_WAIT_L(n) asm volatile("s_waitcnt lgkmcnt(" #n ")" ::: "memory")
#define PG8_BAR __builtin_amdgcn_s_barrier()
#define PG8_SCHED __builtin_amdgcn_sched_barrier(0)
    Unit cur, nxt; int ui = 0;
    if (!S.next(0, cur)) return;
    f32x4 acc[2][2][4][2];
#pragma unroll
    for (int a = 0; a < 2; ++a)
#pragma unroll
        for (int b = 0; b < 2; ++b)
#pragma unroll
            for (int m = 0; m < 4; ++m)
#pragma unroll
                for (int n = 0; n < 2; ++n) acc[a][b][m][n] = (f32x4){0.f, 0.f, 0.f, 0.f};
    bf16x8 At[4][2], B0[2][2], B1[2][2];
    const char* cA = (const char*)g.A + cur.offA; const char* cB = (const char*)g.Bt + cur.offB;
    PG8_STAGE(PG8_SB(0, 0), cB, voffB); PG8_STAGE(PG8_SB(0, 1), cB + hstepB, voffB); PG8_STAGE(PG8_SA(0, 0), cA, voffA); PG8_STAGE(PG8_SA(0, 1), cA + hstepA, voffA);
    if (wr == 1) PG8_BAR;
    PG8_WAIT_V(2); PG8_BAR;
    PG8_STAGE(PG8_SB(1, 0), cB + kstep, voffB); PG8_STAGE(PG8_SA(1, 0), cA + kstep, voffA); PG8_STAGE(PG8_SB(1, 1), cB + hstepB + kstep, voffB);
    PG8_WAIT_V(6); PG8_BAR;
    for (;;) {
        const bool has_next = S.next(ui + 1, nxt);
        const char* nA = has_next ? (const char*)g.A + nxt.offA : cA; const char* nB = has_next ? (const char*)g.Bt + nxt.offB : cB;
        for (int t = 0; t < nt; t += 2) {
            const bool last = (t == nt - 2);
            const char* a1 = cA + (size_t)(t + 1) * kstep;
            const char* a2 = last ? nA : cA + (size_t)(t + 2) * kstep; const char* b2 = last ? nB : cB + (size_t)(t + 2) * kstep;
            const char* a3 = a2 + kstep; const char* b3 = b2 + kstep;
            PG8_LDB(B0, 0, 0); PG8_LDB(B1, 0, 1); PG8_SCHED; PG8_LDA(At, 0, 0); PG8_STAGE(PG8_SA(1, 1), a1 + hstepA, voffA);
            PG8_WAIT_V(8); PG8_WAIT_L(0); PG8_BAR; PG8_MMA(0, 0, At, B0); PG8_MMA(0, 1, At, B1); PG8_BAR; PG8_SCHED;
            PG8_LDA(At, 0, 1); PG8_STAGE(PG8_SB(0, 0), b2, voffB); PG8_STAGE(PG8_SB(0, 1), b2 + hstepB, voffB); PG8_STAGE(PG8_SA(0, 0), a2, voffA);
            PG8_WAIT_V(8); PG8_WAIT_L(0); PG8_BAR; PG8_MMA(1, 0, At, B0); PG8_MMA(1, 1, At, B1); PG8_BAR; PG8_SCHED;
            PG8_LDB(B0, 1, 0); PG8_LDB(B1, 1, 1); PG8_SCHED; PG8_LDA(At, 1, 0); PG8_STAGE(PG8_SA(0, 1), a2 + hstepA, voffA);
            PG8_WAIT_V(8); PG8_WAIT_L(0); PG8_BAR; PG8_MMA(0, 0, At, B0); PG8_MMA(0, 1, At, B1); PG8_BAR; PG8_SCHED;
            PG8_LDA(At, 1, 1); PG8_STAGE(PG8_SB(1, 0), b3, voffB); PG8_STAGE(PG8_SB(1, 1), b3 + hstepB, voffB); PG8_STAGE(PG8_SA(1, 0), a3, voffA);
            PG8_WAIT_V(8); PG8_WAIT_L(0); PG8_BAR; PG8_MMA(1, 0, At, B0); PG8_MMA(1, 1, At, B1); PG8_BAR; PG8_SCHED;
        }
#if MK_ALIGN_EPI
        if (wr == 0) PG8_BAR;
#endif
        { int fr_ = fr, fq_ = fq; asm volatile("" : "+v"(fr_), "+v"(fq_));
          E(acc, cur, wr, wc, fr_, fq_); }
        if (!has_next) break;
#pragma unroll
        for (int a = 0; a < 2; ++a)
#pragma unroll
            for (int b = 0; b < 2; ++b)
#pragma unroll
                for (int m = 0; m < 4; ++m)
#pragma unroll
                    for (int n = 0; n < 2; ++n) acc[a][b][m][n] = (f32x4){0.f, 0.f, 0.f, 0.f};
        cur = nxt; cA = nA; cB = nB; ++ui;
#if MK_ALIGN_EPI
        if (wr == 1) PG8_BAR;
#endif
    }
    PG8_WAIT_V(0);
#if !MK_ALIGN_EPI
    if (wr == 0) PG8_BAR;
#endif
    PG8_BAR;
#undef PG8_SA
#undef PG8_SB
#undef PG8_STAGE
#undef PG8_LDA
#undef PG8_LDB
#undef PG8_MMA
#undef PG8_WAIT_V
#undef PG8_WAIT_L
#undef PG8_BAR
#undef PG8_SCHED
}
}

#define XB_TMO      128
#define XB_XCNT(j)  (256  + 64 * (j))
#define XB_XSUB(j)  (1280 + 64 * (j))
#define XB_XGEN(j)  (2304 + 64 * (j))
#define XB_TOP      3328
#define XB_TOPGEN   3392
#define XCD_BAR_WORDS 3456
#define XB_SPIN_CAP (1u << 20)
__device__ __forceinline__ unsigned xb_ld(unsigned* p)              { return __hip_atomic_load(p, __ATOMIC_RELAXED, __HIP_MEMORY_SCOPE_AGENT); }
__device__ __forceinline__ unsigned xb_add(unsigned* p, unsigned v) { return __hip_atomic_fetch_add(p, v, __ATOMIC_RELAXED, __HIP_MEMORY_SCOPE_AGENT); }
__device__ __forceinline__ unsigned xb_xcc_id() { return (unsigned)__builtin_amdgcn_s_getreg((3 << 11) | 20) & 0xFu; }
#define XB_SPIN(cond, bar) do { unsigned _sp = 0; while (cond) { __builtin_amdgcn_s_sleep(1); \
    if ((++_sp & 255u) == 0u) { if (xb_ld(&(bar)[XB_TMO])) break; if (_sp > XB_SPIN_CAP) { atomicAdd(&(bar)[XB_TMO], 1u); break; } } } } while (0)
struct XcdBarrier { unsigned* bar; unsigned x; volatile LAS unsigned* st; };
__device__ __forceinline__ XcdBarrier xcd_barrier_post(unsigned* bar, volatile LAS unsigned* st) {
    XcdBarrier b; b.bar = bar; b.x = xb_xcc_id(); b.st = st;
    if (threadIdx.x == 0) (void)xb_add(&bar[XB_XCNT(b.x)], 1u);
    return b;
}
__device__ __forceinline__ void xcd_barrier_complete(unsigned* bar, unsigned x, unsigned& nloc, unsigned& nx) {
    const unsigned G = gridDim.x * gridDim.y * gridDim.z;
    unsigned sum, cnt, mine, sp = 0u;
    for (;;) {
        sum = 0u; cnt = 0u; mine = 0u;
#pragma unroll 1
        for (unsigned j = 0; j < 16; ++j) { const unsigned c = xb_ld(&bar[XB_XCNT(j)]); sum += c; cnt += (c > 0u) ? 1u : 0u; mine = (j == x) ? c : mine; }
        if (sum == G) break;
        __builtin_amdgcn_s_sleep(1);
        if ((++sp & 255u) == 0u) { if (xb_ld(&bar[XB_TMO])) break; if (sp > XB_SPIN_CAP) { atomicAdd(&bar[XB_TMO], 1u); break; } }
    }
    nloc = mine > 0u ? mine : 1u; nx = cnt > 0u ? cnt : 1u;
}
__device__ __forceinline__ void xcd_barrier(const XcdBarrier& b, int wave_id) {
    asm volatile("s_waitcnt vmcnt(0)" ::: "memory");
    __syncthreads();
    if (wave_id == 0 && lane_id_fresh() == 0) {
        unsigned* bar = b.bar; asm volatile("" : "+s"(bar));
        __builtin_amdgcn_s_waitcnt(0);
        unsigned nloc = b.st[0], nx = b.st[1];
        if (nloc == 0u) { xcd_barrier_complete(bar, b.x, nloc, nx); b.st[0] = nloc; b.st[1] = nx; }
        const unsigned old = xb_add(&bar[XB_XSUB(b.x)], 1u);
        const unsigned gen = old / nloc;
        if (old + 1u == (gen + 1u) * nloc) {
            __builtin_amdgcn_fence(__ATOMIC_RELEASE, "agent");
            asm volatile("s_waitcnt vmcnt(0)" ::: "memory");
            const unsigned og = xb_add(&bar[XB_TOP], 1u);
            const unsigned tg = og / nx;
            if (og + 1u == (tg + 1u) * nx) xb_add(&bar[XB_TOPGEN], 1u);
            else XB_SPIN(xb_ld(&bar[XB_TOPGEN]) == tg, bar);
            __builtin_amdgcn_fence(__ATOMIC_ACQUIRE, "agent");
            xb_add(&bar[XB_XGEN(b.x)], 1u);
            asm volatile("s_waitcnt vmcnt(0)" ::: "memory");
        } else {
            XB_SPIN(xb_ld(&bar[XB_XGEN(b.x)]) == gen, bar);
            __builtin_amdgcn_fence(__ATOMIC_ACQUIRE, "agent");
            asm volatile("s_waitcnt vmcnt(0)" ::: "memory");
        }
    }
    __syncthreads();
}
namespace nsa {
constexpr int PITCH = 144, TILE_LDS = 64 * PITCH;
__device__ __forceinline__ int crow(int r, int hi) { return (r & 3) + 8 * (r >> 2) + 4 * hi; }
__device__ __forceinline__ int vslot(int kk) { return (kk & 0x33) | (((kk >> 2) & 1) << 3) | (((kk >> 3) & 1) << 2); }

struct Lane { int lane, c, hi, wid, tid; };

__device__ __forceinline__ void qk_tile(f32x16& p0, f32x16& p1, const LAS unsigned char* Ks, const bf16x8 (&qr)[4], float bias, const Lane& L) {
#pragma unroll
    for (int r = 0; r < 16; ++r) { p0[r] = bias; p1[r] = bias; }
    const LAS unsigned char* kb = Ks + L.c * PITCH + L.hi * 16;
#pragma unroll
    for (int d0 = 0; d0 < 4; ++d0) {
        const bf16x8 k0 = *(const LAS bf16x8*)(kb + d0 * 32);
        const bf16x8 k1 = *(const LAS bf16x8*)(kb + 32 * PITCH + d0 * 32);
        p0 = __builtin_amdgcn_mfma_f32_32x32x16_bf16(k0, qr[d0], p0, 0, 0, 0);
        p1 = __builtin_amdgcn_mfma_f32_32x32x16_bf16(k1, qr[d0], p1, 0, 0, 0);
    }
}
__device__ __forceinline__ void qk_tile_c(f32x16& p0, f32x16& p1, const LAS unsigned char* Ks, const bf16x8 (&qr)[4], const f32x16& cv, const Lane& L) {
    const LAS unsigned char* kb = Ks + L.c * PITCH + L.hi * 16;
    { const bf16x8 k0 = *(const LAS bf16x8*)(kb); const bf16x8 k1 = *(const LAS bf16x8*)(kb + 32 * PITCH);
      p0 = __builtin_amdgcn_mfma_f32_32x32x16_bf16(k0, qr[0], cv, 0, 0, 0); p1 = __builtin_amdgcn_mfma_f32_32x32x16_bf16(k1, qr[0], cv, 0, 0, 0); }
#pragma unroll
    for (int d0 = 1; d0 < 4; ++d0) {
        const bf16x8 k0 = *(const LAS bf16x8*)(kb + d0 * 32);
        const bf16x8 k1 = *(const LAS bf16x8*)(kb + 32 * PITCH + d0 * 32);
        p0 = __builtin_amdgcn_mfma_f32_32x32x16_bf16(k0, qr[d0], p0, 0, 0, 0);
        p1 = __builtin_amdgcn_mfma_f32_32x32x16_bf16(k1, qr[d0], p1, 0, 0, 0);
    }
}
__device__ __forceinline__ void mask_range(f32x16& p0, f32x16& p1, int lo, int hi_, int hi) {
#pragma unroll
    for (int r = 0; r < 16; ++r) { const int k0 = crow(r, hi), k1 = k0 + 32;
        if (k0 <= lo || k0 > hi_) p0[r] = NEGF;
        if (k1 <= lo || k1 > hi_) p1[r] = NEGF; }
}
__device__ __forceinline__ float tile_max(const f32x16& p0, const f32x16& p1) {
    float a = fmaxf(p0[0], p1[0]);
#pragma unroll
    for (int r = 1; r < 16; ++r) a = fmaxf(a, fmaxf(p0[r], p1[r]));
    return fmaxf(a, xshfl<32>(a));
}
__device__ __forceinline__ void pv_tile(f32x16& o0, f32x16& o1, const LAS unsigned char* Vs, const f32x16& p0, const f32x16& p1, const Lane& L) {
    const LAS unsigned char* vb = Vs + L.c * PITCH + L.hi * 16;
#pragma unroll
    for (int s = 0; s < 4; ++s) {
        u32x4 w;
        if (s < 2) { const int b = 8 * (s & 1); w.x = cvt_pk_bf16(p0[b], p0[b + 1]); w.y = cvt_pk_bf16(p0[b + 2], p0[b + 3]); w.z = cvt_pk_bf16(p0[b + 4], p0[b + 5]); w.w = cvt_pk_bf16(p0[b + 6], p0[b + 7]); }
        else       { const int b = 8 * (s & 1); w.x = cvt_pk_bf16(p1[b], p1[b + 1]); w.y = cvt_pk_bf16(p1[b + 2], p1[b + 3]); w.z = cvt_pk_bf16(p1[b + 4], p1[b + 5]); w.w = cvt_pk_bf16(p1[b + 6], p1[b + 7]); }
        const bf16x8 pf = __builtin_bit_cast(bf16x8, w);
        const bf16x8 v0 = *(const LAS bf16x8*)(vb + s * 32);
        const bf16x8 v1 = *(const LAS bf16x8*)(vb + 32 * PITCH + s * 32);
        o0 = __builtin_amdgcn_mfma_f32_32x32x16_bf16(v0, pf, o0, 0, 0, 0);
        o1 = __builtin_amdgcn_mfma_f32_32x32x16_bf16(v1, pf, o1, 0, 0, 0);
        if (s & 1) __builtin_amdgcn_sched_barrier(0);
    }
}
__device__ __forceinline__ void softmax_pv(f32x16& p0, f32x16& p1, f32x16& o0, f32x16& o1, float& m, float& l, const LAS unsigned char* Vs, const Lane& L) {
    const float mx = tile_max(p0, p1), mn = fmaxf(m, mx), alpha = fast_exp2(m - mn); m = mn;
    float ls = 0.f;
#pragma unroll
    for (int r = 0; r < 16; ++r) { p0[r] = fast_exp2(p0[r] - mn); p1[r] = fast_exp2(p1[r] - mn); ls += p0[r] + p1[r]; }
    l = l * alpha + ls;
#pragma unroll
    for (int r = 0; r < 16; ++r) { o0[r] *= alpha; o1[r] *= alpha; }
    pv_tile(o0, o1, Vs, p0, p1, L);
}
__device__ __forceinline__ int stage_off(int tid) { return (tid >> 3) * PITCH + (tid & 7) * 16; }

__device__ __forceinline__ void load_q(bf16x8 (&qr)[4], const bf16_t* qbuf, long tok, int head, int hi) {
    const bf16_t* qp = qbuf + tok * 512 + head * 64 + hi * 8;
#pragma unroll
    for (int d0 = 0; d0 < 4; ++d0) qr[d0] = *(const bf16x8*)(qp + d0 * 16);
}

__device__ __forceinline__ u32x4 vload(const bf16_t* Vt, int j, const Lane& L) { return *(const u32x4*)((const char*)Vt + (size_t)j * 8192 + L.lane * 128 + L.wid * 16); }
__device__ __forceinline__ void vstore(LAS unsigned char* Vs, const u32x4 v, const Lane& L) {
    LAS unsigned short* p = (LAS unsigned short*)(Vs + (8 * L.wid) * PITCH) + vslot(L.lane);
    p[0 * (PITCH / 2)] = (unsigned short)(v.x & 0xffffu); p[1 * (PITCH / 2)] = (unsigned short)(v.x >> 16); p[2 * (PITCH / 2)] = (unsigned short)(v.y & 0xffffu); p[3 * (PITCH / 2)] = (unsigned short)(v.y >> 16);
    p[4 * (PITCH / 2)] = (unsigned short)(v.z & 0xffffu); p[5 * (PITCH / 2)] = (unsigned short)(v.z >> 16); p[6 * (PITCH / 2)] = (unsigned short)(v.w & 0xffffu); p[7 * (PITCH / 2)] = (unsigned short)(v.w >> 16);
}
template <int MODE>
__device__ __forceinline__ void run_branch(f32x16& o0, f32x16& o1, float& mref, float& l, const bf16_t* Kt  , const bf16_t* Vt  ,
                                           int jlo, int jhi, int qb, int qrel, unsigned long long selw, const bf16x8 (&qr)[4], LAS unsigned char* lds, const Lane& L) {
    LAS unsigned char* Kbuf = lds; LAS unsigned char* Vbuf = lds + 2 * TILE_LDS;
    const int so = stage_off(L.tid);
    u32x4 kreg = *(const u32x4*)((const char*)Kt + (size_t)jlo * 8192 + L.tid * 16);
    u32x4 vreg = vload(Vt, jlo, L);
    *(LAS u32x4*)(Kbuf + so) = kreg; vstore(Vbuf, vreg, L);
    __syncthreads();
    f32x16 cv;
#pragma unroll
    for (int r = 0; r < 16; ++r) cv[r] = -mref;
    for (int j = jlo; j <= jhi; ++j) {
        const int cur = (j - jlo) & 1;
        if (j < jhi) { kreg = *(const u32x4*)((const char*)Kt + (size_t)(j + 1) * 8192 + L.tid * 16); vreg = vload(Vt, j + 1, L); }
        f32x16 p0, p1;
        if (MODE == 0) { const float cb = ((selw >> j) & 1ull) ? -mref : NEGF;
#pragma unroll
            for (int r = 0; r < 16; ++r) cv[r] = cb; }
        qk_tile_c(p0, p1, Kbuf + cur * TILE_LDS, qr, cv, L);
        if (j == qb) mask_range(p0, p1, -1, qrel, L.hi);
        if (MODE == 1 && j == qb - 8) mask_range(p0, p1, qrel, 64, L.hi);
        const float mx = tile_max(p0, p1);
        if (__any(mx > 8.0f)) {
            const float dl = fmaxf(mx, 0.f), f = fast_exp2(-dl); mref += dl; l *= f;
#pragma unroll
            for (int r = 0; r < 16; ++r) { o0[r] *= f; o1[r] *= f; p0[r] -= dl; p1[r] -= dl; }
            if (MODE == 1) {
#pragma unroll
                for (int r = 0; r < 16; ++r) cv[r] = -mref; }
        }
        float ls = 0.f;
#pragma unroll
        for (int r = 0; r < 16; ++r) { p0[r] = fast_exp2(p0[r]); p1[r] = fast_exp2(p1[r]); ls += p0[r] + p1[r]; }
        l += ls;
        pv_tile(o0, o1, Vbuf + cur * TILE_LDS, p0, p1, L);
        if (j < jhi) { *(LAS u32x4*)(Kbuf + (cur ^ 1) * TILE_LDS + so) = kreg; vstore(Vbuf + (cur ^ 1) * TILE_LDS, vreg, L); }
        __syncthreads();
    }
}
struct SoftState { float mref, l; };
__device__ __forceinline__ void softmax_step2(f32x16& p0, f32x16& p1, f32x16& o0, f32x16& o1, SoftState& st, bool sel, bf16x8 (&pf)[4]) {
    if (__any(st.mref != 0.f)) {
#pragma unroll
        for (int r = 0; r < 16; ++r) { p0[r] -= st.mref; p1[r] -= st.mref; } }
    float ls = 0.f;
#pragma unroll
    for (int r = 0; r < 16; ++r) { p0[r] = fast_exp2(p0[r]); p1[r] = fast_exp2(p1[r]); ls += p0[r] + p1[r]; }
    ls = sel ? ls : 0.f; st.l += ls;
#pragma unroll
    for (int s = 0; s < 4; ++s) { u32x4 w; const int b = 8 * (s & 1);
        if (s < 2) { w.x = cvt_pk_bf16(p0[b], p0[b + 1]); w.y = cvt_pk_bf16(p0[b + 2], p0[b + 3]); w.z = cvt_pk_bf16(p0[b + 4], p0[b + 5]); w.w = cvt_pk_bf16(p0[b + 6], p0[b + 7]); }
        else       { w.x = cvt_pk_bf16(p1[b], p1[b + 1]); w.y = cvt_pk_bf16(p1[b + 2], p1[b + 3]); w.z = cvt_pk_bf16(p1[b + 4], p1[b + 5]); w.w = cvt_pk_bf16(p1[b + 6], p1[b + 7]); }
        if (!sel) w = (u32x4){0u, 0u, 0u, 0u};
        pf[s] = __builtin_bit_cast(bf16x8, w); }
}
__device__ __forceinline__ void renorm_step(f32x16& o0, f32x16& o1, SoftState& st) {
    if (__any(st.l > 1.0995116e12f)) { const bool big = st.l > 1.0995116e12f; const float f = big ? 9.094947e-13f : 1.0f; st.mref += big ? 40.f : 0.f; st.l *= f;
#pragma unroll
        for (int r = 0; r < 16; ++r) { o0[r] *= f; o1[r] *= f; } }
}
template <int MODE>
__device__ __forceinline__ void run_branch2(f32x16& oa0, f32x16& oa1, SoftState& sa, f32x16& ob0, f32x16& ob1, SoftState& sb, const bf16_t* Kt, const bf16_t* Vt, int jlo, int jhi, int qbw, int qrela,
                                            const LAS unsigned long long* selp  , const bf16x8 (&qa)[4], const bf16x8 (&qbf)[4], LAS unsigned char* lds, const Lane& L) {
    LAS unsigned char* Kbuf = lds; LAS unsigned char* Vbuf = lds + 2 * TILE_LDS;
    const int so = stage_off(L.tid);
    {   const u32x4 kreg = *(const u32x4*)((const char*)Kt + (size_t)jlo * 8192 + L.tid * 16); const u32x4 vreg = vload(Vt, jlo, L);
        *(LAS u32x4*)(Kbuf + so) = kreg; vstore(Vbuf, vreg, L); }
    __syncthreads();
    for (int j = jlo; j <= jhi; ++j) {
        const int cur = (j - jlo) & 1;
        const bool act = (j <= qbw) && (MODE == 0 || j >= qbw - 8);
        u32x4 kreg, vreg;
        bf16x8 fa[4], fb[4];
        if (act) {
            f32x16 pa0, pa1, pb0, pb1;
#pragma unroll
            for (int r = 0; r < 16; ++r) { pa0[r] = 0.f; pa1[r] = 0.f; pb0[r] = 0.f; pb1[r] = 0.f; }
            const LAS unsigned char* kb = Kbuf + cur * TILE_LDS + L.c * PITCH + L.hi * 16;
#pragma unroll
            for (int d0 = 0; d0 < 4; ++d0) { const bf16x8 k0 = *(const LAS bf16x8*)(kb + d0 * 32); const bf16x8 k1 = *(const LAS bf16x8*)(kb + 32 * PITCH + d0 * 32);
                pa0 = __builtin_amdgcn_mfma_f32_32x32x16_bf16(k0, qa[d0], pa0, 0, 0, 0); pa1 = __builtin_amdgcn_mfma_f32_32x32x16_bf16(k1, qa[d0], pa1, 0, 0, 0);
                pb0 = __builtin_amdgcn_mfma_f32_32x32x16_bf16(k0, qbf[d0], pb0, 0, 0, 0); pb1 = __builtin_amdgcn_mfma_f32_32x32x16_bf16(k1, qbf[d0], pb1, 0, 0, 0); }
            if (j == qbw) { mask_range(pa0, pa1, -1, qrela, L.hi); mask_range(pb0, pb1, -1, qrela + 8, L.hi); }
            if (MODE == 1 && j == qbw - 8) { mask_range(pa0, pa1, qrela, 64, L.hi); mask_range(pb0, pb1, qrela + 8, 64, L.hi); }
            bool sela = true, selb = true;
            if (MODE == 0) { sela = (selp[0] >> j) & 1ull; selb = (selp[1] >> j) & 1ull; }
            softmax_step2(pa0, pa1, oa0, oa1, sa, sela, fa);
            __builtin_amdgcn_sched_barrier(0);
            softmax_step2(pb0, pb1, ob0, ob1, sb, selb, fb);
            __builtin_amdgcn_sched_barrier(0);
        }
        if (j < jhi) { kreg = *(const u32x4*)((const char*)Kt + (size_t)(j + 1) * 8192 + L.tid * 16); vreg = vload(Vt, j + 1, L); }
        if (act) {
            const LAS unsigned char* vb = Vbuf + cur * TILE_LDS + L.c * PITCH + L.hi * 16;
#pragma unroll
            for (int s = 0; s < 4; ++s) {
                const bf16x8 v0 = *(const LAS bf16x8*)(vb + s * 32); const bf16x8 v1 = *(const LAS bf16x8*)(vb + 32 * PITCH + s * 32);
                oa0 = __builtin_amdgcn_mfma_f32_32x32x16_bf16(v0, fa[s], oa0, 0, 0, 0); oa1 = __builtin_amdgcn_mfma_f32_32x32x16_bf16(v1, fa[s], oa1, 0, 0, 0);
                ob0 = __builtin_amdgcn_mfma_f32_32x32x16_bf16(v0, fb[s], ob0, 0, 0, 0); ob1 = __builtin_amdgcn_mfma_f32_32x32x16_bf16(v1, fb[s], ob1, 0, 0, 0); }
            renorm_step(oa0, oa1, sa); renorm_step(ob0, ob1, sb);
        }
        if (j < jhi) { *(LAS u32x4*)(Kbuf + (cur ^ 1) * TILE_LDS + so) = kreg; vstore(Vbuf + (cur ^ 1) * TILE_LDS, vreg, L); }
        __syncthreads();
    }
}
}
namespace nsa {
struct AttnPtrs {
    const bf16_t* q;
    const bf16_t* z;
    const bf16_t* kc;
    const bf16_t* vct;
    const bf16_t* ksel;
    const bf16_t* vselt;
    const bf16_t* kwin; const bf16_t* vwint;
    unsigned long long* selmask;
    bf16_t* mix;
};
template <bool ACCUM>
__device__ __forceinline__ void store_o(const f32x16& a0, const f32x16& a1, bf16_t* mix, long tok, int head, int hi) {
    bf16_t* op = mix + tok * 1024 + head * 64 + 4 * hi;
#pragma unroll
    for (int dd = 0; dd < 2; ++dd)
#pragma unroll
        for (int rq = 0; rq < 4; ++rq) {
            float v0, v1, v2, v3;
            if (dd == 0) { v0 = a0[4 * rq]; v1 = a0[4 * rq + 1]; v2 = a0[4 * rq + 2]; v3 = a0[4 * rq + 3]; }
            else         { v0 = a1[4 * rq]; v1 = a1[4 * rq + 1]; v2 = a1[4 * rq + 2]; v3 = a1[4 * rq + 3]; }
            u32x2* p = (u32x2*)(op + dd * 32 + rq * 8);
            if (ACCUM) { const u32x2 old = *p; v0 += bflo(old.x); v1 += bfhi(old.x); v2 += bflo(old.y); v3 += bfhi(old.y); }
            u32x2 w; w.x = cvt_pk_bf16(v0, v1); w.y = cvt_pk_bf16(v2, v3); *p = w;
        }
}
__device__ __forceinline__ float gate_of(const bf16_t* z, long tok, int head, int br) { return sigmoidf_(bf2f(z[tok * INP + ZG + head * 3 + br])); }

struct CmpPre { bf16x8 qr[4]; };
__device__ __forceinline__ void cmp_prefetch(CmpPre& R, int bh, int qb, const AttnPtrs& P, const Lane& L) {
    const int b = bh >> 1, h = bh & 1, tq = qb * 64 + 8 * L.wid + (L.c >> 2), head = 4 * h + (L.c & 3); const long tok = (long)b * SEQ + tq;
    load_q(R.qr, P.q, tok, head, L.hi);
}
__device__ __forceinline__ void cmp_stage(const CmpPre& R, LAS unsigned char* lds, const Lane& L, bf16x8 (&qr)[4], float& gt) {
    (void)lds; (void)L;
#pragma unroll
    for (int d0 = 0; d0 < 4; ++d0) qr[d0] = R.qr[d0];
    gt = 0.f;
}
template <bool STAGE>
__device__ __forceinline__ void cmp_unit(int bh, int qb, const AttnPtrs& P, LAS unsigned char* lds, const Lane& L) {
    const int b = bh >> 1, h = bh & 1, t0 = qb * 64;
    const int ql = 8 * L.wid + (L.c >> 2), g = L.c & 3, tq = t0 + ql, head = 4 * h + g;
    const long tok = (long)b * SEQ + tq;
    LAS unsigned char* Kb = lds; LAS unsigned char* Vb = lds + 4 * TILE_LDS;
    LAS float* G4 = (LAS float*)(lds + 8 * TILE_LDS); LAS float* E3 = G4 + 64 * 64;
    const float gate_raw = bf2f(P.z[tok * INP + ZG + head * 3 + 0]);
    bf16x8 qr[4]; load_q(qr, P.q, tok, head, L.hi);
    if (STAGE) { const char* ks = (const char*)(P.kc + (size_t)bh * 256 * 64); const char* vs = (const char*)(P.vct + (size_t)bh * 256 * 64); const int so = stage_off(L.tid); u32x4 kk[4], vv[4];
#pragma unroll
      for (int jn = 0; jn < 4; ++jn) kk[jn] = *(const u32x4*)(ks + jn * 8192 + L.tid * 16);
#pragma unroll
      for (int jn = 0; jn < 4; ++jn) vv[jn] = *(const u32x4*)(vs + jn * 8192 + L.tid * 16);
#pragma unroll
      for (int jn = 0; jn < 4; ++jn) *(LAS u32x4*)(Kb + jn * TILE_LDS + so) = kk[jn];
#pragma unroll
      for (int jn = 0; jn < 4; ++jn) *(LAS u32x4*)(Vb + jn * TILE_LDS + so) = vv[jn]; }
    __syncthreads();
    const int nmax = (tq >= 31) ? ((tq - 31) >> 4) : -1;
    const int tq_lo = t0 + 8 * L.wid, tq_hi = tq_lo + 7;
    const int nmax_lo = (tq_lo >= 31) ? ((tq_lo - 31) >> 4) : -1, nmax_hi = (tq_hi >= 31) ? ((tq_hi - 31) >> 4) : -1;
    const int ntile = (nmax_hi >= 0) ? (nmax_hi >> 6) + 1 : 0;
    const bool need_imp = qb >= 16;
    float l = 0.f;
    f32x16 o0, o1;
#pragma unroll
    for (int r = 0; r < 16; ++r) { o0[r] = 0.f; o1[r] = 0.f; }
    float gsr[4][8], e3r[4][8];
#pragma unroll
    for (int jn = 0; jn < 4; ++jn)
#pragma unroll
        for (int i = 0; i < 8; ++i) { gsr[jn][i] = 0.f; e3r[jn][i] = 0.f; }
#pragma unroll
    for (int jn = 0; jn < 4; ++jn) {
        if (jn < ntile) {
            f32x16 p0, p1; qk_tile(p0, p1, Kb + jn * TILE_LDS, qr, 0.f, L);
            if (64 * jn + 63 > nmax_lo) mask_range(p0, p1, -1, nmax - 64 * jn, L.hi);
            float ls = 0.f;
#pragma unroll
            for (int r = 0; r < 16; ++r) { p0[r] = fast_exp2(p0[r]); p1[r] = fast_exp2(p1[r]); ls += p0[r] + p1[r]; }
            l += ls;
            if (need_imp) {
#pragma unroll
                for (int rq = 0; rq < 4; ++rq) { gsr[jn][rq] = (p0[4 * rq] + p0[4 * rq + 1]) + (p0[4 * rq + 2] + p0[4 * rq + 3]); e3r[jn][rq] = p0[4 * rq + 3];
                                                 gsr[jn][4 + rq] = (p1[4 * rq] + p1[4 * rq + 1]) + (p1[4 * rq + 2] + p1[4 * rq + 3]); e3r[jn][4 + rq] = p1[4 * rq + 3]; } }
            pv_tile(o0, o1, Vb + jn * TILE_LDS, p0, p1, L);
        }
        __builtin_amdgcn_sched_barrier(0);
    }
    l = xsum32(l);
    const float inv = (nmax >= 0 && l > 0.f) ? fast_rcp(l) : 0.f;
    if (need_imp) {
        LAS float* gp = G4 + ql * 64 + L.hi; asm volatile("" : "+v"(gp));
#pragma unroll
        for (int jn = 0; jn < 4; ++jn) {
            if (jn < ntile) {
#pragma unroll
                for (int i = 0; i < 8; ++i) { float gs = gsr[jn][i] * inv, e3 = e3r[jn][i] * inv;
                    gs += xshfl<1>(gs); gs += xshfl<2>(gs); e3 += xshfl<1>(e3); e3 += xshfl<2>(e3);
                    if (g == 0) { gp[16 * jn + 2 * i] = gs; gp[64 * 64 + 16 * jn + 2 * i] = e3; } }
            }
        }
    }
    {
        const float gt = sigmoidf_(gate_raw) * inv;
#pragma unroll
        for (int r = 0; r < 16; ++r) { o0[r] *= gt; o1[r] *= gt; }
        store_o<false>(o0, o1, P.mix, tok, head, L.hi);
    }
    __syncthreads();
}
__device__ __forceinline__ void cmp_topk(int bh, int qb, const AttnPtrs& P, LAS unsigned char* lds, const Lane& L) {
    const int t0 = qb * 64; LAS float* G4 = (LAS float*)(lds + 8 * TILE_LDS); LAS float* E3 = G4 + 64 * 64;
    const int s = L.lane;
    if (qb < 16) { const unsigned long long mask = (1ull << (qb + 1)) - 1ull;
        if (L.lane < 8) P.selmask[(size_t)bh * SEQ + t0 + 8 * L.wid + L.lane] = mask; }
    else {
        const bool cand = (s >= 1) && (s <= qb - 2);
        unsigned bits[8], T[8];
#pragma unroll
        for (int i = 0; i < 8; ++i) { const int q = 8 * L.wid + i; const float imp = G4[q * 64 + s] + (s > 0 ? E3[q * 64 + s - 1] : 0.f); bits[i] = cand ? __float_as_uint(fmaxf(imp, 0.f)) : 0u; T[i] = 0u; }
        int cnt[8];
#pragma unroll
        for (int i = 0; i < 8; ++i) cnt[i] = qb - 2;
        for (int bit = 30; bit >= 0; --bit) { int open_ = 0;
#pragma unroll
            for (int i = 0; i < 8; ++i) { const unsigned c = T[i] | (1u << bit); const int n = __popcll(__ballot(cand && bits[i] >= c)); if (n >= 13) { T[i] = c; cnt[i] = n; } open_ |= (cnt[i] != 13); }
            if (!open_) break; }
#pragma unroll
        for (int i = 0; i < 8; ++i) {
            const unsigned long long gt = __ballot(cand && bits[i] > T[i]); unsigned long long eq = __ballot(cand && bits[i] == T[i]);
            int need = 13 - __popcll(gt); unsigned long long take = 0ull;
            while (need > 0 && eq) { const unsigned long long low = eq & (0ull - eq); take |= low; eq ^= low; --need; }
            const unsigned long long mask = gt | take | 1ull | (1ull << qb) | (1ull << (qb - 1));
            if (L.lane == 0) P.selmask[(size_t)bh * SEQ + t0 + 8 * L.wid + i] = mask; }
    }
    __syncthreads();
}

__device__ __forceinline__ void sw_unit(int bh, int qb, const AttnPtrs& P, LAS unsigned char* lds, const Lane& L) {
    const int b = bh >> 1, h = bh & 1, t0 = qb * 64;
    const int ql = 8 * L.wid + (L.c >> 2), g = L.c & 3, tq = t0 + ql, head = 4 * h + g;
    const long tok = (long)b * SEQ + tq;
    bf16x8 qr[4]; load_q(qr, P.q, tok, head, L.hi);
    const unsigned long long selw = P.selmask[(size_t)bh * SEQ + tq];
    const float g1raw = bf2f(P.z[tok * INP + ZG + head * 3 + 1]), g2raw = bf2f(P.z[tok * INP + ZG + head * 3 + 2]);
    f32x16 r0, r1;
    {
        f32x16 o0, o1; float m = 0.f, l = 0.f;
#pragma unroll
        for (int r = 0; r < 16; ++r) { o0[r] = 0.f; o1[r] = 0.f; }
        run_branch<0>(o0, o1, m, l, P.ksel + (size_t)bh * SEQ * 64, P.vselt + (size_t)bh * SEQ * 64, 0, qb, qb, ql, selw, qr, lds, L);
        l = xsum32(l);
        const float sc = sigmoidf_(g1raw) * fast_rcp(l);
#pragma unroll
        for (int r = 0; r < 16; ++r) { r0[r] = o0[r] * sc; r1[r] = o1[r] * sc; }
    }
    {
        f32x16 o0, o1; float m = 0.f, l = 0.f;
#pragma unroll
        for (int r = 0; r < 16; ++r) { o0[r] = 0.f; o1[r] = 0.f; }
        run_branch<1>(o0, o1, m, l, P.kwin + (size_t)bh * SEQ * 64, P.vwint + (size_t)bh * SEQ * 64, qb >= 8 ? qb - 8 : 0, qb, qb, ql, 0ull, qr, lds, L);
        l = xsum32(l);
        const float sc = sigmoidf_(g2raw) * fast_rcp(l);
#pragma unroll
        for (int r = 0; r < 16; ++r) { r0[r] += o0[r] * sc; r1[r] += o1[r] * sc; }
    }
    store_o<true>(r0, r1, P.mix, tok, head, L.hi);
}
__device__ __forceinline__ void sw_unit2(int bh, int qb2, const AttnPtrs& P, LAS unsigned char* lds, const Lane& L) {
    const int b = bh >> 1, h = bh & 1, qbw = 2 * qb2 + (L.wid >> 2);
    const int qrela = 16 * (L.wid & 3) + (L.c >> 2), qrelb = qrela + 8, g = L.c & 3, head = 4 * h + g;
    const long toka = (long)b * SEQ + 64 * qbw + qrela, tokb = toka + 8;
    bf16x8 qa[4], qbf[4]; load_q(qa, P.q, toka, head, L.hi); load_q(qbf, P.q, tokb, head, L.hi);
    LAS unsigned long long* selp = (LAS unsigned long long*)(lds + 4 * TILE_LDS + 8192) + L.tid * 2;
    selp[0] = P.selmask[(size_t)bh * SEQ + 64 * qbw + qrela]; selp[1] = P.selmask[(size_t)bh * SEQ + 64 * qbw + qrelb];
    LAS float* gpark = (LAS float*)(lds + 4 * TILE_LDS) + L.tid * 4;
    gpark[0] = bf2f(P.z[toka * INP + ZG + head * 3 + 1]); gpark[1] = bf2f(P.z[tokb * INP + ZG + head * 3 + 1]); gpark[2] = bf2f(P.z[toka * INP + ZG + head * 3 + 2]); gpark[3] = bf2f(P.z[tokb * INP + ZG + head * 3 + 2]);
    {
        f32x16 oa0, oa1, ob0, ob1; SoftState sa{0.f, 0.f}, sb{0.f, 0.f};
#pragma unroll
        for (int r = 0; r < 16; ++r) { oa0[r] = 0.f; oa1[r] = 0.f; ob0[r] = 0.f; ob1[r] = 0.f; }
        run_branch2<0>(oa0, oa1, sa, ob0, ob1, sb, P.ksel + (size_t)bh * SEQ * 64, P.vselt + (size_t)bh * SEQ * 64, 0, 2 * qb2 + 1, qbw, qrela, selp, qa, qbf, lds, L);
        sa.l = xsum32(sa.l); sb.l = xsum32(sb.l);
        const float sca = sigmoidf_(gpark[0]) * fast_rcp(sa.l), scb = sigmoidf_(gpark[1]) * fast_rcp(sb.l);
#pragma unroll
        for (int r = 0; r < 16; ++r) { oa0[r] *= sca; oa1[r] *= sca; ob0[r] *= scb; ob1[r] *= scb; }
        { int qe = qrela; asm volatile("" : "+v"(qe));
          store_o<true>(oa0, oa1, P.mix, (long)b * SEQ + 64 * qbw + qe, head, L.hi); store_o<true>(ob0, ob1, P.mix, (long)b * SEQ + 64 * qbw + qe + 8, head, L.hi); }
    }
    {
        f32x16 oa0, oa1, ob0, ob1; SoftState sa{0.f, 0.f}, sb{0.f, 0.f};
#pragma unroll
        for (int r = 0; r < 16; ++r) { oa0[r] = 0.f; oa1[r] = 0.f; ob0[r] = 0.f; ob1[r] = 0.f; }
        run_branch2<1>(oa0, oa1, sa, ob0, ob1, sb, P.kwin + (size_t)bh * SEQ * 64, P.vwint + (size_t)bh * SEQ * 64, 2 * qb2 >= 8 ? 2 * qb2 - 8 : 0, 2 * qb2 + 1, qbw, qrela, selp, qa, qbf, lds, L);
        sa.l = xsum32(sa.l); sb.l = xsum32(sb.l);
        const float sca = sigmoidf_(gpark[2]) * fast_rcp(sa.l), scb = sigmoidf_(gpark[3]) * fast_rcp(sb.l);
#pragma unroll
        for (int r = 0; r < 16; ++r) { oa0[r] *= sca; oa1[r] *= sca; ob0[r] *= scb; ob1[r] *= scb; }
        { int qe = qrela; asm volatile("" : "+v"(qe));
          store_o<true>(oa0, oa1, P.mix, (long)b * SEQ + 64 * qbw + qe, head, L.hi); store_o<true>(ob0, ob1, P.mix, (long)b * SEQ + 64 * qbw + qe + 8, head, L.hi); }
    }
}
}
namespace epi {
using pg8::Unit; using pg8::BM; using pg8::HALF;
struct Bf16Plain {
    static constexpr bool PERM = true;
    bf16_t* O; int ldc;
    __device__ __forceinline__ void operator()(const f32x4 (&acc)[2][2][4][2], const Unit& u, int wr, int wc, int fr, int fq) const {
        const int row0 = u.pm * BM + wr * 64 + fr, col0 = u.pn * BM + wc * 32 + 8 * fq;
#pragma unroll
        for (int ai = 0; ai < 2; ++ai)
#pragma unroll
            for (int m = 0; m < 4; ++m) { bf16_t* rowp = O + (size_t)(row0 + ai * HALF + m * 16) * ldc + col0;
#pragma unroll
                for (int bj = 0; bj < 2; ++bj) { const f32x4 v0 = acc[ai][bj][m][0], v1 = acc[ai][bj][m][1];
                    u32x4 w; w.x = cvt_pk_bf16(v0[0], v0[1]); w.y = cvt_pk_bf16(v0[2], v0[3]); w.z = cvt_pk_bf16(v1[0], v1[1]); w.w = cvt_pk_bf16(v1[2], v1[3]);
                    *(u32x4*)(rowp + bj * HALF) = w; } }
    }
};
struct Bf16Sc1 {
    static constexpr bool PERM = true;
    bf16_t* O; int ldc; unsigned nbytes;
    __device__ __forceinline__ void operator()(const f32x4 (&acc)[2][2][4][2], const Unit& u, int wr, int wc, int fr, int fq) const {
        const __amdgpu_buffer_rsrc_t rsrc = __builtin_amdgcn_make_buffer_rsrc(O, 0, nbytes, 0x00020000);
        const int row0 = u.pm * BM + wr * 64 + fr, col0 = u.pn * BM + wc * 32 + 8 * fq;
#pragma unroll
        for (int ai = 0; ai < 2; ++ai)
#pragma unroll
            for (int m = 0; m < 4; ++m) { const unsigned off = (unsigned)(((size_t)(row0 + ai * HALF + m * 16) * ldc + col0) * 2);
#pragma unroll
                for (int bj = 0; bj < 2; ++bj) { const f32x4 v0 = acc[ai][bj][m][0], v1 = acc[ai][bj][m][1];
                    u32x4 w; w.x = cvt_pk_bf16(v0[0], v0[1]); w.y = cvt_pk_bf16(v0[2], v0[3]); w.z = cvt_pk_bf16(v1[0], v1[1]); w.w = cvt_pk_bf16(v1[2], v1[3]);
                    __builtin_amdgcn_raw_buffer_store_b128(w, rsrc, off + bj * HALF * 2, 0,   16); } }
    }
};
struct F32Grouped {
    static constexpr bool PERM = false;
    float* C; int ldc; size_t gstride;
    __device__ __forceinline__ void operator()(const f32x4 (&acc)[2][2][4][2], const Unit& u, int wr, int wc, int fr, int fq) const {
        const int row0 = u.pm * BM + wr * 64 + fr, col0 = u.pn * BM + wc * 32 + 4 * fq; float* Cg = C + (size_t)u.aux * gstride;
#pragma unroll
        for (int ai = 0; ai < 2; ++ai)
#pragma unroll
            for (int m = 0; m < 4; ++m) { float* rowp = Cg + (size_t)(row0 + ai * HALF + m * 16) * ldc + col0;
#pragma unroll
                for (int bj = 0; bj < 2; ++bj)
#pragma unroll
                    for (int n = 0; n < 2; ++n) *(f32x4*)(rowp + bj * HALF + n * 16) = acc[ai][bj][m][n]; }
    }
};
struct SwiGlu {
    static constexpr bool PERM = true;
    bf16_t* H; int ldc;
    __device__ __forceinline__ void operator()(const f32x4 (&acc)[2][2][4][2], const Unit& u, int wr, int wc, int fr, int fq) const {
        const int row0 = u.pm * BM + wr * 64 + fr, col0 = u.pn * HALF + wc * 32 + 8 * fq;
#pragma unroll
        for (int ai = 0; ai < 2; ++ai)
#pragma unroll
            for (int m = 0; m < 4; ++m) { bf16_t* rowp = H + (size_t)(row0 + ai * HALF + m * 16) * ldc + col0;
                float o[8];
#pragma unroll
                for (int n = 0; n < 2; ++n)
#pragma unroll
                    for (int e = 0; e < 4; ++e) o[4 * n + e] = siluf_(acc[ai][0][m][n][e]) * acc[ai][1][m][n][e];
                u32x4 w; w.x = cvt_pk_bf16(o[0], o[1]); w.y = cvt_pk_bf16(o[2], o[3]); w.z = cvt_pk_bf16(o[4], o[5]); w.w = cvt_pk_bf16(o[6], o[7]);
                *(u32x4*)rowp = w; }
    }
};
struct MoeDown {
    static constexpr bool PERM = true;
    bf16_t* Y; const int* row_tok;
    __device__ __forceinline__ void operator()(const f32x4 (&acc)[2][2][4][2], const Unit& u, int wr, int wc, int fr, int fq) const {
        const int srow0 = u.aux * BM + wr * 64 + fr, col0 = u.pn * BM + wc * 32 + 8 * fq;
        int dsts[8];
#pragma unroll
        for (int it = 0; it < 8; ++it) dsts[it] = row_tok[srow0 + (it >> 2) * HALF + (it & 3) * 16];
#pragma unroll
        for (int ai = 0; ai < 2; ++ai)
#pragma unroll
            for (int m = 0; m < 4; ++m) { const int dst = dsts[ai * 4 + m];
                if (dst >= 0) { bf16_t* rowp = Y + (size_t)dst * D + col0;
#pragma unroll
                    for (int bj = 0; bj < 2; ++bj) { const f32x4 v0 = acc[ai][bj][m][0], v1 = acc[ai][bj][m][1];
                        u32x4 w; w.x = cvt_pk_bf16(v0[0], v0[1]); w.y = cvt_pk_bf16(v0[2], v0[3]); w.z = cvt_pk_bf16(v1[0], v1[1]); w.w = cvt_pk_bf16(v1[2], v1[3]);
                        *(u32x4*)(rowp + bj * HALF) = w; } } }
    }
};
struct SigmoidBias {
    static constexpr bool PERM = true;
    bf16_t* O; int ldc; const float* bias;
    __device__ __forceinline__ void operator()(const f32x4 (&acc)[2][2][4][2], const Unit& u, int wr, int wc, int fr, int fq) const {
        const int row0 = u.pm * BM + wr * 64 + fr, col0 = u.pn * BM + wc * 32 + 8 * fq;
        f32x4 bv[2][2];
#pragma unroll
        for (int bj = 0; bj < 2; ++bj)
#pragma unroll
            for (int n = 0; n < 2; ++n) bv[bj][n] = *(const f32x4*)(bias + col0 + bj * HALF + 4 * n);
#pragma unroll
        for (int ai = 0; ai < 2; ++ai)
#pragma unroll
            for (int m = 0; m < 4; ++m) { bf16_t* rowp = O + (size_t)(row0 + ai * HALF + m * 16) * ldc + col0;
#pragma unroll
                for (int bj = 0; bj < 2; ++bj) { f32x4 v0 = acc[ai][bj][m][0] + bv[bj][0], v1 = acc[ai][bj][m][1] + bv[bj][1];
#pragma unroll
                    for (int e = 0; e < 4; ++e) { v0[e] = sigmoidf_(v0[e]); v1[e] = sigmoidf_(v1[e]); }
                    u32x4 w; w.x = cvt_pk_bf16(v0[0], v0[1]); w.y = cvt_pk_bf16(v0[2], v0[3]); w.z = cvt_pk_bf16(v1[0], v1[1]); w.w = cvt_pk_bf16(v1[2], v1[3]);
                    *(u32x4*)(rowp + bj * HALF) = w; } }
    }
};
struct MulBf16 {
    static constexpr bool PERM = true;
    bf16_t* O; const bf16_t* G; int ldc;
    __device__ __forceinline__ void operator()(const f32x4 (&acc)[2][2][4][2], const Unit& u, int wr, int wc, int fr, int fq) const {
        const int row0 = u.pm * BM + wr * 64 + fr, col0 = u.pn * BM + wc * 32 + 8 * fq;
        u32x4 gq[2], gn[2];
        { const size_t off = (size_t)row0 * ldc + col0; gn[0] = *(const u32x4*)(G + off); gn[1] = *(const u32x4*)(G + off + HALF); }
#pragma unroll
        for (int it = 0; it < 8; ++it) { const int ai = it >> 2, m = it & 3; const size_t off = (size_t)(row0 + ai * HALF + m * 16) * ldc + col0;
            gq[0] = gn[0]; gq[1] = gn[1];
            if (it < 7) { const int ai2 = (it + 1) >> 2, m2 = (it + 1) & 3; const size_t off2 = (size_t)(row0 + ai2 * HALF + m2 * 16) * ldc + col0; gn[0] = *(const u32x4*)(G + off2); gn[1] = *(const u32x4*)(G + off2 + HALF); }
#pragma unroll
            for (int bj = 0; bj < 2; ++bj) { const f32x4 v0 = acc[ai][bj][m][0], v1 = acc[ai][bj][m][1]; const u32x4 g4 = gq[bj];
                u32x4 w; w.x = cvt_pk_bf16(v0[0] * bflo(g4.x), v0[1] * bfhi(g4.x)); w.y = cvt_pk_bf16(v0[2] * bflo(g4.y), v0[3] * bfhi(g4.y));
                w.z = cvt_pk_bf16(v1[0] * bflo(g4.z), v1[1] * bfhi(g4.z)); w.w = cvt_pk_bf16(v1[2] * bflo(g4.w), v1[3] * bfhi(g4.w));
                *(u32x4*)(O + off + bj * HALF) = w; }
            asm volatile("" ::: "memory"); }
    }
};
struct S5Out {
    static constexpr bool PERM = true;
    bf16_t* ZS5; const bf16_t* Z; const float* dskip;
    __device__ __forceinline__ void operator()(const f32x4 (&acc)[2][2][4][2], const Unit& u, int wr, int wc, int fr, int fq) const {
        const int g = u.aux, row0 = u.pm * BM + wr * 64 + fr;
#pragma unroll
        for (int bj = 0; bj < 2; ++bj) { const int col = u.pn * BM + bj * HALF + wc * 32 + 8 * fq, jo = col >> 4, co0 = col & 15, ch0 = g * 16 + co0;
            const f32x4 d0 = *(const f32x4*)(dskip + ch0), d1 = *(const f32x4*)(dskip + ch0 + 4);
#pragma unroll
            for (int ai = 0; ai < 2; ++ai)
#pragma unroll
                for (int m = 0; m < 4; ++m) { const int mr = row0 + ai * HALF + m * 16; const long tok = (long)(mr >> 7) * SEQ + (mr & 127) * S5LC + jo;
                    const u32x4 uq = *(const u32x4*)(Z + tok * INP + ZS + ch0); const f32x4 v0 = acc[ai][bj][m][0], v1 = acc[ai][bj][m][1];
                    u32x4 w; w.x = cvt_pk_bf16(gelu_tanh(v0[0] + d0[0] * bflo(uq.x)), gelu_tanh(v0[1] + d0[1] * bfhi(uq.x)));
                    w.y = cvt_pk_bf16(gelu_tanh(v0[2] + d0[2] * bflo(uq.y)), gelu_tanh(v0[3] + d0[3] * bfhi(uq.y)));
                    w.z = cvt_pk_bf16(gelu_tanh(v1[0] + d1[0] * bflo(uq.z)), gelu_tanh(v1[1] + d1[1] * bfhi(uq.z)));
                    w.w = cvt_pk_bf16(gelu_tanh(v1[2] + d1[2] * bflo(uq.w)), gelu_tanh(v1[3] + d1[3] * bfhi(uq.w)));
                    *(u32x4*)(ZS5 + tok * 256 + ch0) = w; asm volatile("" ::: "memory"); } }
    }
};
struct S5Glu {
    static constexpr bool PERM = true;
    bf16_t* MIX; const bf16_t* ZS5; const float* bias;
    __device__ __forceinline__ void operator()(const f32x4 (&acc)[2][2][4][2], const Unit& u, int wr, int wc, int fr, int fq) const {
        const int row0 = u.pm * BM + wr * 64 + fr, col0 = wc * 32 + 8 * fq;
#pragma unroll
        for (int bj = 0; bj < 2; ++bj) { const int col = col0 + bj * HALF; const f32x4 b0 = *(const f32x4*)(bias + col), b1 = *(const f32x4*)(bias + col + 4);
#pragma unroll
            for (int ai = 0; ai < 2; ++ai)
#pragma unroll
                for (int m = 0; m < 4; ++m) { const size_t row = (size_t)(row0 + ai * HALF + m * 16); const u32x4 zq = *(const u32x4*)(ZS5 + row * 256 + col);
                    const f32x4 v0 = acc[ai][bj][m][0] + b0, v1 = acc[ai][bj][m][1] + b1;
                    u32x4 w; w.x = cvt_pk_bf16(bflo(zq.x) * sigmoidf_(v0[0]), bfhi(zq.x) * sigmoidf_(v0[1])); w.y = cvt_pk_bf16(bflo(zq.y) * sigmoidf_(v0[2]), bfhi(zq.y) * sigmoidf_(v0[3]));
                    w.z = cvt_pk_bf16(bflo(zq.z) * sigmoidf_(v1[0]), bfhi(zq.z) * sigmoidf_(v1[1])); w.w = cvt_pk_bf16(bflo(zq.w) * sigmoidf_(v1[2]), bfhi(zq.w) * sigmoidf_(v1[3]));
                    *(u32x4*)(MIX + row * 1024 + 768 + col) = w; asm volatile("" ::: "memory"); } }
    }
};
struct EpiWin {
    static constexpr bool PERM = true;
    bf16_t* Z; bf16_t* Q; bf16_t* KV; bf16_t* AP; const f32x2* rope;
    __device__ __forceinline__ void operator()(const f32x4 (&acc)[2][2][4][2], const Unit& u, int wr, int wc, int fr, int fq) const {
        const int row0 = u.pm * BM + wr * 64 + fr;
        if (u.pn >= 5) {
#pragma unroll
            for (int bj = 0; bj < 2; ++bj) { const int col0 = u.pn * BM + bj * HALF + wc * 32 + 8 * fq; const int sc0 = col0 - ZS; const bool s5 = (sc0 >= 0) && (sc0 < 256);
#pragma unroll
                for (int ai = 0; ai < 2; ++ai)
#pragma unroll
                    for (int m = 0; m < 4; ++m) { const int tok = row0 + ai * HALF + m * 16; const f32x4 v0 = acc[ai][bj][m][0], v1 = acc[ai][bj][m][1];
                        u32x4 w; w.x = cvt_pk_bf16(v0[0], v0[1]); w.y = cvt_pk_bf16(v0[2], v0[3]); w.z = cvt_pk_bf16(v1[0], v1[1]); w.w = cvt_pk_bf16(v1[2], v1[3]);
                        *(u32x4*)(Z + (size_t)tok * INP + col0) = w;
                        if (s5) { const int b = tok >> 12, t = tok & 4095; *(u32x4*)(AP + ((size_t)(sc0 >> 4) * 2048 + b * 128 + (t >> 5)) * S5K + (t & 31) * 16 + (sc0 & 15)) = w; } } }
            return;
        }
#pragma unroll
        for (int bj = 0; bj < 2; ++bj) {
            const int colh = bj * HALF + wc * 32 + 8 * fq;
            const int qi = 4 * (wc & 1) + fq, d1 = 4 * qi;
            const bool isv = (u.pn >= 2) && (bj == 1);
            f32x4 cn0 = (f32x4){0.f, 0.f, 0.f, 0.f}, cn1 = cn0;
            if (!isv) { cn0 = *(const f32x4*)(rope + (size_t)row0 * 32 + d1); cn1 = *(const f32x4*)(rope + (size_t)row0 * 32 + d1 + 2); }
#pragma unroll
            for (int it = 0; it < 8; ++it) { const int ai = it >> 2, m = it & 3; const int tok = row0 + ai * HALF + m * 16; const int b = tok >> 12, t = tok & 4095; const f32x4 x1 = acc[ai][bj][m][0], x2 = acc[ai][bj][m][1];
                    if (isv) { bf16_t* dst = KV + (size_t)((u.pn - 2) * 2 + 1) * (8u << 20) + ((size_t)(b * 2 + (wc >> 1)) * SEQ + t) * 64 + 32 * (wc & 1) + 8 * fq;
                        u32x4 w; w.x = cvt_pk_bf16(x1[0], x1[1]); w.y = cvt_pk_bf16(x1[2], x1[3]); w.z = cvt_pk_bf16(x2[0], x2[1]); w.w = cvt_pk_bf16(x2[2], x2[3]); *(u32x4*)dst = w; }
                    else { const f32x4 cs0 = cn0, cs1 = cn1;
                        if (it < 7) { const int tok2 = row0 + ((it + 1) >> 2) * HALF + ((it + 1) & 3) * 16; cn0 = *(const f32x4*)(rope + (size_t)tok2 * 32 + d1); cn1 = *(const f32x4*)(rope + (size_t)tok2 * 32 + d1 + 2); }
                        const float sc = (u.pn < 2) ? QSCALE : 1.0f;
                        const float o10 = (x1[0] * cs0[0] - x2[0] * cs0[1]) * sc, o11 = (x1[1] * cs0[2] - x2[1] * cs0[3]) * sc, o12 = (x1[2] * cs1[0] - x2[2] * cs1[1]) * sc, o13 = (x1[3] * cs1[2] - x2[3] * cs1[3]) * sc;
                        const float o20 = (x2[0] * cs0[0] + x1[0] * cs0[1]) * sc, o21 = (x2[1] * cs0[2] + x1[1] * cs0[3]) * sc, o22 = (x2[2] * cs1[0] + x1[2] * cs1[1]) * sc, o23 = (x2[3] * cs1[2] + x1[3] * cs1[3]) * sc;
                        bf16_t* dst = (u.pn < 2) ? Q + (size_t)tok * 512 + (u.pn * 4 + (colh >> 6)) * 64 + d1
                                                 : KV + (size_t)((u.pn - 2) * 2) * (8u << 20) + ((size_t)(b * 2 + (wc >> 1)) * SEQ + t) * 64 + d1;
                        u32x2 w1, w2; w1.x = cvt_pk_bf16(o10, o11); w1.y = cvt_pk_bf16(o12, o13); w2.x = cvt_pk_bf16(o20, o21); w2.y = cvt_pk_bf16(o22, o23);
                        *(u32x2*)dst = w1; *(u32x2*)(dst + 32) = w2; }
                    asm volatile("" ::: "memory"); }
        }
    }
};
}
constexpr size_t MiB = 1u << 20;
constexpr size_t WS_CTL = 0, CTL_ZERO_BYTES = 1 * MiB;
constexpr size_t WS_SMALL = 1 * MiB;
constexpr size_t SM_APOW = WS_SMALL;
constexpr size_t SM_BBAR = WS_SMALL + 5 * MiB / 4;
constexpr size_t SM_KTAB = WS_SMALL + 2 * MiB;
constexpr size_t SM_CMPB = WS_SMALL + 4 * MiB;
constexpr size_t SM_TOKE = WS_SMALL + 4 * MiB + 256 * 1024;
constexpr size_t SM_TOKW = WS_SMALL + 4 * MiB + 512 * 1024;
constexpr size_t SM_ROWTOK = WS_SMALL + 5 * MiB + 256 * 1024;
constexpr size_t SM_PCNT = WS_SMALL + 6 * MiB;
constexpr size_t SM_TILEEXP = WS_SMALL + 6 * MiB + 16384;
constexpr size_t WS_ROPE = 8 * MiB;
constexpr size_t WS_W = 24 * MiB;
constexpr size_t W_IN = WS_W;
constexpr size_t W_OUT = W_IN + (size_t)INP * D * 2;
constexpr size_t W_GATE = W_OUT + (size_t)D * D * 2;
constexpr size_t W_PROJ = W_GATE + (size_t)D * D * 2;
constexpr size_t W_CMP = W_PROJ + (size_t)D * PLE * 2;
constexpr size_t W_GLU = W_CMP + (size_t)2 * 512 * 1024 * 2;
constexpr size_t W_S5B = W_GLU + (size_t)256 * 256 * 2;
constexpr size_t W_S5S = W_S5B + (size_t)16 * 512 * S5K * 2;
constexpr size_t W_UP = W_S5S + (size_t)16 * 256 * 512 * 2;
constexpr size_t W_DN = W_UP + (size_t)NEXP * 2 * DFE * D * 2;
constexpr size_t W_END_ = W_DN + (size_t)NEXP * D * DFE * 2;
static_assert(W_END_ <= WS_W + 240 * MiB, "weight region");
constexpr size_t WS_XB = 264 * MiB;
constexpr size_t WS_PB = 392 * MiB;
constexpr size_t WS_Z = 424 * MiB;
constexpr size_t WS_QKV = 712 * MiB;
constexpr size_t WS_Q = WS_QKV, WS_KCMP = WS_QKV + 64 * MiB, WS_VCMP = WS_KCMP + 16 * MiB, WS_KSEL = WS_VCMP + 16 * MiB, WS_VSEL = WS_KSEL + 16 * MiB, WS_KWIN = WS_VSEL + 16 * MiB, WS_VWIN = WS_KWIN + 16 * MiB;
constexpr size_t WS_MIX = 872 * MiB;
constexpr size_t WS_CMP = 1000 * MiB;
constexpr size_t WS_CMPP = WS_CMP, WS_KC = WS_CMP + 32 * MiB, WS_VCT = WS_KC + 1 * MiB, WS_SELM = WS_VCT + 1 * MiB;
constexpr size_t WS_S5 = 1036 * MiB;
constexpr size_t WS_S5A = WS_S5, WS_S5S = WS_S5 + 40 * MiB, WS_ZS5 = WS_S5S + 32 * MiB;
constexpr size_t WS_HBUF = 1140 * MiB;
constexpr size_t WS_END = 1268 * MiB;
constexpr size_t WS_FFH = WS_Z, WS_XS = WS_Z, WS_MH = WS_Z + 260 * MiB, WS_YB = WS_MH + 224 * MiB;
static_assert(WS_YB + 256 * MiB <= WS_END && WS_FFH + (size_t)T * DFF * 2 <= WS_MIX, "overlays");
constexpr size_t WS_PLEG = WS_Z, WS_PLEH = WS_Z + 128 * MiB;
static_assert(WS_PLEH + 128 * MiB <= WS_MH, "per-layer-embedding buffers of the MoE layers");
constexpr int CW_BAR = 4096;
constexpr int CW_TMO = 64;
constexpr int CW_CNT = 16384, CNT_BANK = 256 * 64;
static_assert((CW_CNT + 8 * CNT_BANK) * 4 <= (int)CTL_ZERO_BYTES, "panel counters inside the per-call memset");

struct Args { const void* in[36]; float* out; unsigned char* ws; int gp_lo, gp_hi, use_bar, pad; };
struct Frame { LAS unsigned char* lds; int tid, lane, wave, G, bid; };
constexpr int RING_BYTES = 131072, LDSCTL_OFF = RING_BYTES, LDS_BYTES = 147456;
typedef __attribute__((address_space(4))) const Args CArgs;
__device__ __forceinline__ void load_args(Args& a) { CArgs* p = (CArgs*)__builtin_amdgcn_kernarg_segment_ptr(); asm volatile("" : "+s"(p)); __builtin_memcpy(&a, p, sizeof(Args)); }
__device__ __forceinline__ Frame make_frame(LAS unsigned char* lds, int wave0) { Frame F; F.lds = lds;
    int w = wave0; asm volatile("" : "+s"(w)); int ln = lane_id_fresh(); F.lane = ln; F.wave = w; F.tid = w * 64 + ln;
    int b = blockIdx.x, g = gridDim.x; asm volatile("" : "+s"(b), "+s"(g)); F.bid = b; F.G = g; return F; }

__constant__ double c_invfreq_rev[32] = {0.15915494309189535, 0.11934937021124886, 0.08949940160889101, 0.06711508300522726, 0.050329212104487035, 0.03774158471741977, 0.0283021958306234, 0.02122365276477766, 0.015915494309189534, 0.011934937021124886, 0.008949940160889102, 0.006711508300522725, 0.005032921210448704, 0.003774158471741977, 0.00283021958306234, 0.0021223652764777662, 0.0015915494309189536, 0.0011934937021124885, 0.0008949940160889102, 0.0006711508300522726, 0.0005032921210448703, 0.00037741584717419774, 0.00028302195830623395, 0.0002122365276477766, 0.00015915494309189535, 0.00011934937021124886, 8.949940160889102e-05, 6.711508300522725e-05, 5.0329212104487035e-05, 3.774158471741978e-05, 2.8302195830623396e-05, 2.122365276477766e-05};

__device__ __forceinline__ void sincos_rev(double rev, float& c, float& s) { const double fr = rev - __builtin_floor(rev); const float f = (float)fr; s = __builtin_amdgcn_sinf(f); c = __builtin_amdgcn_cosf(f); }

template <class Sched>
__device__ __forceinline__ void panels_publish_wait(const Frame& F, unsigned* ctl, int bank, const Sched& S, unsigned need) {
    unsigned* cnt = ctl + CW_CNT + bank * CNT_BANK;
    if (F.tid == 0) { pg8::Unit u; for (int i = 0; S.next(i, u); ++i) __hip_atomic_fetch_add(cnt + 64 * u.pm, 1u, __ATOMIC_RELAXED, __HIP_MEMORY_SCOPE_AGENT); }
    if (F.wave == 0) {
        for (int pm = F.bid; pm < T / 256; pm += F.G) { unsigned spins = 0;
            while ((unsigned)__builtin_amdgcn_readfirstlane(__hip_atomic_load(cnt + 64 * pm, __ATOMIC_RELAXED, __HIP_MEMORY_SCOPE_AGENT)) < need) {
                __builtin_amdgcn_s_sleep(1);
                if (++spins > (1u << 22)) { if (F.lane == 0) __hip_atomic_store(ctl + CW_TMO, 1u, __ATOMIC_RELAXED, __HIP_MEMORY_SCOPE_AGENT); break; }
                if ((spins & 1023u) == 0u && __builtin_amdgcn_readfirstlane(__hip_atomic_load(ctl + CW_TMO, __ATOMIC_RELAXED, __HIP_MEMORY_SCOPE_AGENT))) break; } }
        __builtin_amdgcn_fence(__ATOMIC_ACQUIRE, "agent");
        asm volatile("s_waitcnt vmcnt(0)" ::: "memory");
    }
    __syncthreads();
}
__device__ __forceinline__ void phase_init0(const Frame& F, const Args& a) {
    const size_t gt = (size_t)F.bid * 512 + F.tid, NT = (size_t)F.G * 512;
    const int* pos = (const int*)a.in[2]; f32x2* rope = (f32x2*)(a.ws + WS_ROPE);
    for (size_t i = gt; i < (size_t)T * 32; i += NT) { const int tok = (int)(i >> 5), k = (int)(i & 31); float c, s; sincos_rev((double)pos[tok] * c_invfreq_rev[k], c, s); rope[i] = (f32x2){c, s}; }
    const float* are = (const float*)a.in[14]; const float* aim = (const float*)a.in[15]; const float* ldt = (const float*)a.in[16];
    const float* bre = (const float*)a.in[17]; const float* bim = (const float*)a.in[18];
    f32x2* apow = (f32x2*)(a.ws + SM_APOW); f32x2* bbar = (f32x2*)(a.ws + SM_BBAR);
    for (size_t i = gt; i < (size_t)DEPTH * 16 * 64 * 34; i += NT) { const int k = (int)(i % 34), lgn = (int)(i / 34), lg = lgn >> 6;
        const float dt = __expf(ldt[lg]); const float ar = are[lgn] * dt; const double rev = (double)k * ((double)aim[lgn] * (double)dt) * 0.15915494309189535;
        float c, s; sincos_rev(rev, c, s); const float mg = __expf((float)k * ar); apow[i] = (f32x2){mg * c, mg * s}; }
    for (size_t i = gt; i < (size_t)DEPTH * 16 * 64 * 16; i += NT) { const int lgn = (int)(i >> 4), lg = lgn >> 6;
        const float dt = __expf(ldt[lg]); const float lr = are[lgn], li = aim[lgn]; const double rev = ((double)li * (double)dt) * 0.15915494309189535;
        float c, s; sincos_rev(rev, c, s); const float mg = __expf(lr * dt); const float abr = mg * c, abi = mg * s, den = lr * lr + li * li;
        const float cr = ((abr - 1.0f) * lr + abi * li) / den, ci = (abi * lr - (abr - 1.0f) * li) / den;
        const float br = bre[i], bi = bim[i]; bbar[i] = (f32x2){cr * br - ci * bi, cr * bi + ci * br}; }
    const f32x4* x4 = (const f32x4*)a.in[0]; u32x2* xb = (u32x2*)(a.ws + WS_XB);
    for (size_t i = gt; i < (size_t)T * D / 4; i += 4 * NT) { f32x4 v[4];
#pragma unroll
        for (int q = 0; q < 4; ++q) { const size_t ii = i + q * NT; v[q] = (ii < (size_t)T * D / 4) ? x4[ii] : (f32x4){0.f, 0.f, 0.f, 0.f}; }
#pragma unroll
        for (int q = 0; q < 4; ++q) { const size_t ii = i + q * NT; if (ii < (size_t)T * D / 4) { u32x2 w; w.x = cvt_pk_bf16(v[q][0], v[q][1]); w.y = cvt_pk_bf16(v[q][2], v[q][3]); xb[ii] = w; } } }
}
__device__ __forceinline__ void phase_init1(const Frame& F, const Args& a) {
    const size_t gt = (size_t)F.bid * 512 + F.tid, NT = (size_t)F.G * 512;
    const float* cre = (const float*)a.in[19]; const float* cim = (const float*)a.in[20];
    const f32x2* apow = (const f32x2*)(a.ws + SM_APOW); const f32x2* bbar = (const f32x2*)(a.ws + SM_BBAR); float* ktab = (float*)(a.ws + SM_KTAB);
    for (size_t i = gt; i < (size_t)DEPTH * 16 * 32 * 256; i += NT) { const int ci = (int)(i & 15), co = (int)((i >> 4) & 15), tau = (int)((i >> 8) & 31), lg = (int)(i >> 13);
        float acc = 0.f;
        for (int n = 0; n < 64; ++n) { const f32x2 P = apow[((size_t)lg * 64 + n) * 34 + tau], Bb = bbar[((size_t)lg * 64 + n) * 16 + ci]; const float cr = cre[((size_t)lg * 16 + co) * 64 + n], cm = cim[((size_t)lg * 16 + co) * 64 + n];
            const float hr = P.x * Bb.x - P.y * Bb.y, hi = P.x * Bb.y + P.y * Bb.x; acc += cr * hr - cm * hi; }
        ktab[i] = acc; }
}

__device__ __forceinline__ void transpose_item(const float* W, int ldw, int k0, int n0, int nvalid, bf16_t* dstrow, int dst_ld, LAS float* scr, int lane, int permhi) {
    float tv[32];
#pragma unroll
    for (int i = 0; i < 32; ++i) { const int kk = 2 * i + (lane >> 5), nn = lane & 31; tv[i] = (nn < nvalid) ? W[(size_t)(k0 + kk) * ldw + n0 + nn] : 0.f; }
#pragma unroll
    for (int i = 0; i < 32; ++i) { const int kk = 2 * i + (lane >> 5), nn = lane & 31; scr[kk * 33 + nn] = tv[i]; }
    LDS_WAIT(); asm volatile("" ::: "memory");
    const int c = lane & 7;
#pragma unroll
    for (int j = 0; j < 4; ++j) { const int n = (lane >> 3) + 8 * j; const LAS float* s = scr + (8 * c) * 33 + n;
        u32x4 o; o.x = cvt_pk_bf16(s[0 * 33], s[1 * 33]); o.y = cvt_pk_bf16(s[2 * 33], s[3 * 33]); o.z = cvt_pk_bf16(s[4 * 33], s[5 * 33]); o.w = cvt_pk_bf16(s[6 * 33], s[7 * 33]);
        const int drow = permhi < 0 ? n : (8 * (n >> 2) + 4 * permhi + (n & 3));
        if (n < nvalid) *(u32x4*)(dstrow + (size_t)drow * dst_ld + 8 * c) = o; }
    LDS_WAIT(); asm volatile("" ::: "memory");
}
__device__ __forceinline__ void transpose_mat(const float* W, int K, int N, bf16_t* dst, int dst_ld, int mode, LAS float* scr, int lane, int& cursor, int gw, int NGW) {
    const int nblk = (N + 31) / 32, items = (K / 64) * nblk;
    int it = ((gw - cursor) % NGW + NGW) % NGW;
    for (; it < items; it += NGW) { const int kb = it / nblk, nb = it % nblk, k0 = 64 * kb, n0 = 32 * nb; const int nv = (N - n0) < 32 ? (N - n0) : 32;
        int drow = n0, permhi = -1;
        if (mode == 1 || mode == 2) drow = (n0 >> 7) * 256 + (n0 & 127) + (mode == 2 ? 128 : 0);
        if (mode == 3 && (n0 < 512 || (n0 < 1280 && (((n0 - 512) >> 7) & 1) == 0))) { drow = n0 & ~63; permhi = (n0 >> 5) & 1; }
        transpose_item(W, N, k0, n0, nv, dst + (size_t)drow * dst_ld + k0, dst_ld, scr, lane, permhi); }
    cursor = (cursor + items) % NGW;
}

__device__ __forceinline__ void phase_prep(const Frame& F, const Args& a, int l) {
    LAS float* scr = (LAS float*)(F.lds + F.wave * 16384);
    const int gw = F.bid * 8 + F.wave, NGW = F.G * 8; int cursor = 0;
    unsigned char* ws = a.ws;
    transpose_mat((const float*)a.in[3] + (size_t)l * D * INW, D, INW, (bf16_t*)(ws + W_IN), D, 3, scr, F.lane, cursor, gw, NGW);
    transpose_mat((const float*)a.in[4] + (size_t)l * D * D, D, D, (bf16_t*)(ws + W_OUT), D, 0, scr, F.lane, cursor, gw, NGW);
    transpose_mat((const float*)a.in[31] + (size_t)l * D * D, D, D, (bf16_t*)(ws + W_GATE), D, 0, scr, F.lane, cursor, gw, NGW);
    transpose_mat((const float*)a.in[33] + (size_t)l * PLE * D, PLE, D, (bf16_t*)(ws + W_PROJ), PLE, 0, scr, F.lane, cursor, gw, NGW);
    for (int j = 0; j < 2; ++j) { const float* w1 = (const float*)a.in[6] + ((size_t)l * 2 + j) * 2048 * 256; bf16_t* dst = (bf16_t*)(ws + W_CMP) + (size_t)j * 512 * 1024;
        transpose_mat(w1, 1024, 256, dst, 1024, 0, scr, F.lane, cursor, gw, NGW);
        transpose_mat(w1 + (size_t)1024 * 256, 1024, 256, dst + (size_t)256 * 1024, 1024, 0, scr, F.lane, cursor, gw, NGW); }
    transpose_mat((const float*)a.in[22] + (size_t)l * 256 * 256, 256, 256, (bf16_t*)(ws + W_GLU), 256, 0, scr, F.lane, cursor, gw, NGW);
    const int j2 = l >> 1;
    if ((l & 1) == 0) {
        transpose_mat((const float*)a.in[24] + (size_t)j2 * D * DFF, D, DFF, (bf16_t*)(ws + W_UP), D, 1, scr, F.lane, cursor, gw, NGW);
        transpose_mat((const float*)a.in[25] + (size_t)j2 * D * DFF, D, DFF, (bf16_t*)(ws + W_UP), D, 2, scr, F.lane, cursor, gw, NGW);
        transpose_mat((const float*)a.in[26] + (size_t)j2 * DFF * D, DFF, D, (bf16_t*)(ws + W_DN), DFF, 0, scr, F.lane, cursor, gw, NGW);
    } else {
        for (int e = 0; e < NEXP; ++e) { const size_t eo = (size_t)j2 * NEXP + e;
            transpose_mat((const float*)a.in[28] + eo * D * DFE, D, DFE, (bf16_t*)(ws + W_UP) + (size_t)e * 2 * DFE * D, D, 1, scr, F.lane, cursor, gw, NGW);
            transpose_mat((const float*)a.in[29] + eo * D * DFE, D, DFE, (bf16_t*)(ws + W_UP) + (size_t)e * 2 * DFE * D, D, 2, scr, F.lane, cursor, gw, NGW);
            transpose_mat((const float*)a.in[30] + eo * DFE * D, DFE, D, (bf16_t*)(ws + W_DN) + (size_t)e * D * DFE, DFE, 0, scr, F.lane, cursor, gw, NGW); }
    }
    const size_t gt = (size_t)F.bid * 512 + F.tid, NT = (size_t)F.G * 512;
    {
        u32x4* zp = (u32x4*)((bf16_t*)(ws + W_IN) + (size_t)INW * D); const size_t n16 = (size_t)(INP - INW) * D * 2 / 16;
        unsigned zz = 0u; asm volatile("" : "+v"(zz));
        for (size_t i = gt; i < n16; i += NT) zp[i] = (u32x4){zz, zz, zz, zz};
    }
    {
        const f32x4* p4 = (const f32x4*)((const float*)a.in[1] + (size_t)l * T * PLE); u32x2* pb = (u32x2*)(ws + WS_PB);
        for (size_t i = gt; i < (size_t)T * PLE / 4; i += 4 * NT) { f32x4 v[4];
#pragma unroll
            for (int q = 0; q < 4; ++q) { const size_t ii = i + q * NT; v[q] = (ii < (size_t)T * PLE / 4) ? p4[ii] : (f32x4){0.f, 0.f, 0.f, 0.f}; }
#pragma unroll
            for (int q = 0; q < 4; ++q) { const size_t ii = i + q * NT; if (ii < (size_t)T * PLE / 4) { u32x2 w; w.x = cvt_pk_bf16(v[q][0], v[q][1]); w.y = cvt_pk_bf16(v[q][2], v[q][3]); pb[ii] = w; } } }
    }
    {
        const float* ktab = (const float*)(ws + SM_KTAB) + (size_t)l * 16 * 32 * 256; const f32x2* apow = (const f32x2*)(ws + SM_APOW) + (size_t)l * 16 * 64 * 34; const f32x2* bbar = (const f32x2*)(ws + SM_BBAR) + (size_t)l * 16 * 64 * 16;
        const float* cre = (const float*)a.in[19] + (size_t)l * 16 * 16 * 64; const float* cim = (const float*)a.in[20] + (size_t)l * 16 * 16 * 64;
        bf16_t* Bt = (bf16_t*)(ws + W_S5B);
        for (size_t i = gt; i < (size_t)16 * 512 * S5K; i += NT) { const int k = (int)(i % S5K), row = (int)((i / S5K) & 511), g = (int)(i / ((size_t)S5K * 512)); const int jo = row >> 4, co = row & 15;
            float v;
            if (k < 512) { const int ji = k >> 4, ci = k & 15; v = (jo >= ji) ? ktab[(((size_t)g * 32 + (jo - ji)) * 16 + co) * 16 + ci] : 0.f; }
            else { const int n = (k - 512) & 63; const f32x2 P = apow[((size_t)g * 64 + n) * 34 + jo + 1]; const float cr = cre[((size_t)g * 16 + co) * 64 + n], cm = cim[((size_t)g * 16 + co) * 64 + n];
                v = (k < 576) ? (cr * P.x - cm * P.y) : -(cr * P.y + cm * P.x); }
            Bt[i] = f2bf(v); }
        bf16_t* St = (bf16_t*)(ws + W_S5S);
        for (size_t i = gt; i < (size_t)16 * 256 * 512; i += NT) { const int k = (int)(i & 511), np = (int)((i >> 9) & 255), g = (int)(i >> 17); const int j = k >> 4, ci = k & 15;
            float v = 0.f;
            if (np < 128) { const int n = np & 63; const f32x2 P = apow[((size_t)g * 64 + n) * 34 + (S5LC - 1 - j)], Bb = bbar[((size_t)g * 64 + n) * 16 + ci]; v = (np < 64) ? (P.x * Bb.x - P.y * Bb.y) : (P.x * Bb.y + P.y * Bb.x); }
            St[i] = f2bf(v); }
    }
    {
        float* cb = (float*)(ws + SM_CMPB); LAS float* red = (LAS float*)(F.lds + 8 * 16384 - 4096);
        for (int o = F.bid; o < 8; o += F.G) { const int j = o >> 2, cblk = o & 3; const float* w1 = (const float*)a.in[6] + ((size_t)l * 2 + j) * 2048 * 256 + cblk * 64 + F.lane; const float* pe = (const float*)a.in[5] + ((size_t)l * 2 + j) * 2048;
            float s0 = 0.f, s1 = 0.f, s2 = 0.f, s3 = 0.f;
#pragma unroll 4
            for (int k = 256 * F.wave; k < 256 * F.wave + 256; k += 4) { s0 += pe[k] * w1[(size_t)k * 256]; s1 += pe[k + 1] * w1[(size_t)(k + 1) * 256]; s2 += pe[k + 2] * w1[(size_t)(k + 2) * 256]; s3 += pe[k + 3] * w1[(size_t)(k + 3) * 256]; }
            __syncthreads(); red[F.wave * 64 + F.lane] = (s0 + s1) + (s2 + s3); __syncthreads();
            if (F.wave == 0) { float t = ((const float*)a.in[7])[((size_t)l * 2 + j) * 256 + cblk * 64 + F.lane];
#pragma unroll
                for (int w = 0; w < 8; ++w) t += red[w * 64 + F.lane];
                cb[j * 256 + cblk * 64 + F.lane] = t; }
            __syncthreads(); }
    }
}

__device__ __forceinline__ void conv_items(const Frame& F, const Args& a, int l, int first, int stride, int last = NB * (SEQ / 32)) {
    const bf16_t* z = (const bf16_t*)(a.ws + WS_Z); bf16_t* mix = (bf16_t*)(a.ws + WS_MIX);
    const float* cw = (const float*)a.in[10] + (size_t)l * 31 * 256; const float* cb = (const float*)a.in[11] + (size_t)l * 256;
    const float* lg = (const float*)a.in[12] + (size_t)l * 256; const float* lb = (const float*)a.in[13] + (size_t)l * 256;
    LAS float* U = (LAS float*)F.lds;
    LAS float* Y = (LAS float*)(F.lds + 65536);
    const int cp = F.tid & 127, tg = F.tid >> 7, c = 2 * cp;
    f32x2 w[31];
#pragma unroll
    for (int j = 0; j < 31; ++j) w[j] = *(const f32x2*)(cw + j * 256 + c);
    const f32x2 bias = *(const f32x2*)(cb + c);
    unsigned pva[16], pvg[16];
    auto fetch = [&](int it) { const int b = it >> 7, t0 = (it & 127) * 32;
#pragma unroll
        for (int q = 0; q < 16; ++q) { const int r = tg + 4 * q, t = t0 - 30 + r; pva[q] = 0u; pvg[q] = 0u;
            if (r < 62 && t >= 0) { const bf16_t* zr = z + ((size_t)b * SEQ + t) * INP + ZC; pva[q] = *(const unsigned*)(zr + c); pvg[q] = *(const unsigned*)(zr + 256 + c); } } };
    if (first < last) fetch(first);
    for (int it = first; it < last; it += stride) { const int b = it >> 7, t0 = (it & 127) * 32;
#pragma unroll
        for (int q = 0; q < 16; ++q) { const int r = tg + 4 * q, t = t0 - 30 + r;
            if (r < 62) { f32x2 u = (f32x2){0.f, 0.f}; if (t >= 0) u = (f32x2){bflo(pva[q]) * sigmoidf_(bflo(pvg[q])), bfhi(pva[q]) * sigmoidf_(bfhi(pvg[q]))};
                *(LAS f32x2*)(U + r * 256 + c) = u; } }
        if (it + stride < last) fetch(it + stride);
        __syncthreads();
        {   f32x2 acc[8];
#pragma unroll
            for (int i = 0; i < 8; ++i) acc[i] = bias;
#pragma unroll
            for (int k = 0; k < 38; ++k) { const f32x2 u = *(const LAS f32x2*)(U + (tg * 8 + k) * 256 + c);
#pragma unroll
                for (int i = 0; i < 8; ++i) { const int j = k - i; if (j >= 0 && j < 31) acc[i] += w[j] * u; } }
#pragma unroll
            for (int i = 0; i < 8; ++i) *(LAS f32x2*)(Y + (tg * 8 + i) * 256 + c) = acc[i];
        }
        __syncthreads();
        for (int i = 0; i < 4; ++i) { const int tl = F.wave * 4 + i; const f32x4 v = *(const LAS f32x4*)(Y + tl * 256 + F.lane * 4);
            const float mean = wave_sum((v[0] + v[1]) + (v[2] + v[3])) * (1.f / 256.f); const f32x4 dlt = v - mean;
            const float var = wave_sum((dlt[0] * dlt[0] + dlt[1] * dlt[1]) + (dlt[2] * dlt[2] + dlt[3] * dlt[3])) * (1.f / 256.f); const float rstd = 1.0f / sqrtf(var + LN_EPS);
            const f32x4 gg = *(const f32x4*)(lg + F.lane * 4), bb = *(const f32x4*)(lb + F.lane * 4);
            float o[4];
#pragma unroll
            for (int e = 0; e < 4; ++e) o[e] = siluf_(dlt[e] * rstd * gg[e] + bb[e]);
            u32x2 wv; wv.x = cvt_pk_bf16(o[0], o[1]); wv.y = cvt_pk_bf16(o[2], o[3]);
            *(u32x2*)(mix + ((size_t)b * SEQ + t0 + tl) * 1024 + 512 + F.lane * 4) = wv; }
        __syncthreads();
    }
}
__device__ __forceinline__ void cmp_stage2(const Frame& F, const Args& a, int l) {
    unsigned char* ws = a.ws; const float* cb = (const float*)(ws + SM_CMPB);
    LAS float* w2s = (LAS float*)F.lds;
    LAS float* hs = (LAS float*)(F.lds + 65536 + F.wave * 1024);
    const int gw = F.bid * 8 + F.wave, NGW = F.G * 8, lane = F.lane;
    for (int j = 0; j < 2; ++j) {
        const float* w2 = (const float*)a.in[8] + ((size_t)l * 2 + j) * 256 * 64; const float* b2 = (const float*)a.in[9] + ((size_t)l * 2 + j) * 64;
        __syncthreads();
        for (int i = F.tid; i < 256 * 64 / 4; i += 512) *(LAS f32x4*)(w2s + 4 * i) = *(const f32x4*)(w2 + 4 * i);
        __syncthreads();
        for (int it = gw; it < 32 * 256; it += NGW) { const int bh = it >> 8, n = it & 255;
            float outv = 0.f;
            if (n < NCMP) {
                const float* P = (const float*)(ws + WS_CMPP) + (size_t)j * 8192 * 512 + ((size_t)bh * 256 + n) * 512;
                const f32x4 p0 = *(const f32x4*)(P + lane * 4), p1 = *(const f32x4*)(P + 512 + 256 + lane * 4), bb = *(const f32x4*)(cb + j * 256 + lane * 4);
                f32x4 hv;
#pragma unroll
                for (int e = 0; e < 4; ++e) hv[e] = gelu_tanh(p0[e] + p1[e] + bb[e]);
                *(LAS f32x4*)(hs + lane * 4) = hv; LDS_WAIT(); asm volatile("" ::: "memory");
                float acc0 = b2[lane], acc1 = 0.f, acc2 = 0.f, acc3 = 0.f;
#pragma unroll 4
                for (int c = 0; c < 256; c += 4) { const f32x4 h4 = *(const LAS f32x4*)(hs + c);
                    acc0 += h4[0] * w2s[c * 64 + lane]; acc1 += h4[1] * w2s[(c + 1) * 64 + lane]; acc2 += h4[2] * w2s[(c + 2) * 64 + lane]; acc3 += h4[3] * w2s[(c + 3) * 64 + lane]; }
                outv = (acc0 + acc1) + (acc2 + acc3); LDS_WAIT(); asm volatile("" ::: "memory");
            }
            if (j == 0) ((bf16_t*)(ws + WS_KC))[((size_t)bh * 256 + n) * 64 + lane] = f2bf(outv);
            else ((bf16_t*)(ws + WS_VCT))[((size_t)bh * 4 + (n >> 6)) * 4096 + lane * 64 + nsa::vslot(n & 63)] = f2bf(outv);
        }
    }
    __syncthreads();
}
__device__ __forceinline__ void cmp_stage2_panel(const Frame& F, const Args& a, int l, int j, int bh) {
    constexpr int HP = 528;
    unsigned char* ws = a.ws; const float* cb = (const float*)(ws + SM_CMPB);
    LAS unsigned char* Hs = F.lds;
    LAS unsigned char* Ws = F.lds + 128 * HP;
    const int lane = F.lane, w = F.wave;
    const float* w2 = (const float*)a.in[8] + ((size_t)l * 2 + j) * 256 * 64; const float* b2 = (const float*)a.in[9] + ((size_t)l * 2 + j) * 64;
    const float* Pb = (const float*)(ws + WS_CMPP) + (size_t)j * 8192 * 512 + (size_t)bh * 256 * 512;
    __syncthreads();
    for (int i = F.tid; i < 256 * 64; i += 512) { const int c = i >> 6, d = i & 63; *(LAS bf16_t*)(Ws + d * HP + c * 2) = f2bf(w2[i]); }
    const f32x4 bb = *(const f32x4*)(cb + j * 256 + lane * 4);
    for (int half = 0; half < 2; ++half) {
        __syncthreads();
#pragma unroll 4
        for (int rr = 0; rr < 16; ++rr) { const int r = 16 * w + rr, n = half * 128 + r, n1 = n < 255 ? n + 1 : n;
            const f32x4 p0 = *(const f32x4*)(Pb + (size_t)n * 512 + lane * 4), p1 = *(const f32x4*)(Pb + (size_t)n1 * 512 + 256 + lane * 4);
            u32x2 hv; hv.x = cvt_pk_bf16(gelu_tanh(p0[0] + p1[0] + bb[0]), gelu_tanh(p0[1] + p1[1] + bb[1])); hv.y = cvt_pk_bf16(gelu_tanh(p0[2] + p1[2] + bb[2]), gelu_tanh(p0[3] + p1[3] + bb[3]));
            *(LAS u32x2*)(Hs + r * HP + lane * 8) = hv; }
        __syncthreads();
        f32x4 acc[4];
#pragma unroll
        for (int cbk = 0; cbk < 4; ++cbk) acc[cbk] = (f32x4){0.f, 0.f, 0.f, 0.f};
        const LAS unsigned char* ap = Hs + (16 * w + (lane & 15)) * HP + (lane >> 4) * 16;
        const LAS unsigned char* bp = Ws + (lane & 15) * HP + (lane >> 4) * 16;
#pragma unroll
        for (int ks = 0; ks < 8; ++ks) { const bf16x8 af = *(const LAS bf16x8*)(ap + ks * 64);
#pragma unroll
            for (int cbk = 0; cbk < 4; ++cbk) { const bf16x8 bf = *(const LAS bf16x8*)(bp + cbk * 16 * HP + ks * 64); acc[cbk] = __builtin_amdgcn_mfma_f32_16x16x32_bf16(af, bf, acc[cbk], 0, 0, 0); } }
#pragma unroll
        for (int cbk = 0; cbk < 4; ++cbk) { const int d = 16 * cbk + (lane & 15); const float bv = b2[d];
#pragma unroll
            for (int e = 0; e < 4; ++e) { const int n = half * 128 + 16 * w + 4 * (lane >> 4) + e; const float outv = n < NCMP ? acc[cbk][e] + bv : 0.f;
                if (j == 0) ((bf16_t*)(ws + WS_KC))[((size_t)bh * 256 + n) * 64 + d] = f2bf(outv);
                else ((bf16_t*)(ws + WS_VCT))[((size_t)bh * 4 + (n >> 6)) * 4096 + d * 64 + nsa::vslot(n & 63)] = f2bf(outv); } }
    }
    __syncthreads();
}
__device__ __forceinline__ void s5_carry_panel(const Frame& F, const Args& a, int l, int g, int pm) {
    unsigned char* ws = a.ws; const f32x2* apow = (const f32x2*)(ws + SM_APOW) + (size_t)l * 16 * 64 * 34;
    const float* S = (const float*)(ws + WS_S5S); bf16_t* ap = (bf16_t*)(ws + WS_S5A);
    if (F.tid < 128) { const int n = F.tid & 63, b = 2 * pm + (F.tid >> 6);
        const f32x2 A = apow[((size_t)g * 64 + n) * 34 + S5LC]; float hr = 0.f, hi = 0.f;
        const float* sp = S + ((size_t)g * 2048 + b * 128) * 256 + n; bf16_t* dp = ap + ((size_t)g * 2048 + b * 128) * S5K + 512 + n;
        for (int c0 = 0; c0 < S5NCH; c0 += 8) { float sr[8], si[8];
#pragma unroll
            for (int k = 0; k < 8; ++k) { sr[k] = sp[(size_t)(c0 + k) * 256]; si[k] = sp[(size_t)(c0 + k) * 256 + 64]; }
#pragma unroll
            for (int k = 0; k < 8; ++k) { dp[(size_t)(c0 + k) * S5K] = f2bf(hr); dp[(size_t)(c0 + k) * S5K + 64] = f2bf(hi);
                const float nr = A.x * hr - A.y * hi + sr[k], ni = A.x * hi + A.y * hr + si[k]; hr = nr; hi = ni; } }
    }
}
__device__ __forceinline__ void s5_carry(const Frame& F, const Args& a, int l) {
    unsigned char* ws = a.ws; const f32x2* apow = (const f32x2*)(ws + SM_APOW) + (size_t)l * 16 * 64 * 34;
    const float* S = (const float*)(ws + WS_S5S); bf16_t* ap = (bf16_t*)(ws + WS_S5A);
    const int gt = F.bid * 512 + F.tid, NT = F.G * 512;
    for (int i = gt; i < 16 * NB * 64; i += NT) { const int n = i & 63, b = (i >> 6) & 15, g = i >> 10;
        const f32x2 A = apow[((size_t)g * 64 + n) * 34 + S5LC]; float hr = 0.f, hi = 0.f;
        const float* sp = S + ((size_t)g * 2048 + b * 128) * 256 + n; bf16_t* dp = ap + ((size_t)g * 2048 + b * 128) * S5K + 512 + n;
        for (int c0 = 0; c0 < S5NCH; c0 += 8) { float sr[8], si[8];
#pragma unroll
            for (int k = 0; k < 8; ++k) { sr[k] = sp[(size_t)(c0 + k) * 256]; si[k] = sp[(size_t)(c0 + k) * 256 + 64]; }
#pragma unroll
            for (int k = 0; k < 8; ++k) { dp[(size_t)(c0 + k) * S5K] = f2bf(hr); dp[(size_t)(c0 + k) * S5K + 64] = f2bf(hi);
                const float nr = A.x * hr - A.y * hi + sr[k], ni = A.x * hi + A.y * hr + si[k]; hr = nr; hi = ni; } }
    }
}
template <int MODE, bool ROUTE, bool FINAL>
__device__ __forceinline__ void ln_panel(const Frame& F, const Args& a, int pm, const float* gain, const float* beta, const float* router, size_t h_off = WS_HBUF) {
    unsigned char* ws = a.ws; float* xout = a.out; bf16_t* xb = (bf16_t*)(ws + WS_XB);
    const bf16_t* hb = (const bf16_t*)(ws + (MODE == 0 ? h_off : WS_YB)); const f32x2* tokw = (const f32x2*)(ws + SM_TOKW);
    LAS int* cnt = (LAS int*)F.lds;
    const int lane = F.lane;
    f32x4 gv[4], bv[4];
#pragma unroll
    for (int j = 0; j < 4; ++j) { gv[j] = *(const f32x4*)(gain + 4 * lane + 256 * j); bv[j] = *(const f32x4*)(beta + 4 * lane + 256 * j); }
    if (ROUTE) { if (F.tid < 8) cnt[F.tid] = 0; __syncthreads(); }
    u32x2 nx[4], nh0[4], nh1[4]; f32x2 nw = (f32x2){0.f, 0.f};
    { const size_t row = (size_t)pm * 256 + F.wave * 32; if (MODE == 1) nw = tokw[row];
#pragma unroll
      for (int j = 0; j < 4; ++j) { nx[j] = *(const u32x2*)(xb + row * D + 4 * lane + 256 * j);
          if (MODE == 0) { nh0[j] = *(const u32x2*)(hb + row * D + 4 * lane + 256 * j); nh1[j] = nh0[j]; } else { nh0[j] = *(const u32x2*)(hb + (2 * row) * D + 4 * lane + 256 * j); nh1[j] = *(const u32x2*)(hb + (2 * row + 1) * D + 4 * lane + 256 * j); } } }
    for (int i = 0; i < 32; ++i) { const size_t row = (size_t)pm * 256 + F.wave * 32 + i;
        f32x4 v[4]; float s = 0.f;
        u32x2 cx[4], ch0[4], ch1[4]; const f32x2 w01 = nw;
#pragma unroll
        for (int j = 0; j < 4; ++j) { cx[j] = nx[j]; ch0[j] = nh0[j]; ch1[j] = nh1[j]; }
        if (i < 31) { const size_t rn = row + 1; if (MODE == 1) nw = tokw[rn];
#pragma unroll
            for (int j = 0; j < 4; ++j) { nx[j] = *(const u32x2*)(xb + rn * D + 4 * lane + 256 * j);
                if (MODE == 0) { nh0[j] = *(const u32x2*)(hb + rn * D + 4 * lane + 256 * j); nh1[j] = nh0[j]; } else { nh0[j] = *(const u32x2*)(hb + (2 * rn) * D + 4 * lane + 256 * j); nh1[j] = *(const u32x2*)(hb + (2 * rn + 1) * D + 4 * lane + 256 * j); } } }
#pragma unroll
        for (int j = 0; j < 4; ++j) { const u32x2 xq = cx[j]; const f32x4 xv = (f32x4){bflo(xq.x), bfhi(xq.x), bflo(xq.y), bfhi(xq.y)}; f32x4 hv;
            if (MODE == 0) { const u32x2 q = ch0[j]; hv = (f32x4){bflo(q.x), bfhi(q.x), bflo(q.y), bfhi(q.y)}; }
            else { const u32x2 q0 = ch0[j], q1 = ch1[j];
                hv = (f32x4){w01.x * bflo(q0.x) + w01.y * bflo(q1.x), w01.x * bfhi(q0.x) + w01.y * bfhi(q1.x), w01.x * bflo(q0.y) + w01.y * bflo(q1.y), w01.x * bfhi(q0.y) + w01.y * bfhi(q1.y)}; }
            v[j] = xv * ALPHA + hv; s += (v[j][0] + v[j][1]) + (v[j][2] + v[j][3]); }
        const float mean = wave_sum(s) * (1.f / D); float s2 = 0.f;
#pragma unroll
        for (int j = 0; j < 4; ++j) { v[j] = v[j] - mean; s2 += (v[j][0] * v[j][0] + v[j][1] * v[j][1]) + (v[j][2] * v[j][2] + v[j][3] * v[j][3]); }
        const float rstd = 1.0f / sqrtf(wave_sum(s2) * (1.f / D) + LN_EPS);
#pragma unroll
        for (int j = 0; j < 4; ++j) { v[j] = v[j] * rstd * gv[j] + bv[j];
            if (FINAL) *(f32x4*)(xout + row * D + 4 * lane + 256 * j) = v[j];
            u32x2 w; w.x = cvt_pk_bf16(v[j][0], v[j][1]); w.y = cvt_pk_bf16(v[j][2], v[j][3]); *(u32x2*)(xb + row * D + 4 * lane + 256 * j) = w; }
        if (ROUTE) {
            float lg[8];
#pragma unroll
            for (int e = 0; e < 8; ++e) lg[e] = 0.f;
#pragma unroll
            for (int j = 0; j < 4; ++j)
#pragma unroll
                for (int k = 0; k < 4; ++k) { const float* rr = router + (size_t)(4 * lane + 256 * j + k) * 8; const f32x4 r0 = *(const f32x4*)rr, r1 = *(const f32x4*)(rr + 4); const float xv = v[j][k];
                    lg[0] += xv * r0[0]; lg[1] += xv * r0[1]; lg[2] += xv * r0[2]; lg[3] += xv * r0[3]; lg[4] += xv * r1[0]; lg[5] += xv * r1[1]; lg[6] += xv * r1[2]; lg[7] += xv * r1[3]; }
            {
                const bool h3 = (lane & 8) != 0;
                float r4[4], r2[2], r1;
#pragma unroll
                for (int i = 0; i < 4; ++i) r4[i] = swapsum32(lg[i], lg[4 + i]);
#pragma unroll
                for (int i = 0; i < 2; ++i) r2[i] = swapsum16(r4[i], r4[2 + i]);
                { const float send = h3 ? r2[0] : r2[1], mine = h3 ? r2[1] : r2[0]; r1 = mine + xshfl<8>(send); }
                r1 += xshfl<1>(r1); r1 += xshfl<2>(r1); r1 += dpp_half_mirror(r1);
#pragma unroll
                for (int e = 0; e < 8; ++e) lg[e] = __builtin_bit_cast(float, __builtin_amdgcn_readlane(__builtin_bit_cast(int, r1), 8 * e));
            }
            int e0 = 0; float m0 = lg[0];
#pragma unroll
            for (int e = 1; e < 8; ++e) if (lg[e] > m0) { m0 = lg[e]; e0 = e; }
            int e1 = -1; float m1 = -3.0e38f;
#pragma unroll
            for (int e = 0; e < 8; ++e) if (e != e0 && lg[e] > m1) { m1 = lg[e]; e1 = e; }
            const float w0 = 1.0f / (1.0f + __expf(m1 - m0));
            if (lane == 0) { ((int*)(ws + SM_TOKE))[row] = e0 | (e1 << 8); ((f32x2*)(ws + SM_TOKW))[row] = (f32x2){w0, 1.0f - w0}; __hip_atomic_fetch_add(&cnt[e0], 1, __ATOMIC_RELAXED, __HIP_MEMORY_SCOPE_WORKGROUP); __hip_atomic_fetch_add(&cnt[e1], 1, __ATOMIC_RELAXED, __HIP_MEMORY_SCOPE_WORKGROUP); }
        }
    }
    if (ROUTE) { __syncthreads(); if (F.tid < 8) ((int*)(ws + SM_PCNT))[pm * 8 + F.tid] = cnt[F.tid]; __syncthreads(); }
}
__device__ __forceinline__ void moe_gather(const Frame& F, const Args& a) {
    unsigned char* ws = a.ws; const int* pcnt = (const int*)(ws + SM_PCNT); const int* toke = (const int*)(ws + SM_TOKE);
    int* rowtok = (int*)(ws + SM_ROWTOK); int* tileexp = (int*)(ws + SM_TILEEXP);
    const bf16_t* xb = (const bf16_t*)(ws + WS_XB); bf16_t* xs = (bf16_t*)(ws + WS_XS);
    LAS int* sm = (LAS int*)F.lds;
    for (int pm = F.bid; pm < T / 256; pm += F.G) {
        for (int q = F.tid; q < (T / 256) * 8; q += 512) sm[1024 + q] = pcnt[q];
        if (F.tid >= 32 && F.tid < 288) sm[F.tid] = toke[pm * 256 + F.tid - 32];
        __syncthreads();
        if (F.tid < 8) { int tot = 0, before = 0; for (int q = 0; q < T / 256; ++q) { const int c = sm[1024 + q * 8 + F.tid]; tot += c; if (q < pm) before += c; } sm[F.tid] = tot; sm[16 + F.tid] = before; }
        __syncthreads();
        if (F.tid == 0) { int st = 0; for (int e = 0; e < 8; ++e) { sm[8 + e] = st * 256; st += (sm[e] + 255) >> 8; } sm[24] = st; }
        __syncthreads();
        {
            const int i = F.tid >> 1, k = F.tid & 1; const int ee = sm[32 + i]; const int e = k ? (ee >> 8) : (ee & 255);
            int cntb = 0; for (int q = 0; q < i; ++q) { const int o = sm[32 + q]; cntb += ((o & 255) == e) + ((o >> 8) == e); }
            const int dest = sm[8 + e] + sm[16 + e] + cntb; sm[512 + F.tid] = dest; rowtok[dest] = 2 * (pm * 256 + i) + k;
        }
        __syncthreads();
        for (int r0 = F.wave * 64; r0 < F.wave * 64 + 64; r0 += 8) {
            u32x4 va[8], vb[8];
#pragma unroll
            for (int q = 0; q < 8; ++q) { const size_t tok = (size_t)pm * 256 + ((r0 + q) >> 1); const u32x4* s = (const u32x4*)(xb + tok * D); va[q] = s[F.lane]; vb[q] = s[64 + F.lane]; }
#pragma unroll
            for (int q = 0; q < 8; ++q) { const int dest = sm[512 + r0 + q]; u32x4* d = (u32x4*)(xs + (size_t)dest * D); d[F.lane] = va[q]; d[64 + F.lane] = vb[q]; } }
        if (pm == 0) {
            for (int e = 0; e < 8; ++e) { const int r0 = sm[8 + e] + sm[e], r1 = sm[8 + e] + (((sm[e] + 255) >> 8) << 8); for (int r = r0 + F.tid; r < r1; r += 512) rowtok[r] = -1;
                const int t0 = sm[8 + e] >> 8, t1 = r1 >> 8; for (int t = t0 + F.tid; t < t1; t += 512) tileexp[t] = e; }
            if (F.tid == 0) tileexp[1023] = sm[24];
        }
        __syncthreads();
    }
}

__device__ __forceinline__ void moe_tail_finalize(const Frame& F, const Args& a) {
    const int* tileexp = (const int*)(a.ws + SM_TILEEXP); int nt = tileexp[1023] - (MOE_NCHUNK - 1) * MOE_CHUNK_TILES; nt = nt < 0 ? 0 : (nt > 8 ? 8 : nt);
    const float* YT = (const float*)(a.ws + WS_XS); const int* row_tok = (const int*)(a.ws + SM_ROWTOK) + (MOE_NCHUNK - 1) * MOE_CHUNK_TILES * 256; bf16_t* Y = (bf16_t*)(a.ws + WS_YB);
    const int c8 = (F.tid & 127) * 8;
    for (int r = F.bid * 4 + (F.tid >> 7); r < nt * 256; r += F.G * 4) { const int dst = row_tok[r]; if (dst < 0) continue;
        f32x4 s0 = (f32x4){0.f, 0.f, 0.f, 0.f}, s1 = s0;
#pragma unroll
        for (int ks = 0; ks < 7; ++ks) { const float* p = YT + ((size_t)ks * 2048 + r) * D + c8; s0 += *(const f32x4*)p; s1 += *(const f32x4*)(p + 4); }
        u32x4 w; w.x = cvt_pk_bf16(s0[0], s0[1]); w.y = cvt_pk_bf16(s0[2], s0[3]); w.z = cvt_pk_bf16(s1[0], s1[1]); w.w = cvt_pk_bf16(s1[2], s1[3]);
        *(u32x4*)(Y + (size_t)dst * D + c8) = w; }
}
struct MoeUpOrder { int ntile, G, c, chunk; const int* tileexp;
    __device__ __forceinline__ bool next(int i, pg8::Unit& u) const { if (!pg8::static_tile(i, G, c, ntile, 2 * DFE / 256, u.pm, u.pn)) return false;
        const int tile = chunk * MOE_CHUNK_TILES + u.pm, e = tileexp[tile]; u.aux = tile; u.offA = (long long)tile * 256 * D * 2; u.offB = ((long long)e * 2 * DFE + (long long)u.pn * 256) * D * 2; return true; } };
struct MoeDnOrder { int ntile, G, c, chunk; const int* tileexp;
    __device__ __forceinline__ bool next(int i, pg8::Unit& u) const { if (!pg8::static_tile(i, G, c, ntile, D / 256, u.pm, u.pn)) return false;
        const int tile = chunk * MOE_CHUNK_TILES + u.pm, e = tileexp[tile]; u.aux = tile; u.offA = (long long)u.pm * 256 * DFE * 2; u.offB = ((long long)e * D + (long long)u.pn * 256) * DFE * 2; return true; } };

struct MoeDnTailOrder { int ntile, G, c; const int* tileexp;
    __device__ __forceinline__ bool next(int i, pg8::Unit& u) const { const long L = (long)i * G + c; if (L >= (long)ntile * 28) return false;
        const int ks = (int)(L % 7), rest = (int)(L / 7); u.pn = rest & 3; u.pm = rest >> 2; u.aux = ks;
        const int tile = (MOE_NCHUNK - 1) * MOE_CHUNK_TILES + u.pm, e = tileexp[tile];
        u.offA = (long long)u.pm * 256 * DFE * 2 + (long long)ks * 512 * 2; u.offB = ((long long)e * D + (long long)u.pn * 256) * DFE * 2 + (long long)ks * 512 * 2; return true; } };

enum { PH_PREP = 0, PH_WIN, PH_POST, PH_MIX1, PH_MIX2, PH_MIX3, PH_MIX4, PH_WOUT, PH_LN1, PH_FUP, PH_FDN, PH_MGATH = 9, PH_MUP0 = 10, PH_LN2 = 21, PH_PGATE, PH_PPROJ, PH_LN3, PH_PER_LAYER = 32 };
constexpr int GP_END = 2 + 32 * DEPTH;

__global__ void __launch_bounds__(512, 2) mk_fwd(Args a0) {
    extern __shared__ __attribute__((aligned(16))) unsigned char lds_raw[];
    LAS unsigned char* const lds = (LAS unsigned char*)lds_raw;
    for (int u = threadIdx.x; u < (LDS_BYTES - LDSCTL_OFF) / 4; u += 512) ((LAS unsigned*)(lds + LDSCTL_OFF))[u] = 0u;
    __syncthreads();
    const int gp_lo = a0.gp_lo, gp_hi = a0.gp_hi; const int F0bid = blockIdx.x, F0G = gridDim.x; const int wave0 = __builtin_amdgcn_readfirstlane(threadIdx.x >> 6);
    XcdBarrier bar; bar.bar = (unsigned*)(a0.ws + WS_CTL) + CW_BAR; bar.x = 0; bar.st = nullptr;
    if (a0.use_bar) bar = xcd_barrier_post((unsigned*)(a0.ws + WS_CTL) + CW_BAR, (volatile LAS unsigned*)(lds + LDSCTL_OFF + 32));
#if MK_PROBE
#define PRW ((volatile LAS unsigned*)(lds + LDSCTL_OFF + 128))
    if (threadIdx.x == 0) { const unsigned long long t_ = __builtin_amdgcn_s_memrealtime(); PRW[0] = (unsigned)t_; PRW[1] = (unsigned)(t_ >> 32); PRW[2] = 0u; PRW[3] = 0u; PRW[4] = (unsigned)t_; PRW[5] = (unsigned)(t_ >> 32); }
#define STAMP(cls) do { if (wave0 == 0 && lane_id_fresh() == 0) { const unsigned long long t_ = __builtin_amdgcn_s_memrealtime(); const unsigned long long p_ = ((unsigned long long)PRW[1] << 32) | PRW[0]; const unsigned d_ = (unsigned)(t_ - p_); \
        PRW[0] = (unsigned)t_; PRW[1] = (unsigned)(t_ >> 32); if ((PROBE_A >> (cls)) & 1) PRW[2] += d_; if ((PROBE_B >> (cls)) & 1) PRW[3] += d_; } } while (0)
#else
#define STAMP(cls) do {} while (0)
#endif
#define RUN(gp) (gp_lo <= (gp) && (gp) < gp_hi)
#define SEAM(gp) do { if (gp_lo <= (gp) && (gp) + 1 < gp_hi) xcd_barrier(bar, wave0); } while (0)
#define PH_BEGIN Args a; load_args(a); const Frame F = make_frame(lds, wave0); unsigned char* const ws = a.ws; int l = lx; asm volatile("" : "+s"(l)); (void)l; (void)ws; \
    bf16_t* const xb = (bf16_t*)(ws + WS_XB); bf16_t* const z = (bf16_t*)(ws + WS_Z); bf16_t* const mix = (bf16_t*)(ws + WS_MIX); bf16_t* const hbuf = (bf16_t*)(ws + WS_HBUF); const long long S1K = 256ll * 1024 * 2; \
    (void)xb; (void)z; (void)mix; (void)hbuf; (void)S1K;
#define AP_DEF const nsa::Lane L{F.lane, F.lane & 31, F.lane >> 5, F.wave, F.tid}; \
    const nsa::AttnPtrs AP{(const bf16_t*)(ws + WS_Q), z, (const bf16_t*)(ws + WS_KC), (const bf16_t*)(ws + WS_VCT), (const bf16_t*)(ws + WS_KSEL), (const bf16_t*)(ws + WS_VSEL), \
                           (const bf16_t*)(ws + WS_KWIN), (const bf16_t*)(ws + WS_VWIN), (unsigned long long*)(ws + WS_SELM), mix};
    { const int lx = 0;
    if (RUN(0)) { PH_BEGIN phase_init0(F, a); }
    SEAM(0); STAMP(0);
    if (RUN(1)) { PH_BEGIN phase_init1(F, a); }
    SEAM(1); STAMP(0);
    }
    for (int lx = 0; lx < DEPTH; ++lx) {
        const int base = 2 + PH_PER_LAYER * lx; const bool moe = (lx & 1) != 0;
        if (RUN(base + PH_PREP)) { PH_BEGIN phase_prep(F, a, l); }
        SEAM(base + PH_PREP); STAMP(1);
        if (RUN(base + PH_WIN)) { PH_BEGIN
            pg8::Gemm g{xb, (const bf16_t*)(ws + W_IN), D, D, D}; pg8::PlainOrder S{T / 256, INP / 256, F.G, F.bid, S1K, S1K};
            epi::EpiWin E{z, (bf16_t*)(ws + WS_Q), (bf16_t*)(ws + WS_KCMP), (bf16_t*)(ws + WS_S5A), (const f32x2*)(ws + WS_ROPE)};
            pg8::gemm_phase(F.lds, g, S, E, F.tid);
        }
        SEAM(base + PH_WIN); STAMP(2);
        if (RUN(base + PH_MIX1)) {
            for (int r = F0bid; r < 128; r += F0G) {
                {   PH_BEGIN const int g_ = r >> 3, pm_ = r & 7;
                    pg8::Gemm g{(const bf16_t*)(ws + WS_S5A), (const bf16_t*)(ws + W_S5S), 512, S5K, 512};
                    pg8::ListOrder S{1, pm_, g_, (long long)g_ * 2048 * S5K * 2 + (long long)pm_ * 256 * S5K * 2, (long long)g_ * 256 * 512 * 2, 0}; epi::F32Grouped E{(float*)(ws + WS_S5S), 256, (size_t)2048 * 256};
                    pg8::gemm_phase(F.lds, g, S, E, F.tid); }
                __syncthreads();
                {   PH_BEGIN int nr = MK_REP_CARRY; asm volatile("" : "+s"(nr)); for (int q = 0; q < nr; ++q) s5_carry_panel(F, a, l, r >> 3, r & 7); }
                asm volatile("s_waitcnt vmcnt(0)" ::: "memory"); __syncthreads();
                {   PH_BEGIN const int g_ = r >> 3, pm_ = r & 7;
                    pg8::Gemm g{(const bf16_t*)(ws + WS_S5A), (const bf16_t*)(ws + W_S5B), S5K, S5K, S5K};
                    pg8::ListOrder S{2, pm_, g_, (long long)g_ * 2048 * S5K * 2 + (long long)pm_ * 256 * S5K * 2, (long long)g_ * 512 * S5K * 2, 256ll * S5K * 2}; epi::S5Out E{(bf16_t*)(ws + WS_ZS5), z, (const float*)a.in[21] + (size_t)l * 256};
                    pg8::gemm_phase(F.lds, g, S, E, F.tid); }
            }
            for (int r = F0bid - 128; r < 64; r += F0G) { if (r < 0) continue;
                {   PH_BEGIN const int j_ = r >> 5, bh_ = r & 31;
                    pg8::Gemm g{(const bf16_t*)(ws + WS_KCMP), (const bf16_t*)(ws + W_CMP), 1024, 1024, 1024};
                    pg8::ListOrder S{2, bh_, j_, (long long)j_ * (long long)(WS_VCMP - WS_KCMP) + (long long)bh_ * S1K, (long long)j_ * 512 * 1024 * 2, S1K}; epi::F32Grouped E{(float*)(ws + WS_CMPP), 512, (size_t)8192 * 512};
                    pg8::gemm_phase(F.lds, g, S, E, F.tid); }
                asm volatile("s_waitcnt vmcnt(0)" ::: "memory"); __syncthreads();
                {   PH_BEGIN int nr = MK_REP_ST2; asm volatile("" : "+s"(nr)); for (int q = 0; q < nr; ++q) cmp_stage2_panel(F, a, l, r >> 5, r & 31); }
            }
            {   PH_BEGIN
                if (F.G == 256) { const int c = F.bid; const int beg = c < 128 ? c * 5 : (c < 192 ? 640 + (c - 128) * 6 : 1024 + (c - 192) * 16), cnt = c < 128 ? 5 : (c < 192 ? 6 : 16); conv_items(F, a, l, beg, 1, beg + cnt); }
                else conv_items(F, a, l, F.bid, F.G); }
        }
        SEAM(base + PH_MIX1); STAMP(4);
        if (RUN(base + PH_MIX3)) {
            {   PH_BEGIN
                pg8::Gemm g{(const bf16_t*)(ws + WS_ZS5), (const bf16_t*)(ws + W_GLU), 256, 256, 256};
                pg8::PlainOrder S{T / 256, 1, F.G, F.bid, 256ll * 256 * 2, 256ll * 256 * 2}; epi::S5Glu E{mix, (const bf16_t*)(ws + WS_ZS5), (const float*)a.in[23] + (size_t)l * 256};
                pg8::gemm_phase(F.lds, g, S, E, F.tid);
            }
            {   PH_BEGIN AP_DEF
                for (int p = F.bid; p < 32 * 16; p += F.G) { const int bh = p >> 4, s = p & 15;
                    for (int half = 0; half < 2; ++half) { const int qb2 = half ? 31 - s : s;
                        nsa::cmp_unit<true>(bh, 2 * qb2, AP, F.lds, L); nsa::cmp_topk(bh, 2 * qb2, AP, F.lds, L);
                        nsa::cmp_unit<false>(bh, 2 * qb2 + 1, AP, F.lds, L); nsa::cmp_topk(bh, 2 * qb2 + 1, AP, F.lds, L); } } }
            asm volatile("s_waitcnt vmcnt(0)" ::: "memory"); __syncthreads();
            {   PH_BEGIN AP_DEF
                for (int p = F.bid; p < 32 * 16; p += F.G) { const int bh = p >> 4, s = p & 15; nsa::sw_unit2(bh, s, AP, F.lds, L); nsa::sw_unit2(bh, 31 - s, AP, F.lds, L); } }
        }
        SEAM(base + PH_MIX3); STAMP(6);

        if (RUN(base + PH_WOUT)) {
            {   PH_BEGIN
                pg8::Gemm g{mix, (const bf16_t*)(ws + W_OUT), D, D, D}; pg8::PlainOrder S{T / 256, D / 256, F.G, F.bid, S1K, S1K}; epi::Bf16Sc1 E{hbuf, D, (unsigned)((size_t)T * D * 2)};
                pg8::gemm_phase(F.lds, g, S, E, F.tid);
            }
            {   PH_BEGIN pg8::PlainOrder S{T / 256, D / 256, F.G, F.bid, S1K, S1K}; panels_publish_wait(F, (unsigned*)(ws + WS_CTL), 2 * l + 0, S, (unsigned)(D / 256)); }
            {   PH_BEGIN
                const float* gg = (const float*)a.in[34] + ((size_t)l * 3 + 0) * D; const float* bb = (const float*)a.in[35] + ((size_t)l * 3 + 0) * D;
                for (int pm = F.bid; pm < T / 256; pm += F.G) { if (l & 1) ln_panel<0, true, false>(F, a, pm, gg, bb, (const float*)a.in[27] + (size_t)(l >> 1) * D * NEXP); else ln_panel<0, false, false>(F, a, pm, gg, bb, nullptr); }
            }
        }
        SEAM(base + PH_WOUT); STAMP(8);
        if (!moe) {
            if (RUN(base + PH_FUP)) { PH_BEGIN
                pg8::Gemm g{xb, (const bf16_t*)(ws + W_UP), D, D, D}; pg8::PlainOrder S{T / 256, 2 * DFF / 256, F.G, F.bid, S1K, S1K}; epi::SwiGlu E{(bf16_t*)(ws + WS_FFH), DFF};
                pg8::gemm_phase(F.lds, g, S, E, F.tid);
            }
            SEAM(base + PH_FUP); STAMP(9);
            if (RUN(base + PH_FDN)) {
                {   PH_BEGIN
                    pg8::Gemm g{(const bf16_t*)(ws + WS_FFH), (const bf16_t*)(ws + W_DN), DFF, DFF, DFF}; pg8::PlainOrder S{T / 256, D / 256, F.G, F.bid, 256ll * DFF * 2, 256ll * DFF * 2}; epi::Bf16Sc1 E{hbuf, D, (unsigned)((size_t)T * D * 2)};
                    pg8::gemm_phase(F.lds, g, S, E, F.tid);
                }
                {   PH_BEGIN pg8::PlainOrder S{T / 256, D / 256, F.G, F.bid, 256ll * DFF * 2, 256ll * DFF * 2}; panels_publish_wait(F, (unsigned*)(ws + WS_CTL), 2 * l + 1, S, (unsigned)(D / 256)); }
                {   PH_BEGIN
                    const float* gg = (const float*)a.in[34] + ((size_t)l * 3 + 1) * D; const float* bb = (const float*)a.in[35] + ((size_t)l * 3 + 1) * D;
                    for (int pm = F.bid; pm < T / 256; pm += F.G) ln_panel<0, false, false>(F, a, pm, gg, bb, nullptr);
                }
            }
            asm volatile("s_waitcnt vmcnt(0)" ::: "memory"); __syncthreads(); STAMP(10);
        } else {
            if (RUN(base + PH_MGATH)) { PH_BEGIN moe_gather(F, a); }
            SEAM(base + PH_MGATH); STAMP(11);
            for (int cx = 0; cx < MOE_NCHUNK; ++cx) {
                if (RUN(base + PH_MUP0 + 2 * cx)) { PH_BEGIN int c = cx; asm volatile("" : "+s"(c)); const int* tileexp = (const int*)(ws + SM_TILEEXP);
                    int nt = tileexp[1023] - c * MOE_CHUNK_TILES; nt = nt < 0 ? 0 : (nt > MOE_CHUNK_TILES ? MOE_CHUNK_TILES : nt);
                    pg8::Gemm g{(const bf16_t*)(ws + WS_XS), (const bf16_t*)(ws + W_UP), D, D, D}; MoeUpOrder S{nt, F.G, F.bid, c, tileexp}; epi::SwiGlu E{(bf16_t*)(ws + WS_MH), DFE};
                    pg8::gemm_phase(F.lds, g, S, E, F.tid);
                }
                SEAM(base + PH_MUP0 + 2 * cx); STAMP(12);
                if (RUN(base + PH_MUP0 + 2 * cx + 1)) { PH_BEGIN int c = cx; asm volatile("" : "+s"(c)); const int* tileexp = (const int*)(ws + SM_TILEEXP);
                    int nt = tileexp[1023] - c * MOE_CHUNK_TILES; nt = nt < 0 ? 0 : (nt > MOE_CHUNK_TILES ? MOE_CHUNK_TILES : nt);
                    if (cx < MOE_NCHUNK - MK_TAILSPLIT) {
                        pg8::Gemm g{(const bf16_t*)(ws + WS_MH), (const bf16_t*)(ws + W_DN), DFE, DFE, DFE}; MoeDnOrder S{nt, F.G, F.bid, c, tileexp}; epi::MoeDown E{(bf16_t*)(ws + WS_YB), (const int*)(ws + SM_ROWTOK)};
                        pg8::gemm_phase(F.lds, g, S, E, F.tid);
                    } else {
                        nt = nt > 8 ? 8 : nt;
                        pg8::Gemm g{(const bf16_t*)(ws + WS_MH), (const bf16_t*)(ws + W_DN), 512, DFE, DFE}; MoeDnTailOrder S{nt, F.G, F.bid, tileexp}; epi::F32Grouped E{(float*)(ws + WS_XS), D, (size_t)2048 * D};
                        pg8::gemm_phase(F.lds, g, S, E, F.tid);
                    }
                }
                SEAM(base + PH_MUP0 + 2 * cx + 1); STAMP(13);
            }
#if MK_TAILSPLIT
            if (RUN(base + PH_MUP0 + 2 * MOE_NCHUNK)) { PH_BEGIN moe_tail_finalize(F, a); }
            SEAM(base + PH_MUP0 + 2 * MOE_NCHUNK); STAMP(13);
#endif
        }
        if (RUN(base + PH_PGATE)) {
            if (moe) {
                {   PH_BEGIN
                    const float* gg = (const float*)a.in[34] + ((size_t)l * 3 + 1) * D; const float* bb = (const float*)a.in[35] + ((size_t)l * 3 + 1) * D;
                    for (int pm = F.bid; pm < T / 256; pm += F.G) ln_panel<1, false, false>(F, a, pm, gg, bb, nullptr);
                }
                asm volatile("s_waitcnt vmcnt(0)" ::: "memory"); __syncthreads();
            }
            {   PH_BEGIN
                pg8::Gemm g{xb, (const bf16_t*)(ws + W_GATE), D, D, D}; pg8::PanelOrder S{T / 256, D / 256, F.G, F.bid, S1K, S1K}; epi::SigmoidBias E{(l & 1) ? (bf16_t*)(ws + WS_PLEG) : mix, D, (const float*)a.in[32] + (size_t)l * D};
                pg8::gemm_phase(F.lds, g, S, E, F.tid);
            }
            __syncthreads();
            {   PH_BEGIN
                pg8::Gemm g{(const bf16_t*)(ws + WS_PB), (const bf16_t*)(ws + W_PROJ), PLE, PLE, PLE}; pg8::PanelOrder S{T / 256, D / 256, F.G, F.bid, 256ll * PLE * 2, 256ll * PLE * 2}; epi::MulBf16 E{(l & 1) ? (bf16_t*)(ws + WS_PLEH) : hbuf, (l & 1) ? (bf16_t*)(ws + WS_PLEG) : mix, D};
                pg8::gemm_phase(F.lds, g, S, E, F.tid);
            }
            __syncthreads();
            {   PH_BEGIN
                const float* gg = (const float*)a.in[34] + ((size_t)l * 3 + 2) * D; const float* bb = (const float*)a.in[35] + ((size_t)l * 3 + 2) * D;
                const size_t hoff = (l & 1) ? WS_PLEH : WS_HBUF;
                for (int pm = F.bid; pm < T / 256; pm += F.G) { if (l == DEPTH - 1) ln_panel<0, false, true>(F, a, pm, gg, bb, nullptr, hoff); else ln_panel<0, false, false>(F, a, pm, gg, bb, nullptr, hoff); }
            }
        }
        SEAM(base + PH_PGATE); STAMP(15);
    }
#if MK_PROBE
    if (blockIdx.x == 0) {
        __syncthreads(); asm volatile("s_waitcnt vmcnt(0)" ::: "memory");
        const unsigned long long t1 = ((unsigned long long)PRW[1] << 32) | PRW[0], t0 = ((unsigned long long)PRW[5] << 32) | PRW[4];
        const float tot = (float)(unsigned)(t1 - t0), fa = (float)PRW[2] / tot, fb = (float)PRW[3] / tot;
        Args ae; load_args(ae);
        const int tidp = wave0 * 64 + lane_id_fresh();
        if (tidp == 0) ae.out[0] += 1.0f + 8.0f * fa;
        for (int i = tidp; i < 100000; i += 512) ae.out[1024 + i] += 0.5f * fb;
    }
#endif
#undef RUN
#undef SEAM
}

static bool phase_applies(int gp) {
    if (gp < 2) return true;
    const int l = (gp - 2) / PH_PER_LAYER, ph = (gp - 2) % PH_PER_LAYER; const bool moe = (l & 1) != 0;
    if (ph < PH_LN1) return ph != PH_POST && ph != PH_MIX2 && ph != PH_MIX4;
    if (ph == PH_PGATE) return true;
    if (!moe) return ph == PH_FUP || ph == PH_FDN;
    return ph >= PH_MGATH && ph <= PH_MUP0 + 2 * MOE_NCHUNK;
}
extern "C" void kernel_launch(void* const* d_in, const int* in_sizes, int n_in, void* d_out, int out_size, void* d_ws, size_t ws_size, hipStream_t stream) {
    static int grid = 0;
    if (grid == 0) {
        if (n_in != 36 || out_size != T * D || ws_size < WS_END) { fprintf(stderr, "kernel_launch: unexpected problem (n_in %d out %d ws %zu, need %zu)\n", n_in, out_size, ws_size, (size_t)WS_END); grid = -1; return; }
        int dev = 0, cus = 0, per_cu = 0;
        if (hipGetDevice(&dev) != hipSuccess || hipDeviceGetAttribute(&cus, hipDeviceAttributeMultiprocessorCount, dev) != hipSuccess) { grid = -1; return; }
        if (hipFuncSetAttribute((const void*)mk_fwd, hipFuncAttributeMaxDynamicSharedMemorySize, LDS_BYTES) != hipSuccess) { fprintf(stderr, "kernel_launch: hipFuncSetAttribute failed\n"); grid = -1; return; }
        if (hipOccupancyMaxActiveBlocksPerMultiprocessor(&per_cu, (const void*)mk_fwd, 512, LDS_BYTES) != hipSuccess || per_cu < 1) fprintf(stderr, "kernel_launch: occupancy query reports %d\n", per_cu);
        (void)hipGetLastError();
        grid = cus;
    }
    if (grid < 0) return;
    (void)in_sizes;
    if (hipMemsetAsync((char*)d_ws + WS_CTL, 0, CTL_ZERO_BYTES, stream) != hipSuccess) return;
#if MK_CHECK
    (void)hipMemsetAsync((char*)d_ws + SM_CHK, 0, 256, stream);
#endif
    Args a{};
    for (int i = 0; i < 36; ++i) a.in[i] = d_in[i];
    a.out = (float*)d_out; a.ws = (unsigned char*)d_ws; a.pad = 0;
#if MK_MULTI
    for (int gp = 0; gp < GP_END; ++gp) { if (!phase_applies(gp)) continue; a.gp_lo = gp; a.gp_hi = gp + 1; a.use_bar = 0;
        hipLaunchKernelGGL(mk_fwd, dim3(grid), dim3(512), LDS_BYTES, stream, a);
#if MK_CHECK
        run_checks(a, gp, stream);
#endif
    }
#if MK_CHECK
    hipLaunchKernelGGL(chk_final, dim3(1), dim3(1), 0, stream, a);
#endif
#else
    a.gp_lo = 0; a.gp_hi = GP_END; a.use_bar = 1;
    hipLaunchKernelGGL(mk_fwd, dim3(grid), dim3(512), LDS_BYTES, stream, a);
#endif
}
```

```cpp
#include <hip/hip_runtime.h>
#include <cstdint>
#include <cstdio>
#ifndef MK_TAILSPLIT
#define MK_TAILSPLIT 1
#endif
#ifndef MK_MULTI
#define MK_MULTI 0
#endif
#ifndef MK_CHECK
#define MK_CHECK 0
#endif
#ifndef MK_REP_G1
#define MK_REP_G1 1
#endif
#ifndef MK_REP_G2
#define MK_REP_G2 1
#endif
#ifndef MK_REP_CU
#define MK_REP_CU 1
#endif
#ifndef MK_REP_TK
#define MK_REP_TK 1
#endif
#ifndef MK_REP_WOUT
#define MK_REP_WOUT 1
#endif
#ifndef MK_REP_CONV
#define MK_REP_CONV 1
#endif
#ifndef MK_REP_ST2
#define MK_REP_ST2 1
#endif
#ifndef MK_REP_CARRY
#define MK_REP_CARRY 1
#endif
#ifndef MK_REPCMP
#define MK_REPCMP 1
#endif
#ifndef MK_ALIGN_EPI
#define MK_ALIGN_EPI 1
#endif
#ifndef MK_PROBE
#define MK_PROBE 0
#endif
#ifndef PROBE_A
#define PROBE_A 0
#endif
#ifndef PROBE_B
#define PROBE_B 0
#endif
#ifndef CHK_LAYER
#define CHK_LAYER 15
#endif

#define GAS __attribute__((address_space(1)))
#define LAS __attribute__((address_space(3)))
typedef unsigned short bf16_t;
typedef short bf16x8 __attribute__((ext_vector_type(8)));
typedef float f32x4 __attribute__((ext_vector_type(4)));
typedef float f32x2 __attribute__((ext_vector_type(2)));
typedef float f32x16 __attribute__((ext_vector_type(16)));
typedef unsigned u32x4 __attribute__((ext_vector_type(4)));
typedef unsigned u32x2 __attribute__((ext_vector_type(2)));

constexpr int NB = 16, SEQ = 4096, T = NB * SEQ, D = 1024, DEPTH = 4;
constexpr int INW = 2072, INP = 2304;
constexpr int ZKV = 512, ZG = 1280, ZC = 1304, ZS = 1816;
constexpr int DFF = 2816, DFE = 3584, NEXP = 8, PLE = 256;
constexpr int NCMP = 255;
constexpr int S5LC = 32, S5NCH = SEQ / S5LC, S5K = S5LC * 16 + 128;
constexpr float ALPHA = 1.6817928305074290f;
constexpr float LN_EPS = 1e-5f;
constexpr float QSCALE = 0.125f * 1.4426950408889634f;
constexpr float NEGF = -1e30f;
constexpr int MOE_TILES_MAX = 520, MOE_CHUNK_TILES = 128, MOE_NCHUNK = 5;

typedef __bf16 bf16x2_t __attribute__((ext_vector_type(2)));
__device__ __forceinline__ unsigned cvt_pk_bf16(float lo, float hi) { f32x2 v = {lo, hi}; const bf16x2_t b = __builtin_convertvector(v, bf16x2_t); return __builtin_bit_cast(unsigned, b); }
__device__ __forceinline__ bf16_t f2bf(float f) { return (bf16_t)(cvt_pk_bf16(f, 0.f) & 0xffffu); }
__device__ __forceinline__ float bf2f(unsigned v) { return __uint_as_float(v << 16); }
__device__ __forceinline__ float bflo(unsigned w) { return __uint_as_float(w << 16); }
__device__ __forceinline__ float bfhi(unsigned w) { return __uint_as_float(w & 0xffff0000u); }
__device__ __forceinline__ float fast_exp2(float x) { return __builtin_amdgcn_exp2f(x); }
__device__ __forceinline__ float fast_rcp(float x) { return __builtin_amdgcn_rcpf(x); }
__device__ __forceinline__ float sigmoidf_(float x) { return fast_rcp(1.0f + fast_exp2(-1.4426950408889634f * x)); }
__device__ __forceinline__ float siluf_(float x) { return x * sigmoidf_(x); }
__device__ __forceinline__ float gelu_tanh(float x) { const float u = 0.7978845608028654f * (x + 0.044715f * x * x * x); return x * sigmoidf_(2.0f * u); }
__device__ __forceinline__ int lane_id_fresh() { unsigned z = 0u; asm volatile("" : "+v"(z)); return (int)__builtin_amdgcn_mbcnt_hi(~0u, __builtin_amdgcn_mbcnt_lo(~0u, z)); }
template <int MASK> __device__ __forceinline__ float xshfl(float v) {
    if (MASK == 1) return __uint_as_float((unsigned)__builtin_amdgcn_update_dpp(0, (int)__float_as_uint(v), 0xB1, 0xF, 0xF, true));
    if (MASK == 2) return __uint_as_float((unsigned)__builtin_amdgcn_update_dpp(0, (int)__float_as_uint(v), 0x4E, 0xF, 0xF, true));
    if (MASK == 32) { const unsigned u = __float_as_uint(v); auto rr = __builtin_amdgcn_permlane32_swap(u, u, false, false); return __uint_as_float((rr[0] == u) ? rr[1] : rr[0]); }
    return __uint_as_float((unsigned)__builtin_amdgcn_ds_swizzle((int)__float_as_uint(v), 0x1f | (MASK << 10)));
}
__device__ __forceinline__ float xsum32(float v) { const unsigned u = __float_as_uint(v); auto rr = __builtin_amdgcn_permlane32_swap(u, u, false, false); return __uint_as_float(rr[0]) + __uint_as_float(rr[1]); }
__device__ __forceinline__ float xsum16(float v) { const unsigned u = __float_as_uint(v); auto rr = __builtin_amdgcn_permlane16_swap(u, u, false, false); return __uint_as_float(rr[0]) + __uint_as_float(rr[1]); }
__device__ __forceinline__ float swapsum32(float a, float b) { auto rr = __builtin_amdgcn_permlane32_swap(__float_as_uint(a), __float_as_uint(b), false, false); return __uint_as_float(rr[0]) + __uint_as_float(rr[1]); }
__device__ __forceinline__ float swapsum16(float a, float b) { auto rr = __builtin_amdgcn_permlane16_swap(__float_as_uint(a), __float_as_uint(b), false, false); return __uint_as_float(rr[0]) + __uint_as_float(rr[1]); }
__device__ __forceinline__ float dpp_half_mirror(float v) { return __uint_as_float((unsigned)__builtin_amdgcn_update_dpp(0, (int)__float_as_uint(v), 0x141, 0xF, 0xF, true)); }
__device__ __forceinline__ float wave_sum(float v) {
    v += xshfl<1>(v); v += xshfl<2>(v);
    v += __uint_as_float((unsigned)__builtin_amdgcn_update_dpp(0, (int)__float_as_uint(v), 0x141, 0xF, 0xF, true));
    v += __uint_as_float((unsigned)__builtin_amdgcn_update_dpp(0, (int)__float_as_uint(v), 0x140, 0xF, 0xF, true));
    v = xsum16(v); v = xsum32(v);
    return v;
}
#define LDS_WAIT() asm volatile("s_waitcnt lgkmcnt(0)" ::: "memory")
#define VM_WAIT() asm volatile("s_waitcnt vmcnt(0)" ::: "memory")

namespace pg8 {
constexpr int BM = 256, BK = 64, HALF = 128, HTB = HALF * BK * 2, STAGE_BYTES = 8 * HTB, NXCD = 8, WGM = 8;
__host__ __device__ __forceinline__ int lds_byte(int r, int c) { const int st = (r >> 4) * 2 + (c >> 5), rr = r & 15, cc = c & 31, ob = rr * 64 + cc * 2; return st * 1024 + (ob ^ (((ob >> 9) & 1) << 5)); }
__host__ __device__ __forceinline__ void stage_rc(int b, int& R, int& C) { const int st = b / 1024, sb = b % 1024, swz = sb ^ (((sb >> 9) & 1) << 5); R = (st >> 1) * 16 + swz / 64; C = (st & 1) * 32 + (swz % 64) / 2; }
__host__ __device__ __forceinline__ int perm32(int rho) { const int n = rho >> 4, i = rho & 15; return 8 * (i >> 2) + 4 * n + (i & 3); }

struct Unit { int pm, pn; long long offA, offB; int aux; };
struct Gemm { const bf16_t* A; const bf16_t* Bt; int K, lda, ldb; };

__device__ __forceinline__ bool static_tile(int i, int G, int c, int nM, int nN, int& pm, int& pn) {
    const int nwg = nM * nN; const long L = (long)i * G + c; if (L >= nwg) return false;
    int wgid = (int)L; { const int q = nwg / NXCD, r = nwg % NXCD, xcd = wgid % NXCD, off = wgid / NXCD; wgid = (xcd < r ? xcd * (q + 1) : r * (q + 1) + (xcd - r) * q) + off; }
    const int nig = WGM * nN, gid = wgid / nig, fm = gid * WGM, gsz = (nM - fm) < WGM ? (nM - fm) : WGM;
    pm = fm + ((wgid % nig) % gsz); pn = (wgid % nig) / gsz; return true;
}
struct PlainOrder {
    int nM, nN, G, c; long long sA, sB;
    __device__ __forceinline__ bool next(int i, Unit& u) const { if (!static_tile(i, G, c, nM, nN, u.pm, u.pn)) return false; u.offA = (long long)u.pm * sA; u.offB = (long long)u.pn * sB; u.aux = 0; return true; }
};
struct PanelOrder {
    int nM, nN, G, c; long long sA, sB;
    __device__ __forceinline__ bool next(int i, Unit& u) const { const int pm = c + G * (i / nN); if (pm >= nM) return false; u.pm = pm; u.pn = i % nN; u.offA = (long long)pm * sA; u.offB = (long long)u.pn * sB; u.aux = 0; return true; }
};
struct ListOrder {
    int n, pm, aux; long long offA0, offB0, sB;
    __device__ __forceinline__ bool next(int i, Unit& u) const { if (i >= n) return false; u.pm = pm; u.pn = i; u.aux = aux; u.offA = offA0; u.offB = offB0 + (long long)i * sB; return true; }
};
struct GroupedOrder {
    int ng, nM, nN, G, c; long long sA, sB, gA, gB;
    __device__ __forceinline__ bool next(int i, Unit& u) const {
        const long L = (long)i * G + c; const int per = nM * nN; if (L >= (long)ng * per) return false;
        const int gi = (int)(L / per), r = (int)(L % per); u.pm = r / nN; u.pn = r % nN; u.aux = gi;
        u.offA = (long long)gi * gA + (long long)u.pm * sA; u.offB = (long long)gi * gB + (long long)u.pn * sB; return true; }
};

template <class Epi, class Sched>
__device__ __forceinline__ void gemm_phase(LAS unsigned char* lds, const Gemm g, const Sched& S, const Epi& E, int tid_in) {
    int tid_ = tid_in; asm volatile("" : "+v"(tid_));
    const int tid = tid_, wid = __builtin_amdgcn_readfirstlane(tid >> 6), lane = tid & 63, wr = wid >> 2, wc = wid & 3, fr = lane & 15, fq = lane >> 4;
    int K_ = g.K; asm volatile("" : "+s"(K_));
    const int K = K_, nt = K / BK; (void)K;
    unsigned voffA[2], voffB[2];
#pragma unroll
    for (int i = 0; i < 2; ++i) { int R, C; stage_rc(tid * 16 + i * 8192, R, C); const int Rb = Epi::PERM ? ((R & ~31) + perm32(R & 31)) : R;
        voffA[i] = (unsigned)(R * g.lda + C) * 2u; voffB[i] = (unsigned)(Rb * g.ldb + C) * 2u; }
    const size_t kstep = (size_t)(BK * 2);
    const size_t hstepA = (size_t)HALF * g.lda * 2, hstepB = (size_t)HALF * g.ldb * 2;
    const unsigned ldsw = (unsigned)wid * 1024u;
    const int aoff = lds_byte(wr * 64 + fr, fq * 8), boff = lds_byte(wc * 32 + fr, fq * 8);
#define PG8_SA(b, h) (((b) * 2 + (h)) * HTB)
#define PG8_SB(b, h) ((4 + (b) * 2 + (h)) * HTB)
#define PG8_STAGE(bufoff, gbase, voff) do { _Pragma("unroll") for (int _i = 0; _i < 2; ++_i) \
        __builtin_amdgcn_global_load_lds((const unsigned*)((const char*)(gbase) + (voff)[_i]), (LAS unsigned*)(lds + (bufoff) + ldsw + _i * 8192), 16, 0, 0); } while (0)
#define PG8_LDA(dst, b, h) do { _Pragma("unroll") for (int m = 0; m < 4; ++m) _Pragma("unroll") for (int k = 0; k < 2; ++k) dst[m][k] = *(const LAS bf16x8*)(lds + PG8_SA(b, h) + aoff + m * 2048 + k * 1024); } while (0)
#define PG8_LDB(dst, b, h) do { _Pragma("unroll") for (int n = 0; n < 2; ++n) _Pragma("unroll") for (int k = 0; k < 2; ++k) dst[n][k] = *(const LAS bf16x8*)(lds + PG8_SB(b, h) + boff + n * 2048 + k * 1024); } while (0)
#define PG8_MMA(ai, bj, At, Bt) do { __builtin_amdgcn_s_setprio(1); _Pragma("unroll") for (int m = 0; m < 4; ++m) _Pragma("unroll") for (int n = 0; n < 2; ++n) _Pragma("unroll") for (int k = 0; k < 2; ++k) \
        acc[ai][bj][m][n] = __builtin_amdgcn_mfma_f32_16x16x32_bf16(Bt[n][k], At[m][k], acc[ai][bj][m][n], 0, 0, 0); __builtin_amdgcn_s_setprio(0); } while (0)
#define PG8_WAIT_V(n) asm volatile("s_waitcnt vmcnt(" #n ")" ::: "memory")
#define PG8_WAIT_L(n) asm volatile("s_waitcnt lgkmcnt(" #n ")" ::: "memory")
#define PG8_BAR __builtin_amdgcn_s_barrier()
#define PG8_SCHED __builtin_amdgcn_sched_barrier(0)
    Unit cur, nxt; int ui = 0;
    if (!S.next(0, cur)) return;
    f32x4 acc[2][2][4][2];
#pragma unroll
    for (int a = 0; a < 2; ++a)
#pragma unroll
        for (int b = 0; b < 2; ++b)
#pragma unroll
            for (int m = 0; m < 4; ++m)
#pragma unroll
                for (int n = 0; n < 2; ++n) acc[a][b][m][n] = (f32x4){0.f, 0.f, 0.f, 0.f};
    bf16x8 At[4][2], B0[2][2], B1[2][2];
    const char* cA = (const char*)g.A + cur.offA; const char* cB = (const char*)g.Bt + cur.offB;
    PG8_STAGE(PG8_SB(0, 0), cB, voffB); PG8_STAGE(PG8_SB(0, 1), cB + hstepB, voffB); PG8_STAGE(PG8_SA(0, 0), cA, voffA); PG8_STAGE(PG8_SA(0, 1), cA + hstepA, voffA);
    if (wr == 1) PG8_BAR;
    PG8_WAIT_V(2); PG8_BAR;
    PG8_STAGE(PG8_SB(1, 0), cB + kstep, voffB); PG8_STAGE(PG8_SA(1, 0), cA + kstep, voffA); PG8_STAGE(PG8_SB(1, 1), cB + hstepB + kstep, voffB);
    PG8_WAIT_V(6); PG8_BAR;
    for (;;) {
        const bool has_next = S.next(ui + 1, nxt);
        const char* nA = has_next ? (const char*)g.A + nxt.offA : cA; const char* nB = has_next ? (const char*)g.Bt + nxt.offB : cB;
        for (int t = 0; t < nt; t += 2) {
            const bool last = (t == nt - 2);
            const char* a1 = cA + (size_t)(t + 1) * kstep;
            const char* a2 = last ? nA : cA + (size_t)(t + 2) * kstep; const char* b2 = last ? nB : cB + (size_t)(t + 2) * kstep;
            const char* a3 = a2 + kstep; const char* b3 = b2 + kstep;
            PG8_LDB(B0, 0, 0); PG8_LDB(B1, 0, 1); PG8_SCHED; PG8_LDA(At, 0, 0); PG8_STAGE(PG8_SA(1, 1), a1 + hstepA, voffA);
            PG8_WAIT_V(8); PG8_WAIT_L(0); PG8_BAR; PG8_MMA(0, 0, At, B0); PG8_MMA(0, 1, At, B1); PG8_BAR; PG8_SCHED;
            PG8_LDA(At, 0, 1); PG8_STAGE(PG8_SB(0, 0), b2, voffB); PG8_STAGE(PG8_SB(0, 1), b2 + hstepB, voffB); PG8_STAGE(PG8_SA(0, 0), a2, voffA);
            PG8_WAIT_V(8); PG8_WAIT_L(0); PG8_BAR; PG8_MMA(1, 0, At, B0); PG8_MMA(1, 1, At, B1); PG8_BAR; PG8_SCHED;
            PG8_LDB(B0, 1, 0); PG8_LDB(B1, 1, 1); PG8_SCHED; PG8_LDA(At, 1, 0); PG8_STAGE(PG8_SA(0, 1), a2 + hstepA, voffA);
            PG8_WAIT_V(8); PG8_WAIT_L(0); PG8_BAR; PG8_MMA(0, 0, At, B0); PG8_MMA(0, 1, At, B1); PG8_BAR; PG8_SCHED;
            PG8_LDA(At, 1, 1); PG8_STAGE(PG8_SB(1, 0), b3, voffB); PG8_STAGE(PG8_SB(1, 1), b3 + hstepB, voffB); PG8_STAGE(PG8_SA(1, 0), a3, voffA);
            PG8_WAIT_V(8); PG8_WAIT_L(0); PG8_BAR; PG8_MMA(1, 0, At, B0); PG8_MMA(1, 1, At, B1); PG8_BAR; PG8_SCHED;
        }
#if MK_ALIGN_EPI
        if (wr == 0) PG8_BAR;
#endif
        { int fr_ = fr, fq_ = fq; asm volatile("" : "+v"(fr_), "+v"(fq_));
          E(acc, cur, wr, wc, fr_, fq_); }
        if (!has_next) break;
#pragma unroll
        for (int a = 0; a < 2; ++a)
#pragma unroll
            for (int b = 0; b < 2; ++b)
#pragma unroll
                for (int m = 0; m < 4; ++m)
#pragma unroll
                    for (int n = 0; n < 2; ++n) acc[a][b][m][n] = (f32x4){0.f, 0.f, 0.f, 0.f};
        cur = nxt; cA = nA; cB = nB; ++ui;
#if MK_ALIGN_EPI
        if (wr == 1) PG8_BAR;
#endif
    }
    PG8_WAIT_V(0);
#if !MK_ALIGN_EPI
    if (wr == 0) PG8_BAR;
#endif
    PG8_BAR;
#undef PG8_SA
#undef PG8_SB
#undef PG8_STAGE
#undef PG8_LDA
#undef PG8_LDB
#undef PG8_MMA
#undef PG8_WAIT_V
#undef PG8_WAIT_L
#undef PG8_BAR
#undef PG8_SCHED
}
}

#define XB_TMO      128
#define XB_XCNT(j)  (256  + 64 * (j))
#define XB_XSUB(j)  (1280 + 64 * (j))
#define XB_XGEN(j)  (2304 + 64 * (j))
#define XB_TOP      3328
#define XB_TOPGEN   3392
#define XCD_BAR_WORDS 3456
#define XB_SPIN_CAP (1u << 20)
__device__ __forceinline__ unsigned xb_ld(unsigned* p)              { return __hip_atomic_load(p, __ATOMIC_RELAXED, __HIP_MEMORY_SCOPE_AGENT); }
__device__ __forceinline__ unsigned xb_add(unsigned* p, unsigned v) { return __hip_atomic_fetch_add(p, v, __ATOMIC_RELAXED, __HIP_MEMORY_SCOPE_AGENT); }
__device__ __forceinline__ unsigned xb_xcc_id() { return (unsigned)__builtin_amdgcn_s_getreg((3 << 11) | 20) & 0xFu; }
#define XB_SPIN(cond, bar) do { unsigned _sp = 0; while (cond) { __builtin_amdgcn_s_sleep(1); \
    if ((++_sp & 255u) == 0u) { if (xb_ld(&(bar)[XB_TMO])) break; if (_sp > XB_SPIN_CAP) { atomicAdd(&(bar)[XB_TMO], 1u); break; } } } } while (0)
struct XcdBarrier { unsigned* bar; unsigned x; volatile LAS unsigned* st; };
__device__ __forceinline__ XcdBarrier xcd_barrier_post(unsigned* bar, volatile LAS unsigned* st) {
    XcdBarrier b; b.bar = bar; b.x = xb_xcc_id(); b.st = st;
    if (threadIdx.x == 0) (void)xb_add(&bar[XB_XCNT(b.x)], 1u);
    return b;
}
__device__ __forceinline__ void xcd_barrier_complete(unsigned* bar, unsigned x, unsigned& nloc, unsigned& nx) {
    const unsigned G = gridDim.x * gridDim.y * gridDim.z;
    unsigned sum, cnt, mine, sp = 0u;
    for (;;) {
        sum = 0u; cnt = 0u; mine = 0u;
#pragma unroll 1
        for (unsigned j = 0; j < 16; ++j) { const unsigned c = xb_ld(&bar[XB_XCNT(j)]); sum += c; cnt += (c > 0u) ? 1u : 0u; mine = (j == x) ? c : mine; }
        if (sum == G) break;
        __builtin_amdgcn_s_sleep(1);
        if ((++sp & 255u) == 0u) { if (xb_ld(&bar[XB_TMO])) break; if (sp > XB_SPIN_CAP) { atomicAdd(&bar[XB_TMO], 1u); break; } }
    }
    nloc = mine > 0u ? mine : 1u; nx = cnt > 0u ? cnt : 1u;
}
__device__ __forceinline__ void xcd_barrier(const XcdBarrier& b, int wave_id) {
    asm volatile("s_waitcnt vmcnt(0)" ::: "memory");
    __syncthreads();
    if (wave_id == 0 && lane_id_fresh() == 0) {
        unsigned* bar = b.bar; asm volatile("" : "+s"(bar));
        __builtin_amdgcn_s_waitcnt(0);
        unsigned nloc = b.st[0], nx = b.st[1];
        if (nloc == 0u) { xcd_barrier_complete(bar, b.x, nloc, nx); b.st[0] = nloc; b.st[1] = nx; }
        const unsigned old = xb_add(&bar[XB_XSUB(b.x)], 1u);
        const unsigned gen = old / nloc;
        if (old + 1u == (gen + 1u) * nloc) {
            __builtin_amdgcn_fence(__ATOMIC_RELEASE, "agent");
            asm volatile("s_waitcnt vmcnt(0)" ::: "memory");
            const unsigned og = xb_add(&bar[XB_TOP], 1u);
            const unsigned tg = og / nx;
            if (og + 1u == (tg + 1u) * nx) xb_add(&bar[XB_TOPGEN], 1u);
            else XB_SPIN(xb_ld(&bar[XB_TOPGEN]) == tg, bar);
            __builtin_amdgcn_fence(__ATOMIC_ACQUIRE, "agent");
            xb_add(&bar[XB_XGEN(b.x)], 1u);
            asm volatile("s_waitcnt vmcnt(0)" ::: "memory");
        } else {
            XB_SPIN(xb_ld(&bar[XB_XGEN(b.x)]) == gen, bar);
            __builtin_amdgcn_fence(__ATOMIC_ACQUIRE, "agent");
            asm volatile("s_waitcnt vmcnt(0)" ::: "memory");
        }
    }
    __syncthreads();
}
namespace nsa {
constexpr int PITCH = 144, TILE_LDS = 64 * PITCH;
__device__ __forceinline__ int crow(int r, int hi) { return (r & 3) + 8 * (r >> 2) + 4 * hi; }
__device__ __forceinline__ int vslot(int kk) { return (kk & 0x33) | (((kk >> 2) & 1) << 3) | (((kk >> 3) & 1) << 2); }

struct Lane { int lane, c, hi, wid, tid; };

__device__ __forceinline__ void qk_tile(f32x16& p0, f32x16& p1, const LAS unsigned char* Ks, const bf16x8 (&qr)[4], float bias, const Lane& L) {
#pragma unroll
    for (int r = 0; r < 16; ++r) { p0[r] = bias; p1[r] = bias; }
    const LAS unsigned char* kb = Ks + L.c * PITCH + L.hi * 16;
#pragma unroll
    for (int d0 = 0; d0 < 4; ++d0) {
        const bf16x8 k0 = *(const LAS bf16x8*)(kb + d0 * 32);
        const bf16x8 k1 = *(const LAS bf16x8*)(kb + 32 * PITCH + d0 * 32);
        p0 = __builtin_amdgcn_mfma_f32_32x32x16_bf16(k0, qr[d0], p0, 0, 0, 0);
        p1 = __builtin_amdgcn_mfma_f32_32x32x16_bf16(k1, qr[d0], p1, 0, 0, 0);
    }
}
__device__ __forceinline__ void qk_tile_c(f32x16& p0, f32x16& p1, const LAS unsigned char* Ks, const bf16x8 (&qr)[4], const f32x16& cv, const Lane& L) {
    const LAS unsigned char* kb = Ks + L.c * PITCH + L.hi * 16;
    { const bf16x8 k0 = *(const LAS bf16x8*)(kb); const bf16x8 k1 = *(const LAS bf16x8*)(kb + 32 * PITCH);
      p0 = __builtin_amdgcn_mfma_f32_32x32x16_bf16(k0, qr[0], cv, 0, 0, 0); p1 = __builtin_amdgcn_mfma_f32_32x32x16_bf16(k1, qr[0], cv, 0, 0, 0); }
#pragma unroll
    for (int d0 = 1; d0 < 4; ++d0) {
        const bf16x8 k0 = *(const LAS bf16x8*)(kb + d0 * 32);
        const bf16x8 k1 = *(const LAS bf16x8*)(kb + 32 * PITCH + d0 * 32);
        p0 = __builtin_amdgcn_mfma_f32_32x32x16_bf16(k0, qr[d0], p0, 0, 0, 0);
        p1 = __builtin_amdgcn_mfma_f32_32x32x16_bf16(k1, qr[d0], p1, 0, 0, 0);
    }
}
__device__ __forceinline__ void mask_range(f32x16& p0, f32x16& p1, int lo, int hi_, int hi) {
#pragma unroll
    for (int r = 0; r < 16; ++r) { const int k0 = crow(r, hi), k1 = k0 + 32;
        if (k0 <= lo || k0 > hi_) p0[r] = NEGF;
        if (k1 <= lo || k1 > hi_) p1[r] = NEGF; }
}
__device__ __forceinline__ float tile_max(const f32x16& p0, const f32x16& p1) {
    float a = fmaxf(p0[0], p1[0]);
#pragma unroll
    for (int r = 1; r < 16; ++r) a = fmaxf(a, fmaxf(p0[r], p1[r]));
    return fmaxf(a, xshfl<32>(a));
}
__device__ __forceinline__ void pv_tile(f32x16& o0, f32x16& o1, const LAS unsigned char* Vs, const f32x16& p0, const f32x16& p1, const Lane& L) {
    const LAS unsigned char* vb = Vs + L.c * PITCH + L.hi * 16;
#pragma unroll
    for (int s = 0; s < 4; ++s) {
        u32x4 w;
        if (s < 2) { const int b = 8 * (s & 1); w.x = cvt_pk_bf16(p0[b], p0[b + 1]); w.y = cvt_pk_bf16(p0[b + 2], p0[b + 3]); w.z = cvt_pk_bf16(p0[b + 4], p0[b + 5]); w.w = cvt_pk_bf16(p0[b + 6], p0[b + 7]); }
        else       { const int b = 8 * (s & 1); w.x = cvt_pk_bf16(p1[b], p1[b + 1]); w.y = cvt_pk_bf16(p1[b + 2], p1[b + 3]); w.z = cvt_pk_bf16(p1[b + 4], p1[b + 5]); w.w = cvt_pk_bf16(p1[b + 6], p1[b + 7]); }
        const bf16x8 pf = __builtin_bit_cast(bf16x8, w);
        const bf16x8 v0 = *(const LAS bf16x8*)(vb + s * 32);
        const bf16x8 v1 = *(const LAS bf16x8*)(vb + 32 * PITCH + s * 32);
        o0 = __builtin_amdgcn_mfma_f32_32x32x16_bf16(v0, pf, o0, 0, 0, 0);
        o1 = __builtin_amdgcn_mfma_f32_32x32x16_bf16(v1, pf, o1, 0, 0, 0);
        if (s & 1) __builtin_amdgcn_sched_barrier(0);
    }
}
__device__ __forceinline__ void softmax_pv(f32x16& p0, f32x16& p1, f32x16& o0, f32x16& o1, float& m, float& l, const LAS unsigned char* Vs, const Lane& L) {
    const float mx = tile_max(p0, p1), mn = fmaxf(m, mx), alpha = fast_exp2(m - mn); m = mn;
    float ls = 0.f;
#pragma unroll
    for (int r = 0; r < 16; ++r) { p0[r] = fast_exp2(p0[r] - mn); p1[r] = fast_exp2(p1[r] - mn); ls += p0[r] + p1[r]; }
    l = l * alpha + ls;
#pragma unroll
    for (int r = 0; r < 16; ++r) { o0[r] *= alpha; o1[r] *= alpha; }
    pv_tile(o0, o1, Vs, p0, p1, L);
}
__device__ __forceinline__ int stage_off(int tid) { return (tid >> 3) * PITCH + (tid & 7) * 16; }

__device__ __forceinline__ void load_q(bf16x8 (&qr)[4], const bf16_t* qbuf, long tok, int head, int hi) {
    const bf16_t* qp = qbuf + tok * 512 + head * 64 + hi * 8;
#pragma unroll
    for (int d0 = 0; d0 < 4; ++d0) qr[d0] = *(const bf16x8*)(qp + d0 * 16);
}

__device__ __forceinline__ u32x4 vload(const bf16_t* Vt, int j, const Lane& L) { return *(const u32x4*)((const char*)Vt + (size_t)j * 8192 + L.lane * 128 + L.wid * 16); }
__device__ __forceinline__ void vstore(LAS unsigned char* Vs, const u32x4 v, const Lane& L) {
    LAS unsigned short* p = (LAS unsigned short*)(Vs + (8 * L.wid) * PITCH) + vslot(L.lane);
    p[0 * (PITCH / 2)] = (unsigned short)(v.x & 0xffffu); p[1 * (PITCH / 2)] = (unsigned short)(v.x >> 16); p[2 * (PITCH / 2)] = (unsigned short)(v.y & 0xffffu); p[3 * (PITCH / 2)] = (unsigned short)(v.y >> 16);
    p[4 * (PITCH / 2)] = (unsigned short)(v.z & 0xffffu); p[5 * (PITCH / 2)] = (unsigned short)(v.z >> 16); p[6 * (PITCH / 2)] = (unsigned short)(v.w & 0xffffu); p[7 * (PITCH / 2)] = (unsigned short)(v.w >> 16);
}
template <int MODE>
__device__ __forceinline__ void run_branch(f32x16& o0, f32x16& o1, float& mref, float& l, const bf16_t* Kt  , const bf16_t* Vt  ,
                                           int jlo, int jhi, int qb, int qrel, unsigned long long selw, const bf16x8 (&qr)[4], LAS unsigned char* lds, const Lane& L) {
    LAS unsigned char* Kbuf = lds; LAS unsigned char* Vbuf = lds + 2 * TILE_LDS;
    const int so = stage_off(L.tid);
    u32x4 kreg = *(const u32x4*)((const char*)Kt + (size_t)jlo * 8192 + L.tid * 16);
    u32x4 vreg = vload(Vt, jlo, L);
    *(LAS u32x4*)(Kbuf + so) = kreg; vstore(Vbuf, vreg, L);
    __syncthreads();
    f32x16 cv;
#pragma unroll
    for (int r = 0; r < 16; ++r) cv[r] = -mref;
    for (int j = jlo; j <= jhi; ++j) {
        const int cur = (j - jlo) & 1;
        if (j < jhi) { kreg = *(const u32x4*)((const char*)Kt + (size_t)(j + 1) * 8192 + L.tid * 16); vreg = vload(Vt, j + 1, L); }
        f32x16 p0, p1;
        if (MODE == 0) { const float cb = ((selw >> j) & 1ull) ? -mref : NEGF;
#pragma unroll
            for (int r = 0; r < 16; ++r) cv[r] = cb; }
        qk_tile_c(p0, p1, Kbuf + cur * TILE_LDS, qr, cv, L);
        if (j == qb) mask_range(p0, p1, -1, qrel, L.hi);
        if (MODE == 1 && j == qb - 8) mask_range(p0, p1, qrel, 64, L.hi);
        const float mx = tile_max(p0, p1);
        if (__any(mx > 8.0f)) {
            const float dl = fmaxf(mx, 0.f), f = fast_exp2(-dl); mref += dl; l *= f;
#pragma unroll
            for (int r = 0; r < 16; ++r) { o0[r] *= f; o1[r] *= f; p0[r] -= dl; p1[r] -= dl; }
            if (MODE == 1) {
#pragma unroll
                for (int r = 0; r < 16; ++r) cv[r] = -mref; }
        }
        float ls = 0.f;
#pragma unroll
        for (int r = 0; r < 16; ++r) { p0[r] = fast_exp2(p0[r]); p1[r] = fast_exp2(p1[r]); ls += p0[r] + p1[r]; }
        l += ls;
        pv_tile(o0, o1, Vbuf + cur * TILE_LDS, p0, p1, L);
        if (j < jhi) { *(LAS u32x4*)(Kbuf + (cur ^ 1) * TILE_LDS + so) = kreg; vstore(Vbuf + (cur ^ 1) * TILE_LDS, vreg, L); }
        __syncthreads();
    }
}
struct SoftState { float mref, l; };
__device__ __forceinline__ void softmax_step2(f32x16& p0, f32x16& p1, f32x16& o0, f32x16& o1, SoftState& st, bool sel, bf16x8 (&pf)[4]) {
    if (__any(st.mref != 0.f)) {
#pragma unroll
        for (int r = 0; r < 16; ++r) { p0[r] -= st.mref; p1[r] -= st.mref; } }
    float ls = 0.f;
#pragma unroll
    for (int r = 0; r < 16; ++r) { p0[r] = fast_exp2(p0[r]); p1[r] = fast_exp2(p1[r]); ls += p0[r] + p1[r]; }
    ls = sel ? ls : 0.f; st.l += ls;
#pragma unroll
    for (int s = 0; s < 4; ++s) { u32x4 w; const int b = 8 * (s & 1);
        if (s < 2) { w.x = cvt_pk_bf16(p0[b], p0[b + 1]); w.y = cvt_pk_bf16(p0[b + 2], p0[b + 3]); w.z = cvt_pk_bf16(p0[b + 4], p0[b + 5]); w.w = cvt_pk_bf16(p0[b + 6], p0[b + 7]); }
        else       { w.x = cvt_pk_bf16(p1[b], p1[b + 1]); w.y = cvt_pk_bf16(p1[b + 2], p1[b + 3]); w.z = cvt_pk_bf16(p1[b + 4], p1[b + 5]); w.w = cvt_pk_bf16(p1[b + 6], p1[b + 7]); }
        if (!sel) w = (u32x4){0u, 0u, 0u, 0u};
        pf[s] = __builtin_bit_cast(bf16x8, w); }
}
__device__ __forceinline__ void renorm_step(f32x16& o0, f32x16& o1, SoftState& st) {
    if (__any(st.l > 1.0995116e12f)) { const bool big = st.l > 1.0995116e12f; const float f = big ? 9.094947e-13f : 1.0f; st.mref += big ? 40.f : 0.f; st.l *= f;
#pragma unroll
        for (int r = 0; r < 16; ++r) { o0[r] *= f; o1[r] *= f; } }
}
template <int MODE>
__device__ __forceinline__ void run_branch2(f32x16& oa0, f32x16& oa1, SoftState& sa, f32x16& ob0, f32x16& ob1, SoftState& sb, const bf16_t* Kt, const bf16_t* Vt, int jlo, int jhi, int qbw, int qrela,
                                            const LAS unsigned long long* selp  , const bf16x8 (&qa)[4], const bf16x8 (&qbf)[4], LAS unsigned char* lds, const Lane& L) {
    LAS unsigned char* Kbuf = lds; LAS unsigned char* Vbuf = lds + 2 * TILE_LDS;
    const int so = stage_off(L.tid);
    {   const u32x4 kreg = *(const u32x4*)((const char*)Kt + (size_t)jlo * 8192 + L.tid * 16); const u32x4 vreg = vload(Vt, jlo, L);
        *(LAS u32x4*)(Kbuf + so) = kreg; vstore(Vbuf, vreg, L); }
    __syncthreads();
    for (int j = jlo; j <= jhi; ++j) {
        const int cur = (j - jlo) & 1;
        const bool act = (j <= qbw) && (MODE == 0 || j >= qbw - 8);
        u32x4 kreg, vreg;
        bf16x8 fa[4], fb[4];
        if (act) {
            f32x16 pa0, pa1, pb0, pb1;
#pragma unroll
            for (int r = 0; r < 16; ++r) { pa0[r] = 0.f; pa1[r] = 0.f; pb0[r] = 0.f; pb1[r] = 0.f; }
            const LAS unsigned char* kb = Kbuf + cur * TILE_LDS + L.c * PITCH + L.hi * 16;
#pragma unroll
            for (int d0 = 0; d0 < 4; ++d0) { const bf16x8 k0 = *(const LAS bf16x8*)(kb + d0 * 32); const bf16x8 k1 = *(const LAS bf16x8*)(kb + 32 * PITCH + d0 * 32);
                pa0 = __builtin_amdgcn_mfma_f32_32x32x16_bf16(k0, qa[d0], pa0, 0, 0, 0); pa1 = __builtin_amdgcn_mfma_f32_32x32x16_bf16(k1, qa[d0], pa1, 0, 0, 0);
                pb0 = __builtin_amdgcn_mfma_f32_32x32x16_bf16(k0, qbf[d0], pb0, 0, 0, 0); pb1 = __builtin_amdgcn_mfma_f32_32x32x16_bf16(k1, qbf[d0], pb1, 0, 0, 0); }
            if (j == qbw) { mask_range(pa0, pa1, -1, qrela, L.hi); mask_range(pb0, pb1, -1, qrela + 8, L.hi); }
            if (MODE == 1 && j == qbw - 8) { mask_range(pa0, pa1, qrela, 64, L.hi); mask_range(pb0, pb1, qrela + 8, 64, L.hi); }
            bool sela = true, selb = true;
            if (MODE == 0) { sela = (selp[0] >> j) & 1ull; selb = (selp[1] >> j) & 1ull; }
            softmax_step2(pa0, pa1, oa0, oa1, sa, sela, fa);
            __builtin_amdgcn_sched_barrier(0);
            softmax_step2(pb0, pb1, ob0, ob1, sb, selb, fb);
            __builtin_amdgcn_sched_barrier(0);
        }
        if (j < jhi) { kreg = *(const u32x4*)((const char*)Kt + (size_t)(j + 1) * 8192 + L.tid * 16); vreg = vload(Vt, j + 1, L); }
        if (act) {
            const LAS unsigned char* vb = Vbuf + cur * TILE_LDS + L.c * PITCH + L.hi * 16;
#pragma unroll
            for (int s = 0; s < 4; ++s) {
                const bf16x8 v0 = *(const LAS bf16x8*)(vb + s * 32); const bf16x8 v1 = *(const LAS bf16x8*)(vb + 32 * PITCH + s * 32);
                oa0 = __builtin_amdgcn_mfma_f32_32x32x16_bf16(v0, fa[s], oa0, 0, 0, 0); oa1 = __builtin_amdgcn_mfma_f32_32x32x16_bf16(v1, fa[s], oa1, 0, 0, 0);
                ob0 = __builtin_amdgcn_mfma_f32_32x32x16_bf16(v0, fb[s], ob0, 0, 0, 0); ob1 = __builtin_amdgcn_mfma_f32_32x32x16_bf16(v1, fb[s], ob1, 0, 0, 0); }
            renorm_step(oa0, oa1, sa); renorm_step(ob0, ob1, sb);
        }
        if (j < jhi) { *(LAS u32x4*)(Kbuf + (cur ^ 1) * TILE_LDS + so) = kreg; vstore(Vbuf + (cur ^ 1) * TILE_LDS, vreg, L); }
        __syncthreads();
    }
}
}
namespace nsa {
struct AttnPtrs {
    const bf16_t* q;
    const bf16_t* z;
    const bf16_t* kc;
    const bf16_t* vct;
    const bf16_t* ksel;
    const bf16_t* vselt;
    const bf16_t* kwin; const bf16_t* vwint;
    unsigned long long* selmask;
    bf16_t* mix;
};
template <bool ACCUM>
__device__ __forceinline__ void store_o(const f32x16& a0, const f32x16& a1, bf16_t* mix, long tok, int head, int hi) {
    bf16_t* op = mix + tok * 1024 + head * 64 + 4 * hi;
#pragma unroll
    for (int dd = 0; dd < 2; ++dd)
#pragma unroll
        for (int rq = 0; rq < 4; ++rq) {
            float v0, v1, v2, v3;
            if (dd == 0) { v0 = a0[4 * rq]; v1 = a0[4 * rq + 1]; v2 = a0[4 * rq + 2]; v3 = a0[4 * rq + 3]; }
            else         { v0 = a1[4 * rq]; v1 = a1[4 * rq + 1]; v2 = a1[4 * rq + 2]; v3 = a1[4 * rq + 3]; }
            u32x2* p = (u32x2*)(op + dd * 32 + rq * 8);
            if (ACCUM) { const u32x2 old = *p; v0 += bflo(old.x); v1 += bfhi(old.x); v2 += bflo(old.y); v3 += bfhi(old.y); }
            u32x2 w; w.x = cvt_pk_bf16(v0, v1); w.y = cvt_pk_bf16(v2, v3); *p = w;
        }
}
__device__ __forceinline__ float gate_of(const bf16_t* z, long tok, int head, int br) { return sigmoidf_(bf2f(z[tok * INP + ZG + head * 3 + br])); }

struct CmpPre { bf16x8 qr[4]; };
__device__ __forceinline__ void cmp_prefetch(CmpPre& R, int bh, int qb, const AttnPtrs& P, const Lane& L) {
    const int b = bh >> 1, h = bh & 1, tq = qb * 64 + 8 * L.wid + (L.c >> 2), head = 4 * h + (L.c & 3); const long tok = (long)b * SEQ + tq;
    load_q(R.qr, P.q, tok, head, L.hi);
}
__device__ __forceinline__ void cmp_stage(const CmpPre& R, LAS unsigned char* lds, const Lane& L, bf16x8 (&qr)[4], float& gt) {
    (void)lds; (void)L;
#pragma unroll
    for (int d0 = 0; d0 < 4; ++d0) qr[d0] = R.qr[d0];
    gt = 0.f;
}
template <bool STAGE>
__device__ __forceinline__ void cmp_unit(int bh, int qb, const AttnPtrs& P, LAS unsigned char* lds, const Lane& L) {
    const int b = bh >> 1, h = bh & 1, t0 = qb * 64;
    const int ql = 8 * L.wid + (L.c >> 2), g = L.c & 3, tq = t0 + ql, head = 4 * h + g;
    const long tok = (long)b * SEQ + tq;
    LAS unsigned char* Kb = lds; LAS unsigned char* Vb = lds + 4 * TILE_LDS;
    LAS float* G4 = (LAS float*)(lds + 8 * TILE_LDS); LAS float* E3 = G4 + 64 * 64;
    const float gate_raw = bf2f(P.z[tok * INP + ZG + head * 3 + 0]);
    bf16x8 qr[4]; load_q(qr, P.q, tok, head, L.hi);
    if (STAGE) { const char* ks = (const char*)(P.kc + (size_t)bh * 256 * 64); const char* vs = (const char*)(P.vct + (size_t)bh * 256 * 64); const int so = stage_off(L.tid); u32x4 kk[4], vv[4];
#pragma unroll
      for (int jn = 0; jn < 4; ++jn) kk[jn] = *(const u32x4*)(ks + jn * 8192 + L.tid * 16);
#pragma unroll
      for (int jn = 0; jn < 4; ++jn) vv[jn] = *(const u32x4*)(vs + jn * 8192 + L.tid * 16);
#pragma unroll
      for (int jn = 0; jn < 4; ++jn) *(LAS u32x4*)(Kb + jn * TILE_LDS + so) = kk[jn];
#pragma unroll
      for (int jn = 0; jn < 4; ++jn) *(LAS u32x4*)(Vb + jn * TILE_LDS + so) = vv[jn]; }
    __syncthreads();
    const int nmax = (tq >= 31) ? ((tq - 31) >> 4) : -1;
    const int tq_lo = t0 + 8 * L.wid, tq_hi = tq_lo + 7;
    const int nmax_lo = (tq_lo >= 31) ? ((tq_lo - 31) >> 4) : -1, nmax_hi = (tq_hi >= 31) ? ((tq_hi - 31) >> 4) : -1;
    const int ntile = (nmax_hi >= 0) ? (nmax_hi >> 6) + 1 : 0;
    const bool need_imp = qb >= 16;
    float l = 0.f;
    f32x16 o0, o1;
#pragma unroll
    for (int r = 0; r < 16; ++r) { o0[r] = 0.f; o1[r] = 0.f; }
    float gsr[4][8], e3r[4][8];
#pragma unroll
    for (int jn = 0; jn < 4; ++jn)
#pragma unroll
        for (int i = 0; i < 8; ++i) { gsr[jn][i] = 0.f; e3r[jn][i] = 0.f; }
#pragma unroll
    for (int jn = 0; jn < 4; ++jn) {
        if (jn < ntile) {
            f32x16 p0, p1; qk_tile(p0, p1, Kb + jn * TILE_LDS, qr, 0.f, L);
            if (64 * jn + 63 > nmax_lo) mask_range(p0, p1, -1, nmax - 64 * jn, L.hi);
            float ls = 0.f;
#pragma unroll
            for (int r = 0; r < 16; ++r) { p0[r] = fast_exp2(p0[r]); p1[r] = fast_exp2(p1[r]); ls += p0[r] + p1[r]; }
            l += ls;
            if (need_imp) {
#pragma unroll
                for (int rq = 0; rq < 4; ++rq) { gsr[jn][rq] = (p0[4 * rq] + p0[4 * rq + 1]) + (p0[4 * rq + 2] + p0[4 * rq + 3]); e3r[jn][rq] = p0[4 * rq + 3];
                                                 gsr[jn][4 + rq] = (p1[4 * rq] + p1[4 * rq + 1]) + (p1[4 * rq + 2] + p1[4 * rq + 3]); e3r[jn][4 + rq] = p1[4 * rq + 3]; } }
            pv_tile(o0, o1, Vb + jn * TILE_LDS, p0, p1, L);
        }
        __builtin_amdgcn_sched_barrier(0);
    }
    l = xsum32(l);
    const float inv = (nmax >= 0 && l > 0.f) ? fast_rcp(l) : 0.f;
    if (need_imp) {
        LAS float* gp = G4 + ql * 64 + L.hi; asm volatile("" : "+v"(gp));
#pragma unroll
        for (int jn = 0; jn < 4; ++jn) {
            if (jn < ntile) {
#pragma unroll
                for (int i = 0; i < 8; ++i) { float gs = gsr[jn][i] * inv, e3 = e3r[jn][i] * inv;
                    gs += xshfl<1>(gs); gs += xshfl<2>(gs); e3 += xshfl<1>(e3); e3 += xshfl<2>(e3);
                    if (g == 0) { gp[16 * jn + 2 * i] = gs; gp[64 * 64 + 16 * jn + 2 * i] = e3; } }
            }
        }
    }
    {
        const float gt = sigmoidf_(gate_raw) * inv;
#pragma unroll
        for (int r = 0; r < 16; ++r) { o0[r] *= gt; o1[r] *= gt; }
        store_o<false>(o0, o1, P.mix, tok, head, L.hi);
    }
    __syncthreads();
}
__device__ __forceinline__ void cmp_topk(int bh, int qb, const AttnPtrs& P, LAS unsigned char* lds, const Lane& L) {
    const int t0 = qb * 64; LAS float* G4 = (LAS float*)(lds + 8 * TILE_LDS); LAS float* E3 = G4 + 64 * 64;
    const int s = L.lane;
    if (qb < 16) { const unsigned long long mask = (1ull << (qb + 1)) - 1ull;
        if (L.lane < 8) P.selmask[(size_t)bh * SEQ + t0 + 8 * L.wid + L.lane] = mask; }
    else {
        const bool cand = (s >= 1) && (s <= qb - 2);
        unsigned bits[8], T[8];
#pragma unroll
        for (int i = 0; i < 8; ++i) { const int q = 8 * L.wid + i; const float imp = G4[q * 64 + s] + (s > 0 ? E3[q * 64 + s - 1] : 0.f); bits[i] = cand ? __float_as_uint(fmaxf(imp, 0.f)) : 0u; T[i] = 0u; }
        int cnt[8];
#pragma unroll
        for (int i = 0; i < 8; ++i) cnt[i] = qb - 2;
        for (int bit = 30; bit >= 0; --bit) { int open_ = 0;
#pragma unroll
            for (int i = 0; i < 8; ++i) { const unsigned c = T[i] | (1u << bit); const int n = __popcll(__ballot(cand && bits[i] >= c)); if (n >= 13) { T[i] = c; cnt[i] = n; } open_ |= (cnt[i] != 13); }
            if (!open_) break; }
#pragma unroll
        for (int i = 0; i < 8; ++i) {
            const unsigned long long gt = __ballot(cand && bits[i] > T[i]); unsigned long long eq = __ballot(cand && bits[i] == T[i]);
            int need = 13 - __popcll(gt); unsigned long long take = 0ull;
            while (need > 0 && eq) { const unsigned long long low = eq & (0ull - eq); take |= low; eq ^= low; --need; }
            const unsigned long long mask = gt | take | 1ull | (1ull << qb) | (1ull << (qb - 1));
            if (L.lane == 0) P.selmask[(size_t)bh * SEQ + t0 + 8 * L.wid + i] = mask; }
    }
    __syncthreads();
}

__device__ __forceinline__ void sw_unit(int bh, int qb, const AttnPtrs& P, LAS unsigned char* lds, const Lane& L) {
    const int b = bh >> 1, h = bh & 1, t0 = qb * 64;
    const int ql = 8 * L.wid + (L.c >> 2), g = L.c & 3, tq = t0 + ql, head = 4 * h + g;
    const long tok = (long)b * SEQ + tq;
    bf16x8 qr[4]; load_q(qr, P.q, tok, head, L.hi);
    const unsigned long long selw = P.selmask[(size_t)bh * SEQ + tq];
    const float g1raw = bf2f(P.z[tok * INP + ZG + head * 3 + 1]), g2raw = bf2f(P.z[tok * INP + ZG + head * 3 + 2]);
    f32x16 r0, r1;
    {
        f32x16 o0, o1; float m = 0.f, l = 0.f;
#pragma unroll
        for (int r = 0; r < 16; ++r) { o0[r] = 0.f; o1[r] = 0.f; }
        run_branch<0>(o0, o1, m, l, P.ksel + (size_t)bh * SEQ * 64, P.vselt + (size_t)bh * SEQ * 64, 0, qb, qb, ql, selw, qr, lds, L);
        l = xsum32(l);
        const float sc = sigmoidf_(g1raw) * fast_rcp(l);
#pragma unroll
        for (int r = 0; r < 16; ++r) { r0[r] = o0[r] * sc; r1[r] = o1[r] * sc; }
    }
    {
        f32x16 o0, o1; float m = 0.f, l = 0.f;
#pragma unroll
        for (int r = 0; r < 16; ++r) { o0[r] = 0.f; o1[r] = 0.f; }
        run_branch<1>(o0, o1, m, l, P.kwin + (size_t)bh * SEQ * 64, P.vwint + (size_t)bh * SEQ * 64, qb >= 8 ? qb - 8 : 0, qb, qb, ql, 0ull, qr, lds, L);
        l = xsum32(l);
        const float sc = sigmoidf_(g2raw) * fast_rcp(l);
#pragma unroll
        for (int r = 0; r < 16; ++r) { r0[r] += o0[r] * sc; r1[r] += o1[r] * sc; }
    }
    store_o<true>(r0, r1, P.mix, tok, head, L.hi);
}
__device__ __forceinline__ void sw_unit2(int bh, int qb2, const AttnPtrs& P, LAS unsigned char* lds, const Lane& L) {
    const int b = bh >> 1, h = bh & 1, qbw = 2 * qb2 + (L.wid >> 2);
    const int qrela = 16 * (L.wid & 3) + (L.c >> 2), qrelb = qrela + 8, g = L.c & 3, head = 4 * h + g;
    const long toka = (long)b * SEQ + 64 * qbw + qrela, tokb = toka + 8;
    bf16x8 qa[4], qbf[4]; load_q(qa, P.q, toka, head, L.hi); load_q(qbf, P.q, tokb, head, L.hi);
    LAS unsigned long long* selp = (LAS unsigned long long*)(lds + 4 * TILE_LDS + 8192) + L.tid * 2;
    selp[0] = P.selmask[(size_t)bh * SEQ + 64 * qbw + qrela]; selp[1] = P.selmask[(size_t)bh * SEQ + 64 * qbw + qrelb];
    LAS float* gpark = (LAS float*)(lds + 4 * TILE_LDS) + L.tid * 4;
    gpark[0] = bf2f(P.z[toka * INP + ZG + head * 3 + 1]); gpark[1] = bf2f(P.z[tokb * INP + ZG + head * 3 + 1]); gpark[2] = bf2f(P.z[toka * INP + ZG + head * 3 + 2]); gpark[3] = bf2f(P.z[tokb * INP + ZG + head * 3 + 2]);
    {
        f32x16 oa0, oa1, ob0, ob1; SoftState sa{0.f, 0.f}, sb{0.f, 0.f};
#pragma unroll
        for (int r = 0; r < 16; ++r) { oa0[r] = 0.f; oa1[r] = 0.f; ob0[r] = 0.f; ob1[r] = 0.f; }
        run_branch2<0>(oa0, oa1, sa, ob0, ob1, sb, P.ksel + (size_t)bh * SEQ * 64, P.vselt + (size_t)bh * SEQ * 64, 0, 2 * qb2 + 1, qbw, qrela, selp, qa, qbf, lds, L);
        sa.l = xsum32(sa.l); sb.l = xsum32(sb.l);
        const float sca = sigmoidf_(gpark[0]) * fast_rcp(sa.l), scb = sigmoidf_(gpark[1]) * fast_rcp(sb.l);
#pragma unroll
        for (int r = 0; r < 16; ++r) { oa0[r] *= sca; oa1[r] *= sca; ob0[r] *= scb; ob1[r] *= scb; }
        { int qe = qrela; asm volatile("" : "+v"(qe));
          store_o<true>(oa0, oa1, P.mix, (long)b * SEQ + 64 * qbw + qe, head, L.hi); store_o<true>(ob0, ob1, P.mix, (long)b * SEQ + 64 * qbw + qe + 8, head, L.hi); }
    }
    {
        f32x16 oa0, oa1, ob0, ob1; SoftState sa{0.f, 0.f}, sb{0.f, 0.f};
#pragma unroll
        for (int r = 0; r < 16; ++r) { oa0[r] = 0.f; oa1[r] = 0.f; ob0[r] = 0.f; ob1[r] = 0.f; }
        run_branch2<1>(oa0, oa1, sa, ob0, ob1, sb, P.kwin + (size_t)bh * SEQ * 64, P.vwint + (size_t)bh * SEQ * 64, 2 * qb2 >= 8 ? 2 * qb2 - 8 : 0, 2 * qb2 + 1, qbw, qrela, selp, qa, qbf, lds, L);
        sa.l = xsum32(sa.l); sb.l = xsum32(sb.l);
        const float sca = sigmoidf_(gpark[2]) * fast_rcp(sa.l), scb = sigmoidf_(gpark[3]) * fast_rcp(sb.l);
#pragma unroll
        for (int r = 0; r < 16; ++r) { oa0[r] *= sca; oa1[r] *= sca; ob0[r] *= scb; ob1[r] *= scb; }
        { int qe = qrela; asm volatile("" : "+v"(qe));
          store_o<true>(oa0, oa1, P.mix, (long)b * SEQ + 64 * qbw + qe, head, L.hi); store_o<true>(ob0, ob1, P.mix, (long)b * SEQ + 64 * qbw + qe + 8, head, L.hi); }
    }
}
}
namespace epi {
using pg8::Unit; using pg8::BM; using pg8::HALF;
struct Bf16Plain {
    static constexpr bool PERM = true;
    bf16_t* O; int ldc;
    __device__ __forceinline__ void operator()(const f32x4 (&acc)[2][2][4][2], const Unit& u, int wr, int wc, int fr, int fq) const {
        const int row0 = u.pm * BM + wr * 64 + fr, col0 = u.pn * BM + wc * 32 + 8 * fq;
#pragma unroll
        for (int ai = 0; ai < 2; ++ai)
#pragma unroll
            for (int m = 0; m < 4; ++m) { bf16_t* rowp = O + (size_t)(row0 + ai * HALF + m * 16) * ldc + col0;
#pragma unroll
                for (int bj = 0; bj < 2; ++bj) { const f32x4 v0 = acc[ai][bj][m][0], v1 = acc[ai][bj][m][1];
                    u32x4 w; w.x = cvt_pk_bf16(v0[0], v0[1]); w.y = cvt_pk_bf16(v0[2], v0[3]); w.z = cvt_pk_bf16(v1[0], v1[1]); w.w = cvt_pk_bf16(v1[2], v1[3]);
                    *(u32x4*)(rowp + bj * HALF) = w; } }
    }
};
struct Bf16Sc1 {
    static constexpr bool PERM = true;
    bf16_t* O; int ldc; unsigned nbytes;
    __device__ __forceinline__ void operator()(const f32x4 (&acc)[2][2][4][2], const Unit& u, int wr, int wc, int fr, int fq) const {
        const __amdgpu_buffer_rsrc_t rsrc = __builtin_amdgcn_make_buffer_rsrc(O, 0, nbytes, 0x00020000);
        const int row0 = u.pm * BM + wr * 64 + fr, col0 = u.pn * BM + wc * 32 + 8 * fq;
#pragma unroll
        for (int ai = 0; ai < 2; ++ai)
#pragma unroll
            for (int m = 0; m < 4; ++m) { const unsigned off = (unsigned)(((size_t)(row0 + ai * HALF + m * 16) * ldc + col0) * 2);
#pragma unroll
                for (int bj = 0; bj < 2; ++bj) { const f32x4 v0 = acc[ai][bj][m][0], v1 = acc[ai][bj][m][1];
                    u32x4 w; w.x = cvt_pk_bf16(v0[0], v0[1]); w.y = cvt_pk_bf16(v0[2], v0[3]); w.z = cvt_pk_bf16(v1[0], v1[1]); w.w = cvt_pk_bf16(v1[2], v1[3]);
                    __builtin_amdgcn_raw_buffer_store_b128(w, rsrc, off + bj * HALF * 2, 0,   16); } }
    }
};
struct F32Grouped {
    static constexpr bool PERM = false;
    float* C; int ldc; size_t gstride;
    __device__ __forceinline__ void operator()(const f32x4 (&acc)[2][2][4][2], const Unit& u, int wr, int wc, int fr, int fq) const {
        const int row0 = u.pm * BM + wr * 64 + fr, col0 = u.pn * BM + wc * 32 + 4 * fq; float* Cg = C + (size_t)u.aux * gstride;
#pragma unroll
        for (int ai = 0; ai < 2; ++ai)
#pragma unroll
            for (int m = 0; m < 4; ++m) { float* rowp = Cg + (size_t)(row0 + ai * HALF + m * 16) * ldc + col0;
#pragma unroll
                for (int bj = 0; bj < 2; ++bj)
#pragma unroll
                    for (int n = 0; n < 2; ++n) *(f32x4*)(rowp + bj * HALF + n * 16) = acc[ai][bj][m][n]; }
    }
};
struct SwiGlu {
    static constexpr bool PERM = true;
    bf16_t* H; int ldc;
    __device__ __forceinline__ void operator()(const f32x4 (&acc)[2][2][4][2], const Unit& u, int wr, int wc, int fr, int fq) const {
        const int row0 = u.pm * BM + wr * 64 + fr, col0 = u.pn * HALF + wc * 32 + 8 * fq;
#pragma unroll
        for (int ai = 0; ai < 2; ++ai)
#pragma unroll
            for (int m = 0; m < 4; ++m) { bf16_t* rowp = H + (size_t)(row0 + ai * HALF + m * 16) * ldc + col0;
                float o[8];
#pragma unroll
                for (int n = 0; n < 2; ++n)
#pragma unroll
                    for (int e = 0; e < 4; ++e) o[4 * n + e] = siluf_(acc[ai][0][m][n][e]) * acc[ai][1][m][n][e];
                u32x4 w; w.x = cvt_pk_bf16(o[0], o[1]); w.y = cvt_pk_bf16(o[2], o[3]); w.z = cvt_pk_bf16(o[4], o[5]); w.w = cvt_pk_bf16(o[6], o[7]);
                *(u32x4*)rowp = w; }
    }
};
struct MoeDown {
    static constexpr bool PERM = true;
    bf16_t* Y; const int* row_tok;
    __device__ __forceinline__ void operator()(const f32x4 (&acc)[2][2][4][2], const Unit& u, int wr, int wc, int fr, int fq) const {
        const int srow0 = u.aux * BM + wr * 64 + fr, col0 = u.pn * BM + wc * 32 + 8 * fq;
        int dsts[8];
#pragma unroll
        for (int it = 0; it < 8; ++it) dsts[it] = row_tok[srow0 + (it >> 2) * HALF + (it & 3) * 16];
#pragma unroll
        for (int ai = 0; ai < 2; ++ai)
#pragma unroll
            for (int m = 0; m < 4; ++m) { const int dst = dsts[ai * 4 + m];
                if (dst >= 0) { bf16_t* rowp = Y + (size_t)dst * D + col0;
#pragma unroll
                    for (int bj = 0; bj < 2; ++bj) { const f32x4 v0 = acc[ai][bj][m][0], v1 = acc[ai][bj][m][1];
                        u32x4 w; w.x = cvt_pk_bf16(v0[0], v0[1]); w.y = cvt_pk_bf16(v0[2], v0[3]); w.z = cvt_pk_bf16(v1[0], v1[1]); w.w = cvt_pk_bf16(v1[2], v1[3]);
                        *(u32x4*)(rowp + bj * HALF) = w; } } }
    }
};
struct SigmoidBias {
    static constexpr bool PERM = true;
    bf16_t* O; int ldc; const float* bias;
    __device__ __forceinline__ void operator()(const f32x4 (&acc)[2][2][4][2], const Unit& u, int wr, int wc, int fr, int fq) const {
        const int row0 = u.pm * BM + wr * 64 + fr, col0 = u.pn * BM + wc * 32 + 8 * fq;
        f32x4 bv[2][2];
#pragma unroll
        for (int bj = 0; bj < 2; ++bj)
#pragma unroll
            for (int n = 0; n < 2; ++n) bv[bj][n] = *(const f32x4*)(bias + col0 + bj * HALF + 4 * n);
#pragma unroll
        for (int ai = 0; ai < 2; ++ai)
#pragma unroll
            for (int m = 0; m < 4; ++m) { bf16_t* rowp = O + (size_t)(row0 + ai * HALF + m * 16) * ldc + col0;
#pragma unroll
                for (int bj = 0; bj < 2; ++bj) { f32x4 v0 = acc[ai][bj][m][0] + bv[bj][0], v1 = acc[ai][bj][m][1] + bv[bj][1];
#pragma unroll
                    for (int e = 0; e < 4; ++e) { v0[e] = sigmoidf_(v0[e]); v1[e] = sigmoidf_(v1[e]); }
                    u32x4 w; w.x = cvt_pk_bf16(v0[0], v0[1]); w.y = cvt_pk_bf16(v0[2], v0[3]); w.z = cvt_pk_bf16(v1[0], v1[1]); w.w = cvt_pk_bf16(v1[2], v1[3]);
                    *(u32x4*)(rowp + bj * HALF) = w; } }
    }
};
struct MulBf16 {
    static constexpr bool PERM = true;
    bf16_t* O; const bf16_t* G; int ldc;
    __device__ __forceinline__ void operator()(const f32x4 (&acc)[2][2][4][2], const Unit& u, int wr, int wc, int fr, int fq) const {
        const int row0 = u.pm * BM + wr * 64 + fr, col0 = u.pn * BM + wc * 32 + 8 * fq;
        u32x4 gq[2], gn[2];
        { const size_t off = (size_t)row0 * ldc + col0; gn[0] = *(const u32x4*)(G + off); gn[1] = *(const u32x4*)(G + off + HALF); }
#pragma unroll
        for (int it = 0; it < 8; ++it) { const int ai = it >> 2, m = it & 3; const size_t off = (size_t)(row0 + ai * HALF + m * 16) * ldc + col0;
            gq[0] = gn[0]; gq[1] = gn[1];
            if (it < 7) { const int ai2 = (it + 1) >> 2, m2 = (it + 1) & 3; const size_t off2 = (size_t)(row0 + ai2 * HALF + m2 * 16) * ldc + col0; gn[0] = *(const u32x4*)(G + off2); gn[1] = *(const u32x4*)(G + off2 + HALF); }
#pragma unroll
            for (int bj = 0; bj < 2; ++bj) { const f32x4 v0 = acc[ai][bj][m][0], v1 = acc[ai][bj][m][1]; const u32x4 g4 = gq[bj];
                u32x4 w; w.x = cvt_pk_bf16(v0[0] * bflo(g4.x), v0[1] * bfhi(g4.x)); w.y = cvt_pk_bf16(v0[2] * bflo(g4.y), v0[3] * bfhi(g4.y));
                w.z = cvt_pk_bf16(v1[0] * bflo(g4.z), v1[1] * bfhi(g4.z)); w.w = cvt_pk_bf16(v1[2] * bflo(g4.w), v1[3] * bfhi(g4.w));
                *(u32x4*)(O + off + bj * HALF) = w; }
            asm volatile("" ::: "memory"); }
    }
};
struct S5Out {
    static constexpr bool PERM = true;
    bf16_t* ZS5; const bf16_t* Z; const float* dskip;
    __device__ __forceinline__ void operator()(const f32x4 (&acc)[2][2][4][2], const Unit& u, int wr, int wc, int fr, int fq) const {
        const int g = u.aux, row0 = u.pm * BM + wr * 64 + fr;
#pragma unroll
        for (int bj = 0; bj < 2; ++bj) { const int col = u.pn * BM + bj * HALF + wc * 32 + 8 * fq, jo = col >> 4, co0 = col & 15, ch0 = g * 16 + co0;
            const f32x4 d0 = *(const f32x4*)(dskip + ch0), d1 = *(const f32x4*)(dskip + ch0 + 4);
#pragma unroll
            for (int ai = 0; ai < 2; ++ai)
#pragma unroll
                for (int m = 0; m < 4; ++m) { const int mr = row0 + ai * HALF + m * 16; const long tok = (long)(mr >> 7) * SEQ + (mr & 127) * S5LC + jo;
                    const u32x4 uq = *(const u32x4*)(Z + tok * INP + ZS + ch0); const f32x4 v0 = acc[ai][bj][m][0], v1 = acc[ai][bj][m][1];
                    u32x4 w; w.x = cvt_pk_bf16(gelu_tanh(v0[0] + d0[0] * bflo(uq.x)), gelu_tanh(v0[1] + d0[1] * bfhi(uq.x)));
                    w.y = cvt_pk_bf16(gelu_tanh(v0[2] + d0[2] * bflo(uq.y)), gelu_tanh(v0[3] + d0[3] * bfhi(uq.y)));
                    w.z = cvt_pk_bf16(gelu_tanh(v1[0] + d1[0] * bflo(uq.z)), gelu_tanh(v1[1] + d1[1] * bfhi(uq.z)));
                    w.w = cvt_pk_bf16(gelu_tanh(v1[2] + d1[2] * bflo(uq.w)), gelu_tanh(v1[3] + d1[3] * bfhi(uq.w)));
                    *(u32x4*)(ZS5 + tok * 256 + ch0) = w; asm volatile("" ::: "memory"); } }
    }
};
struct S5Glu {
    static constexpr bool PERM = true;
    bf16_t* MIX; const bf16_t* ZS5; const float* bias;
    __device__ __forceinline__ void operator()(const f32x4 (&acc)[2][2][4][2], const Unit& u, int wr, int wc, int fr, int fq) const {
        const int row0 = u.pm * BM + wr * 64 + fr, col0 = wc * 32 + 8 * fq;
#pragma unroll
        for (int bj = 0; bj < 2; ++bj) { const int col = col0 + bj * HALF; const f32x4 b0 = *(const f32x4*)(bias + col), b1 = *(const f32x4*)(bias + col + 4);
#pragma unroll
            for (int ai = 0; ai < 2; ++ai)
#pragma unroll
                for (int m = 0; m < 4; ++m) { const size_t row = (size_t)(row0 + ai * HALF + m * 16); const u32x4 zq = *(const u32x4*)(ZS5 + row * 256 + col);
                    const f32x4 v0 = acc[ai][bj][m][0] + b0, v1 = acc[ai][bj][m][1] + b1;
                    u32x4 w; w.x = cvt_pk_bf16(bflo(zq.x) * sigmoidf_(v0[0]), bfhi(zq.x) * sigmoidf_(v0[1])); w.y = cvt_pk_bf16(bflo(zq.y) * sigmoidf_(v0[2]), bfhi(zq.y) * sigmoidf_(v0[3]));
                    w.z = cvt_pk_bf16(bflo(zq.z) * sigmoidf_(v1[0]), bfhi(zq.z) * sigmoidf_(v1[1])); w.w = cvt_pk_bf16(bflo(zq.w) * sigmoidf_(v1[2]), bfhi(zq.w) * sigmoidf_(v1[3]));
                    *(u32x4*)(MIX + row * 1024 + 768 + col) = w; asm volatile("" ::: "memory"); } }
    }
};
struct EpiWin {
    static constexpr bool PERM = true;
    bf16_t* Z; bf16_t* Q; bf16_t* KV; bf16_t* AP; const f32x2* rope;
    __device__ __forceinline__ void operator()(const f32x4 (&acc)[2][2][4][2], const Unit& u, int wr, int wc, int fr, int fq) const {
        const int row0 = u.pm * BM + wr * 64 + fr;
        if (u.pn >= 5) {
#pragma unroll
            for (int bj = 0; bj < 2; ++bj) { const int col0 = u.pn * BM + bj * HALF + wc * 32 + 8 * fq; const int sc0 = col0 - ZS; const bool s5 = (sc0 >= 0) && (sc0 < 256);
#pragma unroll
                for (int ai = 0; ai < 2; ++ai)
#pragma unroll
                    for (int m = 0; m < 4; ++m) { const int tok = row0 + ai * HALF + m * 16; const f32x4 v0 = acc[ai][bj][m][0], v1 = acc[ai][bj][m][1];
                        u32x4 w; w.x = cvt_pk_bf16(v0[0], v0[1]); w.y = cvt_pk_bf16(v0[2], v0[3]); w.z = cvt_pk_bf16(v1[0], v1[1]); w.w = cvt_pk_bf16(v1[2], v1[3]);
                        *(u32x4*)(Z + (size_t)tok * INP + col0) = w;
                        if (s5) { const int b = tok >> 12, t = tok & 4095; *(u32x4*)(AP + ((size_t)(sc0 >> 4) * 2048 + b * 128 + (t >> 5)) * S5K + (t & 31) * 16 + (sc0 & 15)) = w; } } }
            return;
        }
#pragma unroll
        for (int bj = 0; bj < 2; ++bj) {
            const int colh = bj * HALF + wc * 32 + 8 * fq;
            const int qi = 4 * (wc & 1) + fq, d1 = 4 * qi;
            const bool isv = (u.pn >= 2) && (bj == 1);
            f32x4 cn0 = (f32x4){0.f, 0.f, 0.f, 0.f}, cn1 = cn0;
            if (!isv) { cn0 = *(const f32x4*)(rope + (size_t)row0 * 32 + d1); cn1 = *(const f32x4*)(rope + (size_t)row0 * 32 + d1 + 2); }
#pragma unroll
            for (int it = 0; it < 8; ++it) { const int ai = it >> 2, m = it & 3; const int tok = row0 + ai * HALF + m * 16; const int b = tok >> 12, t = tok & 4095; const f32x4 x1 = acc[ai][bj][m][0], x2 = acc[ai][bj][m][1];
                    if (isv) { bf16_t* dst = KV + (size_t)((u.pn - 2) * 2 + 1) * (8u << 20) + ((size_t)(b * 2 + (wc >> 1)) * SEQ + t) * 64 + 32 * (wc & 1) + 8 * fq;
                        u32x4 w; w.x = cvt_pk_bf16(x1[0], x1[1]); w.y = cvt_pk_bf16(x1[2], x1[3]); w.z = cvt_pk_bf16(x2[0], x2[1]); w.w = cvt_pk_bf16(x2[2], x2[3]); *(u32x4*)dst = w; }
                    else { const f32x4 cs0 = cn0, cs1 = cn1;
                        if (it < 7) { const int tok2 = row0 + ((it + 1) >> 2) * HALF + ((it + 1) & 3) * 16; cn0 = *(const f32x4*)(rope + (size_t)tok2 * 32 + d1); cn1 = *(const f32x4*)(rope + (size_t)tok2 * 32 + d1 + 2); }
                        const float sc = (u.pn < 2) ? QSCALE : 1.0f;
                        const float o10 = (x1[0] * cs0[0] - x2[0] * cs0[1]) * sc, o11 = (x1[1] * cs0[2] - x2[1] * cs0[3]) * sc, o12 = (x1[2] * cs1[0] - x2[2] * cs1[1]) * sc, o13 = (x1[3] * cs1[2] - x2[3] * cs1[3]) * sc;
                        const float o20 = (x2[0] * cs0[0] + x1[0] * cs0[1]) * sc, o21 = (x2[1] * cs0[2] + x1[1] * cs0[3]) * sc, o22 = (x2[2] * cs1[0] + x1[2] * cs1[1]) * sc, o23 = (x2[3] * cs1[2] + x1[3] * cs1[3]) * sc;
                        bf16_t* dst = (u.pn < 2) ? Q + (size_t)tok * 512 + (u.pn * 4 + (colh >> 6)) * 64 + d1
                                                 : KV + (size_t)((u.pn - 2) * 2) * (8u << 20) + ((size_t)(b * 2 + (wc >> 1)) * SEQ + t) * 64 + d1;
                        u32x2 w1, w2; w1.x = cvt_pk_bf16(o10, o11); w1.y = cvt_pk_bf16(o12, o13); w2.x = cvt_pk_bf16(o20, o21); w2.y = cvt_pk_bf16(o22, o23);
                        *(u32x2*)dst = w1; *(u32x2*)(dst + 32) = w2; }
                    asm volatile("" ::: "memory"); }
        }
    }
};
}
constexpr size_t MiB = 1u << 20;
constexpr size_t WS_CTL = 0, CTL_ZERO_BYTES = 1 * MiB;
constexpr size_t WS_SMALL = 1 * MiB;
constexpr size_t SM_APOW = WS_SMALL;
constexpr size_t SM_BBAR = WS_SMALL + 5 * MiB / 4;
constexpr size_t SM_KTAB = WS_SMALL + 2 * MiB;
constexpr size_t SM_CMPB = WS_SMALL + 4 * MiB;
constexpr size_t SM_TOKE = WS_SMALL + 4 * MiB + 256 * 1024;
constexpr size_t SM_TOKW = WS_SMALL + 4 * MiB + 512 * 1024;
constexpr size_t SM_ROWTOK = WS_SMALL + 5 * MiB + 256 * 1024;
constexpr size_t SM_PCNT = WS_SMALL + 6 * MiB;
constexpr size_t SM_TILEEXP = WS_SMALL + 6 * MiB + 16384;
constexpr size_t WS_ROPE = 8 * MiB;
constexpr size_t WS_W = 24 * MiB;
constexpr size_t W_IN = WS_W;
constexpr size_t W_OUT = W_IN + (size_t)INP * D * 2;
constexpr size_t W_GATE = W_OUT + (size_t)D * D * 2;
constexpr size_t W_PROJ = W_GATE + (size_t)D * D * 2;
constexpr size_t W_CMP = W_PROJ + (size_t)D * PLE * 2;
constexpr size_t W_GLU = W_CMP + (size_t)2 * 512 * 1024 * 2;
constexpr size_t W_S5B = W_GLU + (size_t)256 * 256 * 2;
constexpr size_t W_S5S = W_S5B + (size_t)16 * 512 * S5K * 2;
constexpr size_t W_UP = W_S5S + (size_t)16 * 256 * 512 * 2;
constexpr size_t W_DN = W_UP + (size_t)NEXP * 2 * DFE * D * 2;
constexpr size_t W_END_ = W_DN + (size_t)NEXP * D * DFE * 2;
static_assert(W_END_ <= WS_W + 240 * MiB, "weight region");
constexpr size_t WS_XB = 264 * MiB;
constexpr size_t WS_PB = 392 * MiB;
constexpr size_t WS_Z = 424 * MiB;
constexpr size_t WS_QKV = 712 * MiB;
constexpr size_t WS_Q = WS_QKV, WS_KCMP = WS_QKV + 64 * MiB, WS_VCMP = WS_KCMP + 16 * MiB, WS_KSEL = WS_VCMP + 16 * MiB, WS_VSEL = WS_KSEL + 16 * MiB, WS_KWIN = WS_VSEL + 16 * MiB, WS_VWIN = WS_KWIN + 16 * MiB;
constexpr size_t WS_MIX = 872 * MiB;
constexpr size_t WS_CMP = 1000 * MiB;
constexpr size_t WS_CMPP = WS_CMP, WS_KC = WS_CMP + 32 * MiB, WS_VCT = WS_KC + 1 * MiB, WS_SELM = WS_VCT + 1 * MiB;
constexpr size_t WS_S5 = 1036 * MiB;
constexpr size_t WS_S5A = WS_S5, WS_S5S = WS_S5 + 40 * MiB, WS_ZS5 = WS_S5S + 32 * MiB;
constexpr size_t WS_HBUF = 1140 * MiB;
constexpr size_t WS_END = 1268 * MiB;
constexpr size_t WS_FFH = WS_Z, WS_XS = WS_Z, WS_MH = WS_Z + 260 * MiB, WS_YB = WS_MH + 224 * MiB;
static_assert(WS_YB + 256 * MiB <= WS_END && WS_FFH + (size_t)T * DFF * 2 <= WS_MIX, "overlays");
constexpr size_t WS_PLEG = WS_Z, WS_PLEH = WS_Z + 128 * MiB;
static_assert(WS_PLEH + 128 * MiB <= WS_MH, "per-layer-embedding buffers of the MoE layers");
constexpr int CW_BAR = 4096;
constexpr int CW_TMO = 64;
constexpr int CW_CNT = 16384, CNT_BANK = 256 * 64;
static_assert((CW_CNT + 8 * CNT_BANK) * 4 <= (int)CTL_ZERO_BYTES, "panel counters inside the per-call memset");

struct Args { const void* in[36]; float* out; unsigned char* ws; int gp_lo, gp_hi, use_bar, pad; };
struct Frame { LAS unsigned char* lds; int tid, lane, wave, G, bid; };
constexpr int RING_BYTES = 131072, LDSCTL_OFF = RING_BYTES, LDS_BYTES = 147456;
typedef __attribute__((address_space(4))) const Args CArgs;
__device__ __forceinline__ void load_args(Args& a) { CArgs* p = (CArgs*)__builtin_amdgcn_kernarg_segment_ptr(); asm volatile("" : "+s"(p)); __builtin_memcpy(&a, p, sizeof(Args)); }
__device__ __forceinline__ Frame make_frame(LAS unsigned char* lds, int wave0) { Frame F; F.lds = lds;
    int w = wave0; asm volatile("" : "+s"(w)); int ln = lane_id_fresh(); F.lane = ln; F.wave = w; F.tid = w * 64 + ln;
    int b = blockIdx.x, g = gridDim.x; asm volatile("" : "+s"(b), "+s"(g)); F.bid = b; F.G = g; return F; }

__constant__ double c_invfreq_rev[32] = {0.15915494309189535, 0.11934937021124886, 0.08949940160889101, 0.06711508300522726, 0.050329212104487035, 0.03774158471741977, 0.0283021958306234, 0.02122365276477766, 0.015915494309189534, 0.011934937021124886, 0.008949940160889102, 0.006711508300522725, 0.005032921210448704, 0.003774158471741977, 0.00283021958306234, 0.0021223652764777662, 0.0015915494309189536, 0.0011934937021124885, 0.0008949940160889102, 0.0006711508300522726, 0.0005032921210448703, 0.00037741584717419774, 0.00028302195830623395, 0.0002122365276477766, 0.00015915494309189535, 0.00011934937021124886, 8.949940160889102e-05, 6.711508300522725e-05, 5.0329212104487035e-05, 3.774158471741978e-05, 2.8302195830623396e-05, 2.122365276477766e-05};

__device__ __forceinline__ void sincos_rev(double rev, float& c, float& s) { const double fr = rev - __builtin_floor(rev); const float f = (float)fr; s = __builtin_amdgcn_sinf(f); c = __builtin_amdgcn_cosf(f); }

template <class Sched>
__device__ __forceinline__ void panels_publish_wait(const Frame& F, unsigned* ctl, int bank, const Sched& S, unsigned need) {
    unsigned* cnt = ctl + CW_CNT + bank * CNT_BANK;
    if (F.tid == 0) { pg8::Unit u; for (int i = 0; S.next(i, u); ++i) __hip_atomic_fetch_add(cnt + 64 * u.pm, 1u, __ATOMIC_RELAXED, __HIP_MEMORY_SCOPE_AGENT); }
    if (F.wave == 0) {
        for (int pm = F.bid; pm < T / 256; pm += F.G) { unsigned spins = 0;
            while ((unsigned)__builtin_amdgcn_readfirstlane(__hip_atomic_load(cnt + 64 * pm, __ATOMIC_RELAXED, __HIP_MEMORY_SCOPE_AGENT)) < need) {
                __builtin_amdgcn_s_sleep(1);
                if (++spins > (1u << 22)) { if (F.lane == 0) __hip_atomic_store(ctl + CW_TMO, 1u, __ATOMIC_RELAXED, __HIP_MEMORY_SCOPE_AGENT); break; }
                if ((spins & 1023u) == 0u && __builtin_amdgcn_readfirstlane(__hip_atomic_load(ctl + CW_TMO, __ATOMIC_RELAXED, __HIP_MEMORY_SCOPE_AGENT))) break; } }
        __builtin_amdgcn_fence(__ATOMIC_ACQUIRE, "agent");
        asm volatile("s_waitcnt vmcnt(0)" ::: "memory");
    }
    __syncthreads();
}
__device__ __forceinline__ void phase_init0(const Frame& F, const Args& a) {
    const size_t gt = (size_t)F.bid * 512 + F.tid, NT = (size_t)F.G * 512;
    const int* pos = (const int*)a.in[2]; f32x2* rope = (f32x2*)(a.ws + WS_ROPE);
    for (size_t i = gt; i < (size_t)T * 32; i += NT) { const int tok = (int)(i >> 5), k = (int)(i & 31); float c, s; sincos_rev((double)pos[tok] * c_invfreq_rev[k], c, s); rope[i] = (f32x2){c, s}; }
    const float* are = (const float*)a.in[14]; const float* aim = (const float*)a.in[15]; const float* ldt = (const float*)a.in[16];
    const float* bre = (const float*)a.in[17]; const float* bim = (const float*)a.in[18];
    f32x2* apow = (f32x2*)(a.ws + SM_APOW); f32x2* bbar = (f32x2*)(a.ws + SM_BBAR);
    for (size_t i = gt; i < (size_t)DEPTH * 16 * 64 * 34; i += NT) { const int k = (int)(i % 34), lgn = (int)(i / 34), lg = lgn >> 6;
        const float dt = __expf(ldt[lg]); const float ar = are[lgn] * dt; const double rev = (double)k * ((double)aim[lgn] * (double)dt) * 0.15915494309189535;
        float c, s; sincos_rev(rev, c, s); const float mg = __expf((float)k * ar); apow[i] = (f32x2){mg * c, mg * s}; }
    for (size_t i = gt; i < (size_t)DEPTH * 16 * 64 * 16; i += NT) { const int lgn = (int)(i >> 4), lg = lgn >> 6;
        const float dt = __expf(ldt[lg]); const float lr = are[lgn], li = aim[lgn]; const double rev = ((double)li * (double)dt) * 0.15915494309189535;
        float c, s; sincos_rev(rev, c, s); const float mg = __expf(lr * dt); const float abr = mg * c, abi = mg * s, den = lr * lr + li * li;
        const float cr = ((abr - 1.0f) * lr + abi * li) / den, ci = (abi * lr - (abr - 1.0f) * li) / den;
        const float br = bre[i], bi = bim[i]; bbar[i] = (f32x2){cr * br - ci * bi, cr * bi + ci * br}; }
    const f32x4* x4 = (const f32x4*)a.in[0]; u32x2* xb = (u32x2*)(a.ws + WS_XB);
    for (size_t i = gt; i < (size_t)T * D / 4; i += 4 * NT) { f32x4 v[4];
#pragma unroll
        for (int q = 0; q < 4; ++q) { const size_t ii = i + q * NT; v[q] = (ii < (size_t)T * D / 4) ? x4[ii] : (f32x4){0.f, 0.f, 0.f, 0.f}; }
#pragma unroll
        for (int q = 0; q < 4; ++q) { const size_t ii = i + q * NT; if (ii < (size_t)T * D / 4) { u32x2 w; w.x = cvt_pk_bf16(v[q][0], v[q][1]); w.y = cvt_pk_bf16(v[q][2], v[q][3]); xb[ii] = w; } } }
}
__device__ __forceinline__ void phase_init1(const Frame& F, const Args& a) {
    const size_t gt = (size_t)F.bid * 512 + F.tid, NT = (size_t)F.G * 512;
    const float* cre = (const float*)a.in[19]; const float* cim = (const float*)a.in[20];
    const f32x2* apow = (const f32x2*)(a.ws + SM_APOW); const f32x2* bbar = (const f32x2*)(a.ws + SM_BBAR); float* ktab = (float*)(a.ws + SM_KTAB);
    for (size_t i = gt; i < (size_t)DEPTH * 16 * 32 * 256; i += NT) { const int ci = (int)(i & 15), co = (int)((i >> 4) & 15), tau = (int)((i >> 8) & 31), lg = (int)(i >> 13);
        float acc = 0.f;
        for (int n = 0; n < 64; ++n) { const f32x2 P = apow[((size_t)lg * 64 + n) * 34 + tau], Bb = bbar[((size_t)lg * 64 + n) * 16 + ci]; const float cr = cre[((size_t)lg * 16 + co) * 64 + n], cm = cim[((size_t)lg * 16 + co) * 64 + n];
            const float hr = P.x * Bb.x - P.y * Bb.y, hi = P.x * Bb.y + P.y * Bb.x; acc += cr * hr - cm * hi; }
        ktab[i] = acc; }
}

__device__ __forceinline__ void transpose_item(const float* W, int ldw, int k0, int n0, int nvalid, bf16_t* dstrow, int dst_ld, LAS float* scr, int lane, int permhi) {
    float tv[32];
#pragma unroll
    for (int i = 0; i < 32; ++i) { const int kk = 2 * i + (lane >> 5), nn = lane & 31; tv[i] = (nn < nvalid) ? W[(size_t)(k0 + kk) * ldw + n0 + nn] : 0.f; }
#pragma unroll
    for (int i = 0; i < 32; ++i) { const int kk = 2 * i + (lane >> 5), nn = lane & 31; scr[kk * 33 + nn] = tv[i]; }
    LDS_WAIT(); asm volatile("" ::: "memory");
    const int c = lane & 7;
#pragma unroll
    for (int j = 0; j < 4; ++j) { const int n = (lane >> 3) + 8 * j; const LAS float* s = scr + (8 * c) * 33 + n;
        u32x4 o; o.x = cvt_pk_bf16(s[0 * 33], s[1 * 33]); o.y = cvt_pk_bf16(s[2 * 33], s[3 * 33]); o.z = cvt_pk_bf16(s[4 * 33], s[5 * 33]); o.w = cvt_pk_bf16(s[6 * 33], s[7 * 33]);
        const int drow = permhi < 0 ? n : (8 * (n >> 2) + 4 * permhi + (n & 3));
        if (n < nvalid) *(u32x4*)(dstrow + (size_t)drow * dst_ld + 8 * c) = o; }
    LDS_WAIT(); asm volatile("" ::: "memory");
}
__device__ __forceinline__ void transpose_mat(const float* W, int K, int N, bf16_t* dst, int dst_ld, int mode, LAS float* scr, int lane, int& cursor, int gw, int NGW) {
    const int nblk = (N + 31) / 32, items = (K / 64) * nblk;
    int it = ((gw - cursor) % NGW + NGW) % NGW;
    for (; it < items; it += NGW) { const int kb = it / nblk, nb = it % nblk, k0 = 64 * kb, n0 = 32 * nb; const int nv = (N - n0) < 32 ? (N - n0) : 32;
        int drow = n0, permhi = -1;
        if (mode == 1 || mode == 2) drow = (n0 >> 7) * 256 + (n0 & 127) + (mode == 2 ? 128 : 0);
        if (mode == 3 && (n0 < 512 || (n0 < 1280 && (((n0 - 512) >> 7) & 1) == 0))) { drow = n0 & ~63; permhi = (n0 >> 5) & 1; }
        transpose_item(W, N, k0, n0, nv, dst + (size_t)drow * dst_ld + k0, dst_ld, scr, lane, permhi); }
    cursor = (cursor + items) % NGW;
}

__device__ __forceinline__ void phase_prep(const Frame& F, const Args& a, int l) {
    LAS float* scr = (LAS float*)(F.lds + F.wave * 16384);
    const int gw = F.bid * 8 + F.wave, NGW = F.G * 8; int cursor = 0;
    unsigned char* ws = a.ws;
    transpose_mat((const float*)a.in[3] + (size_t)l * D * INW, D, INW, (bf16_t*)(ws + W_IN), D, 3, scr, F.lane, cursor, gw, NGW);
    transpose_mat((const float*)a.in[4] + (size_t)l * D * D, D, D, (bf16_t*)(ws + W_OUT), D, 0, scr, F.lane, cursor, gw, NGW);
    transpose_mat((const float*)a.in[31] + (size_t)l * D * D, D, D, (bf16_t*)(ws + W_GATE), D, 0, scr, F.lane, cursor, gw, NGW);
    transpose_mat((const float*)a.in[33] + (size_t)l * PLE * D, PLE, D, (bf16_t*)(ws + W_PROJ), PLE, 0, scr, F.lane, cursor, gw, NGW);
    for (int j = 0; j < 2; ++j) { const float* w1 = (const float*)a.in[6] + ((size_t)l * 2 + j) * 2048 * 256; bf16_t* dst = (bf16_t*)(ws + W_CMP) + (size_t)j * 512 * 1024;
        transpose_mat(w1, 1024, 256, dst, 1024, 0, scr, F.lane, cursor, gw, NGW);
        transpose_mat(w1 + (size_t)1024 * 256, 1024, 256, dst + (size_t)256 * 1024, 1024, 0, scr, F.lane, cursor, gw, NGW); }
    transpose_mat((const float*)a.in[22] + (size_t)l * 256 * 256, 256, 256, (bf16_t*)(ws + W_GLU), 256, 0, scr, F.lane, cursor, gw, NGW);
    const int j2 = l >> 1;
    if ((l & 1) == 0) {
        transpose_mat((const float*)a.in[24] + (size_t)j2 * D * DFF, D, DFF, (bf16_t*)(ws + W_UP), D, 1, scr, F.lane, cursor, gw, NGW);
        transpose_mat((const float*)a.in[25] + (size_t)j2 * D * DFF, D, DFF, (bf16_t*)(ws + W_UP), D, 2, scr, F.lane, cursor, gw, NGW);
        transpose_mat((const float*)a.in[26] + (size_t)j2 * DFF * D, DFF, D, (bf16_t*)(ws + W_DN), DFF, 0, scr, F.lane, cursor, gw, NGW);
    } else {
        for (int e = 0; e < NEXP; ++e) { const size_t eo = (size_t)j2 * NEXP + e;
            transpose_mat((const float*)a.in[28] + eo * D * DFE, D, DFE, (bf16_t*)(ws + W_UP) + (size_t)e * 2 * DFE * D, D, 1, scr, F.lane, cursor, gw, NGW);
            transpose_mat((const float*)a.in[29] + eo * D * DFE, D, DFE, (bf16_t*)(ws + W_UP) + (size_t)e * 2 * DFE * D, D, 2, scr, F.lane, cursor, gw, NGW);
            transpose_mat((const float*)a.in[30] + eo * DFE * D, DFE, D, (bf16_t*)(ws + W_DN) + (size_t)e * D * DFE, DFE, 0, scr, F.lane, cursor, gw, NGW); }
    }
    const size_t gt = (size_t)F.bid * 512 + F.tid, NT = (size_t)F.G * 512;
    {
        u32x4* zp = (u32x4*)((bf16_t*)(ws + W_IN) + (size_t)INW * D); const size_t n16 = (size_t)(INP - INW) * D * 2 / 16;
        unsigned zz = 0u; asm volatile("" : "+v"(zz));
        for (size_t i = gt; i < n16; i += NT) zp[i] = (u32x4){zz, zz, zz, zz};
    }
    {
        const f32x4* p4 = (const f32x4*)((const float*)a.in[1] + (size_t)l * T * PLE); u32x2* pb = (u32x2*)(ws + WS_PB);
        for (size_t i = gt; i < (size_t)T * PLE / 4; i += 4 * NT) { f32x4 v[4];
#pragma unroll
            for (int q = 0; q < 4; ++q) { const size_t ii = i + q * NT; v[q] = (ii < (size_t)T * PLE / 4) ? p4[ii] : (f32x4){0.f, 0.f, 0.f, 0.f}; }
#pragma unroll
            for (int q = 0; q < 4; ++q) { const size_t ii = i + q * NT; if (ii < (size_t)T * PLE / 4) { u32x2 w; w.x = cvt_pk_bf16(v[q][0], v[q][1]); w.y = cvt_pk_bf16(v[q][2], v[q][3]); pb[ii] = w; } } }
    }
    {
        const float* ktab = (const float*)(ws + SM_KTAB) + (size_t)l * 16 * 32 * 256; const f32x2* apow = (const f32x2*)(ws + SM_APOW) + (size_t)l * 16 * 64 * 34; const f32x2* bbar = (const f32x2*)(ws + SM_BBAR) + (size_t)l * 16 * 64 * 16;
        const float* cre = (const float*)a.in[19] + (size_t)l * 16 * 16 * 64; const float* cim = (const float*)a.in[20] + (size_t)l * 16 * 16 * 64;
        bf16_t* Bt = (bf16_t*)(ws + W_S5B);
        for (size_t i = gt; i < (size_t)16 * 512 * S5K; i += NT) { const int k = (int)(i % S5K), row = (int)((i / S5K) & 511), g = (int)(i / ((size_t)S5K * 512)); const int jo = row >> 4, co = row & 15;
            float v;
            if (k < 512) { const int ji = k >> 4, ci = k & 15; v = (jo >= ji) ? ktab[(((size_t)g * 32 + (jo - ji)) * 16 + co) * 16 + ci] : 0.f; }
            else { const int n = (k - 512) & 63; const f32x2 P = apow[((size_t)g * 64 + n) * 34 + jo + 1]; const float cr = cre[((size_t)g * 16 + co) * 64 + n], cm = cim[((size_t)g * 16 + co) * 64 + n];
                v = (k < 576) ? (cr * P.x - cm * P.y) : -(cr * P.y + cm * P.x); }
            Bt[i] = f2bf(v); }
        bf16_t* St = (bf16_t*)(ws + W_S5S);
        for (size_t i = gt; i < (size_t)16 * 256 * 512; i += NT) { const int k = (int)(i & 511), np = (int)((i >> 9) & 255), g = (int)(i >> 17); const int j = k >> 4, ci = k & 15;
            float v = 0.f;
            if (np < 128) { const int n = np & 63; const f32x2 P = apow[((size_t)g * 64 + n) * 34 + (S5LC - 1 - j)], Bb = bbar[((size_t)g * 64 + n) * 16 + ci]; v = (np < 64) ? (P.x * Bb.x - P.y * Bb.y) : (P.x * Bb.y + P.y * Bb.x); }
            St[i] = f2bf(v); }
    }
    {
        float* cb = (float*)(ws + SM_CMPB); LAS float* red = (LAS float*)(F.lds + 8 * 16384 - 4096);
        for (int o = F.bid; o < 8; o += F.G) { const int j = o >> 2, cblk = o & 3; const float* w1 = (const float*)a.in[6] + ((size_t)l * 2 + j) * 2048 * 256 + cblk * 64 + F.lane; const float* pe = (const float*)a.in[5] + ((size_t)l * 2 + j) * 2048;
            float s0 = 0.f, s1 = 0.f, s2 = 0.f, s3 = 0.f;
#pragma unroll 4
            for (int k = 256 * F.wave; k < 256 * F.wave + 256; k += 4) { s0 += pe[k] * w1[(size_t)k * 256]; s1 += pe[k + 1] * w1[(size_t)(k + 1) * 256]; s2 += pe[k + 2] * w1[(size_t)(k + 2) * 256]; s3 += pe[k + 3] * w1[(size_t)(k + 3) * 256]; }
            __syncthreads(); red[F.wave * 64 + F.lane] = (s0 + s1) + (s2 + s3); __syncthreads();
            if (F.wave == 0) { float t = ((const float*)a.in[7])[((size_t)l * 2 + j) * 256 + cblk * 64 + F.lane];
#pragma unroll
                for (int w = 0; w < 8; ++w) t += red[w * 64 + F.lane];
                cb[j * 256 + cblk * 64 + F.lane] = t; }
            __syncthreads(); }
    }
}

__device__ __forceinline__ void conv_items(const Frame& F, const Args& a, int l, int first, int stride, int last = NB * (SEQ / 32)) {
    const bf16_t* z = (const bf16_t*)(a.ws + WS_Z); bf16_t* mix = (bf16_t*)(a.ws + WS_MIX);
    const float* cw = (const float*)a.in[10] + (size_t)l * 31 * 256; const float* cb = (const float*)a.in[11] + (size_t)l * 256;
    const float* lg = (const float*)a.in[12] + (size_t)l * 256; const float* lb = (const float*)a.in[13] + (size_t)l * 256;
    LAS float* U = (LAS float*)F.lds;
    LAS float* Y = (LAS float*)(F.lds + 65536);
    const int cp = F.tid & 127, tg = F.tid >> 7, c = 2 * cp;
    f32x2 w[31];
#pragma unroll
    for (int j = 0; j < 31; ++j) w[j] = *(const f32x2*)(cw + j * 256 + c);
    const f32x2 bias = *(const f32x2*)(cb + c);
    unsigned pva[16], pvg[16];
    auto fetch = [&](int it) { const int b = it >> 7, t0 = (it & 127) * 32;
#pragma unroll
        for (int q = 0; q < 16; ++q) { const int r = tg + 4 * q, t = t0 - 30 + r; pva[q] = 0u; pvg[q] = 0u;
            if (r < 62 && t >= 0) { const bf16_t* zr = z + ((size_t)b * SEQ + t) * INP + ZC; pva[q] = *(const unsigned*)(zr + c); pvg[q] = *(const unsigned*)(zr + 256 + c); } } };
    if (first < last) fetch(first);
    for (int it = first; it < last; it += stride) { const int b = it >> 7, t0 = (it & 127) * 32;
#pragma unroll
        for (int q = 0; q < 16; ++q) { const int r = tg + 4 * q, t = t0 - 30 + r;
            if (r < 62) { f32x2 u = (f32x2){0.f, 0.f}; if (t >= 0) u = (f32x2){bflo(pva[q]) * sigmoidf_(bflo(pvg[q])), bfhi(pva[q]) * sigmoidf_(bfhi(pvg[q]))};
                *(LAS f32x2*)(U + r * 256 + c) = u; } }
        if (it + stride < last) fetch(it + stride);
        __syncthreads();
        {   f32x2 acc[8];
#pragma unroll
            for (int i = 0; i < 8; ++i) acc[i] = bias;
#pragma unroll
            for (int k = 0; k < 38; ++k) { const f32x2 u = *(const LAS f32x2*)(U + (tg * 8 + k) * 256 + c);
#pragma unroll
                for (int i = 0; i < 8; ++i) { const int j = k - i; if (j >= 0 && j < 31) acc[i] += w[j] * u; } }
#pragma unroll
            for (int i = 0; i < 8; ++i) *(LAS f32x2*)(Y + (tg * 8 + i) * 256 + c) = acc[i];
        }
        __syncthreads();
        for (int i = 0; i < 4; ++i) { const int tl = F.wave * 4 + i; const f32x4 v = *(const LAS f32x4*)(Y + tl * 256 + F.lane * 4);
            const float mean = wave_sum((v[0] + v[1]) + (v[2] + v[3])) * (1.f / 256.f); const f32x4 dlt = v - mean;
            const float var = wave_sum((dlt[0] * dlt[0] + dlt[1] * dlt[1]) + (dlt[2] * dlt[2] + dlt[3] * dlt[3])) * (1.f / 256.f); const float rstd = 1.0f / sqrtf(var + LN_EPS);
            const f32x4 gg = *(const f32x4*)(lg + F.lane * 4), bb = *(const f32x4*)(lb + F.lane * 4);
            float o[4];
#pragma unroll
            for (int e = 0; e < 4; ++e) o[e] = siluf_(dlt[e] * rstd * gg[e] + bb[e]);
            u32x2 wv; wv.x = cvt_pk_bf16(o[0], o[1]); wv.y = cvt_pk_bf16(o[2], o[3]);
            *(u32x2*)(mix + ((size_t)b * SEQ + t0 + tl) * 1024 + 512 + F.lane * 4) = wv; }
        __syncthreads();
    }
}
__device__ __forceinline__ void cmp_stage2(const Frame& F, const Args& a, int l) {
    unsigned char* ws = a.ws; const float* cb = (const float*)(ws + SM_CMPB);
    LAS float* w2s = (LAS float*)F.lds;
    LAS float* hs = (LAS float*)(F.lds + 65536 + F.wave * 1024);
    const int gw = F.bid * 8 + F.wave, NGW = F.G * 8, lane = F.lane;
    for (int j = 0; j < 2; ++j) {
        const float* w2 = (const float*)a.in[8] + ((size_t)l * 2 + j) * 256 * 64; const float* b2 = (const float*)a.in[9] + ((size_t)l * 2 + j) * 64;
        __syncthreads();
        for (int i = F.tid; i < 256 * 64 / 4; i += 512) *(LAS f32x4*)(w2s + 4 * i) = *(const f32x4*)(w2 + 4 * i);
        __syncthreads();
        for (int it = gw; it < 32 * 256; it += NGW) { const int bh = it >> 8, n = it & 255;
            float outv = 0.f;
            if (n < NCMP) {
                const float* P = (const float*)(ws + WS_CMPP) + (size_t)j * 8192 * 512 + ((size_t)bh * 256 + n) * 512;
                const f32x4 p0 = *(const f32x4*)(P + lane * 4), p1 = *(const f32x4*)(P + 512 + 256 + lane * 4), bb = *(const f32x4*)(cb + j * 256 + lane * 4);
                f32x4 hv;
#pragma unroll
                for (int e = 0; e < 4; ++e) hv[e] = gelu_tanh(p0[e] + p1[e] + bb[e]);
                *(LAS f32x4*)(hs + lane * 4) = hv; LDS_WAIT(); asm volatile("" ::: "memory");
                float acc0 = b2[lane], acc1 = 0.f, acc2 = 0.f, acc3 = 0.f;
#pragma unroll 4
                for (int c = 0; c < 256; c += 4) { const f32x4 h4 = *(const LAS f32x4*)(hs + c);
                    acc0 += h4[0] * w2s[c * 64 + lane]; acc1 += h4[1] * w2s[(c + 1) * 64 + lane]; acc2 += h4[2] * w2s[(c + 2) * 64 + lane]; acc3 += h4[3] * w2s[(c + 3) * 64 + lane]; }
                outv = (acc0 + acc1) + (acc2 + acc3); LDS_WAIT(); asm volatile("" ::: "memory");
            }
            if (j == 0) ((bf16_t*)(ws + WS_KC))[((size_t)bh * 256 + n) * 64 + lane] = f2bf(outv);
            else ((bf16_t*)(ws + WS_VCT))[((size_t)bh * 4 + (n >> 6)) * 4096 + lane * 64 + nsa::vslot(n & 63)] = f2bf(outv);
        }
    }
    __syncthreads();
}
__device__ __forceinline__ void cmp_stage2_panel(const Frame& F, const Args& a, int l, int j, int bh) {
    constexpr int HP = 528;
    unsigned char* ws = a.ws; const float* cb = (const float*)(ws + SM_CMPB);
    LAS unsigned char* Hs = F.lds;
    LAS unsigned char* Ws = F.lds + 128 * HP;
    const int lane = F.lane, w = F.wave;
    const float* w2 = (const float*)a.in[8] + ((size_t)l * 2 + j) * 256 * 64; const float* b2 = (const float*)a.in[9] + ((size_t)l * 2 + j) * 64;
    const float* Pb = (const float*)(ws + WS_CMPP) + (size_t)j * 8192 * 512 + (size_t)bh * 256 * 512;
    __syncthreads();
    for (int i = F.tid; i < 256 * 64; i += 512) { const int c = i >> 6, d = i & 63; *(LAS bf16_t*)(Ws + d * HP + c * 2) = f2bf(w2[i]); }
    const f32x4 bb = *(const f32x4*)(cb + j * 256 + lane * 4);
    for (int half = 0; half < 2; ++half) {
        __syncthreads();
#pragma unroll 4
        for (int rr = 0; rr < 16; ++rr) { const int r = 16 * w + rr, n = half * 128 + r, n1 = n < 255 ? n + 1 : n;
            const f32x4 p0 = *(const f32x4*)(Pb + (size_t)n * 512 + lane * 4), p1 = *(const f32x4*)(Pb + (size_t)n1 * 512 + 256 + lane * 4);
            u32x2 hv; hv.x = cvt_pk_bf16(gelu_tanh(p0[0] + p1[0] + bb[0]), gelu_tanh(p0[1] + p1[1] + bb[1])); hv.y = cvt_pk_bf16(gelu_tanh(p0[2] + p1[2] + bb[2]), gelu_tanh(p0[3] + p1[3] + bb[3]));
            *(LAS u32x2*)(Hs + r * HP + lane * 8) = hv; }
        __syncthreads();
        f32x4 acc[4];
#pragma unroll
        for (int cbk = 0; cbk < 4; ++cbk) acc[cbk] = (f32x4){0.f, 0.f, 0.f, 0.f};
        const LAS unsigned char* ap = Hs + (16 * w + (lane & 15)) * HP + (lane >> 4) * 16;
        const LAS unsigned char* bp = Ws + (lane & 15) * HP + (lane >> 4) * 16;
#pragma unroll
        for (int ks = 0; ks < 8; ++ks) { const bf16x8 af = *(const LAS bf16x8*)(ap + ks * 64);
#pragma unroll
            for (int cbk = 0; cbk < 4; ++cbk) { const bf16x8 bf = *(const LAS bf16x8*)(bp + cbk * 16 * HP + ks * 64); acc[cbk] = __builtin_amdgcn_mfma_f32_16x16x32_bf16(af, bf, acc[cbk], 0, 0, 0); } }
#pragma unroll
        for (int cbk = 0; cbk < 4; ++cbk) { const int d = 16 * cbk + (lane & 15); const float bv = b2[d];
#pragma unroll
            for (int e = 0; e < 4; ++e) { const int n = half * 128 + 16 * w + 4 * (lane >> 4) + e; const float outv = n < NCMP ? acc[cbk][e] + bv : 0.f;
                if (j == 0) ((bf16_t*)(ws + WS_KC))[((size_t)bh * 256 + n) * 64 + d] = f2bf(outv);
                else ((bf16_t*)(ws + WS_VCT))[((size_t)bh * 4 + (n >> 6)) * 4096 + d * 64 + nsa::vslot(n & 63)] = f2bf(outv); } }
    }
    __syncthreads();
}
__device__ __forceinline__ void s5_carry_panel(const Frame& F, const Args& a, int l, int g, int pm) {
    unsigned char* ws = a.ws; const f32x2* apow = (const f32x2*)(ws + SM_APOW) + (size_t)l * 16 * 64 * 34;
    const float* S = (const float*)(ws + WS_S5S); bf16_t* ap = (bf16_t*)(ws + WS_S5A);
    if (F.tid < 128) { const int n = F.tid & 63, b = 2 * pm + (F.tid >> 6);
        const f32x2 A = apow[((size_t)g * 64 + n) * 34 + S5LC]; float hr = 0.f, hi = 0.f;
        const float* sp = S + ((size_t)g * 2048 + b * 128) * 256 + n; bf16_t* dp = ap + ((size_t)g * 2048 + b * 128) * S5K + 512 + n;
        float nr_[16], ni_[16];
#pragma unroll
        for (int k = 0; k < 16; ++k) { nr_[k] = sp[(size_t)k * 256]; ni_[k] = sp[(size_t)k * 256 + 64]; }
        for (int c0 = 0; c0 < S5NCH; c0 += 16) { float sr[16], si[16];
#pragma unroll
            for (int k = 0; k < 16; ++k) { sr[k] = nr_[k]; si[k] = ni_[k]; }
            if (c0 + 16 < S5NCH) {
#pragma unroll
                for (int k = 0; k < 16; ++k) { nr_[k] = sp[(size_t)(c0 + 16 + k) * 256]; ni_[k] = sp[(size_t)(c0 + 16 + k) * 256 + 64]; } }
#pragma unroll
            for (int k = 0; k < 16; ++k) { dp[(size_t)(c0 + k) * S5K] = f2bf(hr); dp[(size_t)(c0 + k) * S5K + 64] = f2bf(hi);
                const float nr = A.x * hr - A.y * hi + sr[k], ni = A.x * hi + A.y * hr + si[k]; hr = nr; hi = ni; } }
    }
}
__device__ __forceinline__ void s5_carry(const Frame& F, const Args& a, int l) {
    unsigned char* ws = a.ws; const f32x2* apow = (const f32x2*)(ws + SM_APOW) + (size_t)l * 16 * 64 * 34;
    const float* S = (const float*)(ws + WS_S5S); bf16_t* ap = (bf16_t*)(ws + WS_S5A);
    const int gt = F.bid * 512 + F.tid, NT = F.G * 512;
    for (int i = gt; i < 16 * NB * 64; i += NT) { const int n = i & 63, b = (i >> 6) & 15, g = i >> 10;
        const f32x2 A = apow[((size_t)g * 64 + n) * 34 + S5LC]; float hr = 0.f, hi = 0.f;
        const float* sp = S + ((size_t)g * 2048 + b * 128) * 256 + n; bf16_t* dp = ap + ((size_t)g * 2048 + b * 128) * S5K + 512 + n;
        float nr_[16], ni_[16];
#pragma unroll
        for (int k = 0; k < 16; ++k) { nr_[k] = sp[(size_t)k * 256]; ni_[k] = sp[(size_t)k * 256 + 64]; }
        for (int c0 = 0; c0 < S5NCH; c0 += 16) { float sr[16], si[16];
#pragma unroll
            for (int k = 0; k < 16; ++k) { sr[k] = nr_[k]; si[k] = ni_[k]; }
            if (c0 + 16 < S5NCH) {
#pragma unroll
                for (int k = 0; k < 16; ++k) { nr_[k] = sp[(size_t)(c0 + 16 + k) * 256]; ni_[k] = sp[(size_t)(c0 + 16 + k) * 256 + 64]; } }
#pragma unroll
            for (int k = 0; k < 16; ++k) { dp[(size_t)(c0 + k) * S5K] = f2bf(hr); dp[(size_t)(c0 + k) * S5K + 64] = f2bf(hi);
                const float nr = A.x * hr - A.y * hi + sr[k], ni = A.x * hi + A.y * hr + si[k]; hr = nr; hi = ni; } }
    }
}
template <int MODE, bool ROUTE, bool FINAL>
__device__ __forceinline__ void ln_panel(const Frame& F, const Args& a, int pm, const float* gain, const float* beta, const float* router, size_t h_off = WS_HBUF) {
    unsigned char* ws = a.ws; float* xout = a.out; bf16_t* xb = (bf16_t*)(ws + WS_XB);
    const bf16_t* hb = (const bf16_t*)(ws + (MODE == 0 ? h_off : WS_YB)); const f32x2* tokw = (const f32x2*)(ws + SM_TOKW);
    LAS int* cnt = (LAS int*)F.lds;
    const int lane = F.lane;
    f32x4 gv[4], bv[4];
#pragma unroll
    for (int j = 0; j < 4; ++j) { gv[j] = *(const f32x4*)(gain + 4 * lane + 256 * j); bv[j] = *(const f32x4*)(beta + 4 * lane + 256 * j); }
    if (ROUTE) { if (F.tid < 8) cnt[F.tid] = 0; __syncthreads(); }
    u32x2 nx[4], nh0[4], nh1[4]; f32x2 nw = (f32x2){0.f, 0.f};
    { const size_t row = (size_t)pm * 256 + F.wave * 32; if (MODE == 1) nw = tokw[row];
#pragma unroll
      for (int j = 0; j < 4; ++j) { nx[j] = *(const u32x2*)(xb + row * D + 4 * lane + 256 * j);
          if (MODE == 0) { nh0[j] = *(const u32x2*)(hb + row * D + 4 * lane + 256 * j); nh1[j] = nh0[j]; } else { nh0[j] = *(const u32x2*)(hb + (2 * row) * D + 4 * lane + 256 * j); nh1[j] = *(const u32x2*)(hb + (2 * row + 1) * D + 4 * lane + 256 * j); } } }
    for (int i = 0; i < 32; ++i) { const size_t row = (size_t)pm * 256 + F.wave * 32 + i;
        f32x4 v[4]; float s = 0.f;
        u32x2 cx[4], ch0[4], ch1[4]; const f32x2 w01 = nw;
#pragma unroll
        for (int j = 0; j < 4; ++j) { cx[j] = nx[j]; ch0[j] = nh0[j]; ch1[j] = nh1[j]; }
        if (i < 31) { const size_t rn = row + 1; if (MODE == 1) nw = tokw[rn];
#pragma unroll
            for (int j = 0; j < 4; ++j) { nx[j] = *(const u32x2*)(xb + rn * D + 4 * lane + 256 * j);
                if (MODE == 0) { nh0[j] = *(const u32x2*)(hb + rn * D + 4 * lane + 256 * j); nh1[j] = nh0[j]; } else { nh0[j] = *(const u32x2*)(hb + (2 * rn) * D + 4 * lane + 256 * j); nh1[j] = *(const u32x2*)(hb + (2 * rn + 1) * D + 4 * lane + 256 * j); } } }
#pragma unroll
        for (int j = 0; j < 4; ++j) { const u32x2 xq = cx[j]; const f32x4 xv = (f32x4){bflo(xq.x), bfhi(xq.x), bflo(xq.y), bfhi(xq.y)}; f32x4 hv;
            if (MODE == 0) { const u32x2 q = ch0[j]; hv = (f32x4){bflo(q.x), bfhi(q.x), bflo(q.y), bfhi(q.y)}; }
            else { const u32x2 q0 = ch0[j], q1 = ch1[j];
                hv = (f32x4){w01.x * bflo(q0.x) + w01.y * bflo(q1.x), w01.x * bfhi(q0.x) + w01.y * bfhi(q1.x), w01.x * bflo(q0.y) + w01.y * bflo(q1.y), w01.x * bfhi(q0.y) + w01.y * bfhi(q1.y)}; }
            v[j] = xv * ALPHA + hv; s += (v[j][0] + v[j][1]) + (v[j][2] + v[j][3]); }
        const float mean = wave_sum(s) * (1.f / D); float s2 = 0.f;
#pragma unroll
        for (int j = 0; j < 4; ++j) { v[j] = v[j] - mean; s2 += (v[j][0] * v[j][0] + v[j][1] * v[j][1]) + (v[j][2] * v[j][2] + v[j][3] * v[j][3]); }
        const float rstd = 1.0f / sqrtf(wave_sum(s2) * (1.f / D) + LN_EPS);
#pragma unroll
        for (int j = 0; j < 4; ++j) { v[j] = v[j] * rstd * gv[j] + bv[j];
            if (FINAL) *(f32x4*)(xout + row * D + 4 * lane + 256 * j) = v[j];
            u32x2 w; w.x = cvt_pk_bf16(v[j][0], v[j][1]); w.y = cvt_pk_bf16(v[j][2], v[j][3]); *(u32x2*)(xb + row * D + 4 * lane + 256 * j) = w; }
        if (ROUTE) {
            float lg[8];
#pragma unroll
            for (int e = 0; e < 8; ++e) lg[e] = 0.f;
#pragma unroll
            for (int j = 0; j < 4; ++j)
#pragma unroll
                for (int k = 0; k < 4; ++k) { const float* rr = router + (size_t)(4 * lane + 256 * j + k) * 8; const f32x4 r0 = *(const f32x4*)rr, r1 = *(const f32x4*)(rr + 4); const float xv = v[j][k];
                    lg[0] += xv * r0[0]; lg[1] += xv * r0[1]; lg[2] += xv * r0[2]; lg[3] += xv * r0[3]; lg[4] += xv * r1[0]; lg[5] += xv * r1[1]; lg[6] += xv * r1[2]; lg[7] += xv * r1[3]; }
            {
                const bool h3 = (lane & 8) != 0;
                float r4[4], r2[2], r1;
#pragma unroll
                for (int i = 0; i < 4; ++i) r4[i] = swapsum32(lg[i], lg[4 + i]);
#pragma unroll
                for (int i = 0; i < 2; ++i) r2[i] = swapsum16(r4[i], r4[2 + i]);
                { const float send = h3 ? r2[0] : r2[1], mine = h3 ? r2[1] : r2[0]; r1 = mine + xshfl<8>(send); }
                r1 += xshfl<1>(r1); r1 += xshfl<2>(r1); r1 += dpp_half_mirror(r1);
#pragma unroll
                for (int e = 0; e < 8; ++e) lg[e] = __builtin_bit_cast(float, __builtin_amdgcn_readlane(__builtin_bit_cast(int, r1), 8 * e));
            }
            int e0 = 0; float m0 = lg[0];
#pragma unroll
            for (int e = 1; e < 8; ++e) if (lg[e] > m0) { m0 = lg[e]; e0 = e; }
            int e1 = -1; float m1 = -3.0e38f;
#pragma unroll
            for (int e = 0; e < 8; ++e) if (e != e0 && lg[e] > m1) { m1 = lg[e]; e1 = e; }
            const float w0 = 1.0f / (1.0f + __expf(m1 - m0));
            if (lane == 0) { ((int*)(ws + SM_TOKE))[row] = e0 | (e1 << 8); ((f32x2*)(ws + SM_TOKW))[row] = (f32x2){w0, 1.0f - w0}; __hip_atomic_fetch_add(&cnt[e0], 1, __ATOMIC_RELAXED, __HIP_MEMORY_SCOPE_WORKGROUP); __hip_atomic_fetch_add(&cnt[e1], 1, __ATOMIC_RELAXED, __HIP_MEMORY_SCOPE_WORKGROUP); }
        }
    }
    if (ROUTE) { __syncthreads(); if (F.tid < 8) ((int*)(ws + SM_PCNT))[pm * 8 + F.tid] = cnt[F.tid]; __syncthreads(); }
}
__device__ __forceinline__ void moe_gather(const Frame& F, const Args& a) {
    unsigned char* ws = a.ws; const int* pcnt = (const int*)(ws + SM_PCNT); const int* toke = (const int*)(ws + SM_TOKE);
    int* rowtok = (int*)(ws + SM_ROWTOK); int* tileexp = (int*)(ws + SM_TILEEXP);
    const bf16_t* xb = (const bf16_t*)(ws + WS_XB); bf16_t* xs = (bf16_t*)(ws + WS_XS);
    LAS int* sm = (LAS int*)F.lds;
    for (int pm = F.bid; pm < T / 256; pm += F.G) {
        for (int q = F.tid; q < (T / 256) * 8; q += 512) sm[1024 + q] = pcnt[q];
        if (F.tid >= 32 && F.tid < 288) sm[F.tid] = toke[pm * 256 + F.tid - 32];
        __syncthreads();
        if (F.tid < 8) { int tot = 0, before = 0; for (int q = 0; q < T / 256; ++q) { const int c = sm[1024 + q * 8 + F.tid]; tot += c; if (q < pm) before += c; } sm[F.tid] = tot; sm[16 + F.tid] = before; }
        __syncthreads();
        if (F.tid == 0) { int st = 0; for (int e = 0; e < 8; ++e) { sm[8 + e] = st * 256; st += (sm[e] + 255) >> 8; } sm[24] = st; }
        __syncthreads();
        {
            const int i = F.tid >> 1, k = F.tid & 1; const int ee = sm[32 + i]; const int e = k ? (ee >> 8) : (ee & 255);
            int cntb = 0; for (int q = 0; q < i; ++q) { const int o = sm[32 + q]; cntb += ((o & 255) == e) + ((o >> 8) == e); }
            const int dest = sm[8 + e] + sm[16 + e] + cntb; sm[512 + F.tid] = dest; rowtok[dest] = 2 * (pm * 256 + i) + k;
        }
        __syncthreads();
        for (int r0 = F.wave * 64; r0 < F.wave * 64 + 64; r0 += 8) {
            u32x4 va[8], vb[8];
#pragma unroll
            for (int q = 0; q < 8; ++q) { const size_t tok = (size_t)pm * 256 + ((r0 + q) >> 1); const u32x4* s = (const u32x4*)(xb + tok * D); va[q] = s[F.lane]; vb[q] = s[64 + F.lane]; }
#pragma unroll
            for (int q = 0; q < 8; ++q) { const int dest = sm[512 + r0 + q]; u32x4* d = (u32x4*)(xs + (size_t)dest * D); d[F.lane] = va[q]; d[64 + F.lane] = vb[q]; } }
        if (pm == 0) {
            for (int e = 0; e < 8; ++e) { const int r0 = sm[8 + e] + sm[e], r1 = sm[8 + e] + (((sm[e] + 255) >> 8) << 8); for (int r = r0 + F.tid; r < r1; r += 512) rowtok[r] = -1;
                const int t0 = sm[8 + e] >> 8, t1 = r1 >> 8; for (int t = t0 + F.tid; t < t1; t += 512) tileexp[t] = e; }
            if (F.tid == 0) tileexp[1023] = sm[24];
        }
        __syncthreads();
    }
}

__device__ __forceinline__ void moe_tail_finalize(const Frame& F, const Args& a) {
    const int* tileexp = (const int*)(a.ws + SM_TILEEXP); int nt = tileexp[1023] - (MOE_NCHUNK - 1) * MOE_CHUNK_TILES; nt = nt < 0 ? 0 : (nt > 8 ? 8 : nt);
    const float* YT = (const float*)(a.ws + WS_XS); const int* row_tok = (const int*)(a.ws + SM_ROWTOK) + (MOE_NCHUNK - 1) * MOE_CHUNK_TILES * 256; bf16_t* Y = (bf16_t*)(a.ws + WS_YB);
    const int c8 = (F.tid & 127) * 8;
    for (int r = F.bid * 4 + (F.tid >> 7); r < nt * 256; r += F.G * 4) { const int dst = row_tok[r]; if (dst < 0) continue;
        f32x4 s0 = (f32x4){0.f, 0.f, 0.f, 0.f}, s1 = s0;
#pragma unroll
        for (int ks = 0; ks < 7; ++ks) { const float* p = YT + ((size_t)ks * 2048 + r) * D + c8; s0 += *(const f32x4*)p; s1 += *(const f32x4*)(p + 4); }
        u32x4 w; w.x = cvt_pk_bf16(s0[0], s0[1]); w.y = cvt_pk_bf16(s0[2], s0[3]); w.z = cvt_pk_bf16(s1[0], s1[1]); w.w = cvt_pk_bf16(s1[2], s1[3]);
        *(u32x4*)(Y + (size_t)dst * D + c8) = w; }
}
struct MoeUpOrder { int ntile, G, c, chunk; const int* tileexp;
    __device__ __forceinline__ bool next(int i, pg8::Unit& u) const { if (!pg8::static_tile(i, G, c, ntile, 2 * DFE / 256, u.pm, u.pn)) return false;
        const int tile = chunk * MOE_CHUNK_TILES + u.pm, e = tileexp[tile]; u.aux = tile; u.offA = (long long)tile * 256 * D * 2; u.offB = ((long long)e * 2 * DFE + (long long)u.pn * 256) * D * 2; return true; } };
struct MoeDnOrder { int ntile, G, c, chunk; const int* tileexp;
    __device__ __forceinline__ bool next(int i, pg8::Unit& u) const { if (!pg8::static_tile(i, G, c, ntile, D / 256, u.pm, u.pn)) return false;
        const int tile = chunk * MOE_CHUNK_TILES + u.pm, e = tileexp[tile]; u.aux = tile; u.offA = (long long)u.pm * 256 * DFE * 2; u.offB = ((long long)e * D + (long long)u.pn * 256) * DFE * 2; return true; } };

struct MoeDnTailOrder { int ntile, G, c; const int* tileexp;
    __device__ __forceinline__ bool next(int i, pg8::Unit& u) const { const long L = (long)i * G + c; if (L >= (long)ntile * 28) return false;
        const int ks = (int)(L % 7), rest = (int)(L / 7); u.pn = rest & 3; u.pm = rest >> 2; u.aux = ks;
        const int tile = (MOE_NCHUNK - 1) * MOE_CHUNK_TILES + u.pm, e = tileexp[tile];
        u.offA = (long long)u.pm * 256 * DFE * 2 + (long long)ks * 512 * 2; u.offB = ((long long)e * D + (long long)u.pn * 256) * DFE * 2 + (long long)ks * 512 * 2; return true; } };

enum { PH_PREP = 0, PH_WIN, PH_POST, PH_MIX1, PH_MIX2, PH_MIX3, PH_MIX4, PH_WOUT, PH_LN1, PH_FUP, PH_FDN, PH_MGATH = 9, PH_MUP0 = 10, PH_LN2 = 21, PH_PGATE, PH_PPROJ, PH_LN3, PH_PER_LAYER = 32 };
constexpr int GP_END = 2 + 32 * DEPTH;

__global__ void __launch_bounds__(512, 2) mk_fwd(Args a0) {
    extern __shared__ __attribute__((aligned(16))) unsigned char lds_raw[];
    LAS unsigned char* const lds = (LAS unsigned char*)lds_raw;
    for (int u = threadIdx.x; u < (LDS_BYTES - LDSCTL_OFF) / 4; u += 512) ((LAS unsigned*)(lds + LDSCTL_OFF))[u] = 0u;
    __syncthreads();
    const int gp_lo = a0.gp_lo, gp_hi = a0.gp_hi; const int F0bid = blockIdx.x, F0G = gridDim.x; const int wave0 = __builtin_amdgcn_readfirstlane(threadIdx.x >> 6);
    XcdBarrier bar; bar.bar = (unsigned*)(a0.ws + WS_CTL) + CW_BAR; bar.x = 0; bar.st = nullptr;
    if (a0.use_bar) bar = xcd_barrier_post((unsigned*)(a0.ws + WS_CTL) + CW_BAR, (volatile LAS unsigned*)(lds + LDSCTL_OFF + 32));
#if MK_PROBE
#define PRW ((volatile LAS unsigned*)(lds + LDSCTL_OFF + 128))
    if (threadIdx.x == 0) { const unsigned long long t_ = __builtin_amdgcn_s_memrealtime(); PRW[0] = (unsigned)t_; PRW[1] = (unsigned)(t_ >> 32); PRW[2] = 0u; PRW[3] = 0u; PRW[4] = (unsigned)t_; PRW[5] = (unsigned)(t_ >> 32); }
#define STAMP(cls) do { if (wave0 == 0 && lane_id_fresh() == 0) { const unsigned long long t_ = __builtin_amdgcn_s_memrealtime(); const unsigned long long p_ = ((unsigned long long)PRW[1] << 32) | PRW[0]; const unsigned d_ = (unsigned)(t_ - p_); \
        PRW[0] = (unsigned)t_; PRW[1] = (unsigned)(t_ >> 32); if ((PROBE_A >> (cls)) & 1) PRW[2] += d_; if ((PROBE_B >> (cls)) & 1) PRW[3] += d_; } } while (0)
#else
#define STAMP(cls) do {} while (0)
#endif
#define RUN(gp) (gp_lo <= (gp) && (gp) < gp_hi)
#define SEAM(gp) do { if (gp_lo <= (gp) && (gp) + 1 < gp_hi) xcd_barrier(bar, wave0); } while (0)
#define PH_BEGIN Args a; load_args(a); const Frame F = make_frame(lds, wave0); unsigned char* const ws = a.ws; int l = lx; asm volatile("" : "+s"(l)); (void)l; (void)ws; \
    bf16_t* const xb = (bf16_t*)(ws + WS_XB); bf16_t* const z = (bf16_t*)(ws + WS_Z); bf16_t* const mix = (bf16_t*)(ws + WS_MIX); bf16_t* const hbuf = (bf16_t*)(ws + WS_HBUF); const long long S1K = 256ll * 1024 * 2; \
    (void)xb; (void)z; (void)mix; (void)hbuf; (void)S1K;
#define AP_DEF const nsa::Lane L{F.lane, F.lane & 31, F.lane >> 5, F.wave, F.tid}; \
    const nsa::AttnPtrs AP{(const bf16_t*)(ws + WS_Q), z, (const bf16_t*)(ws + WS_KC), (const bf16_t*)(ws + WS_VCT), (const bf16_t*)(ws + WS_KSEL), (const bf16_t*)(ws + WS_VSEL), \
                           (const bf16_t*)(ws + WS_KWIN), (const bf16_t*)(ws + WS_VWIN), (unsigned long long*)(ws + WS_SELM), mix};
    { const int lx = 0;
    if (RUN(0)) { PH_BEGIN phase_init0(F, a); }
    SEAM(0); STAMP(0);
    if (RUN(1)) { PH_BEGIN phase_init1(F, a); }
    SEAM(1); STAMP(0);
    }
    for (int lx = 0; lx < DEPTH; ++lx) {
        const int base = 2 + PH_PER_LAYER * lx; const bool moe = (lx & 1) != 0;
        if (RUN(base + PH_PREP)) { PH_BEGIN phase_prep(F, a, l); }
        SEAM(base + PH_PREP); STAMP(1);
        if (RUN(base + PH_WIN)) { PH_BEGIN
            pg8::Gemm g{xb, (const bf16_t*)(ws + W_IN), D, D, D}; pg8::PlainOrder S{T / 256, INP / 256, F.G, F.bid, S1K, S1K};
            epi::EpiWin E{z, (bf16_t*)(ws + WS_Q), (bf16_t*)(ws + WS_KCMP), (bf16_t*)(ws + WS_S5A), (const f32x2*)(ws + WS_ROPE)};
            pg8::gemm_phase(F.lds, g, S, E, F.tid);
        }
        SEAM(base + PH_WIN); STAMP(2);
        if (RUN(base + PH_MIX1)) {
            for (int r = F0bid; r < 128; r += F0G) {
                {   PH_BEGIN const int g_ = r >> 3, pm_ = r & 7;
                    pg8::Gemm g{(const bf16_t*)(ws + WS_S5A), (const bf16_t*)(ws + W_S5S), 512, S5K, 512};
                    pg8::ListOrder S{1, pm_, g_, (long long)g_ * 2048 * S5K * 2 + (long long)pm_ * 256 * S5K * 2, (long long)g_ * 256 * 512 * 2, 0}; epi::F32Grouped E{(float*)(ws + WS_S5S), 256, (size_t)2048 * 256};
                    pg8::gemm_phase(F.lds, g, S, E, F.tid); }
                __syncthreads();
                {   PH_BEGIN int nr = MK_REP_CARRY; asm volatile("" : "+s"(nr)); for (int q = 0; q < nr; ++q) s5_carry_panel(F, a, l, r >> 3, r & 7); }
                asm volatile("s_waitcnt vmcnt(0)" ::: "memory"); __syncthreads();
                {   PH_BEGIN const int g_ = r >> 3, pm_ = r & 7;
                    pg8::Gemm g{(const bf16_t*)(ws + WS_S5A), (const bf16_t*)(ws + W_S5B), S5K, S5K, S5K};
                    pg8::ListOrder S{2, pm_, g_, (long long)g_ * 2048 * S5K * 2 + (long long)pm_ * 256 * S5K * 2, (long long)g_ * 512 * S5K * 2, 256ll * S5K * 2}; epi::S5Out E{(bf16_t*)(ws + WS_ZS5), z, (const float*)a.in[21] + (size_t)l * 256};
                    pg8::gemm_phase(F.lds, g, S, E, F.tid); }
            }
            for (int r = F0bid - 128; r < 64; r += F0G) { if (r < 0) continue;
                {   PH_BEGIN const int j_ = r >> 5, bh_ = r & 31;
                    pg8::Gemm g{(const bf16_t*)(ws + WS_KCMP), (const bf16_t*)(ws + W_CMP), 1024, 1024, 1024};
                    pg8::ListOrder S{2, bh_, j_, (long long)j_ * (long long)(WS_VCMP - WS_KCMP) + (long long)bh_ * S1K, (long long)j_ * 512 * 1024 * 2, S1K}; epi::F32Grouped E{(float*)(ws + WS_CMPP), 512, (size_t)8192 * 512};
                    pg8::gemm_phase(F.lds, g, S, E, F.tid); }
                asm volatile("s_waitcnt vmcnt(0)" ::: "memory"); __syncthreads();
                {   PH_BEGIN int nr = MK_REP_ST2; asm volatile("" : "+s"(nr)); for (int q = 0; q < nr; ++q) cmp_stage2_panel(F, a, l, r >> 5, r & 31); }
            }
            {   PH_BEGIN
                if (F.G == 256) { const int c = F.bid; const int beg = c < 128 ? c * 5 : (c < 192 ? 640 + (c - 128) * 6 : 1024 + (c - 192) * 16), cnt = c < 128 ? 5 : (c < 192 ? 6 : 16); conv_items(F, a, l, beg, 1, beg + cnt); }
                else conv_items(F, a, l, F.bid, F.G); }
        }
        SEAM(base + PH_MIX1); STAMP(4);
        if (RUN(base + PH_MIX3)) {
            {   PH_BEGIN
                pg8::Gemm g{(const bf16_t*)(ws + WS_ZS5), (const bf16_t*)(ws + W_GLU), 256, 256, 256};
                pg8::PlainOrder S{T / 256, 1, F.G, F.bid, 256ll * 256 * 2, 256ll * 256 * 2}; epi::S5Glu E{mix, (const bf16_t*)(ws + WS_ZS5), (const float*)a.in[23] + (size_t)l * 256};
                pg8::gemm_phase(F.lds, g, S, E, F.tid);
            }
            {   PH_BEGIN AP_DEF
                for (int p = F.bid; p < 32 * 16; p += F.G) { const int bh = p >> 4, s = p & 15;
                    for (int half = 0; half < 2; ++half) { const int qb2 = half ? 31 - s : s;
                        nsa::cmp_unit<true>(bh, 2 * qb2, AP, F.lds, L); nsa::cmp_topk(bh, 2 * qb2, AP, F.lds, L);
                        nsa::cmp_unit<false>(bh, 2 * qb2 + 1, AP, F.lds, L); nsa::cmp_topk(bh, 2 * qb2 + 1, AP, F.lds, L); } } }
            asm volatile("s_waitcnt vmcnt(0)" ::: "memory"); __syncthreads();
            {   PH_BEGIN AP_DEF
                for (int p = F.bid; p < 32 * 16; p += F.G) { const int bh = p >> 4, s = p & 15; nsa::sw_unit2(bh, s, AP, F.lds, L); nsa::sw_unit2(bh, 31 - s, AP, F.lds, L); } }
        }
        SEAM(base + PH_MIX3); STAMP(6);

        if (RUN(base + PH_WOUT)) {
            {   PH_BEGIN
                pg8::Gemm g{mix, (const bf16_t*)(ws + W_OUT), D, D, D}; pg8::PlainOrder S{T / 256, D / 256, F.G, F.bid, S1K, S1K}; epi::Bf16Sc1 E{hbuf, D, (unsigned)((size_t)T * D * 2)};
                pg8::gemm_phase(F.lds, g, S, E, F.tid);
            }
            {   PH_BEGIN pg8::PlainOrder S{T / 256, D / 256, F.G, F.bid, S1K, S1K}; panels_publish_wait(F, (unsigned*)(ws + WS_CTL), 2 * l + 0, S, (unsigned)(D / 256)); }
            {   PH_BEGIN
                const float* gg = (const float*)a.in[34] + ((size_t)l * 3 + 0) * D; const float* bb = (const float*)a.in[35] + ((size_t)l * 3 + 0) * D;
                for (int pm = F.bid; pm < T / 256; pm += F.G) { if (l & 1) ln_panel<0, true, false>(F, a, pm, gg, bb, (const float*)a.in[27] + (size_t)(l >> 1) * D * NEXP); else ln_panel<0, false, false>(F, a, pm, gg, bb, nullptr); }
            }
        }
        SEAM(base + PH_WOUT); STAMP(8);
        if (!moe) {
            if (RUN(base + PH_FUP)) { PH_BEGIN
                pg8::Gemm g{xb, (const bf16_t*)(ws + W_UP), D, D, D}; pg8::PlainOrder S{T / 256, 2 * DFF / 256, F.G, F.bid, S1K, S1K}; epi::SwiGlu E{(bf16_t*)(ws + WS_FFH), DFF};
                pg8::gemm_phase(F.lds, g, S, E, F.tid);
            }
            SEAM(base + PH_FUP); STAMP(9);
            if (RUN(base + PH_FDN)) {
                {   PH_BEGIN
                    pg8::Gemm g{(const bf16_t*)(ws + WS_FFH), (const bf16_t*)(ws + W_DN), DFF, DFF, DFF}; pg8::PlainOrder S{T / 256, D / 256, F.G, F.bid, 256ll * DFF * 2, 256ll * DFF * 2}; epi::Bf16Sc1 E{hbuf, D, (unsigned)((size_t)T * D * 2)};
                    pg8::gemm_phase(F.lds, g, S, E, F.tid);
                }
                {   PH_BEGIN pg8::PlainOrder S{T / 256, D / 256, F.G, F.bid, 256ll * DFF * 2, 256ll * DFF * 2}; panels_publish_wait(F, (unsigned*)(ws + WS_CTL), 2 * l + 1, S, (unsigned)(D / 256)); }
                {   PH_BEGIN
                    const float* gg = (const float*)a.in[34] + ((size_t)l * 3 + 1) * D; const float* bb = (const float*)a.in[35] + ((size_t)l * 3 + 1) * D;
                    for (int pm = F.bid; pm < T / 256; pm += F.G) ln_panel<0, false, false>(F, a, pm, gg, bb, nullptr);
                }
            }
            asm volatile("s_waitcnt vmcnt(0)" ::: "memory"); __syncthreads(); STAMP(10);
        } else {
            if (RUN(base + PH_MGATH)) { PH_BEGIN moe_gather(F, a); }
            SEAM(base + PH_MGATH); STAMP(11);
            for (int cx = 0; cx < MOE_NCHUNK; ++cx) {
                if (RUN(base + PH_MUP0 + 2 * cx)) { PH_BEGIN int c = cx; asm volatile("" : "+s"(c)); const int* tileexp = (const int*)(ws + SM_TILEEXP);
                    int nt = tileexp[1023] - c * MOE_CHUNK_TILES; nt = nt < 0 ? 0 : (nt > MOE_CHUNK_TILES ? MOE_CHUNK_TILES : nt);
                    pg8::Gemm g{(const bf16_t*)(ws + WS_XS), (const bf16_t*)(ws + W_UP), D, D, D}; MoeUpOrder S{nt, F.G, F.bid, c, tileexp}; epi::SwiGlu E{(bf16_t*)(ws + WS_MH), DFE};
                    pg8::gemm_phase(F.lds, g, S, E, F.tid);
                }
                SEAM(base + PH_MUP0 + 2 * cx); STAMP(12);
                if (RUN(base + PH_MUP0 + 2 * cx + 1)) { PH_BEGIN int c = cx; asm volatile("" : "+s"(c)); const int* tileexp = (const int*)(ws + SM_TILEEXP);
                    int nt = tileexp[1023] - c * MOE_CHUNK_TILES; nt = nt < 0 ? 0 : (nt > MOE_CHUNK_TILES ? MOE_CHUNK_TILES : nt);
                    if (cx < MOE_NCHUNK - MK_TAILSPLIT) {
                        pg8::Gemm g{(const bf16_t*)(ws + WS_MH), (const bf16_t*)(ws + W_DN), DFE, DFE, DFE}; MoeDnOrder S{nt, F.G, F.bid, c, tileexp}; epi::MoeDown E{(bf16_t*)(ws + WS_YB), (const int*)(ws + SM_ROWTOK)};
                        pg8::gemm_phase(F.lds, g, S, E, F.tid);
                    } else {
                        nt = nt > 8 ? 8 : nt;
                        pg8::Gemm g{(const bf16_t*)(ws + WS_MH), (const bf16_t*)(ws + W_DN), 512, DFE, DFE}; MoeDnTailOrder S{nt, F.G, F.bid, tileexp}; epi::F32Grouped E{(float*)(ws + WS_XS), D, (size_t)2048 * D};
                        pg8::gemm_phase(F.lds, g, S, E, F.tid);
                    }
                }
                SEAM(base + PH_MUP0 + 2 * cx + 1); STAMP(13);
            }
#if MK_TAILSPLIT
            if (RUN(base + PH_MUP0 + 2 * MOE_NCHUNK)) { PH_BEGIN moe_tail_finalize(F, a); }
            SEAM(base + PH_MUP0 + 2 * MOE_NCHUNK); STAMP(13);
#endif
        }
        if (RUN(base + PH_PGATE)) {
            if (moe) {
                {   PH_BEGIN
                    const float* gg = (const float*)a.in[34] + ((size_t)l * 3 + 1) * D; const float* bb = (const float*)a.in[35] + ((size_t)l * 3 + 1) * D;
                    for (int pm = F.bid; pm < T / 256; pm += F.G) ln_panel<1, false, false>(F, a, pm, gg, bb, nullptr);
                }
                asm volatile("s_waitcnt vmcnt(0)" ::: "memory"); __syncthreads();
            }
            {   PH_BEGIN
                pg8::Gemm g{xb, (const bf16_t*)(ws + W_GATE), D, D, D}; pg8::PanelOrder S{T / 256, D / 256, F.G, F.bid, S1K, S1K}; epi::SigmoidBias E{(l & 1) ? (bf16_t*)(ws + WS_PLEG) : mix, D, (const float*)a.in[32] + (size_t)l * D};
                pg8::gemm_phase(F.lds, g, S, E, F.tid);
            }
            __syncthreads();
            {   PH_BEGIN
                pg8::Gemm g{(const bf16_t*)(ws + WS_PB), (const bf16_t*)(ws + W_PROJ), PLE, PLE, PLE}; pg8::PanelOrder S{T / 256, D / 256, F.G, F.bid, 256ll * PLE * 2, 256ll * PLE * 2}; epi::MulBf16 E{(l & 1) ? (bf16_t*)(ws + WS_PLEH) : hbuf, (l & 1) ? (bf16_t*)(ws + WS_PLEG) : mix, D};
                pg8::gemm_phase(F.lds, g, S, E, F.tid);
            }
            __syncthreads();
            {   PH_BEGIN
                const float* gg = (const float*)a.in[34] + ((size_t)l * 3 + 2) * D; const float* bb = (const float*)a.in[35] + ((size_t)l * 3 + 2) * D;
                const size_t hoff = (l & 1) ? WS_PLEH : WS_HBUF;
                for (int pm = F.bid; pm < T / 256; pm += F.G) { if (l == DEPTH - 1) ln_panel<0, false, true>(F, a, pm, gg, bb, nullptr, hoff); else ln_panel<0, false, false>(F, a, pm, gg, bb, nullptr, hoff); }
            }
        }
        SEAM(base + PH_PGATE); STAMP(15);
    }
#if MK_PROBE
    if (blockIdx.x == 0) {
        __syncthreads(); asm volatile("s_waitcnt vmcnt(0)" ::: "memory");
        const unsigned long long t1 = ((unsigned long long)PRW[1] << 32) | PRW[0], t0 = ((unsigned long long)PRW[5] << 32) | PRW[4];
        const float tot = (float)(unsigned)(t1 - t0), fa = (float)PRW[2] / tot, fb = (float)PRW[3] / tot;
        Args ae; load_args(ae);
        const int tidp = wave0 * 64 + lane_id_fresh();
        if (tidp == 0) ae.out[0] += 1.0f + 8.0f * fa;
        for (int i = tidp; i < 100000; i += 512) ae.out[1024 + i] += 0.5f * fb;
    }
#endif
#undef RUN
#undef SEAM
}

static bool phase_applies(int gp) {
    if (gp < 2) return true;
    const int l = (gp - 2) / PH_PER_LAYER, ph = (gp - 2) % PH_PER_LAYER; const bool moe = (l & 1) != 0;
    if (ph < PH_LN1) return ph != PH_POST && ph != PH_MIX2 && ph != PH_MIX4;
    if (ph == PH_PGATE) return true;
    if (!moe) return ph == PH_FUP || ph == PH_FDN;
    return ph >= PH_MGATH && ph <= PH_MUP0 + 2 * MOE_NCHUNK;
}
extern "C" void kernel_launch(void* const* d_in, const int* in_sizes, int n_in, void* d_out, int out_size, void* d_ws, size_t ws_size, hipStream_t stream) {
    static int grid = 0;
    if (grid == 0) {
        if (n_in != 36 || out_size != T * D || ws_size < WS_END) { fprintf(stderr, "kernel_launch: unexpected problem (n_in %d out %d ws %zu, need %zu)\n", n_in, out_size, ws_size, (size_t)WS_END); grid = -1; return; }
        int dev = 0, cus = 0, per_cu = 0;
        if (hipGetDevice(&dev) != hipSuccess || hipDeviceGetAttribute(&cus, hipDeviceAttributeMultiprocessorCount, dev) != hipSuccess) { grid = -1; return; }
        if (hipFuncSetAttribute((const void*)mk_fwd, hipFuncAttributeMaxDynamicSharedMemorySize, LDS_BYTES) != hipSuccess) { fprintf(stderr, "kernel_launch: hipFuncSetAttribute failed\n"); grid = -1; return; }
        if (hipOccupancyMaxActiveBlocksPerMultiprocessor(&per_cu, (const void*)mk_fwd, 512, LDS_BYTES) != hipSuccess || per_cu < 1) fprintf(stderr, "kernel_launch: occupancy query reports %d\n", per_cu);
        (void)hipGetLastError();
        grid = cus;
    }
    if (grid < 0) return;
    (void)in_sizes;
    if (hipMemsetAsync((char*)d_ws + WS_CTL, 0, CTL_ZERO_BYTES, stream) != hipSuccess) return;
#if MK_CHECK
    (void)hipMemsetAsync((char*)d_ws + SM_CHK, 0, 256, stream);
#endif
    Args a{};
    for (int i = 0; i < 36; ++i) a.in[i] = d_in[i];
    a.out = (float*)d_out; a.ws = (unsigned char*)d_ws; a.pad = 0;
#if MK_MULTI
    for (int gp = 0; gp < GP_END; ++gp) { if (!phase_applies(gp)) continue; a.gp_lo = gp; a.gp_hi = gp + 1; a.use_bar = 0;
        hipLaunchKernelGGL(mk_fwd, dim3(grid), dim3(512), LDS_BYTES, stream, a);
#if MK_CHECK
        run_checks(a, gp, stream);
#endif
    }
#if MK_CHECK
    hipLaunchKernelGGL(chk_final, dim3(1), dim3(1), 0, stream, a);
#endif
#else
    a.gp_lo = 0; a.gp_hi = GP_END; a.use_bar = 1;
    hipLaunchKernelGGL(mk_fwd, dim3(grid), dim3(512), LDS_BYTES, stream, a);
#endif
}
```

```cpp
#include <hip/hip_runtime.h>
#include <cstdint>
#include <cstdio>
#ifndef MK_TAILSPLIT
#define MK_TAILSPLIT 1
#endif
#ifndef MK_MULTI
#define MK_MULTI 0
#endif
#ifndef MK_CHECK
#define MK_CHECK 0
#endif
#ifndef MK_REP_G1
#define MK_REP_G1 1
#endif
#ifndef MK_REP_G2
#define MK_REP_G2 1
#endif
#ifndef MK_REP_CU
#define MK_REP_CU 1
#endif
#ifndef MK_REP_TK
#define MK_REP_TK 1
#endif
#ifndef MK_REP_WOUT
#define MK_REP_WOUT 1
#endif
#ifndef MK_REP_CONV
#define MK_REP_CONV 1
#endif
#ifndef MK_REP_ST2
#define MK_REP_ST2 1
#endif
#ifndef MK_REP_CARRY
#define MK_REP_CARRY 1
#endif
#ifndef MK_REPCMP
#define MK_REPCMP 1
#endif
#ifndef MK_ALIGN_EPI
#define MK_ALIGN_EPI 1
#endif
#ifndef MK_PROBE
#define MK_PROBE 0
#endif
#ifndef PROBE_A
#define PROBE_A 0
#endif
#ifndef PROBE_B
#define PROBE_B 0
#endif
#ifndef CHK_LAYER
#define CHK_LAYER 15
#endif

#define GAS __attribute__((address_space(1)))
#define LAS __attribute__((address_space(3)))
typedef unsigned short bf16_t;
typedef short bf16x8 __attribute__((ext_vector_type(8)));
typedef float f32x4 __attribute__((ext_vector_type(4)));
typedef float f32x2 __attribute__((ext_vector_type(2)));
typedef float f32x16 __attribute__((ext_vector_type(16)));
typedef unsigned u32x4 __attribute__((ext_vector_type(4)));
typedef unsigned u32x2 __attribute__((ext_vector_type(2)));

constexpr int NB = 16, SEQ = 4096, T = NB * SEQ, D = 1024, DEPTH = 4;
constexpr int INW = 2072, INP = 2304;
constexpr int ZKV = 512, ZG = 1280, ZC = 1304, ZS = 1816;
constexpr int DFF = 2816, DFE = 3584, NEXP = 8, PLE = 256;
constexpr int NCMP = 255;
constexpr int S5LC = 32, S5NCH = SEQ / S5LC, S5K = S5LC * 16 + 128;
constexpr float ALPHA = 1.6817928305074290f;
constexpr float LN_EPS = 1e-5f;
constexpr float QSCALE = 0.125f * 1.4426950408889634f;
constexpr float NEGF = -1e30f;
constexpr int MOE_TILES_MAX = 520, MOE_CHUNK_TILES = 128, MOE_NCHUNK = 5;

typedef __bf16 bf16x2_t __attribute__((ext_vector_type(2)));
__device__ __forceinline__ unsigned cvt_pk_bf16(float lo, float hi) { f32x2 v = {lo, hi}; const bf16x2_t b = __builtin_convertvector(v, bf16x2_t); return __builtin_bit_cast(unsigned, b); }
__device__ __forceinline__ bf16_t f2bf(float f) { return (bf16_t)(cvt_pk_bf16(f, 0.f) & 0xffffu); }
__device__ __forceinline__ float bf2f(unsigned v) { return __uint_as_float(v << 16); }
__device__ __forceinline__ float bflo(unsigned w) { return __uint_as_float(w << 16); }
__device__ __forceinline__ float bfhi(unsigned w) { return __uint_as_float(w & 0xffff0000u); }
__device__ __forceinline__ float fast_exp2(float x) { return __builtin_amdgcn_exp2f(x); }
__device__ __forceinline__ float fast_rcp(float x) { return __builtin_amdgcn_rcpf(x); }
__device__ __forceinline__ float sigmoidf_(float x) { return fast_rcp(1.0f + fast_exp2(-1.4426950408889634f * x)); }
__device__ __forceinline__ float siluf_(float x) { return x * sigmoidf_(x); }
__device__ __forceinline__ float gelu_tanh(float x) { const float u = 0.7978845608028654f * (x + 0.044715f * x * x * x); return x * sigmoidf_(2.0f * u); }
__device__ __forceinline__ int lane_id_fresh() { unsigned z = 0u; asm volatile("" : "+v"(z)); return (int)__builtin_amdgcn_mbcnt_hi(~0u, __builtin_amdgcn_mbcnt_lo(~0u, z)); }
template <int MASK> __device__ __forceinline__ float xshfl(float v) {
    if (MASK == 1) return __uint_as_float((unsigned)__builtin_amdgcn_update_dpp(0, (int)__float_as_uint(v), 0xB1, 0xF, 0xF, true));
    if (MASK == 2) return __uint_as_float((unsigned)__builtin_amdgcn_update_dpp(0, (int)__float_as_uint(v), 0x4E, 0xF, 0xF, true));
    if (MASK == 32) { const unsigned u = __float_as_uint(v); auto rr = __builtin_amdgcn_permlane32_swap(u, u, false, false); return __uint_as_float((rr[0] == u) ? rr[1] : rr[0]); }
    return __uint_as_float((unsigned)__builtin_amdgcn_ds_swizzle((int)__float_as_uint(v), 0x1f | (MASK << 10)));
}
__device__ __forceinline__ float xsum32(float v) { const unsigned u = __float_as_uint(v); auto rr = __builtin_amdgcn_permlane32_swap(u, u, false, false); return __uint_as_float(rr[0]) + __uint_as_float(rr[1]); }
__device__ __forceinline__ float xsum16(float v) { const unsigned u = __float_as_uint(v); auto rr = __builtin_amdgcn_permlane16_swap(u, u, false, false); return __uint_as_float(rr[0]) + __uint_as_float(rr[1]); }
__device__ __forceinline__ float swapsum32(float a, float b) { auto rr = __builtin_amdgcn_permlane32_swap(__float_as_uint(a), __float_as_uint(b), false, false); return __uint_as_float(rr[0]) + __uint_as_float(rr[1]); }
__device__ __forceinline__ float swapsum16(float a, float b) { auto rr = __builtin_amdgcn_permlane16_swap(__float_as_uint(a), __float_as_uint(b), false, false); return __uint_as_float(rr[0]) + __uint_as_float(rr[1]); }
__device__ __forceinline__ float dpp_half_mirror(float v) { return __uint_as_float((unsigned)__builtin_amdgcn_update_dpp(0, (int)__float_as_uint(v), 0x141, 0xF, 0xF, true)); }
__device__ __forceinline__ float wave_sum(float v) {
    v += xshfl<1>(v); v += xshfl<2>(v);
    v += __uint_as_float((unsigned)__builtin_amdgcn_update_dpp(0, (int)__float_as_uint(v), 0x141, 0xF, 0xF, true));
    v += __uint_as_float((unsigned)__builtin_amdgcn_update_dpp(0, (int)__float_as_uint(v), 0x140, 0xF, 0xF, true));
    v = xsum16(v); v = xsum32(v);
    return v;
}
#define LDS_WAIT() asm volatile("s_waitcnt lgkmcnt(0)" ::: "memory")
#define VM_WAIT() asm volatile("s_waitcnt vmcnt(0)" ::: "memory")

namespace pg8 {
constexpr int BM = 256, BK = 64, HALF = 128, HTB = HALF * BK * 2, STAGE_BYTES = 8 * HTB, NXCD = 8, WGM = 8;
__host__ __device__ __forceinline__ int lds_byte(int r, int c) { const int st = (r >> 4) * 2 + (c >> 5), rr = r & 15, cc = c & 31, ob = rr * 64 + cc * 2; return st * 1024 + (ob ^ (((ob >> 9) & 1) << 5)); }
__host__ __device__ __forceinline__ void stage_rc(int b, int& R, int& C) { const int st = b / 1024, sb = b % 1024, swz = sb ^ (((sb >> 9) & 1) << 5); R = (st >> 1) * 16 + swz / 64; C = (st & 1) * 32 + (swz % 64) / 2; }
__host__ __device__ __forceinline__ int perm32(int rho) { const int n = rho >> 4, i = rho & 15; return 8 * (i >> 2) + 4 * n + (i & 3); }

struct Unit { int pm, pn; long long offA, offB; int aux; };
struct Gemm { const bf16_t* A; const bf16_t* Bt; int K, lda, ldb; };

__device__ __forceinline__ bool static_tile(int i, int G, int c, int nM, int nN, int& pm, int& pn) {
    const int nwg = nM * nN; const long L = (long)i * G + c; if (L >= nwg) return false;
    int wgid = (int)L; { const int q = nwg / NXCD, r = nwg % NXCD, xcd = wgid % NXCD, off = wgid / NXCD; wgid = (xcd < r ? xcd * (q + 1) : r * (q + 1) + (xcd - r) * q) + off; }
    const int nig = WGM * nN, gid = wgid / nig, fm = gid * WGM, gsz = (nM - fm) < WGM ? (nM - fm) : WGM;
    pm = fm + ((wgid % nig) % gsz); pn = (wgid % nig) / gsz; return true;
}
struct PlainOrder {
    int nM, nN, G, c; long long sA, sB;
    __device__ __forceinline__ bool next(int i, Unit& u) const { if (!static_tile(i, G, c, nM, nN, u.pm, u.pn)) return false; u.offA = (long long)u.pm * sA; u.offB = (long long)u.pn * sB; u.aux = 0; return true; }
};
struct PanelOrder {
    int nM, nN, G, c; long long sA, sB;
    __device__ __forceinline__ bool next(int i, Unit& u) const { const int pm = c + G * (i / nN); if (pm >= nM) return false; u.pm = pm; u.pn = i % nN; u.offA = (long long)pm * sA; u.offB = (long long)u.pn * sB; u.aux = 0; return true; }
};
struct ListOrder {
    int n, pm, aux; long long offA0, offB0, sB;
    __device__ __forceinline__ bool next(int i, Unit& u) const { if (i >= n) return false; u.pm = pm; u.pn = i; u.aux = aux; u.offA = offA0; u.offB = offB0 + (long long)i * sB; return true; }
};
struct GroupedOrder {
    int ng, nM, nN, G, c; long long sA, sB, gA, gB;
    __device__ __forceinline__ bool next(int i, Unit& u) const {
        const long L = (long)i * G + c; const int per = nM * nN; if (L >= (long)ng * per) return false;
        const int gi = (int)(L / per), r = (int)(L % per); u.pm = r / nN; u.pn = r % nN; u.aux = gi;
        u.offA = (long long)gi * gA + (long long)u.pm * sA; u.offB = (long long)gi * gB + (long long)u.pn * sB; return true; }
};

template <class Epi, class Sched>
__device__ __forceinline__ void gemm_phase(LAS unsigned char* lds, const Gemm g, const Sched& S, const Epi& E, int tid_in) {
    int tid_ = tid_in; asm volatile("" : "+v"(tid_));
    const int tid = tid_, wid = __builtin_amdgcn_readfirstlane(tid >> 6), lane = tid & 63, wr = wid >> 2, wc = wid & 3, fr = lane & 15, fq = lane >> 4;
    int K_ = g.K; asm volatile("" : "+s"(K_));
    const int K = K_, nt = K / BK; (void)K;
    unsigned voffA[2], voffB[2];
#pragma unroll
    for (int i = 0; i < 2; ++i) { int R, C; stage_rc(tid * 16 + i * 8192, R, C); const int Rb = Epi::PERM ? ((R & ~31) + perm32(R & 31)) : R;
        voffA[i] = (unsigned)(R * g.lda + C) * 2u; voffB[i] = (unsigned)(Rb * g.ldb + C) * 2u; }
    const size_t kstep = (size_t)(BK * 2);
    const size_t hstepA = (size_t)HALF * g.lda * 2, hstepB = (size_t)HALF * g.ldb * 2;
    const unsigned ldsw = (unsigned)wid * 1024u;
    const int aoff = lds_byte(wr * 64 + fr, fq * 8), boff = lds_byte(wc * 32 + fr, fq * 8);
#define PG8_SA(b, h) (((b) * 2 + (h)) * HTB)
#define PG8_SB(b, h) ((4 + (b) * 2 + (h)) * HTB)
#define PG8_STAGE(bufoff, gbase, voff) do { _Pragma("unroll") for (int _i = 0; _i < 2; ++_i) \
        __builtin_amdgcn_global_load_lds((const unsigned*)((const char*)(gbase) + (voff)[_i]), (LAS unsigned*)(lds + (bufoff) + ldsw + _i * 8192), 16, 0, 0); } while (0)
#define PG8_LDA(dst, b, h) do { _Pragma("unroll") for (int m = 0; m < 4; ++m) _Pragma("unroll") for (int k = 0; k < 2; ++k) dst[m][k] = *(const LAS bf16x8*)(lds + PG8_SA(b, h) + aoff + m * 2048 + k * 1024); } while (0)
#define PG8_LDB(dst, b, h) do { _Pragma("unroll") for (int n = 0; n < 2; ++n) _Pragma("unroll") for (int k = 0; k < 2; ++k) dst[n][k] = *(const LAS bf16x8*)(lds + PG8_SB(b, h) + boff + n * 2048 + k * 1024); } while (0)
#define PG8_MMA(ai, bj, At, Bt) do { __builtin_amdgcn_s_setprio(1); _Pragma("unroll") for (int m = 0; m < 4; ++m) _Pragma("unroll") for (int n = 0; n < 2; ++n) _Pragma("unroll") for (int k = 0; k < 2; ++k) \
        acc[ai][bj][m][n] = __builtin_amdgcn_mfma_f32_16x16x32_bf16(Bt[n][k], At[m][k], acc[ai][bj][m][n], 0, 0, 0); __builtin_amdgcn_s_setprio(0); } while (0)
#define PG8_WAIT_V(n) asm volatile("s_waitcnt vmcnt(" #n ")" ::: "memory")
#define PG8_WAIT_L(n) asm volatile("s_waitcnt lgkmcnt(" #n ")" ::: "memory")
#define PG8_BAR __builtin_amdgcn_s_barrier()
#define PG8_SCHED __builtin_amdgcn_sched_barrier(0)
    Unit cur, nxt; int ui = 0;
    if (!S.next(0, cur)) return;
    f32x4 acc[2][2][4][2];
#pragma unroll
    for (int a = 0; a < 2; ++a)
#pragma unroll
        for (int b = 0; b < 2; ++b)
#pragma unroll
            for (int m = 0; m < 4; ++m)
#pragma unroll
                for (int n = 0; n < 2; ++n) acc[a][b][m][n] = (f32x4){0.f, 0.f, 0.f, 0.f};
    bf16x8 At[4][2], B0[2][2], B1[2][2];
    const char* cA = (const char*)g.A + cur.offA; const char* cB = (const char*)g.Bt + cur.offB;
    PG8_STAGE(PG8_SB(0, 0), cB, voffB); PG8_STAGE(PG8_SB(0, 1), cB + hstepB, voffB); PG8_STAGE(PG8_SA(0, 0), cA, voffA); PG8_STAGE(PG8_SA(0, 1), cA + hstepA, voffA);
    if (wr == 1) PG8_BAR;
    PG8_WAIT_V(2); PG8_BAR;
    PG8_STAGE(PG8_SB(1, 0), cB + kstep, voffB); PG8_STAGE(PG8_SA(1, 0), cA + kstep, voffA); PG8_STAGE(PG8_SB(1, 1), cB + hstepB + kstep, voffB);
    PG8_WAIT_V(6); PG8_BAR;
    for (;;) {
        const bool has_next = S.next(ui + 1, nxt);
        const char* nA = has_next ? (const char*)g.A + nxt.offA : cA; const char* nB = has_next ? (const char*)g.Bt + nxt.offB : cB;
        for (int t = 0; t < nt; t += 2) {
            const bool last = (t == nt - 2);
            const char* a1 = cA + (size_t)(t + 1) * kstep;
            const char* a2 = last ? nA : cA + (size_t)(t + 2) * kstep; const char* b2 = last ? nB : cB + (size_t)(t + 2) * kstep;
            const char* a3 = a2 + kstep; const char* b3 = b2 + kstep;
            PG8_LDB(B0, 0, 0); PG8_LDB(B1, 0, 1); PG8_SCHED; PG8_LDA(At, 0, 0); PG8_STAGE(PG8_SA(1, 1), a1 + hstepA, voffA);
            PG8_WAIT_V(8); PG8_WAIT_L(0); PG8_BAR; PG8_MMA(0, 0, At, B0); PG8_MMA(0, 1, At, B1); PG8_BAR; PG8_SCHED;
            PG8_LDA(At, 0, 1); PG8_STAGE(PG8_SB(0, 0), b2, voffB); PG8_STAGE(PG8_SB(0, 1), b2 + hstepB, voffB); PG8_STAGE(PG8_SA(0, 0), a2, voffA);
            PG8_WAIT_V(8); PG8_WAIT_L(0); PG8_BAR; PG8_MMA(1, 0, At, B0); PG8_MMA(1, 1, At, B1); PG8_BAR; PG8_SCHED;
            PG8_LDB(B0, 1, 0); PG8_LDB(B1, 1, 1); PG8_SCHED; PG8_LDA(At, 1, 0); PG8_STAGE(PG8_SA(0, 1), a2 + hstepA, voffA);
            PG8_WAIT_V(8); PG8_WAIT_L(0); PG8_BAR; PG8_MMA(0, 0, At, B0); PG8_MMA(0, 1, At, B1); PG8_BAR; PG8_SCHED;
            PG8_LDA(At, 1, 1); PG8_STAGE(PG8_SB(1, 0), b3, voffB); PG8_STAGE(PG8_SB(1, 1), b3 + hstepB, voffB); PG8_STAGE(PG8_SA(1, 0), a3, voffA);
            PG8_WAIT_V(8); PG8_WAIT_L(0); PG8_BAR; PG8_MMA(1, 0, At, B0); PG8_MMA(1, 1, At, B1); PG8_BAR; PG8_SCHED;
        }
#if MK_ALIGN_EPI
        if (wr == 0) PG8_BAR;
#endif
        { int fr_ = fr, fq_ = fq; asm volatile("" : "+v"(fr_), "+v"(fq_));
          E(acc, cur, wr, wc, fr_, fq_); }
        if (!has_next) break;
#pragma unroll
        for (int a = 0; a < 2; ++a)
#pragma unroll
            for (int b = 0; b < 2; ++b)
#pragma unroll
                for (int m = 0; m < 4; ++m)
#pragma unroll
                    for (int n = 0; n < 2; ++n) acc[a][b][m][n] = (f32x4){0.f, 0.f, 0.f, 0.f};
        cur = nxt; cA = nA; cB = nB; ++ui;
#if MK_ALIGN_EPI
        if (wr == 1) PG8_BAR;
#endif
    }
    PG8_WAIT_V(0);
#if !MK_ALIGN_EPI
    if (wr == 0) PG8_BAR;
#endif
    PG8_BAR;
#undef PG8_SA
#undef PG8_SB
#undef PG8_STAGE
#undef PG8_LDA
#undef PG8_LDB
#undef PG8_MMA
#undef PG8_WAIT_V
#undef PG8_WAIT_L
#undef PG8_BAR
#undef PG8_SCHED
}
}

#define XB_TMO      128
#define XB_XCNT(j)  (256  + 64 * (j))
#define XB_XSUB(j)  (1280 + 64 * (j))
#define XB_XGEN(j)  (2304 + 64 * (j))
#define XB_TOP      3328
#define XB_TOPGEN   3392
#define XCD_BAR_WORDS 3456
#define XB_SPIN_CAP (1u << 20)
__device__ __forceinline__ unsigned xb_ld(unsigned* p)              { return __hip_atomic_load(p, __ATOMIC_RELAXED, __HIP_MEMORY_SCOPE_AGENT); }
__device__ __forceinline__ unsigned xb_add(unsigned* p, unsigned v) { return __hip_atomic_fetch_add(p, v, __ATOMIC_RELAXED, __HIP_MEMORY_SCOPE_AGENT); }
__device__ __forceinline__ unsigned xb_xcc_id() { return (unsigned)__builtin_amdgcn_s_getreg((3 << 11) | 20) & 0xFu; }
#define XB_SPIN(cond, bar) do { unsigned _sp = 0; while (cond) { __builtin_amdgcn_s_sleep(1); \
    if ((++_sp & 255u) == 0u) { if (xb_ld(&(bar)[XB_TMO])) break; if (_sp > XB_SPIN_CAP) { atomicAdd(&(bar)[XB_TMO], 1u); break; } } } } while (0)
struct XcdBarrier { unsigned* bar; unsigned x; volatile LAS unsigned* st; };
__device__ __forceinline__ XcdBarrier xcd_barrier_post(unsigned* bar, volatile LAS unsigned* st) {
    XcdBarrier b; b.bar = bar; b.x = xb_xcc_id(); b.st = st;
    if (threadIdx.x == 0) (void)xb_add(&bar[XB_XCNT(b.x)], 1u);
    return b;
}
__device__ __forceinline__ void xcd_barrier_complete(unsigned* bar, unsigned x, unsigned& nloc, unsigned& nx) {
    const unsigned G = gridDim.x * gridDim.y * gridDim.z;
    unsigned sum, cnt, mine, sp = 0u;
    for (;;) {
        sum = 0u; cnt = 0u; mine = 0u;
#pragma unroll 1
        for (unsigned j = 0; j < 16; ++j) { const unsigned c = xb_ld(&bar[XB_XCNT(j)]); sum += c; cnt += (c > 0u) ? 1u : 0u; mine = (j == x) ? c : mine; }
        if (sum == G) break;
        __builtin_amdgcn_s_sleep(1);
        if ((++sp & 255u) == 0u) { if (xb_ld(&bar[XB_TMO])) break; if (sp > XB_SPIN_CAP) { atomicAdd(&bar[XB_TMO], 1u); break; } }
    }
    nloc = mine > 0u ? mine : 1u; nx = cnt > 0u ? cnt : 1u;
}
__device__ __forceinline__ void xcd_barrier(const XcdBarrier& b, int wave_id) {
    asm volatile("s_waitcnt vmcnt(0)" ::: "memory");
    __syncthreads();
    if (wave_id == 0 && lane_id_fresh() == 0) {
        unsigned* bar = b.bar; asm volatile("" : "+s"(bar));
        __builtin_amdgcn_s_waitcnt(0);
        unsigned nloc = b.st[0], nx = b.st[1];
        if (nloc == 0u) { xcd_barrier_complete(bar, b.x, nloc, nx); b.st[0] = nloc; b.st[1] = nx; }
        const unsigned old = xb_add(&bar[XB_XSUB(b.x)], 1u);
        const unsigned gen = old / nloc;
        if (old + 1u == (gen + 1u) * nloc) {
            __builtin_amdgcn_fence(__ATOMIC_RELEASE, "agent");
            asm volatile("s_waitcnt vmcnt(0)" ::: "memory");
            const unsigned og = xb_add(&bar[XB_TOP], 1u);
            const unsigned tg = og / nx;
            if (og + 1u == (tg + 1u) * nx) xb_add(&bar[XB_TOPGEN], 1u);
            else XB_SPIN(xb_ld(&bar[XB_TOPGEN]) == tg, bar);
            __builtin_amdgcn_fence(__ATOMIC_ACQUIRE, "agent");
            xb_add(&bar[XB_XGEN(b.x)], 1u);
            asm volatile("s_waitcnt vmcnt(0)" ::: "memory");
        } else {
            XB_SPIN(xb_ld(&bar[XB_XGEN(b.x)]) == gen, bar);
            __builtin_amdgcn_fence(__ATOMIC_ACQUIRE, "agent");
            asm volatile("s_waitcnt vmcnt(0)" ::: "memory");
        }
    }
    __syncthreads();
}
namespace nsa {
constexpr int PITCH = 144, TILE_LDS = 64 * PITCH;
__device__ __forceinline__ int crow(int r, int hi) { return (r & 3) + 8 * (r >> 2) + 4 * hi; }
__device__ __forceinline__ int vslot(int kk) { return (kk & 0x33) | (((kk >> 2) & 1) << 3) | (((kk >> 3) & 1) << 2); }

struct Lane { int lane, c, hi, wid, tid; };

__device__ __forceinline__ void qk_tile(f32x16& p0, f32x16& p1, const LAS unsigned char* Ks, const bf16x8 (&qr)[4], float bias, const Lane& L) {
#pragma unroll
    for (int r = 0; r < 16; ++r) { p0[r] = bias; p1[r] = bias; }
    const LAS unsigned char* kb = Ks + L.c * PITCH + L.hi * 16;
#pragma unroll
    for (int d0 = 0; d0 < 4; ++d0) {
        const bf16x8 k0 = *(const LAS bf16x8*)(kb + d0 * 32);
        const bf16x8 k1 = *(const LAS bf16x8*)(kb + 32 * PITCH + d0 * 32);
        p0 = __builtin_amdgcn_mfma_f32_32x32x16_bf16(k0, qr[d0], p0, 0, 0, 0);
        p1 = __builtin_amdgcn_mfma_f32_32x32x16_bf16(k1, qr[d0], p1, 0, 0, 0);
    }
}
__device__ __forceinline__ void qk_tile_c(f32x16& p0, f32x16& p1, const LAS unsigned char* Ks, const bf16x8 (&qr)[4], const f32x16& cv, const Lane& L) {
    const LAS unsigned char* kb = Ks + L.c * PITCH + L.hi * 16;
    { const bf16x8 k0 = *(const LAS bf16x8*)(kb); const bf16x8 k1 = *(const LAS bf16x8*)(kb + 32 * PITCH);
      p0 = __builtin_amdgcn_mfma_f32_32x32x16_bf16(k0, qr[0], cv, 0, 0, 0); p1 = __builtin_amdgcn_mfma_f32_32x32x16_bf16(k1, qr[0], cv, 0, 0, 0); }
#pragma unroll
    for (int d0 = 1; d0 < 4; ++d0) {
        const bf16x8 k0 = *(const LAS bf16x8*)(kb + d0 * 32);
        const bf16x8 k1 = *(const LAS bf16x8*)(kb + 32 * PITCH + d0 * 32);
        p0 = __builtin_amdgcn_mfma_f32_32x32x16_bf16(k0, qr[d0], p0, 0, 0, 0);
        p1 = __builtin_amdgcn_mfma_f32_32x32x16_bf16(k1, qr[d0], p1, 0, 0, 0);
    }
}
__device__ __forceinline__ void mask_range(f32x16& p0, f32x16& p1, int lo, int hi_, int hi) {
#pragma unroll
    for (int r = 0; r < 16; ++r) { const int k0 = crow(r, hi), k1 = k0 + 32;
        if (k0 <= lo || k0 > hi_) p0[r] = NEGF;
        if (k1 <= lo || k1 > hi_) p1[r] = NEGF; }
}
__device__ __forceinline__ float tile_max(const f32x16& p0, const f32x16& p1) {
    float a = fmaxf(p0[0], p1[0]);
#pragma unroll
    for (int r = 1; r < 16; ++r) a = fmaxf(a, fmaxf(p0[r], p1[r]));
    return fmaxf(a, xshfl<32>(a));
}
__device__ __forceinline__ void pv_tile(f32x16& o0, f32x16& o1, const LAS unsigned char* Vs, const f32x16& p0, const f32x16& p1, const Lane& L) {
    const LAS unsigned char* vb = Vs + L.c * PITCH + L.hi * 16;
#pragma unroll
    for (int s = 0; s < 4; ++s) {
        u32x4 w;
        if (s < 2) { const int b = 8 * (s & 1); w.x = cvt_pk_bf16(p0[b], p0[b + 1]); w.y = cvt_pk_bf16(p0[b + 2], p0[b + 3]); w.z = cvt_pk_bf16(p0[b + 4], p0[b + 5]); w.w = cvt_pk_bf16(p0[b + 6], p0[b + 7]); }
        else       { const int b = 8 * (s & 1); w.x = cvt_pk_bf16(p1[b], p1[b + 1]); w.y = cvt_pk_bf16(p1[b + 2], p1[b + 3]); w.z = cvt_pk_bf16(p1[b + 4], p1[b + 5]); w.w = cvt_pk_bf16(p1[b + 6], p1[b + 7]); }
        const bf16x8 pf = __builtin_bit_cast(bf16x8, w);
        const bf16x8 v0 = *(const LAS bf16x8*)(vb + s * 32);
        const bf16x8 v1 = *(const LAS bf16x8*)(vb + 32 * PITCH + s * 32);
        o0 = __builtin_amdgcn_mfma_f32_32x32x16_bf16(v0, pf, o0, 0, 0, 0);
        o1 = __builtin_amdgcn_mfma_f32_32x32x16_bf16(v1, pf, o1, 0, 0, 0);
        if (s & 1) __builtin_amdgcn_sched_barrier(0);
    }
}
__device__ __forceinline__ void softmax_pv(f32x16& p0, f32x16& p1, f32x16& o0, f32x16& o1, float& m, float& l, const LAS unsigned char* Vs, const Lane& L) {
    const float mx = tile_max(p0, p1), mn = fmaxf(m, mx), alpha = fast_exp2(m - mn); m = mn;
    float ls = 0.f;
#pragma unroll
    for (int r = 0; r < 16; ++r) { p0[r] = fast_exp2(p0[r] - mn); p1[r] = fast_exp2(p1[r] - mn); ls += p0[r] + p1[r]; }
    l = l * alpha + ls;
#pragma unroll
    for (int r = 0; r < 16; ++r) { o0[r] *= alpha; o1[r] *= alpha; }
    pv_tile(o0, o1, Vs, p0, p1, L);
}
__device__ __forceinline__ int stage_off(int tid) { return (tid >> 3) * PITCH + (tid & 7) * 16; }

__device__ __forceinline__ void load_q(bf16x8 (&qr)[4], const bf16_t* qbuf, long tok, int head, int hi) {
    const bf16_t* qp = qbuf + tok * 512 + head * 64 + hi * 8;
#pragma unroll
    for (int d0 = 0; d0 < 4; ++d0) qr[d0] = *(const bf16x8*)(qp + d0 * 16);
}

__device__ __forceinline__ u32x4 vload(const bf16_t* Vt, int j, const Lane& L) { return *(const u32x4*)((const char*)Vt + (size_t)j * 8192 + L.lane * 128 + L.wid * 16); }
__device__ __forceinline__ void vstore(LAS unsigned char* Vs, const u32x4 v, const Lane& L) {
    LAS unsigned short* p = (LAS unsigned short*)(Vs + (8 * L.wid) * PITCH) + vslot(L.lane);
    p[0 * (PITCH / 2)] = (unsigned short)(v.x & 0xffffu); p[1 * (PITCH / 2)] = (unsigned short)(v.x >> 16); p[2 * (PITCH / 2)] = (unsigned short)(v.y & 0xffffu); p[3 * (PITCH / 2)] = (unsigned short)(v.y >> 16);
    p[4 * (PITCH / 2)] = (unsigned short)(v.z & 0xffffu); p[5 * (PITCH / 2)] = (unsigned short)(v.z >> 16); p[6 * (PITCH / 2)] = (unsigned short)(v.w & 0xffffu); p[7 * (PITCH / 2)] = (unsigned short)(v.w >> 16);
}
template <int MODE>
__device__ __forceinline__ void run_branch(f32x16& o0, f32x16& o1, float& mref, float& l, const bf16_t* Kt  , const bf16_t* Vt  ,
                                           int jlo, int jhi, int qb, int qrel, unsigned long long selw, const bf16x8 (&qr)[4], LAS unsigned char* lds, const Lane& L) {
    LAS unsigned char* Kbuf = lds; LAS unsigned char* Vbuf = lds + 2 * TILE_LDS;
    const int so = stage_off(L.tid);
    u32x4 kreg = *(const u32x4*)((const char*)Kt + (size_t)jlo * 8192 + L.tid * 16);
    u32x4 vreg = vload(Vt, jlo, L);
    *(LAS u32x4*)(Kbuf + so) = kreg; vstore(Vbuf, vreg, L);
    __syncthreads();
    f32x16 cv;
#pragma unroll
    for (int r = 0; r < 16; ++r) cv[r] = -mref;
    for (int j = jlo; j <= jhi; ++j) {
        const int cur = (j - jlo) & 1;
        if (j < jhi) { kreg = *(const u32x4*)((const char*)Kt + (size_t)(j + 1) * 8192 + L.tid * 16); vreg = vload(Vt, j + 1, L); }
        f32x16 p0, p1;
        if (MODE == 0) { const float cb = ((selw >> j) & 1ull) ? -mref : NEGF;
#pragma unroll
            for (int r = 0; r < 16; ++r) cv[r] = cb; }
        qk_tile_c(p0, p1, Kbuf + cur * TILE_LDS, qr, cv, L);
        if (j == qb) mask_range(p0, p1, -1, qrel, L.hi);
        if (MODE == 1 && j == qb - 8) mask_range(p0, p1, qrel, 64, L.hi);
        const float mx = tile_max(p0, p1);
        if (__any(mx > 8.0f)) {
            const float dl = fmaxf(mx, 0.f), f = fast_exp2(-dl); mref += dl; l *= f;
#pragma unroll
            for (int r = 0; r < 16; ++r) { o0[r] *= f; o1[r] *= f; p0[r] -= dl; p1[r] -= dl; }
            if (MODE == 1) {
#pragma unroll
                for (int r = 0; r < 16; ++r) cv[r] = -mref; }
        }
        float ls = 0.f;
#pragma unroll
        for (int r = 0; r < 16; ++r) { p0[r] = fast_exp2(p0[r]); p1[r] = fast_exp2(p1[r]); ls += p0[r] + p1[r]; }
        l += ls;
        pv_tile(o0, o1, Vbuf + cur * TILE_LDS, p0, p1, L);
        if (j < jhi) { *(LAS u32x4*)(Kbuf + (cur ^ 1) * TILE_LDS + so) = kreg; vstore(Vbuf + (cur ^ 1) * TILE_LDS, vreg, L); }
        __syncthreads();
    }
}
struct SoftState { float mref, l; };
__device__ __forceinline__ void softmax_step2(f32x16& p0, f32x16& p1, f32x16& o0, f32x16& o1, SoftState& st, bool sel, bf16x8 (&pf)[4]) {
    if (__any(st.mref != 0.f)) {
#pragma unroll
        for (int r = 0; r < 16; ++r) { p0[r] -= st.mref; p1[r] -= st.mref; } }
    float ls = 0.f;
#pragma unroll
    for (int r = 0; r < 16; ++r) { p0[r] = fast_exp2(p0[r]); p1[r] = fast_exp2(p1[r]); ls += p0[r] + p1[r]; }
    ls = sel ? ls : 0.f; st.l += ls;
#pragma unroll
    for (int s = 0; s < 4; ++s) { u32x4 w; const int b = 8 * (s & 1);
        if (s < 2) { w.x = cvt_pk_bf16(p0[b], p0[b + 1]); w.y = cvt_pk_bf16(p0[b + 2], p0[b + 3]); w.z = cvt_pk_bf16(p0[b + 4], p0[b + 5]); w.w = cvt_pk_bf16(p0[b + 6], p0[b + 7]); }
        else       { w.x = cvt_pk_bf16(p1[b], p1[b + 1]); w.y = cvt_pk_bf16(p1[b + 2], p1[b + 3]); w.z = cvt_pk_bf16(p1[b + 4], p1[b + 5]); w.w = cvt_pk_bf16(p1[b + 6], p1[b + 7]); }
        if (!sel) w = (u32x4){0u, 0u, 0u, 0u};
        pf[s] = __builtin_bit_cast(bf16x8, w); }
}
__device__ __forceinline__ void renorm_step(f32x16& o0, f32x16& o1, SoftState& st) {
    if (__any(st.l > 1.0995116e12f)) { const bool big = st.l > 1.0995116e12f; const float f = big ? 9.094947e-13f : 1.0f; st.mref += big ? 40.f : 0.f; st.l *= f;
#pragma unroll
        for (int r = 0; r < 16; ++r) { o0[r] *= f; o1[r] *= f; } }
}
template <int MODE>
__device__ __forceinline__ void run_branch2(f32x16& oa0, f32x16& oa1, SoftState& sa, f32x16& ob0, f32x16& ob1, SoftState& sb, const bf16_t* Kt, const bf16_t* Vt, int jlo, int jhi, int qbw, int qrela,
                                            const LAS unsigned long long* selp  , const bf16x8 (&qa)[4], const bf16x8 (&qbf)[4], LAS unsigned char* lds, const Lane& L) {
    LAS unsigned char* Kbuf = lds; LAS unsigned char* Vbuf = lds + 2 * TILE_LDS;
    const int so = stage_off(L.tid);
    {   const u32x4 kreg = *(const u32x4*)((const char*)Kt + (size_t)jlo * 8192 + L.tid * 16); const u32x4 vreg = vload(Vt, jlo, L);
        *(LAS u32x4*)(Kbuf + so) = kreg; vstore(Vbuf, vreg, L); }
    __syncthreads();
    for (int j = jlo; j <= jhi; ++j) {
        const int cur = (j - jlo) & 1;
        const bool act = (j <= qbw) && (MODE == 0 || j >= qbw - 8);
        u32x4 kreg, vreg;
        bf16x8 fa[4], fb[4];
        if (act) {
            f32x16 pa0, pa1, pb0, pb1;
#pragma unroll
            for (int r = 0; r < 16; ++r) { pa0[r] = 0.f; pa1[r] = 0.f; pb0[r] = 0.f; pb1[r] = 0.f; }
            const LAS unsigned char* kb = Kbuf + cur * TILE_LDS + L.c * PITCH + L.hi * 16;
#pragma unroll
            for (int d0 = 0; d0 < 4; ++d0) { const bf16x8 k0 = *(const LAS bf16x8*)(kb + d0 * 32); const bf16x8 k1 = *(const LAS bf16x8*)(kb + 32 * PITCH + d0 * 32);
                pa0 = __builtin_amdgcn_mfma_f32_32x32x16_bf16(k0, qa[d0], pa0, 0, 0, 0); pa1 = __builtin_amdgcn_mfma_f32_32x32x16_bf16(k1, qa[d0], pa1, 0, 0, 0);
                pb0 = __builtin_amdgcn_mfma_f32_32x32x16_bf16(k0, qbf[d0], pb0, 0, 0, 0); pb1 = __builtin_amdgcn_mfma_f32_32x32x16_bf16(k1, qbf[d0], pb1, 0, 0, 0); }
            if (j == qbw) { mask_range(pa0, pa1, -1, qrela, L.hi); mask_range(pb0, pb1, -1, qrela + 8, L.hi); }
            if (MODE == 1 && j == qbw - 8) { mask_range(pa0, pa1, qrela, 64, L.hi); mask_range(pb0, pb1, qrela + 8, 64, L.hi); }
            bool sela = true, selb = true;
            if (MODE == 0) { sela = (selp[0] >> j) & 1ull; selb = (selp[1] >> j) & 1ull; }
            softmax_step2(pa0, pa1, oa0, oa1, sa, sela, fa);
            __builtin_amdgcn_sched_barrier(0);
            softmax_step2(pb0, pb1, ob0, ob1, sb, selb, fb);
            __builtin_amdgcn_sched_barrier(0);
        }
        if (j < jhi) { kreg = *(const u32x4*)((const char*)Kt + (size_t)(j + 1) * 8192 + L.tid * 16); vreg = vload(Vt, j + 1, L); }
        if (act) {
            const LAS unsigned char* vb = Vbuf + cur * TILE_LDS + L.c * PITCH + L.hi * 16;
#pragma unroll
            for (int s = 0; s < 4; ++s) {
                const bf16x8 v0 = *(const LAS bf16x8*)(vb + s * 32); const bf16x8 v1 = *(const LAS bf16x8*)(vb + 32 * PITCH + s * 32);
                oa0 = __builtin_amdgcn_mfma_f32_32x32x16_bf16(v0, fa[s], oa0, 0, 0, 0); oa1 = __builtin_amdgcn_mfma_f32_32x32x16_bf16(v1, fa[s], oa1, 0, 0, 0);
                ob0 = __builtin_amdgcn_mfma_f32_32x32x16_bf16(v0, fb[s], ob0, 0, 0, 0); ob1 = __builtin_amdgcn_mfma_f32_32x32x16_bf16(v1, fb[s], ob1, 0, 0, 0); }
            renorm_step(oa0, oa1, sa); renorm_step(ob0, ob1, sb);
        }
        if (j < jhi) { *(LAS u32x4*)(Kbuf + (cur ^ 1) * TILE_LDS + so) = kreg; vstore(Vbuf + (cur ^ 1) * TILE_LDS, vreg, L); }
        __syncthreads();
    }
}
}
namespace nsa {
struct AttnPtrs {
    const bf16_t* q;
    const bf16_t* z;
    const bf16_t* kc;
    const bf16_t* vct;
    const bf16_t* ksel;
    const bf16_t* vselt;
    const bf16_t* kwin; const bf16_t* vwint;
    unsigned long long* selmask;
    bf16_t* mix;
};
template <bool ACCUM>
__device__ __forceinline__ void store_o(const f32x16& a0, const f32x16& a1, bf16_t* mix, long tok, int head, int hi) {
    bf16_t* op = mix + tok * 1024 + head * 64 + 4 * hi;
#pragma unroll
    for (int dd = 0; dd < 2; ++dd)
#pragma unroll
        for (int rq = 0; rq < 4; ++rq) {
            float v0, v1, v2, v3;
            if (dd == 0) { v0 = a0[4 * rq]; v1 = a0[4 * rq + 1]; v2 = a0[4 * rq + 2]; v3 = a0[4 * rq + 3]; }
            else         { v0 = a1[4 * rq]; v1 = a1[4 * rq + 1]; v2 = a1[4 * rq + 2]; v3 = a1[4 * rq + 3]; }
            u32x2* p = (u32x2*)(op + dd * 32 + rq * 8);
            if (ACCUM) { const u32x2 old = *p; v0 += bflo(old.x); v1 += bfhi(old.x); v2 += bflo(old.y); v3 += bfhi(old.y); }
            u32x2 w; w.x = cvt_pk_bf16(v0, v1); w.y = cvt_pk_bf16(v2, v3); *p = w;
        }
}
__device__ __forceinline__ float gate_of(const bf16_t* z, long tok, int head, int br) { return sigmoidf_(bf2f(z[tok * INP + ZG + head * 3 + br])); }

struct CmpPre { bf16x8 qr[4]; };
__device__ __forceinline__ void cmp_prefetch(CmpPre& R, int bh, int qb, const AttnPtrs& P, const Lane& L) {
    const int b = bh >> 1, h = bh & 1, tq = qb * 64 + 8 * L.wid + (L.c >> 2), head = 4 * h + (L.c & 3); const long tok = (long)b * SEQ + tq;
    load_q(R.qr, P.q, tok, head, L.hi);
}
__device__ __forceinline__ void cmp_stage(const CmpPre& R, LAS unsigned char* lds, const Lane& L, bf16x8 (&qr)[4], float& gt) {
    (void)lds; (void)L;
#pragma unroll
    for (int d0 = 0; d0 < 4; ++d0) qr[d0] = R.qr[d0];
    gt = 0.f;
}
template <bool STAGE>
__device__ __forceinline__ void cmp_unit(int bh, int qb, const AttnPtrs& P, LAS unsigned char* lds, const Lane& L) {
    const int b = bh >> 1, h = bh & 1, t0 = qb * 64;
    const int ql = 8 * L.wid + (L.c >> 2), g = L.c & 3, tq = t0 + ql, head = 4 * h + g;
    const long tok = (long)b * SEQ + tq;
    LAS unsigned char* Kb = lds; LAS unsigned char* Vb = lds + 4 * TILE_LDS;
    LAS float* G4 = (LAS float*)(lds + 8 * TILE_LDS); LAS float* E3 = G4 + 64 * 64;
    const float gate_raw = bf2f(P.z[tok * INP + ZG + head * 3 + 0]);
    bf16x8 qr[4]; load_q(qr, P.q, tok, head, L.hi);
    if (STAGE) { const char* ks = (const char*)(P.kc + (size_t)bh * 256 * 64); const char* vs = (const char*)(P.vct + (size_t)bh * 256 * 64); const int so = stage_off(L.tid); u32x4 kk[4], vv[4];
#pragma unroll
      for (int jn = 0; jn < 4; ++jn) kk[jn] = *(const u32x4*)(ks + jn * 8192 + L.tid * 16);
#pragma unroll
      for (int jn = 0; jn < 4; ++jn) vv[jn] = *(const u32x4*)(vs + jn * 8192 + L.tid * 16);
#pragma unroll
      for (int jn = 0; jn < 4; ++jn) *(LAS u32x4*)(Kb + jn * TILE_LDS + so) = kk[jn];
#pragma unroll
      for (int jn = 0; jn < 4; ++jn) *(LAS u32x4*)(Vb + jn * TILE_LDS + so) = vv[jn]; }
    __syncthreads();
    const int nmax = (tq >= 31) ? ((tq - 31) >> 4) : -1;
    const int tq_lo = t0 + 8 * L.wid, tq_hi = tq_lo + 7;
    const int nmax_lo = (tq_lo >= 31) ? ((tq_lo - 31) >> 4) : -1, nmax_hi = (tq_hi >= 31) ? ((tq_hi - 31) >> 4) : -1;
    const int ntile = (nmax_hi >= 0) ? (nmax_hi >> 6) + 1 : 0;
    const bool need_imp = qb >= 16;
    float l = 0.f;
    f32x16 o0, o1;
#pragma unroll
    for (int r = 0; r < 16; ++r) { o0[r] = 0.f; o1[r] = 0.f; }
    float gsr[4][8], e3r[4][8];
#pragma unroll
    for (int jn = 0; jn < 4; ++jn)
#pragma unroll
        for (int i = 0; i < 8; ++i) { gsr[jn][i] = 0.f; e3r[jn][i] = 0.f; }
#pragma unroll
    for (int jn = 0; jn < 4; ++jn) {
        if (jn < ntile) {
            f32x16 p0, p1; qk_tile(p0, p1, Kb + jn * TILE_LDS, qr, 0.f, L);
            if (64 * jn + 63 > nmax_lo) mask_range(p0, p1, -1, nmax - 64 * jn, L.hi);
            float ls = 0.f;
#pragma unroll
            for (int r = 0; r < 16; ++r) { p0[r] = fast_exp2(p0[r]); p1[r] = fast_exp2(p1[r]); ls += p0[r] + p1[r]; }
            l += ls;
            if (need_imp) {
#pragma unroll
                for (int rq = 0; rq < 4; ++rq) { gsr[jn][rq] = (p0[4 * rq] + p0[4 * rq + 1]) + (p0[4 * rq + 2] + p0[4 * rq + 3]); e3r[jn][rq] = p0[4 * rq + 3];
                                                 gsr[jn][4 + rq] = (p1[4 * rq] + p1[4 * rq + 1]) + (p1[4 * rq + 2] + p1[4 * rq + 3]); e3r[jn][4 + rq] = p1[4 * rq + 3]; } }
            pv_tile(o0, o1, Vb + jn * TILE_LDS, p0, p1, L);
        }
        __builtin_amdgcn_sched_barrier(0);
    }
    l = xsum32(l);
    const float inv = (nmax >= 0 && l > 0.f) ? fast_rcp(l) : 0.f;
    if (need_imp) {
        LAS float* gp = G4 + ql * 64 + L.hi; asm volatile("" : "+v"(gp));
#pragma unroll
        for (int jn = 0; jn < 4; ++jn) {
            if (jn < ntile) {
#pragma unroll
                for (int i = 0; i < 8; ++i) { float gs = gsr[jn][i] * inv, e3 = e3r[jn][i] * inv;
                    gs += xshfl<1>(gs); gs += xshfl<2>(gs); e3 += xshfl<1>(e3); e3 += xshfl<2>(e3);
                    if (g == 0) { gp[16 * jn + 2 * i] = gs; gp[64 * 64 + 16 * jn + 2 * i] = e3; } }
            }
        }
    }
    {
        const float gt = sigmoidf_(gate_raw) * inv;
#pragma unroll
        for (int r = 0; r < 16; ++r) { o0[r] *= gt; o1[r] *= gt; }
        store_o<false>(o0, o1, P.mix, tok, head, L.hi);
    }
    __syncthreads();
}
__device__ __forceinline__ void cmp_topk(int bh, int qb, const AttnPtrs& P, LAS unsigned char* lds, const Lane& L) {
    const int t0 = qb * 64; LAS float* G4 = (LAS float*)(lds + 8 * TILE_LDS); LAS float* E3 = G4 + 64 * 64;
    const int s = L.lane;
    if (qb < 16) { const unsigned long long mask = (1ull << (qb + 1)) - 1ull;
        if (L.lane < 8) P.selmask[(size_t)bh * SEQ + t0 + 8 * L.wid + L.lane] = mask; }
    else {
        const bool cand = (s >= 1) && (s <= qb - 2);
        unsigned bits[8], T[8];
#pragma unroll
        for (int i = 0; i < 8; ++i) { const int q = 8 * L.wid + i; const float imp = G4[q * 64 + s] + (s > 0 ? E3[q * 64 + s - 1] : 0.f); bits[i] = cand ? __float_as_uint(fmaxf(imp, 0.f)) : 0u; T[i] = 0u; }
        int cnt[8];
#pragma unroll
        for (int i = 0; i < 8; ++i) cnt[i] = qb - 2;
        for (int bit = 30; bit >= 0; --bit) { int open_ = 0;
#pragma unroll
            for (int i = 0; i < 8; ++i) { const unsigned c = T[i] | (1u << bit); const int n = __popcll(__ballot(cand && bits[i] >= c)); if (n >= 13) { T[i] = c; cnt[i] = n; } open_ |= (cnt[i] != 13); }
            if (!open_) break; }
#pragma unroll
        for (int i = 0; i < 8; ++i) {
            const unsigned long long gt = __ballot(cand && bits[i] > T[i]); unsigned long long eq = __ballot(cand && bits[i] == T[i]);
            int need = 13 - __popcll(gt); unsigned long long take = 0ull;
            while (need > 0 && eq) { const unsigned long long low = eq & (0ull - eq); take |= low; eq ^= low; --need; }
            const unsigned long long mask = gt | take | 1ull | (1ull << qb) | (1ull << (qb - 1));
            if (L.lane == 0) P.selmask[(size_t)bh * SEQ + t0 + 8 * L.wid + i] = mask; }
    }
    __syncthreads();
}

__device__ __forceinline__ void sw_unit(int bh, int qb, const AttnPtrs& P, LAS unsigned char* lds, const Lane& L) {
    const int b = bh >> 1, h = bh & 1, t0 = qb * 64;
    const int ql = 8 * L.wid + (L.c >> 2), g = L.c & 3, tq = t0 + ql, head = 4 * h + g;
    const long tok = (long)b * SEQ + tq;
    bf16x8 qr[4]; load_q(qr, P.q, tok, head, L.hi);
    const unsigned long long selw = P.selmask[(size_t)bh * SEQ + tq];
    const float g1raw = bf2f(P.z[tok * INP + ZG + head * 3 + 1]), g2raw = bf2f(P.z[tok * INP + ZG + head * 3 + 2]);
    f32x16 r0, r1;
    {
        f32x16 o0, o1; float m = 0.f, l = 0.f;
#pragma unroll
        for (int r = 0; r < 16; ++r) { o0[r] = 0.f; o1[r] = 0.f; }
        run_branch<0>(o0, o1, m, l, P.ksel + (size_t)bh * SEQ * 64, P.vselt + (size_t)bh * SEQ * 64, 0, qb, qb, ql, selw, qr, lds, L);
        l = xsum32(l);
        const float sc = sigmoidf_(g1raw) * fast_rcp(l);
#pragma unroll
        for (int r = 0; r < 16; ++r) { r0[r] = o0[r] * sc; r1[r] = o1[r] * sc; }
    }
    {
        f32x16 o0, o1; float m = 0.f, l = 0.f;
#pragma unroll
        for (int r = 0; r < 16; ++r) { o0[r] = 0.f; o1[r] = 0.f; }
        run_branch<1>(o0, o1, m, l, P.kwin + (size_t)bh * SEQ * 64, P.vwint + (size_t)bh * SEQ * 64, qb >= 8 ? qb - 8 : 0, qb, qb, ql, 0ull, qr, lds, L);
        l = xsum32(l);
        const float sc = sigmoidf_(g2raw) * fast_rcp(l);
#pragma unroll
        for (int r = 0; r < 16; ++r) { r0[r] += o0[r] * sc; r1[r] += o1[r] * sc; }
    }
    store_o<true>(r0, r1, P.mix, tok, head, L.hi);
}
__device__ __forceinline__ void sw_unit2(int bh, int qb2, const AttnPtrs& P, LAS unsigned char* lds, const Lane& L) {
    const int b = bh >> 1, h = bh & 1, qbw = 2 * qb2 + (L.wid >> 2);
    const int qrela = 16 * (L.wid & 3) + (L.c >> 2), qrelb = qrela + 8, g = L.c & 3, head = 4 * h + g;
    const long toka = (long)b * SEQ + 64 * qbw + qrela, tokb = toka + 8;
    bf16x8 qa[4], qbf[4]; load_q(qa, P.q, toka, head, L.hi); load_q(qbf, P.q, tokb, head, L.hi);
    LAS unsigned long long* selp = (LAS unsigned long long*)(lds + 4 * TILE_LDS + 8192) + L.tid * 2;
    selp[0] = P.selmask[(size_t)bh * SEQ + 64 * qbw + qrela]; selp[1] = P.selmask[(size_t)bh * SEQ + 64 * qbw + qrelb];
    LAS float* gpark = (LAS float*)(lds + 4 * TILE_LDS) + L.tid * 4;
    gpark[0] = bf2f(P.z[toka * INP + ZG + head * 3 + 1]); gpark[1] = bf2f(P.z[tokb * INP + ZG + head * 3 + 1]); gpark[2] = bf2f(P.z[toka * INP + ZG + head * 3 + 2]); gpark[3] = bf2f(P.z[tokb * INP + ZG + head * 3 + 2]);
    {
        f32x16 oa0, oa1, ob0, ob1; SoftState sa{0.f, 0.f}, sb{0.f, 0.f};
#pragma unroll
        for (int r = 0; r < 16; ++r) { oa0[r] = 0.f; oa1[r] = 0.f; ob0[r] = 0.f; ob1[r] = 0.f; }
        run_branch2<0>(oa0, oa1, sa, ob0, ob1, sb, P.ksel + (size_t)bh * SEQ * 64, P.vselt + (size_t)bh * SEQ * 64, 0, 2 * qb2 + 1, qbw, qrela, selp, qa, qbf, lds, L);
        sa.l = xsum32(sa.l); sb.l = xsum32(sb.l);
        const float sca = sigmoidf_(gpark[0]) * fast_rcp(sa.l), scb = sigmoidf_(gpark[1]) * fast_rcp(sb.l);
#pragma unroll
        for (int r = 0; r < 16; ++r) { oa0[r] *= sca; oa1[r] *= sca; ob0[r] *= scb; ob1[r] *= scb; }
        { int qe = qrela; asm volatile("" : "+v"(qe));
          store_o<true>(oa0, oa1, P.mix, (long)b * SEQ + 64 * qbw + qe, head, L.hi); store_o<true>(ob0, ob1, P.mix, (long)b * SEQ + 64 * qbw + qe + 8, head, L.hi); }
    }
    {
        f32x16 oa0, oa1, ob0, ob1; SoftState sa{0.f, 0.f}, sb{0.f, 0.f};
#pragma unroll
        for (int r = 0; r < 16; ++r) { oa0[r] = 0.f; oa1[r] = 0.f; ob0[r] = 0.f; ob1[r] = 0.f; }
        run_branch2<1>(oa0, oa1, sa, ob0, ob1, sb, P.kwin + (size_t)bh * SEQ * 64, P.vwint + (size_t)bh * SEQ * 64, 2 * qb2 >= 8 ? 2 * qb2 - 8 : 0, 2 * qb2 + 1, qbw, qrela, selp, qa, qbf, lds, L);
        sa.l = xsum32(sa.l); sb.l = xsum32(sb.l);
        const float sca = sigmoidf_(gpark[2]) * fast_rcp(sa.l), scb = sigmoidf_(gpark[3]) * fast_rcp(sb.l);
#pragma unroll
        for (int r = 0; r < 16; ++r) { oa0[r] *= sca; oa1[r] *= sca; ob0[r] *= scb; ob1[r] *= scb; }
        { int qe = qrela; asm volatile("" : "+v"(qe));
          store_o<true>(oa0, oa1, P.mix, (long)b * SEQ + 64 * qbw + qe, head, L.hi); store_o<true>(ob0, ob1, P.mix, (long)b * SEQ + 64 * qbw + qe + 8, head, L.hi); }
    }
}
}
namespace epi {
using pg8::Unit; using pg8::BM; using pg8::HALF;
struct Bf16Plain {
    static constexpr bool PERM = true;
    bf16_t* O; int ldc;
    __device__ __forceinline__ void operator()(const f32x4 (&acc)[2][2][4][2], const Unit& u, int wr, int wc, int fr, int fq) const {
        const int row0 = u.pm * BM + wr * 64 + fr, col0 = u.pn * BM + wc * 32 + 8 * fq;
#pragma unroll
        for (int ai = 0; ai < 2; ++ai)
#pragma unroll
            for (int m = 0; m < 4; ++m) { bf16_t* rowp = O + (size_t)(row0 + ai * HALF + m * 16) * ldc + col0;
#pragma unroll
                for (int bj = 0; bj < 2; ++bj) { const f32x4 v0 = acc[ai][bj][m][0], v1 = acc[ai][bj][m][1];
                    u32x4 w; w.x = cvt_pk_bf16(v0[0], v0[1]); w.y = cvt_pk_bf16(v0[2], v0[3]); w.z = cvt_pk_bf16(v1[0], v1[1]); w.w = cvt_pk_bf16(v1[2], v1[3]);
                    *(u32x4*)(rowp + bj * HALF) = w; } }
    }
};
struct Bf16Sc1 {
    static constexpr bool PERM = true;
    bf16_t* O; int ldc; unsigned nbytes;
    __device__ __forceinline__ void operator()(const f32x4 (&acc)[2][2][4][2], const Unit& u, int wr, int wc, int fr, int fq) const {
        const __amdgpu_buffer_rsrc_t rsrc = __builtin_amdgcn_make_buffer_rsrc(O, 0, nbytes, 0x00020000);
        const int row0 = u.pm * BM + wr * 64 + fr, col0 = u.pn * BM + wc * 32 + 8 * fq;
#pragma unroll
        for (int ai = 0; ai < 2; ++ai)
#pragma unroll
            for (int m = 0; m < 4; ++m) { const unsigned off = (unsigned)(((size_t)(row0 + ai * HALF + m * 16) * ldc + col0) * 2);
#pragma unroll
                for (int bj = 0; bj < 2; ++bj) { const f32x4 v0 = acc[ai][bj][m][0], v1 = acc[ai][bj][m][1];
                    u32x4 w; w.x = cvt_pk_bf16(v0[0], v0[1]); w.y = cvt_pk_bf16(v0[2], v0[3]); w.z = cvt_pk_bf16(v1[0], v1[1]); w.w = cvt_pk_bf16(v1[2], v1[3]);
                    __builtin_amdgcn_raw_buffer_store_b128(w, rsrc, off + bj * HALF * 2, 0,   16); } }
    }
};
struct F32Grouped {
    static constexpr bool PERM = false;
    float* C; int ldc; size_t gstride;
    __device__ __forceinline__ void operator()(const f32x4 (&acc)[2][2][4][2], const Unit& u, int wr, int wc, int fr, int fq) const {
        const int row0 = u.pm * BM + wr * 64 + fr, col0 = u.pn * BM + wc * 32 + 4 * fq; float* Cg = C + (size_t)u.aux * gstride;
#pragma unroll
        for (int ai = 0; ai < 2; ++ai)
#pragma unroll
            for (int m = 0; m < 4; ++m) { float* rowp = Cg + (size_t)(row0 + ai * HALF + m * 16) * ldc + col0;
#pragma unroll
                for (int bj = 0; bj < 2; ++bj)
#pragma unroll
                    for (int n = 0; n < 2; ++n) *(f32x4*)(rowp + bj * HALF + n * 16) = acc[ai][bj][m][n]; }
    }
};
struct SwiGlu {
    static constexpr bool PERM = true;
    bf16_t* H; int ldc;
    __device__ __forceinline__ void operator()(const f32x4 (&acc)[2][2][4][2], const Unit& u, int wr, int wc, int fr, int fq) const {
        const int row0 = u.pm * BM + wr * 64 + fr, col0 = u.pn * HALF + wc * 32 + 8 * fq;
#pragma unroll
        for (int ai = 0; ai < 2; ++ai)
#pragma unroll
            for (int m = 0; m < 4; ++m) { bf16_t* rowp = H + (size_t)(row0 + ai * HALF + m * 16) * ldc + col0;
                float o[8];
#pragma unroll
                for (int n = 0; n < 2; ++n)
#pragma unroll
                    for (int e = 0; e < 4; ++e) o[4 * n + e] = siluf_(acc[ai][0][m][n][e]) * acc[ai][1][m][n][e];
                u32x4 w; w.x = cvt_pk_bf16(o[0], o[1]); w.y = cvt_pk_bf16(o[2], o[3]); w.z = cvt_pk_bf16(o[4], o[5]); w.w = cvt_pk_bf16(o[6], o[7]);
                *(u32x4*)rowp = w; }
    }
};
struct MoeDown {
    static constexpr bool PERM = true;
    bf16_t* Y; const int* row_tok;
    __device__ __forceinline__ void operator()(const f32x4 (&acc)[2][2][4][2], const Unit& u, int wr, int wc, int fr, int fq) const {
        const int srow0 = u.aux * BM + wr * 64 + fr, col0 = u.pn * BM + wc * 32 + 8 * fq;
        int dsts[8];
#pragma unroll
        for (int it = 0; it < 8; ++it) dsts[it] = row_tok[srow0 + (it >> 2) * HALF + (it & 3) * 16];
#pragma unroll
        for (int ai = 0; ai < 2; ++ai)
#pragma unroll
            for (int m = 0; m < 4; ++m) { const int dst = dsts[ai * 4 + m];
                if (dst >= 0) { bf16_t* rowp = Y + (size_t)dst * D + col0;
#pragma unroll
                    for (int bj = 0; bj < 2; ++bj) { const f32x4 v0 = acc[ai][bj][m][0], v1 = acc[ai][bj][m][1];
                        u32x4 w; w.x = cvt_pk_bf16(v0[0], v0[1]); w.y = cvt_pk_bf16(v0[2], v0[3]); w.z = cvt_pk_bf16(v1[0], v1[1]); w.w = cvt_pk_bf16(v1[2], v1[3]);
                        *(u32x4*)(rowp + bj * HALF) = w; } } }
    }
};
struct SigmoidBias {
    static constexpr bool PERM = true;
    bf16_t* O; int ldc; const float* bias;
    __device__ __forceinline__ void operator()(const f32x4 (&acc)[2][2][4][2], const Unit& u, int wr, int wc, int fr, int fq) const {
        const int row0 = u.pm * BM + wr * 64 + fr, col0 = u.pn * BM + wc * 32 + 8 * fq;
        f32x4 bv[2][2];
#pragma unroll
        for (int bj = 0; bj < 2; ++bj)
#pragma unroll
            for (int n = 0; n < 2; ++n) bv[bj][n] = *(const f32x4*)(bias + col0 + bj * HALF + 4 * n);
#pragma unroll
        for (int ai = 0; ai < 2; ++ai)
#pragma unroll
            for (int m = 0; m < 4; ++m) { bf16_t* rowp = O + (size_t)(row0 + ai * HALF + m * 16) * ldc + col0;
#pragma unroll
                for (int bj = 0; bj < 2; ++bj) { f32x4 v0 = acc[ai][bj][m][0] + bv[bj][0], v1 = acc[ai][bj][m][1] + bv[bj][1];
#pragma unroll
                    for (int e = 0; e < 4; ++e) { v0[e] = sigmoidf_(v0[e]); v1[e] = sigmoidf_(v1[e]); }
                    u32x4 w; w.x = cvt_pk_bf16(v0[0], v0[1]); w.y = cvt_pk_bf16(v0[2], v0[3]); w.z = cvt_pk_bf16(v1[0], v1[1]); w.w = cvt_pk_bf16(v1[2], v1[3]);
                    *(u32x4*)(rowp + bj * HALF) = w; } }
    }
};
struct MulBf16 {
    static constexpr bool PERM = true;
    bf16_t* O; const bf16_t* G; int ldc;
    __device__ __forceinline__ void operator()(const f32x4 (&acc)[2][2][4][2], const Unit& u, int wr, int wc, int fr, int fq) const {
        const int row0 = u.pm * BM + wr * 64 + fr, col0 = u.pn * BM + wc * 32 + 8 * fq;
        u32x4 gq[2], gn[2];
        { const size_t off = (size_t)row0 * ldc + col0; gn[0] = *(const u32x4*)(G + off); gn[1] = *(const u32x4*)(G + off + HALF); }
#pragma unroll
        for (int it = 0; it < 8; ++it) { const int ai = it >> 2, m = it & 3; const size_t off = (size_t)(row0 + ai * HALF + m * 16) * ldc + col0;
            gq[0] = gn[0]; gq[1] = gn[1];
            if (it < 7) { const int ai2 = (it + 1) >> 2, m2 = (it + 1) & 3; const size_t off2 = (size_t)(row0 + ai2 * HALF + m2 * 16) * ldc + col0; gn[0] = *(const u32x4*)(G + off2); gn[1] = *(const u32x4*)(G + off2 + HALF); }
#pragma unroll
            for (int bj = 0; bj < 2; ++bj) { const f32x4 v0 = acc[ai][bj][m][0], v1 = acc[ai][bj][m][1]; const u32x4 g4 = gq[bj];
                u32x4 w; w.x = cvt_pk_bf16(v0[0] * bflo(g4.x), v0[1] * bfhi(g4.x)); w.y = cvt_pk_bf16(v0[2] * bflo(g4.y), v0[3] * bfhi(g4.y));
                w.z = cvt_pk_bf16(v1[0] * bflo(g4.z), v1[1] * bfhi(g4.z)); w.w = cvt_pk_bf16(v1[2] * bflo(g4.w), v1[3] * bfhi(g4.w));
                *(u32x4*)(O + off + bj * HALF) = w; }
            asm volatile("" ::: "memory"); }
    }
};
struct S5Out {
    static constexpr bool PERM = true;
    bf16_t* ZS5; const bf16_t* Z; const float* dskip;
    __device__ __forceinline__ void operator()(const f32x4 (&acc)[2][2][4][2], const Unit& u, int wr, int wc, int fr, int fq) const {
        const int g = u.aux, row0 = u.pm * BM + wr * 64 + fr;
#pragma unroll
        for (int bj = 0; bj < 2; ++bj) { const int col = u.pn * BM + bj * HALF + wc * 32 + 8 * fq, jo = col >> 4, co0 = col & 15, ch0 = g * 16 + co0;
            const f32x4 d0 = *(const f32x4*)(dskip + ch0), d1 = *(const f32x4*)(dskip + ch0 + 4);
#pragma unroll
            for (int ai = 0; ai < 2; ++ai)
#pragma unroll
                for (int m = 0; m < 4; ++m) { const int mr = row0 + ai * HALF + m * 16; const long tok = (long)(mr >> 7) * SEQ + (mr & 127) * S5LC + jo;
                    const u32x4 uq = *(const u32x4*)(Z + tok * INP + ZS + ch0); const f32x4 v0 = acc[ai][bj][m][0], v1 = acc[ai][bj][m][1];
                    u32x4 w; w.x = cvt_pk_bf16(gelu_tanh(v0[0] + d0[0] * bflo(uq.x)), gelu_tanh(v0[1] + d0[1] * bfhi(uq.x)));
                    w.y = cvt_pk_bf16(gelu_tanh(v0[2] + d0[2] * bflo(uq.y)), gelu_tanh(v0[3] + d0[3] * bfhi(uq.y)));
                    w.z = cvt_pk_bf16(gelu_tanh(v1[0] + d1[0] * bflo(uq.z)), gelu_tanh(v1[1] + d1[1] * bfhi(uq.z)));
                    w.w = cvt_pk_bf16(gelu_tanh(v1[2] + d1[2] * bflo(uq.w)), gelu_tanh(v1[3] + d1[3] * bfhi(uq.w)));
                    *(u32x4*)(ZS5 + tok * 256 + ch0) = w; asm volatile("" ::: "memory"); } }
    }
};
struct S5Glu {
    static constexpr bool PERM = true;
    bf16_t* MIX; const bf16_t* ZS5; const float* bias;
    __device__ __forceinline__ void operator()(const f32x4 (&acc)[2][2][4][2], const Unit& u, int wr, int wc, int fr, int fq) const {
        const int row0 = u.pm * BM + wr * 64 + fr, col0 = wc * 32 + 8 * fq;
#pragma unroll
        for (int bj = 0; bj < 2; ++bj) { const int col = col0 + bj * HALF; const f32x4 b0 = *(const f32x4*)(bias + col), b1 = *(const f32x4*)(bias + col + 4);
#pragma unroll
            for (int ai = 0; ai < 2; ++ai)
#pragma unroll
                for (int m = 0; m < 4; ++m) { const size_t row = (size_t)(row0 + ai * HALF + m * 16); const u32x4 zq = *(const u32x4*)(ZS5 + row * 256 + col);
                    const f32x4 v0 = acc[ai][bj][m][0] + b0, v1 = acc[ai][bj][m][1] + b1;
                    u32x4 w; w.x = cvt_pk_bf16(bflo(zq.x) * sigmoidf_(v0[0]), bfhi(zq.x) * sigmoidf_(v0[1])); w.y = cvt_pk_bf16(bflo(zq.y) * sigmoidf_(v0[2]), bfhi(zq.y) * sigmoidf_(v0[3]));
                    w.z = cvt_pk_bf16(bflo(zq.z) * sigmoidf_(v1[0]), bfhi(zq.z) * sigmoidf_(v1[1])); w.w = cvt_pk_bf16(bflo(zq.w) * sigmoidf_(v1[2]), bfhi(zq.w) * sigmoidf_(v1[3]));
                    *(u32x4*)(MIX + row * 1024 + 768 + col) = w; asm volatile("" ::: "memory"); } }
    }
};
struct EpiWin {
    static constexpr bool PERM = true;
    bf16_t* Z; bf16_t* Q; bf16_t* KV; bf16_t* AP; const f32x2* rope;
    __device__ __forceinline__ void operator()(const f32x4 (&acc)[2][2][4][2], const Unit& u, int wr, int wc, int fr, int fq) const {
        const int row0 = u.pm * BM + wr * 64 + fr;
        if (u.pn >= 5) {
#pragma unroll
            for (int bj = 0; bj < 2; ++bj) { const int col0 = u.pn * BM + bj * HALF + wc * 32 + 8 * fq; const int sc0 = col0 - ZS; const bool s5 = (sc0 >= 0) && (sc0 < 256);
#pragma unroll
                for (int ai = 0; ai < 2; ++ai)
#pragma unroll
                    for (int m = 0; m < 4; ++m) { const int tok = row0 + ai * HALF + m * 16; const f32x4 v0 = acc[ai][bj][m][0], v1 = acc[ai][bj][m][1];
                        u32x4 w; w.x = cvt_pk_bf16(v0[0], v0[1]); w.y = cvt_pk_bf16(v0[2], v0[3]); w.z = cvt_pk_bf16(v1[0], v1[1]); w.w = cvt_pk_bf16(v1[2], v1[3]);
                        *(u32x4*)(Z + (size_t)tok * INP + col0) = w;
                        if (s5) { const int b = tok >> 12, t = tok & 4095; *(u32x4*)(AP + ((size_t)(sc0 >> 4) * 2048 + b * 128 + (t >> 5)) * S5K + (t & 31) * 16 + (sc0 & 15)) = w; } } }
            return;
        }
#pragma unroll
        for (int bj = 0; bj < 2; ++bj) {
            const int colh = bj * HALF + wc * 32 + 8 * fq;
            const int qi = 4 * (wc & 1) + fq, d1 = 4 * qi;
            const bool isv = (u.pn >= 2) && (bj == 1);
            f32x4 cn0 = (f32x4){0.f, 0.f, 0.f, 0.f}, cn1 = cn0;
            if (!isv) { cn0 = *(const f32x4*)(rope + (size_t)row0 * 32 + d1); cn1 = *(const f32x4*)(rope + (size_t)row0 * 32 + d1 + 2); }
#pragma unroll
            for (int it = 0; it < 8; ++it) { const int ai = it >> 2, m = it & 3; const int tok = row0 + ai * HALF + m * 16; const int b = tok >> 12, t = tok & 4095; const f32x4 x1 = acc[ai][bj][m][0], x2 = acc[ai][bj][m][1];
                    if (isv) { bf16_t* dst = KV + (size_t)((u.pn - 2) * 2 + 1) * (8u << 20) + ((size_t)(b * 2 + (wc >> 1)) * SEQ + t) * 64 + 32 * (wc & 1) + 8 * fq;
                        u32x4 w; w.x = cvt_pk_bf16(x1[0], x1[1]); w.y = cvt_pk_bf16(x1[2], x1[3]); w.z = cvt_pk_bf16(x2[0], x2[1]); w.w = cvt_pk_bf16(x2[2], x2[3]); *(u32x4*)dst = w; }
                    else { const f32x4 cs0 = cn0, cs1 = cn1;
                        if (it < 7) { const int tok2 = row0 + ((it + 1) >> 2) * HALF + ((it + 1) & 3) * 16; cn0 = *(const f32x4*)(rope + (size_t)tok2 * 32 + d1); cn1 = *(const f32x4*)(rope + (size_t)tok2 * 32 + d1 + 2); }
                        const float sc = (u.pn < 2) ? QSCALE : 1.0f;
                        const float o10 = (x1[0] * cs0[0] - x2[0] * cs0[1]) * sc, o11 = (x1[1] * cs0[2] - x2[1] * cs0[3]) * sc, o12 = (x1[2] * cs1[0] - x2[2] * cs1[1]) * sc, o13 = (x1[3] * cs1[2] - x2[3] * cs1[3]) * sc;
                        const float o20 = (x2[0] * cs0[0] + x1[0] * cs0[1]) * sc, o21 = (x2[1] * cs0[2] + x1[1] * cs0[3]) * sc, o22 = (x2[2] * cs1[0] + x1[2] * cs1[1]) * sc, o23 = (x2[3] * cs1[2] + x1[3] * cs1[3]) * sc;
                        bf16_t* dst = (u.pn < 2) ? Q + (size_t)tok * 512 + (u.pn * 4 + (colh >> 6)) * 64 + d1
                                                 : KV + (size_t)((u.pn - 2) * 2) * (8u << 20) + ((size_t)(b * 2 + (wc >> 1)) * SEQ + t) * 64 + d1;
                        u32x2 w1, w2; w1.x = cvt_pk_bf16(o10, o11); w1.y = cvt_pk_bf16(o12, o13); w2.x = cvt_pk_bf16(o20, o21); w2.y = cvt_pk_bf16(o22, o23);
                        *(u32x2*)dst = w1; *(u32x2*)(dst + 32) = w2; }
                    asm volatile("" ::: "memory"); }
        }
    }
};
}
constexpr size_t MiB = 1u << 20;
constexpr size_t WS_CTL = 0, CTL_ZERO_BYTES = 1 * MiB;
constexpr size_t WS_SMALL = 1 * MiB;
constexpr size_t SM_APOW = WS_SMALL;
constexpr size_t SM_BBAR = WS_SMALL + 5 * MiB / 4;
constexpr size_t SM_KTAB = WS_SMALL + 2 * MiB;
constexpr size_t SM_CMPB = WS_SMALL + 4 * MiB;
constexpr size_t SM_TOKE = WS_SMALL + 4 * MiB + 256 * 1024;
constexpr size_t SM_TOKW = WS_SMALL + 4 * MiB + 512 * 1024;
constexpr size_t SM_ROWTOK = WS_SMALL + 5 * MiB + 256 * 1024;
constexpr size_t SM_PCNT = WS_SMALL + 6 * MiB;
constexpr size_t SM_TILEEXP = WS_SMALL + 6 * MiB + 16384;
constexpr size_t WS_ROPE = 8 * MiB;
constexpr size_t WS_W = 24 * MiB;
constexpr size_t W_IN = WS_W;
constexpr size_t W_OUT = W_IN + (size_t)INP * D * 2;
constexpr size_t W_GATE = W_OUT + (size_t)D * D * 2;
constexpr size_t W_PROJ = W_GATE + (size_t)D * D * 2;
constexpr size_t W_CMP = W_PROJ + (size_t)D * PLE * 2;
constexpr size_t W_GLU = W_CMP + (size_t)2 * 512 * 1024 * 2;
constexpr size_t W_S5B = W_GLU + (size_t)256 * 256 * 2;
constexpr size_t W_S5S = W_S5B + (size_t)16 * 512 * S5K * 2;
constexpr size_t W_UP = W_S5S + (size_t)16 * 256 * 512 * 2;
constexpr size_t W_DN = W_UP + (size_t)NEXP * 2 * DFE * D * 2;
constexpr size_t W_END_ = W_DN + (size_t)NEXP * D * DFE * 2;
static_assert(W_END_ <= WS_W + 240 * MiB, "weight region");
constexpr size_t WS_XB = 264 * MiB;
constexpr size_t WS_PB = 392 * MiB;
constexpr size_t WS_Z = 424 * MiB;
constexpr size_t WS_QKV = 712 * MiB;
constexpr size_t WS_Q = WS_QKV, WS_KCMP = WS_QKV + 64 * MiB, WS_VCMP = WS_KCMP + 16 * MiB, WS_KSEL = WS_VCMP + 16 * MiB, WS_VSEL = WS_KSEL + 16 * MiB, WS_KWIN = WS_VSEL + 16 * MiB, WS_VWIN = WS_KWIN + 16 * MiB;
constexpr size_t WS_MIX = 872 * MiB;
constexpr size_t WS_CMP = 1000 * MiB;
constexpr size_t WS_CMPP = WS_CMP, WS_KC = WS_CMP + 32 * MiB, WS_VCT = WS_KC + 1 * MiB, WS_SELM = WS_VCT + 1 * MiB;
constexpr size_t WS_S5 = 1036 * MiB;
constexpr size_t WS_S5A = WS_S5, WS_S5S = WS_S5 + 40 * MiB, WS_ZS5 = WS_S5S + 32 * MiB;
constexpr size_t WS_HBUF = 1140 * MiB;
constexpr size_t WS_END = 1268 * MiB;
constexpr size_t WS_FFH = WS_Z, WS_XS = WS_Z, WS_MH = WS_Z + 260 * MiB, WS_YB = WS_MH + 224 * MiB;
static_assert(WS_YB + 256 * MiB <= WS_END && WS_FFH + (size_t)T * DFF * 2 <= WS_MIX, "overlays");
constexpr size_t WS_PLEG = WS_Z, WS_PLEH = WS_Z + 128 * MiB;
static_assert(WS_PLEH + 128 * MiB <= WS_MH, "per-layer-embedding buffers of the MoE layers");
constexpr int CW_BAR = 4096;
constexpr int CW_TMO = 64;
constexpr int CW_CNT = 16384, CNT_BANK = 256 * 64;
static_assert((CW_CNT + 8 * CNT_BANK) * 4 <= (int)CTL_ZERO_BYTES, "panel counters inside the per-call memset");

struct Args { const void* in[36]; float* out; unsigned char* ws; int gp_lo, gp_hi, use_bar, pad; };
struct Frame { LAS unsigned char* lds; int tid, lane, wave, G, bid; };
constexpr int RING_BYTES = 131072, LDSCTL_OFF = RING_BYTES, LDS_BYTES = 147456;
typedef __attribute__((address_space(4))) const Args CArgs;
__device__ __forceinline__ void load_args(Args& a) { CArgs* p = (CArgs*)__builtin_amdgcn_kernarg_segment_ptr(); asm volatile("" : "+s"(p)); __builtin_memcpy(&a, p, sizeof(Args)); }
__device__ __forceinline__ Frame make_frame(LAS unsigned char* lds, int wave0) { Frame F; F.lds = lds;
    int w = wave0; asm volatile("" : "+s"(w)); int ln = lane_id_fresh(); F.lane = ln; F.wave = w; F.tid = w * 64 + ln;
    int b = blockIdx.x, g = gridDim.x; asm volatile("" : "+s"(b), "+s"(g)); F.bid = b; F.G = g; return F; }

__constant__ double c_invfreq_rev[32] = {0.15915494309189535, 0.11934937021124886, 0.08949940160889101, 0.06711508300522726, 0.050329212104487035, 0.03774158471741977, 0.0283021958306234, 0.02122365276477766, 0.015915494309189534, 0.011934937021124886, 0.008949940160889102, 0.006711508300522725, 0.005032921210448704, 0.003774158471741977, 0.00283021958306234, 0.0021223652764777662, 0.0015915494309189536, 0.0011934937021124885, 0.0008949940160889102, 0.0006711508300522726, 0.0005032921210448703, 0.00037741584717419774, 0.00028302195830623395, 0.0002122365276477766, 0.00015915494309189535, 0.00011934937021124886, 8.949940160889102e-05, 6.711508300522725e-05, 5.0329212104487035e-05, 3.774158471741978e-05, 2.8302195830623396e-05, 2.122365276477766e-05};

__device__ __forceinline__ void sincos_rev(double rev, float& c, float& s) { const double fr = rev - __builtin_floor(rev); const float f = (float)fr; s = __builtin_amdgcn_sinf(f); c = __builtin_amdgcn_cosf(f); }

template <class Sched>
__device__ __forceinline__ void panels_publish_wait(const Frame& F, unsigned* ctl, int bank, const Sched& S, unsigned need) {
    unsigned* cnt = ctl + CW_CNT + bank * CNT_BANK;
    if (F.tid == 0) { pg8::Unit u; for (int i = 0; S.next(i, u); ++i) __hip_atomic_fetch_add(cnt + 64 * u.pm, 1u, __ATOMIC_RELAXED, __HIP_MEMORY_SCOPE_AGENT); }
    if (F.wave == 0) {
        for (int pm = F.bid; pm < T / 256; pm += F.G) { unsigned spins = 0;
            while ((unsigned)__builtin_amdgcn_readfirstlane(__hip_atomic_load(cnt + 64 * pm, __ATOMIC_RELAXED, __HIP_MEMORY_SCOPE_AGENT)) < need) {
                __builtin_amdgcn_s_sleep(1);
                if (++spins > (1u << 22)) { if (F.lane == 0) __hip_atomic_store(ctl + CW_TMO, 1u, __ATOMIC_RELAXED, __HIP_MEMORY_SCOPE_AGENT); break; }
                if ((spins & 1023u) == 0u && __builtin_amdgcn_readfirstlane(__hip_atomic_load(ctl + CW_TMO, __ATOMIC_RELAXED, __HIP_MEMORY_SCOPE_AGENT))) break; } }
        __builtin_amdgcn_fence(__ATOMIC_ACQUIRE, "agent");
        asm volatile("s_waitcnt vmcnt(0)" ::: "memory");
    }
    __syncthreads();
}
__device__ __forceinline__ void phase_init0(const Frame& F, const Args& a) {
    const size_t gt = (size_t)F.bid * 512 + F.tid, NT = (size_t)F.G * 512;
    const int* pos = (const int*)a.in[2]; f32x2* rope = (f32x2*)(a.ws + WS_ROPE);
    for (size_t i = gt; i < (size_t)T * 32; i += NT) { const int tok = (int)(i >> 5), k = (int)(i & 31); float c, s; sincos_rev((double)pos[tok] * c_invfreq_rev[k], c, s); rope[i] = (f32x2){c, s}; }
    const float* are = (const float*)a.in[14]; const float* aim = (const float*)a.in[15]; const float* ldt = (const float*)a.in[16];
    const float* bre = (const float*)a.in[17]; const float* bim = (const float*)a.in[18];
    f32x2* apow = (f32x2*)(a.ws + SM_APOW); f32x2* bbar = (f32x2*)(a.ws + SM_BBAR);
    for (size_t i = gt; i < (size_t)DEPTH * 16 * 64 * 34; i += NT) { const int k = (int)(i % 34), lgn = (int)(i / 34), lg = lgn >> 6;
        const float dt = __expf(ldt[lg]); const float ar = are[lgn] * dt; const double rev = (double)k * ((double)aim[lgn] * (double)dt) * 0.15915494309189535;
        float c, s; sincos_rev(rev, c, s); const float mg = __expf((float)k * ar); apow[i] = (f32x2){mg * c, mg * s}; }
    for (size_t i = gt; i < (size_t)DEPTH * 16 * 64 * 16; i += NT) { const int lgn = (int)(i >> 4), lg = lgn >> 6;
        const float dt = __expf(ldt[lg]); const float lr = are[lgn], li = aim[lgn]; const double rev = ((double)li * (double)dt) * 0.15915494309189535;
        float c, s; sincos_rev(rev, c, s); const float mg = __expf(lr * dt); const float abr = mg * c, abi = mg * s, den = lr * lr + li * li;
        const float cr = ((abr - 1.0f) * lr + abi * li) / den, ci = (abi * lr - (abr - 1.0f) * li) / den;
        const float br = bre[i], bi = bim[i]; bbar[i] = (f32x2){cr * br - ci * bi, cr * bi + ci * br}; }
    const f32x4* x4 = (const f32x4*)a.in[0]; u32x2* xb = (u32x2*)(a.ws + WS_XB);
    for (size_t i = gt; i < (size_t)T * D / 4; i += 4 * NT) { f32x4 v[4];
#pragma unroll
        for (int q = 0; q < 4; ++q) { const size_t ii = i + q * NT; v[q] = (ii < (size_t)T * D / 4) ? x4[ii] : (f32x4){0.f, 0.f, 0.f, 0.f}; }
#pragma unroll
        for (int q = 0; q < 4; ++q) { const size_t ii = i + q * NT; if (ii < (size_t)T * D / 4) { u32x2 w; w.x = cvt_pk_bf16(v[q][0], v[q][1]); w.y = cvt_pk_bf16(v[q][2], v[q][3]); xb[ii] = w; } } }
}
__device__ __forceinline__ void phase_init1(const Frame& F, const Args& a) {
    const size_t gt = (size_t)F.bid * 512 + F.tid, NT = (size_t)F.G * 512;
    const float* cre = (const float*)a.in[19]; const float* cim = (const float*)a.in[20];
    const f32x2* apow = (const f32x2*)(a.ws + SM_APOW); const f32x2* bbar = (const f32x2*)(a.ws + SM_BBAR); float* ktab = (float*)(a.ws + SM_KTAB);
    for (size_t i = gt; i < (size_t)DEPTH * 16 * 32 * 256; i += NT) { const int ci = (int)(i & 15), co = (int)((i >> 4) & 15), tau = (int)((i >> 8) & 31), lg = (int)(i >> 13);
        float acc = 0.f;
        for (int n = 0; n < 64; ++n) { const f32x2 P = apow[((size_t)lg * 64 + n) * 34 + tau], Bb = bbar[((size_t)lg * 64 + n) * 16 + ci]; const float cr = cre[((size_t)lg * 16 + co) * 64 + n], cm = cim[((size_t)lg * 16 + co) * 64 + n];
            const float hr = P.x * Bb.x - P.y * Bb.y, hi = P.x * Bb.y + P.y * Bb.x; acc += cr * hr - cm * hi; }
        ktab[i] = acc; }
}

__device__ __forceinline__ void transpose_item(const float* W, int ldw, int k0, int n0, int nvalid, bf16_t* dstrow, int dst_ld, LAS float* scr, int lane, int permhi) {
    float tv[32];
#pragma unroll
    for (int i = 0; i < 32; ++i) { const int kk = 2 * i + (lane >> 5), nn = lane & 31; tv[i] = (nn < nvalid) ? W[(size_t)(k0 + kk) * ldw + n0 + nn] : 0.f; }
#pragma unroll
    for (int i = 0; i < 32; ++i) { const int kk = 2 * i + (lane >> 5), nn = lane & 31; scr[kk * 33 + nn] = tv[i]; }
    LDS_WAIT(); asm volatile("" ::: "memory");
    const int c = lane & 7;
#pragma unroll
    for (int j = 0; j < 4; ++j) { const int n = (lane >> 3) + 8 * j; const LAS float* s = scr + (8 * c) * 33 + n;
        u32x4 o; o.x = cvt_pk_bf16(s[0 * 33], s[1 * 33]); o.y = cvt_pk_bf16(s[2 * 33], s[3 * 33]); o.z = cvt_pk_bf16(s[4 * 33], s[5 * 33]); o.w = cvt_pk_bf16(s[6 * 33], s[7 * 33]);
        const int drow = permhi < 0 ? n : (8 * (n >> 2) + 4 * permhi + (n & 3));
        if (n < nvalid) *(u32x4*)(dstrow + (size_t)drow * dst_ld + 8 * c) = o; }
    LDS_WAIT(); asm volatile("" ::: "memory");
}
__device__ __forceinline__ void transpose_mat(const float* W, int K, int N, bf16_t* dst, int dst_ld, int mode, LAS float* scr, int lane, int& cursor, int gw, int NGW) {
    const int nblk = (N + 31) / 32, items = (K / 64) * nblk;
    int it = ((gw - cursor) % NGW + NGW) % NGW;
    for (; it < items; it += NGW) { const int kb = it / nblk, nb = it % nblk, k0 = 64 * kb, n0 = 32 * nb; const int nv = (N - n0) < 32 ? (N - n0) : 32;
        int drow = n0, permhi = -1;
        if (mode == 1 || mode == 2) drow = (n0 >> 7) * 256 + (n0 & 127) + (mode == 2 ? 128 : 0);
        if (mode == 3 && (n0 < 512 || (n0 < 1280 && (((n0 - 512) >> 7) & 1) == 0))) { drow = n0 & ~63; permhi = (n0 >> 5) & 1; }
        transpose_item(W, N, k0, n0, nv, dst + (size_t)drow * dst_ld + k0, dst_ld, scr, lane, permhi); }
    cursor = (cursor + items) % NGW;
}

__device__ __forceinline__ void phase_prep(const Frame& F, const Args& a, int l) {
    LAS float* scr = (LAS float*)(F.lds + F.wave * 16384);
    const int gw = F.bid * 8 + F.wave, NGW = F.G * 8; int cursor = 0;
    unsigned char* ws = a.ws;
    transpose_mat((const float*)a.in[3] + (size_t)l * D * INW, D, INW, (bf16_t*)(ws + W_IN), D, 3, scr, F.lane, cursor, gw, NGW);
    transpose_mat((const float*)a.in[4] + (size_t)l * D * D, D, D, (bf16_t*)(ws + W_OUT), D, 0, scr, F.lane, cursor, gw, NGW);
    transpose_mat((const float*)a.in[31] + (size_t)l * D * D, D, D, (bf16_t*)(ws + W_GATE), D, 0, scr, F.lane, cursor, gw, NGW);
    transpose_mat((const float*)a.in[33] + (size_t)l * PLE * D, PLE, D, (bf16_t*)(ws + W_PROJ), PLE, 0, scr, F.lane, cursor, gw, NGW);
    for (int j = 0; j < 2; ++j) { const float* w1 = (const float*)a.in[6] + ((size_t)l * 2 + j) * 2048 * 256; bf16_t* dst = (bf16_t*)(ws + W_CMP) + (size_t)j * 512 * 1024;
        transpose_mat(w1, 1024, 256, dst, 1024, 0, scr, F.lane, cursor, gw, NGW);
        transpose_mat(w1 + (size_t)1024 * 256, 1024, 256, dst + (size_t)256 * 1024, 1024, 0, scr, F.lane, cursor, gw, NGW); }
    transpose_mat((const float*)a.in[22] + (size_t)l * 256 * 256, 256, 256, (bf16_t*)(ws + W_GLU), 256, 0, scr, F.lane, cursor, gw, NGW);
    const int j2 = l >> 1;
    if ((l & 1) == 0) {
        transpose_mat((const float*)a.in[24] + (size_t)j2 * D * DFF, D, DFF, (bf16_t*)(ws + W_UP), D, 1, scr, F.lane, cursor, gw, NGW);
        transpose_mat((const float*)a.in[25] + (size_t)j2 * D * DFF, D, DFF, (bf16_t*)(ws + W_UP), D, 2, scr, F.lane, cursor, gw, NGW);
        transpose_mat((const float*)a.in[26] + (size_t)j2 * DFF * D, DFF, D, (bf16_t*)(ws + W_DN), DFF, 0, scr, F.lane, cursor, gw, NGW);
    } else {
        for (int e = 0; e < NEXP; ++e) { const size_t eo = (size_t)j2 * NEXP + e;
            transpose_mat((const float*)a.in[28] + eo * D * DFE, D, DFE, (bf16_t*)(ws + W_UP) + (size_t)e * 2 * DFE * D, D, 1, scr, F.lane, cursor, gw, NGW);
            transpose_mat((const float*)a.in[29] + eo * D * DFE, D, DFE, (bf16_t*)(ws + W_UP) + (size_t)e * 2 * DFE * D, D, 2, scr, F.lane, cursor, gw, NGW);
            transpose_mat((const float*)a.in[30] + eo * DFE * D, DFE, D, (bf16_t*)(ws + W_DN) + (size_t)e * D * DFE, DFE, 0, scr, F.lane, cursor, gw, NGW); }
    }
    const size_t gt = (size_t)F.bid * 512 + F.tid, NT = (size_t)F.G * 512;
    {
        u32x4* zp = (u32x4*)((bf16_t*)(ws + W_IN) + (size_t)INW * D); const size_t n16 = (size_t)(INP - INW) * D * 2 / 16;
        unsigned zz = 0u; asm volatile("" : "+v"(zz));
        for (size_t i = gt; i < n16; i += NT) zp[i] = (u32x4){zz, zz, zz, zz};
    }
    {
        const f32x4* p4 = (const f32x4*)((const float*)a.in[1] + (size_t)l * T * PLE); u32x2* pb = (u32x2*)(ws + WS_PB);
        for (size_t i = gt; i < (size_t)T * PLE / 4; i += 4 * NT) { f32x4 v[4];
#pragma unroll
            for (int q = 0; q < 4; ++q) { const size_t ii = i + q * NT; v[q] = (ii < (size_t)T * PLE / 4) ? p4[ii] : (f32x4){0.f, 0.f, 0.f, 0.f}; }
#pragma unroll
            for (int q = 0; q < 4; ++q) { const size_t ii = i + q * NT; if (ii < (size_t)T * PLE / 4) { u32x2 w; w.x = cvt_pk_bf16(v[q][0], v[q][1]); w.y = cvt_pk_bf16(v[q][2], v[q][3]); pb[ii] = w; } } }
    }
    {
        const float* ktab = (const float*)(ws + SM_KTAB) + (size_t)l * 16 * 32 * 256; const f32x2* apow = (const f32x2*)(ws + SM_APOW) + (size_t)l * 16 * 64 * 34; const f32x2* bbar = (const f32x2*)(ws + SM_BBAR) + (size_t)l * 16 * 64 * 16;
        const float* cre = (const float*)a.in[19] + (size_t)l * 16 * 16 * 64; const float* cim = (const float*)a.in[20] + (size_t)l * 16 * 16 * 64;
        bf16_t* Bt = (bf16_t*)(ws + W_S5B);
        for (size_t i = gt; i < (size_t)16 * 512 * S5K; i += NT) { const int k = (int)(i % S5K), row = (int)((i / S5K) & 511), g = (int)(i / ((size_t)S5K * 512)); const int jo = row >> 4, co = row & 15;
            float v;
            if (k < 512) { const int ji = k >> 4, ci = k & 15; v = (jo >= ji) ? ktab[(((size_t)g * 32 + (jo - ji)) * 16 + co) * 16 + ci] : 0.f; }
            else { const int n = (k - 512) & 63; const f32x2 P = apow[((size_t)g * 64 + n) * 34 + jo + 1]; const float cr = cre[((size_t)g * 16 + co) * 64 + n], cm = cim[((size_t)g * 16 + co) * 64 + n];
                v = (k < 576) ? (cr * P.x - cm * P.y) : -(cr * P.y + cm * P.x); }
            Bt[i] = f2bf(v); }
        bf16_t* St = (bf16_t*)(ws + W_S5S);
        for (size_t i = gt; i < (size_t)16 * 256 * 512; i += NT) { const int k = (int)(i & 511), np = (int)((i >> 9) & 255), g = (int)(i >> 17); const int j = k >> 4, ci = k & 15;
            float v = 0.f;
            if (np < 128) { const int n = np & 63; const f32x2 P = apow[((size_t)g * 64 + n) * 34 + (S5LC - 1 - j)], Bb = bbar[((size_t)g * 64 + n) * 16 + ci]; v = (np < 64) ? (P.x * Bb.x - P.y * Bb.y) : (P.x * Bb.y + P.y * Bb.x); }
            St[i] = f2bf(v); }
    }
    {
        float* cb = (float*)(ws + SM_CMPB); LAS float* red = (LAS float*)(F.lds + 8 * 16384 - 4096);
        for (int o = F.bid; o < 8; o += F.G) { const int j = o >> 2, cblk = o & 3; const float* w1 = (const float*)a.in[6] + ((size_t)l * 2 + j) * 2048 * 256 + cblk * 64 + F.lane; const float* pe = (const float*)a.in[5] + ((size_t)l * 2 + j) * 2048;
            float s0 = 0.f, s1 = 0.f, s2 = 0.f, s3 = 0.f;
#pragma unroll 4
            for (int k = 256 * F.wave; k < 256 * F.wave + 256; k += 4) { s0 += pe[k] * w1[(size_t)k * 256]; s1 += pe[k + 1] * w1[(size_t)(k + 1) * 256]; s2 += pe[k + 2] * w1[(size_t)(k + 2) * 256]; s3 += pe[k + 3] * w1[(size_t)(k + 3) * 256]; }
            __syncthreads(); red[F.wave * 64 + F.lane] = (s0 + s1) + (s2 + s3); __syncthreads();
            if (F.wave == 0) { float t = ((const float*)a.in[7])[((size_t)l * 2 + j) * 256 + cblk * 64 + F.lane];
#pragma unroll
                for (int w = 0; w < 8; ++w) t += red[w * 64 + F.lane];
                cb[j * 256 + cblk * 64 + F.lane] = t; }
            __syncthreads(); }
    }
}

__device__ __forceinline__ void conv_items(const Frame& F, const Args& a, int l, int first, int stride, int last = NB * (SEQ / 32)) {
    const bf16_t* z = (const bf16_t*)(a.ws + WS_Z); bf16_t* mix = (bf16_t*)(a.ws + WS_MIX);
    const float* cw = (const float*)a.in[10] + (size_t)l * 31 * 256; const float* cb = (const float*)a.in[11] + (size_t)l * 256;
    const float* lg = (const float*)a.in[12] + (size_t)l * 256; const float* lb = (const float*)a.in[13] + (size_t)l * 256;
    LAS float* U = (LAS float*)F.lds;
    LAS float* Y = (LAS float*)(F.lds + 65536);
    const int cp = F.tid & 127, tg = F.tid >> 7, c = 2 * cp;
    f32x2 w[31];
#pragma unroll
    for (int j = 0; j < 31; ++j) w[j] = *(const f32x2*)(cw + j * 256 + c);
    const f32x2 bias = *(const f32x2*)(cb + c);
    unsigned pva[16], pvg[16];
    auto fetch = [&](int it) { const int b = it >> 7, t0 = (it & 127) * 32;
#pragma unroll
        for (int q = 0; q < 16; ++q) { const int r = tg + 4 * q, t = t0 - 30 + r; pva[q] = 0u; pvg[q] = 0u;
            if (r < 62 && t >= 0) { const bf16_t* zr = z + ((size_t)b * SEQ + t) * INP + ZC; pva[q] = *(const unsigned*)(zr + c); pvg[q] = *(const unsigned*)(zr + 256 + c); } } };
    if (first < last) fetch(first);
    for (int it = first; it < last; it += stride) { const int b = it >> 7, t0 = (it & 127) * 32;
#pragma unroll
        for (int q = 0; q < 16; ++q) { const int r = tg + 4 * q, t = t0 - 30 + r;
            if (r < 62) { f32x2 u = (f32x2){0.f, 0.f}; if (t >= 0) u = (f32x2){bflo(pva[q]) * sigmoidf_(bflo(pvg[q])), bfhi(pva[q]) * sigmoidf_(bfhi(pvg[q]))};
                *(LAS f32x2*)(U + r * 256 + c) = u; } }
        if (it + stride < last) fetch(it + stride);
        __syncthreads();
        {   f32x2 acc[8];
#pragma unroll
            for (int i = 0; i < 8; ++i) acc[i] = bias;
#pragma unroll
            for (int k = 0; k < 38; ++k) { const f32x2 u = *(const LAS f32x2*)(U + (tg * 8 + k) * 256 + c);
#pragma unroll
                for (int i = 0; i < 8; ++i) { const int j = k - i; if (j >= 0 && j < 31) acc[i] += w[j] * u; } }
#pragma unroll
            for (int i = 0; i < 8; ++i) *(LAS f32x2*)(Y + (tg * 8 + i) * 256 + c) = acc[i];
        }
        __syncthreads();
        for (int i = 0; i < 4; ++i) { const int tl = F.wave * 4 + i; const f32x4 v = *(const LAS f32x4*)(Y + tl * 256 + F.lane * 4);
            const float mean = wave_sum((v[0] + v[1]) + (v[2] + v[3])) * (1.f / 256.f); const f32x4 dlt = v - mean;
            const float var = wave_sum((dlt[0] * dlt[0] + dlt[1] * dlt[1]) + (dlt[2] * dlt[2] + dlt[3] * dlt[3])) * (1.f / 256.f); const float rstd = 1.0f / sqrtf(var + LN_EPS);
            const f32x4 gg = *(const f32x4*)(lg + F.lane * 4), bb = *(const f32x4*)(lb + F.lane * 4);
            float o[4];
#pragma unroll
            for (int e = 0; e < 4; ++e) o[e] = siluf_(dlt[e] * rstd * gg[e] + bb[e]);
            u32x2 wv; wv.x = cvt_pk_bf16(o[0], o[1]); wv.y = cvt_pk_bf16(o[2], o[3]);
            *(u32x2*)(mix + ((size_t)b * SEQ + t0 + tl) * 1024 + 512 + F.lane * 4) = wv; }
        __syncthreads();
    }
}
__device__ __forceinline__ void cmp_stage2(const Frame& F, const Args& a, int l) {
    unsigned char* ws = a.ws; const float* cb = (const float*)(ws + SM_CMPB);
    LAS float* w2s = (LAS float*)F.lds;
    LAS float* hs = (LAS float*)(F.lds + 65536 + F.wave * 1024);
    const int gw = F.bid * 8 + F.wave, NGW = F.G * 8, lane = F.lane;
    for (int j = 0; j < 2; ++j) {
        const float* w2 = (const float*)a.in[8] + ((size_t)l * 2 + j) * 256 * 64; const float* b2 = (const float*)a.in[9] + ((size_t)l * 2 + j) * 64;
        __syncthreads();
        for (int i = F.tid; i < 256 * 64 / 4; i += 512) *(LAS f32x4*)(w2s + 4 * i) = *(const f32x4*)(w2 + 4 * i);
        __syncthreads();
        for (int it = gw; it < 32 * 256; it += NGW) { const int bh = it >> 8, n = it & 255;
            float outv = 0.f;
            if (n < NCMP) {
                const float* P = (const float*)(ws + WS_CMPP) + (size_t)j * 8192 * 512 + ((size_t)bh * 256 + n) * 512;
                const f32x4 p0 = *(const f32x4*)(P + lane * 4), p1 = *(const f32x4*)(P + 512 + 256 + lane * 4), bb = *(const f32x4*)(cb + j * 256 + lane * 4);
                f32x4 hv;
#pragma unroll
                for (int e = 0; e < 4; ++e) hv[e] = gelu_tanh(p0[e] + p1[e] + bb[e]);
                *(LAS f32x4*)(hs + lane * 4) = hv; LDS_WAIT(); asm volatile("" ::: "memory");
                float acc0 = b2[lane], acc1 = 0.f, acc2 = 0.f, acc3 = 0.f;
#pragma unroll 4
                for (int c = 0; c < 256; c += 4) { const f32x4 h4 = *(const LAS f32x4*)(hs + c);
                    acc0 += h4[0] * w2s[c * 64 + lane]; acc1 += h4[1] * w2s[(c + 1) * 64 + lane]; acc2 += h4[2] * w2s[(c + 2) * 64 + lane]; acc3 += h4[3] * w2s[(c + 3) * 64 + lane]; }
                outv = (acc0 + acc1) + (acc2 + acc3); LDS_WAIT(); asm volatile("" ::: "memory");
            }
            if (j == 0) ((bf16_t*)(ws + WS_KC))[((size_t)bh * 256 + n) * 64 + lane] = f2bf(outv);
            else ((bf16_t*)(ws + WS_VCT))[((size_t)bh * 4 + (n >> 6)) * 4096 + lane * 64 + nsa::vslot(n & 63)] = f2bf(outv);
        }
    }
    __syncthreads();
}
__device__ __forceinline__ void cmp_stage2_panel(const Frame& F, const Args& a, int l, int j, int bh) {
    constexpr int HP = 528;
    unsigned char* ws = a.ws; const float* cb = (const float*)(ws + SM_CMPB);
    LAS unsigned char* Hs = F.lds;
    LAS unsigned char* Ws = F.lds + 128 * HP;
    const int lane = F.lane, w = F.wave;
    const float* w2 = (const float*)a.in[8] + ((size_t)l * 2 + j) * 256 * 64; const float* b2 = (const float*)a.in[9] + ((size_t)l * 2 + j) * 64;
    const float* Pb = (const float*)(ws + WS_CMPP) + (size_t)j * 8192 * 512 + (size_t)bh * 256 * 512;
    __syncthreads();
    for (int i = F.tid; i < 256 * 64; i += 512) { const int c = i >> 6, d = i & 63; *(LAS bf16_t*)(Ws + d * HP + c * 2) = f2bf(w2[i]); }
    const f32x4 bb = *(const f32x4*)(cb + j * 256 + lane * 4);
    for (int half = 0; half < 2; ++half) {
        __syncthreads();
#pragma unroll 4
        for (int rr = 0; rr < 16; ++rr) { const int r = 16 * w + rr, n = half * 128 + r, n1 = n < 255 ? n + 1 : n;
            const f32x4 p0 = *(const f32x4*)(Pb + (size_t)n * 512 + lane * 4), p1 = *(const f32x4*)(Pb + (size_t)n1 * 512 + 256 + lane * 4);
            u32x2 hv; hv.x = cvt_pk_bf16(gelu_tanh(p0[0] + p1[0] + bb[0]), gelu_tanh(p0[1] + p1[1] + bb[1])); hv.y = cvt_pk_bf16(gelu_tanh(p0[2] + p1[2] + bb[2]), gelu_tanh(p0[3] + p1[3] + bb[3]));
            *(LAS u32x2*)(Hs + r * HP + lane * 8) = hv; }
        __syncthreads();
        f32x4 acc[4];
#pragma unroll
        for (int cbk = 0; cbk < 4; ++cbk) acc[cbk] = (f32x4){0.f, 0.f, 0.f, 0.f};
        const LAS unsigned char* ap = Hs + (16 * w + (lane & 15)) * HP + (lane >> 4) * 16;
        const LAS unsigned char* bp = Ws + (lane & 15) * HP + (lane >> 4) * 16;
#pragma unroll
        for (int ks = 0; ks < 8; ++ks) { const bf16x8 af = *(const LAS bf16x8*)(ap + ks * 64);
#pragma unroll
            for (int cbk = 0; cbk < 4; ++cbk) { const bf16x8 bf = *(const LAS bf16x8*)(bp + cbk * 16 * HP + ks * 64); acc[cbk] = __builtin_amdgcn_mfma_f32_16x16x32_bf16(af, bf, acc[cbk], 0, 0, 0); } }
#pragma unroll
        for (int cbk = 0; cbk < 4; ++cbk) { const int d = 16 * cbk + (lane & 15); const float bv = b2[d];
#pragma unroll
            for (int e = 0; e < 4; ++e) { const int n = half * 128 + 16 * w + 4 * (lane >> 4) + e; const float outv = n < NCMP ? acc[cbk][e] + bv : 0.f;
                if (j == 0) ((bf16_t*)(ws + WS_KC))[((size_t)bh * 256 + n) * 64 + d] = f2bf(outv);
                else ((bf16_t*)(ws + WS_VCT))[((size_t)bh * 4 + (n >> 6)) * 4096 + d * 64 + nsa::vslot(n & 63)] = f2bf(outv); } }
    }
    __syncthreads();
}
__device__ __forceinline__ void s5_carry_panel(const Frame& F, const Args& a, int l, int g, int pm) {
    unsigned char* ws = a.ws; const f32x2* apow = (const f32x2*)(ws + SM_APOW) + (size_t)l * 16 * 64 * 34;
    const float* S = (const float*)(ws + WS_S5S); bf16_t* ap = (bf16_t*)(ws + WS_S5A);
    if (F.tid < 128) { const int n = F.tid & 63, b = 2 * pm + (F.tid >> 6);
        const f32x2 A = apow[((size_t)g * 64 + n) * 34 + S5LC]; float hr = 0.f, hi = 0.f;
        const float* sp = S + ((size_t)g * 2048 + b * 128) * 256 + n; bf16_t* dp = ap + ((size_t)g * 2048 + b * 128) * S5K + 512 + n;
        float nr_[16], ni_[16];
#pragma unroll
        for (int k = 0; k < 16; ++k) { nr_[k] = sp[(size_t)k * 256]; ni_[k] = sp[(size_t)k * 256 + 64]; }
        for (int c0 = 0; c0 < S5NCH; c0 += 16) { float sr[16], si[16];
#pragma unroll
            for (int k = 0; k < 16; ++k) { sr[k] = nr_[k]; si[k] = ni_[k]; }
            if (c0 + 16 < S5NCH) {
#pragma unroll
                for (int k = 0; k < 16; ++k) { nr_[k] = sp[(size_t)(c0 + 16 + k) * 256]; ni_[k] = sp[(size_t)(c0 + 16 + k) * 256 + 64]; } }
#pragma unroll
            for (int k = 0; k < 16; ++k) { dp[(size_t)(c0 + k) * S5K] = f2bf(hr); dp[(size_t)(c0 + k) * S5K + 64] = f2bf(hi);
                const float nr = A.x * hr - A.y * hi + sr[k], ni = A.x * hi + A.y * hr + si[k]; hr = nr; hi = ni; } }
    }
}
__device__ __forceinline__ void s5_carry(const Frame& F, const Args& a, int l) {
    unsigned char* ws = a.ws; const f32x2* apow = (const f32x2*)(ws + SM_APOW) + (size_t)l * 16 * 64 * 34;
    const float* S = (const float*)(ws + WS_S5S); bf16_t* ap = (bf16_t*)(ws + WS_S5A);
    const int gt = F.bid * 512 + F.tid, NT = F.G * 512;
    for (int i = gt; i < 16 * NB * 64; i += NT) { const int n = i & 63, b = (i >> 6) & 15, g = i >> 10;
        const f32x2 A = apow[((size_t)g * 64 + n) * 34 + S5LC]; float hr = 0.f, hi = 0.f;
        const float* sp = S + ((size_t)g * 2048 + b * 128) * 256 + n; bf16_t* dp = ap + ((size_t)g * 2048 + b * 128) * S5K + 512 + n;
        float nr_[16], ni_[16];
#pragma unroll
        for (int k = 0; k < 16; ++k) { nr_[k] = sp[(size_t)k * 256]; ni_[k] = sp[(size_t)k * 256 + 64]; }
        for (int c0 = 0; c0 < S5NCH; c0 += 16) { float sr[16], si[16];
#pragma unroll
            for (int k = 0; k < 16; ++k) { sr[k] = nr_[k]; si[k] = ni_[k]; }
            if (c0 + 16 < S5NCH) {
#pragma unroll
                for (int k = 0; k < 16; ++k) { nr_[k] = sp[(size_t)(c0 + 16 + k) * 256]; ni_[k] = sp[(size_t)(c0 + 16 + k) * 256 + 64]; } }
#pragma unroll
            for (int k = 0; k < 16; ++k) { dp[(size_t)(c0 + k) * S5K] = f2bf(hr); dp[(size_t)(c0 + k) * S5K + 64] = f2bf(hi);
                const float nr = A.x * hr - A.y * hi + sr[k], ni = A.x * hi + A.y * hr + si[k]; hr = nr; hi = ni; } }
    }
}
template <int MODE, bool ROUTE, bool FINAL>
__device__ __forceinline__ void ln_panel(const Frame& F, const Args& a, int pm, const float* gain, const float* beta, const float* router, size_t h_off = WS_HBUF) {
    unsigned char* ws = a.ws; float* xout = a.out; bf16_t* xb = (bf16_t*)(ws + WS_XB);
    const bf16_t* hb = (const bf16_t*)(ws + (MODE == 0 ? h_off : WS_YB)); const f32x2* tokw = (const f32x2*)(ws + SM_TOKW);
    LAS int* cnt = (LAS int*)F.lds;
    const int lane = F.lane;
    f32x4 gv[4], bv[4];
#pragma unroll
    for (int j = 0; j < 4; ++j) { gv[j] = *(const f32x4*)(gain + 4 * lane + 256 * j); bv[j] = *(const f32x4*)(beta + 4 * lane + 256 * j); }
    if (ROUTE) { if (F.tid < 8) cnt[F.tid] = 0; __syncthreads(); }
    u32x2 nx[4], nh0[4], nh1[4]; f32x2 nw = (f32x2){0.f, 0.f};
    { const size_t row = (size_t)pm * 256 + F.wave * 32; if (MODE == 1) nw = tokw[row];
#pragma unroll
      for (int j = 0; j < 4; ++j) { nx[j] = *(const u32x2*)(xb + row * D + 4 * lane + 256 * j);
          if (MODE == 0) { nh0[j] = *(const u32x2*)(hb + row * D + 4 * lane + 256 * j); nh1[j] = nh0[j]; } else { nh0[j] = *(const u32x2*)(hb + (2 * row) * D + 4 * lane + 256 * j); nh1[j] = *(const u32x2*)(hb + (2 * row + 1) * D + 4 * lane + 256 * j); } } }
    for (int i = 0; i < 32; ++i) { const size_t row = (size_t)pm * 256 + F.wave * 32 + i;
        f32x4 v[4]; float s = 0.f;
        u32x2 cx[4], ch0[4], ch1[4]; const f32x2 w01 = nw;
#pragma unroll
        for (int j = 0; j < 4; ++j) { cx[j] = nx[j]; ch0[j] = nh0[j]; ch1[j] = nh1[j]; }
        if (i < 31) { const size_t rn = row + 1; if (MODE == 1) nw = tokw[rn];
#pragma unroll
            for (int j = 0; j < 4; ++j) { nx[j] = *(const u32x2*)(xb + rn * D + 4 * lane + 256 * j);
                if (MODE == 0) { nh0[j] = *(const u32x2*)(hb + rn * D + 4 * lane + 256 * j); nh1[j] = nh0[j]; } else { nh0[j] = *(const u32x2*)(hb + (2 * rn) * D + 4 * lane + 256 * j); nh1[j] = *(const u32x2*)(hb + (2 * rn + 1) * D + 4 * lane + 256 * j); } } }
#pragma unroll
        for (int j = 0; j < 4; ++j) { const u32x2 xq = cx[j]; const f32x4 xv = (f32x4){bflo(xq.x), bfhi(xq.x), bflo(xq.y), bfhi(xq.y)}; f32x4 hv;
            if (MODE == 0) { const u32x2 q = ch0[j]; hv = (f32x4){bflo(q.x), bfhi(q.x), bflo(q.y), bfhi(q.y)}; }
            else { const u32x2 q0 = ch0[j], q1 = ch1[j];
                hv = (f32x4){w01.x * bflo(q0.x) + w01.y * bflo(q1.x), w01.x * bfhi(q0.x) + w01.y * bfhi(q1.x), w01.x * bflo(q0.y) + w01.y * bflo(q1.y), w01.x * bfhi(q0.y) + w01.y * bfhi(q1.y)}; }
            v[j] = xv * ALPHA + hv; s += (v[j][0] + v[j][1]) + (v[j][2] + v[j][3]); }
        const float mean = wave_sum(s) * (1.f / D); float s2 = 0.f;
#pragma unroll
        for (int j = 0; j < 4; ++j) { v[j] = v[j] - mean; s2 += (v[j][0] * v[j][0] + v[j][1] * v[j][1]) + (v[j][2] * v[j][2] + v[j][3] * v[j][3]); }
        const float rstd = 1.0f / sqrtf(wave_sum(s2) * (1.f / D) + LN_EPS);
#pragma unroll
        for (int j = 0; j < 4; ++j) { v[j] = v[j] * rstd * gv[j] + bv[j];
            if (FINAL) *(f32x4*)(xout + row * D + 4 * lane + 256 * j) = v[j];
            u32x2 w; w.x = cvt_pk_bf16(v[j][0], v[j][1]); w.y = cvt_pk_bf16(v[j][2], v[j][3]); *(u32x2*)(xb + row * D + 4 * lane + 256 * j) = w; }
        if (ROUTE) {
            float lg[8];
#pragma unroll
            for (int e = 0; e < 8; ++e) lg[e] = 0.f;
#pragma unroll
            for (int j = 0; j < 4; ++j)
#pragma unroll
                for (int k = 0; k < 4; ++k) { const float* rr = router + (size_t)(4 * lane + 256 * j + k) * 8; const f32x4 r0 = *(const f32x4*)rr, r1 = *(const f32x4*)(rr + 4); const float xv = v[j][k];
                    lg[0] += xv * r0[0]; lg[1] += xv * r0[1]; lg[2] += xv * r0[2]; lg[3] += xv * r0[3]; lg[4] += xv * r1[0]; lg[5] += xv * r1[1]; lg[6] += xv * r1[2]; lg[7] += xv * r1[3]; }
            {
                const bool h3 = (lane & 8) != 0;
                float r4[4], r2[2], r1;
#pragma unroll
                for (int i = 0; i < 4; ++i) r4[i] = swapsum32(lg[i], lg[4 + i]);
#pragma unroll
                for (int i = 0; i < 2; ++i) r2[i] = swapsum16(r4[i], r4[2 + i]);
                { const float send = h3 ? r2[0] : r2[1], mine = h3 ? r2[1] : r2[0]; r1 = mine + xshfl<8>(send); }
                r1 += xshfl<1>(r1); r1 += xshfl<2>(r1); r1 += dpp_half_mirror(r1);
#pragma unroll
                for (int e = 0; e < 8; ++e) lg[e] = __builtin_bit_cast(float, __builtin_amdgcn_readlane(__builtin_bit_cast(int, r1), 8 * e));
            }
            int e0 = 0; float m0 = lg[0];
#pragma unroll
            for (int e = 1; e < 8; ++e) if (lg[e] > m0) { m0 = lg[e]; e0 = e; }
            int e1 = -1; float m1 = -3.0e38f;
#pragma unroll
            for (int e = 0; e < 8; ++e) if (e != e0 && lg[e] > m1) { m1 = lg[e]; e1 = e; }
            const float w0 = 1.0f / (1.0f + __expf(m1 - m0));
            if (lane == 0) { ((int*)(ws + SM_TOKE))[row] = e0 | (e1 << 8); ((f32x2*)(ws + SM_TOKW))[row] = (f32x2){w0, 1.0f - w0}; __hip_atomic_fetch_add(&cnt[e0], 1, __ATOMIC_RELAXED, __HIP_MEMORY_SCOPE_WORKGROUP); __hip_atomic_fetch_add(&cnt[e1], 1, __ATOMIC_RELAXED, __HIP_MEMORY_SCOPE_WORKGROUP); }
        }
    }
    if (ROUTE) { __syncthreads(); if (F.tid < 8) ((int*)(ws + SM_PCNT))[pm * 8 + F.tid] = cnt[F.tid]; __syncthreads(); }
}
__device__ __forceinline__ void moe_gather(const Frame& F, const Args& a) {
    unsigned char* ws = a.ws; const int* pcnt = (const int*)(ws + SM_PCNT); const int* toke = (const int*)(ws + SM_TOKE);
    int* rowtok = (int*)(ws + SM_ROWTOK); int* tileexp = (int*)(ws + SM_TILEEXP);
    const bf16_t* xb = (const bf16_t*)(ws + WS_XB); bf16_t* xs = (bf16_t*)(ws + WS_XS);
    LAS int* sm = (LAS int*)F.lds;
    for (int pm = F.bid; pm < T / 256; pm += F.G) {
        for (int q = F.tid; q < (T / 256) * 8; q += 512) sm[1024 + q] = pcnt[q];
        if (F.tid >= 32 && F.tid < 288) sm[F.tid] = toke[pm * 256 + F.tid - 32];
        __syncthreads();
        if (F.tid < 8) { int tot = 0, before = 0; for (int q = 0; q < T / 256; ++q) { const int c = sm[1024 + q * 8 + F.tid]; tot += c; if (q < pm) before += c; } sm[F.tid] = tot; sm[16 + F.tid] = before; }
        __syncthreads();
        if (F.tid == 0) { int st = 0; for (int e = 0; e < 8; ++e) { sm[8 + e] = st * 256; st += (sm[e] + 255) >> 8; } sm[24] = st; }
        __syncthreads();
        {
            const int i = F.tid >> 1, k = F.tid & 1; const int ee = sm[32 + i]; const int e = k ? (ee >> 8) : (ee & 255);
            int cntb = 0; for (int q = 0; q < i; ++q) { const int o = sm[32 + q]; cntb += ((o & 255) == e) + ((o >> 8) == e); }
            const int dest = sm[8 + e] + sm[16 + e] + cntb; sm[512 + F.tid] = dest; rowtok[dest] = 2 * (pm * 256 + i) + k;
        }
        __syncthreads();
        for (int r0 = F.wave * 64; r0 < F.wave * 64 + 64; r0 += 8) {
            u32x4 va[8], vb[8];
#pragma unroll
            for (int q = 0; q < 8; ++q) { const size_t tok = (size_t)pm * 256 + ((r0 + q) >> 1); const u32x4* s = (const u32x4*)(xb + tok * D); va[q] = s[F.lane]; vb[q] = s[64 + F.lane]; }
#pragma unroll
            for (int q = 0; q < 8; ++q) { const int dest = sm[512 + r0 + q]; u32x4* d = (u32x4*)(xs + (size_t)dest * D); d[F.lane] = va[q]; d[64 + F.lane] = vb[q]; } }
        if (pm == 0) {
            for (int e = 0; e < 8; ++e) { const int r0 = sm[8 + e] + sm[e], r1 = sm[8 + e] + (((sm[e] + 255) >> 8) << 8); for (int r = r0 + F.tid; r < r1; r += 512) rowtok[r] = -1;
                const int t0 = sm[8 + e] >> 8, t1 = r1 >> 8; for (int t = t0 + F.tid; t < t1; t += 512) tileexp[t] = e; }
            if (F.tid == 0) tileexp[1023] = sm[24];
        }
        __syncthreads();
    }
}

__device__ __forceinline__ void moe_tail_finalize(const Frame& F, const Args& a) {
    const int* tileexp = (const int*)(a.ws + SM_TILEEXP); int nt = tileexp[1023] - (MOE_NCHUNK - 1) * MOE_CHUNK_TILES; nt = nt < 0 ? 0 : (nt > 8 ? 8 : nt);
    const float* YT = (const float*)(a.ws + WS_XS); const int* row_tok = (const int*)(a.ws + SM_ROWTOK) + (MOE_NCHUNK - 1) * MOE_CHUNK_TILES * 256; bf16_t* Y = (bf16_t*)(a.ws + WS_YB);
    const int c8 = (F.tid & 127) * 8;
    for (int r = F.bid * 4 + (F.tid >> 7); r < nt * 256; r += F.G * 4) { const int dst = row_tok[r]; if (dst < 0) continue;
        f32x4 s0 = (f32x4){0.f, 0.f, 0.f, 0.f}, s1 = s0;
#pragma unroll
        for (int ks = 0; ks < 7; ++ks) { const float* p = YT + ((size_t)ks * 2048 + r) * D + c8; s0 += *(const f32x4*)p; s1 += *(const f32x4*)(p + 4); }
        u32x4 w; w.x = cvt_pk_bf16(s0[0], s0[1]); w.y = cvt_pk_bf16(s0[2], s0[3]); w.z = cvt_pk_bf16(s1[0], s1[1]); w.w = cvt_pk_bf16(s1[2], s1[3]);
        *(u32x4*)(Y + (size_t)dst * D + c8) = w; }
}
struct MoeUpOrder { int ntile, G, c, chunk; const int* tileexp;
    __device__ __forceinline__ bool next(int i, pg8::Unit& u) const { if (!pg8::static_tile(i, G, c, ntile, 2 * DFE / 256, u.pm, u.pn)) return false;
        const int tile = chunk * MOE_CHUNK_TILES + u.pm, e = tileexp[tile]; u.aux = tile; u.offA = (long long)tile * 256 * D * 2; u.offB = ((long long)e * 2 * DFE + (long long)u.pn * 256) * D * 2; return true; } };
struct MoeDnOrder { int ntile, G, c, chunk; const int* tileexp;
    __device__ __forceinline__ bool next(int i, pg8::Unit& u) const { if (!pg8::static_tile(i, G, c, ntile, D / 256, u.pm, u.pn)) return false;
        const int tile = chunk * MOE_CHUNK_TILES + u.pm, e = tileexp[tile]; u.aux = tile; u.offA = (long long)u.pm * 256 * DFE * 2; u.offB = ((long long)e * D + (long long)u.pn * 256) * DFE * 2; return true; } };

struct MoeDnTailOrder { int ntile, G, c; const int* tileexp;
    __device__ __forceinline__ bool next(int i, pg8::Unit& u) const { const long L = (long)i * G + c; if (L >= (long)ntile * 28) return false;
        const int ks = (int)(L % 7), rest = (int)(L / 7); u.pn = rest & 3; u.pm = rest >> 2; u.aux = ks;
        const int tile = (MOE_NCHUNK - 1) * MOE_CHUNK_TILES + u.pm, e = tileexp[tile];
        u.offA = (long long)u.pm * 256 * DFE * 2 + (long long)ks * 512 * 2; u.offB = ((long long)e * D + (long long)u.pn * 256) * DFE * 2 + (long long)ks * 512 * 2; return true; } };

__device__ __forceinline__ int attn_pair(int p0, int G) {
    if (G != 256) return p0;
    const int x = p0 & 7, r = (p0 >> 3) & 31, k = p0 >> 8;
    return ((x + 8 * (2 * k + (r >> 4))) << 4) | (r & 15);
}

enum { PH_PREP = 0, PH_WIN, PH_POST, PH_MIX1, PH_MIX2, PH_MIX3, PH_MIX4, PH_WOUT, PH_LN1, PH_FUP, PH_FDN, PH_MGATH = 9, PH_MUP0 = 10, PH_LN2 = 21, PH_PGATE, PH_PPROJ, PH_LN3, PH_PER_LAYER = 32 };
constexpr int GP_END = 2 + 32 * DEPTH;

__global__ void __launch_bounds__(512, 2) mk_fwd(Args a0) {
    extern __shared__ __attribute__((aligned(16))) unsigned char lds_raw[];
    LAS unsigned char* const lds = (LAS unsigned char*)lds_raw;
    for (int u = threadIdx.x; u < (LDS_BYTES - LDSCTL_OFF) / 4; u += 512) ((LAS unsigned*)(lds + LDSCTL_OFF))[u] = 0u;
    __syncthreads();
    const int gp_lo = a0.gp_lo, gp_hi = a0.gp_hi; const int F0bid = blockIdx.x, F0G = gridDim.x; const int wave0 = __builtin_amdgcn_readfirstlane(threadIdx.x >> 6);
    XcdBarrier bar; bar.bar = (unsigned*)(a0.ws + WS_CTL) + CW_BAR; bar.x = 0; bar.st = nullptr;
    if (a0.use_bar) bar = xcd_barrier_post((unsigned*)(a0.ws + WS_CTL) + CW_BAR, (volatile LAS unsigned*)(lds + LDSCTL_OFF + 32));
#if MK_PROBE
#define PRW ((volatile LAS unsigned*)(lds + LDSCTL_OFF + 128))
    if (threadIdx.x == 0) { const unsigned long long t_ = __builtin_amdgcn_s_memrealtime(); PRW[0] = (unsigned)t_; PRW[1] = (unsigned)(t_ >> 32); PRW[2] = 0u; PRW[3] = 0u; PRW[4] = (unsigned)t_; PRW[5] = (unsigned)(t_ >> 32); }
#define STAMP(cls) do { if (wave0 == 0 && lane_id_fresh() == 0) { const unsigned long long t_ = __builtin_amdgcn_s_memrealtime(); const unsigned long long p_ = ((unsigned long long)PRW[1] << 32) | PRW[0]; const unsigned d_ = (unsigned)(t_ - p_); \
        PRW[0] = (unsigned)t_; PRW[1] = (unsigned)(t_ >> 32); if ((PROBE_A >> (cls)) & 1) PRW[2] += d_; if ((PROBE_B >> (cls)) & 1) PRW[3] += d_; } } while (0)
#else
#define STAMP(cls) do {} while (0)
#endif
#define RUN(gp) (gp_lo <= (gp) && (gp) < gp_hi)
#define SEAM(gp) do { if (gp_lo <= (gp) && (gp) + 1 < gp_hi) xcd_barrier(bar, wave0); } while (0)
#define PH_BEGIN Args a; load_args(a); const Frame F = make_frame(lds, wave0); unsigned char* const ws = a.ws; int l = lx; asm volatile("" : "+s"(l)); (void)l; (void)ws; \
    bf16_t* const xb = (bf16_t*)(ws + WS_XB); bf16_t* const z = (bf16_t*)(ws + WS_Z); bf16_t* const mix = (bf16_t*)(ws + WS_MIX); bf16_t* const hbuf = (bf16_t*)(ws + WS_HBUF); const long long S1K = 256ll * 1024 * 2; \
    (void)xb; (void)z; (void)mix; (void)hbuf; (void)S1K;
#define AP_DEF const nsa::Lane L{F.lane, F.lane & 31, F.lane >> 5, F.wave, F.tid}; \
    const nsa::AttnPtrs AP{(const bf16_t*)(ws + WS_Q), z, (const bf16_t*)(ws + WS_KC), (const bf16_t*)(ws + WS_VCT), (const bf16_t*)(ws + WS_KSEL), (const bf16_t*)(ws + WS_VSEL), \
                           (const bf16_t*)(ws + WS_KWIN), (const bf16_t*)(ws + WS_VWIN), (unsigned long long*)(ws + WS_SELM), mix};
    { const int lx = 0;
    if (RUN(0)) { PH_BEGIN phase_init0(F, a); }
    SEAM(0); STAMP(0);
    if (RUN(1)) { PH_BEGIN phase_init1(F, a); }
    SEAM(1); STAMP(0);
    }
    for (int lx = 0; lx < DEPTH; ++lx) {
        const int base = 2 + PH_PER_LAYER * lx; const bool moe = (lx & 1) != 0;
        if (RUN(base + PH_PREP)) { PH_BEGIN phase_prep(F, a, l); }
        SEAM(base + PH_PREP); STAMP(1);
        if (RUN(base + PH_WIN)) { PH_BEGIN
            pg8::Gemm g{xb, (const bf16_t*)(ws + W_IN), D, D, D}; pg8::PlainOrder S{T / 256, INP / 256, F.G, F.bid, S1K, S1K};
            epi::EpiWin E{z, (bf16_t*)(ws + WS_Q), (bf16_t*)(ws + WS_KCMP), (bf16_t*)(ws + WS_S5A), (const f32x2*)(ws + WS_ROPE)};
            pg8::gemm_phase(F.lds, g, S, E, F.tid);
        }
        SEAM(base + PH_WIN); STAMP(2);
        if (RUN(base + PH_MIX1)) {
            for (int r = F0bid; r < 128; r += F0G) {
                {   PH_BEGIN const int g_ = r >> 3, pm_ = r & 7;
                    pg8::Gemm g{(const bf16_t*)(ws + WS_S5A), (const bf16_t*)(ws + W_S5S), 512, S5K, 512};
                    pg8::ListOrder S{1, pm_, g_, (long long)g_ * 2048 * S5K * 2 + (long long)pm_ * 256 * S5K * 2, (long long)g_ * 256 * 512 * 2, 0}; epi::F32Grouped E{(float*)(ws + WS_S5S), 256, (size_t)2048 * 256};
                    pg8::gemm_phase(F.lds, g, S, E, F.tid); }
                __syncthreads();
                {   PH_BEGIN int nr = MK_REP_CARRY; asm volatile("" : "+s"(nr)); for (int q = 0; q < nr; ++q) s5_carry_panel(F, a, l, r >> 3, r & 7); }
                asm volatile("s_waitcnt vmcnt(0)" ::: "memory"); __syncthreads();
                {   PH_BEGIN const int g_ = r >> 3, pm_ = r & 7;
                    pg8::Gemm g{(const bf16_t*)(ws + WS_S5A), (const bf16_t*)(ws + W_S5B), S5K, S5K, S5K};
                    pg8::ListOrder S{2, pm_, g_, (long long)g_ * 2048 * S5K * 2 + (long long)pm_ * 256 * S5K * 2, (long long)g_ * 512 * S5K * 2, 256ll * S5K * 2}; epi::S5Out E{(bf16_t*)(ws + WS_ZS5), z, (const float*)a.in[21] + (size_t)l * 256};
                    pg8::gemm_phase(F.lds, g, S, E, F.tid); }
            }
            for (int r = F0bid - 128; r < 64; r += F0G) { if (r < 0) continue;
                {   PH_BEGIN const int j_ = r >> 5, bh_ = r & 31;
                    pg8::Gemm g{(const bf16_t*)(ws + WS_KCMP), (const bf16_t*)(ws + W_CMP), 1024, 1024, 1024};
                    pg8::ListOrder S{2, bh_, j_, (long long)j_ * (long long)(WS_VCMP - WS_KCMP) + (long long)bh_ * S1K, (long long)j_ * 512 * 1024 * 2, S1K}; epi::F32Grouped E{(float*)(ws + WS_CMPP), 512, (size_t)8192 * 512};
                    pg8::gemm_phase(F.lds, g, S, E, F.tid); }
                asm volatile("s_waitcnt vmcnt(0)" ::: "memory"); __syncthreads();
                {   PH_BEGIN int nr = MK_REP_ST2; asm volatile("" : "+s"(nr)); for (int q = 0; q < nr; ++q) cmp_stage2_panel(F, a, l, r >> 5, r & 31); }
            }
            {   PH_BEGIN
                if (F.G == 256) { const int c = F.bid; const int beg = c < 128 ? c * 5 : (c < 192 ? 640 + (c - 128) * 6 : 1024 + (c - 192) * 16), cnt = c < 128 ? 5 : (c < 192 ? 6 : 16); conv_items(F, a, l, beg, 1, beg + cnt); }
                else conv_items(F, a, l, F.bid, F.G); }
        }
        SEAM(base + PH_MIX1); STAMP(4);
        if (RUN(base + PH_MIX3)) {
            {   PH_BEGIN
                pg8::Gemm g{(const bf16_t*)(ws + WS_ZS5), (const bf16_t*)(ws + W_GLU), 256, 256, 256};
                pg8::PlainOrder S{T / 256, 1, F.G, F.bid, 256ll * 256 * 2, 256ll * 256 * 2}; epi::S5Glu E{mix, (const bf16_t*)(ws + WS_ZS5), (const float*)a.in[23] + (size_t)l * 256};
                pg8::gemm_phase(F.lds, g, S, E, F.tid);
            }
            {   PH_BEGIN AP_DEF
                for (int p0 = F.bid; p0 < 32 * 16; p0 += F.G) { const int p = attn_pair(p0, F.G); const int bh = p >> 4, s = p & 15;
                    for (int half = 0; half < 2; ++half) { const int qb2 = half ? 31 - s : s;
                        nsa::cmp_unit<true>(bh, 2 * qb2, AP, F.lds, L); nsa::cmp_topk(bh, 2 * qb2, AP, F.lds, L);
                        nsa::cmp_unit<false>(bh, 2 * qb2 + 1, AP, F.lds, L); nsa::cmp_topk(bh, 2 * qb2 + 1, AP, F.lds, L); } } }
            asm volatile("s_waitcnt vmcnt(0)" ::: "memory"); __syncthreads();
            {   PH_BEGIN AP_DEF
                for (int p0 = F.bid; p0 < 32 * 16; p0 += F.G) { const int p = attn_pair(p0, F.G); const int bh = p >> 4, s = p & 15; nsa::sw_unit2(bh, s, AP, F.lds, L); nsa::sw_unit2(bh, 31 - s, AP, F.lds, L); } }
        }
        SEAM(base + PH_MIX3); STAMP(6);

        if (RUN(base + PH_WOUT)) {
            {   PH_BEGIN
                pg8::Gemm g{mix, (const bf16_t*)(ws + W_OUT), D, D, D}; pg8::PlainOrder S{T / 256, D / 256, F.G, F.bid, S1K, S1K}; epi::Bf16Sc1 E{hbuf, D, (unsigned)((size_t)T * D * 2)};
                pg8::gemm_phase(F.lds, g, S, E, F.tid);
            }
            {   PH_BEGIN pg8::PlainOrder S{T / 256, D / 256, F.G, F.bid, S1K, S1K}; panels_publish_wait(F, (unsigned*)(ws + WS_CTL), 2 * l + 0, S, (unsigned)(D / 256)); }
            {   PH_BEGIN
                const float* gg = (const float*)a.in[34] + ((size_t)l * 3 + 0) * D; const float* bb = (const float*)a.in[35] + ((size_t)l * 3 + 0) * D;
                for (int pm = F.bid; pm < T / 256; pm += F.G) { if (l & 1) ln_panel<0, true, false>(F, a, pm, gg, bb, (const float*)a.in[27] + (size_t)(l >> 1) * D * NEXP); else ln_panel<0, false, false>(F, a, pm, gg, bb, nullptr); }
            }
        }
        SEAM(base + PH_WOUT); STAMP(8);
        if (!moe) {
            if (RUN(base + PH_FUP)) { PH_BEGIN
                pg8::Gemm g{xb, (const bf16_t*)(ws + W_UP), D, D, D}; pg8::PlainOrder S{T / 256, 2 * DFF / 256, F.G, F.bid, S1K, S1K}; epi::SwiGlu E{(bf16_t*)(ws + WS_FFH), DFF};
                pg8::gemm_phase(F.lds, g, S, E, F.tid);
            }
            SEAM(base + PH_FUP); STAMP(9);
            if (RUN(base + PH_FDN)) {
                {   PH_BEGIN
                    pg8::Gemm g{(const bf16_t*)(ws + WS_FFH), (const bf16_t*)(ws + W_DN), DFF, DFF, DFF}; pg8::PlainOrder S{T / 256, D / 256, F.G, F.bid, 256ll * DFF * 2, 256ll * DFF * 2}; epi::Bf16Sc1 E{hbuf, D, (unsigned)((size_t)T * D * 2)};
                    pg8::gemm_phase(F.lds, g, S, E, F.tid);
                }
                {   PH_BEGIN pg8::PlainOrder S{T / 256, D / 256, F.G, F.bid, 256ll * DFF * 2, 256ll * DFF * 2}; panels_publish_wait(F, (unsigned*)(ws + WS_CTL), 2 * l + 1, S, (unsigned)(D / 256)); }
                {   PH_BEGIN
                    const float* gg = (const float*)a.in[34] + ((size_t)l * 3 + 1) * D; const float* bb = (const float*)a.in[35] + ((size_t)l * 3 + 1) * D;
                    for (int pm = F.bid; pm < T / 256; pm += F.G) ln_panel<0, false, false>(F, a, pm, gg, bb, nullptr);
                }
            }
            asm volatile("s_waitcnt vmcnt(0)" ::: "memory"); __syncthreads(); STAMP(10);
        } else {
            if (RUN(base + PH_MGATH)) { PH_BEGIN moe_gather(F, a); }
            SEAM(base + PH_MGATH); STAMP(11);
            for (int cx = 0; cx < MOE_NCHUNK; ++cx) {
                if (RUN(base + PH_MUP0 + 2 * cx)) { PH_BEGIN int c = cx; asm volatile("" : "+s"(c)); const int* tileexp = (const int*)(ws + SM_TILEEXP);
                    int nt = tileexp[1023] - c * MOE_CHUNK_TILES; nt = nt < 0 ? 0 : (nt > MOE_CHUNK_TILES ? MOE_CHUNK_TILES : nt);
                    pg8::Gemm g{(const bf16_t*)(ws + WS_XS), (const bf16_t*)(ws + W_UP), D, D, D}; MoeUpOrder S{nt, F.G, F.bid, c, tileexp}; epi::SwiGlu E{(bf16_t*)(ws + WS_MH), DFE};
                    pg8::gemm_phase(F.lds, g, S, E, F.tid);
                }
                SEAM(base + PH_MUP0 + 2 * cx); STAMP(12);
                if (RUN(base + PH_MUP0 + 2 * cx + 1)) { PH_BEGIN int c = cx; asm volatile("" : "+s"(c)); const int* tileexp = (const int*)(ws + SM_TILEEXP);
                    int nt = tileexp[1023] - c * MOE_CHUNK_TILES; nt = nt < 0 ? 0 : (nt > MOE_CHUNK_TILES ? MOE_CHUNK_TILES : nt);
                    if (cx < MOE_NCHUNK - MK_TAILSPLIT) {
                        pg8::Gemm g{(const bf16_t*)(ws + WS_MH), (const bf16_t*)(ws + W_DN), DFE, DFE, DFE}; MoeDnOrder S{nt, F.G, F.bid, c, tileexp}; epi::MoeDown E{(bf16_t*)(ws + WS_YB), (const int*)(ws + SM_ROWTOK)};
                        pg8::gemm_phase(F.lds, g, S, E, F.tid);
                    } else {
                        nt = nt > 8 ? 8 : nt;
                        pg8::Gemm g{(const bf16_t*)(ws + WS_MH), (const bf16_t*)(ws + W_DN), 512, DFE, DFE}; MoeDnTailOrder S{nt, F.G, F.bid, tileexp}; epi::F32Grouped E{(float*)(ws + WS_XS), D, (size_t)2048 * D};
                        pg8::gemm_phase(F.lds, g, S, E, F.tid);
                    }
                }
                SEAM(base + PH_MUP0 + 2 * cx + 1); STAMP(13);
            }
#if MK_TAILSPLIT
            if (RUN(base + PH_MUP0 + 2 * MOE_NCHUNK)) { PH_BEGIN moe_tail_finalize(F, a); }
            SEAM(base + PH_MUP0 + 2 * MOE_NCHUNK); STAMP(13);
#endif
        }
        if (RUN(base + PH_PGATE)) {
            if (moe) {
                {   PH_BEGIN
                    const float* gg = (const float*)a.in[34] + ((size_t)l * 3 + 1) * D; const float* bb = (const float*)a.in[35] + ((size_t)l * 3 + 1) * D;
                    for (int pm = F.bid; pm < T / 256; pm += F.G) ln_panel<1, false, false>(F, a, pm, gg, bb, nullptr);
                }
                asm volatile("s_waitcnt vmcnt(0)" ::: "memory"); __syncthreads();
            }
            {   PH_BEGIN
                pg8::Gemm g{xb, (const bf16_t*)(ws + W_GATE), D, D, D}; pg8::PanelOrder S{T / 256, D / 256, F.G, F.bid, S1K, S1K}; epi::SigmoidBias E{(l & 1) ? (bf16_t*)(ws + WS_PLEG) : mix, D, (const float*)a.in[32] + (size_t)l * D};
                pg8::gemm_phase(F.lds, g, S, E, F.tid);
            }
            __syncthreads();
            {   PH_BEGIN
                pg8::Gemm g{(const bf16_t*)(ws + WS_PB), (const bf16_t*)(ws + W_PROJ), PLE, PLE, PLE}; pg8::PanelOrder S{T / 256, D / 256, F.G, F.bid, 256ll * PLE * 2, 256ll * PLE * 2}; epi::MulBf16 E{(l & 1) ? (bf16_t*)(ws + WS_PLEH) : hbuf, (l & 1) ? (bf16_t*)(ws + WS_PLEG) : mix, D};
                pg8::gemm_phase(F.lds, g, S, E, F.tid);
            }
            __syncthreads();
            {   PH_BEGIN
                const float* gg = (const float*)a.in[34] + ((size_t)l * 3 + 2) * D; const float* bb = (const float*)a.in[35] + ((size_t)l * 3 + 2) * D;
                const size_t hoff = (l & 1) ? WS_PLEH : WS_HBUF;
                for (int pm = F.bid; pm < T / 256; pm += F.G) { if (l == DEPTH - 1) ln_panel<0, false, true>(F, a, pm, gg, bb, nullptr, hoff); else ln_panel<0, false, false>(F, a, pm, gg, bb, nullptr, hoff); }
            }
        }
        SEAM(base + PH_PGATE); STAMP(15);
    }
#if MK_PROBE
    if (blockIdx.x == 0) {
        __syncthreads(); asm volatile("s_waitcnt vmcnt(0)" ::: "memory");
        const unsigned long long t1 = ((unsigned long long)PRW[1] << 32) | PRW[0], t0 = ((unsigned long long)PRW[5] << 32) | PRW[4];
        const float tot = (float)(unsigned)(t1 - t0), fa = (float)PRW[2] / tot, fb = (float)PRW[3] / tot;
        Args ae; load_args(ae);
        const int tidp = wave0 * 64 + lane_id_fresh();
        if (tidp == 0) ae.out[0] += 1.0f + 8.0f * fa;
        for (int i = tidp; i < 100000; i += 512) ae.out[1024 + i] += 0.5f * fb;
    }
#endif
#undef RUN
#undef SEAM
}

static bool phase_applies(int gp) {
    if (gp < 2) return true;
    const int l = (gp - 2) / PH_PER_LAYER, ph = (gp - 2) % PH_PER_LAYER; const bool moe = (l & 1) != 0;
    if (ph < PH_LN1) return ph != PH_POST && ph != PH_MIX2 && ph != PH_MIX4;
    if (ph == PH_PGATE) return true;
    if (!moe) return ph == PH_FUP || ph == PH_FDN;
    return ph >= PH_MGATH && ph <= PH_MUP0 + 2 * MOE_NCHUNK;
}
extern "C" void kernel_launch(void* const* d_in, const int* in_sizes, int n_in, void* d_out, int out_size, void* d_ws, size_t ws_size, hipStream_t stream) {
    static int grid = 0;
    if (grid == 0) {
        if (n_in != 36 || out_size != T * D || ws_size < WS_END) { fprintf(stderr, "kernel_launch: unexpected problem (n_in %d out %d ws %zu, need %zu)\n", n_in, out_size, ws_size, (size_t)WS_END); grid = -1; return; }
        int dev = 0, cus = 0, per_cu = 0;
        if (hipGetDevice(&dev) != hipSuccess || hipDeviceGetAttribute(&cus, hipDeviceAttributeMultiprocessorCount, dev) != hipSuccess) { grid = -1; return; }
        if (hipFuncSetAttribute((const void*)mk_fwd, hipFuncAttributeMaxDynamicSharedMemorySize, LDS_BYTES) != hipSuccess) { fprintf(stderr, "kernel_launch: hipFuncSetAttribute failed\n"); grid = -1; return; }
        if (hipOccupancyMaxActiveBlocksPerMultiprocessor(&per_cu, (const void*)mk_fwd, 512, LDS_BYTES) != hipSuccess || per_cu < 1) fprintf(stderr, "kernel_launch: occupancy query reports %d\n", per_cu);
        (void)hipGetLastError();
        grid = cus;
    }
    if (grid < 0) return;
    (void)in_sizes;
    if (hipMemsetAsync((char*)d_ws + WS_CTL, 0, CTL_ZERO_BYTES, stream) != hipSuccess) return;
#if MK_CHECK
    (void)hipMemsetAsync((char*)d_ws + SM_CHK, 0, 256, stream);
#endif
    Args a{};
    for (int i = 0; i < 36; ++i) a.in[i] = d_in[i];
    a.out = (float*)d_out; a.ws = (unsigned char*)d_ws; a.pad = 0;
#if MK_MULTI
    for (int gp = 0; gp < GP_END; ++gp) { if (!phase_applies(gp)) continue; a.gp_lo = gp; a.gp_hi = gp + 1; a.use_bar = 0;
        hipLaunchKernelGGL(mk_fwd, dim3(grid), dim3(512), LDS_BYTES, stream, a);
#if MK_CHECK
        run_checks(a, gp, stream);
#endif
    }
#if MK_CHECK
    hipLaunchKernelGGL(chk_final, dim3(1), dim3(1), 0, stream, a);
#endif
#else
    a.gp_lo = 0; a.gp_hi = GP_END; a.use_bar = 1;
    hipLaunchKernelGGL(mk_fwd, dim3(grid), dim3(512), LDS_BYTES, stream, a);
#endif
}
```

```cpp
#include <hip/hip_runtime.h>
#include <cstdint>
#include <cstdio>
#ifndef MK_TAILSPLIT
#define MK_TAILSPLIT 1
#endif
#ifndef MK_MULTI
#define MK_MULTI 0
#endif
#ifndef MK_CHECK
#define MK_CHECK 0
#endif
#ifndef MK_REP_G1
#define MK_REP_G1 1
#endif
#ifndef MK_REP_G2
#define MK_REP_G2 1
#endif
#ifndef MK_REP_CU
#define MK_REP_CU 1
#endif
#ifndef MK_REP_TK
#define MK_REP_TK 1
#endif
#ifndef MK_REP_WOUT
#define MK_REP_WOUT 1
#endif
#ifndef MK_REP_CONV
#define MK_REP_CONV 1
#endif
#ifndef MK_REP_ST2
#define MK_REP_ST2 1
#endif
#ifndef MK_REP_CARRY
#define MK_REP_CARRY 1
#endif
#ifndef MK_REPCMP
#define MK_REPCMP 1
#endif
#ifndef MK_ALIGN_EPI
#define MK_ALIGN_EPI 1
#endif
#ifndef MK_PROBE
#define MK_PROBE 0
#endif
#ifndef PROBE_A
#define PROBE_A 0
#endif
#ifndef PROBE_B
#define PROBE_B 0
#endif
#ifndef CHK_LAYER
#define CHK_LAYER 15
#endif

#define GAS __attribute__((address_space(1)))
#define LAS __attribute__((address_space(3)))
typedef unsigned short bf16_t;
typedef short bf16x8 __attribute__((ext_vector_type(8)));
typedef float f32x4 __attribute__((ext_vector_type(4)));
typedef float f32x2 __attribute__((ext_vector_type(2)));
typedef float f32x16 __attribute__((ext_vector_type(16)));
typedef unsigned u32x4 __attribute__((ext_vector_type(4)));
typedef unsigned u32x2 __attribute__((ext_vector_type(2)));

constexpr int NB = 16, SEQ = 4096, T = NB * SEQ, D = 1024, DEPTH = 4;
constexpr int INW = 2072, INP = 2304;
constexpr int ZKV = 512, ZG = 1280, ZC = 1304, ZS = 1816;
constexpr int DFF = 2816, DFE = 3584, NEXP = 8, PLE = 256;
constexpr int NCMP = 255;
constexpr int S5LC = 32, S5NCH = SEQ / S5LC, S5K = S5LC * 16 + 128;
constexpr float ALPHA = 1.6817928305074290f;
constexpr float LN_EPS = 1e-5f;
constexpr float QSCALE = 0.125f * 1.4426950408889634f;
constexpr float NEGF = -1e30f;
constexpr int MOE_TILES_MAX = 520, MOE_CHUNK_TILES = 128, MOE_NCHUNK = 5;

typedef __bf16 bf16x2_t __attribute__((ext_vector_type(2)));
__device__ __forceinline__ unsigned cvt_pk_bf16(float lo, float hi) { f32x2 v = {lo, hi}; const bf16x2_t b = __builtin_convertvector(v, bf16x2_t); return __builtin_bit_cast(unsigned, b); }
__device__ __forceinline__ bf16_t f2bf(float f) { return (bf16_t)(cvt_pk_bf16(f, 0.f) & 0xffffu); }
__device__ __forceinline__ float bf2f(unsigned v) { return __uint_as_float(v << 16); }
__device__ __forceinline__ float bflo(unsigned w) { return __uint_as_float(w << 16); }
__device__ __forceinline__ float bfhi(unsigned w) { return __uint_as_float(w & 0xffff0000u); }
__device__ __forceinline__ float fast_exp2(float x) { return __builtin_amdgcn_exp2f(x); }
__device__ __forceinline__ float fast_rcp(float x) { return __builtin_amdgcn_rcpf(x); }
__device__ __forceinline__ float sigmoidf_(float x) { return fast_rcp(1.0f + fast_exp2(-1.4426950408889634f * x)); }
__device__ __forceinline__ float siluf_(float x) { return x * sigmoidf_(x); }
__device__ __forceinline__ float gelu_tanh(float x) { const float u = 0.7978845608028654f * (x + 0.044715f * x * x * x); return x * sigmoidf_(2.0f * u); }
__device__ __forceinline__ int lane_id_fresh() { unsigned z = 0u; asm volatile("" : "+v"(z)); return (int)__builtin_amdgcn_mbcnt_hi(~0u, __builtin_amdgcn_mbcnt_lo(~0u, z)); }
template <int MASK> __device__ __forceinline__ float xshfl(float v) {
    if (MASK == 1) return __uint_as_float((unsigned)__builtin_amdgcn_update_dpp(0, (int)__float_as_uint(v), 0xB1, 0xF, 0xF, true));
    if (MASK == 2) return __uint_as_float((unsigned)__builtin_amdgcn_update_dpp(0, (int)__float_as_uint(v), 0x4E, 0xF, 0xF, true));
    if (MASK == 32) { const unsigned u = __float_as_uint(v); auto rr = __builtin_amdgcn_permlane32_swap(u, u, false, false); return __uint_as_float((rr[0] == u) ? rr[1] : rr[0]); }
    return __uint_as_float((unsigned)__builtin_amdgcn_ds_swizzle((int)__float_as_uint(v), 0x1f | (MASK << 10)));
}
__device__ __forceinline__ float xsum32(float v) { const unsigned u = __float_as_uint(v); auto rr = __builtin_amdgcn_permlane32_swap(u, u, false, false); return __uint_as_float(rr[0]) + __uint_as_float(rr[1]); }
__device__ __forceinline__ float xsum16(float v) { const unsigned u = __float_as_uint(v); auto rr = __builtin_amdgcn_permlane16_swap(u, u, false, false); return __uint_as_float(rr[0]) + __uint_as_float(rr[1]); }
__device__ __forceinline__ float swapsum32(float a, float b) { auto rr = __builtin_amdgcn_permlane32_swap(__float_as_uint(a), __float_as_uint(b), false, false); return __uint_as_float(rr[0]) + __uint_as_float(rr[1]); }
__device__ __forceinline__ float swapsum16(float a, float b) { auto rr = __builtin_amdgcn_permlane16_swap(__float_as_uint(a), __float_as_uint(b), false, false); return __uint_as_float(rr[0]) + __uint_as_float(rr[1]); }
__device__ __forceinline__ float dpp_half_mirror(float v) { return __uint_as_float((unsigned)__builtin_amdgcn_update_dpp(0, (int)__float_as_uint(v), 0x141, 0xF, 0xF, true)); }
__device__ __forceinline__ float wave_sum(float v) {
    v += xshfl<1>(v); v += xshfl<2>(v);
    v += __uint_as_float((unsigned)__builtin_amdgcn_update_dpp(0, (int)__float_as_uint(v), 0x141, 0xF, 0xF, true));
    v += __uint_as_float((unsigned)__builtin_amdgcn_update_dpp(0, (int)__float_as_uint(v), 0x140, 0xF, 0xF, true));
    v = xsum16(v); v = xsum32(v);
    return v;
}
#define LDS_WAIT() asm volatile("s_waitcnt lgkmcnt(0)" ::: "memory")
#define VM_WAIT() asm volatile("s_waitcnt vmcnt(0)" ::: "memory")

namespace pg8 {
constexpr int BM = 256, BK = 64, HALF = 128, HTB = HALF * BK * 2, STAGE_BYTES = 8 * HTB, NXCD = 8, WGM = 8;
__host__ __device__ __forceinline__ int lds_byte(int r, int c) { const int st = (r >> 4) * 2 + (c >> 5), rr = r & 15, cc = c & 31, ob = rr * 64 + cc * 2; return st * 1024 + (ob ^ (((ob >> 9) & 1) << 5)); }
__host__ __device__ __forceinline__ void stage_rc(int b, int& R, int& C) { const int st = b / 1024, sb = b % 1024, swz = sb ^ (((sb >> 9) & 1) << 5); R = (st >> 1) * 16 + swz / 64; C = (st & 1) * 32 + (swz % 64) / 2; }
__host__ __device__ __forceinline__ int perm32(int rho) { const int n = rho >> 4, i = rho & 15; return 8 * (i >> 2) + 4 * n + (i & 3); }

struct Unit { int pm, pn; long long offA, offB; int aux; };
struct Gemm { const bf16_t* A; const bf16_t* Bt; int K, lda, ldb; };

__device__ __forceinline__ bool static_tile(int i, int G, int c, int nM, int nN, int& pm, int& pn) {
    const int nwg = nM * nN; const long L = (long)i * G + c; if (L >= nwg) return false;
    int wgid = (int)L; { const int q = nwg / NXCD, r = nwg % NXCD, xcd = wgid % NXCD, off = wgid / NXCD; wgid = (xcd < r ? xcd * (q + 1) : r * (q + 1) + (xcd - r) * q) + off; }
    const int nig = WGM * nN, gid = wgid / nig, fm = gid * WGM, gsz = (nM - fm) < WGM ? (nM - fm) : WGM;
    pm = fm + ((wgid % nig) % gsz); pn = (wgid % nig) / gsz; return true;
}
struct PlainOrder {
    int nM, nN, G, c; long long sA, sB;
    __device__ __forceinline__ bool next(int i, Unit& u) const { if (!static_tile(i, G, c, nM, nN, u.pm, u.pn)) return false; u.offA = (long long)u.pm * sA; u.offB = (long long)u.pn * sB; u.aux = 0; return true; }
};
struct PanelOrder {
    int nM, nN, G, c; long long sA, sB;
    __device__ __forceinline__ bool next(int i, Unit& u) const { const int pm = c + G * (i / nN); if (pm >= nM) return false; u.pm = pm; u.pn = i % nN; u.offA = (long long)pm * sA; u.offB = (long long)u.pn * sB; u.aux = 0; return true; }
};
struct ListOrder {
    int n, pm, aux; long long offA0, offB0, sB;
    __device__ __forceinline__ bool next(int i, Unit& u) const { if (i >= n) return false; u.pm = pm; u.pn = i; u.aux = aux; u.offA = offA0; u.offB = offB0 + (long long)i * sB; return true; }
};
struct GroupedOrder {
    int ng, nM, nN, G, c; long long sA, sB, gA, gB;
    __device__ __forceinline__ bool next(int i, Unit& u) const {
        const long L = (long)i * G + c; const int per = nM * nN; if (L >= (long)ng * per) return false;
        const int gi = (int)(L / per), r = (int)(L % per); u.pm = r / nN; u.pn = r % nN; u.aux = gi;
        u.offA = (long long)gi * gA + (long long)u.pm * sA; u.offB = (long long)gi * gB + (long long)u.pn * sB; return true; }
};

template <class Epi, class Sched>
__device__ __forceinline__ void gemm_phase(LAS unsigned char* lds, const Gemm g, const Sched& S, const Epi& E, int tid_in) {
    int tid_ = tid_in; asm volatile("" : "+v"(tid_));
    const int tid = tid_, wid = __builtin_amdgcn_readfirstlane(tid >> 6), lane = tid & 63, wr = wid >> 2, wc = wid & 3, fr = lane & 15, fq = lane >> 4;
    int K_ = g.K; asm volatile("" : "+s"(K_));
    const int K = K_, nt = K / BK; (void)K;
    unsigned voffA[2], voffB[2];
#pragma unroll
    for (int i = 0; i < 2; ++i) { int R, C; stage_rc(tid * 16 + i * 8192, R, C); const int Rb = Epi::PERM ? ((R & ~31) + perm32(R & 31)) : R;
        voffA[i] = (unsigned)(R * g.lda + C) * 2u; voffB[i] = (unsigned)(Rb * g.ldb + C) * 2u; }
    const size_t kstep = (size_t)(BK * 2);
    const size_t hstepA = (size_t)HALF * g.lda * 2, hstepB = (size_t)HALF * g.ldb * 2;
    const unsigned ldsw = (unsigned)wid * 1024u;
    const int aoff = lds_byte(wr * 64 + fr, fq * 8), boff = lds_byte(wc * 32 + fr, fq * 8);
#define PG8_SA(b, h) (((b) * 2 + (h)) * HTB)
#define PG8_SB(b, h) ((4 + (b) * 2 + (h)) * HTB)
#define PG8_STAGE(bufoff, gbase, voff) do { _Pragma("unroll") for (int _i = 0; _i < 2; ++_i) \
        __builtin_amdgcn_global_load_lds((const unsigned*)((const char*)(gbase) + (voff)[_i]), (LAS unsigned*)(lds + (bufoff) + ldsw + _i * 8192), 16, 0, 0); } while (0)
#define PG8_LDA(dst, b, h) do { _Pragma("unroll") for (int m = 0; m < 4; ++m) _Pragma("unroll") for (int k = 0; k < 2; ++k) dst[m][k] = *(const LAS bf16x8*)(lds + PG8_SA(b, h) + aoff + m * 2048 + k * 1024); } while (0)
#define PG8_LDB(dst, b, h) do { _Pragma("unroll") for (int n = 0; n < 2; ++n) _Pragma("unroll") for (int k = 0; k < 2; ++k) dst[n][k] = *(const LAS bf16x8*)(lds + PG8_SB(b, h) + boff + n * 2048 + k * 1024); } while (0)
#define PG8_MMA(ai, bj, At, Bt) do { __builtin_amdgcn_s_setprio(1); _Pragma("unroll") for (int m = 0; m < 4; ++m) _Pragma("unroll") for (int n = 0; n < 2; ++n) _Pragma("unroll") for (int k = 0; k < 2; ++k) \
        acc[ai][bj][m][n] = __builtin_amdgcn_mfma_f32_16x16x32_bf16(Bt[n][k], At[m][k], acc[ai][bj][m][n], 0, 0, 0); __builtin_amdgcn_s_setprio(0); } while (0)
#define PG8_WAIT_V(n) asm volatile("s_waitcnt vmcnt(" #n ")" ::: "memory")
#define PG8_WAIT_L(n) asm volatile("s_waitcnt lgkmcnt(" #n ")" ::: "memory")
#define PG8_BAR __builtin_amdgcn_s_barrier()
#define PG8_SCHED __builtin_amdgcn_sched_barrier(0)
    Unit cur, nxt; int ui = 0;
    if (!S.next(0, cur)) return;
    f32x4 acc[2][2][4][2];
#pragma unroll
    for (int a = 0; a < 2; ++a)
#pragma unroll
        for (int b = 0; b < 2; ++b)
#pragma unroll
            for (int m = 0; m < 4; ++m)
#pragma unroll
                for (int n = 0; n < 2; ++n) acc[a][b][m][n] = (f32x4){0.f, 0.f, 0.f, 0.f};
    bf16x8 At[4][2], B0[2][2], B1[2][2];
    const char* cA = (const char*)g.A + cur.offA; const char* cB = (const char*)g.Bt + cur.offB;
    PG8_STAGE(PG8_SB(0, 0), cB, voffB); PG8_STAGE(PG8_SB(0, 1), cB + hstepB, voffB); PG8_STAGE(PG8_SA(0, 0), cA, voffA); PG8_STAGE(PG8_SA(0, 1), cA + hstepA, voffA);
    if (wr == 1) PG8_BAR;
    PG8_WAIT_V(2); PG8_BAR;
    PG8_STAGE(PG8_SB(1, 0), cB + kstep, voffB); PG8_STAGE(PG8_SA(1, 0), cA + kstep, voffA); PG8_STAGE(PG8_SB(1, 1), cB + hstepB + kstep, voffB);
    PG8_WAIT_V(6); PG8_BAR;
    for (;;) {
        const bool has_next = S.next(ui + 1, nxt);
        const char* nA = has_next ? (const char*)g.A + nxt.offA : cA; const char* nB = has_next ? (const char*)g.Bt + nxt.offB : cB;
        for (int t = 0; t < nt; t += 2) {
            const bool last = (t == nt - 2);
            const char* a1 = cA + (size_t)(t + 1) * kstep;
            const char* a2 = last ? nA : cA + (size_t)(t + 2) * kstep; const char* b2 = last ? nB : cB + (size_t)(t + 2) * kstep;
            const char* a3 = a2 + kstep; const char* b3 = b2 + kstep;
            PG8_LDB(B0, 0, 0); PG8_LDB(B1, 0, 1); PG8_SCHED; PG8_LDA(At, 0, 0); PG8_STAGE(PG8_SA(1, 1), a1 + hstepA, voffA);
            PG8_WAIT_V(8); PG8_WAIT_L(0); PG8_BAR; PG8_MMA(0, 0, At, B0); PG8_MMA(0, 1, At, B1); PG8_BAR; PG8_SCHED;
            PG8_LDA(At, 0, 1); PG8_STAGE(PG8_SB(0, 0), b2, voffB); PG8_STAGE(PG8_SB(0, 1), b2 + hstepB, voffB); PG8_STAGE(PG8_SA(0, 0), a2, voffA);
            PG8_WAIT_V(8); PG8_WAIT_L(0); PG8_BAR; PG8_MMA(1, 0, At, B0); PG8_MMA(1, 1, At, B1); PG8_BAR; PG8_SCHED;
            PG8_LDB(B0, 1, 0); PG8_LDB(B1, 1, 1); PG8_SCHED; PG8_LDA(At, 1, 0); PG8_STAGE(PG8_SA(0, 1), a2 + hstepA, voffA);
            PG8_WAIT_V(8); PG8_WAIT_L(0); PG8_BAR; PG8_MMA(0, 0, At, B0); PG8_MMA(0, 1, At, B1); PG8_BAR; PG8_SCHED;
            PG8_LDA(At, 1, 1); PG8_STAGE(PG8_SB(1, 0), b3, voffB); PG8_STAGE(PG8_SB(1, 1), b3 + hstepB, voffB); PG8_STAGE(PG8_SA(1, 0), a3, voffA);
            PG8_WAIT_V(8); PG8_WAIT_L(0); PG8_BAR; PG8_MMA(1, 0, At, B0); PG8_MMA(1, 1, At, B1); PG8_BAR; PG8_SCHED;
        }
#if MK_ALIGN_EPI
        if (wr == 0) PG8_BAR;
#endif
        { int fr_ = fr, fq_ = fq; asm volatile("" : "+v"(fr_), "+v"(fq_));
          E(acc, cur, wr, wc, fr_, fq_); }
        if (!has_next) break;
#pragma unroll
        for (int a = 0; a < 2; ++a)
#pragma unroll
            for (int b = 0; b < 2; ++b)
#pragma unroll
                for (int m = 0; m < 4; ++m)
#pragma unroll
                    for (int n = 0; n < 2; ++n) acc[a][b][m][n] = (f32x4){0.f, 0.f, 0.f, 0.f};
        cur = nxt; cA = nA; cB = nB; ++ui;
#if MK_ALIGN_EPI
        if (wr == 1) PG8_BAR;
#endif
    }
    PG8_WAIT_V(0);
#if !MK_ALIGN_EPI
    if (wr == 0) PG8_BAR;
#endif
    PG8_BAR;
#undef PG8_SA
#undef PG8_SB
#undef PG8_STAGE
#undef PG8_LDA
#undef PG8_LDB
#undef PG8_MMA
#undef PG8_WAIT_V
#undef PG8_WAIT_L
#undef PG8_BAR
#undef PG8_SCHED
}
}

#define XB_TMO      128
#define XB_XCNT(j)  (256  + 64 * (j))
#define XB_XSUB(j)  (1280 + 64 * (j))
#define XB_XGEN(j)  (2304 + 64 * (j))
#define XB_TOP      3328
#define XB_TOPGEN   3392
#define XCD_BAR_WORDS 3456
#define XB_SPIN_CAP (1u << 20)
__device__ __forceinline__ unsigned xb_ld(unsigned* p)              { return __hip_atomic_load(p, __ATOMIC_RELAXED, __HIP_MEMORY_SCOPE_AGENT); }
__device__ __forceinline__ unsigned xb_add(unsigned* p, unsigned v) { return __hip_atomic_fetch_add(p, v, __ATOMIC_RELAXED, __HIP_MEMORY_SCOPE_AGENT); }
__device__ __forceinline__ unsigned xb_xcc_id() { return (unsigned)__builtin_amdgcn_s_getreg((3 << 11) | 20) & 0xFu; }
#define XB_SPIN(cond, bar) do { unsigned _sp = 0; while (cond) { __builtin_amdgcn_s_sleep(1); \
    if ((++_sp & 255u) == 0u) { if (xb_ld(&(bar)[XB_TMO])) break; if (_sp > XB_SPIN_CAP) { atomicAdd(&(bar)[XB_TMO], 1u); break; } } } } while (0)
struct XcdBarrier { unsigned* bar; unsigned x; volatile LAS unsigned* st; };
__device__ __forceinline__ XcdBarrier xcd_barrier_post(unsigned* bar, volatile LAS unsigned* st) {
    XcdBarrier b; b.bar = bar; b.x = xb_xcc_id(); b.st = st;
    if (threadIdx.x == 0) (void)xb_add(&bar[XB_XCNT(b.x)], 1u);
    return b;
}
__device__ __forceinline__ void xcd_barrier_complete(unsigned* bar, unsigned x, unsigned& nloc, unsigned& nx) {
    const unsigned G = gridDim.x * gridDim.y * gridDim.z;
    unsigned sum, cnt, mine, sp = 0u;
    for (;;) {
        sum = 0u; cnt = 0u; mine = 0u;
#pragma unroll 1
        for (unsigned j = 0; j < 16; ++j) { const unsigned c = xb_ld(&bar[XB_XCNT(j)]); sum += c; cnt += (c > 0u) ? 1u : 0u; mine = (j == x) ? c : mine; }
        if (sum == G) break;
        __builtin_amdgcn_s_sleep(1);
        if ((++sp & 255u) == 0u) { if (xb_ld(&bar[XB_TMO])) break; if (sp > XB_SPIN_CAP) { atomicAdd(&bar[XB_TMO], 1u); break; } }
    }
    nloc = mine > 0u ? mine : 1u; nx = cnt > 0u ? cnt : 1u;
}
__device__ __forceinline__ void xcd_barrier(const XcdBarrier& b, int wave_id) {
    asm volatile("s_waitcnt vmcnt(0)" ::: "memory");
    __syncthreads();
    if (wave_id == 0 && lane_id_fresh() == 0) {
        unsigned* bar = b.bar; asm volatile("" : "+s"(bar));
        __builtin_amdgcn_s_waitcnt(0);
        unsigned nloc = b.st[0], nx = b.st[1];
        if (nloc == 0u) { xcd_barrier_complete(bar, b.x, nloc, nx); b.st[0] = nloc; b.st[1] = nx; }
        const unsigned old = xb_add(&bar[XB_XSUB(b.x)], 1u);
        const unsigned gen = old / nloc;
        if (old + 1u == (gen + 1u) * nloc) {
            __builtin_amdgcn_fence(__ATOMIC_RELEASE, "agent");
            asm volatile("s_waitcnt vmcnt(0)" ::: "memory");
            const unsigned og = xb_add(&bar[XB_TOP], 1u);
            const unsigned tg = og / nx;
            if (og + 1u == (tg + 1u) * nx) xb_add(&bar[XB_TOPGEN], 1u);
            else XB_SPIN(xb_ld(&bar[XB_TOPGEN]) == tg, bar);
            __builtin_amdgcn_fence(__ATOMIC_ACQUIRE, "agent");
            xb_add(&bar[XB_XGEN(b.x)], 1u);
            asm volatile("s_waitcnt vmcnt(0)" ::: "memory");
        } else {
            XB_SPIN(xb_ld(&bar[XB_XGEN(b.x)]) == gen, bar);
            __builtin_amdgcn_fence(__ATOMIC_ACQUIRE, "agent");
            asm volatile("s_waitcnt vmcnt(0)" ::: "memory");
        }
    }
    __syncthreads();
}
namespace nsa {
constexpr int PITCH = 144, TILE_LDS = 64 * PITCH;
__device__ __forceinline__ int crow(int r, int hi) { return (r & 3) + 8 * (r >> 2) + 4 * hi; }
__device__ __forceinline__ int vslot(int kk) { return (kk & 0x33) | (((kk >> 2) & 1) << 3) | (((kk >> 3) & 1) << 2); }

struct Lane { int lane, c, hi, wid, tid; };

__device__ __forceinline__ void qk_tile(f32x16& p0, f32x16& p1, const LAS unsigned char* Ks, const bf16x8 (&qr)[4], float bias, const Lane& L) {
#pragma unroll
    for (int r = 0; r < 16; ++r) { p0[r] = bias; p1[r] = bias; }
    const LAS unsigned char* kb = Ks + L.c * PITCH + L.hi * 16;
#pragma unroll
    for (int d0 = 0; d0 < 4; ++d0) {
        const bf16x8 k0 = *(const LAS bf16x8*)(kb + d0 * 32);
        const bf16x8 k1 = *(const LAS bf16x8*)(kb + 32 * PITCH + d0 * 32);
        p0 = __builtin_amdgcn_mfma_f32_32x32x16_bf16(k0, qr[d0], p0, 0, 0, 0);
        p1 = __builtin_amdgcn_mfma_f32_32x32x16_bf16(k1, qr[d0], p1, 0, 0, 0);
    }
}
__device__ __forceinline__ void qk_tile_c(f32x16& p0, f32x16& p1, const LAS unsigned char* Ks, const bf16x8 (&qr)[4], const f32x16& cv, const Lane& L) {
    const LAS unsigned char* kb = Ks + L.c * PITCH + L.hi * 16;
    { const bf16x8 k0 = *(const LAS bf16x8*)(kb); const bf16x8 k1 = *(const LAS bf16x8*)(kb + 32 * PITCH);
      p0 = __builtin_amdgcn_mfma_f32_32x32x16_bf16(k0, qr[0], cv, 0, 0, 0); p1 = __builtin_amdgcn_mfma_f32_32x32x16_bf16(k1, qr[0], cv, 0, 0, 0); }
#pragma unroll
    for (int d0 = 1; d0 < 4; ++d0) {
        const bf16x8 k0 = *(const LAS bf16x8*)(kb + d0 * 32);
        const bf16x8 k1 = *(const LAS bf16x8*)(kb + 32 * PITCH + d0 * 32);
        p0 = __builtin_amdgcn_mfma_f32_32x32x16_bf16(k0, qr[d0], p0, 0, 0, 0);
        p1 = __builtin_amdgcn_mfma_f32_32x32x16_bf16(k1, qr[d0], p1, 0, 0, 0);
    }
}
__device__ __forceinline__ void mask_range(f32x16& p0, f32x16& p1, int lo, int hi_, int hi) {
#pragma unroll
    for (int r = 0; r < 16; ++r) { const int k0 = crow(r, hi), k1 = k0 + 32;
        if (k0 <= lo || k0 > hi_) p0[r] = NEGF;
        if (k1 <= lo || k1 > hi_) p1[r] = NEGF; }
}
__device__ __forceinline__ float tile_max(const f32x16& p0, const f32x16& p1) {
    float a = fmaxf(p0[0], p1[0]);
#pragma unroll
    for (int r = 1; r < 16; ++r) a = fmaxf(a, fmaxf(p0[r], p1[r]));
    return fmaxf(a, xshfl<32>(a));
}
__device__ __forceinline__ void pv_tile(f32x16& o0, f32x16& o1, const LAS unsigned char* Vs, const f32x16& p0, const f32x16& p1, const Lane& L) {
    const LAS unsigned char* vb = Vs + L.c * PITCH + L.hi * 16;
#pragma unroll
    for (int s = 0; s < 4; ++s) {
        u32x4 w;
        if (s < 2) { const int b = 8 * (s & 1); w.x = cvt_pk_bf16(p0[b], p0[b + 1]); w.y = cvt_pk_bf16(p0[b + 2], p0[b + 3]); w.z = cvt_pk_bf16(p0[b + 4], p0[b + 5]); w.w = cvt_pk_bf16(p0[b + 6], p0[b + 7]); }
        else       { const int b = 8 * (s & 1); w.x = cvt_pk_bf16(p1[b], p1[b + 1]); w.y = cvt_pk_bf16(p1[b + 2], p1[b + 3]); w.z = cvt_pk_bf16(p1[b + 4], p1[b + 5]); w.w = cvt_pk_bf16(p1[b + 6], p1[b + 7]); }
        const bf16x8 pf = __builtin_bit_cast(bf16x8, w);
        const bf16x8 v0 = *(const LAS bf16x8*)(vb + s * 32);
        const bf16x8 v1 = *(const LAS bf16x8*)(vb + 32 * PITCH + s * 32);
        o0 = __builtin_amdgcn_mfma_f32_32x32x16_bf16(v0, pf, o0, 0, 0, 0);
        o1 = __builtin_amdgcn_mfma_f32_32x32x16_bf16(v1, pf, o1, 0, 0, 0);
        if (s & 1) __builtin_amdgcn_sched_barrier(0);
    }
}
__device__ __forceinline__ void softmax_pv(f32x16& p0, f32x16& p1, f32x16& o0, f32x16& o1, float& m, float& l, const LAS unsigned char* Vs, const Lane& L) {
    const float mx = tile_max(p0, p1), mn = fmaxf(m, mx), alpha = fast_exp2(m - mn); m = mn;
    float ls = 0.f;
#pragma unroll
    for (int r = 0; r < 16; ++r) { p0[r] = fast_exp2(p0[r] - mn); p1[r] = fast_exp2(p1[r] - mn); ls += p0[r] + p1[r]; }
    l = l * alpha + ls;
#pragma unroll
    for (int r = 0; r < 16; ++r) { o0[r] *= alpha; o1[r] *= alpha; }
    pv_tile(o0, o1, Vs, p0, p1, L);
}
__device__ __forceinline__ int stage_off(int tid) { return (tid >> 3) * PITCH + (tid & 7) * 16; }

__device__ __forceinline__ void load_q(bf16x8 (&qr)[4], const bf16_t* qbuf, long tok, int head, int hi) {
    const bf16_t* qp = qbuf + tok * 512 + head * 64 + hi * 8;
#pragma unroll
    for (int d0 = 0; d0 < 4; ++d0) qr[d0] = *(const bf16x8*)(qp + d0 * 16);
}

__device__ __forceinline__ u32x4 vload(const bf16_t* Vt, int j, const Lane& L) { return *(const u32x4*)((const char*)Vt + (size_t)j * 8192 + L.lane * 128 + L.wid * 16); }
__device__ __forceinline__ void vstore(LAS unsigned char* Vs, const u32x4 v, const Lane& L) {
    LAS unsigned short* p = (LAS unsigned short*)(Vs + (8 * L.wid) * PITCH) + vslot(L.lane);
    p[0 * (PITCH / 2)] = (unsigned short)(v.x & 0xffffu); p[1 * (PITCH / 2)] = (unsigned short)(v.x >> 16); p[2 * (PITCH / 2)] = (unsigned short)(v.y & 0xffffu); p[3 * (PITCH / 2)] = (unsigned short)(v.y >> 16);
    p[4 * (PITCH / 2)] = (unsigned short)(v.z & 0xffffu); p[5 * (PITCH / 2)] = (unsigned short)(v.z >> 16); p[6 * (PITCH / 2)] = (unsigned short)(v.w & 0xffffu); p[7 * (PITCH / 2)] = (unsigned short)(v.w >> 16);
}
template <int MODE>
__device__ __forceinline__ void run_branch(f32x16& o0, f32x16& o1, float& mref, float& l, const bf16_t* Kt  , const bf16_t* Vt  ,
                                           int jlo, int jhi, int qb, int qrel, unsigned long long selw, const bf16x8 (&qr)[4], LAS unsigned char* lds, const Lane& L) {
    LAS unsigned char* Kbuf = lds; LAS unsigned char* Vbuf = lds + 2 * TILE_LDS;
    const int so = stage_off(L.tid);
    u32x4 kreg = *(const u32x4*)((const char*)Kt + (size_t)jlo * 8192 + L.tid * 16);
    u32x4 vreg = vload(Vt, jlo, L);
    *(LAS u32x4*)(Kbuf + so) = kreg; vstore(Vbuf, vreg, L);
    __syncthreads();
    f32x16 cv;
#pragma unroll
    for (int r = 0; r < 16; ++r) cv[r] = -mref;
    for (int j = jlo; j <= jhi; ++j) {
        const int cur = (j - jlo) & 1;
        if (j < jhi) { kreg = *(const u32x4*)((const char*)Kt + (size_t)(j + 1) * 8192 + L.tid * 16); vreg = vload(Vt, j + 1, L); }
        f32x16 p0, p1;
        if (MODE == 0) { const float cb = ((selw >> j) & 1ull) ? -mref : NEGF;
#pragma unroll
            for (int r = 0; r < 16; ++r) cv[r] = cb; }
        qk_tile_c(p0, p1, Kbuf + cur * TILE_LDS, qr, cv, L);
        if (j == qb) mask_range(p0, p1, -1, qrel, L.hi);
        if (MODE == 1 && j == qb - 8) mask_range(p0, p1, qrel, 64, L.hi);
        const float mx = tile_max(p0, p1);
        if (__any(mx > 8.0f)) {
            const float dl = fmaxf(mx, 0.f), f = fast_exp2(-dl); mref += dl; l *= f;
#pragma unroll
            for (int r = 0; r < 16; ++r) { o0[r] *= f; o1[r] *= f; p0[r] -= dl; p1[r] -= dl; }
            if (MODE == 1) {
#pragma unroll
                for (int r = 0; r < 16; ++r) cv[r] = -mref; }
        }
        float ls = 0.f;
#pragma unroll
        for (int r = 0; r < 16; ++r) { p0[r] = fast_exp2(p0[r]); p1[r] = fast_exp2(p1[r]); ls += p0[r] + p1[r]; }
        l += ls;
        pv_tile(o0, o1, Vbuf + cur * TILE_LDS, p0, p1, L);
        if (j < jhi) { *(LAS u32x4*)(Kbuf + (cur ^ 1) * TILE_LDS + so) = kreg; vstore(Vbuf + (cur ^ 1) * TILE_LDS, vreg, L); }
        __syncthreads();
    }
}
struct SoftState { float mref, l; };
__device__ __forceinline__ void softmax_step2(f32x16& p0, f32x16& p1, f32x16& o0, f32x16& o1, SoftState& st, bool sel, bf16x8 (&pf)[4]) {
    if (__any(st.mref != 0.f)) {
#pragma unroll
        for (int r = 0; r < 16; ++r) { p0[r] -= st.mref; p1[r] -= st.mref; } }
    float ls = 0.f;
#pragma unroll
    for (int r = 0; r < 16; ++r) { p0[r] = fast_exp2(p0[r]); p1[r] = fast_exp2(p1[r]); ls += p0[r] + p1[r]; }
    ls = sel ? ls : 0.f; st.l += ls;
#pragma unroll
    for (int s = 0; s < 4; ++s) { u32x4 w; const int b = 8 * (s & 1);
        if (s < 2) { w.x = cvt_pk_bf16(p0[b], p0[b + 1]); w.y = cvt_pk_bf16(p0[b + 2], p0[b + 3]); w.z = cvt_pk_bf16(p0[b + 4], p0[b + 5]); w.w = cvt_pk_bf16(p0[b + 6], p0[b + 7]); }
        else       { w.x = cvt_pk_bf16(p1[b], p1[b + 1]); w.y = cvt_pk_bf16(p1[b + 2], p1[b + 3]); w.z = cvt_pk_bf16(p1[b + 4], p1[b + 5]); w.w = cvt_pk_bf16(p1[b + 6], p1[b + 7]); }
        if (!sel) w = (u32x4){0u, 0u, 0u, 0u};
        pf[s] = __builtin_bit_cast(bf16x8, w); }
}
__device__ __forceinline__ void renorm_step(f32x16& o0, f32x16& o1, SoftState& st) {
    if (__any(st.l > 1.0995116e12f)) { const bool big = st.l > 1.0995116e12f; const float f = big ? 9.094947e-13f : 1.0f; st.mref += big ? 40.f : 0.f; st.l *= f;
#pragma unroll
        for (int r = 0; r < 16; ++r) { o0[r] *= f; o1[r] *= f; } }
}
template <int MODE>
__device__ __forceinline__ void run_branch2(f32x16& oa0, f32x16& oa1, SoftState& sa, f32x16& ob0, f32x16& ob1, SoftState& sb, const bf16_t* Kt, const bf16_t* Vt, int jlo, int jhi, int qbw, int qrela,
                                            const LAS unsigned long long* selp  , const bf16x8 (&qa)[4], const bf16x8 (&qbf)[4], LAS unsigned char* lds, const Lane& L) {
    LAS unsigned char* Kbuf = lds; LAS unsigned char* Vbuf = lds + 2 * TILE_LDS;
    const int so = stage_off(L.tid);
    {   const u32x4 kreg = *(const u32x4*)((const char*)Kt + (size_t)jlo * 8192 + L.tid * 16); const u32x4 vreg = vload(Vt, jlo, L);
        *(LAS u32x4*)(Kbuf + so) = kreg; vstore(Vbuf, vreg, L); }
    __syncthreads();
    for (int j = jlo; j <= jhi; ++j) {
        const int cur = (j - jlo) & 1;
        const bool act = (j <= qbw) && (MODE == 0 || j >= qbw - 8);
        u32x4 kreg, vreg;
        bf16x8 fa[4], fb[4];
        if (act) {
            f32x16 pa0, pa1, pb0, pb1;
#pragma unroll
            for (int r = 0; r < 16; ++r) { pa0[r] = 0.f; pa1[r] = 0.f; pb0[r] = 0.f; pb1[r] = 0.f; }
            const LAS unsigned char* kb = Kbuf + cur * TILE_LDS + L.c * PITCH + L.hi * 16;
#pragma unroll
            for (int d0 = 0; d0 < 4; ++d0) { const bf16x8 k0 = *(const LAS bf16x8*)(kb + d0 * 32); const bf16x8 k1 = *(const LAS bf16x8*)(kb + 32 * PITCH + d0 * 32);
                pa0 = __builtin_amdgcn_mfma_f32_32x32x16_bf16(k0, qa[d0], pa0, 0, 0, 0); pa1 = __builtin_amdgcn_mfma_f32_32x32x16_bf16(k1, qa[d0], pa1, 0, 0, 0);
                pb0 = __builtin_amdgcn_mfma_f32_32x32x16_bf16(k0, qbf[d0], pb0, 0, 0, 0); pb1 = __builtin_amdgcn_mfma_f32_32x32x16_bf16(k1, qbf[d0], pb1, 0, 0, 0); }
            if (j == qbw) { mask_range(pa0, pa1, -1, qrela, L.hi); mask_range(pb0, pb1, -1, qrela + 8, L.hi); }
            if (MODE == 1 && j == qbw - 8) { mask_range(pa0, pa1, qrela, 64, L.hi); mask_range(pb0, pb1, qrela + 8, 64, L.hi); }
            bool sela = true, selb = true;
            if (MODE == 0) { sela = (selp[0] >> j) & 1ull; selb = (selp[1] >> j) & 1ull; }
            softmax_step2(pa0, pa1, oa0, oa1, sa, sela, fa);
            __builtin_amdgcn_sched_barrier(0);
            softmax_step2(pb0, pb1, ob0, ob1, sb, selb, fb);
            __builtin_amdgcn_sched_barrier(0);
        }
        if (j < jhi) { kreg = *(const u32x4*)((const char*)Kt + (size_t)(j + 1) * 8192 + L.tid * 16); vreg = vload(Vt, j + 1, L); }
        if (act) {
            const LAS unsigned char* vb = Vbuf + cur * TILE_LDS + L.c * PITCH + L.hi * 16;
#pragma unroll
            for (int s = 0; s < 4; ++s) {
                const bf16x8 v0 = *(const LAS bf16x8*)(vb + s * 32); const bf16x8 v1 = *(const LAS bf16x8*)(vb + 32 * PITCH + s * 32);
                oa0 = __builtin_amdgcn_mfma_f32_32x32x16_bf16(v0, fa[s], oa0, 0, 0, 0); oa1 = __builtin_amdgcn_mfma_f32_32x32x16_bf16(v1, fa[s], oa1, 0, 0, 0);
                ob0 = __builtin_amdgcn_mfma_f32_32x32x16_bf16(v0, fb[s], ob0, 0, 0, 0); ob1 = __builtin_amdgcn_mfma_f32_32x32x16_bf16(v1, fb[s], ob1, 0, 0, 0); }
            renorm_step(oa0, oa1, sa); renorm_step(ob0, ob1, sb);
        }
        if (j < jhi) { *(LAS u32x4*)(Kbuf + (cur ^ 1) * TILE_LDS + so) = kreg; vstore(Vbuf + (cur ^ 1) * TILE_LDS, vreg, L); }
        __syncthreads();
    }
}
}
namespace nsa {
struct AttnPtrs {
    const bf16_t* q;
    const bf16_t* z;
    const bf16_t* kc;
    const bf16_t* vct;
    const bf16_t* ksel;
    const bf16_t* vselt;
    const bf16_t* kwin; const bf16_t* vwint;
    unsigned long long* selmask;
    bf16_t* mix;
};
template <bool ACCUM>
__device__ __forceinline__ void store_o(const f32x16& a0, const f32x16& a1, bf16_t* mix, long tok, int head, int hi) {
    bf16_t* op = mix + tok * 1024 + head * 64 + 4 * hi;
#pragma unroll
    for (int dd = 0; dd < 2; ++dd)
#pragma unroll
        for (int rq = 0; rq < 4; ++rq) {
            float v0, v1, v2, v3;
            if (dd == 0) { v0 = a0[4 * rq]; v1 = a0[4 * rq + 1]; v2 = a0[4 * rq + 2]; v3 = a0[4 * rq + 3]; }
            else         { v0 = a1[4 * rq]; v1 = a1[4 * rq + 1]; v2 = a1[4 * rq + 2]; v3 = a1[4 * rq + 3]; }
            u32x2* p = (u32x2*)(op + dd * 32 + rq * 8);
            if (ACCUM) { const u32x2 old = *p; v0 += bflo(old.x); v1 += bfhi(old.x); v2 += bflo(old.y); v3 += bfhi(old.y); }
            u32x2 w; w.x = cvt_pk_bf16(v0, v1); w.y = cvt_pk_bf16(v2, v3); *p = w;
        }
}
__device__ __forceinline__ float gate_of(const bf16_t* z, long tok, int head, int br) { return sigmoidf_(bf2f(z[tok * INP + ZG + head * 3 + br])); }

struct CmpPre { bf16x8 qr[4]; };
__device__ __forceinline__ void cmp_prefetch(CmpPre& R, int bh, int qb, const AttnPtrs& P, const Lane& L) {
    const int b = bh >> 1, h = bh & 1, tq = qb * 64 + 8 * L.wid + (L.c >> 2), head = 4 * h + (L.c & 3); const long tok = (long)b * SEQ + tq;
    load_q(R.qr, P.q, tok, head, L.hi);
}
__device__ __forceinline__ void cmp_stage(const CmpPre& R, LAS unsigned char* lds, const Lane& L, bf16x8 (&qr)[4], float& gt) {
    (void)lds; (void)L;
#pragma unroll
    for (int d0 = 0; d0 < 4; ++d0) qr[d0] = R.qr[d0];
    gt = 0.f;
}
template <bool STAGE>
__device__ __forceinline__ void cmp_unit(int bh, int qb, const AttnPtrs& P, LAS unsigned char* lds, const Lane& L) {
    const int b = bh >> 1, h = bh & 1, t0 = qb * 64;
    const int ql = 8 * L.wid + (L.c >> 2), g = L.c & 3, tq = t0 + ql, head = 4 * h + g;
    const long tok = (long)b * SEQ + tq;
    LAS unsigned char* Kb = lds; LAS unsigned char* Vb = lds + 4 * TILE_LDS;
    LAS float* G4 = (LAS float*)(lds + 8 * TILE_LDS); LAS float* E3 = G4 + 64 * 64;
    const float gate_raw = bf2f(P.z[tok * INP + ZG + head * 3 + 0]);
    bf16x8 qr[4]; load_q(qr, P.q, tok, head, L.hi);
    if (STAGE) { const char* ks = (const char*)(P.kc + (size_t)bh * 256 * 64); const char* vs = (const char*)(P.vct + (size_t)bh * 256 * 64); const int so = stage_off(L.tid); u32x4 kk[4], vv[4];
#pragma unroll
      for (int jn = 0; jn < 4; ++jn) kk[jn] = *(const u32x4*)(ks + jn * 8192 + L.tid * 16);
#pragma unroll
      for (int jn = 0; jn < 4; ++jn) vv[jn] = *(const u32x4*)(vs + jn * 8192 + L.tid * 16);
#pragma unroll
      for (int jn = 0; jn < 4; ++jn) *(LAS u32x4*)(Kb + jn * TILE_LDS + so) = kk[jn];
#pragma unroll
      for (int jn = 0; jn < 4; ++jn) *(LAS u32x4*)(Vb + jn * TILE_LDS + so) = vv[jn]; }
    __syncthreads();
    const int nmax = (tq >= 31) ? ((tq - 31) >> 4) : -1;
    const int tq_lo = t0 + 8 * L.wid, tq_hi = tq_lo + 7;
    const int nmax_lo = (tq_lo >= 31) ? ((tq_lo - 31) >> 4) : -1, nmax_hi = (tq_hi >= 31) ? ((tq_hi - 31) >> 4) : -1;
    const int ntile = (nmax_hi >= 0) ? (nmax_hi >> 6) + 1 : 0;
    const bool need_imp = qb >= 16;
    float l = 0.f;
    f32x16 o0, o1;
#pragma unroll
    for (int r = 0; r < 16; ++r) { o0[r] = 0.f; o1[r] = 0.f; }
    float gsr[4][8], e3r[4][8];
#pragma unroll
    for (int jn = 0; jn < 4; ++jn)
#pragma unroll
        for (int i = 0; i < 8; ++i) { gsr[jn][i] = 0.f; e3r[jn][i] = 0.f; }
#pragma unroll
    for (int jn = 0; jn < 4; ++jn) {
        if (jn < ntile) {
            f32x16 p0, p1; qk_tile(p0, p1, Kb + jn * TILE_LDS, qr, 0.f, L);
            if (64 * jn + 63 > nmax_lo) mask_range(p0, p1, -1, nmax - 64 * jn, L.hi);
            float ls = 0.f;
#pragma unroll
            for (int r = 0; r < 16; ++r) { p0[r] = fast_exp2(p0[r]); p1[r] = fast_exp2(p1[r]); ls += p0[r] + p1[r]; }
            l += ls;
            if (need_imp) {
#pragma unroll
                for (int rq = 0; rq < 4; ++rq) { gsr[jn][rq] = (p0[4 * rq] + p0[4 * rq + 1]) + (p0[4 * rq + 2] + p0[4 * rq + 3]); e3r[jn][rq] = p0[4 * rq + 3];
                                                 gsr[jn][4 + rq] = (p1[4 * rq] + p1[4 * rq + 1]) + (p1[4 * rq + 2] + p1[4 * rq + 3]); e3r[jn][4 + rq] = p1[4 * rq + 3]; } }
            pv_tile(o0, o1, Vb + jn * TILE_LDS, p0, p1, L);
        }
        __builtin_amdgcn_sched_barrier(0);
    }
    l = xsum32(l);
    const float inv = (nmax >= 0 && l > 0.f) ? fast_rcp(l) : 0.f;
    if (need_imp) {
        LAS float* gp = G4 + ql * 64 + L.hi; asm volatile("" : "+v"(gp));
#pragma unroll
        for (int jn = 0; jn < 4; ++jn) {
            if (jn < ntile) {
#pragma unroll
                for (int i = 0; i < 8; ++i) { float gs = gsr[jn][i] * inv, e3 = e3r[jn][i] * inv;
                    gs += xshfl<1>(gs); gs += xshfl<2>(gs); e3 += xshfl<1>(e3); e3 += xshfl<2>(e3);
                    if (g == 0) { gp[16 * jn + 2 * i] = gs; gp[64 * 64 + 16 * jn + 2 * i] = e3; } }
            }
        }
    }
    {
        const float gt = sigmoidf_(gate_raw) * inv;
#pragma unroll
        for (int r = 0; r < 16; ++r) { o0[r] *= gt; o1[r] *= gt; }
        store_o<false>(o0, o1, P.mix, tok, head, L.hi);
    }
    __syncthreads();
}
__device__ __forceinline__ void cmp_topk(int bh, int qb, const AttnPtrs& P, LAS unsigned char* lds, const Lane& L) {
    const int t0 = qb * 64; LAS float* G4 = (LAS float*)(lds + 8 * TILE_LDS); LAS float* E3 = G4 + 64 * 64;
    const int s = L.lane;
    if (qb < 16) { const unsigned long long mask = (1ull << (qb + 1)) - 1ull;
        if (L.lane < 8) P.selmask[(size_t)bh * SEQ + t0 + 8 * L.wid + L.lane] = mask; }
    else {
        const bool cand = (s >= 1) && (s <= qb - 2);
        unsigned bits[8], T[8];
#pragma unroll
        for (int i = 0; i < 8; ++i) { const int q = 8 * L.wid + i; const float imp = G4[q * 64 + s] + (s > 0 ? E3[q * 64 + s - 1] : 0.f); bits[i] = cand ? __float_as_uint(fmaxf(imp, 0.f)) : 0u; T[i] = 0u; }
        int cnt[8];
#pragma unroll
        for (int i = 0; i < 8; ++i) cnt[i] = qb - 2;
        for (int bit = 30; bit >= 0; --bit) { int open_ = 0;
#pragma unroll
            for (int i = 0; i < 8; ++i) { const unsigned c = T[i] | (1u << bit); const int n = __popcll(__ballot(cand && bits[i] >= c)); if (n >= 13) { T[i] = c; cnt[i] = n; } open_ |= (cnt[i] != 13); }
            if (!open_) break; }
#pragma unroll
        for (int i = 0; i < 8; ++i) {
            const unsigned long long gt = __ballot(cand && bits[i] > T[i]); unsigned long long eq = __ballot(cand && bits[i] == T[i]);
            int need = 13 - __popcll(gt); unsigned long long take = 0ull;
            while (need > 0 && eq) { const unsigned long long low = eq & (0ull - eq); take |= low; eq ^= low; --need; }
            const unsigned long long mask = gt | take | 1ull | (1ull << qb) | (1ull << (qb - 1));
            if (L.lane == 0) P.selmask[(size_t)bh * SEQ + t0 + 8 * L.wid + i] = mask; }
    }
    __syncthreads();
}

__device__ __forceinline__ void sw_unit(int bh, int qb, const AttnPtrs& P, LAS unsigned char* lds, const Lane& L) {
    const int b = bh >> 1, h = bh & 1, t0 = qb * 64;
    const int ql = 8 * L.wid + (L.c >> 2), g = L.c & 3, tq = t0 + ql, head = 4 * h + g;
    const long tok = (long)b * SEQ + tq;
    bf16x8 qr[4]; load_q(qr, P.q, tok, head, L.hi);
    const unsigned long long selw = P.selmask[(size_t)bh * SEQ + tq];
    const float g1raw = bf2f(P.z[tok * INP + ZG + head * 3 + 1]), g2raw = bf2f(P.z[tok * INP + ZG + head * 3 + 2]);
    f32x16 r0, r1;
    {
        f32x16 o0, o1; float m = 0.f, l = 0.f;
#pragma unroll
        for (int r = 0; r < 16; ++r) { o0[r] = 0.f; o1[r] = 0.f; }
        run_branch<0>(o0, o1, m, l, P.ksel + (size_t)bh * SEQ * 64, P.vselt + (size_t)bh * SEQ * 64, 0, qb, qb, ql, selw, qr, lds, L);
        l = xsum32(l);
        const float sc = sigmoidf_(g1raw) * fast_rcp(l);
#pragma unroll
        for (int r = 0; r < 16; ++r) { r0[r] = o0[r] * sc; r1[r] = o1[r] * sc; }
    }
    {
        f32x16 o0, o1; float m = 0.f, l = 0.f;
#pragma unroll
        for (int r = 0; r < 16; ++r) { o0[r] = 0.f; o1[r] = 0.f; }
        run_branch<1>(o0, o1, m, l, P.kwin + (size_t)bh * SEQ * 64, P.vwint + (size_t)bh * SEQ * 64, qb >= 8 ? qb - 8 : 0, qb, qb, ql, 0ull, qr, lds, L);
        l = xsum32(l);
        const float sc = sigmoidf_(g2raw) * fast_rcp(l);
#pragma unroll
        for (int r = 0; r < 16; ++r) { r0[r] += o0[r] * sc; r1[r] += o1[r] * sc; }
    }
    store_o<true>(r0, r1, P.mix, tok, head, L.hi);
}
__device__ __forceinline__ void sw_unit2(int bh, int qb2, const AttnPtrs& P, LAS unsigned char* lds, const Lane& L) {
    const int b = bh >> 1, h = bh & 1, qbw = 2 * qb2 + (L.wid >> 2);
    const int qrela = 16 * (L.wid & 3) + (L.c >> 2), qrelb = qrela + 8, g = L.c & 3, head = 4 * h + g;
    const long toka = (long)b * SEQ + 64 * qbw + qrela, tokb = toka + 8;
    bf16x8 qa[4], qbf[4]; load_q(qa, P.q, toka, head, L.hi); load_q(qbf, P.q, tokb, head, L.hi);
    LAS unsigned long long* selp = (LAS unsigned long long*)(lds + 4 * TILE_LDS + 8192) + L.tid * 2;
    selp[0] = P.selmask[(size_t)bh * SEQ + 64 * qbw + qrela]; selp[1] = P.selmask[(size_t)bh * SEQ + 64 * qbw + qrelb];
    LAS float* gpark = (LAS float*)(lds + 4 * TILE_LDS) + L.tid * 4;
    gpark[0] = bf2f(P.z[toka * INP + ZG + head * 3 + 1]); gpark[1] = bf2f(P.z[tokb * INP + ZG + head * 3 + 1]); gpark[2] = bf2f(P.z[toka * INP + ZG + head * 3 + 2]); gpark[3] = bf2f(P.z[tokb * INP + ZG + head * 3 + 2]);
    {
        f32x16 oa0, oa1, ob0, ob1; SoftState sa{0.f, 0.f}, sb{0.f, 0.f};
#pragma unroll
        for (int r = 0; r < 16; ++r) { oa0[r] = 0.f; oa1[r] = 0.f; ob0[r] = 0.f; ob1[r] = 0.f; }
        run_branch2<0>(oa0, oa1, sa, ob0, ob1, sb, P.ksel + (size_t)bh * SEQ * 64, P.vselt + (size_t)bh * SEQ * 64, 0, 2 * qb2 + 1, qbw, qrela, selp, qa, qbf, lds, L);
        sa.l = xsum32(sa.l); sb.l = xsum32(sb.l);
        const float sca = sigmoidf_(gpark[0]) * fast_rcp(sa.l), scb = sigmoidf_(gpark[1]) * fast_rcp(sb.l);
#pragma unroll
        for (int r = 0; r < 16; ++r) { oa0[r] *= sca; oa1[r] *= sca; ob0[r] *= scb; ob1[r] *= scb; }
        { int qe = qrela; asm volatile("" : "+v"(qe));
          store_o<true>(oa0, oa1, P.mix, (long)b * SEQ + 64 * qbw + qe, head, L.hi); store_o<true>(ob0, ob1, P.mix, (long)b * SEQ + 64 * qbw + qe + 8, head, L.hi); }
    }
    {
        f32x16 oa0, oa1, ob0, ob1; SoftState sa{0.f, 0.f}, sb{0.f, 0.f};
#pragma unroll
        for (int r = 0; r < 16; ++r) { oa0[r] = 0.f; oa1[r] = 0.f; ob0[r] = 0.f; ob1[r] = 0.f; }
        run_branch2<1>(oa0, oa1, sa, ob0, ob1, sb, P.kwin + (size_t)bh * SEQ * 64, P.vwint + (size_t)bh * SEQ * 64, 2 * qb2 >= 8 ? 2 * qb2 - 8 : 0, 2 * qb2 + 1, qbw, qrela, selp, qa, qbf, lds, L);
        sa.l = xsum32(sa.l); sb.l = xsum32(sb.l);
        const float sca = sigmoidf_(gpark[2]) * fast_rcp(sa.l), scb = sigmoidf_(gpark[3]) * fast_rcp(sb.l);
#pragma unroll
        for (int r = 0; r < 16; ++r) { oa0[r] *= sca; oa1[r] *= sca; ob0[r] *= scb; ob1[r] *= scb; }
        { int qe = qrela; asm volatile("" : "+v"(qe));
          store_o<true>(oa0, oa1, P.mix, (long)b * SEQ + 64 * qbw + qe, head, L.hi); store_o<true>(ob0, ob1, P.mix, (long)b * SEQ + 64 * qbw + qe + 8, head, L.hi); }
    }
}
}
namespace epi {
using pg8::Unit; using pg8::BM; using pg8::HALF;
struct Bf16Plain {
    static constexpr bool PERM = true;
    bf16_t* O; int ldc;
    __device__ __forceinline__ void operator()(const f32x4 (&acc)[2][2][4][2], const Unit& u, int wr, int wc, int fr, int fq) const {
        const int row0 = u.pm * BM + wr * 64 + fr, col0 = u.pn * BM + wc * 32 + 8 * fq;
#pragma unroll
        for (int ai = 0; ai < 2; ++ai)
#pragma unroll
            for (int m = 0; m < 4; ++m) { bf16_t* rowp = O + (size_t)(row0 + ai * HALF + m * 16) * ldc + col0;
#pragma unroll
                for (int bj = 0; bj < 2; ++bj) { const f32x4 v0 = acc[ai][bj][m][0], v1 = acc[ai][bj][m][1];
                    u32x4 w; w.x = cvt_pk_bf16(v0[0], v0[1]); w.y = cvt_pk_bf16(v0[2], v0[3]); w.z = cvt_pk_bf16(v1[0], v1[1]); w.w = cvt_pk_bf16(v1[2], v1[3]);
                    *(u32x4*)(rowp + bj * HALF) = w; } }
    }
};
struct Bf16Sc1 {
    static constexpr bool PERM = true;
    bf16_t* O; int ldc; unsigned nbytes;
    __device__ __forceinline__ void operator()(const f32x4 (&acc)[2][2][4][2], const Unit& u, int wr, int wc, int fr, int fq) const {
        const __amdgpu_buffer_rsrc_t rsrc = __builtin_amdgcn_make_buffer_rsrc(O, 0, nbytes, 0x00020000);
        const int row0 = u.pm * BM + wr * 64 + fr, col0 = u.pn * BM + wc * 32 + 8 * fq;
#pragma unroll
        for (int ai = 0; ai < 2; ++ai)
#pragma unroll
            for (int m = 0; m < 4; ++m) { const unsigned off = (unsigned)(((size_t)(row0 + ai * HALF + m * 16) * ldc + col0) * 2);
#pragma unroll
                for (int bj = 0; bj < 2; ++bj) { const f32x4 v0 = acc[ai][bj][m][0], v1 = acc[ai][bj][m][1];
                    u32x4 w; w.x = cvt_pk_bf16(v0[0], v0[1]); w.y = cvt_pk_bf16(v0[2], v0[3]); w.z = cvt_pk_bf16(v1[0], v1[1]); w.w = cvt_pk_bf16(v1[2], v1[3]);
                    __builtin_amdgcn_raw_buffer_store_b128(w, rsrc, off + bj * HALF * 2, 0,   16); } }
    }
};
struct F32Grouped {
    static constexpr bool PERM = false;
    float* C; int ldc; size_t gstride;
    __device__ __forceinline__ void operator()(const f32x4 (&acc)[2][2][4][2], const Unit& u, int wr, int wc, int fr, int fq) const {
        const int row0 = u.pm * BM + wr * 64 + fr, col0 = u.pn * BM + wc * 32 + 4 * fq; float* Cg = C + (size_t)u.aux * gstride;
#pragma unroll
        for (int ai = 0; ai < 2; ++ai)
#pragma unroll
            for (int m = 0; m < 4; ++m) { float* rowp = Cg + (size_t)(row0 + ai * HALF + m * 16) * ldc + col0;
#pragma unroll
                for (int bj = 0; bj < 2; ++bj)
#pragma unroll
                    for (int n = 0; n < 2; ++n) *(f32x4*)(rowp + bj * HALF + n * 16) = acc[ai][bj][m][n]; }
    }
};
struct SwiGlu {
    static constexpr bool PERM = true;
    bf16_t* H; int ldc;
    __device__ __forceinline__ void operator()(const f32x4 (&acc)[2][2][4][2], const Unit& u, int wr, int wc, int fr, int fq) const {
        const int row0 = u.pm * BM + wr * 64 + fr, col0 = u.pn * HALF + wc * 32 + 8 * fq;
#pragma unroll
        for (int ai = 0; ai < 2; ++ai)
#pragma unroll
            for (int m = 0; m < 4; ++m) { bf16_t* rowp = H + (size_t)(row0 + ai * HALF + m * 16) * ldc + col0;
                float o[8];
#pragma unroll
                for (int n = 0; n < 2; ++n)
#pragma unroll
                    for (int e = 0; e < 4; ++e) o[4 * n + e] = siluf_(acc[ai][0][m][n][e]) * acc[ai][1][m][n][e];
                u32x4 w; w.x = cvt_pk_bf16(o[0], o[1]); w.y = cvt_pk_bf16(o[2], o[3]); w.z = cvt_pk_bf16(o[4], o[5]); w.w = cvt_pk_bf16(o[6], o[7]);
                *(u32x4*)rowp = w; }
    }
};
struct MoeDown {
    static constexpr bool PERM = true;
    bf16_t* Y; const int* row_tok;
    __device__ __forceinline__ void operator()(const f32x4 (&acc)[2][2][4][2], const Unit& u, int wr, int wc, int fr, int fq) const {
        const int srow0 = u.aux * BM + wr * 64 + fr, col0 = u.pn * BM + wc * 32 + 8 * fq;
        int dsts[8];
#pragma unroll
        for (int it = 0; it < 8; ++it) dsts[it] = row_tok[srow0 + (it >> 2) * HALF + (it & 3) * 16];
#pragma unroll
        for (int ai = 0; ai < 2; ++ai)
#pragma unroll
            for (int m = 0; m < 4; ++m) { const int dst = dsts[ai * 4 + m];
                if (dst >= 0) { bf16_t* rowp = Y + (size_t)dst * D + col0;
#pragma unroll
                    for (int bj = 0; bj < 2; ++bj) { const f32x4 v0 = acc[ai][bj][m][0], v1 = acc[ai][bj][m][1];
                        u32x4 w; w.x = cvt_pk_bf16(v0[0], v0[1]); w.y = cvt_pk_bf16(v0[2], v0[3]); w.z = cvt_pk_bf16(v1[0], v1[1]); w.w = cvt_pk_bf16(v1[2], v1[3]);
                        *(u32x4*)(rowp + bj * HALF) = w; } } }
    }
};
struct SigmoidBias {
    static constexpr bool PERM = true;
    bf16_t* O; int ldc; const float* bias;
    __device__ __forceinline__ void operator()(const f32x4 (&acc)[2][2][4][2], const Unit& u, int wr, int wc, int fr, int fq) const {
        const int row0 = u.pm * BM + wr * 64 + fr, col0 = u.pn * BM + wc * 32 + 8 * fq;
        f32x4 bv[2][2];
#pragma unroll
        for (int bj = 0; bj < 2; ++bj)
#pragma unroll
            for (int n = 0; n < 2; ++n) bv[bj][n] = *(const f32x4*)(bias + col0 + bj * HALF + 4 * n);
#pragma unroll
        for (int ai = 0; ai < 2; ++ai)
#pragma unroll
            for (int m = 0; m < 4; ++m) { bf16_t* rowp = O + (size_t)(row0 + ai * HALF + m * 16) * ldc + col0;
#pragma unroll
                for (int bj = 0; bj < 2; ++bj) { f32x4 v0 = acc[ai][bj][m][0] + bv[bj][0], v1 = acc[ai][bj][m][1] + bv[bj][1];
#pragma unroll
                    for (int e = 0; e < 4; ++e) { v0[e] = sigmoidf_(v0[e]); v1[e] = sigmoidf_(v1[e]); }
                    u32x4 w; w.x = cvt_pk_bf16(v0[0], v0[1]); w.y = cvt_pk_bf16(v0[2], v0[3]); w.z = cvt_pk_bf16(v1[0], v1[1]); w.w = cvt_pk_bf16(v1[2], v1[3]);
                    *(u32x4*)(rowp + bj * HALF) = w; } }
    }
};
struct MulBf16 {
    static constexpr bool PERM = true;
    bf16_t* O; const bf16_t* G; int ldc;
    __device__ __forceinline__ void operator()(const f32x4 (&acc)[2][2][4][2], const Unit& u, int wr, int wc, int fr, int fq) const {
        const int row0 = u.pm * BM + wr * 64 + fr, col0 = u.pn * BM + wc * 32 + 8 * fq;
        u32x4 gq[2], gn[2];
        { const size_t off = (size_t)row0 * ldc + col0; gn[0] = *(const u32x4*)(G + off); gn[1] = *(const u32x4*)(G + off + HALF); }
#pragma unroll
        for (int it = 0; it < 8; ++it) { const int ai = it >> 2, m = it & 3; const size_t off = (size_t)(row0 + ai * HALF + m * 16) * ldc + col0;
            gq[0] = gn[0]; gq[1] = gn[1];
            if (it < 7) { const int ai2 = (it + 1) >> 2, m2 = (it + 1) & 3; const size_t off2 = (size_t)(row0 + ai2 * HALF + m2 * 16) * ldc + col0; gn[0] = *(const u32x4*)(G + off2); gn[1] = *(const u32x4*)(G + off2 + HALF); }
#pragma unroll
            for (int bj = 0; bj < 2; ++bj) { const f32x4 v0 = acc[ai][bj][m][0], v1 = acc[ai][bj][m][1]; const u32x4 g4 = gq[bj];
                u32x4 w; w.x = cvt_pk_bf16(v0[0] * bflo(g4.x), v0[1] * bfhi(g4.x)); w.y = cvt_pk_bf16(v0[2] * bflo(g4.y), v0[3] * bfhi(g4.y));
                w.z = cvt_pk_bf16(v1[0] * bflo(g4.z), v1[1] * bfhi(g4.z)); w.w = cvt_pk_bf16(v1[2] * bflo(g4.w), v1[3] * bfhi(g4.w));
                *(u32x4*)(O + off + bj * HALF) = w; }
            asm volatile("" ::: "memory"); }
    }
};
struct S5Out {
    static constexpr bool PERM = true;
    bf16_t* ZS5; const bf16_t* Z; const float* dskip;
    __device__ __forceinline__ void operator()(const f32x4 (&acc)[2][2][4][2], const Unit& u, int wr, int wc, int fr, int fq) const {
        const int g = u.aux, row0 = u.pm * BM + wr * 64 + fr;
#pragma unroll
        for (int bj = 0; bj < 2; ++bj) { const int col = u.pn * BM + bj * HALF + wc * 32 + 8 * fq, jo = col >> 4, co0 = col & 15, ch0 = g * 16 + co0;
            const f32x4 d0 = *(const f32x4*)(dskip + ch0), d1 = *(const f32x4*)(dskip + ch0 + 4);
#pragma unroll
            for (int ai = 0; ai < 2; ++ai)
#pragma unroll
                for (int m = 0; m < 4; ++m) { const int mr = row0 + ai * HALF + m * 16; const long tok = (long)(mr >> 7) * SEQ + (mr & 127) * S5LC + jo;
                    const u32x4 uq = *(const u32x4*)(Z + tok * INP + ZS + ch0); const f32x4 v0 = acc[ai][bj][m][0], v1 = acc[ai][bj][m][1];
                    u32x4 w; w.x = cvt_pk_bf16(gelu_tanh(v0[0] + d0[0] * bflo(uq.x)), gelu_tanh(v0[1] + d0[1] * bfhi(uq.x)));
                    w.y = cvt_pk_bf16(gelu_tanh(v0[2] + d0[2] * bflo(uq.y)), gelu_tanh(v0[3] + d0[3] * bfhi(uq.y)));
                    w.z = cvt_pk_bf16(gelu_tanh(v1[0] + d1[0] * bflo(uq.z)), gelu_tanh(v1[1] + d1[1] * bfhi(uq.z)));
                    w.w = cvt_pk_bf16(gelu_tanh(v1[2] + d1[2] * bflo(uq.w)), gelu_tanh(v1[3] + d1[3] * bfhi(uq.w)));
                    *(u32x4*)(ZS5 + tok * 256 + ch0) = w; asm volatile("" ::: "memory"); } }
    }
};
struct S5Glu {
    static constexpr bool PERM = true;
    bf16_t* MIX; const bf16_t* ZS5; const float* bias;
    __device__ __forceinline__ void operator()(const f32x4 (&acc)[2][2][4][2], const Unit& u, int wr, int wc, int fr, int fq) const {
        const int row0 = u.pm * BM + wr * 64 + fr, col0 = wc * 32 + 8 * fq;
#pragma unroll
        for (int bj = 0; bj < 2; ++bj) { const int col = col0 + bj * HALF; const f32x4 b0 = *(const f32x4*)(bias + col), b1 = *(const f32x4*)(bias + col + 4);
#pragma unroll
            for (int ai = 0; ai < 2; ++ai)
#pragma unroll
                for (int m = 0; m < 4; ++m) { const size_t row = (size_t)(row0 + ai * HALF + m * 16); const u32x4 zq = *(const u32x4*)(ZS5 + row * 256 + col);
                    const f32x4 v0 = acc[ai][bj][m][0] + b0, v1 = acc[ai][bj][m][1] + b1;
                    u32x4 w; w.x = cvt_pk_bf16(bflo(zq.x) * sigmoidf_(v0[0]), bfhi(zq.x) * sigmoidf_(v0[1])); w.y = cvt_pk_bf16(bflo(zq.y) * sigmoidf_(v0[2]), bfhi(zq.y) * sigmoidf_(v0[3]));
                    w.z = cvt_pk_bf16(bflo(zq.z) * sigmoidf_(v1[0]), bfhi(zq.z) * sigmoidf_(v1[1])); w.w = cvt_pk_bf16(bflo(zq.w) * sigmoidf_(v1[2]), bfhi(zq.w) * sigmoidf_(v1[3]));
                    *(u32x4*)(MIX + row * 1024 + 768 + col) = w; asm volatile("" ::: "memory"); } }
    }
};
struct EpiWin {
    static constexpr bool PERM = true;
    bf16_t* Z; bf16_t* Q; bf16_t* KV; bf16_t* AP; const f32x2* rope;
    __device__ __forceinline__ void operator()(const f32x4 (&acc)[2][2][4][2], const Unit& u, int wr, int wc, int fr, int fq) const {
        const int row0 = u.pm * BM + wr * 64 + fr;
        if (u.pn >= 5) {
#pragma unroll
            for (int bj = 0; bj < 2; ++bj) { const int col0 = u.pn * BM + bj * HALF + wc * 32 + 8 * fq; const int sc0 = col0 - ZS; const bool s5 = (sc0 >= 0) && (sc0 < 256);
#pragma unroll
                for (int ai = 0; ai < 2; ++ai)
#pragma unroll
                    for (int m = 0; m < 4; ++m) { const int tok = row0 + ai * HALF + m * 16; const f32x4 v0 = acc[ai][bj][m][0], v1 = acc[ai][bj][m][1];
                        u32x4 w; w.x = cvt_pk_bf16(v0[0], v0[1]); w.y = cvt_pk_bf16(v0[2], v0[3]); w.z = cvt_pk_bf16(v1[0], v1[1]); w.w = cvt_pk_bf16(v1[2], v1[3]);
                        *(u32x4*)(Z + (size_t)tok * INP + col0) = w;
                        if (s5) { const int b = tok >> 12, t = tok & 4095; *(u32x4*)(AP + ((size_t)(sc0 >> 4) * 2048 + b * 128 + (t >> 5)) * S5K + (t & 31) * 16 + (sc0 & 15)) = w; } } }
            return;
        }
#pragma unroll
        for (int bj = 0; bj < 2; ++bj) {
            const int colh = bj * HALF + wc * 32 + 8 * fq;
            const int qi = 4 * (wc & 1) + fq, d1 = 4 * qi;
            const bool isv = (u.pn >= 2) && (bj == 1);
            f32x4 cn0 = (f32x4){0.f, 0.f, 0.f, 0.f}, cn1 = cn0;
            if (!isv) { cn0 = *(const f32x4*)(rope + (size_t)row0 * 32 + d1); cn1 = *(const f32x4*)(rope + (size_t)row0 * 32 + d1 + 2); }
#pragma unroll
            for (int it = 0; it < 8; ++it) { const int ai = it >> 2, m = it & 3; const int tok = row0 + ai * HALF + m * 16; const int b = tok >> 12, t = tok & 4095; const f32x4 x1 = acc[ai][bj][m][0], x2 = acc[ai][bj][m][1];
                    if (isv) { bf16_t* dst = KV + (size_t)((u.pn - 2) * 2 + 1) * (8u << 20) + ((size_t)(b * 2 + (wc >> 1)) * SEQ + t) * 64 + 32 * (wc & 1) + 8 * fq;
                        u32x4 w; w.x = cvt_pk_bf16(x1[0], x1[1]); w.y = cvt_pk_bf16(x1[2], x1[3]); w.z = cvt_pk_bf16(x2[0], x2[1]); w.w = cvt_pk_bf16(x2[2], x2[3]); *(u32x4*)dst = w; }
                    else { const f32x4 cs0 = cn0, cs1 = cn1;
                        if (it < 7) { const int tok2 = row0 + ((it + 1) >> 2) * HALF + ((it + 1) & 3) * 16; cn0 = *(const f32x4*)(rope + (size_t)tok2 * 32 + d1); cn1 = *(const f32x4*)(rope + (size_t)tok2 * 32 + d1 + 2); }
                        const float sc = (u.pn < 2) ? QSCALE : 1.0f;
                        const float o10 = (x1[0] * cs0[0] - x2[0] * cs0[1]) * sc, o11 = (x1[1] * cs0[2] - x2[1] * cs0[3]) * sc, o12 = (x1[2] * cs1[0] - x2[2] * cs1[1]) * sc, o13 = (x1[3] * cs1[2] - x2[3] * cs1[3]) * sc;
                        const float o20 = (x2[0] * cs0[0] + x1[0] * cs0[1]) * sc, o21 = (x2[1] * cs0[2] + x1[1] * cs0[3]) * sc, o22 = (x2[2] * cs1[0] + x1[2] * cs1[1]) * sc, o23 = (x2[3] * cs1[2] + x1[3] * cs1[3]) * sc;
                        bf16_t* dst = (u.pn < 2) ? Q + (size_t)tok * 512 + (u.pn * 4 + (colh >> 6)) * 64 + d1
                                                 : KV + (size_t)((u.pn - 2) * 2) * (8u << 20) + ((size_t)(b * 2 + (wc >> 1)) * SEQ + t) * 64 + d1;
                        u32x2 w1, w2; w1.x = cvt_pk_bf16(o10, o11); w1.y = cvt_pk_bf16(o12, o13); w2.x = cvt_pk_bf16(o20, o21); w2.y = cvt_pk_bf16(o22, o23);
                        *(u32x2*)dst = w1; *(u32x2*)(dst + 32) = w2; }
                    asm volatile("" ::: "memory"); }
        }
    }
};
}
constexpr size_t MiB = 1u << 20;
constexpr size_t WS_CTL = 0, CTL_ZERO_BYTES = 1 * MiB;
constexpr size_t WS_SMALL = 1 * MiB;
constexpr size_t SM_APOW = WS_SMALL;
constexpr size_t SM_BBAR = WS_SMALL + 5 * MiB / 4;
constexpr size_t SM_KTAB = WS_SMALL + 2 * MiB;
constexpr size_t SM_CMPB = WS_SMALL + 4 * MiB;
constexpr size_t SM_TOKE = WS_SMALL + 4 * MiB + 256 * 1024;
constexpr size_t SM_TOKW = WS_SMALL + 4 * MiB + 512 * 1024;
constexpr size_t SM_ROWTOK = WS_SMALL + 5 * MiB + 256 * 1024;
constexpr size_t SM_PCNT = WS_SMALL + 6 * MiB;
constexpr size_t SM_TILEEXP = WS_SMALL + 6 * MiB + 16384;
constexpr size_t WS_ROPE = 8 * MiB;
constexpr size_t WS_W = 24 * MiB;
constexpr size_t W_IN = WS_W;
constexpr size_t W_OUT = W_IN + (size_t)INP * D * 2;
constexpr size_t W_GATE = W_OUT + (size_t)D * D * 2;
constexpr size_t W_PROJ = W_GATE + (size_t)D * D * 2;
constexpr size_t W_CMP = W_PROJ + (size_t)D * PLE * 2;
constexpr size_t W_GLU = W_CMP + (size_t)2 * 512 * 1024 * 2;
constexpr size_t W_S5B = W_GLU + (size_t)256 * 256 * 2;
constexpr size_t W_S5S = W_S5B + (size_t)16 * 512 * S5K * 2;
constexpr size_t W_UP = W_S5S + (size_t)16 * 256 * 512 * 2;
constexpr size_t W_DN = W_UP + (size_t)NEXP * 2 * DFE * D * 2;
constexpr size_t W_END_ = W_DN + (size_t)NEXP * D * DFE * 2;
static_assert(W_END_ <= WS_W + 240 * MiB, "weight region");
constexpr size_t WS_XB = 264 * MiB;
constexpr size_t WS_PB = 392 * MiB;
constexpr size_t WS_Z = 424 * MiB;
constexpr size_t WS_QKV = 712 * MiB;
constexpr size_t WS_Q = WS_QKV, WS_KCMP = WS_QKV + 64 * MiB, WS_VCMP = WS_KCMP + 16 * MiB, WS_KSEL = WS_VCMP + 16 * MiB, WS_VSEL = WS_KSEL + 16 * MiB, WS_KWIN = WS_VSEL + 16 * MiB, WS_VWIN = WS_KWIN + 16 * MiB;
constexpr size_t WS_MIX = 872 * MiB;
constexpr size_t WS_CMP = 1000 * MiB;
constexpr size_t WS_CMPP = WS_CMP, WS_KC = WS_CMP + 32 * MiB, WS_VCT = WS_KC + 1 * MiB, WS_SELM = WS_VCT + 1 * MiB;
constexpr size_t WS_S5 = 1036 * MiB;
constexpr size_t WS_S5A = WS_S5, WS_S5S = WS_S5 + 40 * MiB, WS_ZS5 = WS_S5S + 32 * MiB;
constexpr size_t WS_HBUF = 1140 * MiB;
constexpr size_t WS_END = 1268 * MiB;
constexpr size_t WS_FFH = WS_Z, WS_XS = WS_Z, WS_MH = WS_Z + 260 * MiB, WS_YB = WS_MH + 224 * MiB;
static_assert(WS_YB + 256 * MiB <= WS_END && WS_FFH + (size_t)T * DFF * 2 <= WS_MIX, "overlays");
constexpr size_t WS_PLEG = WS_Z, WS_PLEH = WS_Z + 128 * MiB;
static_assert(WS_PLEH + 128 * MiB <= WS_MH, "per-layer-embedding buffers of the MoE layers");
constexpr int CW_BAR = 4096;
constexpr int CW_TMO = 64;
constexpr int CW_CNT = 16384, CNT_BANK = 256 * 64;
static_assert((CW_CNT + 8 * CNT_BANK) * 4 <= (int)CTL_ZERO_BYTES, "panel counters inside the per-call memset");

struct Args { const void* in[36]; float* out; unsigned char* ws; int gp_lo, gp_hi, use_bar, pad; };
struct Frame { LAS unsigned char* lds; int tid, lane, wave, G, bid, own; };
constexpr int RING_BYTES = 131072, LDSCTL_OFF = RING_BYTES, LDS_BYTES = 147456;
typedef __attribute__((address_space(4))) const Args CArgs;
__device__ __forceinline__ void load_args(Args& a) { CArgs* p = (CArgs*)__builtin_amdgcn_kernarg_segment_ptr(); asm volatile("" : "+s"(p)); __builtin_memcpy(&a, p, sizeof(Args)); }
__device__ __forceinline__ Frame make_frame(LAS unsigned char* lds, int wave0) { Frame F; F.lds = lds;
    int w = wave0; asm volatile("" : "+s"(w)); int ln = lane_id_fresh(); F.lane = ln; F.wave = w; F.tid = w * 64 + ln;
    int b = blockIdx.x, g = gridDim.x; asm volatile("" : "+s"(b), "+s"(g)); F.bid = b; F.G = g;
    F.own = (g == 256) ? 32 * (b & 7) + (b >> 3) : b; return F; }

__constant__ double c_invfreq_rev[32] = {0.15915494309189535, 0.11934937021124886, 0.08949940160889101, 0.06711508300522726, 0.050329212104487035, 0.03774158471741977, 0.0283021958306234, 0.02122365276477766, 0.015915494309189534, 0.011934937021124886, 0.008949940160889102, 0.006711508300522725, 0.005032921210448704, 0.003774158471741977, 0.00283021958306234, 0.0021223652764777662, 0.0015915494309189536, 0.0011934937021124885, 0.0008949940160889102, 0.0006711508300522726, 0.0005032921210448703, 0.00037741584717419774, 0.00028302195830623395, 0.0002122365276477766, 0.00015915494309189535, 0.00011934937021124886, 8.949940160889102e-05, 6.711508300522725e-05, 5.0329212104487035e-05, 3.774158471741978e-05, 2.8302195830623396e-05, 2.122365276477766e-05};

__device__ __forceinline__ void sincos_rev(double rev, float& c, float& s) { const double fr = rev - __builtin_floor(rev); const float f = (float)fr; s = __builtin_amdgcn_sinf(f); c = __builtin_amdgcn_cosf(f); }

template <class Sched>
__device__ __forceinline__ void panels_publish_wait(const Frame& F, unsigned* ctl, int bank, const Sched& S, unsigned need) {
    unsigned* cnt = ctl + CW_CNT + bank * CNT_BANK;
    if (F.tid == 0) { pg8::Unit u; for (int i = 0; S.next(i, u); ++i) __hip_atomic_fetch_add(cnt + 64 * u.pm, 1u, __ATOMIC_RELAXED, __HIP_MEMORY_SCOPE_AGENT); }
    if (F.wave == 0) {
        for (int pm = F.own; pm < T / 256; pm += F.G) { unsigned spins = 0;
            while ((unsigned)__builtin_amdgcn_readfirstlane(__hip_atomic_load(cnt + 64 * pm, __ATOMIC_RELAXED, __HIP_MEMORY_SCOPE_AGENT)) < need) {
                __builtin_amdgcn_s_sleep(1);
                if (++spins > (1u << 22)) { if (F.lane == 0) __hip_atomic_store(ctl + CW_TMO, 1u, __ATOMIC_RELAXED, __HIP_MEMORY_SCOPE_AGENT); break; }
                if ((spins & 1023u) == 0u && __builtin_amdgcn_readfirstlane(__hip_atomic_load(ctl + CW_TMO, __ATOMIC_RELAXED, __HIP_MEMORY_SCOPE_AGENT))) break; } }
        __builtin_amdgcn_fence(__ATOMIC_ACQUIRE, "agent");
        asm volatile("s_waitcnt vmcnt(0)" ::: "memory");
    }
    __syncthreads();
}
__device__ __forceinline__ void phase_init0(const Frame& F, const Args& a) {
    const size_t gt = (size_t)F.bid * 512 + F.tid, NT = (size_t)F.G * 512;
    const int* pos = (const int*)a.in[2]; f32x2* rope = (f32x2*)(a.ws + WS_ROPE);
    for (size_t i = gt; i < (size_t)T * 32; i += NT) { const int tok = (int)(i >> 5), k = (int)(i & 31); float c, s; sincos_rev((double)pos[tok] * c_invfreq_rev[k], c, s); rope[i] = (f32x2){c, s}; }
    const float* are = (const float*)a.in[14]; const float* aim = (const float*)a.in[15]; const float* ldt = (const float*)a.in[16];
    const float* bre = (const float*)a.in[17]; const float* bim = (const float*)a.in[18];
    f32x2* apow = (f32x2*)(a.ws + SM_APOW); f32x2* bbar = (f32x2*)(a.ws + SM_BBAR);
    for (size_t i = gt; i < (size_t)DEPTH * 16 * 64 * 34; i += NT) { const int k = (int)(i % 34), lgn = (int)(i / 34), lg = lgn >> 6;
        const float dt = __expf(ldt[lg]); const float ar = are[lgn] * dt; const double rev = (double)k * ((double)aim[lgn] * (double)dt) * 0.15915494309189535;
        float c, s; sincos_rev(rev, c, s); const float mg = __expf((float)k * ar); apow[i] = (f32x2){mg * c, mg * s}; }
    for (size_t i = gt; i < (size_t)DEPTH * 16 * 64 * 16; i += NT) { const int lgn = (int)(i >> 4), lg = lgn >> 6;
        const float dt = __expf(ldt[lg]); const float lr = are[lgn], li = aim[lgn]; const double rev = ((double)li * (double)dt) * 0.15915494309189535;
        float c, s; sincos_rev(rev, c, s); const float mg = __expf(lr * dt); const float abr = mg * c, abi = mg * s, den = lr * lr + li * li;
        const float cr = ((abr - 1.0f) * lr + abi * li) / den, ci = (abi * lr - (abr - 1.0f) * li) / den;
        const float br = bre[i], bi = bim[i]; bbar[i] = (f32x2){cr * br - ci * bi, cr * bi + ci * br}; }
    const f32x4* x4 = (const f32x4*)a.in[0]; u32x2* xb = (u32x2*)(a.ws + WS_XB);
    for (size_t i = gt; i < (size_t)T * D / 4; i += 4 * NT) { f32x4 v[4];
#pragma unroll
        for (int q = 0; q < 4; ++q) { const size_t ii = i + q * NT; v[q] = (ii < (size_t)T * D / 4) ? x4[ii] : (f32x4){0.f, 0.f, 0.f, 0.f}; }
#pragma unroll
        for (int q = 0; q < 4; ++q) { const size_t ii = i + q * NT; if (ii < (size_t)T * D / 4) { u32x2 w; w.x = cvt_pk_bf16(v[q][0], v[q][1]); w.y = cvt_pk_bf16(v[q][2], v[q][3]); xb[ii] = w; } } }
}
__device__ __forceinline__ void phase_init1(const Frame& F, const Args& a) {
    const size_t gt = (size_t)F.bid * 512 + F.tid, NT = (size_t)F.G * 512;
    const float* cre = (const float*)a.in[19]; const float* cim = (const float*)a.in[20];
    const f32x2* apow = (const f32x2*)(a.ws + SM_APOW); const f32x2* bbar = (const f32x2*)(a.ws + SM_BBAR); float* ktab = (float*)(a.ws + SM_KTAB);
    for (size_t i = gt; i < (size_t)DEPTH * 16 * 32 * 256; i += NT) { const int ci = (int)(i & 15), co = (int)((i >> 4) & 15), tau = (int)((i >> 8) & 31), lg = (int)(i >> 13);
        float acc = 0.f;
        for (int n = 0; n < 64; ++n) { const f32x2 P = apow[((size_t)lg * 64 + n) * 34 + tau], Bb = bbar[((size_t)lg * 64 + n) * 16 + ci]; const float cr = cre[((size_t)lg * 16 + co) * 64 + n], cm = cim[((size_t)lg * 16 + co) * 64 + n];
            const float hr = P.x * Bb.x - P.y * Bb.y, hi = P.x * Bb.y + P.y * Bb.x; acc += cr * hr - cm * hi; }
        ktab[i] = acc; }
}

__device__ __forceinline__ void transpose_item(const float* W, int ldw, int k0, int n0, int nvalid, bf16_t* dstrow, int dst_ld, LAS float* scr, int lane, int permhi) {
    float tv[32];
#pragma unroll
    for (int i = 0; i < 32; ++i) { const int kk = 2 * i + (lane >> 5), nn = lane & 31; tv[i] = (nn < nvalid) ? W[(size_t)(k0 + kk) * ldw + n0 + nn] : 0.f; }
#pragma unroll
    for (int i = 0; i < 32; ++i) { const int kk = 2 * i + (lane >> 5), nn = lane & 31; scr[kk * 33 + nn] = tv[i]; }
    LDS_WAIT(); asm volatile("" ::: "memory");
    const int c = lane & 7;
#pragma unroll
    for (int j = 0; j < 4; ++j) { const int n = (lane >> 3) + 8 * j; const LAS float* s = scr + (8 * c) * 33 + n;
        u32x4 o; o.x = cvt_pk_bf16(s[0 * 33], s[1 * 33]); o.y = cvt_pk_bf16(s[2 * 33], s[3 * 33]); o.z = cvt_pk_bf16(s[4 * 33], s[5 * 33]); o.w = cvt_pk_bf16(s[6 * 33], s[7 * 33]);
        const int drow = permhi < 0 ? n : (8 * (n >> 2) + 4 * permhi + (n & 3));
        if (n < nvalid) *(u32x4*)(dstrow + (size_t)drow * dst_ld + 8 * c) = o; }
    LDS_WAIT(); asm volatile("" ::: "memory");
}
__device__ __forceinline__ void transpose_mat(const float* W, int K, int N, bf16_t* dst, int dst_ld, int mode, LAS float* scr, int lane, int& cursor, int gw, int NGW) {
    const int nblk = (N + 31) / 32, items = (K / 64) * nblk;
    int it = ((gw - cursor) % NGW + NGW) % NGW;
    for (; it < items; it += NGW) { const int kb = it / nblk, nb = it % nblk, k0 = 64 * kb, n0 = 32 * nb; const int nv = (N - n0) < 32 ? (N - n0) : 32;
        int drow = n0, permhi = -1;
        if (mode == 1 || mode == 2) drow = (n0 >> 7) * 256 + (n0 & 127) + (mode == 2 ? 128 : 0);
        if (mode == 3 && (n0 < 512 || (n0 < 1280 && (((n0 - 512) >> 7) & 1) == 0))) { drow = n0 & ~63; permhi = (n0 >> 5) & 1; }
        transpose_item(W, N, k0, n0, nv, dst + (size_t)drow * dst_ld + k0, dst_ld, scr, lane, permhi); }
    cursor = (cursor + items) % NGW;
}

__device__ __forceinline__ void phase_prep(const Frame& F, const Args& a, int l) {
    LAS float* scr = (LAS float*)(F.lds + F.wave * 16384);
    const int gw = F.bid * 8 + F.wave, NGW = F.G * 8; int cursor = 0;
    unsigned char* ws = a.ws;
    transpose_mat((const float*)a.in[3] + (size_t)l * D * INW, D, INW, (bf16_t*)(ws + W_IN), D, 3, scr, F.lane, cursor, gw, NGW);
    transpose_mat((const float*)a.in[4] + (size_t)l * D * D, D, D, (bf16_t*)(ws + W_OUT), D, 0, scr, F.lane, cursor, gw, NGW);
    transpose_mat((const float*)a.in[31] + (size_t)l * D * D, D, D, (bf16_t*)(ws + W_GATE), D, 0, scr, F.lane, cursor, gw, NGW);
    transpose_mat((const float*)a.in[33] + (size_t)l * PLE * D, PLE, D, (bf16_t*)(ws + W_PROJ), PLE, 0, scr, F.lane, cursor, gw, NGW);
    for (int j = 0; j < 2; ++j) { const float* w1 = (const float*)a.in[6] + ((size_t)l * 2 + j) * 2048 * 256; bf16_t* dst = (bf16_t*)(ws + W_CMP) + (size_t)j * 512 * 1024;
        transpose_mat(w1, 1024, 256, dst, 1024, 0, scr, F.lane, cursor, gw, NGW);
        transpose_mat(w1 + (size_t)1024 * 256, 1024, 256, dst + (size_t)256 * 1024, 1024, 0, scr, F.lane, cursor, gw, NGW); }
    transpose_mat((const float*)a.in[22] + (size_t)l * 256 * 256, 256, 256, (bf16_t*)(ws + W_GLU), 256, 0, scr, F.lane, cursor, gw, NGW);
    const int j2 = l >> 1;
    if ((l & 1) == 0) {
        transpose_mat((const float*)a.in[24] + (size_t)j2 * D * DFF, D, DFF, (bf16_t*)(ws + W_UP), D, 1, scr, F.lane, cursor, gw, NGW);
        transpose_mat((const float*)a.in[25] + (size_t)j2 * D * DFF, D, DFF, (bf16_t*)(ws + W_UP), D, 2, scr, F.lane, cursor, gw, NGW);
        transpose_mat((const float*)a.in[26] + (size_t)j2 * DFF * D, DFF, D, (bf16_t*)(ws + W_DN), DFF, 0, scr, F.lane, cursor, gw, NGW);
    } else {
        for (int e = 0; e < NEXP; ++e) { const size_t eo = (size_t)j2 * NEXP + e;
            transpose_mat((const float*)a.in[28] + eo * D * DFE, D, DFE, (bf16_t*)(ws + W_UP) + (size_t)e * 2 * DFE * D, D, 1, scr, F.lane, cursor, gw, NGW);
            transpose_mat((const float*)a.in[29] + eo * D * DFE, D, DFE, (bf16_t*)(ws + W_UP) + (size_t)e * 2 * DFE * D, D, 2, scr, F.lane, cursor, gw, NGW);
            transpose_mat((const float*)a.in[30] + eo * DFE * D, DFE, D, (bf16_t*)(ws + W_DN) + (size_t)e * D * DFE, DFE, 0, scr, F.lane, cursor, gw, NGW); }
    }
    const size_t gt = (size_t)F.bid * 512 + F.tid, NT = (size_t)F.G * 512;
    {
        u32x4* zp = (u32x4*)((bf16_t*)(ws + W_IN) + (size_t)INW * D); const size_t n16 = (size_t)(INP - INW) * D * 2 / 16;
        unsigned zz = 0u; asm volatile("" : "+v"(zz));
        for (size_t i = gt; i < n16; i += NT) zp[i] = (u32x4){zz, zz, zz, zz};
    }
    {
        const f32x4* p4 = (const f32x4*)((const float*)a.in[1] + (size_t)l * T * PLE); u32x2* pb = (u32x2*)(ws + WS_PB);
        for (size_t i = gt; i < (size_t)T * PLE / 4; i += 4 * NT) { f32x4 v[4];
#pragma unroll
            for (int q = 0; q < 4; ++q) { const size_t ii = i + q * NT; v[q] = (ii < (size_t)T * PLE / 4) ? p4[ii] : (f32x4){0.f, 0.f, 0.f, 0.f}; }
#pragma unroll
            for (int q = 0; q < 4; ++q) { const size_t ii = i + q * NT; if (ii < (size_t)T * PLE / 4) { u32x2 w; w.x = cvt_pk_bf16(v[q][0], v[q][1]); w.y = cvt_pk_bf16(v[q][2], v[q][3]); pb[ii] = w; } } }
    }
    {
        const float* ktab = (const float*)(ws + SM_KTAB) + (size_t)l * 16 * 32 * 256; const f32x2* apow = (const f32x2*)(ws + SM_APOW) + (size_t)l * 16 * 64 * 34; const f32x2* bbar = (const f32x2*)(ws + SM_BBAR) + (size_t)l * 16 * 64 * 16;
        const float* cre = (const float*)a.in[19] + (size_t)l * 16 * 16 * 64; const float* cim = (const float*)a.in[20] + (size_t)l * 16 * 16 * 64;
        bf16_t* Bt = (bf16_t*)(ws + W_S5B);
        for (size_t i = gt; i < (size_t)16 * 512 * S5K; i += NT) { const int k = (int)(i % S5K), row = (int)((i / S5K) & 511), g = (int)(i / ((size_t)S5K * 512)); const int jo = row >> 4, co = row & 15;
            float v;
            if (k < 512) { const int ji = k >> 4, ci = k & 15; v = (jo >= ji) ? ktab[(((size_t)g * 32 + (jo - ji)) * 16 + co) * 16 + ci] : 0.f; }
            else { const int n = (k - 512) & 63; const f32x2 P = apow[((size_t)g * 64 + n) * 34 + jo + 1]; const float cr = cre[((size_t)g * 16 + co) * 64 + n], cm = cim[((size_t)g * 16 + co) * 64 + n];
                v = (k < 576) ? (cr * P.x - cm * P.y) : -(cr * P.y + cm * P.x); }
            Bt[i] = f2bf(v); }
        bf16_t* St = (bf16_t*)(ws + W_S5S);
        for (size_t i = gt; i < (size_t)16 * 256 * 512; i += NT) { const int k = (int)(i & 511), np = (int)((i >> 9) & 255), g = (int)(i >> 17); const int j = k >> 4, ci = k & 15;
            float v = 0.f;
            if (np < 128) { const int n = np & 63; const f32x2 P = apow[((size_t)g * 64 + n) * 34 + (S5LC - 1 - j)], Bb = bbar[((size_t)g * 64 + n) * 16 + ci]; v = (np < 64) ? (P.x * Bb.x - P.y * Bb.y) : (P.x * Bb.y + P.y * Bb.x); }
            St[i] = f2bf(v); }
    }
    {
        float* cb = (float*)(ws + SM_CMPB); LAS float* red = (LAS float*)(F.lds + 8 * 16384 - 4096);
        for (int o = F.bid; o < 8; o += F.G) { const int j = o >> 2, cblk = o & 3; const float* w1 = (const float*)a.in[6] + ((size_t)l * 2 + j) * 2048 * 256 + cblk * 64 + F.lane; const float* pe = (const float*)a.in[5] + ((size_t)l * 2 + j) * 2048;
            float s0 = 0.f, s1 = 0.f, s2 = 0.f, s3 = 0.f;
#pragma unroll 4
            for (int k = 256 * F.wave; k < 256 * F.wave + 256; k += 4) { s0 += pe[k] * w1[(size_t)k * 256]; s1 += pe[k + 1] * w1[(size_t)(k + 1) * 256]; s2 += pe[k + 2] * w1[(size_t)(k + 2) * 256]; s3 += pe[k + 3] * w1[(size_t)(k + 3) * 256]; }
            __syncthreads(); red[F.wave * 64 + F.lane] = (s0 + s1) + (s2 + s3); __syncthreads();
            if (F.wave == 0) { float t = ((const float*)a.in[7])[((size_t)l * 2 + j) * 256 + cblk * 64 + F.lane];
#pragma unroll
                for (int w = 0; w < 8; ++w) t += red[w * 64 + F.lane];
                cb[j * 256 + cblk * 64 + F.lane] = t; }
            __syncthreads(); }
    }
}

__device__ __forceinline__ void conv_items(const Frame& F, const Args& a, int l, int first, int stride, int last = NB * (SEQ / 32)) {
    const bf16_t* z = (const bf16_t*)(a.ws + WS_Z); bf16_t* mix = (bf16_t*)(a.ws + WS_MIX);
    const float* cw = (const float*)a.in[10] + (size_t)l * 31 * 256; const float* cb = (const float*)a.in[11] + (size_t)l * 256;
    const float* lg = (const float*)a.in[12] + (size_t)l * 256; const float* lb = (const float*)a.in[13] + (size_t)l * 256;
    LAS float* U = (LAS float*)F.lds;
    LAS float* Y = (LAS float*)(F.lds + 65536);
    const int cp = F.tid & 127, tg = F.tid >> 7, c = 2 * cp;
    f32x2 w[31];
#pragma unroll
    for (int j = 0; j < 31; ++j) w[j] = *(const f32x2*)(cw + j * 256 + c);
    const f32x2 bias = *(const f32x2*)(cb + c);
    unsigned pva[16], pvg[16];
    auto fetch = [&](int it) { const int b = it >> 7, t0 = (it & 127) * 32;
#pragma unroll
        for (int q = 0; q < 16; ++q) { const int r = tg + 4 * q, t = t0 - 30 + r; pva[q] = 0u; pvg[q] = 0u;
            if (r < 62 && t >= 0) { const bf16_t* zr = z + ((size_t)b * SEQ + t) * INP + ZC; pva[q] = *(const unsigned*)(zr + c); pvg[q] = *(const unsigned*)(zr + 256 + c); } } };
    if (first < last) fetch(first);
    for (int it = first; it < last; it += stride) { const int b = it >> 7, t0 = (it & 127) * 32;
#pragma unroll
        for (int q = 0; q < 16; ++q) { const int r = tg + 4 * q, t = t0 - 30 + r;
            if (r < 62) { f32x2 u = (f32x2){0.f, 0.f}; if (t >= 0) u = (f32x2){bflo(pva[q]) * sigmoidf_(bflo(pvg[q])), bfhi(pva[q]) * sigmoidf_(bfhi(pvg[q]))};
                *(LAS f32x2*)(U + r * 256 + c) = u; } }
        if (it + stride < last) fetch(it + stride);
        __syncthreads();
        {   f32x2 acc[8];
#pragma unroll
            for (int i = 0; i < 8; ++i) acc[i] = bias;
#pragma unroll
            for (int k = 0; k < 38; ++k) { const f32x2 u = *(const LAS f32x2*)(U + (tg * 8 + k) * 256 + c);
#pragma unroll
                for (int i = 0; i < 8; ++i) { const int j = k - i; if (j >= 0 && j < 31) acc[i] += w[j] * u; } }
#pragma unroll
            for (int i = 0; i < 8; ++i) *(LAS f32x2*)(Y + (tg * 8 + i) * 256 + c) = acc[i];
        }
        __syncthreads();
        for (int i = 0; i < 4; ++i) { const int tl = F.wave * 4 + i; const f32x4 v = *(const LAS f32x4*)(Y + tl * 256 + F.lane * 4);
            const float mean = wave_sum((v[0] + v[1]) + (v[2] + v[3])) * (1.f / 256.f); const f32x4 dlt = v - mean;
            const float var = wave_sum((dlt[0] * dlt[0] + dlt[1] * dlt[1]) + (dlt[2] * dlt[2] + dlt[3] * dlt[3])) * (1.f / 256.f); const float rstd = 1.0f / sqrtf(var + LN_EPS);
            const f32x4 gg = *(const f32x4*)(lg + F.lane * 4), bb = *(const f32x4*)(lb + F.lane * 4);
            float o[4];
#pragma unroll
            for (int e = 0; e < 4; ++e) o[e] = siluf_(dlt[e] * rstd * gg[e] + bb[e]);
            u32x2 wv; wv.x = cvt_pk_bf16(o[0], o[1]); wv.y = cvt_pk_bf16(o[2], o[3]);
            *(u32x2*)(mix + ((size_t)b * SEQ + t0 + tl) * 1024 + 512 + F.lane * 4) = wv; }
        __syncthreads();
    }
}
__device__ __forceinline__ void cmp_stage2(const Frame& F, const Args& a, int l) {
    unsigned char* ws = a.ws; const float* cb = (const float*)(ws + SM_CMPB);
    LAS float* w2s = (LAS float*)F.lds;
    LAS float* hs = (LAS float*)(F.lds + 65536 + F.wave * 1024);
    const int gw = F.bid * 8 + F.wave, NGW = F.G * 8, lane = F.lane;
    for (int j = 0; j < 2; ++j) {
        const float* w2 = (const float*)a.in[8] + ((size_t)l * 2 + j) * 256 * 64; const float* b2 = (const float*)a.in[9] + ((size_t)l * 2 + j) * 64;
        __syncthreads();
        for (int i = F.tid; i < 256 * 64 / 4; i += 512) *(LAS f32x4*)(w2s + 4 * i) = *(const f32x4*)(w2 + 4 * i);
        __syncthreads();
        for (int it = gw; it < 32 * 256; it += NGW) { const int bh = it >> 8, n = it & 255;
            float outv = 0.f;
            if (n < NCMP) {
                const float* P = (const float*)(ws + WS_CMPP) + (size_t)j * 8192 * 512 + ((size_t)bh * 256 + n) * 512;
                const f32x4 p0 = *(const f32x4*)(P + lane * 4), p1 = *(const f32x4*)(P + 512 + 256 + lane * 4), bb = *(const f32x4*)(cb + j * 256 + lane * 4);
                f32x4 hv;
#pragma unroll
                for (int e = 0; e < 4; ++e) hv[e] = gelu_tanh(p0[e] + p1[e] + bb[e]);
                *(LAS f32x4*)(hs + lane * 4) = hv; LDS_WAIT(); asm volatile("" ::: "memory");
                float acc0 = b2[lane], acc1 = 0.f, acc2 = 0.f, acc3 = 0.f;
#pragma unroll 4
                for (int c = 0; c < 256; c += 4) { const f32x4 h4 = *(const LAS f32x4*)(hs + c);
                    acc0 += h4[0] * w2s[c * 64 + lane]; acc1 += h4[1] * w2s[(c + 1) * 64 + lane]; acc2 += h4[2] * w2s[(c + 2) * 64 + lane]; acc3 += h4[3] * w2s[(c + 3) * 64 + lane]; }
                outv = (acc0 + acc1) + (acc2 + acc3); LDS_WAIT(); asm volatile("" ::: "memory");
            }
            if (j == 0) ((bf16_t*)(ws + WS_KC))[((size_t)bh * 256 + n) * 64 + lane] = f2bf(outv);
            else ((bf16_t*)(ws + WS_VCT))[((size_t)bh * 4 + (n >> 6)) * 4096 + lane * 64 + nsa::vslot(n & 63)] = f2bf(outv);
        }
    }
    __syncthreads();
}
__device__ __forceinline__ void cmp_stage2_panel(const Frame& F, const Args& a, int l, int j, int bh) {
    constexpr int HP = 528;
    unsigned char* ws = a.ws; const float* cb = (const float*)(ws + SM_CMPB);
    LAS unsigned char* Hs = F.lds;
    LAS unsigned char* Ws = F.lds + 128 * HP;
    const int lane = F.lane, w = F.wave;
    const float* w2 = (const float*)a.in[8] + ((size_t)l * 2 + j) * 256 * 64; const float* b2 = (const float*)a.in[9] + ((size_t)l * 2 + j) * 64;
    const float* Pb = (const float*)(ws + WS_CMPP) + (size_t)j * 8192 * 512 + (size_t)bh * 256 * 512;
    __syncthreads();
    for (int i = F.tid; i < 256 * 64; i += 512) { const int c = i >> 6, d = i & 63; *(LAS bf16_t*)(Ws + d * HP + c * 2) = f2bf(w2[i]); }
    const f32x4 bb = *(const f32x4*)(cb + j * 256 + lane * 4);
    for (int half = 0; half < 2; ++half) {
        __syncthreads();
#pragma unroll 4
        for (int rr = 0; rr < 16; ++rr) { const int r = 16 * w + rr, n = half * 128 + r, n1 = n < 255 ? n + 1 : n;
            const f32x4 p0 = *(const f32x4*)(Pb + (size_t)n * 512 + lane * 4), p1 = *(const f32x4*)(Pb + (size_t)n1 * 512 + 256 + lane * 4);
            u32x2 hv; hv.x = cvt_pk_bf16(gelu_tanh(p0[0] + p1[0] + bb[0]), gelu_tanh(p0[1] + p1[1] + bb[1])); hv.y = cvt_pk_bf16(gelu_tanh(p0[2] + p1[2] + bb[2]), gelu_tanh(p0[3] + p1[3] + bb[3]));
            *(LAS u32x2*)(Hs + r * HP + lane * 8) = hv; }
        __syncthreads();
        f32x4 acc[4];
#pragma unroll
        for (int cbk = 0; cbk < 4; ++cbk) acc[cbk] = (f32x4){0.f, 0.f, 0.f, 0.f};
        const LAS unsigned char* ap = Hs + (16 * w + (lane & 15)) * HP + (lane >> 4) * 16;
        const LAS unsigned char* bp = Ws + (lane & 15) * HP + (lane >> 4) * 16;
#pragma unroll
        for (int ks = 0; ks < 8; ++ks) { const bf16x8 af = *(const LAS bf16x8*)(ap + ks * 64);
#pragma unroll
            for (int cbk = 0; cbk < 4; ++cbk) { const bf16x8 bf = *(const LAS bf16x8*)(bp + cbk * 16 * HP + ks * 64); acc[cbk] = __builtin_amdgcn_mfma_f32_16x16x32_bf16(af, bf, acc[cbk], 0, 0, 0); } }
#pragma unroll
        for (int cbk = 0; cbk < 4; ++cbk) { const int d = 16 * cbk + (lane & 15); const float bv = b2[d];
#pragma unroll
            for (int e = 0; e < 4; ++e) { const int n = half * 128 + 16 * w + 4 * (lane >> 4) + e; const float outv = n < NCMP ? acc[cbk][e] + bv : 0.f;
                if (j == 0) ((bf16_t*)(ws + WS_KC))[((size_t)bh * 256 + n) * 64 + d] = f2bf(outv);
                else ((bf16_t*)(ws + WS_VCT))[((size_t)bh * 4 + (n >> 6)) * 4096 + d * 64 + nsa::vslot(n & 63)] = f2bf(outv); } }
    }
    __syncthreads();
}
__device__ __forceinline__ void s5_carry_panel(const Frame& F, const Args& a, int l, int g, int pm) {
    unsigned char* ws = a.ws; const f32x2* apow = (const f32x2*)(ws + SM_APOW) + (size_t)l * 16 * 64 * 34;
    const float* S = (const float*)(ws + WS_S5S); bf16_t* ap = (bf16_t*)(ws + WS_S5A);
    if (F.tid < 128) { const int n = F.tid & 63, b = 2 * pm + (F.tid >> 6);
        const f32x2 A = apow[((size_t)g * 64 + n) * 34 + S5LC]; float hr = 0.f, hi = 0.f;
        const float* sp = S + ((size_t)g * 2048 + b * 128) * 256 + n; bf16_t* dp = ap + ((size_t)g * 2048 + b * 128) * S5K + 512 + n;
        float nr_[16], ni_[16];
#pragma unroll
        for (int k = 0; k < 16; ++k) { nr_[k] = sp[(size_t)k * 256]; ni_[k] = sp[(size_t)k * 256 + 64]; }
        for (int c0 = 0; c0 < S5NCH; c0 += 16) { float sr[16], si[16];
#pragma unroll
            for (int k = 0; k < 16; ++k) { sr[k] = nr_[k]; si[k] = ni_[k]; }
            if (c0 + 16 < S5NCH) {
#pragma unroll
                for (int k = 0; k < 16; ++k) { nr_[k] = sp[(size_t)(c0 + 16 + k) * 256]; ni_[k] = sp[(size_t)(c0 + 16 + k) * 256 + 64]; } }
#pragma unroll
            for (int k = 0; k < 16; ++k) { dp[(size_t)(c0 + k) * S5K] = f2bf(hr); dp[(size_t)(c0 + k) * S5K + 64] = f2bf(hi);
                const float nr = A.x * hr - A.y * hi + sr[k], ni = A.x * hi + A.y * hr + si[k]; hr = nr; hi = ni; } }
    }
}
__device__ __forceinline__ void s5_carry(const Frame& F, const Args& a, int l) {
    unsigned char* ws = a.ws; const f32x2* apow = (const f32x2*)(ws + SM_APOW) + (size_t)l * 16 * 64 * 34;
    const float* S = (const float*)(ws + WS_S5S); bf16_t* ap = (bf16_t*)(ws + WS_S5A);
    const int gt = F.bid * 512 + F.tid, NT = F.G * 512;
    for (int i = gt; i < 16 * NB * 64; i += NT) { const int n = i & 63, b = (i >> 6) & 15, g = i >> 10;
        const f32x2 A = apow[((size_t)g * 64 + n) * 34 + S5LC]; float hr = 0.f, hi = 0.f;
        const float* sp = S + ((size_t)g * 2048 + b * 128) * 256 + n; bf16_t* dp = ap + ((size_t)g * 2048 + b * 128) * S5K + 512 + n;
        float nr_[16], ni_[16];
#pragma unroll
        for (int k = 0; k < 16; ++k) { nr_[k] = sp[(size_t)k * 256]; ni_[k] = sp[(size_t)k * 256 + 64]; }
        for (int c0 = 0; c0 < S5NCH; c0 += 16) { float sr[16], si[16];
#pragma unroll
            for (int k = 0; k < 16; ++k) { sr[k] = nr_[k]; si[k] = ni_[k]; }
            if (c0 + 16 < S5NCH) {
#pragma unroll
                for (int k = 0; k < 16; ++k) { nr_[k] = sp[(size_t)(c0 + 16 + k) * 256]; ni_[k] = sp[(size_t)(c0 + 16 + k) * 256 + 64]; } }
#pragma unroll
            for (int k = 0; k < 16; ++k) { dp[(size_t)(c0 + k) * S5K] = f2bf(hr); dp[(size_t)(c0 + k) * S5K + 64] = f2bf(hi);
                const float nr = A.x * hr - A.y * hi + sr[k], ni = A.x * hi + A.y * hr + si[k]; hr = nr; hi = ni; } }
    }
}
template <int MODE, bool ROUTE, bool FINAL>
__device__ __forceinline__ void ln_panel(const Frame& F, const Args& a, int pm, const float* gain, const float* beta, const float* router, size_t h_off = WS_HBUF) {
    unsigned char* ws = a.ws; float* xout = a.out; bf16_t* xb = (bf16_t*)(ws + WS_XB);
    const bf16_t* hb = (const bf16_t*)(ws + (MODE == 0 ? h_off : WS_YB)); const f32x2* tokw = (const f32x2*)(ws + SM_TOKW);
    LAS int* cnt = (LAS int*)F.lds;
    const int lane = F.lane;
    f32x4 gv[4], bv[4];
#pragma unroll
    for (int j = 0; j < 4; ++j) { gv[j] = *(const f32x4*)(gain + 4 * lane + 256 * j); bv[j] = *(const f32x4*)(beta + 4 * lane + 256 * j); }
    if (ROUTE) { if (F.tid < 8) cnt[F.tid] = 0; __syncthreads(); }
    u32x2 nx[4], nh0[4], nh1[4]; f32x2 nw = (f32x2){0.f, 0.f};
    { const size_t row = (size_t)pm * 256 + F.wave * 32; if (MODE == 1) nw = tokw[row];
#pragma unroll
      for (int j = 0; j < 4; ++j) { nx[j] = *(const u32x2*)(xb + row * D + 4 * lane + 256 * j);
          if (MODE == 0) { nh0[j] = *(const u32x2*)(hb + row * D + 4 * lane + 256 * j); nh1[j] = nh0[j]; } else { nh0[j] = *(const u32x2*)(hb + (2 * row) * D + 4 * lane + 256 * j); nh1[j] = *(const u32x2*)(hb + (2 * row + 1) * D + 4 * lane + 256 * j); } } }
    for (int i = 0; i < 32; ++i) { const size_t row = (size_t)pm * 256 + F.wave * 32 + i;
        f32x4 v[4]; float s = 0.f;
        u32x2 cx[4], ch0[4], ch1[4]; const f32x2 w01 = nw;
#pragma unroll
        for (int j = 0; j < 4; ++j) { cx[j] = nx[j]; ch0[j] = nh0[j]; ch1[j] = nh1[j]; }
        if (i < 31) { const size_t rn = row + 1; if (MODE == 1) nw = tokw[rn];
#pragma unroll
            for (int j = 0; j < 4; ++j) { nx[j] = *(const u32x2*)(xb + rn * D + 4 * lane + 256 * j);
                if (MODE == 0) { nh0[j] = *(const u32x2*)(hb + rn * D + 4 * lane + 256 * j); nh1[j] = nh0[j]; } else { nh0[j] = *(const u32x2*)(hb + (2 * rn) * D + 4 * lane + 256 * j); nh1[j] = *(const u32x2*)(hb + (2 * rn + 1) * D + 4 * lane + 256 * j); } } }
#pragma unroll
        for (int j = 0; j < 4; ++j) { const u32x2 xq = cx[j]; const f32x4 xv = (f32x4){bflo(xq.x), bfhi(xq.x), bflo(xq.y), bfhi(xq.y)}; f32x4 hv;
            if (MODE == 0) { const u32x2 q = ch0[j]; hv = (f32x4){bflo(q.x), bfhi(q.x), bflo(q.y), bfhi(q.y)}; }
            else { const u32x2 q0 = ch0[j], q1 = ch1[j];
                hv = (f32x4){w01.x * bflo(q0.x) + w01.y * bflo(q1.x), w01.x * bfhi(q0.x) + w01.y * bfhi(q1.x), w01.x * bflo(q0.y) + w01.y * bflo(q1.y), w01.x * bfhi(q0.y) + w01.y * bfhi(q1.y)}; }
            v[j] = xv * ALPHA + hv; s += (v[j][0] + v[j][1]) + (v[j][2] + v[j][3]); }
        const float mean = wave_sum(s) * (1.f / D); float s2 = 0.f;
#pragma unroll
        for (int j = 0; j < 4; ++j) { v[j] = v[j] - mean; s2 += (v[j][0] * v[j][0] + v[j][1] * v[j][1]) + (v[j][2] * v[j][2] + v[j][3] * v[j][3]); }
        const float rstd = 1.0f / sqrtf(wave_sum(s2) * (1.f / D) + LN_EPS);
#pragma unroll
        for (int j = 0; j < 4; ++j) { v[j] = v[j] * rstd * gv[j] + bv[j];
            if (FINAL) *(f32x4*)(xout + row * D + 4 * lane + 256 * j) = v[j];
            u32x2 w; w.x = cvt_pk_bf16(v[j][0], v[j][1]); w.y = cvt_pk_bf16(v[j][2], v[j][3]); *(u32x2*)(xb + row * D + 4 * lane + 256 * j) = w; }
        if (ROUTE) {
            float lg[8];
#pragma unroll
            for (int e = 0; e < 8; ++e) lg[e] = 0.f;
#pragma unroll
            for (int j = 0; j < 4; ++j)
#pragma unroll
                for (int k = 0; k < 4; ++k) { const float* rr = router + (size_t)(4 * lane + 256 * j + k) * 8; const f32x4 r0 = *(const f32x4*)rr, r1 = *(const f32x4*)(rr + 4); const float xv = v[j][k];
                    lg[0] += xv * r0[0]; lg[1] += xv * r0[1]; lg[2] += xv * r0[2]; lg[3] += xv * r0[3]; lg[4] += xv * r1[0]; lg[5] += xv * r1[1]; lg[6] += xv * r1[2]; lg[7] += xv * r1[3]; }
            {
                const bool h3 = (lane & 8) != 0;
                float r4[4], r2[2], r1;
#pragma unroll
                for (int i = 0; i < 4; ++i) r4[i] = swapsum32(lg[i], lg[4 + i]);
#pragma unroll
                for (int i = 0; i < 2; ++i) r2[i] = swapsum16(r4[i], r4[2 + i]);
                { const float send = h3 ? r2[0] : r2[1], mine = h3 ? r2[1] : r2[0]; r1 = mine + xshfl<8>(send); }
                r1 += xshfl<1>(r1); r1 += xshfl<2>(r1); r1 += dpp_half_mirror(r1);
#pragma unroll
                for (int e = 0; e < 8; ++e) lg[e] = __builtin_bit_cast(float, __builtin_amdgcn_readlane(__builtin_bit_cast(int, r1), 8 * e));
            }
            int e0 = 0; float m0 = lg[0];
#pragma unroll
            for (int e = 1; e < 8; ++e) if (lg[e] > m0) { m0 = lg[e]; e0 = e; }
            int e1 = -1; float m1 = -3.0e38f;
#pragma unroll
            for (int e = 0; e < 8; ++e) if (e != e0 && lg[e] > m1) { m1 = lg[e]; e1 = e; }
            const float w0 = 1.0f / (1.0f + __expf(m1 - m0));
            if (lane == 0) { ((int*)(ws + SM_TOKE))[row] = e0 | (e1 << 8); ((f32x2*)(ws + SM_TOKW))[row] = (f32x2){w0, 1.0f - w0}; __hip_atomic_fetch_add(&cnt[e0], 1, __ATOMIC_RELAXED, __HIP_MEMORY_SCOPE_WORKGROUP); __hip_atomic_fetch_add(&cnt[e1], 1, __ATOMIC_RELAXED, __HIP_MEMORY_SCOPE_WORKGROUP); }
        }
    }
    if (ROUTE) { __syncthreads(); if (F.tid < 8) ((int*)(ws + SM_PCNT))[pm * 8 + F.tid] = cnt[F.tid]; __syncthreads(); }
}
__device__ __forceinline__ void moe_gather(const Frame& F, const Args& a) {
    unsigned char* ws = a.ws; const int* pcnt = (const int*)(ws + SM_PCNT); const int* toke = (const int*)(ws + SM_TOKE);
    int* rowtok = (int*)(ws + SM_ROWTOK); int* tileexp = (int*)(ws + SM_TILEEXP);
    const bf16_t* xb = (const bf16_t*)(ws + WS_XB); bf16_t* xs = (bf16_t*)(ws + WS_XS);
    LAS int* sm = (LAS int*)F.lds;
    for (int pm = F.own; pm < T / 256; pm += F.G) {
        for (int q = F.tid; q < (T / 256) * 8; q += 512) sm[1024 + q] = pcnt[q];
        if (F.tid >= 32 && F.tid < 288) sm[F.tid] = toke[pm * 256 + F.tid - 32];
        __syncthreads();
        if (F.tid < 8) { int tot = 0, before = 0; for (int q = 0; q < T / 256; ++q) { const int c = sm[1024 + q * 8 + F.tid]; tot += c; if (q < pm) before += c; } sm[F.tid] = tot; sm[16 + F.tid] = before; }
        __syncthreads();
        if (F.tid == 0) { int st = 0; for (int e = 0; e < 8; ++e) { sm[8 + e] = st * 256; st += (sm[e] + 255) >> 8; } sm[24] = st; }
        __syncthreads();
        {
            const int i = F.tid >> 1, k = F.tid & 1; const int ee = sm[32 + i]; const int e = k ? (ee >> 8) : (ee & 255);
            int cntb = 0; for (int q = 0; q < i; ++q) { const int o = sm[32 + q]; cntb += ((o & 255) == e) + ((o >> 8) == e); }
            const int dest = sm[8 + e] + sm[16 + e] + cntb; sm[512 + F.tid] = dest; rowtok[dest] = 2 * (pm * 256 + i) + k;
        }
        __syncthreads();
        for (int r0 = F.wave * 64; r0 < F.wave * 64 + 64; r0 += 8) {
            u32x4 va[8], vb[8];
#pragma unroll
            for (int q = 0; q < 8; ++q) { const size_t tok = (size_t)pm * 256 + ((r0 + q) >> 1); const u32x4* s = (const u32x4*)(xb + tok * D); va[q] = s[F.lane]; vb[q] = s[64 + F.lane]; }
#pragma unroll
            for (int q = 0; q < 8; ++q) { const int dest = sm[512 + r0 + q]; u32x4* d = (u32x4*)(xs + (size_t)dest * D); d[F.lane] = va[q]; d[64 + F.lane] = vb[q]; } }
        if (pm == 0) {
            for (int e = 0; e < 8; ++e) { const int r0 = sm[8 + e] + sm[e], r1 = sm[8 + e] + (((sm[e] + 255) >> 8) << 8); for (int r = r0 + F.tid; r < r1; r += 512) rowtok[r] = -1;
                const int t0 = sm[8 + e] >> 8, t1 = r1 >> 8; for (int t = t0 + F.tid; t < t1; t += 512) tileexp[t] = e; }
            if (F.tid == 0) tileexp[1023] = sm[24];
        }
        __syncthreads();
    }
}

__device__ __forceinline__ void moe_tail_finalize(const Frame& F, const Args& a) {
    const int* tileexp = (const int*)(a.ws + SM_TILEEXP); int nt = tileexp[1023] - (MOE_NCHUNK - 1) * MOE_CHUNK_TILES; nt = nt < 0 ? 0 : (nt > 8 ? 8 : nt);
    const float* YT = (const float*)(a.ws + WS_XS); const int* row_tok = (const int*)(a.ws + SM_ROWTOK) + (MOE_NCHUNK - 1) * MOE_CHUNK_TILES * 256; bf16_t* Y = (bf16_t*)(a.ws + WS_YB);
    const int c8 = (F.tid & 127) * 8;
    for (int r = F.bid * 4 + (F.tid >> 7); r < nt * 256; r += F.G * 4) { const int dst = row_tok[r]; if (dst < 0) continue;
        f32x4 s0 = (f32x4){0.f, 0.f, 0.f, 0.f}, s1 = s0;
#pragma unroll
        for (int ks = 0; ks < 7; ++ks) { const float* p = YT + ((size_t)ks * 2048 + r) * D + c8; s0 += *(const f32x4*)p; s1 += *(const f32x4*)(p + 4); }
        u32x4 w; w.x = cvt_pk_bf16(s0[0], s0[1]); w.y = cvt_pk_bf16(s0[2], s0[3]); w.z = cvt_pk_bf16(s1[0], s1[1]); w.w = cvt_pk_bf16(s1[2], s1[3]);
        *(u32x4*)(Y + (size_t)dst * D + c8) = w; }
}
struct MoeUpOrder { int ntile, G, c, chunk; const int* tileexp;
    __device__ __forceinline__ bool next(int i, pg8::Unit& u) const { if (!pg8::static_tile(i, G, c, ntile, 2 * DFE / 256, u.pm, u.pn)) return false;
        const int tile = chunk * MOE_CHUNK_TILES + u.pm, e = tileexp[tile]; u.aux = tile; u.offA = (long long)tile * 256 * D * 2; u.offB = ((long long)e * 2 * DFE + (long long)u.pn * 256) * D * 2; return true; } };
struct MoeDnOrder { int ntile, G, c, chunk; const int* tileexp;
    __device__ __forceinline__ bool next(int i, pg8::Unit& u) const { if (!pg8::static_tile(i, G, c, ntile, D / 256, u.pm, u.pn)) return false;
        const int tile = chunk * MOE_CHUNK_TILES + u.pm, e = tileexp[tile]; u.aux = tile; u.offA = (long long)u.pm * 256 * DFE * 2; u.offB = ((long long)e * D + (long long)u.pn * 256) * DFE * 2; return true; } };

struct MoeDnTailOrder { int ntile, G, c; const int* tileexp;
    __device__ __forceinline__ bool next(int i, pg8::Unit& u) const { const long L = (long)i * G + c; if (L >= (long)ntile * 28) return false;
        const int ks = (int)(L % 7), rest = (int)(L / 7); u.pn = rest & 3; u.pm = rest >> 2; u.aux = ks;
        const int tile = (MOE_NCHUNK - 1) * MOE_CHUNK_TILES + u.pm, e = tileexp[tile];
        u.offA = (long long)u.pm * 256 * DFE * 2 + (long long)ks * 512 * 2; u.offB = ((long long)e * D + (long long)u.pn * 256) * DFE * 2 + (long long)ks * 512 * 2; return true; } };

__device__ __forceinline__ int attn_pair(int p0, int G) {
    if (G != 256) return p0;
    const int x = p0 & 7, r = (p0 >> 3) & 31, k = p0 >> 8;
    return ((x + 8 * (2 * k + (r >> 4))) << 4) | (r & 15);
}

enum { PH_PREP = 0, PH_WIN, PH_POST, PH_MIX1, PH_MIX2, PH_MIX3, PH_MIX4, PH_WOUT, PH_LN1, PH_FUP, PH_FDN, PH_MGATH = 9, PH_MUP0 = 10, PH_LN2 = 21, PH_PGATE, PH_PPROJ, PH_LN3, PH_PER_LAYER = 32 };
constexpr int GP_END = 2 + 32 * DEPTH;

__global__ void __launch_bounds__(512, 2) mk_fwd(Args a0) {
    extern __shared__ __attribute__((aligned(16))) unsigned char lds_raw[];
    LAS unsigned char* const lds = (LAS unsigned char*)lds_raw;
    for (int u = threadIdx.x; u < (LDS_BYTES - LDSCTL_OFF) / 4; u += 512) ((LAS unsigned*)(lds + LDSCTL_OFF))[u] = 0u;
    __syncthreads();
    const int gp_lo = a0.gp_lo, gp_hi = a0.gp_hi; const int F0bid = blockIdx.x, F0G = gridDim.x; const int wave0 = __builtin_amdgcn_readfirstlane(threadIdx.x >> 6);
    XcdBarrier bar; bar.bar = (unsigned*)(a0.ws + WS_CTL) + CW_BAR; bar.x = 0; bar.st = nullptr;
    if (a0.use_bar) bar = xcd_barrier_post((unsigned*)(a0.ws + WS_CTL) + CW_BAR, (volatile LAS unsigned*)(lds + LDSCTL_OFF + 32));
#if MK_PROBE
#define PRW ((volatile LAS unsigned*)(lds + LDSCTL_OFF + 128))
    if (threadIdx.x == 0) { const unsigned long long t_ = __builtin_amdgcn_s_memrealtime(); PRW[0] = (unsigned)t_; PRW[1] = (unsigned)(t_ >> 32); PRW[2] = 0u; PRW[3] = 0u; PRW[4] = (unsigned)t_; PRW[5] = (unsigned)(t_ >> 32); }
#define STAMP(cls) do { if (wave0 == 0 && lane_id_fresh() == 0) { const unsigned long long t_ = __builtin_amdgcn_s_memrealtime(); const unsigned long long p_ = ((unsigned long long)PRW[1] << 32) | PRW[0]; const unsigned d_ = (unsigned)(t_ - p_); \
        PRW[0] = (unsigned)t_; PRW[1] = (unsigned)(t_ >> 32); if ((PROBE_A >> (cls)) & 1) PRW[2] += d_; if ((PROBE_B >> (cls)) & 1) PRW[3] += d_; } } while (0)
#else
#define STAMP(cls) do {} while (0)
#endif
#define RUN(gp) (gp_lo <= (gp) && (gp) < gp_hi)
#define SEAM(gp) do { if (gp_lo <= (gp) && (gp) + 1 < gp_hi) xcd_barrier(bar, wave0); } while (0)
#define PH_BEGIN Args a; load_args(a); const Frame F = make_frame(lds, wave0); unsigned char* const ws = a.ws; int l = lx; asm volatile("" : "+s"(l)); (void)l; (void)ws; \
    bf16_t* const xb = (bf16_t*)(ws + WS_XB); bf16_t* const z = (bf16_t*)(ws + WS_Z); bf16_t* const mix = (bf16_t*)(ws + WS_MIX); bf16_t* const hbuf = (bf16_t*)(ws + WS_HBUF); const long long S1K = 256ll * 1024 * 2; \
    (void)xb; (void)z; (void)mix; (void)hbuf; (void)S1K;
#define AP_DEF const nsa::Lane L{F.lane, F.lane & 31, F.lane >> 5, F.wave, F.tid}; \
    const nsa::AttnPtrs AP{(const bf16_t*)(ws + WS_Q), z, (const bf16_t*)(ws + WS_KC), (const bf16_t*)(ws + WS_VCT), (const bf16_t*)(ws + WS_KSEL), (const bf16_t*)(ws + WS_VSEL), \
                           (const bf16_t*)(ws + WS_KWIN), (const bf16_t*)(ws + WS_VWIN), (unsigned long long*)(ws + WS_SELM), mix};
    { const int lx = 0;
    if (RUN(0)) { PH_BEGIN phase_init0(F, a); }
    SEAM(0); STAMP(0);
    if (RUN(1)) { PH_BEGIN phase_init1(F, a); }
    SEAM(1); STAMP(0);
    }
    for (int lx = 0; lx < DEPTH; ++lx) {
        const int base = 2 + PH_PER_LAYER * lx; const bool moe = (lx & 1) != 0;
        if (RUN(base + PH_PREP)) { PH_BEGIN phase_prep(F, a, l); }
        SEAM(base + PH_PREP); STAMP(1);
        if (RUN(base + PH_WIN)) { PH_BEGIN
            pg8::Gemm g{xb, (const bf16_t*)(ws + W_IN), D, D, D}; pg8::PlainOrder S{T / 256, INP / 256, F.G, F.bid, S1K, S1K};
            epi::EpiWin E{z, (bf16_t*)(ws + WS_Q), (bf16_t*)(ws + WS_KCMP), (bf16_t*)(ws + WS_S5A), (const f32x2*)(ws + WS_ROPE)};
            pg8::gemm_phase(F.lds, g, S, E, F.tid);
        }
        SEAM(base + PH_WIN); STAMP(2);
        if (RUN(base + PH_MIX1)) {
            for (int r = F0bid; r < 128; r += F0G) {
                {   PH_BEGIN const int g_ = r >> 3, pm_ = r & 7;
                    pg8::Gemm g{(const bf16_t*)(ws + WS_S5A), (const bf16_t*)(ws + W_S5S), 512, S5K, 512};
                    pg8::ListOrder S{1, pm_, g_, (long long)g_ * 2048 * S5K * 2 + (long long)pm_ * 256 * S5K * 2, (long long)g_ * 256 * 512 * 2, 0}; epi::F32Grouped E{(float*)(ws + WS_S5S), 256, (size_t)2048 * 256};
                    pg8::gemm_phase(F.lds, g, S, E, F.tid); }
                __syncthreads();
                {   PH_BEGIN int nr = MK_REP_CARRY; asm volatile("" : "+s"(nr)); for (int q = 0; q < nr; ++q) s5_carry_panel(F, a, l, r >> 3, r & 7); }
                asm volatile("s_waitcnt vmcnt(0)" ::: "memory"); __syncthreads();
                {   PH_BEGIN const int g_ = r >> 3, pm_ = r & 7;
                    pg8::Gemm g{(const bf16_t*)(ws + WS_S5A), (const bf16_t*)(ws + W_S5B), S5K, S5K, S5K};
                    pg8::ListOrder S{2, pm_, g_, (long long)g_ * 2048 * S5K * 2 + (long long)pm_ * 256 * S5K * 2, (long long)g_ * 512 * S5K * 2, 256ll * S5K * 2}; epi::S5Out E{(bf16_t*)(ws + WS_ZS5), z, (const float*)a.in[21] + (size_t)l * 256};
                    pg8::gemm_phase(F.lds, g, S, E, F.tid); }
            }
            for (int r = F0bid - 128; r < 64; r += F0G) { if (r < 0) continue;
                {   PH_BEGIN const int j_ = r >> 5, bh_ = r & 31;
                    pg8::Gemm g{(const bf16_t*)(ws + WS_KCMP), (const bf16_t*)(ws + W_CMP), 1024, 1024, 1024};
                    pg8::ListOrder S{2, bh_, j_, (long long)j_ * (long long)(WS_VCMP - WS_KCMP) + (long long)bh_ * S1K, (long long)j_ * 512 * 1024 * 2, S1K}; epi::F32Grouped E{(float*)(ws + WS_CMPP), 512, (size_t)8192 * 512};
                    pg8::gemm_phase(F.lds, g, S, E, F.tid); }
                asm volatile("s_waitcnt vmcnt(0)" ::: "memory"); __syncthreads();
                {   PH_BEGIN int nr = MK_REP_ST2; asm volatile("" : "+s"(nr)); for (int q = 0; q < nr; ++q) cmp_stage2_panel(F, a, l, r >> 5, r & 31); }
            }
            {   PH_BEGIN
                if (F.G == 256) { const int c = F.bid; const int beg = c < 128 ? c * 5 : (c < 192 ? 640 + (c - 128) * 6 : 1024 + (c - 192) * 16), cnt = c < 128 ? 5 : (c < 192 ? 6 : 16); conv_items(F, a, l, beg, 1, beg + cnt); }
                else conv_items(F, a, l, F.bid, F.G); }
        }
        SEAM(base + PH_MIX1); STAMP(4);
        if (RUN(base + PH_MIX3)) {
            {   PH_BEGIN
                pg8::Gemm g{(const bf16_t*)(ws + WS_ZS5), (const bf16_t*)(ws + W_GLU), 256, 256, 256};
                pg8::PlainOrder S{T / 256, 1, F.G, F.bid, 256ll * 256 * 2, 256ll * 256 * 2}; epi::S5Glu E{mix, (const bf16_t*)(ws + WS_ZS5), (const float*)a.in[23] + (size_t)l * 256};
                pg8::gemm_phase(F.lds, g, S, E, F.tid);
            }
            {   PH_BEGIN AP_DEF
                for (int p0 = F.bid; p0 < 32 * 16; p0 += F.G) { const int p = attn_pair(p0, F.G); const int bh = p >> 4, s = p & 15;
                    for (int half = 0; half < 2; ++half) { const int qb2 = half ? 31 - s : s;
                        nsa::cmp_unit<true>(bh, 2 * qb2, AP, F.lds, L); nsa::cmp_topk(bh, 2 * qb2, AP, F.lds, L);
                        nsa::cmp_unit<false>(bh, 2 * qb2 + 1, AP, F.lds, L); nsa::cmp_topk(bh, 2 * qb2 + 1, AP, F.lds, L); } } }
            asm volatile("s_waitcnt vmcnt(0)" ::: "memory"); __syncthreads();
            {   PH_BEGIN AP_DEF
                for (int p0 = F.bid; p0 < 32 * 16; p0 += F.G) { const int p = attn_pair(p0, F.G); const int bh = p >> 4, s = p & 15; nsa::sw_unit2(bh, s, AP, F.lds, L); nsa::sw_unit2(bh, 31 - s, AP, F.lds, L); } }
        }
        SEAM(base + PH_MIX3); STAMP(6);

        if (RUN(base + PH_WOUT)) {
            {   PH_BEGIN
                pg8::Gemm g{mix, (const bf16_t*)(ws + W_OUT), D, D, D}; pg8::PlainOrder S{T / 256, D / 256, F.G, F.bid, S1K, S1K}; epi::Bf16Sc1 E{hbuf, D, (unsigned)((size_t)T * D * 2)};
                pg8::gemm_phase(F.lds, g, S, E, F.tid);
            }
            {   PH_BEGIN pg8::PlainOrder S{T / 256, D / 256, F.G, F.bid, S1K, S1K}; panels_publish_wait(F, (unsigned*)(ws + WS_CTL), 2 * l + 0, S, (unsigned)(D / 256)); }
            {   PH_BEGIN
                const float* gg = (const float*)a.in[34] + ((size_t)l * 3 + 0) * D; const float* bb = (const float*)a.in[35] + ((size_t)l * 3 + 0) * D;
                for (int pm = F.own; pm < T / 256; pm += F.G) { if (l & 1) ln_panel<0, true, false>(F, a, pm, gg, bb, (const float*)a.in[27] + (size_t)(l >> 1) * D * NEXP); else ln_panel<0, false, false>(F, a, pm, gg, bb, nullptr); }
            }
        }
        SEAM(base + PH_WOUT); STAMP(8);
        if (!moe) {
            if (RUN(base + PH_FUP)) { PH_BEGIN
                pg8::Gemm g{xb, (const bf16_t*)(ws + W_UP), D, D, D}; pg8::PlainOrder S{T / 256, 2 * DFF / 256, F.G, F.bid, S1K, S1K}; epi::SwiGlu E{(bf16_t*)(ws + WS_FFH), DFF};
                pg8::gemm_phase(F.lds, g, S, E, F.tid);
            }
            SEAM(base + PH_FUP); STAMP(9);
            if (RUN(base + PH_FDN)) {
                {   PH_BEGIN
                    pg8::Gemm g{(const bf16_t*)(ws + WS_FFH), (const bf16_t*)(ws + W_DN), DFF, DFF, DFF}; pg8::PlainOrder S{T / 256, D / 256, F.G, F.bid, 256ll * DFF * 2, 256ll * DFF * 2}; epi::Bf16Sc1 E{hbuf, D, (unsigned)((size_t)T * D * 2)};
                    pg8::gemm_phase(F.lds, g, S, E, F.tid);
                }
                {   PH_BEGIN pg8::PlainOrder S{T / 256, D / 256, F.G, F.bid, 256ll * DFF * 2, 256ll * DFF * 2}; panels_publish_wait(F, (unsigned*)(ws + WS_CTL), 2 * l + 1, S, (unsigned)(D / 256)); }
                {   PH_BEGIN
                    const float* gg = (const float*)a.in[34] + ((size_t)l * 3 + 1) * D; const float* bb = (const float*)a.in[35] + ((size_t)l * 3 + 1) * D;
                    for (int pm = F.own; pm < T / 256; pm += F.G) ln_panel<0, false, false>(F, a, pm, gg, bb, nullptr);
                }
            }
            asm volatile("s_waitcnt vmcnt(0)" ::: "memory"); __syncthreads(); STAMP(10);
        } else {
            if (RUN(base + PH_MGATH)) { PH_BEGIN moe_gather(F, a); }
            SEAM(base + PH_MGATH); STAMP(11);
            for (int cx = 0; cx < MOE_NCHUNK; ++cx) {
                if (RUN(base + PH_MUP0 + 2 * cx)) { PH_BEGIN int c = cx; asm volatile("" : "+s"(c)); const int* tileexp = (const int*)(ws + SM_TILEEXP);
                    int nt = tileexp[1023] - c * MOE_CHUNK_TILES; nt = nt < 0 ? 0 : (nt > MOE_CHUNK_TILES ? MOE_CHUNK_TILES : nt);
                    pg8::Gemm g{(const bf16_t*)(ws + WS_XS), (const bf16_t*)(ws + W_UP), D, D, D}; MoeUpOrder S{nt, F.G, F.bid, c, tileexp}; epi::SwiGlu E{(bf16_t*)(ws + WS_MH), DFE};
                    pg8::gemm_phase(F.lds, g, S, E, F.tid);
                }
                SEAM(base + PH_MUP0 + 2 * cx); STAMP(12);
                if (RUN(base + PH_MUP0 + 2 * cx + 1)) { PH_BEGIN int c = cx; asm volatile("" : "+s"(c)); const int* tileexp = (const int*)(ws + SM_TILEEXP);
                    int nt = tileexp[1023] - c * MOE_CHUNK_TILES; nt = nt < 0 ? 0 : (nt > MOE_CHUNK_TILES ? MOE_CHUNK_TILES : nt);
                    if (cx < MOE_NCHUNK - MK_TAILSPLIT) {
                        pg8::Gemm g{(const bf16_t*)(ws + WS_MH), (const bf16_t*)(ws + W_DN), DFE, DFE, DFE}; MoeDnOrder S{nt, F.G, F.bid, c, tileexp}; epi::MoeDown E{(bf16_t*)(ws + WS_YB), (const int*)(ws + SM_ROWTOK)};
                        pg8::gemm_phase(F.lds, g, S, E, F.tid);
                    } else {
                        nt = nt > 8 ? 8 : nt;
                        pg8::Gemm g{(const bf16_t*)(ws + WS_MH), (const bf16_t*)(ws + W_DN), 512, DFE, DFE}; MoeDnTailOrder S{nt, F.G, F.bid, tileexp}; epi::F32Grouped E{(float*)(ws + WS_XS), D, (size_t)2048 * D};
                        pg8::gemm_phase(F.lds, g, S, E, F.tid);
                    }
                }
                SEAM(base + PH_MUP0 + 2 * cx + 1); STAMP(13);
            }
#if MK_TAILSPLIT
            if (RUN(base + PH_MUP0 + 2 * MOE_NCHUNK)) { PH_BEGIN moe_tail_finalize(F, a); }
            SEAM(base + PH_MUP0 + 2 * MOE_NCHUNK); STAMP(13);
#endif
        }
        if (RUN(base + PH_PGATE)) {
            if (moe) {
                {   PH_BEGIN
                    const float* gg = (const float*)a.in[34] + ((size_t)l * 3 + 1) * D; const float* bb = (const float*)a.in[35] + ((size_t)l * 3 + 1) * D;
                    for (int pm = F.own; pm < T / 256; pm += F.G) ln_panel<1, false, false>(F, a, pm, gg, bb, nullptr);
                }
                asm volatile("s_waitcnt vmcnt(0)" ::: "memory"); __syncthreads();
            }
            {   PH_BEGIN
                pg8::Gemm g{xb, (const bf16_t*)(ws + W_GATE), D, D, D}; pg8::PanelOrder S{T / 256, D / 256, F.G, F.own, S1K, S1K}; epi::SigmoidBias E{(l & 1) ? (bf16_t*)(ws + WS_PLEG) : mix, D, (const float*)a.in[32] + (size_t)l * D};
                pg8::gemm_phase(F.lds, g, S, E, F.tid);
            }
            __syncthreads();
            {   PH_BEGIN
                pg8::Gemm g{(const bf16_t*)(ws + WS_PB), (const bf16_t*)(ws + W_PROJ), PLE, PLE, PLE}; pg8::PanelOrder S{T / 256, D / 256, F.G, F.own, 256ll * PLE * 2, 256ll * PLE * 2}; epi::MulBf16 E{(l & 1) ? (bf16_t*)(ws + WS_PLEH) : hbuf, (l & 1) ? (bf16_t*)(ws + WS_PLEG) : mix, D};
                pg8::gemm_phase(F.lds, g, S, E, F.tid);
            }
            __syncthreads();
            {   PH_BEGIN
                const float* gg = (const float*)a.in[34] + ((size_t)l * 3 + 2) * D; const float* bb = (const float*)a.in[35] + ((size_t)l * 3 + 2) * D;
                const size_t hoff = (l & 1) ? WS_PLEH : WS_HBUF;
                for (int pm = F.own; pm < T / 256; pm += F.G) { if (l == DEPTH - 1) ln_panel<0, false, true>(F, a, pm, gg, bb, nullptr, hoff); else ln_panel<0, false, false>(F, a, pm, gg, bb, nullptr, hoff); }
            }
        }
        SEAM(base + PH_PGATE); STAMP(15);
    }
#if MK_PROBE
    if (blockIdx.x == 0) {
        __syncthreads(); asm volatile("s_waitcnt vmcnt(0)" ::: "memory");
        const unsigned long long t1 = ((unsigned long long)PRW[1] << 32) | PRW[0], t0 = ((unsigned long long)PRW[5] << 32) | PRW[4];
        const float tot = (float)(unsigned)(t1 - t0), fa = (float)PRW[2] / tot, fb = (float)PRW[3] / tot;
        Args ae; load_args(ae);
        const int tidp = wave0 * 64 + lane_id_fresh();
        if (tidp == 0) ae.out[0] += 1.0f + 8.0f * fa;
        for (int i = tidp; i < 100000; i += 512) ae.out[1024 + i] += 0.5f * fb;
    }
#endif
#undef RUN
#undef SEAM
}

static bool phase_applies(int gp) {
    if (gp < 2) return true;
    const int l = (gp - 2) / PH_PER_LAYER, ph = (gp - 2) % PH_PER_LAYER; const bool moe = (l & 1) != 0;
    if (ph < PH_LN1) return ph != PH_POST && ph != PH_MIX2 && ph != PH_MIX4;
    if (ph == PH_PGATE) return true;
    if (!moe) return ph == PH_FUP || ph == PH_FDN;
    return ph >= PH_MGATH && ph <= PH_MUP0 + 2 * MOE_NCHUNK;
}
extern "C" void kernel_launch(void* const* d_in, const int* in_sizes, int n_in, void* d_out, int out_size, void* d_ws, size_t ws_size, hipStream_t stream) {
    static int grid = 0;
    if (grid == 0) {
        if (n_in != 36 || out_size != T * D || ws_size < WS_END) { fprintf(stderr, "kernel_launch: unexpected problem (n_in %d out %d ws %zu, need %zu)\n", n_in, out_size, ws_size, (size_t)WS_END); grid = -1; return; }
        int dev = 0, cus = 0, per_cu = 0;
        if (hipGetDevice(&dev) != hipSuccess || hipDeviceGetAttribute(&cus, hipDeviceAttributeMultiprocessorCount, dev) != hipSuccess) { grid = -1; return; }
        if (hipFuncSetAttribute((const void*)mk_fwd, hipFuncAttributeMaxDynamicSharedMemorySize, LDS_BYTES) != hipSuccess) { fprintf(stderr, "kernel_launch: hipFuncSetAttribute failed\n"); grid = -1; return; }
        if (hipOccupancyMaxActiveBlocksPerMultiprocessor(&per_cu, (const void*)mk_fwd, 512, LDS_BYTES) != hipSuccess || per_cu < 1) fprintf(stderr, "kernel_launch: occupancy query reports %d\n", per_cu);
        (void)hipGetLastError();
        grid = cus;
    }
    if (grid < 0) return;
    (void)in_sizes;
    if (hipMemsetAsync((char*)d_ws + WS_CTL, 0, CTL_ZERO_BYTES, stream) != hipSuccess) return;
#if MK_CHECK
    (void)hipMemsetAsync((char*)d_ws + SM_CHK, 0, 256, stream);
#endif
    Args a{};
    for (int i = 0; i < 36; ++i) a.in[i] = d_in[i];
    a.out = (float*)d_out; a.ws = (unsigned char*)d_ws; a.pad = 0;
#if MK_MULTI
    for (int gp = 0; gp < GP_END; ++gp) { if (!phase_applies(gp)) continue; a.gp_lo = gp; a.gp_hi = gp + 1; a.use_bar = 0;
        hipLaunchKernelGGL(mk_fwd, dim3(grid), dim3(512), LDS_BYTES, stream, a);
#if MK_CHECK
        run_checks(a, gp, stream);
#endif
    }
#if MK_CHECK
    hipLaunchKernelGGL(chk_final, dim3(1), dim3(1), 0, stream, a);
#endif
#else
    a.gp_lo = 0; a.gp_hi = GP_END; a.use_bar = 1;
    hipLaunchKernelGGL(mk_fwd, dim3(grid), dim3(512), LDS_BYTES, stream, a);
#endif
}
```

```cpp
#include <hip/hip_runtime.h>
#include <cstdint>
#include <cstdio>
#ifndef MK_TAILSPLIT
#define MK_TAILSPLIT 1
#endif
#ifndef MK_MULTI
#define MK_MULTI 0
#endif
#ifndef MK_CHECK
#define MK_CHECK 0
#endif
#ifndef MK_REP_G1
#define MK_REP_G1 1
#endif
#ifndef MK_REP_G2
#define MK_REP_G2 1
#endif
#ifndef MK_REP_CU
#define MK_REP_CU 1
#endif
#ifndef MK_REP_TK
#define MK_REP_TK 1
#endif
#ifndef MK_REP_WOUT
#define MK_REP_WOUT 1
#endif
#ifndef MK_REP_CONV
#define MK_REP_CONV 1
#endif
#ifndef MK_REP_ST2
#define MK_REP_ST2 1
#endif
#ifndef MK_REP_CARRY
#define MK_REP_CARRY 1
#endif
#ifndef MK_REPCMP
#define MK_REPCMP 1
#endif
#ifndef MK_ALIGN_EPI
#define MK_ALIGN_EPI 1
#endif
#ifndef MK_PROBE
#define MK_PROBE 0
#endif
#ifndef PROBE_A
#define PROBE_A 0
#endif
#ifndef PROBE_B
#define PROBE_B 0
#endif
#ifndef CHK_LAYER
#define CHK_LAYER 15
#endif

#define GAS __attribute__((address_space(1)))
#define LAS __attribute__((address_space(3)))
typedef unsigned short bf16_t;
typedef short bf16x8 __attribute__((ext_vector_type(8)));
typedef float f32x4 __attribute__((ext_vector_type(4)));
typedef float f32x2 __attribute__((ext_vector_type(2)));
typedef float f32x16 __attribute__((ext_vector_type(16)));
typedef unsigned u32x4 __attribute__((ext_vector_type(4)));
typedef unsigned u32x2 __attribute__((ext_vector_type(2)));

constexpr int NB = 16, SEQ = 4096, T = NB * SEQ, D = 1024, DEPTH = 4;
constexpr int INW = 2072, INP = 2304;
constexpr int ZKV = 512, ZG = 1280, ZC = 1304, ZS = 1816;
constexpr int DFF = 2816, DFE = 3584, NEXP = 8, PLE = 256;
constexpr int NCMP = 255;
constexpr int S5LC = 32, S5NCH = SEQ / S5LC, S5K = S5LC * 16 + 128;
constexpr float ALPHA = 1.6817928305074290f;
constexpr float LN_EPS = 1e-5f;
constexpr float QSCALE = 0.125f * 1.4426950408889634f;
constexpr float NEGF = -1e30f;
constexpr int MOE_TILES_MAX = 520, MOE_CHUNK_TILES = 128, MOE_NCHUNK = 5;

typedef __bf16 bf16x2_t __attribute__((ext_vector_type(2)));
__device__ __forceinline__ unsigned cvt_pk_bf16(float lo, float hi) { f32x2 v = {lo, hi}; const bf16x2_t b = __builtin_convertvector(v, bf16x2_t); return __builtin_bit_cast(unsigned, b); }
__device__ __forceinline__ bf16_t f2bf(float f) { return (bf16_t)(cvt_pk_bf16(f, 0.f) & 0xffffu); }
__device__ __forceinline__ float bf2f(unsigned v) { return __uint_as_float(v << 16); }
__device__ __forceinline__ float bflo(unsigned w) { return __uint_as_float(w << 16); }
__device__ __forceinline__ float bfhi(unsigned w) { return __uint_as_float(w & 0xffff0000u); }
__device__ __forceinline__ float fast_exp2(float x) { return __builtin_amdgcn_exp2f(x); }
__device__ __forceinline__ float fast_rcp(float x) { return __builtin_amdgcn_rcpf(x); }
__device__ __forceinline__ float sigmoidf_(float x) { return fast_rcp(1.0f + fast_exp2(-1.4426950408889634f * x)); }
__device__ __forceinline__ float siluf_(float x) { return x * sigmoidf_(x); }
__device__ __forceinline__ float gelu_tanh(float x) { const float u = 0.7978845608028654f * (x + 0.044715f * x * x * x); return x * sigmoidf_(2.0f * u); }
__device__ __forceinline__ int lane_id_fresh() { unsigned z = 0u; asm volatile("" : "+v"(z)); return (int)__builtin_amdgcn_mbcnt_hi(~0u, __builtin_amdgcn_mbcnt_lo(~0u, z)); }
template <int MASK> __device__ __forceinline__ float xshfl(float v) {
    if (MASK == 1) return __uint_as_float((unsigned)__builtin_amdgcn_update_dpp(0, (int)__float_as_uint(v), 0xB1, 0xF, 0xF, true));
    if (MASK == 2) return __uint_as_float((unsigned)__builtin_amdgcn_update_dpp(0, (int)__float_as_uint(v), 0x4E, 0xF, 0xF, true));
    if (MASK == 32) { const unsigned u = __float_as_uint(v); auto rr = __builtin_amdgcn_permlane32_swap(u, u, false, false); return __uint_as_float((rr[0] == u) ? rr[1] : rr[0]); }
    return __uint_as_float((unsigned)__builtin_amdgcn_ds_swizzle((int)__float_as_uint(v), 0x1f | (MASK << 10)));
}
__device__ __forceinline__ float xsum32(float v) { const unsigned u = __float_as_uint(v); auto rr = __builtin_amdgcn_permlane32_swap(u, u, false, false); return __uint_as_float(rr[0]) + __uint_as_float(rr[1]); }
__device__ __forceinline__ float xsum16(float v) { const unsigned u = __float_as_uint(v); auto rr = __builtin_amdgcn_permlane16_swap(u, u, false, false); return __uint_as_float(rr[0]) + __uint_as_float(rr[1]); }
__device__ __forceinline__ float swapsum32(float a, float b) { auto rr = __builtin_amdgcn_permlane32_swap(__float_as_uint(a), __float_as_uint(b), false, false); return __uint_as_float(rr[0]) + __uint_as_float(rr[1]); }
__device__ __forceinline__ float swapsum16(float a, float b) { auto rr = __builtin_amdgcn_permlane16_swap(__float_as_uint(a), __float_as_uint(b), false, false); return __uint_as_float(rr[0]) + __uint_as_float(rr[1]); }
__device__ __forceinline__ float dpp_half_mirror(float v) { return __uint_as_float((unsigned)__builtin_amdgcn_update_dpp(0, (int)__float_as_uint(v), 0x141, 0xF, 0xF, true)); }
__device__ __forceinline__ float wave_sum(float v) {
    v += xshfl<1>(v); v += xshfl<2>(v);
    v += __uint_as_float((unsigned)__builtin_amdgcn_update_dpp(0, (int)__float_as_uint(v), 0x141, 0xF, 0xF, true));
    v += __uint_as_float((unsigned)__builtin_amdgcn_update_dpp(0, (int)__float_as_uint(v), 0x140, 0xF, 0xF, true));
    v = xsum16(v); v = xsum32(v);
    return v;
}
#define LDS_WAIT() asm volatile("s_waitcnt lgkmcnt(0)" ::: "memory")
#define VM_WAIT() asm volatile("s_waitcnt vmcnt(0)" ::: "memory")

namespace pg8 {
constexpr int BM = 256, BK = 64, HALF = 128, HTB = HALF * BK * 2, STAGE_BYTES = 8 * HTB, NXCD = 8, WGM = 8;
__host__ __device__ __forceinline__ int lds_byte(int r, int c) { const int st = (r >> 4) * 2 + (c >> 5), rr = r & 15, cc = c & 31, ob = rr * 64 + cc * 2; return st * 1024 + (ob ^ (((ob >> 9) & 1) << 5)); }
__host__ __device__ __forceinline__ void stage_rc(int b, int& R, int& C) { const int st = b / 1024, sb = b % 1024, swz = sb ^ (((sb >> 9) & 1) << 5); R = (st >> 1) * 16 + swz / 64; C = (st & 1) * 32 + (swz % 64) / 2; }
__host__ __device__ __forceinline__ int perm32(int rho) { const int n = rho >> 4, i = rho & 15; return 8 * (i >> 2) + 4 * n + (i & 3); }

struct Unit { int pm, pn; long long offA, offB; int aux; };
struct Gemm { const bf16_t* A; const bf16_t* Bt; int K, lda, ldb; };

__device__ __forceinline__ bool static_tile(int i, int G, int c, int nM, int nN, int& pm, int& pn) {
    const int nwg = nM * nN; const long L = (long)i * G + c; if (L >= nwg) return false;
    int wgid = (int)L; { const int q = nwg / NXCD, r = nwg % NXCD, xcd = wgid % NXCD, off = wgid / NXCD; wgid = (xcd < r ? xcd * (q + 1) : r * (q + 1) + (xcd - r) * q) + off; }
    const int nig = WGM * nN, gid = wgid / nig, fm = gid * WGM, gsz = (nM - fm) < WGM ? (nM - fm) : WGM;
    pm = fm + ((wgid % nig) % gsz); pn = (wgid % nig) / gsz; return true;
}
struct PlainOrder {
    int nM, nN, G, c; long long sA, sB;
    __device__ __forceinline__ bool next(int i, Unit& u) const { if (!static_tile(i, G, c, nM, nN, u.pm, u.pn)) return false; u.offA = (long long)u.pm * sA; u.offB = (long long)u.pn * sB; u.aux = 0; return true; }
};
struct PanelOrder {
    int nM, nN, G, c; long long sA, sB;
    __device__ __forceinline__ bool next(int i, Unit& u) const { const int pm = c + G * (i / nN); if (pm >= nM) return false; u.pm = pm; u.pn = i % nN; u.offA = (long long)pm * sA; u.offB = (long long)u.pn * sB; u.aux = 0; return true; }
};
struct ListOrder {
    int n, pm, aux; long long offA0, offB0, sB;
    __device__ __forceinline__ bool next(int i, Unit& u) const { if (i >= n) return false; u.pm = pm; u.pn = i; u.aux = aux; u.offA = offA0; u.offB = offB0 + (long long)i * sB; return true; }
};
struct GroupedOrder {
    int ng, nM, nN, G, c; long long sA, sB, gA, gB;
    __device__ __forceinline__ bool next(int i, Unit& u) const {
        const long L = (long)i * G + c; const int per = nM * nN; if (L >= (long)ng * per) return false;
        const int gi = (int)(L / per), r = (int)(L % per); u.pm = r / nN; u.pn = r % nN; u.aux = gi;
        u.offA = (long long)gi * gA + (long long)u.pm * sA; u.offB = (long long)gi * gB + (long long)u.pn * sB; return true; }
};

template <class Epi, class Sched>
__device__ __forceinline__ void gemm_phase(LAS unsigned char* lds, const Gemm g, const Sched& S, const Epi& E, int tid_in) {
    int tid_ = tid_in; asm volatile("" : "+v"(tid_));
    const int tid = tid_, wid = __builtin_amdgcn_readfirstlane(tid >> 6), lane = tid & 63, wr = wid >> 2, wc = wid & 3, fr = lane & 15, fq = lane >> 4;
    int K_ = g.K; asm volatile("" : "+s"(K_));
    const int K = K_, nt = K / BK; (void)K;
    unsigned voffA[2], voffB[2];
#pragma unroll
    for (int i = 0; i < 2; ++i) { int R, C; stage_rc(tid * 16 + i * 8192, R, C); const int Rb = Epi::PERM ? ((R & ~31) + perm32(R & 31)) : R;
        voffA[i] = (unsigned)(R * g.lda + C) * 2u; voffB[i] = (unsigned)(Rb * g.ldb + C) * 2u; }
    const size_t kstep = (size_t)(BK * 2);
    const size_t hstepA = (size_t)HALF * g.lda * 2, hstepB = (size_t)HALF * g.ldb * 2;
    const unsigned ldsw = (unsigned)wid * 1024u;
    const int aoff = lds_byte(wr * 64 + fr, fq * 8), boff = lds_byte(wc * 32 + fr, fq * 8);
#define PG8_SA(b, h) (((b) * 2 + (h)) * HTB)
#define PG8_SB(b, h) ((4 + (b) * 2 + (h)) * HTB)
#define PG8_STAGE(bufoff, gbase, voff) do { _Pragma("unroll") for (int _i = 0; _i < 2; ++_i) \
        __builtin_amdgcn_global_load_lds((const unsigned*)((const char*)(gbase) + (voff)[_i]), (LAS unsigned*)(lds + (bufoff) + ldsw + _i * 8192), 16, 0, 0); } while (0)
#define PG8_LDA(dst, b, h) do { _Pragma("unroll") for (int m = 0; m < 4; ++m) _Pragma("unroll") for (int k = 0; k < 2; ++k) dst[m][k] = *(const LAS bf16x8*)(lds + PG8_SA(b, h) + aoff + m * 2048 + k * 1024); } while (0)
#define PG8_LDB(dst, b, h) do { _Pragma("unroll") for (int n = 0; n < 2; ++n) _Pragma("unroll") for (int k = 0; k < 2; ++k) dst[n][k] = *(const LAS bf16x8*)(lds + PG8_SB(b, h) + boff + n * 2048 + k * 1024); } while (0)
#define PG8_MMA(ai, bj, At, Bt) do { __builtin_amdgcn_s_setprio(1); _Pragma("unroll") for (int m = 0; m < 4; ++m) _Pragma("unroll") for (int n = 0; n < 2; ++n) _Pragma("unroll") for (int k = 0; k < 2; ++k) \
        acc[ai][bj][m][n] = __builtin_amdgcn_mfma_f32_16x16x32_bf16(Bt[n][k], At[m][k], acc[ai][bj][m][n], 0, 0, 0); __builtin_amdgcn_s_setprio(0); } while (0)
#define PG8_WAIT_V(n) asm volatile("s_waitcnt vmcnt(" #n ")" ::: "memory")
#define PG8_WAIT_L(n) asm volatile("s_waitcnt lgkmcnt(" #n ")" ::: "memory")
#define PG8_BAR __builtin_amdgcn_s_barrier()
#define PG8_SCHED __builtin_amdgcn_sched_barrier(0)
    Unit cur, nxt; int ui = 0;
    if (!S.next(0, cur)) return;
    f32x4 acc[2][2][4][2];
#pragma unroll
    for (int a = 0; a < 2; ++a)
#pragma unroll
        for (int b = 0; b < 2; ++b)
#pragma unroll
            for (int m = 0; m < 4; ++m)
#pragma unroll
                for (int n = 0; n < 2; ++n) acc[a][b][m][n] = (f32x4){0.f, 0.f, 0.f, 0.f};
    bf16x8 At[4][2], B0[2][2], B1[2][2];
    const char* cA = (const char*)g.A + cur.offA; const char* cB = (const char*)g.Bt + cur.offB;
    PG8_STAGE(PG8_SB(0, 0), cB, voffB); PG8_STAGE(PG8_SB(0, 1), cB + hstepB, voffB); PG8_STAGE(PG8_SA(0, 0), cA, voffA); PG8_STAGE(PG8_SA(0, 1), cA + hstepA, voffA);
    if (wr == 1) PG8_BAR;
    PG8_WAIT_V(2); PG8_BAR;
    PG8_STAGE(PG8_SB(1, 0), cB + kstep, voffB); PG8_STAGE(PG8_SA(1, 0), cA + kstep, voffA); PG8_STAGE(PG8_SB(1, 1), cB + hstepB + kstep, voffB);
    PG8_WAIT_V(6); PG8_BAR;
    for (;;) {
        const bool has_next = S.next(ui + 1, nxt);
        const char* nA = has_next ? (const char*)g.A + nxt.offA : cA; const char* nB = has_next ? (const char*)g.Bt + nxt.offB : cB;
        for (int t = 0; t < nt; t += 2) {
            const bool last = (t == nt - 2);
            const char* a1 = cA + (size_t)(t + 1) * kstep;
            const char* a2 = last ? nA : cA + (size_t)(t + 2) * kstep; const char* b2 = last ? nB : cB + (size_t)(t + 2) * kstep;
            const char* a3 = a2 + kstep; const char* b3 = b2 + kstep;
            PG8_LDB(B0, 0, 0); PG8_LDB(B1, 0, 1); PG8_SCHED; PG8_LDA(At, 0, 0); PG8_STAGE(PG8_SA(1, 1), a1 + hstepA, voffA);
            PG8_WAIT_V(8); PG8_WAIT_L(0); PG8_BAR; PG8_MMA(0, 0, At, B0); PG8_MMA(0, 1, At, B1); PG8_BAR; PG8_SCHED;
            PG8_LDA(At, 0, 1); PG8_STAGE(PG8_SB(0, 0), b2, voffB); PG8_STAGE(PG8_SB(0, 1), b2 + hstepB, voffB); PG8_STAGE(PG8_SA(0, 0), a2, voffA);
            PG8_WAIT_V(8); PG8_WAIT_L(0); PG8_BAR; PG8_MMA(1, 0, At, B0); PG8_MMA(1, 1, At, B1); PG8_BAR; PG8_SCHED;
            PG8_LDB(B0, 1, 0); PG8_LDB(B1, 1, 1); PG8_SCHED; PG8_LDA(At, 1, 0); PG8_STAGE(PG8_SA(0, 1), a2 + hstepA, voffA);
            PG8_WAIT_V(8); PG8_WAIT_L(0); PG8_BAR; PG8_MMA(0, 0, At, B0); PG8_MMA(0, 1, At, B1); PG8_BAR; PG8_SCHED;
            PG8_LDA(At, 1, 1); PG8_STAGE(PG8_SB(1, 0), b3, voffB); PG8_STAGE(PG8_SB(1, 1), b3 + hstepB, voffB); PG8_STAGE(PG8_SA(1, 0), a3, voffA);
            PG8_WAIT_V(8); PG8_WAIT_L(0); PG8_BAR; PG8_MMA(1, 0, At, B0); PG8_MMA(1, 1, At, B1); PG8_BAR; PG8_SCHED;
        }
#if MK_ALIGN_EPI
        if (wr == 0) PG8_BAR;
#endif
        { int fr_ = fr, fq_ = fq; asm volatile("" : "+v"(fr_), "+v"(fq_));
          E(acc, cur, wr, wc, fr_, fq_); }
        if (!has_next) break;
#pragma unroll
        for (int a = 0; a < 2; ++a)
#pragma unroll
            for (int b = 0; b < 2; ++b)
#pragma unroll
                for (int m = 0; m < 4; ++m)
#pragma unroll
                    for (int n = 0; n < 2; ++n) acc[a][b][m][n] = (f32x4){0.f, 0.f, 0.f, 0.f};
        cur = nxt; cA = nA; cB = nB; ++ui;
#if MK_ALIGN_EPI
        if (wr == 1) PG8_BAR;
#endif
    }
    PG8_WAIT_V(0);
#if !MK_ALIGN_EPI
    if (wr == 0) PG8_BAR;
#endif
    PG8_BAR;
#undef PG8_SA
#undef PG8_SB
#undef PG8_STAGE
#undef PG8_LDA
#undef PG8_LDB
#undef PG8_MMA
#undef PG8_WAIT_V
#undef PG8_WAIT_L
#undef PG8_BAR
#undef PG8_SCHED
}
}

#define XB_TMO      128
#define XB_XCNT(j)  (256  + 64 * (j))
#define XB_XSUB(j)  (1280 + 64 * (j))
#define XB_XGEN(j)  (2304 + 64 * (j))
#define XB_TOP      3328
#define XB_TOPGEN   3392
#define XCD_BAR_WORDS 3456
#define XB_SPIN_CAP (1u << 20)
__device__ __forceinline__ unsigned xb_ld(unsigned* p)              { return __hip_atomic_load(p, __ATOMIC_RELAXED, __HIP_MEMORY_SCOPE_AGENT); }
__device__ __forceinline__ unsigned xb_add(unsigned* p, unsigned v) { return __hip_atomic_fetch_add(p, v, __ATOMIC_RELAXED, __HIP_MEMORY_SCOPE_AGENT); }
__device__ __forceinline__ unsigned xb_xcc_id() { return (unsigned)__builtin_amdgcn_s_getreg((3 << 11) | 20) & 0xFu; }
#define XB_SPIN(cond, bar) do { unsigned _sp = 0; while (cond) { __builtin_amdgcn_s_sleep(1); \
    if ((++_sp & 255u) == 0u) { if (xb_ld(&(bar)[XB_TMO])) break; if (_sp > XB_SPIN_CAP) { atomicAdd(&(bar)[XB_TMO], 1u); break; } } } } while (0)
struct XcdBarrier { unsigned* bar; unsigned x; volatile LAS unsigned* st; };
__device__ __forceinline__ XcdBarrier xcd_barrier_post(unsigned* bar, volatile LAS unsigned* st) {
    XcdBarrier b; b.bar = bar; b.x = xb_xcc_id(); b.st = st;
    if (threadIdx.x == 0) (void)xb_add(&bar[XB_XCNT(b.x)], 1u);
    return b;
}
__device__ __forceinline__ void xcd_barrier_complete(unsigned* bar, unsigned x, unsigned& nloc, unsigned& nx) {
    const unsigned G = gridDim.x * gridDim.y * gridDim.z;
    unsigned sum, cnt, mine, sp = 0u;
    for (;;) {
        sum = 0u; cnt = 0u; mine = 0u;
#pragma unroll 1
        for (unsigned j = 0; j < 16; ++j) { const unsigned c = xb_ld(&bar[XB_XCNT(j)]); sum += c; cnt += (c > 0u) ? 1u : 0u; mine = (j == x) ? c : mine; }
        if (sum == G) break;
        __builtin_amdgcn_s_sleep(1);
        if ((++sp & 255u) == 0u) { if (xb_ld(&bar[XB_TMO])) break; if (sp > XB_SPIN_CAP) { atomicAdd(&bar[XB_TMO], 1u); break; } }
    }
    nloc = mine > 0u ? mine : 1u; nx = cnt > 0u ? cnt : 1u;
}
__device__ __forceinline__ void xcd_barrier(const XcdBarrier& b, int wave_id) {
    asm volatile("s_waitcnt vmcnt(0)" ::: "memory");
    __syncthreads();
    if (wave_id == 0 && lane_id_fresh() == 0) {
        unsigned* bar = b.bar; asm volatile("" : "+s"(bar));
        __builtin_amdgcn_s_waitcnt(0);
        unsigned nloc = b.st[0], nx = b.st[1];
        if (nloc == 0u) { xcd_barrier_complete(bar, b.x, nloc, nx); b.st[0] = nloc; b.st[1] = nx; }
        const unsigned old = xb_add(&bar[XB_XSUB(b.x)], 1u);
        const unsigned gen = old / nloc;
        if (old + 1u == (gen + 1u) * nloc) {
            __builtin_amdgcn_fence(__ATOMIC_RELEASE, "agent");
            asm volatile("s_waitcnt vmcnt(0)" ::: "memory");
            const unsigned og = xb_add(&bar[XB_TOP], 1u);
            const unsigned tg = og / nx;
            if (og + 1u == (tg + 1u) * nx) xb_add(&bar[XB_TOPGEN], 1u);
            else XB_SPIN(xb_ld(&bar[XB_TOPGEN]) == tg, bar);
            __builtin_amdgcn_fence(__ATOMIC_ACQUIRE, "agent");
            xb_add(&bar[XB_XGEN(b.x)], 1u);
            asm volatile("s_waitcnt vmcnt(0)" ::: "memory");
        } else {
            XB_SPIN(xb_ld(&bar[XB_XGEN(b.x)]) == gen, bar);
            __builtin_amdgcn_fence(__ATOMIC_ACQUIRE, "agent");
            asm volatile("s_waitcnt vmcnt(0)" ::: "memory");
        }
    }
    __syncthreads();
}
namespace nsa {
constexpr int PITCH = 144, TILE_LDS = 64 * PITCH;
__device__ __forceinline__ int crow(int r, int hi) { return (r & 3) + 8 * (r >> 2) + 4 * hi; }
__device__ __forceinline__ int vslot(int kk) { return (kk & 0x33) | (((kk >> 2) & 1) << 3) | (((kk >> 3) & 1) << 2); }

struct Lane { int lane, c, hi, wid, tid; };

__device__ __forceinline__ void qk_tile(f32x16& p0, f32x16& p1, const LAS unsigned char* Ks, const bf16x8 (&qr)[4], float bias, const Lane& L) {
#pragma unroll
    for (int r = 0; r < 16; ++r) { p0[r] = bias; p1[r] = bias; }
    const LAS unsigned char* kb = Ks + L.c * PITCH + L.hi * 16;
#pragma unroll
    for (int d0 = 0; d0 < 4; ++d0) {
        const bf16x8 k0 = *(const LAS bf16x8*)(kb + d0 * 32);
        const bf16x8 k1 = *(const LAS bf16x8*)(kb + 32 * PITCH + d0 * 32);
        p0 = __builtin_amdgcn_mfma_f32_32x32x16_bf16(k0, qr[d0], p0, 0, 0, 0);
        p1 = __builtin_amdgcn_mfma_f32_32x32x16_bf16(k1, qr[d0], p1, 0, 0, 0);
    }
}
__device__ __forceinline__ void qk_tile_c(f32x16& p0, f32x16& p1, const LAS unsigned char* Ks, const bf16x8 (&qr)[4], const f32x16& cv, const Lane& L) {
    const LAS unsigned char* kb = Ks + L.c * PITCH + L.hi * 16;
    { const bf16x8 k0 = *(const LAS bf16x8*)(kb); const bf16x8 k1 = *(const LAS bf16x8*)(kb + 32 * PITCH);
      p0 = __builtin_amdgcn_mfma_f32_32x32x16_bf16(k0, qr[0], cv, 0, 0, 0); p1 = __builtin_amdgcn_mfma_f32_32x32x16_bf16(k1, qr[0], cv, 0, 0, 0); }
#pragma unroll
    for (int d0 = 1; d0 < 4; ++d0) {
        const bf16x8 k0 = *(const LAS bf16x8*)(kb + d0 * 32);
        const bf16x8 k1 = *(const LAS bf16x8*)(kb + 32 * PITCH + d0 * 32);
        p0 = __builtin_amdgcn_mfma_f32_32x32x16_bf16(k0, qr[d0], p0, 0, 0, 0);
        p1 = __builtin_amdgcn_mfma_f32_32x32x16_bf16(k1, qr[d0], p1, 0, 0, 0);
    }
}
__device__ __forceinline__ void mask_range(f32x16& p0, f32x16& p1, int lo, int hi_, int hi) {
#pragma unroll
    for (int r = 0; r < 16; ++r) { const int k0 = crow(r, hi), k1 = k0 + 32;
        if (k0 <= lo || k0 > hi_) p0[r] = NEGF;
        if (k1 <= lo || k1 > hi_) p1[r] = NEGF; }
}
__device__ __forceinline__ float tile_max(const f32x16& p0, const f32x16& p1) {
    float a = fmaxf(p0[0], p1[0]);
#pragma unroll
    for (int r = 1; r < 16; ++r) a = fmaxf(a, fmaxf(p0[r], p1[r]));
    return fmaxf(a, xshfl<32>(a));
}
__device__ __forceinline__ void pv_tile(f32x16& o0, f32x16& o1, const LAS unsigned char* Vs, const f32x16& p0, const f32x16& p1, const Lane& L) {
    const LAS unsigned char* vb = Vs + L.c * PITCH + L.hi * 16;
#pragma unroll
    for (int s = 0; s < 4; ++s) {
        u32x4 w;
        if (s < 2) { const int b = 8 * (s & 1); w.x = cvt_pk_bf16(p0[b], p0[b + 1]); w.y = cvt_pk_bf16(p0[b + 2], p0[b + 3]); w.z = cvt_pk_bf16(p0[b + 4], p0[b + 5]); w.w = cvt_pk_bf16(p0[b + 6], p0[b + 7]); }
        else       { const int b = 8 * (s & 1); w.x = cvt_pk_bf16(p1[b], p1[b + 1]); w.y = cvt_pk_bf16(p1[b + 2], p1[b + 3]); w.z = cvt_pk_bf16(p1[b + 4], p1[b + 5]); w.w = cvt_pk_bf16(p1[b + 6], p1[b + 7]); }
        const bf16x8 pf = __builtin_bit_cast(bf16x8, w);
        const bf16x8 v0 = *(const LAS bf16x8*)(vb + s * 32);
        const bf16x8 v1 = *(const LAS bf16x8*)(vb + 32 * PITCH + s * 32);
        o0 = __builtin_amdgcn_mfma_f32_32x32x16_bf16(v0, pf, o0, 0, 0, 0);
        o1 = __builtin_amdgcn_mfma_f32_32x32x16_bf16(v1, pf, o1, 0, 0, 0);
        if (s & 1) __builtin_amdgcn_sched_barrier(0);
    }
}
__device__ __forceinline__ void softmax_pv(f32x16& p0, f32x16& p1, f32x16& o0, f32x16& o1, float& m, float& l, const LAS unsigned char* Vs, const Lane& L) {
    const float mx = tile_max(p0, p1), mn = fmaxf(m, mx), alpha = fast_exp2(m - mn); m = mn;
    float ls = 0.f;
#pragma unroll
    for (int r = 0; r < 16; ++r) { p0[r] = fast_exp2(p0[r] - mn); p1[r] = fast_exp2(p1[r] - mn); ls += p0[r] + p1[r]; }
    l = l * alpha + ls;
#pragma unroll
    for (int r = 0; r < 16; ++r) { o0[r] *= alpha; o1[r] *= alpha; }
    pv_tile(o0, o1, Vs, p0, p1, L);
}
__device__ __forceinline__ int stage_off(int tid) { return (tid >> 3) * PITCH + (tid & 7) * 16; }

__device__ __forceinline__ void load_q(bf16x8 (&qr)[4], const bf16_t* qbuf, long tok, int head, int hi) {
    const bf16_t* qp = qbuf + tok * 512 + head * 64 + hi * 8;
#pragma unroll
    for (int d0 = 0; d0 < 4; ++d0) qr[d0] = *(const bf16x8*)(qp + d0 * 16);
}

__device__ __forceinline__ u32x4 vload(const bf16_t* Vt, int j, const Lane& L) { return *(const u32x4*)((const char*)Vt + (size_t)j * 8192 + L.lane * 128 + L.wid * 16); }
__device__ __forceinline__ void vstore(LAS unsigned char* Vs, const u32x4 v, const Lane& L) {
    LAS unsigned short* p = (LAS unsigned short*)(Vs + (8 * L.wid) * PITCH) + vslot(L.lane);
    p[0 * (PITCH / 2)] = (unsigned short)(v.x & 0xffffu); p[1 * (PITCH / 2)] = (unsigned short)(v.x >> 16); p[2 * (PITCH / 2)] = (unsigned short)(v.y & 0xffffu); p[3 * (PITCH / 2)] = (unsigned short)(v.y >> 16);
    p[4 * (PITCH / 2)] = (unsigned short)(v.z & 0xffffu); p[5 * (PITCH / 2)] = (unsigned short)(v.z >> 16); p[6 * (PITCH / 2)] = (unsigned short)(v.w & 0xffffu); p[7 * (PITCH / 2)] = (unsigned short)(v.w >> 16);
}
template <int MODE>
__device__ __forceinline__ void run_branch(f32x16& o0, f32x16& o1, float& mref, float& l, const bf16_t* Kt  , const bf16_t* Vt  ,
                                           int jlo, int jhi, int qb, int qrel, unsigned long long selw, const bf16x8 (&qr)[4], LAS unsigned char* lds, const Lane& L) {
    LAS unsigned char* Kbuf = lds; LAS unsigned char* Vbuf = lds + 2 * TILE_LDS;
    const int so = stage_off(L.tid);
    u32x4 kreg = *(const u32x4*)((const char*)Kt + (size_t)jlo * 8192 + L.tid * 16);
    u32x4 vreg = vload(Vt, jlo, L);
    *(LAS u32x4*)(Kbuf + so) = kreg; vstore(Vbuf, vreg, L);
    __syncthreads();
    f32x16 cv;
#pragma unroll
    for (int r = 0; r < 16; ++r) cv[r] = -mref;
    for (int j = jlo; j <= jhi; ++j) {
        const int cur = (j - jlo) & 1;
        if (j < jhi) { kreg = *(const u32x4*)((const char*)Kt + (size_t)(j + 1) * 8192 + L.tid * 16); vreg = vload(Vt, j + 1, L); }
        f32x16 p0, p1;
        if (MODE == 0) { const float cb = ((selw >> j) & 1ull) ? -mref : NEGF;
#pragma unroll
            for (int r = 0; r < 16; ++r) cv[r] = cb; }
        qk_tile_c(p0, p1, Kbuf + cur * TILE_LDS, qr, cv, L);
        if (j == qb) mask_range(p0, p1, -1, qrel, L.hi);
        if (MODE == 1 && j == qb - 8) mask_range(p0, p1, qrel, 64, L.hi);
        const float mx = tile_max(p0, p1);
        if (__any(mx > 8.0f)) {
            const float dl = fmaxf(mx, 0.f), f = fast_exp2(-dl); mref += dl; l *= f;
#pragma unroll
            for (int r = 0; r < 16; ++r) { o0[r] *= f; o1[r] *= f; p0[r] -= dl; p1[r] -= dl; }
            if (MODE == 1) {
#pragma unroll
                for (int r = 0; r < 16; ++r) cv[r] = -mref; }
        }
        float ls = 0.f;
#pragma unroll
        for (int r = 0; r < 16; ++r) { p0[r] = fast_exp2(p0[r]); p1[r] = fast_exp2(p1[r]); ls += p0[r] + p1[r]; }
        l += ls;
        pv_tile(o0, o1, Vbuf + cur * TILE_LDS, p0, p1, L);
        if (j < jhi) { *(LAS u32x4*)(Kbuf + (cur ^ 1) * TILE_LDS + so) = kreg; vstore(Vbuf + (cur ^ 1) * TILE_LDS, vreg, L); }
        __syncthreads();
    }
}
struct SoftState { float mref, l; };
__device__ __forceinline__ void softmax_step2(f32x16& p0, f32x16& p1, f32x16& o0, f32x16& o1, SoftState& st, bool sel, bf16x8 (&pf)[4]) {
    if (__any(st.mref != 0.f)) {
#pragma unroll
        for (int r = 0; r < 16; ++r) { p0[r] -= st.mref; p1[r] -= st.mref; } }
    float ls = 0.f;
#pragma unroll
    for (int r = 0; r < 16; ++r) { p0[r] = fast_exp2(p0[r]); p1[r] = fast_exp2(p1[r]); ls += p0[r] + p1[r]; }
    ls = sel ? ls : 0.f; st.l += ls;
#pragma unroll
    for (int s = 0; s < 4; ++s) { u32x4 w; const int b = 8 * (s & 1);
        if (s < 2) { w.x = cvt_pk_bf16(p0[b], p0[b + 1]); w.y = cvt_pk_bf16(p0[b + 2], p0[b + 3]); w.z = cvt_pk_bf16(p0[b + 4], p0[b + 5]); w.w = cvt_pk_bf16(p0[b + 6], p0[b + 7]); }
        else       { w.x = cvt_pk_bf16(p1[b], p1[b + 1]); w.y = cvt_pk_bf16(p1[b + 2], p1[b + 3]); w.z = cvt_pk_bf16(p1[b + 4], p1[b + 5]); w.w = cvt_pk_bf16(p1[b + 6], p1[b + 7]); }
        if (!sel) w = (u32x4){0u, 0u, 0u, 0u};
        pf[s] = __builtin_bit_cast(bf16x8, w); }
}
__device__ __forceinline__ void renorm_step(f32x16& o0, f32x16& o1, SoftState& st) {
    if (__any(st.l > 1.0995116e12f)) { const bool big = st.l > 1.0995116e12f; const float f = big ? 9.094947e-13f : 1.0f; st.mref += big ? 40.f : 0.f; st.l *= f;
#pragma unroll
        for (int r = 0; r < 16; ++r) { o0[r] *= f; o1[r] *= f; } }
}
template <int MODE>
__device__ __forceinline__ void run_branch2(f32x16& oa0, f32x16& oa1, SoftState& sa, f32x16& ob0, f32x16& ob1, SoftState& sb, const bf16_t* Kt, const bf16_t* Vt, int jlo, int jhi, int qbw, int qrela,
                                            const LAS unsigned long long* selp  , const bf16x8 (&qa)[4], const bf16x8 (&qbf)[4], LAS unsigned char* lds, const Lane& L) {
    LAS unsigned char* Kbuf = lds; LAS unsigned char* Vbuf = lds + 2 * TILE_LDS;
    const int so = stage_off(L.tid);
    {   const u32x4 kreg = *(const u32x4*)((const char*)Kt + (size_t)jlo * 8192 + L.tid * 16); const u32x4 vreg = vload(Vt, jlo, L);
        *(LAS u32x4*)(Kbuf + so) = kreg; vstore(Vbuf, vreg, L); }
    __syncthreads();
    for (int j = jlo; j <= jhi; ++j) {
        const int cur = (j - jlo) & 1;
        const bool act = (j <= qbw) && (MODE == 0 || j >= qbw - 8);
        u32x4 kreg, vreg;
        bf16x8 fa[4], fb[4];
        if (act) {
            f32x16 pa0, pa1, pb0, pb1;
#pragma unroll
            for (int r = 0; r < 16; ++r) { pa0[r] = 0.f; pa1[r] = 0.f; pb0[r] = 0.f; pb1[r] = 0.f; }
            const LAS unsigned char* kb = Kbuf + cur * TILE_LDS + L.c * PITCH + L.hi * 16;
#pragma unroll
            for (int d0 = 0; d0 < 4; ++d0) { const bf16x8 k0 = *(const LAS bf16x8*)(kb + d0 * 32); const bf16x8 k1 = *(const LAS bf16x8*)(kb + 32 * PITCH + d0 * 32);
                pa0 = __builtin_amdgcn_mfma_f32_32x32x16_bf16(k0, qa[d0], pa0, 0, 0, 0); pa1 = __builtin_amdgcn_mfma_f32_32x32x16_bf16(k1, qa[d0], pa1, 0, 0, 0);
                pb0 = __builtin_amdgcn_mfma_f32_32x32x16_bf16(k0, qbf[d0], pb0, 0, 0, 0); pb1 = __builtin_amdgcn_mfma_f32_32x32x16_bf16(k1, qbf[d0], pb1, 0, 0, 0); }
            if (j == qbw) { mask_range(pa0, pa1, -1, qrela, L.hi); mask_range(pb0, pb1, -1, qrela + 8, L.hi); }
            if (MODE == 1 && j == qbw - 8) { mask_range(pa0, pa1, qrela, 64, L.hi); mask_range(pb0, pb1, qrela + 8, 64, L.hi); }
            bool sela = true, selb = true;
            if (MODE == 0) { sela = (selp[0] >> j) & 1ull; selb = (selp[1] >> j) & 1ull; }
            softmax_step2(pa0, pa1, oa0, oa1, sa, sela, fa);
            __builtin_amdgcn_sched_barrier(0);
            softmax_step2(pb0, pb1, ob0, ob1, sb, selb, fb);
            __builtin_amdgcn_sched_barrier(0);
        }
        if (j < jhi) { kreg = *(const u32x4*)((const char*)Kt + (size_t)(j + 1) * 8192 + L.tid * 16); vreg = vload(Vt, j + 1, L); }
        if (act) {
            const LAS unsigned char* vb = Vbuf + cur * TILE_LDS + L.c * PITCH + L.hi * 16;
#pragma unroll
            for (int s = 0; s < 4; ++s) {
                const bf16x8 v0 = *(const LAS bf16x8*)(vb + s * 32); const bf16x8 v1 = *(const LAS bf16x8*)(vb + 32 * PITCH + s * 32);
                oa0 = __builtin_amdgcn_mfma_f32_32x32x16_bf16(v0, fa[s], oa0, 0, 0, 0); oa1 = __builtin_amdgcn_mfma_f32_32x32x16_bf16(v1, fa[s], oa1, 0, 0, 0);
                ob0 = __builtin_amdgcn_mfma_f32_32x32x16_bf16(v0, fb[s], ob0, 0, 0, 0); ob1 = __builtin_amdgcn_mfma_f32_32x32x16_bf16(v1, fb[s], ob1, 0, 0, 0); }
            renorm_step(oa0, oa1, sa); renorm_step(ob0, ob1, sb);
        }
        if (j < jhi) { *(LAS u32x4*)(Kbuf + (cur ^ 1) * TILE_LDS + so) = kreg; vstore(Vbuf + (cur ^ 1) * TILE_LDS, vreg, L); }
        __syncthreads();
    }
}
}
namespace nsa {
struct AttnPtrs {
    const bf16_t* q;
    const bf16_t* z;
    const bf16_t* kc;
    const bf16_t* vct;
    const bf16_t* ksel;
    const bf16_t* vselt;
    const bf16_t* kwin; const bf16_t* vwint;
    unsigned long long* selmask;
    bf16_t* mix;
};
template <bool ACCUM>
__device__ __forceinline__ void store_o(const f32x16& a0, const f32x16& a1, bf16_t* mix, long tok, int head, int hi) {
    bf16_t* op = mix + tok * 1024 + head * 64 + 4 * hi;
#pragma unroll
    for (int dd = 0; dd < 2; ++dd)
#pragma unroll
        for (int rq = 0; rq < 4; ++rq) {
            float v0, v1, v2, v3;
            if (dd == 0) { v0 = a0[4 * rq]; v1 = a0[4 * rq + 1]; v2 = a0[4 * rq + 2]; v3 = a0[4 * rq + 3]; }
            else         { v0 = a1[4 * rq]; v1 = a1[4 * rq + 1]; v2 = a1[4 * rq + 2]; v3 = a1[4 * rq + 3]; }
            u32x2* p = (u32x2*)(op + dd * 32 + rq * 8);
            if (ACCUM) { const u32x2 old = *p; v0 += bflo(old.x); v1 += bfhi(old.x); v2 += bflo(old.y); v3 += bfhi(old.y); }
            u32x2 w; w.x = cvt_pk_bf16(v0, v1); w.y = cvt_pk_bf16(v2, v3); *p = w;
        }
}
__device__ __forceinline__ float gate_of(const bf16_t* z, long tok, int head, int br) { return sigmoidf_(bf2f(z[tok * INP + ZG + head * 3 + br])); }

struct CmpPre { bf16x8 qr[4]; };
__device__ __forceinline__ void cmp_prefetch(CmpPre& R, int bh, int qb, const AttnPtrs& P, const Lane& L) {
    const int b = bh >> 1, h = bh & 1, tq = qb * 64 + 8 * L.wid + (L.c >> 2), head = 4 * h + (L.c & 3); const long tok = (long)b * SEQ + tq;
    load_q(R.qr, P.q, tok, head, L.hi);
}
__device__ __forceinline__ void cmp_stage(const CmpPre& R, LAS unsigned char* lds, const Lane& L, bf16x8 (&qr)[4], float& gt) {
    (void)lds; (void)L;
#pragma unroll
    for (int d0 = 0; d0 < 4; ++d0) qr[d0] = R.qr[d0];
    gt = 0.f;
}
template <bool STAGE>
__device__ __forceinline__ void cmp_unit(int bh, int qb, const AttnPtrs& P, LAS unsigned char* lds, const Lane& L) {
    const int b = bh >> 1, h = bh & 1, t0 = qb * 64;
    const int ql = 8 * L.wid + (L.c >> 2), g = L.c & 3, tq = t0 + ql, head = 4 * h + g;
    const long tok = (long)b * SEQ + tq;
    LAS unsigned char* Kb = lds; LAS unsigned char* Vb = lds + 4 * TILE_LDS;
    LAS float* G4 = (LAS float*)(lds + 8 * TILE_LDS); LAS float* E3 = G4 + 64 * 64;
    const float gate_raw = bf2f(P.z[tok * INP + ZG + head * 3 + 0]);
    bf16x8 qr[4]; load_q(qr, P.q, tok, head, L.hi);
    if (STAGE) { const char* ks = (const char*)(P.kc + (size_t)bh * 256 * 64); const char* vs = (const char*)(P.vct + (size_t)bh * 256 * 64); const int so = stage_off(L.tid); u32x4 kk[4], vv[4];
#pragma unroll
      for (int jn = 0; jn < 4; ++jn) kk[jn] = *(const u32x4*)(ks + jn * 8192 + L.tid * 16);
#pragma unroll
      for (int jn = 0; jn < 4; ++jn) vv[jn] = *(const u32x4*)(vs + jn * 8192 + L.tid * 16);
#pragma unroll
      for (int jn = 0; jn < 4; ++jn) *(LAS u32x4*)(Kb + jn * TILE_LDS + so) = kk[jn];
#pragma unroll
      for (int jn = 0; jn < 4; ++jn) *(LAS u32x4*)(Vb + jn * TILE_LDS + so) = vv[jn]; }
    __syncthreads();
    const int nmax = (tq >= 31) ? ((tq - 31) >> 4) : -1;
    const int tq_lo = t0 + 8 * L.wid, tq_hi = tq_lo + 7;
    const int nmax_lo = (tq_lo >= 31) ? ((tq_lo - 31) >> 4) : -1, nmax_hi = (tq_hi >= 31) ? ((tq_hi - 31) >> 4) : -1;
    const int ntile = (nmax_hi >= 0) ? (nmax_hi >> 6) + 1 : 0;
    const bool need_imp = qb >= 16;
    float l = 0.f;
    f32x16 o0, o1;
#pragma unroll
    for (int r = 0; r < 16; ++r) { o0[r] = 0.f; o1[r] = 0.f; }
    float gsr[4][8], e3r[4][8];
#pragma unroll
    for (int jn = 0; jn < 4; ++jn)
#pragma unroll
        for (int i = 0; i < 8; ++i) { gsr[jn][i] = 0.f; e3r[jn][i] = 0.f; }
#pragma unroll
    for (int jn = 0; jn < 4; ++jn) {
        if (jn < ntile) {
            f32x16 p0, p1; qk_tile(p0, p1, Kb + jn * TILE_LDS, qr, 0.f, L);
            if (64 * jn + 63 > nmax_lo) mask_range(p0, p1, -1, nmax - 64 * jn, L.hi);
            float ls = 0.f;
#pragma unroll
            for (int r = 0; r < 16; ++r) { p0[r] = fast_exp2(p0[r]); p1[r] = fast_exp2(p1[r]); ls += p0[r] + p1[r]; }
            l += ls;
            if (need_imp) {
#pragma unroll
                for (int rq = 0; rq < 4; ++rq) { gsr[jn][rq] = (p0[4 * rq] + p0[4 * rq + 1]) + (p0[4 * rq + 2] + p0[4 * rq + 3]); e3r[jn][rq] = p0[4 * rq + 3];
                                                 gsr[jn][4 + rq] = (p1[4 * rq] + p1[4 * rq + 1]) + (p1[4 * rq + 2] + p1[4 * rq + 3]); e3r[jn][4 + rq] = p1[4 * rq + 3]; } }
            pv_tile(o0, o1, Vb + jn * TILE_LDS, p0, p1, L);
        }
        __builtin_amdgcn_sched_barrier(0);
    }
    l = xsum32(l);
    const float inv = (nmax >= 0 && l > 0.f) ? fast_rcp(l) : 0.f;
    if (need_imp) {
        LAS float* gp = G4 + ql * 64 + L.hi; asm volatile("" : "+v"(gp));
#pragma unroll
        for (int jn = 0; jn < 4; ++jn) {
            if (jn < ntile) {
#pragma unroll
                for (int i = 0; i < 8; ++i) { float gs = gsr[jn][i] * inv, e3 = e3r[jn][i] * inv;
                    gs += xshfl<1>(gs); gs += xshfl<2>(gs); e3 += xshfl<1>(e3); e3 += xshfl<2>(e3);
                    if (g == 0) { gp[16 * jn + 2 * i] = gs; gp[64 * 64 + 16 * jn + 2 * i] = e3; } }
            }
        }
    }
    {
        const float gt = sigmoidf_(gate_raw) * inv;
#pragma unroll
        for (int r = 0; r < 16; ++r) { o0[r] *= gt; o1[r] *= gt; }
        store_o<false>(o0, o1, P.mix, tok, head, L.hi);
    }
    __syncthreads();
}
__device__ __forceinline__ void cmp_topk(int bh, int qb, const AttnPtrs& P, LAS unsigned char* lds, const Lane& L) {
    const int t0 = qb * 64; LAS float* G4 = (LAS float*)(lds + 8 * TILE_LDS); LAS float* E3 = G4 + 64 * 64;
    const int s = L.lane;
    if (qb < 16) { const unsigned long long mask = (1ull << (qb + 1)) - 1ull;
        if (L.lane < 8) P.selmask[(size_t)bh * SEQ + t0 + 8 * L.wid + L.lane] = mask; }
    else {
        const bool cand = (s >= 1) && (s <= qb - 2);
        unsigned bits[8], T[8];
#pragma unroll
        for (int i = 0; i < 8; ++i) { const int q = 8 * L.wid + i; const float imp = G4[q * 64 + s] + (s > 0 ? E3[q * 64 + s - 1] : 0.f); bits[i] = cand ? __float_as_uint(fmaxf(imp, 0.f)) : 0u; T[i] = 0u; }
        int cnt[8];
#pragma unroll
        for (int i = 0; i < 8; ++i) cnt[i] = qb - 2;
        for (int bit = 30; bit >= 0; --bit) { int open_ = 0;
#pragma unroll
            for (int i = 0; i < 8; ++i) { const unsigned c = T[i] | (1u << bit); const int n = __popcll(__ballot(cand && bits[i] >= c)); if (n >= 13) { T[i] = c; cnt[i] = n; } open_ |= (cnt[i] != 13); }
            if (!open_) break; }
#pragma unroll
        for (int i = 0; i < 8; ++i) {
            const unsigned long long gt = __ballot(cand && bits[i] > T[i]); unsigned long long eq = __ballot(cand && bits[i] == T[i]);
            int need = 13 - __popcll(gt); unsigned long long take = 0ull;
            while (need > 0 && eq) { const unsigned long long low = eq & (0ull - eq); take |= low; eq ^= low; --need; }
            const unsigned long long mask = gt | take | 1ull | (1ull << qb) | (1ull << (qb - 1));
            if (L.lane == 0) P.selmask[(size_t)bh * SEQ + t0 + 8 * L.wid + i] = mask; }
    }
    __syncthreads();
}

__device__ __forceinline__ void sw_unit(int bh, int qb, const AttnPtrs& P, LAS unsigned char* lds, const Lane& L) {
    const int b = bh >> 1, h = bh & 1, t0 = qb * 64;
    const int ql = 8 * L.wid + (L.c >> 2), g = L.c & 3, tq = t0 + ql, head = 4 * h + g;
    const long tok = (long)b * SEQ + tq;
    bf16x8 qr[4]; load_q(qr, P.q, tok, head, L.hi);
    const unsigned long long selw = P.selmask[(size_t)bh * SEQ + tq];
    const float g1raw = bf2f(P.z[tok * INP + ZG + head * 3 + 1]), g2raw = bf2f(P.z[tok * INP + ZG + head * 3 + 2]);
    f32x16 r0, r1;
    {
        f32x16 o0, o1; float m = 0.f, l = 0.f;
#pragma unroll
        for (int r = 0; r < 16; ++r) { o0[r] = 0.f; o1[r] = 0.f; }
        run_branch<0>(o0, o1, m, l, P.ksel + (size_t)bh * SEQ * 64, P.vselt + (size_t)bh * SEQ * 64, 0, qb, qb, ql, selw, qr, lds, L);
        l = xsum32(l);
        const float sc = sigmoidf_(g1raw) * fast_rcp(l);
#pragma unroll
        for (int r = 0; r < 16; ++r) { r0[r] = o0[r] * sc; r1[r] = o1[r] * sc; }
    }
    {
        f32x16 o0, o1; float m = 0.f, l = 0.f;
#pragma unroll
        for (int r = 0; r < 16; ++r) { o0[r] = 0.f; o1[r] = 0.f; }
        run_branch<1>(o0, o1, m, l, P.kwin + (size_t)bh * SEQ * 64, P.vwint + (size_t)bh * SEQ * 64, qb >= 8 ? qb - 8 : 0, qb, qb, ql, 0ull, qr, lds, L);
        l = xsum32(l);
        const float sc = sigmoidf_(g2raw) * fast_rcp(l);
#pragma unroll
        for (int r = 0; r < 16; ++r) { r0[r] += o0[r] * sc; r1[r] += o1[r] * sc; }
    }
    store_o<true>(r0, r1, P.mix, tok, head, L.hi);
}
__device__ __forceinline__ void sw_unit2(int bh, int qb2, const AttnPtrs& P, LAS unsigned char* lds, const Lane& L) {
    const int b = bh >> 1, h = bh & 1, qbw = 2 * qb2 + (L.wid >> 2);
    const int qrela = 16 * (L.wid & 3) + (L.c >> 2), qrelb = qrela + 8, g = L.c & 3, head = 4 * h + g;
    const long toka = (long)b * SEQ + 64 * qbw + qrela, tokb = toka + 8;
    bf16x8 qa[4], qbf[4]; load_q(qa, P.q, toka, head, L.hi); load_q(qbf, P.q, tokb, head, L.hi);
    LAS unsigned long long* selp = (LAS unsigned long long*)(lds + 4 * TILE_LDS + 8192) + L.tid * 2;
    selp[0] = P.selmask[(size_t)bh * SEQ + 64 * qbw + qrela]; selp[1] = P.selmask[(size_t)bh * SEQ + 64 * qbw + qrelb];
    LAS float* gpark = (LAS float*)(lds + 4 * TILE_LDS) + L.tid * 4;
    gpark[0] = bf2f(P.z[toka * INP + ZG + head * 3 + 1]); gpark[1] = bf2f(P.z[tokb * INP + ZG + head * 3 + 1]); gpark[2] = bf2f(P.z[toka * INP + ZG + head * 3 + 2]); gpark[3] = bf2f(P.z[tokb * INP + ZG + head * 3 + 2]);
    {
        f32x16 oa0, oa1, ob0, ob1; SoftState sa{0.f, 0.f}, sb{0.f, 0.f};
#pragma unroll
        for (int r = 0; r < 16; ++r) { oa0[r] = 0.f; oa1[r] = 0.f; ob0[r] = 0.f; ob1[r] = 0.f; }
        run_branch2<0>(oa0, oa1, sa, ob0, ob1, sb, P.ksel + (size_t)bh * SEQ * 64, P.vselt + (size_t)bh * SEQ * 64, 0, 2 * qb2 + 1, qbw, qrela, selp, qa, qbf, lds, L);
        sa.l = xsum32(sa.l); sb.l = xsum32(sb.l);
        const float sca = sigmoidf_(gpark[0]) * fast_rcp(sa.l), scb = sigmoidf_(gpark[1]) * fast_rcp(sb.l);
#pragma unroll
        for (int r = 0; r < 16; ++r) { oa0[r] *= sca; oa1[r] *= sca; ob0[r] *= scb; ob1[r] *= scb; }
        { int qe = qrela; asm volatile("" : "+v"(qe));
          store_o<true>(oa0, oa1, P.mix, (long)b * SEQ + 64 * qbw + qe, head, L.hi); store_o<true>(ob0, ob1, P.mix, (long)b * SEQ + 64 * qbw + qe + 8, head, L.hi); }
    }
    {
        f32x16 oa0, oa1, ob0, ob1; SoftState sa{0.f, 0.f}, sb{0.f, 0.f};
#pragma unroll
        for (int r = 0; r < 16; ++r) { oa0[r] = 0.f; oa1[r] = 0.f; ob0[r] = 0.f; ob1[r] = 0.f; }
        run_branch2<1>(oa0, oa1, sa, ob0, ob1, sb, P.kwin + (size_t)bh * SEQ * 64, P.vwint + (size_t)bh * SEQ * 64, 2 * qb2 >= 8 ? 2 * qb2 - 8 : 0, 2 * qb2 + 1, qbw, qrela, selp, qa, qbf, lds, L);
        sa.l = xsum32(sa.l); sb.l = xsum32(sb.l);
        const float sca = sigmoidf_(gpark[2]) * fast_rcp(sa.l), scb = sigmoidf_(gpark[3]) * fast_rcp(sb.l);
#pragma unroll
        for (int r = 0; r < 16; ++r) { oa0[r] *= sca; oa1[r] *= sca; ob0[r] *= scb; ob1[r] *= scb; }
        { int qe = qrela; asm volatile("" : "+v"(qe));
          store_o<true>(oa0, oa1, P.mix, (long)b * SEQ + 64 * qbw + qe, head, L.hi); store_o<true>(ob0, ob1, P.mix, (long)b * SEQ + 64 * qbw + qe + 8, head, L.hi); }
    }
}
}
namespace epi {
using pg8::Unit; using pg8::BM; using pg8::HALF;
struct Bf16Plain {
    static constexpr bool PERM = true;
    bf16_t* O; int ldc;
    __device__ __forceinline__ void operator()(const f32x4 (&acc)[2][2][4][2], const Unit& u, int wr, int wc, int fr, int fq) const {
        const int row0 = u.pm * BM + wr * 64 + fr, col0 = u.pn * BM + wc * 32 + 8 * fq;
#pragma unroll
        for (int ai = 0; ai < 2; ++ai)
#pragma unroll
            for (int m = 0; m < 4; ++m) { bf16_t* rowp = O + (size_t)(row0 + ai * HALF + m * 16) * ldc + col0;
#pragma unroll
                for (int bj = 0; bj < 2; ++bj) { const f32x4 v0 = acc[ai][bj][m][0], v1 = acc[ai][bj][m][1];
                    u32x4 w; w.x = cvt_pk_bf16(v0[0], v0[1]); w.y = cvt_pk_bf16(v0[2], v0[3]); w.z = cvt_pk_bf16(v1[0], v1[1]); w.w = cvt_pk_bf16(v1[2], v1[3]);
                    *(u32x4*)(rowp + bj * HALF) = w; } }
    }
};
struct Bf16Sc1 {
    static constexpr bool PERM = true;
    bf16_t* O; int ldc; unsigned nbytes;
    __device__ __forceinline__ void operator()(const f32x4 (&acc)[2][2][4][2], const Unit& u, int wr, int wc, int fr, int fq) const {
        const __amdgpu_buffer_rsrc_t rsrc = __builtin_amdgcn_make_buffer_rsrc(O, 0, nbytes, 0x00020000);
        const int row0 = u.pm * BM + wr * 64 + fr, col0 = u.pn * BM + wc * 32 + 8 * fq;
#pragma unroll
        for (int ai = 0; ai < 2; ++ai)
#pragma unroll
            for (int m = 0; m < 4; ++m) { const unsigned off = (unsigned)(((size_t)(row0 + ai * HALF + m * 16) * ldc + col0) * 2);
#pragma unroll
                for (int bj = 0; bj < 2; ++bj) { const f32x4 v0 = acc[ai][bj][m][0], v1 = acc[ai][bj][m][1];
                    u32x4 w; w.x = cvt_pk_bf16(v0[0], v0[1]); w.y = cvt_pk_bf16(v0[2], v0[3]); w.z = cvt_pk_bf16(v1[0], v1[1]); w.w = cvt_pk_bf16(v1[2], v1[3]);
                    __builtin_amdgcn_raw_buffer_store_b128(w, rsrc, off + bj * HALF * 2, 0,   16); } }
    }
};
struct F32Grouped {
    static constexpr bool PERM = false;
    float* C; int ldc; size_t gstride;
    __device__ __forceinline__ void operator()(const f32x4 (&acc)[2][2][4][2], const Unit& u, int wr, int wc, int fr, int fq) const {
        const int row0 = u.pm * BM + wr * 64 + fr, col0 = u.pn * BM + wc * 32 + 4 * fq; float* Cg = C + (size_t)u.aux * gstride;
#pragma unroll
        for (int ai = 0; ai < 2; ++ai)
#pragma unroll
            for (int m = 0; m < 4; ++m) { float* rowp = Cg + (size_t)(row0 + ai * HALF + m * 16) * ldc + col0;
#pragma unroll
                for (int bj = 0; bj < 2; ++bj)
#pragma unroll
                    for (int n = 0; n < 2; ++n) *(f32x4*)(rowp + bj * HALF + n * 16) = acc[ai][bj][m][n]; }
    }
};
struct SwiGlu {
    static constexpr bool PERM = true;
    bf16_t* H; int ldc;
    __device__ __forceinline__ void operator()(const f32x4 (&acc)[2][2][4][2], const Unit& u, int wr, int wc, int fr, int fq) const {
        const int row0 = u.pm * BM + wr * 64 + fr, col0 = u.pn * HALF + wc * 32 + 8 * fq;
#pragma unroll
        for (int ai = 0; ai < 2; ++ai)
#pragma unroll
            for (int m = 0; m < 4; ++m) { bf16_t* rowp = H + (size_t)(row0 + ai * HALF + m * 16) * ldc + col0;
                float o[8];
#pragma unroll
                for (int n = 0; n < 2; ++n)
#pragma unroll
                    for (int e = 0; e < 4; ++e) o[4 * n + e] = siluf_(acc[ai][0][m][n][e]) * acc[ai][1][m][n][e];
                u32x4 w; w.x = cvt_pk_bf16(o[0], o[1]); w.y = cvt_pk_bf16(o[2], o[3]); w.z = cvt_pk_bf16(o[4], o[5]); w.w = cvt_pk_bf16(o[6], o[7]);
                *(u32x4*)rowp = w; }
    }
};
struct MoeDown {
    static constexpr bool PERM = true;
    bf16_t* Y; const int* row_tok;
    __device__ __forceinline__ void operator()(const f32x4 (&acc)[2][2][4][2], const Unit& u, int wr, int wc, int fr, int fq) const {
        const int srow0 = u.aux * BM + wr * 64 + fr, col0 = u.pn * BM + wc * 32 + 8 * fq;
        int dsts[8];
#pragma unroll
        for (int it = 0; it < 8; ++it) dsts[it] = row_tok[srow0 + (it >> 2) * HALF + (it & 3) * 16];
#pragma unroll
        for (int ai = 0; ai < 2; ++ai)
#pragma unroll
            for (int m = 0; m < 4; ++m) { const int dst = dsts[ai * 4 + m];
                if (dst >= 0) { bf16_t* rowp = Y + (size_t)dst * D + col0;
#pragma unroll
                    for (int bj = 0; bj < 2; ++bj) { const f32x4 v0 = acc[ai][bj][m][0], v1 = acc[ai][bj][m][1];
                        u32x4 w; w.x = cvt_pk_bf16(v0[0], v0[1]); w.y = cvt_pk_bf16(v0[2], v0[3]); w.z = cvt_pk_bf16(v1[0], v1[1]); w.w = cvt_pk_bf16(v1[2], v1[3]);
                        *(u32x4*)(rowp + bj * HALF) = w; } } }
    }
};
struct SigmoidBias {
    static constexpr bool PERM = true;
    bf16_t* O; int ldc; const float* bias;
    __device__ __forceinline__ void operator()(const f32x4 (&acc)[2][2][4][2], const Unit& u, int wr, int wc, int fr, int fq) const {
        const int row0 = u.pm * BM + wr * 64 + fr, col0 = u.pn * BM + wc * 32 + 8 * fq;
        f32x4 bv[2][2];
#pragma unroll
        for (int bj = 0; bj < 2; ++bj)
#pragma unroll
            for (int n = 0; n < 2; ++n) bv[bj][n] = *(const f32x4*)(bias + col0 + bj * HALF + 4 * n);
#pragma unroll
        for (int ai = 0; ai < 2; ++ai)
#pragma unroll
            for (int m = 0; m < 4; ++m) { bf16_t* rowp = O + (size_t)(row0 + ai * HALF + m * 16) * ldc + col0;
#pragma unroll
                for (int bj = 0; bj < 2; ++bj) { f32x4 v0 = acc[ai][bj][m][0] + bv[bj][0], v1 = acc[ai][bj][m][1] + bv[bj][1];
#pragma unroll
                    for (int e = 0; e < 4; ++e) { v0[e] = sigmoidf_(v0[e]); v1[e] = sigmoidf_(v1[e]); }
                    u32x4 w; w.x = cvt_pk_bf16(v0[0], v0[1]); w.y = cvt_pk_bf16(v0[2], v0[3]); w.z = cvt_pk_bf16(v1[0], v1[1]); w.w = cvt_pk_bf16(v1[2], v1[3]);
                    *(u32x4*)(rowp + bj * HALF) = w; } }
    }
};
struct MulBf16 {
    static constexpr bool PERM = true;
    bf16_t* O; const bf16_t* G; int ldc;
    __device__ __forceinline__ void operator()(const f32x4 (&acc)[2][2][4][2], const Unit& u, int wr, int wc, int fr, int fq) const {
        const int row0 = u.pm * BM + wr * 64 + fr, col0 = u.pn * BM + wc * 32 + 8 * fq;
        u32x4 gq[2], gn[2];
        { const size_t off = (size_t)row0 * ldc + col0; gn[0] = *(const u32x4*)(G + off); gn[1] = *(const u32x4*)(G + off + HALF); }
#pragma unroll
        for (int it = 0; it < 8; ++it) { const int ai = it >> 2, m = it & 3; const size_t off = (size_t)(row0 + ai * HALF + m * 16) * ldc + col0;
            gq[0] = gn[0]; gq[1] = gn[1];
            if (it < 7) { const int ai2 = (it + 1) >> 2, m2 = (it + 1) & 3; const size_t off2 = (size_t)(row0 + ai2 * HALF + m2 * 16) * ldc + col0; gn[0] = *(const u32x4*)(G + off2); gn[1] = *(const u32x4*)(G + off2 + HALF); }
#pragma unroll
            for (int bj = 0; bj < 2; ++bj) { const f32x4 v0 = acc[ai][bj][m][0], v1 = acc[ai][bj][m][1]; const u32x4 g4 = gq[bj];
                u32x4 w; w.x = cvt_pk_bf16(v0[0] * bflo(g4.x), v0[1] * bfhi(g4.x)); w.y = cvt_pk_bf16(v0[2] * bflo(g4.y), v0[3] * bfhi(g4.y));
                w.z = cvt_pk_bf16(v1[0] * bflo(g4.z), v1[1] * bfhi(g4.z)); w.w = cvt_pk_bf16(v1[2] * bflo(g4.w), v1[3] * bfhi(g4.w));
                *(u32x4*)(O + off + bj * HALF) = w; }
            asm volatile("" ::: "memory"); }
    }
};
struct S5Out {
    static constexpr bool PERM = true;
    bf16_t* ZS5; const bf16_t* Z; const float* dskip;
    __device__ __forceinline__ void operator()(const f32x4 (&acc)[2][2][4][2], const Unit& u, int wr, int wc, int fr, int fq) const {
        const int g = u.aux, row0 = u.pm * BM + wr * 64 + fr;
#pragma unroll
        for (int bj = 0; bj < 2; ++bj) { const int col = u.pn * BM + bj * HALF + wc * 32 + 8 * fq, jo = col >> 4, co0 = col & 15, ch0 = g * 16 + co0;
            const f32x4 d0 = *(const f32x4*)(dskip + ch0), d1 = *(const f32x4*)(dskip + ch0 + 4);
#pragma unroll
            for (int ai = 0; ai < 2; ++ai)
#pragma unroll
                for (int m = 0; m < 4; ++m) { const int mr = row0 + ai * HALF + m * 16; const long tok = (long)(mr >> 7) * SEQ + (mr & 127) * S5LC + jo;
                    const u32x4 uq = *(const u32x4*)(Z + tok * INP + ZS + ch0); const f32x4 v0 = acc[ai][bj][m][0], v1 = acc[ai][bj][m][1];
                    u32x4 w; w.x = cvt_pk_bf16(gelu_tanh(v0[0] + d0[0] * bflo(uq.x)), gelu_tanh(v0[1] + d0[1] * bfhi(uq.x)));
                    w.y = cvt_pk_bf16(gelu_tanh(v0[2] + d0[2] * bflo(uq.y)), gelu_tanh(v0[3] + d0[3] * bfhi(uq.y)));
                    w.z = cvt_pk_bf16(gelu_tanh(v1[0] + d1[0] * bflo(uq.z)), gelu_tanh(v1[1] + d1[1] * bfhi(uq.z)));
                    w.w = cvt_pk_bf16(gelu_tanh(v1[2] + d1[2] * bflo(uq.w)), gelu_tanh(v1[3] + d1[3] * bfhi(uq.w)));
                    *(u32x4*)(ZS5 + tok * 256 + ch0) = w; asm volatile("" ::: "memory"); } }
    }
};
struct S5Glu {
    static constexpr bool PERM = true;
    bf16_t* MIX; const bf16_t* ZS5; const float* bias;
    __device__ __forceinline__ void operator()(const f32x4 (&acc)[2][2][4][2], const Unit& u, int wr, int wc, int fr, int fq) const {
        const int row0 = u.pm * BM + wr * 64 + fr, col0 = wc * 32 + 8 * fq;
#pragma unroll
        for (int bj = 0; bj < 2; ++bj) { const int col = col0 + bj * HALF; const f32x4 b0 = *(const f32x4*)(bias + col), b1 = *(const f32x4*)(bias + col + 4);
#pragma unroll
            for (int ai = 0; ai < 2; ++ai)
#pragma unroll
                for (int m = 0; m < 4; ++m) { const size_t row = (size_t)(row0 + ai * HALF + m * 16); const u32x4 zq = *(const u32x4*)(ZS5 + row * 256 + col);
                    const f32x4 v0 = acc[ai][bj][m][0] + b0, v1 = acc[ai][bj][m][1] + b1;
                    u32x4 w; w.x = cvt_pk_bf16(bflo(zq.x) * sigmoidf_(v0[0]), bfhi(zq.x) * sigmoidf_(v0[1])); w.y = cvt_pk_bf16(bflo(zq.y) * sigmoidf_(v0[2]), bfhi(zq.y) * sigmoidf_(v0[3]));
                    w.z = cvt_pk_bf16(bflo(zq.z) * sigmoidf_(v1[0]), bfhi(zq.z) * sigmoidf_(v1[1])); w.w = cvt_pk_bf16(bflo(zq.w) * sigmoidf_(v1[2]), bfhi(zq.w) * sigmoidf_(v1[3]));
                    *(u32x4*)(MIX + row * 1024 + 768 + col) = w; asm volatile("" ::: "memory"); } }
    }
};
struct EpiWin {
    static constexpr bool PERM = true;
    bf16_t* Z; bf16_t* Q; bf16_t* KV; bf16_t* AP; const f32x2* rope;
    __device__ __forceinline__ void operator()(const f32x4 (&acc)[2][2][4][2], const Unit& u, int wr, int wc, int fr, int fq) const {
        const int row0 = u.pm * BM + wr * 64 + fr;
        if (u.pn >= 5) {
#pragma unroll
            for (int bj = 0; bj < 2; ++bj) { const int col0 = u.pn * BM + bj * HALF + wc * 32 + 8 * fq; const int sc0 = col0 - ZS; const bool s5 = (sc0 >= 0) && (sc0 < 256);
#pragma unroll
                for (int ai = 0; ai < 2; ++ai)
#pragma unroll
                    for (int m = 0; m < 4; ++m) { const int tok = row0 + ai * HALF + m * 16; const f32x4 v0 = acc[ai][bj][m][0], v1 = acc[ai][bj][m][1];
                        u32x4 w; w.x = cvt_pk_bf16(v0[0], v0[1]); w.y = cvt_pk_bf16(v0[2], v0[3]); w.z = cvt_pk_bf16(v1[0], v1[1]); w.w = cvt_pk_bf16(v1[2], v1[3]);
                        *(u32x4*)(Z + (size_t)tok * INP + col0) = w;
                        if (s5) { const int b = tok >> 12, t = tok & 4095; *(u32x4*)(AP + ((size_t)(sc0 >> 4) * 2048 + b * 128 + (t >> 5)) * S5K + (t & 31) * 16 + (sc0 & 15)) = w; } } }
            return;
        }
#pragma unroll
        for (int bj = 0; bj < 2; ++bj) {
            const int colh = bj * HALF + wc * 32 + 8 * fq;
            const int qi = 4 * (wc & 1) + fq, d1 = 4 * qi;
            const bool isv = (u.pn >= 2) && (bj == 1);
            f32x4 cn0 = (f32x4){0.f, 0.f, 0.f, 0.f}, cn1 = cn0;
            if (!isv) { cn0 = *(const f32x4*)(rope + (size_t)row0 * 32 + d1); cn1 = *(const f32x4*)(rope + (size_t)row0 * 32 + d1 + 2); }
#pragma unroll
            for (int it = 0; it < 8; ++it) { const int ai = it >> 2, m = it & 3; const int tok = row0 + ai * HALF + m * 16; const int b = tok >> 12, t = tok & 4095; const f32x4 x1 = acc[ai][bj][m][0], x2 = acc[ai][bj][m][1];
                    if (isv) { bf16_t* dst = KV + (size_t)((u.pn - 2) * 2 + 1) * (8u << 20) + ((size_t)(b * 2 + (wc >> 1)) * SEQ + t) * 64 + 32 * (wc & 1) + 8 * fq;
                        u32x4 w; w.x = cvt_pk_bf16(x1[0], x1[1]); w.y = cvt_pk_bf16(x1[2], x1[3]); w.z = cvt_pk_bf16(x2[0], x2[1]); w.w = cvt_pk_bf16(x2[2], x2[3]); *(u32x4*)dst = w; }
                    else { const f32x4 cs0 = cn0, cs1 = cn1;
                        if (it < 7) { const int tok2 = row0 + ((it + 1) >> 2) * HALF + ((it + 1) & 3) * 16; cn0 = *(const f32x4*)(rope + (size_t)tok2 * 32 + d1); cn1 = *(const f32x4*)(rope + (size_t)tok2 * 32 + d1 + 2); }
                        const float sc = (u.pn < 2) ? QSCALE : 1.0f;
                        const float o10 = (x1[0] * cs0[0] - x2[0] * cs0[1]) * sc, o11 = (x1[1] * cs0[2] - x2[1] * cs0[3]) * sc, o12 = (x1[2] * cs1[0] - x2[2] * cs1[1]) * sc, o13 = (x1[3] * cs1[2] - x2[3] * cs1[3]) * sc;
                        const float o20 = (x2[0] * cs0[0] + x1[0] * cs0[1]) * sc, o21 = (x2[1] * cs0[2] + x1[1] * cs0[3]) * sc, o22 = (x2[2] * cs1[0] + x1[2] * cs1[1]) * sc, o23 = (x2[3] * cs1[2] + x1[3] * cs1[3]) * sc;
                        bf16_t* dst = (u.pn < 2) ? Q + (size_t)tok * 512 + (u.pn * 4 + (colh >> 6)) * 64 + d1
                                                 : KV + (size_t)((u.pn - 2) * 2) * (8u << 20) + ((size_t)(b * 2 + (wc >> 1)) * SEQ + t) * 64 + d1;
                        u32x2 w1, w2; w1.x = cvt_pk_bf16(o10, o11); w1.y = cvt_pk_bf16(o12, o13); w2.x = cvt_pk_bf16(o20, o21); w2.y = cvt_pk_bf16(o22, o23);
                        *(u32x2*)dst = w1; *(u32x2*)(dst + 32) = w2; }
                    asm volatile("" ::: "memory"); }
        }
    }
};
}
constexpr size_t MiB = 1u << 20;
constexpr size_t WS_CTL = 0, CTL_ZERO_BYTES = 1 * MiB;
constexpr size_t WS_SMALL = 1 * MiB;
constexpr size_t SM_APOW = WS_SMALL;
constexpr size_t SM_BBAR = WS_SMALL + 5 * MiB / 4;
constexpr size_t SM_KTAB = WS_SMALL + 2 * MiB;
constexpr size_t SM_CMPB = WS_SMALL + 4 * MiB;
constexpr size_t SM_TOKE = WS_SMALL + 4 * MiB + 256 * 1024;
constexpr size_t SM_TOKW = WS_SMALL + 4 * MiB + 512 * 1024;
constexpr size_t SM_ROWTOK = WS_SMALL + 5 * MiB + 256 * 1024;
constexpr size_t SM_PCNT = WS_SMALL + 6 * MiB;
constexpr size_t SM_TILEEXP = WS_SMALL + 6 * MiB + 16384;
constexpr size_t WS_ROPE = 8 * MiB;
constexpr size_t WS_W = 24 * MiB;
constexpr size_t W_IN = WS_W;
constexpr size_t W_OUT = W_IN + (size_t)INP * D * 2;
constexpr size_t W_GATE = W_OUT + (size_t)D * D * 2;
constexpr size_t W_PROJ = W_GATE + (size_t)D * D * 2;
constexpr size_t W_CMP = W_PROJ + (size_t)D * PLE * 2;
constexpr size_t W_GLU = W_CMP + (size_t)2 * 512 * 1024 * 2;
constexpr size_t W_S5B = W_GLU + (size_t)256 * 256 * 2;
constexpr size_t W_S5S = W_S5B + (size_t)16 * 512 * S5K * 2;
constexpr size_t W_UP = W_S5S + (size_t)16 * 256 * 512 * 2;
constexpr size_t W_DN = W_UP + (size_t)NEXP * 2 * DFE * D * 2;
constexpr size_t W_END_ = W_DN + (size_t)NEXP * D * DFE * 2;
static_assert(W_END_ <= WS_W + 240 * MiB, "weight region");
constexpr size_t WS_XB = 264 * MiB;
constexpr size_t WS_PB = 392 * MiB;
constexpr size_t WS_Z = 424 * MiB;
constexpr size_t WS_QKV = 712 * MiB;
constexpr size_t WS_Q = WS_QKV, WS_KCMP = WS_QKV + 64 * MiB, WS_VCMP = WS_KCMP + 16 * MiB, WS_KSEL = WS_VCMP + 16 * MiB, WS_VSEL = WS_KSEL + 16 * MiB, WS_KWIN = WS_VSEL + 16 * MiB, WS_VWIN = WS_KWIN + 16 * MiB;
constexpr size_t WS_MIX = 872 * MiB;
constexpr size_t WS_CMP = 1000 * MiB;
constexpr size_t WS_CMPP = WS_CMP, WS_KC = WS_CMP + 32 * MiB, WS_VCT = WS_KC + 1 * MiB, WS_SELM = WS_VCT + 1 * MiB;
constexpr size_t WS_S5 = 1036 * MiB;
constexpr size_t WS_S5A = WS_S5, WS_S5S = WS_S5 + 40 * MiB, WS_ZS5 = WS_S5S + 32 * MiB;
constexpr size_t WS_HBUF = 1140 * MiB;
constexpr size_t WS_END = 1268 * MiB;
constexpr size_t WS_FFH = WS_Z, WS_XS = WS_Z, WS_MH = WS_Z + 260 * MiB, WS_YB = WS_MH + 224 * MiB;
static_assert(WS_YB + 256 * MiB <= WS_END && WS_FFH + (size_t)T * DFF * 2 <= WS_MIX, "overlays");
constexpr size_t WS_PLEG = WS_Z, WS_PLEH = WS_Z + 128 * MiB;
static_assert(WS_PLEH + 128 * MiB <= WS_MH, "per-layer-embedding buffers of the MoE layers");
constexpr int CW_BAR = 4096;
constexpr int CW_TMO = 64;
constexpr int CW_CNT = 16384, CNT_BANK = 256 * 64;
static_assert((CW_CNT + 8 * CNT_BANK) * 4 <= (int)CTL_ZERO_BYTES, "panel counters inside the per-call memset");

struct Args { const void* in[36]; float* out; unsigned char* ws; int gp_lo, gp_hi, use_bar, pad; };
struct Frame { LAS unsigned char* lds; int tid, lane, wave, G, bid, own; };
constexpr int RING_BYTES = 131072, LDSCTL_OFF = RING_BYTES, LDS_BYTES = 147456;
typedef __attribute__((address_space(4))) const Args CArgs;
__device__ __forceinline__ void load_args(Args& a) { CArgs* p = (CArgs*)__builtin_amdgcn_kernarg_segment_ptr(); asm volatile("" : "+s"(p)); __builtin_memcpy(&a, p, sizeof(Args)); }
__device__ __forceinline__ Frame make_frame(LAS unsigned char* lds, int wave0) { Frame F; F.lds = lds;
    int w = wave0; asm volatile("" : "+s"(w)); int ln = lane_id_fresh(); F.lane = ln; F.wave = w; F.tid = w * 64 + ln;
    int b = blockIdx.x, g = gridDim.x; asm volatile("" : "+s"(b), "+s"(g)); F.bid = b; F.G = g;
    F.own = (g == 256) ? 32 * (b & 7) + (b >> 3) : b; return F; }

__constant__ double c_invfreq_rev[32] = {0.15915494309189535, 0.11934937021124886, 0.08949940160889101, 0.06711508300522726, 0.050329212104487035, 0.03774158471741977, 0.0283021958306234, 0.02122365276477766, 0.015915494309189534, 0.011934937021124886, 0.008949940160889102, 0.006711508300522725, 0.005032921210448704, 0.003774158471741977, 0.00283021958306234, 0.0021223652764777662, 0.0015915494309189536, 0.0011934937021124885, 0.0008949940160889102, 0.0006711508300522726, 0.0005032921210448703, 0.00037741584717419774, 0.00028302195830623395, 0.0002122365276477766, 0.00015915494309189535, 0.00011934937021124886, 8.949940160889102e-05, 6.711508300522725e-05, 5.0329212104487035e-05, 3.774158471741978e-05, 2.8302195830623396e-05, 2.122365276477766e-05};

__device__ __forceinline__ void sincos_rev(double rev, float& c, float& s) { const double fr = rev - __builtin_floor(rev); const float f = (float)fr; s = __builtin_amdgcn_sinf(f); c = __builtin_amdgcn_cosf(f); }

template <class Sched>
__device__ __forceinline__ void panels_publish_wait(const Frame& F, unsigned* ctl, int bank, const Sched& S, unsigned need) {
    unsigned* cnt = ctl + CW_CNT + bank * CNT_BANK;
    if (F.tid == 0) { pg8::Unit u; for (int i = 0; S.next(i, u); ++i) __hip_atomic_fetch_add(cnt + 64 * u.pm, 1u, __ATOMIC_RELAXED, __HIP_MEMORY_SCOPE_AGENT); }
    if (F.wave == 0) {
        for (int pm = F.own; pm < T / 256; pm += F.G) { unsigned spins = 0;
            while ((unsigned)__builtin_amdgcn_readfirstlane(__hip_atomic_load(cnt + 64 * pm, __ATOMIC_RELAXED, __HIP_MEMORY_SCOPE_AGENT)) < need) {
                __builtin_amdgcn_s_sleep(1);
                if (++spins > (1u << 22)) { if (F.lane == 0) __hip_atomic_store(ctl + CW_TMO, 1u, __ATOMIC_RELAXED, __HIP_MEMORY_SCOPE_AGENT); break; }
                if ((spins & 1023u) == 0u && __builtin_amdgcn_readfirstlane(__hip_atomic_load(ctl + CW_TMO, __ATOMIC_RELAXED, __HIP_MEMORY_SCOPE_AGENT))) break; } }
        __builtin_amdgcn_fence(__ATOMIC_ACQUIRE, "agent");
        asm volatile("s_waitcnt vmcnt(0)" ::: "memory");
    }
    __syncthreads();
}
__device__ __forceinline__ void phase_init0(const Frame& F, const Args& a) {
    const size_t gt = (size_t)F.bid * 512 + F.tid, NT = (size_t)F.G * 512;
    const int* pos = (const int*)a.in[2]; f32x2* rope = (f32x2*)(a.ws + WS_ROPE);
    for (size_t i = gt; i < (size_t)T * 32; i += NT) { const int tok = (int)(i >> 5), k = (int)(i & 31); float c, s; sincos_rev((double)pos[tok] * c_invfreq_rev[k], c, s); rope[i] = (f32x2){c, s}; }
    const float* are = (const float*)a.in[14]; const float* aim = (const float*)a.in[15]; const float* ldt = (const float*)a.in[16];
    const float* bre = (const float*)a.in[17]; const float* bim = (const float*)a.in[18];
    f32x2* apow = (f32x2*)(a.ws + SM_APOW); f32x2* bbar = (f32x2*)(a.ws + SM_BBAR);
    for (size_t i = gt; i < (size_t)DEPTH * 16 * 64 * 34; i += NT) { const int k = (int)(i % 34), lgn = (int)(i / 34), lg = lgn >> 6;
        const float dt = __expf(ldt[lg]); const float ar = are[lgn] * dt; const double rev = (double)k * ((double)aim[lgn] * (double)dt) * 0.15915494309189535;
        float c, s; sincos_rev(rev, c, s); const float mg = __expf((float)k * ar); apow[i] = (f32x2){mg * c, mg * s}; }
    for (size_t i = gt; i < (size_t)DEPTH * 16 * 64 * 16; i += NT) { const int lgn = (int)(i >> 4), lg = lgn >> 6;
        const float dt = __expf(ldt[lg]); const float lr = are[lgn], li = aim[lgn]; const double rev = ((double)li * (double)dt) * 0.15915494309189535;
        float c, s; sincos_rev(rev, c, s); const float mg = __expf(lr * dt); const float abr = mg * c, abi = mg * s, den = lr * lr + li * li;
        const float cr = ((abr - 1.0f) * lr + abi * li) / den, ci = (abi * lr - (abr - 1.0f) * li) / den;
        const float br = bre[i], bi = bim[i]; bbar[i] = (f32x2){cr * br - ci * bi, cr * bi + ci * br}; }
    const f32x4* x4 = (const f32x4*)a.in[0]; u32x2* xb = (u32x2*)(a.ws + WS_XB);
    for (size_t i = gt; i < (size_t)T * D / 4; i += 4 * NT) { f32x4 v[4];
#pragma unroll
        for (int q = 0; q < 4; ++q) { const size_t ii = i + q * NT; v[q] = (ii < (size_t)T * D / 4) ? x4[ii] : (f32x4){0.f, 0.f, 0.f, 0.f}; }
#pragma unroll
        for (int q = 0; q < 4; ++q) { const size_t ii = i + q * NT; if (ii < (size_t)T * D / 4) { u32x2 w; w.x = cvt_pk_bf16(v[q][0], v[q][1]); w.y = cvt_pk_bf16(v[q][2], v[q][3]); xb[ii] = w; } } }
}
__device__ __forceinline__ void phase_init1(const Frame& F, const Args& a) {
    const size_t gt = (size_t)F.bid * 512 + F.tid, NT = (size_t)F.G * 512;
    const float* cre = (const float*)a.in[19]; const float* cim = (const float*)a.in[20];
    const f32x2* apow = (const f32x2*)(a.ws + SM_APOW); const f32x2* bbar = (const f32x2*)(a.ws + SM_BBAR); float* ktab = (float*)(a.ws + SM_KTAB);
    for (size_t i = gt; i < (size_t)DEPTH * 16 * 32 * 256; i += NT) { const int ci = (int)(i & 15), co = (int)((i >> 4) & 15), tau = (int)((i >> 8) & 31), lg = (int)(i >> 13);
        float acc = 0.f;
        for (int n = 0; n < 64; ++n) { const f32x2 P = apow[((size_t)lg * 64 + n) * 34 + tau], Bb = bbar[((size_t)lg * 64 + n) * 16 + ci]; const float cr = cre[((size_t)lg * 16 + co) * 64 + n], cm = cim[((size_t)lg * 16 + co) * 64 + n];
            const float hr = P.x * Bb.x - P.y * Bb.y, hi = P.x * Bb.y + P.y * Bb.x; acc += cr * hr - cm * hi; }
        ktab[i] = acc; }
}

__device__ __forceinline__ void transpose_item(const float* W, int ldw, int k0, int n0, int nvalid, bf16_t* dstrow, int dst_ld, LAS float* scr, int lane, int permhi) {
    float tv[32];
#pragma unroll
    for (int i = 0; i < 32; ++i) { const int kk = 2 * i + (lane >> 5), nn = lane & 31; tv[i] = (nn < nvalid) ? W[(size_t)(k0 + kk) * ldw + n0 + nn] : 0.f; }
#pragma unroll
    for (int i = 0; i < 32; ++i) { const int kk = 2 * i + (lane >> 5), nn = lane & 31; scr[kk * 33 + nn] = tv[i]; }
    LDS_WAIT(); asm volatile("" ::: "memory");
    const int c = lane & 7;
#pragma unroll
    for (int j = 0; j < 4; ++j) { const int n = (lane >> 3) + 8 * j; const LAS float* s = scr + (8 * c) * 33 + n;
        u32x4 o; o.x = cvt_pk_bf16(s[0 * 33], s[1 * 33]); o.y = cvt_pk_bf16(s[2 * 33], s[3 * 33]); o.z = cvt_pk_bf16(s[4 * 33], s[5 * 33]); o.w = cvt_pk_bf16(s[6 * 33], s[7 * 33]);
        const int drow = permhi < 0 ? n : (8 * (n >> 2) + 4 * permhi + (n & 3));
        if (n < nvalid) *(u32x4*)(dstrow + (size_t)drow * dst_ld + 8 * c) = o; }
    LDS_WAIT(); asm volatile("" ::: "memory");
}
__device__ __forceinline__ void transpose_mat(const float* W, int K, int N, bf16_t* dst, int dst_ld, int mode, LAS float* scr, int lane, int& cursor, int gw, int NGW) {
    const int nblk = (N + 31) / 32, items = (K / 64) * nblk;
    int it = ((gw - cursor) % NGW + NGW) % NGW;
    for (; it < items; it += NGW) { const int kb = it / nblk, nb = it % nblk, k0 = 64 * kb, n0 = 32 * nb; const int nv = (N - n0) < 32 ? (N - n0) : 32;
        int drow = n0, permhi = -1;
        if (mode == 1 || mode == 2) drow = (n0 >> 7) * 256 + (n0 & 127) + (mode == 2 ? 128 : 0);
        if (mode == 3 && (n0 < 512 || (n0 < 1280 && (((n0 - 512) >> 7) & 1) == 0))) { drow = n0 & ~63; permhi = (n0 >> 5) & 1; }
        transpose_item(W, N, k0, n0, nv, dst + (size_t)drow * dst_ld + k0, dst_ld, scr, lane, permhi); }
    cursor = (cursor + items) % NGW;
}

__device__ __forceinline__ void phase_prep(const Frame& F, const Args& a, int l) {
    LAS float* scr = (LAS float*)(F.lds + F.wave * 16384);
    const int gw = F.bid * 8 + F.wave, NGW = F.G * 8; int cursor = 0;
    unsigned char* ws = a.ws;
    transpose_mat((const float*)a.in[3] + (size_t)l * D * INW, D, INW, (bf16_t*)(ws + W_IN), D, 3, scr, F.lane, cursor, gw, NGW);
    transpose_mat((const float*)a.in[4] + (size_t)l * D * D, D, D, (bf16_t*)(ws + W_OUT), D, 0, scr, F.lane, cursor, gw, NGW);
    transpose_mat((const float*)a.in[31] + (size_t)l * D * D, D, D, (bf16_t*)(ws + W_GATE), D, 0, scr, F.lane, cursor, gw, NGW);
    transpose_mat((const float*)a.in[33] + (size_t)l * PLE * D, PLE, D, (bf16_t*)(ws + W_PROJ), PLE, 0, scr, F.lane, cursor, gw, NGW);
    for (int j = 0; j < 2; ++j) { const float* w1 = (const float*)a.in[6] + ((size_t)l * 2 + j) * 2048 * 256; bf16_t* dst = (bf16_t*)(ws + W_CMP) + (size_t)j * 512 * 1024;
        transpose_mat(w1, 1024, 256, dst, 1024, 0, scr, F.lane, cursor, gw, NGW);
        transpose_mat(w1 + (size_t)1024 * 256, 1024, 256, dst + (size_t)256 * 1024, 1024, 0, scr, F.lane, cursor, gw, NGW); }
    transpose_mat((const float*)a.in[22] + (size_t)l * 256 * 256, 256, 256, (bf16_t*)(ws + W_GLU), 256, 0, scr, F.lane, cursor, gw, NGW);
    const int j2 = l >> 1;
    if ((l & 1) == 0) {
        transpose_mat((const float*)a.in[24] + (size_t)j2 * D * DFF, D, DFF, (bf16_t*)(ws + W_UP), D, 1, scr, F.lane, cursor, gw, NGW);
        transpose_mat((const float*)a.in[25] + (size_t)j2 * D * DFF, D, DFF, (bf16_t*)(ws + W_UP), D, 2, scr, F.lane, cursor, gw, NGW);
        transpose_mat((const float*)a.in[26] + (size_t)j2 * DFF * D, DFF, D, (bf16_t*)(ws + W_DN), DFF, 0, scr, F.lane, cursor, gw, NGW);
    } else {
        for (int e = 0; e < NEXP; ++e) { const size_t eo = (size_t)j2 * NEXP + e;
            transpose_mat((const float*)a.in[28] + eo * D * DFE, D, DFE, (bf16_t*)(ws + W_UP) + (size_t)e * 2 * DFE * D, D, 1, scr, F.lane, cursor, gw, NGW);
            transpose_mat((const float*)a.in[29] + eo * D * DFE, D, DFE, (bf16_t*)(ws + W_UP) + (size_t)e * 2 * DFE * D, D, 2, scr, F.lane, cursor, gw, NGW);
            transpose_mat((const float*)a.in[30] + eo * DFE * D, DFE, D, (bf16_t*)(ws + W_DN) + (size_t)e * D * DFE, DFE, 0, scr, F.lane, cursor, gw, NGW); }
    }
    const size_t gt = (size_t)F.bid * 512 + F.tid, NT = (size_t)F.G * 512;
    {
        u32x4* zp = (u32x4*)((bf16_t*)(ws + W_IN) + (size_t)INW * D); const size_t n16 = (size_t)(INP - INW) * D * 2 / 16;
        unsigned zz = 0u; asm volatile("" : "+v"(zz));
        for (size_t i = gt; i < n16; i += NT) zp[i] = (u32x4){zz, zz, zz, zz};
    }
    {
        const f32x4* p4 = (const f32x4*)((const float*)a.in[1] + (size_t)l * T * PLE); u32x2* pb = (u32x2*)(ws + WS_PB);
        for (size_t i = gt; i < (size_t)T * PLE / 4; i += 4 * NT) { f32x4 v[4];
#pragma unroll
            for (int q = 0; q < 4; ++q) { const size_t ii = i + q * NT; v[q] = (ii < (size_t)T * PLE / 4) ? p4[ii] : (f32x4){0.f, 0.f, 0.f, 0.f}; }
#pragma unroll
            for (int q = 0; q < 4; ++q) { const size_t ii = i + q * NT; if (ii < (size_t)T * PLE / 4) { u32x2 w; w.x = cvt_pk_bf16(v[q][0], v[q][1]); w.y = cvt_pk_bf16(v[q][2], v[q][3]); pb[ii] = w; } } }
    }
    {
        const float* ktab = (const float*)(ws + SM_KTAB) + (size_t)l * 16 * 32 * 256; const f32x2* apow = (const f32x2*)(ws + SM_APOW) + (size_t)l * 16 * 64 * 34; const f32x2* bbar = (const f32x2*)(ws + SM_BBAR) + (size_t)l * 16 * 64 * 16;
        const float* cre = (const float*)a.in[19] + (size_t)l * 16 * 16 * 64; const float* cim = (const float*)a.in[20] + (size_t)l * 16 * 16 * 64;
        bf16_t* Bt = (bf16_t*)(ws + W_S5B);
        for (size_t i = gt; i < (size_t)16 * 512 * S5K; i += NT) { const int k = (int)(i % S5K), row = (int)((i / S5K) & 511), g = (int)(i / ((size_t)S5K * 512)); const int jo = row >> 4, co = row & 15;
            float v;
            if (k < 512) { const int ji = k >> 4, ci = k & 15; v = (jo >= ji) ? ktab[(((size_t)g * 32 + (jo - ji)) * 16 + co) * 16 + ci] : 0.f; }
            else { const int n = (k - 512) & 63; const f32x2 P = apow[((size_t)g * 64 + n) * 34 + jo + 1]; const float cr = cre[((size_t)g * 16 + co) * 64 + n], cm = cim[((size_t)g * 16 + co) * 64 + n];
                v = (k < 576) ? (cr * P.x - cm * P.y) : -(cr * P.y + cm * P.x); }
            Bt[i] = f2bf(v); }
        bf16_t* St = (bf16_t*)(ws + W_S5S);
        for (size_t i = gt; i < (size_t)16 * 256 * 512; i += NT) { const int k = (int)(i & 511), np = (int)((i >> 9) & 255), g = (int)(i >> 17); const int j = k >> 4, ci = k & 15;
            float v = 0.f;
            if (np < 128) { const int n = np & 63; const f32x2 P = apow[((size_t)g * 64 + n) * 34 + (S5LC - 1 - j)], Bb = bbar[((size_t)g * 64 + n) * 16 + ci]; v = (np < 64) ? (P.x * Bb.x - P.y * Bb.y) : (P.x * Bb.y + P.y * Bb.x); }
            St[i] = f2bf(v); }
    }
    {
        float* cb = (float*)(ws + SM_CMPB); LAS float* red = (LAS float*)(F.lds + 8 * 16384 - 4096);
        for (int o = F.bid; o < 8; o += F.G) { const int j = o >> 2, cblk = o & 3; const float* w1 = (const float*)a.in[6] + ((size_t)l * 2 + j) * 2048 * 256 + cblk * 64 + F.lane; const float* pe = (const float*)a.in[5] + ((size_t)l * 2 + j) * 2048;
            float s0 = 0.f, s1 = 0.f, s2 = 0.f, s3 = 0.f;
#pragma unroll 4
            for (int k = 256 * F.wave; k < 256 * F.wave + 256; k += 4) { s0 += pe[k] * w1[(size_t)k * 256]; s1 += pe[k + 1] * w1[(size_t)(k + 1) * 256]; s2 += pe[k + 2] * w1[(size_t)(k + 2) * 256]; s3 += pe[k + 3] * w1[(size_t)(k + 3) * 256]; }
            __syncthreads(); red[F.wave * 64 + F.lane] = (s0 + s1) + (s2 + s3); __syncthreads();
            if (F.wave == 0) { float t = ((const float*)a.in[7])[((size_t)l * 2 + j) * 256 + cblk * 64 + F.lane];
#pragma unroll
                for (int w = 0; w < 8; ++w) t += red[w * 64 + F.lane];
                cb[j * 256 + cblk * 64 + F.lane] = t; }
            __syncthreads(); }
    }
}

__device__ __forceinline__ void conv_items(const Frame& F, const Args& a, int l, int first, int stride, int last = NB * (SEQ / 32)) {
    const bf16_t* z = (const bf16_t*)(a.ws + WS_Z); bf16_t* mix = (bf16_t*)(a.ws + WS_MIX);
    const float* cw = (const float*)a.in[10] + (size_t)l * 31 * 256; const float* cb = (const float*)a.in[11] + (size_t)l * 256;
    const float* lg = (const float*)a.in[12] + (size_t)l * 256; const float* lb = (const float*)a.in[13] + (size_t)l * 256;
    LAS float* U = (LAS float*)F.lds;
    LAS float* Y = (LAS float*)(F.lds + 65536);
    const int cp = F.tid & 127, tg = F.tid >> 7, c = 2 * cp;
    f32x2 w[31];
#pragma unroll
    for (int j = 0; j < 31; ++j) w[j] = *(const f32x2*)(cw + j * 256 + c);
    const f32x2 bias = *(const f32x2*)(cb + c);
    unsigned pva[16], pvg[16];
    auto fetch = [&](int it) { const int b = it >> 7, t0 = (it & 127) * 32;
#pragma unroll
        for (int q = 0; q < 16; ++q) { const int r = tg + 4 * q, t = t0 - 30 + r; pva[q] = 0u; pvg[q] = 0u;
            if (r < 62 && t >= 0) { const bf16_t* zr = z + ((size_t)b * SEQ + t) * INP + ZC; pva[q] = *(const unsigned*)(zr + c); pvg[q] = *(const unsigned*)(zr + 256 + c); } } };
    if (first < last) fetch(first);
    for (int it = first; it < last; it += stride) { const int b = it >> 7, t0 = (it & 127) * 32;
#pragma unroll
        for (int q = 0; q < 16; ++q) { const int r = tg + 4 * q, t = t0 - 30 + r;
            if (r < 62) { f32x2 u = (f32x2){0.f, 0.f}; if (t >= 0) u = (f32x2){bflo(pva[q]) * sigmoidf_(bflo(pvg[q])), bfhi(pva[q]) * sigmoidf_(bfhi(pvg[q]))};
                *(LAS f32x2*)(U + r * 256 + c) = u; } }
        if (it + stride < last) fetch(it + stride);
        __syncthreads();
        {   f32x2 acc[8];
#pragma unroll
            for (int i = 0; i < 8; ++i) acc[i] = bias;
#pragma unroll
            for (int k = 0; k < 38; ++k) { const f32x2 u = *(const LAS f32x2*)(U + (tg * 8 + k) * 256 + c);
#pragma unroll
                for (int i = 0; i < 8; ++i) { const int j = k - i; if (j >= 0 && j < 31) acc[i] += w[j] * u; } }
#pragma unroll
            for (int i = 0; i < 8; ++i) *(LAS f32x2*)(Y + (tg * 8 + i) * 256 + c) = acc[i];
        }
        __syncthreads();
        for (int i = 0; i < 4; ++i) { const int tl = F.wave * 4 + i; const f32x4 v = *(const LAS f32x4*)(Y + tl * 256 + F.lane * 4);
            const float mean = wave_sum((v[0] + v[1]) + (v[2] + v[3])) * (1.f / 256.f); const f32x4 dlt = v - mean;
            const float var = wave_sum((dlt[0] * dlt[0] + dlt[1] * dlt[1]) + (dlt[2] * dlt[2] + dlt[3] * dlt[3])) * (1.f / 256.f); const float rstd = 1.0f / sqrtf(var + LN_EPS);
            const f32x4 gg = *(const f32x4*)(lg + F.lane * 4), bb = *(const f32x4*)(lb + F.lane * 4);
            float o[4];
#pragma unroll
            for (int e = 0; e < 4; ++e) o[e] = siluf_(dlt[e] * rstd * gg[e] + bb[e]);
            u32x2 wv; wv.x = cvt_pk_bf16(o[0], o[1]); wv.y = cvt_pk_bf16(o[2], o[3]);
            *(u32x2*)(mix + ((size_t)b * SEQ + t0 + tl) * 1024 + 512 + F.lane * 4) = wv; }
        __syncthreads();
    }
}
__device__ __forceinline__ void cmp_stage2(const Frame& F, const Args& a, int l) {
    unsigned char* ws = a.ws; const float* cb = (const float*)(ws + SM_CMPB);
    LAS float* w2s = (LAS float*)F.lds;
    LAS float* hs = (LAS float*)(F.lds + 65536 + F.wave * 1024);
    const int gw = F.bid * 8 + F.wave, NGW = F.G * 8, lane = F.lane;
    for (int j = 0; j < 2; ++j) {
        const float* w2 = (const float*)a.in[8] + ((size_t)l * 2 + j) * 256 * 64; const float* b2 = (const float*)a.in[9] + ((size_t)l * 2 + j) * 64;
        __syncthreads();
        for (int i = F.tid; i < 256 * 64 / 4; i += 512) *(LAS f32x4*)(w2s + 4 * i) = *(const f32x4*)(w2 + 4 * i);
        __syncthreads();
        for (int it = gw; it < 32 * 256; it += NGW) { const int bh = it >> 8, n = it & 255;
            float outv = 0.f;
            if (n < NCMP) {
                const float* P = (const float*)(ws + WS_CMPP) + (size_t)j * 8192 * 512 + ((size_t)bh * 256 + n) * 512;
                const f32x4 p0 = *(const f32x4*)(P + lane * 4), p1 = *(const f32x4*)(P + 512 + 256 + lane * 4), bb = *(const f32x4*)(cb + j * 256 + lane * 4);
                f32x4 hv;
#pragma unroll
                for (int e = 0; e < 4; ++e) hv[e] = gelu_tanh(p0[e] + p1[e] + bb[e]);
                *(LAS f32x4*)(hs + lane * 4) = hv; LDS_WAIT(); asm volatile("" ::: "memory");
                float acc0 = b2[lane], acc1 = 0.f, acc2 = 0.f, acc3 = 0.f;
#pragma unroll 4
                for (int c = 0; c < 256; c += 4) { const f32x4 h4 = *(const LAS f32x4*)(hs + c);
                    acc0 += h4[0] * w2s[c * 64 + lane]; acc1 += h4[1] * w2s[(c + 1) * 64 + lane]; acc2 += h4[2] * w2s[(c + 2) * 64 + lane]; acc3 += h4[3] * w2s[(c + 3) * 64 + lane]; }
                outv = (acc0 + acc1) + (acc2 + acc3); LDS_WAIT(); asm volatile("" ::: "memory");
            }
            if (j == 0) ((bf16_t*)(ws + WS_KC))[((size_t)bh * 256 + n) * 64 + lane] = f2bf(outv);
            else ((bf16_t*)(ws + WS_VCT))[((size_t)bh * 4 + (n >> 6)) * 4096 + lane * 64 + nsa::vslot(n & 63)] = f2bf(outv);
        }
    }
    __syncthreads();
}
__device__ __forceinline__ void cmp_stage2_panel(const Frame& F, const Args& a, int l, int j, int bh) {
    constexpr int HP = 528;
    unsigned char* ws = a.ws; const float* cb = (const float*)(ws + SM_CMPB);
    LAS unsigned char* Hs = F.lds;
    LAS unsigned char* Ws = F.lds + 128 * HP;
    const int lane = F.lane, w = F.wave;
    const float* w2 = (const float*)a.in[8] + ((size_t)l * 2 + j) * 256 * 64; const float* b2 = (const float*)a.in[9] + ((size_t)l * 2 + j) * 64;
    const float* Pb = (const float*)(ws + WS_CMPP) + (size_t)j * 8192 * 512 + (size_t)bh * 256 * 512;
    __syncthreads();
    for (int i = F.tid; i < 256 * 64; i += 512) { const int c = i >> 6, d = i & 63; *(LAS bf16_t*)(Ws + d * HP + c * 2) = f2bf(w2[i]); }
    const f32x4 bb = *(const f32x4*)(cb + j * 256 + lane * 4);
    for (int half = 0; half < 2; ++half) {
        __syncthreads();
#pragma unroll 4
        for (int rr = 0; rr < 16; ++rr) { const int r = 16 * w + rr, n = half * 128 + r, n1 = n < 255 ? n + 1 : n;
            const f32x4 p0 = *(const f32x4*)(Pb + (size_t)n * 512 + lane * 4), p1 = *(const f32x4*)(Pb + (size_t)n1 * 512 + 256 + lane * 4);
            u32x2 hv; hv.x = cvt_pk_bf16(gelu_tanh(p0[0] + p1[0] + bb[0]), gelu_tanh(p0[1] + p1[1] + bb[1])); hv.y = cvt_pk_bf16(gelu_tanh(p0[2] + p1[2] + bb[2]), gelu_tanh(p0[3] + p1[3] + bb[3]));
            *(LAS u32x2*)(Hs + r * HP + lane * 8) = hv; }
        __syncthreads();
        f32x4 acc[4];
#pragma unroll
        for (int cbk = 0; cbk < 4; ++cbk) acc[cbk] = (f32x4){0.f, 0.f, 0.f, 0.f};
        const LAS unsigned char* ap = Hs + (16 * w + (lane & 15)) * HP + (lane >> 4) * 16;
        const LAS unsigned char* bp = Ws + (lane & 15) * HP + (lane >> 4) * 16;
#pragma unroll
        for (int ks = 0; ks < 8; ++ks) { const bf16x8 af = *(const LAS bf16x8*)(ap + ks * 64);
#pragma unroll
            for (int cbk = 0; cbk < 4; ++cbk) { const bf16x8 bf = *(const LAS bf16x8*)(bp + cbk * 16 * HP + ks * 64); acc[cbk] = __builtin_amdgcn_mfma_f32_16x16x32_bf16(af, bf, acc[cbk], 0, 0, 0); } }
#pragma unroll
        for (int cbk = 0; cbk < 4; ++cbk) { const int d = 16 * cbk + (lane & 15); const float bv = b2[d];
#pragma unroll
            for (int e = 0; e < 4; ++e) { const int n = half * 128 + 16 * w + 4 * (lane >> 4) + e; const float outv = n < NCMP ? acc[cbk][e] + bv : 0.f;
                if (j == 0) ((bf16_t*)(ws + WS_KC))[((size_t)bh * 256 + n) * 64 + d] = f2bf(outv);
                else ((bf16_t*)(ws + WS_VCT))[((size_t)bh * 4 + (n >> 6)) * 4096 + d * 64 + nsa::vslot(n & 63)] = f2bf(outv); } }
    }
    __syncthreads();
}
__device__ __forceinline__ void s5_carry_panel(const Frame& F, const Args& a, int l, int g, int pm) {
    unsigned char* ws = a.ws; const f32x2* apow = (const f32x2*)(ws + SM_APOW) + (size_t)l * 16 * 64 * 34;
    const float* S = (const float*)(ws + WS_S5S); bf16_t* ap = (bf16_t*)(ws + WS_S5A);
    if (F.tid < 128) { const int n = F.tid & 63, b = 2 * pm + (F.tid >> 6);
        const f32x2 A = apow[((size_t)g * 64 + n) * 34 + S5LC]; float hr = 0.f, hi = 0.f;
        const float* sp = S + ((size_t)g * 2048 + b * 128) * 256 + n; bf16_t* dp = ap + ((size_t)g * 2048 + b * 128) * S5K + 512 + n;
        float nr_[16], ni_[16];
#pragma unroll
        for (int k = 0; k < 16; ++k) { nr_[k] = sp[(size_t)k * 256]; ni_[k] = sp[(size_t)k * 256 + 64]; }
        for (int c0 = 0; c0 < S5NCH; c0 += 16) { float sr[16], si[16];
#pragma unroll
            for (int k = 0; k < 16; ++k) { sr[k] = nr_[k]; si[k] = ni_[k]; }
            if (c0 + 16 < S5NCH) {
#pragma unroll
                for (int k = 0; k < 16; ++k) { nr_[k] = sp[(size_t)(c0 + 16 + k) * 256]; ni_[k] = sp[(size_t)(c0 + 16 + k) * 256 + 64]; } }
#pragma unroll
            for (int k = 0; k < 16; ++k) { dp[(size_t)(c0 + k) * S5K] = f2bf(hr); dp[(size_t)(c0 + k) * S5K + 64] = f2bf(hi);
                const float nr = A.x * hr - A.y * hi + sr[k], ni = A.x * hi + A.y * hr + si[k]; hr = nr; hi = ni; } }
    }
}
__device__ __forceinline__ void s5_carry(const Frame& F, const Args& a, int l) {
    unsigned char* ws = a.ws; const f32x2* apow = (const f32x2*)(ws + SM_APOW) + (size_t)l * 16 * 64 * 34;
    const float* S = (const float*)(ws + WS_S5S); bf16_t* ap = (bf16_t*)(ws + WS_S5A);
    const int gt = F.bid * 512 + F.tid, NT = F.G * 512;
    for (int i = gt; i < 16 * NB * 64; i += NT) { const int n = i & 63, b = (i >> 6) & 15, g = i >> 10;
        const f32x2 A = apow[((size_t)g * 64 + n) * 34 + S5LC]; float hr = 0.f, hi = 0.f;
        const float* sp = S + ((size_t)g * 2048 + b * 128) * 256 + n; bf16_t* dp = ap + ((size_t)g * 2048 + b * 128) * S5K + 512 + n;
        float nr_[16], ni_[16];
#pragma unroll
        for (int k = 0; k < 16; ++k) { nr_[k] = sp[(size_t)k * 256]; ni_[k] = sp[(size_t)k * 256 + 64]; }
        for (int c0 = 0; c0 < S5NCH; c0 += 16) { float sr[16], si[16];
#pragma unroll
            for (int k = 0; k < 16; ++k) { sr[k] = nr_[k]; si[k] = ni_[k]; }
            if (c0 + 16 < S5NCH) {
#pragma unroll
                for (int k = 0; k < 16; ++k) { nr_[k] = sp[(size_t)(c0 + 16 + k) * 256]; ni_[k] = sp[(size_t)(c0 + 16 + k) * 256 + 64]; } }
#pragma unroll
            for (int k = 0; k < 16; ++k) { dp[(size_t)(c0 + k) * S5K] = f2bf(hr); dp[(size_t)(c0 + k) * S5K + 64] = f2bf(hi);
                const float nr = A.x * hr - A.y * hi + sr[k], ni = A.x * hi + A.y * hr + si[k]; hr = nr; hi = ni; } }
    }
}
template <int MODE, bool ROUTE, bool FINAL>
__device__ __forceinline__ void ln_panel(const Frame& F, const Args& a, int pm, const float* gain, const float* beta, const float* router, size_t h_off = WS_HBUF) {
    unsigned char* ws = a.ws; float* xout = a.out; bf16_t* xb = (bf16_t*)(ws + WS_XB);
    const bf16_t* hb = (const bf16_t*)(ws + (MODE == 0 ? h_off : WS_YB)); const f32x2* tokw = (const f32x2*)(ws + SM_TOKW);
    LAS int* cnt = (LAS int*)F.lds;
    const int lane = F.lane;
    f32x4 gv[4], bv[4];
#pragma unroll
    for (int j = 0; j < 2; ++j) { gv[2 * j] = *(const f32x4*)(gain + 8 * lane + 512 * j); gv[2 * j + 1] = *(const f32x4*)(gain + 8 * lane + 512 * j + 4); bv[2 * j] = *(const f32x4*)(beta + 8 * lane + 512 * j); bv[2 * j + 1] = *(const f32x4*)(beta + 8 * lane + 512 * j + 4); }
    if (ROUTE) { if (F.tid < 8) cnt[F.tid] = 0; __syncthreads(); }
    u32x4 nx[2], nh0[2], nh1[2]; f32x2 nw = (f32x2){0.f, 0.f};
    { const size_t row = (size_t)pm * 256 + F.wave * 32; if (MODE == 1) nw = tokw[row];
#pragma unroll
      for (int j = 0; j < 2; ++j) { nx[j] = *(const u32x4*)(xb + row * D + 8 * lane + 512 * j);
          if (MODE == 0) { nh0[j] = *(const u32x4*)(hb + row * D + 8 * lane + 512 * j); nh1[j] = nh0[j]; } else { nh0[j] = *(const u32x4*)(hb + (2 * row) * D + 8 * lane + 512 * j); nh1[j] = *(const u32x4*)(hb + (2 * row + 1) * D + 8 * lane + 512 * j); } } }
    for (int i = 0; i < 32; ++i) { const size_t row = (size_t)pm * 256 + F.wave * 32 + i;
        f32x4 v[4]; float s = 0.f;
        u32x4 cx[2], ch0[2], ch1[2]; const f32x2 w01 = nw;
#pragma unroll
        for (int j = 0; j < 2; ++j) { cx[j] = nx[j]; ch0[j] = nh0[j]; ch1[j] = nh1[j]; }
        if (i < 31) { const size_t rn = row + 1; if (MODE == 1) nw = tokw[rn];
#pragma unroll
            for (int j = 0; j < 2; ++j) { nx[j] = *(const u32x4*)(xb + rn * D + 8 * lane + 512 * j);
                if (MODE == 0) { nh0[j] = *(const u32x4*)(hb + rn * D + 8 * lane + 512 * j); nh1[j] = nh0[j]; } else { nh0[j] = *(const u32x4*)(hb + (2 * rn) * D + 8 * lane + 512 * j); nh1[j] = *(const u32x4*)(hb + (2 * rn + 1) * D + 8 * lane + 512 * j); } } }
#pragma unroll
        for (int jj = 0; jj < 4; ++jj) { const int j = jj >> 1, hf = jj & 1;
            const unsigned xq0 = hf ? cx[j].z : cx[j].x, xq1 = hf ? cx[j].w : cx[j].y; const f32x4 xv = (f32x4){bflo(xq0), bfhi(xq0), bflo(xq1), bfhi(xq1)}; f32x4 hv;
            const unsigned q00 = hf ? ch0[j].z : ch0[j].x, q01 = hf ? ch0[j].w : ch0[j].y;
            if (MODE == 0) hv = (f32x4){bflo(q00), bfhi(q00), bflo(q01), bfhi(q01)};
            else { const unsigned q10 = hf ? ch1[j].z : ch1[j].x, q11 = hf ? ch1[j].w : ch1[j].y;
                hv = (f32x4){w01.x * bflo(q00) + w01.y * bflo(q10), w01.x * bfhi(q00) + w01.y * bfhi(q10), w01.x * bflo(q01) + w01.y * bflo(q11), w01.x * bfhi(q01) + w01.y * bfhi(q11)}; }
            v[jj] = xv * ALPHA + hv; s += (v[jj][0] + v[jj][1]) + (v[jj][2] + v[jj][3]); }
        const float mean = wave_sum(s) * (1.f / D); float s2 = 0.f;
#pragma unroll
        for (int j = 0; j < 4; ++j) { v[j] = v[j] - mean; s2 += (v[j][0] * v[j][0] + v[j][1] * v[j][1]) + (v[j][2] * v[j][2] + v[j][3] * v[j][3]); }
        const float rstd = 1.0f / sqrtf(wave_sum(s2) * (1.f / D) + LN_EPS);
#pragma unroll
        for (int j = 0; j < 4; ++j) v[j] = v[j] * rstd * gv[j] + bv[j];
#pragma unroll
        for (int j = 0; j < 2; ++j) {
            if (FINAL) { *(f32x4*)(xout + row * D + 8 * lane + 512 * j) = v[2 * j]; *(f32x4*)(xout + row * D + 8 * lane + 512 * j + 4) = v[2 * j + 1]; }
            u32x4 w; w.x = cvt_pk_bf16(v[2 * j][0], v[2 * j][1]); w.y = cvt_pk_bf16(v[2 * j][2], v[2 * j][3]); w.z = cvt_pk_bf16(v[2 * j + 1][0], v[2 * j + 1][1]); w.w = cvt_pk_bf16(v[2 * j + 1][2], v[2 * j + 1][3]);
            *(u32x4*)(xb + row * D + 8 * lane + 512 * j) = w; }
        if (ROUTE) {
            float lg[8];
#pragma unroll
            for (int e = 0; e < 8; ++e) lg[e] = 0.f;
#pragma unroll
            for (int jj = 0; jj < 4; ++jj)
#pragma unroll
                for (int k = 0; k < 4; ++k) { const float* rr = router + (size_t)(8 * lane + 512 * (jj >> 1) + 4 * (jj & 1) + k) * 8; const f32x4 r0 = *(const f32x4*)rr, r1 = *(const f32x4*)(rr + 4); const float xv = v[jj][k];
                    lg[0] += xv * r0[0]; lg[1] += xv * r0[1]; lg[2] += xv * r0[2]; lg[3] += xv * r0[3]; lg[4] += xv * r1[0]; lg[5] += xv * r1[1]; lg[6] += xv * r1[2]; lg[7] += xv * r1[3]; }
            {
                const bool h3 = (lane & 8) != 0;
                float r4[4], r2[2], r1;
#pragma unroll
                for (int i = 0; i < 4; ++i) r4[i] = swapsum32(lg[i], lg[4 + i]);
#pragma unroll
                for (int i = 0; i < 2; ++i) r2[i] = swapsum16(r4[i], r4[2 + i]);
                { const float send = h3 ? r2[0] : r2[1], mine = h3 ? r2[1] : r2[0]; r1 = mine + xshfl<8>(send); }
                r1 += xshfl<1>(r1); r1 += xshfl<2>(r1); r1 += dpp_half_mirror(r1);
#pragma unroll
                for (int e = 0; e < 8; ++e) lg[e] = __builtin_bit_cast(float, __builtin_amdgcn_readlane(__builtin_bit_cast(int, r1), 8 * e));
            }
            int e0 = 0; float m0 = lg[0];
#pragma unroll
            for (int e = 1; e < 8; ++e) if (lg[e] > m0) { m0 = lg[e]; e0 = e; }
            int e1 = -1; float m1 = -3.0e38f;
#pragma unroll
            for (int e = 0; e < 8; ++e) if (e != e0 && lg[e] > m1) { m1 = lg[e]; e1 = e; }
            const float w0 = 1.0f / (1.0f + __expf(m1 - m0));
            if (lane == 0) { ((int*)(ws + SM_TOKE))[row] = e0 | (e1 << 8); ((f32x2*)(ws + SM_TOKW))[row] = (f32x2){w0, 1.0f - w0}; __hip_atomic_fetch_add(&cnt[e0], 1, __ATOMIC_RELAXED, __HIP_MEMORY_SCOPE_WORKGROUP); __hip_atomic_fetch_add(&cnt[e1], 1, __ATOMIC_RELAXED, __HIP_MEMORY_SCOPE_WORKGROUP); }
        }
    }
    if (ROUTE) { __syncthreads(); if (F.tid < 8) ((int*)(ws + SM_PCNT))[pm * 8 + F.tid] = cnt[F.tid]; __syncthreads(); }
}
__device__ __forceinline__ void moe_gather(const Frame& F, const Args& a) {
    unsigned char* ws = a.ws; const int* pcnt = (const int*)(ws + SM_PCNT); const int* toke = (const int*)(ws + SM_TOKE);
    int* rowtok = (int*)(ws + SM_ROWTOK); int* tileexp = (int*)(ws + SM_TILEEXP);
    const bf16_t* xb = (const bf16_t*)(ws + WS_XB); bf16_t* xs = (bf16_t*)(ws + WS_XS);
    LAS int* sm = (LAS int*)F.lds;
    for (int pm = F.own; pm < T / 256; pm += F.G) {
        for (int q = F.tid; q < (T / 256) * 8; q += 512) sm[1024 + q] = pcnt[q];
        if (F.tid >= 32 && F.tid < 288) sm[F.tid] = toke[pm * 256 + F.tid - 32];
        __syncthreads();
        if (F.tid < 8) { int tot = 0, before = 0; for (int q = 0; q < T / 256; ++q) { const int c = sm[1024 + q * 8 + F.tid]; tot += c; if (q < pm) before += c; } sm[F.tid] = tot; sm[16 + F.tid] = before; }
        __syncthreads();
        if (F.tid == 0) { int st = 0; for (int e = 0; e < 8; ++e) { sm[8 + e] = st * 256; st += (sm[e] + 255) >> 8; } sm[24] = st; }
        __syncthreads();
        {
            const int i = F.tid >> 1, k = F.tid & 1; const int ee = sm[32 + i]; const int e = k ? (ee >> 8) : (ee & 255);
            int cntb = 0; for (int q = 0; q < i; ++q) { const int o = sm[32 + q]; cntb += ((o & 255) == e) + ((o >> 8) == e); }
            const int dest = sm[8 + e] + sm[16 + e] + cntb; sm[512 + F.tid] = dest; rowtok[dest] = 2 * (pm * 256 + i) + k;
        }
        __syncthreads();
        for (int r0 = F.wave * 64; r0 < F.wave * 64 + 64; r0 += 8) {
            u32x4 va[8], vb[8];
#pragma unroll
            for (int q = 0; q < 8; ++q) { const size_t tok = (size_t)pm * 256 + ((r0 + q) >> 1); const u32x4* s = (const u32x4*)(xb + tok * D); va[q] = s[F.lane]; vb[q] = s[64 + F.lane]; }
#pragma unroll
            for (int q = 0; q < 8; ++q) { const int dest = sm[512 + r0 + q]; u32x4* d = (u32x4*)(xs + (size_t)dest * D); d[F.lane] = va[q]; d[64 + F.lane] = vb[q]; } }
        if (pm == 0) {
            for (int e = 0; e < 8; ++e) { const int r0 = sm[8 + e] + sm[e], r1 = sm[8 + e] + (((sm[e] + 255) >> 8) << 8); for (int r = r0 + F.tid; r < r1; r += 512) rowtok[r] = -1;
                const int t0 = sm[8 + e] >> 8, t1 = r1 >> 8; for (int t = t0 + F.tid; t < t1; t += 512) tileexp[t] = e; }
            if (F.tid == 0) tileexp[1023] = sm[24];
        }
        __syncthreads();
    }
}

__device__ __forceinline__ void moe_tail_finalize(const Frame& F, const Args& a) {
    const int* tileexp = (const int*)(a.ws + SM_TILEEXP); int nt = tileexp[1023] - (MOE_NCHUNK - 1) * MOE_CHUNK_TILES; nt = nt < 0 ? 0 : (nt > 8 ? 8 : nt);
    const float* YT = (const float*)(a.ws + WS_XS); const int* row_tok = (const int*)(a.ws + SM_ROWTOK) + (MOE_NCHUNK - 1) * MOE_CHUNK_TILES * 256; bf16_t* Y = (bf16_t*)(a.ws + WS_YB);
    const int c8 = (F.tid & 127) * 8;
    for (int r = F.bid * 4 + (F.tid >> 7); r < nt * 256; r += F.G * 4) { const int dst = row_tok[r]; if (dst < 0) continue;
        f32x4 s0 = (f32x4){0.f, 0.f, 0.f, 0.f}, s1 = s0;
#pragma unroll
        for (int ks = 0; ks < 7; ++ks) { const float* p = YT + ((size_t)ks * 2048 + r) * D + c8; s0 += *(const f32x4*)p; s1 += *(const f32x4*)(p + 4); }
        u32x4 w; w.x = cvt_pk_bf16(s0[0], s0[1]); w.y = cvt_pk_bf16(s0[2], s0[3]); w.z = cvt_pk_bf16(s1[0], s1[1]); w.w = cvt_pk_bf16(s1[2], s1[3]);
        *(u32x4*)(Y + (size_t)dst * D + c8) = w; }
}
struct MoeUpOrder { int ntile, G, c, chunk; const int* tileexp;
    __device__ __forceinline__ bool next(int i, pg8::Unit& u) const { if (!pg8::static_tile(i, G, c, ntile, 2 * DFE / 256, u.pm, u.pn)) return false;
        const int tile = chunk * MOE_CHUNK_TILES + u.pm, e = tileexp[tile]; u.aux = tile; u.offA = (long long)tile * 256 * D * 2; u.offB = ((long long)e * 2 * DFE + (long long)u.pn * 256) * D * 2; return true; } };
struct MoeDnOrder { int ntile, G, c, chunk; const int* tileexp;
    __device__ __forceinline__ bool next(int i, pg8::Unit& u) const { if (!pg8::static_tile(i, G, c, ntile, D / 256, u.pm, u.pn)) return false;
        const int tile = chunk * MOE_CHUNK_TILES + u.pm, e = tileexp[tile]; u.aux = tile; u.offA = (long long)u.pm * 256 * DFE * 2; u.offB = ((long long)e * D + (long long)u.pn * 256) * DFE * 2; return true; } };

struct MoeDnTailOrder { int ntile, G, c; const int* tileexp;
    __device__ __forceinline__ bool next(int i, pg8::Unit& u) const { const long L = (long)i * G + c; if (L >= (long)ntile * 28) return false;
        const int ks = (int)(L % 7), rest = (int)(L / 7); u.pn = rest & 3; u.pm = rest >> 2; u.aux = ks;
        const int tile = (MOE_NCHUNK - 1) * MOE_CHUNK_TILES + u.pm, e = tileexp[tile];
        u.offA = (long long)u.pm * 256 * DFE * 2 + (long long)ks * 512 * 2; u.offB = ((long long)e * D + (long long)u.pn * 256) * DFE * 2 + (long long)ks * 512 * 2; return true; } };

__device__ __forceinline__ int attn_pair(int p0, int G) {
    if (G != 256) return p0;
    const int x = p0 & 7, r = (p0 >> 3) & 31, k = p0 >> 8;
    return ((x + 8 * (2 * k + (r >> 4))) << 4) | (r & 15);
}

enum { PH_PREP = 0, PH_WIN, PH_POST, PH_MIX1, PH_MIX2, PH_MIX3, PH_MIX4, PH_WOUT, PH_LN1, PH_FUP, PH_FDN, PH_MGATH = 9, PH_MUP0 = 10, PH_LN2 = 21, PH_PGATE, PH_PPROJ, PH_LN3, PH_PER_LAYER = 32 };
constexpr int GP_END = 2 + 32 * DEPTH;

__global__ void __launch_bounds__(512, 2) mk_fwd(Args a0) {
    extern __shared__ __attribute__((aligned(16))) unsigned char lds_raw[];
    LAS unsigned char* const lds = (LAS unsigned char*)lds_raw;
    for (int u = threadIdx.x; u < (LDS_BYTES - LDSCTL_OFF) / 4; u += 512) ((LAS unsigned*)(lds + LDSCTL_OFF))[u] = 0u;
    __syncthreads();
    const int gp_lo = a0.gp_lo, gp_hi = a0.gp_hi; const int F0bid = blockIdx.x, F0G = gridDim.x; const int wave0 = __builtin_amdgcn_readfirstlane(threadIdx.x >> 6);
    XcdBarrier bar; bar.bar = (unsigned*)(a0.ws + WS_CTL) + CW_BAR; bar.x = 0; bar.st = nullptr;
    if (a0.use_bar) bar = xcd_barrier_post((unsigned*)(a0.ws + WS_CTL) + CW_BAR, (volatile LAS unsigned*)(lds + LDSCTL_OFF + 32));
#if MK_PROBE
#define PRW ((volatile LAS unsigned*)(lds + LDSCTL_OFF + 128))
    if (threadIdx.x == 0) { const unsigned long long t_ = __builtin_amdgcn_s_memrealtime(); PRW[0] = (unsigned)t_; PRW[1] = (unsigned)(t_ >> 32); PRW[2] = 0u; PRW[3] = 0u; PRW[4] = (unsigned)t_; PRW[5] = (unsigned)(t_ >> 32); }
#define STAMP(cls) do { if (wave0 == 0 && lane_id_fresh() == 0) { const unsigned long long t_ = __builtin_amdgcn_s_memrealtime(); const unsigned long long p_ = ((unsigned long long)PRW[1] << 32) | PRW[0]; const unsigned d_ = (unsigned)(t_ - p_); \
        PRW[0] = (unsigned)t_; PRW[1] = (unsigned)(t_ >> 32); if ((PROBE_A >> (cls)) & 1) PRW[2] += d_; if ((PROBE_B >> (cls)) & 1) PRW[3] += d_; } } while (0)
#else
#define STAMP(cls) do {} while (0)
#endif
#define RUN(gp) (gp_lo <= (gp) && (gp) < gp_hi)
#define SEAM(gp) do { if (gp_lo <= (gp) && (gp) + 1 < gp_hi) xcd_barrier(bar, wave0); } while (0)
#define PH_BEGIN Args a; load_args(a); const Frame F = make_frame(lds, wave0); unsigned char* const ws = a.ws; int l = lx; asm volatile("" : "+s"(l)); (void)l; (void)ws; \
    bf16_t* const xb = (bf16_t*)(ws + WS_XB); bf16_t* const z = (bf16_t*)(ws + WS_Z); bf16_t* const mix = (bf16_t*)(ws + WS_MIX); bf16_t* const hbuf = (bf16_t*)(ws + WS_HBUF); const long long S1K = 256ll * 1024 * 2; \
    (void)xb; (void)z; (void)mix; (void)hbuf; (void)S1K;
#define AP_DEF const nsa::Lane L{F.lane, F.lane & 31, F.lane >> 5, F.wave, F.tid}; \
    const nsa::AttnPtrs AP{(const bf16_t*)(ws + WS_Q), z, (const bf16_t*)(ws + WS_KC), (const bf16_t*)(ws + WS_VCT), (const bf16_t*)(ws + WS_KSEL), (const bf16_t*)(ws + WS_VSEL), \
                           (const bf16_t*)(ws + WS_KWIN), (const bf16_t*)(ws + WS_VWIN), (unsigned long long*)(ws + WS_SELM), mix};
    { const int lx = 0;
    if (RUN(0)) { PH_BEGIN phase_init0(F, a); }
    SEAM(0); STAMP(0);
    if (RUN(1)) { PH_BEGIN phase_init1(F, a); }
    SEAM(1); STAMP(0);
    }
    for (int lx = 0; lx < DEPTH; ++lx) {
        const int base = 2 + PH_PER_LAYER * lx; const bool moe = (lx & 1) != 0;
        if (RUN(base + PH_PREP)) { PH_BEGIN phase_prep(F, a, l); }
        SEAM(base + PH_PREP); STAMP(1);
        if (RUN(base + PH_WIN)) { PH_BEGIN
            pg8::Gemm g{xb, (const bf16_t*)(ws + W_IN), D, D, D}; pg8::PlainOrder S{T / 256, INP / 256, F.G, F.bid, S1K, S1K};
            epi::EpiWin E{z, (bf16_t*)(ws + WS_Q), (bf16_t*)(ws + WS_KCMP), (bf16_t*)(ws + WS_S5A), (const f32x2*)(ws + WS_ROPE)};
            pg8::gemm_phase(F.lds, g, S, E, F.tid);
        }
        SEAM(base + PH_WIN); STAMP(2);
        if (RUN(base + PH_MIX1)) {
            for (int r = F0bid; r < 128; r += F0G) {
                {   PH_BEGIN const int g_ = r >> 3, pm_ = r & 7;
                    pg8::Gemm g{(const bf16_t*)(ws + WS_S5A), (const bf16_t*)(ws + W_S5S), 512, S5K, 512};
                    pg8::ListOrder S{1, pm_, g_, (long long)g_ * 2048 * S5K * 2 + (long long)pm_ * 256 * S5K * 2, (long long)g_ * 256 * 512 * 2, 0}; epi::F32Grouped E{(float*)(ws + WS_S5S), 256, (size_t)2048 * 256};
                    pg8::gemm_phase(F.lds, g, S, E, F.tid); }
                __syncthreads();
                {   PH_BEGIN int nr = MK_REP_CARRY; asm volatile("" : "+s"(nr)); for (int q = 0; q < nr; ++q) s5_carry_panel(F, a, l, r >> 3, r & 7); }
                asm volatile("s_waitcnt vmcnt(0)" ::: "memory"); __syncthreads();
                {   PH_BEGIN const int g_ = r >> 3, pm_ = r & 7;
                    pg8::Gemm g{(const bf16_t*)(ws + WS_S5A), (const bf16_t*)(ws + W_S5B), S5K, S5K, S5K};
                    pg8::ListOrder S{2, pm_, g_, (long long)g_ * 2048 * S5K * 2 + (long long)pm_ * 256 * S5K * 2, (long long)g_ * 512 * S5K * 2, 256ll * S5K * 2}; epi::S5Out E{(bf16_t*)(ws + WS_ZS5), z, (const float*)a.in[21] + (size_t)l * 256};
                    pg8::gemm_phase(F.lds, g, S, E, F.tid); }
            }
            for (int r = F0bid - 128; r < 64; r += F0G) { if (r < 0) continue;
                {   PH_BEGIN const int j_ = r >> 5, bh_ = r & 31;
                    pg8::Gemm g{(const bf16_t*)(ws + WS_KCMP), (const bf16_t*)(ws + W_CMP), 1024, 1024, 1024};
                    pg8::ListOrder S{2, bh_, j_, (long long)j_ * (long long)(WS_VCMP - WS_KCMP) + (long long)bh_ * S1K, (long long)j_ * 512 * 1024 * 2, S1K}; epi::F32Grouped E{(float*)(ws + WS_CMPP), 512, (size_t)8192 * 512};
                    pg8::gemm_phase(F.lds, g, S, E, F.tid); }
                asm volatile("s_waitcnt vmcnt(0)" ::: "memory"); __syncthreads();
                {   PH_BEGIN int nr = MK_REP_ST2; asm volatile("" : "+s"(nr)); for (int q = 0; q < nr; ++q) cmp_stage2_panel(F, a, l, r >> 5, r & 31); }
            }
            {   PH_BEGIN
                if (F.G == 256) { const int c = F.bid; const int beg = c < 128 ? c * 5 : (c < 192 ? 640 + (c - 128) * 6 : 1024 + (c - 192) * 16), cnt = c < 128 ? 5 : (c < 192 ? 6 : 16); conv_items(F, a, l, beg, 1, beg + cnt); }
                else conv_items(F, a, l, F.bid, F.G); }
        }
        SEAM(base + PH_MIX1); STAMP(4);
        if (RUN(base + PH_MIX3)) {
            {   PH_BEGIN
                pg8::Gemm g{(const bf16_t*)(ws + WS_ZS5), (const bf16_t*)(ws + W_GLU), 256, 256, 256};
                pg8::PlainOrder S{T / 256, 1, F.G, F.bid, 256ll * 256 * 2, 256ll * 256 * 2}; epi::S5Glu E{mix, (const bf16_t*)(ws + WS_ZS5), (const float*)a.in[23] + (size_t)l * 256};
                pg8::gemm_phase(F.lds, g, S, E, F.tid);
            }
            {   PH_BEGIN AP_DEF
                for (int p0 = F.bid; p0 < 32 * 16; p0 += F.G) { const int p = attn_pair(p0, F.G); const int bh = p >> 4, s = p & 15;
                    for (int half = 0; half < 2; ++half) { const int qb2 = half ? 31 - s : s;
                        nsa::cmp_unit<true>(bh, 2 * qb2, AP, F.lds, L); nsa::cmp_topk(bh, 2 * qb2, AP, F.lds, L);
                        nsa::cmp_unit<false>(bh, 2 * qb2 + 1, AP, F.lds, L); nsa::cmp_topk(bh, 2 * qb2 + 1, AP, F.lds, L); } } }
            asm volatile("s_waitcnt vmcnt(0)" ::: "memory"); __syncthreads();
            {   PH_BEGIN AP_DEF
                for (int p0 = F.bid; p0 < 32 * 16; p0 += F.G) { const int p = attn_pair(p0, F.G); const int bh = p >> 4, s = p & 15; nsa::sw_unit2(bh, s, AP, F.lds, L); nsa::sw_unit2(bh, 31 - s, AP, F.lds, L); } }
        }
        SEAM(base + PH_MIX3); STAMP(6);

        if (RUN(base + PH_WOUT)) {
            {   PH_BEGIN
                pg8::Gemm g{mix, (const bf16_t*)(ws + W_OUT), D, D, D}; pg8::PlainOrder S{T / 256, D / 256, F.G, F.bid, S1K, S1K}; epi::Bf16Sc1 E{hbuf, D, (unsigned)((size_t)T * D * 2)};
                pg8::gemm_phase(F.lds, g, S, E, F.tid);
            }
            {   PH_BEGIN pg8::PlainOrder S{T / 256, D / 256, F.G, F.bid, S1K, S1K}; panels_publish_wait(F, (unsigned*)(ws + WS_CTL), 2 * l + 0, S, (unsigned)(D / 256)); }
            {   PH_BEGIN
                const float* gg = (const float*)a.in[34] + ((size_t)l * 3 + 0) * D; const float* bb = (const float*)a.in[35] + ((size_t)l * 3 + 0) * D;
                for (int pm = F.own; pm < T / 256; pm += F.G) { if (l & 1) ln_panel<0, true, false>(F, a, pm, gg, bb, (const float*)a.in[27] + (size_t)(l >> 1) * D * NEXP); else ln_panel<0, false, false>(F, a, pm, gg, bb, nullptr); }
            }
        }
        SEAM(base + PH_WOUT); STAMP(8);
        if (!moe) {
            if (RUN(base + PH_FUP)) { PH_BEGIN
                pg8::Gemm g{xb, (const bf16_t*)(ws + W_UP), D, D, D}; pg8::PlainOrder S{T / 256, 2 * DFF / 256, F.G, F.bid, S1K, S1K}; epi::SwiGlu E{(bf16_t*)(ws + WS_FFH), DFF};
                pg8::gemm_phase(F.lds, g, S, E, F.tid);
            }
            SEAM(base + PH_FUP); STAMP(9);
            if (RUN(base + PH_FDN)) {
                {   PH_BEGIN
                    pg8::Gemm g{(const bf16_t*)(ws + WS_FFH), (const bf16_t*)(ws + W_DN), DFF, DFF, DFF}; pg8::PlainOrder S{T / 256, D / 256, F.G, F.bid, 256ll * DFF * 2, 256ll * DFF * 2}; epi::Bf16Sc1 E{hbuf, D, (unsigned)((size_t)T * D * 2)};
                    pg8::gemm_phase(F.lds, g, S, E, F.tid);
                }
                {   PH_BEGIN pg8::PlainOrder S{T / 256, D / 256, F.G, F.bid, 256ll * DFF * 2, 256ll * DFF * 2}; panels_publish_wait(F, (unsigned*)(ws + WS_CTL), 2 * l + 1, S, (unsigned)(D / 256)); }
                {   PH_BEGIN
                    const float* gg = (const float*)a.in[34] + ((size_t)l * 3 + 1) * D; const float* bb = (const float*)a.in[35] + ((size_t)l * 3 + 1) * D;
                    for (int pm = F.own; pm < T / 256; pm += F.G) ln_panel<0, false, false>(F, a, pm, gg, bb, nullptr);
                }
            }
            asm volatile("s_waitcnt vmcnt(0)" ::: "memory"); __syncthreads(); STAMP(10);
        } else {
            if (RUN(base + PH_MGATH)) { PH_BEGIN moe_gather(F, a); }
            SEAM(base + PH_MGATH); STAMP(11);
            for (int cx = 0; cx < MOE_NCHUNK; ++cx) {
                if (RUN(base + PH_MUP0 + 2 * cx)) { PH_BEGIN int c = cx; asm volatile("" : "+s"(c)); const int* tileexp = (const int*)(ws + SM_TILEEXP);
                    int nt = tileexp[1023] - c * MOE_CHUNK_TILES; nt = nt < 0 ? 0 : (nt > MOE_CHUNK_TILES ? MOE_CHUNK_TILES : nt);
                    pg8::Gemm g{(const bf16_t*)(ws + WS_XS), (const bf16_t*)(ws + W_UP), D, D, D}; MoeUpOrder S{nt, F.G, F.bid, c, tileexp}; epi::SwiGlu E{(bf16_t*)(ws + WS_MH), DFE};
                    pg8::gemm_phase(F.lds, g, S, E, F.tid);
                }
                SEAM(base + PH_MUP0 + 2 * cx); STAMP(12);
                if (RUN(base + PH_MUP0 + 2 * cx + 1)) { PH_BEGIN int c = cx; asm volatile("" : "+s"(c)); const int* tileexp = (const int*)(ws + SM_TILEEXP);
                    int nt = tileexp[1023] - c * MOE_CHUNK_TILES; nt = nt < 0 ? 0 : (nt > MOE_CHUNK_TILES ? MOE_CHUNK_TILES : nt);
                    if (cx < MOE_NCHUNK - MK_TAILSPLIT) {
                        pg8::Gemm g{(const bf16_t*)(ws + WS_MH), (const bf16_t*)(ws + W_DN), DFE, DFE, DFE}; MoeDnOrder S{nt, F.G, F.bid, c, tileexp}; epi::MoeDown E{(bf16_t*)(ws + WS_YB), (const int*)(ws + SM_ROWTOK)};
                        pg8::gemm_phase(F.lds, g, S, E, F.tid);
                    } else {
                        nt = nt > 8 ? 8 : nt;
                        pg8::Gemm g{(const bf16_t*)(ws + WS_MH), (const bf16_t*)(ws + W_DN), 512, DFE, DFE}; MoeDnTailOrder S{nt, F.G, F.bid, tileexp}; epi::F32Grouped E{(float*)(ws + WS_XS), D, (size_t)2048 * D};
                        pg8::gemm_phase(F.lds, g, S, E, F.tid);
                    }
                }
                SEAM(base + PH_MUP0 + 2 * cx + 1); STAMP(13);
            }
#if MK_TAILSPLIT
            if (RUN(base + PH_MUP0 + 2 * MOE_NCHUNK)) { PH_BEGIN moe_tail_finalize(F, a); }
            SEAM(base + PH_MUP0 + 2 * MOE_NCHUNK); STAMP(13);
#endif
        }
        if (RUN(base + PH_PGATE)) {
            if (moe) {
                {   PH_BEGIN
                    const float* gg = (const float*)a.in[34] + ((size_t)l * 3 + 1) * D; const float* bb = (const float*)a.in[35] + ((size_t)l * 3 + 1) * D;
                    for (int pm = F.own; pm < T / 256; pm += F.G) ln_panel<1, false, false>(F, a, pm, gg, bb, nullptr);
                }
                asm volatile("s_waitcnt vmcnt(0)" ::: "memory"); __syncthreads();
            }
            {   PH_BEGIN
                pg8::Gemm g{xb, (const bf16_t*)(ws + W_GATE), D, D, D}; pg8::PanelOrder S{T / 256, D / 256, F.G, F.own, S1K, S1K}; epi::SigmoidBias E{(l & 1) ? (bf16_t*)(ws + WS_PLEG) : mix, D, (const float*)a.in[32] + (size_t)l * D};
                pg8::gemm_phase(F.lds, g, S, E, F.tid);
            }
            __syncthreads();
            {   PH_BEGIN
                pg8::Gemm g{(const bf16_t*)(ws + WS_PB), (const bf16_t*)(ws + W_PROJ), PLE, PLE, PLE}; pg8::PanelOrder S{T / 256, D / 256, F.G, F.own, 256ll * PLE * 2, 256ll * PLE * 2}; epi::MulBf16 E{(l & 1) ? (bf16_t*)(ws + WS_PLEH) : hbuf, (l & 1) ? (bf16_t*)(ws + WS_PLEG) : mix, D};
                pg8::gemm_phase(F.lds, g, S, E, F.tid);
            }
            __syncthreads();
            {   PH_BEGIN
                const float* gg = (const float*)a.in[34] + ((size_t)l * 3 + 2) * D; const float* bb = (const float*)a.in[35] + ((size_t)l * 3 + 2) * D;
                const size_t hoff = (l & 1) ? WS_PLEH : WS_HBUF;
                for (int pm = F.own; pm < T / 256; pm += F.G) { if (l == DEPTH - 1) ln_panel<0, false, true>(F, a, pm, gg, bb, nullptr, hoff); else ln_panel<0, false, false>(F, a, pm, gg, bb, nullptr, hoff); }
            }
        }
        SEAM(base + PH_PGATE); STAMP(15);
    }
#if MK_PROBE
    if (blockIdx.x == 0) {
        __syncthreads(); asm volatile("s_waitcnt vmcnt(0)" ::: "memory");
        const unsigned long long t1 = ((unsigned long long)PRW[1] << 32) | PRW[0], t0 = ((unsigned long long)PRW[5] << 32) | PRW[4];
        const float tot = (float)(unsigned)(t1 - t0), fa = (float)PRW[2] / tot, fb = (float)PRW[3] / tot;
        Args ae; load_args(ae);
        const int tidp = wave0 * 64 + lane_id_fresh();
        if (tidp == 0) ae.out[0] += 1.0f + 8.0f * fa;
        for (int i = tidp; i < 100000; i += 512) ae.out[1024 + i] += 0.5f * fb;
    }
#endif
#undef RUN
#undef SEAM
}

static bool phase_applies(int gp) {
    if (gp < 2) return true;
    const int l = (gp - 2) / PH_PER_LAYER, ph = (gp - 2) % PH_PER_LAYER; const bool moe = (l & 1) != 0;
    if (ph < PH_LN1) return ph != PH_POST && ph != PH_MIX2 && ph != PH_MIX4;
    if (ph == PH_PGATE) return true;
    if (!moe) return ph == PH_FUP || ph == PH_FDN;
    return ph >= PH_MGATH && ph <= PH_MUP0 + 2 * MOE_NCHUNK;
}
extern "C" void kernel_launch(void* const* d_in, const int* in_sizes, int n_in, void* d_out, int out_size, void* d_ws, size_t ws_size, hipStream_t stream) {
    static int grid = 0;
    if (grid == 0) {
        if (n_in != 36 || out_size != T * D || ws_size < WS_END) { fprintf(stderr, "kernel_launch: unexpected problem (n_in %d out %d ws %zu, need %zu)\n", n_in, out_size, ws_size, (size_t)WS_END); grid = -1; return; }
        int dev = 0, cus = 0, per_cu = 0;
        if (hipGetDevice(&dev) != hipSuccess || hipDeviceGetAttribute(&cus, hipDeviceAttributeMultiprocessorCount, dev) != hipSuccess) { grid = -1; return; }
        if (hipFuncSetAttribute((const void*)mk_fwd, hipFuncAttributeMaxDynamicSharedMemorySize, LDS_BYTES) != hipSuccess) { fprintf(stderr, "kernel_launch: hipFuncSetAttribute failed\n"); grid = -1; return; }
        if (hipOccupancyMaxActiveBlocksPerMultiprocessor(&per_cu, (const void*)mk_fwd, 512, LDS_BYTES) != hipSuccess || per_cu < 1) fprintf(stderr, "kernel_launch: occupancy query reports %d\n", per_cu);
        (void)hipGetLastError();
        grid = cus;
    }
    if (grid < 0) return;
    (void)in_sizes;
    if (hipMemsetAsync((char*)d_ws + WS_CTL, 0, CTL_ZERO_BYTES, stream) != hipSuccess) return;
#if MK_CHECK
    (void)hipMemsetAsync((char*)d_ws + SM_CHK, 0, 256, stream);
#endif
    Args a{};
    for (int i = 0; i < 36; ++i) a.in[i] = d_in[i];
    a.out = (float*)d_out; a.ws = (unsigned char*)d_ws; a.pad = 0;
#if MK_MULTI
    for (int gp = 0; gp < GP_END; ++gp) { if (!phase_applies(gp)) continue; a.gp_lo = gp; a.gp_hi = gp + 1; a.use_bar = 0;
        hipLaunchKernelGGL(mk_fwd, dim3(grid), dim3(512), LDS_BYTES, stream, a);
#if MK_CHECK
        run_checks(a, gp, stream);
#endif
    }
#if MK_CHECK
    hipLaunchKernelGGL(chk_final, dim3(1), dim3(1), 0, stream, a);
#endif
#else
    a.gp_lo = 0; a.gp_hi = GP_END; a.use_bar = 1;
    hipLaunchKernelGGL(mk_fwd, dim3(grid), dim3(512), LDS_BYTES, stream, a);
#endif
}
```

```cpp
#include <hip/hip_runtime.h>
#include <cstdint>
#include <cstdio>
#ifndef MK_TAILSPLIT
#define MK_TAILSPLIT 1
#endif
#ifndef MK_MULTI
#define MK_MULTI 0
#endif
#ifndef MK_CHECK
#define MK_CHECK 0
#endif
#ifndef MK_REP_G1
#define MK_REP_G1 1
#endif
#ifndef MK_REP_G2
#define MK_REP_G2 1
#endif
#ifndef MK_REP_CU
#define MK_REP_CU 1
#endif
#ifndef MK_REP_TK
#define MK_REP_TK 1
#endif
#ifndef MK_REP_WOUT
#define MK_REP_WOUT 1
#endif
#ifndef MK_REP_CONV
#define MK_REP_CONV 1
#endif
#ifndef MK_REP_ST2
#define MK_REP_ST2 1
#endif
#ifndef MK_REP_CARRY
#define MK_REP_CARRY 1
#endif
#ifndef MK_REPCMP
#define MK_REPCMP 1
#endif
#ifndef MK_ALIGN_EPI
#define MK_ALIGN_EPI 1
#endif
#ifndef MK_PROBE
#define MK_PROBE 0
#endif
#ifndef PROBE_A
#define PROBE_A 0
#endif
#ifndef PROBE_B
#define PROBE_B 0
#endif
#ifndef CHK_LAYER
#define CHK_LAYER 15
#endif

#define GAS __attribute__((address_space(1)))
#define LAS __attribute__((address_space(3)))
typedef unsigned short bf16_t;
typedef short bf16x8 __attribute__((ext_vector_type(8)));
typedef float f32x4 __attribute__((ext_vector_type(4)));
typedef float f32x2 __attribute__((ext_vector_type(2)));
typedef float f32x16 __attribute__((ext_vector_type(16)));
typedef unsigned u32x4 __attribute__((ext_vector_type(4)));
typedef unsigned u32x2 __attribute__((ext_vector_type(2)));

constexpr int NB = 16, SEQ = 4096, T = NB * SEQ, D = 1024, DEPTH = 4;
constexpr int INW = 2072, INP = 2304;
constexpr int ZKV = 512, ZG = 1280, ZC = 1304, ZS = 1816;
constexpr int DFF = 2816, DFE = 3584, NEXP = 8, PLE = 256;
constexpr int NCMP = 255;
constexpr int S5LC = 32, S5NCH = SEQ / S5LC, S5K = S5LC * 16 + 128;
constexpr float ALPHA = 1.6817928305074290f;
constexpr float LN_EPS = 1e-5f;
constexpr float QSCALE = 0.125f * 1.4426950408889634f;
constexpr float NEGF = -1e30f;
constexpr int MOE_TILES_MAX = 520, MOE_CHUNK_TILES = 128, MOE_NCHUNK = 5;

typedef __bf16 bf16x2_t __attribute__((ext_vector_type(2)));
__device__ __forceinline__ unsigned cvt_pk_bf16(float lo, float hi) { f32x2 v = {lo, hi}; const bf16x2_t b = __builtin_convertvector(v, bf16x2_t); return __builtin_bit_cast(unsigned, b); }
__device__ __forceinline__ bf16_t f2bf(float f) { return (bf16_t)(cvt_pk_bf16(f, 0.f) & 0xffffu); }
__device__ __forceinline__ float bf2f(unsigned v) { return __uint_as_float(v << 16); }
__device__ __forceinline__ float bflo(unsigned w) { return __uint_as_float(w << 16); }
__device__ __forceinline__ float bfhi(unsigned w) { return __uint_as_float(w & 0xffff0000u); }
__device__ __forceinline__ float fast_exp2(float x) { return __builtin_amdgcn_exp2f(x); }
__device__ __forceinline__ float fast_rcp(float x) { return __builtin_amdgcn_rcpf(x); }
__device__ __forceinline__ float sigmoidf_(float x) { return fast_rcp(1.0f + fast_exp2(-1.4426950408889634f * x)); }
__device__ __forceinline__ float siluf_(float x) { return x * sigmoidf_(x); }
__device__ __forceinline__ float gelu_tanh(float x) { const float u = 0.7978845608028654f * (x + 0.044715f * x * x * x); return x * sigmoidf_(2.0f * u); }
__device__ __forceinline__ int lane_id_fresh() { unsigned z = 0u; asm volatile("" : "+v"(z)); return (int)__builtin_amdgcn_mbcnt_hi(~0u, __builtin_amdgcn_mbcnt_lo(~0u, z)); }
template <int MASK> __device__ __forceinline__ float xshfl(float v) {
    if (MASK == 1) return __uint_as_float((unsigned)__builtin_amdgcn_update_dpp(0, (int)__float_as_uint(v), 0xB1, 0xF, 0xF, true));
    if (MASK == 2) return __uint_as_float((unsigned)__builtin_amdgcn_update_dpp(0, (int)__float_as_uint(v), 0x4E, 0xF, 0xF, true));
    if (MASK == 32) { const unsigned u = __float_as_uint(v); auto rr = __builtin_amdgcn_permlane32_swap(u, u, false, false); return __uint_as_float((rr[0] == u) ? rr[1] : rr[0]); }
    return __uint_as_float((unsigned)__builtin_amdgcn_ds_swizzle((int)__float_as_uint(v), 0x1f | (MASK << 10)));
}
__device__ __forceinline__ float xsum32(float v) { const unsigned u = __float_as_uint(v); auto rr = __builtin_amdgcn_permlane32_swap(u, u, false, false); return __uint_as_float(rr[0]) + __uint_as_float(rr[1]); }
__device__ __forceinline__ float xsum16(float v) { const unsigned u = __float_as_uint(v); auto rr = __builtin_amdgcn_permlane16_swap(u, u, false, false); return __uint_as_float(rr[0]) + __uint_as_float(rr[1]); }
__device__ __forceinline__ float swapsum32(float a, float b) { auto rr = __builtin_amdgcn_permlane32_swap(__float_as_uint(a), __float_as_uint(b), false, false); return __uint_as_float(rr[0]) + __uint_as_float(rr[1]); }
__device__ __forceinline__ float swapsum16(float a, float b) { auto rr = __builtin_amdgcn_permlane16_swap(__float_as_uint(a), __float_as_uint(b), false, false); return __uint_as_float(rr[0]) + __uint_as_float(rr[1]); }
__device__ __forceinline__ float dpp_half_mirror(float v) { return __uint_as_float((unsigned)__builtin_amdgcn_update_dpp(0, (int)__float_as_uint(v), 0x141, 0xF, 0xF, true)); }
__device__ __forceinline__ float wave_sum(float v) {
    v += xshfl<1>(v); v += xshfl<2>(v);
    v += __uint_as_float((unsigned)__builtin_amdgcn_update_dpp(0, (int)__float_as_uint(v), 0x141, 0xF, 0xF, true));
    v += __uint_as_float((unsigned)__builtin_amdgcn_update_dpp(0, (int)__float_as_uint(v), 0x140, 0xF, 0xF, true));
    v = xsum16(v); v = xsum32(v);
    return v;
}
#define LDS_WAIT() asm volatile("s_waitcnt lgkmcnt(0)" ::: "memory")
#define VM_WAIT() asm volatile("s_waitcnt vmcnt(0)" ::: "memory")

namespace pg8 {
constexpr int BM = 256, BK = 64, HALF = 128, HTB = HALF * BK * 2, STAGE_BYTES = 8 * HTB, NXCD = 8, WGM = 8;
__host__ __device__ __forceinline__ int lds_byte(int r, int c) { const int st = (r >> 4) * 2 + (c >> 5), rr = r & 15, cc = c & 31, ob = rr * 64 + cc * 2; return st * 1024 + (ob ^ (((ob >> 9) & 1) << 5)); }
__host__ __device__ __forceinline__ void stage_rc(int b, int& R, int& C) { const int st = b / 1024, sb = b % 1024, swz = sb ^ (((sb >> 9) & 1) << 5); R = (st >> 1) * 16 + swz / 64; C = (st & 1) * 32 + (swz % 64) / 2; }
__host__ __device__ __forceinline__ int perm32(int rho) { const int n = rho >> 4, i = rho & 15; return 8 * (i >> 2) + 4 * n + (i & 3); }

struct Unit { int pm, pn; long long offA, offB; int aux; };
struct Gemm { const bf16_t* A; const bf16_t* Bt; int K, lda, ldb; };

__device__ __forceinline__ bool static_tile(int i, int G, int c, int nM, int nN, int& pm, int& pn) {
    const int nwg = nM * nN; const long L = (long)i * G + c; if (L >= nwg) return false;
    int wgid = (int)L; { const int q = nwg / NXCD, r = nwg % NXCD, xcd = wgid % NXCD, off = wgid / NXCD; wgid = (xcd < r ? xcd * (q + 1) : r * (q + 1) + (xcd - r) * q) + off; }
    const int nig = WGM * nN, gid = wgid / nig, fm = gid * WGM, gsz = (nM - fm) < WGM ? (nM - fm) : WGM;
    pm = fm + ((wgid % nig) % gsz); pn = (wgid % nig) / gsz; return true;
}
struct PlainOrder {
    int nM, nN, G, c; long long sA, sB;
    __device__ __forceinline__ bool next(int i, Unit& u) const { if (!static_tile(i, G, c, nM, nN, u.pm, u.pn)) return false; u.offA = (long long)u.pm * sA; u.offB = (long long)u.pn * sB; u.aux = 0; return true; }
};
struct PanelOrder {
    int nM, nN, G, c; long long sA, sB;
    __device__ __forceinline__ bool next(int i, Unit& u) const { const int pm = c + G * (i / nN); if (pm >= nM) return false; u.pm = pm; u.pn = i % nN; u.offA = (long long)pm * sA; u.offB = (long long)u.pn * sB; u.aux = 0; return true; }
};
struct ListOrder {
    int n, pm, aux; long long offA0, offB0, sB;
    __device__ __forceinline__ bool next(int i, Unit& u) const { if (i >= n) return false; u.pm = pm; u.pn = i; u.aux = aux; u.offA = offA0; u.offB = offB0 + (long long)i * sB; return true; }
};
struct GroupedOrder {
    int ng, nM, nN, G, c; long long sA, sB, gA, gB;
    __device__ __forceinline__ bool next(int i, Unit& u) const {
        const long L = (long)i * G + c; const int per = nM * nN; if (L >= (long)ng * per) return false;
        const int gi = (int)(L / per), r = (int)(L % per); u.pm = r / nN; u.pn = r % nN; u.aux = gi;
        u.offA = (long long)gi * gA + (long long)u.pm * sA; u.offB = (long long)gi * gB + (long long)u.pn * sB; return true; }
};

template <class Epi, class Sched, bool GATHER = false>
__device__ __forceinline__ void gemm_phase(LAS unsigned char* lds, const Gemm g, const Sched& S, const Epi& E, int tid_in, const int* rowmap = nullptr) {
    int tid_ = tid_in; asm volatile("" : "+v"(tid_));
    const int tid = tid_, wid = __builtin_amdgcn_readfirstlane(tid >> 6), lane = tid & 63, wr = wid >> 2, wc = wid & 3, fr = lane & 15, fq = lane >> 4;
    int K_ = g.K; asm volatile("" : "+s"(K_));
    const int K = K_, nt = K / BK; (void)K;
    unsigned voffA[2], voffB[2];
#pragma unroll
    for (int i = 0; i < 2; ++i) { int R, C; stage_rc(tid * 16 + i * 8192, R, C); const int Rb = Epi::PERM ? ((R & ~31) + perm32(R & 31)) : R;
        voffA[i] = (unsigned)(R * g.lda + C) * 2u; voffB[i] = (unsigned)(Rb * g.ldb + C) * 2u; }
    const size_t kstep = (size_t)(BK * 2);
    const size_t hstepA = GATHER ? (size_t)0 : (size_t)HALF * g.lda * 2, hstepB = (size_t)HALF * g.ldb * 2;
    unsigned vA[4]; int vN[4];
#pragma unroll
    for (int j = 0; j < 4; ++j) { vA[j] = 0u; vN[j] = 0; }
    auto rows_req = [&](const Unit& u) {
#pragma unroll
        for (int j = 0; j < 4; ++j) { int R, C; stage_rc(tid * 16 + (j & 1) * 8192, R, C); vN[j] = rowmap[u.aux * 256 + (j >> 1) * HALF + R]; } };
    auto rows_req_async = [&](const Unit& u) {
#pragma unroll
        for (int j = 0; j < 4; ++j) { int R, C; stage_rc(tid * 16 + (j & 1) * 8192, R, C); const int* src = rowmap + u.aux * 256 + (j >> 1) * HALF + R;
            asm volatile("global_load_dword %0, %1, off" : "=v"(vN[j]) : "v"(src) : "memory"); } };
    auto rows_set = [&]() {
#pragma unroll
        for (int j = 0; j < 4; ++j) { int R, C; stage_rc(tid * 16 + (j & 1) * 8192, R, C); vA[j] = (unsigned)(vN[j] < 0 ? 0 : (vN[j] >> 1)) * (unsigned)(g.lda * 2) + (unsigned)C * 2u; } };
    const unsigned ldsw = (unsigned)wid * 1024u;
    const int aoff = lds_byte(wr * 64 + fr, fq * 8), boff = lds_byte(wc * 32 + fr, fq * 8);
#define PG8_SA(b, h) (((b) * 2 + (h)) * HTB)
#define PG8_SB(b, h) ((4 + (b) * 2 + (h)) * HTB)
#define PG8_STAGE(bufoff, gbase, voff) do { _Pragma("unroll") for (int _i = 0; _i < 2; ++_i) \
        __builtin_amdgcn_global_load_lds((const unsigned*)((const char*)(gbase) + (voff)[_i]), (LAS unsigned*)(lds + (bufoff) + ldsw + _i * 8192), 16, 0, 0); } while (0)
#define PG8_STAGE_A(bufoff, gbase, h) do { if (GATHER) { _Pragma("unroll") for (int _i = 0; _i < 2; ++_i) \
        __builtin_amdgcn_global_load_lds((const unsigned*)((const char*)(gbase) + vA[(h) * 2 + _i]), (LAS unsigned*)(lds + (bufoff) + ldsw + _i * 8192), 16, 0, 0); } else PG8_STAGE(bufoff, (gbase) + (h) * hstepA, voffA); } while (0)
#define PG8_LDA(dst, b, h) do { _Pragma("unroll") for (int m = 0; m < 4; ++m) _Pragma("unroll") for (int k = 0; k < 2; ++k) dst[m][k] = *(const LAS bf16x8*)(lds + PG8_SA(b, h) + aoff + m * 2048 + k * 1024); } while (0)
#define PG8_LDB(dst, b, h) do { _Pragma("unroll") for (int n = 0; n < 2; ++n) _Pragma("unroll") for (int k = 0; k < 2; ++k) dst[n][k] = *(const LAS bf16x8*)(lds + PG8_SB(b, h) + boff + n * 2048 + k * 1024); } while (0)
#define PG8_MMA(ai, bj, At, Bt) do { __builtin_amdgcn_s_setprio(1); _Pragma("unroll") for (int m = 0; m < 4; ++m) _Pragma("unroll") for (int n = 0; n < 2; ++n) _Pragma("unroll") for (int k = 0; k < 2; ++k) \
        acc[ai][bj][m][n] = __builtin_amdgcn_mfma_f32_16x16x32_bf16(Bt[n][k], At[m][k], acc[ai][bj][m][n], 0, 0, 0); __builtin_amdgcn_s_setprio(0); } while (0)
#define PG8_WAIT_V(n) asm volatile("s_waitcnt vmcnt(" #n ")" ::: "memory")
#define PG8_WAIT_L(n) asm volatile("s_waitcnt lgkmcnt(" #n ")" ::: "memory")
#define PG8_BAR __builtin_amdgcn_s_barrier()
#define PG8_SCHED __builtin_amdgcn_sched_barrier(0)
    Unit cur, nxt; int ui = 0;
    if (!S.next(0, cur)) return;
    f32x4 acc[2][2][4][2];
#pragma unroll
    for (int a = 0; a < 2; ++a)
#pragma unroll
        for (int b = 0; b < 2; ++b)
#pragma unroll
            for (int m = 0; m < 4; ++m)
#pragma unroll
                for (int n = 0; n < 2; ++n) acc[a][b][m][n] = (f32x4){0.f, 0.f, 0.f, 0.f};
    bf16x8 At[4][2], B0[2][2], B1[2][2];
    const char* cA = (const char*)g.A + (GATHER ? 0ll : cur.offA); const char* cB = (const char*)g.Bt + cur.offB;
    if (GATHER) { rows_req(cur); rows_set(); }
    PG8_STAGE(PG8_SB(0, 0), cB, voffB); PG8_STAGE(PG8_SB(0, 1), cB + hstepB, voffB); PG8_STAGE_A(PG8_SA(0, 0), cA, 0); PG8_STAGE_A(PG8_SA(0, 1), cA, 1);
    if (wr == 1) PG8_BAR;
    PG8_WAIT_V(2); PG8_BAR;
    PG8_STAGE(PG8_SB(1, 0), cB + kstep, voffB); PG8_STAGE_A(PG8_SA(1, 0), cA + kstep, 0); PG8_STAGE(PG8_SB(1, 1), cB + hstepB + kstep, voffB);
    PG8_WAIT_V(6); PG8_BAR;
    for (;;) {
        const bool has_next = S.next(ui + 1, nxt);
        const char* nA = (has_next && !GATHER) ? (const char*)g.A + nxt.offA : cA; const char* nB = has_next ? (const char*)g.Bt + nxt.offB : cB;
        for (int t = 0; t < nt; t += 2) {
            const bool last = (t == nt - 2);
            if (GATHER && has_next && t == nt - 4) rows_req_async(nxt);
            const char* a1 = cA + (size_t)(t + 1) * kstep;
            const char* a2 = last ? nA : cA + (size_t)(t + 2) * kstep; const char* b2 = last ? nB : cB + (size_t)(t + 2) * kstep;
            const char* a3 = a2 + kstep; const char* b3 = b2 + kstep;
            PG8_LDB(B0, 0, 0); PG8_LDB(B1, 0, 1); PG8_SCHED; PG8_LDA(At, 0, 0); PG8_STAGE_A(PG8_SA(1, 1), a1, 1);
            if (GATHER && last && has_next) rows_set();
            PG8_WAIT_V(8); PG8_WAIT_L(0); PG8_BAR; PG8_MMA(0, 0, At, B0); PG8_MMA(0, 1, At, B1); PG8_BAR; PG8_SCHED;
            PG8_LDA(At, 0, 1); PG8_STAGE(PG8_SB(0, 0), b2, voffB); PG8_STAGE(PG8_SB(0, 1), b2 + hstepB, voffB); PG8_STAGE_A(PG8_SA(0, 0), a2, 0);
            PG8_WAIT_V(8); PG8_WAIT_L(0); PG8_BAR; PG8_MMA(1, 0, At, B0); PG8_MMA(1, 1, At, B1); PG8_BAR; PG8_SCHED;
            PG8_LDB(B0, 1, 0); PG8_LDB(B1, 1, 1); PG8_SCHED; PG8_LDA(At, 1, 0); PG8_STAGE_A(PG8_SA(0, 1), a2, 1);
            PG8_WAIT_V(8); PG8_WAIT_L(0); PG8_BAR; PG8_MMA(0, 0, At, B0); PG8_MMA(0, 1, At, B1); PG8_BAR; PG8_SCHED;
            PG8_LDA(At, 1, 1); PG8_STAGE(PG8_SB(1, 0), b3, voffB); PG8_STAGE(PG8_SB(1, 1), b3 + hstepB, voffB); PG8_STAGE_A(PG8_SA(1, 0), a3, 0);
            PG8_WAIT_V(8); PG8_WAIT_L(0); PG8_BAR; PG8_MMA(1, 0, At, B0); PG8_MMA(1, 1, At, B1); PG8_BAR; PG8_SCHED;
        }
#if MK_ALIGN_EPI
        if (wr == 0) PG8_BAR;
#endif
        { int fr_ = fr, fq_ = fq; asm volatile("" : "+v"(fr_), "+v"(fq_));
          E(acc, cur, wr, wc, fr_, fq_); }
        if (!has_next) break;
#pragma unroll
        for (int a = 0; a < 2; ++a)
#pragma unroll
            for (int b = 0; b < 2; ++b)
#pragma unroll
                for (int m = 0; m < 4; ++m)
#pragma unroll
                    for (int n = 0; n < 2; ++n) acc[a][b][m][n] = (f32x4){0.f, 0.f, 0.f, 0.f};
        cur = nxt; cA = nA; cB = nB; ++ui;
#if MK_ALIGN_EPI
        if (wr == 1) PG8_BAR;
#endif
    }
    PG8_WAIT_V(0);
#if !MK_ALIGN_EPI
    if (wr == 0) PG8_BAR;
#endif
    PG8_BAR;
#undef PG8_SA
#undef PG8_SB
#undef PG8_STAGE
#undef PG8_STAGE_A
#undef PG8_LDA
#undef PG8_LDB
#undef PG8_MMA
#undef PG8_WAIT_V
#undef PG8_WAIT_L
#undef PG8_BAR
#undef PG8_SCHED
}
}

#define XB_TMO      128
#define XB_XCNT(j)  (256  + 64 * (j))
#define XB_XSUB(j)  (1280 + 64 * (j))
#define XB_XGEN(j)  (2304 + 64 * (j))
#define XB_TOP      3328
#define XB_TOPGEN   3392
#define XCD_BAR_WORDS 3456
#define XB_SPIN_CAP (1u << 20)
__device__ __forceinline__ unsigned xb_ld(unsigned* p)              { return __hip_atomic_load(p, __ATOMIC_RELAXED, __HIP_MEMORY_SCOPE_AGENT); }
__device__ __forceinline__ unsigned xb_add(unsigned* p, unsigned v) { return __hip_atomic_fetch_add(p, v, __ATOMIC_RELAXED, __HIP_MEMORY_SCOPE_AGENT); }
__device__ __forceinline__ unsigned xb_xcc_id() { return (unsigned)__builtin_amdgcn_s_getreg((3 << 11) | 20) & 0xFu; }
#define XB_SPIN(cond, bar) do { unsigned _sp = 0; while (cond) { __builtin_amdgcn_s_sleep(1); \
    if ((++_sp & 255u) == 0u) { if (xb_ld(&(bar)[XB_TMO])) break; if (_sp > XB_SPIN_CAP) { atomicAdd(&(bar)[XB_TMO], 1u); break; } } } } while (0)
struct XcdBarrier { unsigned* bar; unsigned x; volatile LAS unsigned* st; };
__device__ __forceinline__ XcdBarrier xcd_barrier_post(unsigned* bar, volatile LAS unsigned* st) {
    XcdBarrier b; b.bar = bar; b.x = xb_xcc_id(); b.st = st;
    if (threadIdx.x == 0) (void)xb_add(&bar[XB_XCNT(b.x)], 1u);
    return b;
}
__device__ __forceinline__ void xcd_barrier_complete(unsigned* bar, unsigned x, unsigned& nloc, unsigned& nx) {
    const unsigned G = gridDim.x * gridDim.y * gridDim.z;
    unsigned sum, cnt, mine, sp = 0u;
    for (;;) {
        sum = 0u; cnt = 0u; mine = 0u;
#pragma unroll 1
        for (unsigned j = 0; j < 16; ++j) { const unsigned c = xb_ld(&bar[XB_XCNT(j)]); sum += c; cnt += (c > 0u) ? 1u : 0u; mine = (j == x) ? c : mine; }
        if (sum == G) break;
        __builtin_amdgcn_s_sleep(1);
        if ((++sp & 255u) == 0u) { if (xb_ld(&bar[XB_TMO])) break; if (sp > XB_SPIN_CAP) { atomicAdd(&bar[XB_TMO], 1u); break; } }
    }
    nloc = mine > 0u ? mine : 1u; nx = cnt > 0u ? cnt : 1u;
}
__device__ __forceinline__ void xcd_barrier(const XcdBarrier& b, int wave_id) {
    asm volatile("s_waitcnt vmcnt(0)" ::: "memory");
    __syncthreads();
    if (wave_id == 0 && lane_id_fresh() == 0) {
        unsigned* bar = b.bar; asm volatile("" : "+s"(bar));
        __builtin_amdgcn_s_waitcnt(0);
        unsigned nloc = b.st[0], nx = b.st[1];
        if (nloc == 0u) { xcd_barrier_complete(bar, b.x, nloc, nx); b.st[0] = nloc; b.st[1] = nx; }
        const unsigned old = xb_add(&bar[XB_XSUB(b.x)], 1u);
        const unsigned gen = old / nloc;
        if (old + 1u == (gen + 1u) * nloc) {
            __builtin_amdgcn_fence(__ATOMIC_RELEASE, "agent");
            asm volatile("s_waitcnt vmcnt(0)" ::: "memory");
            const unsigned og = xb_add(&bar[XB_TOP], 1u);
            const unsigned tg = og / nx;
            if (og + 1u == (tg + 1u) * nx) xb_add(&bar[XB_TOPGEN], 1u);
            else XB_SPIN(xb_ld(&bar[XB_TOPGEN]) == tg, bar);
            __builtin_amdgcn_fence(__ATOMIC_ACQUIRE, "agent");
            xb_add(&bar[XB_XGEN(b.x)], 1u);
            asm volatile("s_waitcnt vmcnt(0)" ::: "memory");
        } else {
            XB_SPIN(xb_ld(&bar[XB_XGEN(b.x)]) == gen, bar);
            __builtin_amdgcn_fence(__ATOMIC_ACQUIRE, "agent");
            asm volatile("s_waitcnt vmcnt(0)" ::: "memory");
        }
    }
    __syncthreads();
}
namespace nsa {
constexpr int PITCH = 144, TILE_LDS = 64 * PITCH;
__device__ __forceinline__ int crow(int r, int hi) { return (r & 3) + 8 * (r >> 2) + 4 * hi; }
__device__ __forceinline__ int vslot(int kk) { return (kk & 0x33) | (((kk >> 2) & 1) << 3) | (((kk >> 3) & 1) << 2); }

struct Lane { int lane, c, hi, wid, tid; };

__device__ __forceinline__ void qk_tile(f32x16& p0, f32x16& p1, const LAS unsigned char* Ks, const bf16x8 (&qr)[4], float bias, const Lane& L) {
#pragma unroll
    for (int r = 0; r < 16; ++r) { p0[r] = bias; p1[r] = bias; }
    const LAS unsigned char* kb = Ks + L.c * PITCH + L.hi * 16;
#pragma unroll
    for (int d0 = 0; d0 < 4; ++d0) {
        const bf16x8 k0 = *(const LAS bf16x8*)(kb + d0 * 32);
        const bf16x8 k1 = *(const LAS bf16x8*)(kb + 32 * PITCH + d0 * 32);
        p0 = __builtin_amdgcn_mfma_f32_32x32x16_bf16(k0, qr[d0], p0, 0, 0, 0);
        p1 = __builtin_amdgcn_mfma_f32_32x32x16_bf16(k1, qr[d0], p1, 0, 0, 0);
    }
}
__device__ __forceinline__ void qk_tile_c(f32x16& p0, f32x16& p1, const LAS unsigned char* Ks, const bf16x8 (&qr)[4], const f32x16& cv, const Lane& L) {
    const LAS unsigned char* kb = Ks + L.c * PITCH + L.hi * 16;
    { const bf16x8 k0 = *(const LAS bf16x8*)(kb); const bf16x8 k1 = *(const LAS bf16x8*)(kb + 32 * PITCH);
      p0 = __builtin_amdgcn_mfma_f32_32x32x16_bf16(k0, qr[0], cv, 0, 0, 0); p1 = __builtin_amdgcn_mfma_f32_32x32x16_bf16(k1, qr[0], cv, 0, 0, 0); }
#pragma unroll
    for (int d0 = 1; d0 < 4; ++d0) {
        const bf16x8 k0 = *(const LAS bf16x8*)(kb + d0 * 32);
        const bf16x8 k1 = *(const LAS bf16x8*)(kb + 32 * PITCH + d0 * 32);
        p0 = __builtin_amdgcn_mfma_f32_32x32x16_bf16(k0, qr[d0], p0, 0, 0, 0);
        p1 = __builtin_amdgcn_mfma_f32_32x32x16_bf16(k1, qr[d0], p1, 0, 0, 0);
    }
}
__device__ __forceinline__ void mask_range(f32x16& p0, f32x16& p1, int lo, int hi_, int hi) {
#pragma unroll
    for (int r = 0; r < 16; ++r) { const int k0 = crow(r, hi), k1 = k0 + 32;
        if (k0 <= lo || k0 > hi_) p0[r] = NEGF;
        if (k1 <= lo || k1 > hi_) p1[r] = NEGF; }
}
__device__ __forceinline__ float tile_max(const f32x16& p0, const f32x16& p1) {
    float a = fmaxf(p0[0], p1[0]);
#pragma unroll
    for (int r = 1; r < 16; ++r) a = fmaxf(a, fmaxf(p0[r], p1[r]));
    return fmaxf(a, xshfl<32>(a));
}
__device__ __forceinline__ void pv_tile(f32x16& o0, f32x16& o1, const LAS unsigned char* Vs, const f32x16& p0, const f32x16& p1, const Lane& L) {
    const LAS unsigned char* vb = Vs + L.c * PITCH + L.hi * 16;
#pragma unroll
    for (int s = 0; s < 4; ++s) {
        u32x4 w;
        if (s < 2) { const int b = 8 * (s & 1); w.x = cvt_pk_bf16(p0[b], p0[b + 1]); w.y = cvt_pk_bf16(p0[b + 2], p0[b + 3]); w.z = cvt_pk_bf16(p0[b + 4], p0[b + 5]); w.w = cvt_pk_bf16(p0[b + 6], p0[b + 7]); }
        else       { const int b = 8 * (s & 1); w.x = cvt_pk_bf16(p1[b], p1[b + 1]); w.y = cvt_pk_bf16(p1[b + 2], p1[b + 3]); w.z = cvt_pk_bf16(p1[b + 4], p1[b + 5]); w.w = cvt_pk_bf16(p1[b + 6], p1[b + 7]); }
        const bf16x8 pf = __builtin_bit_cast(bf16x8, w);
        const bf16x8 v0 = *(const LAS bf16x8*)(vb + s * 32);
        const bf16x8 v1 = *(const LAS bf16x8*)(vb + 32 * PITCH + s * 32);
        o0 = __builtin_amdgcn_mfma_f32_32x32x16_bf16(v0, pf, o0, 0, 0, 0);
        o1 = __builtin_amdgcn_mfma_f32_32x32x16_bf16(v1, pf, o1, 0, 0, 0);
        if (s & 1) __builtin_amdgcn_sched_barrier(0);
    }
}
__device__ __forceinline__ void softmax_pv(f32x16& p0, f32x16& p1, f32x16& o0, f32x16& o1, float& m, float& l, const LAS unsigned char* Vs, const Lane& L) {
    const float mx = tile_max(p0, p1), mn = fmaxf(m, mx), alpha = fast_exp2(m - mn); m = mn;
    float ls = 0.f;
#pragma unroll
    for (int r = 0; r < 16; ++r) { p0[r] = fast_exp2(p0[r] - mn); p1[r] = fast_exp2(p1[r] - mn); ls += p0[r] + p1[r]; }
    l = l * alpha + ls;
#pragma unroll
    for (int r = 0; r < 16; ++r) { o0[r] *= alpha; o1[r] *= alpha; }
    pv_tile(o0, o1, Vs, p0, p1, L);
}
__device__ __forceinline__ int stage_off(int tid) { return (tid >> 3) * PITCH + (tid & 7) * 16; }

__device__ __forceinline__ void load_q(bf16x8 (&qr)[4], const bf16_t* qbuf, long tok, int head, int hi) {
    const bf16_t* qp = qbuf + tok * 512 + head * 64 + hi * 8;
#pragma unroll
    for (int d0 = 0; d0 < 4; ++d0) qr[d0] = *(const bf16x8*)(qp + d0 * 16);
}

__device__ __forceinline__ u32x4 vload(const bf16_t* Vt, int j, const Lane& L) { return *(const u32x4*)((const char*)Vt + (size_t)j * 8192 + L.lane * 128 + L.wid * 16); }
__device__ __forceinline__ void vstore(LAS unsigned char* Vs, const u32x4 v, const Lane& L) {
    LAS unsigned short* p = (LAS unsigned short*)(Vs + (8 * L.wid) * PITCH) + vslot(L.lane);
    p[0 * (PITCH / 2)] = (unsigned short)(v.x & 0xffffu); p[1 * (PITCH / 2)] = (unsigned short)(v.x >> 16); p[2 * (PITCH / 2)] = (unsigned short)(v.y & 0xffffu); p[3 * (PITCH / 2)] = (unsigned short)(v.y >> 16);
    p[4 * (PITCH / 2)] = (unsigned short)(v.z & 0xffffu); p[5 * (PITCH / 2)] = (unsigned short)(v.z >> 16); p[6 * (PITCH / 2)] = (unsigned short)(v.w & 0xffffu); p[7 * (PITCH / 2)] = (unsigned short)(v.w >> 16);
}
template <int MODE>
__device__ __forceinline__ void run_branch(f32x16& o0, f32x16& o1, float& mref, float& l, const bf16_t* Kt  , const bf16_t* Vt  ,
                                           int jlo, int jhi, int qb, int qrel, unsigned long long selw, const bf16x8 (&qr)[4], LAS unsigned char* lds, const Lane& L) {
    LAS unsigned char* Kbuf = lds; LAS unsigned char* Vbuf = lds + 2 * TILE_LDS;
    const int so = stage_off(L.tid);
    u32x4 kreg = *(const u32x4*)((const char*)Kt + (size_t)jlo * 8192 + L.tid * 16);
    u32x4 vreg = vload(Vt, jlo, L);
    *(LAS u32x4*)(Kbuf + so) = kreg; vstore(Vbuf, vreg, L);
    __syncthreads();
    f32x16 cv;
#pragma unroll
    for (int r = 0; r < 16; ++r) cv[r] = -mref;
    for (int j = jlo; j <= jhi; ++j) {
        const int cur = (j - jlo) & 1;
        if (j < jhi) { kreg = *(const u32x4*)((const char*)Kt + (size_t)(j + 1) * 8192 + L.tid * 16); vreg = vload(Vt, j + 1, L); }
        f32x16 p0, p1;
        if (MODE == 0) { const float cb = ((selw >> j) & 1ull) ? -mref : NEGF;
#pragma unroll
            for (int r = 0; r < 16; ++r) cv[r] = cb; }
        qk_tile_c(p0, p1, Kbuf + cur * TILE_LDS, qr, cv, L);
        if (j == qb) mask_range(p0, p1, -1, qrel, L.hi);
        if (MODE == 1 && j == qb - 8) mask_range(p0, p1, qrel, 64, L.hi);
        const float mx = tile_max(p0, p1);
        if (__any(mx > 8.0f)) {
            const float dl = fmaxf(mx, 0.f), f = fast_exp2(-dl); mref += dl; l *= f;
#pragma unroll
            for (int r = 0; r < 16; ++r) { o0[r] *= f; o1[r] *= f; p0[r] -= dl; p1[r] -= dl; }
            if (MODE == 1) {
#pragma unroll
                for (int r = 0; r < 16; ++r) cv[r] = -mref; }
        }
        float ls = 0.f;
#pragma unroll
        for (int r = 0; r < 16; ++r) { p0[r] = fast_exp2(p0[r]); p1[r] = fast_exp2(p1[r]); ls += p0[r] + p1[r]; }
        l += ls;
        pv_tile(o0, o1, Vbuf + cur * TILE_LDS, p0, p1, L);
        if (j < jhi) { *(LAS u32x4*)(Kbuf + (cur ^ 1) * TILE_LDS + so) = kreg; vstore(Vbuf + (cur ^ 1) * TILE_LDS, vreg, L); }
        __syncthreads();
    }
}
struct SoftState { float mref, l; };
__device__ __forceinline__ void softmax_step2(f32x16& p0, f32x16& p1, f32x16& o0, f32x16& o1, SoftState& st, bool sel, bf16x8 (&pf)[4]) {
    if (__any(st.mref != 0.f)) {
#pragma unroll
        for (int r = 0; r < 16; ++r) { p0[r] -= st.mref; p1[r] -= st.mref; } }
    float ls = 0.f;
#pragma unroll
    for (int r = 0; r < 16; ++r) { p0[r] = fast_exp2(p0[r]); p1[r] = fast_exp2(p1[r]); ls += p0[r] + p1[r]; }
    ls = sel ? ls : 0.f; st.l += ls;
#pragma unroll
    for (int s = 0; s < 4; ++s) { u32x4 w; const int b = 8 * (s & 1);
        if (s < 2) { w.x = cvt_pk_bf16(p0[b], p0[b + 1]); w.y = cvt_pk_bf16(p0[b + 2], p0[b + 3]); w.z = cvt_pk_bf16(p0[b + 4], p0[b + 5]); w.w = cvt_pk_bf16(p0[b + 6], p0[b + 7]); }
        else       { w.x = cvt_pk_bf16(p1[b], p1[b + 1]); w.y = cvt_pk_bf16(p1[b + 2], p1[b + 3]); w.z = cvt_pk_bf16(p1[b + 4], p1[b + 5]); w.w = cvt_pk_bf16(p1[b + 6], p1[b + 7]); }
        if (!sel) w = (u32x4){0u, 0u, 0u, 0u};
        pf[s] = __builtin_bit_cast(bf16x8, w); }
}
__device__ __forceinline__ void renorm_step(f32x16& o0, f32x16& o1, SoftState& st) {
    if (__any(st.l > 1.0995116e12f)) { const bool big = st.l > 1.0995116e12f; const float f = big ? 9.094947e-13f : 1.0f; st.mref += big ? 40.f : 0.f; st.l *= f;
#pragma unroll
        for (int r = 0; r < 16; ++r) { o0[r] *= f; o1[r] *= f; } }
}
template <int MODE>
__device__ __forceinline__ void run_branch2(f32x16& oa0, f32x16& oa1, SoftState& sa, f32x16& ob0, f32x16& ob1, SoftState& sb, const bf16_t* Kt, const bf16_t* Vt, int jlo, int jhi, int qbw, int qrela,
                                            const LAS unsigned long long* selp  , const bf16x8 (&qa)[4], const bf16x8 (&qbf)[4], LAS unsigned char* lds, const Lane& L) {
    LAS unsigned char* Kbuf = lds; LAS unsigned char* Vbuf = lds + 2 * TILE_LDS;
    const int so = stage_off(L.tid);
    {   const u32x4 kreg = *(const u32x4*)((const char*)Kt + (size_t)jlo * 8192 + L.tid * 16); const u32x4 vreg = vload(Vt, jlo, L);
        *(LAS u32x4*)(Kbuf + so) = kreg; vstore(Vbuf, vreg, L); }
    __syncthreads();
    for (int j = jlo; j <= jhi; ++j) {
        const int cur = (j - jlo) & 1;
        const bool act = (j <= qbw) && (MODE == 0 || j >= qbw - 8);
        u32x4 kreg, vreg;
        bf16x8 fa[4], fb[4];
        if (act) {
            f32x16 pa0, pa1, pb0, pb1;
#pragma unroll
            for (int r = 0; r < 16; ++r) { pa0[r] = 0.f; pa1[r] = 0.f; pb0[r] = 0.f; pb1[r] = 0.f; }
            const LAS unsigned char* kb = Kbuf + cur * TILE_LDS + L.c * PITCH + L.hi * 16;
#pragma unroll
            for (int d0 = 0; d0 < 4; ++d0) { const bf16x8 k0 = *(const LAS bf16x8*)(kb + d0 * 32); const bf16x8 k1 = *(const LAS bf16x8*)(kb + 32 * PITCH + d0 * 32);
                pa0 = __builtin_amdgcn_mfma_f32_32x32x16_bf16(k0, qa[d0], pa0, 0, 0, 0); pa1 = __builtin_amdgcn_mfma_f32_32x32x16_bf16(k1, qa[d0], pa1, 0, 0, 0);
                pb0 = __builtin_amdgcn_mfma_f32_32x32x16_bf16(k0, qbf[d0], pb0, 0, 0, 0); pb1 = __builtin_amdgcn_mfma_f32_32x32x16_bf16(k1, qbf[d0], pb1, 0, 0, 0); }
            if (j == qbw) { mask_range(pa0, pa1, -1, qrela, L.hi); mask_range(pb0, pb1, -1, qrela + 8, L.hi); }
            if (MODE == 1 && j == qbw - 8) { mask_range(pa0, pa1, qrela, 64, L.hi); mask_range(pb0, pb1, qrela + 8, 64, L.hi); }
            bool sela = true, selb = true;
            if (MODE == 0) { sela = (selp[0] >> j) & 1ull; selb = (selp[1] >> j) & 1ull; }
            softmax_step2(pa0, pa1, oa0, oa1, sa, sela, fa);
            __builtin_amdgcn_sched_barrier(0);
            softmax_step2(pb0, pb1, ob0, ob1, sb, selb, fb);
            __builtin_amdgcn_sched_barrier(0);
        }
        if (j < jhi) { kreg = *(const u32x4*)((const char*)Kt + (size_t)(j + 1) * 8192 + L.tid * 16); vreg = vload(Vt, j + 1, L); }
        if (act) {
            const LAS unsigned char* vb = Vbuf + cur * TILE_LDS + L.c * PITCH + L.hi * 16;
#pragma unroll
            for (int s = 0; s < 4; ++s) {
                const bf16x8 v0 = *(const LAS bf16x8*)(vb + s * 32); const bf16x8 v1 = *(const LAS bf16x8*)(vb + 32 * PITCH + s * 32);
                oa0 = __builtin_amdgcn_mfma_f32_32x32x16_bf16(v0, fa[s], oa0, 0, 0, 0); oa1 = __builtin_amdgcn_mfma_f32_32x32x16_bf16(v1, fa[s], oa1, 0, 0, 0);
                ob0 = __builtin_amdgcn_mfma_f32_32x32x16_bf16(v0, fb[s], ob0, 0, 0, 0); ob1 = __builtin_amdgcn_mfma_f32_32x32x16_bf16(v1, fb[s], ob1, 0, 0, 0); }
            renorm_step(oa0, oa1, sa); renorm_step(ob0, ob1, sb);
        }
        if (j < jhi) { *(LAS u32x4*)(Kbuf + (cur ^ 1) * TILE_LDS + so) = kreg; vstore(Vbuf + (cur ^ 1) * TILE_LDS, vreg, L); }
        __syncthreads();
    }
}
}
namespace nsa {
struct AttnPtrs {
    const bf16_t* q;
    const bf16_t* z;
    const bf16_t* kc;
    const bf16_t* vct;
    const bf16_t* ksel;
    const bf16_t* vselt;
    const bf16_t* kwin; const bf16_t* vwint;
    unsigned long long* selmask;
    bf16_t* mix;
};
template <bool ACCUM>
__device__ __forceinline__ void store_o(const f32x16& a0, const f32x16& a1, bf16_t* mix, long tok, int head, int hi) {
    bf16_t* op = mix + tok * 1024 + head * 64 + 4 * hi;
#pragma unroll
    for (int dd = 0; dd < 2; ++dd)
#pragma unroll
        for (int rq = 0; rq < 4; ++rq) {
            float v0, v1, v2, v3;
            if (dd == 0) { v0 = a0[4 * rq]; v1 = a0[4 * rq + 1]; v2 = a0[4 * rq + 2]; v3 = a0[4 * rq + 3]; }
            else         { v0 = a1[4 * rq]; v1 = a1[4 * rq + 1]; v2 = a1[4 * rq + 2]; v3 = a1[4 * rq + 3]; }
            u32x2* p = (u32x2*)(op + dd * 32 + rq * 8);
            if (ACCUM) { const u32x2 old = *p; v0 += bflo(old.x); v1 += bfhi(old.x); v2 += bflo(old.y); v3 += bfhi(old.y); }
            u32x2 w; w.x = cvt_pk_bf16(v0, v1); w.y = cvt_pk_bf16(v2, v3); *p = w;
        }
}
__device__ __forceinline__ float gate_of(const bf16_t* z, long tok, int head, int br) { return sigmoidf_(bf2f(z[tok * INP + ZG + head * 3 + br])); }

struct CmpPre { bf16x8 qr[4]; };
__device__ __forceinline__ void cmp_prefetch(CmpPre& R, int bh, int qb, const AttnPtrs& P, const Lane& L) {
    const int b = bh >> 1, h = bh & 1, tq = qb * 64 + 8 * L.wid + (L.c >> 2), head = 4 * h + (L.c & 3); const long tok = (long)b * SEQ + tq;
    load_q(R.qr, P.q, tok, head, L.hi);
}
__device__ __forceinline__ void cmp_stage(const CmpPre& R, LAS unsigned char* lds, const Lane& L, bf16x8 (&qr)[4], float& gt) {
    (void)lds; (void)L;
#pragma unroll
    for (int d0 = 0; d0 < 4; ++d0) qr[d0] = R.qr[d0];
    gt = 0.f;
}
template <bool STAGE>
__device__ __forceinline__ void cmp_unit(int bh, int qb, const AttnPtrs& P, LAS unsigned char* lds, const Lane& L) {
    const int b = bh >> 1, h = bh & 1, t0 = qb * 64;
    const int ql = 8 * L.wid + (L.c >> 2), g = L.c & 3, tq = t0 + ql, head = 4 * h + g;
    const long tok = (long)b * SEQ + tq;
    LAS unsigned char* Kb = lds; LAS unsigned char* Vb = lds + 4 * TILE_LDS;
    LAS float* G4 = (LAS float*)(lds + 8 * TILE_LDS); LAS float* E3 = G4 + 64 * 64;
    const float gate_raw = bf2f(P.z[tok * INP + ZG + head * 3 + 0]);
    bf16x8 qr[4]; load_q(qr, P.q, tok, head, L.hi);
    if (STAGE) { const char* ks = (const char*)(P.kc + (size_t)bh * 256 * 64); const char* vs = (const char*)(P.vct + (size_t)bh * 256 * 64); const int so = stage_off(L.tid); u32x4 kk[4], vv[4];
#pragma unroll
      for (int jn = 0; jn < 4; ++jn) kk[jn] = *(const u32x4*)(ks + jn * 8192 + L.tid * 16);
#pragma unroll
      for (int jn = 0; jn < 4; ++jn) vv[jn] = *(const u32x4*)(vs + jn * 8192 + L.tid * 16);
#pragma unroll
      for (int jn = 0; jn < 4; ++jn) *(LAS u32x4*)(Kb + jn * TILE_LDS + so) = kk[jn];
#pragma unroll
      for (int jn = 0; jn < 4; ++jn) *(LAS u32x4*)(Vb + jn * TILE_LDS + so) = vv[jn]; }
    __syncthreads();
    const int nmax = (tq >= 31) ? ((tq - 31) >> 4) : -1;
    const int tq_lo = t0 + 8 * L.wid, tq_hi = tq_lo + 7;
    const int nmax_lo = (tq_lo >= 31) ? ((tq_lo - 31) >> 4) : -1, nmax_hi = (tq_hi >= 31) ? ((tq_hi - 31) >> 4) : -1;
    const int ntile = (nmax_hi >= 0) ? (nmax_hi >> 6) + 1 : 0;
    const bool need_imp = qb >= 16;
    float l = 0.f;
    f32x16 o0, o1;
#pragma unroll
    for (int r = 0; r < 16; ++r) { o0[r] = 0.f; o1[r] = 0.f; }
    float gsr[4][8], e3r[4][8];
#pragma unroll
    for (int jn = 0; jn < 4; ++jn)
#pragma unroll
        for (int i = 0; i < 8; ++i) { gsr[jn][i] = 0.f; e3r[jn][i] = 0.f; }
#pragma unroll
    for (int jn = 0; jn < 4; ++jn) {
        if (jn < ntile) {
            f32x16 p0, p1; qk_tile(p0, p1, Kb + jn * TILE_LDS, qr, 0.f, L);
            if (64 * jn + 63 > nmax_lo) mask_range(p0, p1, -1, nmax - 64 * jn, L.hi);
            float ls = 0.f;
#pragma unroll
            for (int r = 0; r < 16; ++r) { p0[r] = fast_exp2(p0[r]); p1[r] = fast_exp2(p1[r]); ls += p0[r] + p1[r]; }
            l += ls;
            if (need_imp) {
#pragma unroll
                for (int rq = 0; rq < 4; ++rq) { gsr[jn][rq] = (p0[4 * rq] + p0[4 * rq + 1]) + (p0[4 * rq + 2] + p0[4 * rq + 3]); e3r[jn][rq] = p0[4 * rq + 3];
                                                 gsr[jn][4 + rq] = (p1[4 * rq] + p1[4 * rq + 1]) + (p1[4 * rq + 2] + p1[4 * rq + 3]); e3r[jn][4 + rq] = p1[4 * rq + 3]; } }
            pv_tile(o0, o1, Vb + jn * TILE_LDS, p0, p1, L);
        }
        __builtin_amdgcn_sched_barrier(0);
    }
    l = xsum32(l);
    const float inv = (nmax >= 0 && l > 0.f) ? fast_rcp(l) : 0.f;
    if (need_imp) {
        LAS float* gp = G4 + ql * 64 + L.hi; asm volatile("" : "+v"(gp));
#pragma unroll
        for (int jn = 0; jn < 4; ++jn) {
            if (jn < ntile) {
#pragma unroll
                for (int i = 0; i < 8; ++i) { float gs = gsr[jn][i] * inv, e3 = e3r[jn][i] * inv;
                    gs += xshfl<1>(gs); gs += xshfl<2>(gs); e3 += xshfl<1>(e3); e3 += xshfl<2>(e3);
                    if (g == 0) { gp[16 * jn + 2 * i] = gs; gp[64 * 64 + 16 * jn + 2 * i] = e3; } }
            }
        }
    }
    {
        const float gt = sigmoidf_(gate_raw) * inv;
#pragma unroll
        for (int r = 0; r < 16; ++r) { o0[r] *= gt; o1[r] *= gt; }
        store_o<false>(o0, o1, P.mix, tok, head, L.hi);
    }
    __syncthreads();
}
__device__ __forceinline__ void cmp_topk(int bh, int qb, const AttnPtrs& P, LAS unsigned char* lds, const Lane& L) {
    const int t0 = qb * 64; LAS float* G4 = (LAS float*)(lds + 8 * TILE_LDS); LAS float* E3 = G4 + 64 * 64;
    const int s = L.lane;
    if (qb < 16) { const unsigned long long mask = (1ull << (qb + 1)) - 1ull;
        if (L.lane < 8) P.selmask[(size_t)bh * SEQ + t0 + 8 * L.wid + L.lane] = mask; }
    else {
        const bool cand = (s >= 1) && (s <= qb - 2);
        unsigned bits[8], T[8];
#pragma unroll
        for (int i = 0; i < 8; ++i) { const int q = 8 * L.wid + i; const float imp = G4[q * 64 + s] + (s > 0 ? E3[q * 64 + s - 1] : 0.f); bits[i] = cand ? __float_as_uint(fmaxf(imp, 0.f)) : 0u; T[i] = 0u; }
        int cnt[8];
#pragma unroll
        for (int i = 0; i < 8; ++i) cnt[i] = qb - 2;
        for (int bit = 30; bit >= 0; --bit) { int open_ = 0;
#pragma unroll
            for (int i = 0; i < 8; ++i) { const unsigned c = T[i] | (1u << bit); const int n = __popcll(__ballot(cand && bits[i] >= c)); if (n >= 13) { T[i] = c; cnt[i] = n; } open_ |= (cnt[i] != 13); }
            if (!open_) break; }
#pragma unroll
        for (int i = 0; i < 8; ++i) {
            const unsigned long long gt = __ballot(cand && bits[i] > T[i]); unsigned long long eq = __ballot(cand && bits[i] == T[i]);
            int need = 13 - __popcll(gt); unsigned long long take = 0ull;
            while (need > 0 && eq) { const unsigned long long low = eq & (0ull - eq); take |= low; eq ^= low; --need; }
            const unsigned long long mask = gt | take | 1ull | (1ull << qb) | (1ull << (qb - 1));
            if (L.lane == 0) P.selmask[(size_t)bh * SEQ + t0 + 8 * L.wid + i] = mask; }
    }
    __syncthreads();
}

__device__ __forceinline__ void sw_unit(int bh, int qb, const AttnPtrs& P, LAS unsigned char* lds, const Lane& L) {
    const int b = bh >> 1, h = bh & 1, t0 = qb * 64;
    const int ql = 8 * L.wid + (L.c >> 2), g = L.c & 3, tq = t0 + ql, head = 4 * h + g;
    const long tok = (long)b * SEQ + tq;
    bf16x8 qr[4]; load_q(qr, P.q, tok, head, L.hi);
    const unsigned long long selw = P.selmask[(size_t)bh * SEQ + tq];
    const float g1raw = bf2f(P.z[tok * INP + ZG + head * 3 + 1]), g2raw = bf2f(P.z[tok * INP + ZG + head * 3 + 2]);
    f32x16 r0, r1;
    {
        f32x16 o0, o1; float m = 0.f, l = 0.f;
#pragma unroll
        for (int r = 0; r < 16; ++r) { o0[r] = 0.f; o1[r] = 0.f; }
        run_branch<0>(o0, o1, m, l, P.ksel + (size_t)bh * SEQ * 64, P.vselt + (size_t)bh * SEQ * 64, 0, qb, qb, ql, selw, qr, lds, L);
        l = xsum32(l);
        const float sc = sigmoidf_(g1raw) * fast_rcp(l);
#pragma unroll
        for (int r = 0; r < 16; ++r) { r0[r] = o0[r] * sc; r1[r] = o1[r] * sc; }
    }
    {
        f32x16 o0, o1; float m = 0.f, l = 0.f;
#pragma unroll
        for (int r = 0; r < 16; ++r) { o0[r] = 0.f; o1[r] = 0.f; }
        run_branch<1>(o0, o1, m, l, P.kwin + (size_t)bh * SEQ * 64, P.vwint + (size_t)bh * SEQ * 64, qb >= 8 ? qb - 8 : 0, qb, qb, ql, 0ull, qr, lds, L);
        l = xsum32(l);
        const float sc = sigmoidf_(g2raw) * fast_rcp(l);
#pragma unroll
        for (int r = 0; r < 16; ++r) { r0[r] += o0[r] * sc; r1[r] += o1[r] * sc; }
    }
    store_o<true>(r0, r1, P.mix, tok, head, L.hi);
}
__device__ __forceinline__ void sw_unit2(int bh, int qb2, const AttnPtrs& P, LAS unsigned char* lds, const Lane& L) {
    const int b = bh >> 1, h = bh & 1, qbw = 2 * qb2 + (L.wid >> 2);
    const int qrela = 16 * (L.wid & 3) + (L.c >> 2), qrelb = qrela + 8, g = L.c & 3, head = 4 * h + g;
    const long toka = (long)b * SEQ + 64 * qbw + qrela, tokb = toka + 8;
    bf16x8 qa[4], qbf[4]; load_q(qa, P.q, toka, head, L.hi); load_q(qbf, P.q, tokb, head, L.hi);
    LAS unsigned long long* selp = (LAS unsigned long long*)(lds + 4 * TILE_LDS + 8192) + L.tid * 2;
    selp[0] = P.selmask[(size_t)bh * SEQ + 64 * qbw + qrela]; selp[1] = P.selmask[(size_t)bh * SEQ + 64 * qbw + qrelb];
    LAS float* gpark = (LAS float*)(lds + 4 * TILE_LDS) + L.tid * 4;
    gpark[0] = bf2f(P.z[toka * INP + ZG + head * 3 + 1]); gpark[1] = bf2f(P.z[tokb * INP + ZG + head * 3 + 1]); gpark[2] = bf2f(P.z[toka * INP + ZG + head * 3 + 2]); gpark[3] = bf2f(P.z[tokb * INP + ZG + head * 3 + 2]);
    {
        f32x16 oa0, oa1, ob0, ob1; SoftState sa{0.f, 0.f}, sb{0.f, 0.f};
#pragma unroll
        for (int r = 0; r < 16; ++r) { oa0[r] = 0.f; oa1[r] = 0.f; ob0[r] = 0.f; ob1[r] = 0.f; }
        run_branch2<0>(oa0, oa1, sa, ob0, ob1, sb, P.ksel + (size_t)bh * SEQ * 64, P.vselt + (size_t)bh * SEQ * 64, 0, 2 * qb2 + 1, qbw, qrela, selp, qa, qbf, lds, L);
        sa.l = xsum32(sa.l); sb.l = xsum32(sb.l);
        const float sca = sigmoidf_(gpark[0]) * fast_rcp(sa.l), scb = sigmoidf_(gpark[1]) * fast_rcp(sb.l);
#pragma unroll
        for (int r = 0; r < 16; ++r) { oa0[r] *= sca; oa1[r] *= sca; ob0[r] *= scb; ob1[r] *= scb; }
        { int qe = qrela; asm volatile("" : "+v"(qe));
          store_o<true>(oa0, oa1, P.mix, (long)b * SEQ + 64 * qbw + qe, head, L.hi); store_o<true>(ob0, ob1, P.mix, (long)b * SEQ + 64 * qbw + qe + 8, head, L.hi); }
    }
    {
        f32x16 oa0, oa1, ob0, ob1; SoftState sa{0.f, 0.f}, sb{0.f, 0.f};
#pragma unroll
        for (int r = 0; r < 16; ++r) { oa0[r] = 0.f; oa1[r] = 0.f; ob0[r] = 0.f; ob1[r] = 0.f; }
        run_branch2<1>(oa0, oa1, sa, ob0, ob1, sb, P.kwin + (size_t)bh * SEQ * 64, P.vwint + (size_t)bh * SEQ * 64, 2 * qb2 >= 8 ? 2 * qb2 - 8 : 0, 2 * qb2 + 1, qbw, qrela, selp, qa, qbf, lds, L);
        sa.l = xsum32(sa.l); sb.l = xsum32(sb.l);
        const float sca = sigmoidf_(gpark[2]) * fast_rcp(sa.l), scb = sigmoidf_(gpark[3]) * fast_rcp(sb.l);
#pragma unroll
        for (int r = 0; r < 16; ++r) { oa0[r] *= sca; oa1[r] *= sca; ob0[r] *= scb; ob1[r] *= scb; }
        { int qe = qrela; asm volatile("" : "+v"(qe));
          store_o<true>(oa0, oa1, P.mix, (long)b * SEQ + 64 * qbw + qe, head, L.hi); store_o<true>(ob0, ob1, P.mix, (long)b * SEQ + 64 * qbw + qe + 8, head, L.hi); }
    }
}
}
namespace epi {
using pg8::Unit; using pg8::BM; using pg8::HALF;
struct Bf16Plain {
    static constexpr bool PERM = true;
    bf16_t* O; int ldc;
    __device__ __forceinline__ void operator()(const f32x4 (&acc)[2][2][4][2], const Unit& u, int wr, int wc, int fr, int fq) const {
        const int row0 = u.pm * BM + wr * 64 + fr, col0 = u.pn * BM + wc * 32 + 8 * fq;
#pragma unroll
        for (int ai = 0; ai < 2; ++ai)
#pragma unroll
            for (int m = 0; m < 4; ++m) { bf16_t* rowp = O + (size_t)(row0 + ai * HALF + m * 16) * ldc + col0;
#pragma unroll
                for (int bj = 0; bj < 2; ++bj) { const f32x4 v0 = acc[ai][bj][m][0], v1 = acc[ai][bj][m][1];
                    u32x4 w; w.x = cvt_pk_bf16(v0[0], v0[1]); w.y = cvt_pk_bf16(v0[2], v0[3]); w.z = cvt_pk_bf16(v1[0], v1[1]); w.w = cvt_pk_bf16(v1[2], v1[3]);
                    *(u32x4*)(rowp + bj * HALF) = w; } }
    }
};
struct Bf16Sc1 {
    static constexpr bool PERM = true;
    bf16_t* O; int ldc; unsigned nbytes;
    __device__ __forceinline__ void operator()(const f32x4 (&acc)[2][2][4][2], const Unit& u, int wr, int wc, int fr, int fq) const {
        const __amdgpu_buffer_rsrc_t rsrc = __builtin_amdgcn_make_buffer_rsrc(O, 0, nbytes, 0x00020000);
        const int row0 = u.pm * BM + wr * 64 + fr, col0 = u.pn * BM + wc * 32 + 8 * fq;
#pragma unroll
        for (int ai = 0; ai < 2; ++ai)
#pragma unroll
            for (int m = 0; m < 4; ++m) { const unsigned off = (unsigned)(((size_t)(row0 + ai * HALF + m * 16) * ldc + col0) * 2);
#pragma unroll
                for (int bj = 0; bj < 2; ++bj) { const f32x4 v0 = acc[ai][bj][m][0], v1 = acc[ai][bj][m][1];
                    u32x4 w; w.x = cvt_pk_bf16(v0[0], v0[1]); w.y = cvt_pk_bf16(v0[2], v0[3]); w.z = cvt_pk_bf16(v1[0], v1[1]); w.w = cvt_pk_bf16(v1[2], v1[3]);
                    __builtin_amdgcn_raw_buffer_store_b128(w, rsrc, off + bj * HALF * 2, 0,   16); } }
    }
};
struct F32Grouped {
    static constexpr bool PERM = false;
    float* C; int ldc; size_t gstride;
    __device__ __forceinline__ void operator()(const f32x4 (&acc)[2][2][4][2], const Unit& u, int wr, int wc, int fr, int fq) const {
        const int row0 = u.pm * BM + wr * 64 + fr, col0 = u.pn * BM + wc * 32 + 4 * fq; float* Cg = C + (size_t)u.aux * gstride;
#pragma unroll
        for (int ai = 0; ai < 2; ++ai)
#pragma unroll
            for (int m = 0; m < 4; ++m) { float* rowp = Cg + (size_t)(row0 + ai * HALF + m * 16) * ldc + col0;
#pragma unroll
                for (int bj = 0; bj < 2; ++bj)
#pragma unroll
                    for (int n = 0; n < 2; ++n) *(f32x4*)(rowp + bj * HALF + n * 16) = acc[ai][bj][m][n]; }
    }
};
struct SwiGlu {
    static constexpr bool PERM = true;
    bf16_t* H; int ldc;
    __device__ __forceinline__ void operator()(const f32x4 (&acc)[2][2][4][2], const Unit& u, int wr, int wc, int fr, int fq) const {
        const int row0 = u.pm * BM + wr * 64 + fr, col0 = u.pn * HALF + wc * 32 + 8 * fq;
#pragma unroll
        for (int ai = 0; ai < 2; ++ai)
#pragma unroll
            for (int m = 0; m < 4; ++m) { bf16_t* rowp = H + (size_t)(row0 + ai * HALF + m * 16) * ldc + col0;
                float o[8];
#pragma unroll
                for (int n = 0; n < 2; ++n)
#pragma unroll
                    for (int e = 0; e < 4; ++e) o[4 * n + e] = siluf_(acc[ai][0][m][n][e]) * acc[ai][1][m][n][e];
                u32x4 w; w.x = cvt_pk_bf16(o[0], o[1]); w.y = cvt_pk_bf16(o[2], o[3]); w.z = cvt_pk_bf16(o[4], o[5]); w.w = cvt_pk_bf16(o[6], o[7]);
                *(u32x4*)rowp = w; }
    }
};
struct MoeDown {
    static constexpr bool PERM = true;
    bf16_t* Y; const int* row_tok;
    __device__ __forceinline__ void operator()(const f32x4 (&acc)[2][2][4][2], const Unit& u, int wr, int wc, int fr, int fq) const {
        const int srow0 = u.aux * BM + wr * 64 + fr, col0 = u.pn * BM + wc * 32 + 8 * fq;
        int dsts[8];
#pragma unroll
        for (int it = 0; it < 8; ++it) dsts[it] = row_tok[srow0 + (it >> 2) * HALF + (it & 3) * 16];
#pragma unroll
        for (int ai = 0; ai < 2; ++ai)
#pragma unroll
            for (int m = 0; m < 4; ++m) { const int dst = dsts[ai * 4 + m];
                if (dst >= 0) { bf16_t* rowp = Y + (size_t)dst * D + col0;
#pragma unroll
                    for (int bj = 0; bj < 2; ++bj) { const f32x4 v0 = acc[ai][bj][m][0], v1 = acc[ai][bj][m][1];
                        u32x4 w; w.x = cvt_pk_bf16(v0[0], v0[1]); w.y = cvt_pk_bf16(v0[2], v0[3]); w.z = cvt_pk_bf16(v1[0], v1[1]); w.w = cvt_pk_bf16(v1[2], v1[3]);
                        *(u32x4*)(rowp + bj * HALF) = w; } } }
    }
};
struct SigmoidBias {
    static constexpr bool PERM = true;
    bf16_t* O; int ldc; const float* bias;
    __device__ __forceinline__ void operator()(const f32x4 (&acc)[2][2][4][2], const Unit& u, int wr, int wc, int fr, int fq) const {
        const int row0 = u.pm * BM + wr * 64 + fr, col0 = u.pn * BM + wc * 32 + 8 * fq;
        f32x4 bv[2][2];
#pragma unroll
        for (int bj = 0; bj < 2; ++bj)
#pragma unroll
            for (int n = 0; n < 2; ++n) bv[bj][n] = *(const f32x4*)(bias + col0 + bj * HALF + 4 * n);
#pragma unroll
        for (int ai = 0; ai < 2; ++ai)
#pragma unroll
            for (int m = 0; m < 4; ++m) { bf16_t* rowp = O + (size_t)(row0 + ai * HALF + m * 16) * ldc + col0;
#pragma unroll
                for (int bj = 0; bj < 2; ++bj) { f32x4 v0 = acc[ai][bj][m][0] + bv[bj][0], v1 = acc[ai][bj][m][1] + bv[bj][1];
#pragma unroll
                    for (int e = 0; e < 4; ++e) { v0[e] = sigmoidf_(v0[e]); v1[e] = sigmoidf_(v1[e]); }
                    u32x4 w; w.x = cvt_pk_bf16(v0[0], v0[1]); w.y = cvt_pk_bf16(v0[2], v0[3]); w.z = cvt_pk_bf16(v1[0], v1[1]); w.w = cvt_pk_bf16(v1[2], v1[3]);
                    *(u32x4*)(rowp + bj * HALF) = w; } }
    }
};
struct MulBf16 {
    static constexpr bool PERM = true;
    bf16_t* O; const bf16_t* G; int ldc;
    __device__ __forceinline__ void operator()(const f32x4 (&acc)[2][2][4][2], const Unit& u, int wr, int wc, int fr, int fq) const {
        const int row0 = u.pm * BM + wr * 64 + fr, col0 = u.pn * BM + wc * 32 + 8 * fq;
        u32x4 gq[2], gn[2];
        { const size_t off = (size_t)row0 * ldc + col0; gn[0] = *(const u32x4*)(G + off); gn[1] = *(const u32x4*)(G + off + HALF); }
#pragma unroll
        for (int it = 0; it < 8; ++it) { const int ai = it >> 2, m = it & 3; const size_t off = (size_t)(row0 + ai * HALF + m * 16) * ldc + col0;
            gq[0] = gn[0]; gq[1] = gn[1];
            if (it < 7) { const int ai2 = (it + 1) >> 2, m2 = (it + 1) & 3; const size_t off2 = (size_t)(row0 + ai2 * HALF + m2 * 16) * ldc + col0; gn[0] = *(const u32x4*)(G + off2); gn[1] = *(const u32x4*)(G + off2 + HALF); }
#pragma unroll
            for (int bj = 0; bj < 2; ++bj) { const f32x4 v0 = acc[ai][bj][m][0], v1 = acc[ai][bj][m][1]; const u32x4 g4 = gq[bj];
                u32x4 w; w.x = cvt_pk_bf16(v0[0] * bflo(g4.x), v0[1] * bfhi(g4.x)); w.y = cvt_pk_bf16(v0[2] * bflo(g4.y), v0[3] * bfhi(g4.y));
                w.z = cvt_pk_bf16(v1[0] * bflo(g4.z), v1[1] * bfhi(g4.z)); w.w = cvt_pk_bf16(v1[2] * bflo(g4.w), v1[3] * bfhi(g4.w));
                *(u32x4*)(O + off + bj * HALF) = w; }
            asm volatile("" ::: "memory"); }
    }
};
struct S5Out {
    static constexpr bool PERM = true;
    bf16_t* ZS5; const bf16_t* Z; const float* dskip;
    __device__ __forceinline__ void operator()(const f32x4 (&acc)[2][2][4][2], const Unit& u, int wr, int wc, int fr, int fq) const {
        const int g = u.aux, row0 = u.pm * BM + wr * 64 + fr;
#pragma unroll
        for (int bj = 0; bj < 2; ++bj) { const int col = u.pn * BM + bj * HALF + wc * 32 + 8 * fq, jo = col >> 4, co0 = col & 15, ch0 = g * 16 + co0;
            const f32x4 d0 = *(const f32x4*)(dskip + ch0), d1 = *(const f32x4*)(dskip + ch0 + 4);
#pragma unroll
            for (int ai = 0; ai < 2; ++ai)
#pragma unroll
                for (int m = 0; m < 4; ++m) { const int mr = row0 + ai * HALF + m * 16; const long tok = (long)(mr >> 7) * SEQ + (mr & 127) * S5LC + jo;
                    const u32x4 uq = *(const u32x4*)(Z + tok * INP + ZS + ch0); const f32x4 v0 = acc[ai][bj][m][0], v1 = acc[ai][bj][m][1];
                    u32x4 w; w.x = cvt_pk_bf16(gelu_tanh(v0[0] + d0[0] * bflo(uq.x)), gelu_tanh(v0[1] + d0[1] * bfhi(uq.x)));
                    w.y = cvt_pk_bf16(gelu_tanh(v0[2] + d0[2] * bflo(uq.y)), gelu_tanh(v0[3] + d0[3] * bfhi(uq.y)));
                    w.z = cvt_pk_bf16(gelu_tanh(v1[0] + d1[0] * bflo(uq.z)), gelu_tanh(v1[1] + d1[1] * bfhi(uq.z)));
                    w.w = cvt_pk_bf16(gelu_tanh(v1[2] + d1[2] * bflo(uq.w)), gelu_tanh(v1[3] + d1[3] * bfhi(uq.w)));
                    *(u32x4*)(ZS5 + tok * 256 + ch0) = w; asm volatile("" ::: "memory"); } }
    }
};
struct S5Glu {
    static constexpr bool PERM = true;
    bf16_t* MIX; const bf16_t* ZS5; const float* bias;
    __device__ __forceinline__ void operator()(const f32x4 (&acc)[2][2][4][2], const Unit& u, int wr, int wc, int fr, int fq) const {
        const int row0 = u.pm * BM + wr * 64 + fr, col0 = wc * 32 + 8 * fq;
#pragma unroll
        for (int bj = 0; bj < 2; ++bj) { const int col = col0 + bj * HALF; const f32x4 b0 = *(const f32x4*)(bias + col), b1 = *(const f32x4*)(bias + col + 4);
#pragma unroll
            for (int ai = 0; ai < 2; ++ai)
#pragma unroll
                for (int m = 0; m < 4; ++m) { const size_t row = (size_t)(row0 + ai * HALF + m * 16); const u32x4 zq = *(const u32x4*)(ZS5 + row * 256 + col);
                    const f32x4 v0 = acc[ai][bj][m][0] + b0, v1 = acc[ai][bj][m][1] + b1;
                    u32x4 w; w.x = cvt_pk_bf16(bflo(zq.x) * sigmoidf_(v0[0]), bfhi(zq.x) * sigmoidf_(v0[1])); w.y = cvt_pk_bf16(bflo(zq.y) * sigmoidf_(v0[2]), bfhi(zq.y) * sigmoidf_(v0[3]));
                    w.z = cvt_pk_bf16(bflo(zq.z) * sigmoidf_(v1[0]), bfhi(zq.z) * sigmoidf_(v1[1])); w.w = cvt_pk_bf16(bflo(zq.w) * sigmoidf_(v1[2]), bfhi(zq.w) * sigmoidf_(v1[3]));
                    *(u32x4*)(MIX + row * 1024 + 768 + col) = w; asm volatile("" ::: "memory"); } }
    }
};
struct EpiWin {
    static constexpr bool PERM = true;
    bf16_t* Z; bf16_t* Q; bf16_t* KV; bf16_t* AP; const f32x2* rope;
    __device__ __forceinline__ void operator()(const f32x4 (&acc)[2][2][4][2], const Unit& u, int wr, int wc, int fr, int fq) const {
        const int row0 = u.pm * BM + wr * 64 + fr;
        if (u.pn >= 5) {
#pragma unroll
            for (int bj = 0; bj < 2; ++bj) { const int col0 = u.pn * BM + bj * HALF + wc * 32 + 8 * fq; const int sc0 = col0 - ZS; const bool s5 = (sc0 >= 0) && (sc0 < 256);
#pragma unroll
                for (int ai = 0; ai < 2; ++ai)
#pragma unroll
                    for (int m = 0; m < 4; ++m) { const int tok = row0 + ai * HALF + m * 16; const f32x4 v0 = acc[ai][bj][m][0], v1 = acc[ai][bj][m][1];
                        u32x4 w; w.x = cvt_pk_bf16(v0[0], v0[1]); w.y = cvt_pk_bf16(v0[2], v0[3]); w.z = cvt_pk_bf16(v1[0], v1[1]); w.w = cvt_pk_bf16(v1[2], v1[3]);
                        *(u32x4*)(Z + (size_t)tok * INP + col0) = w;
                        if (s5) { const int b = tok >> 12, t = tok & 4095; *(u32x4*)(AP + ((size_t)(sc0 >> 4) * 2048 + b * 128 + (t >> 5)) * S5K + (t & 31) * 16 + (sc0 & 15)) = w; } } }
            return;
        }
#pragma unroll
        for (int bj = 0; bj < 2; ++bj) {
            const int colh = bj * HALF + wc * 32 + 8 * fq;
            const int qi = 4 * (wc & 1) + fq, d1 = 4 * qi;
            const bool isv = (u.pn >= 2) && (bj == 1);
            f32x4 cn0 = (f32x4){0.f, 0.f, 0.f, 0.f}, cn1 = cn0;
            if (!isv) { cn0 = *(const f32x4*)(rope + (size_t)row0 * 32 + d1); cn1 = *(const f32x4*)(rope + (size_t)row0 * 32 + d1 + 2); }
#pragma unroll
            for (int it = 0; it < 8; ++it) { const int ai = it >> 2, m = it & 3; const int tok = row0 + ai * HALF + m * 16; const int b = tok >> 12, t = tok & 4095; const f32x4 x1 = acc[ai][bj][m][0], x2 = acc[ai][bj][m][1];
                    if (isv) { bf16_t* dst = KV + (size_t)((u.pn - 2) * 2 + 1) * (8u << 20) + ((size_t)(b * 2 + (wc >> 1)) * SEQ + t) * 64 + 32 * (wc & 1) + 8 * fq;
                        u32x4 w; w.x = cvt_pk_bf16(x1[0], x1[1]); w.y = cvt_pk_bf16(x1[2], x1[3]); w.z = cvt_pk_bf16(x2[0], x2[1]); w.w = cvt_pk_bf16(x2[2], x2[3]); *(u32x4*)dst = w; }
                    else { const f32x4 cs0 = cn0, cs1 = cn1;
                        if (it < 7) { const int tok2 = row0 + ((it + 1) >> 2) * HALF + ((it + 1) & 3) * 16; cn0 = *(const f32x4*)(rope + (size_t)tok2 * 32 + d1); cn1 = *(const f32x4*)(rope + (size_t)tok2 * 32 + d1 + 2); }
                        const float sc = (u.pn < 2) ? QSCALE : 1.0f;
                        const float o10 = (x1[0] * cs0[0] - x2[0] * cs0[1]) * sc, o11 = (x1[1] * cs0[2] - x2[1] * cs0[3]) * sc, o12 = (x1[2] * cs1[0] - x2[2] * cs1[1]) * sc, o13 = (x1[3] * cs1[2] - x2[3] * cs1[3]) * sc;
                        const float o20 = (x2[0] * cs0[0] + x1[0] * cs0[1]) * sc, o21 = (x2[1] * cs0[2] + x1[1] * cs0[3]) * sc, o22 = (x2[2] * cs1[0] + x1[2] * cs1[1]) * sc, o23 = (x2[3] * cs1[2] + x1[3] * cs1[3]) * sc;
                        bf16_t* dst = (u.pn < 2) ? Q + (size_t)tok * 512 + (u.pn * 4 + (colh >> 6)) * 64 + d1
                                                 : KV + (size_t)((u.pn - 2) * 2) * (8u << 20) + ((size_t)(b * 2 + (wc >> 1)) * SEQ + t) * 64 + d1;
                        u32x2 w1, w2; w1.x = cvt_pk_bf16(o10, o11); w1.y = cvt_pk_bf16(o12, o13); w2.x = cvt_pk_bf16(o20, o21); w2.y = cvt_pk_bf16(o22, o23);
                        *(u32x2*)dst = w1; *(u32x2*)(dst + 32) = w2; }
                    asm volatile("" ::: "memory"); }
        }
    }
};
}
constexpr size_t MiB = 1u << 20;
constexpr size_t WS_CTL = 0, CTL_ZERO_BYTES = 1 * MiB;
constexpr size_t WS_SMALL = 1 * MiB;
constexpr size_t SM_APOW = WS_SMALL;
constexpr size_t SM_BBAR = WS_SMALL + 5 * MiB / 4;
constexpr size_t SM_KTAB = WS_SMALL + 2 * MiB;
constexpr size_t SM_CMPB = WS_SMALL + 4 * MiB;
constexpr size_t SM_TOKE = WS_SMALL + 4 * MiB + 256 * 1024;
constexpr size_t SM_TOKW = WS_SMALL + 4 * MiB + 512 * 1024;
constexpr size_t SM_ROWTOK = WS_SMALL + 5 * MiB + 256 * 1024;
constexpr size_t SM_PCNT = WS_SMALL + 6 * MiB;
constexpr size_t SM_TILEEXP = WS_SMALL + 6 * MiB + 16384;
constexpr size_t WS_ROPE = 8 * MiB;
constexpr size_t WS_W = 24 * MiB;
constexpr size_t W_IN = WS_W;
constexpr size_t W_OUT = W_IN + (size_t)INP * D * 2;
constexpr size_t W_GATE = W_OUT + (size_t)D * D * 2;
constexpr size_t W_PROJ = W_GATE + (size_t)D * D * 2;
constexpr size_t W_CMP = W_PROJ + (size_t)D * PLE * 2;
constexpr size_t W_GLU = W_CMP + (size_t)2 * 512 * 1024 * 2;
constexpr size_t W_S5B = W_GLU + (size_t)256 * 256 * 2;
constexpr size_t W_S5S = W_S5B + (size_t)16 * 512 * S5K * 2;
constexpr size_t W_UP = W_S5S + (size_t)16 * 256 * 512 * 2;
constexpr size_t W_DN = W_UP + (size_t)NEXP * 2 * DFE * D * 2;
constexpr size_t W_END_ = W_DN + (size_t)NEXP * D * DFE * 2;
static_assert(W_END_ <= WS_W + 240 * MiB, "weight region");
constexpr size_t WS_XB = 264 * MiB;
constexpr size_t WS_PB = 392 * MiB;
constexpr size_t WS_Z = 424 * MiB;
constexpr size_t WS_QKV = 712 * MiB;
constexpr size_t WS_Q = WS_QKV, WS_KCMP = WS_QKV + 64 * MiB, WS_VCMP = WS_KCMP + 16 * MiB, WS_KSEL = WS_VCMP + 16 * MiB, WS_VSEL = WS_KSEL + 16 * MiB, WS_KWIN = WS_VSEL + 16 * MiB, WS_VWIN = WS_KWIN + 16 * MiB;
constexpr size_t WS_MIX = 872 * MiB;
constexpr size_t WS_CMP = 1000 * MiB;
constexpr size_t WS_CMPP = WS_CMP, WS_KC = WS_CMP + 32 * MiB, WS_VCT = WS_KC + 1 * MiB, WS_SELM = WS_VCT + 1 * MiB;
constexpr size_t WS_S5 = 1036 * MiB;
constexpr size_t WS_S5A = WS_S5, WS_S5S = WS_S5 + 40 * MiB, WS_ZS5 = WS_S5S + 32 * MiB;
constexpr size_t WS_HBUF = 1140 * MiB;
constexpr size_t WS_END = 1268 * MiB;
constexpr size_t WS_FFH = WS_Z, WS_XS = WS_Z, WS_MH = WS_Z + 260 * MiB, WS_YB = WS_MH + 224 * MiB;
static_assert(WS_YB + 256 * MiB <= WS_END && WS_FFH + (size_t)T * DFF * 2 <= WS_MIX, "overlays");
constexpr size_t WS_PLEG = WS_Z, WS_PLEH = WS_Z + 128 * MiB;
static_assert(WS_PLEH + 128 * MiB <= WS_MH, "per-layer-embedding buffers of the MoE layers");
constexpr int CW_BAR = 4096;
constexpr int CW_TMO = 64;
constexpr int CW_CNT = 16384, CNT_BANK = 256 * 64;
static_assert((CW_CNT + 8 * CNT_BANK) * 4 <= (int)CTL_ZERO_BYTES, "panel counters inside the per-call memset");

struct Args { const void* in[36]; float* out; unsigned char* ws; int gp_lo, gp_hi, use_bar, pad; };
struct Frame { LAS unsigned char* lds; int tid, lane, wave, G, bid, own; };
constexpr int RING_BYTES = 131072, LDSCTL_OFF = RING_BYTES, LDS_BYTES = 147456;
typedef __attribute__((address_space(4))) const Args CArgs;
__device__ __forceinline__ void load_args(Args& a) { CArgs* p = (CArgs*)__builtin_amdgcn_kernarg_segment_ptr(); asm volatile("" : "+s"(p)); __builtin_memcpy(&a, p, sizeof(Args)); }
__device__ __forceinline__ Frame make_frame(LAS unsigned char* lds, int wave0) { Frame F; F.lds = lds;
    int w = wave0; asm volatile("" : "+s"(w)); int ln = lane_id_fresh(); F.lane = ln; F.wave = w; F.tid = w * 64 + ln;
    int b = blockIdx.x, g = gridDim.x; asm volatile("" : "+s"(b), "+s"(g)); F.bid = b; F.G = g;
    F.own = (g == 256) ? 32 * (b & 7) + (b >> 3) : b; return F; }

__constant__ double c_invfreq_rev[32] = {0.15915494309189535, 0.11934937021124886, 0.08949940160889101, 0.06711508300522726, 0.050329212104487035, 0.03774158471741977, 0.0283021958306234, 0.02122365276477766, 0.015915494309189534, 0.011934937021124886, 0.008949940160889102, 0.006711508300522725, 0.005032921210448704, 0.003774158471741977, 0.00283021958306234, 0.0021223652764777662, 0.0015915494309189536, 0.0011934937021124885, 0.0008949940160889102, 0.0006711508300522726, 0.0005032921210448703, 0.00037741584717419774, 0.00028302195830623395, 0.0002122365276477766, 0.00015915494309189535, 0.00011934937021124886, 8.949940160889102e-05, 6.711508300522725e-05, 5.0329212104487035e-05, 3.774158471741978e-05, 2.8302195830623396e-05, 2.122365276477766e-05};

__device__ __forceinline__ void sincos_rev(double rev, float& c, float& s) { const double fr = rev - __builtin_floor(rev); const float f = (float)fr; s = __builtin_amdgcn_sinf(f); c = __builtin_amdgcn_cosf(f); }

template <class Sched>
__device__ __forceinline__ void panels_publish_wait(const Frame& F, unsigned* ctl, int bank, const Sched& S, unsigned need) {
    unsigned* cnt = ctl + CW_CNT + bank * CNT_BANK;
    if (F.tid == 0) { pg8::Unit u; for (int i = 0; S.next(i, u); ++i) __hip_atomic_fetch_add(cnt + 64 * u.pm, 1u, __ATOMIC_RELAXED, __HIP_MEMORY_SCOPE_AGENT); }
    if (F.wave == 0) {
        for (int pm = F.own; pm < T / 256; pm += F.G) { unsigned spins = 0;
            while ((unsigned)__builtin_amdgcn_readfirstlane(__hip_atomic_load(cnt + 64 * pm, __ATOMIC_RELAXED, __HIP_MEMORY_SCOPE_AGENT)) < need) {
                __builtin_amdgcn_s_sleep(1);
                if (++spins > (1u << 22)) { if (F.lane == 0) __hip_atomic_store(ctl + CW_TMO, 1u, __ATOMIC_RELAXED, __HIP_MEMORY_SCOPE_AGENT); break; }
                if ((spins & 1023u) == 0u && __builtin_amdgcn_readfirstlane(__hip_atomic_load(ctl + CW_TMO, __ATOMIC_RELAXED, __HIP_MEMORY_SCOPE_AGENT))) break; } }
        __builtin_amdgcn_fence(__ATOMIC_ACQUIRE, "agent");
        asm volatile("s_waitcnt vmcnt(0)" ::: "memory");
    }
    __syncthreads();
}
__device__ __forceinline__ void phase_init0(const Frame& F, const Args& a) {
    const size_t gt = (size_t)F.bid * 512 + F.tid, NT = (size_t)F.G * 512;
    const int* pos = (const int*)a.in[2]; f32x2* rope = (f32x2*)(a.ws + WS_ROPE);
    for (size_t i = gt; i < (size_t)T * 32; i += NT) { const int tok = (int)(i >> 5), k = (int)(i & 31); float c, s; sincos_rev((double)pos[tok] * c_invfreq_rev[k], c, s); rope[i] = (f32x2){c, s}; }
    const float* are = (const float*)a.in[14]; const float* aim = (const float*)a.in[15]; const float* ldt = (const float*)a.in[16];
    const float* bre = (const float*)a.in[17]; const float* bim = (const float*)a.in[18];
    f32x2* apow = (f32x2*)(a.ws + SM_APOW); f32x2* bbar = (f32x2*)(a.ws + SM_BBAR);
    for (size_t i = gt; i < (size_t)DEPTH * 16 * 64 * 34; i += NT) { const int k = (int)(i % 34), lgn = (int)(i / 34), lg = lgn >> 6;
        const float dt = __expf(ldt[lg]); const float ar = are[lgn] * dt; const double rev = (double)k * ((double)aim[lgn] * (double)dt) * 0.15915494309189535;
        float c, s; sincos_rev(rev, c, s); const float mg = __expf((float)k * ar); apow[i] = (f32x2){mg * c, mg * s}; }
    for (size_t i = gt; i < (size_t)DEPTH * 16 * 64 * 16; i += NT) { const int lgn = (int)(i >> 4), lg = lgn >> 6;
        const float dt = __expf(ldt[lg]); const float lr = are[lgn], li = aim[lgn]; const double rev = ((double)li * (double)dt) * 0.15915494309189535;
        float c, s; sincos_rev(rev, c, s); const float mg = __expf(lr * dt); const float abr = mg * c, abi = mg * s, den = lr * lr + li * li;
        const float cr = ((abr - 1.0f) * lr + abi * li) / den, ci = (abi * lr - (abr - 1.0f) * li) / den;
        const float br = bre[i], bi = bim[i]; bbar[i] = (f32x2){cr * br - ci * bi, cr * bi + ci * br}; }
    const f32x4* x4 = (const f32x4*)a.in[0]; u32x2* xb = (u32x2*)(a.ws + WS_XB);
    for (size_t i = gt; i < (size_t)T * D / 4; i += 4 * NT) { f32x4 v[4];
#pragma unroll
        for (int q = 0; q < 4; ++q) { const size_t ii = i + q * NT; v[q] = (ii < (size_t)T * D / 4) ? x4[ii] : (f32x4){0.f, 0.f, 0.f, 0.f}; }
#pragma unroll
        for (int q = 0; q < 4; ++q) { const size_t ii = i + q * NT; if (ii < (size_t)T * D / 4) { u32x2 w; w.x = cvt_pk_bf16(v[q][0], v[q][1]); w.y = cvt_pk_bf16(v[q][2], v[q][3]); xb[ii] = w; } } }
}
__device__ __forceinline__ void phase_init1(const Frame& F, const Args& a) {
    const size_t gt = (size_t)F.bid * 512 + F.tid, NT = (size_t)F.G * 512;
    const float* cre = (const float*)a.in[19]; const float* cim = (const float*)a.in[20];
    const f32x2* apow = (const f32x2*)(a.ws + SM_APOW); const f32x2* bbar = (const f32x2*)(a.ws + SM_BBAR); float* ktab = (float*)(a.ws + SM_KTAB);
    for (size_t i = gt; i < (size_t)DEPTH * 16 * 32 * 256; i += NT) { const int ci = (int)(i & 15), co = (int)((i >> 4) & 15), tau = (int)((i >> 8) & 31), lg = (int)(i >> 13);
        float acc = 0.f;
        for (int n = 0; n < 64; ++n) { const f32x2 P = apow[((size_t)lg * 64 + n) * 34 + tau], Bb = bbar[((size_t)lg * 64 + n) * 16 + ci]; const float cr = cre[((size_t)lg * 16 + co) * 64 + n], cm = cim[((size_t)lg * 16 + co) * 64 + n];
            const float hr = P.x * Bb.x - P.y * Bb.y, hi = P.x * Bb.y + P.y * Bb.x; acc += cr * hr - cm * hi; }
        ktab[i] = acc; }
}

__device__ __forceinline__ void transpose_item(const float* W, int ldw, int k0, int n0, int nvalid, bf16_t* dstrow, int dst_ld, LAS float* scr, int lane, int permhi) {
    float tv[32];
#pragma unroll
    for (int i = 0; i < 32; ++i) { const int kk = 2 * i + (lane >> 5), nn = lane & 31; tv[i] = (nn < nvalid) ? W[(size_t)(k0 + kk) * ldw + n0 + nn] : 0.f; }
#pragma unroll
    for (int i = 0; i < 32; ++i) { const int kk = 2 * i + (lane >> 5), nn = lane & 31; scr[kk * 33 + nn] = tv[i]; }
    LDS_WAIT(); asm volatile("" ::: "memory");
    const int c = lane & 7;
#pragma unroll
    for (int j = 0; j < 4; ++j) { const int n = (lane >> 3) + 8 * j; const LAS float* s = scr + (8 * c) * 33 + n;
        u32x4 o; o.x = cvt_pk_bf16(s[0 * 33], s[1 * 33]); o.y = cvt_pk_bf16(s[2 * 33], s[3 * 33]); o.z = cvt_pk_bf16(s[4 * 33], s[5 * 33]); o.w = cvt_pk_bf16(s[6 * 33], s[7 * 33]);
        const int drow = permhi < 0 ? n : (8 * (n >> 2) + 4 * permhi + (n & 3));
        if (n < nvalid) *(u32x4*)(dstrow + (size_t)drow * dst_ld + 8 * c) = o; }
    LDS_WAIT(); asm volatile("" ::: "memory");
}
__device__ __forceinline__ void transpose_mat(const float* W, int K, int N, bf16_t* dst, int dst_ld, int mode, LAS float* scr, int lane, int& cursor, int gw, int NGW) {
    const int nblk = (N + 31) / 32, items = (K / 64) * nblk;
    int it = ((gw - cursor) % NGW + NGW) % NGW;
    for (; it < items; it += NGW) { const int kb = it / nblk, nb = it % nblk, k0 = 64 * kb, n0 = 32 * nb; const int nv = (N - n0) < 32 ? (N - n0) : 32;
        int drow = n0, permhi = -1;
        if (mode == 1 || mode == 2) drow = (n0 >> 7) * 256 + (n0 & 127) + (mode == 2 ? 128 : 0);
        if (mode == 3 && (n0 < 512 || (n0 < 1280 && (((n0 - 512) >> 7) & 1) == 0))) { drow = n0 & ~63; permhi = (n0 >> 5) & 1; }
        transpose_item(W, N, k0, n0, nv, dst + (size_t)drow * dst_ld + k0, dst_ld, scr, lane, permhi); }
    cursor = (cursor + items) % NGW;
}

__device__ __forceinline__ void phase_prep(const Frame& F, const Args& a, int l) {
    LAS float* scr = (LAS float*)(F.lds + F.wave * 16384);
    const int gw = F.bid * 8 + F.wave, NGW = F.G * 8; int cursor = 0;
    unsigned char* ws = a.ws;
    transpose_mat((const float*)a.in[3] + (size_t)l * D * INW, D, INW, (bf16_t*)(ws + W_IN), D, 3, scr, F.lane, cursor, gw, NGW);
    transpose_mat((const float*)a.in[4] + (size_t)l * D * D, D, D, (bf16_t*)(ws + W_OUT), D, 0, scr, F.lane, cursor, gw, NGW);
    transpose_mat((const float*)a.in[31] + (size_t)l * D * D, D, D, (bf16_t*)(ws + W_GATE), D, 0, scr, F.lane, cursor, gw, NGW);
    transpose_mat((const float*)a.in[33] + (size_t)l * PLE * D, PLE, D, (bf16_t*)(ws + W_PROJ), PLE, 0, scr, F.lane, cursor, gw, NGW);
    for (int j = 0; j < 2; ++j) { const float* w1 = (const float*)a.in[6] + ((size_t)l * 2 + j) * 2048 * 256; bf16_t* dst = (bf16_t*)(ws + W_CMP) + (size_t)j * 512 * 1024;
        transpose_mat(w1, 1024, 256, dst, 1024, 0, scr, F.lane, cursor, gw, NGW);
        transpose_mat(w1 + (size_t)1024 * 256, 1024, 256, dst + (size_t)256 * 1024, 1024, 0, scr, F.lane, cursor, gw, NGW); }
    transpose_mat((const float*)a.in[22] + (size_t)l * 256 * 256, 256, 256, (bf16_t*)(ws + W_GLU), 256, 0, scr, F.lane, cursor, gw, NGW);
    const int j2 = l >> 1;
    if ((l & 1) == 0) {
        transpose_mat((const float*)a.in[24] + (size_t)j2 * D * DFF, D, DFF, (bf16_t*)(ws + W_UP), D, 1, scr, F.lane, cursor, gw, NGW);
        transpose_mat((const float*)a.in[25] + (size_t)j2 * D * DFF, D, DFF, (bf16_t*)(ws + W_UP), D, 2, scr, F.lane, cursor, gw, NGW);
        transpose_mat((const float*)a.in[26] + (size_t)j2 * DFF * D, DFF, D, (bf16_t*)(ws + W_DN), DFF, 0, scr, F.lane, cursor, gw, NGW);
    } else {
        for (int e = 0; e < NEXP; ++e) { const size_t eo = (size_t)j2 * NEXP + e;
            transpose_mat((const float*)a.in[28] + eo * D * DFE, D, DFE, (bf16_t*)(ws + W_UP) + (size_t)e * 2 * DFE * D, D, 1, scr, F.lane, cursor, gw, NGW);
            transpose_mat((const float*)a.in[29] + eo * D * DFE, D, DFE, (bf16_t*)(ws + W_UP) + (size_t)e * 2 * DFE * D, D, 2, scr, F.lane, cursor, gw, NGW);
            transpose_mat((const float*)a.in[30] + eo * DFE * D, DFE, D, (bf16_t*)(ws + W_DN) + (size_t)e * D * DFE, DFE, 0, scr, F.lane, cursor, gw, NGW); }
    }
    const size_t gt = (size_t)F.bid * 512 + F.tid, NT = (size_t)F.G * 512;
    {
        u32x4* zp = (u32x4*)((bf16_t*)(ws + W_IN) + (size_t)INW * D); const size_t n16 = (size_t)(INP - INW) * D * 2 / 16;
        unsigned zz = 0u; asm volatile("" : "+v"(zz));
        for (size_t i = gt; i < n16; i += NT) zp[i] = (u32x4){zz, zz, zz, zz};
    }
    {
        const f32x4* p4 = (const f32x4*)((const float*)a.in[1] + (size_t)l * T * PLE); u32x2* pb = (u32x2*)(ws + WS_PB);
        for (size_t i = gt; i < (size_t)T * PLE / 4; i += 4 * NT) { f32x4 v[4];
#pragma unroll
            for (int q = 0; q < 4; ++q) { const size_t ii = i + q * NT; v[q] = (ii < (size_t)T * PLE / 4) ? p4[ii] : (f32x4){0.f, 0.f, 0.f, 0.f}; }
#pragma unroll
            for (int q = 0; q < 4; ++q) { const size_t ii = i + q * NT; if (ii < (size_t)T * PLE / 4) { u32x2 w; w.x = cvt_pk_bf16(v[q][0], v[q][1]); w.y = cvt_pk_bf16(v[q][2], v[q][3]); pb[ii] = w; } } }
    }
    {
        const float* ktab = (const float*)(ws + SM_KTAB) + (size_t)l * 16 * 32 * 256; const f32x2* apow = (const f32x2*)(ws + SM_APOW) + (size_t)l * 16 * 64 * 34; const f32x2* bbar = (const f32x2*)(ws + SM_BBAR) + (size_t)l * 16 * 64 * 16;
        const float* cre = (const float*)a.in[19] + (size_t)l * 16 * 16 * 64; const float* cim = (const float*)a.in[20] + (size_t)l * 16 * 16 * 64;
        bf16_t* Bt = (bf16_t*)(ws + W_S5B);
        for (size_t i = gt; i < (size_t)16 * 512 * S5K; i += NT) { const int k = (int)(i % S5K), row = (int)((i / S5K) & 511), g = (int)(i / ((size_t)S5K * 512)); const int jo = row >> 4, co = row & 15;
            float v;
            if (k < 512) { const int ji = k >> 4, ci = k & 15; v = (jo >= ji) ? ktab[(((size_t)g * 32 + (jo - ji)) * 16 + co) * 16 + ci] : 0.f; }
            else { const int n = (k - 512) & 63; const f32x2 P = apow[((size_t)g * 64 + n) * 34 + jo + 1]; const float cr = cre[((size_t)g * 16 + co) * 64 + n], cm = cim[((size_t)g * 16 + co) * 64 + n];
                v = (k < 576) ? (cr * P.x - cm * P.y) : -(cr * P.y + cm * P.x); }
            Bt[i] = f2bf(v); }
        bf16_t* St = (bf16_t*)(ws + W_S5S);
        for (size_t i = gt; i < (size_t)16 * 256 * 512; i += NT) { const int k = (int)(i & 511), np = (int)((i >> 9) & 255), g = (int)(i >> 17); const int j = k >> 4, ci = k & 15;
            float v = 0.f;
            if (np < 128) { const int n = np & 63; const f32x2 P = apow[((size_t)g * 64 + n) * 34 + (S5LC - 1 - j)], Bb = bbar[((size_t)g * 64 + n) * 16 + ci]; v = (np < 64) ? (P.x * Bb.x - P.y * Bb.y) : (P.x * Bb.y + P.y * Bb.x); }
            St[i] = f2bf(v); }
    }
    {
        float* cb = (float*)(ws + SM_CMPB); LAS float* red = (LAS float*)(F.lds + 8 * 16384 - 4096);
        for (int o = F.bid; o < 8; o += F.G) { const int j = o >> 2, cblk = o & 3; const float* w1 = (const float*)a.in[6] + ((size_t)l * 2 + j) * 2048 * 256 + cblk * 64 + F.lane; const float* pe = (const float*)a.in[5] + ((size_t)l * 2 + j) * 2048;
            float s0 = 0.f, s1 = 0.f, s2 = 0.f, s3 = 0.f;
#pragma unroll 4
            for (int k = 256 * F.wave; k < 256 * F.wave + 256; k += 4) { s0 += pe[k] * w1[(size_t)k * 256]; s1 += pe[k + 1] * w1[(size_t)(k + 1) * 256]; s2 += pe[k + 2] * w1[(size_t)(k + 2) * 256]; s3 += pe[k + 3] * w1[(size_t)(k + 3) * 256]; }
            __syncthreads(); red[F.wave * 64 + F.lane] = (s0 + s1) + (s2 + s3); __syncthreads();
            if (F.wave == 0) { float t = ((const float*)a.in[7])[((size_t)l * 2 + j) * 256 + cblk * 64 + F.lane];
#pragma unroll
                for (int w = 0; w < 8; ++w) t += red[w * 64 + F.lane];
                cb[j * 256 + cblk * 64 + F.lane] = t; }
            __syncthreads(); }
    }
}

__device__ __forceinline__ void conv_items(const Frame& F, const Args& a, int l, int first, int stride, int last = NB * (SEQ / 32)) {
    const bf16_t* z = (const bf16_t*)(a.ws + WS_Z); bf16_t* mix = (bf16_t*)(a.ws + WS_MIX);
    const float* cw = (const float*)a.in[10] + (size_t)l * 31 * 256; const float* cb = (const float*)a.in[11] + (size_t)l * 256;
    const float* lg = (const float*)a.in[12] + (size_t)l * 256; const float* lb = (const float*)a.in[13] + (size_t)l * 256;
    LAS float* U = (LAS float*)F.lds;
    LAS float* Y = (LAS float*)(F.lds + 65536);
    const int cp = F.tid & 127, tg = F.tid >> 7, c = 2 * cp;
    f32x2 w[31];
#pragma unroll
    for (int j = 0; j < 31; ++j) w[j] = *(const f32x2*)(cw + j * 256 + c);
    const f32x2 bias = *(const f32x2*)(cb + c);
    unsigned pva[16], pvg[16];
    auto fetch = [&](int it) { const int b = it >> 7, t0 = (it & 127) * 32;
#pragma unroll
        for (int q = 0; q < 16; ++q) { const int r = tg + 4 * q, t = t0 - 30 + r; pva[q] = 0u; pvg[q] = 0u;
            if (r < 62 && t >= 0) { const bf16_t* zr = z + ((size_t)b * SEQ + t) * INP + ZC; pva[q] = *(const unsigned*)(zr + c); pvg[q] = *(const unsigned*)(zr + 256 + c); } } };
    if (first < last) fetch(first);
    for (int it = first; it < last; it += stride) { const int b = it >> 7, t0 = (it & 127) * 32;
#pragma unroll
        for (int q = 0; q < 16; ++q) { const int r = tg + 4 * q, t = t0 - 30 + r;
            if (r < 62) { f32x2 u = (f32x2){0.f, 0.f}; if (t >= 0) u = (f32x2){bflo(pva[q]) * sigmoidf_(bflo(pvg[q])), bfhi(pva[q]) * sigmoidf_(bfhi(pvg[q]))};
                *(LAS f32x2*)(U + r * 256 + c) = u; } }
        if (it + stride < last) fetch(it + stride);
        __syncthreads();
        {   f32x2 acc[8];
#pragma unroll
            for (int i = 0; i < 8; ++i) acc[i] = bias;
#pragma unroll
            for (int k = 0; k < 38; ++k) { const f32x2 u = *(const LAS f32x2*)(U + (tg * 8 + k) * 256 + c);
#pragma unroll
                for (int i = 0; i < 8; ++i) { const int j = k - i; if (j >= 0 && j < 31) acc[i] += w[j] * u; } }
#pragma unroll
            for (int i = 0; i < 8; ++i) *(LAS f32x2*)(Y + (tg * 8 + i) * 256 + c) = acc[i];
        }
        __syncthreads();
        for (int i = 0; i < 4; ++i) { const int tl = F.wave * 4 + i; const f32x4 v = *(const LAS f32x4*)(Y + tl * 256 + F.lane * 4);
            const float mean = wave_sum((v[0] + v[1]) + (v[2] + v[3])) * (1.f / 256.f); const f32x4 dlt = v - mean;
            const float var = wave_sum((dlt[0] * dlt[0] + dlt[1] * dlt[1]) + (dlt[2] * dlt[2] + dlt[3] * dlt[3])) * (1.f / 256.f); const float rstd = 1.0f / sqrtf(var + LN_EPS);
            const f32x4 gg = *(const f32x4*)(lg + F.lane * 4), bb = *(const f32x4*)(lb + F.lane * 4);
            float o[4];
#pragma unroll
            for (int e = 0; e < 4; ++e) o[e] = siluf_(dlt[e] * rstd * gg[e] + bb[e]);
            u32x2 wv; wv.x = cvt_pk_bf16(o[0], o[1]); wv.y = cvt_pk_bf16(o[2], o[3]);
            *(u32x2*)(mix + ((size_t)b * SEQ + t0 + tl) * 1024 + 512 + F.lane * 4) = wv; }
        __syncthreads();
    }
}
__device__ __forceinline__ void cmp_stage2(const Frame& F, const Args& a, int l) {
    unsigned char* ws = a.ws; const float* cb = (const float*)(ws + SM_CMPB);
    LAS float* w2s = (LAS float*)F.lds;
    LAS float* hs = (LAS float*)(F.lds + 65536 + F.wave * 1024);
    const int gw = F.bid * 8 + F.wave, NGW = F.G * 8, lane = F.lane;
    for (int j = 0; j < 2; ++j) {
        const float* w2 = (const float*)a.in[8] + ((size_t)l * 2 + j) * 256 * 64; const float* b2 = (const float*)a.in[9] + ((size_t)l * 2 + j) * 64;
        __syncthreads();
        for (int i = F.tid; i < 256 * 64 / 4; i += 512) *(LAS f32x4*)(w2s + 4 * i) = *(const f32x4*)(w2 + 4 * i);
        __syncthreads();
        for (int it = gw; it < 32 * 256; it += NGW) { const int bh = it >> 8, n = it & 255;
            float outv = 0.f;
            if (n < NCMP) {
                const float* P = (const float*)(ws + WS_CMPP) + (size_t)j * 8192 * 512 + ((size_t)bh * 256 + n) * 512;
                const f32x4 p0 = *(const f32x4*)(P + lane * 4), p1 = *(const f32x4*)(P + 512 + 256 + lane * 4), bb = *(const f32x4*)(cb + j * 256 + lane * 4);
                f32x4 hv;
#pragma unroll
                for (int e = 0; e < 4; ++e) hv[e] = gelu_tanh(p0[e] + p1[e] + bb[e]);
                *(LAS f32x4*)(hs + lane * 4) = hv; LDS_WAIT(); asm volatile("" ::: "memory");
                float acc0 = b2[lane], acc1 = 0.f, acc2 = 0.f, acc3 = 0.f;
#pragma unroll 4
                for (int c = 0; c < 256; c += 4) { const f32x4 h4 = *(const LAS f32x4*)(hs + c);
                    acc0 += h4[0] * w2s[c * 64 + lane]; acc1 += h4[1] * w2s[(c + 1) * 64 + lane]; acc2 += h4[2] * w2s[(c + 2) * 64 + lane]; acc3 += h4[3] * w2s[(c + 3) * 64 + lane]; }
                outv = (acc0 + acc1) + (acc2 + acc3); LDS_WAIT(); asm volatile("" ::: "memory");
            }
            if (j == 0) ((bf16_t*)(ws + WS_KC))[((size_t)bh * 256 + n) * 64 + lane] = f2bf(outv);
            else ((bf16_t*)(ws + WS_VCT))[((size_t)bh * 4 + (n >> 6)) * 4096 + lane * 64 + nsa::vslot(n & 63)] = f2bf(outv);
        }
    }
    __syncthreads();
}
__device__ __forceinline__ void cmp_stage2_panel(const Frame& F, const Args& a, int l, int j, int bh) {
    constexpr int HP = 528;
    unsigned char* ws = a.ws; const float* cb = (const float*)(ws + SM_CMPB);
    LAS unsigned char* Hs = F.lds;
    LAS unsigned char* Ws = F.lds + 128 * HP;
    const int lane = F.lane, w = F.wave;
    const float* w2 = (const float*)a.in[8] + ((size_t)l * 2 + j) * 256 * 64; const float* b2 = (const float*)a.in[9] + ((size_t)l * 2 + j) * 64;
    const float* Pb = (const float*)(ws + WS_CMPP) + (size_t)j * 8192 * 512 + (size_t)bh * 256 * 512;
    __syncthreads();
    for (int i = F.tid; i < 256 * 64; i += 512) { const int c = i >> 6, d = i & 63; *(LAS bf16_t*)(Ws + d * HP + c * 2) = f2bf(w2[i]); }
    const f32x4 bb = *(const f32x4*)(cb + j * 256 + lane * 4);
    for (int half = 0; half < 2; ++half) {
        __syncthreads();
#pragma unroll 4
        for (int rr = 0; rr < 16; ++rr) { const int r = 16 * w + rr, n = half * 128 + r, n1 = n < 255 ? n + 1 : n;
            const f32x4 p0 = *(const f32x4*)(Pb + (size_t)n * 512 + lane * 4), p1 = *(const f32x4*)(Pb + (size_t)n1 * 512 + 256 + lane * 4);
            u32x2 hv; hv.x = cvt_pk_bf16(gelu_tanh(p0[0] + p1[0] + bb[0]), gelu_tanh(p0[1] + p1[1] + bb[1])); hv.y = cvt_pk_bf16(gelu_tanh(p0[2] + p1[2] + bb[2]), gelu_tanh(p0[3] + p1[3] + bb[3]));
            *(LAS u32x2*)(Hs + r * HP + lane * 8) = hv; }
        __syncthreads();
        f32x4 acc[4];
#pragma unroll
        for (int cbk = 0; cbk < 4; ++cbk) acc[cbk] = (f32x4){0.f, 0.f, 0.f, 0.f};
        const LAS unsigned char* ap = Hs + (16 * w + (lane & 15)) * HP + (lane >> 4) * 16;
        const LAS unsigned char* bp = Ws + (lane & 15) * HP + (lane >> 4) * 16;
#pragma unroll
        for (int ks = 0; ks < 8; ++ks) { const bf16x8 af = *(const LAS bf16x8*)(ap + ks * 64);
#pragma unroll
            for (int cbk = 0; cbk < 4; ++cbk) { const bf16x8 bf = *(const LAS bf16x8*)(bp + cbk * 16 * HP + ks * 64); acc[cbk] = __builtin_amdgcn_mfma_f32_16x16x32_bf16(af, bf, acc[cbk], 0, 0, 0); } }
#pragma unroll
        for (int cbk = 0; cbk < 4; ++cbk) { const int d = 16 * cbk + (lane & 15); const float bv = b2[d];
#pragma unroll
            for (int e = 0; e < 4; ++e) { const int n = half * 128 + 16 * w + 4 * (lane >> 4) + e; const float outv = n < NCMP ? acc[cbk][e] + bv : 0.f;
                if (j == 0) ((bf16_t*)(ws + WS_KC))[((size_t)bh * 256 + n) * 64 + d] = f2bf(outv);
                else ((bf16_t*)(ws + WS_VCT))[((size_t)bh * 4 + (n >> 6)) * 4096 + d * 64 + nsa::vslot(n & 63)] = f2bf(outv); } }
    }
    __syncthreads();
}
__device__ __forceinline__ void s5_carry_panel(const Frame& F, const Args& a, int l, int g, int pm) {
    unsigned char* ws = a.ws; const f32x2* apow = (const f32x2*)(ws + SM_APOW) + (size_t)l * 16 * 64 * 34;
    const float* S = (const float*)(ws + WS_S5S); bf16_t* ap = (bf16_t*)(ws + WS_S5A);
    if (F.tid < 128) { const int n = F.tid & 63, b = 2 * pm + (F.tid >> 6);
        const f32x2 A = apow[((size_t)g * 64 + n) * 34 + S5LC]; float hr = 0.f, hi = 0.f;
        const float* sp = S + ((size_t)g * 2048 + b * 128) * 256 + n; bf16_t* dp = ap + ((size_t)g * 2048 + b * 128) * S5K + 512 + n;
        float nr_[16], ni_[16];
#pragma unroll
        for (int k = 0; k < 16; ++k) { nr_[k] = sp[(size_t)k * 256]; ni_[k] = sp[(size_t)k * 256 + 64]; }
        for (int c0 = 0; c0 < S5NCH; c0 += 16) { float sr[16], si[16];
#pragma unroll
            for (int k = 0; k < 16; ++k) { sr[k] = nr_[k]; si[k] = ni_[k]; }
            if (c0 + 16 < S5NCH) {
#pragma unroll
                for (int k = 0; k < 16; ++k) { nr_[k] = sp[(size_t)(c0 + 16 + k) * 256]; ni_[k] = sp[(size_t)(c0 + 16 + k) * 256 + 64]; } }
#pragma unroll
            for (int k = 0; k < 16; ++k) { dp[(size_t)(c0 + k) * S5K] = f2bf(hr); dp[(size_t)(c0 + k) * S5K + 64] = f2bf(hi);
                const float nr = A.x * hr - A.y * hi + sr[k], ni = A.x * hi + A.y * hr + si[k]; hr = nr; hi = ni; } }
    }
}
__device__ __forceinline__ void s5_carry(const Frame& F, const Args& a, int l) {
    unsigned char* ws = a.ws; const f32x2* apow = (const f32x2*)(ws + SM_APOW) + (size_t)l * 16 * 64 * 34;
    const float* S = (const float*)(ws + WS_S5S); bf16_t* ap = (bf16_t*)(ws + WS_S5A);
    const int gt = F.bid * 512 + F.tid, NT = F.G * 512;
    for (int i = gt; i < 16 * NB * 64; i += NT) { const int n = i & 63, b = (i >> 6) & 15, g = i >> 10;
        const f32x2 A = apow[((size_t)g * 64 + n) * 34 + S5LC]; float hr = 0.f, hi = 0.f;
        const float* sp = S + ((size_t)g * 2048 + b * 128) * 256 + n; bf16_t* dp = ap + ((size_t)g * 2048 + b * 128) * S5K + 512 + n;
        float nr_[16], ni_[16];
#pragma unroll
        for (int k = 0; k < 16; ++k) { nr_[k] = sp[(size_t)k * 256]; ni_[k] = sp[(size_t)k * 256 + 64]; }
        for (int c0 = 0; c0 < S5NCH; c0 += 16) { float sr[16], si[16];
#pragma unroll
            for (int k = 0; k < 16; ++k) { sr[k] = nr_[k]; si[k] = ni_[k]; }
            if (c0 + 16 < S5NCH) {
#pragma unroll
                for (int k = 0; k < 16; ++k) { nr_[k] = sp[(size_t)(c0 + 16 + k) * 256]; ni_[k] = sp[(size_t)(c0 + 16 + k) * 256 + 64]; } }
#pragma unroll
            for (int k = 0; k < 16; ++k) { dp[(size_t)(c0 + k) * S5K] = f2bf(hr); dp[(size_t)(c0 + k) * S5K + 64] = f2bf(hi);
                const float nr = A.x * hr - A.y * hi + sr[k], ni = A.x * hi + A.y * hr + si[k]; hr = nr; hi = ni; } }
    }
}
template <int MODE, bool ROUTE, bool FINAL>
__device__ __forceinline__ void ln_panel(const Frame& F, const Args& a, int pm, const float* gain, const float* beta, const float* router, size_t h_off = WS_HBUF) {
    unsigned char* ws = a.ws; float* xout = a.out; bf16_t* xb = (bf16_t*)(ws + WS_XB);
    const bf16_t* hb = (const bf16_t*)(ws + (MODE == 0 ? h_off : WS_YB)); const f32x2* tokw = (const f32x2*)(ws + SM_TOKW);
    LAS int* cnt = (LAS int*)F.lds;
    const int lane = F.lane;
    f32x4 gv[4], bv[4];
#pragma unroll
    for (int j = 0; j < 2; ++j) { gv[2 * j] = *(const f32x4*)(gain + 8 * lane + 512 * j); gv[2 * j + 1] = *(const f32x4*)(gain + 8 * lane + 512 * j + 4); bv[2 * j] = *(const f32x4*)(beta + 8 * lane + 512 * j); bv[2 * j + 1] = *(const f32x4*)(beta + 8 * lane + 512 * j + 4); }
    if (ROUTE) { if (F.tid < 8) cnt[F.tid] = 0; __syncthreads(); }
    u32x4 nx[2], nh0[2], nh1[2]; f32x2 nw = (f32x2){0.f, 0.f};
    { const size_t row = (size_t)pm * 256 + F.wave * 32; if (MODE == 1) nw = tokw[row];
#pragma unroll
      for (int j = 0; j < 2; ++j) { nx[j] = *(const u32x4*)(xb + row * D + 8 * lane + 512 * j);
          if (MODE == 0) { nh0[j] = *(const u32x4*)(hb + row * D + 8 * lane + 512 * j); nh1[j] = nh0[j]; } else { nh0[j] = *(const u32x4*)(hb + (2 * row) * D + 8 * lane + 512 * j); nh1[j] = *(const u32x4*)(hb + (2 * row + 1) * D + 8 * lane + 512 * j); } } }
    for (int i = 0; i < 32; ++i) { const size_t row = (size_t)pm * 256 + F.wave * 32 + i;
        f32x4 v[4]; float s = 0.f;
        u32x4 cx[2], ch0[2], ch1[2]; const f32x2 w01 = nw;
#pragma unroll
        for (int j = 0; j < 2; ++j) { cx[j] = nx[j]; ch0[j] = nh0[j]; ch1[j] = nh1[j]; }
        if (i < 31) { const size_t rn = row + 1; if (MODE == 1) nw = tokw[rn];
#pragma unroll
            for (int j = 0; j < 2; ++j) { nx[j] = *(const u32x4*)(xb + rn * D + 8 * lane + 512 * j);
                if (MODE == 0) { nh0[j] = *(const u32x4*)(hb + rn * D + 8 * lane + 512 * j); nh1[j] = nh0[j]; } else { nh0[j] = *(const u32x4*)(hb + (2 * rn) * D + 8 * lane + 512 * j); nh1[j] = *(const u32x4*)(hb + (2 * rn + 1) * D + 8 * lane + 512 * j); } } }
#pragma unroll
        for (int jj = 0; jj < 4; ++jj) { const int j = jj >> 1, hf = jj & 1;
            const unsigned xq0 = hf ? cx[j].z : cx[j].x, xq1 = hf ? cx[j].w : cx[j].y; const f32x4 xv = (f32x4){bflo(xq0), bfhi(xq0), bflo(xq1), bfhi(xq1)}; f32x4 hv;
            const unsigned q00 = hf ? ch0[j].z : ch0[j].x, q01 = hf ? ch0[j].w : ch0[j].y;
            if (MODE == 0) hv = (f32x4){bflo(q00), bfhi(q00), bflo(q01), bfhi(q01)};
            else { const unsigned q10 = hf ? ch1[j].z : ch1[j].x, q11 = hf ? ch1[j].w : ch1[j].y;
                hv = (f32x4){w01.x * bflo(q00) + w01.y * bflo(q10), w01.x * bfhi(q00) + w01.y * bfhi(q10), w01.x * bflo(q01) + w01.y * bflo(q11), w01.x * bfhi(q01) + w01.y * bfhi(q11)}; }
            v[jj] = xv * ALPHA + hv; s += (v[jj][0] + v[jj][1]) + (v[jj][2] + v[jj][3]); }
        const float mean = wave_sum(s) * (1.f / D); float s2 = 0.f;
#pragma unroll
        for (int j = 0; j < 4; ++j) { v[j] = v[j] - mean; s2 += (v[j][0] * v[j][0] + v[j][1] * v[j][1]) + (v[j][2] * v[j][2] + v[j][3] * v[j][3]); }
        const float rstd = 1.0f / sqrtf(wave_sum(s2) * (1.f / D) + LN_EPS);
#pragma unroll
        for (int j = 0; j < 4; ++j) v[j] = v[j] * rstd * gv[j] + bv[j];
#pragma unroll
        for (int j = 0; j < 2; ++j) {
            if (FINAL) { *(f32x4*)(xout + row * D + 8 * lane + 512 * j) = v[2 * j]; *(f32x4*)(xout + row * D + 8 * lane + 512 * j + 4) = v[2 * j + 1]; }
            u32x4 w; w.x = cvt_pk_bf16(v[2 * j][0], v[2 * j][1]); w.y = cvt_pk_bf16(v[2 * j][2], v[2 * j][3]); w.z = cvt_pk_bf16(v[2 * j + 1][0], v[2 * j + 1][1]); w.w = cvt_pk_bf16(v[2 * j + 1][2], v[2 * j + 1][3]);
            *(u32x4*)(xb + row * D + 8 * lane + 512 * j) = w; }
        if (ROUTE) {
            float lg[8];
#pragma unroll
            for (int e = 0; e < 8; ++e) lg[e] = 0.f;
#pragma unroll
            for (int jj = 0; jj < 4; ++jj)
#pragma unroll
                for (int k = 0; k < 4; ++k) { const float* rr = router + (size_t)(8 * lane + 512 * (jj >> 1) + 4 * (jj & 1) + k) * 8; const f32x4 r0 = *(const f32x4*)rr, r1 = *(const f32x4*)(rr + 4); const float xv = v[jj][k];
                    lg[0] += xv * r0[0]; lg[1] += xv * r0[1]; lg[2] += xv * r0[2]; lg[3] += xv * r0[3]; lg[4] += xv * r1[0]; lg[5] += xv * r1[1]; lg[6] += xv * r1[2]; lg[7] += xv * r1[3]; }
            {
                const bool h3 = (lane & 8) != 0;
                float r4[4], r2[2], r1;
#pragma unroll
                for (int i = 0; i < 4; ++i) r4[i] = swapsum32(lg[i], lg[4 + i]);
#pragma unroll
                for (int i = 0; i < 2; ++i) r2[i] = swapsum16(r4[i], r4[2 + i]);
                { const float send = h3 ? r2[0] : r2[1], mine = h3 ? r2[1] : r2[0]; r1 = mine + xshfl<8>(send); }
                r1 += xshfl<1>(r1); r1 += xshfl<2>(r1); r1 += dpp_half_mirror(r1);
#pragma unroll
                for (int e = 0; e < 8; ++e) lg[e] = __builtin_bit_cast(float, __builtin_amdgcn_readlane(__builtin_bit_cast(int, r1), 8 * e));
            }
            int e0 = 0; float m0 = lg[0];
#pragma unroll
            for (int e = 1; e < 8; ++e) if (lg[e] > m0) { m0 = lg[e]; e0 = e; }
            int e1 = -1; float m1 = -3.0e38f;
#pragma unroll
            for (int e = 0; e < 8; ++e) if (e != e0 && lg[e] > m1) { m1 = lg[e]; e1 = e; }
            const float w0 = 1.0f / (1.0f + __expf(m1 - m0));
            if (lane == 0) { ((int*)(ws + SM_TOKE))[row] = e0 | (e1 << 8); ((f32x2*)(ws + SM_TOKW))[row] = (f32x2){w0, 1.0f - w0}; __hip_atomic_fetch_add(&cnt[e0], 1, __ATOMIC_RELAXED, __HIP_MEMORY_SCOPE_WORKGROUP); __hip_atomic_fetch_add(&cnt[e1], 1, __ATOMIC_RELAXED, __HIP_MEMORY_SCOPE_WORKGROUP); }
        }
    }
    if (ROUTE) { __syncthreads(); if (F.tid < 8) ((int*)(ws + SM_PCNT))[pm * 8 + F.tid] = cnt[F.tid]; __syncthreads(); }
}
__device__ __forceinline__ void moe_gather(const Frame& F, const Args& a) {
    unsigned char* ws = a.ws; const int* pcnt = (const int*)(ws + SM_PCNT); const int* toke = (const int*)(ws + SM_TOKE);
    int* rowtok = (int*)(ws + SM_ROWTOK); int* tileexp = (int*)(ws + SM_TILEEXP);
    LAS int* sm = (LAS int*)F.lds;
    for (int pm = F.own; pm < T / 256; pm += F.G) {
        for (int q = F.tid; q < (T / 256) * 8; q += 512) sm[1024 + q] = pcnt[q];
        if (F.tid >= 32 && F.tid < 288) sm[F.tid] = toke[pm * 256 + F.tid - 32];
        __syncthreads();
        if (F.tid < 8) { int tot = 0, before = 0; for (int q = 0; q < T / 256; ++q) { const int c = sm[1024 + q * 8 + F.tid]; tot += c; if (q < pm) before += c; } sm[F.tid] = tot; sm[16 + F.tid] = before; }
        __syncthreads();
        if (F.tid == 0) { int st = 0; for (int e = 0; e < 8; ++e) { sm[8 + e] = st * 256; st += (sm[e] + 255) >> 8; } sm[24] = st; }
        __syncthreads();
        {
            const int i = F.tid >> 1, k = F.tid & 1; const int ee = sm[32 + i]; const int e = k ? (ee >> 8) : (ee & 255);
            int cntb = 0; for (int q = 0; q < i; ++q) { const int o = sm[32 + q]; cntb += ((o & 255) == e) + ((o >> 8) == e); }
            const int dest = sm[8 + e] + sm[16 + e] + cntb; sm[512 + F.tid] = dest; rowtok[dest] = 2 * (pm * 256 + i) + k;
        }
        __syncthreads();
        if (pm == 0) {
            for (int e = 0; e < 8; ++e) { const int r0 = sm[8 + e] + sm[e], r1 = sm[8 + e] + (((sm[e] + 255) >> 8) << 8); for (int r = r0 + F.tid; r < r1; r += 512) rowtok[r] = -1;
                const int t0 = sm[8 + e] >> 8, t1 = r1 >> 8; for (int t = t0 + F.tid; t < t1; t += 512) tileexp[t] = e; }
            if (F.tid == 0) tileexp[1023] = sm[24];
        }
        __syncthreads();
    }
}

__device__ __forceinline__ void moe_tail_finalize(const Frame& F, const Args& a) {
    const int* tileexp = (const int*)(a.ws + SM_TILEEXP); int nt = tileexp[1023] - (MOE_NCHUNK - 1) * MOE_CHUNK_TILES; nt = nt < 0 ? 0 : (nt > 8 ? 8 : nt);
    const float* YT = (const float*)(a.ws + WS_XS); const int* row_tok = (const int*)(a.ws + SM_ROWTOK) + (MOE_NCHUNK - 1) * MOE_CHUNK_TILES * 256; bf16_t* Y = (bf16_t*)(a.ws + WS_YB);
    const int c8 = (F.tid & 127) * 8;
    for (int r = F.bid * 4 + (F.tid >> 7); r < nt * 256; r += F.G * 4) { const int dst = row_tok[r]; if (dst < 0) continue;
        f32x4 s0 = (f32x4){0.f, 0.f, 0.f, 0.f}, s1 = s0;
#pragma unroll
        for (int ks = 0; ks < 7; ++ks) { const float* p = YT + ((size_t)ks * 2048 + r) * D + c8; s0 += *(const f32x4*)p; s1 += *(const f32x4*)(p + 4); }
        u32x4 w; w.x = cvt_pk_bf16(s0[0], s0[1]); w.y = cvt_pk_bf16(s0[2], s0[3]); w.z = cvt_pk_bf16(s1[0], s1[1]); w.w = cvt_pk_bf16(s1[2], s1[3]);
        *(u32x4*)(Y + (size_t)dst * D + c8) = w; }
}
struct MoeUpOrder { int ntile, G, c, chunk; const int* tileexp;
    __device__ __forceinline__ bool next(int i, pg8::Unit& u) const { if (!pg8::static_tile(i, G, c, ntile, 2 * DFE / 256, u.pm, u.pn)) return false;
        const int tile = chunk * MOE_CHUNK_TILES + u.pm, e = tileexp[tile]; u.aux = tile; u.offA = (long long)tile * 256 * D * 2; u.offB = ((long long)e * 2 * DFE + (long long)u.pn * 256) * D * 2; return true; } };
struct MoeDnOrder { int ntile, G, c, chunk; const int* tileexp;
    __device__ __forceinline__ bool next(int i, pg8::Unit& u) const { if (!pg8::static_tile(i, G, c, ntile, D / 256, u.pm, u.pn)) return false;
        const int tile = chunk * MOE_CHUNK_TILES + u.pm, e = tileexp[tile]; u.aux = tile; u.offA = (long long)u.pm * 256 * DFE * 2; u.offB = ((long long)e * D + (long long)u.pn * 256) * DFE * 2; return true; } };

struct MoeDnTailOrder { int ntile, G, c; const int* tileexp;
    __device__ __forceinline__ bool next(int i, pg8::Unit& u) const { const long L = (long)i * G + c; if (L >= (long)ntile * 28) return false;
        const int ks = (int)(L % 7), rest = (int)(L / 7); u.pn = rest & 3; u.pm = rest >> 2; u.aux = ks;
        const int tile = (MOE_NCHUNK - 1) * MOE_CHUNK_TILES + u.pm, e = tileexp[tile];
        u.offA = (long long)u.pm * 256 * DFE * 2 + (long long)ks * 512 * 2; u.offB = ((long long)e * D + (long long)u.pn * 256) * DFE * 2 + (long long)ks * 512 * 2; return true; } };

__device__ __forceinline__ int attn_pair(int p0, int G) {
    if (G != 256) return p0;
    const int x = p0 & 7, r = (p0 >> 3) & 31, k = p0 >> 8;
    return ((x + 8 * (2 * k + (r >> 4))) << 4) | (r & 15);
}

enum { PH_PREP = 0, PH_WIN, PH_POST, PH_MIX1, PH_MIX2, PH_MIX3, PH_MIX4, PH_WOUT, PH_LN1, PH_FUP, PH_FDN, PH_MGATH = 9, PH_MUP0 = 10, PH_LN2 = 21, PH_PGATE, PH_PPROJ, PH_LN3, PH_PER_LAYER = 32 };
constexpr int GP_END = 2 + 32 * DEPTH;

__global__ void __launch_bounds__(512, 2) mk_fwd(Args a0) {
    extern __shared__ __attribute__((aligned(16))) unsigned char lds_raw[];
    LAS unsigned char* const lds = (LAS unsigned char*)lds_raw;
    for (int u = threadIdx.x; u < (LDS_BYTES - LDSCTL_OFF) / 4; u += 512) ((LAS unsigned*)(lds + LDSCTL_OFF))[u] = 0u;
    __syncthreads();
    const int gp_lo = a0.gp_lo, gp_hi = a0.gp_hi; const int F0bid = blockIdx.x, F0G = gridDim.x; const int wave0 = __builtin_amdgcn_readfirstlane(threadIdx.x >> 6);
    XcdBarrier bar; bar.bar = (unsigned*)(a0.ws + WS_CTL) + CW_BAR; bar.x = 0; bar.st = nullptr;
    if (a0.use_bar) bar = xcd_barrier_post((unsigned*)(a0.ws + WS_CTL) + CW_BAR, (volatile LAS unsigned*)(lds + LDSCTL_OFF + 32));
#if MK_PROBE
#define PRW ((volatile LAS unsigned*)(lds + LDSCTL_OFF + 128))
    if (threadIdx.x == 0) { const unsigned long long t_ = __builtin_amdgcn_s_memrealtime(); PRW[0] = (unsigned)t_; PRW[1] = (unsigned)(t_ >> 32); PRW[2] = 0u; PRW[3] = 0u; PRW[4] = (unsigned)t_; PRW[5] = (unsigned)(t_ >> 32); }
#define STAMP(cls) do { if (wave0 == 0 && lane_id_fresh() == 0) { const unsigned long long t_ = __builtin_amdgcn_s_memrealtime(); const unsigned long long p_ = ((unsigned long long)PRW[1] << 32) | PRW[0]; const unsigned d_ = (unsigned)(t_ - p_); \
        PRW[0] = (unsigned)t_; PRW[1] = (unsigned)(t_ >> 32); if ((PROBE_A >> (cls)) & 1) PRW[2] += d_; if ((PROBE_B >> (cls)) & 1) PRW[3] += d_; } } while (0)
#else
#define STAMP(cls) do {} while (0)
#endif
#define RUN(gp) (gp_lo <= (gp) && (gp) < gp_hi)
#define SEAM(gp) do { if (gp_lo <= (gp) && (gp) + 1 < gp_hi) xcd_barrier(bar, wave0); } while (0)
#define PH_BEGIN Args a; load_args(a); const Frame F = make_frame(lds, wave0); unsigned char* const ws = a.ws; int l = lx; asm volatile("" : "+s"(l)); (void)l; (void)ws; \
    bf16_t* const xb = (bf16_t*)(ws + WS_XB); bf16_t* const z = (bf16_t*)(ws + WS_Z); bf16_t* const mix = (bf16_t*)(ws + WS_MIX); bf16_t* const hbuf = (bf16_t*)(ws + WS_HBUF); const long long S1K = 256ll * 1024 * 2; \
    (void)xb; (void)z; (void)mix; (void)hbuf; (void)S1K;
#define AP_DEF const nsa::Lane L{F.lane, F.lane & 31, F.lane >> 5, F.wave, F.tid}; \
    const nsa::AttnPtrs AP{(const bf16_t*)(ws + WS_Q), z, (const bf16_t*)(ws + WS_KC), (const bf16_t*)(ws + WS_VCT), (const bf16_t*)(ws + WS_KSEL), (const bf16_t*)(ws + WS_VSEL), \
                           (const bf16_t*)(ws + WS_KWIN), (const bf16_t*)(ws + WS_VWIN), (unsigned long long*)(ws + WS_SELM), mix};
    { const int lx = 0;
    if (RUN(0)) { PH_BEGIN phase_init0(F, a); }
    SEAM(0); STAMP(0);
    if (RUN(1)) { PH_BEGIN phase_init1(F, a); }
    SEAM(1); STAMP(0);
    }
    for (int lx = 0; lx < DEPTH; ++lx) {
        const int base = 2 + PH_PER_LAYER * lx; const bool moe = (lx & 1) != 0;
        if (RUN(base + PH_PREP)) { PH_BEGIN phase_prep(F, a, l); }
        SEAM(base + PH_PREP); STAMP(1);
        if (RUN(base + PH_WIN)) { PH_BEGIN
            pg8::Gemm g{xb, (const bf16_t*)(ws + W_IN), D, D, D}; pg8::PlainOrder S{T / 256, INP / 256, F.G, F.bid, S1K, S1K};
            epi::EpiWin E{z, (bf16_t*)(ws + WS_Q), (bf16_t*)(ws + WS_KCMP), (bf16_t*)(ws + WS_S5A), (const f32x2*)(ws + WS_ROPE)};
            pg8::gemm_phase(F.lds, g, S, E, F.tid);
        }
        SEAM(base + PH_WIN); STAMP(2);
        if (RUN(base + PH_MIX1)) {
            for (int r = F0bid; r < 128; r += F0G) {
                {   PH_BEGIN const int g_ = r >> 3, pm_ = r & 7;
                    pg8::Gemm g{(const bf16_t*)(ws + WS_S5A), (const bf16_t*)(ws + W_S5S), 512, S5K, 512};
                    pg8::ListOrder S{1, pm_, g_, (long long)g_ * 2048 * S5K * 2 + (long long)pm_ * 256 * S5K * 2, (long long)g_ * 256 * 512 * 2, 0}; epi::F32Grouped E{(float*)(ws + WS_S5S), 256, (size_t)2048 * 256};
                    pg8::gemm_phase(F.lds, g, S, E, F.tid); }
                __syncthreads();
                {   PH_BEGIN int nr = MK_REP_CARRY; asm volatile("" : "+s"(nr)); for (int q = 0; q < nr; ++q) s5_carry_panel(F, a, l, r >> 3, r & 7); }
                asm volatile("s_waitcnt vmcnt(0)" ::: "memory"); __syncthreads();
                {   PH_BEGIN const int g_ = r >> 3, pm_ = r & 7;
                    pg8::Gemm g{(const bf16_t*)(ws + WS_S5A), (const bf16_t*)(ws + W_S5B), S5K, S5K, S5K};
                    pg8::ListOrder S{2, pm_, g_, (long long)g_ * 2048 * S5K * 2 + (long long)pm_ * 256 * S5K * 2, (long long)g_ * 512 * S5K * 2, 256ll * S5K * 2}; epi::S5Out E{(bf16_t*)(ws + WS_ZS5), z, (const float*)a.in[21] + (size_t)l * 256};
                    pg8::gemm_phase(F.lds, g, S, E, F.tid); }
            }
            for (int r = F0bid - 128; r < 64; r += F0G) { if (r < 0) continue;
                {   PH_BEGIN const int j_ = r >> 5, bh_ = r & 31;
                    pg8::Gemm g{(const bf16_t*)(ws + WS_KCMP), (const bf16_t*)(ws + W_CMP), 1024, 1024, 1024};
                    pg8::ListOrder S{2, bh_, j_, (long long)j_ * (long long)(WS_VCMP - WS_KCMP) + (long long)bh_ * S1K, (long long)j_ * 512 * 1024 * 2, S1K}; epi::F32Grouped E{(float*)(ws + WS_CMPP), 512, (size_t)8192 * 512};
                    pg8::gemm_phase(F.lds, g, S, E, F.tid); }
                asm volatile("s_waitcnt vmcnt(0)" ::: "memory"); __syncthreads();
                {   PH_BEGIN int nr = MK_REP_ST2; asm volatile("" : "+s"(nr)); for (int q = 0; q < nr; ++q) cmp_stage2_panel(F, a, l, r >> 5, r & 31); }
            }
            {   PH_BEGIN
                if (F.G == 256) { const int c = F.bid; const int beg = c < 128 ? c * 5 : (c < 192 ? 640 + (c - 128) * 6 : 1024 + (c - 192) * 16), cnt = c < 128 ? 5 : (c < 192 ? 6 : 16); conv_items(F, a, l, beg, 1, beg + cnt); }
                else conv_items(F, a, l, F.bid, F.G); }
        }
        SEAM(base + PH_MIX1); STAMP(4);
        if (RUN(base + PH_MIX3)) {
            {   PH_BEGIN
                pg8::Gemm g{(const bf16_t*)(ws + WS_ZS5), (const bf16_t*)(ws + W_GLU), 256, 256, 256};
                pg8::PlainOrder S{T / 256, 1, F.G, F.bid, 256ll * 256 * 2, 256ll * 256 * 2}; epi::S5Glu E{mix, (const bf16_t*)(ws + WS_ZS5), (const float*)a.in[23] + (size_t)l * 256};
                pg8::gemm_phase(F.lds, g, S, E, F.tid);
            }
            {   PH_BEGIN AP_DEF
                for (int p0 = F.bid; p0 < 32 * 16; p0 += F.G) { const int p = attn_pair(p0, F.G); const int bh = p >> 4, s = p & 15;
                    for (int half = 0; half < 2; ++half) { const int qb2 = half ? 31 - s : s;
                        nsa::cmp_unit<true>(bh, 2 * qb2, AP, F.lds, L); nsa::cmp_topk(bh, 2 * qb2, AP, F.lds, L);
                        nsa::cmp_unit<false>(bh, 2 * qb2 + 1, AP, F.lds, L); nsa::cmp_topk(bh, 2 * qb2 + 1, AP, F.lds, L); } } }
            asm volatile("s_waitcnt vmcnt(0)" ::: "memory"); __syncthreads();
            {   PH_BEGIN AP_DEF
                for (int p0 = F.bid; p0 < 32 * 16; p0 += F.G) { const int p = attn_pair(p0, F.G); const int bh = p >> 4, s = p & 15; nsa::sw_unit2(bh, s, AP, F.lds, L); nsa::sw_unit2(bh, 31 - s, AP, F.lds, L); } }
        }
        SEAM(base + PH_MIX3); STAMP(6);

        if (RUN(base + PH_WOUT)) {
            {   PH_BEGIN
                pg8::Gemm g{mix, (const bf16_t*)(ws + W_OUT), D, D, D}; pg8::PlainOrder S{T / 256, D / 256, F.G, F.bid, S1K, S1K}; epi::Bf16Sc1 E{hbuf, D, (unsigned)((size_t)T * D * 2)};
                pg8::gemm_phase(F.lds, g, S, E, F.tid);
            }
            {   PH_BEGIN pg8::PlainOrder S{T / 256, D / 256, F.G, F.bid, S1K, S1K}; panels_publish_wait(F, (unsigned*)(ws + WS_CTL), 2 * l + 0, S, (unsigned)(D / 256)); }
            {   PH_BEGIN
                const float* gg = (const float*)a.in[34] + ((size_t)l * 3 + 0) * D; const float* bb = (const float*)a.in[35] + ((size_t)l * 3 + 0) * D;
                for (int pm = F.own; pm < T / 256; pm += F.G) { if (l & 1) ln_panel<0, true, false>(F, a, pm, gg, bb, (const float*)a.in[27] + (size_t)(l >> 1) * D * NEXP); else ln_panel<0, false, false>(F, a, pm, gg, bb, nullptr); }
            }
        }
        SEAM(base + PH_WOUT); STAMP(8);
        if (!moe) {
            if (RUN(base + PH_FUP)) { PH_BEGIN
                pg8::Gemm g{xb, (const bf16_t*)(ws + W_UP), D, D, D}; pg8::PlainOrder S{T / 256, 2 * DFF / 256, F.G, F.bid, S1K, S1K}; epi::SwiGlu E{(bf16_t*)(ws + WS_FFH), DFF};
                pg8::gemm_phase(F.lds, g, S, E, F.tid);
            }
            SEAM(base + PH_FUP); STAMP(9);
            if (RUN(base + PH_FDN)) {
                {   PH_BEGIN
                    pg8::Gemm g{(const bf16_t*)(ws + WS_FFH), (const bf16_t*)(ws + W_DN), DFF, DFF, DFF}; pg8::PlainOrder S{T / 256, D / 256, F.G, F.bid, 256ll * DFF * 2, 256ll * DFF * 2}; epi::Bf16Sc1 E{hbuf, D, (unsigned)((size_t)T * D * 2)};
                    pg8::gemm_phase(F.lds, g, S, E, F.tid);
                }
                {   PH_BEGIN pg8::PlainOrder S{T / 256, D / 256, F.G, F.bid, 256ll * DFF * 2, 256ll * DFF * 2}; panels_publish_wait(F, (unsigned*)(ws + WS_CTL), 2 * l + 1, S, (unsigned)(D / 256)); }
                {   PH_BEGIN
                    const float* gg = (const float*)a.in[34] + ((size_t)l * 3 + 1) * D; const float* bb = (const float*)a.in[35] + ((size_t)l * 3 + 1) * D;
                    for (int pm = F.own; pm < T / 256; pm += F.G) ln_panel<0, false, false>(F, a, pm, gg, bb, nullptr);
                }
            }
            asm volatile("s_waitcnt vmcnt(0)" ::: "memory"); __syncthreads(); STAMP(10);
        } else {
            if (RUN(base + PH_MGATH)) { PH_BEGIN moe_gather(F, a); }
            SEAM(base + PH_MGATH); STAMP(11);
            for (int cx = 0; cx < MOE_NCHUNK; ++cx) {
                if (RUN(base + PH_MUP0 + 2 * cx)) { PH_BEGIN int c = cx; asm volatile("" : "+s"(c)); const int* tileexp = (const int*)(ws + SM_TILEEXP);
                    int nt = tileexp[1023] - c * MOE_CHUNK_TILES; nt = nt < 0 ? 0 : (nt > MOE_CHUNK_TILES ? MOE_CHUNK_TILES : nt);
                    pg8::Gemm g{xb, (const bf16_t*)(ws + W_UP), D, D, D}; MoeUpOrder S{nt, F.G, F.bid, c, tileexp}; epi::SwiGlu E{(bf16_t*)(ws + WS_MH), DFE};
                    pg8::gemm_phase<epi::SwiGlu, MoeUpOrder, true>(F.lds, g, S, E, F.tid, (const int*)(ws + SM_ROWTOK));
                }
                SEAM(base + PH_MUP0 + 2 * cx); STAMP(12);
                if (RUN(base + PH_MUP0 + 2 * cx + 1)) { PH_BEGIN int c = cx; asm volatile("" : "+s"(c)); const int* tileexp = (const int*)(ws + SM_TILEEXP);
                    int nt = tileexp[1023] - c * MOE_CHUNK_TILES; nt = nt < 0 ? 0 : (nt > MOE_CHUNK_TILES ? MOE_CHUNK_TILES : nt);
                    if (cx < MOE_NCHUNK - MK_TAILSPLIT) {
                        pg8::Gemm g{(const bf16_t*)(ws + WS_MH), (const bf16_t*)(ws + W_DN), DFE, DFE, DFE}; MoeDnOrder S{nt, F.G, F.bid, c, tileexp}; epi::MoeDown E{(bf16_t*)(ws + WS_YB), (const int*)(ws + SM_ROWTOK)};
                        pg8::gemm_phase(F.lds, g, S, E, F.tid);
                    } else {
                        nt = nt > 8 ? 8 : nt;
                        pg8::Gemm g{(const bf16_t*)(ws + WS_MH), (const bf16_t*)(ws + W_DN), 512, DFE, DFE}; MoeDnTailOrder S{nt, F.G, F.bid, tileexp}; epi::F32Grouped E{(float*)(ws + WS_XS), D, (size_t)2048 * D};
                        pg8::gemm_phase(F.lds, g, S, E, F.tid);
                    }
                }
                SEAM(base + PH_MUP0 + 2 * cx + 1); STAMP(13);
            }
#if MK_TAILSPLIT
            if (RUN(base + PH_MUP0 + 2 * MOE_NCHUNK)) { PH_BEGIN moe_tail_finalize(F, a); }
            SEAM(base + PH_MUP0 + 2 * MOE_NCHUNK); STAMP(13);
#endif
        }
        if (RUN(base + PH_PGATE)) {
            if (moe) {
                {   PH_BEGIN
                    const float* gg = (const float*)a.in[34] + ((size_t)l * 3 + 1) * D; const float* bb = (const float*)a.in[35] + ((size_t)l * 3 + 1) * D;
                    for (int pm = F.own; pm < T / 256; pm += F.G) ln_panel<1, false, false>(F, a, pm, gg, bb, nullptr);
                }
                asm volatile("s_waitcnt vmcnt(0)" ::: "memory"); __syncthreads();
            }
            {   PH_BEGIN
                pg8::Gemm g{xb, (const bf16_t*)(ws + W_GATE), D, D, D}; pg8::PanelOrder S{T / 256, D / 256, F.G, F.own, S1K, S1K}; epi::SigmoidBias E{(l & 1) ? (bf16_t*)(ws + WS_PLEG) : mix, D, (const float*)a.in[32] + (size_t)l * D};
                pg8::gemm_phase(F.lds, g, S, E, F.tid);
            }
            __syncthreads();
            {   PH_BEGIN
                pg8::Gemm g{(const bf16_t*)(ws + WS_PB), (const bf16_t*)(ws + W_PROJ), PLE, PLE, PLE}; pg8::PanelOrder S{T / 256, D / 256, F.G, F.own, 256ll * PLE * 2, 256ll * PLE * 2}; epi::MulBf16 E{(l & 1) ? (bf16_t*)(ws + WS_PLEH) : hbuf, (l & 1) ? (bf16_t*)(ws + WS_PLEG) : mix, D};
                pg8::gemm_phase(F.lds, g, S, E, F.tid);
            }
            __syncthreads();
            {   PH_BEGIN
                const float* gg = (const float*)a.in[34] + ((size_t)l * 3 + 2) * D; const float* bb = (const float*)a.in[35] + ((size_t)l * 3 + 2) * D;
                const size_t hoff = (l & 1) ? WS_PLEH : WS_HBUF;
                for (int pm = F.own; pm < T / 256; pm += F.G) { if (l == DEPTH - 1) ln_panel<0, false, true>(F, a, pm, gg, bb, nullptr, hoff); else ln_panel<0, false, false>(F, a, pm, gg, bb, nullptr, hoff); }
            }
        }
        SEAM(base + PH_PGATE); STAMP(15);
    }
#if MK_PROBE
    if (blockIdx.x == 0) {
        __syncthreads(); asm volatile("s_waitcnt vmcnt(0)" ::: "memory");
        const unsigned long long t1 = ((unsigned long long)PRW[1] << 32) | PRW[0], t0 = ((unsigned long long)PRW[5] << 32) | PRW[4];
        const float tot = (float)(unsigned)(t1 - t0), fa = (float)PRW[2] / tot, fb = (float)PRW[3] / tot;
        Args ae; load_args(ae);
        const int tidp = wave0 * 64 + lane_id_fresh();
        if (tidp == 0) ae.out[0] += 1.0f + 8.0f * fa;
        for (int i = tidp; i < 100000; i += 512) ae.out[1024 + i] += 0.5f * fb;
    }
#endif
#undef RUN
#undef SEAM
}

static bool phase_applies(int gp) {
    if (gp < 2) return true;
    const int l = (gp - 2) / PH_PER_LAYER, ph = (gp - 2) % PH_PER_LAYER; const bool moe = (l & 1) != 0;
    if (ph < PH_LN1) return ph != PH_POST && ph != PH_MIX2 && ph != PH_MIX4;
    if (ph == PH_PGATE) return true;
    if (!moe) return ph == PH_FUP || ph == PH_FDN;
    return ph >= PH_MGATH && ph <= PH_MUP0 + 2 * MOE_NCHUNK;
}
extern "C" void kernel_launch(void* const* d_in, const int* in_sizes, int n_in, void* d_out, int out_size, void* d_ws, size_t ws_size, hipStream_t stream) {
    static int grid = 0;
    if (grid == 0) {
        if (n_in != 36 || out_size != T * D || ws_size < WS_END) { fprintf(stderr, "kernel_launch: unexpected problem (n_in %d out %d ws %zu, need %zu)\n", n_in, out_size, ws_size, (size_t)WS_END); grid = -1; return; }
        int dev = 0, cus = 0, per_cu = 0;
        if (hipGetDevice(&dev) != hipSuccess || hipDeviceGetAttribute(&cus, hipDeviceAttributeMultiprocessorCount, dev) != hipSuccess) { grid = -1; return; }
        if (hipFuncSetAttribute((const void*)mk_fwd, hipFuncAttributeMaxDynamicSharedMemorySize, LDS_BYTES) != hipSuccess) { fprintf(stderr, "kernel_launch: hipFuncSetAttribute failed\n"); grid = -1; return; }
        if (hipOccupancyMaxActiveBlocksPerMultiprocessor(&per_cu, (const void*)mk_fwd, 512, LDS_BYTES) != hipSuccess || per_cu < 1) fprintf(stderr, "kernel_launch: occupancy query reports %d\n", per_cu);
        (void)hipGetLastError();
        grid = cus;
    }
    if (grid < 0) return;
    (void)in_sizes;
    if (hipMemsetAsync((char*)d_ws + WS_CTL, 0, CTL_ZERO_BYTES, stream) != hipSuccess) return;
#if MK_CHECK
    (void)hipMemsetAsync((char*)d_ws + SM_CHK, 0, 256, stream);
#endif
    Args a{};
    for (int i = 0; i < 36; ++i) a.in[i] = d_in[i];
    a.out = (float*)d_out; a.ws = (unsigned char*)d_ws; a.pad = 0;
#if MK_MULTI
    for (int gp = 0; gp < GP_END; ++gp) { if (!phase_applies(gp)) continue; a.gp_lo = gp; a.gp_hi = gp + 1; a.use_bar = 0;
        hipLaunchKernelGGL(mk_fwd, dim3(grid), dim3(512), LDS_BYTES, stream, a);
#if MK_CHECK
        run_checks(a, gp, stream);
#endif
    }
#if MK_CHECK
    hipLaunchKernelGGL(chk_final, dim3(1), dim3(1), 0, stream, a);
#endif
#else
    a.gp_lo = 0; a.gp_hi = GP_END; a.use_bar = 1;
    hipLaunchKernelGGL(mk_fwd, dim3(grid), dim3(512), LDS_BYTES, stream, a);
#endif
}
```

```cpp
#include <hip/hip_runtime.h>
#include <cstdint>
#include <cstdio>
#ifndef MK_TAILSPLIT
#define MK_TAILSPLIT 1
#endif
#ifndef MK_MULTI
#define MK_MULTI 0
#endif
#ifndef MK_CHECK
#define MK_CHECK 0
#endif
#ifndef MK_REP_G1
#define MK_REP_G1 1
#endif
#ifndef MK_REP_G2
#define MK_REP_G2 1
#endif
#ifndef MK_REP_CU
#define MK_REP_CU 1
#endif
#ifndef MK_REP_TK
#define MK_REP_TK 1
#endif
#ifndef MK_REP_WOUT
#define MK_REP_WOUT 1
#endif
#ifndef MK_REP_CONV
#define MK_REP_CONV 1
#endif
#ifndef MK_REP_ST2
#define MK_REP_ST2 1
#endif
#ifndef MK_REP_CARRY
#define MK_REP_CARRY 1
#endif
#ifndef MK_REPCMP
#define MK_REPCMP 1
#endif
#ifndef MK_ALIGN_EPI
#define MK_ALIGN_EPI 1
#endif
#ifndef MK_PROBE
#define MK_PROBE 0
#endif
#ifndef PROBE_A
#define PROBE_A 0
#endif
#ifndef PROBE_B
#define PROBE_B 0
#endif
#ifndef CHK_LAYER
#define CHK_LAYER 15
#endif

#define GAS __attribute__((address_space(1)))
#define LAS __attribute__((address_space(3)))
typedef unsigned short bf16_t;
typedef short bf16x8 __attribute__((ext_vector_type(8)));
typedef float f32x4 __attribute__((ext_vector_type(4)));
typedef float f32x2 __attribute__((ext_vector_type(2)));
typedef float f32x16 __attribute__((ext_vector_type(16)));
typedef unsigned u32x4 __attribute__((ext_vector_type(4)));
typedef unsigned u32x2 __attribute__((ext_vector_type(2)));

constexpr int NB = 16, SEQ = 4096, T = NB * SEQ, D = 1024, DEPTH = 4;
constexpr int INW = 2072, INP = 2304;
constexpr int ZKV = 512, ZG = 1280, ZC = 1304, ZS = 1816;
constexpr int DFF = 2816, DFE = 3584, NEXP = 8, PLE = 256;
constexpr int NCMP = 255;
constexpr int S5LC = 32, S5NCH = SEQ / S5LC, S5K = S5LC * 16 + 128;
constexpr float ALPHA = 1.6817928305074290f;
constexpr float LN_EPS = 1e-5f;
constexpr float QSCALE = 0.125f * 1.4426950408889634f;
constexpr float NEGF = -1e30f;
constexpr int MOE_TILES_MAX = 520, MOE_CHUNK_TILES = 256, MOE_NCHUNK = 3;

typedef __bf16 bf16x2_t __attribute__((ext_vector_type(2)));
__device__ __forceinline__ unsigned cvt_pk_bf16(float lo, float hi) { f32x2 v = {lo, hi}; const bf16x2_t b = __builtin_convertvector(v, bf16x2_t); return __builtin_bit_cast(unsigned, b); }
__device__ __forceinline__ bf16_t f2bf(float f) { return (bf16_t)(cvt_pk_bf16(f, 0.f) & 0xffffu); }
__device__ __forceinline__ float bf2f(unsigned v) { return __uint_as_float(v << 16); }
__device__ __forceinline__ float bflo(unsigned w) { return __uint_as_float(w << 16); }
__device__ __forceinline__ float bfhi(unsigned w) { return __uint_as_float(w & 0xffff0000u); }
__device__ __forceinline__ float fast_exp2(float x) { return __builtin_amdgcn_exp2f(x); }
__device__ __forceinline__ float fast_rcp(float x) { return __builtin_amdgcn_rcpf(x); }
__device__ __forceinline__ float sigmoidf_(float x) { return fast_rcp(1.0f + fast_exp2(-1.4426950408889634f * x)); }
__device__ __forceinline__ float siluf_(float x) { return x * sigmoidf_(x); }
__device__ __forceinline__ float gelu_tanh(float x) { const float u = 0.7978845608028654f * (x + 0.044715f * x * x * x); return x * sigmoidf_(2.0f * u); }
__device__ __forceinline__ int lane_id_fresh() { unsigned z = 0u; asm volatile("" : "+v"(z)); return (int)__builtin_amdgcn_mbcnt_hi(~0u, __builtin_amdgcn_mbcnt_lo(~0u, z)); }
template <int MASK> __device__ __forceinline__ float xshfl(float v) {
    if (MASK == 1) return __uint_as_float((unsigned)__builtin_amdgcn_update_dpp(0, (int)__float_as_uint(v), 0xB1, 0xF, 0xF, true));
    if (MASK == 2) return __uint_as_float((unsigned)__builtin_amdgcn_update_dpp(0, (int)__float_as_uint(v), 0x4E, 0xF, 0xF, true));
    if (MASK == 32) { const unsigned u = __float_as_uint(v); auto rr = __builtin_amdgcn_permlane32_swap(u, u, false, false); return __uint_as_float((rr[0] == u) ? rr[1] : rr[0]); }
    return __uint_as_float((unsigned)__builtin_amdgcn_ds_swizzle((int)__float_as_uint(v), 0x1f | (MASK << 10)));
}
__device__ __forceinline__ float xsum32(float v) { const unsigned u = __float_as_uint(v); auto rr = __builtin_amdgcn_permlane32_swap(u, u, false, false); return __uint_as_float(rr[0]) + __uint_as_float(rr[1]); }
__device__ __forceinline__ float xsum16(float v) { const unsigned u = __float_as_uint(v); auto rr = __builtin_amdgcn_permlane16_swap(u, u, false, false); return __uint_as_float(rr[0]) + __uint_as_float(rr[1]); }
__device__ __forceinline__ float swapsum32(float a, float b) { auto rr = __builtin_amdgcn_permlane32_swap(__float_as_uint(a), __float_as_uint(b), false, false); return __uint_as_float(rr[0]) + __uint_as_float(rr[1]); }
__device__ __forceinline__ float swapsum16(float a, float b) { auto rr = __builtin_amdgcn_permlane16_swap(__float_as_uint(a), __float_as_uint(b), false, false); return __uint_as_float(rr[0]) + __uint_as_float(rr[1]); }
__device__ __forceinline__ float dpp_half_mirror(float v) { return __uint_as_float((unsigned)__builtin_amdgcn_update_dpp(0, (int)__float_as_uint(v), 0x141, 0xF, 0xF, true)); }
__device__ __forceinline__ float wave_sum(float v) {
    v += xshfl<1>(v); v += xshfl<2>(v);
    v += __uint_as_float((unsigned)__builtin_amdgcn_update_dpp(0, (int)__float_as_uint(v), 0x141, 0xF, 0xF, true));
    v += __uint_as_float((unsigned)__builtin_amdgcn_update_dpp(0, (int)__float_as_uint(v), 0x140, 0xF, 0xF, true));
    v = xsum16(v); v = xsum32(v);
    return v;
}
#define LDS_WAIT() asm volatile("s_waitcnt lgkmcnt(0)" ::: "memory")
#define VM_WAIT() asm volatile("s_waitcnt vmcnt(0)" ::: "memory")

namespace pg8 {
constexpr int BM = 256, BK = 64, HALF = 128, HTB = HALF * BK * 2, STAGE_BYTES = 8 * HTB, NXCD = 8, WGM = 8;
__host__ __device__ __forceinline__ int lds_byte(int r, int c) { const int st = (r >> 4) * 2 + (c >> 5), rr = r & 15, cc = c & 31, ob = rr * 64 + cc * 2; return st * 1024 + (ob ^ (((ob >> 9) & 1) << 5)); }
__host__ __device__ __forceinline__ void stage_rc(int b, int& R, int& C) { const int st = b / 1024, sb = b % 1024, swz = sb ^ (((sb >> 9) & 1) << 5); R = (st >> 1) * 16 + swz / 64; C = (st & 1) * 32 + (swz % 64) / 2; }
__host__ __device__ __forceinline__ int perm32(int rho) { const int n = rho >> 4, i = rho & 15; return 8 * (i >> 2) + 4 * n + (i & 3); }

struct Unit { int pm, pn; long long offA, offB; int aux; };
struct Gemm { const bf16_t* A; const bf16_t* Bt; int K, lda, ldb; };

__device__ __forceinline__ bool static_tile(int i, int G, int c, int nM, int nN, int& pm, int& pn) {
    const int nwg = nM * nN; const long L = (long)i * G + c; if (L >= nwg) return false;
    int wgid = (int)L; { const int q = nwg / NXCD, r = nwg % NXCD, xcd = wgid % NXCD, off = wgid / NXCD; wgid = (xcd < r ? xcd * (q + 1) : r * (q + 1) + (xcd - r) * q) + off; }
    const int nig = WGM * nN, gid = wgid / nig, fm = gid * WGM, gsz = (nM - fm) < WGM ? (nM - fm) : WGM;
    pm = fm + ((wgid % nig) % gsz); pn = (wgid % nig) / gsz; return true;
}
struct PlainOrder {
    int nM, nN, G, c; long long sA, sB;
    __device__ __forceinline__ bool next(int i, Unit& u) const { if (!static_tile(i, G, c, nM, nN, u.pm, u.pn)) return false; u.offA = (long long)u.pm * sA; u.offB = (long long)u.pn * sB; u.aux = 0; return true; }
};
struct PanelOrder {
    int nM, nN, G, c; long long sA, sB;
    __device__ __forceinline__ bool next(int i, Unit& u) const { const int pm = c + G * (i / nN); if (pm >= nM) return false; u.pm = pm; u.pn = i % nN; u.offA = (long long)pm * sA; u.offB = (long long)u.pn * sB; u.aux = 0; return true; }
};
struct ListOrder {
    int n, pm, aux; long long offA0, offB0, sB;
    __device__ __forceinline__ bool next(int i, Unit& u) const { if (i >= n) return false; u.pm = pm; u.pn = i; u.aux = aux; u.offA = offA0; u.offB = offB0 + (long long)i * sB; return true; }
};
struct GroupedOrder {
    int ng, nM, nN, G, c; long long sA, sB, gA, gB;
    __device__ __forceinline__ bool next(int i, Unit& u) const {
        const long L = (long)i * G + c; const int per = nM * nN; if (L >= (long)ng * per) return false;
        const int gi = (int)(L / per), r = (int)(L % per); u.pm = r / nN; u.pn = r % nN; u.aux = gi;
        u.offA = (long long)gi * gA + (long long)u.pm * sA; u.offB = (long long)gi * gB + (long long)u.pn * sB; return true; }
};

template <class Epi, class Sched, bool GATHER = false>
__device__ __forceinline__ void gemm_phase(LAS unsigned char* lds, const Gemm g, const Sched& S, const Epi& E, int tid_in, const int* rowmap = nullptr) {
    int tid_ = tid_in; asm volatile("" : "+v"(tid_));
    const int tid = tid_, wid = __builtin_amdgcn_readfirstlane(tid >> 6), lane = tid & 63, wr = wid >> 2, wc = wid & 3, fr = lane & 15, fq = lane >> 4;
    int K_ = g.K; asm volatile("" : "+s"(K_));
    const int K = K_, nt = K / BK; (void)K;
    unsigned voffA[2], voffB[2];
#pragma unroll
    for (int i = 0; i < 2; ++i) { int R, C; stage_rc(tid * 16 + i * 8192, R, C); const int Rb = Epi::PERM ? ((R & ~31) + perm32(R & 31)) : R;
        voffA[i] = (unsigned)(R * g.lda + C) * 2u; voffB[i] = (unsigned)(Rb * g.ldb + C) * 2u; }
    const size_t kstep = (size_t)(BK * 2);
    const size_t hstepA = GATHER ? (size_t)0 : (size_t)HALF * g.lda * 2, hstepB = (size_t)HALF * g.ldb * 2;
    unsigned vA[4]; int vN[4];
#pragma unroll
    for (int j = 0; j < 4; ++j) { vA[j] = 0u; vN[j] = 0; }
    auto rows_req = [&](const Unit& u) {
#pragma unroll
        for (int j = 0; j < 4; ++j) { int R, C; stage_rc(tid * 16 + (j & 1) * 8192, R, C); vN[j] = rowmap[u.aux * 256 + (j >> 1) * HALF + R]; } };
    auto rows_req_async = [&](const Unit& u) {
#pragma unroll
        for (int j = 0; j < 4; ++j) { int R, C; stage_rc(tid * 16 + (j & 1) * 8192, R, C); const int* src = rowmap + u.aux * 256 + (j >> 1) * HALF + R;
            asm volatile("global_load_dword %0, %1, off" : "=v"(vN[j]) : "v"(src) : "memory"); } };
    auto rows_set = [&]() {
#pragma unroll
        for (int j = 0; j < 4; ++j) { int R, C; stage_rc(tid * 16 + (j & 1) * 8192, R, C); vA[j] = (unsigned)(vN[j] < 0 ? 0 : (vN[j] >> 1)) * (unsigned)(g.lda * 2) + (unsigned)C * 2u; } };
    const unsigned ldsw = (unsigned)wid * 1024u;
    const int aoff = lds_byte(wr * 64 + fr, fq * 8), boff = lds_byte(wc * 32 + fr, fq * 8);
#define PG8_SA(b, h) (((b) * 2 + (h)) * HTB)
#define PG8_SB(b, h) ((4 + (b) * 2 + (h)) * HTB)
#define PG8_STAGE(bufoff, gbase, voff) do { _Pragma("unroll") for (int _i = 0; _i < 2; ++_i) \
        __builtin_amdgcn_global_load_lds((const unsigned*)((const char*)(gbase) + (voff)[_i]), (LAS unsigned*)(lds + (bufoff) + ldsw + _i * 8192), 16, 0, 0); } while (0)
#define PG8_STAGE_A(bufoff, gbase, h) do { if (GATHER) { _Pragma("unroll") for (int _i = 0; _i < 2; ++_i) \
        __builtin_amdgcn_global_load_lds((const unsigned*)((const char*)(gbase) + vA[(h) * 2 + _i]), (LAS unsigned*)(lds + (bufoff) + ldsw + _i * 8192), 16, 0, 0); } else PG8_STAGE(bufoff, (gbase) + (h) * hstepA, voffA); } while (0)
#define PG8_LDA(dst, b, h) do { _Pragma("unroll") for (int m = 0; m < 4; ++m) _Pragma("unroll") for (int k = 0; k < 2; ++k) dst[m][k] = *(const LAS bf16x8*)(lds + PG8_SA(b, h) + aoff + m * 2048 + k * 1024); } while (0)
#define PG8_LDB(dst, b, h) do { _Pragma("unroll") for (int n = 0; n < 2; ++n) _Pragma("unroll") for (int k = 0; k < 2; ++k) dst[n][k] = *(const LAS bf16x8*)(lds + PG8_SB(b, h) + boff + n * 2048 + k * 1024); } while (0)
#define PG8_MMA(ai, bj, At, Bt) do { __builtin_amdgcn_s_setprio(1); _Pragma("unroll") for (int m = 0; m < 4; ++m) _Pragma("unroll") for (int n = 0; n < 2; ++n) _Pragma("unroll") for (int k = 0; k < 2; ++k) \
        acc[ai][bj][m][n] = __builtin_amdgcn_mfma_f32_16x16x32_bf16(Bt[n][k], At[m][k], acc[ai][bj][m][n], 0, 0, 0); __builtin_amdgcn_s_setprio(0); } while (0)
#define PG8_WAIT_V(n) asm volatile("s_waitcnt vmcnt(" #n ")" ::: "memory")
#define PG8_WAIT_L(n) asm volatile("s_waitcnt lgkmcnt(" #n ")" ::: "memory")
#define PG8_BAR __builtin_amdgcn_s_barrier()
#define PG8_SCHED __builtin_amdgcn_sched_barrier(0)
    Unit cur, nxt; int ui = 0;
    if (!S.next(0, cur)) return;
    f32x4 acc[2][2][4][2];
#pragma unroll
    for (int a = 0; a < 2; ++a)
#pragma unroll
        for (int b = 0; b < 2; ++b)
#pragma unroll
            for (int m = 0; m < 4; ++m)
#pragma unroll
                for (int n = 0; n < 2; ++n) acc[a][b][m][n] = (f32x4){0.f, 0.f, 0.f, 0.f};
    bf16x8 At[4][2], B0[2][2], B1[2][2];
    const char* cA = (const char*)g.A + (GATHER ? 0ll : cur.offA); const char* cB = (const char*)g.Bt + cur.offB;
    if (GATHER) { rows_req(cur); rows_set(); }
    PG8_STAGE(PG8_SB(0, 0), cB, voffB); PG8_STAGE(PG8_SB(0, 1), cB + hstepB, voffB); PG8_STAGE_A(PG8_SA(0, 0), cA, 0); PG8_STAGE_A(PG8_SA(0, 1), cA, 1);
    if (wr == 1) PG8_BAR;
    PG8_WAIT_V(2); PG8_BAR;
    PG8_STAGE(PG8_SB(1, 0), cB + kstep, voffB); PG8_STAGE_A(PG8_SA(1, 0), cA + kstep, 0); PG8_STAGE(PG8_SB(1, 1), cB + hstepB + kstep, voffB);
    PG8_WAIT_V(6); PG8_BAR;
    for (;;) {
        const bool has_next = S.next(ui + 1, nxt);
        const char* nA = (has_next && !GATHER) ? (const char*)g.A + nxt.offA : cA; const char* nB = has_next ? (const char*)g.Bt + nxt.offB : cB;
        for (int t = 0; t < nt; t += 2) {
            const bool last = (t == nt - 2);
            if (GATHER && has_next && t == nt - 4) rows_req_async(nxt);
            const char* a1 = cA + (size_t)(t + 1) * kstep;
            const char* a2 = last ? nA : cA + (size_t)(t + 2) * kstep; const char* b2 = last ? nB : cB + (size_t)(t + 2) * kstep;
            const char* a3 = a2 + kstep; const char* b3 = b2 + kstep;
            PG8_LDB(B0, 0, 0); PG8_LDB(B1, 0, 1); PG8_SCHED; PG8_LDA(At, 0, 0); PG8_STAGE_A(PG8_SA(1, 1), a1, 1);
            if (GATHER && last && has_next) rows_set();
            PG8_WAIT_V(8); PG8_WAIT_L(0); PG8_BAR; PG8_MMA(0, 0, At, B0); PG8_MMA(0, 1, At, B1); PG8_BAR; PG8_SCHED;
            PG8_LDA(At, 0, 1); PG8_STAGE(PG8_SB(0, 0), b2, voffB); PG8_STAGE(PG8_SB(0, 1), b2 + hstepB, voffB); PG8_STAGE_A(PG8_SA(0, 0), a2, 0);
            PG8_WAIT_V(8); PG8_WAIT_L(0); PG8_BAR; PG8_MMA(1, 0, At, B0); PG8_MMA(1, 1, At, B1); PG8_BAR; PG8_SCHED;
            PG8_LDB(B0, 1, 0); PG8_LDB(B1, 1, 1); PG8_SCHED; PG8_LDA(At, 1, 0); PG8_STAGE_A(PG8_SA(0, 1), a2, 1);
            PG8_WAIT_V(8); PG8_WAIT_L(0); PG8_BAR; PG8_MMA(0, 0, At, B0); PG8_MMA(0, 1, At, B1); PG8_BAR; PG8_SCHED;
            PG8_LDA(At, 1, 1); PG8_STAGE(PG8_SB(1, 0), b3, voffB); PG8_STAGE(PG8_SB(1, 1), b3 + hstepB, voffB); PG8_STAGE_A(PG8_SA(1, 0), a3, 0);
            PG8_WAIT_V(8); PG8_WAIT_L(0); PG8_BAR; PG8_MMA(1, 0, At, B0); PG8_MMA(1, 1, At, B1); PG8_BAR; PG8_SCHED;
        }
#if MK_ALIGN_EPI
        if (wr == 0) PG8_BAR;
#endif
        { int fr_ = fr, fq_ = fq; asm volatile("" : "+v"(fr_), "+v"(fq_));
          E(acc, cur, wr, wc, fr_, fq_); }
        if (!has_next) break;
#pragma unroll
        for (int a = 0; a < 2; ++a)
#pragma unroll
            for (int b = 0; b < 2; ++b)
#pragma unroll
                for (int m = 0; m < 4; ++m)
#pragma unroll
                    for (int n = 0; n < 2; ++n) acc[a][b][m][n] = (f32x4){0.f, 0.f, 0.f, 0.f};
        cur = nxt; cA = nA; cB = nB; ++ui;
#if MK_ALIGN_EPI
        if (wr == 1) PG8_BAR;
#endif
    }
    PG8_WAIT_V(0);
#if !MK_ALIGN_EPI
    if (wr == 0) PG8_BAR;
#endif
    PG8_BAR;
#undef PG8_SA
#undef PG8_SB
#undef PG8_STAGE
#undef PG8_STAGE_A
#undef PG8_LDA
#undef PG8_LDB
#undef PG8_MMA
#undef PG8_WAIT_V
#undef PG8_WAIT_L
#undef PG8_BAR
#undef PG8_SCHED
}
}

#define XB_TMO      128
#define XB_XCNT(j)  (256  + 64 * (j))
#define XB_XSUB(j)  (1280 + 64 * (j))
#define XB_XGEN(j)  (2304 + 64 * (j))
#define XB_TOP      3328
#define XB_TOPGEN   3392
#define XCD_BAR_WORDS 3456
#define XB_SPIN_CAP (1u << 20)
__device__ __forceinline__ unsigned xb_ld(unsigned* p)              { return __hip_atomic_load(p, __ATOMIC_RELAXED, __HIP_MEMORY_SCOPE_AGENT); }
__device__ __forceinline__ unsigned xb_add(unsigned* p, unsigned v) { return __hip_atomic_fetch_add(p, v, __ATOMIC_RELAXED, __HIP_MEMORY_SCOPE_AGENT); }
__device__ __forceinline__ unsigned xb_xcc_id() { return (unsigned)__builtin_amdgcn_s_getreg((3 << 11) | 20) & 0xFu; }
#define XB_SPIN(cond, bar) do { unsigned _sp = 0; while (cond) { __builtin_amdgcn_s_sleep(1); \
    if ((++_sp & 255u) == 0u) { if (xb_ld(&(bar)[XB_TMO])) break; if (_sp > XB_SPIN_CAP) { atomicAdd(&(bar)[XB_TMO], 1u); break; } } } } while (0)
struct XcdBarrier { unsigned* bar; unsigned x; volatile LAS unsigned* st; };
__device__ __forceinline__ XcdBarrier xcd_barrier_post(unsigned* bar, volatile LAS unsigned* st) {
    XcdBarrier b; b.bar = bar; b.x = xb_xcc_id(); b.st = st;
    if (threadIdx.x == 0) (void)xb_add(&bar[XB_XCNT(b.x)], 1u);
    return b;
}
__device__ __forceinline__ void xcd_barrier_complete(unsigned* bar, unsigned x, unsigned& nloc, unsigned& nx) {
    const unsigned G = gridDim.x * gridDim.y * gridDim.z;
    unsigned sum, cnt, mine, sp = 0u;
    for (;;) {
        sum = 0u; cnt = 0u; mine = 0u;
#pragma unroll 1
        for (unsigned j = 0; j < 16; ++j) { const unsigned c = xb_ld(&bar[XB_XCNT(j)]); sum += c; cnt += (c > 0u) ? 1u : 0u; mine = (j == x) ? c : mine; }
        if (sum == G) break;
        __builtin_amdgcn_s_sleep(1);
        if ((++sp & 255u) == 0u) { if (xb_ld(&bar[XB_TMO])) break; if (sp > XB_SPIN_CAP) { atomicAdd(&bar[XB_TMO], 1u); break; } }
    }
    nloc = mine > 0u ? mine : 1u; nx = cnt > 0u ? cnt : 1u;
}
__device__ __forceinline__ void xcd_barrier(const XcdBarrier& b, int wave_id) {
    asm volatile("s_waitcnt vmcnt(0)" ::: "memory");
    __syncthreads();
    if (wave_id == 0 && lane_id_fresh() == 0) {
        unsigned* bar = b.bar; asm volatile("" : "+s"(bar));
        __builtin_amdgcn_s_waitcnt(0);
        unsigned nloc = b.st[0], nx = b.st[1];
        if (nloc == 0u) { xcd_barrier_complete(bar, b.x, nloc, nx); b.st[0] = nloc; b.st[1] = nx; }
        const unsigned old = xb_add(&bar[XB_XSUB(b.x)], 1u);
        const unsigned gen = old / nloc;
        if (old + 1u == (gen + 1u) * nloc) {
            __builtin_amdgcn_fence(__ATOMIC_RELEASE, "agent");
            asm volatile("s_waitcnt vmcnt(0)" ::: "memory");
            const unsigned og = xb_add(&bar[XB_TOP], 1u);
            const unsigned tg = og / nx;
            if (og + 1u == (tg + 1u) * nx) xb_add(&bar[XB_TOPGEN], 1u);
            else XB_SPIN(xb_ld(&bar[XB_TOPGEN]) == tg, bar);
            __builtin_amdgcn_fence(__ATOMIC_ACQUIRE, "agent");
            xb_add(&bar[XB_XGEN(b.x)], 1u);
            asm volatile("s_waitcnt vmcnt(0)" ::: "memory");
        } else {
            XB_SPIN(xb_ld(&bar[XB_XGEN(b.x)]) == gen, bar);
            __builtin_amdgcn_fence(__ATOMIC_ACQUIRE, "agent");
            asm volatile("s_waitcnt vmcnt(0)" ::: "memory");
        }
    }
    __syncthreads();
}
namespace nsa {
constexpr int PITCH = 144, TILE_LDS = 64 * PITCH;
__device__ __forceinline__ int crow(int r, int hi) { return (r & 3) + 8 * (r >> 2) + 4 * hi; }
__device__ __forceinline__ int vslot(int kk) { return (kk & 0x33) | (((kk >> 2) & 1) << 3) | (((kk >> 3) & 1) << 2); }

struct Lane { int lane, c, hi, wid, tid; };

__device__ __forceinline__ void qk_tile(f32x16& p0, f32x16& p1, const LAS unsigned char* Ks, const bf16x8 (&qr)[4], float bias, const Lane& L) {
#pragma unroll
    for (int r = 0; r < 16; ++r) { p0[r] = bias; p1[r] = bias; }
    const LAS unsigned char* kb = Ks + L.c * PITCH + L.hi * 16;
#pragma unroll
    for (int d0 = 0; d0 < 4; ++d0) {
        const bf16x8 k0 = *(const LAS bf16x8*)(kb + d0 * 32);
        const bf16x8 k1 = *(const LAS bf16x8*)(kb + 32 * PITCH + d0 * 32);
        p0 = __builtin_amdgcn_mfma_f32_32x32x16_bf16(k0, qr[d0], p0, 0, 0, 0);
        p1 = __builtin_amdgcn_mfma_f32_32x32x16_bf16(k1, qr[d0], p1, 0, 0, 0);
    }
}
__device__ __forceinline__ void qk_tile_c(f32x16& p0, f32x16& p1, const LAS unsigned char* Ks, const bf16x8 (&qr)[4], const f32x16& cv, const Lane& L) {
    const LAS unsigned char* kb = Ks + L.c * PITCH + L.hi * 16;
    { const bf16x8 k0 = *(const LAS bf16x8*)(kb); const bf16x8 k1 = *(const LAS bf16x8*)(kb + 32 * PITCH);
      p0 = __builtin_amdgcn_mfma_f32_32x32x16_bf16(k0, qr[0], cv, 0, 0, 0); p1 = __builtin_amdgcn_mfma_f32_32x32x16_bf16(k1, qr[0], cv, 0, 0, 0); }
#pragma unroll
    for (int d0 = 1; d0 < 4; ++d0) {
        const bf16x8 k0 = *(const LAS bf16x8*)(kb + d0 * 32);
        const bf16x8 k1 = *(const LAS bf16x8*)(kb + 32 * PITCH + d0 * 32);
        p0 = __builtin_amdgcn_mfma_f32_32x32x16_bf16(k0, qr[d0], p0, 0, 0, 0);
        p1 = __builtin_amdgcn_mfma_f32_32x32x16_bf16(k1, qr[d0], p1, 0, 0, 0);
    }
}
__device__ __forceinline__ void mask_range(f32x16& p0, f32x16& p1, int lo, int hi_, int hi) {
#pragma unroll
    for (int r = 0; r < 16; ++r) { const int k0 = crow(r, hi), k1 = k0 + 32;
        if (k0 <= lo || k0 > hi_) p0[r] = NEGF;
        if (k1 <= lo || k1 > hi_) p1[r] = NEGF; }
}
__device__ __forceinline__ float tile_max(const f32x16& p0, const f32x16& p1) {
    float a = fmaxf(p0[0], p1[0]);
#pragma unroll
    for (int r = 1; r < 16; ++r) a = fmaxf(a, fmaxf(p0[r], p1[r]));
    return fmaxf(a, xshfl<32>(a));
}
__device__ __forceinline__ void pv_tile(f32x16& o0, f32x16& o1, const LAS unsigned char* Vs, const f32x16& p0, const f32x16& p1, const Lane& L) {
    const LAS unsigned char* vb = Vs + L.c * PITCH + L.hi * 16;
#pragma unroll
    for (int s = 0; s < 4; ++s) {
        u32x4 w;
        if (s < 2) { const int b = 8 * (s & 1); w.x = cvt_pk_bf16(p0[b], p0[b + 1]); w.y = cvt_pk_bf16(p0[b + 2], p0[b + 3]); w.z = cvt_pk_bf16(p0[b + 4], p0[b + 5]); w.w = cvt_pk_bf16(p0[b + 6], p0[b + 7]); }
        else       { const int b = 8 * (s & 1); w.x = cvt_pk_bf16(p1[b], p1[b + 1]); w.y = cvt_pk_bf16(p1[b + 2], p1[b + 3]); w.z = cvt_pk_bf16(p1[b + 4], p1[b + 5]); w.w = cvt_pk_bf16(p1[b + 6], p1[b + 7]); }
        const bf16x8 pf = __builtin_bit_cast(bf16x8, w);
        const bf16x8 v0 = *(const LAS bf16x8*)(vb + s * 32);
        const bf16x8 v1 = *(const LAS bf16x8*)(vb + 32 * PITCH + s * 32);
        o0 = __builtin_amdgcn_mfma_f32_32x32x16_bf16(v0, pf, o0, 0, 0, 0);
        o1 = __builtin_amdgcn_mfma_f32_32x32x16_bf16(v1, pf, o1, 0, 0, 0);
        if (s & 1) __builtin_amdgcn_sched_barrier(0);
    }
}
__device__ __forceinline__ void softmax_pv(f32x16& p0, f32x16& p1, f32x16& o0, f32x16& o1, float& m, float& l, const LAS unsigned char* Vs, const Lane& L) {
    const float mx = tile_max(p0, p1), mn = fmaxf(m, mx), alpha = fast_exp2(m - mn); m = mn;
    float ls = 0.f;
#pragma unroll
    for (int r = 0; r < 16; ++r) { p0[r] = fast_exp2(p0[r] - mn); p1[r] = fast_exp2(p1[r] - mn); ls += p0[r] + p1[r]; }
    l = l * alpha + ls;
#pragma unroll
    for (int r = 0; r < 16; ++r) { o0[r] *= alpha; o1[r] *= alpha; }
    pv_tile(o0, o1, Vs, p0, p1, L);
}
__device__ __forceinline__ int stage_off(int tid) { return (tid >> 3) * PITCH + (tid & 7) * 16; }

__device__ __forceinline__ void load_q(bf16x8 (&qr)[4], const bf16_t* qbuf, long tok, int head, int hi) {
    const bf16_t* qp = qbuf + tok * 512 + head * 64 + hi * 8;
#pragma unroll
    for (int d0 = 0; d0 < 4; ++d0) qr[d0] = *(const bf16x8*)(qp + d0 * 16);
}

__device__ __forceinline__ u32x4 vload(const bf16_t* Vt, int j, const Lane& L) { return *(const u32x4*)((const char*)Vt + (size_t)j * 8192 + L.lane * 128 + L.wid * 16); }
__device__ __forceinline__ void vstore(LAS unsigned char* Vs, const u32x4 v, const Lane& L) {
    LAS unsigned short* p = (LAS unsigned short*)(Vs + (8 * L.wid) * PITCH) + vslot(L.lane);
    p[0 * (PITCH / 2)] = (unsigned short)(v.x & 0xffffu); p[1 * (PITCH / 2)] = (unsigned short)(v.x >> 16); p[2 * (PITCH / 2)] = (unsigned short)(v.y & 0xffffu); p[3 * (PITCH / 2)] = (unsigned short)(v.y >> 16);
    p[4 * (PITCH / 2)] = (unsigned short)(v.z & 0xffffu); p[5 * (PITCH / 2)] = (unsigned short)(v.z >> 16); p[6 * (PITCH / 2)] = (unsigned short)(v.w & 0xffffu); p[7 * (PITCH / 2)] = (unsigned short)(v.w >> 16);
}
template <int MODE>
__device__ __forceinline__ void run_branch(f32x16& o0, f32x16& o1, float& mref, float& l, const bf16_t* Kt  , const bf16_t* Vt  ,
                                           int jlo, int jhi, int qb, int qrel, unsigned long long selw, const bf16x8 (&qr)[4], LAS unsigned char* lds, const Lane& L) {
    LAS unsigned char* Kbuf = lds; LAS unsigned char* Vbuf = lds + 2 * TILE_LDS;
    const int so = stage_off(L.tid);
    u32x4 kreg = *(const u32x4*)((const char*)Kt + (size_t)jlo * 8192 + L.tid * 16);
    u32x4 vreg = vload(Vt, jlo, L);
    *(LAS u32x4*)(Kbuf + so) = kreg; vstore(Vbuf, vreg, L);
    __syncthreads();
    f32x16 cv;
#pragma unroll
    for (int r = 0; r < 16; ++r) cv[r] = -mref;
    for (int j = jlo; j <= jhi; ++j) {
        const int cur = (j - jlo) & 1;
        if (j < jhi) { kreg = *(const u32x4*)((const char*)Kt + (size_t)(j + 1) * 8192 + L.tid * 16); vreg = vload(Vt, j + 1, L); }
        f32x16 p0, p1;
        if (MODE == 0) { const float cb = ((selw >> j) & 1ull) ? -mref : NEGF;
#pragma unroll
            for (int r = 0; r < 16; ++r) cv[r] = cb; }
        qk_tile_c(p0, p1, Kbuf + cur * TILE_LDS, qr, cv, L);
        if (j == qb) mask_range(p0, p1, -1, qrel, L.hi);
        if (MODE == 1 && j == qb - 8) mask_range(p0, p1, qrel, 64, L.hi);
        const float mx = tile_max(p0, p1);
        if (__any(mx > 8.0f)) {
            const float dl = fmaxf(mx, 0.f), f = fast_exp2(-dl); mref += dl; l *= f;
#pragma unroll
            for (int r = 0; r < 16; ++r) { o0[r] *= f; o1[r] *= f; p0[r] -= dl; p1[r] -= dl; }
            if (MODE == 1) {
#pragma unroll
                for (int r = 0; r < 16; ++r) cv[r] = -mref; }
        }
        float ls = 0.f;
#pragma unroll
        for (int r = 0; r < 16; ++r) { p0[r] = fast_exp2(p0[r]); p1[r] = fast_exp2(p1[r]); ls += p0[r] + p1[r]; }
        l += ls;
        pv_tile(o0, o1, Vbuf + cur * TILE_LDS, p0, p1, L);
        if (j < jhi) { *(LAS u32x4*)(Kbuf + (cur ^ 1) * TILE_LDS + so) = kreg; vstore(Vbuf + (cur ^ 1) * TILE_LDS, vreg, L); }
        __syncthreads();
    }
}
struct SoftState { float mref, l; };
__device__ __forceinline__ void softmax_step2(f32x16& p0, f32x16& p1, f32x16& o0, f32x16& o1, SoftState& st, bool sel, bf16x8 (&pf)[4]) {
    if (__any(st.mref != 0.f)) {
#pragma unroll
        for (int r = 0; r < 16; ++r) { p0[r] -= st.mref; p1[r] -= st.mref; } }
    float ls = 0.f;
#pragma unroll
    for (int r = 0; r < 16; ++r) { p0[r] = fast_exp2(p0[r]); p1[r] = fast_exp2(p1[r]); ls += p0[r] + p1[r]; }
    ls = sel ? ls : 0.f; st.l += ls;
#pragma unroll
    for (int s = 0; s < 4; ++s) { u32x4 w; const int b = 8 * (s & 1);
        if (s < 2) { w.x = cvt_pk_bf16(p0[b], p0[b + 1]); w.y = cvt_pk_bf16(p0[b + 2], p0[b + 3]); w.z = cvt_pk_bf16(p0[b + 4], p0[b + 5]); w.w = cvt_pk_bf16(p0[b + 6], p0[b + 7]); }
        else       { w.x = cvt_pk_bf16(p1[b], p1[b + 1]); w.y = cvt_pk_bf16(p1[b + 2], p1[b + 3]); w.z = cvt_pk_bf16(p1[b + 4], p1[b + 5]); w.w = cvt_pk_bf16(p1[b + 6], p1[b + 7]); }
        if (!sel) w = (u32x4){0u, 0u, 0u, 0u};
        pf[s] = __builtin_bit_cast(bf16x8, w); }
}
__device__ __forceinline__ void renorm_step(f32x16& o0, f32x16& o1, SoftState& st) {
    if (__any(st.l > 1.0995116e12f)) { const bool big = st.l > 1.0995116e12f; const float f = big ? 9.094947e-13f : 1.0f; st.mref += big ? 40.f : 0.f; st.l *= f;
#pragma unroll
        for (int r = 0; r < 16; ++r) { o0[r] *= f; o1[r] *= f; } }
}
template <int MODE>
__device__ __forceinline__ void run_branch2(f32x16& oa0, f32x16& oa1, SoftState& sa, f32x16& ob0, f32x16& ob1, SoftState& sb, const bf16_t* Kt, const bf16_t* Vt, int jlo, int jhi, int qbw, int qrela,
                                            const LAS unsigned long long* selp  , const bf16x8 (&qa)[4], const bf16x8 (&qbf)[4], LAS unsigned char* lds, const Lane& L) {
    LAS unsigned char* Kbuf = lds; LAS unsigned char* Vbuf = lds + 2 * TILE_LDS;
    const int so = stage_off(L.tid);
    {   const u32x4 kreg = *(const u32x4*)((const char*)Kt + (size_t)jlo * 8192 + L.tid * 16); const u32x4 vreg = vload(Vt, jlo, L);
        *(LAS u32x4*)(Kbuf + so) = kreg; vstore(Vbuf, vreg, L); }
    __syncthreads();
    for (int j = jlo; j <= jhi; ++j) {
        const int cur = (j - jlo) & 1;
        const bool act = (j <= qbw) && (MODE == 0 || j >= qbw - 8);
        u32x4 kreg, vreg;
        bf16x8 fa[4], fb[4];
        if (act) {
            f32x16 pa0, pa1, pb0, pb1;
#pragma unroll
            for (int r = 0; r < 16; ++r) { pa0[r] = 0.f; pa1[r] = 0.f; pb0[r] = 0.f; pb1[r] = 0.f; }
            const LAS unsigned char* kb = Kbuf + cur * TILE_LDS + L.c * PITCH + L.hi * 16;
#pragma unroll
            for (int d0 = 0; d0 < 4; ++d0) { const bf16x8 k0 = *(const LAS bf16x8*)(kb + d0 * 32); const bf16x8 k1 = *(const LAS bf16x8*)(kb + 32 * PITCH + d0 * 32);
                pa0 = __builtin_amdgcn_mfma_f32_32x32x16_bf16(k0, qa[d0], pa0, 0, 0, 0); pa1 = __builtin_amdgcn_mfma_f32_32x32x16_bf16(k1, qa[d0], pa1, 0, 0, 0);
                pb0 = __builtin_amdgcn_mfma_f32_32x32x16_bf16(k0, qbf[d0], pb0, 0, 0, 0); pb1 = __builtin_amdgcn_mfma_f32_32x32x16_bf16(k1, qbf[d0], pb1, 0, 0, 0); }
            if (j == qbw) { mask_range(pa0, pa1, -1, qrela, L.hi); mask_range(pb0, pb1, -1, qrela + 8, L.hi); }
            if (MODE == 1 && j == qbw - 8) { mask_range(pa0, pa1, qrela, 64, L.hi); mask_range(pb0, pb1, qrela + 8, 64, L.hi); }
            bool sela = true, selb = true;
            if (MODE == 0) { sela = (selp[0] >> j) & 1ull; selb = (selp[1] >> j) & 1ull; }
            softmax_step2(pa0, pa1, oa0, oa1, sa, sela, fa);
            __builtin_amdgcn_sched_barrier(0);
            softmax_step2(pb0, pb1, ob0, ob1, sb, selb, fb);
            __builtin_amdgcn_sched_barrier(0);
        }
        if (j < jhi) { kreg = *(const u32x4*)((const char*)Kt + (size_t)(j + 1) * 8192 + L.tid * 16); vreg = vload(Vt, j + 1, L); }
        if (act) {
            const LAS unsigned char* vb = Vbuf + cur * TILE_LDS + L.c * PITCH + L.hi * 16;
#pragma unroll
            for (int s = 0; s < 4; ++s) {
                const bf16x8 v0 = *(const LAS bf16x8*)(vb + s * 32); const bf16x8 v1 = *(const LAS bf16x8*)(vb + 32 * PITCH + s * 32);
                oa0 = __builtin_amdgcn_mfma_f32_32x32x16_bf16(v0, fa[s], oa0, 0, 0, 0); oa1 = __builtin_amdgcn_mfma_f32_32x32x16_bf16(v1, fa[s], oa1, 0, 0, 0);
                ob0 = __builtin_amdgcn_mfma_f32_32x32x16_bf16(v0, fb[s], ob0, 0, 0, 0); ob1 = __builtin_amdgcn_mfma_f32_32x32x16_bf16(v1, fb[s], ob1, 0, 0, 0); }
            renorm_step(oa0, oa1, sa); renorm_step(ob0, ob1, sb);
        }
        if (j < jhi) { *(LAS u32x4*)(Kbuf + (cur ^ 1) * TILE_LDS + so) = kreg; vstore(Vbuf + (cur ^ 1) * TILE_LDS, vreg, L); }
        __syncthreads();
    }
}
}
namespace nsa {
struct AttnPtrs {
    const bf16_t* q;
    const bf16_t* z;
    const bf16_t* kc;
    const bf16_t* vct;
    const bf16_t* ksel;
    const bf16_t* vselt;
    const bf16_t* kwin; const bf16_t* vwint;
    unsigned long long* selmask;
    bf16_t* mix;
};
template <bool ACCUM>
__device__ __forceinline__ void store_o(const f32x16& a0, const f32x16& a1, bf16_t* mix, long tok, int head, int hi) {
    bf16_t* op = mix + tok * 1024 + head * 64 + 4 * hi;
#pragma unroll
    for (int dd = 0; dd < 2; ++dd)
#pragma unroll
        for (int rq = 0; rq < 4; ++rq) {
            float v0, v1, v2, v3;
            if (dd == 0) { v0 = a0[4 * rq]; v1 = a0[4 * rq + 1]; v2 = a0[4 * rq + 2]; v3 = a0[4 * rq + 3]; }
            else         { v0 = a1[4 * rq]; v1 = a1[4 * rq + 1]; v2 = a1[4 * rq + 2]; v3 = a1[4 * rq + 3]; }
            u32x2* p = (u32x2*)(op + dd * 32 + rq * 8);
            if (ACCUM) { const u32x2 old = *p; v0 += bflo(old.x); v1 += bfhi(old.x); v2 += bflo(old.y); v3 += bfhi(old.y); }
            u32x2 w; w.x = cvt_pk_bf16(v0, v1); w.y = cvt_pk_bf16(v2, v3); *p = w;
        }
}
__device__ __forceinline__ float gate_of(const bf16_t* z, long tok, int head, int br) { return sigmoidf_(bf2f(z[tok * INP + ZG + head * 3 + br])); }

struct CmpPre { bf16x8 qr[4]; };
__device__ __forceinline__ void cmp_prefetch(CmpPre& R, int bh, int qb, const AttnPtrs& P, const Lane& L) {
    const int b = bh >> 1, h = bh & 1, tq = qb * 64 + 8 * L.wid + (L.c >> 2), head = 4 * h + (L.c & 3); const long tok = (long)b * SEQ + tq;
    load_q(R.qr, P.q, tok, head, L.hi);
}
__device__ __forceinline__ void cmp_stage(const CmpPre& R, LAS unsigned char* lds, const Lane& L, bf16x8 (&qr)[4], float& gt) {
    (void)lds; (void)L;
#pragma unroll
    for (int d0 = 0; d0 < 4; ++d0) qr[d0] = R.qr[d0];
    gt = 0.f;
}
template <bool STAGE>
__device__ __forceinline__ void cmp_unit(int bh, int qb, const AttnPtrs& P, LAS unsigned char* lds, const Lane& L) {
    const int b = bh >> 1, h = bh & 1, t0 = qb * 64;
    const int ql = 8 * L.wid + (L.c >> 2), g = L.c & 3, tq = t0 + ql, head = 4 * h + g;
    const long tok = (long)b * SEQ + tq;
    LAS unsigned char* Kb = lds; LAS unsigned char* Vb = lds + 4 * TILE_LDS;
    LAS float* G4 = (LAS float*)(lds + 8 * TILE_LDS); LAS float* E3 = G4 + 64 * 64;
    const float gate_raw = bf2f(P.z[tok * INP + ZG + head * 3 + 0]);
    bf16x8 qr[4]; load_q(qr, P.q, tok, head, L.hi);
    if (STAGE) { const char* ks = (const char*)(P.kc + (size_t)bh * 256 * 64); const char* vs = (const char*)(P.vct + (size_t)bh * 256 * 64); const int so = stage_off(L.tid); u32x4 kk[4], vv[4];
#pragma unroll
      for (int jn = 0; jn < 4; ++jn) kk[jn] = *(const u32x4*)(ks + jn * 8192 + L.tid * 16);
#pragma unroll
      for (int jn = 0; jn < 4; ++jn) vv[jn] = *(const u32x4*)(vs + jn * 8192 + L.tid * 16);
#pragma unroll
      for (int jn = 0; jn < 4; ++jn) *(LAS u32x4*)(Kb + jn * TILE_LDS + so) = kk[jn];
#pragma unroll
      for (int jn = 0; jn < 4; ++jn) *(LAS u32x4*)(Vb + jn * TILE_LDS + so) = vv[jn]; }
    __syncthreads();
    const int nmax = (tq >= 31) ? ((tq - 31) >> 4) : -1;
    const int tq_lo = t0 + 8 * L.wid, tq_hi = tq_lo + 7;
    const int nmax_lo = (tq_lo >= 31) ? ((tq_lo - 31) >> 4) : -1, nmax_hi = (tq_hi >= 31) ? ((tq_hi - 31) >> 4) : -1;
    const int ntile = (nmax_hi >= 0) ? (nmax_hi >> 6) + 1 : 0;
    const bool need_imp = qb >= 16;
    float l = 0.f;
    f32x16 o0, o1;
#pragma unroll
    for (int r = 0; r < 16; ++r) { o0[r] = 0.f; o1[r] = 0.f; }
    float gsr[4][8], e3r[4][8];
#pragma unroll
    for (int jn = 0; jn < 4; ++jn)
#pragma unroll
        for (int i = 0; i < 8; ++i) { gsr[jn][i] = 0.f; e3r[jn][i] = 0.f; }
#pragma unroll
    for (int jn = 0; jn < 4; ++jn) {
        if (jn < ntile) {
            f32x16 p0, p1; qk_tile(p0, p1, Kb + jn * TILE_LDS, qr, 0.f, L);
            if (64 * jn + 63 > nmax_lo) mask_range(p0, p1, -1, nmax - 64 * jn, L.hi);
            float ls = 0.f;
#pragma unroll
            for (int r = 0; r < 16; ++r) { p0[r] = fast_exp2(p0[r]); p1[r] = fast_exp2(p1[r]); ls += p0[r] + p1[r]; }
            l += ls;
            if (need_imp) {
#pragma unroll
                for (int rq = 0; rq < 4; ++rq) { gsr[jn][rq] = (p0[4 * rq] + p0[4 * rq + 1]) + (p0[4 * rq + 2] + p0[4 * rq + 3]); e3r[jn][rq] = p0[4 * rq + 3];
                                                 gsr[jn][4 + rq] = (p1[4 * rq] + p1[4 * rq + 1]) + (p1[4 * rq + 2] + p1[4 * rq + 3]); e3r[jn][4 + rq] = p1[4 * rq + 3]; } }
            pv_tile(o0, o1, Vb + jn * TILE_LDS, p0, p1, L);
        }
        __builtin_amdgcn_sched_barrier(0);
    }
    l = xsum32(l);
    const float inv = (nmax >= 0 && l > 0.f) ? fast_rcp(l) : 0.f;
    if (need_imp) {
        LAS float* gp = G4 + ql * 64 + L.hi; asm volatile("" : "+v"(gp));
#pragma unroll
        for (int jn = 0; jn < 4; ++jn) {
            if (jn < ntile) {
#pragma unroll
                for (int i = 0; i < 8; ++i) { float gs = gsr[jn][i] * inv, e3 = e3r[jn][i] * inv;
                    gs += xshfl<1>(gs); gs += xshfl<2>(gs); e3 += xshfl<1>(e3); e3 += xshfl<2>(e3);
                    if (g == 0) { gp[16 * jn + 2 * i] = gs; gp[64 * 64 + 16 * jn + 2 * i] = e3; } }
            }
        }
    }
    {
        const float gt = sigmoidf_(gate_raw) * inv;
#pragma unroll
        for (int r = 0; r < 16; ++r) { o0[r] *= gt; o1[r] *= gt; }
        store_o<false>(o0, o1, P.mix, tok, head, L.hi);
    }
    __syncthreads();
}
__device__ __forceinline__ void cmp_topk(int bh, int qb, const AttnPtrs& P, LAS unsigned char* lds, const Lane& L) {
    const int t0 = qb * 64; LAS float* G4 = (LAS float*)(lds + 8 * TILE_LDS); LAS float* E3 = G4 + 64 * 64;
    const int s = L.lane;
    if (qb < 16) { const unsigned long long mask = (1ull << (qb + 1)) - 1ull;
        if (L.lane < 8) P.selmask[(size_t)bh * SEQ + t0 + 8 * L.wid + L.lane] = mask; }
    else {
        const bool cand = (s >= 1) && (s <= qb - 2);
        unsigned bits[8], T[8];
#pragma unroll
        for (int i = 0; i < 8; ++i) { const int q = 8 * L.wid + i; const float imp = G4[q * 64 + s] + (s > 0 ? E3[q * 64 + s - 1] : 0.f); bits[i] = cand ? __float_as_uint(fmaxf(imp, 0.f)) : 0u; T[i] = 0u; }
        int cnt[8];
#pragma unroll
        for (int i = 0; i < 8; ++i) cnt[i] = qb - 2;
        for (int bit = 30; bit >= 0; --bit) { int open_ = 0;
#pragma unroll
            for (int i = 0; i < 8; ++i) { const unsigned c = T[i] | (1u << bit); const int n = __popcll(__ballot(cand && bits[i] >= c)); if (n >= 13) { T[i] = c; cnt[i] = n; } open_ |= (cnt[i] != 13); }
            if (!open_) break; }
#pragma unroll
        for (int i = 0; i < 8; ++i) {
            const unsigned long long gt = __ballot(cand && bits[i] > T[i]); unsigned long long eq = __ballot(cand && bits[i] == T[i]);
            int need = 13 - __popcll(gt); unsigned long long take = 0ull;
            while (need > 0 && eq) { const unsigned long long low = eq & (0ull - eq); take |= low; eq ^= low; --need; }
            const unsigned long long mask = gt | take | 1ull | (1ull << qb) | (1ull << (qb - 1));
            if (L.lane == 0) P.selmask[(size_t)bh * SEQ + t0 + 8 * L.wid + i] = mask; }
    }
    __syncthreads();
}

__device__ __forceinline__ void sw_unit(int bh, int qb, const AttnPtrs& P, LAS unsigned char* lds, const Lane& L) {
    const int b = bh >> 1, h = bh & 1, t0 = qb * 64;
    const int ql = 8 * L.wid + (L.c >> 2), g = L.c & 3, tq = t0 + ql, head = 4 * h + g;
    const long tok = (long)b * SEQ + tq;
    bf16x8 qr[4]; load_q(qr, P.q, tok, head, L.hi);
    const unsigned long long selw = P.selmask[(size_t)bh * SEQ + tq];
    const float g1raw = bf2f(P.z[tok * INP + ZG + head * 3 + 1]), g2raw = bf2f(P.z[tok * INP + ZG + head * 3 + 2]);
    f32x16 r0, r1;
    {
        f32x16 o0, o1; float m = 0.f, l = 0.f;
#pragma unroll
        for (int r = 0; r < 16; ++r) { o0[r] = 0.f; o1[r] = 0.f; }
        run_branch<0>(o0, o1, m, l, P.ksel + (size_t)bh * SEQ * 64, P.vselt + (size_t)bh * SEQ * 64, 0, qb, qb, ql, selw, qr, lds, L);
        l = xsum32(l);
        const float sc = sigmoidf_(g1raw) * fast_rcp(l);
#pragma unroll
        for (int r = 0; r < 16; ++r) { r0[r] = o0[r] * sc; r1[r] = o1[r] * sc; }
    }
    {
        f32x16 o0, o1; float m = 0.f, l = 0.f;
#pragma unroll
        for (int r = 0; r < 16; ++r) { o0[r] = 0.f; o1[r] = 0.f; }
        run_branch<1>(o0, o1, m, l, P.kwin + (size_t)bh * SEQ * 64, P.vwint + (size_t)bh * SEQ * 64, qb >= 8 ? qb - 8 : 0, qb, qb, ql, 0ull, qr, lds, L);
        l = xsum32(l);
        const float sc = sigmoidf_(g2raw) * fast_rcp(l);
#pragma unroll
        for (int r = 0; r < 16; ++r) { r0[r] += o0[r] * sc; r1[r] += o1[r] * sc; }
    }
    store_o<true>(r0, r1, P.mix, tok, head, L.hi);
}
__device__ __forceinline__ void sw_unit2(int bh, int qb2, const AttnPtrs& P, LAS unsigned char* lds, const Lane& L) {
    const int b = bh >> 1, h = bh & 1, qbw = 2 * qb2 + (L.wid >> 2);
    const int qrela = 16 * (L.wid & 3) + (L.c >> 2), qrelb = qrela + 8, g = L.c & 3, head = 4 * h + g;
    const long toka = (long)b * SEQ + 64 * qbw + qrela, tokb = toka + 8;
    bf16x8 qa[4], qbf[4]; load_q(qa, P.q, toka, head, L.hi); load_q(qbf, P.q, tokb, head, L.hi);
    LAS unsigned long long* selp = (LAS unsigned long long*)(lds + 4 * TILE_LDS + 8192) + L.tid * 2;
    selp[0] = P.selmask[(size_t)bh * SEQ + 64 * qbw + qrela]; selp[1] = P.selmask[(size_t)bh * SEQ + 64 * qbw + qrelb];
    LAS float* gpark = (LAS float*)(lds + 4 * TILE_LDS) + L.tid * 4;
    gpark[0] = bf2f(P.z[toka * INP + ZG + head * 3 + 1]); gpark[1] = bf2f(P.z[tokb * INP + ZG + head * 3 + 1]); gpark[2] = bf2f(P.z[toka * INP + ZG + head * 3 + 2]); gpark[3] = bf2f(P.z[tokb * INP + ZG + head * 3 + 2]);
    {
        f32x16 oa0, oa1, ob0, ob1; SoftState sa{0.f, 0.f}, sb{0.f, 0.f};
#pragma unroll
        for (int r = 0; r < 16; ++r) { oa0[r] = 0.f; oa1[r] = 0.f; ob0[r] = 0.f; ob1[r] = 0.f; }
        run_branch2<0>(oa0, oa1, sa, ob0, ob1, sb, P.ksel + (size_t)bh * SEQ * 64, P.vselt + (size_t)bh * SEQ * 64, 0, 2 * qb2 + 1, qbw, qrela, selp, qa, qbf, lds, L);
        sa.l = xsum32(sa.l); sb.l = xsum32(sb.l);
        const float sca = sigmoidf_(gpark[0]) * fast_rcp(sa.l), scb = sigmoidf_(gpark[1]) * fast_rcp(sb.l);
#pragma unroll
        for (int r = 0; r < 16; ++r) { oa0[r] *= sca; oa1[r] *= sca; ob0[r] *= scb; ob1[r] *= scb; }
        { int qe = qrela; asm volatile("" : "+v"(qe));
          store_o<true>(oa0, oa1, P.mix, (long)b * SEQ + 64 * qbw + qe, head, L.hi); store_o<true>(ob0, ob1, P.mix, (long)b * SEQ + 64 * qbw + qe + 8, head, L.hi); }
    }
    {
        f32x16 oa0, oa1, ob0, ob1; SoftState sa{0.f, 0.f}, sb{0.f, 0.f};
#pragma unroll
        for (int r = 0; r < 16; ++r) { oa0[r] = 0.f; oa1[r] = 0.f; ob0[r] = 0.f; ob1[r] = 0.f; }
        run_branch2<1>(oa0, oa1, sa, ob0, ob1, sb, P.kwin + (size_t)bh * SEQ * 64, P.vwint + (size_t)bh * SEQ * 64, 2 * qb2 >= 8 ? 2 * qb2 - 8 : 0, 2 * qb2 + 1, qbw, qrela, selp, qa, qbf, lds, L);
        sa.l = xsum32(sa.l); sb.l = xsum32(sb.l);
        const float sca = sigmoidf_(gpark[2]) * fast_rcp(sa.l), scb = sigmoidf_(gpark[3]) * fast_rcp(sb.l);
#pragma unroll
        for (int r = 0; r < 16; ++r) { oa0[r] *= sca; oa1[r] *= sca; ob0[r] *= scb; ob1[r] *= scb; }
        { int qe = qrela; asm volatile("" : "+v"(qe));
          store_o<true>(oa0, oa1, P.mix, (long)b * SEQ + 64 * qbw + qe, head, L.hi); store_o<true>(ob0, ob1, P.mix, (long)b * SEQ + 64 * qbw + qe + 8, head, L.hi); }
    }
}
}
namespace epi {
using pg8::Unit; using pg8::BM; using pg8::HALF;
struct Bf16Plain {
    static constexpr bool PERM = true;
    bf16_t* O; int ldc;
    __device__ __forceinline__ void operator()(const f32x4 (&acc)[2][2][4][2], const Unit& u, int wr, int wc, int fr, int fq) const {
        const int row0 = u.pm * BM + wr * 64 + fr, col0 = u.pn * BM + wc * 32 + 8 * fq;
#pragma unroll
        for (int ai = 0; ai < 2; ++ai)
#pragma unroll
            for (int m = 0; m < 4; ++m) { bf16_t* rowp = O + (size_t)(row0 + ai * HALF + m * 16) * ldc + col0;
#pragma unroll
                for (int bj = 0; bj < 2; ++bj) { const f32x4 v0 = acc[ai][bj][m][0], v1 = acc[ai][bj][m][1];
                    u32x4 w; w.x = cvt_pk_bf16(v0[0], v0[1]); w.y = cvt_pk_bf16(v0[2], v0[3]); w.z = cvt_pk_bf16(v1[0], v1[1]); w.w = cvt_pk_bf16(v1[2], v1[3]);
                    *(u32x4*)(rowp + bj * HALF) = w; } }
    }
};
struct Bf16Sc1 {
    static constexpr bool PERM = true;
    bf16_t* O; int ldc; unsigned nbytes;
    __device__ __forceinline__ void operator()(const f32x4 (&acc)[2][2][4][2], const Unit& u, int wr, int wc, int fr, int fq) const {
        const __amdgpu_buffer_rsrc_t rsrc = __builtin_amdgcn_make_buffer_rsrc(O, 0, nbytes, 0x00020000);
        const int row0 = u.pm * BM + wr * 64 + fr, col0 = u.pn * BM + wc * 32 + 8 * fq;
#pragma unroll
        for (int ai = 0; ai < 2; ++ai)
#pragma unroll
            for (int m = 0; m < 4; ++m) { const unsigned off = (unsigned)(((size_t)(row0 + ai * HALF + m * 16) * ldc + col0) * 2);
#pragma unroll
                for (int bj = 0; bj < 2; ++bj) { const f32x4 v0 = acc[ai][bj][m][0], v1 = acc[ai][bj][m][1];
                    u32x4 w; w.x = cvt_pk_bf16(v0[0], v0[1]); w.y = cvt_pk_bf16(v0[2], v0[3]); w.z = cvt_pk_bf16(v1[0], v1[1]); w.w = cvt_pk_bf16(v1[2], v1[3]);
                    __builtin_amdgcn_raw_buffer_store_b128(w, rsrc, off + bj * HALF * 2, 0,   16); } }
    }
};
struct F32Grouped {
    static constexpr bool PERM = false;
    float* C; int ldc; size_t gstride;
    __device__ __forceinline__ void operator()(const f32x4 (&acc)[2][2][4][2], const Unit& u, int wr, int wc, int fr, int fq) const {
        const int row0 = u.pm * BM + wr * 64 + fr, col0 = u.pn * BM + wc * 32 + 4 * fq; float* Cg = C + (size_t)u.aux * gstride;
#pragma unroll
        for (int ai = 0; ai < 2; ++ai)
#pragma unroll
            for (int m = 0; m < 4; ++m) { float* rowp = Cg + (size_t)(row0 + ai * HALF + m * 16) * ldc + col0;
#pragma unroll
                for (int bj = 0; bj < 2; ++bj)
#pragma unroll
                    for (int n = 0; n < 2; ++n) *(f32x4*)(rowp + bj * HALF + n * 16) = acc[ai][bj][m][n]; }
    }
};
struct SwiGlu {
    static constexpr bool PERM = true;
    bf16_t* H; int ldc;
    __device__ __forceinline__ void operator()(const f32x4 (&acc)[2][2][4][2], const Unit& u, int wr, int wc, int fr, int fq) const {
        const int row0 = u.pm * BM + wr * 64 + fr, col0 = u.pn * HALF + wc * 32 + 8 * fq;
#pragma unroll
        for (int ai = 0; ai < 2; ++ai)
#pragma unroll
            for (int m = 0; m < 4; ++m) { bf16_t* rowp = H + (size_t)(row0 + ai * HALF + m * 16) * ldc + col0;
                float o[8];
#pragma unroll
                for (int n = 0; n < 2; ++n)
#pragma unroll
                    for (int e = 0; e < 4; ++e) o[4 * n + e] = siluf_(acc[ai][0][m][n][e]) * acc[ai][1][m][n][e];
                u32x4 w; w.x = cvt_pk_bf16(o[0], o[1]); w.y = cvt_pk_bf16(o[2], o[3]); w.z = cvt_pk_bf16(o[4], o[5]); w.w = cvt_pk_bf16(o[6], o[7]);
                *(u32x4*)rowp = w; }
    }
};
struct MoeDown {
    static constexpr bool PERM = true;
    bf16_t* Y; const int* row_tok;
    __device__ __forceinline__ void operator()(const f32x4 (&acc)[2][2][4][2], const Unit& u, int wr, int wc, int fr, int fq) const {
        const int srow0 = u.aux * BM + wr * 64 + fr, col0 = u.pn * BM + wc * 32 + 8 * fq;
        int dsts[8];
#pragma unroll
        for (int it = 0; it < 8; ++it) dsts[it] = row_tok[srow0 + (it >> 2) * HALF + (it & 3) * 16];
#pragma unroll
        for (int ai = 0; ai < 2; ++ai)
#pragma unroll
            for (int m = 0; m < 4; ++m) { const int dst = dsts[ai * 4 + m];
                if (dst >= 0) { bf16_t* rowp = Y + (size_t)dst * D + col0;
#pragma unroll
                    for (int bj = 0; bj < 2; ++bj) { const f32x4 v0 = acc[ai][bj][m][0], v1 = acc[ai][bj][m][1];
                        u32x4 w; w.x = cvt_pk_bf16(v0[0], v0[1]); w.y = cvt_pk_bf16(v0[2], v0[3]); w.z = cvt_pk_bf16(v1[0], v1[1]); w.w = cvt_pk_bf16(v1[2], v1[3]);
                        *(u32x4*)(rowp + bj * HALF) = w; } } }
    }
};
struct SigmoidBias {
    static constexpr bool PERM = true;
    bf16_t* O; int ldc; const float* bias;
    __device__ __forceinline__ void operator()(const f32x4 (&acc)[2][2][4][2], const Unit& u, int wr, int wc, int fr, int fq) const {
        const int row0 = u.pm * BM + wr * 64 + fr, col0 = u.pn * BM + wc * 32 + 8 * fq;
        f32x4 bv[2][2];
#pragma unroll
        for (int bj = 0; bj < 2; ++bj)
#pragma unroll
            for (int n = 0; n < 2; ++n) bv[bj][n] = *(const f32x4*)(bias + col0 + bj * HALF + 4 * n);
#pragma unroll
        for (int ai = 0; ai < 2; ++ai)
#pragma unroll
            for (int m = 0; m < 4; ++m) { bf16_t* rowp = O + (size_t)(row0 + ai * HALF + m * 16) * ldc + col0;
#pragma unroll
                for (int bj = 0; bj < 2; ++bj) { f32x4 v0 = acc[ai][bj][m][0] + bv[bj][0], v1 = acc[ai][bj][m][1] + bv[bj][1];
#pragma unroll
                    for (int e = 0; e < 4; ++e) { v0[e] = sigmoidf_(v0[e]); v1[e] = sigmoidf_(v1[e]); }
                    u32x4 w; w.x = cvt_pk_bf16(v0[0], v0[1]); w.y = cvt_pk_bf16(v0[2], v0[3]); w.z = cvt_pk_bf16(v1[0], v1[1]); w.w = cvt_pk_bf16(v1[2], v1[3]);
                    *(u32x4*)(rowp + bj * HALF) = w; } }
    }
};
struct MulBf16 {
    static constexpr bool PERM = true;
    bf16_t* O; const bf16_t* G; int ldc;
    __device__ __forceinline__ void operator()(const f32x4 (&acc)[2][2][4][2], const Unit& u, int wr, int wc, int fr, int fq) const {
        const int row0 = u.pm * BM + wr * 64 + fr, col0 = u.pn * BM + wc * 32 + 8 * fq;
        u32x4 gq[2], gn[2];
        { const size_t off = (size_t)row0 * ldc + col0; gn[0] = *(const u32x4*)(G + off); gn[1] = *(const u32x4*)(G + off + HALF); }
#pragma unroll
        for (int it = 0; it < 8; ++it) { const int ai = it >> 2, m = it & 3; const size_t off = (size_t)(row0 + ai * HALF + m * 16) * ldc + col0;
            gq[0] = gn[0]; gq[1] = gn[1];
            if (it < 7) { const int ai2 = (it + 1) >> 2, m2 = (it + 1) & 3; const size_t off2 = (size_t)(row0 + ai2 * HALF + m2 * 16) * ldc + col0; gn[0] = *(const u32x4*)(G + off2); gn[1] = *(const u32x4*)(G + off2 + HALF); }
#pragma unroll
            for (int bj = 0; bj < 2; ++bj) { const f32x4 v0 = acc[ai][bj][m][0], v1 = acc[ai][bj][m][1]; const u32x4 g4 = gq[bj];
                u32x4 w; w.x = cvt_pk_bf16(v0[0] * bflo(g4.x), v0[1] * bfhi(g4.x)); w.y = cvt_pk_bf16(v0[2] * bflo(g4.y), v0[3] * bfhi(g4.y));
                w.z = cvt_pk_bf16(v1[0] * bflo(g4.z), v1[1] * bfhi(g4.z)); w.w = cvt_pk_bf16(v1[2] * bflo(g4.w), v1[3] * bfhi(g4.w));
                *(u32x4*)(O + off + bj * HALF) = w; }
            asm volatile("" ::: "memory"); }
    }
};
struct S5Out {
    static constexpr bool PERM = true;
    bf16_t* ZS5; const bf16_t* Z; const float* dskip;
    __device__ __forceinline__ void operator()(const f32x4 (&acc)[2][2][4][2], const Unit& u, int wr, int wc, int fr, int fq) const {
        const int g = u.aux, row0 = u.pm * BM + wr * 64 + fr;
#pragma unroll
        for (int bj = 0; bj < 2; ++bj) { const int col = u.pn * BM + bj * HALF + wc * 32 + 8 * fq, jo = col >> 4, co0 = col & 15, ch0 = g * 16 + co0;
            const f32x4 d0 = *(const f32x4*)(dskip + ch0), d1 = *(const f32x4*)(dskip + ch0 + 4);
#pragma unroll
            for (int ai = 0; ai < 2; ++ai)
#pragma unroll
                for (int m = 0; m < 4; ++m) { const int mr = row0 + ai * HALF + m * 16; const long tok = (long)(mr >> 7) * SEQ + (mr & 127) * S5LC + jo;
                    const u32x4 uq = *(const u32x4*)(Z + tok * INP + ZS + ch0); const f32x4 v0 = acc[ai][bj][m][0], v1 = acc[ai][bj][m][1];
                    u32x4 w; w.x = cvt_pk_bf16(gelu_tanh(v0[0] + d0[0] * bflo(uq.x)), gelu_tanh(v0[1] + d0[1] * bfhi(uq.x)));
                    w.y = cvt_pk_bf16(gelu_tanh(v0[2] + d0[2] * bflo(uq.y)), gelu_tanh(v0[3] + d0[3] * bfhi(uq.y)));
                    w.z = cvt_pk_bf16(gelu_tanh(v1[0] + d1[0] * bflo(uq.z)), gelu_tanh(v1[1] + d1[1] * bfhi(uq.z)));
                    w.w = cvt_pk_bf16(gelu_tanh(v1[2] + d1[2] * bflo(uq.w)), gelu_tanh(v1[3] + d1[3] * bfhi(uq.w)));
                    *(u32x4*)(ZS5 + tok * 256 + ch0) = w; asm volatile("" ::: "memory"); } }
    }
};
struct S5Glu {
    static constexpr bool PERM = true;
    bf16_t* MIX; const bf16_t* ZS5; const float* bias;
    __device__ __forceinline__ void operator()(const f32x4 (&acc)[2][2][4][2], const Unit& u, int wr, int wc, int fr, int fq) const {
        const int row0 = u.pm * BM + wr * 64 + fr, col0 = wc * 32 + 8 * fq;
#pragma unroll
        for (int bj = 0; bj < 2; ++bj) { const int col = col0 + bj * HALF; const f32x4 b0 = *(const f32x4*)(bias + col), b1 = *(const f32x4*)(bias + col + 4);
#pragma unroll
            for (int ai = 0; ai < 2; ++ai)
#pragma unroll
                for (int m = 0; m < 4; ++m) { const size_t row = (size_t)(row0 + ai * HALF + m * 16); const u32x4 zq = *(const u32x4*)(ZS5 + row * 256 + col);
                    const f32x4 v0 = acc[ai][bj][m][0] + b0, v1 = acc[ai][bj][m][1] + b1;
                    u32x4 w; w.x = cvt_pk_bf16(bflo(zq.x) * sigmoidf_(v0[0]), bfhi(zq.x) * sigmoidf_(v0[1])); w.y = cvt_pk_bf16(bflo(zq.y) * sigmoidf_(v0[2]), bfhi(zq.y) * sigmoidf_(v0[3]));
                    w.z = cvt_pk_bf16(bflo(zq.z) * sigmoidf_(v1[0]), bfhi(zq.z) * sigmoidf_(v1[1])); w.w = cvt_pk_bf16(bflo(zq.w) * sigmoidf_(v1[2]), bfhi(zq.w) * sigmoidf_(v1[3]));
                    *(u32x4*)(MIX + row * 1024 + 768 + col) = w; asm volatile("" ::: "memory"); } }
    }
};
struct EpiWin {
    static constexpr bool PERM = true;
    bf16_t* Z; bf16_t* Q; bf16_t* KV; bf16_t* AP; const f32x2* rope;
    __device__ __forceinline__ void operator()(const f32x4 (&acc)[2][2][4][2], const Unit& u, int wr, int wc, int fr, int fq) const {
        const int row0 = u.pm * BM + wr * 64 + fr;
        if (u.pn >= 5) {
#pragma unroll
            for (int bj = 0; bj < 2; ++bj) { const int col0 = u.pn * BM + bj * HALF + wc * 32 + 8 * fq; const int sc0 = col0 - ZS; const bool s5 = (sc0 >= 0) && (sc0 < 256);
#pragma unroll
                for (int ai = 0; ai < 2; ++ai)
#pragma unroll
                    for (int m = 0; m < 4; ++m) { const int tok = row0 + ai * HALF + m * 16; const f32x4 v0 = acc[ai][bj][m][0], v1 = acc[ai][bj][m][1];
                        u32x4 w; w.x = cvt_pk_bf16(v0[0], v0[1]); w.y = cvt_pk_bf16(v0[2], v0[3]); w.z = cvt_pk_bf16(v1[0], v1[1]); w.w = cvt_pk_bf16(v1[2], v1[3]);
                        *(u32x4*)(Z + (size_t)tok * INP + col0) = w;
                        if (s5) { const int b = tok >> 12, t = tok & 4095; *(u32x4*)(AP + ((size_t)(sc0 >> 4) * 2048 + b * 128 + (t >> 5)) * S5K + (t & 31) * 16 + (sc0 & 15)) = w; } } }
            return;
        }
#pragma unroll
        for (int bj = 0; bj < 2; ++bj) {
            const int colh = bj * HALF + wc * 32 + 8 * fq;
            const int qi = 4 * (wc & 1) + fq, d1 = 4 * qi;
            const bool isv = (u.pn >= 2) && (bj == 1);
            f32x4 cn0 = (f32x4){0.f, 0.f, 0.f, 0.f}, cn1 = cn0;
            if (!isv) { cn0 = *(const f32x4*)(rope + (size_t)row0 * 32 + d1); cn1 = *(const f32x4*)(rope + (size_t)row0 * 32 + d1 + 2); }
#pragma unroll
            for (int it = 0; it < 8; ++it) { const int ai = it >> 2, m = it & 3; const int tok = row0 + ai * HALF + m * 16; const int b = tok >> 12, t = tok & 4095; const f32x4 x1 = acc[ai][bj][m][0], x2 = acc[ai][bj][m][1];
                    if (isv) { bf16_t* dst = KV + (size_t)((u.pn - 2) * 2 + 1) * (8u << 20) + ((size_t)(b * 2 + (wc >> 1)) * SEQ + t) * 64 + 32 * (wc & 1) + 8 * fq;
                        u32x4 w; w.x = cvt_pk_bf16(x1[0], x1[1]); w.y = cvt_pk_bf16(x1[2], x1[3]); w.z = cvt_pk_bf16(x2[0], x2[1]); w.w = cvt_pk_bf16(x2[2], x2[3]); *(u32x4*)dst = w; }
                    else { const f32x4 cs0 = cn0, cs1 = cn1;
                        if (it < 7) { const int tok2 = row0 + ((it + 1) >> 2) * HALF + ((it + 1) & 3) * 16; cn0 = *(const f32x4*)(rope + (size_t)tok2 * 32 + d1); cn1 = *(const f32x4*)(rope + (size_t)tok2 * 32 + d1 + 2); }
                        const float sc = (u.pn < 2) ? QSCALE : 1.0f;
                        const float o10 = (x1[0] * cs0[0] - x2[0] * cs0[1]) * sc, o11 = (x1[1] * cs0[2] - x2[1] * cs0[3]) * sc, o12 = (x1[2] * cs1[0] - x2[2] * cs1[1]) * sc, o13 = (x1[3] * cs1[2] - x2[3] * cs1[3]) * sc;
                        const float o20 = (x2[0] * cs0[0] + x1[0] * cs0[1]) * sc, o21 = (x2[1] * cs0[2] + x1[1] * cs0[3]) * sc, o22 = (x2[2] * cs1[0] + x1[2] * cs1[1]) * sc, o23 = (x2[3] * cs1[2] + x1[3] * cs1[3]) * sc;
                        bf16_t* dst = (u.pn < 2) ? Q + (size_t)tok * 512 + (u.pn * 4 + (colh >> 6)) * 64 + d1
                                                 : KV + (size_t)((u.pn - 2) * 2) * (8u << 20) + ((size_t)(b * 2 + (wc >> 1)) * SEQ + t) * 64 + d1;
                        u32x2 w1, w2; w1.x = cvt_pk_bf16(o10, o11); w1.y = cvt_pk_bf16(o12, o13); w2.x = cvt_pk_bf16(o20, o21); w2.y = cvt_pk_bf16(o22, o23);
                        *(u32x2*)dst = w1; *(u32x2*)(dst + 32) = w2; }
                    asm volatile("" ::: "memory"); }
        }
    }
};
}
constexpr size_t MiB = 1u << 20;
constexpr size_t WS_CTL = 0, CTL_ZERO_BYTES = 1 * MiB;
constexpr size_t WS_SMALL = 1 * MiB;
constexpr size_t SM_APOW = WS_SMALL;
constexpr size_t SM_BBAR = WS_SMALL + 5 * MiB / 4;
constexpr size_t SM_KTAB = WS_SMALL + 2 * MiB;
constexpr size_t SM_CMPB = WS_SMALL + 4 * MiB;
constexpr size_t SM_TOKE = WS_SMALL + 4 * MiB + 256 * 1024;
constexpr size_t SM_TOKW = WS_SMALL + 4 * MiB + 512 * 1024;
constexpr size_t SM_ROWTOK = WS_SMALL + 5 * MiB + 256 * 1024;
constexpr size_t SM_PCNT = WS_SMALL + 6 * MiB;
constexpr size_t SM_TILEEXP = WS_SMALL + 6 * MiB + 16384;
constexpr size_t WS_ROPE = 8 * MiB;
constexpr size_t WS_W = 24 * MiB;
constexpr size_t W_IN = WS_W;
constexpr size_t W_OUT = W_IN + (size_t)INP * D * 2;
constexpr size_t W_GATE = W_OUT + (size_t)D * D * 2;
constexpr size_t W_PROJ = W_GATE + (size_t)D * D * 2;
constexpr size_t W_CMP = W_PROJ + (size_t)D * PLE * 2;
constexpr size_t W_GLU = W_CMP + (size_t)2 * 512 * 1024 * 2;
constexpr size_t W_S5B = W_GLU + (size_t)256 * 256 * 2;
constexpr size_t W_S5S = W_S5B + (size_t)16 * 512 * S5K * 2;
constexpr size_t W_UP = W_S5S + (size_t)16 * 256 * 512 * 2;
constexpr size_t W_DN = W_UP + (size_t)NEXP * 2 * DFE * D * 2;
constexpr size_t W_END_ = W_DN + (size_t)NEXP * D * DFE * 2;
static_assert(W_END_ <= WS_W + 240 * MiB, "weight region");
constexpr size_t WS_XB = 264 * MiB;
constexpr size_t WS_PB = 392 * MiB;
constexpr size_t WS_Z = 424 * MiB;
constexpr size_t WS_QKV = 712 * MiB;
constexpr size_t WS_Q = WS_QKV, WS_KCMP = WS_QKV + 64 * MiB, WS_VCMP = WS_KCMP + 16 * MiB, WS_KSEL = WS_VCMP + 16 * MiB, WS_VSEL = WS_KSEL + 16 * MiB, WS_KWIN = WS_VSEL + 16 * MiB, WS_VWIN = WS_KWIN + 16 * MiB;
constexpr size_t WS_MIX = 872 * MiB;
constexpr size_t WS_CMP = 1000 * MiB;
constexpr size_t WS_CMPP = WS_CMP, WS_KC = WS_CMP + 32 * MiB, WS_VCT = WS_KC + 1 * MiB, WS_SELM = WS_VCT + 1 * MiB;
constexpr size_t WS_S5 = 1036 * MiB;
constexpr size_t WS_S5A = WS_S5, WS_S5S = WS_S5 + 40 * MiB, WS_ZS5 = WS_S5S + 32 * MiB;
constexpr size_t WS_HBUF = 1140 * MiB;
constexpr size_t WS_END = 1268 * MiB;
constexpr size_t WS_FFH = WS_Z, WS_MH = WS_Z, WS_YT = WS_MIX, WS_YB = WS_END - 256 * MiB;
static_assert(WS_MH + (size_t)MOE_CHUNK_TILES * 256 * DFE * 2 <= WS_YT && WS_YT + 7ull * 2048 * D * 4 <= WS_YB && WS_FFH + (size_t)T * DFF * 2 <= WS_MIX, "overlays");
constexpr size_t WS_PLEG = WS_Z, WS_PLEH = WS_Z + 128 * MiB;
static_assert(WS_PLEH + 128 * MiB <= WS_YB, "per-layer-embedding buffers of the MoE layers");
constexpr int CW_BAR = 4096;
constexpr int CW_TMO = 64;
constexpr int CW_CNT = 16384, CNT_BANK = 256 * 64;
static_assert((CW_CNT + 8 * CNT_BANK) * 4 <= (int)CTL_ZERO_BYTES, "panel counters inside the per-call memset");

struct Args { const void* in[36]; float* out; unsigned char* ws; int gp_lo, gp_hi, use_bar, pad; };
struct Frame { LAS unsigned char* lds; int tid, lane, wave, G, bid, own; };
constexpr int RING_BYTES = 131072, LDSCTL_OFF = RING_BYTES, LDS_BYTES = 147456;
typedef __attribute__((address_space(4))) const Args CArgs;
__device__ __forceinline__ void load_args(Args& a) { CArgs* p = (CArgs*)__builtin_amdgcn_kernarg_segment_ptr(); asm volatile("" : "+s"(p)); __builtin_memcpy(&a, p, sizeof(Args)); }
__device__ __forceinline__ Frame make_frame(LAS unsigned char* lds, int wave0) { Frame F; F.lds = lds;
    int w = wave0; asm volatile("" : "+s"(w)); int ln = lane_id_fresh(); F.lane = ln; F.wave = w; F.tid = w * 64 + ln;
    int b = blockIdx.x, g = gridDim.x; asm volatile("" : "+s"(b), "+s"(g)); F.bid = b; F.G = g;
    F.own = (g == 256) ? 32 * (b & 7) + (b >> 3) : b; return F; }

__constant__ double c_invfreq_rev[32] = {0.15915494309189535, 0.11934937021124886, 0.08949940160889101, 0.06711508300522726, 0.050329212104487035, 0.03774158471741977, 0.0283021958306234, 0.02122365276477766, 0.015915494309189534, 0.011934937021124886, 0.008949940160889102, 0.006711508300522725, 0.005032921210448704, 0.003774158471741977, 0.00283021958306234, 0.0021223652764777662, 0.0015915494309189536, 0.0011934937021124885, 0.0008949940160889102, 0.0006711508300522726, 0.0005032921210448703, 0.00037741584717419774, 0.00028302195830623395, 0.0002122365276477766, 0.00015915494309189535, 0.00011934937021124886, 8.949940160889102e-05, 6.711508300522725e-05, 5.0329212104487035e-05, 3.774158471741978e-05, 2.8302195830623396e-05, 2.122365276477766e-05};

__device__ __forceinline__ void sincos_rev(double rev, float& c, float& s) { const double fr = rev - __builtin_floor(rev); const float f = (float)fr; s = __builtin_amdgcn_sinf(f); c = __builtin_amdgcn_cosf(f); }

template <class Sched>
__device__ __forceinline__ void panels_publish_wait(const Frame& F, unsigned* ctl, int bank, const Sched& S, unsigned need) {
    unsigned* cnt = ctl + CW_CNT + bank * CNT_BANK;
    if (F.tid == 0) { pg8::Unit u; for (int i = 0; S.next(i, u); ++i) __hip_atomic_fetch_add(cnt + 64 * u.pm, 1u, __ATOMIC_RELAXED, __HIP_MEMORY_SCOPE_AGENT); }
    if (F.wave == 0) {
        for (int pm = F.own; pm < T / 256; pm += F.G) { unsigned spins = 0;
            while ((unsigned)__builtin_amdgcn_readfirstlane(__hip_atomic_load(cnt + 64 * pm, __ATOMIC_RELAXED, __HIP_MEMORY_SCOPE_AGENT)) < need) {
                __builtin_amdgcn_s_sleep(1);
                if (++spins > (1u << 22)) { if (F.lane == 0) __hip_atomic_store(ctl + CW_TMO, 1u, __ATOMIC_RELAXED, __HIP_MEMORY_SCOPE_AGENT); break; }
                if ((spins & 1023u) == 0u && __builtin_amdgcn_readfirstlane(__hip_atomic_load(ctl + CW_TMO, __ATOMIC_RELAXED, __HIP_MEMORY_SCOPE_AGENT))) break; } }
        __builtin_amdgcn_fence(__ATOMIC_ACQUIRE, "agent");
        asm volatile("s_waitcnt vmcnt(0)" ::: "memory");
    }
    __syncthreads();
}
__device__ __forceinline__ void phase_init0(const Frame& F, const Args& a) {
    const size_t gt = (size_t)F.bid * 512 + F.tid, NT = (size_t)F.G * 512;
    const int* pos = (const int*)a.in[2]; f32x2* rope = (f32x2*)(a.ws + WS_ROPE);
    for (size_t i = gt; i < (size_t)T * 32; i += NT) { const int tok = (int)(i >> 5), k = (int)(i & 31); float c, s; sincos_rev((double)pos[tok] * c_invfreq_rev[k], c, s); rope[i] = (f32x2){c, s}; }
    const float* are = (const float*)a.in[14]; const float* aim = (const float*)a.in[15]; const float* ldt = (const float*)a.in[16];
    const float* bre = (const float*)a.in[17]; const float* bim = (const float*)a.in[18];
    f32x2* apow = (f32x2*)(a.ws + SM_APOW); f32x2* bbar = (f32x2*)(a.ws + SM_BBAR);
    for (size_t i = gt; i < (size_t)DEPTH * 16 * 64 * 34; i += NT) { const int k = (int)(i % 34), lgn = (int)(i / 34), lg = lgn >> 6;
        const float dt = __expf(ldt[lg]); const float ar = are[lgn] * dt; const double rev = (double)k * ((double)aim[lgn] * (double)dt) * 0.15915494309189535;
        float c, s; sincos_rev(rev, c, s); const float mg = __expf((float)k * ar); apow[i] = (f32x2){mg * c, mg * s}; }
    for (size_t i = gt; i < (size_t)DEPTH * 16 * 64 * 16; i += NT) { const int lgn = (int)(i >> 4), lg = lgn >> 6;
        const float dt = __expf(ldt[lg]); const float lr = are[lgn], li = aim[lgn]; const double rev = ((double)li * (double)dt) * 0.15915494309189535;
        float c, s; sincos_rev(rev, c, s); const float mg = __expf(lr * dt); const float abr = mg * c, abi = mg * s, den = lr * lr + li * li;
        const float cr = ((abr - 1.0f) * lr + abi * li) / den, ci = (abi * lr - (abr - 1.0f) * li) / den;
        const float br = bre[i], bi = bim[i]; bbar[i] = (f32x2){cr * br - ci * bi, cr * bi + ci * br}; }
    const f32x4* x4 = (const f32x4*)a.in[0]; u32x2* xb = (u32x2*)(a.ws + WS_XB);
    for (size_t i = gt; i < (size_t)T * D / 4; i += 4 * NT) { f32x4 v[4];
#pragma unroll
        for (int q = 0; q < 4; ++q) { const size_t ii = i + q * NT; v[q] = (ii < (size_t)T * D / 4) ? x4[ii] : (f32x4){0.f, 0.f, 0.f, 0.f}; }
#pragma unroll
        for (int q = 0; q < 4; ++q) { const size_t ii = i + q * NT; if (ii < (size_t)T * D / 4) { u32x2 w; w.x = cvt_pk_bf16(v[q][0], v[q][1]); w.y = cvt_pk_bf16(v[q][2], v[q][3]); xb[ii] = w; } } }
}
__device__ __forceinline__ void phase_init1(const Frame& F, const Args& a) {
    const size_t gt = (size_t)F.bid * 512 + F.tid, NT = (size_t)F.G * 512;
    const float* cre = (const float*)a.in[19]; const float* cim = (const float*)a.in[20];
    const f32x2* apow = (const f32x2*)(a.ws + SM_APOW); const f32x2* bbar = (const f32x2*)(a.ws + SM_BBAR); float* ktab = (float*)(a.ws + SM_KTAB);
    for (size_t i = gt; i < (size_t)DEPTH * 16 * 32 * 256; i += NT) { const int ci = (int)(i & 15), co = (int)((i >> 4) & 15), tau = (int)((i >> 8) & 31), lg = (int)(i >> 13);
        float acc = 0.f;
        for (int n = 0; n < 64; ++n) { const f32x2 P = apow[((size_t)lg * 64 + n) * 34 + tau], Bb = bbar[((size_t)lg * 64 + n) * 16 + ci]; const float cr = cre[((size_t)lg * 16 + co) * 64 + n], cm = cim[((size_t)lg * 16 + co) * 64 + n];
            const float hr = P.x * Bb.x - P.y * Bb.y, hi = P.x * Bb.y + P.y * Bb.x; acc += cr * hr - cm * hi; }
        ktab[i] = acc; }
}

__device__ __forceinline__ void transpose_item(const float* W, int ldw, int k0, int n0, int nvalid, bf16_t* dstrow, int dst_ld, LAS float* scr, int lane, int permhi) {
    float tv[32];
#pragma unroll
    for (int i = 0; i < 32; ++i) { const int kk = 2 * i + (lane >> 5), nn = lane & 31; tv[i] = (nn < nvalid) ? W[(size_t)(k0 + kk) * ldw + n0 + nn] : 0.f; }
#pragma unroll
    for (int i = 0; i < 32; ++i) { const int kk = 2 * i + (lane >> 5), nn = lane & 31; scr[kk * 33 + nn] = tv[i]; }
    LDS_WAIT(); asm volatile("" ::: "memory");
    const int c = lane & 7;
#pragma unroll
    for (int j = 0; j < 4; ++j) { const int n = (lane >> 3) + 8 * j; const LAS float* s = scr + (8 * c) * 33 + n;
        u32x4 o; o.x = cvt_pk_bf16(s[0 * 33], s[1 * 33]); o.y = cvt_pk_bf16(s[2 * 33], s[3 * 33]); o.z = cvt_pk_bf16(s[4 * 33], s[5 * 33]); o.w = cvt_pk_bf16(s[6 * 33], s[7 * 33]);
        const int drow = permhi < 0 ? n : (8 * (n >> 2) + 4 * permhi + (n & 3));
        if (n < nvalid) *(u32x4*)(dstrow + (size_t)drow * dst_ld + 8 * c) = o; }
    LDS_WAIT(); asm volatile("" ::: "memory");
}
__device__ __forceinline__ void transpose_mat(const float* W, int K, int N, bf16_t* dst, int dst_ld, int mode, LAS float* scr, int lane, int& cursor, int gw, int NGW) {
    const int nblk = (N + 31) / 32, items = (K / 64) * nblk;
    int it = ((gw - cursor) % NGW + NGW) % NGW;
    for (; it < items; it += NGW) { const int kb = it / nblk, nb = it % nblk, k0 = 64 * kb, n0 = 32 * nb; const int nv = (N - n0) < 32 ? (N - n0) : 32;
        int drow = n0, permhi = -1;
        if (mode == 1 || mode == 2) drow = (n0 >> 7) * 256 + (n0 & 127) + (mode == 2 ? 128 : 0);
        if (mode == 3 && (n0 < 512 || (n0 < 1280 && (((n0 - 512) >> 7) & 1) == 0))) { drow = n0 & ~63; permhi = (n0 >> 5) & 1; }
        transpose_item(W, N, k0, n0, nv, dst + (size_t)drow * dst_ld + k0, dst_ld, scr, lane, permhi); }
    cursor = (cursor + items) % NGW;
}

__device__ __forceinline__ void phase_prep(const Frame& F, const Args& a, int l) {
    LAS float* scr = (LAS float*)(F.lds + F.wave * 16384);
    const int gw = F.bid * 8 + F.wave, NGW = F.G * 8; int cursor = 0;
    unsigned char* ws = a.ws;
    transpose_mat((const float*)a.in[3] + (size_t)l * D * INW, D, INW, (bf16_t*)(ws + W_IN), D, 3, scr, F.lane, cursor, gw, NGW);
    transpose_mat((const float*)a.in[4] + (size_t)l * D * D, D, D, (bf16_t*)(ws + W_OUT), D, 0, scr, F.lane, cursor, gw, NGW);
    transpose_mat((const float*)a.in[31] + (size_t)l * D * D, D, D, (bf16_t*)(ws + W_GATE), D, 0, scr, F.lane, cursor, gw, NGW);
    transpose_mat((const float*)a.in[33] + (size_t)l * PLE * D, PLE, D, (bf16_t*)(ws + W_PROJ), PLE, 0, scr, F.lane, cursor, gw, NGW);
    for (int j = 0; j < 2; ++j) { const float* w1 = (const float*)a.in[6] + ((size_t)l * 2 + j) * 2048 * 256; bf16_t* dst = (bf16_t*)(ws + W_CMP) + (size_t)j * 512 * 1024;
        transpose_mat(w1, 1024, 256, dst, 1024, 0, scr, F.lane, cursor, gw, NGW);
        transpose_mat(w1 + (size_t)1024 * 256, 1024, 256, dst + (size_t)256 * 1024, 1024, 0, scr, F.lane, cursor, gw, NGW); }
    transpose_mat((const float*)a.in[22] + (size_t)l * 256 * 256, 256, 256, (bf16_t*)(ws + W_GLU), 256, 0, scr, F.lane, cursor, gw, NGW);
    const int j2 = l >> 1;
    if ((l & 1) == 0) {
        transpose_mat((const float*)a.in[24] + (size_t)j2 * D * DFF, D, DFF, (bf16_t*)(ws + W_UP), D, 1, scr, F.lane, cursor, gw, NGW);
        transpose_mat((const float*)a.in[25] + (size_t)j2 * D * DFF, D, DFF, (bf16_t*)(ws + W_UP), D, 2, scr, F.lane, cursor, gw, NGW);
        transpose_mat((const float*)a.in[26] + (size_t)j2 * DFF * D, DFF, D, (bf16_t*)(ws + W_DN), DFF, 0, scr, F.lane, cursor, gw, NGW);
    } else {
        for (int e = 0; e < NEXP; ++e) { const size_t eo = (size_t)j2 * NEXP + e;
            transpose_mat((const float*)a.in[28] + eo * D * DFE, D, DFE, (bf16_t*)(ws + W_UP) + (size_t)e * 2 * DFE * D, D, 1, scr, F.lane, cursor, gw, NGW);
            transpose_mat((const float*)a.in[29] + eo * D * DFE, D, DFE, (bf16_t*)(ws + W_UP) + (size_t)e * 2 * DFE * D, D, 2, scr, F.lane, cursor, gw, NGW);
            transpose_mat((const float*)a.in[30] + eo * DFE * D, DFE, D, (bf16_t*)(ws + W_DN) + (size_t)e * D * DFE, DFE, 0, scr, F.lane, cursor, gw, NGW); }
    }
    const size_t gt = (size_t)F.bid * 512 + F.tid, NT = (size_t)F.G * 512;
    {
        u32x4* zp = (u32x4*)((bf16_t*)(ws + W_IN) + (size_t)INW * D); const size_t n16 = (size_t)(INP - INW) * D * 2 / 16;
        unsigned zz = 0u; asm volatile("" : "+v"(zz));
        for (size_t i = gt; i < n16; i += NT) zp[i] = (u32x4){zz, zz, zz, zz};
    }
    {
        const f32x4* p4 = (const f32x4*)((const float*)a.in[1] + (size_t)l * T * PLE); u32x2* pb = (u32x2*)(ws + WS_PB);
        for (size_t i = gt; i < (size_t)T * PLE / 4; i += 4 * NT) { f32x4 v[4];
#pragma unroll
            for (int q = 0; q < 4; ++q) { const size_t ii = i + q * NT; v[q] = (ii < (size_t)T * PLE / 4) ? p4[ii] : (f32x4){0.f, 0.f, 0.f, 0.f}; }
#pragma unroll
            for (int q = 0; q < 4; ++q) { const size_t ii = i + q * NT; if (ii < (size_t)T * PLE / 4) { u32x2 w; w.x = cvt_pk_bf16(v[q][0], v[q][1]); w.y = cvt_pk_bf16(v[q][2], v[q][3]); pb[ii] = w; } } }
    }
    {
        const float* ktab = (const float*)(ws + SM_KTAB) + (size_t)l * 16 * 32 * 256; const f32x2* apow = (const f32x2*)(ws + SM_APOW) + (size_t)l * 16 * 64 * 34; const f32x2* bbar = (const f32x2*)(ws + SM_BBAR) + (size_t)l * 16 * 64 * 16;
        const float* cre = (const float*)a.in[19] + (size_t)l * 16 * 16 * 64; const float* cim = (const float*)a.in[20] + (size_t)l * 16 * 16 * 64;
        bf16_t* Bt = (bf16_t*)(ws + W_S5B);
        for (size_t i = gt; i < (size_t)16 * 512 * S5K; i += NT) { const int k = (int)(i % S5K), row = (int)((i / S5K) & 511), g = (int)(i / ((size_t)S5K * 512)); const int jo = row >> 4, co = row & 15;
            float v;
            if (k < 512) { const int ji = k >> 4, ci = k & 15; v = (jo >= ji) ? ktab[(((size_t)g * 32 + (jo - ji)) * 16 + co) * 16 + ci] : 0.f; }
            else { const int n = (k - 512) & 63; const f32x2 P = apow[((size_t)g * 64 + n) * 34 + jo + 1]; const float cr = cre[((size_t)g * 16 + co) * 64 + n], cm = cim[((size_t)g * 16 + co) * 64 + n];
                v = (k < 576) ? (cr * P.x - cm * P.y) : -(cr * P.y + cm * P.x); }
            Bt[i] = f2bf(v); }
        bf16_t* St = (bf16_t*)(ws + W_S5S);
        for (size_t i = gt; i < (size_t)16 * 256 * 512; i += NT) { const int k = (int)(i & 511), np = (int)((i >> 9) & 255), g = (int)(i >> 17); const int j = k >> 4, ci = k & 15;
            float v = 0.f;
            if (np < 128) { const int n = np & 63; const f32x2 P = apow[((size_t)g * 64 + n) * 34 + (S5LC - 1 - j)], Bb = bbar[((size_t)g * 64 + n) * 16 + ci]; v = (np < 64) ? (P.x * Bb.x - P.y * Bb.y) : (P.x * Bb.y + P.y * Bb.x); }
            St[i] = f2bf(v); }
    }
    {
        float* cb = (float*)(ws + SM_CMPB); LAS float* red = (LAS float*)(F.lds + 8 * 16384 - 4096);
        for (int o = F.bid; o < 8; o += F.G) { const int j = o >> 2, cblk = o & 3; const float* w1 = (const float*)a.in[6] + ((size_t)l * 2 + j) * 2048 * 256 + cblk * 64 + F.lane; const float* pe = (const float*)a.in[5] + ((size_t)l * 2 + j) * 2048;
            float s0 = 0.f, s1 = 0.f, s2 = 0.f, s3 = 0.f;
#pragma unroll 4
            for (int k = 256 * F.wave; k < 256 * F.wave + 256; k += 4) { s0 += pe[k] * w1[(size_t)k * 256]; s1 += pe[k + 1] * w1[(size_t)(k + 1) * 256]; s2 += pe[k + 2] * w1[(size_t)(k + 2) * 256]; s3 += pe[k + 3] * w1[(size_t)(k + 3) * 256]; }
            __syncthreads(); red[F.wave * 64 + F.lane] = (s0 + s1) + (s2 + s3); __syncthreads();
            if (F.wave == 0) { float t = ((const float*)a.in[7])[((size_t)l * 2 + j) * 256 + cblk * 64 + F.lane];
#pragma unroll
                for (int w = 0; w < 8; ++w) t += red[w * 64 + F.lane];
                cb[j * 256 + cblk * 64 + F.lane] = t; }
            __syncthreads(); }
    }
}

__device__ __forceinline__ void conv_items(const Frame& F, const Args& a, int l, int first, int stride, int last = NB * (SEQ / 32)) {
    const bf16_t* z = (const bf16_t*)(a.ws + WS_Z); bf16_t* mix = (bf16_t*)(a.ws + WS_MIX);
    const float* cw = (const float*)a.in[10] + (size_t)l * 31 * 256; const float* cb = (const float*)a.in[11] + (size_t)l * 256;
    const float* lg = (const float*)a.in[12] + (size_t)l * 256; const float* lb = (const float*)a.in[13] + (size_t)l * 256;
    LAS float* U = (LAS float*)F.lds;
    LAS float* Y = (LAS float*)(F.lds + 65536);
    const int cp = F.tid & 127, tg = F.tid >> 7, c = 2 * cp;
    f32x2 w[31];
#pragma unroll
    for (int j = 0; j < 31; ++j) w[j] = *(const f32x2*)(cw + j * 256 + c);
    const f32x2 bias = *(const f32x2*)(cb + c);
    unsigned pva[16], pvg[16];
    auto fetch = [&](int it) { const int b = it >> 7, t0 = (it & 127) * 32;
#pragma unroll
        for (int q = 0; q < 16; ++q) { const int r = tg + 4 * q, t = t0 - 30 + r; pva[q] = 0u; pvg[q] = 0u;
            if (r < 62 && t >= 0) { const bf16_t* zr = z + ((size_t)b * SEQ + t) * INP + ZC; pva[q] = *(const unsigned*)(zr + c); pvg[q] = *(const unsigned*)(zr + 256 + c); } } };
    if (first < last) fetch(first);
    for (int it = first; it < last; it += stride) { const int b = it >> 7, t0 = (it & 127) * 32;
#pragma unroll
        for (int q = 0; q < 16; ++q) { const int r = tg + 4 * q, t = t0 - 30 + r;
            if (r < 62) { f32x2 u = (f32x2){0.f, 0.f}; if (t >= 0) u = (f32x2){bflo(pva[q]) * sigmoidf_(bflo(pvg[q])), bfhi(pva[q]) * sigmoidf_(bfhi(pvg[q]))};
                *(LAS f32x2*)(U + r * 256 + c) = u; } }
        if (it + stride < last) fetch(it + stride);
        __syncthreads();
        {   f32x2 acc[8];
#pragma unroll
            for (int i = 0; i < 8; ++i) acc[i] = bias;
#pragma unroll
            for (int k = 0; k < 38; ++k) { const f32x2 u = *(const LAS f32x2*)(U + (tg * 8 + k) * 256 + c);
#pragma unroll
                for (int i = 0; i < 8; ++i) { const int j = k - i; if (j >= 0 && j < 31) acc[i] += w[j] * u; } }
#pragma unroll
            for (int i = 0; i < 8; ++i) *(LAS f32x2*)(Y + (tg * 8 + i) * 256 + c) = acc[i];
        }
        __syncthreads();
        for (int i = 0; i < 4; ++i) { const int tl = F.wave * 4 + i; const f32x4 v = *(const LAS f32x4*)(Y + tl * 256 + F.lane * 4);
            const float mean = wave_sum((v[0] + v[1]) + (v[2] + v[3])) * (1.f / 256.f); const f32x4 dlt = v - mean;
            const float var = wave_sum((dlt[0] * dlt[0] + dlt[1] * dlt[1]) + (dlt[2] * dlt[2] + dlt[3] * dlt[3])) * (1.f / 256.f); const float rstd = 1.0f / sqrtf(var + LN_EPS);
            const f32x4 gg = *(const f32x4*)(lg + F.lane * 4), bb = *(const f32x4*)(lb + F.lane * 4);
            float o[4];
#pragma unroll
            for (int e = 0; e < 4; ++e) o[e] = siluf_(dlt[e] * rstd * gg[e] + bb[e]);
            u32x2 wv; wv.x = cvt_pk_bf16(o[0], o[1]); wv.y = cvt_pk_bf16(o[2], o[3]);
            *(u32x2*)(mix + ((size_t)b * SEQ + t0 + tl) * 1024 + 512 + F.lane * 4) = wv; }
        __syncthreads();
    }
}
__device__ __forceinline__ void cmp_stage2(const Frame& F, const Args& a, int l) {
    unsigned char* ws = a.ws; const float* cb = (const float*)(ws + SM_CMPB);
    LAS float* w2s = (LAS float*)F.lds;
    LAS float* hs = (LAS float*)(F.lds + 65536 + F.wave * 1024);
    const int gw = F.bid * 8 + F.wave, NGW = F.G * 8, lane = F.lane;
    for (int j = 0; j < 2; ++j) {
        const float* w2 = (const float*)a.in[8] + ((size_t)l * 2 + j) * 256 * 64; const float* b2 = (const float*)a.in[9] + ((size_t)l * 2 + j) * 64;
        __syncthreads();
        for (int i = F.tid; i < 256 * 64 / 4; i += 512) *(LAS f32x4*)(w2s + 4 * i) = *(const f32x4*)(w2 + 4 * i);
        __syncthreads();
        for (int it = gw; it < 32 * 256; it += NGW) { const int bh = it >> 8, n = it & 255;
            float outv = 0.f;
            if (n < NCMP) {
                const float* P = (const float*)(ws + WS_CMPP) + (size_t)j * 8192 * 512 + ((size_t)bh * 256 + n) * 512;
                const f32x4 p0 = *(const f32x4*)(P + lane * 4), p1 = *(const f32x4*)(P + 512 + 256 + lane * 4), bb = *(const f32x4*)(cb + j * 256 + lane * 4);
                f32x4 hv;
#pragma unroll
                for (int e = 0; e < 4; ++e) hv[e] = gelu_tanh(p0[e] + p1[e] + bb[e]);
                *(LAS f32x4*)(hs + lane * 4) = hv; LDS_WAIT(); asm volatile("" ::: "memory");
                float acc0 = b2[lane], acc1 = 0.f, acc2 = 0.f, acc3 = 0.f;
#pragma unroll 4
                for (int c = 0; c < 256; c += 4) { const f32x4 h4 = *(const LAS f32x4*)(hs + c);
                    acc0 += h4[0] * w2s[c * 64 + lane]; acc1 += h4[1] * w2s[(c + 1) * 64 + lane]; acc2 += h4[2] * w2s[(c + 2) * 64 + lane]; acc3 += h4[3] * w2s[(c + 3) * 64 + lane]; }
                outv = (acc0 + acc1) + (acc2 + acc3); LDS_WAIT(); asm volatile("" ::: "memory");
            }
            if (j == 0) ((bf16_t*)(ws + WS_KC))[((size_t)bh * 256 + n) * 64 + lane] = f2bf(outv);
            else ((bf16_t*)(ws + WS_VCT))[((size_t)bh * 4 + (n >> 6)) * 4096 + lane * 64 + nsa::vslot(n & 63)] = f2bf(outv);
        }
    }
    __syncthreads();
}
__device__ __forceinline__ void cmp_stage2_panel(const Frame& F, const Args& a, int l, int j, int bh) {
    constexpr int HP = 528;
    unsigned char* ws = a.ws; const float* cb = (const float*)(ws + SM_CMPB);
    LAS unsigned char* Hs = F.lds;
    LAS unsigned char* Ws = F.lds + 128 * HP;
    const int lane = F.lane, w = F.wave;
    const float* w2 = (const float*)a.in[8] + ((size_t)l * 2 + j) * 256 * 64; const float* b2 = (const float*)a.in[9] + ((size_t)l * 2 + j) * 64;
    const float* Pb = (const float*)(ws + WS_CMPP) + (size_t)j * 8192 * 512 + (size_t)bh * 256 * 512;
    __syncthreads();
    for (int i = F.tid; i < 256 * 64; i += 512) { const int c = i >> 6, d = i & 63; *(LAS bf16_t*)(Ws + d * HP + c * 2) = f2bf(w2[i]); }
    const f32x4 bb = *(const f32x4*)(cb + j * 256 + lane * 4);
    for (int half = 0; half < 2; ++half) {
        __syncthreads();
#pragma unroll 4
        for (int rr = 0; rr < 16; ++rr) { const int r = 16 * w + rr, n = half * 128 + r, n1 = n < 255 ? n + 1 : n;
            const f32x4 p0 = *(const f32x4*)(Pb + (size_t)n * 512 + lane * 4), p1 = *(const f32x4*)(Pb + (size_t)n1 * 512 + 256 + lane * 4);
            u32x2 hv; hv.x = cvt_pk_bf16(gelu_tanh(p0[0] + p1[0] + bb[0]), gelu_tanh(p0[1] + p1[1] + bb[1])); hv.y = cvt_pk_bf16(gelu_tanh(p0[2] + p1[2] + bb[2]), gelu_tanh(p0[3] + p1[3] + bb[3]));
            *(LAS u32x2*)(Hs + r * HP + lane * 8) = hv; }
        __syncthreads();
        f32x4 acc[4];
#pragma unroll
        for (int cbk = 0; cbk < 4; ++cbk) acc[cbk] = (f32x4){0.f, 0.f, 0.f, 0.f};
        const LAS unsigned char* ap = Hs + (16 * w + (lane & 15)) * HP + (lane >> 4) * 16;
        const LAS unsigned char* bp = Ws + (lane & 15) * HP + (lane >> 4) * 16;
#pragma unroll
        for (int ks = 0; ks < 8; ++ks) { const bf16x8 af = *(const LAS bf16x8*)(ap + ks * 64);
#pragma unroll
            for (int cbk = 0; cbk < 4; ++cbk) { const bf16x8 bf = *(const LAS bf16x8*)(bp + cbk * 16 * HP + ks * 64); acc[cbk] = __builtin_amdgcn_mfma_f32_16x16x32_bf16(af, bf, acc[cbk], 0, 0, 0); } }
#pragma unroll
        for (int cbk = 0; cbk < 4; ++cbk) { const int d = 16 * cbk + (lane & 15); const float bv = b2[d];
#pragma unroll
            for (int e = 0; e < 4; ++e) { const int n = half * 128 + 16 * w + 4 * (lane >> 4) + e; const float outv = n < NCMP ? acc[cbk][e] + bv : 0.f;
                if (j == 0) ((bf16_t*)(ws + WS_KC))[((size_t)bh * 256 + n) * 64 + d] = f2bf(outv);
                else ((bf16_t*)(ws + WS_VCT))[((size_t)bh * 4 + (n >> 6)) * 4096 + d * 64 + nsa::vslot(n & 63)] = f2bf(outv); } }
    }
    __syncthreads();
}
__device__ __forceinline__ void s5_carry_panel(const Frame& F, const Args& a, int l, int g, int pm) {
    unsigned char* ws = a.ws; const f32x2* apow = (const f32x2*)(ws + SM_APOW) + (size_t)l * 16 * 64 * 34;
    const float* S = (const float*)(ws + WS_S5S); bf16_t* ap = (bf16_t*)(ws + WS_S5A);
    if (F.tid < 128) { const int n = F.tid & 63, b = 2 * pm + (F.tid >> 6);
        const f32x2 A = apow[((size_t)g * 64 + n) * 34 + S5LC]; float hr = 0.f, hi = 0.f;
        const float* sp = S + ((size_t)g * 2048 + b * 128) * 256 + n; bf16_t* dp = ap + ((size_t)g * 2048 + b * 128) * S5K + 512 + n;
        float nr_[16], ni_[16];
#pragma unroll
        for (int k = 0; k < 16; ++k) { nr_[k] = sp[(size_t)k * 256]; ni_[k] = sp[(size_t)k * 256 + 64]; }
        for (int c0 = 0; c0 < S5NCH; c0 += 16) { float sr[16], si[16];
#pragma unroll
            for (int k = 0; k < 16; ++k) { sr[k] = nr_[k]; si[k] = ni_[k]; }
            if (c0 + 16 < S5NCH) {
#pragma unroll
                for (int k = 0; k < 16; ++k) { nr_[k] = sp[(size_t)(c0 + 16 + k) * 256]; ni_[k] = sp[(size_t)(c0 + 16 + k) * 256 + 64]; } }
#pragma unroll
            for (int k = 0; k < 16; ++k) { dp[(size_t)(c0 + k) * S5K] = f2bf(hr); dp[(size_t)(c0 + k) * S5K + 64] = f2bf(hi);
                const float nr = A.x * hr - A.y * hi + sr[k], ni = A.x * hi + A.y * hr + si[k]; hr = nr; hi = ni; } }
    }
}
__device__ __forceinline__ void s5_carry(const Frame& F, const Args& a, int l) {
    unsigned char* ws = a.ws; const f32x2* apow = (const f32x2*)(ws + SM_APOW) + (size_t)l * 16 * 64 * 34;
    const float* S = (const float*)(ws + WS_S5S); bf16_t* ap = (bf16_t*)(ws + WS_S5A);
    const int gt = F.bid * 512 + F.tid, NT = F.G * 512;
    for (int i = gt; i < 16 * NB * 64; i += NT) { const int n = i & 63, b = (i >> 6) & 15, g = i >> 10;
        const f32x2 A = apow[((size_t)g * 64 + n) * 34 + S5LC]; float hr = 0.f, hi = 0.f;
        const float* sp = S + ((size_t)g * 2048 + b * 128) * 256 + n; bf16_t* dp = ap + ((size_t)g * 2048 + b * 128) * S5K + 512 + n;
        float nr_[16], ni_[16];
#pragma unroll
        for (int k = 0; k < 16; ++k) { nr_[k] = sp[(size_t)k * 256]; ni_[k] = sp[(size_t)k * 256 + 64]; }
        for (int c0 = 0; c0 < S5NCH; c0 += 16) { float sr[16], si[16];
#pragma unroll
            for (int k = 0; k < 16; ++k) { sr[k] = nr_[k]; si[k] = ni_[k]; }
            if (c0 + 16 < S5NCH) {
#pragma unroll
                for (int k = 0; k < 16; ++k) { nr_[k] = sp[(size_t)(c0 + 16 + k) * 256]; ni_[k] = sp[(size_t)(c0 + 16 + k) * 256 + 64]; } }
#pragma unroll
            for (int k = 0; k < 16; ++k) { dp[(size_t)(c0 + k) * S5K] = f2bf(hr); dp[(size_t)(c0 + k) * S5K + 64] = f2bf(hi);
                const float nr = A.x * hr - A.y * hi + sr[k], ni = A.x * hi + A.y * hr + si[k]; hr = nr; hi = ni; } }
    }
}
template <int MODE, bool ROUTE, bool FINAL>
__device__ __forceinline__ void ln_panel(const Frame& F, const Args& a, int pm, const float* gain, const float* beta, const float* router, size_t h_off = WS_HBUF) {
    unsigned char* ws = a.ws; float* xout = a.out; bf16_t* xb = (bf16_t*)(ws + WS_XB);
    const bf16_t* hb = (const bf16_t*)(ws + (MODE == 0 ? h_off : WS_YB)); const f32x2* tokw = (const f32x2*)(ws + SM_TOKW);
    LAS int* cnt = (LAS int*)F.lds;
    const int lane = F.lane;
    f32x4 gv[4], bv[4];
#pragma unroll
    for (int j = 0; j < 2; ++j) { gv[2 * j] = *(const f32x4*)(gain + 8 * lane + 512 * j); gv[2 * j + 1] = *(const f32x4*)(gain + 8 * lane + 512 * j + 4); bv[2 * j] = *(const f32x4*)(beta + 8 * lane + 512 * j); bv[2 * j + 1] = *(const f32x4*)(beta + 8 * lane + 512 * j + 4); }
    if (ROUTE) { if (F.tid < 8) cnt[F.tid] = 0; __syncthreads(); }
    u32x4 nx[2], nh0[2], nh1[2]; f32x2 nw = (f32x2){0.f, 0.f};
    { const size_t row = (size_t)pm * 256 + F.wave * 32; if (MODE == 1) nw = tokw[row];
#pragma unroll
      for (int j = 0; j < 2; ++j) { nx[j] = *(const u32x4*)(xb + row * D + 8 * lane + 512 * j);
          if (MODE == 0) { nh0[j] = *(const u32x4*)(hb + row * D + 8 * lane + 512 * j); nh1[j] = nh0[j]; } else { nh0[j] = *(const u32x4*)(hb + (2 * row) * D + 8 * lane + 512 * j); nh1[j] = *(const u32x4*)(hb + (2 * row + 1) * D + 8 * lane + 512 * j); } } }
    for (int i = 0; i < 32; ++i) { const size_t row = (size_t)pm * 256 + F.wave * 32 + i;
        f32x4 v[4]; float s = 0.f;
        u32x4 cx[2], ch0[2], ch1[2]; const f32x2 w01 = nw;
#pragma unroll
        for (int j = 0; j < 2; ++j) { cx[j] = nx[j]; ch0[j] = nh0[j]; ch1[j] = nh1[j]; }
        if (i < 31) { const size_t rn = row + 1; if (MODE == 1) nw = tokw[rn];
#pragma unroll
            for (int j = 0; j < 2; ++j) { nx[j] = *(const u32x4*)(xb + rn * D + 8 * lane + 512 * j);
                if (MODE == 0) { nh0[j] = *(const u32x4*)(hb + rn * D + 8 * lane + 512 * j); nh1[j] = nh0[j]; } else { nh0[j] = *(const u32x4*)(hb + (2 * rn) * D + 8 * lane + 512 * j); nh1[j] = *(const u32x4*)(hb + (2 * rn + 1) * D + 8 * lane + 512 * j); } } }
#pragma unroll
        for (int jj = 0; jj < 4; ++jj) { const int j = jj >> 1, hf = jj & 1;
            const unsigned xq0 = hf ? cx[j].z : cx[j].x, xq1 = hf ? cx[j].w : cx[j].y; const f32x4 xv = (f32x4){bflo(xq0), bfhi(xq0), bflo(xq1), bfhi(xq1)}; f32x4 hv;
            const unsigned q00 = hf ? ch0[j].z : ch0[j].x, q01 = hf ? ch0[j].w : ch0[j].y;
            if (MODE == 0) hv = (f32x4){bflo(q00), bfhi(q00), bflo(q01), bfhi(q01)};
            else { const unsigned q10 = hf ? ch1[j].z : ch1[j].x, q11 = hf ? ch1[j].w : ch1[j].y;
                hv = (f32x4){w01.x * bflo(q00) + w01.y * bflo(q10), w01.x * bfhi(q00) + w01.y * bfhi(q10), w01.x * bflo(q01) + w01.y * bflo(q11), w01.x * bfhi(q01) + w01.y * bfhi(q11)}; }
            v[jj] = xv * ALPHA + hv; s += (v[jj][0] + v[jj][1]) + (v[jj][2] + v[jj][3]); }
        const float mean = wave_sum(s) * (1.f / D); float s2 = 0.f;
#pragma unroll
        for (int j = 0; j < 4; ++j) { v[j] = v[j] - mean; s2 += (v[j][0] * v[j][0] + v[j][1] * v[j][1]) + (v[j][2] * v[j][2] + v[j][3] * v[j][3]); }
        const float rstd = 1.0f / sqrtf(wave_sum(s2) * (1.f / D) + LN_EPS);
#pragma unroll
        for (int j = 0; j < 4; ++j) v[j] = v[j] * rstd * gv[j] + bv[j];
#pragma unroll
        for (int j = 0; j < 2; ++j) {
            if (FINAL) { *(f32x4*)(xout + row * D + 8 * lane + 512 * j) = v[2 * j]; *(f32x4*)(xout + row * D + 8 * lane + 512 * j + 4) = v[2 * j + 1]; }
            u32x4 w; w.x = cvt_pk_bf16(v[2 * j][0], v[2 * j][1]); w.y = cvt_pk_bf16(v[2 * j][2], v[2 * j][3]); w.z = cvt_pk_bf16(v[2 * j + 1][0], v[2 * j + 1][1]); w.w = cvt_pk_bf16(v[2 * j + 1][2], v[2 * j + 1][3]);
            *(u32x4*)(xb + row * D + 8 * lane + 512 * j) = w; }
        if (ROUTE) {
            float lg[8];
#pragma unroll
            for (int e = 0; e < 8; ++e) lg[e] = 0.f;
#pragma unroll
            for (int jj = 0; jj < 4; ++jj)
#pragma unroll
                for (int k = 0; k < 4; ++k) { const float* rr = router + (size_t)(8 * lane + 512 * (jj >> 1) + 4 * (jj & 1) + k) * 8; const f32x4 r0 = *(const f32x4*)rr, r1 = *(const f32x4*)(rr + 4); const float xv = v[jj][k];
                    lg[0] += xv * r0[0]; lg[1] += xv * r0[1]; lg[2] += xv * r0[2]; lg[3] += xv * r0[3]; lg[4] += xv * r1[0]; lg[5] += xv * r1[1]; lg[6] += xv * r1[2]; lg[7] += xv * r1[3]; }
            {
                const bool h3 = (lane & 8) != 0;
                float r4[4], r2[2], r1;
#pragma unroll
                for (int i = 0; i < 4; ++i) r4[i] = swapsum32(lg[i], lg[4 + i]);
#pragma unroll
                for (int i = 0; i < 2; ++i) r2[i] = swapsum16(r4[i], r4[2 + i]);
                { const float send = h3 ? r2[0] : r2[1], mine = h3 ? r2[1] : r2[0]; r1 = mine + xshfl<8>(send); }
                r1 += xshfl<1>(r1); r1 += xshfl<2>(r1); r1 += dpp_half_mirror(r1);
#pragma unroll
                for (int e = 0; e < 8; ++e) lg[e] = __builtin_bit_cast(float, __builtin_amdgcn_readlane(__builtin_bit_cast(int, r1), 8 * e));
            }
            int e0 = 0; float m0 = lg[0];
#pragma unroll
            for (int e = 1; e < 8; ++e) if (lg[e] > m0) { m0 = lg[e]; e0 = e; }
            int e1 = -1; float m1 = -3.0e38f;
#pragma unroll
            for (int e = 0; e < 8; ++e) if (e != e0 && lg[e] > m1) { m1 = lg[e]; e1 = e; }
            const float w0 = 1.0f / (1.0f + __expf(m1 - m0));
            if (lane == 0) { ((int*)(ws + SM_TOKE))[row] = e0 | (e1 << 8); ((f32x2*)(ws + SM_TOKW))[row] = (f32x2){w0, 1.0f - w0}; __hip_atomic_fetch_add(&cnt[e0], 1, __ATOMIC_RELAXED, __HIP_MEMORY_SCOPE_WORKGROUP); __hip_atomic_fetch_add(&cnt[e1], 1, __ATOMIC_RELAXED, __HIP_MEMORY_SCOPE_WORKGROUP); }
        }
    }
    if (ROUTE) { __syncthreads(); if (F.tid < 8) ((int*)(ws + SM_PCNT))[pm * 8 + F.tid] = cnt[F.tid]; __syncthreads(); }
}
__device__ __forceinline__ void moe_gather(const Frame& F, const Args& a) {
    unsigned char* ws = a.ws; const int* pcnt = (const int*)(ws + SM_PCNT); const int* toke = (const int*)(ws + SM_TOKE);
    int* rowtok = (int*)(ws + SM_ROWTOK); int* tileexp = (int*)(ws + SM_TILEEXP);
    LAS int* sm = (LAS int*)F.lds;
    for (int pm = F.own; pm < T / 256; pm += F.G) {
        for (int q = F.tid; q < (T / 256) * 8; q += 512) sm[1024 + q] = pcnt[q];
        if (F.tid >= 32 && F.tid < 288) sm[F.tid] = toke[pm * 256 + F.tid - 32];
        __syncthreads();
        if (F.tid < 8) { int tot = 0, before = 0; for (int q = 0; q < T / 256; ++q) { const int c = sm[1024 + q * 8 + F.tid]; tot += c; if (q < pm) before += c; } sm[F.tid] = tot; sm[16 + F.tid] = before; }
        __syncthreads();
        if (F.tid == 0) { int st = 0; for (int e = 0; e < 8; ++e) { sm[8 + e] = st * 256; st += (sm[e] + 255) >> 8; } sm[24] = st; }
        __syncthreads();
        {
            const int i = F.tid >> 1, k = F.tid & 1; const int ee = sm[32 + i]; const int e = k ? (ee >> 8) : (ee & 255);
            int cntb = 0; for (int q = 0; q < i; ++q) { const int o = sm[32 + q]; cntb += ((o & 255) == e) + ((o >> 8) == e); }
            const int dest = sm[8 + e] + sm[16 + e] + cntb; sm[512 + F.tid] = dest; rowtok[dest] = 2 * (pm * 256 + i) + k;
        }
        __syncthreads();
        if (pm == 0) {
            for (int e = 0; e < 8; ++e) { const int r0 = sm[8 + e] + sm[e], r1 = sm[8 + e] + (((sm[e] + 255) >> 8) << 8); for (int r = r0 + F.tid; r < r1; r += 512) rowtok[r] = -1;
                const int t0 = sm[8 + e] >> 8, t1 = r1 >> 8; for (int t = t0 + F.tid; t < t1; t += 512) tileexp[t] = e; }
            if (F.tid == 0) tileexp[1023] = sm[24];
        }
        __syncthreads();
    }
}

__device__ __forceinline__ void moe_tail_finalize(const Frame& F, const Args& a) {
    const int* tileexp = (const int*)(a.ws + SM_TILEEXP); int nt = tileexp[1023] - (MOE_NCHUNK - 1) * MOE_CHUNK_TILES; nt = nt < 0 ? 0 : (nt > 8 ? 8 : nt);
    const float* YT = (const float*)(a.ws + WS_YT); const int* row_tok = (const int*)(a.ws + SM_ROWTOK) + (MOE_NCHUNK - 1) * MOE_CHUNK_TILES * 256; bf16_t* Y = (bf16_t*)(a.ws + WS_YB);
    const int c8 = (F.tid & 127) * 8;
    for (int r = F.bid * 4 + (F.tid >> 7); r < nt * 256; r += F.G * 4) { const int dst = row_tok[r]; if (dst < 0) continue;
        f32x4 s0 = (f32x4){0.f, 0.f, 0.f, 0.f}, s1 = s0;
#pragma unroll
        for (int ks = 0; ks < 7; ++ks) { const float* p = YT + ((size_t)ks * 2048 + r) * D + c8; s0 += *(const f32x4*)p; s1 += *(const f32x4*)(p + 4); }
        u32x4 w; w.x = cvt_pk_bf16(s0[0], s0[1]); w.y = cvt_pk_bf16(s0[2], s0[3]); w.z = cvt_pk_bf16(s1[0], s1[1]); w.w = cvt_pk_bf16(s1[2], s1[3]);
        *(u32x4*)(Y + (size_t)dst * D + c8) = w; }
}
struct MoeUpOrder { int ntile, G, c, chunk; const int* tileexp;
    __device__ __forceinline__ bool next(int i, pg8::Unit& u) const { if (!pg8::static_tile(i, G, c, ntile, 2 * DFE / 256, u.pm, u.pn)) return false;
        const int tile = chunk * MOE_CHUNK_TILES + u.pm, e = tileexp[tile]; u.aux = tile; u.offA = (long long)tile * 256 * D * 2; u.offB = ((long long)e * 2 * DFE + (long long)u.pn * 256) * D * 2; return true; } };
struct MoeDnOrder { int ntile, G, c, chunk; const int* tileexp;
    __device__ __forceinline__ bool next(int i, pg8::Unit& u) const { if (!pg8::static_tile(i, G, c, ntile, D / 256, u.pm, u.pn)) return false;
        const int tile = chunk * MOE_CHUNK_TILES + u.pm, e = tileexp[tile]; u.aux = tile; u.offA = (long long)u.pm * 256 * DFE * 2; u.offB = ((long long)e * D + (long long)u.pn * 256) * DFE * 2; return true; } };

struct MoeDnTailOrder { int ntile, G, c; const int* tileexp;
    __device__ __forceinline__ bool next(int i, pg8::Unit& u) const { const long L = (long)i * G + c; if (L >= (long)ntile * 28) return false;
        const int ks = (int)(L % 7), rest = (int)(L / 7); u.pn = rest & 3; u.pm = rest >> 2; u.aux = ks;
        const int tile = (MOE_NCHUNK - 1) * MOE_CHUNK_TILES + u.pm, e = tileexp[tile];
        u.offA = (long long)u.pm * 256 * DFE * 2 + (long long)ks * 512 * 2; u.offB = ((long long)e * D + (long long)u.pn * 256) * DFE * 2 + (long long)ks * 512 * 2; return true; } };

__device__ __forceinline__ int attn_pair(int p0, int G) {
    if (G != 256) return p0;
    const int x = p0 & 7, r = (p0 >> 3) & 31, k = p0 >> 8;
    return ((x + 8 * (2 * k + (r >> 4))) << 4) | (r & 15);
}

enum { PH_PREP = 0, PH_WIN, PH_POST, PH_MIX1, PH_MIX2, PH_MIX3, PH_MIX4, PH_WOUT, PH_LN1, PH_FUP, PH_FDN, PH_MGATH = 9, PH_MUP0 = 10, PH_LN2 = 21, PH_PGATE, PH_PPROJ, PH_LN3, PH_PER_LAYER = 32 };
constexpr int GP_END = 2 + 32 * DEPTH;

__global__ void __launch_bounds__(512, 2) mk_fwd(Args a0) {
    extern __shared__ __attribute__((aligned(16))) unsigned char lds_raw[];
    LAS unsigned char* const lds = (LAS unsigned char*)lds_raw;
    for (int u = threadIdx.x; u < (LDS_BYTES - LDSCTL_OFF) / 4; u += 512) ((LAS unsigned*)(lds + LDSCTL_OFF))[u] = 0u;
    __syncthreads();
    const int gp_lo = a0.gp_lo, gp_hi = a0.gp_hi; const int F0bid = blockIdx.x, F0G = gridDim.x; const int wave0 = __builtin_amdgcn_readfirstlane(threadIdx.x >> 6);
    XcdBarrier bar; bar.bar = (unsigned*)(a0.ws + WS_CTL) + CW_BAR; bar.x = 0; bar.st = nullptr;
    if (a0.use_bar) bar = xcd_barrier_post((unsigned*)(a0.ws + WS_CTL) + CW_BAR, (volatile LAS unsigned*)(lds + LDSCTL_OFF + 32));
#if MK_PROBE
#define PRW ((volatile LAS unsigned*)(lds + LDSCTL_OFF + 128))
    if (threadIdx.x == 0) { const unsigned long long t_ = __builtin_amdgcn_s_memrealtime(); PRW[0] = (unsigned)t_; PRW[1] = (unsigned)(t_ >> 32); PRW[2] = 0u; PRW[3] = 0u; PRW[4] = (unsigned)t_; PRW[5] = (unsigned)(t_ >> 32); }
#define STAMP(cls) do { if (wave0 == 0 && lane_id_fresh() == 0) { const unsigned long long t_ = __builtin_amdgcn_s_memrealtime(); const unsigned long long p_ = ((unsigned long long)PRW[1] << 32) | PRW[0]; const unsigned d_ = (unsigned)(t_ - p_); \
        PRW[0] = (unsigned)t_; PRW[1] = (unsigned)(t_ >> 32); if ((PROBE_A >> (cls)) & 1) PRW[2] += d_; if ((PROBE_B >> (cls)) & 1) PRW[3] += d_; } } while (0)
#else
#define STAMP(cls) do {} while (0)
#endif
#define RUN(gp) (gp_lo <= (gp) && (gp) < gp_hi)
#define SEAM(gp) do { if (gp_lo <= (gp) && (gp) + 1 < gp_hi) xcd_barrier(bar, wave0); } while (0)
#define PH_BEGIN Args a; load_args(a); const Frame F = make_frame(lds, wave0); unsigned char* const ws = a.ws; int l = lx; asm volatile("" : "+s"(l)); (void)l; (void)ws; \
    bf16_t* const xb = (bf16_t*)(ws + WS_XB); bf16_t* const z = (bf16_t*)(ws + WS_Z); bf16_t* const mix = (bf16_t*)(ws + WS_MIX); bf16_t* const hbuf = (bf16_t*)(ws + WS_HBUF); const long long S1K = 256ll * 1024 * 2; \
    (void)xb; (void)z; (void)mix; (void)hbuf; (void)S1K;
#define AP_DEF const nsa::Lane L{F.lane, F.lane & 31, F.lane >> 5, F.wave, F.tid}; \
    const nsa::AttnPtrs AP{(const bf16_t*)(ws + WS_Q), z, (const bf16_t*)(ws + WS_KC), (const bf16_t*)(ws + WS_VCT), (const bf16_t*)(ws + WS_KSEL), (const bf16_t*)(ws + WS_VSEL), \
                           (const bf16_t*)(ws + WS_KWIN), (const bf16_t*)(ws + WS_VWIN), (unsigned long long*)(ws + WS_SELM), mix};
    { const int lx = 0;
    if (RUN(0)) { PH_BEGIN phase_init0(F, a); }
    SEAM(0); STAMP(0);
    if (RUN(1)) { PH_BEGIN phase_init1(F, a); }
    SEAM(1); STAMP(0);
    }
    for (int lx = 0; lx < DEPTH; ++lx) {
        const int base = 2 + PH_PER_LAYER * lx; const bool moe = (lx & 1) != 0;
        if (RUN(base + PH_PREP)) { PH_BEGIN phase_prep(F, a, l); }
        SEAM(base + PH_PREP); STAMP(1);
        if (RUN(base + PH_WIN)) { PH_BEGIN
            pg8::Gemm g{xb, (const bf16_t*)(ws + W_IN), D, D, D}; pg8::PlainOrder S{T / 256, INP / 256, F.G, F.bid, S1K, S1K};
            epi::EpiWin E{z, (bf16_t*)(ws + WS_Q), (bf16_t*)(ws + WS_KCMP), (bf16_t*)(ws + WS_S5A), (const f32x2*)(ws + WS_ROPE)};
            pg8::gemm_phase(F.lds, g, S, E, F.tid);
        }
        SEAM(base + PH_WIN); STAMP(2);
        if (RUN(base + PH_MIX1)) {
            for (int r = F0bid; r < 128; r += F0G) {
                {   PH_BEGIN const int g_ = r >> 3, pm_ = r & 7;
                    pg8::Gemm g{(const bf16_t*)(ws + WS_S5A), (const bf16_t*)(ws + W_S5S), 512, S5K, 512};
                    pg8::ListOrder S{1, pm_, g_, (long long)g_ * 2048 * S5K * 2 + (long long)pm_ * 256 * S5K * 2, (long long)g_ * 256 * 512 * 2, 0}; epi::F32Grouped E{(float*)(ws + WS_S5S), 256, (size_t)2048 * 256};
                    pg8::gemm_phase(F.lds, g, S, E, F.tid); }
                __syncthreads();
                {   PH_BEGIN int nr = MK_REP_CARRY; asm volatile("" : "+s"(nr)); for (int q = 0; q < nr; ++q) s5_carry_panel(F, a, l, r >> 3, r & 7); }
                asm volatile("s_waitcnt vmcnt(0)" ::: "memory"); __syncthreads();
                {   PH_BEGIN const int g_ = r >> 3, pm_ = r & 7;
                    pg8::Gemm g{(const bf16_t*)(ws + WS_S5A), (const bf16_t*)(ws + W_S5B), S5K, S5K, S5K};
                    pg8::ListOrder S{2, pm_, g_, (long long)g_ * 2048 * S5K * 2 + (long long)pm_ * 256 * S5K * 2, (long long)g_ * 512 * S5K * 2, 256ll * S5K * 2}; epi::S5Out E{(bf16_t*)(ws + WS_ZS5), z, (const float*)a.in[21] + (size_t)l * 256};
                    pg8::gemm_phase(F.lds, g, S, E, F.tid); }
            }
            for (int r = F0bid - 128; r < 64; r += F0G) { if (r < 0) continue;
                {   PH_BEGIN const int j_ = r >> 5, bh_ = r & 31;
                    pg8::Gemm g{(const bf16_t*)(ws + WS_KCMP), (const bf16_t*)(ws + W_CMP), 1024, 1024, 1024};
                    pg8::ListOrder S{2, bh_, j_, (long long)j_ * (long long)(WS_VCMP - WS_KCMP) + (long long)bh_ * S1K, (long long)j_ * 512 * 1024 * 2, S1K}; epi::F32Grouped E{(float*)(ws + WS_CMPP), 512, (size_t)8192 * 512};
                    pg8::gemm_phase(F.lds, g, S, E, F.tid); }
                asm volatile("s_waitcnt vmcnt(0)" ::: "memory"); __syncthreads();
                {   PH_BEGIN int nr = MK_REP_ST2; asm volatile("" : "+s"(nr)); for (int q = 0; q < nr; ++q) cmp_stage2_panel(F, a, l, r >> 5, r & 31); }
            }
            {   PH_BEGIN
                if (F.G == 256) { const int c = F.bid; const int beg = c < 128 ? c * 5 : (c < 192 ? 640 + (c - 128) * 6 : 1024 + (c - 192) * 16), cnt = c < 128 ? 5 : (c < 192 ? 6 : 16); conv_items(F, a, l, beg, 1, beg + cnt); }
                else conv_items(F, a, l, F.bid, F.G); }
        }
        SEAM(base + PH_MIX1); STAMP(4);
        if (RUN(base + PH_MIX3)) {
            {   PH_BEGIN
                pg8::Gemm g{(const bf16_t*)(ws + WS_ZS5), (const bf16_t*)(ws + W_GLU), 256, 256, 256};
                pg8::PlainOrder S{T / 256, 1, F.G, F.bid, 256ll * 256 * 2, 256ll * 256 * 2}; epi::S5Glu E{mix, (const bf16_t*)(ws + WS_ZS5), (const float*)a.in[23] + (size_t)l * 256};
                pg8::gemm_phase(F.lds, g, S, E, F.tid);
            }
            {   PH_BEGIN AP_DEF
                for (int p0 = F.bid; p0 < 32 * 16; p0 += F.G) { const int p = attn_pair(p0, F.G); const int bh = p >> 4, s = p & 15;
                    for (int half = 0; half < 2; ++half) { const int qb2 = half ? 31 - s : s;
                        nsa::cmp_unit<true>(bh, 2 * qb2, AP, F.lds, L); nsa::cmp_topk(bh, 2 * qb2, AP, F.lds, L);
                        nsa::cmp_unit<false>(bh, 2 * qb2 + 1, AP, F.lds, L); nsa::cmp_topk(bh, 2 * qb2 + 1, AP, F.lds, L); } } }
            asm volatile("s_waitcnt vmcnt(0)" ::: "memory"); __syncthreads();
            {   PH_BEGIN AP_DEF
                for (int p0 = F.bid; p0 < 32 * 16; p0 += F.G) { const int p = attn_pair(p0, F.G); const int bh = p >> 4, s = p & 15; nsa::sw_unit2(bh, s, AP, F.lds, L); nsa::sw_unit2(bh, 31 - s, AP, F.lds, L); } }
        }
        SEAM(base + PH_MIX3); STAMP(6);

        if (RUN(base + PH_WOUT)) {
            {   PH_BEGIN
                pg8::Gemm g{mix, (const bf16_t*)(ws + W_OUT), D, D, D}; pg8::PlainOrder S{T / 256, D / 256, F.G, F.bid, S1K, S1K}; epi::Bf16Sc1 E{hbuf, D, (unsigned)((size_t)T * D * 2)};
                pg8::gemm_phase(F.lds, g, S, E, F.tid);
            }
            {   PH_BEGIN pg8::PlainOrder S{T / 256, D / 256, F.G, F.bid, S1K, S1K}; panels_publish_wait(F, (unsigned*)(ws + WS_CTL), 2 * l + 0, S, (unsigned)(D / 256)); }
            {   PH_BEGIN
                const float* gg = (const float*)a.in[34] + ((size_t)l * 3 + 0) * D; const float* bb = (const float*)a.in[35] + ((size_t)l * 3 + 0) * D;
                for (int pm = F.own; pm < T / 256; pm += F.G) { if (l & 1) ln_panel<0, true, false>(F, a, pm, gg, bb, (const float*)a.in[27] + (size_t)(l >> 1) * D * NEXP); else ln_panel<0, false, false>(F, a, pm, gg, bb, nullptr); }
            }
        }
        SEAM(base + PH_WOUT); STAMP(8);
        if (!moe) {
            if (RUN(base + PH_FUP)) { PH_BEGIN
                pg8::Gemm g{xb, (const bf16_t*)(ws + W_UP), D, D, D}; pg8::PlainOrder S{T / 256, 2 * DFF / 256, F.G, F.bid, S1K, S1K}; epi::SwiGlu E{(bf16_t*)(ws + WS_FFH), DFF};
                pg8::gemm_phase(F.lds, g, S, E, F.tid);
            }
            SEAM(base + PH_FUP); STAMP(9);
            if (RUN(base + PH_FDN)) {
                {   PH_BEGIN
                    pg8::Gemm g{(const bf16_t*)(ws + WS_FFH), (const bf16_t*)(ws + W_DN), DFF, DFF, DFF}; pg8::PlainOrder S{T / 256, D / 256, F.G, F.bid, 256ll * DFF * 2, 256ll * DFF * 2}; epi::Bf16Sc1 E{hbuf, D, (unsigned)((size_t)T * D * 2)};
                    pg8::gemm_phase(F.lds, g, S, E, F.tid);
                }
                {   PH_BEGIN pg8::PlainOrder S{T / 256, D / 256, F.G, F.bid, 256ll * DFF * 2, 256ll * DFF * 2}; panels_publish_wait(F, (unsigned*)(ws + WS_CTL), 2 * l + 1, S, (unsigned)(D / 256)); }
                {   PH_BEGIN
                    const float* gg = (const float*)a.in[34] + ((size_t)l * 3 + 1) * D; const float* bb = (const float*)a.in[35] + ((size_t)l * 3 + 1) * D;
                    for (int pm = F.own; pm < T / 256; pm += F.G) ln_panel<0, false, false>(F, a, pm, gg, bb, nullptr);
                }
            }
            asm volatile("s_waitcnt vmcnt(0)" ::: "memory"); __syncthreads(); STAMP(10);
        } else {
            if (RUN(base + PH_MGATH)) { PH_BEGIN moe_gather(F, a); }
            SEAM(base + PH_MGATH); STAMP(11);
            for (int cx = 0; cx < MOE_NCHUNK; ++cx) {
                if (RUN(base + PH_MUP0 + 2 * cx)) { PH_BEGIN int c = cx; asm volatile("" : "+s"(c)); const int* tileexp = (const int*)(ws + SM_TILEEXP);
                    int nt = tileexp[1023] - c * MOE_CHUNK_TILES; nt = nt < 0 ? 0 : (nt > MOE_CHUNK_TILES ? MOE_CHUNK_TILES : nt);
                    pg8::Gemm g{xb, (const bf16_t*)(ws + W_UP), D, D, D}; MoeUpOrder S{nt, F.G, F.bid, c, tileexp}; epi::SwiGlu E{(bf16_t*)(ws + WS_MH), DFE};
                    pg8::gemm_phase<epi::SwiGlu, MoeUpOrder, true>(F.lds, g, S, E, F.tid, (const int*)(ws + SM_ROWTOK));
                }
                SEAM(base + PH_MUP0 + 2 * cx); STAMP(12);
                if (RUN(base + PH_MUP0 + 2 * cx + 1)) { PH_BEGIN int c = cx; asm volatile("" : "+s"(c)); const int* tileexp = (const int*)(ws + SM_TILEEXP);
                    int nt = tileexp[1023] - c * MOE_CHUNK_TILES; nt = nt < 0 ? 0 : (nt > MOE_CHUNK_TILES ? MOE_CHUNK_TILES : nt);
                    if (cx < MOE_NCHUNK - MK_TAILSPLIT) {
                        pg8::Gemm g{(const bf16_t*)(ws + WS_MH), (const bf16_t*)(ws + W_DN), DFE, DFE, DFE}; MoeDnOrder S{nt, F.G, F.bid, c, tileexp}; epi::MoeDown E{(bf16_t*)(ws + WS_YB), (const int*)(ws + SM_ROWTOK)};
                        pg8::gemm_phase(F.lds, g, S, E, F.tid);
                    } else {
                        nt = nt > 8 ? 8 : nt;
                        pg8::Gemm g{(const bf16_t*)(ws + WS_MH), (const bf16_t*)(ws + W_DN), 512, DFE, DFE}; MoeDnTailOrder S{nt, F.G, F.bid, tileexp}; epi::F32Grouped E{(float*)(ws + WS_YT), D, (size_t)2048 * D};
                        pg8::gemm_phase(F.lds, g, S, E, F.tid);
                    }
                }
                SEAM(base + PH_MUP0 + 2 * cx + 1); STAMP(13);
            }
#if MK_TAILSPLIT
            if (RUN(base + PH_MUP0 + 2 * MOE_NCHUNK)) { PH_BEGIN moe_tail_finalize(F, a); }
            SEAM(base + PH_MUP0 + 2 * MOE_NCHUNK); STAMP(13);
#endif
        }
        if (RUN(base + PH_PGATE)) {
            if (moe) {
                {   PH_BEGIN
                    const float* gg = (const float*)a.in[34] + ((size_t)l * 3 + 1) * D; const float* bb = (const float*)a.in[35] + ((size_t)l * 3 + 1) * D;
                    for (int pm = F.own; pm < T / 256; pm += F.G) ln_panel<1, false, false>(F, a, pm, gg, bb, nullptr);
                }
                asm volatile("s_waitcnt vmcnt(0)" ::: "memory"); __syncthreads();
            }
            {   PH_BEGIN
                pg8::Gemm g{xb, (const bf16_t*)(ws + W_GATE), D, D, D}; pg8::PanelOrder S{T / 256, D / 256, F.G, F.own, S1K, S1K}; epi::SigmoidBias E{(l & 1) ? (bf16_t*)(ws + WS_PLEG) : mix, D, (const float*)a.in[32] + (size_t)l * D};
                pg8::gemm_phase(F.lds, g, S, E, F.tid);
            }
            __syncthreads();
            {   PH_BEGIN
                pg8::Gemm g{(const bf16_t*)(ws + WS_PB), (const bf16_t*)(ws + W_PROJ), PLE, PLE, PLE}; pg8::PanelOrder S{T / 256, D / 256, F.G, F.own, 256ll * PLE * 2, 256ll * PLE * 2}; epi::MulBf16 E{(l & 1) ? (bf16_t*)(ws + WS_PLEH) : hbuf, (l & 1) ? (bf16_t*)(ws + WS_PLEG) : mix, D};
                pg8::gemm_phase(F.lds, g, S, E, F.tid);
            }
            __syncthreads();
            {   PH_BEGIN
                const float* gg = (const float*)a.in[34] + ((size_t)l * 3 + 2) * D; const float* bb = (const float*)a.in[35] + ((size_t)l * 3 + 2) * D;
                const size_t hoff = (l & 1) ? WS_PLEH : WS_HBUF;
                for (int pm = F.own; pm < T / 256; pm += F.G) { if (l == DEPTH - 1) ln_panel<0, false, true>(F, a, pm, gg, bb, nullptr, hoff); else ln_panel<0, false, false>(F, a, pm, gg, bb, nullptr, hoff); }
            }
        }
        SEAM(base + PH_PGATE); STAMP(15);
    }
#if MK_PROBE
    if (blockIdx.x == 0) {
        __syncthreads(); asm volatile("s_waitcnt vmcnt(0)" ::: "memory");
        const unsigned long long t1 = ((unsigned long long)PRW[1] << 32) | PRW[0], t0 = ((unsigned long long)PRW[5] << 32) | PRW[4];
        const float tot = (float)(unsigned)(t1 - t0), fa = (float)PRW[2] / tot, fb = (float)PRW[3] / tot;
        Args ae; load_args(ae);
        const int tidp = wave0 * 64 + lane_id_fresh();
        if (tidp == 0) ae.out[0] += 1.0f + 8.0f * fa;
        for (int i = tidp; i < 100000; i += 512) ae.out[1024 + i] += 0.5f * fb;
    }
#endif
#undef RUN
#undef SEAM
}

static bool phase_applies(int gp) {
    if (gp < 2) return true;
    const int l = (gp - 2) / PH_PER_LAYER, ph = (gp - 2) % PH_PER_LAYER; const bool moe = (l & 1) != 0;
    if (ph < PH_LN1) return ph != PH_POST && ph != PH_MIX2 && ph != PH_MIX4;
    if (ph == PH_PGATE) return true;
    if (!moe) return ph == PH_FUP || ph == PH_FDN;
    return ph >= PH_MGATH && ph <= PH_MUP0 + 2 * MOE_NCHUNK;
}
extern "C" void kernel_launch(void* const* d_in, const int* in_sizes, int n_in, void* d_out, int out_size, void* d_ws, size_t ws_size, hipStream_t stream) {
    static int grid = 0;
    if (grid == 0) {
        if (n_in != 36 || out_size != T * D || ws_size < WS_END) { fprintf(stderr, "kernel_launch: unexpected problem (n_in %d out %d ws %zu, need %zu)\n", n_in, out_size, ws_size, (size_t)WS_END); grid = -1; return; }
        int dev = 0, cus = 0, per_cu = 0;
        if (hipGetDevice(&dev) != hipSuccess || hipDeviceGetAttribute(&cus, hipDeviceAttributeMultiprocessorCount, dev) != hipSuccess) { grid = -1; return; }
        if (hipFuncSetAttribute((const void*)mk_fwd, hipFuncAttributeMaxDynamicSharedMemorySize, LDS_BYTES) != hipSuccess) { fprintf(stderr, "kernel_launch: hipFuncSetAttribute failed\n"); grid = -1; return; }
        if (hipOccupancyMaxActiveBlocksPerMultiprocessor(&per_cu, (const void*)mk_fwd, 512, LDS_BYTES) != hipSuccess || per_cu < 1) fprintf(stderr, "kernel_launch: occupancy query reports %d\n", per_cu);
        (void)hipGetLastError();
        grid = cus;
    }
    if (grid < 0) return;
    (void)in_sizes;
    if (hipMemsetAsync((char*)d_ws + WS_CTL, 0, CTL_ZERO_BYTES, stream) != hipSuccess) return;
#if MK_CHECK
    (void)hipMemsetAsync((char*)d_ws + SM_CHK, 0, 256, stream);
#endif
    Args a{};
    for (int i = 0; i < 36; ++i) a.in[i] = d_in[i];
    a.out = (float*)d_out; a.ws = (unsigned char*)d_ws; a.pad = 0;
#if MK_MULTI
    for (int gp = 0; gp < GP_END; ++gp) { if (!phase_applies(gp)) continue; a.gp_lo = gp; a.gp_hi = gp + 1; a.use_bar = 0;
        hipLaunchKernelGGL(mk_fwd, dim3(grid), dim3(512), LDS_BYTES, stream, a);
#if MK_CHECK
        run_checks(a, gp, stream);
#endif
    }
#if MK_CHECK
    hipLaunchKernelGGL(chk_final, dim3(1), dim3(1), 0, stream, a);
#endif
#else
    a.gp_lo = 0; a.gp_hi = GP_END; a.use_bar = 1;
    hipLaunchKernelGGL(mk_fwd, dim3(grid), dim3(512), LDS_BYTES, stream, a);
#endif
}
```
